# Optimizing an MI355X kernel written in HIP

```python
import math
import jax, jax.numpy as jnp
from jax import lax
import numpy as np

D_MODEL = 1024
BATCH = 2
SEQ = 8192
DEPTH = 2

N_META = 16
GRID_W = 64
HEAD_DIM = 64
NA_WIDTH = D_MODEL // 2
NA_HEADS = NA_WIDTH // HEAD_DIM
NA_WIN_ROWS = 8
NA_WIN_COLS = 16
RWKV_WIDTH = D_MODEL // 2
RWKV_HEADS = RWKV_WIDTH // HEAD_DIM
RWKV_W_RANK = 64
RWKV_A_RANK = 64
RWKV_G_RANK = 128
MIX_WIDTH = NA_WIDTH + RWKV_WIDTH
SHIFT_COLS = 3 * RWKV_WIDTH + RWKV_W_RANK + RWKV_A_RANK + RWKV_G_RANK
IN_COLS = 3 * NA_WIDTH + SHIFT_COLS
S5_GROUP_CH = 16
S5_GROUPS = D_MODEL // S5_GROUP_CH
S5_STATE = 64
MOE_GROUPS = 4
MOE_PER_GROUP = 8
MOE_EXPERTS = MOE_GROUPS * MOE_PER_GROUP
MOE_TOP_K = 2
MOE_D_FF = D_MODEL // 2
MOE_BLOCK = 128
NORM_EPS = 1e-6
RWKV_GN_EPS = 64e-5
NEG_INF = -1e30

kernel_name = 'hybrid_na_rwkv7_s5_hmoe_encoder'


def rms_norm(x, gain):
    xf = x.astype(jnp.float32)
    y = xf * lax.rsqrt(jnp.mean(xf * xf, axis=-1, keepdims=True) + NORM_EPS)
    return (y * gain.astype(jnp.float32)).astype(x.dtype)


def centred_token_shift(p, mu):
    pad = jnp.pad(p, ((0, 0), (1, 1), (0, 0)))
    nb = 0.5 * (pad[:, :-2] + pad[:, 2:])
    return p + mu.astype(p.dtype) * (nb - p)


def neighbourhood_attention(q, k, v, rpb):
    Bsz, L, H, Dh = q.shape
    T = L - N_META
    rows = T // GRID_W
    wr = min(NA_WIN_ROWS, rows)
    scale = Dh ** -0.5
    f32 = jnp.float32
    grid = lambda t: t[:, N_META:].reshape(Bsz, rows, GRID_W, H, Dh)
    qm, km, vm = q[:, :N_META], k[:, :N_META], v[:, :N_META]
    qg, kg, vg = grid(q), grid(k), grid(v)
    r_ids = jnp.arange(rows)
    row_idx = jnp.clip(r_ids - wr // 2, 0, rows - wr)[:, None] + jnp.arange(wr)[None, :]
    kb = kg[:, row_idx].reshape(Bsz, rows, wr * GRID_W, H, Dh)
    vb = vg[:, row_idx].reshape(Bsz, rows, wr * GRID_W, H, Dh)
    c_ids = jnp.arange(GRID_W)
    c_start = jnp.clip(c_ids - NA_WIN_COLS // 2, 0, GRID_W - NA_WIN_COLS)
    in_band = (c_ids[None, :] >= c_start[:, None]) & (c_ids[None, :] < c_start[:, None] + NA_WIN_COLS)
    dr = row_idx - r_ids[:, None] + NA_WIN_ROWS - 1
    dc = jnp.clip(c_ids[None, :] - c_ids[:, None] + NA_WIN_COLS - 1, 0, 2 * NA_WIN_COLS - 2)
    bias = rpb.astype(f32)[:, dr[:, None, :, None], dc[None, :, None, :]]
    bias = jnp.where(in_band[None, None, :, None, :], bias, NEG_INF).reshape(H, rows, GRID_W, wr * GRID_W)
    s_grid = jnp.einsum('brqhd,brkhd->bhrqk', qg, kb).astype(f32) * scale + bias[None]
    s_meta = jnp.einsum('brqhd,bmhd->bhrqm', qg, km).astype(f32) * scale
    p = jax.nn.softmax(jnp.concatenate([s_meta, s_grid], axis=-1), axis=-1).astype(v.dtype)
    o_grid = (jnp.einsum('bhrqm,bmhd->brqhd', p[..., :N_META], vm)
              + jnp.einsum('bhrqk,brkhd->brqhd', p[..., N_META:], vb))
    s_mm = jnp.einsum('bqhd,bkhd->bhqk', qm, km).astype(f32) * scale
    o_meta = jnp.einsum('bhqk,bkhd->bqhd', jax.nn.softmax(s_mm, axis=-1).astype(v.dtype), vm)
    return jnp.concatenate([o_meta, o_grid.reshape(Bsz, T, H, Dh)], axis=1)


def _rwkv7_step(S, inp):
    w_t, kk_t, a_t, k_t, v_t, r_t = inp
    sa = jnp.einsum('dbhvk,dbhk->dbhv', S, -kk_t)
    S = (S * w_t[..., None, :] + sa[..., :, None] * (kk_t * a_t)[..., None, :]
         + v_t[..., :, None] * k_t[..., None, :])
    y = jnp.einsum('dbhvk,dbhk->dbhv', S, r_t)
    return S, y


def rwkv7_bidir(r, k, v, w_lo, a_lo, g_lo, w0, w_up, a0, a_up, g_up, k_k, k_a, r_k, lnx_g, lnx_b):
    Bsz, L, C = r.shape
    out_dtype = r.dtype
    f = lambda t: t.astype(jnp.float32)
    r, k, v, w_lo, a_lo, g_lo = f(r), f(k), f(v), f(w_lo), f(a_lo), f(g_lo)
    w_log = -jax.nn.softplus(-(f(w0)[:, None, None, :]
                               + jnp.einsum('blr,drc->dblc', jnp.tanh(w_lo), f(w_up)))) - 0.5
    decay = jnp.exp(-jnp.exp(w_log))
    a = jax.nn.sigmoid(f(a0)[:, None, None, :] + jnp.einsum('blr,drc->dblc', a_lo, f(a_up)))
    g = jax.nn.sigmoid(g_lo) @ f(g_up)
    hd = lambda t: t.reshape(t.shape[:-1] + (RWKV_HEADS, HEAD_DIM))
    kk = hd(k * f(k_k))
    kk = kk / jnp.maximum(jnp.sqrt(jnp.sum(kk * kk, axis=-1, keepdims=True)), 1e-12)
    k_dir = hd(k[None] * (1.0 + (a - 1.0) * f(k_a)))
    rh, vh = hd(r), hd(v)

    def both(t):
        return jnp.stack([t, jnp.flip(t, axis=1)])

    def per(t):
        return jnp.stack([t[0], jnp.flip(t[1], axis=1)])

    xs = (per(hd(decay)), both(kk), per(hd(a)), per(k_dir), both(vh), both(rh))
    xs = tuple(jnp.moveaxis(t, 2, 0) for t in xs)
    S0 = jnp.zeros((2, Bsz, RWKV_HEADS, HEAD_DIM, HEAD_DIM), jnp.float32)
    _, ys = lax.scan(_rwkv7_step, S0, xs)
    y = per(jnp.moveaxis(ys, 0, 2)).sum(axis=0)
    mean = jnp.mean(y, axis=-1, keepdims=True)
    var = jnp.mean(jnp.square(y - mean), axis=-1, keepdims=True)
    y = ((y - mean) * lax.rsqrt(var + RWKV_GN_EPS)).reshape(Bsz, L, C) * f(lnx_g) + f(lnx_b)
    bonus = (jnp.sum(rh[None] * k_dir * f(r_k), axis=-1, keepdims=True) * vh[None]).sum(axis=0)
    return ((y + bonus.reshape(Bsz, L, C)) * g).astype(out_dtype)


def na_rwkv_mixer(hn, w_in, w_out, rpb, mu, w0, w_up, a0, a_up, g_up, k_k, k_a, r_k, lnx_g, lnx_b):
    Bsz, L, _ = hn.shape
    proj = hn @ w_in
    q, k, v, rest = jnp.split(proj, [NA_WIDTH, 2 * NA_WIDTH, 3 * NA_WIDTH], axis=-1)
    rest = centred_token_shift(rest, mu)
    C = RWKV_WIDTH
    r, kr, vr, w_lo, a_lo, g_lo = jnp.split(
        rest, [C, 2 * C, 3 * C, 3 * C + RWKV_W_RANK, 3 * C + RWKV_W_RANK + RWKV_A_RANK], axis=-1)
    heads = lambda t: t.reshape(Bsz, L, NA_HEADS, HEAD_DIM)
    na = neighbourhood_attention(heads(q), heads(k), heads(v), rpb).reshape(Bsz, L, NA_WIDTH)
    rw = rwkv7_bidir(r, kr, vr, w_lo, a_lo, g_lo, w0, w_up, a0, a_up, g_up, k_k, k_a, r_k, lnx_g, lnx_b)
    return jnp.concatenate([na, rw], axis=-1) @ w_out


def _complex_linear_combine(e1, e2):
    a1r, a1i, b1r, b1i = e1
    a2r, a2i, b2r, b2i = e2
    return (a2r * a1r - a2i * a1i, a2r * a1i + a2i * a1r,
            a2r * b1r - a2i * b1i + b2r, a2r * b1i + a2i * b1r + b2i)


def s5_mixer(hn, b_re, b_im, lam_re, lam_im, log_step, c_re, c_im, d, w_glu):
    Bsz, L, Dm = hn.shape
    f32 = jnp.float32
    u = hn.astype(f32)
    ug = u.reshape(Bsz, L, S5_GROUPS, S5_GROUP_CH)
    lr, li = lam_re.astype(f32), lam_im.astype(f32)
    step = jnp.exp(log_step.astype(f32))[..., None]
    mag = jnp.exp(lr * step)
    ab_re, ab_im = mag * jnp.cos(li * step), mag * jnp.sin(li * step)
    den = lr * lr + li * li
    z_re = ((ab_re - 1.0) * lr + ab_im * li) / den
    z_im = (ab_im * lr - (ab_re - 1.0) * li) / den
    br, bi = b_re.astype(f32)[None], b_im.astype(f32)[None]
    bb_re = z_re[..., None] * br - z_im[..., None] * bi
    bb_im = z_re[..., None] * bi + z_im[..., None] * br

    def per(t):
        return jnp.stack([t[0], jnp.flip(t[1], axis=1)])

    bu_re = per(jnp.einsum('dgpi,blgi->dblgp', bb_re, ug))
    bu_im = per(jnp.einsum('dgpi,blgi->dblgp', bb_im, ug))
    a_re = jnp.broadcast_to(ab_re[:, None, None], (2, 1, L, S5_GROUPS, S5_STATE))
    a_im = jnp.broadcast_to(ab_im[:, None, None], (2, 1, L, S5_GROUPS, S5_STATE))
    _, _, s_re, s_im = lax.associative_scan(_complex_linear_combine, (a_re, a_im, bu_re, bu_im), axis=2)
    y_dir = (jnp.einsum('dgip,dblgp->dblgi', c_re.astype(f32), s_re)
             - jnp.einsum('dgip,dblgp->dblgi', c_im.astype(f32), s_im))
    y = per(y_dir).sum(axis=0).reshape(Bsz, L, Dm) + d.astype(f32) * u
    hcat = jax.nn.gelu(y).astype(hn.dtype) @ w_glu
    return hcat[..., :Dm] * jax.nn.sigmoid(hcat[..., Dm:])


def hierarchical_moe(h, w_group, b_group, w_expert, b_expert, w1, w3, w2):
    Bsz, L, Dm = h.shape
    n_tok = Bsz * L
    n_assign = n_tok * MOE_TOP_K
    f32 = jnp.float32
    hf = h.reshape(n_tok, Dm)
    pg = jax.nn.softmax((hf @ w_group).astype(f32) + b_group.astype(f32), axis=-1)
    grp = jnp.argmax(pg, axis=-1)
    p_grp = jnp.take_along_axis(pg, grp[:, None], axis=-1)
    le_all = jnp.einsum('nd,gde->nge', hf, w_expert).astype(f32) + b_expert.astype(f32)
    le = jnp.take_along_axis(le_all, grp[:, None, None], axis=1)[:, 0]
    top_p, top_i = lax.top_k(jax.nn.softmax(le, axis=-1), MOE_TOP_K)
    gates = p_grp * top_p / jnp.sum(top_p, axis=-1, keepdims=True)
    flat_e = (grp[:, None] * MOE_PER_GROUP + top_i).reshape(-1)
    flat_g = gates.reshape(-1)
    flat_tok = jnp.repeat(jnp.arange(n_tok), MOE_TOP_K)
    order = jnp.argsort(flat_e)
    se, stok, sg = flat_e[order], flat_tok[order], flat_g[order]
    counts = jnp.bincount(flat_e, length=MOE_EXPERTS)
    padded = (counts + MOE_BLOCK - 1) // MOE_BLOCK * MOE_BLOCK
    pad_end = jnp.cumsum(padded)
    pad_start = pad_end - padded
    start = jnp.cumsum(counts) - counts
    dest = pad_start[se] + jnp.arange(n_assign) - start[se]
    n_blocks = -(-n_assign // MOE_BLOCK) + MOE_EXPERTS
    n_rows = n_blocks * MOE_BLOCK
    xbuf = jnp.zeros((n_rows, Dm), h.dtype).at[dest].set(hf[stok])
    blk_e = jnp.minimum(jnp.searchsorted(pad_end, jnp.arange(n_blocks) * MOE_BLOCK, side='right'),
                        MOE_EXPERTS - 1)

    def expert_block(args):
        xb, e = args
        return (jax.nn.silu(xb @ w1[e]) * (xb @ w3[e])) @ w2[e]

    ybuf = lax.map(expert_block, (xbuf.reshape(n_blocks, MOE_BLOCK, Dm), blk_e)).reshape(n_rows, Dm)
    y = ybuf[dest] * sg[:, None].astype(h.dtype)
    return jax.ops.segment_sum(y, stok, num_segments=n_tok).reshape(Bsz, L, Dm)


def setup_inputs(seed: int = 0) -> dict:
    key = jax.random.key(seed)
    keys = jax.random.split(key, 48)
    counter = [0]

    def nxt():
        kk = keys[counter[0]]
        counter[0] += 1
        return kk

    nrm = lambda shape, s: jax.random.normal(nxt(), shape, jnp.float32) * s
    uni = lambda shape, lo, hi: jax.random.uniform(nxt(), shape, jnp.float32, lo, hi)
    ne, no = (DEPTH + 1) // 2, DEPTH // 2
    C, G, P, I = RWKV_WIDTH, S5_GROUPS, S5_STATE, S5_GROUP_CH
    E, F = MOE_EXPERTS, MOE_D_FF
    return {
        'x': nrm((BATCH, SEQ, D_MODEL), 1.0),
        'meta_tokens': nrm((N_META, D_MODEL), 1.0),
        'norm_mix': 1.0 + nrm((DEPTH, D_MODEL), 0.05),
        'norm_ffn': 1.0 + nrm((DEPTH, D_MODEL), 0.05),
        'norm_final': 1.0 + nrm((D_MODEL,), 0.05),
        'mix_w_in': nrm((ne, D_MODEL, IN_COLS), D_MODEL ** -0.5),
        'mix_w_out': nrm((ne, MIX_WIDTH, D_MODEL), MIX_WIDTH ** -0.5),
        'na_rpb': nrm((ne, NA_HEADS, 2 * NA_WIN_ROWS - 1, 2 * NA_WIN_COLS - 1), 0.5),
        'rwkv_mu': uni((ne, SHIFT_COLS), 0.0, 1.0),
        'rwkv_w0': uni((ne, 2, C), -6.0, -1.0),
        'rwkv_w_up': nrm((ne, 2, RWKV_W_RANK, C), 0.1),
        'rwkv_a0': nrm((ne, 2, C), 0.5),
        'rwkv_a_up': nrm((ne, 2, RWKV_A_RANK, C), 0.1),
        'rwkv_g_up': nrm((ne, RWKV_G_RANK, C), RWKV_G_RANK ** -0.5),
        'rwkv_k_k': 0.85 + nrm((ne, C), 0.05),
        'rwkv_k_a': 1.0 + nrm((ne, C), 0.05),
        'rwkv_r_k': nrm((ne, RWKV_HEADS, HEAD_DIM), 0.1),
        'rwkv_lnx_g': 1.0 + nrm((ne, C), 0.05),
        'rwkv_lnx_b': nrm((ne, C), 0.02),
        's5_b_re': nrm((no, G, P, I), (2 * I) ** -0.5),
        's5_b_im': nrm((no, G, P, I), (2 * I) ** -0.5),
        's5_lambda_re': -0.5 + nrm((no, 2, G, P), 0.01),
        's5_lambda_im': math.pi * jnp.arange(P, dtype=jnp.float32) + nrm((no, 2, G, P), 0.01),
        's5_log_step': uni((no, 2, G), math.log(1e-3), math.log(1e-1)),
        's5_c_re': nrm((no, 2, G, I, P), P ** -0.5),
        's5_c_im': nrm((no, 2, G, I, P), P ** -0.5),
        's5_d': nrm((no, D_MODEL), 1.0),
        's5_w_glu': nrm((no, D_MODEL, 2 * D_MODEL), D_MODEL ** -0.5),
        'moe_w_group': nrm((DEPTH, D_MODEL, MOE_GROUPS), D_MODEL ** -0.5),
        'moe_b_group': nrm((DEPTH, MOE_GROUPS), 0.01),
        'moe_w_expert': nrm((DEPTH, MOE_GROUPS, D_MODEL, MOE_PER_GROUP), D_MODEL ** -0.5),
        'moe_b_expert': nrm((DEPTH, MOE_GROUPS, MOE_PER_GROUP), 0.01),
        'moe_w1': nrm((DEPTH, E, D_MODEL, F), D_MODEL ** -0.5),
        'moe_w3': nrm((DEPTH, E, D_MODEL, F), D_MODEL ** -0.5),
        'moe_w2': nrm((DEPTH, E, F, D_MODEL), F ** -0.5),
    }


def reference(x, meta_tokens, norm_mix, norm_ffn, norm_final, mix_w_in, mix_w_out, na_rpb, rwkv_mu,
              rwkv_w0, rwkv_w_up, rwkv_a0, rwkv_a_up, rwkv_g_up, rwkv_k_k, rwkv_k_a, rwkv_r_k,
              rwkv_lnx_g, rwkv_lnx_b, s5_b_re, s5_b_im, s5_lambda_re, s5_lambda_im, s5_log_step,
              s5_c_re, s5_c_im, s5_d, s5_w_glu, moe_w_group, moe_b_group, moe_w_expert, moe_b_expert,
              moe_w1, moe_w3, moe_w2):
    Bsz = x.shape[0]
    meta = jnp.broadcast_to(meta_tokens.astype(x.dtype)[None], (Bsz, N_META, D_MODEL))
    h = jnp.concatenate([meta, x], axis=1)
    for layer in range(DEPTH):
        i = layer // 2
        hn = rms_norm(h, norm_mix[layer])
        if layer % 2 == 0:
            mix = na_rwkv_mixer(hn, mix_w_in[i], mix_w_out[i], na_rpb[i], rwkv_mu[i], rwkv_w0[i],
                                rwkv_w_up[i], rwkv_a0[i], rwkv_a_up[i], rwkv_g_up[i], rwkv_k_k[i],
                                rwkv_k_a[i], rwkv_r_k[i], rwkv_lnx_g[i], rwkv_lnx_b[i])
        else:
            mix = s5_mixer(hn, s5_b_re[i], s5_b_im[i], s5_lambda_re[i], s5_lambda_im[i], s5_log_step[i],
                           s5_c_re[i], s5_c_im[i], s5_d[i], s5_w_glu[i])
        h = h + mix
        h = h + hierarchical_moe(rms_norm(h, norm_ffn[layer]), moe_w_group[layer], moe_b_group[layer],
                                 moe_w_expert[layer], moe_b_expert[layer], moe_w1[layer],
                                 moe_w3[layer], moe_w2[layer])
    return rms_norm(h, norm_final)[:, N_META:]
```

```cpp
#include <hip/hip_runtime.h>
#include <stdint.h>
#include <stdio.h>

#define DM 1024
#define NB 2
#define SEQ 8192
#define NMETA 16
#define LSEQ (SEQ + NMETA)
#define NMAIN (NB * SEQ)
#define NT (NB * LSEQ)
#define INCOLS 3328
#define RESTC 1792
#define NEXP 32
#define DFF 512
#define S5TC 48
#define S5NC 171
#define MOE_RT 128
#define MOE_MAXROWS 36992

typedef unsigned short bf16_t;
typedef short bf16x8 __attribute__((ext_vector_type(8)));
typedef float f32x4 __attribute__((ext_vector_type(4)));
typedef unsigned u32x4 __attribute__((ext_vector_type(4)));
typedef unsigned u32x2 __attribute__((ext_vector_type(2)));

constexpr size_t MiB = 1u << 20;
constexpr size_t WS_CTL = 0;
constexpr size_t WS_H = 1 * MiB;
constexpr size_t WS_HN = 69 * MiB;
constexpr size_t WS_A2 = 103 * MiB;
constexpr size_t WS_BIG = 137 * MiB;
constexpr size_t WS_Q = WS_BIG + 0 * MiB;
constexpr size_t WS_K = WS_BIG + 17 * MiB;
constexpr size_t WS_V = WS_BIG + 34 * MiB;
constexpr size_t WS_REST = WS_BIG + 51 * MiB;
constexpr size_t WS_YFB = WS_REST;
constexpr size_t WS_R = WS_BIG + 110 * MiB;
constexpr size_t WS_VV = WS_BIG + 127 * MiB;
constexpr size_t WS_KK = WS_BIG + 144 * MiB;
constexpr size_t WS_KKA = WS_BIG + 161 * MiB;
constexpr size_t WS_KD = WS_BIG + 195 * MiB;
constexpr size_t WS_W = WS_BIG + 229 * MiB;
constexpr size_t WS_G = WS_BIG + 297 * MiB;
constexpr size_t WS_KR = WS_BIG + 314 * MiB;
constexpr size_t WS_LOW = WS_BIG + 331 * MiB;
constexpr size_t WS_BC = WS_BIG + 340 * MiB;
constexpr size_t WS_AA = WS_Q;
constexpr size_t WS_HB = WS_BIG + 0 * MiB;
constexpr size_t WS_YB = WS_BIG + 40 * MiB;
constexpr size_t WS_ROWTOK = WS_BIG + 120 * MiB;
constexpr size_t WS_EID = WS_BIG + 121 * MiB;
constexpr size_t WS_POS = WS_BIG + 122 * MiB;
constexpr size_t WS_DEST = WS_BIG + 123 * MiB;
constexpr size_t WS_GATE = WS_BIG + 124 * MiB;
constexpr size_t WS_YS = WS_BIG + 130 * MiB;
constexpr size_t WS_END = WS_BIG + 262 * MiB;
constexpr size_t WS_CARRY = WS_BIG + 286 * MiB;
constexpr size_t WS_TOTAL = WS_BIG + 341 * MiB;

#define CW_CNT(l) (1024 + 64 * (l))

struct Params {
    const float* in[35];
    float* out;
    unsigned char* ws;
    int ph_lo, ph_hi;
};

__device__ __forceinline__ float bf2f(bf16_t v) { return __uint_as_float(((unsigned)v) << 16); }
__device__ __forceinline__ unsigned f2bf(float f) { unsigned u = __float_as_uint(f); return (u + 0x7fffu + ((u >> 16) & 1u)) >> 16; }
__device__ __forceinline__ unsigned pk2(float lo, float hi) { return f2bf(lo) | (f2bf(hi) << 16); }
__device__ __forceinline__ float bflo(unsigned u) { return __uint_as_float(u << 16); }
__device__ __forceinline__ float bfhi(unsigned u) { return __uint_as_float(u & 0xffff0000u); }
__device__ __forceinline__ float wave_sum(float v) {
#pragma unroll
    for (int o = 1; o < 64; o <<= 1) v += __shfl_xor(v, o);
    return v;
}
__device__ __forceinline__ float wave_max(float v) {
#pragma unroll
    for (int o = 1; o < 64; o <<= 1) v = fmaxf(v, __shfl_xor(v, o));
    return v;
}
__device__ __forceinline__ float sigmoidf_(float x) { return 1.f / (1.f + __expf(-x)); }
__device__ __forceinline__ int rowof(int b, int p) { return p < NMETA ? NMAIN + b * NMETA + p : b * SEQ + (p - NMETA); }

#define SA_STRIDE 40
template <class AF, class BF>
__device__ __forceinline__ void gemm_tile(unsigned char* lds, int K, int ldb, const AF& arow, const BF& bcol, f32x4 (&acc)[4][2]) {
    bf16_t* sA = (bf16_t*)lds;
    bf16_t* sB = (bf16_t*)(lds + 128 * SA_STRIDE * 2);
    const int tid = threadIdx.x, lane = tid & 63, wave = tid >> 6, wr = wave >> 2, wc = wave & 3, fr = lane & 15, fq = lane >> 4;
#pragma unroll
    for (int mi = 0; mi < 4; ++mi)
#pragma unroll
        for (int ni = 0; ni < 2; ++ni) acc[mi][ni] = (f32x4){0.f, 0.f, 0.f, 0.f};
    const int ar = tid >> 2, akc = (tid & 3) * 8;
    const bf16_t* ap = arow(ar) + akc;
    const int bnq = (tid & 31) * 4, bkp = (tid >> 5) * 2;
    const float* bp = bcol(bnq) + (size_t)bkp * ldb;
    const int nk = K / 32;
    u32x4 ra = *(const u32x4*)ap;
    f32x4 rb0 = *(const f32x4*)bp, rb1 = *(const f32x4*)(bp + ldb);
    for (int kt = 0; kt < nk; ++kt) {
        __syncthreads();
        *(u32x4*)(sA + ar * SA_STRIDE + akc) = ra;
        {
            unsigned* d = (unsigned*)(sB + bnq * SA_STRIDE + bkp);
            d[0 * (SA_STRIDE / 2)] = pk2(rb0[0], rb1[0]);
            d[1 * (SA_STRIDE / 2)] = pk2(rb0[1], rb1[1]);
            d[2 * (SA_STRIDE / 2)] = pk2(rb0[2], rb1[2]);
            d[3 * (SA_STRIDE / 2)] = pk2(rb0[3], rb1[3]);
        }
        __syncthreads();
        if (kt + 1 < nk) {
            ra = *(const u32x4*)(ap + (kt + 1) * 32);
            const float* q = bp + (size_t)(kt + 1) * 32 * ldb;
            rb0 = *(const f32x4*)q; rb1 = *(const f32x4*)(q + ldb);
        }
        bf16x8 a[4], b[2];
#pragma unroll
        for (int mi = 0; mi < 4; ++mi) a[mi] = *(const bf16x8*)(sA + (wr * 64 + mi * 16 + fr) * SA_STRIDE + fq * 8);
#pragma unroll
        for (int ni = 0; ni < 2; ++ni) b[ni] = *(const bf16x8*)(sB + (wc * 32 + ni * 16 + fr) * SA_STRIDE + fq * 8);
#pragma unroll
        for (int mi = 0; mi < 4; ++mi)
#pragma unroll
            for (int ni = 0; ni < 2; ++ni) acc[mi][ni] = __builtin_amdgcn_mfma_f32_16x16x32_bf16(a[mi], b[ni], acc[mi][ni], 0, 0, 0);
    }
    __syncthreads();
}
#define ACC_FOREACH(acc, ...) do { const int _l = threadIdx.x & 63, _w = threadIdx.x >> 6, _wr = _w >> 2, _wc = _w & 3, _fr = _l & 15, _fq = _l >> 4; \
    _Pragma("unroll") for (int _mi = 0; _mi < 4; ++_mi) _Pragma("unroll") for (int _ni = 0; _ni < 2; ++_ni) _Pragma("unroll") for (int _j = 0; _j < 4; ++_j) { \
        const int rl = _wr * 64 + _mi * 16 + _fq * 4 + _j, cl = _wc * 32 + _ni * 16 + _fr; const float val = acc[_mi][_ni][_j]; __VA_ARGS__ } } while (0)
#define ACC_FOREACH_PAIR(acc, ...) do { const int _l = threadIdx.x & 63, _w = threadIdx.x >> 6, _wr = _w >> 2, _wc = _w & 3, _fr = _l & 15, _fq = _l >> 4; \
    _Pragma("unroll") for (int _mi = 0; _mi < 4; ++_mi) _Pragma("unroll") for (int _j = 0; _j < 4; ++_j) { \
        const int rl = _wr * 64 + _mi * 16 + _fq * 4 + _j, co = _wc * 16 + _fr; const float va = acc[_mi][0][_j], vg = acc[_mi][1][_j]; __VA_ARGS__ } } while (0)

__device__ __forceinline__ void store_norm_bf16(const f32x4 (&v)[4], const float* gain, bf16_t* dst, int lane) {
    float ss = 0.f;
#pragma unroll
    for (int j = 0; j < 4; ++j) ss += v[j][0] * v[j][0] + v[j][1] * v[j][1] + v[j][2] * v[j][2] + v[j][3] * v[j][3];
    ss = wave_sum(ss);
    const float rstd = rsqrtf(ss * (1.f / DM) + 1e-6f);
#pragma unroll
    for (int j = 0; j < 4; ++j) {
        const f32x4 g = ((const f32x4*)gain)[lane + 64 * j];
        u32x2 o; o.x = pk2(v[j][0] * rstd * g[0], v[j][1] * rstd * g[1]); o.y = pk2(v[j][2] * rstd * g[2], v[j][3] * rstd * g[3]);
        ((u32x2*)dst)[lane + 64 * j] = o;
    }
}

#define PHASE_PROLOGUE \
    const int tid = threadIdx.x, lane = tid & 63, wave = tid >> 6; \
    const int G = gridDim.x, bid = blockIdx.x; \
    const int gw = bid * 8 + wave, NGW = G * 8; \
    unsigned char* ws = P.ws; \
    float* H = (float*)(ws + WS_H); \
    bf16_t* HN = (bf16_t*)(ws + WS_HN); \
    bf16_t* A2 = (bf16_t*)(ws + WS_A2); \
    bf16_t* Qb = (bf16_t*)(ws + WS_Q); bf16_t* Kb = (bf16_t*)(ws + WS_K); bf16_t* Vb = (bf16_t*)(ws + WS_V); \
    bf16_t* REST = (bf16_t*)(ws + WS_REST); \
    bf16_t* YFB = (bf16_t*)(ws + WS_YFB); \
    bf16_t* Rr = (bf16_t*)(ws + WS_R); bf16_t* VV = (bf16_t*)(ws + WS_VV); bf16_t* KK = (bf16_t*)(ws + WS_KK); \
    bf16_t* KKA = (bf16_t*)(ws + WS_KKA); bf16_t* KD = (bf16_t*)(ws + WS_KD); \
    float* Wd = (float*)(ws + WS_W); \
    bf16_t* Gg = (bf16_t*)(ws + WS_G); bf16_t* KR = (bf16_t*)(ws + WS_KR); bf16_t* LOW = (bf16_t*)(ws + WS_LOW); \
    float* BC = (float*)(ws + WS_BC); \
    bf16_t* AA = (bf16_t*)(ws + WS_AA); \
    bf16_t* HB = (bf16_t*)(ws + WS_HB); bf16_t* YB = (bf16_t*)(ws + WS_YB); \
    int* ROWTOK = (int*)(ws + WS_ROWTOK); int* EID = (int*)(ws + WS_EID); int* POS = (int*)(ws + WS_POS); int* DEST = (int*)(ws + WS_DEST); \
    float* GATE = (float*)(ws + WS_GATE); \
    float* YS = (float*)(ws + WS_YS); \
    float* ENDS = (float*)(ws + WS_END); float* CARRY = (float*)(ws + WS_CARRY); \
    unsigned* CTL = (unsigned*)(ws + WS_CTL); \
    const float* x = P.in[0]; const float* meta = P.in[1]; const float* norm_mix = P.in[2]; const float* norm_ffn = P.in[3]; const float* norm_final = P.in[4]; \
    const float* w_in = P.in[5]; const float* w_out = P.in[6]; const float* rpb = P.in[7]; const float* mu = P.in[8]; \
    const float* w0 = P.in[9]; const float* w_up = P.in[10]; const float* a0 = P.in[11]; const float* a_up = P.in[12]; const float* g_up = P.in[13]; \
    const float* k_k = P.in[14]; const float* k_a = P.in[15]; const float* r_k = P.in[16]; const float* lnx_g = P.in[17]; const float* lnx_b = P.in[18]; \
    const float* s5_b_re = P.in[19]; const float* s5_b_im = P.in[20]; const float* s5_lre = P.in[21]; const float* s5_lim = P.in[22]; const float* s5_ls = P.in[23]; \
    const float* s5_c_re = P.in[24]; const float* s5_c_im = P.in[25]; const float* s5_d = P.in[26]; const float* w_glu = P.in[27]; \
    const float* moe_wg = P.in[28]; const float* moe_bg = P.in[29]; const float* moe_we = P.in[30]; const float* moe_be = P.in[31]; \
    const float* moe_w1 = P.in[32]; const float* moe_w3 = P.in[33]; const float* moe_w2 = P.in[34];

__device__ __forceinline__ void phase_0(const Params& P, unsigned char* lds, const int ph) {
    PHASE_PROLOGUE
            for (int row = gw; row < NT; row += NGW) {
                const float* src = row < NMAIN ? x + (size_t)row * DM : meta + (size_t)((row - NMAIN) & 15) * DM;
                f32x4 v[4];
#pragma unroll
                for (int j = 0; j < 4; ++j) { v[j] = ((const f32x4*)src)[lane + 64 * j]; ((f32x4*)(H + (size_t)row * DM))[lane + 64 * j] = v[j]; }
                store_norm_bf16(v, norm_mix, HN + (size_t)row * DM, lane);
            }
}

__device__ __forceinline__ void phase_1(const Params& P, unsigned char* lds, const int ph) {
    PHASE_PROLOGUE
            const int nrt = (NT + 127) / 128, nct = INCOLS / 128;
            for (int u = bid; u < nrt * nct; u += G) {
                const int rt = u / nct, ct = u % nct;
                f32x4 acc[4][2];
                gemm_tile(lds, DM, INCOLS,
                          [&](int r) { int row = rt * 128 + r; if (row >= NT) row = NT - 1; return HN + (size_t)row * DM; },
                          [&](int n) { return w_in + ct * 128 + n; }, acc);
                ACC_FOREACH(acc, { const int row = rt * 128 + rl, col = ct * 128 + cl; if (row < NT) { const bf16_t o = (bf16_t)f2bf(val);
                    if (col < 512) Qb[(size_t)row * 512 + col] = o; else if (col < 1024) Kb[(size_t)row * 512 + col - 512] = o;
                    else if (col < 1536) Vb[(size_t)row * 512 + col - 1024] = o; else REST[(size_t)row * RESTC + col - 1536] = o; } });
            }
}

__device__ __forceinline__ void phase_2(const Params& P, unsigned char* lds, const int ph) {
    PHASE_PROLOGUE
            const int ntask = NB * 8 * LSEQ;
            for (int tk = gw; tk < ntask; tk += NGW) {
                const int b = tk / (8 * LSEQ), rem = tk % (8 * LSEQ), h = rem / LSEQ, p = rem % LSEQ;
                const int qrow = rowof(b, p);
                const float qv = bf2f(Qb[(size_t)qrow * 512 + h * 64 + lane]) * 0.125f;
                const int nkeys = p < NMETA ? NMETA : 144;
                int r = 0, c = 0, R0 = 0, C0 = 0;
                if (p >= NMETA) { const int t = p - NMETA; r = t >> 6; c = t & 63; R0 = min(max(r - 4, 0), 120); C0 = min(max(c - 8, 0), 48); }
                float sc[3];
#pragma unroll
                for (int rd = 0; rd < 3; ++rd) {
                    const int j = lane + 64 * rd;
                    int krow = NMAIN + b * NMETA + (j & 15); float bias = 0.f;
                    if (j >= 16) { const int jj = j - 16, kr = R0 + (jj >> 4), kc = C0 + (jj & 15); krow = b * SEQ + kr * 64 + kc;
                        if (j < nkeys) bias = rpb[(h * 15 + (kr - r + 7)) * 31 + (kc - c + 15)]; }
                    if (j >= nkeys) krow = NMAIN + b * NMETA;
                    const u32x4* kp = (const u32x4*)(Kb + (size_t)krow * 512 + h * 64);
                    float s = 0.f;
#pragma unroll
                    for (int ch = 0; ch < 8; ++ch) {
                        const u32x4 kv = kp[ch];
#pragma unroll
                        for (int e = 0; e < 4; ++e) {
                            const float q0 = __int_as_float(__builtin_amdgcn_readlane(__float_as_int(qv), ch * 8 + e * 2));
                            const float q1 = __int_as_float(__builtin_amdgcn_readlane(__float_as_int(qv), ch * 8 + e * 2 + 1));
                            s += q0 * bflo(kv[e]) + q1 * bfhi(kv[e]);
                        }
                    }
                    sc[rd] = (j < nkeys) ? s + bias : -1e30f;
                }
                const float m = wave_max(fmaxf(sc[0], fmaxf(sc[1], sc[2])));
                float e0 = __expf(sc[0] - m), e1 = __expf(sc[1] - m), e2 = __expf(sc[2] - m);
                if (lane >= nkeys) e0 = 0.f;
                if (lane + 64 >= nkeys) e1 = 0.f;
                if (lane + 128 >= nkeys) e2 = 0.f;
                const float inv = 1.f / wave_sum(e0 + e1 + e2);
                float o = 0.f;
                for (int j = 0; j < nkeys; ++j) {
                    int krow = NMAIN + b * NMETA + (j & 15);
                    if (j >= 16) { const int jj = j - 16; krow = b * SEQ + (R0 + (jj >> 4)) * 64 + C0 + (jj & 15); }
                    const float src = j < 64 ? e0 : (j < 128 ? e1 : e2);
                    const float pj = __int_as_float(__builtin_amdgcn_readlane(__float_as_int(src), j & 63));
                    o += pj * bf2f(Vb[(size_t)krow * 512 + h * 64 + lane]);
                }
                A2[(size_t)qrow * DM + h * 64 + lane] = (bf16_t)f2bf(o * inv);
            }
}

__device__ __forceinline__ void phase_3(const Params& P, unsigned char* lds, const int ph) {
    PHASE_PROLOGUE
            for (int tk = gw; tk < NT; tk += NGW) {
                const int b = tk / LSEQ, p = tk % LSEQ, row = rowof(b, p);
                const bool hp = p > 0, hn = p + 1 < LSEQ;
                const int rowp = hp ? rowof(b, p - 1) : row, rown = hn ? rowof(b, p + 1) : row;
#pragma unroll
                for (int j = 0; j < 7; ++j) {
                    const int c = 4 * lane + 256 * j;
                    const u32x2 vc = *(const u32x2*)(REST + (size_t)row * RESTC + c);
                    u32x2 vp = *(const u32x2*)(REST + (size_t)rowp * RESTC + c);
                    u32x2 vn = *(const u32x2*)(REST + (size_t)rown * RESTC + c);
                    if (!hp) { vp.x = 0; vp.y = 0; }
                    if (!hn) { vn.x = 0; vn.y = 0; }
                    const f32x4 m4 = *(const f32x4*)(mu + c);
                    float pc[4] = {bflo(vc.x), bfhi(vc.x), bflo(vc.y), bfhi(vc.y)};
                    float pp[4] = {bflo(vp.x), bfhi(vp.x), bflo(vp.y), bfhi(vp.y)};
                    float pn[4] = {bflo(vn.x), bfhi(vn.x), bflo(vn.y), bfhi(vn.y)};
                    float o[4];
#pragma unroll
                    for (int i = 0; i < 4; ++i) o[i] = pc[i] + m4[i] * (0.5f * (pp[i] + pn[i]) - pc[i]);
                    if (j == 6) {
                        if (lane < 16) { for (int i = 0; i < 4; ++i) o[i] = tanhf(o[i]); }
                        else if (lane >= 32) { for (int i = 0; i < 4; ++i) o[i] = sigmoidf_(o[i]); }
                    }
                    u32x2 ov; ov.x = pk2(o[0], o[1]); ov.y = pk2(o[2], o[3]);
                    bf16_t* dst = j < 2 ? Rr + (size_t)row * 512 + c : (j < 4 ? KR + (size_t)row * 512 + (c - 512) : (j < 6 ? VV + (size_t)row * 512 + (c - 1024) : LOW + (size_t)row * 256 + (c - 1536)));
                    *(u32x2*)dst = ov;
                }
            }
}

__device__ __forceinline__ void phase_4(const Params& P, unsigned char* lds, const int ph) {
    PHASE_PROLOGUE
            const int nrt = (NT + 127) / 128;
            const int nunits = nrt * 4 * 5;
            for (int u = bid; u < nunits; u += G) {
                const int which = u / (nrt * 4), rem = u % (nrt * 4), rt = rem / 4, ct = rem % 4;
                f32x4 acc[4][2];
                const int koff = which < 2 ? 0 : (which < 4 ? 64 : 128), KK_ = which < 4 ? 64 : 128;
                const float* Bsrc = which < 2 ? w_up + (size_t)which * 64 * 512 : (which < 4 ? a_up + (size_t)(which - 2) * 64 * 512 : g_up);
                gemm_tile(lds, KK_, 512,
                          [&](int r) { int row = rt * 128 + r; if (row >= NT) row = NT - 1; return LOW + (size_t)row * 256 + koff; },
                          [&](int n) { return Bsrc + ct * 128 + n; }, acc);
                ACC_FOREACH(acc, { const int row = rt * 128 + rl, col = ct * 128 + cl; if (row < NT) {
                    if (which < 2) { const float wl = w0[which * 512 + col] + val; Wd[((size_t)which * NT + row) * 512 + col] = __expf(-0.6065306597f * sigmoidf_(wl)); }
                    else if (which < 4) { const int d = which - 2; AA[((size_t)d * NT + row) * 512 + col] = (bf16_t)f2bf(sigmoidf_(a0[d * 512 + col] + val)); }
                    else Gg[(size_t)row * 512 + col] = (bf16_t)f2bf(val); } });
            }
}

__device__ __forceinline__ void phase_5(const Params& P, unsigned char* lds, const int ph) {
    PHASE_PROLOGUE
            for (int row = gw; row < NT; row += NGW) {
                const int c0 = lane * 8;
                const u32x4 krv = *(const u32x4*)(KR + (size_t)row * 512 + c0);
                const u32x4 rv = *(const u32x4*)(Rr + (size_t)row * 512 + c0);
                float kr[8], rr[8], kkv[8];
#pragma unroll
                for (int i = 0; i < 4; ++i) { kr[2 * i] = bflo(krv[i]); kr[2 * i + 1] = bfhi(krv[i]); rr[2 * i] = bflo(rv[i]); rr[2 * i + 1] = bfhi(rv[i]); }
                float ss = 0.f;
#pragma unroll
                for (int i = 0; i < 8; ++i) { kkv[i] = kr[i] * k_k[c0 + i]; ss += kkv[i] * kkv[i]; }
                ss += __shfl_xor(ss, 1); ss += __shfl_xor(ss, 2); ss += __shfl_xor(ss, 4);
                const float inv = 1.f / fmaxf(sqrtf(ss), 1e-12f);
#pragma unroll
                for (int i = 0; i < 8; ++i) kkv[i] *= inv;
                u32x4 o; o.x = pk2(kkv[0], kkv[1]); o.y = pk2(kkv[2], kkv[3]); o.z = pk2(kkv[4], kkv[5]); o.w = pk2(kkv[6], kkv[7]);
                *(u32x4*)(KK + (size_t)row * 512 + c0) = o;
                float bsum = 0.f;
#pragma unroll
                for (int d = 0; d < 2; ++d) {
                    const u32x4 av = *(const u32x4*)(AA + ((size_t)d * NT + row) * 512 + c0);
                    float a[8], kka[8], kd[8];
#pragma unroll
                    for (int i = 0; i < 4; ++i) { a[2 * i] = bflo(av[i]); a[2 * i + 1] = bfhi(av[i]); }
#pragma unroll
                    for (int i = 0; i < 8; ++i) { kka[i] = kkv[i] * a[i]; kd[i] = kr[i] * (1.f + (a[i] - 1.f) * k_a[c0 + i]); bsum += rr[i] * kd[i] * r_k[c0 + i]; }
                    u32x4 o1; o1.x = pk2(kka[0], kka[1]); o1.y = pk2(kka[2], kka[3]); o1.z = pk2(kka[4], kka[5]); o1.w = pk2(kka[6], kka[7]);
                    *(u32x4*)(KKA + ((size_t)d * NT + row) * 512 + c0) = o1;
                    u32x4 o2; o2.x = pk2(kd[0], kd[1]); o2.y = pk2(kd[2], kd[3]); o2.z = pk2(kd[4], kd[5]); o2.w = pk2(kd[6], kd[7]);
                    *(u32x4*)(KD + ((size_t)d * NT + row) * 512 + c0) = o2;
                }
                bsum += __shfl_xor(bsum, 1); bsum += __shfl_xor(bsum, 2); bsum += __shfl_xor(bsum, 4);
                if ((lane & 7) == 0) BC[(size_t)row * 8 + (lane >> 3)] = bsum;
            }
}

__device__ __forceinline__ void phase_6(const Params& P, unsigned char* lds, const int ph) {
    PHASE_PROLOGUE
            for (int cw = bid * 2 + wave; wave < 2 && cw < 512; cw += G * 2) {
                const int chain = cw >> 4, rg = cw & 15, d = chain >> 4, b = (chain >> 3) & 1, h = chain & 7;
                const int rr_ = lane >> 4, kq = lane & 15, vi = rg * 4 + rr_;
                float s0 = 0.f, s1 = 0.f, s2 = 0.f, s3 = 0.f;
                const float* Wp = Wd + (size_t)d * NT * 512;
                const bf16_t* KKAp = KKA + (size_t)d * NT * 512;
                const bf16_t* KDp = KD + (size_t)d * NT * 512;
                bf16_t* Yp = YFB + (size_t)d * NT * 512;
                for (int s = 0; s < LSEQ; ++s) {
                    const int p = d ? LSEQ - 1 - s : s;
                    const int row = rowof(b, p);
                    const size_t base = (size_t)row * 512 + h * 64;
                    const f32x4 w4 = *(const f32x4*)(Wp + base + 4 * kq);
                    const u32x2 kk2 = *(const u32x2*)(KK + base + 4 * kq);
                    const u32x2 ka2 = *(const u32x2*)(KKAp + base + 4 * kq);
                    const u32x2 kd2 = *(const u32x2*)(KDp + base + 4 * kq);
                    const u32x2 r2 = *(const u32x2*)(Rr + base + 4 * kq);
                    const float vv = bf2f(VV[base + vi]);
                    float dot = s0 * bflo(kk2.x) + s1 * bfhi(kk2.x) + s2 * bflo(kk2.y) + s3 * bfhi(kk2.y);
                    dot += __shfl_xor(dot, 1); dot += __shfl_xor(dot, 2); dot += __shfl_xor(dot, 4); dot += __shfl_xor(dot, 8);
                    const float sa = -dot;
                    s0 = s0 * w4[0] + sa * bflo(ka2.x) + vv * bflo(kd2.x);
                    s1 = s1 * w4[1] + sa * bfhi(ka2.x) + vv * bfhi(kd2.x);
                    s2 = s2 * w4[2] + sa * bflo(ka2.y) + vv * bflo(kd2.y);
                    s3 = s3 * w4[3] + sa * bfhi(ka2.y) + vv * bfhi(kd2.y);
                    float y = s0 * bflo(r2.x) + s1 * bfhi(r2.x) + s2 * bflo(r2.y) + s3 * bfhi(r2.y);
                    y += __shfl_xor(y, 1); y += __shfl_xor(y, 2); y += __shfl_xor(y, 4); y += __shfl_xor(y, 8);
                    if (kq == 0) Yp[base + vi] = (bf16_t)f2bf(y);
                }
            }
}

__device__ __forceinline__ void phase_7(const Params& P, unsigned char* lds, const int ph) {
    PHASE_PROLOGUE
            for (int row = gw; row < NT; row += NGW) {
                const int c0 = lane * 8;
                const u32x4 yf = *(const u32x4*)(YFB + (size_t)row * 512 + c0);
                const u32x4 yb = *(const u32x4*)(YFB + ((size_t)NT + row) * 512 + c0);
                const u32x4 vv = *(const u32x4*)(VV + (size_t)row * 512 + c0);
                const u32x4 gg = *(const u32x4*)(Gg + (size_t)row * 512 + c0);
                float y[8], v[8], g[8];
#pragma unroll
                for (int i = 0; i < 4; ++i) { y[2 * i] = bflo(yf[i]) + bflo(yb[i]); y[2 * i + 1] = bfhi(yf[i]) + bfhi(yb[i]); v[2 * i] = bflo(vv[i]); v[2 * i + 1] = bfhi(vv[i]); g[2 * i] = bflo(gg[i]); g[2 * i + 1] = bfhi(gg[i]); }
                float sm = 0.f;
#pragma unroll
                for (int i = 0; i < 8; ++i) sm += y[i];
                sm += __shfl_xor(sm, 1); sm += __shfl_xor(sm, 2); sm += __shfl_xor(sm, 4);
                const float mean = sm * (1.f / 64.f);
                float vr = 0.f;
#pragma unroll
                for (int i = 0; i < 8; ++i) { const float dlt = y[i] - mean; vr += dlt * dlt; }
                vr += __shfl_xor(vr, 1); vr += __shfl_xor(vr, 2); vr += __shfl_xor(vr, 4);
                const float rstd = rsqrtf(vr * (1.f / 64.f) + 64e-5f);
                const float bc = BC[(size_t)row * 8 + (lane >> 3)];
                float o[8];
#pragma unroll
                for (int i = 0; i < 8; ++i) o[i] = ((y[i] - mean) * rstd * lnx_g[c0 + i] + lnx_b[c0 + i] + bc * v[i]) * g[i];
                u32x4 ov; ov.x = pk2(o[0], o[1]); ov.y = pk2(o[2], o[3]); ov.z = pk2(o[4], o[5]); ov.w = pk2(o[6], o[7]);
                *(u32x4*)(A2 + (size_t)row * DM + 512 + c0) = ov;
            }
}

__device__ __forceinline__ void phase_8(const Params& P, unsigned char* lds, const int ph) {
    PHASE_PROLOGUE
            const int nrt = (NT + 127) / 128, nct = DM / 128;
            for (int u = bid; u < nrt * nct; u += G) {
                const int rt = u / nct, ct = u % nct;
                f32x4 acc[4][2];
                gemm_tile(lds, DM, DM,
                          [&](int r) { int row = rt * 128 + r; if (row >= NT) row = NT - 1; return A2 + (size_t)row * DM; },
                          [&](int n) { return w_out + ct * 128 + n; }, acc);
                ACC_FOREACH(acc, { const int row = rt * 128 + rl, col = ct * 128 + cl; if (row < NT) H[(size_t)row * DM + col] += val; });
            }
}

__device__ __forceinline__ void phase_9(const Params& P, unsigned char* lds, const int ph) {
    PHASE_PROLOGUE
            const int l = ph == 9 ? 0 : 1;
            for (int i = bid * 512 + tid; i < MOE_MAXROWS; i += G * 512) ROWTOK[i] = -1;
            unsigned* cnt = CTL + CW_CNT(l);
            const float* wg = moe_wg + (size_t)l * DM * 4; const float* bg = moe_bg + l * 4;
            for (int row = gw; row < NT; row += NGW) {
                f32x4 v[4]; float ss = 0.f;
#pragma unroll
                for (int j = 0; j < 4; ++j) { v[j] = ((const f32x4*)(H + (size_t)row * DM))[lane + 64 * j]; ss += v[j][0] * v[j][0] + v[j][1] * v[j][1] + v[j][2] * v[j][2] + v[j][3] * v[j][3]; }
                ss = wave_sum(ss);
                const float rstd = rsqrtf(ss * (1.f / DM) + 1e-6f);
                float lg[4] = {0.f, 0.f, 0.f, 0.f};
#pragma unroll
                for (int j = 0; j < 4; ++j) {
                    const f32x4 g = ((const f32x4*)(norm_ffn + l * DM))[lane + 64 * j];
#pragma unroll
                    for (int i = 0; i < 4; ++i) v[j][i] = v[j][i] * rstd * g[i];
                    u32x2 o; o.x = pk2(v[j][0], v[j][1]); o.y = pk2(v[j][2], v[j][3]);
                    ((u32x2*)(HN + (size_t)row * DM))[lane + 64 * j] = o;
#pragma unroll
                    for (int i = 0; i < 4; ++i) { const f32x4 w = *(const f32x4*)(wg + (size_t)(4 * (lane + 64 * j) + i) * 4);
                        lg[0] += v[j][i] * w[0]; lg[1] += v[j][i] * w[1]; lg[2] += v[j][i] * w[2]; lg[3] += v[j][i] * w[3]; }
                }
#pragma unroll
                for (int q = 0; q < 4; ++q) lg[q] = wave_sum(lg[q]) + bg[q];
                int grp = 0; float mx = lg[0];
#pragma unroll
                for (int q = 1; q < 4; ++q) if (lg[q] > mx) { mx = lg[q]; grp = q; }
                float den = 0.f;
#pragma unroll
                for (int q = 0; q < 4; ++q) den += __expf(lg[q] - mx);
                const float pgrp = 1.f / den;
                const float* we = moe_we + ((size_t)(l * 4 + grp) * DM) * 8;
                float le[8] = {0.f, 0.f, 0.f, 0.f, 0.f, 0.f, 0.f, 0.f};
#pragma unroll
                for (int j = 0; j < 4; ++j)
#pragma unroll
                    for (int i = 0; i < 4; ++i) { const float* wr_ = we + (size_t)(4 * (lane + 64 * j) + i) * 8; const f32x4 wa = *(const f32x4*)wr_, wb = *(const f32x4*)(wr_ + 4);
                        le[0] += v[j][i] * wa[0]; le[1] += v[j][i] * wa[1]; le[2] += v[j][i] * wa[2]; le[3] += v[j][i] * wa[3];
                        le[4] += v[j][i] * wb[0]; le[5] += v[j][i] * wb[1]; le[6] += v[j][i] * wb[2]; le[7] += v[j][i] * wb[3]; }
#pragma unroll
                for (int q = 0; q < 8; ++q) le[q] = wave_sum(le[q]) + moe_be[(l * 4 + grp) * 8 + q];
                int i1 = 0; float m1 = le[0];
#pragma unroll
                for (int q = 1; q < 8; ++q) if (le[q] > m1) { m1 = le[q]; i1 = q; }
                int i2 = -1; float m2 = -3.0e38f;
#pragma unroll
                for (int q = 0; q < 8; ++q) if (q != i1 && le[q] > m2) { m2 = le[q]; i2 = q; }
                const float e2 = __expf(m2 - m1);
                const float g1 = pgrp / (1.f + e2), g2 = pgrp * e2 / (1.f + e2);
                if (lane == 0) {
                    const int ea = grp * 8 + i1, eb = grp * 8 + i2;
                    const unsigned pa = atomicAdd(cnt + ea, 1u), pb = atomicAdd(cnt + eb, 1u);
                    EID[row * 2] = ea; EID[row * 2 + 1] = eb; POS[row * 2] = (int)pa; POS[row * 2 + 1] = (int)pb;
                    GATE[row * 2] = g1; GATE[row * 2 + 1] = g2;
                }
            }
}

__device__ __forceinline__ void phase_10(const Params& P, unsigned char* lds, const int ph) {
    PHASE_PROLOGUE
            const int l = ph == 10 ? 0 : 1;
            int* ps = (int*)lds;
            if (tid == 0) { int acc_ = 0; for (int e = 0; e < NEXP; ++e) { ps[e] = acc_; const int c = (int)CTL[CW_CNT(l) + e]; acc_ += (c + MOE_RT - 1) / MOE_RT * MOE_RT; } ps[NEXP] = acc_; }
            __syncthreads();
            for (int i = bid * 512 + tid; i < NT * 2; i += G * 512) {
                const int dest = ps[EID[i]] + POS[i];
                DEST[i] = dest; ROWTOK[dest] = i >> 1;
            }
            __syncthreads();
}

__device__ __forceinline__ void phase_11(const Params& P, unsigned char* lds, const int ph) {
    PHASE_PROLOGUE
            const int l = ph == 11 ? 0 : 1;
            int* ts = (int*)lds + 64;
            if (tid == 0) { int acc_ = 0; for (int e = 0; e < NEXP; ++e) { ts[e] = acc_; const int c = (int)CTL[CW_CNT(l) + e]; acc_ += (c + MOE_RT - 1) / MOE_RT; } ts[NEXP] = acc_; }
            __syncthreads();
            int tsr[NEXP + 1];
#pragma unroll
            for (int e = 0; e <= NEXP; ++e) tsr[e] = ts[e];
            __syncthreads();
            const int TT = tsr[NEXP];
            for (int u = bid; u < TT * 8; u += G) {
                const int rt = u >> 3, ct = u & 7;
                int e = 0;
#pragma unroll
                for (int q = 1; q < NEXP; ++q) if (rt >= tsr[q]) e = q;
                const float* W1 = moe_w1 + ((size_t)(l * NEXP + e) * DM) * DFF;
                const float* W3 = moe_w3 + ((size_t)(l * NEXP + e) * DM) * DFF;
                f32x4 acc[4][2];
                gemm_tile(lds, DM, DFF,
                          [&](int r) { int tok = ROWTOK[rt * 128 + r]; if (tok < 0) tok = 0; return HN + (size_t)tok * DM; },
                          [&](int n) { const int wc = n >> 5, ni = (n >> 4) & 1, c = n & 15; return (ni ? W3 : W1) + ct * 64 + wc * 16 + c; }, acc);
                ACC_FOREACH_PAIR(acc, { const float sg = va / (1.f + __expf(-va)); HB[(size_t)(rt * 128 + rl) * DFF + ct * 64 + co] = (bf16_t)f2bf(sg * vg); });
            }
}

__device__ __forceinline__ void phase_12(const Params& P, unsigned char* lds, const int ph) {
    PHASE_PROLOGUE
            const int l = ph == 12 ? 0 : 1;
            int* ts = (int*)lds + 64;
            if (tid == 0) { int acc_ = 0; for (int e = 0; e < NEXP; ++e) { ts[e] = acc_; const int c = (int)CTL[CW_CNT(l) + e]; acc_ += (c + MOE_RT - 1) / MOE_RT; } ts[NEXP] = acc_; }
            __syncthreads();
            int tsr[NEXP + 1];
#pragma unroll
            for (int e = 0; e <= NEXP; ++e) tsr[e] = ts[e];
            __syncthreads();
            const int TT = tsr[NEXP];
            for (int u = bid; u < TT * 8; u += G) {
                const int rt = u >> 3, ct = u & 7;
                int e = 0;
#pragma unroll
                for (int q = 1; q < NEXP; ++q) if (rt >= tsr[q]) e = q;
                const float* W2 = moe_w2 + ((size_t)(l * NEXP + e) * DFF) * DM;
                f32x4 acc[4][2];
                gemm_tile(lds, DFF, DM,
                          [&](int r) { return HB + (size_t)(rt * 128 + r) * DFF; },
                          [&](int n) { return W2 + ct * 128 + n; }, acc);
                ACC_FOREACH(acc, { YB[(size_t)(rt * 128 + rl) * DM + ct * 128 + cl] = (bf16_t)f2bf(val); });
            }
}

__device__ __forceinline__ void phase_13(const Params& P, unsigned char* lds, const int ph) {
    PHASE_PROLOGUE
            const bool fin = ph == 21;
            for (int row = gw; row < NT; row += NGW) {
                const int d0 = DEST[row * 2], d1 = DEST[row * 2 + 1];
                const float g0 = GATE[row * 2], g1 = GATE[row * 2 + 1];
                f32x4 v[4];
#pragma unroll
                for (int j = 0; j < 4; ++j) {
                    v[j] = ((const f32x4*)(H + (size_t)row * DM))[lane + 64 * j];
                    const u32x2 ya = ((const u32x2*)(YB + (size_t)d0 * DM))[lane + 64 * j];
                    const u32x2 yb = ((const u32x2*)(YB + (size_t)d1 * DM))[lane + 64 * j];
                    v[j][0] += g0 * bflo(ya.x) + g1 * bflo(yb.x); v[j][1] += g0 * bfhi(ya.x) + g1 * bfhi(yb.x);
                    v[j][2] += g0 * bflo(ya.y) + g1 * bflo(yb.y); v[j][3] += g0 * bfhi(ya.y) + g1 * bfhi(yb.y);
                }
                if (!fin) {
#pragma unroll
                    for (int j = 0; j < 4; ++j) ((f32x4*)(H + (size_t)row * DM))[lane + 64 * j] = v[j];
                    store_norm_bf16(v, norm_mix + DM, HN + (size_t)row * DM, lane);
                } else if (row < NMAIN) {
                    float ss = 0.f;
#pragma unroll
                    for (int j = 0; j < 4; ++j) ss += v[j][0] * v[j][0] + v[j][1] * v[j][1] + v[j][2] * v[j][2] + v[j][3] * v[j][3];
                    ss = wave_sum(ss);
                    const float rstd = rsqrtf(ss * (1.f / DM) + 1e-6f);
#pragma unroll
                    for (int j = 0; j < 4; ++j) { const f32x4 g = ((const f32x4*)norm_final)[lane + 64 * j]; f32x4 o;
                        o[0] = v[j][0] * rstd * g[0]; o[1] = v[j][1] * rstd * g[1]; o[2] = v[j][2] * rstd * g[2]; o[3] = v[j][3] * rstd * g[3];
                        ((f32x4*)(P.out + (size_t)row * DM))[lane + 64 * j] = o; }
                }
            }
}

__device__ __forceinline__ void phase_14(const Params& P, unsigned char* lds, const int ph) {
    PHASE_PROLOGUE
            const bool outp = ph == 16;
            const int nunits = 2 * NB * 64 * S5NC;
            for (int u = gw; u < nunits; u += NGW) {
                const int c = u % S5NC, dbg = u / S5NC, g = dbg & 63, b = (dbg >> 6) & 1, d = dbg >> 7;
                const int p = lane;
                const float step = __expf(s5_ls[d * 64 + g]);
                const float lr = s5_lre[(d * 64 + g) * 64 + p], li = s5_lim[(d * 64 + g) * 64 + p];
                const float mag = expf(lr * step);
                const float abr = mag * cosf(li * step), abi = mag * sinf(li * step);
                const float den = lr * lr + li * li;
                const float zr = ((abr - 1.f) * lr + abi * li) / den, zi = (abi * lr - (abr - 1.f) * li) / den;
                float bbr[16], bbi[16];
#pragma unroll
                for (int q = 0; q < 4; ++q) {
                    const f32x4 br = *(const f32x4*)(s5_b_re + ((size_t)(g * 64 + p)) * 16 + 4 * q), bi = *(const f32x4*)(s5_b_im + ((size_t)(g * 64 + p)) * 16 + 4 * q);
#pragma unroll
                    for (int i = 0; i < 4; ++i) { bbr[4 * q + i] = zr * br[i] - zi * bi[i]; bbi[4 * q + i] = zr * bi[i] + zi * br[i]; }
                }
                float sr = 0.f, si = 0.f;
                if (outp) { const float* cp = CARRY + (((size_t)dbg * S5NC + c) * 64 + p) * 2; sr = cp[0]; si = cp[1]; }
                float cre[16], cim[16];
                if (outp) {
#pragma unroll
                    for (int i = 0; i < 16; ++i) { cre[i] = s5_c_re[((size_t)(d * 64 + g) * 16 + i) * 64 + p]; cim[i] = s5_c_im[((size_t)(d * 64 + g) * 16 + i) * 64 + p]; }
                }
                for (int tt = 0; tt < S5TC; ++tt) {
                    const int sidx = c * S5TC + tt, pos = d ? LSEQ - 1 - sidx : sidx, row = rowof(b, pos);
                    const u32x4 ua = *(const u32x4*)(HN + (size_t)row * DM + g * 16), ub = *(const u32x4*)(HN + (size_t)row * DM + g * 16 + 8);
                    float uu[16];
#pragma unroll
                    for (int i = 0; i < 4; ++i) { uu[2 * i] = bflo(ua[i]); uu[2 * i + 1] = bfhi(ua[i]); uu[8 + 2 * i] = bflo(ub[i]); uu[8 + 2 * i + 1] = bfhi(ub[i]); }
                    float bur = 0.f, bui = 0.f;
#pragma unroll
                    for (int i = 0; i < 16; ++i) { bur += bbr[i] * uu[i]; bui += bbi[i] * uu[i]; }
                    const float nr = abr * sr - abi * si + bur, ni = abr * si + abi * sr + bui;
                    sr = nr; si = ni;
                    if (outp) {
                        float mine = 0.f;
#pragma unroll
                        for (int i = 0; i < 16; ++i) { const float yv = wave_sum(cre[i] * sr - cim[i] * si); if (lane == i) mine = yv; }
                        if (lane < 16) YS[((size_t)d * NT + row) * DM + g * 16 + lane] = mine;
                    }
                }
                if (!outp) { float* ep = ENDS + (((size_t)dbg * S5NC + c) * 64 + p) * 2; ep[0] = sr; ep[1] = si; }
            }
}

__device__ __forceinline__ void phase_15(const Params& P, unsigned char* lds, const int ph) {
    PHASE_PROLOGUE
            for (int i = bid * 512 + tid; i < 2 * NB * 64 * 64; i += G * 512) {
                const int p = i & 63, dbg = i >> 6, g = dbg & 63, d = dbg >> 7;
                const float step = __expf(s5_ls[d * 64 + g]);
                const float lr = s5_lre[(d * 64 + g) * 64 + p], li = s5_lim[(d * 64 + g) * 64 + p];
                const float mag = expf(lr * step * (float)S5TC);
                const float ang = li * step;
                float pr = 1.f, pi = 0.f; const float cr = cosf(ang), ci = sinf(ang);
                for (int q = 0; q < S5TC; ++q) { const float t = pr * cr - pi * ci; pi = pr * ci + pi * cr; pr = t; }
                const float ar = mag * pr, ai = mag * pi;
                float yr = 0.f, yi = 0.f;
                for (int c = 0; c < S5NC; ++c) {
                    const size_t o = (((size_t)dbg * S5NC + c) * 64 + p) * 2;
                    CARRY[o] = yr; CARRY[o + 1] = yi;
                    const float er = ENDS[o], ei = ENDS[o + 1];
                    const float t = ar * yr - ai * yi + er; yi = ar * yi + ai * yr + ei; yr = t;
                }
            }
}

__device__ __forceinline__ void phase_22(const Params& P, unsigned char* lds, const int ph) {
    PHASE_PROLOGUE
            for (size_t i = (size_t)bid * 512 + tid; i < (size_t)NT * DM / 4; i += (size_t)G * 512) {
                const f32x4 y0 = ((const f32x4*)YS)[i], y1 = ((const f32x4*)(YS + (size_t)NT * DM))[i];
                const int col = (int)((i * 4) & (DM - 1));
                const f32x4 dd = *(const f32x4*)(s5_d + col);
                const u32x2 uu = ((const u32x2*)HN)[i];
                float u4[4] = {bflo(uu.x), bfhi(uu.x), bflo(uu.y), bfhi(uu.y)};
                float o[4];
#pragma unroll
                for (int q = 0; q < 4; ++q) { const float yv = y0[q] + y1[q] + dd[q] * u4[q];
                    o[q] = 0.5f * yv * (1.f + tanhf(0.7978845608f * (yv + 0.044715f * yv * yv * yv))); }
                u32x2 ov; ov.x = pk2(o[0], o[1]); ov.y = pk2(o[2], o[3]);
                ((u32x2*)A2)[i] = ov;
            }
}

__device__ __forceinline__ void phase_23(const Params& P, unsigned char* lds, const int ph) {
    PHASE_PROLOGUE
            const int nrt = (NT + 127) / 128, nct = DM / 64;
            for (int u = bid; u < nrt * nct; u += G) {
                const int rt = u / nct, ct = u % nct;
                f32x4 acc[4][2];
                gemm_tile(lds, DM, 2 * DM,
                          [&](int r) { int row = rt * 128 + r; if (row >= NT) row = NT - 1; return A2 + (size_t)row * DM; },
                          [&](int n) { const int wc = n >> 5, ni = (n >> 4) & 1, c = n & 15; return w_glu + (ni ? DM : 0) + ct * 64 + wc * 16 + c; }, acc);
                ACC_FOREACH_PAIR(acc, { const int row = rt * 128 + rl; if (row < NT) H[(size_t)row * DM + ct * 64 + co] += va * sigmoidf_(vg); });
            }
}

#define PHASE_CALL(PH) \
    if constexpr (PH == 0) phase_0(P, lds, PH); \
    if constexpr (PH == 1) phase_1(P, lds, PH); \
    if constexpr (PH == 2) phase_2(P, lds, PH); \
    if constexpr (PH == 3) phase_3(P, lds, PH); \
    if constexpr (PH == 4) phase_4(P, lds, PH); \
    if constexpr (PH == 5) phase_5(P, lds, PH); \
    if constexpr (PH == 6) phase_6(P, lds, PH); \
    if constexpr (PH == 7) phase_7(P, lds, PH); \
    if constexpr (PH == 8) phase_8(P, lds, PH); \
    if constexpr (PH == 9) phase_9(P, lds, PH); \
    if constexpr (PH == 10) phase_10(P, lds, PH); \
    if constexpr (PH == 11) phase_11(P, lds, PH); \
    if constexpr (PH == 12) phase_12(P, lds, PH); \
    if constexpr (PH == 13) phase_13(P, lds, PH); \
    if constexpr (PH == 14) phase_14(P, lds, PH); \
    if constexpr (PH == 15) phase_15(P, lds, PH); \
    if constexpr (PH == 16) phase_14(P, lds, PH); \
    if constexpr (PH == 17) phase_9(P, lds, PH); \
    if constexpr (PH == 18) phase_10(P, lds, PH); \
    if constexpr (PH == 19) phase_11(P, lds, PH); \
    if constexpr (PH == 20) phase_12(P, lds, PH); \
    if constexpr (PH == 21) phase_13(P, lds, PH); \
    if constexpr (PH == 22) phase_22(P, lds, PH); \
    if constexpr (PH == 23) phase_23(P, lds, PH);

template <int PH> __global__ void __launch_bounds__(512, 2) k_phase(Params P) {
    __shared__ __attribute__((aligned(16))) unsigned char lds[32768];
    PHASE_CALL(PH)
}

#define LAUNCH_PH(n) hipLaunchKernelGGL(k_phase<n>, dim3(256), dim3(512), 0, stream, P)

extern "C" void kernel_launch(void* const* d_in, const int* in_sizes, int n_in, void* d_out, int out_size, void* d_ws, size_t ws_size, hipStream_t stream) {
    if (n_in != 35 || ws_size < WS_TOTAL) { fprintf(stderr, "kernel_launch: unexpected n_in %d or ws_size %zu (need %zu)\n", n_in, ws_size, (size_t)WS_TOTAL); return; }
    (void)hipMemsetAsync((char*)d_ws + WS_CTL, 0, 1 * MiB, stream);
    Params P{};
    for (int i = 0; i < 35; ++i) P.in[i] = (const float*)d_in[i];
    P.out = (float*)d_out; P.ws = (unsigned char*)d_ws; P.ph_lo = 0; P.ph_hi = 0;
    LAUNCH_PH(0); LAUNCH_PH(1); LAUNCH_PH(2); LAUNCH_PH(3); LAUNCH_PH(4); LAUNCH_PH(5); LAUNCH_PH(6); LAUNCH_PH(7); LAUNCH_PH(8);
    LAUNCH_PH(9); LAUNCH_PH(10); LAUNCH_PH(11); LAUNCH_PH(12); LAUNCH_PH(13);
    LAUNCH_PH(14); LAUNCH_PH(15); LAUNCH_PH(16); LAUNCH_PH(22); LAUNCH_PH(23);
    LAUNCH_PH(17); LAUNCH_PH(18); LAUNCH_PH(19); LAUNCH_PH(20); LAUNCH_PH(21);
}
```

```cpp
#include <hip/hip_runtime.h>
#include <stdint.h>
#include <stdio.h>

#define DM 1024
#define NB 2
#define SEQ 8192
#define NMETA 16
#define LSEQ (SEQ + NMETA)
#define NMAIN (NB * SEQ)
#define NT (NB * LSEQ)
#define INCOLS 3328
#define RESTC 1792
#define NEXP 32
#define DFF 512
#define S5TC 48
#define S5NC 171
#define MOE_RT 128
#define MOE_MAXROWS 36992

typedef unsigned short bf16_t;
typedef short bf16x8 __attribute__((ext_vector_type(8)));
typedef float f32x4 __attribute__((ext_vector_type(4)));
typedef unsigned u32x4 __attribute__((ext_vector_type(4)));
typedef unsigned u32x2 __attribute__((ext_vector_type(2)));

constexpr size_t MiB = 1u << 20;
constexpr size_t WS_CTL = 0;
constexpr size_t WS_H = 1 * MiB;
constexpr size_t WS_HN = 69 * MiB;
constexpr size_t WS_A2 = 103 * MiB;
constexpr size_t WS_BIG = 137 * MiB;
constexpr size_t WS_Q = WS_BIG + 0 * MiB;
constexpr size_t WS_K = WS_BIG + 17 * MiB;
constexpr size_t WS_V = WS_BIG + 34 * MiB;
constexpr size_t WS_REST = WS_BIG + 51 * MiB;
constexpr size_t WS_YFB = WS_REST;
constexpr size_t WS_R = WS_BIG + 110 * MiB;
constexpr size_t WS_VV = WS_BIG + 127 * MiB;
constexpr size_t WS_KK = WS_BIG + 144 * MiB;
constexpr size_t WS_KKA = WS_BIG + 161 * MiB;
constexpr size_t WS_KD = WS_BIG + 195 * MiB;
constexpr size_t WS_W = WS_BIG + 229 * MiB;
constexpr size_t WS_G = WS_BIG + 297 * MiB;
constexpr size_t WS_KR = WS_BIG + 314 * MiB;
constexpr size_t WS_LOW = WS_BIG + 331 * MiB;
constexpr size_t WS_BC = WS_BIG + 340 * MiB;
constexpr size_t WS_AA = WS_Q;
constexpr size_t WS_HB = WS_BIG + 0 * MiB;
constexpr size_t WS_YB = WS_BIG + 40 * MiB;
constexpr size_t WS_ROWTOK = WS_BIG + 120 * MiB;
constexpr size_t WS_EID = WS_BIG + 121 * MiB;
constexpr size_t WS_POS = WS_BIG + 122 * MiB;
constexpr size_t WS_DEST = WS_BIG + 123 * MiB;
constexpr size_t WS_GATE = WS_BIG + 124 * MiB;
constexpr size_t WS_YS = WS_BIG + 130 * MiB;
constexpr size_t WS_END = WS_BIG + 262 * MiB;
constexpr size_t WS_CARRY = WS_BIG + 286 * MiB;
constexpr size_t WS_TOTAL = WS_BIG + 341 * MiB;

#define CW_CNT(l) (1024 + 64 * (l))

struct Params {
    const float* in[35];
    float* out;
    unsigned char* ws;
    int ph_lo, ph_hi;
};

__device__ __forceinline__ float bf2f(bf16_t v) { return __uint_as_float(((unsigned)v) << 16); }
__device__ __forceinline__ unsigned f2bf(float f) { unsigned u = __float_as_uint(f); return (u + 0x7fffu + ((u >> 16) & 1u)) >> 16; }
__device__ __forceinline__ unsigned pk2(float lo, float hi) { return f2bf(lo) | (f2bf(hi) << 16); }
__device__ __forceinline__ float bflo(unsigned u) { return __uint_as_float(u << 16); }
__device__ __forceinline__ float bfhi(unsigned u) { return __uint_as_float(u & 0xffff0000u); }
__device__ __forceinline__ float wave_sum(float v) {
#pragma unroll
    for (int o = 1; o < 64; o <<= 1) v += __shfl_xor(v, o);
    return v;
}
__device__ __forceinline__ float wave_max(float v) {
#pragma unroll
    for (int o = 1; o < 64; o <<= 1) v = fmaxf(v, __shfl_xor(v, o));
    return v;
}
__device__ __forceinline__ float sigmoidf_(float x) { return 1.f / (1.f + __expf(-x)); }
__device__ __forceinline__ int rowof(int b, int p) { return p < NMETA ? NMAIN + b * NMETA + p : b * SEQ + (p - NMETA); }

#define SA_STRIDE 40
template <class AF, class BF>
__device__ __forceinline__ void gemm_tile(unsigned char* lds, int K, int ldb, const AF& arow, const BF& bcol, f32x4 (&acc)[4][2]) {
    bf16_t* sA = (bf16_t*)lds;
    bf16_t* sB = (bf16_t*)(lds + 128 * SA_STRIDE * 2);
    const int tid = threadIdx.x, lane = tid & 63, wave = tid >> 6, wr = wave >> 2, wc = wave & 3, fr = lane & 15, fq = lane >> 4;
#pragma unroll
    for (int mi = 0; mi < 4; ++mi)
#pragma unroll
        for (int ni = 0; ni < 2; ++ni) acc[mi][ni] = (f32x4){0.f, 0.f, 0.f, 0.f};
    const int ar = tid >> 2, akc = (tid & 3) * 8;
    const bf16_t* ap = arow(ar) + akc;
    const int bnq = (tid & 31) * 4, bkp = (tid >> 5) * 2;
    const float* bp = bcol(bnq) + (size_t)bkp * ldb;
    const int nk = K / 32;
    u32x4 ra = *(const u32x4*)ap;
    f32x4 rb0 = *(const f32x4*)bp, rb1 = *(const f32x4*)(bp + ldb);
    for (int kt = 0; kt < nk; ++kt) {
        __syncthreads();
        *(u32x4*)(sA + ar * SA_STRIDE + akc) = ra;
        {
            unsigned* d = (unsigned*)(sB + bnq * SA_STRIDE + bkp);
            d[0 * (SA_STRIDE / 2)] = pk2(rb0[0], rb1[0]);
            d[1 * (SA_STRIDE / 2)] = pk2(rb0[1], rb1[1]);
            d[2 * (SA_STRIDE / 2)] = pk2(rb0[2], rb1[2]);
            d[3 * (SA_STRIDE / 2)] = pk2(rb0[3], rb1[3]);
        }
        __syncthreads();
        if (kt + 1 < nk) {
            ra = *(const u32x4*)(ap + (kt + 1) * 32);
            const float* q = bp + (size_t)(kt + 1) * 32 * ldb;
            rb0 = *(const f32x4*)q; rb1 = *(const f32x4*)(q + ldb);
        }
        bf16x8 a[4], b[2];
#pragma unroll
        for (int mi = 0; mi < 4; ++mi) a[mi] = *(const bf16x8*)(sA + (wr * 64 + mi * 16 + fr) * SA_STRIDE + fq * 8);
#pragma unroll
        for (int ni = 0; ni < 2; ++ni) b[ni] = *(const bf16x8*)(sB + (wc * 32 + ni * 16 + fr) * SA_STRIDE + fq * 8);
#pragma unroll
        for (int mi = 0; mi < 4; ++mi)
#pragma unroll
            for (int ni = 0; ni < 2; ++ni) acc[mi][ni] = __builtin_amdgcn_mfma_f32_16x16x32_bf16(a[mi], b[ni], acc[mi][ni], 0, 0, 0);
    }
    __syncthreads();
}
#define ACC_FOREACH(acc, ...) do { const int _l = threadIdx.x & 63, _w = threadIdx.x >> 6, _wr = _w >> 2, _wc = _w & 3, _fr = _l & 15, _fq = _l >> 4; \
    _Pragma("unroll") for (int _mi = 0; _mi < 4; ++_mi) _Pragma("unroll") for (int _ni = 0; _ni < 2; ++_ni) _Pragma("unroll") for (int _j = 0; _j < 4; ++_j) { \
        const int rl = _wr * 64 + _mi * 16 + _fq * 4 + _j, cl = _wc * 32 + _ni * 16 + _fr; const float val = acc[_mi][_ni][_j]; __VA_ARGS__ } } while (0)
#define ACC_FOREACH_PAIR(acc, ...) do { const int _l = threadIdx.x & 63, _w = threadIdx.x >> 6, _wr = _w >> 2, _wc = _w & 3, _fr = _l & 15, _fq = _l >> 4; \
    _Pragma("unroll") for (int _mi = 0; _mi < 4; ++_mi) _Pragma("unroll") for (int _j = 0; _j < 4; ++_j) { \
        const int rl = _wr * 64 + _mi * 16 + _fq * 4 + _j, co = _wc * 16 + _fr; const float va = acc[_mi][0][_j], vg = acc[_mi][1][_j]; __VA_ARGS__ } } while (0)

__device__ __forceinline__ void store_norm_bf16(const f32x4 (&v)[4], const float* gain, bf16_t* dst, int lane) {
    float ss = 0.f;
#pragma unroll
    for (int j = 0; j < 4; ++j) ss += v[j][0] * v[j][0] + v[j][1] * v[j][1] + v[j][2] * v[j][2] + v[j][3] * v[j][3];
    ss = wave_sum(ss);
    const float rstd = rsqrtf(ss * (1.f / DM) + 1e-6f);
#pragma unroll
    for (int j = 0; j < 4; ++j) {
        const f32x4 g = ((const f32x4*)gain)[lane + 64 * j];
        u32x2 o; o.x = pk2(v[j][0] * rstd * g[0], v[j][1] * rstd * g[1]); o.y = pk2(v[j][2] * rstd * g[2], v[j][3] * rstd * g[3]);
        ((u32x2*)dst)[lane + 64 * j] = o;
    }
}

#define PHASE_PROLOGUE \
    const int tid = threadIdx.x, lane = tid & 63, wave = tid >> 6; \
    const int G = gridDim.x, bid = blockIdx.x; \
    const int gw = bid * 8 + wave, NGW = G * 8; \
    unsigned char* ws = P.ws; \
    float* H = (float*)(ws + WS_H); \
    bf16_t* HN = (bf16_t*)(ws + WS_HN); \
    bf16_t* A2 = (bf16_t*)(ws + WS_A2); \
    bf16_t* Qb = (bf16_t*)(ws + WS_Q); bf16_t* Kb = (bf16_t*)(ws + WS_K); bf16_t* Vb = (bf16_t*)(ws + WS_V); \
    bf16_t* REST = (bf16_t*)(ws + WS_REST); \
    bf16_t* YFB = (bf16_t*)(ws + WS_YFB); \
    bf16_t* Rr = (bf16_t*)(ws + WS_R); bf16_t* VV = (bf16_t*)(ws + WS_VV); bf16_t* KK = (bf16_t*)(ws + WS_KK); \
    bf16_t* KKA = (bf16_t*)(ws + WS_KKA); bf16_t* KD = (bf16_t*)(ws + WS_KD); \
    float* Wd = (float*)(ws + WS_W); \
    bf16_t* Gg = (bf16_t*)(ws + WS_G); bf16_t* KR = (bf16_t*)(ws + WS_KR); bf16_t* LOW = (bf16_t*)(ws + WS_LOW); \
    float* BC = (float*)(ws + WS_BC); \
    bf16_t* AA = (bf16_t*)(ws + WS_AA); \
    bf16_t* HB = (bf16_t*)(ws + WS_HB); bf16_t* YB = (bf16_t*)(ws + WS_YB); \
    int* ROWTOK = (int*)(ws + WS_ROWTOK); int* EID = (int*)(ws + WS_EID); int* POS = (int*)(ws + WS_POS); int* DEST = (int*)(ws + WS_DEST); \
    float* GATE = (float*)(ws + WS_GATE); \
    float* YS = (float*)(ws + WS_YS); \
    float* ENDS = (float*)(ws + WS_END); float* CARRY = (float*)(ws + WS_CARRY); \
    unsigned* CTL = (unsigned*)(ws + WS_CTL); \
    const float* x = P.in[0]; const float* meta = P.in[1]; const float* norm_mix = P.in[2]; const float* norm_ffn = P.in[3]; const float* norm_final = P.in[4]; \
    const float* w_in = P.in[5]; const float* w_out = P.in[6]; const float* rpb = P.in[7]; const float* mu = P.in[8]; \
    const float* w0 = P.in[9]; const float* w_up = P.in[10]; const float* a0 = P.in[11]; const float* a_up = P.in[12]; const float* g_up = P.in[13]; \
    const float* k_k = P.in[14]; const float* k_a = P.in[15]; const float* r_k = P.in[16]; const float* lnx_g = P.in[17]; const float* lnx_b = P.in[18]; \
    const float* s5_b_re = P.in[19]; const float* s5_b_im = P.in[20]; const float* s5_lre = P.in[21]; const float* s5_lim = P.in[22]; const float* s5_ls = P.in[23]; \
    const float* s5_c_re = P.in[24]; const float* s5_c_im = P.in[25]; const float* s5_d = P.in[26]; const float* w_glu = P.in[27]; \
    const float* moe_wg = P.in[28]; const float* moe_bg = P.in[29]; const float* moe_we = P.in[30]; const float* moe_be = P.in[31]; \
    const float* moe_w1 = P.in[32]; const float* moe_w3 = P.in[33]; const float* moe_w2 = P.in[34];

__device__ __forceinline__ void phase_0(const Params& P, unsigned char* lds, const int ph) {
    PHASE_PROLOGUE
            for (int row = gw; row < NT; row += NGW) {
                const float* src = row < NMAIN ? x + (size_t)row * DM : meta + (size_t)((row - NMAIN) & 15) * DM;
                f32x4 v[4];
#pragma unroll
                for (int j = 0; j < 4; ++j) { v[j] = ((const f32x4*)src)[lane + 64 * j]; ((f32x4*)(H + (size_t)row * DM))[lane + 64 * j] = v[j]; }
                store_norm_bf16(v, norm_mix, HN + (size_t)row * DM, lane);
            }
}

__device__ __forceinline__ void phase_1(const Params& P, unsigned char* lds, const int ph) {
    PHASE_PROLOGUE
            const int nrt = (NT + 127) / 128, nct = INCOLS / 128;
            for (int u = bid; u < nrt * nct; u += G) {
                const int rt = u / nct, ct = u % nct;
                f32x4 acc[4][2];
                gemm_tile(lds, DM, INCOLS,
                          [&](int r) { int row = rt * 128 + r; if (row >= NT) row = NT - 1; return HN + (size_t)row * DM; },
                          [&](int n) { return w_in + ct * 128 + n; }, acc);
                ACC_FOREACH(acc, { const int row = rt * 128 + rl, col = ct * 128 + cl; if (row < NT) { const bf16_t o = (bf16_t)f2bf(val);
                    if (col < 512) Qb[(size_t)row * 512 + col] = o; else if (col < 1024) Kb[(size_t)row * 512 + col - 512] = o;
                    else if (col < 1536) Vb[(size_t)row * 512 + col - 1024] = o; else REST[(size_t)row * RESTC + col - 1536] = o; } });
            }
}

__device__ __forceinline__ void phase_2(const Params& P, unsigned char* lds, const int ph) {
    PHASE_PROLOGUE
            const int ntask = NB * 8 * LSEQ;
            for (int tk = gw; tk < ntask; tk += NGW) {
                const int b = tk / (8 * LSEQ), rem = tk % (8 * LSEQ), h = rem / LSEQ, p = rem % LSEQ;
                const int qrow = rowof(b, p);
                const float qv = bf2f(Qb[(size_t)qrow * 512 + h * 64 + lane]) * 0.125f;
                const int nkeys = p < NMETA ? NMETA : 144;
                int r = 0, c = 0, R0 = 0, C0 = 0;
                if (p >= NMETA) { const int t = p - NMETA; r = t >> 6; c = t & 63; R0 = min(max(r - 4, 0), 120); C0 = min(max(c - 8, 0), 48); }
                float sc[3];
#pragma unroll
                for (int rd = 0; rd < 3; ++rd) {
                    const int j = lane + 64 * rd;
                    int krow = NMAIN + b * NMETA + (j & 15); float bias = 0.f;
                    if (j >= 16) { const int jj = j - 16, kr = R0 + (jj >> 4), kc = C0 + (jj & 15); krow = b * SEQ + kr * 64 + kc;
                        if (j < nkeys) bias = rpb[(h * 15 + (kr - r + 7)) * 31 + (kc - c + 15)]; }
                    if (j >= nkeys) krow = NMAIN + b * NMETA;
                    const u32x4* kp = (const u32x4*)(Kb + (size_t)krow * 512 + h * 64);
                    float s = 0.f;
#pragma unroll
                    for (int ch = 0; ch < 8; ++ch) {
                        const u32x4 kv = kp[ch];
#pragma unroll
                        for (int e = 0; e < 4; ++e) {
                            const float q0 = __int_as_float(__builtin_amdgcn_readlane(__float_as_int(qv), ch * 8 + e * 2));
                            const float q1 = __int_as_float(__builtin_amdgcn_readlane(__float_as_int(qv), ch * 8 + e * 2 + 1));
                            s += q0 * bflo(kv[e]) + q1 * bfhi(kv[e]);
                        }
                    }
                    sc[rd] = (j < nkeys) ? s + bias : -1e30f;
                }
                const float m = wave_max(fmaxf(sc[0], fmaxf(sc[1], sc[2])));
                float e0 = __expf(sc[0] - m), e1 = __expf(sc[1] - m), e2 = __expf(sc[2] - m);
                if (lane >= nkeys) e0 = 0.f;
                if (lane + 64 >= nkeys) e1 = 0.f;
                if (lane + 128 >= nkeys) e2 = 0.f;
                const float inv = 1.f / wave_sum(e0 + e1 + e2);
                float o = 0.f;
                for (int j = 0; j < nkeys; ++j) {
                    int krow = NMAIN + b * NMETA + (j & 15);
                    if (j >= 16) { const int jj = j - 16; krow = b * SEQ + (R0 + (jj >> 4)) * 64 + C0 + (jj & 15); }
                    const float src = j < 64 ? e0 : (j < 128 ? e1 : e2);
                    const float pj = __int_as_float(__builtin_amdgcn_readlane(__float_as_int(src), j & 63));
                    o += pj * bf2f(Vb[(size_t)krow * 512 + h * 64 + lane]);
                }
                A2[(size_t)qrow * DM + h * 64 + lane] = (bf16_t)f2bf(o * inv);
            }
}

__device__ __forceinline__ void phase_3(const Params& P, unsigned char* lds, const int ph) {
    PHASE_PROLOGUE
            for (int tk = gw; tk < NT; tk += NGW) {
                const int b = tk / LSEQ, p = tk % LSEQ, row = rowof(b, p);
                const bool hp = p > 0, hn = p + 1 < LSEQ;
                const int rowp = hp ? rowof(b, p - 1) : row, rown = hn ? rowof(b, p + 1) : row;
#pragma unroll
                for (int j = 0; j < 7; ++j) {
                    const int c = 4 * lane + 256 * j;
                    const u32x2 vc = *(const u32x2*)(REST + (size_t)row * RESTC + c);
                    u32x2 vp = *(const u32x2*)(REST + (size_t)rowp * RESTC + c);
                    u32x2 vn = *(const u32x2*)(REST + (size_t)rown * RESTC + c);
                    if (!hp) { vp.x = 0; vp.y = 0; }
                    if (!hn) { vn.x = 0; vn.y = 0; }
                    const f32x4 m4 = *(const f32x4*)(mu + c);
                    float pc[4] = {bflo(vc.x), bfhi(vc.x), bflo(vc.y), bfhi(vc.y)};
                    float pp[4] = {bflo(vp.x), bfhi(vp.x), bflo(vp.y), bfhi(vp.y)};
                    float pn[4] = {bflo(vn.x), bfhi(vn.x), bflo(vn.y), bfhi(vn.y)};
                    float o[4];
#pragma unroll
                    for (int i = 0; i < 4; ++i) o[i] = pc[i] + m4[i] * (0.5f * (pp[i] + pn[i]) - pc[i]);
                    if (j == 6) {
                        if (lane < 16) { for (int i = 0; i < 4; ++i) o[i] = tanhf(o[i]); }
                        else if (lane >= 32) { for (int i = 0; i < 4; ++i) o[i] = sigmoidf_(o[i]); }
                    }
                    u32x2 ov; ov.x = pk2(o[0], o[1]); ov.y = pk2(o[2], o[3]);
                    bf16_t* dst = j < 2 ? Rr + (size_t)row * 512 + c : (j < 4 ? KR + (size_t)row * 512 + (c - 512) : (j < 6 ? VV + (size_t)row * 512 + (c - 1024) : LOW + (size_t)row * 256 + (c - 1536)));
                    *(u32x2*)dst = ov;
                }
            }
}

__device__ __forceinline__ void phase_4(const Params& P, unsigned char* lds, const int ph) {
    PHASE_PROLOGUE
            const int nrt = (NT + 127) / 128;
            const int nunits = nrt * 4 * 5;
            for (int u = bid; u < nunits; u += G) {
                const int which = u / (nrt * 4), rem = u % (nrt * 4), rt = rem / 4, ct = rem % 4;
                f32x4 acc[4][2];
                const int koff = which < 2 ? 0 : (which < 4 ? 64 : 128), KK_ = which < 4 ? 64 : 128;
                const float* Bsrc = which < 2 ? w_up + (size_t)which * 64 * 512 : (which < 4 ? a_up + (size_t)(which - 2) * 64 * 512 : g_up);
                gemm_tile(lds, KK_, 512,
                          [&](int r) { int row = rt * 128 + r; if (row >= NT) row = NT - 1; return LOW + (size_t)row * 256 + koff; },
                          [&](int n) { return Bsrc + ct * 128 + n; }, acc);
                ACC_FOREACH(acc, { const int row = rt * 128 + rl, col = ct * 128 + cl; if (row < NT) {
                    if (which < 2) { const float wl = w0[which * 512 + col] + val; Wd[((size_t)which * NT + row) * 512 + col] = __expf(-0.6065306597f * sigmoidf_(wl)); }
                    else if (which < 4) { const int d = which - 2; AA[((size_t)d * NT + row) * 512 + col] = (bf16_t)f2bf(sigmoidf_(a0[d * 512 + col] + val)); }
                    else Gg[(size_t)row * 512 + col] = (bf16_t)f2bf(val); } });
            }
}

__device__ __forceinline__ void phase_5(const Params& P, unsigned char* lds, const int ph) {
    PHASE_PROLOGUE
            for (int row = gw; row < NT; row += NGW) {
                const int c0 = lane * 8;
                const u32x4 krv = *(const u32x4*)(KR + (size_t)row * 512 + c0);
                const u32x4 rv = *(const u32x4*)(Rr + (size_t)row * 512 + c0);
                float kr[8], rr[8], kkv[8];
#pragma unroll
                for (int i = 0; i < 4; ++i) { kr[2 * i] = bflo(krv[i]); kr[2 * i + 1] = bfhi(krv[i]); rr[2 * i] = bflo(rv[i]); rr[2 * i + 1] = bfhi(rv[i]); }
                float ss = 0.f;
#pragma unroll
                for (int i = 0; i < 8; ++i) { kkv[i] = kr[i] * k_k[c0 + i]; ss += kkv[i] * kkv[i]; }
                ss += __shfl_xor(ss, 1); ss += __shfl_xor(ss, 2); ss += __shfl_xor(ss, 4);
                const float inv = 1.f / fmaxf(sqrtf(ss), 1e-12f);
#pragma unroll
                for (int i = 0; i < 8; ++i) kkv[i] *= inv;
                u32x4 o; o.x = pk2(kkv[0], kkv[1]); o.y = pk2(kkv[2], kkv[3]); o.z = pk2(kkv[4], kkv[5]); o.w = pk2(kkv[6], kkv[7]);
                *(u32x4*)(KK + (size_t)row * 512 + c0) = o;
                float bsum = 0.f;
#pragma unroll
                for (int d = 0; d < 2; ++d) {
                    const u32x4 av = *(const u32x4*)(AA + ((size_t)d * NT + row) * 512 + c0);
                    float a[8], kka[8], kd[8];
#pragma unroll
                    for (int i = 0; i < 4; ++i) { a[2 * i] = bflo(av[i]); a[2 * i + 1] = bfhi(av[i]); }
#pragma unroll
                    for (int i = 0; i < 8; ++i) { kka[i] = kkv[i] * a[i]; kd[i] = kr[i] * (1.f + (a[i] - 1.f) * k_a[c0 + i]); bsum += rr[i] * kd[i] * r_k[c0 + i]; }
                    u32x4 o1; o1.x = pk2(kka[0], kka[1]); o1.y = pk2(kka[2], kka[3]); o1.z = pk2(kka[4], kka[5]); o1.w = pk2(kka[6], kka[7]);
                    *(u32x4*)(KKA + ((size_t)d * NT + row) * 512 + c0) = o1;
                    u32x4 o2; o2.x = pk2(kd[0], kd[1]); o2.y = pk2(kd[2], kd[3]); o2.z = pk2(kd[4], kd[5]); o2.w = pk2(kd[6], kd[7]);
                    *(u32x4*)(KD + ((size_t)d * NT + row) * 512 + c0) = o2;
                }
                bsum += __shfl_xor(bsum, 1); bsum += __shfl_xor(bsum, 2); bsum += __shfl_xor(bsum, 4);
                if ((lane & 7) == 0) BC[(size_t)row * 8 + (lane >> 3)] = bsum;
            }
}

__device__ __forceinline__ void phase_6(const Params& P, unsigned char* lds, const int ph) {
    PHASE_PROLOGUE
            for (int cw = bid * 2 + wave; wave < 2 && cw < 512; cw += G * 2) {
                const int chain = cw >> 4, rg = cw & 15, d = chain >> 4, b = (chain >> 3) & 1, h = chain & 7;
                const int rr_ = lane >> 4, kq = lane & 15, vi = rg * 4 + rr_;
                float s0 = 0.f, s1 = 0.f, s2 = 0.f, s3 = 0.f;
                const float* Wp = Wd + (size_t)d * NT * 512;
                const bf16_t* KKAp = KKA + (size_t)d * NT * 512;
                const bf16_t* KDp = KD + (size_t)d * NT * 512;
                bf16_t* Yp = YFB + (size_t)d * NT * 512;
                for (int s = 0; s < LSEQ; ++s) {
                    const int p = d ? LSEQ - 1 - s : s;
                    const int row = rowof(b, p);
                    const size_t base = (size_t)row * 512 + h * 64;
                    const f32x4 w4 = *(const f32x4*)(Wp + base + 4 * kq);
                    const u32x2 kk2 = *(const u32x2*)(KK + base + 4 * kq);
                    const u32x2 ka2 = *(const u32x2*)(KKAp + base + 4 * kq);
                    const u32x2 kd2 = *(const u32x2*)(KDp + base + 4 * kq);
                    const u32x2 r2 = *(const u32x2*)(Rr + base + 4 * kq);
                    const float vv = bf2f(VV[base + vi]);
                    float dot = s0 * bflo(kk2.x) + s1 * bfhi(kk2.x) + s2 * bflo(kk2.y) + s3 * bfhi(kk2.y);
                    dot += __shfl_xor(dot, 1); dot += __shfl_xor(dot, 2); dot += __shfl_xor(dot, 4); dot += __shfl_xor(dot, 8);
                    const float sa = -dot;
                    s0 = s0 * w4[0] + sa * bflo(ka2.x) + vv * bflo(kd2.x);
                    s1 = s1 * w4[1] + sa * bfhi(ka2.x) + vv * bfhi(kd2.x);
                    s2 = s2 * w4[2] + sa * bflo(ka2.y) + vv * bflo(kd2.y);
                    s3 = s3 * w4[3] + sa * bfhi(ka2.y) + vv * bfhi(kd2.y);
                    float y = s0 * bflo(r2.x) + s1 * bfhi(r2.x) + s2 * bflo(r2.y) + s3 * bfhi(r2.y);
                    y += __shfl_xor(y, 1); y += __shfl_xor(y, 2); y += __shfl_xor(y, 4); y += __shfl_xor(y, 8);
                    if (kq == 0) Yp[base + vi] = (bf16_t)f2bf(y);
                }
            }
}

__device__ __forceinline__ void phase_7(const Params& P, unsigned char* lds, const int ph) {
    PHASE_PROLOGUE
            for (int row = gw; row < NT; row += NGW) {
                const int c0 = lane * 8;
                const u32x4 yf = *(const u32x4*)(YFB + (size_t)row * 512 + c0);
                const u32x4 yb = *(const u32x4*)(YFB + ((size_t)NT + row) * 512 + c0);
                const u32x4 vv = *(const u32x4*)(VV + (size_t)row * 512 + c0);
                const u32x4 gg = *(const u32x4*)(Gg + (size_t)row * 512 + c0);
                float y[8], v[8], g[8];
#pragma unroll
                for (int i = 0; i < 4; ++i) { y[2 * i] = bflo(yf[i]) + bflo(yb[i]); y[2 * i + 1] = bfhi(yf[i]) + bfhi(yb[i]); v[2 * i] = bflo(vv[i]); v[2 * i + 1] = bfhi(vv[i]); g[2 * i] = bflo(gg[i]); g[2 * i + 1] = bfhi(gg[i]); }
                float sm = 0.f;
#pragma unroll
                for (int i = 0; i < 8; ++i) sm += y[i];
                sm += __shfl_xor(sm, 1); sm += __shfl_xor(sm, 2); sm += __shfl_xor(sm, 4);
                const float mean = sm * (1.f / 64.f);
                float vr = 0.f;
#pragma unroll
                for (int i = 0; i < 8; ++i) { const float dlt = y[i] - mean; vr += dlt * dlt; }
                vr += __shfl_xor(vr, 1); vr += __shfl_xor(vr, 2); vr += __shfl_xor(vr, 4);
                const float rstd = rsqrtf(vr * (1.f / 64.f) + 64e-5f);
                const float bc = BC[(size_t)row * 8 + (lane >> 3)];
                float o[8];
#pragma unroll
                for (int i = 0; i < 8; ++i) o[i] = ((y[i] - mean) * rstd * lnx_g[c0 + i] + lnx_b[c0 + i] + bc * v[i]) * g[i];
                u32x4 ov; ov.x = pk2(o[0], o[1]); ov.y = pk2(o[2], o[3]); ov.z = pk2(o[4], o[5]); ov.w = pk2(o[6], o[7]);
                *(u32x4*)(A2 + (size_t)row * DM + 512 + c0) = ov;
            }
}

__device__ __forceinline__ void phase_8(const Params& P, unsigned char* lds, const int ph) {
    PHASE_PROLOGUE
            const int nrt = (NT + 127) / 128, nct = DM / 128;
            for (int u = bid; u < nrt * nct; u += G) {
                const int rt = u / nct, ct = u % nct;
                f32x4 acc[4][2];
                gemm_tile(lds, DM, DM,
                          [&](int r) { int row = rt * 128 + r; if (row >= NT) row = NT - 1; return A2 + (size_t)row * DM; },
                          [&](int n) { return w_out + ct * 128 + n; }, acc);
                ACC_FOREACH(acc, { const int row = rt * 128 + rl, col = ct * 128 + cl; if (row < NT) H[(size_t)row * DM + col] += val; });
            }
}

__device__ __forceinline__ void phase_9(const Params& P, unsigned char* lds, const int ph) {
    PHASE_PROLOGUE
            const int l = ph == 9 ? 0 : 1;
            for (int i = bid * 512 + tid; i < MOE_MAXROWS; i += G * 512) ROWTOK[i] = -1;
            unsigned* cnt = CTL + CW_CNT(l);
            const float* wg = moe_wg + (size_t)l * DM * 4; const float* bg = moe_bg + l * 4;
            for (int row = gw; row < NT; row += NGW) {
                f32x4 v[4]; float ss = 0.f;
#pragma unroll
                for (int j = 0; j < 4; ++j) { v[j] = ((const f32x4*)(H + (size_t)row * DM))[lane + 64 * j]; ss += v[j][0] * v[j][0] + v[j][1] * v[j][1] + v[j][2] * v[j][2] + v[j][3] * v[j][3]; }
                ss = wave_sum(ss);
                const float rstd = rsqrtf(ss * (1.f / DM) + 1e-6f);
                float lg[4] = {0.f, 0.f, 0.f, 0.f};
#pragma unroll
                for (int j = 0; j < 4; ++j) {
                    const f32x4 g = ((const f32x4*)(norm_ffn + l * DM))[lane + 64 * j];
#pragma unroll
                    for (int i = 0; i < 4; ++i) v[j][i] = v[j][i] * rstd * g[i];
                    u32x2 o; o.x = pk2(v[j][0], v[j][1]); o.y = pk2(v[j][2], v[j][3]);
                    ((u32x2*)(HN + (size_t)row * DM))[lane + 64 * j] = o;
#pragma unroll
                    for (int i = 0; i < 4; ++i) { const f32x4 w = *(const f32x4*)(wg + (size_t)(4 * (lane + 64 * j) + i) * 4);
                        lg[0] += v[j][i] * w[0]; lg[1] += v[j][i] * w[1]; lg[2] += v[j][i] * w[2]; lg[3] += v[j][i] * w[3]; }
                }
#pragma unroll
                for (int q = 0; q < 4; ++q) lg[q] = wave_sum(lg[q]) + bg[q];
                int grp = 0; float mx = lg[0];
#pragma unroll
                for (int q = 1; q < 4; ++q) if (lg[q] > mx) { mx = lg[q]; grp = q; }
                float den = 0.f;
#pragma unroll
                for (int q = 0; q < 4; ++q) den += __expf(lg[q] - mx);
                const float pgrp = 1.f / den;
                const float* we = moe_we + ((size_t)(l * 4 + grp) * DM) * 8;
                float le[8] = {0.f, 0.f, 0.f, 0.f, 0.f, 0.f, 0.f, 0.f};
#pragma unroll
                for (int j = 0; j < 4; ++j)
#pragma unroll
                    for (int i = 0; i < 4; ++i) { const float* wr_ = we + (size_t)(4 * (lane + 64 * j) + i) * 8; const f32x4 wa = *(const f32x4*)wr_, wb = *(const f32x4*)(wr_ + 4);
                        le[0] += v[j][i] * wa[0]; le[1] += v[j][i] * wa[1]; le[2] += v[j][i] * wa[2]; le[3] += v[j][i] * wa[3];
                        le[4] += v[j][i] * wb[0]; le[5] += v[j][i] * wb[1]; le[6] += v[j][i] * wb[2]; le[7] += v[j][i] * wb[3]; }
#pragma unroll
                for (int q = 0; q < 8; ++q) le[q] = wave_sum(le[q]) + moe_be[(l * 4 + grp) * 8 + q];
                int i1 = 0; float m1 = le[0];
#pragma unroll
                for (int q = 1; q < 8; ++q) if (le[q] > m1) { m1 = le[q]; i1 = q; }
                int i2 = -1; float m2 = -3.0e38f;
#pragma unroll
                for (int q = 0; q < 8; ++q) if (q != i1 && le[q] > m2) { m2 = le[q]; i2 = q; }
                const float e2 = __expf(m2 - m1);
                const float g1 = pgrp / (1.f + e2), g2 = pgrp * e2 / (1.f + e2);
                if (lane == 0) {
                    const int ea = grp * 8 + i1, eb = grp * 8 + i2;
                    const unsigned pa = atomicAdd(cnt + ea, 1u), pb = atomicAdd(cnt + eb, 1u);
                    EID[row * 2] = ea; EID[row * 2 + 1] = eb; POS[row * 2] = (int)pa; POS[row * 2 + 1] = (int)pb;
                    GATE[row * 2] = g1; GATE[row * 2 + 1] = g2;
                }
            }
}

__device__ __forceinline__ void phase_10(const Params& P, unsigned char* lds, const int ph) {
    PHASE_PROLOGUE
            const int l = ph == 10 ? 0 : 1;
            int* ps = (int*)lds;
            if (tid == 0) { int acc_ = 0; for (int e = 0; e < NEXP; ++e) { ps[e] = acc_; const int c = (int)CTL[CW_CNT(l) + e]; acc_ += (c + MOE_RT - 1) / MOE_RT * MOE_RT; } ps[NEXP] = acc_; }
            __syncthreads();
            for (int i = bid * 512 + tid; i < NT * 2; i += G * 512) {
                const int dest = ps[EID[i]] + POS[i];
                DEST[i] = dest; ROWTOK[dest] = i >> 1;
            }
            __syncthreads();
}

__device__ __forceinline__ void phase_11(const Params& P, unsigned char* lds, const int ph) {
    PHASE_PROLOGUE
            const int l = ph == 11 ? 0 : 1;
            int* ts = (int*)lds + 64;
            if (tid == 0) { int acc_ = 0; for (int e = 0; e < NEXP; ++e) { ts[e] = acc_; const int c = (int)CTL[CW_CNT(l) + e]; acc_ += (c + MOE_RT - 1) / MOE_RT; } ts[NEXP] = acc_; }
            __syncthreads();
            int tsr[NEXP + 1];
#pragma unroll
            for (int e = 0; e <= NEXP; ++e) tsr[e] = ts[e];
            __syncthreads();
            const int TT = tsr[NEXP];
            for (int u = bid; u < TT * 8; u += G) {
                const int rt = u >> 3, ct = u & 7;
                int e = 0;
#pragma unroll
                for (int q = 1; q < NEXP; ++q) if (rt >= tsr[q]) e = q;
                const float* W1 = moe_w1 + ((size_t)(l * NEXP + e) * DM) * DFF;
                const float* W3 = moe_w3 + ((size_t)(l * NEXP + e) * DM) * DFF;
                f32x4 acc[4][2];
                gemm_tile(lds, DM, DFF,
                          [&](int r) { int tok = ROWTOK[rt * 128 + r]; if (tok < 0) tok = 0; return HN + (size_t)tok * DM; },
                          [&](int n) { const int wc = n >> 5, ni = (n >> 4) & 1, c = n & 15; return (ni ? W3 : W1) + ct * 64 + wc * 16 + c; }, acc);
                ACC_FOREACH_PAIR(acc, { const float sg = va / (1.f + __expf(-va)); HB[(size_t)(rt * 128 + rl) * DFF + ct * 64 + co] = (bf16_t)f2bf(sg * vg); });
            }
}

__device__ __forceinline__ void phase_12(const Params& P, unsigned char* lds, const int ph) {
    PHASE_PROLOGUE
            const int l = ph == 12 ? 0 : 1;
            int* ts = (int*)lds + 64;
            if (tid == 0) { int acc_ = 0; for (int e = 0; e < NEXP; ++e) { ts[e] = acc_; const int c = (int)CTL[CW_CNT(l) + e]; acc_ += (c + MOE_RT - 1) / MOE_RT; } ts[NEXP] = acc_; }
            __syncthreads();
            int tsr[NEXP + 1];
#pragma unroll
            for (int e = 0; e <= NEXP; ++e) tsr[e] = ts[e];
            __syncthreads();
            const int TT = tsr[NEXP];
            for (int u = bid; u < TT * 8; u += G) {
                const int rt = u >> 3, ct = u & 7;
                int e = 0;
#pragma unroll
                for (int q = 1; q < NEXP; ++q) if (rt >= tsr[q]) e = q;
                const float* W2 = moe_w2 + ((size_t)(l * NEXP + e) * DFF) * DM;
                f32x4 acc[4][2];
                gemm_tile(lds, DFF, DM,
                          [&](int r) { return HB + (size_t)(rt * 128 + r) * DFF; },
                          [&](int n) { return W2 + ct * 128 + n; }, acc);
                ACC_FOREACH(acc, { YB[(size_t)(rt * 128 + rl) * DM + ct * 128 + cl] = (bf16_t)f2bf(val); });
            }
}

__device__ __forceinline__ void phase_13(const Params& P, unsigned char* lds, const int ph) {
    PHASE_PROLOGUE
            const bool fin = ph == 21;
            for (int row = gw; row < NT; row += NGW) {
                const int d0 = DEST[row * 2], d1 = DEST[row * 2 + 1];
                const float g0 = GATE[row * 2], g1 = GATE[row * 2 + 1];
                f32x4 v[4];
#pragma unroll
                for (int j = 0; j < 4; ++j) {
                    v[j] = ((const f32x4*)(H + (size_t)row * DM))[lane + 64 * j];
                    const u32x2 ya = ((const u32x2*)(YB + (size_t)d0 * DM))[lane + 64 * j];
                    const u32x2 yb = ((const u32x2*)(YB + (size_t)d1 * DM))[lane + 64 * j];
                    v[j][0] += g0 * bflo(ya.x) + g1 * bflo(yb.x); v[j][1] += g0 * bfhi(ya.x) + g1 * bfhi(yb.x);
                    v[j][2] += g0 * bflo(ya.y) + g1 * bflo(yb.y); v[j][3] += g0 * bfhi(ya.y) + g1 * bfhi(yb.y);
                }
                if (!fin) {
#pragma unroll
                    for (int j = 0; j < 4; ++j) ((f32x4*)(H + (size_t)row * DM))[lane + 64 * j] = v[j];
                    store_norm_bf16(v, norm_mix + DM, HN + (size_t)row * DM, lane);
                } else if (row < NMAIN) {
                    float ss = 0.f;
#pragma unroll
                    for (int j = 0; j < 4; ++j) ss += v[j][0] * v[j][0] + v[j][1] * v[j][1] + v[j][2] * v[j][2] + v[j][3] * v[j][3];
                    ss = wave_sum(ss);
                    const float rstd = rsqrtf(ss * (1.f / DM) + 1e-6f);
#pragma unroll
                    for (int j = 0; j < 4; ++j) { const f32x4 g = ((const f32x4*)norm_final)[lane + 64 * j]; f32x4 o;
                        o[0] = v[j][0] * rstd * g[0]; o[1] = v[j][1] * rstd * g[1]; o[2] = v[j][2] * rstd * g[2]; o[3] = v[j][3] * rstd * g[3];
                        ((f32x4*)(P.out + (size_t)row * DM))[lane + 64 * j] = o; }
                }
            }
}

__device__ __forceinline__ void phase_14(const Params& P, unsigned char* lds, const int ph) {
    PHASE_PROLOGUE
            const bool outp = ph == 16;
            const int nunits = 2 * NB * 64 * S5NC;
            for (int u = gw; u < nunits; u += NGW) {
                const int c = u % S5NC, dbg = u / S5NC, g = dbg & 63, b = (dbg >> 6) & 1, d = dbg >> 7;
                const int p = lane;
                const float step = __expf(s5_ls[d * 64 + g]);
                const float lr = s5_lre[(d * 64 + g) * 64 + p], li = s5_lim[(d * 64 + g) * 64 + p];
                const float mag = expf(lr * step);
                const float abr = mag * cosf(li * step), abi = mag * sinf(li * step);
                const float den = lr * lr + li * li;
                const float zr = ((abr - 1.f) * lr + abi * li) / den, zi = (abi * lr - (abr - 1.f) * li) / den;
                float bbr[16], bbi[16];
#pragma unroll
                for (int q = 0; q < 4; ++q) {
                    const f32x4 br = *(const f32x4*)(s5_b_re + ((size_t)(g * 64 + p)) * 16 + 4 * q), bi = *(const f32x4*)(s5_b_im + ((size_t)(g * 64 + p)) * 16 + 4 * q);
#pragma unroll
                    for (int i = 0; i < 4; ++i) { bbr[4 * q + i] = zr * br[i] - zi * bi[i]; bbi[4 * q + i] = zr * bi[i] + zi * br[i]; }
                }
                float sr = 0.f, si = 0.f;
                if (outp) { const float* cp = CARRY + (((size_t)dbg * S5NC + c) * 64 + p) * 2; sr = cp[0]; si = cp[1]; }
                float cre[16], cim[16];
                if (outp) {
#pragma unroll
                    for (int i = 0; i < 16; ++i) { cre[i] = s5_c_re[((size_t)(d * 64 + g) * 16 + i) * 64 + p]; cim[i] = s5_c_im[((size_t)(d * 64 + g) * 16 + i) * 64 + p]; }
                }
                for (int tt = 0; tt < S5TC; ++tt) {
                    const int sidx = c * S5TC + tt, pos = d ? LSEQ - 1 - sidx : sidx, row = rowof(b, pos);
                    const u32x4 ua = *(const u32x4*)(HN + (size_t)row * DM + g * 16), ub = *(const u32x4*)(HN + (size_t)row * DM + g * 16 + 8);
                    float uu[16];
#pragma unroll
                    for (int i = 0; i < 4; ++i) { uu[2 * i] = bflo(ua[i]); uu[2 * i + 1] = bfhi(ua[i]); uu[8 + 2 * i] = bflo(ub[i]); uu[8 + 2 * i + 1] = bfhi(ub[i]); }
                    float bur = 0.f, bui = 0.f;
#pragma unroll
                    for (int i = 0; i < 16; ++i) { bur += bbr[i] * uu[i]; bui += bbi[i] * uu[i]; }
                    const float nr = abr * sr - abi * si + bur, ni = abr * si + abi * sr + bui;
                    sr = nr; si = ni;
                    if (outp) {
                        float mine = 0.f;
#pragma unroll
                        for (int i = 0; i < 16; ++i) { const float yv = wave_sum(cre[i] * sr - cim[i] * si); if (lane == i) mine = yv; }
                        if (lane < 16) YS[((size_t)d * NT + row) * DM + g * 16 + lane] = mine;
                    }
                }
                if (!outp) { float* ep = ENDS + (((size_t)dbg * S5NC + c) * 64 + p) * 2; ep[0] = sr; ep[1] = si; }
            }
}

__device__ __forceinline__ void phase_15(const Params& P, unsigned char* lds, const int ph) {
    PHASE_PROLOGUE
            for (int i = bid * 512 + tid; i < 2 * NB * 64 * 64; i += G * 512) {
                const int p = i & 63, dbg = i >> 6, g = dbg & 63, d = dbg >> 7;
                const float step = __expf(s5_ls[d * 64 + g]);
                const float lr = s5_lre[(d * 64 + g) * 64 + p], li = s5_lim[(d * 64 + g) * 64 + p];
                const float mag = expf(lr * step * (float)S5TC);
                const float ang = li * step;
                float pr = 1.f, pi = 0.f; const float cr = cosf(ang), ci = sinf(ang);
                for (int q = 0; q < S5TC; ++q) { const float t = pr * cr - pi * ci; pi = pr * ci + pi * cr; pr = t; }
                const float ar = mag * pr, ai = mag * pi;
                float yr = 0.f, yi = 0.f;
                for (int c = 0; c < S5NC; ++c) {
                    const size_t o = (((size_t)dbg * S5NC + c) * 64 + p) * 2;
                    CARRY[o] = yr; CARRY[o + 1] = yi;
                    const float er = ENDS[o], ei = ENDS[o + 1];
                    const float t = ar * yr - ai * yi + er; yi = ar * yi + ai * yr + ei; yr = t;
                }
            }
}

__device__ __forceinline__ void phase_22(const Params& P, unsigned char* lds, const int ph) {
    PHASE_PROLOGUE
            for (size_t i = (size_t)bid * 512 + tid; i < (size_t)NT * DM / 4; i += (size_t)G * 512) {
                const f32x4 y0 = ((const f32x4*)YS)[i], y1 = ((const f32x4*)(YS + (size_t)NT * DM))[i];
                const int col = (int)((i * 4) & (DM - 1));
                const f32x4 dd = *(const f32x4*)(s5_d + col);
                const u32x2 uu = ((const u32x2*)HN)[i];
                float u4[4] = {bflo(uu.x), bfhi(uu.x), bflo(uu.y), bfhi(uu.y)};
                float o[4];
#pragma unroll
                for (int q = 0; q < 4; ++q) { const float yv = y0[q] + y1[q] + dd[q] * u4[q];
                    o[q] = 0.5f * yv * (1.f + tanhf(0.7978845608f * (yv + 0.044715f * yv * yv * yv))); }
                u32x2 ov; ov.x = pk2(o[0], o[1]); ov.y = pk2(o[2], o[3]);
                ((u32x2*)A2)[i] = ov;
            }
}

__device__ __forceinline__ void phase_23(const Params& P, unsigned char* lds, const int ph) {
    PHASE_PROLOGUE
            const int nrt = (NT + 127) / 128, nct = DM / 64;
            for (int u = bid; u < nrt * nct; u += G) {
                const int rt = u / nct, ct = u % nct;
                f32x4 acc[4][2];
                gemm_tile(lds, DM, 2 * DM,
                          [&](int r) { int row = rt * 128 + r; if (row >= NT) row = NT - 1; return A2 + (size_t)row * DM; },
                          [&](int n) { const int wc = n >> 5, ni = (n >> 4) & 1, c = n & 15; return w_glu + (ni ? DM : 0) + ct * 64 + wc * 16 + c; }, acc);
                ACC_FOREACH_PAIR(acc, { const int row = rt * 128 + rl; if (row < NT) H[(size_t)row * DM + ct * 64 + co] += va * sigmoidf_(vg); });
            }
}

#define PHASE_CALL(PH) \
    if constexpr (PH == 0) phase_0(P, lds, PH); \
    if constexpr (PH == 1) phase_1(P, lds, PH); \
    if constexpr (PH == 2) phase_2(P, lds, PH); \
    if constexpr (PH == 3) phase_3(P, lds, PH); \
    if constexpr (PH == 4) phase_4(P, lds, PH); \
    if constexpr (PH == 5) phase_5(P, lds, PH); \
    if constexpr (PH == 6) phase_6(P, lds, PH); \
    if constexpr (PH == 7) phase_7(P, lds, PH); \
    if constexpr (PH == 8) phase_8(P, lds, PH); \
    if constexpr (PH == 9) phase_9(P, lds, PH); \
    if constexpr (PH == 10) phase_10(P, lds, PH); \
    if constexpr (PH == 11) phase_11(P, lds, PH); \
    if constexpr (PH == 12) phase_12(P, lds, PH); \
    if constexpr (PH == 13) phase_13(P, lds, PH); \
    if constexpr (PH == 14) phase_14(P, lds, PH); \
    if constexpr (PH == 15) phase_15(P, lds, PH); \
    if constexpr (PH == 16) phase_14(P, lds, PH); \
    if constexpr (PH == 17) phase_9(P, lds, PH); \
    if constexpr (PH == 18) phase_10(P, lds, PH); \
    if constexpr (PH == 19) phase_11(P, lds, PH); \
    if constexpr (PH == 20) phase_12(P, lds, PH); \
    if constexpr (PH == 21) phase_13(P, lds, PH); \
    if constexpr (PH == 22) phase_22(P, lds, PH); \
    if constexpr (PH == 23) phase_23(P, lds, PH);


#define LAS __attribute__((address_space(3)))
#define CW_BAR 4096
#define XB_TMO      128
#define XB_XCNT(j)  (256  + 64 * (j))
#define XB_XSUB(j)  (1280 + 64 * (j))
#define XB_XGEN(j)  (2304 + 64 * (j))
#define XB_TOP      3328
#define XB_TOPGEN   3392
#define XCD_BAR_WORDS 3456
#define XB_SPIN_CAP (1u << 22)
__device__ __forceinline__ unsigned xb_ld(unsigned* p)              { return __hip_atomic_load(p, __ATOMIC_RELAXED, __HIP_MEMORY_SCOPE_AGENT); }
__device__ __forceinline__ unsigned xb_add(unsigned* p, unsigned v) { return __hip_atomic_fetch_add(p, v, __ATOMIC_RELAXED, __HIP_MEMORY_SCOPE_AGENT); }
__device__ __forceinline__ unsigned xb_xcc_id() { return (unsigned)__builtin_amdgcn_s_getreg((3 << 11) | 20) & 0xFu; }
#define XB_SPIN(cond, bar) do { unsigned _sp = 0; while (cond) { __builtin_amdgcn_s_sleep(1); \
    if ((++_sp & 255u) == 0u) { if (xb_ld(&(bar)[XB_TMO])) break; if (_sp > XB_SPIN_CAP) { atomicAdd(&(bar)[XB_TMO], 1u); break; } } } } while (0)
struct XcdBarrier { unsigned* bar; unsigned x; volatile LAS unsigned* st; };
__device__ __forceinline__ XcdBarrier xcd_barrier_post(unsigned* bar, volatile LAS unsigned* st) {
    XcdBarrier b; b.bar = bar; b.x = xb_xcc_id(); b.st = st;
    if (threadIdx.x == 0) (void)xb_add(&bar[XB_XCNT(b.x)], 1u);
    return b;
}
__device__ __forceinline__ void xcd_barrier_complete(unsigned* bar, unsigned x, unsigned& nloc, unsigned& nx) {
    const unsigned G = gridDim.x * gridDim.y * gridDim.z;
    unsigned sum, cnt, mine, sp = 0u;
    for (;;) {
        sum = 0u; cnt = 0u; mine = 0u;
#pragma unroll
        for (unsigned j = 0; j < 16; ++j) { const unsigned c = xb_ld(&bar[XB_XCNT(j)]); sum += c; cnt += (c > 0u) ? 1u : 0u; mine = (j == x) ? c : mine; }
        if (sum == G) break;
        __builtin_amdgcn_s_sleep(1);
        if ((++sp & 255u) == 0u) { if (xb_ld(&bar[XB_TMO])) break; if (sp > XB_SPIN_CAP) { atomicAdd(&bar[XB_TMO], 1u); break; } }
    }
    nloc = mine > 0u ? mine : 1u; nx = cnt > 0u ? cnt : 1u;
}
__device__ __forceinline__ void xcd_barrier(const XcdBarrier& b) {
    asm volatile("s_waitcnt vmcnt(0)" ::: "memory");
    __syncthreads();
    if (threadIdx.x == 0) {
        unsigned* bar = b.bar;
        __builtin_amdgcn_s_waitcnt(0);
        unsigned nloc = b.st[0], nx = b.st[1];
        if (nloc == 0u) { xcd_barrier_complete(bar, b.x, nloc, nx); b.st[0] = nloc; b.st[1] = nx; }
        const unsigned old = xb_add(&bar[XB_XSUB(b.x)], 1u);
        const unsigned gen = old / nloc;
        if (old + 1u == (gen + 1u) * nloc) {
            __builtin_amdgcn_fence(__ATOMIC_RELEASE, "agent");
            asm volatile("s_waitcnt vmcnt(0)" ::: "memory");
            const unsigned og = xb_add(&bar[XB_TOP], 1u);
            const unsigned tg = og / nx;
            if (og + 1u == (tg + 1u) * nx) xb_add(&bar[XB_TOPGEN], 1u);
            else XB_SPIN(xb_ld(&bar[XB_TOPGEN]) == tg, bar);
            __builtin_amdgcn_fence(__ATOMIC_ACQUIRE, "agent");
            xb_add(&bar[XB_XGEN(b.x)], 1u);
            asm volatile("s_waitcnt vmcnt(0)" ::: "memory");
        } else {
            XB_SPIN(xb_ld(&bar[XB_XGEN(b.x)]) == gen, bar);
            __builtin_amdgcn_fence(__ATOMIC_ACQUIRE, "agent");
            asm volatile("s_waitcnt vmcnt(0)" ::: "memory");
        }
    }
    __syncthreads();
}

#define LDS_MAIN 32768
__global__ void __launch_bounds__(512, 2) mega(Params P) {
    __shared__ __attribute__((aligned(16))) unsigned char lds[LDS_MAIN + 64];
    volatile LAS unsigned* st = (volatile LAS unsigned*)(LAS unsigned char*)(lds + LDS_MAIN);
    if (threadIdx.x < 16) st[threadIdx.x] = 0u;
    __syncthreads();
    const XcdBarrier bar = xcd_barrier_post((unsigned*)(P.ws + WS_CTL) + CW_BAR, st);
#define GB xcd_barrier(bar)
    phase_0(P, lds, 0); GB;
    phase_1(P, lds, 1); GB;
    phase_2(P, lds, 2);
    phase_3(P, lds, 3); GB;
    phase_4(P, lds, 4); GB;
    phase_5(P, lds, 5); GB;
    phase_6(P, lds, 6); GB;
    phase_7(P, lds, 7); GB;
    phase_8(P, lds, 8); GB;
    phase_9(P, lds, 9); GB;
    phase_10(P, lds, 10); GB;
    phase_11(P, lds, 11); GB;
    phase_12(P, lds, 12); GB;
    phase_13(P, lds, 13); GB;
    phase_14(P, lds, 14); GB;
    phase_15(P, lds, 15); GB;
    phase_14(P, lds, 16); GB;
    phase_22(P, lds, 22); GB;
    phase_23(P, lds, 23); GB;
    phase_9(P, lds, 17); GB;
    phase_10(P, lds, 18); GB;
    phase_11(P, lds, 19); GB;
    phase_12(P, lds, 20); GB;
    phase_13(P, lds, 21);
}

extern "C" void kernel_launch(void* const* d_in, const int* in_sizes, int n_in, void* d_out, int out_size, void* d_ws, size_t ws_size, hipStream_t stream) {
    if (n_in != 35 || ws_size < WS_TOTAL) { fprintf(stderr, "kernel_launch: unexpected n_in %d or ws_size %zu (need %zu)\n", n_in, ws_size, (size_t)WS_TOTAL); return; }
    (void)hipMemsetAsync((char*)d_ws + WS_CTL, 0, 1 * MiB, stream);
    Params P{};
    for (int i = 0; i < 35; ++i) P.in[i] = (const float*)d_in[i];
    P.out = (float*)d_out; P.ws = (unsigned char*)d_ws; P.ph_lo = 0; P.ph_hi = 0;
    hipLaunchKernelGGL(mega, dim3(256), dim3(512), 0, stream, P);
}
```

```cpp
#include <hip/hip_runtime.h>
#include <stdint.h>
#include <stdio.h>

#define DM 1024
#define NB 2
#define SEQ 8192
#define NMETA 16
#define LSEQ (SEQ + NMETA)
#define NMAIN (NB * SEQ)
#define NT (NB * LSEQ)
#define NTP 16640
#define INCOLS 3328
#define RESTC 1792
#define NEXP 32
#define DFF 512
#define S5TC 48
#define S5NC 171
#define MOE_RT 256
#define MOE_MAXROWS 41216

typedef unsigned short bf16_t;
typedef short bf16x8 __attribute__((ext_vector_type(8)));
typedef float f32x4 __attribute__((ext_vector_type(4)));
typedef unsigned u32x4 __attribute__((ext_vector_type(4)));
typedef unsigned u32x2 __attribute__((ext_vector_type(2)));

constexpr size_t MiB = 1u << 20;
constexpr size_t al64k(size_t x) { return (x + 65535) & ~(size_t)65535; }
constexpr size_t WS_CTL = 0;
constexpr size_t WS_H = 1 * MiB;
constexpr size_t WS_HN = WS_H + al64k((size_t)NT * DM * 4);
constexpr size_t WS_A2 = WS_HN + al64k((size_t)NTP * DM * 2);
constexpr size_t WS_WTIN = WS_A2 + al64k((size_t)NTP * DM * 2);
constexpr size_t WS_WTOUT = WS_WTIN + al64k((size_t)INCOLS * DM * 2);
constexpr size_t WS_WTGLU = WS_WTOUT + al64k((size_t)DM * DM * 2);
constexpr size_t WS_WT13 = WS_WTGLU + al64k((size_t)2 * DM * DM * 2);
constexpr size_t WS_WT2 = WS_WT13 + al64k((size_t)NEXP * DM * DM * 2);
constexpr size_t WS_BIG = WS_WT2 + al64k((size_t)NEXP * DM * DFF * 2);
constexpr size_t SZ_T512 = al64k((size_t)NT * 512 * 2);
constexpr size_t SZ_P512 = al64k((size_t)NTP * 512 * 2);
constexpr size_t WS_Q = WS_BIG;
constexpr size_t WS_K = WS_Q + SZ_P512;
constexpr size_t WS_V = WS_K + SZ_P512;
constexpr size_t WS_REST = WS_V + SZ_P512;
constexpr size_t WS_R = WS_REST + al64k((size_t)NTP * RESTC * 2);
constexpr size_t WS_KR = WS_R + SZ_T512;
constexpr size_t WS_VV = WS_KR + SZ_T512;
constexpr size_t WS_LOW = WS_VV + SZ_T512;
constexpr size_t WS_G = WS_LOW + al64k((size_t)NT * 256 * 2);
constexpr size_t WS_KK = WS_G + SZ_T512;
constexpr size_t WS_KKA = WS_KK + SZ_T512;
constexpr size_t WS_KD = WS_KKA + 2 * SZ_T512;
constexpr size_t WS_BC = WS_KD + 2 * SZ_T512;
constexpr size_t WS_MIXEND = WS_BC + al64k((size_t)NT * 8 * 4);
constexpr size_t WS_AA = WS_Q;
constexpr size_t WS_YFB = WS_Q;
constexpr size_t WS_W = WS_V;
static_assert(2 * SZ_T512 <= 2 * SZ_P512, "AA/YFB fit in Q|K");
static_assert((size_t)2 * NT * 512 * 4 <= SZ_P512 + al64k((size_t)NTP * RESTC * 2), "W fits in V|REST");
constexpr size_t WS_XB = WS_BIG;
constexpr size_t WS_HB = WS_XB + al64k((size_t)MOE_MAXROWS * DM * 2);
constexpr size_t WS_YB = WS_HB + al64k((size_t)MOE_MAXROWS * DFF * 2);
constexpr size_t WS_EID = WS_YB + al64k((size_t)MOE_MAXROWS * DM * 2);
constexpr size_t WS_POS = WS_EID + al64k((size_t)NT * 8);
constexpr size_t WS_DEST = WS_POS + al64k((size_t)NT * 8);
constexpr size_t WS_GATE = WS_DEST + al64k((size_t)NT * 8);
constexpr size_t WS_MOEEND = WS_GATE + al64k((size_t)NT * 8);
constexpr size_t WS_YS = WS_BIG;
constexpr size_t WS_END = WS_YS + al64k((size_t)2 * NT * DM * 4);
constexpr size_t WS_CARRY = WS_END + al64k((size_t)256 * S5NC * 64 * 8);
constexpr size_t WS_S5END = WS_CARRY + al64k((size_t)256 * S5NC * 64 * 8);
constexpr size_t cmax(size_t a, size_t b) { return a > b ? a : b; }
constexpr size_t WS_TOTAL = cmax(WS_MIXEND, cmax(WS_MOEEND, WS_S5END));
static_assert(WS_TOTAL <= 512 * MiB, "workspace map exceeds 512 MiB");

#define CW_CNT(l) (1024 + 64 * (l))

#define LDS_RING 131072
#define LDS_BARST (LDS_RING)
#define LDS_TAB (LDS_RING + 256)
#define LDS_BYTES 147456
#define GRID 256

struct Params {
    const float* in[35];
    float* out;
    unsigned char* ws;
    int ph_lo, ph_hi;
};
typedef const __attribute__((address_space(4))) Params CParams;

__device__ __forceinline__ float bf2f(bf16_t v) { return __uint_as_float(((unsigned)v) << 16); }
__device__ __forceinline__ unsigned f2bf(float f) { unsigned u = __float_as_uint(f); return (u + 0x7fffu + ((u >> 16) & 1u)) >> 16; }
__device__ __forceinline__ unsigned pk2(float lo, float hi) { return f2bf(lo) | (f2bf(hi) << 16); }
__device__ __forceinline__ float bflo(unsigned u) { return __uint_as_float(u << 16); }
__device__ __forceinline__ float bfhi(unsigned u) { return __uint_as_float(u & 0xffff0000u); }
__device__ __forceinline__ float wave_sum(float v) {
#pragma unroll
    for (int o = 1; o < 64; o <<= 1) v += __shfl_xor(v, o);
    return v;
}
__device__ __forceinline__ float wave_max(float v) {
#pragma unroll
    for (int o = 1; o < 64; o <<= 1) v = fmaxf(v, __shfl_xor(v, o));
    return v;
}
__device__ __forceinline__ float sigmoidf_(float x) { return 1.f / (1.f + __expf(-x)); }
__device__ __forceinline__ int rowof(int b, int p) { return p < NMETA ? NMAIN + b * NMETA + p : b * SEQ + (p - NMETA); }

#define SA_STRIDE 40
template <class AF, class BF>
__device__ __forceinline__ void gemm_tile(unsigned char* lds, int K, int ldb, const AF& arow, const BF& bcol, f32x4 (&acc)[4][2]) {
    bf16_t* sA = (bf16_t*)lds;
    bf16_t* sB = (bf16_t*)(lds + 128 * SA_STRIDE * 2);
    const int tid = threadIdx.x, lane = tid & 63, wave = tid >> 6, wr = wave >> 2, wc = wave & 3, fr = lane & 15, fq = lane >> 4;
#pragma unroll
    for (int mi = 0; mi < 4; ++mi)
#pragma unroll
        for (int ni = 0; ni < 2; ++ni) acc[mi][ni] = (f32x4){0.f, 0.f, 0.f, 0.f};
    const int ar = tid >> 2, akc = (tid & 3) * 8;
    const bf16_t* ap = arow(ar) + akc;
    const int bnq = (tid & 31) * 4, bkp = (tid >> 5) * 2;
    const float* bp = bcol(bnq) + (size_t)bkp * ldb;
    const int nk = K / 32;
    u32x4 ra = *(const u32x4*)ap;
    f32x4 rb0 = *(const f32x4*)bp, rb1 = *(const f32x4*)(bp + ldb);
    for (int kt = 0; kt < nk; ++kt) {
        __syncthreads();
        *(u32x4*)(sA + ar * SA_STRIDE + akc) = ra;
        {
            unsigned* d = (unsigned*)(sB + bnq * SA_STRIDE + bkp);
            d[0 * (SA_STRIDE / 2)] = pk2(rb0[0], rb1[0]);
            d[1 * (SA_STRIDE / 2)] = pk2(rb0[1], rb1[1]);
            d[2 * (SA_STRIDE / 2)] = pk2(rb0[2], rb1[2]);
            d[3 * (SA_STRIDE / 2)] = pk2(rb0[3], rb1[3]);
        }
        __syncthreads();
        if (kt + 1 < nk) {
            ra = *(const u32x4*)(ap + (kt + 1) * 32);
            const float* q = bp + (size_t)(kt + 1) * 32 * ldb;
            rb0 = *(const f32x4*)q; rb1 = *(const f32x4*)(q + ldb);
        }
        bf16x8 a[4], b[2];
#pragma unroll
        for (int mi = 0; mi < 4; ++mi) a[mi] = *(const bf16x8*)(sA + (wr * 64 + mi * 16 + fr) * SA_STRIDE + fq * 8);
#pragma unroll
        for (int ni = 0; ni < 2; ++ni) b[ni] = *(const bf16x8*)(sB + (wc * 32 + ni * 16 + fr) * SA_STRIDE + fq * 8);
#pragma unroll
        for (int mi = 0; mi < 4; ++mi)
#pragma unroll
            for (int ni = 0; ni < 2; ++ni) acc[mi][ni] = __builtin_amdgcn_mfma_f32_16x16x32_bf16(a[mi], b[ni], acc[mi][ni], 0, 0, 0);
    }
    __syncthreads();
}
#define ACC_FOREACH(acc, ...) do { const int _l = threadIdx.x & 63, _w = threadIdx.x >> 6, _wr = _w >> 2, _wc = _w & 3, _fr = _l & 15, _fq = _l >> 4; \
    _Pragma("unroll") for (int _mi = 0; _mi < 4; ++_mi) _Pragma("unroll") for (int _ni = 0; _ni < 2; ++_ni) _Pragma("unroll") for (int _j = 0; _j < 4; ++_j) { \
        const int rl = _wr * 64 + _mi * 16 + _fq * 4 + _j, cl = _wc * 32 + _ni * 16 + _fr; const float val = acc[_mi][_ni][_j]; __VA_ARGS__ } } while (0)
#define ACC_FOREACH_PAIR(acc, ...) do { const int _l = threadIdx.x & 63, _w = threadIdx.x >> 6, _wr = _w >> 2, _wc = _w & 3, _fr = _l & 15, _fq = _l >> 4; \
    _Pragma("unroll") for (int _mi = 0; _mi < 4; ++_mi) _Pragma("unroll") for (int _j = 0; _j < 4; ++_j) { \
        const int rl = _wr * 64 + _mi * 16 + _fq * 4 + _j, co = _wc * 16 + _fr; const float va = acc[_mi][0][_j], vg = acc[_mi][1][_j]; __VA_ARGS__ } } while (0)

__device__ __forceinline__ void store_norm_bf16(const f32x4 (&v)[4], const float* gain, bf16_t* dst, int lane) {
    float ss = 0.f;
#pragma unroll
    for (int j = 0; j < 4; ++j) ss += v[j][0] * v[j][0] + v[j][1] * v[j][1] + v[j][2] * v[j][2] + v[j][3] * v[j][3];
    ss = wave_sum(ss);
    const float rstd = rsqrtf(ss * (1.f / DM) + 1e-6f);
#pragma unroll
    for (int j = 0; j < 4; ++j) {
        const f32x4 g = ((const f32x4*)gain)[lane + 64 * j];
        u32x2 o; o.x = pk2(v[j][0] * rstd * g[0], v[j][1] * rstd * g[1]); o.y = pk2(v[j][2] * rstd * g[2], v[j][3] * rstd * g[3]);
        ((u32x2*)dst)[lane + 64 * j] = o;
    }
}

namespace pg8 {
#define PG8_LAS __attribute__((address_space(3)))
constexpr int BM = 256, BK = 64, HALF = 128, HTB = HALF * BK * 2  , STAGE_BYTES = 8 * HTB, NXCD = 8, WGM = 8;
__host__ __device__ __forceinline__ int lds_byte(int r, int c) { const int st = (r >> 4) * 2 + (c >> 5), rr = r & 15, cc = c & 31, ob = rr * 64 + cc * 2; return st * 1024 + (ob ^ (((ob >> 9) & 1) << 5)); }
__host__ __device__ __forceinline__ void stage_rc(int b, int& R, int& C) { const int st = b / 1024, sb = b % 1024, swz = sb ^ (((sb >> 9) & 1) << 5); R = (st >> 1) * 16 + swz / 64; C = (st & 1) * 32 + (swz % 64) / 2; }
__host__ __device__ __forceinline__ int perm32(int rho) { const int n = rho >> 4, i = rho & 15; return 8 * (i >> 2) + 4 * n + (i & 3); }

struct Unit { int pm, pn; const char* A; const char* B; };

struct DenseOrder {
    int nM, nN, nwg, G, c; const char* A; const char* Bt; size_t tstep;
    __device__ void init(const bf16_t* A_, const bf16_t* Bt_, int M, int N, int K, int G_, int c_) { nM = M / BM; nN = N / BM; nwg = nM * nN; G = G_; c = c_; A = (const char*)A_; Bt = (const char*)Bt_; tstep = (size_t)BM * K * 2; }
    __device__ bool next(int i, Unit& u) const {
        const long L = (long)i * G + c; if (L >= nwg) return false;
        int wgid = (int)L; { const int q = nwg / NXCD, r = nwg % NXCD, xcd = wgid % NXCD, off = wgid / NXCD; wgid = (xcd < r ? xcd * (q + 1) : r * (q + 1) + (xcd - r) * q) + off; }
        const int nig = WGM * nN, gid = wgid / nig, fm = gid * WGM, gsz = (nM - fm) < WGM ? (nM - fm) : WGM;
        u.pm = fm + ((wgid % nig) % gsz); u.pn = (wgid % nig) / gsz; u.A = A + (size_t)u.pm * tstep; u.B = Bt + (size_t)u.pn * tstep; return true;
    }
    __device__ __forceinline__ void a_ready(const Unit&) const {}
    __device__ __forceinline__ void done(const Unit&) const {}
};
struct MoeOrder {
    const int* et; int TT, vcu; const char* A; const char* Bt; unsigned tstepA, tstepB, estep;
    __device__ __forceinline__ bool next(int i, Unit& u) const {
        const int L = i * GRID + vcu; if (L >= TT * 4) return false;
        const int rt = L >> 2, ct = L & 3, e = et[rt];
        u.pm = rt; u.pn = ct; u.A = A + (size_t)rt * tstepA; u.B = Bt + (size_t)e * estep + (size_t)ct * tstepB; return true;
    }
    __device__ __forceinline__ void a_ready(const Unit&) const {}
    __device__ __forceinline__ void done(const Unit&) const {}
};

__device__ __forceinline__ unsigned cvt_pk_bf16(float lo, float hi) { unsigned r; asm volatile("v_cvt_pk_bf16_f32 %0, %1, %2" : "=v"(r) : "v"(lo), "v"(hi)); return r; }

struct EpiProj {
    static constexpr bool PERM = true, AFTER_DRAIN = false;
    bf16_t *Q, *Kk, *V, *REST;
    __device__ __forceinline__ void operator()(const f32x4 (&acc)[2][2][4][2], const Unit& u, int wr, int wc, int fr, int fq) const {
        const int row0 = u.pm * BM + wr * 64 + fr; int colt = u.pn * BM; bf16_t* base; int ldc;
        if (colt < 512) { base = Q; ldc = 512; } else if (colt < 1024) { base = Kk; colt -= 512; ldc = 512; } else if (colt < 1536) { base = V; colt -= 1024; ldc = 512; } else { base = REST; colt -= 1536; ldc = RESTC; }
        const int col0 = colt + wc * 32 + 8 * fq;
#pragma unroll
        for (int ai = 0; ai < 2; ++ai)
#pragma unroll
            for (int m = 0; m < 4; ++m) { bf16_t* rowp = base + (size_t)(row0 + ai * HALF + m * 16) * ldc + col0;
#pragma unroll
                for (int bj = 0; bj < 2; ++bj) { const f32x4 v0 = acc[ai][bj][m][0], v1 = acc[ai][bj][m][1];
                    u32x4 w; w.x = cvt_pk_bf16(v0[0], v0[1]); w.y = cvt_pk_bf16(v0[2], v0[3]); w.z = cvt_pk_bf16(v1[0], v1[1]); w.w = cvt_pk_bf16(v1[2], v1[3]);
                    *(u32x4*)(rowp + bj * HALF) = w; } }
    }
};
struct EpiBf16Plain {
    static constexpr bool PERM = true, AFTER_DRAIN = false;
    bf16_t* O; int ldc;
    __device__ __forceinline__ void operator()(const f32x4 (&acc)[2][2][4][2], const Unit& u, int wr, int wc, int fr, int fq) const {
        const int row0 = u.pm * BM + wr * 64 + fr; const int col0 = u.pn * BM + wc * 32 + 8 * fq;
#pragma unroll
        for (int ai = 0; ai < 2; ++ai)
#pragma unroll
            for (int m = 0; m < 4; ++m) { bf16_t* rowp = O + (size_t)(row0 + ai * HALF + m * 16) * ldc + col0;
#pragma unroll
                for (int bj = 0; bj < 2; ++bj) { const f32x4 v0 = acc[ai][bj][m][0], v1 = acc[ai][bj][m][1];
                    u32x4 w; w.x = cvt_pk_bf16(v0[0], v0[1]); w.y = cvt_pk_bf16(v0[2], v0[3]); w.z = cvt_pk_bf16(v1[0], v1[1]); w.w = cvt_pk_bf16(v1[2], v1[3]);
                    *(u32x4*)(rowp + bj * HALF) = w; } }
    }
};
struct EpiSwiglu {
    static constexpr bool PERM = true, AFTER_DRAIN = false;
    bf16_t* O;
    __device__ __forceinline__ void operator()(const f32x4 (&acc)[2][2][4][2], const Unit& u, int wr, int wc, int fr, int fq) const {
        const int row0 = u.pm * BM + wr * 64 + fr; const int col0 = u.pn * HALF + wc * 32 + 8 * fq;
#pragma unroll
        for (int ai = 0; ai < 2; ++ai)
#pragma unroll
            for (int m = 0; m < 4; ++m) {
                float o[8];
#pragma unroll
                for (int n = 0; n < 2; ++n)
#pragma unroll
                    for (int i = 0; i < 4; ++i) { const float va = acc[ai][0][m][n][i], vg = acc[ai][1][m][n][i]; o[4 * n + i] = va / (1.f + __expf(-va)) * vg; }
                u32x4 w; w.x = cvt_pk_bf16(o[0], o[1]); w.y = cvt_pk_bf16(o[2], o[3]); w.z = cvt_pk_bf16(o[4], o[5]); w.w = cvt_pk_bf16(o[6], o[7]);
                *(u32x4*)(O + (size_t)(row0 + ai * HALF + m * 16) * DFF + col0) = w; }
    }
};
struct EpiResidual {
    static constexpr bool PERM = false, AFTER_DRAIN = false;
    float* Hh;
    __device__ __forceinline__ void operator()(const f32x4 (&acc)[2][2][4][2], const Unit& u, int wr, int wc, int fr, int fq) const {
        const int row0 = u.pm * BM + wr * 64 + fr; const int col0 = u.pn * BM + wc * 32 + 4 * fq;
#pragma unroll
        for (int ai = 0; ai < 2; ++ai)
#pragma unroll
            for (int m = 0; m < 4; ++m) { float* rowp = Hh + (size_t)(row0 + ai * HALF + m * 16) * DM + col0;
#pragma unroll
                for (int bj = 0; bj < 2; ++bj)
#pragma unroll
                    for (int n = 0; n < 2; ++n) { f32x4* p = (f32x4*)(rowp + bj * HALF + n * 16); *p = *p + acc[ai][bj][m][n]; } }
    }
};
struct EpiGlu {
    static constexpr bool PERM = false, AFTER_DRAIN = false;
    float* Hh;
    __device__ __forceinline__ void operator()(const f32x4 (&acc)[2][2][4][2], const Unit& u, int wr, int wc, int fr, int fq) const {
        const int row0 = u.pm * BM + wr * 64 + fr; const int col0 = u.pn * HALF + wc * 32 + 4 * fq;
#pragma unroll
        for (int ai = 0; ai < 2; ++ai)
#pragma unroll
            for (int m = 0; m < 4; ++m) { float* rowp = Hh + (size_t)(row0 + ai * HALF + m * 16) * DM + col0;
#pragma unroll
                for (int n = 0; n < 2; ++n) { f32x4* p = (f32x4*)(rowp + n * 16); f32x4 hv = *p; const f32x4 va = acc[ai][0][m][n], vg = acc[ai][1][m][n];
#pragma unroll
                    for (int i = 0; i < 4; ++i) hv[i] += va[i] / (1.f + __expf(-vg[i]));
                    *p = hv; } }
    }
};

template <class Epi, class Sched, bool ALIGN_EPI = false, bool SP2 = false>
__device__ __forceinline__ void gemm_phase(PG8_LAS unsigned char* lds, const int K, const Sched& S, const Epi& E) {
    int tid_ = threadIdx.x; asm volatile("" : "+v"(tid_));
    const int tid = tid_, wid = __builtin_amdgcn_readfirstlane(tid >> 6), lane = tid & 63, wr = wid >> 2, wc = wid & 3, fr = lane & 15, fq = lane >> 4;
    const int nt = K / BK;
    unsigned voffA[2], voffB[2];
#pragma unroll
    for (int i = 0; i < 2; ++i) { int R, C; stage_rc(tid * 16 + i * 8192, R, C); const int Rb = Epi::PERM ? ((R & ~31) + perm32(R & 31)) : R;
        voffA[i] = (unsigned)(R * K + C) * 2u; voffB[i] = (unsigned)(Rb * K + C) * 2u; }
    const size_t kstep = (size_t)(BK * 2);
    const size_t hstep = (size_t)HALF * K * 2;
    const unsigned ldsw = (unsigned)wid * 1024u;
    const int aoff = lds_byte(wr * 64 + fr, fq * 8), boff = lds_byte(wc * 32 + fr, fq * 8);
#define PG8_SA(b, h) (((b) * 2 + (h)) * HTB)
#define PG8_SB(b, h) ((4 + (b) * 2 + (h)) * HTB)
#define PG8_STAGE(bufoff, gbase, voff) do { _Pragma("unroll") for (int _i = 0; _i < 2; ++_i) \
        __builtin_amdgcn_global_load_lds((const unsigned*)((const char*)(gbase) + (voff)[_i]), (PG8_LAS unsigned*)(lds + (bufoff) + ldsw + _i * 8192), 16, 0, 0); } while (0)
#define PG8_LDA(dst, b, h) do { _Pragma("unroll") for (int m = 0; m < 4; ++m) _Pragma("unroll") for (int k = 0; k < 2; ++k) dst[m][k] = *(const PG8_LAS bf16x8*)(lds + PG8_SA(b, h) + aoff + m * 2048 + k * 1024); } while (0)
#define PG8_LDB(dst, b, h) do { _Pragma("unroll") for (int n = 0; n < 2; ++n) _Pragma("unroll") for (int k = 0; k < 2; ++k) dst[n][k] = *(const PG8_LAS bf16x8*)(lds + PG8_SB(b, h) + boff + n * 2048 + k * 1024); } while (0)
#define PG8_MMA(ai, bj, At, Bt) do { __builtin_amdgcn_s_setprio(1); _Pragma("unroll") for (int m = 0; m < 4; ++m) _Pragma("unroll") for (int n = 0; n < 2; ++n) _Pragma("unroll") for (int k = 0; k < 2; ++k) \
        acc[ai][bj][m][n] = __builtin_amdgcn_mfma_f32_16x16x32_bf16(Bt[n][k], At[m][k], acc[ai][bj][m][n], 0, 0, 0); __builtin_amdgcn_s_setprio(0); } while (0)
#define PG8_WAIT_V(n) asm volatile("s_waitcnt vmcnt(" #n ")" ::: "memory")
#define PG8_WAIT_L(n) asm volatile("s_waitcnt lgkmcnt(" #n ")" ::: "memory")
#define PG8_BAR __builtin_amdgcn_s_barrier()
#define PG8_SCHED __builtin_amdgcn_sched_barrier(0)
    Unit cur, nxt; int ui = 0;
    if (!S.next(0, cur)) return;
    f32x4 acc[2][2][4][2];
#pragma unroll
    for (int a = 0; a < 2; ++a)
#pragma unroll
        for (int b = 0; b < 2; ++b)
#pragma unroll
            for (int m = 0; m < 4; ++m)
#pragma unroll
                for (int n = 0; n < 2; ++n) acc[a][b][m][n] = (f32x4){0.f, 0.f, 0.f, 0.f};
    bf16x8 At[4][2], B0[2][2], B1[2][2];
    const char* cA = cur.A; const char* cB = cur.B;
    S.a_ready(cur);
    if constexpr (SP2) {
        PG8_STAGE(PG8_SB(0, 0), cB, voffB); PG8_STAGE(PG8_SB(0, 1), cB + hstep, voffB); PG8_STAGE(PG8_SA(0, 0), cA, voffA); PG8_STAGE(PG8_SA(0, 1), cA + hstep, voffA);
        if (wr == 1) PG8_BAR;
        PG8_WAIT_V(2); PG8_BAR;
        PG8_STAGE(PG8_SB(1, 0), cB + kstep, voffB); PG8_STAGE(PG8_SA(1, 0), cA + kstep, voffA); PG8_STAGE(PG8_SB(1, 1), cB + hstep + kstep, voffB);
        PG8_WAIT_V(6); PG8_BAR;
    } else {
        PG8_STAGE(PG8_SB(0, 0), cB, voffB); PG8_STAGE(PG8_SA(0, 0), cA, voffA); PG8_STAGE(PG8_SB(0, 1), cB + hstep, voffB); PG8_STAGE(PG8_SA(0, 1), cA + hstep, voffA);
        if (wr == 1) PG8_BAR;
        PG8_WAIT_V(4); PG8_BAR;
        PG8_STAGE(PG8_SB(1, 0), cB + kstep, voffB); PG8_STAGE(PG8_SA(1, 0), cA + kstep, voffA); PG8_STAGE(PG8_SB(1, 1), cB + hstep + kstep, voffB);
        PG8_WAIT_V(6); PG8_BAR;
    }
    for (;;) {
        const bool has_next = S.next(ui + 1, nxt);
        const char* nA = has_next ? nxt.A : cA; const char* nB = has_next ? nxt.B : cB;
        for (int t = 0; t < nt; t += 2) {
            const bool last = (t == nt - 2);
            const char* a1 = cA + (size_t)(t + 1) * kstep;
            const char* a2 = last ? nA : cA + (size_t)(t + 2) * kstep; const char* b2 = last ? nB : cB + (size_t)(t + 2) * kstep;
            const char* a3 = a2 + kstep; const char* b3 = b2 + kstep;
            if (last && has_next) S.a_ready(nxt);
            if constexpr (SP2) {
            PG8_LDB(B0, 0, 0); PG8_LDB(B1, 0, 1); PG8_SCHED; PG8_LDA(At, 0, 0); PG8_STAGE(PG8_SA(1, 1), a1 + hstep, voffA);
            PG8_WAIT_V(8); PG8_WAIT_L(0); PG8_BAR; PG8_MMA(0, 0, At, B0); PG8_MMA(0, 1, At, B1); PG8_BAR; PG8_SCHED;
            PG8_LDA(At, 0, 1); PG8_STAGE(PG8_SB(0, 0), b2, voffB); PG8_STAGE(PG8_SB(0, 1), b2 + hstep, voffB); PG8_STAGE(PG8_SA(0, 0), a2, voffA);
            PG8_WAIT_V(8); PG8_WAIT_L(0); PG8_BAR; PG8_MMA(1, 0, At, B0); PG8_MMA(1, 1, At, B1); PG8_BAR; PG8_SCHED;
            PG8_LDB(B0, 1, 0); PG8_LDB(B1, 1, 1); PG8_SCHED; PG8_LDA(At, 1, 0); PG8_STAGE(PG8_SA(0, 1), a2 + hstep, voffA);
            PG8_WAIT_V(8); PG8_WAIT_L(0); PG8_BAR; PG8_MMA(0, 0, At, B0); PG8_MMA(0, 1, At, B1); PG8_BAR; PG8_SCHED;
            PG8_LDA(At, 1, 1); PG8_STAGE(PG8_SB(1, 0), b3, voffB); PG8_STAGE(PG8_SB(1, 1), b3 + hstep, voffB); PG8_STAGE(PG8_SA(1, 0), a3, voffA);
            PG8_WAIT_V(8); PG8_WAIT_L(0); PG8_BAR; PG8_MMA(1, 0, At, B0); PG8_MMA(1, 1, At, B1); PG8_BAR; PG8_SCHED;
            } else {
            PG8_LDB(B0, 0, 0); PG8_SCHED; PG8_LDA(At, 0, 0); PG8_STAGE(PG8_SA(1, 1), a1 + hstep, voffA);
            PG8_WAIT_L(8); PG8_BAR; PG8_WAIT_L(0); PG8_MMA(0, 0, At, B0); PG8_BAR; PG8_SCHED;
            PG8_LDB(B1, 0, 1); PG8_STAGE(PG8_SB(0, 0), b2, voffB);
            PG8_BAR; PG8_WAIT_L(0); PG8_MMA(0, 1, At, B1); PG8_BAR;
            PG8_LDA(At, 0, 1); PG8_STAGE(PG8_SA(0, 0), a2, voffA);
            PG8_BAR; PG8_WAIT_L(0); PG8_MMA(1, 0, At, B0); PG8_BAR; PG8_SCHED;
            PG8_STAGE(PG8_SB(0, 1), b2 + hstep, voffB);
            PG8_WAIT_V(6); PG8_BAR; PG8_MMA(1, 1, At, B1); PG8_BAR;
            PG8_LDB(B0, 1, 0); PG8_SCHED; PG8_LDA(At, 1, 0); PG8_STAGE(PG8_SA(0, 1), a2 + hstep, voffA);
            PG8_WAIT_L(8); PG8_BAR; PG8_WAIT_L(0); PG8_MMA(0, 0, At, B0); PG8_BAR; PG8_SCHED;
            PG8_LDB(B1, 1, 1); PG8_STAGE(PG8_SB(1, 0), b3, voffB);
            PG8_BAR; PG8_WAIT_L(0); PG8_MMA(0, 1, At, B1); PG8_BAR;
            PG8_LDA(At, 1, 1); PG8_STAGE(PG8_SA(1, 0), a3, voffA);
            PG8_BAR; PG8_WAIT_L(0); PG8_MMA(1, 0, At, B0); PG8_BAR; PG8_SCHED;
            PG8_STAGE(PG8_SB(1, 1), b3 + hstep, voffB);
            PG8_WAIT_V(6); PG8_BAR; PG8_MMA(1, 1, At, B1); PG8_BAR;
            }
        }
        if constexpr (ALIGN_EPI) { if (wr == 0) PG8_BAR; }
        if constexpr (!Epi::AFTER_DRAIN) { E(acc, cur, wr, wc, fr, fq); S.done(cur); }
        if (!has_next) break;
#pragma unroll
        for (int a = 0; a < 2; ++a)
#pragma unroll
            for (int b = 0; b < 2; ++b)
#pragma unroll
                for (int m = 0; m < 4; ++m)
#pragma unroll
                    for (int n = 0; n < 2; ++n) acc[a][b][m][n] = (f32x4){0.f, 0.f, 0.f, 0.f};
        cur = nxt; cA = nA; cB = nB; ++ui;
        if constexpr (ALIGN_EPI) { if (wr == 1) PG8_BAR; }
    }
    PG8_WAIT_V(0);
    if constexpr (!ALIGN_EPI) { if (wr == 0) PG8_BAR; }
    PG8_BAR;
    if constexpr (Epi::AFTER_DRAIN) { E.fused(acc, cur, wr, wc, fr, fq, lds, wid, lane); S.done(cur); }
#undef PG8_SA
#undef PG8_SB
#undef PG8_STAGE
#undef PG8_LDA
#undef PG8_LDB
#undef PG8_MMA
#undef PG8_WAIT_V
#undef PG8_WAIT_L
#undef PG8_BAR
#undef PG8_SCHED
}
}

#define PHASE_PROLOGUE \
    int tid_ = threadIdx.x; asm volatile("" : "+v"(tid_)); const int tid = tid_, lane = tid & 63, wave = tid >> 6; \
    const int G = GRID, bid = blockIdx.x; \
    const int gw = bid * 8 + wave, NGW = G * 8; \
    unsigned char* ws = P.ws; \
    float* H = (float*)(ws + WS_H); \
    bf16_t* HN = (bf16_t*)(ws + WS_HN); \
    bf16_t* A2 = (bf16_t*)(ws + WS_A2); \
    bf16_t* Qb = (bf16_t*)(ws + WS_Q); bf16_t* Kb = (bf16_t*)(ws + WS_K); bf16_t* Vb = (bf16_t*)(ws + WS_V); \
    bf16_t* REST = (bf16_t*)(ws + WS_REST); \
    bf16_t* YFB = (bf16_t*)(ws + WS_YFB); \
    bf16_t* Rr = (bf16_t*)(ws + WS_R); bf16_t* VV = (bf16_t*)(ws + WS_VV); bf16_t* KK = (bf16_t*)(ws + WS_KK); \
    bf16_t* KKA = (bf16_t*)(ws + WS_KKA); bf16_t* KD = (bf16_t*)(ws + WS_KD); \
    float* Wd = (float*)(ws + WS_W); \
    bf16_t* Gg = (bf16_t*)(ws + WS_G); bf16_t* KR = (bf16_t*)(ws + WS_KR); bf16_t* LOW = (bf16_t*)(ws + WS_LOW); \
    float* BC = (float*)(ws + WS_BC); \
    bf16_t* AA = (bf16_t*)(ws + WS_AA); \
    bf16_t* HB = (bf16_t*)(ws + WS_HB); bf16_t* YB = (bf16_t*)(ws + WS_YB); \
    bf16_t* XB = (bf16_t*)(ws + WS_XB); int* EID = (int*)(ws + WS_EID); int* POS = (int*)(ws + WS_POS); int* DEST = (int*)(ws + WS_DEST); \
    float* GATE = (float*)(ws + WS_GATE); \
    float* YS = (float*)(ws + WS_YS); \
    float* ENDS = (float*)(ws + WS_END); float* CARRY = (float*)(ws + WS_CARRY); \
    unsigned* CTL = (unsigned*)(ws + WS_CTL); \
    bf16_t* WTIN = (bf16_t*)(ws + WS_WTIN); bf16_t* WTOUT = (bf16_t*)(ws + WS_WTOUT); bf16_t* WTGLU = (bf16_t*)(ws + WS_WTGLU); bf16_t* WT13 = (bf16_t*)(ws + WS_WT13); bf16_t* WT2 = (bf16_t*)(ws + WS_WT2); \
    const int vcu = (G % 8 == 0) ? (bid % 8) * (G / 8) + bid / 8 : bid; \
    const float* x = P.in[0]; const float* meta = P.in[1]; const float* norm_mix = P.in[2]; const float* norm_ffn = P.in[3]; const float* norm_final = P.in[4]; \
    const float* w_in = P.in[5]; const float* w_out = P.in[6]; const float* rpb = P.in[7]; const float* mu = P.in[8]; \
    const float* w0 = P.in[9]; const float* w_up = P.in[10]; const float* a0 = P.in[11]; const float* a_up = P.in[12]; const float* g_up = P.in[13]; \
    const float* k_k = P.in[14]; const float* k_a = P.in[15]; const float* r_k = P.in[16]; const float* lnx_g = P.in[17]; const float* lnx_b = P.in[18]; \
    const float* s5_b_re = P.in[19]; const float* s5_b_im = P.in[20]; const float* s5_lre = P.in[21]; const float* s5_lim = P.in[22]; const float* s5_ls = P.in[23]; \
    const float* s5_c_re = P.in[24]; const float* s5_c_im = P.in[25]; const float* s5_d = P.in[26]; const float* w_glu = P.in[27]; \
    const float* moe_wg = P.in[28]; const float* moe_bg = P.in[29]; const float* moe_we = P.in[30]; const float* moe_be = P.in[31]; \
    const float* moe_w1 = P.in[32]; const float* moe_w3 = P.in[33]; const float* moe_w2 = P.in[34];


__device__ __forceinline__ void transpose_item(const float* W, int N, int K, int k0, int n0, bf16_t* dstrow0, int lane) {
    const int nq = lane & 15, kb = lane >> 4;
    const float* src = W + (size_t)(k0 + 16 * kb) * N + n0 + 4 * nq;
    f32x4 v[16];
#pragma unroll
    for (int kk = 0; kk < 16; ++kk) v[kk] = *(const f32x4*)(src + (size_t)kk * N);
#pragma unroll
    for (int i = 0; i < 4; ++i) {
        bf16_t* d = dstrow0 + (size_t)(4 * nq + i) * K + k0 + 16 * kb;
        u32x4 lo, hi;
        lo.x = pk2(v[0][i], v[1][i]); lo.y = pk2(v[2][i], v[3][i]); lo.z = pk2(v[4][i], v[5][i]); lo.w = pk2(v[6][i], v[7][i]);
        hi.x = pk2(v[8][i], v[9][i]); hi.y = pk2(v[10][i], v[11][i]); hi.z = pk2(v[12][i], v[13][i]); hi.w = pk2(v[14][i], v[15][i]);
        *(u32x4*)d = lo; *(u32x4*)(d + 8) = hi;
    }
}
#define CONV_DENSE_ITEMS (832 + 256 + 512)
__device__ __forceinline__ void conv_dense_item(CParams& P, int it, int lane) {
    unsigned char* ws = P.ws;
    if (it < 832) { const int kb = it / 52, nb = it % 52; transpose_item(P.in[5], INCOLS, DM, kb * 64, nb * 64, (bf16_t*)(ws + WS_WTIN) + (size_t)nb * 64 * DM, lane); return; }
    it -= 832;
    if (it < 256) { const int kb = it / 16, nb = it % 16; transpose_item(P.in[6], DM, DM, kb * 64, nb * 64, (bf16_t*)(ws + WS_WTOUT) + (size_t)nb * 64 * DM, lane); return; }
    it -= 256;
    { const int kb = it / 32, nb = it % 32, n = nb * 64, half = n >> 10, c = n & 1023, row = (c >> 7) * 256 + half * 128 + (c & 127);
      transpose_item(P.in[27], 2 * DM, DM, kb * 64, n, (bf16_t*)(ws + WS_WTGLU) + (size_t)row * DM, lane); }
}
#define CONV_MOE_ITEMS (NEXP * 384)
__device__ __forceinline__ void conv_moe_item(CParams& P, int l, int it, int lane) {
    unsigned char* ws = P.ws;
    const int e = it / 384; int r = it % 384;
    if (r < 256) { const int which = r >> 7; r &= 127; const int kb = r >> 3, nb = r & 7, n = nb * 64, row = (n >> 7) * 256 + which * 128 + (n & 127);
        const float* W = (which ? P.in[33] : P.in[32]) + ((size_t)(l * NEXP + e) * DM) * DFF;
        transpose_item(W, DFF, DM, kb * 64, n, (bf16_t*)(ws + WS_WT13) + ((size_t)e * DM + row) * DM, lane); return; }
    r -= 256;
    { const int kb = r >> 4, nb = r & 15; const float* W = P.in[34] + ((size_t)(l * NEXP + e) * DFF) * DM;
      transpose_item(W, DM, DFF, kb * 64, nb * 64, (bf16_t*)(ws + WS_WT2) + ((size_t)e * DM + nb * 64) * DFF, lane); }
}

template <int MODE>
__device__ __forceinline__ void meta_gemm(const bf16_t* A, const bf16_t* Bt, float* Hrows, int task, int lane) {
    const int fr = lane & 15, fq = lane >> 4, c = task * 16 + fr;
    const bf16_t* b0 = MODE == 0 ? Bt + (size_t)c * DM : Bt + (size_t)((c >> 7) * 256 + (c & 127)) * DM;
    const bf16_t* b1 = b0 + (size_t)128 * DM;
    f32x4 acc0[2], acc1[2];
    acc0[0] = acc0[1] = acc1[0] = acc1[1] = (f32x4){0.f, 0.f, 0.f, 0.f};
#pragma unroll 4
    for (int kt = 0; kt < 32; ++kt) {
        const int ko = kt * 32 + fq * 8;
        const bf16x8 a0 = *(const bf16x8*)(A + (size_t)fr * DM + ko), a1 = *(const bf16x8*)(A + (size_t)(16 + fr) * DM + ko);
        const bf16x8 bv = *(const bf16x8*)(b0 + ko);
        acc0[0] = __builtin_amdgcn_mfma_f32_16x16x32_bf16(a0, bv, acc0[0], 0, 0, 0);
        acc0[1] = __builtin_amdgcn_mfma_f32_16x16x32_bf16(a1, bv, acc0[1], 0, 0, 0);
        if (MODE == 1) { const bf16x8 bg = *(const bf16x8*)(b1 + ko);
            acc1[0] = __builtin_amdgcn_mfma_f32_16x16x32_bf16(a0, bg, acc1[0], 0, 0, 0);
            acc1[1] = __builtin_amdgcn_mfma_f32_16x16x32_bf16(a1, bg, acc1[1], 0, 0, 0); }
    }
#pragma unroll
    for (int mi = 0; mi < 2; ++mi)
#pragma unroll
        for (int j = 0; j < 4; ++j) { float* p = Hrows + (size_t)(mi * 16 + fq * 4 + j) * DM + c;
            if (MODE == 0) *p += acc0[mi][j]; else *p += acc0[mi][j] / (1.f + __expf(-acc1[mi][j])); }
}
__device__ __forceinline__ void phase_0(CParams& P, unsigned char* lds, const int ph) {
    PHASE_PROLOGUE
            for (int row = gw; row < NT; row += NGW) {
                const float* src = row < NMAIN ? x + (size_t)row * DM : meta + (size_t)((row - NMAIN) & 15) * DM;
                f32x4 v[4];
#pragma unroll
                for (int j = 0; j < 4; ++j) { v[j] = ((const f32x4*)src)[lane + 64 * j]; ((f32x4*)(H + (size_t)row * DM))[lane + 64 * j] = v[j]; }
                store_norm_bf16(v, norm_mix, HN + (size_t)row * DM, lane);
            }
    for (int it = gw; it < CONV_DENSE_ITEMS; it += NGW) conv_dense_item(P, it, lane);
    for (int it = gw; it < CONV_MOE_ITEMS; it += NGW) conv_moe_item(P, 0, it, lane);
}

__device__ __forceinline__ void phase_1(CParams& P, unsigned char* lds, const int ph) {
    PHASE_PROLOGUE
    pg8::DenseOrder S; S.init(HN, WTIN, NTP, INCOLS, DM, G, bid);
    pg8::EpiProj E{Qb, Kb, Vb, REST};
    pg8::gemm_phase<pg8::EpiProj, pg8::DenseOrder, true, true>((PG8_LAS unsigned char*)lds, DM, S, E);
}

__device__ __forceinline__ void phase_2(CParams& P, unsigned char* lds, const int ph) {
    PHASE_PROLOGUE
            const int ntask = NB * 8 * LSEQ;
            for (int tk = gw; tk < ntask; tk += NGW) {
                const int b = tk / (8 * LSEQ), rem = tk % (8 * LSEQ), h = rem / LSEQ, p = rem % LSEQ;
                const int qrow = rowof(b, p);
                const float qv = bf2f(Qb[(size_t)qrow * 512 + h * 64 + lane]) * 0.125f;
        float* qs = (float*)lds + wave * 64;
        qs[lane] = qv;
        const int nkeys = p < NMETA ? NMETA : 144;
        int r = 0, c = 0, R0 = 0, C0 = 0;
        if (p >= NMETA) { const int t = p - NMETA; r = t >> 6; c = t & 63; R0 = min(max(r - 4, 0), 120); C0 = min(max(c - 8, 0), 48); }
        float sc[3];
#pragma unroll
        for (int rd = 0; rd < 3; ++rd) {
            const int j = lane + 64 * rd;
            int krow = NMAIN + b * NMETA + (j & 15); float bias = 0.f;
            if (j >= 16) { const int jj = j - 16, kr = R0 + (jj >> 4), kc = C0 + (jj & 15); krow = b * SEQ + kr * 64 + kc;
                if (j < nkeys) bias = rpb[(h * 15 + (kr - r + 7)) * 31 + (kc - c + 15)]; }
            if (j >= nkeys) krow = NMAIN + b * NMETA;
            const u32x4* kp = (const u32x4*)(Kb + (size_t)krow * 512 + h * 64);
            float s = 0.f;
#pragma unroll
            for (int ch = 0; ch < 8; ++ch) {
                const u32x4 kv = kp[ch];
                const f32x4 qa = *(const f32x4*)(qs + ch * 8), qb = *(const f32x4*)(qs + ch * 8 + 4);
                s += qa[0] * bflo(kv[0]) + qa[1] * bfhi(kv[0]) + qa[2] * bflo(kv[1]) + qa[3] * bfhi(kv[1])
                   + qb[0] * bflo(kv[2]) + qb[1] * bfhi(kv[2]) + qb[2] * bflo(kv[3]) + qb[3] * bfhi(kv[3]);
            }
            sc[rd] = (j < nkeys) ? s + bias : -1e30f;
                }
                const float m = wave_max(fmaxf(sc[0], fmaxf(sc[1], sc[2])));
                float e0 = __expf(sc[0] - m), e1 = __expf(sc[1] - m), e2 = __expf(sc[2] - m);
                if (lane >= nkeys) e0 = 0.f;
                if (lane + 64 >= nkeys) e1 = 0.f;
                if (lane + 128 >= nkeys) e2 = 0.f;
                const float inv = 1.f / wave_sum(e0 + e1 + e2);
                float o = 0.f;
                for (int j = 0; j < nkeys; ++j) {
                    int krow = NMAIN + b * NMETA + (j & 15);
                    if (j >= 16) { const int jj = j - 16; krow = b * SEQ + (R0 + (jj >> 4)) * 64 + C0 + (jj & 15); }
                    const float src = j < 64 ? e0 : (j < 128 ? e1 : e2);
                    const float pj = __int_as_float(__builtin_amdgcn_readlane(__float_as_int(src), j & 63));
                    o += pj * bf2f(Vb[(size_t)krow * 512 + h * 64 + lane]);
                }
                A2[(size_t)qrow * DM + h * 64 + lane] = (bf16_t)f2bf(o * inv);
            }
}


__device__ __forceinline__ void phase_3(CParams& P, unsigned char* lds, const int ph) {
    PHASE_PROLOGUE
            for (int tk = gw; tk < NT; tk += NGW) {
                const int b = tk / LSEQ, p = tk % LSEQ, row = rowof(b, p);
                const bool hp = p > 0, hn = p + 1 < LSEQ;
                const int rowp = hp ? rowof(b, p - 1) : row, rown = hn ? rowof(b, p + 1) : row;
#pragma unroll
                for (int j = 0; j < 7; ++j) {
                    const int c = 4 * lane + 256 * j;
                    const u32x2 vc = *(const u32x2*)(REST + (size_t)row * RESTC + c);
                    u32x2 vp = *(const u32x2*)(REST + (size_t)rowp * RESTC + c);
                    u32x2 vn = *(const u32x2*)(REST + (size_t)rown * RESTC + c);
                    if (!hp) { vp.x = 0; vp.y = 0; }
                    if (!hn) { vn.x = 0; vn.y = 0; }
                    const f32x4 m4 = *(const f32x4*)(mu + c);
                    float pc[4] = {bflo(vc.x), bfhi(vc.x), bflo(vc.y), bfhi(vc.y)};
                    float pp[4] = {bflo(vp.x), bfhi(vp.x), bflo(vp.y), bfhi(vp.y)};
                    float pn[4] = {bflo(vn.x), bfhi(vn.x), bflo(vn.y), bfhi(vn.y)};
                    float o[4];
#pragma unroll
                    for (int i = 0; i < 4; ++i) o[i] = pc[i] + m4[i] * (0.5f * (pp[i] + pn[i]) - pc[i]);
                    if (j == 6) {
                        if (lane < 16) { for (int i = 0; i < 4; ++i) o[i] = tanhf(o[i]); }
                        else if (lane >= 32) { for (int i = 0; i < 4; ++i) o[i] = sigmoidf_(o[i]); }
                    }
                    u32x2 ov; ov.x = pk2(o[0], o[1]); ov.y = pk2(o[2], o[3]);
                    bf16_t* dst = j < 2 ? Rr + (size_t)row * 512 + c : (j < 4 ? KR + (size_t)row * 512 + (c - 512) : (j < 6 ? VV + (size_t)row * 512 + (c - 1024) : LOW + (size_t)row * 256 + (c - 1536)));
                    *(u32x2*)dst = ov;
                }
            }
}


__device__ __forceinline__ void phase_4(CParams& P, unsigned char* lds, const int ph) {
    PHASE_PROLOGUE
            const int nrt = (NT + 127) / 128;
            const int nunits = nrt * 4 * 5;
            for (int u = bid; u < nunits; u += G) {
                const int which = u / (nrt * 4), rem = u % (nrt * 4), rt = rem / 4, ct = rem % 4;
                f32x4 acc[4][2];
                const int koff = which < 2 ? 0 : (which < 4 ? 64 : 128), KK_ = which < 4 ? 64 : 128;
                const float* Bsrc = which < 2 ? w_up + (size_t)which * 64 * 512 : (which < 4 ? a_up + (size_t)(which - 2) * 64 * 512 : g_up);
                gemm_tile(lds, KK_, 512,
                          [&](int r) { int row = rt * 128 + r; if (row >= NT) row = NT - 1; return LOW + (size_t)row * 256 + koff; },
                          [&](int n) { return Bsrc + ct * 128 + n; }, acc);
                ACC_FOREACH(acc, { const int row = rt * 128 + rl, col = ct * 128 + cl; if (row < NT) {
                    if (which < 2) { const float wl = w0[which * 512 + col] + val; Wd[((size_t)which * NT + row) * 512 + col] = __expf(-0.6065306597f * sigmoidf_(wl)); }
                    else if (which < 4) { const int d = which - 2; AA[((size_t)d * NT + row) * 512 + col] = (bf16_t)f2bf(sigmoidf_(a0[d * 512 + col] + val)); }
                    else Gg[(size_t)row * 512 + col] = (bf16_t)f2bf(val); } });
            }
}


__device__ __forceinline__ void phase_5(CParams& P, unsigned char* lds, const int ph) {
    PHASE_PROLOGUE
            for (int row = gw; row < NT; row += NGW) {
                const int c0 = lane * 8;
                const u32x4 krv = *(const u32x4*)(KR + (size_t)row * 512 + c0);
                const u32x4 rv = *(const u32x4*)(Rr + (size_t)row * 512 + c0);
                float kr[8], rr[8], kkv[8];
#pragma unroll
                for (int i = 0; i < 4; ++i) { kr[2 * i] = bflo(krv[i]); kr[2 * i + 1] = bfhi(krv[i]); rr[2 * i] = bflo(rv[i]); rr[2 * i + 1] = bfhi(rv[i]); }
                float ss = 0.f;
#pragma unroll
                for (int i = 0; i < 8; ++i) { kkv[i] = kr[i] * k_k[c0 + i]; ss += kkv[i] * kkv[i]; }
                ss += __shfl_xor(ss, 1); ss += __shfl_xor(ss, 2); ss += __shfl_xor(ss, 4);
                const float inv = 1.f / fmaxf(sqrtf(ss), 1e-12f);
#pragma unroll
                for (int i = 0; i < 8; ++i) kkv[i] *= inv;
                u32x4 o; o.x = pk2(kkv[0], kkv[1]); o.y = pk2(kkv[2], kkv[3]); o.z = pk2(kkv[4], kkv[5]); o.w = pk2(kkv[6], kkv[7]);
                *(u32x4*)(KK + (size_t)row * 512 + c0) = o;
                float bsum = 0.f;
#pragma unroll
                for (int d = 0; d < 2; ++d) {
                    const u32x4 av = *(const u32x4*)(AA + ((size_t)d * NT + row) * 512 + c0);
                    float a[8], kka[8], kd[8];
#pragma unroll
                    for (int i = 0; i < 4; ++i) { a[2 * i] = bflo(av[i]); a[2 * i + 1] = bfhi(av[i]); }
#pragma unroll
                    for (int i = 0; i < 8; ++i) { kka[i] = kkv[i] * a[i]; kd[i] = kr[i] * (1.f + (a[i] - 1.f) * k_a[c0 + i]); bsum += rr[i] * kd[i] * r_k[c0 + i]; }
                    u32x4 o1; o1.x = pk2(kka[0], kka[1]); o1.y = pk2(kka[2], kka[3]); o1.z = pk2(kka[4], kka[5]); o1.w = pk2(kka[6], kka[7]);
                    *(u32x4*)(KKA + ((size_t)d * NT + row) * 512 + c0) = o1;
                    u32x4 o2; o2.x = pk2(kd[0], kd[1]); o2.y = pk2(kd[2], kd[3]); o2.z = pk2(kd[4], kd[5]); o2.w = pk2(kd[6], kd[7]);
                    *(u32x4*)(KD + ((size_t)d * NT + row) * 512 + c0) = o2;
                }
                bsum += __shfl_xor(bsum, 1); bsum += __shfl_xor(bsum, 2); bsum += __shfl_xor(bsum, 4);
                if ((lane & 7) == 0) BC[(size_t)row * 8 + (lane >> 3)] = bsum;
            }
}


__device__ __forceinline__ void phase_6(CParams& P, unsigned char* lds, const int ph) {
    PHASE_PROLOGUE
            for (int cw = bid * 2 + wave; wave < 2 && cw < 512; cw += G * 2) {
                const int chain = cw >> 4, rg = cw & 15, d = chain >> 4, b = (chain >> 3) & 1, h = chain & 7;
                const int rr_ = lane >> 4, kq = lane & 15, vi = rg * 4 + rr_;
                float s0 = 0.f, s1 = 0.f, s2 = 0.f, s3 = 0.f;
                const float* Wp = Wd + (size_t)d * NT * 512;
                const bf16_t* KKAp = KKA + (size_t)d * NT * 512;
                const bf16_t* KDp = KD + (size_t)d * NT * 512;
                bf16_t* Yp = YFB + (size_t)d * NT * 512;
                for (int s = 0; s < LSEQ; ++s) {
                    const int p = d ? LSEQ - 1 - s : s;
                    const int row = rowof(b, p);
                    const size_t base = (size_t)row * 512 + h * 64;
                    const f32x4 w4 = *(const f32x4*)(Wp + base + 4 * kq);
                    const u32x2 kk2 = *(const u32x2*)(KK + base + 4 * kq);
                    const u32x2 ka2 = *(const u32x2*)(KKAp + base + 4 * kq);
                    const u32x2 kd2 = *(const u32x2*)(KDp + base + 4 * kq);
                    const u32x2 r2 = *(const u32x2*)(Rr + base + 4 * kq);
                    const float vv = bf2f(VV[base + vi]);
                    float dot = s0 * bflo(kk2.x) + s1 * bfhi(kk2.x) + s2 * bflo(kk2.y) + s3 * bfhi(kk2.y);
                    dot += __shfl_xor(dot, 1); dot += __shfl_xor(dot, 2); dot += __shfl_xor(dot, 4); dot += __shfl_xor(dot, 8);
                    const float sa = -dot;
                    s0 = s0 * w4[0] + sa * bflo(ka2.x) + vv * bflo(kd2.x);
                    s1 = s1 * w4[1] + sa * bfhi(ka2.x) + vv * bfhi(kd2.x);
                    s2 = s2 * w4[2] + sa * bflo(ka2.y) + vv * bflo(kd2.y);
                    s3 = s3 * w4[3] + sa * bfhi(ka2.y) + vv * bfhi(kd2.y);
                    float y = s0 * bflo(r2.x) + s1 * bfhi(r2.x) + s2 * bflo(r2.y) + s3 * bfhi(r2.y);
                    y += __shfl_xor(y, 1); y += __shfl_xor(y, 2); y += __shfl_xor(y, 4); y += __shfl_xor(y, 8);
                    if (kq == 0) Yp[base + vi] = (bf16_t)f2bf(y);
                }
            }
}


__device__ __forceinline__ void phase_7(CParams& P, unsigned char* lds, const int ph) {
    PHASE_PROLOGUE
            for (int row = gw; row < NT; row += NGW) {
                const int c0 = lane * 8;
                const u32x4 yf = *(const u32x4*)(YFB + (size_t)row * 512 + c0);
                const u32x4 yb = *(const u32x4*)(YFB + ((size_t)NT + row) * 512 + c0);
                const u32x4 vv = *(const u32x4*)(VV + (size_t)row * 512 + c0);
                const u32x4 gg = *(const u32x4*)(Gg + (size_t)row * 512 + c0);
                float y[8], v[8], g[8];
#pragma unroll
                for (int i = 0; i < 4; ++i) { y[2 * i] = bflo(yf[i]) + bflo(yb[i]); y[2 * i + 1] = bfhi(yf[i]) + bfhi(yb[i]); v[2 * i] = bflo(vv[i]); v[2 * i + 1] = bfhi(vv[i]); g[2 * i] = bflo(gg[i]); g[2 * i + 1] = bfhi(gg[i]); }
                float sm = 0.f;
#pragma unroll
                for (int i = 0; i < 8; ++i) sm += y[i];
                sm += __shfl_xor(sm, 1); sm += __shfl_xor(sm, 2); sm += __shfl_xor(sm, 4);
                const float mean = sm * (1.f / 64.f);
                float vr = 0.f;
#pragma unroll
                for (int i = 0; i < 8; ++i) { const float dlt = y[i] - mean; vr += dlt * dlt; }
                vr += __shfl_xor(vr, 1); vr += __shfl_xor(vr, 2); vr += __shfl_xor(vr, 4);
                const float rstd = rsqrtf(vr * (1.f / 64.f) + 64e-5f);
                const float bc = BC[(size_t)row * 8 + (lane >> 3)];
                float o[8];
#pragma unroll
                for (int i = 0; i < 8; ++i) o[i] = ((y[i] - mean) * rstd * lnx_g[c0 + i] + lnx_b[c0 + i] + bc * v[i]) * g[i];
                u32x4 ov; ov.x = pk2(o[0], o[1]); ov.y = pk2(o[2], o[3]); ov.z = pk2(o[4], o[5]); ov.w = pk2(o[6], o[7]);
                *(u32x4*)(A2 + (size_t)row * DM + 512 + c0) = ov;
            }
}


__device__ __forceinline__ void phase_8(CParams& P, unsigned char* lds, const int ph) {
    PHASE_PROLOGUE
    if (gw < 64) meta_gemm<0>(A2 + (size_t)NMAIN * DM, WTOUT, H + (size_t)NMAIN * DM, gw, lane);
    pg8::DenseOrder S; S.init(A2, WTOUT, NMAIN, DM, DM, G, bid);
    pg8::EpiResidual E{H};
    pg8::gemm_phase<pg8::EpiResidual, pg8::DenseOrder, true, true>((PG8_LAS unsigned char*)lds, DM, S, E);
}

__device__ __forceinline__ void phase_9(CParams& P, unsigned char* lds, const int ph) {
    PHASE_PROLOGUE
            const int l = ph == 9 ? 0 : 1;
                    unsigned* cnt = CTL + CW_CNT(l);
            const float* wg = moe_wg + (size_t)l * DM * 4; const float* bg = moe_bg + l * 4;
            for (int row = gw; row < NT; row += NGW) {
                f32x4 v[4]; float ss = 0.f;
#pragma unroll
                for (int j = 0; j < 4; ++j) { v[j] = ((const f32x4*)(H + (size_t)row * DM))[lane + 64 * j]; ss += v[j][0] * v[j][0] + v[j][1] * v[j][1] + v[j][2] * v[j][2] + v[j][3] * v[j][3]; }
                ss = wave_sum(ss);
                const float rstd = rsqrtf(ss * (1.f / DM) + 1e-6f);
                float lg[4] = {0.f, 0.f, 0.f, 0.f};
#pragma unroll
                for (int j = 0; j < 4; ++j) {
                    const f32x4 g = ((const f32x4*)(norm_ffn + l * DM))[lane + 64 * j];
#pragma unroll
                    for (int i = 0; i < 4; ++i) v[j][i] = v[j][i] * rstd * g[i];
                    u32x2 o; o.x = pk2(v[j][0], v[j][1]); o.y = pk2(v[j][2], v[j][3]);
                    ((u32x2*)(HN + (size_t)row * DM))[lane + 64 * j] = o;
#pragma unroll
                    for (int i = 0; i < 4; ++i) { const f32x4 w = *(const f32x4*)(wg + (size_t)(4 * (lane + 64 * j) + i) * 4);
                        lg[0] += v[j][i] * w[0]; lg[1] += v[j][i] * w[1]; lg[2] += v[j][i] * w[2]; lg[3] += v[j][i] * w[3]; }
                }
#pragma unroll
                for (int q = 0; q < 4; ++q) lg[q] = wave_sum(lg[q]) + bg[q];
                int grp = 0; float mx = lg[0];
#pragma unroll
                for (int q = 1; q < 4; ++q) if (lg[q] > mx) { mx = lg[q]; grp = q; }
                float den = 0.f;
#pragma unroll
                for (int q = 0; q < 4; ++q) den += __expf(lg[q] - mx);
                const float pgrp = 1.f / den;
                const float* we = moe_we + ((size_t)(l * 4 + grp) * DM) * 8;
                float le[8] = {0.f, 0.f, 0.f, 0.f, 0.f, 0.f, 0.f, 0.f};
#pragma unroll
                for (int j = 0; j < 4; ++j)
#pragma unroll
                    for (int i = 0; i < 4; ++i) { const float* wr_ = we + (size_t)(4 * (lane + 64 * j) + i) * 8; const f32x4 wa = *(const f32x4*)wr_, wb = *(const f32x4*)(wr_ + 4);
                        le[0] += v[j][i] * wa[0]; le[1] += v[j][i] * wa[1]; le[2] += v[j][i] * wa[2]; le[3] += v[j][i] * wa[3];
                        le[4] += v[j][i] * wb[0]; le[5] += v[j][i] * wb[1]; le[6] += v[j][i] * wb[2]; le[7] += v[j][i] * wb[3]; }
#pragma unroll
                for (int q = 0; q < 8; ++q) le[q] = wave_sum(le[q]) + moe_be[(l * 4 + grp) * 8 + q];
                int i1 = 0; float m1 = le[0];
#pragma unroll
                for (int q = 1; q < 8; ++q) if (le[q] > m1) { m1 = le[q]; i1 = q; }
                int i2 = -1; float m2 = -3.0e38f;
#pragma unroll
                for (int q = 0; q < 8; ++q) if (q != i1 && le[q] > m2) { m2 = le[q]; i2 = q; }
                const float e2 = __expf(m2 - m1);
                const float g1 = pgrp / (1.f + e2), g2 = pgrp * e2 / (1.f + e2);
                if (lane == 0) {
                    const int ea = grp * 8 + i1, eb = grp * 8 + i2;
                    const unsigned pa = atomicAdd(cnt + ea, 1u), pb = atomicAdd(cnt + eb, 1u);
                    EID[row * 2] = ea; EID[row * 2 + 1] = eb; POS[row * 2] = (int)pa; POS[row * 2 + 1] = (int)pb;
                    GATE[row * 2] = g1; GATE[row * 2 + 1] = g2;
                }
            }
}


__device__ __forceinline__ void phase_10(CParams& P, unsigned char* lds, const int ph) {
    PHASE_PROLOGUE
    const int l = ph == 10 ? 0 : 1;
    int* ps = (int*)(lds + LDS_TAB);
    if (tid == 0) { int acc_ = 0; for (int e = 0; e < NEXP; ++e) { ps[e] = acc_; const int c = (int)CTL[CW_CNT(l) + e]; acc_ += (c + MOE_RT - 1) / MOE_RT * MOE_RT; } ps[NEXP] = acc_; }
    __syncthreads();
    for (int row = gw; row < NT; row += NGW) {
        const u32x4 v0 = ((const u32x4*)(HN + (size_t)row * DM))[lane], v1 = ((const u32x4*)(HN + (size_t)row * DM))[lane + 64];
#pragma unroll
        for (int k = 0; k < 2; ++k) {
            const int dest = ps[EID[row * 2 + k]] + POS[row * 2 + k];
            if (lane == 0) DEST[row * 2 + k] = dest;
            ((u32x4*)(XB + (size_t)dest * DM))[lane] = v0; ((u32x4*)(XB + (size_t)dest * DM))[lane + 64] = v1;
        }
    }
    __syncthreads();
}

__device__ __forceinline__ void phase_11(CParams& P, unsigned char* lds, const int ph) {
    PHASE_PROLOGUE
    const int l = ph == 11 ? 0 : 1;
    int* et = (int*)(lds + LDS_TAB);
    if (tid == 0) { int acc_ = 0; for (int e = 0; e < NEXP; ++e) { const int c = (int)CTL[CW_CNT(l) + e], n = (c + MOE_RT - 1) / MOE_RT; for (int q = 0; q < n; ++q) et[1 + acc_ + q] = e; acc_ += n; } et[0] = acc_; }
    __syncthreads();
    pg8::MoeOrder S{et + 1, et[0], vcu, (const char*)XB, (const char*)WT13, 256u * DM * 2u, 256u * DM * 2u, (unsigned)DM * DM * 2u};
    pg8::EpiSwiglu E{HB};
    pg8::gemm_phase<pg8::EpiSwiglu, pg8::MoeOrder, true, true>((PG8_LAS unsigned char*)lds, DM, S, E);
    __syncthreads();
}

__device__ __forceinline__ void phase_12(CParams& P, unsigned char* lds, const int ph) {
    PHASE_PROLOGUE
    const int l = ph == 12 ? 0 : 1;
    int* et = (int*)(lds + LDS_TAB);
    if (tid == 0) { int acc_ = 0; for (int e = 0; e < NEXP; ++e) { const int c = (int)CTL[CW_CNT(l) + e], n = (c + MOE_RT - 1) / MOE_RT; for (int q = 0; q < n; ++q) et[1 + acc_ + q] = e; acc_ += n; } et[0] = acc_; }
    __syncthreads();
    pg8::MoeOrder S{et + 1, et[0], vcu, (const char*)HB, (const char*)WT2, 256u * DFF * 2u, 256u * DFF * 2u, (unsigned)DM * DFF * 2u};
    pg8::EpiBf16Plain E{YB, DM};
    pg8::gemm_phase<pg8::EpiBf16Plain, pg8::MoeOrder, true, true>((PG8_LAS unsigned char*)lds, DFF, S, E);
    __syncthreads();
}

__device__ __forceinline__ void phase_13(CParams& P, unsigned char* lds, const int ph) {
    PHASE_PROLOGUE
            const bool fin = ph == 21;
            for (int row = gw; row < NT; row += NGW) {
                const int d0 = DEST[row * 2], d1 = DEST[row * 2 + 1];
                const float g0 = GATE[row * 2], g1 = GATE[row * 2 + 1];
                f32x4 v[4];
#pragma unroll
                for (int j = 0; j < 4; ++j) {
                    v[j] = ((const f32x4*)(H + (size_t)row * DM))[lane + 64 * j];
                    const u32x2 ya = ((const u32x2*)(YB + (size_t)d0 * DM))[lane + 64 * j];
                    const u32x2 yb = ((const u32x2*)(YB + (size_t)d1 * DM))[lane + 64 * j];
                    v[j][0] += g0 * bflo(ya.x) + g1 * bflo(yb.x); v[j][1] += g0 * bfhi(ya.x) + g1 * bfhi(yb.x);
                    v[j][2] += g0 * bflo(ya.y) + g1 * bflo(yb.y); v[j][3] += g0 * bfhi(ya.y) + g1 * bfhi(yb.y);
                }
                if (!fin) {
#pragma unroll
                    for (int j = 0; j < 4; ++j) ((f32x4*)(H + (size_t)row * DM))[lane + 64 * j] = v[j];
                    store_norm_bf16(v, norm_mix + DM, HN + (size_t)row * DM, lane);
                } else if (row < NMAIN) {
                    float ss = 0.f;
#pragma unroll
                    for (int j = 0; j < 4; ++j) ss += v[j][0] * v[j][0] + v[j][1] * v[j][1] + v[j][2] * v[j][2] + v[j][3] * v[j][3];
                    ss = wave_sum(ss);
                    const float rstd = rsqrtf(ss * (1.f / DM) + 1e-6f);
#pragma unroll
                    for (int j = 0; j < 4; ++j) { const f32x4 g = ((const f32x4*)norm_final)[lane + 64 * j]; f32x4 o;
                        o[0] = v[j][0] * rstd * g[0]; o[1] = v[j][1] * rstd * g[1]; o[2] = v[j][2] * rstd * g[2]; o[3] = v[j][3] * rstd * g[3];
                        ((f32x4*)(P.out + (size_t)row * DM))[lane + 64 * j] = o; }
                }
            }
    if (!fin) { for (int it = gw; it < CONV_MOE_ITEMS; it += NGW) conv_moe_item(P, 1, it, lane); }
}

__device__ __forceinline__ void phase_14(CParams& P, unsigned char* lds, const int ph) {
    PHASE_PROLOGUE
            const bool outp = ph == 16;
            const int nunits = 2 * NB * 64 * S5NC;
            for (int u = gw; u < nunits; u += NGW) {
                const int c = u % S5NC, dbg = u / S5NC, g = dbg & 63, b = (dbg >> 6) & 1, d = dbg >> 7;
                const int p = lane;
                const float step = __expf(s5_ls[d * 64 + g]);
                const float lr = s5_lre[(d * 64 + g) * 64 + p], li = s5_lim[(d * 64 + g) * 64 + p];
                const float mag = expf(lr * step);
                const float abr = mag * cosf(li * step), abi = mag * sinf(li * step);
                const float den = lr * lr + li * li;
                const float zr = ((abr - 1.f) * lr + abi * li) / den, zi = (abi * lr - (abr - 1.f) * li) / den;
                float bbr[16], bbi[16];
#pragma unroll
                for (int q = 0; q < 4; ++q) {
                    const f32x4 br = *(const f32x4*)(s5_b_re + ((size_t)(g * 64 + p)) * 16 + 4 * q), bi = *(const f32x4*)(s5_b_im + ((size_t)(g * 64 + p)) * 16 + 4 * q);
#pragma unroll
                    for (int i = 0; i < 4; ++i) { bbr[4 * q + i] = zr * br[i] - zi * bi[i]; bbi[4 * q + i] = zr * bi[i] + zi * br[i]; }
                }
                float sr = 0.f, si = 0.f;
                if (outp) { const float* cp = CARRY + (((size_t)dbg * S5NC + c) * 64 + p) * 2; sr = cp[0]; si = cp[1]; }
                float cre[16], cim[16];
                if (outp) {
#pragma unroll
                    for (int i = 0; i < 16; ++i) { cre[i] = s5_c_re[((size_t)(d * 64 + g) * 16 + i) * 64 + p]; cim[i] = s5_c_im[((size_t)(d * 64 + g) * 16 + i) * 64 + p]; }
                }
                for (int tt = 0; tt < S5TC; ++tt) {
                    const int sidx = c * S5TC + tt, pos = d ? LSEQ - 1 - sidx : sidx, row = rowof(b, pos);
                    const u32x4 ua = *(const u32x4*)(HN + (size_t)row * DM + g * 16), ub = *(const u32x4*)(HN + (size_t)row * DM + g * 16 + 8);
                    float uu[16];
#pragma unroll
                    for (int i = 0; i < 4; ++i) { uu[2 * i] = bflo(ua[i]); uu[2 * i + 1] = bfhi(ua[i]); uu[8 + 2 * i] = bflo(ub[i]); uu[8 + 2 * i + 1] = bfhi(ub[i]); }
                    float bur = 0.f, bui = 0.f;
#pragma unroll
                    for (int i = 0; i < 16; ++i) { bur += bbr[i] * uu[i]; bui += bbi[i] * uu[i]; }
                    const float nr = abr * sr - abi * si + bur, ni = abr * si + abi * sr + bui;
                    sr = nr; si = ni;
                    if (outp) {
                        float mine = 0.f;
#pragma unroll
                        for (int i = 0; i < 16; ++i) { const float yv = wave_sum(cre[i] * sr - cim[i] * si); if (lane == i) mine = yv; }
                        if (lane < 16) YS[((size_t)d * NT + row) * DM + g * 16 + lane] = mine;
                    }
                }
                if (!outp) { float* ep = ENDS + (((size_t)dbg * S5NC + c) * 64 + p) * 2; ep[0] = sr; ep[1] = si; }
            }
}


__device__ __forceinline__ void phase_15(CParams& P, unsigned char* lds, const int ph) {
    PHASE_PROLOGUE
            for (int i = bid * 512 + tid; i < 2 * NB * 64 * 64; i += G * 512) {
                const int p = i & 63, dbg = i >> 6, g = dbg & 63, d = dbg >> 7;
                const float step = __expf(s5_ls[d * 64 + g]);
                const float lr = s5_lre[(d * 64 + g) * 64 + p], li = s5_lim[(d * 64 + g) * 64 + p];
                const float mag = expf(lr * step * (float)S5TC);
                const float ang = li * step;
                float pr = 1.f, pi = 0.f; const float cr = cosf(ang), ci = sinf(ang);
                for (int q = 0; q < S5TC; ++q) { const float t = pr * cr - pi * ci; pi = pr * ci + pi * cr; pr = t; }
                const float ar = mag * pr, ai = mag * pi;
                float yr = 0.f, yi = 0.f;
                for (int c = 0; c < S5NC; ++c) {
                    const size_t o = (((size_t)dbg * S5NC + c) * 64 + p) * 2;
                    CARRY[o] = yr; CARRY[o + 1] = yi;
                    const float er = ENDS[o], ei = ENDS[o + 1];
                    const float t = ar * yr - ai * yi + er; yi = ar * yi + ai * yr + ei; yr = t;
                }
            }
}


__device__ __forceinline__ void phase_22(CParams& P, unsigned char* lds, const int ph) {
    PHASE_PROLOGUE
            for (size_t i = (size_t)bid * 512 + tid; i < (size_t)NT * DM / 4; i += (size_t)G * 512) {
                const f32x4 y0 = ((const f32x4*)YS)[i], y1 = ((const f32x4*)(YS + (size_t)NT * DM))[i];
                const int col = (int)((i * 4) & (DM - 1));
                const f32x4 dd = *(const f32x4*)(s5_d + col);
                const u32x2 uu = ((const u32x2*)HN)[i];
                float u4[4] = {bflo(uu.x), bfhi(uu.x), bflo(uu.y), bfhi(uu.y)};
                float o[4];
#pragma unroll
                for (int q = 0; q < 4; ++q) { const float yv = y0[q] + y1[q] + dd[q] * u4[q];
                    o[q] = 0.5f * yv * (1.f + tanhf(0.7978845608f * (yv + 0.044715f * yv * yv * yv))); }
                u32x2 ov; ov.x = pk2(o[0], o[1]); ov.y = pk2(o[2], o[3]);
                ((u32x2*)A2)[i] = ov;
            }
}


__device__ __forceinline__ void phase_23(CParams& P, unsigned char* lds, const int ph) {
    PHASE_PROLOGUE
    if (gw < 64) meta_gemm<1>(A2 + (size_t)NMAIN * DM, WTGLU, H + (size_t)NMAIN * DM, gw, lane);
    pg8::DenseOrder S; S.init(A2, WTGLU, NMAIN, 2 * DM, DM, G, bid);
    pg8::EpiGlu E{H};
    pg8::gemm_phase<pg8::EpiGlu, pg8::DenseOrder, true, true>((PG8_LAS unsigned char*)lds, DM, S, E);
}
#define LAS __attribute__((address_space(3)))
#define CW_BAR 4096
#define XB_TMO      128
#define XB_XCNT(j)  (256  + 64 * (j))
#define XB_XSUB(j)  (1280 + 64 * (j))
#define XB_XGEN(j)  (2304 + 64 * (j))
#define XB_TOP      3328
#define XB_TOPGEN   3392
#define XCD_BAR_WORDS 3456
#define XB_SPIN_CAP (1u << 22)
__device__ __forceinline__ unsigned xb_ld(unsigned* p)              { return __hip_atomic_load(p, __ATOMIC_RELAXED, __HIP_MEMORY_SCOPE_AGENT); }
__device__ __forceinline__ unsigned xb_add(unsigned* p, unsigned v) { return __hip_atomic_fetch_add(p, v, __ATOMIC_RELAXED, __HIP_MEMORY_SCOPE_AGENT); }
__device__ __forceinline__ unsigned xb_xcc_id() { return (unsigned)__builtin_amdgcn_s_getreg((3 << 11) | 20) & 0xFu; }
#define XB_SPIN(cond, bar) do { unsigned _sp = 0; while (cond) { __builtin_amdgcn_s_sleep(1); \
    if ((++_sp & 255u) == 0u) { if (xb_ld(&(bar)[XB_TMO])) break; if (_sp > XB_SPIN_CAP) { atomicAdd(&(bar)[XB_TMO], 1u); break; } } } } while (0)
struct XcdBarrier { unsigned* bar; unsigned x; volatile LAS unsigned* st; };
__device__ __forceinline__ XcdBarrier xcd_barrier_post(unsigned* bar, volatile LAS unsigned* st) {
    XcdBarrier b; b.bar = bar; b.x = xb_xcc_id(); b.st = st;
    if (threadIdx.x == 0) (void)xb_add(&bar[XB_XCNT(b.x)], 1u);
    return b;
}
__device__ __forceinline__ void xcd_barrier_complete(unsigned* bar, unsigned x, unsigned& nloc, unsigned& nx) {
    const unsigned G = GRID;
    unsigned sum, cnt, mine, sp = 0u;
    for (;;) {
        sum = 0u; cnt = 0u; mine = 0u;
#pragma unroll
        for (unsigned j = 0; j < 16; ++j) { const unsigned c = xb_ld(&bar[XB_XCNT(j)]); sum += c; cnt += (c > 0u) ? 1u : 0u; mine = (j == x) ? c : mine; }
        if (sum == G) break;
        __builtin_amdgcn_s_sleep(1);
        if ((++sp & 255u) == 0u) { if (xb_ld(&bar[XB_TMO])) break; if (sp > XB_SPIN_CAP) { atomicAdd(&bar[XB_TMO], 1u); break; } }
    }
    nloc = mine > 0u ? mine : 1u; nx = cnt > 0u ? cnt : 1u;
}
__device__ __forceinline__ void xcd_barrier(const XcdBarrier& b) {
    asm volatile("s_waitcnt vmcnt(0)" ::: "memory");
    __syncthreads();
    if (threadIdx.x == 0) {
        unsigned* bar = b.bar;
        __builtin_amdgcn_s_waitcnt(0);
        unsigned nloc = b.st[0], nx = b.st[1];
        if (nloc == 0u) { xcd_barrier_complete(bar, b.x, nloc, nx); b.st[0] = nloc; b.st[1] = nx; }
        const unsigned old = xb_add(&bar[XB_XSUB(b.x)], 1u);
        const unsigned gen = old / nloc;
        if (old + 1u == (gen + 1u) * nloc) {
            __builtin_amdgcn_fence(__ATOMIC_RELEASE, "agent");
            asm volatile("s_waitcnt vmcnt(0)" ::: "memory");
            const unsigned og = xb_add(&bar[XB_TOP], 1u);
            const unsigned tg = og / nx;
            if (og + 1u == (tg + 1u) * nx) xb_add(&bar[XB_TOPGEN], 1u);
            else XB_SPIN(xb_ld(&bar[XB_TOPGEN]) == tg, bar);
            __builtin_amdgcn_fence(__ATOMIC_ACQUIRE, "agent");
            xb_add(&bar[XB_XGEN(b.x)], 1u);
            asm volatile("s_waitcnt vmcnt(0)" ::: "memory");
        } else {
            XB_SPIN(xb_ld(&bar[XB_XGEN(b.x)]) == gen, bar);
            __builtin_amdgcn_fence(__ATOMIC_ACQUIRE, "agent");
            asm volatile("s_waitcnt vmcnt(0)" ::: "memory");
        }
    }
    __syncthreads();
}


__global__ void __launch_bounds__(512, 2) mega(Params P_) {
    extern __shared__ __attribute__((aligned(16))) unsigned char lds[];
    volatile LAS unsigned* st = (volatile LAS unsigned*)(LAS unsigned char*)(lds + LDS_BARST);
    if (threadIdx.x < 16) st[threadIdx.x] = 0u;
    __syncthreads();
    CParams* pp = (CParams*)__builtin_amdgcn_kernarg_segment_ptr();
    (void)xcd_barrier_post((unsigned*)(pp->ws + WS_CTL) + CW_BAR, st);
#define GB do { XcdBarrier bar_; bar_.bar = (unsigned*)(pp->ws + WS_CTL) + CW_BAR; bar_.x = xb_xcc_id(); bar_.st = (volatile LAS unsigned*)(LAS unsigned char*)(lds + LDS_BARST); xcd_barrier(bar_); asm volatile("" : "+s"(pp)); } while (0)
#define P (*pp)
    asm volatile("" : "+s"(pp));
    phase_0(P, lds, 0); GB;
    phase_1(P, lds, 1); GB;
    phase_2(P, lds, 2); asm volatile("" : "+s"(pp));
    phase_3(P, lds, 3); GB;
    phase_4(P, lds, 4); GB;
    phase_5(P, lds, 5); GB;
    phase_6(P, lds, 6); GB;
    phase_7(P, lds, 7); GB;
    phase_8(P, lds, 8); GB;
    phase_9(P, lds, 9); GB;
    phase_10(P, lds, 10); GB;
    phase_11(P, lds, 11); GB;
    phase_12(P, lds, 12); GB;
    phase_13(P, lds, 13); GB;
    phase_14(P, lds, 14); GB;
    phase_15(P, lds, 15); GB;
    phase_14(P, lds, 16); GB;
    phase_22(P, lds, 22); GB;
    phase_23(P, lds, 23); GB;
    phase_9(P, lds, 17); GB;
    phase_10(P, lds, 18); GB;
    phase_11(P, lds, 19); GB;
    phase_12(P, lds, 20); GB;
    phase_13(P, lds, 21);
#undef P
#undef GB
}

extern "C" void kernel_launch(void* const* d_in, const int* in_sizes, int n_in, void* d_out, int out_size, void* d_ws, size_t ws_size, hipStream_t stream) {
    static int ready = 0;
    if (!ready) {
        if (n_in != 35 || ws_size < WS_TOTAL) { fprintf(stderr, "kernel_launch: unexpected n_in %d or ws_size %zu (need %zu)\n", n_in, ws_size, (size_t)WS_TOTAL); ready = -1; return; }
        if (hipFuncSetAttribute((const void*)mega, hipFuncAttributeMaxDynamicSharedMemorySize, LDS_BYTES) != hipSuccess) { fprintf(stderr, "kernel_launch: hipFuncSetAttribute failed\n"); ready = -1; return; }
        ready = 1;
    }
    if (ready < 0) return;
    (void)hipMemsetAsync((char*)d_ws + WS_CTL, 0, 1 * MiB, stream);
    Params P{};
    for (int i = 0; i < 35; ++i) P.in[i] = (const float*)d_in[i];
    P.out = (float*)d_out; P.ws = (unsigned char*)d_ws; P.ph_lo = 0; P.ph_hi = 0;
    hipLaunchKernelGGL(mega, dim3(GRID), dim3(512), LDS_BYTES, stream, P);
}
```

```cpp
#include <hip/hip_runtime.h>
#include <stdint.h>
#include <stdio.h>

#define DM 1024
#define NB 2
#define SEQ 8192
#define NMETA 16
#define LSEQ (SEQ + NMETA)
#define NMAIN (NB * SEQ)
#define NT (NB * LSEQ)
#define NTP 16640
#define INCOLS 3328
#define RESTC 1792
#define NEXP 32
#define DFF 512
#define S5TC 48
#define S5NC 171
#define MOE_RT 256
#define MOE_MAXROWS 41216

typedef unsigned short bf16_t;
typedef short bf16x8 __attribute__((ext_vector_type(8)));
typedef float f32x4 __attribute__((ext_vector_type(4)));
typedef unsigned u32x4 __attribute__((ext_vector_type(4)));
typedef unsigned u32x2 __attribute__((ext_vector_type(2)));

constexpr size_t MiB = 1u << 20;
constexpr size_t al64k(size_t x) { return (x + 65535) & ~(size_t)65535; }
constexpr size_t WS_CTL = 0;
constexpr size_t WS_H = 1 * MiB;
constexpr size_t WS_HN = WS_H + al64k((size_t)NT * DM * 4);
constexpr size_t WS_A2 = WS_HN + al64k((size_t)NTP * DM * 2);
constexpr size_t WS_WTIN = WS_A2 + al64k((size_t)NTP * DM * 2);
constexpr size_t WS_WTOUT = WS_WTIN + al64k((size_t)INCOLS * DM * 2);
constexpr size_t WS_WTGLU = WS_WTOUT + al64k((size_t)DM * DM * 2);
constexpr size_t WS_WT13 = WS_WTGLU + al64k((size_t)2 * DM * DM * 2);
constexpr size_t WS_WT2 = WS_WT13 + al64k((size_t)NEXP * DM * DM * 2);
constexpr size_t WS_BIG = WS_WT2 + al64k((size_t)NEXP * DM * DFF * 2);
constexpr size_t SZ_T512 = al64k((size_t)NT * 512 * 2);
constexpr size_t SZ_P512 = al64k((size_t)NTP * 512 * 2);
constexpr size_t WS_Q = WS_BIG;
constexpr size_t WS_K = WS_Q + SZ_P512;
constexpr size_t WS_V = WS_K + SZ_P512;
constexpr size_t WS_REST = WS_V + SZ_P512;
constexpr size_t WS_R = WS_REST + al64k((size_t)NTP * RESTC * 2);
constexpr size_t WS_KR = WS_R + SZ_T512;
constexpr size_t WS_VV = WS_KR + SZ_T512;
constexpr size_t WS_LOW = WS_VV + SZ_T512;
constexpr size_t WS_G = WS_LOW + al64k((size_t)NT * 256 * 2);
constexpr size_t WS_KK = WS_G + SZ_T512;
constexpr size_t WS_KKA = WS_KK + SZ_T512;
constexpr size_t WS_KD = WS_KKA + 2 * SZ_T512;
constexpr size_t WS_BC = WS_KD + 2 * SZ_T512;
constexpr size_t WS_MIXEND = WS_BC + al64k((size_t)NT * 8 * 4);
constexpr size_t WS_AA = WS_Q;
constexpr size_t WS_YFB = WS_Q;
constexpr size_t WS_W = WS_V;
static_assert(2 * SZ_T512 <= 2 * SZ_P512, "AA/YFB fit in Q|K");
static_assert((size_t)2 * NT * 512 * 4 <= SZ_P512 + al64k((size_t)NTP * RESTC * 2), "W fits in V|REST");
constexpr size_t WS_XB = WS_BIG;
constexpr size_t WS_HB = WS_XB + al64k((size_t)MOE_MAXROWS * DM * 2);
constexpr size_t WS_YB = WS_HB + al64k((size_t)MOE_MAXROWS * DFF * 2);
constexpr size_t WS_EID = WS_YB + al64k((size_t)MOE_MAXROWS * DM * 2);
constexpr size_t WS_POS = WS_EID + al64k((size_t)NT * 8);
constexpr size_t WS_DEST = WS_POS + al64k((size_t)NT * 8);
constexpr size_t WS_GATE = WS_DEST + al64k((size_t)NT * 8);
constexpr size_t WS_MOEEND = WS_GATE + al64k((size_t)NT * 8);
constexpr size_t WS_YS = WS_BIG;
constexpr size_t WS_END = WS_YS + al64k((size_t)2 * NT * DM * 4);
constexpr size_t WS_CARRY = WS_END + al64k((size_t)256 * S5NC * 64 * 8);
constexpr size_t WS_S5END = WS_CARRY + al64k((size_t)256 * S5NC * 64 * 8);
constexpr size_t cmax(size_t a, size_t b) { return a > b ? a : b; }
constexpr size_t WS_TOTAL = cmax(WS_MIXEND, cmax(WS_MOEEND, WS_S5END));
static_assert(WS_TOTAL <= 512 * MiB, "workspace map exceeds 512 MiB");

#define CW_CNT(l) (1024 + 64 * (l))

#define LDS_RING 131072
#define LDS_BARST (LDS_RING)
#define LDS_TAB (LDS_RING + 256)
#define LDS_BYTES 147456
#define GRID 256

struct Params {
    const float* in[35];
    float* out;
    unsigned char* ws;
    int ph_lo, ph_hi;
};
typedef const __attribute__((address_space(4))) Params CParams;

__device__ __forceinline__ float bf2f(bf16_t v) { return __uint_as_float(((unsigned)v) << 16); }
__device__ __forceinline__ unsigned f2bf(float f) { unsigned u = __float_as_uint(f); return (u + 0x7fffu + ((u >> 16) & 1u)) >> 16; }
__device__ __forceinline__ unsigned pk2(float lo, float hi) { return f2bf(lo) | (f2bf(hi) << 16); }
__device__ __forceinline__ float bflo(unsigned u) { return __uint_as_float(u << 16); }
__device__ __forceinline__ float bfhi(unsigned u) { return __uint_as_float(u & 0xffff0000u); }
__device__ __forceinline__ float wave_sum(float v) {
#pragma unroll
    for (int o = 1; o < 64; o <<= 1) v += __shfl_xor(v, o);
    return v;
}
__device__ __forceinline__ float wave_max(float v) {
#pragma unroll
    for (int o = 1; o < 64; o <<= 1) v = fmaxf(v, __shfl_xor(v, o));
    return v;
}
template <int CTRL> __device__ __forceinline__ float dppf(float v) { return __int_as_float(__builtin_amdgcn_update_dpp(0, __float_as_int(v), CTRL, 0xF, 0xF, true)); }
__device__ __forceinline__ float row16_sum(float v) { v += dppf<0xB1>(v); v += dppf<0x4E>(v); v += dppf<0x141>(v); v += dppf<0x140>(v); return v; }
__device__ __forceinline__ float sigmoidf_(float x) { return 1.f / (1.f + __expf(-x)); }
__device__ __forceinline__ int rowof(int b, int p) { return p < NMETA ? NMAIN + b * NMETA + p : b * SEQ + (p - NMETA); }

#define SA_STRIDE 40
template <class AF, class BF>
__device__ __forceinline__ void gemm_tile(unsigned char* lds, int K, int ldb, const AF& arow, const BF& bcol, f32x4 (&acc)[4][2]) {
    bf16_t* sA = (bf16_t*)lds;
    bf16_t* sB = (bf16_t*)(lds + 128 * SA_STRIDE * 2);
    const int tid = threadIdx.x, lane = tid & 63, wave = tid >> 6, wr = wave >> 2, wc = wave & 3, fr = lane & 15, fq = lane >> 4;
#pragma unroll
    for (int mi = 0; mi < 4; ++mi)
#pragma unroll
        for (int ni = 0; ni < 2; ++ni) acc[mi][ni] = (f32x4){0.f, 0.f, 0.f, 0.f};
    const int ar = tid >> 2, akc = (tid & 3) * 8;
    const bf16_t* ap = arow(ar) + akc;
    const int bnq = (tid & 31) * 4, bkp = (tid >> 5) * 2;
    const float* bp = bcol(bnq) + (size_t)bkp * ldb;
    const int nk = K / 32;
    u32x4 ra = *(const u32x4*)ap;
    f32x4 rb0 = *(const f32x4*)bp, rb1 = *(const f32x4*)(bp + ldb);
    for (int kt = 0; kt < nk; ++kt) {
        __syncthreads();
        *(u32x4*)(sA + ar * SA_STRIDE + akc) = ra;
        {
            unsigned* d = (unsigned*)(sB + bnq * SA_STRIDE + bkp);
            d[0 * (SA_STRIDE / 2)] = pk2(rb0[0], rb1[0]);
            d[1 * (SA_STRIDE / 2)] = pk2(rb0[1], rb1[1]);
            d[2 * (SA_STRIDE / 2)] = pk2(rb0[2], rb1[2]);
            d[3 * (SA_STRIDE / 2)] = pk2(rb0[3], rb1[3]);
        }
        __syncthreads();
        if (kt + 1 < nk) {
            ra = *(const u32x4*)(ap + (kt + 1) * 32);
            const float* q = bp + (size_t)(kt + 1) * 32 * ldb;
            rb0 = *(const f32x4*)q; rb1 = *(const f32x4*)(q + ldb);
        }
        bf16x8 a[4], b[2];
#pragma unroll
        for (int mi = 0; mi < 4; ++mi) a[mi] = *(const bf16x8*)(sA + (wr * 64 + mi * 16 + fr) * SA_STRIDE + fq * 8);
#pragma unroll
        for (int ni = 0; ni < 2; ++ni) b[ni] = *(const bf16x8*)(sB + (wc * 32 + ni * 16 + fr) * SA_STRIDE + fq * 8);
#pragma unroll
        for (int mi = 0; mi < 4; ++mi)
#pragma unroll
            for (int ni = 0; ni < 2; ++ni) acc[mi][ni] = __builtin_amdgcn_mfma_f32_16x16x32_bf16(a[mi], b[ni], acc[mi][ni], 0, 0, 0);
    }
    __syncthreads();
}
#define ACC_FOREACH(acc, ...) do { const int _l = threadIdx.x & 63, _w = threadIdx.x >> 6, _wr = _w >> 2, _wc = _w & 3, _fr = _l & 15, _fq = _l >> 4; \
    _Pragma("unroll") for (int _mi = 0; _mi < 4; ++_mi) _Pragma("unroll") for (int _ni = 0; _ni < 2; ++_ni) _Pragma("unroll") for (int _j = 0; _j < 4; ++_j) { \
        const int rl = _wr * 64 + _mi * 16 + _fq * 4 + _j, cl = _wc * 32 + _ni * 16 + _fr; const float val = acc[_mi][_ni][_j]; __VA_ARGS__ } } while (0)
#define ACC_FOREACH_PAIR(acc, ...) do { const int _l = threadIdx.x & 63, _w = threadIdx.x >> 6, _wr = _w >> 2, _wc = _w & 3, _fr = _l & 15, _fq = _l >> 4; \
    _Pragma("unroll") for (int _mi = 0; _mi < 4; ++_mi) _Pragma("unroll") for (int _j = 0; _j < 4; ++_j) { \
        const int rl = _wr * 64 + _mi * 16 + _fq * 4 + _j, co = _wc * 16 + _fr; const float va = acc[_mi][0][_j], vg = acc[_mi][1][_j]; __VA_ARGS__ } } while (0)

__device__ __forceinline__ void store_norm_bf16(const f32x4 (&v)[4], const float* gain, bf16_t* dst, int lane) {
    float ss = 0.f;
#pragma unroll
    for (int j = 0; j < 4; ++j) ss += v[j][0] * v[j][0] + v[j][1] * v[j][1] + v[j][2] * v[j][2] + v[j][3] * v[j][3];
    ss = wave_sum(ss);
    const float rstd = rsqrtf(ss * (1.f / DM) + 1e-6f);
#pragma unroll
    for (int j = 0; j < 4; ++j) {
        const f32x4 g = ((const f32x4*)gain)[lane + 64 * j];
        u32x2 o; o.x = pk2(v[j][0] * rstd * g[0], v[j][1] * rstd * g[1]); o.y = pk2(v[j][2] * rstd * g[2], v[j][3] * rstd * g[3]);
        ((u32x2*)dst)[lane + 64 * j] = o;
    }
}

namespace pg8 {
#define PG8_LAS __attribute__((address_space(3)))
constexpr int BM = 256, BK = 64, HALF = 128, HTB = HALF * BK * 2  , STAGE_BYTES = 8 * HTB, NXCD = 8, WGM = 8;
__host__ __device__ __forceinline__ int lds_byte(int r, int c) { const int st = (r >> 4) * 2 + (c >> 5), rr = r & 15, cc = c & 31, ob = rr * 64 + cc * 2; return st * 1024 + (ob ^ (((ob >> 9) & 1) << 5)); }
__host__ __device__ __forceinline__ void stage_rc(int b, int& R, int& C) { const int st = b / 1024, sb = b % 1024, swz = sb ^ (((sb >> 9) & 1) << 5); R = (st >> 1) * 16 + swz / 64; C = (st & 1) * 32 + (swz % 64) / 2; }
__host__ __device__ __forceinline__ int perm32(int rho) { const int n = rho >> 4, i = rho & 15; return 8 * (i >> 2) + 4 * n + (i & 3); }

struct Unit { int pm, pn; const char* A; const char* B; };

struct DenseOrder {
    int nM, nN, nwg, G, c; const char* A; const char* Bt; size_t tstep;
    __device__ void init(const bf16_t* A_, const bf16_t* Bt_, int M, int N, int K, int G_, int c_) { nM = M / BM; nN = N / BM; nwg = nM * nN; G = G_; c = c_; A = (const char*)A_; Bt = (const char*)Bt_; tstep = (size_t)BM * K * 2; }
    __device__ bool next(int i, Unit& u) const {
        const long L = (long)i * G + c; if (L >= nwg) return false;
        int wgid = (int)L; { const int q = nwg / NXCD, r = nwg % NXCD, xcd = wgid % NXCD, off = wgid / NXCD; wgid = (xcd < r ? xcd * (q + 1) : r * (q + 1) + (xcd - r) * q) + off; }
        const int nig = WGM * nN, gid = wgid / nig, fm = gid * WGM, gsz = (nM - fm) < WGM ? (nM - fm) : WGM;
        u.pm = fm + ((wgid % nig) % gsz); u.pn = (wgid % nig) / gsz; u.A = A + (size_t)u.pm * tstep; u.B = Bt + (size_t)u.pn * tstep; return true;
    }
    __device__ __forceinline__ void a_ready(const Unit&) const {}
    __device__ __forceinline__ void done(const Unit&) const {}
};
struct MoeOrder {
    const int* et; int TT, vcu; const char* A; const char* Bt; unsigned tstepA, tstepB, estep;
    __device__ __forceinline__ bool next(int i, Unit& u) const {
        const int L = i * GRID + vcu; if (L >= TT * 4) return false;
        const int rt = L >> 2, ct = L & 3, e = et[rt];
        u.pm = rt; u.pn = ct; u.A = A + (size_t)rt * tstepA; u.B = Bt + (size_t)e * estep + (size_t)ct * tstepB; return true;
    }
    __device__ __forceinline__ void a_ready(const Unit&) const {}
    __device__ __forceinline__ void done(const Unit&) const {}
};

__device__ __forceinline__ unsigned cvt_pk_bf16(float lo, float hi) { unsigned r; asm volatile("v_cvt_pk_bf16_f32 %0, %1, %2" : "=v"(r) : "v"(lo), "v"(hi)); return r; }

struct EpiProj {
    static constexpr bool PERM = true, AFTER_DRAIN = false;
    bf16_t *Q, *Kk, *V, *REST;
    __device__ __forceinline__ void operator()(const f32x4 (&acc)[2][2][4][2], const Unit& u, int wr, int wc, int fr, int fq) const {
        const int row0 = u.pm * BM + wr * 64 + fr; int colt = u.pn * BM; bf16_t* base; int ldc;
        if (colt < 512) { base = Q; ldc = 512; } else if (colt < 1024) { base = Kk; colt -= 512; ldc = 512; } else if (colt < 1536) { base = V; colt -= 1024; ldc = 512; } else { base = REST; colt -= 1536; ldc = RESTC; }
        const int col0 = colt + wc * 32 + 8 * fq;
#pragma unroll
        for (int ai = 0; ai < 2; ++ai)
#pragma unroll
            for (int m = 0; m < 4; ++m) { bf16_t* rowp = base + (size_t)(row0 + ai * HALF + m * 16) * ldc + col0;
#pragma unroll
                for (int bj = 0; bj < 2; ++bj) { const f32x4 v0 = acc[ai][bj][m][0], v1 = acc[ai][bj][m][1];
                    u32x4 w; w.x = cvt_pk_bf16(v0[0], v0[1]); w.y = cvt_pk_bf16(v0[2], v0[3]); w.z = cvt_pk_bf16(v1[0], v1[1]); w.w = cvt_pk_bf16(v1[2], v1[3]);
                    *(u32x4*)(rowp + bj * HALF) = w; } }
    }
};
struct EpiBf16Plain {
    static constexpr bool PERM = true, AFTER_DRAIN = false;
    bf16_t* O; int ldc;
    __device__ __forceinline__ void operator()(const f32x4 (&acc)[2][2][4][2], const Unit& u, int wr, int wc, int fr, int fq) const {
        const int row0 = u.pm * BM + wr * 64 + fr; const int col0 = u.pn * BM + wc * 32 + 8 * fq;
#pragma unroll
        for (int ai = 0; ai < 2; ++ai)
#pragma unroll
            for (int m = 0; m < 4; ++m) { bf16_t* rowp = O + (size_t)(row0 + ai * HALF + m * 16) * ldc + col0;
#pragma unroll
                for (int bj = 0; bj < 2; ++bj) { const f32x4 v0 = acc[ai][bj][m][0], v1 = acc[ai][bj][m][1];
                    u32x4 w; w.x = cvt_pk_bf16(v0[0], v0[1]); w.y = cvt_pk_bf16(v0[2], v0[3]); w.z = cvt_pk_bf16(v1[0], v1[1]); w.w = cvt_pk_bf16(v1[2], v1[3]);
                    *(u32x4*)(rowp + bj * HALF) = w; } }
    }
};
struct EpiSwiglu {
    static constexpr bool PERM = true, AFTER_DRAIN = false;
    bf16_t* O;
    __device__ __forceinline__ void operator()(const f32x4 (&acc)[2][2][4][2], const Unit& u, int wr, int wc, int fr, int fq) const {
        const int row0 = u.pm * BM + wr * 64 + fr; const int col0 = u.pn * HALF + wc * 32 + 8 * fq;
#pragma unroll
        for (int ai = 0; ai < 2; ++ai)
#pragma unroll
            for (int m = 0; m < 4; ++m) {
                float o[8];
#pragma unroll
                for (int n = 0; n < 2; ++n)
#pragma unroll
                    for (int i = 0; i < 4; ++i) { const float va = acc[ai][0][m][n][i], vg = acc[ai][1][m][n][i]; o[4 * n + i] = va / (1.f + __expf(-va)) * vg; }
                u32x4 w; w.x = cvt_pk_bf16(o[0], o[1]); w.y = cvt_pk_bf16(o[2], o[3]); w.z = cvt_pk_bf16(o[4], o[5]); w.w = cvt_pk_bf16(o[6], o[7]);
                *(u32x4*)(O + (size_t)(row0 + ai * HALF + m * 16) * DFF + col0) = w; }
    }
};
struct EpiResidual {
    static constexpr bool PERM = false, AFTER_DRAIN = false;
    float* Hh;
    __device__ __forceinline__ void operator()(const f32x4 (&acc)[2][2][4][2], const Unit& u, int wr, int wc, int fr, int fq) const {
        const int row0 = u.pm * BM + wr * 64 + fr; const int col0 = u.pn * BM + wc * 32 + 4 * fq;
#pragma unroll
        for (int ai = 0; ai < 2; ++ai)
#pragma unroll
            for (int m = 0; m < 4; ++m) { float* rowp = Hh + (size_t)(row0 + ai * HALF + m * 16) * DM + col0;
#pragma unroll
                for (int bj = 0; bj < 2; ++bj)
#pragma unroll
                    for (int n = 0; n < 2; ++n) { f32x4* p = (f32x4*)(rowp + bj * HALF + n * 16); *p = *p + acc[ai][bj][m][n]; } }
    }
};
struct EpiGlu {
    static constexpr bool PERM = false, AFTER_DRAIN = false;
    float* Hh;
    __device__ __forceinline__ void operator()(const f32x4 (&acc)[2][2][4][2], const Unit& u, int wr, int wc, int fr, int fq) const {
        const int row0 = u.pm * BM + wr * 64 + fr; const int col0 = u.pn * HALF + wc * 32 + 4 * fq;
#pragma unroll
        for (int ai = 0; ai < 2; ++ai)
#pragma unroll
            for (int m = 0; m < 4; ++m) { float* rowp = Hh + (size_t)(row0 + ai * HALF + m * 16) * DM + col0;
#pragma unroll
                for (int n = 0; n < 2; ++n) { f32x4* p = (f32x4*)(rowp + n * 16); f32x4 hv = *p; const f32x4 va = acc[ai][0][m][n], vg = acc[ai][1][m][n];
#pragma unroll
                    for (int i = 0; i < 4; ++i) hv[i] += va[i] / (1.f + __expf(-vg[i]));
                    *p = hv; } }
    }
};

template <class Epi, class Sched, bool ALIGN_EPI = false, bool SP2 = false>
__device__ __forceinline__ void gemm_phase(PG8_LAS unsigned char* lds, const int K, const Sched& S, const Epi& E) {
    int tid_ = threadIdx.x; asm volatile("" : "+v"(tid_));
    const int tid = tid_, wid = __builtin_amdgcn_readfirstlane(tid >> 6), lane = tid & 63, wr = wid >> 2, wc = wid & 3, fr = lane & 15, fq = lane >> 4;
    const int nt = K / BK;
    unsigned voffA[2], voffB[2];
#pragma unroll
    for (int i = 0; i < 2; ++i) { int R, C; stage_rc(tid * 16 + i * 8192, R, C); const int Rb = Epi::PERM ? ((R & ~31) + perm32(R & 31)) : R;
        voffA[i] = (unsigned)(R * K + C) * 2u; voffB[i] = (unsigned)(Rb * K + C) * 2u; }
    const size_t kstep = (size_t)(BK * 2);
    const size_t hstep = (size_t)HALF * K * 2;
    const unsigned ldsw = (unsigned)wid * 1024u;
    const int aoff = lds_byte(wr * 64 + fr, fq * 8), boff = lds_byte(wc * 32 + fr, fq * 8);
#define PG8_SA(b, h) (((b) * 2 + (h)) * HTB)
#define PG8_SB(b, h) ((4 + (b) * 2 + (h)) * HTB)
#define PG8_STAGE(bufoff, gbase, voff) do { _Pragma("unroll") for (int _i = 0; _i < 2; ++_i) \
        __builtin_amdgcn_global_load_lds((const unsigned*)((const char*)(gbase) + (voff)[_i]), (PG8_LAS unsigned*)(lds + (bufoff) + ldsw + _i * 8192), 16, 0, 0); } while (0)
#define PG8_LDA(dst, b, h) do { _Pragma("unroll") for (int m = 0; m < 4; ++m) _Pragma("unroll") for (int k = 0; k < 2; ++k) dst[m][k] = *(const PG8_LAS bf16x8*)(lds + PG8_SA(b, h) + aoff + m * 2048 + k * 1024); } while (0)
#define PG8_LDB(dst, b, h) do { _Pragma("unroll") for (int n = 0; n < 2; ++n) _Pragma("unroll") for (int k = 0; k < 2; ++k) dst[n][k] = *(const PG8_LAS bf16x8*)(lds + PG8_SB(b, h) + boff + n * 2048 + k * 1024); } while (0)
#define PG8_MMA(ai, bj, At, Bt) do { __builtin_amdgcn_s_setprio(1); _Pragma("unroll") for (int m = 0; m < 4; ++m) _Pragma("unroll") for (int n = 0; n < 2; ++n) _Pragma("unroll") for (int k = 0; k < 2; ++k) \
        acc[ai][bj][m][n] = __builtin_amdgcn_mfma_f32_16x16x32_bf16(Bt[n][k], At[m][k], acc[ai][bj][m][n], 0, 0, 0); __builtin_amdgcn_s_setprio(0); } while (0)
#define PG8_WAIT_V(n) asm volatile("s_waitcnt vmcnt(" #n ")" ::: "memory")
#define PG8_WAIT_L(n) asm volatile("s_waitcnt lgkmcnt(" #n ")" ::: "memory")
#define PG8_BAR __builtin_amdgcn_s_barrier()
#define PG8_SCHED __builtin_amdgcn_sched_barrier(0)
    Unit cur, nxt; int ui = 0;
    if (!S.next(0, cur)) return;
    f32x4 acc[2][2][4][2];
#pragma unroll
    for (int a = 0; a < 2; ++a)
#pragma unroll
        for (int b = 0; b < 2; ++b)
#pragma unroll
            for (int m = 0; m < 4; ++m)
#pragma unroll
                for (int n = 0; n < 2; ++n) acc[a][b][m][n] = (f32x4){0.f, 0.f, 0.f, 0.f};
    bf16x8 At[4][2], B0[2][2], B1[2][2];
    const char* cA = cur.A; const char* cB = cur.B;
    S.a_ready(cur);
    if constexpr (SP2) {
        PG8_STAGE(PG8_SB(0, 0), cB, voffB); PG8_STAGE(PG8_SB(0, 1), cB + hstep, voffB); PG8_STAGE(PG8_SA(0, 0), cA, voffA); PG8_STAGE(PG8_SA(0, 1), cA + hstep, voffA);
        if (wr == 1) PG8_BAR;
        PG8_WAIT_V(2); PG8_BAR;
        PG8_STAGE(PG8_SB(1, 0), cB + kstep, voffB); PG8_STAGE(PG8_SA(1, 0), cA + kstep, voffA); PG8_STAGE(PG8_SB(1, 1), cB + hstep + kstep, voffB);
        PG8_WAIT_V(6); PG8_BAR;
    } else {
        PG8_STAGE(PG8_SB(0, 0), cB, voffB); PG8_STAGE(PG8_SA(0, 0), cA, voffA); PG8_STAGE(PG8_SB(0, 1), cB + hstep, voffB); PG8_STAGE(PG8_SA(0, 1), cA + hstep, voffA);
        if (wr == 1) PG8_BAR;
        PG8_WAIT_V(4); PG8_BAR;
        PG8_STAGE(PG8_SB(1, 0), cB + kstep, voffB); PG8_STAGE(PG8_SA(1, 0), cA + kstep, voffA); PG8_STAGE(PG8_SB(1, 1), cB + hstep + kstep, voffB);
        PG8_WAIT_V(6); PG8_BAR;
    }
    for (;;) {
        const bool has_next = S.next(ui + 1, nxt);
        const char* nA = has_next ? nxt.A : cA; const char* nB = has_next ? nxt.B : cB;
        for (int t = 0; t < nt; t += 2) {
            const bool last = (t == nt - 2);
            const char* a1 = cA + (size_t)(t + 1) * kstep;
            const char* a2 = last ? nA : cA + (size_t)(t + 2) * kstep; const char* b2 = last ? nB : cB + (size_t)(t + 2) * kstep;
            const char* a3 = a2 + kstep; const char* b3 = b2 + kstep;
            if (last && has_next) S.a_ready(nxt);
            if constexpr (SP2) {
            PG8_LDB(B0, 0, 0); PG8_LDB(B1, 0, 1); PG8_SCHED; PG8_LDA(At, 0, 0); PG8_STAGE(PG8_SA(1, 1), a1 + hstep, voffA);
            PG8_WAIT_V(8); PG8_WAIT_L(0); PG8_BAR; PG8_MMA(0, 0, At, B0); PG8_MMA(0, 1, At, B1); PG8_BAR; PG8_SCHED;
            PG8_LDA(At, 0, 1); PG8_STAGE(PG8_SB(0, 0), b2, voffB); PG8_STAGE(PG8_SB(0, 1), b2 + hstep, voffB); PG8_STAGE(PG8_SA(0, 0), a2, voffA);
            PG8_WAIT_V(8); PG8_WAIT_L(0); PG8_BAR; PG8_MMA(1, 0, At, B0); PG8_MMA(1, 1, At, B1); PG8_BAR; PG8_SCHED;
            PG8_LDB(B0, 1, 0); PG8_LDB(B1, 1, 1); PG8_SCHED; PG8_LDA(At, 1, 0); PG8_STAGE(PG8_SA(0, 1), a2 + hstep, voffA);
            PG8_WAIT_V(8); PG8_WAIT_L(0); PG8_BAR; PG8_MMA(0, 0, At, B0); PG8_MMA(0, 1, At, B1); PG8_BAR; PG8_SCHED;
            PG8_LDA(At, 1, 1); PG8_STAGE(PG8_SB(1, 0), b3, voffB); PG8_STAGE(PG8_SB(1, 1), b3 + hstep, voffB); PG8_STAGE(PG8_SA(1, 0), a3, voffA);
            PG8_WAIT_V(8); PG8_WAIT_L(0); PG8_BAR; PG8_MMA(1, 0, At, B0); PG8_MMA(1, 1, At, B1); PG8_BAR; PG8_SCHED;
            } else {
            PG8_LDB(B0, 0, 0); PG8_SCHED; PG8_LDA(At, 0, 0); PG8_STAGE(PG8_SA(1, 1), a1 + hstep, voffA);
            PG8_WAIT_L(8); PG8_BAR; PG8_WAIT_L(0); PG8_MMA(0, 0, At, B0); PG8_BAR; PG8_SCHED;
            PG8_LDB(B1, 0, 1); PG8_STAGE(PG8_SB(0, 0), b2, voffB);
            PG8_BAR; PG8_WAIT_L(0); PG8_MMA(0, 1, At, B1); PG8_BAR;
            PG8_LDA(At, 0, 1); PG8_STAGE(PG8_SA(0, 0), a2, voffA);
            PG8_BAR; PG8_WAIT_L(0); PG8_MMA(1, 0, At, B0); PG8_BAR; PG8_SCHED;
            PG8_STAGE(PG8_SB(0, 1), b2 + hstep, voffB);
            PG8_WAIT_V(6); PG8_BAR; PG8_MMA(1, 1, At, B1); PG8_BAR;
            PG8_LDB(B0, 1, 0); PG8_SCHED; PG8_LDA(At, 1, 0); PG8_STAGE(PG8_SA(0, 1), a2 + hstep, voffA);
            PG8_WAIT_L(8); PG8_BAR; PG8_WAIT_L(0); PG8_MMA(0, 0, At, B0); PG8_BAR; PG8_SCHED;
            PG8_LDB(B1, 1, 1); PG8_STAGE(PG8_SB(1, 0), b3, voffB);
            PG8_BAR; PG8_WAIT_L(0); PG8_MMA(0, 1, At, B1); PG8_BAR;
            PG8_LDA(At, 1, 1); PG8_STAGE(PG8_SA(1, 0), a3, voffA);
            PG8_BAR; PG8_WAIT_L(0); PG8_MMA(1, 0, At, B0); PG8_BAR; PG8_SCHED;
            PG8_STAGE(PG8_SB(1, 1), b3 + hstep, voffB);
            PG8_WAIT_V(6); PG8_BAR; PG8_MMA(1, 1, At, B1); PG8_BAR;
            }
        }
        if constexpr (ALIGN_EPI) { if (wr == 0) PG8_BAR; }
        if constexpr (!Epi::AFTER_DRAIN) { E(acc, cur, wr, wc, fr, fq); S.done(cur); }
        if (!has_next) break;
#pragma unroll
        for (int a = 0; a < 2; ++a)
#pragma unroll
            for (int b = 0; b < 2; ++b)
#pragma unroll
                for (int m = 0; m < 4; ++m)
#pragma unroll
                    for (int n = 0; n < 2; ++n) acc[a][b][m][n] = (f32x4){0.f, 0.f, 0.f, 0.f};
        cur = nxt; cA = nA; cB = nB; ++ui;
        if constexpr (ALIGN_EPI) { if (wr == 1) PG8_BAR; }
    }
    PG8_WAIT_V(0);
    if constexpr (!ALIGN_EPI) { if (wr == 0) PG8_BAR; }
    PG8_BAR;
    if constexpr (Epi::AFTER_DRAIN) { E.fused(acc, cur, wr, wc, fr, fq, lds, wid, lane); S.done(cur); }
#undef PG8_SA
#undef PG8_SB
#undef PG8_STAGE
#undef PG8_LDA
#undef PG8_LDB
#undef PG8_MMA
#undef PG8_WAIT_V
#undef PG8_WAIT_L
#undef PG8_BAR
#undef PG8_SCHED
}
}

#define PHASE_PROLOGUE \
    int tid_ = threadIdx.x; asm volatile("" : "+v"(tid_)); const int tid = tid_, lane = tid & 63, wave = tid >> 6; \
    const int G = GRID, bid = blockIdx.x; \
    const int gw = bid * 8 + wave, NGW = G * 8; \
    unsigned char* ws = P.ws; \
    float* H = (float*)(ws + WS_H); \
    bf16_t* HN = (bf16_t*)(ws + WS_HN); \
    bf16_t* A2 = (bf16_t*)(ws + WS_A2); \
    bf16_t* Qb = (bf16_t*)(ws + WS_Q); bf16_t* Kb = (bf16_t*)(ws + WS_K); bf16_t* Vb = (bf16_t*)(ws + WS_V); \
    bf16_t* REST = (bf16_t*)(ws + WS_REST); \
    bf16_t* YFB = (bf16_t*)(ws + WS_YFB); \
    bf16_t* Rr = (bf16_t*)(ws + WS_R); bf16_t* VV = (bf16_t*)(ws + WS_VV); bf16_t* KK = (bf16_t*)(ws + WS_KK); \
    bf16_t* KKA = (bf16_t*)(ws + WS_KKA); bf16_t* KD = (bf16_t*)(ws + WS_KD); \
    float* Wd = (float*)(ws + WS_W); \
    bf16_t* Gg = (bf16_t*)(ws + WS_G); bf16_t* KR = (bf16_t*)(ws + WS_KR); bf16_t* LOW = (bf16_t*)(ws + WS_LOW); \
    float* BC = (float*)(ws + WS_BC); \
    bf16_t* AA = (bf16_t*)(ws + WS_AA); \
    bf16_t* HB = (bf16_t*)(ws + WS_HB); bf16_t* YB = (bf16_t*)(ws + WS_YB); \
    bf16_t* XB = (bf16_t*)(ws + WS_XB); int* EID = (int*)(ws + WS_EID); int* POS = (int*)(ws + WS_POS); int* DEST = (int*)(ws + WS_DEST); \
    float* GATE = (float*)(ws + WS_GATE); \
    float* YS = (float*)(ws + WS_YS); \
    float* ENDS = (float*)(ws + WS_END); float* CARRY = (float*)(ws + WS_CARRY); \
    unsigned* CTL = (unsigned*)(ws + WS_CTL); \
    bf16_t* WTIN = (bf16_t*)(ws + WS_WTIN); bf16_t* WTOUT = (bf16_t*)(ws + WS_WTOUT); bf16_t* WTGLU = (bf16_t*)(ws + WS_WTGLU); bf16_t* WT13 = (bf16_t*)(ws + WS_WT13); bf16_t* WT2 = (bf16_t*)(ws + WS_WT2); \
    const int vcu = (G % 8 == 0) ? (bid % 8) * (G / 8) + bid / 8 : bid; \
    const float* x = P.in[0]; const float* meta = P.in[1]; const float* norm_mix = P.in[2]; const float* norm_ffn = P.in[3]; const float* norm_final = P.in[4]; \
    const float* w_in = P.in[5]; const float* w_out = P.in[6]; const float* rpb = P.in[7]; const float* mu = P.in[8]; \
    const float* w0 = P.in[9]; const float* w_up = P.in[10]; const float* a0 = P.in[11]; const float* a_up = P.in[12]; const float* g_up = P.in[13]; \
    const float* k_k = P.in[14]; const float* k_a = P.in[15]; const float* r_k = P.in[16]; const float* lnx_g = P.in[17]; const float* lnx_b = P.in[18]; \
    const float* s5_b_re = P.in[19]; const float* s5_b_im = P.in[20]; const float* s5_lre = P.in[21]; const float* s5_lim = P.in[22]; const float* s5_ls = P.in[23]; \
    const float* s5_c_re = P.in[24]; const float* s5_c_im = P.in[25]; const float* s5_d = P.in[26]; const float* w_glu = P.in[27]; \
    const float* moe_wg = P.in[28]; const float* moe_bg = P.in[29]; const float* moe_we = P.in[30]; const float* moe_be = P.in[31]; \
    const float* moe_w1 = P.in[32]; const float* moe_w3 = P.in[33]; const float* moe_w2 = P.in[34];


__device__ __forceinline__ void transpose_item(const float* W, int N, int K, int k0, int n0, bf16_t* dstrow0, int lane) {
    const int nq = lane & 15, kb = lane >> 4;
    const float* src = W + (size_t)(k0 + 16 * kb) * N + n0 + 4 * nq;
    f32x4 v[16];
#pragma unroll
    for (int kk = 0; kk < 16; ++kk) v[kk] = *(const f32x4*)(src + (size_t)kk * N);
#pragma unroll
    for (int i = 0; i < 4; ++i) {
        bf16_t* d = dstrow0 + (size_t)(4 * nq + i) * K + k0 + 16 * kb;
        u32x4 lo, hi;
        lo.x = pk2(v[0][i], v[1][i]); lo.y = pk2(v[2][i], v[3][i]); lo.z = pk2(v[4][i], v[5][i]); lo.w = pk2(v[6][i], v[7][i]);
        hi.x = pk2(v[8][i], v[9][i]); hi.y = pk2(v[10][i], v[11][i]); hi.z = pk2(v[12][i], v[13][i]); hi.w = pk2(v[14][i], v[15][i]);
        *(u32x4*)d = lo; *(u32x4*)(d + 8) = hi;
    }
}
#define CONV_DENSE_ITEMS (832 + 256 + 512)
__device__ __forceinline__ void conv_dense_item(CParams& P, int it, int lane) {
    unsigned char* ws = P.ws;
    if (it < 832) { const int kb = it / 52, nb = it % 52; transpose_item(P.in[5], INCOLS, DM, kb * 64, nb * 64, (bf16_t*)(ws + WS_WTIN) + (size_t)nb * 64 * DM, lane); return; }
    it -= 832;
    if (it < 256) { const int kb = it / 16, nb = it % 16; transpose_item(P.in[6], DM, DM, kb * 64, nb * 64, (bf16_t*)(ws + WS_WTOUT) + (size_t)nb * 64 * DM, lane); return; }
    it -= 256;
    { const int kb = it / 32, nb = it % 32, n = nb * 64, half = n >> 10, c = n & 1023, row = (c >> 7) * 256 + half * 128 + (c & 127);
      transpose_item(P.in[27], 2 * DM, DM, kb * 64, n, (bf16_t*)(ws + WS_WTGLU) + (size_t)row * DM, lane); }
}
#define CONV_MOE_ITEMS (NEXP * 384)
__device__ __forceinline__ void conv_moe_item(CParams& P, int l, int it, int lane) {
    unsigned char* ws = P.ws;
    const int e = it / 384; int r = it % 384;
    if (r < 256) { const int which = r >> 7; r &= 127; const int kb = r >> 3, nb = r & 7, n = nb * 64, row = (n >> 7) * 256 + which * 128 + (n & 127);
        const float* W = (which ? P.in[33] : P.in[32]) + ((size_t)(l * NEXP + e) * DM) * DFF;
        transpose_item(W, DFF, DM, kb * 64, n, (bf16_t*)(ws + WS_WT13) + ((size_t)e * DM + row) * DM, lane); return; }
    r -= 256;
    { const int kb = r >> 4, nb = r & 15; const float* W = P.in[34] + ((size_t)(l * NEXP + e) * DFF) * DM;
      transpose_item(W, DM, DFF, kb * 64, nb * 64, (bf16_t*)(ws + WS_WT2) + ((size_t)e * DM + nb * 64) * DFF, lane); }
}

template <int MODE>
__device__ __forceinline__ void meta_gemm(const bf16_t* A, const bf16_t* Bt, float* Hrows, int task, int lane) {
    const int fr = lane & 15, fq = lane >> 4, c = task * 16 + fr;
    const bf16_t* b0 = MODE == 0 ? Bt + (size_t)c * DM : Bt + (size_t)((c >> 7) * 256 + (c & 127)) * DM;
    const bf16_t* b1 = b0 + (size_t)128 * DM;
    f32x4 acc0[2], acc1[2];
    acc0[0] = acc0[1] = acc1[0] = acc1[1] = (f32x4){0.f, 0.f, 0.f, 0.f};
#pragma unroll 4
    for (int kt = 0; kt < 32; ++kt) {
        const int ko = kt * 32 + fq * 8;
        const bf16x8 a0 = *(const bf16x8*)(A + (size_t)fr * DM + ko), a1 = *(const bf16x8*)(A + (size_t)(16 + fr) * DM + ko);
        const bf16x8 bv = *(const bf16x8*)(b0 + ko);
        acc0[0] = __builtin_amdgcn_mfma_f32_16x16x32_bf16(a0, bv, acc0[0], 0, 0, 0);
        acc0[1] = __builtin_amdgcn_mfma_f32_16x16x32_bf16(a1, bv, acc0[1], 0, 0, 0);
        if (MODE == 1) { const bf16x8 bg = *(const bf16x8*)(b1 + ko);
            acc1[0] = __builtin_amdgcn_mfma_f32_16x16x32_bf16(a0, bg, acc1[0], 0, 0, 0);
            acc1[1] = __builtin_amdgcn_mfma_f32_16x16x32_bf16(a1, bg, acc1[1], 0, 0, 0); }
    }
#pragma unroll
    for (int mi = 0; mi < 2; ++mi)
#pragma unroll
        for (int j = 0; j < 4; ++j) { float* p = Hrows + (size_t)(mi * 16 + fq * 4 + j) * DM + c;
            if (MODE == 0) *p += acc0[mi][j]; else *p += acc0[mi][j] / (1.f + __expf(-acc1[mi][j])); }
}
__device__ __forceinline__ void phase_0(CParams& P, unsigned char* lds, const int ph) {
    PHASE_PROLOGUE
            for (int row = gw; row < NT; row += NGW) {
                const float* src = row < NMAIN ? x + (size_t)row * DM : meta + (size_t)((row - NMAIN) & 15) * DM;
                f32x4 v[4];
#pragma unroll
                for (int j = 0; j < 4; ++j) { v[j] = ((const f32x4*)src)[lane + 64 * j]; ((f32x4*)(H + (size_t)row * DM))[lane + 64 * j] = v[j]; }
                store_norm_bf16(v, norm_mix, HN + (size_t)row * DM, lane);
            }
    for (int it = gw; it < CONV_DENSE_ITEMS; it += NGW) conv_dense_item(P, it, lane);
    for (int it = gw; it < CONV_MOE_ITEMS; it += NGW) conv_moe_item(P, 0, it, lane);
}

__device__ __forceinline__ void phase_1(CParams& P, unsigned char* lds, const int ph) {
    PHASE_PROLOGUE
    pg8::DenseOrder S; S.init(HN, WTIN, NTP, INCOLS, DM, G, bid);
    pg8::EpiProj E{Qb, Kb, Vb, REST};
    pg8::gemm_phase<pg8::EpiProj, pg8::DenseOrder, true, true>((PG8_LAS unsigned char*)lds, DM, S, E);
}

__device__ __forceinline__ void phase_2(CParams& P, unsigned char* lds, const int ph) {
    PHASE_PROLOGUE
            const int ntask = NB * 8 * LSEQ;
            for (int tk = gw; tk < ntask; tk += NGW) {
                const int b = tk / (8 * LSEQ), rem = tk % (8 * LSEQ), h = rem / LSEQ, p = rem % LSEQ;
                const int qrow = rowof(b, p);
                const float qv = bf2f(Qb[(size_t)qrow * 512 + h * 64 + lane]) * 0.125f;
        float* qs = (float*)lds + wave * 64;
        qs[lane] = qv;
        const int nkeys = p < NMETA ? NMETA : 144;
        int r = 0, c = 0, R0 = 0, C0 = 0;
        if (p >= NMETA) { const int t = p - NMETA; r = t >> 6; c = t & 63; R0 = min(max(r - 4, 0), 120); C0 = min(max(c - 8, 0), 48); }
        float sc[3];
#pragma unroll
        for (int rd = 0; rd < 3; ++rd) {
            const int j = lane + 64 * rd;
            int krow = NMAIN + b * NMETA + (j & 15); float bias = 0.f;
            if (j >= 16) { const int jj = j - 16, kr = R0 + (jj >> 4), kc = C0 + (jj & 15); krow = b * SEQ + kr * 64 + kc;
                if (j < nkeys) bias = rpb[(h * 15 + (kr - r + 7)) * 31 + (kc - c + 15)]; }
            if (j >= nkeys) krow = NMAIN + b * NMETA;
            const u32x4* kp = (const u32x4*)(Kb + (size_t)krow * 512 + h * 64);
            float s = 0.f;
#pragma unroll
            for (int ch = 0; ch < 8; ++ch) {
                const u32x4 kv = kp[ch];
                const f32x4 qa = *(const f32x4*)(qs + ch * 8), qb = *(const f32x4*)(qs + ch * 8 + 4);
                s += qa[0] * bflo(kv[0]) + qa[1] * bfhi(kv[0]) + qa[2] * bflo(kv[1]) + qa[3] * bfhi(kv[1])
                   + qb[0] * bflo(kv[2]) + qb[1] * bfhi(kv[2]) + qb[2] * bflo(kv[3]) + qb[3] * bfhi(kv[3]);
            }
            sc[rd] = (j < nkeys) ? s + bias : -1e30f;
                }
                const float m = wave_max(fmaxf(sc[0], fmaxf(sc[1], sc[2])));
                float e0 = __expf(sc[0] - m), e1 = __expf(sc[1] - m), e2 = __expf(sc[2] - m);
                if (lane >= nkeys) e0 = 0.f;
                if (lane + 64 >= nkeys) e1 = 0.f;
                if (lane + 128 >= nkeys) e2 = 0.f;
                const float inv = 1.f / wave_sum(e0 + e1 + e2);
                float o = 0.f;
                for (int j = 0; j < nkeys; ++j) {
                    int krow = NMAIN + b * NMETA + (j & 15);
                    if (j >= 16) { const int jj = j - 16; krow = b * SEQ + (R0 + (jj >> 4)) * 64 + C0 + (jj & 15); }
                    const float src = j < 64 ? e0 : (j < 128 ? e1 : e2);
                    const float pj = __int_as_float(__builtin_amdgcn_readlane(__float_as_int(src), j & 63));
                    o += pj * bf2f(Vb[(size_t)krow * 512 + h * 64 + lane]);
                }
                A2[(size_t)qrow * DM + h * 64 + lane] = (bf16_t)f2bf(o * inv);
            }
}


__device__ __forceinline__ void phase_3(CParams& P, unsigned char* lds, const int ph) {
    PHASE_PROLOGUE
            for (int tk = gw; tk < NT; tk += NGW) {
                const int b = tk / LSEQ, p = tk % LSEQ, row = rowof(b, p);
                const bool hp = p > 0, hn = p + 1 < LSEQ;
                const int rowp = hp ? rowof(b, p - 1) : row, rown = hn ? rowof(b, p + 1) : row;
#pragma unroll
                for (int j = 0; j < 7; ++j) {
                    const int c = 4 * lane + 256 * j;
                    const u32x2 vc = *(const u32x2*)(REST + (size_t)row * RESTC + c);
                    u32x2 vp = *(const u32x2*)(REST + (size_t)rowp * RESTC + c);
                    u32x2 vn = *(const u32x2*)(REST + (size_t)rown * RESTC + c);
                    if (!hp) { vp.x = 0; vp.y = 0; }
                    if (!hn) { vn.x = 0; vn.y = 0; }
                    const f32x4 m4 = *(const f32x4*)(mu + c);
                    float pc[4] = {bflo(vc.x), bfhi(vc.x), bflo(vc.y), bfhi(vc.y)};
                    float pp[4] = {bflo(vp.x), bfhi(vp.x), bflo(vp.y), bfhi(vp.y)};
                    float pn[4] = {bflo(vn.x), bfhi(vn.x), bflo(vn.y), bfhi(vn.y)};
                    float o[4];
#pragma unroll
                    for (int i = 0; i < 4; ++i) o[i] = pc[i] + m4[i] * (0.5f * (pp[i] + pn[i]) - pc[i]);
                    if (j == 6) {
                        if (lane < 16) { for (int i = 0; i < 4; ++i) o[i] = tanhf(o[i]); }
                        else if (lane >= 32) { for (int i = 0; i < 4; ++i) o[i] = sigmoidf_(o[i]); }
                    }
                    u32x2 ov; ov.x = pk2(o[0], o[1]); ov.y = pk2(o[2], o[3]);
                    bf16_t* dst = j < 2 ? Rr + (size_t)row * 512 + c : (j < 4 ? KR + (size_t)row * 512 + (c - 512) : (j < 6 ? VV + (size_t)row * 512 + (c - 1024) : LOW + (size_t)row * 256 + (c - 1536)));
                    *(u32x2*)dst = ov;
                }
            }
}


__device__ __forceinline__ void phase_4(CParams& P, unsigned char* lds, const int ph) {
    PHASE_PROLOGUE
            const int nrt = (NT + 127) / 128;
            const int nunits = nrt * 4 * 5;
            for (int u = bid; u < nunits; u += G) {
                const int which = u / (nrt * 4), rem = u % (nrt * 4), rt = rem / 4, ct = rem % 4;
                f32x4 acc[4][2];
                const int koff = which < 2 ? 0 : (which < 4 ? 64 : 128), KK_ = which < 4 ? 64 : 128;
                const float* Bsrc = which < 2 ? w_up + (size_t)which * 64 * 512 : (which < 4 ? a_up + (size_t)(which - 2) * 64 * 512 : g_up);
                gemm_tile(lds, KK_, 512,
                          [&](int r) { int row = rt * 128 + r; if (row >= NT) row = NT - 1; return LOW + (size_t)row * 256 + koff; },
                          [&](int n) { return Bsrc + ct * 128 + n; }, acc);
                ACC_FOREACH(acc, { const int row = rt * 128 + rl, col = ct * 128 + cl; if (row < NT) {
                    if (which < 2) { const float wl = w0[which * 512 + col] + val; Wd[((size_t)which * NT + row) * 512 + col] = __expf(-0.6065306597f * sigmoidf_(wl)); }
                    else if (which < 4) { const int d = which - 2; AA[((size_t)d * NT + row) * 512 + col] = (bf16_t)f2bf(sigmoidf_(a0[d * 512 + col] + val)); }
                    else Gg[(size_t)row * 512 + col] = (bf16_t)f2bf(val); } });
            }
}


__device__ __forceinline__ void phase_5(CParams& P, unsigned char* lds, const int ph) {
    PHASE_PROLOGUE
            for (int row = gw; row < NT; row += NGW) {
                const int c0 = lane * 8;
                const u32x4 krv = *(const u32x4*)(KR + (size_t)row * 512 + c0);
                const u32x4 rv = *(const u32x4*)(Rr + (size_t)row * 512 + c0);
                float kr[8], rr[8], kkv[8];
#pragma unroll
                for (int i = 0; i < 4; ++i) { kr[2 * i] = bflo(krv[i]); kr[2 * i + 1] = bfhi(krv[i]); rr[2 * i] = bflo(rv[i]); rr[2 * i + 1] = bfhi(rv[i]); }
                float ss = 0.f;
#pragma unroll
                for (int i = 0; i < 8; ++i) { kkv[i] = kr[i] * k_k[c0 + i]; ss += kkv[i] * kkv[i]; }
                ss += __shfl_xor(ss, 1); ss += __shfl_xor(ss, 2); ss += __shfl_xor(ss, 4);
                const float inv = 1.f / fmaxf(sqrtf(ss), 1e-12f);
#pragma unroll
                for (int i = 0; i < 8; ++i) kkv[i] *= inv;
                u32x4 o; o.x = pk2(kkv[0], kkv[1]); o.y = pk2(kkv[2], kkv[3]); o.z = pk2(kkv[4], kkv[5]); o.w = pk2(kkv[6], kkv[7]);
                *(u32x4*)(KK + (size_t)row * 512 + c0) = o;
                float bsum = 0.f;
#pragma unroll
                for (int d = 0; d < 2; ++d) {
                    const u32x4 av = *(const u32x4*)(AA + ((size_t)d * NT + row) * 512 + c0);
                    float a[8], kka[8], kd[8];
#pragma unroll
                    for (int i = 0; i < 4; ++i) { a[2 * i] = bflo(av[i]); a[2 * i + 1] = bfhi(av[i]); }
#pragma unroll
                    for (int i = 0; i < 8; ++i) { kka[i] = kkv[i] * a[i]; kd[i] = kr[i] * (1.f + (a[i] - 1.f) * k_a[c0 + i]); bsum += rr[i] * kd[i] * r_k[c0 + i]; }
                    u32x4 o1; o1.x = pk2(kka[0], kka[1]); o1.y = pk2(kka[2], kka[3]); o1.z = pk2(kka[4], kka[5]); o1.w = pk2(kka[6], kka[7]);
                    *(u32x4*)(KKA + ((size_t)d * NT + row) * 512 + c0) = o1;
                    u32x4 o2; o2.x = pk2(kd[0], kd[1]); o2.y = pk2(kd[2], kd[3]); o2.z = pk2(kd[4], kd[5]); o2.w = pk2(kd[6], kd[7]);
                    *(u32x4*)(KD + ((size_t)d * NT + row) * 512 + c0) = o2;
                }
                bsum += __shfl_xor(bsum, 1); bsum += __shfl_xor(bsum, 2); bsum += __shfl_xor(bsum, 4);
                if ((lane & 7) == 0) BC[(size_t)row * 8 + (lane >> 3)] = bsum;
            }
}


struct ScanIn { f32x4 w; u32x2 kk, ka, kd, r; unsigned short vv; };
__device__ __forceinline__ void phase_6(CParams& P, unsigned char* lds, const int ph) {
    PHASE_PROLOGUE
    constexpr int U = 8;
    for (int cw = bid * 2 + wave; wave < 2 && cw < 512; cw += G * 2) {
        const int chain = cw >> 4, rg = cw & 15, d = chain >> 4, b = (chain >> 3) & 1, h = chain & 7;
        const int rr_ = lane >> 4, kq = lane & 15, vi = rg * 4 + rr_;
        float s0 = 0.f, s1 = 0.f, s2 = 0.f, s3 = 0.f;
        const float* Wp = Wd + (size_t)d * NT * 512 + h * 64 + 4 * kq;
        const bf16_t* KKp = KK + h * 64 + 4 * kq;
        const bf16_t* KKAp = KKA + (size_t)d * NT * 512 + h * 64 + 4 * kq;
        const bf16_t* KDp = KD + (size_t)d * NT * 512 + h * 64 + 4 * kq;
        const bf16_t* Rp = Rr + h * 64 + 4 * kq;
        const bf16_t* Vp = VV + h * 64 + vi;
        bf16_t* Yp = YFB + (size_t)d * NT * 512 + h * 64 + vi;
        ScanIn nxt[U];
#define SCAN_LOAD(dst, s_) do { const int p_ = d ? LSEQ - 1 - (s_) : (s_); const size_t o_ = (size_t)rowof(b, p_) * 512; \
            dst.w = *(const f32x4*)(Wp + o_); dst.kk = *(const u32x2*)(KKp + o_); dst.ka = *(const u32x2*)(KKAp + o_); dst.kd = *(const u32x2*)(KDp + o_); dst.r = *(const u32x2*)(Rp + o_); dst.vv = Vp[o_]; } while (0)
#pragma unroll
        for (int q = 0; q < U; ++q) SCAN_LOAD(nxt[q], q);
        for (int s = 0; s < LSEQ; s += U) {
            ScanIn cur[U];
#pragma unroll
            for (int q = 0; q < U; ++q) cur[q] = nxt[q];
            if (s + U < LSEQ) {
#pragma unroll
                for (int q = 0; q < U; ++q) SCAN_LOAD(nxt[q], s + U + q);
            }
#pragma unroll
            for (int q = 0; q < U; ++q) {
                const ScanIn& c = cur[q];
                const float vv = bf2f(c.vv);
                float dot = s0 * bflo(c.kk.x) + s1 * bfhi(c.kk.x) + s2 * bflo(c.kk.y) + s3 * bfhi(c.kk.y);
                const float t0 = s0 * c.w[0] + vv * bflo(c.kd.x), t1 = s1 * c.w[1] + vv * bfhi(c.kd.x), t2 = s2 * c.w[2] + vv * bflo(c.kd.y), t3 = s3 * c.w[3] + vv * bfhi(c.kd.y);
                dot = row16_sum(dot);
                s0 = t0 - dot * bflo(c.ka.x); s1 = t1 - dot * bfhi(c.ka.x); s2 = t2 - dot * bflo(c.ka.y); s3 = t3 - dot * bfhi(c.ka.y);
                float y = s0 * bflo(c.r.x) + s1 * bfhi(c.r.x) + s2 * bflo(c.r.y) + s3 * bfhi(c.r.y);
                y = row16_sum(y);
                const int p_ = d ? LSEQ - 1 - (s + q) : (s + q);
                if (kq == 0) Yp[(size_t)rowof(b, p_) * 512] = (bf16_t)f2bf(y);
            }
        }
#undef SCAN_LOAD
    }
}

__device__ __forceinline__ void phase_7(CParams& P, unsigned char* lds, const int ph) {
    PHASE_PROLOGUE
            for (int row = gw; row < NT; row += NGW) {
                const int c0 = lane * 8;
                const u32x4 yf = *(const u32x4*)(YFB + (size_t)row * 512 + c0);
                const u32x4 yb = *(const u32x4*)(YFB + ((size_t)NT + row) * 512 + c0);
                const u32x4 vv = *(const u32x4*)(VV + (size_t)row * 512 + c0);
                const u32x4 gg = *(const u32x4*)(Gg + (size_t)row * 512 + c0);
                float y[8], v[8], g[8];
#pragma unroll
                for (int i = 0; i < 4; ++i) { y[2 * i] = bflo(yf[i]) + bflo(yb[i]); y[2 * i + 1] = bfhi(yf[i]) + bfhi(yb[i]); v[2 * i] = bflo(vv[i]); v[2 * i + 1] = bfhi(vv[i]); g[2 * i] = bflo(gg[i]); g[2 * i + 1] = bfhi(gg[i]); }
                float sm = 0.f;
#pragma unroll
                for (int i = 0; i < 8; ++i) sm += y[i];
                sm += __shfl_xor(sm, 1); sm += __shfl_xor(sm, 2); sm += __shfl_xor(sm, 4);
                const float mean = sm * (1.f / 64.f);
                float vr = 0.f;
#pragma unroll
                for (int i = 0; i < 8; ++i) { const float dlt = y[i] - mean; vr += dlt * dlt; }
                vr += __shfl_xor(vr, 1); vr += __shfl_xor(vr, 2); vr += __shfl_xor(vr, 4);
                const float rstd = rsqrtf(vr * (1.f / 64.f) + 64e-5f);
                const float bc = BC[(size_t)row * 8 + (lane >> 3)];
                float o[8];
#pragma unroll
                for (int i = 0; i < 8; ++i) o[i] = ((y[i] - mean) * rstd * lnx_g[c0 + i] + lnx_b[c0 + i] + bc * v[i]) * g[i];
                u32x4 ov; ov.x = pk2(o[0], o[1]); ov.y = pk2(o[2], o[3]); ov.z = pk2(o[4], o[5]); ov.w = pk2(o[6], o[7]);
                *(u32x4*)(A2 + (size_t)row * DM + 512 + c0) = ov;
            }
}


__device__ __forceinline__ void phase_8(CParams& P, unsigned char* lds, const int ph) {
    PHASE_PROLOGUE
    if (gw < 64) meta_gemm<0>(A2 + (size_t)NMAIN * DM, WTOUT, H + (size_t)NMAIN * DM, gw, lane);
    pg8::DenseOrder S; S.init(A2, WTOUT, NMAIN, DM, DM, G, bid);
    pg8::EpiResidual E{H};
    pg8::gemm_phase<pg8::EpiResidual, pg8::DenseOrder, true, true>((PG8_LAS unsigned char*)lds, DM, S, E);
}

__device__ __forceinline__ void phase_9(CParams& P, unsigned char* lds, const int ph) {
    PHASE_PROLOGUE
            const int l = ph == 9 ? 0 : 1;
                    unsigned* cnt = CTL + CW_CNT(l);
            const float* wg = moe_wg + (size_t)l * DM * 4; const float* bg = moe_bg + l * 4;
            for (int row = gw; row < NT; row += NGW) {
                f32x4 v[4]; float ss = 0.f;
#pragma unroll
                for (int j = 0; j < 4; ++j) { v[j] = ((const f32x4*)(H + (size_t)row * DM))[lane + 64 * j]; ss += v[j][0] * v[j][0] + v[j][1] * v[j][1] + v[j][2] * v[j][2] + v[j][3] * v[j][3]; }
                ss = wave_sum(ss);
                const float rstd = rsqrtf(ss * (1.f / DM) + 1e-6f);
                float lg[4] = {0.f, 0.f, 0.f, 0.f};
#pragma unroll
                for (int j = 0; j < 4; ++j) {
                    const f32x4 g = ((const f32x4*)(norm_ffn + l * DM))[lane + 64 * j];
#pragma unroll
                    for (int i = 0; i < 4; ++i) v[j][i] = v[j][i] * rstd * g[i];
                    u32x2 o; o.x = pk2(v[j][0], v[j][1]); o.y = pk2(v[j][2], v[j][3]);
                    ((u32x2*)(HN + (size_t)row * DM))[lane + 64 * j] = o;
#pragma unroll
                    for (int i = 0; i < 4; ++i) { const f32x4 w = *(const f32x4*)(wg + (size_t)(4 * (lane + 64 * j) + i) * 4);
                        lg[0] += v[j][i] * w[0]; lg[1] += v[j][i] * w[1]; lg[2] += v[j][i] * w[2]; lg[3] += v[j][i] * w[3]; }
                }
#pragma unroll
                for (int q = 0; q < 4; ++q) lg[q] = wave_sum(lg[q]) + bg[q];
                int grp = 0; float mx = lg[0];
#pragma unroll
                for (int q = 1; q < 4; ++q) if (lg[q] > mx) { mx = lg[q]; grp = q; }
                float den = 0.f;
#pragma unroll
                for (int q = 0; q < 4; ++q) den += __expf(lg[q] - mx);
                const float pgrp = 1.f / den;
                const float* we = moe_we + ((size_t)(l * 4 + grp) * DM) * 8;
                float le[8] = {0.f, 0.f, 0.f, 0.f, 0.f, 0.f, 0.f, 0.f};
#pragma unroll
                for (int j = 0; j < 4; ++j)
#pragma unroll
                    for (int i = 0; i < 4; ++i) { const float* wr_ = we + (size_t)(4 * (lane + 64 * j) + i) * 8; const f32x4 wa = *(const f32x4*)wr_, wb = *(const f32x4*)(wr_ + 4);
                        le[0] += v[j][i] * wa[0]; le[1] += v[j][i] * wa[1]; le[2] += v[j][i] * wa[2]; le[3] += v[j][i] * wa[3];
                        le[4] += v[j][i] * wb[0]; le[5] += v[j][i] * wb[1]; le[6] += v[j][i] * wb[2]; le[7] += v[j][i] * wb[3]; }
#pragma unroll
                for (int q = 0; q < 8; ++q) le[q] = wave_sum(le[q]) + moe_be[(l * 4 + grp) * 8 + q];
                int i1 = 0; float m1 = le[0];
#pragma unroll
                for (int q = 1; q < 8; ++q) if (le[q] > m1) { m1 = le[q]; i1 = q; }
                int i2 = -1; float m2 = -3.0e38f;
#pragma unroll
                for (int q = 0; q < 8; ++q) if (q != i1 && le[q] > m2) { m2 = le[q]; i2 = q; }
                const float e2 = __expf(m2 - m1);
                const float g1 = pgrp / (1.f + e2), g2 = pgrp * e2 / (1.f + e2);
                if (lane == 0) {
                    const int ea = grp * 8 + i1, eb = grp * 8 + i2;
                    const unsigned pa = atomicAdd(cnt + ea, 1u), pb = atomicAdd(cnt + eb, 1u);
                    EID[row * 2] = ea; EID[row * 2 + 1] = eb; POS[row * 2] = (int)pa; POS[row * 2 + 1] = (int)pb;
                    GATE[row * 2] = g1; GATE[row * 2 + 1] = g2;
                }
            }
}


__device__ __forceinline__ void phase_10(CParams& P, unsigned char* lds, const int ph) {
    PHASE_PROLOGUE
    const int l = ph == 10 ? 0 : 1;
    int* ps = (int*)(lds + LDS_TAB);
    if (tid == 0) { int acc_ = 0; for (int e = 0; e < NEXP; ++e) { ps[e] = acc_; const int c = (int)CTL[CW_CNT(l) + e]; acc_ += (c + MOE_RT - 1) / MOE_RT * MOE_RT; } ps[NEXP] = acc_; }
    __syncthreads();
    for (int row = gw; row < NT; row += NGW) {
        const u32x4 v0 = ((const u32x4*)(HN + (size_t)row * DM))[lane], v1 = ((const u32x4*)(HN + (size_t)row * DM))[lane + 64];
#pragma unroll
        for (int k = 0; k < 2; ++k) {
            const int dest = ps[EID[row * 2 + k]] + POS[row * 2 + k];
            if (lane == 0) DEST[row * 2 + k] = dest;
            ((u32x4*)(XB + (size_t)dest * DM))[lane] = v0; ((u32x4*)(XB + (size_t)dest * DM))[lane + 64] = v1;
        }
    }
    __syncthreads();
}

__device__ __forceinline__ void phase_11(CParams& P, unsigned char* lds, const int ph) {
    PHASE_PROLOGUE
    const int l = ph == 11 ? 0 : 1;
    int* et = (int*)(lds + LDS_TAB);
    if (tid == 0) { int acc_ = 0; for (int e = 0; e < NEXP; ++e) { const int c = (int)CTL[CW_CNT(l) + e], n = (c + MOE_RT - 1) / MOE_RT; for (int q = 0; q < n; ++q) et[1 + acc_ + q] = e; acc_ += n; } et[0] = acc_; }
    __syncthreads();
    pg8::MoeOrder S{et + 1, et[0], vcu, (const char*)XB, (const char*)WT13, 256u * DM * 2u, 256u * DM * 2u, (unsigned)DM * DM * 2u};
    pg8::EpiSwiglu E{HB};
    pg8::gemm_phase<pg8::EpiSwiglu, pg8::MoeOrder, true, true>((PG8_LAS unsigned char*)lds, DM, S, E);
    __syncthreads();
}

__device__ __forceinline__ void phase_12(CParams& P, unsigned char* lds, const int ph) {
    PHASE_PROLOGUE
    const int l = ph == 12 ? 0 : 1;
    int* et = (int*)(lds + LDS_TAB);
    if (tid == 0) { int acc_ = 0; for (int e = 0; e < NEXP; ++e) { const int c = (int)CTL[CW_CNT(l) + e], n = (c + MOE_RT - 1) / MOE_RT; for (int q = 0; q < n; ++q) et[1 + acc_ + q] = e; acc_ += n; } et[0] = acc_; }
    __syncthreads();
    pg8::MoeOrder S{et + 1, et[0], vcu, (const char*)HB, (const char*)WT2, 256u * DFF * 2u, 256u * DFF * 2u, (unsigned)DM * DFF * 2u};
    pg8::EpiBf16Plain E{YB, DM};
    pg8::gemm_phase<pg8::EpiBf16Plain, pg8::MoeOrder, true, true>((PG8_LAS unsigned char*)lds, DFF, S, E);
    __syncthreads();
}

__device__ __forceinline__ void phase_13(CParams& P, unsigned char* lds, const int ph) {
    PHASE_PROLOGUE
            const bool fin = ph == 21;
            for (int row = gw; row < NT; row += NGW) {
                const int d0 = DEST[row * 2], d1 = DEST[row * 2 + 1];
                const float g0 = GATE[row * 2], g1 = GATE[row * 2 + 1];
                f32x4 v[4];
#pragma unroll
                for (int j = 0; j < 4; ++j) {
                    v[j] = ((const f32x4*)(H + (size_t)row * DM))[lane + 64 * j];
                    const u32x2 ya = ((const u32x2*)(YB + (size_t)d0 * DM))[lane + 64 * j];
                    const u32x2 yb = ((const u32x2*)(YB + (size_t)d1 * DM))[lane + 64 * j];
                    v[j][0] += g0 * bflo(ya.x) + g1 * bflo(yb.x); v[j][1] += g0 * bfhi(ya.x) + g1 * bfhi(yb.x);
                    v[j][2] += g0 * bflo(ya.y) + g1 * bflo(yb.y); v[j][3] += g0 * bfhi(ya.y) + g1 * bfhi(yb.y);
                }
                if (!fin) {
#pragma unroll
                    for (int j = 0; j < 4; ++j) ((f32x4*)(H + (size_t)row * DM))[lane + 64 * j] = v[j];
                    store_norm_bf16(v, norm_mix + DM, HN + (size_t)row * DM, lane);
                } else if (row < NMAIN) {
                    float ss = 0.f;
#pragma unroll
                    for (int j = 0; j < 4; ++j) ss += v[j][0] * v[j][0] + v[j][1] * v[j][1] + v[j][2] * v[j][2] + v[j][3] * v[j][3];
                    ss = wave_sum(ss);
                    const float rstd = rsqrtf(ss * (1.f / DM) + 1e-6f);
#pragma unroll
                    for (int j = 0; j < 4; ++j) { const f32x4 g = ((const f32x4*)norm_final)[lane + 64 * j]; f32x4 o;
                        o[0] = v[j][0] * rstd * g[0]; o[1] = v[j][1] * rstd * g[1]; o[2] = v[j][2] * rstd * g[2]; o[3] = v[j][3] * rstd * g[3];
                        ((f32x4*)(P.out + (size_t)row * DM))[lane + 64 * j] = o; }
                }
            }
    if (!fin) { for (int it = gw; it < CONV_MOE_ITEMS; it += NGW) conv_moe_item(P, 1, it, lane); }
}

__device__ __forceinline__ void phase_14(CParams& P, unsigned char* lds, const int ph) {
    PHASE_PROLOGUE
            const bool outp = ph == 16;
            const int nunits = 2 * NB * 64 * S5NC;
            for (int u = gw; u < nunits; u += NGW) {
                const int c = u % S5NC, dbg = u / S5NC, g = dbg & 63, b = (dbg >> 6) & 1, d = dbg >> 7;
                const int p = lane;
                const float step = __expf(s5_ls[d * 64 + g]);
                const float lr = s5_lre[(d * 64 + g) * 64 + p], li = s5_lim[(d * 64 + g) * 64 + p];
                const float mag = expf(lr * step);
                const float abr = mag * cosf(li * step), abi = mag * sinf(li * step);
                const float den = lr * lr + li * li;
                const float zr = ((abr - 1.f) * lr + abi * li) / den, zi = (abi * lr - (abr - 1.f) * li) / den;
                float bbr[16], bbi[16];
#pragma unroll
                for (int q = 0; q < 4; ++q) {
                    const f32x4 br = *(const f32x4*)(s5_b_re + ((size_t)(g * 64 + p)) * 16 + 4 * q), bi = *(const f32x4*)(s5_b_im + ((size_t)(g * 64 + p)) * 16 + 4 * q);
#pragma unroll
                    for (int i = 0; i < 4; ++i) { bbr[4 * q + i] = zr * br[i] - zi * bi[i]; bbi[4 * q + i] = zr * bi[i] + zi * br[i]; }
                }
                float sr = 0.f, si = 0.f;
                if (outp) { const float* cp = CARRY + (((size_t)dbg * S5NC + c) * 64 + p) * 2; sr = cp[0]; si = cp[1]; }
                float cre[16], cim[16];
                if (outp) {
#pragma unroll
                    for (int i = 0; i < 16; ++i) { cre[i] = s5_c_re[((size_t)(d * 64 + g) * 16 + i) * 64 + p]; cim[i] = s5_c_im[((size_t)(d * 64 + g) * 16 + i) * 64 + p]; }
                }
                for (int tt = 0; tt < S5TC; ++tt) {
                    const int sidx = c * S5TC + tt, pos = d ? LSEQ - 1 - sidx : sidx, row = rowof(b, pos);
                    const u32x4 ua = *(const u32x4*)(HN + (size_t)row * DM + g * 16), ub = *(const u32x4*)(HN + (size_t)row * DM + g * 16 + 8);
                    float uu[16];
#pragma unroll
                    for (int i = 0; i < 4; ++i) { uu[2 * i] = bflo(ua[i]); uu[2 * i + 1] = bfhi(ua[i]); uu[8 + 2 * i] = bflo(ub[i]); uu[8 + 2 * i + 1] = bfhi(ub[i]); }
                    float bur = 0.f, bui = 0.f;
#pragma unroll
                    for (int i = 0; i < 16; ++i) { bur += bbr[i] * uu[i]; bui += bbi[i] * uu[i]; }
                    const float nr = abr * sr - abi * si + bur, ni = abr * si + abi * sr + bui;
                    sr = nr; si = ni;
                    if (outp) {
                        float mine = 0.f;
#pragma unroll
                        for (int i = 0; i < 16; ++i) { const float yv = wave_sum(cre[i] * sr - cim[i] * si); if (lane == i) mine = yv; }
                        if (lane < 16) YS[((size_t)d * NT + row) * DM + g * 16 + lane] = mine;
                    }
                }
                if (!outp) { float* ep = ENDS + (((size_t)dbg * S5NC + c) * 64 + p) * 2; ep[0] = sr; ep[1] = si; }
            }
}


__device__ __forceinline__ void phase_15(CParams& P, unsigned char* lds, const int ph) {
    PHASE_PROLOGUE
            for (int i = bid * 512 + tid; i < 2 * NB * 64 * 64; i += G * 512) {
                const int p = i & 63, dbg = i >> 6, g = dbg & 63, d = dbg >> 7;
                const float step = __expf(s5_ls[d * 64 + g]);
                const float lr = s5_lre[(d * 64 + g) * 64 + p], li = s5_lim[(d * 64 + g) * 64 + p];
                const float mag = expf(lr * step * (float)S5TC);
                const float ang = li * step;
                float pr = 1.f, pi = 0.f; const float cr = cosf(ang), ci = sinf(ang);
                for (int q = 0; q < S5TC; ++q) { const float t = pr * cr - pi * ci; pi = pr * ci + pi * cr; pr = t; }
                const float ar = mag * pr, ai = mag * pi;
                float yr = 0.f, yi = 0.f;
                for (int c = 0; c < S5NC; ++c) {
                    const size_t o = (((size_t)dbg * S5NC + c) * 64 + p) * 2;
                    CARRY[o] = yr; CARRY[o + 1] = yi;
                    const float er = ENDS[o], ei = ENDS[o + 1];
                    const float t = ar * yr - ai * yi + er; yi = ar * yi + ai * yr + ei; yr = t;
                }
            }
}


__device__ __forceinline__ void phase_22(CParams& P, unsigned char* lds, const int ph) {
    PHASE_PROLOGUE
            for (size_t i = (size_t)bid * 512 + tid; i < (size_t)NT * DM / 4; i += (size_t)G * 512) {
                const f32x4 y0 = ((const f32x4*)YS)[i], y1 = ((const f32x4*)(YS + (size_t)NT * DM))[i];
                const int col = (int)((i * 4) & (DM - 1));
                const f32x4 dd = *(const f32x4*)(s5_d + col);
                const u32x2 uu = ((const u32x2*)HN)[i];
                float u4[4] = {bflo(uu.x), bfhi(uu.x), bflo(uu.y), bfhi(uu.y)};
                float o[4];
#pragma unroll
                for (int q = 0; q < 4; ++q) { const float yv = y0[q] + y1[q] + dd[q] * u4[q];
                    o[q] = 0.5f * yv * (1.f + tanhf(0.7978845608f * (yv + 0.044715f * yv * yv * yv))); }
                u32x2 ov; ov.x = pk2(o[0], o[1]); ov.y = pk2(o[2], o[3]);
                ((u32x2*)A2)[i] = ov;
            }
}


__device__ __forceinline__ void phase_23(CParams& P, unsigned char* lds, const int ph) {
    PHASE_PROLOGUE
    if (gw < 64) meta_gemm<1>(A2 + (size_t)NMAIN * DM, WTGLU, H + (size_t)NMAIN * DM, gw, lane);
    pg8::DenseOrder S; S.init(A2, WTGLU, NMAIN, 2 * DM, DM, G, bid);
    pg8::EpiGlu E{H};
    pg8::gemm_phase<pg8::EpiGlu, pg8::DenseOrder, true, true>((PG8_LAS unsigned char*)lds, DM, S, E);
}
#define LAS __attribute__((address_space(3)))
#define CW_BAR 4096
#define XB_TMO      128
#define XB_XCNT(j)  (256  + 64 * (j))
#define XB_XSUB(j)  (1280 + 64 * (j))
#define XB_XGEN(j)  (2304 + 64 * (j))
#define XB_TOP      3328
#define XB_TOPGEN   3392
#define XCD_BAR_WORDS 3456
#define XB_SPIN_CAP (1u << 22)
__device__ __forceinline__ unsigned xb_ld(unsigned* p)              { return __hip_atomic_load(p, __ATOMIC_RELAXED, __HIP_MEMORY_SCOPE_AGENT); }
__device__ __forceinline__ unsigned xb_add(unsigned* p, unsigned v) { return __hip_atomic_fetch_add(p, v, __ATOMIC_RELAXED, __HIP_MEMORY_SCOPE_AGENT); }
__device__ __forceinline__ unsigned xb_xcc_id() { return (unsigned)__builtin_amdgcn_s_getreg((3 << 11) | 20) & 0xFu; }
#define XB_SPIN(cond, bar) do { unsigned _sp = 0; while (cond) { __builtin_amdgcn_s_sleep(1); \
    if ((++_sp & 255u) == 0u) { if (xb_ld(&(bar)[XB_TMO])) break; if (_sp > XB_SPIN_CAP) { atomicAdd(&(bar)[XB_TMO], 1u); break; } } } } while (0)
struct XcdBarrier { unsigned* bar; unsigned x; volatile LAS unsigned* st; };
__device__ __forceinline__ XcdBarrier xcd_barrier_post(unsigned* bar, volatile LAS unsigned* st) {
    XcdBarrier b; b.bar = bar; b.x = xb_xcc_id(); b.st = st;
    if (threadIdx.x == 0) (void)xb_add(&bar[XB_XCNT(b.x)], 1u);
    return b;
}
__device__ __forceinline__ void xcd_barrier_complete(unsigned* bar, unsigned x, unsigned& nloc, unsigned& nx) {
    const unsigned G = GRID;
    unsigned sum, cnt, mine, sp = 0u;
    for (;;) {
        sum = 0u; cnt = 0u; mine = 0u;
#pragma unroll
        for (unsigned j = 0; j < 16; ++j) { const unsigned c = xb_ld(&bar[XB_XCNT(j)]); sum += c; cnt += (c > 0u) ? 1u : 0u; mine = (j == x) ? c : mine; }
        if (sum == G) break;
        __builtin_amdgcn_s_sleep(1);
        if ((++sp & 255u) == 0u) { if (xb_ld(&bar[XB_TMO])) break; if (sp > XB_SPIN_CAP) { atomicAdd(&bar[XB_TMO], 1u); break; } }
    }
    nloc = mine > 0u ? mine : 1u; nx = cnt > 0u ? cnt : 1u;
}
__device__ __forceinline__ void xcd_barrier(const XcdBarrier& b) {
    asm volatile("s_waitcnt vmcnt(0)" ::: "memory");
    __syncthreads();
    if (threadIdx.x == 0) {
        unsigned* bar = b.bar;
        __builtin_amdgcn_s_waitcnt(0);
        unsigned nloc = b.st[0], nx = b.st[1];
        if (nloc == 0u) { xcd_barrier_complete(bar, b.x, nloc, nx); b.st[0] = nloc; b.st[1] = nx; }
        const unsigned old = xb_add(&bar[XB_XSUB(b.x)], 1u);
        const unsigned gen = old / nloc;
        if (old + 1u == (gen + 1u) * nloc) {
            __builtin_amdgcn_fence(__ATOMIC_RELEASE, "agent");
            asm volatile("s_waitcnt vmcnt(0)" ::: "memory");
            const unsigned og = xb_add(&bar[XB_TOP], 1u);
            const unsigned tg = og / nx;
            if (og + 1u == (tg + 1u) * nx) xb_add(&bar[XB_TOPGEN], 1u);
            else XB_SPIN(xb_ld(&bar[XB_TOPGEN]) == tg, bar);
            __builtin_amdgcn_fence(__ATOMIC_ACQUIRE, "agent");
            xb_add(&bar[XB_XGEN(b.x)], 1u);
            asm volatile("s_waitcnt vmcnt(0)" ::: "memory");
        } else {
            XB_SPIN(xb_ld(&bar[XB_XGEN(b.x)]) == gen, bar);
            __builtin_amdgcn_fence(__ATOMIC_ACQUIRE, "agent");
            asm volatile("s_waitcnt vmcnt(0)" ::: "memory");
        }
    }
    __syncthreads();
}


__global__ void __launch_bounds__(512, 2) mega(Params P_) {
    extern __shared__ __attribute__((aligned(16))) unsigned char lds[];
    volatile LAS unsigned* st = (volatile LAS unsigned*)(LAS unsigned char*)(lds + LDS_BARST);
    if (threadIdx.x < 16) st[threadIdx.x] = 0u;
    __syncthreads();
    CParams* pp = (CParams*)__builtin_amdgcn_kernarg_segment_ptr();
    (void)xcd_barrier_post((unsigned*)(pp->ws + WS_CTL) + CW_BAR, st);
#define GB do { XcdBarrier bar_; bar_.bar = (unsigned*)(pp->ws + WS_CTL) + CW_BAR; bar_.x = xb_xcc_id(); bar_.st = (volatile LAS unsigned*)(LAS unsigned char*)(lds + LDS_BARST); xcd_barrier(bar_); asm volatile("" : "+s"(pp)); } while (0)
#define P (*pp)
    asm volatile("" : "+s"(pp));
    phase_0(P, lds, 0); GB;
#if defined(PROBE_DUP) && PROBE_DUP == 0
    GB; phase_0(P, lds, 0); GB;
#endif
    phase_1(P, lds, 1); GB;
#if defined(PROBE_DUP) && PROBE_DUP == 1
    GB; phase_1(P, lds, 1); GB;
#endif
    phase_2(P, lds, 2); asm volatile("" : "+s"(pp));
#if defined(PROBE_DUP) && PROBE_DUP == 2
    GB; phase_2(P, lds, 2); GB;
#endif
    phase_3(P, lds, 3); GB;
#if defined(PROBE_DUP) && PROBE_DUP == 3
    GB; phase_3(P, lds, 3); GB;
#endif
    phase_4(P, lds, 4); GB;
#if defined(PROBE_DUP) && PROBE_DUP == 4
    GB; phase_4(P, lds, 4); GB;
#endif
    phase_5(P, lds, 5); GB;
#if defined(PROBE_DUP) && PROBE_DUP == 5
    GB; phase_5(P, lds, 5); GB;
#endif
    phase_6(P, lds, 6); GB;
#if defined(PROBE_DUP) && PROBE_DUP == 6
    GB; phase_6(P, lds, 6); GB;
#endif
    phase_7(P, lds, 7); GB;
#if defined(PROBE_DUP) && PROBE_DUP == 7
    GB; phase_7(P, lds, 7); GB;
#endif
    phase_8(P, lds, 8); GB;
#if defined(PROBE_DUP) && PROBE_DUP == 8
    GB; phase_8(P, lds, 8); GB;
#endif
    phase_9(P, lds, 9); GB;
#if defined(PROBE_DUP) && PROBE_DUP == 9
    GB; phase_9(P, lds, 9); GB;
#endif
    phase_10(P, lds, 10); GB;
#if defined(PROBE_DUP) && PROBE_DUP == 10
    GB; phase_10(P, lds, 10); GB;
#endif
    phase_11(P, lds, 11); GB;
#if defined(PROBE_DUP) && PROBE_DUP == 11
    GB; phase_11(P, lds, 11); GB;
#endif
    phase_12(P, lds, 12); GB;
#if defined(PROBE_DUP) && PROBE_DUP == 12
    GB; phase_12(P, lds, 12); GB;
#endif
    phase_13(P, lds, 13); GB;
#if defined(PROBE_DUP) && PROBE_DUP == 13
    GB; phase_13(P, lds, 13); GB;
#endif
    phase_14(P, lds, 14); GB;
#if defined(PROBE_DUP) && PROBE_DUP == 14
    GB; phase_14(P, lds, 14); GB;
#endif
    phase_15(P, lds, 15); GB;
#if defined(PROBE_DUP) && PROBE_DUP == 15
    GB; phase_15(P, lds, 15); GB;
#endif
    phase_14(P, lds, 16); GB;
#if defined(PROBE_DUP) && PROBE_DUP == 16
    GB; phase_14(P, lds, 16); GB;
#endif
    phase_22(P, lds, 22); GB;
#if defined(PROBE_DUP) && PROBE_DUP == 22
    GB; phase_22(P, lds, 22); GB;
#endif
    phase_23(P, lds, 23); GB;
#if defined(PROBE_DUP) && PROBE_DUP == 23
    GB; phase_23(P, lds, 23); GB;
#endif
    phase_9(P, lds, 17); GB;
#if defined(PROBE_DUP) && PROBE_DUP == 17
    GB; phase_9(P, lds, 17); GB;
#endif
    phase_10(P, lds, 18); GB;
#if defined(PROBE_DUP) && PROBE_DUP == 18
    GB; phase_10(P, lds, 18); GB;
#endif
    phase_11(P, lds, 19); GB;
#if defined(PROBE_DUP) && PROBE_DUP == 19
    GB; phase_11(P, lds, 19); GB;
#endif
    phase_12(P, lds, 20); GB;
#if defined(PROBE_DUP) && PROBE_DUP == 20
    GB; phase_12(P, lds, 20); GB;
#endif
    phase_13(P, lds, 21);
#if defined(PROBE_DUP) && PROBE_DUP == 21
    GB; phase_13(P, lds, 21); GB;
#endif
#undef P
#undef GB
}

extern "C" void kernel_launch(void* const* d_in, const int* in_sizes, int n_in, void* d_out, int out_size, void* d_ws, size_t ws_size, hipStream_t stream) {
    static int ready = 0;
    if (!ready) {
        if (n_in != 35 || ws_size < WS_TOTAL) { fprintf(stderr, "kernel_launch: unexpected n_in %d or ws_size %zu (need %zu)\n", n_in, ws_size, (size_t)WS_TOTAL); ready = -1; return; }
        if (hipFuncSetAttribute((const void*)mega, hipFuncAttributeMaxDynamicSharedMemorySize, LDS_BYTES) != hipSuccess) { fprintf(stderr, "kernel_launch: hipFuncSetAttribute failed\n"); ready = -1; return; }
        ready = 1;
    }
    if (ready < 0) return;
    (void)hipMemsetAsync((char*)d_ws + WS_CTL, 0, 1 * MiB, stream);
    Params P{};
    for (int i = 0; i < 35; ++i) P.in[i] = (const float*)d_in[i];
    P.out = (float*)d_out; P.ws = (unsigned char*)d_ws; P.ph_lo = 0; P.ph_hi = 0;
    hipLaunchKernelGGL(mega, dim3(GRID), dim3(512), LDS_BYTES, stream, P);
}
```

```cpp
#include <hip/hip_runtime.h>
#include <stdint.h>
#include <stdio.h>

#define DM 1024
#define NB 2
#define SEQ 8192
#define NMETA 16
#define LSEQ (SEQ + NMETA)
#define NMAIN (NB * SEQ)
#define NT (NB * LSEQ)
#define NTP 16640
#define INCOLS 3328
#define RESTC 1792
#define NEXP 32
#define DFF 512
#define S5TC 48
#define S5NC 171
#define MOE_RT 256
#define MOE_MAXROWS 41216

typedef unsigned short bf16_t;
typedef short bf16x8 __attribute__((ext_vector_type(8)));
typedef float f32x4 __attribute__((ext_vector_type(4)));
typedef unsigned u32x4 __attribute__((ext_vector_type(4)));
typedef unsigned u32x2 __attribute__((ext_vector_type(2)));

constexpr size_t MiB = 1u << 20;
constexpr size_t al64k(size_t x) { return (x + 65535) & ~(size_t)65535; }
constexpr size_t WS_CTL = 0;
constexpr size_t WS_H = 1 * MiB;
constexpr size_t WS_HN = WS_H + al64k((size_t)NT * DM * 4);
constexpr size_t WS_A2 = WS_HN + al64k((size_t)NTP * DM * 2);
constexpr size_t WS_WTIN = WS_A2 + al64k((size_t)NTP * DM * 2);
constexpr size_t WS_WTOUT = WS_WTIN + al64k((size_t)INCOLS * DM * 2);
constexpr size_t WS_WTGLU = WS_WTOUT + al64k((size_t)DM * DM * 2);
constexpr size_t WS_WT13 = WS_WTGLU + al64k((size_t)2 * DM * DM * 2);
constexpr size_t WS_WT2 = WS_WT13 + al64k((size_t)NEXP * DM * DM * 2);
constexpr size_t WS_BIG = WS_WT2 + al64k((size_t)NEXP * DM * DFF * 2);
constexpr size_t SZ_T512 = al64k((size_t)NT * 512 * 2);
constexpr size_t SZ_P512 = al64k((size_t)NTP * 512 * 2);
constexpr size_t WS_Q = WS_BIG;
constexpr size_t WS_K = WS_Q + SZ_P512;
constexpr size_t WS_V = WS_K + SZ_P512;
constexpr size_t WS_REST = WS_V + SZ_P512;
constexpr size_t WS_R = WS_REST + al64k((size_t)NTP * RESTC * 2);
constexpr size_t WS_KR = WS_R + SZ_T512;
constexpr size_t WS_VV = WS_KR + SZ_T512;
constexpr size_t WS_LOW = WS_VV + SZ_T512;
constexpr size_t WS_G = WS_LOW + al64k((size_t)NT * 256 * 2);
constexpr size_t WS_KK = WS_G + SZ_T512;
constexpr size_t WS_KKA = WS_KK + SZ_T512;
constexpr size_t WS_KD = WS_KKA + 2 * SZ_T512;
constexpr size_t WS_BC = WS_KD + 2 * SZ_T512;
constexpr size_t WS_MIXEND = WS_BC + al64k((size_t)NT * 8 * 4);
constexpr size_t WS_AA = WS_Q;
constexpr size_t WS_YFB = WS_Q;
constexpr size_t WS_W = WS_V;
static_assert(2 * SZ_T512 <= 2 * SZ_P512, "AA/YFB fit in Q|K");
static_assert((size_t)2 * NT * 512 * 4 <= SZ_P512 + al64k((size_t)NTP * RESTC * 2), "W fits in V|REST");
constexpr size_t WS_XB = WS_BIG;
constexpr size_t WS_HB = WS_XB + al64k((size_t)MOE_MAXROWS * DM * 2);
constexpr size_t WS_YB = WS_HB + al64k((size_t)MOE_MAXROWS * DFF * 2);
constexpr size_t WS_EID = WS_YB + al64k((size_t)MOE_MAXROWS * DM * 2);
constexpr size_t WS_POS = WS_EID + al64k((size_t)NT * 8);
constexpr size_t WS_DEST = WS_POS + al64k((size_t)NT * 8);
constexpr size_t WS_GATE = WS_DEST + al64k((size_t)NT * 8);
constexpr size_t WS_MOEEND = WS_GATE + al64k((size_t)NT * 8);
constexpr size_t WS_YS = WS_BIG;
constexpr size_t WS_END = WS_YS + al64k((size_t)2 * NT * DM * 4);
constexpr size_t WS_CARRY = WS_END + al64k((size_t)256 * S5NC * 64 * 8);
constexpr size_t WS_S5END = WS_CARRY + al64k((size_t)256 * S5NC * 64 * 8);
constexpr size_t cmax(size_t a, size_t b) { return a > b ? a : b; }
constexpr size_t WS_TOTAL = cmax(WS_MIXEND, cmax(WS_MOEEND, WS_S5END));
static_assert(WS_TOTAL <= 512 * MiB, "workspace map exceeds 512 MiB");

#define CW_CNT(l) (1024 + 64 * (l))

#define LDS_RING 131072
#define LDS_BARST (LDS_RING)
#define LDS_TAB (LDS_RING + 256)
#define LDS_BYTES 147456
#define GRID 256

struct Params {
    const float* in[35];
    float* out;
    unsigned char* ws;
    int ph_lo, ph_hi;
};
typedef const __attribute__((address_space(4))) Params CParams;

__device__ __forceinline__ float bf2f(bf16_t v) { return __uint_as_float(((unsigned)v) << 16); }
__device__ __forceinline__ unsigned f2bf(float f) { unsigned u = __float_as_uint(f); return (u + 0x7fffu + ((u >> 16) & 1u)) >> 16; }
__device__ __forceinline__ unsigned pk2(float lo, float hi) { return f2bf(lo) | (f2bf(hi) << 16); }
__device__ __forceinline__ float bflo(unsigned u) { return __uint_as_float(u << 16); }
__device__ __forceinline__ float bfhi(unsigned u) { return __uint_as_float(u & 0xffff0000u); }
__device__ __forceinline__ float wave_sum(float v) {
#pragma unroll
    for (int o = 1; o < 64; o <<= 1) v += __shfl_xor(v, o);
    return v;
}
__device__ __forceinline__ float wave_max(float v) {
#pragma unroll
    for (int o = 1; o < 64; o <<= 1) v = fmaxf(v, __shfl_xor(v, o));
    return v;
}
template <int CTRL> __device__ __forceinline__ float dppf(float v) { return __int_as_float(__builtin_amdgcn_update_dpp(0, __float_as_int(v), CTRL, 0xF, 0xF, true)); }
__device__ __forceinline__ float row16_sum(float v) { v += dppf<0xB1>(v); v += dppf<0x4E>(v); v += dppf<0x141>(v); v += dppf<0x140>(v); return v; }
__device__ __forceinline__ float sigmoidf_(float x) { return 1.f / (1.f + __expf(-x)); }
__device__ __forceinline__ int rowof(int b, int p) { return p < NMETA ? NMAIN + b * NMETA + p : b * SEQ + (p - NMETA); }

#define SA_STRIDE 40
template <class AF, class BF>
__device__ __forceinline__ void gemm_tile(unsigned char* lds, int K, int ldb, const AF& arow, const BF& bcol, f32x4 (&acc)[4][2]) {
    bf16_t* sA = (bf16_t*)lds;
    bf16_t* sB = (bf16_t*)(lds + 128 * SA_STRIDE * 2);
    const int tid = threadIdx.x, lane = tid & 63, wave = tid >> 6, wr = wave >> 2, wc = wave & 3, fr = lane & 15, fq = lane >> 4;
#pragma unroll
    for (int mi = 0; mi < 4; ++mi)
#pragma unroll
        for (int ni = 0; ni < 2; ++ni) acc[mi][ni] = (f32x4){0.f, 0.f, 0.f, 0.f};
    const int ar = tid >> 2, akc = (tid & 3) * 8;
    const bf16_t* ap = arow(ar) + akc;
    const int bnq = (tid & 31) * 4, bkp = (tid >> 5) * 2;
    const float* bp = bcol(bnq) + (size_t)bkp * ldb;
    const int nk = K / 32;
    u32x4 ra = *(const u32x4*)ap;
    f32x4 rb0 = *(const f32x4*)bp, rb1 = *(const f32x4*)(bp + ldb);
    for (int kt = 0; kt < nk; ++kt) {
        __syncthreads();
        *(u32x4*)(sA + ar * SA_STRIDE + akc) = ra;
        {
            unsigned* d = (unsigned*)(sB + bnq * SA_STRIDE + bkp);
            d[0 * (SA_STRIDE / 2)] = pk2(rb0[0], rb1[0]);
            d[1 * (SA_STRIDE / 2)] = pk2(rb0[1], rb1[1]);
            d[2 * (SA_STRIDE / 2)] = pk2(rb0[2], rb1[2]);
            d[3 * (SA_STRIDE / 2)] = pk2(rb0[3], rb1[3]);
        }
        __syncthreads();
        if (kt + 1 < nk) {
            ra = *(const u32x4*)(ap + (kt + 1) * 32);
            const float* q = bp + (size_t)(kt + 1) * 32 * ldb;
            rb0 = *(const f32x4*)q; rb1 = *(const f32x4*)(q + ldb);
        }
        bf16x8 a[4], b[2];
#pragma unroll
        for (int mi = 0; mi < 4; ++mi) a[mi] = *(const bf16x8*)(sA + (wr * 64 + mi * 16 + fr) * SA_STRIDE + fq * 8);
#pragma unroll
        for (int ni = 0; ni < 2; ++ni) b[ni] = *(const bf16x8*)(sB + (wc * 32 + ni * 16 + fr) * SA_STRIDE + fq * 8);
#pragma unroll
        for (int mi = 0; mi < 4; ++mi)
#pragma unroll
            for (int ni = 0; ni < 2; ++ni) acc[mi][ni] = __builtin_amdgcn_mfma_f32_16x16x32_bf16(a[mi], b[ni], acc[mi][ni], 0, 0, 0);
    }
    __syncthreads();
}
#define ACC_FOREACH(acc, ...) do { const int _l = threadIdx.x & 63, _w = threadIdx.x >> 6, _wr = _w >> 2, _wc = _w & 3, _fr = _l & 15, _fq = _l >> 4; \
    _Pragma("unroll") for (int _mi = 0; _mi < 4; ++_mi) _Pragma("unroll") for (int _ni = 0; _ni < 2; ++_ni) _Pragma("unroll") for (int _j = 0; _j < 4; ++_j) { \
        const int rl = _wr * 64 + _mi * 16 + _fq * 4 + _j, cl = _wc * 32 + _ni * 16 + _fr; const float val = acc[_mi][_ni][_j]; __VA_ARGS__ } } while (0)
#define ACC_FOREACH_PAIR(acc, ...) do { const int _l = threadIdx.x & 63, _w = threadIdx.x >> 6, _wr = _w >> 2, _wc = _w & 3, _fr = _l & 15, _fq = _l >> 4; \
    _Pragma("unroll") for (int _mi = 0; _mi < 4; ++_mi) _Pragma("unroll") for (int _j = 0; _j < 4; ++_j) { \
        const int rl = _wr * 64 + _mi * 16 + _fq * 4 + _j, co = _wc * 16 + _fr; const float va = acc[_mi][0][_j], vg = acc[_mi][1][_j]; __VA_ARGS__ } } while (0)

__device__ __forceinline__ void store_norm_bf16(const f32x4 (&v)[4], const float* gain, bf16_t* dst, int lane) {
    float ss = 0.f;
#pragma unroll
    for (int j = 0; j < 4; ++j) ss += v[j][0] * v[j][0] + v[j][1] * v[j][1] + v[j][2] * v[j][2] + v[j][3] * v[j][3];
    ss = wave_sum(ss);
    const float rstd = rsqrtf(ss * (1.f / DM) + 1e-6f);
#pragma unroll
    for (int j = 0; j < 4; ++j) {
        const f32x4 g = ((const f32x4*)gain)[lane + 64 * j];
        u32x2 o; o.x = pk2(v[j][0] * rstd * g[0], v[j][1] * rstd * g[1]); o.y = pk2(v[j][2] * rstd * g[2], v[j][3] * rstd * g[3]);
        ((u32x2*)dst)[lane + 64 * j] = o;
    }
}

namespace pg8 {
#define PG8_LAS __attribute__((address_space(3)))
constexpr int BM = 256, BK = 64, HALF = 128, HTB = HALF * BK * 2  , STAGE_BYTES = 8 * HTB, NXCD = 8, WGM = 8;
__host__ __device__ __forceinline__ int lds_byte(int r, int c) { const int st = (r >> 4) * 2 + (c >> 5), rr = r & 15, cc = c & 31, ob = rr * 64 + cc * 2; return st * 1024 + (ob ^ (((ob >> 9) & 1) << 5)); }
__host__ __device__ __forceinline__ void stage_rc(int b, int& R, int& C) { const int st = b / 1024, sb = b % 1024, swz = sb ^ (((sb >> 9) & 1) << 5); R = (st >> 1) * 16 + swz / 64; C = (st & 1) * 32 + (swz % 64) / 2; }
__host__ __device__ __forceinline__ int perm32(int rho) { const int n = rho >> 4, i = rho & 15; return 8 * (i >> 2) + 4 * n + (i & 3); }

struct Unit { int pm, pn; const char* A; const char* B; };

struct DenseOrder {
    int nM, nN, nwg, G, c; const char* A; const char* Bt; size_t tstep;
    __device__ void init(const bf16_t* A_, const bf16_t* Bt_, int M, int N, int K, int G_, int c_) { nM = M / BM; nN = N / BM; nwg = nM * nN; G = G_; c = c_; A = (const char*)A_; Bt = (const char*)Bt_; tstep = (size_t)BM * K * 2; }
    __device__ bool next(int i, Unit& u) const {
        const long L = (long)i * G + c; if (L >= nwg) return false;
        int wgid = (int)L; { const int q = nwg / NXCD, r = nwg % NXCD, xcd = wgid % NXCD, off = wgid / NXCD; wgid = (xcd < r ? xcd * (q + 1) : r * (q + 1) + (xcd - r) * q) + off; }
        const int nig = WGM * nN, gid = wgid / nig, fm = gid * WGM, gsz = (nM - fm) < WGM ? (nM - fm) : WGM;
        u.pm = fm + ((wgid % nig) % gsz); u.pn = (wgid % nig) / gsz; u.A = A + (size_t)u.pm * tstep; u.B = Bt + (size_t)u.pn * tstep; return true;
    }
    __device__ __forceinline__ void a_ready(const Unit&) const {}
    __device__ __forceinline__ void done(const Unit&) const {}
};
struct ProjOrder {
    DenseOrder D; const char* HNp; const char* WT;
    __device__ void init(const bf16_t* HN_, const bf16_t* WT_, int c_) { D.init(HN_, WT_, NTP, 13 * BM, DM, GRID, c_); HNp = (const char*)HN_; WT = (const char*)WT_; }
    __device__ bool next(int i, Unit& u) const {
        if (!D.next(i, u)) return false;
        const size_t ts = (size_t)BM * DM * 2;
        if (u.pn < 11) { const int wrow = u.pn < 4 ? u.pn : u.pn + 2; u.A = HNp + (size_t)u.pm * ts; u.B = WT + (size_t)wrow * ts; }
        else { u.A = WT + (size_t)(4 + (u.pn - 11)) * ts; u.B = HNp + (size_t)u.pm * ts; }
        return true;
    }
    __device__ __forceinline__ void a_ready(const Unit&) const {}
    __device__ __forceinline__ void done(const Unit&) const {}
};
struct MoeOrder {
    const int* et; int TT, vcu; const char* A; const char* Bt; unsigned tstepA, tstepB, estep;
    __device__ __forceinline__ bool next(int i, Unit& u) const {
        const int L = i * GRID + vcu; if (L >= TT * 4) return false;
        const int rt = L >> 2, ct = L & 3, e = et[rt];
        u.pm = rt; u.pn = ct; u.A = A + (size_t)rt * tstepA; u.B = Bt + (size_t)e * estep + (size_t)ct * tstepB; return true;
    }
    __device__ __forceinline__ void a_ready(const Unit&) const {}
    __device__ __forceinline__ void done(const Unit&) const {}
};

__device__ __forceinline__ unsigned cvt_pk_bf16(float lo, float hi) { unsigned r; asm volatile("v_cvt_pk_bf16_f32 %0, %1, %2" : "=v"(r) : "v"(lo), "v"(hi)); return r; }

struct EpiProj {
    static constexpr bool PERM = true, AFTER_DRAIN = false;
    bf16_t *Q, *Kk, *VT, *REST;
    __device__ __forceinline__ void operator()(const f32x4 (&acc)[2][2][4][2], const Unit& u, int wr, int wc, int fr, int fq) const {
        bf16_t* base; int ldc; int row0, col0;
        if (u.pn < 11) { row0 = u.pm * BM + wr * 64 + fr; int colt;
            if (u.pn < 2) { base = Q; colt = u.pn * BM; ldc = 512; } else if (u.pn < 4) { base = Kk; colt = (u.pn - 2) * BM; ldc = 512; } else { base = REST; colt = (u.pn - 4) * BM; ldc = RESTC; }
            col0 = colt + wc * 32 + 8 * fq; }
        else { base = VT; ldc = NTP; row0 = (u.pn - 11) * BM + wr * 64 + fr; col0 = u.pm * BM + wc * 32 + 8 * fq; }
#pragma unroll
        for (int ai = 0; ai < 2; ++ai)
#pragma unroll
            for (int m = 0; m < 4; ++m) { bf16_t* rowp = base + (size_t)(row0 + ai * HALF + m * 16) * ldc + col0;
#pragma unroll
                for (int bj = 0; bj < 2; ++bj) { const f32x4 v0 = acc[ai][bj][m][0], v1 = acc[ai][bj][m][1];
                    u32x4 w; w.x = cvt_pk_bf16(v0[0], v0[1]); w.y = cvt_pk_bf16(v0[2], v0[3]); w.z = cvt_pk_bf16(v1[0], v1[1]); w.w = cvt_pk_bf16(v1[2], v1[3]);
                    *(u32x4*)(rowp + bj * HALF) = w; } }
    }
};
struct EpiBf16Plain {
    static constexpr bool PERM = true, AFTER_DRAIN = false;
    bf16_t* O; int ldc;
    __device__ __forceinline__ void operator()(const f32x4 (&acc)[2][2][4][2], const Unit& u, int wr, int wc, int fr, int fq) const {
        const int row0 = u.pm * BM + wr * 64 + fr; const int col0 = u.pn * BM + wc * 32 + 8 * fq;
#pragma unroll
        for (int ai = 0; ai < 2; ++ai)
#pragma unroll
            for (int m = 0; m < 4; ++m) { bf16_t* rowp = O + (size_t)(row0 + ai * HALF + m * 16) * ldc + col0;
#pragma unroll
                for (int bj = 0; bj < 2; ++bj) { const f32x4 v0 = acc[ai][bj][m][0], v1 = acc[ai][bj][m][1];
                    u32x4 w; w.x = cvt_pk_bf16(v0[0], v0[1]); w.y = cvt_pk_bf16(v0[2], v0[3]); w.z = cvt_pk_bf16(v1[0], v1[1]); w.w = cvt_pk_bf16(v1[2], v1[3]);
                    *(u32x4*)(rowp + bj * HALF) = w; } }
    }
};
struct EpiSwiglu {
    static constexpr bool PERM = true, AFTER_DRAIN = false;
    bf16_t* O;
    __device__ __forceinline__ void operator()(const f32x4 (&acc)[2][2][4][2], const Unit& u, int wr, int wc, int fr, int fq) const {
        const int row0 = u.pm * BM + wr * 64 + fr; const int col0 = u.pn * HALF + wc * 32 + 8 * fq;
#pragma unroll
        for (int ai = 0; ai < 2; ++ai)
#pragma unroll
            for (int m = 0; m < 4; ++m) {
                float o[8];
#pragma unroll
                for (int n = 0; n < 2; ++n)
#pragma unroll
                    for (int i = 0; i < 4; ++i) { const float va = acc[ai][0][m][n][i], vg = acc[ai][1][m][n][i]; o[4 * n + i] = va / (1.f + __expf(-va)) * vg; }
                u32x4 w; w.x = cvt_pk_bf16(o[0], o[1]); w.y = cvt_pk_bf16(o[2], o[3]); w.z = cvt_pk_bf16(o[4], o[5]); w.w = cvt_pk_bf16(o[6], o[7]);
                *(u32x4*)(O + (size_t)(row0 + ai * HALF + m * 16) * DFF + col0) = w; }
    }
};
struct EpiResidual {
    static constexpr bool PERM = false, AFTER_DRAIN = false;
    float* Hh;
    __device__ __forceinline__ void operator()(const f32x4 (&acc)[2][2][4][2], const Unit& u, int wr, int wc, int fr, int fq) const {
        const int row0 = u.pm * BM + wr * 64 + fr; const int col0 = u.pn * BM + wc * 32 + 4 * fq;
#pragma unroll
        for (int ai = 0; ai < 2; ++ai)
#pragma unroll
            for (int m = 0; m < 4; ++m) { float* rowp = Hh + (size_t)(row0 + ai * HALF + m * 16) * DM + col0;
#pragma unroll
                for (int bj = 0; bj < 2; ++bj)
#pragma unroll
                    for (int n = 0; n < 2; ++n) { f32x4* p = (f32x4*)(rowp + bj * HALF + n * 16); *p = *p + acc[ai][bj][m][n]; } }
    }
};
struct EpiGlu {
    static constexpr bool PERM = false, AFTER_DRAIN = false;
    float* Hh;
    __device__ __forceinline__ void operator()(const f32x4 (&acc)[2][2][4][2], const Unit& u, int wr, int wc, int fr, int fq) const {
        const int row0 = u.pm * BM + wr * 64 + fr; const int col0 = u.pn * HALF + wc * 32 + 4 * fq;
#pragma unroll
        for (int ai = 0; ai < 2; ++ai)
#pragma unroll
            for (int m = 0; m < 4; ++m) { float* rowp = Hh + (size_t)(row0 + ai * HALF + m * 16) * DM + col0;
#pragma unroll
                for (int n = 0; n < 2; ++n) { f32x4* p = (f32x4*)(rowp + n * 16); f32x4 hv = *p; const f32x4 va = acc[ai][0][m][n], vg = acc[ai][1][m][n];
#pragma unroll
                    for (int i = 0; i < 4; ++i) hv[i] += va[i] / (1.f + __expf(-vg[i]));
                    *p = hv; } }
    }
};

template <class Epi, class Sched, bool ALIGN_EPI = false, bool SP2 = false>
__device__ __forceinline__ void gemm_phase(PG8_LAS unsigned char* lds, const int K, const Sched& S, const Epi& E) {
    int tid_ = threadIdx.x; asm volatile("" : "+v"(tid_));
    const int tid = tid_, wid = __builtin_amdgcn_readfirstlane(tid >> 6), lane = tid & 63, wr = wid >> 2, wc = wid & 3, fr = lane & 15, fq = lane >> 4;
    const int nt = K / BK;
    unsigned voffA[2], voffB[2];
#pragma unroll
    for (int i = 0; i < 2; ++i) { int R, C; stage_rc(tid * 16 + i * 8192, R, C); const int Rb = Epi::PERM ? ((R & ~31) + perm32(R & 31)) : R;
        voffA[i] = (unsigned)(R * K + C) * 2u; voffB[i] = (unsigned)(Rb * K + C) * 2u; }
    const size_t kstep = (size_t)(BK * 2);
    const size_t hstep = (size_t)HALF * K * 2;
    const unsigned ldsw = (unsigned)wid * 1024u;
    const int aoff = lds_byte(wr * 64 + fr, fq * 8), boff = lds_byte(wc * 32 + fr, fq * 8);
#define PG8_SA(b, h) (((b) * 2 + (h)) * HTB)
#define PG8_SB(b, h) ((4 + (b) * 2 + (h)) * HTB)
#define PG8_STAGE(bufoff, gbase, voff) do { _Pragma("unroll") for (int _i = 0; _i < 2; ++_i) \
        __builtin_amdgcn_global_load_lds((const unsigned*)((const char*)(gbase) + (voff)[_i]), (PG8_LAS unsigned*)(lds + (bufoff) + ldsw + _i * 8192), 16, 0, 0); } while (0)
#define PG8_LDA(dst, b, h) do { _Pragma("unroll") for (int m = 0; m < 4; ++m) _Pragma("unroll") for (int k = 0; k < 2; ++k) dst[m][k] = *(const PG8_LAS bf16x8*)(lds + PG8_SA(b, h) + aoff + m * 2048 + k * 1024); } while (0)
#define PG8_LDB(dst, b, h) do { _Pragma("unroll") for (int n = 0; n < 2; ++n) _Pragma("unroll") for (int k = 0; k < 2; ++k) dst[n][k] = *(const PG8_LAS bf16x8*)(lds + PG8_SB(b, h) + boff + n * 2048 + k * 1024); } while (0)
#define PG8_MMA(ai, bj, At, Bt) do { __builtin_amdgcn_s_setprio(1); _Pragma("unroll") for (int m = 0; m < 4; ++m) _Pragma("unroll") for (int n = 0; n < 2; ++n) _Pragma("unroll") for (int k = 0; k < 2; ++k) \
        acc[ai][bj][m][n] = __builtin_amdgcn_mfma_f32_16x16x32_bf16(Bt[n][k], At[m][k], acc[ai][bj][m][n], 0, 0, 0); __builtin_amdgcn_s_setprio(0); } while (0)
#define PG8_WAIT_V(n) asm volatile("s_waitcnt vmcnt(" #n ")" ::: "memory")
#define PG8_WAIT_L(n) asm volatile("s_waitcnt lgkmcnt(" #n ")" ::: "memory")
#define PG8_BAR __builtin_amdgcn_s_barrier()
#define PG8_SCHED __builtin_amdgcn_sched_barrier(0)
    Unit cur, nxt; int ui = 0;
    if (!S.next(0, cur)) return;
    f32x4 acc[2][2][4][2];
#pragma unroll
    for (int a = 0; a < 2; ++a)
#pragma unroll
        for (int b = 0; b < 2; ++b)
#pragma unroll
            for (int m = 0; m < 4; ++m)
#pragma unroll
                for (int n = 0; n < 2; ++n) acc[a][b][m][n] = (f32x4){0.f, 0.f, 0.f, 0.f};
    bf16x8 At[4][2], B0[2][2], B1[2][2];
    const char* cA = cur.A; const char* cB = cur.B;
    S.a_ready(cur);
    if constexpr (SP2) {
        PG8_STAGE(PG8_SB(0, 0), cB, voffB); PG8_STAGE(PG8_SB(0, 1), cB + hstep, voffB); PG8_STAGE(PG8_SA(0, 0), cA, voffA); PG8_STAGE(PG8_SA(0, 1), cA + hstep, voffA);
        if (wr == 1) PG8_BAR;
        PG8_WAIT_V(2); PG8_BAR;
        PG8_STAGE(PG8_SB(1, 0), cB + kstep, voffB); PG8_STAGE(PG8_SA(1, 0), cA + kstep, voffA); PG8_STAGE(PG8_SB(1, 1), cB + hstep + kstep, voffB);
        PG8_WAIT_V(6); PG8_BAR;
    } else {
        PG8_STAGE(PG8_SB(0, 0), cB, voffB); PG8_STAGE(PG8_SA(0, 0), cA, voffA); PG8_STAGE(PG8_SB(0, 1), cB + hstep, voffB); PG8_STAGE(PG8_SA(0, 1), cA + hstep, voffA);
        if (wr == 1) PG8_BAR;
        PG8_WAIT_V(4); PG8_BAR;
        PG8_STAGE(PG8_SB(1, 0), cB + kstep, voffB); PG8_STAGE(PG8_SA(1, 0), cA + kstep, voffA); PG8_STAGE(PG8_SB(1, 1), cB + hstep + kstep, voffB);
        PG8_WAIT_V(6); PG8_BAR;
    }
    for (;;) {
        const bool has_next = S.next(ui + 1, nxt);
        const char* nA = has_next ? nxt.A : cA; const char* nB = has_next ? nxt.B : cB;
        for (int t = 0; t < nt; t += 2) {
            const bool last = (t == nt - 2);
            const char* a1 = cA + (size_t)(t + 1) * kstep;
            const char* a2 = last ? nA : cA + (size_t)(t + 2) * kstep; const char* b2 = last ? nB : cB + (size_t)(t + 2) * kstep;
            const char* a3 = a2 + kstep; const char* b3 = b2 + kstep;
            if (last && has_next) S.a_ready(nxt);
            if constexpr (SP2) {
            PG8_LDB(B0, 0, 0); PG8_LDB(B1, 0, 1); PG8_SCHED; PG8_LDA(At, 0, 0); PG8_STAGE(PG8_SA(1, 1), a1 + hstep, voffA);
            PG8_WAIT_V(8); PG8_WAIT_L(0); PG8_BAR; PG8_MMA(0, 0, At, B0); PG8_MMA(0, 1, At, B1); PG8_BAR; PG8_SCHED;
            PG8_LDA(At, 0, 1); PG8_STAGE(PG8_SB(0, 0), b2, voffB); PG8_STAGE(PG8_SB(0, 1), b2 + hstep, voffB); PG8_STAGE(PG8_SA(0, 0), a2, voffA);
            PG8_WAIT_V(8); PG8_WAIT_L(0); PG8_BAR; PG8_MMA(1, 0, At, B0); PG8_MMA(1, 1, At, B1); PG8_BAR; PG8_SCHED;
            PG8_LDB(B0, 1, 0); PG8_LDB(B1, 1, 1); PG8_SCHED; PG8_LDA(At, 1, 0); PG8_STAGE(PG8_SA(0, 1), a2 + hstep, voffA);
            PG8_WAIT_V(8); PG8_WAIT_L(0); PG8_BAR; PG8_MMA(0, 0, At, B0); PG8_MMA(0, 1, At, B1); PG8_BAR; PG8_SCHED;
            PG8_LDA(At, 1, 1); PG8_STAGE(PG8_SB(1, 0), b3, voffB); PG8_STAGE(PG8_SB(1, 1), b3 + hstep, voffB); PG8_STAGE(PG8_SA(1, 0), a3, voffA);
            PG8_WAIT_V(8); PG8_WAIT_L(0); PG8_BAR; PG8_MMA(1, 0, At, B0); PG8_MMA(1, 1, At, B1); PG8_BAR; PG8_SCHED;
            } else {
            PG8_LDB(B0, 0, 0); PG8_SCHED; PG8_LDA(At, 0, 0); PG8_STAGE(PG8_SA(1, 1), a1 + hstep, voffA);
            PG8_WAIT_L(8); PG8_BAR; PG8_WAIT_L(0); PG8_MMA(0, 0, At, B0); PG8_BAR; PG8_SCHED;
            PG8_LDB(B1, 0, 1); PG8_STAGE(PG8_SB(0, 0), b2, voffB);
            PG8_BAR; PG8_WAIT_L(0); PG8_MMA(0, 1, At, B1); PG8_BAR;
            PG8_LDA(At, 0, 1); PG8_STAGE(PG8_SA(0, 0), a2, voffA);
            PG8_BAR; PG8_WAIT_L(0); PG8_MMA(1, 0, At, B0); PG8_BAR; PG8_SCHED;
            PG8_STAGE(PG8_SB(0, 1), b2 + hstep, voffB);
            PG8_WAIT_V(6); PG8_BAR; PG8_MMA(1, 1, At, B1); PG8_BAR;
            PG8_LDB(B0, 1, 0); PG8_SCHED; PG8_LDA(At, 1, 0); PG8_STAGE(PG8_SA(0, 1), a2 + hstep, voffA);
            PG8_WAIT_L(8); PG8_BAR; PG8_WAIT_L(0); PG8_MMA(0, 0, At, B0); PG8_BAR; PG8_SCHED;
            PG8_LDB(B1, 1, 1); PG8_STAGE(PG8_SB(1, 0), b3, voffB);
            PG8_BAR; PG8_WAIT_L(0); PG8_MMA(0, 1, At, B1); PG8_BAR;
            PG8_LDA(At, 1, 1); PG8_STAGE(PG8_SA(1, 0), a3, voffA);
            PG8_BAR; PG8_WAIT_L(0); PG8_MMA(1, 0, At, B0); PG8_BAR; PG8_SCHED;
            PG8_STAGE(PG8_SB(1, 1), b3 + hstep, voffB);
            PG8_WAIT_V(6); PG8_BAR; PG8_MMA(1, 1, At, B1); PG8_BAR;
            }
        }
        if constexpr (ALIGN_EPI) { if (wr == 0) PG8_BAR; }
        if constexpr (!Epi::AFTER_DRAIN) { E(acc, cur, wr, wc, fr, fq); S.done(cur); }
        if (!has_next) break;
#pragma unroll
        for (int a = 0; a < 2; ++a)
#pragma unroll
            for (int b = 0; b < 2; ++b)
#pragma unroll
                for (int m = 0; m < 4; ++m)
#pragma unroll
                    for (int n = 0; n < 2; ++n) acc[a][b][m][n] = (f32x4){0.f, 0.f, 0.f, 0.f};
        cur = nxt; cA = nA; cB = nB; ++ui;
        if constexpr (ALIGN_EPI) { if (wr == 1) PG8_BAR; }
    }
    PG8_WAIT_V(0);
    if constexpr (!ALIGN_EPI) { if (wr == 0) PG8_BAR; }
    PG8_BAR;
    if constexpr (Epi::AFTER_DRAIN) { E.fused(acc, cur, wr, wc, fr, fq, lds, wid, lane); S.done(cur); }
#undef PG8_SA
#undef PG8_SB
#undef PG8_STAGE
#undef PG8_LDA
#undef PG8_LDB
#undef PG8_MMA
#undef PG8_WAIT_V
#undef PG8_WAIT_L
#undef PG8_BAR
#undef PG8_SCHED
}
}

#define PHASE_PROLOGUE \
    int tid_ = threadIdx.x; asm volatile("" : "+v"(tid_)); const int tid = tid_, lane = tid & 63, wave = tid >> 6; \
    const int G = GRID, bid = blockIdx.x; \
    const int gw = bid * 8 + wave, NGW = G * 8; \
    unsigned char* ws = P.ws; \
    float* H = (float*)(ws + WS_H); \
    bf16_t* HN = (bf16_t*)(ws + WS_HN); \
    bf16_t* A2 = (bf16_t*)(ws + WS_A2); \
    bf16_t* Qb = (bf16_t*)(ws + WS_Q); bf16_t* Kb = (bf16_t*)(ws + WS_K); bf16_t* Vb = (bf16_t*)(ws + WS_V); \
    bf16_t* REST = (bf16_t*)(ws + WS_REST); \
    bf16_t* YFB = (bf16_t*)(ws + WS_YFB); \
    bf16_t* Rr = (bf16_t*)(ws + WS_R); bf16_t* VV = (bf16_t*)(ws + WS_VV); bf16_t* KK = (bf16_t*)(ws + WS_KK); \
    bf16_t* KKA = (bf16_t*)(ws + WS_KKA); bf16_t* KD = (bf16_t*)(ws + WS_KD); \
    float* Wd = (float*)(ws + WS_W); \
    bf16_t* Gg = (bf16_t*)(ws + WS_G); bf16_t* KR = (bf16_t*)(ws + WS_KR); bf16_t* LOW = (bf16_t*)(ws + WS_LOW); \
    float* BC = (float*)(ws + WS_BC); \
    bf16_t* AA = (bf16_t*)(ws + WS_AA); \
    bf16_t* HB = (bf16_t*)(ws + WS_HB); bf16_t* YB = (bf16_t*)(ws + WS_YB); \
    bf16_t* XB = (bf16_t*)(ws + WS_XB); int* EID = (int*)(ws + WS_EID); int* POS = (int*)(ws + WS_POS); int* DEST = (int*)(ws + WS_DEST); \
    float* GATE = (float*)(ws + WS_GATE); \
    float* YS = (float*)(ws + WS_YS); \
    float* ENDS = (float*)(ws + WS_END); float* CARRY = (float*)(ws + WS_CARRY); \
    unsigned* CTL = (unsigned*)(ws + WS_CTL); \
    bf16_t* WTIN = (bf16_t*)(ws + WS_WTIN); bf16_t* WTOUT = (bf16_t*)(ws + WS_WTOUT); bf16_t* WTGLU = (bf16_t*)(ws + WS_WTGLU); bf16_t* WT13 = (bf16_t*)(ws + WS_WT13); bf16_t* WT2 = (bf16_t*)(ws + WS_WT2); \
    const int vcu = (G % 8 == 0) ? (bid % 8) * (G / 8) + bid / 8 : bid; \
    const float* x = P.in[0]; const float* meta = P.in[1]; const float* norm_mix = P.in[2]; const float* norm_ffn = P.in[3]; const float* norm_final = P.in[4]; \
    const float* w_in = P.in[5]; const float* w_out = P.in[6]; const float* rpb = P.in[7]; const float* mu = P.in[8]; \
    const float* w0 = P.in[9]; const float* w_up = P.in[10]; const float* a0 = P.in[11]; const float* a_up = P.in[12]; const float* g_up = P.in[13]; \
    const float* k_k = P.in[14]; const float* k_a = P.in[15]; const float* r_k = P.in[16]; const float* lnx_g = P.in[17]; const float* lnx_b = P.in[18]; \
    const float* s5_b_re = P.in[19]; const float* s5_b_im = P.in[20]; const float* s5_lre = P.in[21]; const float* s5_lim = P.in[22]; const float* s5_ls = P.in[23]; \
    const float* s5_c_re = P.in[24]; const float* s5_c_im = P.in[25]; const float* s5_d = P.in[26]; const float* w_glu = P.in[27]; \
    const float* moe_wg = P.in[28]; const float* moe_bg = P.in[29]; const float* moe_we = P.in[30]; const float* moe_be = P.in[31]; \
    const float* moe_w1 = P.in[32]; const float* moe_w3 = P.in[33]; const float* moe_w2 = P.in[34];


__device__ __forceinline__ void transpose_item(const float* W, int N, int K, int k0, int n0, bf16_t* dstrow0, int lane) {
    const int nq = lane & 15, kb = lane >> 4;
    const float* src = W + (size_t)(k0 + 16 * kb) * N + n0 + 4 * nq;
    f32x4 v[16];
#pragma unroll
    for (int kk = 0; kk < 16; ++kk) v[kk] = *(const f32x4*)(src + (size_t)kk * N);
#pragma unroll
    for (int i = 0; i < 4; ++i) {
        bf16_t* d = dstrow0 + (size_t)(4 * nq + i) * K + k0 + 16 * kb;
        u32x4 lo, hi;
        lo.x = pk2(v[0][i], v[1][i]); lo.y = pk2(v[2][i], v[3][i]); lo.z = pk2(v[4][i], v[5][i]); lo.w = pk2(v[6][i], v[7][i]);
        hi.x = pk2(v[8][i], v[9][i]); hi.y = pk2(v[10][i], v[11][i]); hi.z = pk2(v[12][i], v[13][i]); hi.w = pk2(v[14][i], v[15][i]);
        *(u32x4*)d = lo; *(u32x4*)(d + 8) = hi;
    }
}
#define CONV_DENSE_ITEMS (832 + 256 + 512)
__device__ __forceinline__ void conv_dense_item(CParams& P, int it, int lane) {
    unsigned char* ws = P.ws;
    if (it < 832) { const int kb = it / 52, nb = it % 52; transpose_item(P.in[5], INCOLS, DM, kb * 64, nb * 64, (bf16_t*)(ws + WS_WTIN) + (size_t)nb * 64 * DM, lane); return; }
    it -= 832;
    if (it < 256) { const int kb = it / 16, nb = it % 16; transpose_item(P.in[6], DM, DM, kb * 64, nb * 64, (bf16_t*)(ws + WS_WTOUT) + (size_t)nb * 64 * DM, lane); return; }
    it -= 256;
    { const int kb = it / 32, nb = it % 32, n = nb * 64, half = n >> 10, c = n & 1023, row = (c >> 7) * 256 + half * 128 + (c & 127);
      transpose_item(P.in[27], 2 * DM, DM, kb * 64, n, (bf16_t*)(ws + WS_WTGLU) + (size_t)row * DM, lane); }
}
#define CONV_MOE_ITEMS (NEXP * 384)
__device__ __forceinline__ void conv_moe_item(CParams& P, int l, int it, int lane) {
    unsigned char* ws = P.ws;
    const int e = it / 384; int r = it % 384;
    if (r < 256) { const int which = r >> 7; r &= 127; const int kb = r >> 3, nb = r & 7, n = nb * 64, row = (n >> 7) * 256 + which * 128 + (n & 127);
        const float* W = (which ? P.in[33] : P.in[32]) + ((size_t)(l * NEXP + e) * DM) * DFF;
        transpose_item(W, DFF, DM, kb * 64, n, (bf16_t*)(ws + WS_WT13) + ((size_t)e * DM + row) * DM, lane); return; }
    r -= 256;
    { const int kb = r >> 4, nb = r & 15; const float* W = P.in[34] + ((size_t)(l * NEXP + e) * DFF) * DM;
      transpose_item(W, DM, DFF, kb * 64, nb * 64, (bf16_t*)(ws + WS_WT2) + ((size_t)e * DM + nb * 64) * DFF, lane); }
}

template <int MODE>
__device__ __forceinline__ void meta_gemm(const bf16_t* A, const bf16_t* Bt, float* Hrows, int task, int lane) {
    const int fr = lane & 15, fq = lane >> 4, c = task * 16 + fr;
    const bf16_t* b0 = MODE == 0 ? Bt + (size_t)c * DM : Bt + (size_t)((c >> 7) * 256 + (c & 127)) * DM;
    const bf16_t* b1 = b0 + (size_t)128 * DM;
    f32x4 acc0[2], acc1[2];
    acc0[0] = acc0[1] = acc1[0] = acc1[1] = (f32x4){0.f, 0.f, 0.f, 0.f};
#pragma unroll 4
    for (int kt = 0; kt < 32; ++kt) {
        const int ko = kt * 32 + fq * 8;
        const bf16x8 a0 = *(const bf16x8*)(A + (size_t)fr * DM + ko), a1 = *(const bf16x8*)(A + (size_t)(16 + fr) * DM + ko);
        const bf16x8 bv = *(const bf16x8*)(b0 + ko);
        acc0[0] = __builtin_amdgcn_mfma_f32_16x16x32_bf16(a0, bv, acc0[0], 0, 0, 0);
        acc0[1] = __builtin_amdgcn_mfma_f32_16x16x32_bf16(a1, bv, acc0[1], 0, 0, 0);
        if (MODE == 1) { const bf16x8 bg = *(const bf16x8*)(b1 + ko);
            acc1[0] = __builtin_amdgcn_mfma_f32_16x16x32_bf16(a0, bg, acc1[0], 0, 0, 0);
            acc1[1] = __builtin_amdgcn_mfma_f32_16x16x32_bf16(a1, bg, acc1[1], 0, 0, 0); }
    }
#pragma unroll
    for (int mi = 0; mi < 2; ++mi)
#pragma unroll
        for (int j = 0; j < 4; ++j) { float* p = Hrows + (size_t)(mi * 16 + fq * 4 + j) * DM + c;
            if (MODE == 0) *p += acc0[mi][j]; else *p += acc0[mi][j] / (1.f + __expf(-acc1[mi][j])); }
}
__device__ __forceinline__ void phase_0(CParams& P, unsigned char* lds, const int ph) {
    PHASE_PROLOGUE
            for (int row = gw; row < NT; row += NGW) {
                const float* src = row < NMAIN ? x + (size_t)row * DM : meta + (size_t)((row - NMAIN) & 15) * DM;
                f32x4 v[4];
#pragma unroll
                for (int j = 0; j < 4; ++j) { v[j] = ((const f32x4*)src)[lane + 64 * j]; ((f32x4*)(H + (size_t)row * DM))[lane + 64 * j] = v[j]; }
                store_norm_bf16(v, norm_mix, HN + (size_t)row * DM, lane);
            }
    for (int it = gw; it < CONV_DENSE_ITEMS; it += NGW) conv_dense_item(P, it, lane);
    for (int it = gw; it < CONV_MOE_ITEMS; it += NGW) conv_moe_item(P, 0, it, lane);
}

__device__ __forceinline__ void phase_1(CParams& P, unsigned char* lds, const int ph) {
    PHASE_PROLOGUE
    pg8::ProjOrder S; S.init(HN, WTIN, bid);
    pg8::EpiProj E{Qb, Kb, Vb, REST};
    pg8::gemm_phase<pg8::EpiProj, pg8::ProjOrder, true, true>((PG8_LAS unsigned char*)lds, DM, S, E);
}

__device__ __forceinline__ void phase_2(CParams& P, unsigned char* lds, const int ph) {
    PHASE_PROLOGUE
    float* sb = (float*)lds;
    for (int i = tid; i < 8 * 465; i += 512) sb[i] = rpb[i];
    __syncthreads();
    const bf16_t* VT = Vb;
    const int fr = lane & 15, fq = lane >> 4;
    for (int u = gw; u < 8192 + 16; u += NGW) {
        const bool metaq = u >= 8192;
        int b, h, r = 0, qb = 0;
        if (!metaq) { qb = u & 3; r = (u >> 2) & 127; h = (u >> 9) & 7; b = u >> 12; } else { const int m = u - 8192; b = m >> 3; h = m & 7; }
        const int c = qb * 16 + fr;
        const int qrow = metaq ? NMAIN + b * NMETA + fr : b * SEQ + r * 64 + c;
        const int R0 = min(max(r - 4, 0), 120), cs = qb == 0 ? 0 : (qb == 1 ? 8 : (qb == 2 ? 24 : 32));
        const int C0 = min(max(c - 8, 0), 48);
        bf16x8 qf0 = *(const bf16x8*)(Qb + (size_t)qrow * 512 + h * 64 + fq * 8), qf1 = *(const bf16x8*)(Qb + (size_t)qrow * 512 + h * 64 + 32 + fq * 8);
        f32x4 sacc[17];
        const f32x4 zero4 = (f32x4){0.f, 0.f, 0.f, 0.f};
        if (!metaq) {
#pragma unroll
            for (int kt = 0; kt < 16; ++kt) {
                const int krow0 = b * SEQ + (R0 + (kt >> 1)) * 64 + cs + 16 * (kt & 1);
                const bf16_t* kp = Kb + (size_t)(krow0 + fr) * 512 + h * 64 + fq * 8;
                const bf16x8 a0 = *(const bf16x8*)kp, a1 = *(const bf16x8*)(kp + 32);
                f32x4 acc = __builtin_amdgcn_mfma_f32_16x16x32_bf16(a0, qf0, zero4, 0, 0, 0);
                sacc[kt] = __builtin_amdgcn_mfma_f32_16x16x32_bf16(a1, qf1, acc, 0, 0, 0);
            }
        } else {
#pragma unroll
            for (int kt = 0; kt < 16; ++kt) sacc[kt] = zero4;
        }
        {
            const bf16_t* kp = Kb + (size_t)(NMAIN + b * NMETA + fr) * 512 + h * 64 + fq * 8;
            const bf16x8 a0 = *(const bf16x8*)kp, a1 = *(const bf16x8*)(kp + 32);
            f32x4 acc = __builtin_amdgcn_mfma_f32_16x16x32_bf16(a0, qf0, zero4, 0, 0, 0);
            sacc[16] = __builtin_amdgcn_mfma_f32_16x16x32_bf16(a1, qf1, acc, 0, 0, 0);
        }
        float mx = -1e30f;
#pragma unroll
        for (int kt = 0; kt < 16; ++kt) {
            const int dr = R0 + (kt >> 1) - r + 7;
#pragma unroll
            for (int j = 0; j < 4; ++j) {
                const int kc = cs + 16 * (kt & 1) + 4 * fq + j;
                const bool inb = !metaq && kc >= C0 && kc < C0 + 16;
                const int dc = min(max(kc - c + 15, 0), 30);
                const float s = inb ? sacc[kt][j] * 0.125f + sb[(h * 15 + dr) * 31 + dc] : -1e30f;
                sacc[kt][j] = s; mx = fmaxf(mx, s);
            }
        }
#pragma unroll
        for (int j = 0; j < 4; ++j) { const float s = sacc[16][j] * 0.125f; sacc[16][j] = s; mx = fmaxf(mx, s); }
        mx = fmaxf(mx, __shfl_xor(mx, 16)); mx = fmaxf(mx, __shfl_xor(mx, 32));
        float sum = 0.f;
#pragma unroll
        for (int kt = 0; kt < 17; ++kt)
#pragma unroll
            for (int j = 0; j < 4; ++j) { const float pv = __expf(sacc[kt][j] - mx); sacc[kt][j] = pv; sum += pv; }
        sum += __shfl_xor(sum, 16); sum += __shfl_xor(sum, 32);
        f32x4 o[4] = {zero4, zero4, zero4, zero4};
        if (!metaq) {
#pragma unroll
            for (int kr = 0; kr < 8; ++kr) {
                union { bf16x8 v; unsigned u[4]; } bf;
                bf.u[0] = pk2(sacc[2 * kr][0], sacc[2 * kr][1]); bf.u[1] = pk2(sacc[2 * kr][2], sacc[2 * kr][3]);
                bf.u[2] = pk2(sacc[2 * kr + 1][0], sacc[2 * kr + 1][1]); bf.u[3] = pk2(sacc[2 * kr + 1][2], sacc[2 * kr + 1][3]);
                const size_t tok0 = (size_t)b * SEQ + (R0 + kr) * 64 + cs + 4 * fq;
#pragma unroll
                for (int dt = 0; dt < 4; ++dt) {
                    const bf16_t* vp = VT + (size_t)(h * 64 + dt * 16 + fr) * NTP + tok0;
                    union { bf16x8 v; u32x2 h2[2]; } af;
                    af.h2[0] = *(const u32x2*)vp; af.h2[1] = *(const u32x2*)(vp + 16);
                    o[dt] = __builtin_amdgcn_mfma_f32_16x16x32_bf16(af.v, bf.v, o[dt], 0, 0, 0);
                }
            }
        }
        {
            union { bf16x8 v; unsigned u[4]; } bf;
            bf.u[0] = pk2(sacc[16][0], sacc[16][1]); bf.u[1] = pk2(sacc[16][2], sacc[16][3]); bf.u[2] = 0u; bf.u[3] = 0u;
            const size_t tokm = (size_t)NMAIN + b * NMETA + 4 * fq;
#pragma unroll
            for (int dt = 0; dt < 4; ++dt) {
                const bf16_t* vp = VT + (size_t)(h * 64 + dt * 16 + fr) * NTP + tokm;
                union { bf16x8 v; u32x2 h2[2]; } af;
                af.h2[0] = *(const u32x2*)vp; af.h2[1] = (u32x2){0u, 0u};
                o[dt] = __builtin_amdgcn_mfma_f32_16x16x32_bf16(af.v, bf.v, o[dt], 0, 0, 0);
            }
        }
        const float inv = 1.f / sum;
#pragma unroll
        for (int dt = 0; dt < 4; ++dt) {
            u32x2 ov; ov.x = pk2(o[dt][0] * inv, o[dt][1] * inv); ov.y = pk2(o[dt][2] * inv, o[dt][3] * inv);
            *(u32x2*)(A2 + (size_t)qrow * DM + h * 64 + dt * 16 + 4 * fq) = ov;
        }
    }
    __syncthreads();
}

__device__ __forceinline__ void phase_3(CParams& P, unsigned char* lds, const int ph) {
    PHASE_PROLOGUE
            for (int tk = gw; tk < NT; tk += NGW) {
                const int b = tk / LSEQ, p = tk % LSEQ, row = rowof(b, p);
                const bool hp = p > 0, hn = p + 1 < LSEQ;
                const int rowp = hp ? rowof(b, p - 1) : row, rown = hn ? rowof(b, p + 1) : row;
#pragma unroll
                for (int j = 0; j < 7; ++j) {
                    const int c = 4 * lane + 256 * j;
                    const u32x2 vc = *(const u32x2*)(REST + (size_t)row * RESTC + c);
                    u32x2 vp = *(const u32x2*)(REST + (size_t)rowp * RESTC + c);
                    u32x2 vn = *(const u32x2*)(REST + (size_t)rown * RESTC + c);
                    if (!hp) { vp.x = 0; vp.y = 0; }
                    if (!hn) { vn.x = 0; vn.y = 0; }
                    const f32x4 m4 = *(const f32x4*)(mu + c);
                    float pc[4] = {bflo(vc.x), bfhi(vc.x), bflo(vc.y), bfhi(vc.y)};
                    float pp[4] = {bflo(vp.x), bfhi(vp.x), bflo(vp.y), bfhi(vp.y)};
                    float pn[4] = {bflo(vn.x), bfhi(vn.x), bflo(vn.y), bfhi(vn.y)};
                    float o[4];
#pragma unroll
                    for (int i = 0; i < 4; ++i) o[i] = pc[i] + m4[i] * (0.5f * (pp[i] + pn[i]) - pc[i]);
                    if (j == 6) {
                        if (lane < 16) { for (int i = 0; i < 4; ++i) o[i] = tanhf(o[i]); }
                        else if (lane >= 32) { for (int i = 0; i < 4; ++i) o[i] = sigmoidf_(o[i]); }
                    }
                    u32x2 ov; ov.x = pk2(o[0], o[1]); ov.y = pk2(o[2], o[3]);
                    bf16_t* dst = j < 2 ? Rr + (size_t)row * 512 + c : (j < 4 ? KR + (size_t)row * 512 + (c - 512) : (j < 6 ? VV + (size_t)row * 512 + (c - 1024) : LOW + (size_t)row * 256 + (c - 1536)));
                    *(u32x2*)dst = ov;
                }
            }
}


__device__ __forceinline__ void phase_4(CParams& P, unsigned char* lds, const int ph) {
    PHASE_PROLOGUE
            const int nrt = (NT + 127) / 128;
            const int nunits = nrt * 4 * 5;
            for (int u = bid; u < nunits; u += G) {
                const int which = u / (nrt * 4), rem = u % (nrt * 4), rt = rem / 4, ct = rem % 4;
                f32x4 acc[4][2];
                const int koff = which < 2 ? 0 : (which < 4 ? 64 : 128), KK_ = which < 4 ? 64 : 128;
                const float* Bsrc = which < 2 ? w_up + (size_t)which * 64 * 512 : (which < 4 ? a_up + (size_t)(which - 2) * 64 * 512 : g_up);
                gemm_tile(lds, KK_, 512,
                          [&](int r) { int row = rt * 128 + r; if (row >= NT) row = NT - 1; return LOW + (size_t)row * 256 + koff; },
                          [&](int n) { return Bsrc + ct * 128 + n; }, acc);
                ACC_FOREACH(acc, { const int row = rt * 128 + rl, col = ct * 128 + cl; if (row < NT) {
                    if (which < 2) { const float wl = w0[which * 512 + col] + val; Wd[((size_t)which * NT + row) * 512 + col] = __expf(-0.6065306597f * sigmoidf_(wl)); }
                    else if (which < 4) { const int d = which - 2; AA[((size_t)d * NT + row) * 512 + col] = (bf16_t)f2bf(sigmoidf_(a0[d * 512 + col] + val)); }
                    else Gg[(size_t)row * 512 + col] = (bf16_t)f2bf(val); } });
            }
}


__device__ __forceinline__ void phase_5(CParams& P, unsigned char* lds, const int ph) {
    PHASE_PROLOGUE
            for (int row = gw; row < NT; row += NGW) {
                const int c0 = lane * 8;
                const u32x4 krv = *(const u32x4*)(KR + (size_t)row * 512 + c0);
                const u32x4 rv = *(const u32x4*)(Rr + (size_t)row * 512 + c0);
                float kr[8], rr[8], kkv[8];
#pragma unroll
                for (int i = 0; i < 4; ++i) { kr[2 * i] = bflo(krv[i]); kr[2 * i + 1] = bfhi(krv[i]); rr[2 * i] = bflo(rv[i]); rr[2 * i + 1] = bfhi(rv[i]); }
                float ss = 0.f;
#pragma unroll
                for (int i = 0; i < 8; ++i) { kkv[i] = kr[i] * k_k[c0 + i]; ss += kkv[i] * kkv[i]; }
                ss += __shfl_xor(ss, 1); ss += __shfl_xor(ss, 2); ss += __shfl_xor(ss, 4);
                const float inv = 1.f / fmaxf(sqrtf(ss), 1e-12f);
#pragma unroll
                for (int i = 0; i < 8; ++i) kkv[i] *= inv;
                u32x4 o; o.x = pk2(kkv[0], kkv[1]); o.y = pk2(kkv[2], kkv[3]); o.z = pk2(kkv[4], kkv[5]); o.w = pk2(kkv[6], kkv[7]);
                *(u32x4*)(KK + (size_t)row * 512 + c0) = o;
                float bsum = 0.f;
#pragma unroll
                for (int d = 0; d < 2; ++d) {
                    const u32x4 av = *(const u32x4*)(AA + ((size_t)d * NT + row) * 512 + c0);
                    float a[8], kka[8], kd[8];
#pragma unroll
                    for (int i = 0; i < 4; ++i) { a[2 * i] = bflo(av[i]); a[2 * i + 1] = bfhi(av[i]); }
#pragma unroll
                    for (int i = 0; i < 8; ++i) { kka[i] = kkv[i] * a[i]; kd[i] = kr[i] * (1.f + (a[i] - 1.f) * k_a[c0 + i]); bsum += rr[i] * kd[i] * r_k[c0 + i]; }
                    u32x4 o1; o1.x = pk2(kka[0], kka[1]); o1.y = pk2(kka[2], kka[3]); o1.z = pk2(kka[4], kka[5]); o1.w = pk2(kka[6], kka[7]);
                    *(u32x4*)(KKA + ((size_t)d * NT + row) * 512 + c0) = o1;
                    u32x4 o2; o2.x = pk2(kd[0], kd[1]); o2.y = pk2(kd[2], kd[3]); o2.z = pk2(kd[4], kd[5]); o2.w = pk2(kd[6], kd[7]);
                    *(u32x4*)(KD + ((size_t)d * NT + row) * 512 + c0) = o2;
                }
                bsum += __shfl_xor(bsum, 1); bsum += __shfl_xor(bsum, 2); bsum += __shfl_xor(bsum, 4);
                if ((lane & 7) == 0) BC[(size_t)row * 8 + (lane >> 3)] = bsum;
            }
}


struct ScanIn { f32x4 w; u32x2 kk, ka, kd, r; unsigned short vv; };
__device__ __forceinline__ void phase_6(CParams& P, unsigned char* lds, const int ph) {
    PHASE_PROLOGUE
    constexpr int U = 8;
    for (int cw = bid * 2 + wave; wave < 2 && cw < 512; cw += G * 2) {
        const int chain = cw >> 4, rg = cw & 15, d = chain >> 4, b = (chain >> 3) & 1, h = chain & 7;
        const int rr_ = lane >> 4, kq = lane & 15, vi = rg * 4 + rr_;
        float s0 = 0.f, s1 = 0.f, s2 = 0.f, s3 = 0.f;
        const float* Wp = Wd + (size_t)d * NT * 512 + h * 64 + 4 * kq;
        const bf16_t* KKp = KK + h * 64 + 4 * kq;
        const bf16_t* KKAp = KKA + (size_t)d * NT * 512 + h * 64 + 4 * kq;
        const bf16_t* KDp = KD + (size_t)d * NT * 512 + h * 64 + 4 * kq;
        const bf16_t* Rp = Rr + h * 64 + 4 * kq;
        const bf16_t* Vp = VV + h * 64 + vi;
        bf16_t* Yp = YFB + (size_t)d * NT * 512 + h * 64 + vi;
        ScanIn nxt[U];
#define SCAN_LOAD(dst, s_) do { const int p_ = d ? LSEQ - 1 - (s_) : (s_); const size_t o_ = (size_t)rowof(b, p_) * 512; \
            dst.w = *(const f32x4*)(Wp + o_); dst.kk = *(const u32x2*)(KKp + o_); dst.ka = *(const u32x2*)(KKAp + o_); dst.kd = *(const u32x2*)(KDp + o_); dst.r = *(const u32x2*)(Rp + o_); dst.vv = Vp[o_]; } while (0)
#pragma unroll
        for (int q = 0; q < U; ++q) SCAN_LOAD(nxt[q], q);
        for (int s = 0; s < LSEQ; s += U) {
            ScanIn cur[U];
#pragma unroll
            for (int q = 0; q < U; ++q) cur[q] = nxt[q];
            if (s + U < LSEQ) {
#pragma unroll
                for (int q = 0; q < U; ++q) SCAN_LOAD(nxt[q], s + U + q);
            }
#pragma unroll
            for (int q = 0; q < U; ++q) {
                const ScanIn& c = cur[q];
                const float vv = bf2f(c.vv);
                float dot = s0 * bflo(c.kk.x) + s1 * bfhi(c.kk.x) + s2 * bflo(c.kk.y) + s3 * bfhi(c.kk.y);
                const float t0 = s0 * c.w[0] + vv * bflo(c.kd.x), t1 = s1 * c.w[1] + vv * bfhi(c.kd.x), t2 = s2 * c.w[2] + vv * bflo(c.kd.y), t3 = s3 * c.w[3] + vv * bfhi(c.kd.y);
                dot = row16_sum(dot);
                s0 = t0 - dot * bflo(c.ka.x); s1 = t1 - dot * bfhi(c.ka.x); s2 = t2 - dot * bflo(c.ka.y); s3 = t3 - dot * bfhi(c.ka.y);
                float y = s0 * bflo(c.r.x) + s1 * bfhi(c.r.x) + s2 * bflo(c.r.y) + s3 * bfhi(c.r.y);
                y = row16_sum(y);
                const int p_ = d ? LSEQ - 1 - (s + q) : (s + q);
                if (kq == 0) Yp[(size_t)rowof(b, p_) * 512] = (bf16_t)f2bf(y);
            }
        }
#undef SCAN_LOAD
    }
}

__device__ __forceinline__ void phase_7(CParams& P, unsigned char* lds, const int ph) {
    PHASE_PROLOGUE
            for (int row = gw; row < NT; row += NGW) {
                const int c0 = lane * 8;
                const u32x4 yf = *(const u32x4*)(YFB + (size_t)row * 512 + c0);
                const u32x4 yb = *(const u32x4*)(YFB + ((size_t)NT + row) * 512 + c0);
                const u32x4 vv = *(const u32x4*)(VV + (size_t)row * 512 + c0);
                const u32x4 gg = *(const u32x4*)(Gg + (size_t)row * 512 + c0);
                float y[8], v[8], g[8];
#pragma unroll
                for (int i = 0; i < 4; ++i) { y[2 * i] = bflo(yf[i]) + bflo(yb[i]); y[2 * i + 1] = bfhi(yf[i]) + bfhi(yb[i]); v[2 * i] = bflo(vv[i]); v[2 * i + 1] = bfhi(vv[i]); g[2 * i] = bflo(gg[i]); g[2 * i + 1] = bfhi(gg[i]); }
                float sm = 0.f;
#pragma unroll
                for (int i = 0; i < 8; ++i) sm += y[i];
                sm += __shfl_xor(sm, 1); sm += __shfl_xor(sm, 2); sm += __shfl_xor(sm, 4);
                const float mean = sm * (1.f / 64.f);
                float vr = 0.f;
#pragma unroll
                for (int i = 0; i < 8; ++i) { const float dlt = y[i] - mean; vr += dlt * dlt; }
                vr += __shfl_xor(vr, 1); vr += __shfl_xor(vr, 2); vr += __shfl_xor(vr, 4);
                const float rstd = rsqrtf(vr * (1.f / 64.f) + 64e-5f);
                const float bc = BC[(size_t)row * 8 + (lane >> 3)];
                float o[8];
#pragma unroll
                for (int i = 0; i < 8; ++i) o[i] = ((y[i] - mean) * rstd * lnx_g[c0 + i] + lnx_b[c0 + i] + bc * v[i]) * g[i];
                u32x4 ov; ov.x = pk2(o[0], o[1]); ov.y = pk2(o[2], o[3]); ov.z = pk2(o[4], o[5]); ov.w = pk2(o[6], o[7]);
                *(u32x4*)(A2 + (size_t)row * DM + 512 + c0) = ov;
            }
}


__device__ __forceinline__ void phase_8(CParams& P, unsigned char* lds, const int ph) {
    PHASE_PROLOGUE
    if (gw < 64) meta_gemm<0>(A2 + (size_t)NMAIN * DM, WTOUT, H + (size_t)NMAIN * DM, gw, lane);
    pg8::DenseOrder S; S.init(A2, WTOUT, NMAIN, DM, DM, G, bid);
    pg8::EpiResidual E{H};
    pg8::gemm_phase<pg8::EpiResidual, pg8::DenseOrder, true, true>((PG8_LAS unsigned char*)lds, DM, S, E);
}

__device__ __forceinline__ void phase_9(CParams& P, unsigned char* lds, const int ph) {
    PHASE_PROLOGUE
            const int l = ph == 9 ? 0 : 1;
                    unsigned* cnt = CTL + CW_CNT(l);
            const float* wg = moe_wg + (size_t)l * DM * 4; const float* bg = moe_bg + l * 4;
            for (int row = gw; row < NT; row += NGW) {
                f32x4 v[4]; float ss = 0.f;
#pragma unroll
                for (int j = 0; j < 4; ++j) { v[j] = ((const f32x4*)(H + (size_t)row * DM))[lane + 64 * j]; ss += v[j][0] * v[j][0] + v[j][1] * v[j][1] + v[j][2] * v[j][2] + v[j][3] * v[j][3]; }
                ss = wave_sum(ss);
                const float rstd = rsqrtf(ss * (1.f / DM) + 1e-6f);
                float lg[4] = {0.f, 0.f, 0.f, 0.f};
#pragma unroll
                for (int j = 0; j < 4; ++j) {
                    const f32x4 g = ((const f32x4*)(norm_ffn + l * DM))[lane + 64 * j];
#pragma unroll
                    for (int i = 0; i < 4; ++i) v[j][i] = v[j][i] * rstd * g[i];
                    u32x2 o; o.x = pk2(v[j][0], v[j][1]); o.y = pk2(v[j][2], v[j][3]);
                    ((u32x2*)(HN + (size_t)row * DM))[lane + 64 * j] = o;
#pragma unroll
                    for (int i = 0; i < 4; ++i) { const f32x4 w = *(const f32x4*)(wg + (size_t)(4 * (lane + 64 * j) + i) * 4);
                        lg[0] += v[j][i] * w[0]; lg[1] += v[j][i] * w[1]; lg[2] += v[j][i] * w[2]; lg[3] += v[j][i] * w[3]; }
                }
#pragma unroll
                for (int q = 0; q < 4; ++q) lg[q] = wave_sum(lg[q]) + bg[q];
                int grp = 0; float mx = lg[0];
#pragma unroll
                for (int q = 1; q < 4; ++q) if (lg[q] > mx) { mx = lg[q]; grp = q; }
                float den = 0.f;
#pragma unroll
                for (int q = 0; q < 4; ++q) den += __expf(lg[q] - mx);
                const float pgrp = 1.f / den;
                const float* we = moe_we + ((size_t)(l * 4 + grp) * DM) * 8;
                float le[8] = {0.f, 0.f, 0.f, 0.f, 0.f, 0.f, 0.f, 0.f};
#pragma unroll
                for (int j = 0; j < 4; ++j)
#pragma unroll
                    for (int i = 0; i < 4; ++i) { const float* wr_ = we + (size_t)(4 * (lane + 64 * j) + i) * 8; const f32x4 wa = *(const f32x4*)wr_, wb = *(const f32x4*)(wr_ + 4);
                        le[0] += v[j][i] * wa[0]; le[1] += v[j][i] * wa[1]; le[2] += v[j][i] * wa[2]; le[3] += v[j][i] * wa[3];
                        le[4] += v[j][i] * wb[0]; le[5] += v[j][i] * wb[1]; le[6] += v[j][i] * wb[2]; le[7] += v[j][i] * wb[3]; }
#pragma unroll
                for (int q = 0; q < 8; ++q) le[q] = wave_sum(le[q]) + moe_be[(l * 4 + grp) * 8 + q];
                int i1 = 0; float m1 = le[0];
#pragma unroll
                for (int q = 1; q < 8; ++q) if (le[q] > m1) { m1 = le[q]; i1 = q; }
                int i2 = -1; float m2 = -3.0e38f;
#pragma unroll
                for (int q = 0; q < 8; ++q) if (q != i1 && le[q] > m2) { m2 = le[q]; i2 = q; }
                const float e2 = __expf(m2 - m1);
                const float g1 = pgrp / (1.f + e2), g2 = pgrp * e2 / (1.f + e2);
                if (lane == 0) {
                    const int ea = grp * 8 + i1, eb = grp * 8 + i2;
                    const unsigned pa = atomicAdd(cnt + ea, 1u), pb = atomicAdd(cnt + eb, 1u);
                    EID[row * 2] = ea; EID[row * 2 + 1] = eb; POS[row * 2] = (int)pa; POS[row * 2 + 1] = (int)pb;
                    GATE[row * 2] = g1; GATE[row * 2 + 1] = g2;
                }
            }
}


__device__ __forceinline__ void phase_10(CParams& P, unsigned char* lds, const int ph) {
    PHASE_PROLOGUE
    const int l = ph == 10 ? 0 : 1;
    int* ps = (int*)(lds + LDS_TAB);
    if (tid == 0) { int acc_ = 0; for (int e = 0; e < NEXP; ++e) { ps[e] = acc_; const int c = (int)CTL[CW_CNT(l) + e]; acc_ += (c + MOE_RT - 1) / MOE_RT * MOE_RT; } ps[NEXP] = acc_; }
    __syncthreads();
    for (int row = gw; row < NT; row += NGW) {
        const u32x4 v0 = ((const u32x4*)(HN + (size_t)row * DM))[lane], v1 = ((const u32x4*)(HN + (size_t)row * DM))[lane + 64];
#pragma unroll
        for (int k = 0; k < 2; ++k) {
            const int dest = ps[EID[row * 2 + k]] + POS[row * 2 + k];
            if (lane == 0) DEST[row * 2 + k] = dest;
            ((u32x4*)(XB + (size_t)dest * DM))[lane] = v0; ((u32x4*)(XB + (size_t)dest * DM))[lane + 64] = v1;
        }
    }
    __syncthreads();
}

__device__ __forceinline__ void phase_11(CParams& P, unsigned char* lds, const int ph) {
    PHASE_PROLOGUE
    const int l = ph == 11 ? 0 : 1;
    int* et = (int*)(lds + LDS_TAB);
    if (tid == 0) { int acc_ = 0; for (int e = 0; e < NEXP; ++e) { const int c = (int)CTL[CW_CNT(l) + e], n = (c + MOE_RT - 1) / MOE_RT; for (int q = 0; q < n; ++q) et[1 + acc_ + q] = e; acc_ += n; } et[0] = acc_; }
    __syncthreads();
    pg8::MoeOrder S{et + 1, et[0], vcu, (const char*)XB, (const char*)WT13, 256u * DM * 2u, 256u * DM * 2u, (unsigned)DM * DM * 2u};
    pg8::EpiSwiglu E{HB};
    pg8::gemm_phase<pg8::EpiSwiglu, pg8::MoeOrder, true, true>((PG8_LAS unsigned char*)lds, DM, S, E);
    __syncthreads();
}

__device__ __forceinline__ void phase_12(CParams& P, unsigned char* lds, const int ph) {
    PHASE_PROLOGUE
    const int l = ph == 12 ? 0 : 1;
    int* et = (int*)(lds + LDS_TAB);
    if (tid == 0) { int acc_ = 0; for (int e = 0; e < NEXP; ++e) { const int c = (int)CTL[CW_CNT(l) + e], n = (c + MOE_RT - 1) / MOE_RT; for (int q = 0; q < n; ++q) et[1 + acc_ + q] = e; acc_ += n; } et[0] = acc_; }
    __syncthreads();
    pg8::MoeOrder S{et + 1, et[0], vcu, (const char*)HB, (const char*)WT2, 256u * DFF * 2u, 256u * DFF * 2u, (unsigned)DM * DFF * 2u};
    pg8::EpiBf16Plain E{YB, DM};
    pg8::gemm_phase<pg8::EpiBf16Plain, pg8::MoeOrder, true, true>((PG8_LAS unsigned char*)lds, DFF, S, E);
    __syncthreads();
}

__device__ __forceinline__ void phase_13(CParams& P, unsigned char* lds, const int ph) {
    PHASE_PROLOGUE
            const bool fin = ph == 21;
            for (int row = gw; row < NT; row += NGW) {
                const int d0 = DEST[row * 2], d1 = DEST[row * 2 + 1];
                const float g0 = GATE[row * 2], g1 = GATE[row * 2 + 1];
                f32x4 v[4];
#pragma unroll
                for (int j = 0; j < 4; ++j) {
                    v[j] = ((const f32x4*)(H + (size_t)row * DM))[lane + 64 * j];
                    const u32x2 ya = ((const u32x2*)(YB + (size_t)d0 * DM))[lane + 64 * j];
                    const u32x2 yb = ((const u32x2*)(YB + (size_t)d1 * DM))[lane + 64 * j];
                    v[j][0] += g0 * bflo(ya.x) + g1 * bflo(yb.x); v[j][1] += g0 * bfhi(ya.x) + g1 * bfhi(yb.x);
                    v[j][2] += g0 * bflo(ya.y) + g1 * bflo(yb.y); v[j][3] += g0 * bfhi(ya.y) + g1 * bfhi(yb.y);
                }
                if (!fin) {
#pragma unroll
                    for (int j = 0; j < 4; ++j) ((f32x4*)(H + (size_t)row * DM))[lane + 64 * j] = v[j];
                    store_norm_bf16(v, norm_mix + DM, HN + (size_t)row * DM, lane);
                } else if (row < NMAIN) {
                    float ss = 0.f;
#pragma unroll
                    for (int j = 0; j < 4; ++j) ss += v[j][0] * v[j][0] + v[j][1] * v[j][1] + v[j][2] * v[j][2] + v[j][3] * v[j][3];
                    ss = wave_sum(ss);
                    const float rstd = rsqrtf(ss * (1.f / DM) + 1e-6f);
#pragma unroll
                    for (int j = 0; j < 4; ++j) { const f32x4 g = ((const f32x4*)norm_final)[lane + 64 * j]; f32x4 o;
                        o[0] = v[j][0] * rstd * g[0]; o[1] = v[j][1] * rstd * g[1]; o[2] = v[j][2] * rstd * g[2]; o[3] = v[j][3] * rstd * g[3];
                        ((f32x4*)(P.out + (size_t)row * DM))[lane + 64 * j] = o; }
                }
            }
    if (!fin) { for (int it = gw; it < CONV_MOE_ITEMS; it += NGW) conv_moe_item(P, 1, it, lane); }
}

__device__ __forceinline__ void phase_14(CParams& P, unsigned char* lds, const int ph) {
    PHASE_PROLOGUE
            const bool outp = ph == 16;
            const int nunits = 2 * NB * 64 * S5NC;
            for (int u = gw; u < nunits; u += NGW) {
                const int c = u % S5NC, dbg = u / S5NC, g = dbg & 63, b = (dbg >> 6) & 1, d = dbg >> 7;
                const int p = lane;
                const float step = __expf(s5_ls[d * 64 + g]);
                const float lr = s5_lre[(d * 64 + g) * 64 + p], li = s5_lim[(d * 64 + g) * 64 + p];
                const float mag = expf(lr * step);
                const float abr = mag * cosf(li * step), abi = mag * sinf(li * step);
                const float den = lr * lr + li * li;
                const float zr = ((abr - 1.f) * lr + abi * li) / den, zi = (abi * lr - (abr - 1.f) * li) / den;
                float bbr[16], bbi[16];
#pragma unroll
                for (int q = 0; q < 4; ++q) {
                    const f32x4 br = *(const f32x4*)(s5_b_re + ((size_t)(g * 64 + p)) * 16 + 4 * q), bi = *(const f32x4*)(s5_b_im + ((size_t)(g * 64 + p)) * 16 + 4 * q);
#pragma unroll
                    for (int i = 0; i < 4; ++i) { bbr[4 * q + i] = zr * br[i] - zi * bi[i]; bbi[4 * q + i] = zr * bi[i] + zi * br[i]; }
                }
                float sr = 0.f, si = 0.f;
                if (outp) { const float* cp = CARRY + (((size_t)dbg * S5NC + c) * 64 + p) * 2; sr = cp[0]; si = cp[1]; }
                float cre[16], cim[16];
                if (outp) {
#pragma unroll
                    for (int i = 0; i < 16; ++i) { cre[i] = s5_c_re[((size_t)(d * 64 + g) * 16 + i) * 64 + p]; cim[i] = s5_c_im[((size_t)(d * 64 + g) * 16 + i) * 64 + p]; }
                }
                for (int tt = 0; tt < S5TC; ++tt) {
                    const int sidx = c * S5TC + tt, pos = d ? LSEQ - 1 - sidx : sidx, row = rowof(b, pos);
                    const u32x4 ua = *(const u32x4*)(HN + (size_t)row * DM + g * 16), ub = *(const u32x4*)(HN + (size_t)row * DM + g * 16 + 8);
                    float uu[16];
#pragma unroll
                    for (int i = 0; i < 4; ++i) { uu[2 * i] = bflo(ua[i]); uu[2 * i + 1] = bfhi(ua[i]); uu[8 + 2 * i] = bflo(ub[i]); uu[8 + 2 * i + 1] = bfhi(ub[i]); }
                    float bur = 0.f, bui = 0.f;
#pragma unroll
                    for (int i = 0; i < 16; ++i) { bur += bbr[i] * uu[i]; bui += bbi[i] * uu[i]; }
                    const float nr = abr * sr - abi * si + bur, ni = abr * si + abi * sr + bui;
                    sr = nr; si = ni;
                    if (outp) {
                        float mine = 0.f;
#pragma unroll
                        for (int i = 0; i < 16; ++i) { const float yv = wave_sum(cre[i] * sr - cim[i] * si); if (lane == i) mine = yv; }
                        if (lane < 16) YS[((size_t)d * NT + row) * DM + g * 16 + lane] = mine;
                    }
                }
                if (!outp) { float* ep = ENDS + (((size_t)dbg * S5NC + c) * 64 + p) * 2; ep[0] = sr; ep[1] = si; }
            }
}


__device__ __forceinline__ void phase_15(CParams& P, unsigned char* lds, const int ph) {
    PHASE_PROLOGUE
            for (int i = bid * 512 + tid; i < 2 * NB * 64 * 64; i += G * 512) {
                const int p = i & 63, dbg = i >> 6, g = dbg & 63, d = dbg >> 7;
                const float step = __expf(s5_ls[d * 64 + g]);
                const float lr = s5_lre[(d * 64 + g) * 64 + p], li = s5_lim[(d * 64 + g) * 64 + p];
                const float mag = expf(lr * step * (float)S5TC);
                const float ang = li * step;
                float pr = 1.f, pi = 0.f; const float cr = cosf(ang), ci = sinf(ang);
                for (int q = 0; q < S5TC; ++q) { const float t = pr * cr - pi * ci; pi = pr * ci + pi * cr; pr = t; }
                const float ar = mag * pr, ai = mag * pi;
                float yr = 0.f, yi = 0.f;
                for (int c = 0; c < S5NC; ++c) {
                    const size_t o = (((size_t)dbg * S5NC + c) * 64 + p) * 2;
                    CARRY[o] = yr; CARRY[o + 1] = yi;
                    const float er = ENDS[o], ei = ENDS[o + 1];
                    const float t = ar * yr - ai * yi + er; yi = ar * yi + ai * yr + ei; yr = t;
                }
            }
}


__device__ __forceinline__ void phase_22(CParams& P, unsigned char* lds, const int ph) {
    PHASE_PROLOGUE
            for (size_t i = (size_t)bid * 512 + tid; i < (size_t)NT * DM / 4; i += (size_t)G * 512) {
                const f32x4 y0 = ((const f32x4*)YS)[i], y1 = ((const f32x4*)(YS + (size_t)NT * DM))[i];
                const int col = (int)((i * 4) & (DM - 1));
                const f32x4 dd = *(const f32x4*)(s5_d + col);
                const u32x2 uu = ((const u32x2*)HN)[i];
                float u4[4] = {bflo(uu.x), bfhi(uu.x), bflo(uu.y), bfhi(uu.y)};
                float o[4];
#pragma unroll
                for (int q = 0; q < 4; ++q) { const float yv = y0[q] + y1[q] + dd[q] * u4[q];
                    o[q] = 0.5f * yv * (1.f + tanhf(0.7978845608f * (yv + 0.044715f * yv * yv * yv))); }
                u32x2 ov; ov.x = pk2(o[0], o[1]); ov.y = pk2(o[2], o[3]);
                ((u32x2*)A2)[i] = ov;
            }
}


__device__ __forceinline__ void phase_23(CParams& P, unsigned char* lds, const int ph) {
    PHASE_PROLOGUE
    if (gw < 64) meta_gemm<1>(A2 + (size_t)NMAIN * DM, WTGLU, H + (size_t)NMAIN * DM, gw, lane);
    pg8::DenseOrder S; S.init(A2, WTGLU, NMAIN, 2 * DM, DM, G, bid);
    pg8::EpiGlu E{H};
    pg8::gemm_phase<pg8::EpiGlu, pg8::DenseOrder, true, true>((PG8_LAS unsigned char*)lds, DM, S, E);
}
#define LAS __attribute__((address_space(3)))
#define CW_BAR 4096
#define XB_TMO      128
#define XB_XCNT(j)  (256  + 64 * (j))
#define XB_XSUB(j)  (1280 + 64 * (j))
#define XB_XGEN(j)  (2304 + 64 * (j))
#define XB_TOP      3328
#define XB_TOPGEN   3392
#define XCD_BAR_WORDS 3456
#define XB_SPIN_CAP (1u << 22)
__device__ __forceinline__ unsigned xb_ld(unsigned* p)              { return __hip_atomic_load(p, __ATOMIC_RELAXED, __HIP_MEMORY_SCOPE_AGENT); }
__device__ __forceinline__ unsigned xb_add(unsigned* p, unsigned v) { return __hip_atomic_fetch_add(p, v, __ATOMIC_RELAXED, __HIP_MEMORY_SCOPE_AGENT); }
__device__ __forceinline__ unsigned xb_xcc_id() { return (unsigned)__builtin_amdgcn_s_getreg((3 << 11) | 20) & 0xFu; }
#define XB_SPIN(cond, bar) do { unsigned _sp = 0; while (cond) { __builtin_amdgcn_s_sleep(1); \
    if ((++_sp & 255u) == 0u) { if (xb_ld(&(bar)[XB_TMO])) break; if (_sp > XB_SPIN_CAP) { atomicAdd(&(bar)[XB_TMO], 1u); break; } } } } while (0)
struct XcdBarrier { unsigned* bar; unsigned x; volatile LAS unsigned* st; };
__device__ __forceinline__ XcdBarrier xcd_barrier_post(unsigned* bar, volatile LAS unsigned* st) {
    XcdBarrier b; b.bar = bar; b.x = xb_xcc_id(); b.st = st;
    if (threadIdx.x == 0) (void)xb_add(&bar[XB_XCNT(b.x)], 1u);
    return b;
}
__device__ __forceinline__ void xcd_barrier_complete(unsigned* bar, unsigned x, unsigned& nloc, unsigned& nx) {
    const unsigned G = GRID;
    unsigned sum, cnt, mine, sp = 0u;
    for (;;) {
        sum = 0u; cnt = 0u; mine = 0u;
#pragma unroll
        for (unsigned j = 0; j < 16; ++j) { const unsigned c = xb_ld(&bar[XB_XCNT(j)]); sum += c; cnt += (c > 0u) ? 1u : 0u; mine = (j == x) ? c : mine; }
        if (sum == G) break;
        __builtin_amdgcn_s_sleep(1);
        if ((++sp & 255u) == 0u) { if (xb_ld(&bar[XB_TMO])) break; if (sp > XB_SPIN_CAP) { atomicAdd(&bar[XB_TMO], 1u); break; } }
    }
    nloc = mine > 0u ? mine : 1u; nx = cnt > 0u ? cnt : 1u;
}
__device__ __forceinline__ void xcd_barrier(const XcdBarrier& b) {
    asm volatile("s_waitcnt vmcnt(0)" ::: "memory");
    __syncthreads();
    if (threadIdx.x == 0) {
        unsigned* bar = b.bar;
        __builtin_amdgcn_s_waitcnt(0);
        unsigned nloc = b.st[0], nx = b.st[1];
        if (nloc == 0u) { xcd_barrier_complete(bar, b.x, nloc, nx); b.st[0] = nloc; b.st[1] = nx; }
        const unsigned old = xb_add(&bar[XB_XSUB(b.x)], 1u);
        const unsigned gen = old / nloc;
        if (old + 1u == (gen + 1u) * nloc) {
            __builtin_amdgcn_fence(__ATOMIC_RELEASE, "agent");
            asm volatile("s_waitcnt vmcnt(0)" ::: "memory");
            const unsigned og = xb_add(&bar[XB_TOP], 1u);
            const unsigned tg = og / nx;
            if (og + 1u == (tg + 1u) * nx) xb_add(&bar[XB_TOPGEN], 1u);
            else XB_SPIN(xb_ld(&bar[XB_TOPGEN]) == tg, bar);
            __builtin_amdgcn_fence(__ATOMIC_ACQUIRE, "agent");
            xb_add(&bar[XB_XGEN(b.x)], 1u);
            asm volatile("s_waitcnt vmcnt(0)" ::: "memory");
        } else {
            XB_SPIN(xb_ld(&bar[XB_XGEN(b.x)]) == gen, bar);
            __builtin_amdgcn_fence(__ATOMIC_ACQUIRE, "agent");
            asm volatile("s_waitcnt vmcnt(0)" ::: "memory");
        }
    }
    __syncthreads();
}


__global__ void __launch_bounds__(512, 2) mega(Params P_) {
    extern __shared__ __attribute__((aligned(16))) unsigned char lds[];
    volatile LAS unsigned* st = (volatile LAS unsigned*)(LAS unsigned char*)(lds + LDS_BARST);
    if (threadIdx.x < 16) st[threadIdx.x] = 0u;
    __syncthreads();
    CParams* pp = (CParams*)__builtin_amdgcn_kernarg_segment_ptr();
    (void)xcd_barrier_post((unsigned*)(pp->ws + WS_CTL) + CW_BAR, st);
#define GB do { XcdBarrier bar_; bar_.bar = (unsigned*)(pp->ws + WS_CTL) + CW_BAR; bar_.x = xb_xcc_id(); bar_.st = (volatile LAS unsigned*)(LAS unsigned char*)(lds + LDS_BARST); xcd_barrier(bar_); asm volatile("" : "+s"(pp)); } while (0)
#define P (*pp)
    asm volatile("" : "+s"(pp));
    phase_0(P, lds, 0); GB;
#if defined(PROBE_DUP) && PROBE_DUP == 0
    GB; phase_0(P, lds, 0); GB;
#endif
    phase_1(P, lds, 1); GB;
#if defined(PROBE_DUP) && PROBE_DUP == 1
    GB; phase_1(P, lds, 1); GB;
#endif
    phase_2(P, lds, 2); asm volatile("" : "+s"(pp));
#if defined(PROBE_DUP) && PROBE_DUP == 2
    GB; phase_2(P, lds, 2); GB;
#endif
    phase_3(P, lds, 3); GB;
#if defined(PROBE_DUP) && PROBE_DUP == 3
    GB; phase_3(P, lds, 3); GB;
#endif
    phase_4(P, lds, 4); GB;
#if defined(PROBE_DUP) && PROBE_DUP == 4
    GB; phase_4(P, lds, 4); GB;
#endif
    phase_5(P, lds, 5); GB;
#if defined(PROBE_DUP) && PROBE_DUP == 5
    GB; phase_5(P, lds, 5); GB;
#endif
    phase_6(P, lds, 6); GB;
#if defined(PROBE_DUP) && PROBE_DUP == 6
    GB; phase_6(P, lds, 6); GB;
#endif
    phase_7(P, lds, 7); GB;
#if defined(PROBE_DUP) && PROBE_DUP == 7
    GB; phase_7(P, lds, 7); GB;
#endif
    phase_8(P, lds, 8); GB;
#if defined(PROBE_DUP) && PROBE_DUP == 8
    GB; phase_8(P, lds, 8); GB;
#endif
    phase_9(P, lds, 9); GB;
#if defined(PROBE_DUP) && PROBE_DUP == 9
    GB; phase_9(P, lds, 9); GB;
#endif
    phase_10(P, lds, 10); GB;
#if defined(PROBE_DUP) && PROBE_DUP == 10
    GB; phase_10(P, lds, 10); GB;
#endif
    phase_11(P, lds, 11); GB;
#if defined(PROBE_DUP) && PROBE_DUP == 11
    GB; phase_11(P, lds, 11); GB;
#endif
    phase_12(P, lds, 12); GB;
#if defined(PROBE_DUP) && PROBE_DUP == 12
    GB; phase_12(P, lds, 12); GB;
#endif
    phase_13(P, lds, 13); GB;
#if defined(PROBE_DUP) && PROBE_DUP == 13
    GB; phase_13(P, lds, 13); GB;
#endif
    phase_14(P, lds, 14); GB;
#if defined(PROBE_DUP) && PROBE_DUP == 14
    GB; phase_14(P, lds, 14); GB;
#endif
    phase_15(P, lds, 15); GB;
#if defined(PROBE_DUP) && PROBE_DUP == 15
    GB; phase_15(P, lds, 15); GB;
#endif
    phase_14(P, lds, 16); GB;
#if defined(PROBE_DUP) && PROBE_DUP == 16
    GB; phase_14(P, lds, 16); GB;
#endif
    phase_22(P, lds, 22); GB;
#if defined(PROBE_DUP) && PROBE_DUP == 22
    GB; phase_22(P, lds, 22); GB;
#endif
    phase_23(P, lds, 23); GB;
#if defined(PROBE_DUP) && PROBE_DUP == 23
    GB; phase_23(P, lds, 23); GB;
#endif
    phase_9(P, lds, 17); GB;
#if defined(PROBE_DUP) && PROBE_DUP == 17
    GB; phase_9(P, lds, 17); GB;
#endif
    phase_10(P, lds, 18); GB;
#if defined(PROBE_DUP) && PROBE_DUP == 18
    GB; phase_10(P, lds, 18); GB;
#endif
    phase_11(P, lds, 19); GB;
#if defined(PROBE_DUP) && PROBE_DUP == 19
    GB; phase_11(P, lds, 19); GB;
#endif
    phase_12(P, lds, 20); GB;
#if defined(PROBE_DUP) && PROBE_DUP == 20
    GB; phase_12(P, lds, 20); GB;
#endif
    phase_13(P, lds, 21);
#if defined(PROBE_DUP) && PROBE_DUP == 21
    GB; phase_13(P, lds, 21); GB;
#endif
#undef P
#undef GB
}

extern "C" void kernel_launch(void* const* d_in, const int* in_sizes, int n_in, void* d_out, int out_size, void* d_ws, size_t ws_size, hipStream_t stream) {
    static int ready = 0;
    if (!ready) {
        if (n_in != 35 || ws_size < WS_TOTAL) { fprintf(stderr, "kernel_launch: unexpected n_in %d or ws_size %zu (need %zu)\n", n_in, ws_size, (size_t)WS_TOTAL); ready = -1; return; }
        if (hipFuncSetAttribute((const void*)mega, hipFuncAttributeMaxDynamicSharedMemorySize, LDS_BYTES) != hipSuccess) { fprintf(stderr, "kernel_launch: hipFuncSetAttribute failed\n"); ready = -1; return; }
        ready = 1;
    }
    if (ready < 0) return;
    (void)hipMemsetAsync((char*)d_ws + WS_CTL, 0, 1 * MiB, stream);
    Params P{};
    for (int i = 0; i < 35; ++i) P.in[i] = (const float*)d_in[i];
    P.out = (float*)d_out; P.ws = (unsigned char*)d_ws; P.ph_lo = 0; P.ph_hi = 0;
    hipLaunchKernelGGL(mega, dim3(GRID), dim3(512), LDS_BYTES, stream, P);
}
```

```cpp
#include <hip/hip_runtime.h>
#include <stdint.h>
#include <stdio.h>

#define DM 1024
#define NB 2
#define SEQ 8192
#define NMETA 16
#define LSEQ (SEQ + NMETA)
#define NMAIN (NB * SEQ)
#define NT (NB * LSEQ)
#define NTP 16640
#define INCOLS 3328
#define RESTC 1792
#define NEXP 32
#define DFF 512
#define S5TC 48
#define S5NC 171
#define MOE_RT 256
#define MOE_MAXROWS 41216

typedef unsigned short bf16_t;
typedef short bf16x8 __attribute__((ext_vector_type(8)));
typedef float f32x4 __attribute__((ext_vector_type(4)));
typedef unsigned u32x4 __attribute__((ext_vector_type(4)));
typedef unsigned u32x2 __attribute__((ext_vector_type(2)));

constexpr size_t MiB = 1u << 20;
constexpr size_t al64k(size_t x) { return (x + 65535) & ~(size_t)65535; }
constexpr size_t WS_CTL = 0;
constexpr size_t WS_H = 1 * MiB;
constexpr size_t WS_HN = WS_H + al64k((size_t)NT * DM * 4);
constexpr size_t WS_A2 = WS_HN + al64k((size_t)NTP * DM * 2);
constexpr size_t WS_WTIN = WS_A2 + al64k((size_t)NTP * DM * 2);
constexpr size_t WS_WTOUT = WS_WTIN + al64k((size_t)INCOLS * DM * 2);
constexpr size_t WS_WTGLU = WS_WTOUT + al64k((size_t)DM * DM * 2);
constexpr size_t WS_WT13 = WS_WTGLU + al64k((size_t)2 * DM * DM * 2);
constexpr size_t WS_WT2 = WS_WT13 + al64k((size_t)NEXP * DM * DM * 2);
constexpr size_t WS_BIG = WS_WT2 + al64k((size_t)NEXP * DM * DFF * 2);
constexpr size_t SZ_T512 = al64k((size_t)NT * 512 * 2);
constexpr size_t SZ_P512 = al64k((size_t)NTP * 512 * 2);
constexpr size_t WS_Q = WS_BIG;
constexpr size_t WS_K = WS_Q + SZ_P512;
constexpr size_t WS_V = WS_K + SZ_P512;
constexpr size_t WS_REST = WS_V + SZ_P512;
constexpr size_t WS_R = WS_REST + al64k((size_t)NTP * RESTC * 2);
constexpr size_t WS_KR = WS_R + SZ_T512;
constexpr size_t WS_VV = WS_KR + SZ_T512;
constexpr size_t WS_LOW = WS_VV + SZ_T512;
constexpr size_t WS_G = WS_LOW + al64k((size_t)NT * 256 * 2);
constexpr size_t WS_KK = WS_G + SZ_T512;
constexpr size_t WS_KKA = WS_KK + SZ_T512;
constexpr size_t WS_KD = WS_KKA + 2 * SZ_T512;
constexpr size_t WS_BC = WS_KD + 2 * SZ_T512;
constexpr size_t WS_MIXEND = WS_BC + al64k((size_t)NT * 8 * 4);
constexpr size_t WS_AA = WS_Q;
constexpr size_t WS_YFB = WS_Q;
constexpr size_t WS_W = WS_V;
static_assert(2 * SZ_T512 <= 2 * SZ_P512, "AA/YFB fit in Q|K");
static_assert((size_t)2 * NT * 512 * 4 <= SZ_P512 + al64k((size_t)NTP * RESTC * 2), "W fits in V|REST");
constexpr size_t WS_XB = WS_BIG;
constexpr size_t WS_HB = WS_XB + al64k((size_t)MOE_MAXROWS * DM * 2);
constexpr size_t WS_YB = WS_HB + al64k((size_t)MOE_MAXROWS * DFF * 2);
constexpr size_t WS_EID = WS_YB + al64k((size_t)MOE_MAXROWS * DM * 2);
constexpr size_t WS_POS = WS_EID + al64k((size_t)NT * 8);
constexpr size_t WS_DEST = WS_POS + al64k((size_t)NT * 8);
constexpr size_t WS_GATE = WS_DEST + al64k((size_t)NT * 8);
constexpr size_t WS_MOEEND = WS_GATE + al64k((size_t)NT * 8);
constexpr size_t WS_YI = WS_BIG;
constexpr size_t WS_E = WS_YI + al64k((size_t)NTP * DM * 4);
constexpr size_t WS_CAR = WS_E + al64k((size_t)1040 * 64 * 256 * 4);
constexpr size_t WS_BTA = WS_CAR + al64k((size_t)64 * 1280 * 256 * 2);
constexpr size_t WS_BTC = WS_BTA + al64k((size_t)64 * 512 * 256 * 2);
constexpr size_t WS_S5END = WS_BTC + al64k((size_t)64 * 256 * 256 * 2);
constexpr size_t cmax(size_t a, size_t b) { return a > b ? a : b; }
constexpr size_t WS_TOTAL = cmax(WS_MIXEND, cmax(WS_MOEEND, WS_S5END));
static_assert(WS_TOTAL <= 512 * MiB, "workspace map exceeds 512 MiB");

#define CW_CNT(l) (1024 + 64 * (l))

#define LDS_RING 131072
#define LDS_BARST (LDS_RING)
#define LDS_TAB (LDS_RING + 256)
#define LDS_BYTES 147456
#define GRID 256

struct Params {
    const float* in[35];
    float* out;
    unsigned char* ws;
    int ph_lo, ph_hi;
};
typedef const __attribute__((address_space(4))) Params CParams;

__device__ __forceinline__ float bf2f(bf16_t v) { return __uint_as_float(((unsigned)v) << 16); }
__device__ __forceinline__ unsigned f2bf(float f) { unsigned u = __float_as_uint(f); return (u + 0x7fffu + ((u >> 16) & 1u)) >> 16; }
__device__ __forceinline__ unsigned pk2(float lo, float hi) { return f2bf(lo) | (f2bf(hi) << 16); }
__device__ __forceinline__ float bflo(unsigned u) { return __uint_as_float(u << 16); }
__device__ __forceinline__ float bfhi(unsigned u) { return __uint_as_float(u & 0xffff0000u); }
__device__ __forceinline__ float wave_sum(float v) {
#pragma unroll
    for (int o = 1; o < 64; o <<= 1) v += __shfl_xor(v, o);
    return v;
}
__device__ __forceinline__ float wave_max(float v) {
#pragma unroll
    for (int o = 1; o < 64; o <<= 1) v = fmaxf(v, __shfl_xor(v, o));
    return v;
}
template <int CTRL> __device__ __forceinline__ float dppf(float v) { return __int_as_float(__builtin_amdgcn_update_dpp(0, __float_as_int(v), CTRL, 0xF, 0xF, true)); }
__device__ __forceinline__ float row16_sum(float v) { v += dppf<0xB1>(v); v += dppf<0x4E>(v); v += dppf<0x141>(v); v += dppf<0x140>(v); return v; }
__device__ __forceinline__ float sigmoidf_(float x) { return 1.f / (1.f + __expf(-x)); }
__device__ __forceinline__ int rowof(int b, int p) { return p < NMETA ? NMAIN + b * NMETA + p : b * SEQ + (p - NMETA); }

#define SA_STRIDE 40
template <class AF, class BF>
__device__ __forceinline__ void gemm_tile(unsigned char* lds, int K, int ldb, const AF& arow, const BF& bcol, f32x4 (&acc)[4][2]) {
    bf16_t* sA = (bf16_t*)lds;
    bf16_t* sB = (bf16_t*)(lds + 128 * SA_STRIDE * 2);
    const int tid = threadIdx.x, lane = tid & 63, wave = tid >> 6, wr = wave >> 2, wc = wave & 3, fr = lane & 15, fq = lane >> 4;
#pragma unroll
    for (int mi = 0; mi < 4; ++mi)
#pragma unroll
        for (int ni = 0; ni < 2; ++ni) acc[mi][ni] = (f32x4){0.f, 0.f, 0.f, 0.f};
    const int ar = tid >> 2, akc = (tid & 3) * 8;
    const bf16_t* ap = arow(ar) + akc;
    const int bnq = (tid & 31) * 4, bkp = (tid >> 5) * 2;
    const float* bp = bcol(bnq) + (size_t)bkp * ldb;
    const int nk = K / 32;
    u32x4 ra = *(const u32x4*)ap;
    f32x4 rb0 = *(const f32x4*)bp, rb1 = *(const f32x4*)(bp + ldb);
    for (int kt = 0; kt < nk; ++kt) {
        __syncthreads();
        *(u32x4*)(sA + ar * SA_STRIDE + akc) = ra;
        {
            unsigned* d = (unsigned*)(sB + bnq * SA_STRIDE + bkp);
            d[0 * (SA_STRIDE / 2)] = pk2(rb0[0], rb1[0]);
            d[1 * (SA_STRIDE / 2)] = pk2(rb0[1], rb1[1]);
            d[2 * (SA_STRIDE / 2)] = pk2(rb0[2], rb1[2]);
            d[3 * (SA_STRIDE / 2)] = pk2(rb0[3], rb1[3]);
        }
        __syncthreads();
        if (kt + 1 < nk) {
            ra = *(const u32x4*)(ap + (kt + 1) * 32);
            const float* q = bp + (size_t)(kt + 1) * 32 * ldb;
            rb0 = *(const f32x4*)q; rb1 = *(const f32x4*)(q + ldb);
        }
        bf16x8 a[4], b[2];
#pragma unroll
        for (int mi = 0; mi < 4; ++mi) a[mi] = *(const bf16x8*)(sA + (wr * 64 + mi * 16 + fr) * SA_STRIDE + fq * 8);
#pragma unroll
        for (int ni = 0; ni < 2; ++ni) b[ni] = *(const bf16x8*)(sB + (wc * 32 + ni * 16 + fr) * SA_STRIDE + fq * 8);
#pragma unroll
        for (int mi = 0; mi < 4; ++mi)
#pragma unroll
            for (int ni = 0; ni < 2; ++ni) acc[mi][ni] = __builtin_amdgcn_mfma_f32_16x16x32_bf16(a[mi], b[ni], acc[mi][ni], 0, 0, 0);
    }
    __syncthreads();
}
#define ACC_FOREACH(acc, ...) do { const int _l = threadIdx.x & 63, _w = threadIdx.x >> 6, _wr = _w >> 2, _wc = _w & 3, _fr = _l & 15, _fq = _l >> 4; \
    _Pragma("unroll") for (int _mi = 0; _mi < 4; ++_mi) _Pragma("unroll") for (int _ni = 0; _ni < 2; ++_ni) _Pragma("unroll") for (int _j = 0; _j < 4; ++_j) { \
        const int rl = _wr * 64 + _mi * 16 + _fq * 4 + _j, cl = _wc * 32 + _ni * 16 + _fr; const float val = acc[_mi][_ni][_j]; __VA_ARGS__ } } while (0)
#define ACC_FOREACH_PAIR(acc, ...) do { const int _l = threadIdx.x & 63, _w = threadIdx.x >> 6, _wr = _w >> 2, _wc = _w & 3, _fr = _l & 15, _fq = _l >> 4; \
    _Pragma("unroll") for (int _mi = 0; _mi < 4; ++_mi) _Pragma("unroll") for (int _j = 0; _j < 4; ++_j) { \
        const int rl = _wr * 64 + _mi * 16 + _fq * 4 + _j, co = _wc * 16 + _fr; const float va = acc[_mi][0][_j], vg = acc[_mi][1][_j]; __VA_ARGS__ } } while (0)

__device__ __forceinline__ void store_norm_bf16(const f32x4 (&v)[4], const float* gain, bf16_t* dst, int lane) {
    float ss = 0.f;
#pragma unroll
    for (int j = 0; j < 4; ++j) ss += v[j][0] * v[j][0] + v[j][1] * v[j][1] + v[j][2] * v[j][2] + v[j][3] * v[j][3];
    ss = wave_sum(ss);
    const float rstd = rsqrtf(ss * (1.f / DM) + 1e-6f);
#pragma unroll
    for (int j = 0; j < 4; ++j) {
        const f32x4 g = ((const f32x4*)gain)[lane + 64 * j];
        u32x2 o; o.x = pk2(v[j][0] * rstd * g[0], v[j][1] * rstd * g[1]); o.y = pk2(v[j][2] * rstd * g[2], v[j][3] * rstd * g[3]);
        ((u32x2*)dst)[lane + 64 * j] = o;
    }
}

namespace pg8 {
#define PG8_LAS __attribute__((address_space(3)))
constexpr int BM = 256, BK = 64, HALF = 128, HTB = HALF * BK * 2  , STAGE_BYTES = 8 * HTB, NXCD = 8, WGM = 8;
__host__ __device__ __forceinline__ int lds_byte(int r, int c) { const int st = (r >> 4) * 2 + (c >> 5), rr = r & 15, cc = c & 31, ob = rr * 64 + cc * 2; return st * 1024 + (ob ^ (((ob >> 9) & 1) << 5)); }
__host__ __device__ __forceinline__ void stage_rc(int b, int& R, int& C) { const int st = b / 1024, sb = b % 1024, swz = sb ^ (((sb >> 9) & 1) << 5); R = (st >> 1) * 16 + swz / 64; C = (st & 1) * 32 + (swz % 64) / 2; }
__host__ __device__ __forceinline__ int perm32(int rho) { const int n = rho >> 4, i = rho & 15; return 8 * (i >> 2) + 4 * n + (i & 3); }

struct Unit { int pm, pn; const char* A; const char* B; };

struct DenseOrder {
    static constexpr bool GATHER_A = false;
    int nM, nN, nwg, G, c; const char* A; const char* Bt; size_t tstep;
    __device__ void init(const bf16_t* A_, const bf16_t* Bt_, int M, int N, int K, int G_, int c_) { nM = M / BM; nN = N / BM; nwg = nM * nN; G = G_; c = c_; A = (const char*)A_; Bt = (const char*)Bt_; tstep = (size_t)BM * K * 2; }
    __device__ bool next(int i, Unit& u) const {
        const long L = (long)i * G + c; if (L >= nwg) return false;
        int wgid = (int)L; { const int q = nwg / NXCD, r = nwg % NXCD, xcd = wgid % NXCD, off = wgid / NXCD; wgid = (xcd < r ? xcd * (q + 1) : r * (q + 1) + (xcd - r) * q) + off; }
        const int nig = WGM * nN, gid = wgid / nig, fm = gid * WGM, gsz = (nM - fm) < WGM ? (nM - fm) : WGM;
        u.pm = fm + ((wgid % nig) % gsz); u.pn = (wgid % nig) / gsz; u.A = A + (size_t)u.pm * tstep; u.B = Bt + (size_t)u.pn * tstep; return true;
    }
    __device__ __forceinline__ void a_ready(const Unit&) const {}
    __device__ __forceinline__ void done(const Unit&) const {}
};
struct ProjOrder {
    static constexpr bool GATHER_A = false;
    DenseOrder D; const char* HNp; const char* WT;
    __device__ void init(const bf16_t* HN_, const bf16_t* WT_, int c_) { D.init(HN_, WT_, NTP, 13 * BM, DM, GRID, c_); HNp = (const char*)HN_; WT = (const char*)WT_; }
    __device__ bool next(int i, Unit& u) const {
        if (!D.next(i, u)) return false;
        const size_t ts = (size_t)BM * DM * 2;
        if (u.pn < 11) { const int wrow = u.pn < 4 ? u.pn : u.pn + 2; u.A = HNp + (size_t)u.pm * ts; u.B = WT + (size_t)wrow * ts; }
        else { u.A = WT + (size_t)(4 + (u.pn - 11)) * ts; u.B = HNp + (size_t)u.pm * ts; }
        return true;
    }
    __device__ __forceinline__ void a_ready(const Unit&) const {}
    __device__ __forceinline__ void done(const Unit&) const {}
};
struct MoeOrder {
    static constexpr bool GATHER_A = false;
    const int* et; int TT, vcu; const char* A; const char* Bt; unsigned tstepA, tstepB, estep;
    __device__ __forceinline__ bool next(int i, Unit& u) const {
        const int L = i * GRID + vcu; if (L >= TT * 4) return false;
        const int rt = L >> 2, ct = L & 3, e = et[rt];
        u.pm = rt; u.pn = ct; u.A = A + (size_t)rt * tstepA; u.B = Bt + (size_t)e * estep + (size_t)ct * tstepB; return true;
    }
    __device__ __forceinline__ void a_ready(const Unit&) const {}
    __device__ __forceinline__ void done(const Unit&) const {}
};

struct S5OrderA {
    static constexpr bool GATHER_A = true;
    int vcu; const char* U; const char* BTA;
    __device__ __forceinline__ bool next(int i, Unit& u) const {
        const int L = i * GRID + vcu; if (L >= 640) return false;
        const int g = L / 10, rem = L - g * 10, mt = rem >> 1, nt = rem & 1;
        u.pm = mt; u.pn = g * 2 + nt; u.A = U + ((size_t)mt * 256 * 16 * 1024 + g * 16) * 2; u.B = BTA + ((size_t)(g * 512 + nt * 256) * 256) * 2; return true;
    }
    __device__ __forceinline__ void a_ready(const Unit&) const {}
    __device__ __forceinline__ void done(const Unit&) const {}
};
struct S5OrderC {
    static constexpr bool GATHER_A = false;
    int vcu; const char* CAR; const char* BTC;
    __device__ __forceinline__ bool next(int i, Unit& u) const {
        const int L = i * GRID + vcu; if (L >= 320) return false;
        const int g = L / 5, mt = L - g * 5;
        u.pm = mt; u.pn = g; u.A = CAR + ((size_t)(g * 1280 + mt * 256) * 256) * 2; u.B = BTC + ((size_t)g * 256 * 256) * 2; return true;
    }
    __device__ __forceinline__ void a_ready(const Unit&) const {}
    __device__ __forceinline__ void done(const Unit&) const {}
};
__device__ __forceinline__ unsigned cvt_pk_bf16(float lo, float hi) { unsigned r; asm volatile("v_cvt_pk_bf16_f32 %0, %1, %2" : "=v"(r) : "v"(lo), "v"(hi)); return r; }

struct EpiProj {
    static constexpr bool PERM = true, AFTER_DRAIN = false;
    bf16_t *Q, *Kk, *VT, *REST;
    __device__ __forceinline__ void operator()(const f32x4 (&acc)[2][2][4][2], const Unit& u, int wr, int wc, int fr, int fq) const {
        bf16_t* base; int ldc; int row0, col0;
        if (u.pn < 11) { row0 = u.pm * BM + wr * 64 + fr; int colt;
            if (u.pn < 2) { base = Q; colt = u.pn * BM; ldc = 512; } else if (u.pn < 4) { base = Kk; colt = (u.pn - 2) * BM; ldc = 512; } else { base = REST; colt = (u.pn - 4) * BM; ldc = RESTC; }
            col0 = colt + wc * 32 + 8 * fq; }
        else { base = VT; ldc = NTP; row0 = (u.pn - 11) * BM + wr * 64 + fr; col0 = u.pm * BM + wc * 32 + 8 * fq; }
#pragma unroll
        for (int ai = 0; ai < 2; ++ai)
#pragma unroll
            for (int m = 0; m < 4; ++m) { bf16_t* rowp = base + (size_t)(row0 + ai * HALF + m * 16) * ldc + col0;
#pragma unroll
                for (int bj = 0; bj < 2; ++bj) { const f32x4 v0 = acc[ai][bj][m][0], v1 = acc[ai][bj][m][1];
                    u32x4 w; w.x = cvt_pk_bf16(v0[0], v0[1]); w.y = cvt_pk_bf16(v0[2], v0[3]); w.z = cvt_pk_bf16(v1[0], v1[1]); w.w = cvt_pk_bf16(v1[2], v1[3]);
                    *(u32x4*)(rowp + bj * HALF) = w; } }
    }
};
struct EpiBf16Plain {
    static constexpr bool PERM = true, AFTER_DRAIN = false;
    bf16_t* O; int ldc;
    __device__ __forceinline__ void operator()(const f32x4 (&acc)[2][2][4][2], const Unit& u, int wr, int wc, int fr, int fq) const {
        const int row0 = u.pm * BM + wr * 64 + fr; const int col0 = u.pn * BM + wc * 32 + 8 * fq;
#pragma unroll
        for (int ai = 0; ai < 2; ++ai)
#pragma unroll
            for (int m = 0; m < 4; ++m) { bf16_t* rowp = O + (size_t)(row0 + ai * HALF + m * 16) * ldc + col0;
#pragma unroll
                for (int bj = 0; bj < 2; ++bj) { const f32x4 v0 = acc[ai][bj][m][0], v1 = acc[ai][bj][m][1];
                    u32x4 w; w.x = cvt_pk_bf16(v0[0], v0[1]); w.y = cvt_pk_bf16(v0[2], v0[3]); w.z = cvt_pk_bf16(v1[0], v1[1]); w.w = cvt_pk_bf16(v1[2], v1[3]);
                    *(u32x4*)(rowp + bj * HALF) = w; } }
    }
};
struct EpiSwiglu {
    static constexpr bool PERM = true, AFTER_DRAIN = false;
    bf16_t* O;
    __device__ __forceinline__ void operator()(const f32x4 (&acc)[2][2][4][2], const Unit& u, int wr, int wc, int fr, int fq) const {
        const int row0 = u.pm * BM + wr * 64 + fr; const int col0 = u.pn * HALF + wc * 32 + 8 * fq;
#pragma unroll
        for (int ai = 0; ai < 2; ++ai)
#pragma unroll
            for (int m = 0; m < 4; ++m) {
                float o[8];
#pragma unroll
                for (int n = 0; n < 2; ++n)
#pragma unroll
                    for (int i = 0; i < 4; ++i) { const float va = acc[ai][0][m][n][i], vg = acc[ai][1][m][n][i]; o[4 * n + i] = va / (1.f + __expf(-va)) * vg; }
                u32x4 w; w.x = cvt_pk_bf16(o[0], o[1]); w.y = cvt_pk_bf16(o[2], o[3]); w.z = cvt_pk_bf16(o[4], o[5]); w.w = cvt_pk_bf16(o[6], o[7]);
                *(u32x4*)(O + (size_t)(row0 + ai * HALF + m * 16) * DFF + col0) = w; }
    }
};
struct EpiResidual {
    static constexpr bool PERM = false, AFTER_DRAIN = false;
    float* Hh;
    __device__ __forceinline__ void operator()(const f32x4 (&acc)[2][2][4][2], const Unit& u, int wr, int wc, int fr, int fq) const {
        const int row0 = u.pm * BM + wr * 64 + fr; const int col0 = u.pn * BM + wc * 32 + 4 * fq;
#pragma unroll
        for (int ai = 0; ai < 2; ++ai)
#pragma unroll
            for (int m = 0; m < 4; ++m) { float* rowp = Hh + (size_t)(row0 + ai * HALF + m * 16) * DM + col0;
#pragma unroll
                for (int bj = 0; bj < 2; ++bj)
#pragma unroll
                    for (int n = 0; n < 2; ++n) { f32x4* p = (f32x4*)(rowp + bj * HALF + n * 16); *p = *p + acc[ai][bj][m][n]; } }
    }
};
struct EpiGlu {
    static constexpr bool PERM = false, AFTER_DRAIN = false;
    float* Hh;
    __device__ __forceinline__ void operator()(const f32x4 (&acc)[2][2][4][2], const Unit& u, int wr, int wc, int fr, int fq) const {
        const int row0 = u.pm * BM + wr * 64 + fr; const int col0 = u.pn * HALF + wc * 32 + 4 * fq;
#pragma unroll
        for (int ai = 0; ai < 2; ++ai)
#pragma unroll
            for (int m = 0; m < 4; ++m) { float* rowp = Hh + (size_t)(row0 + ai * HALF + m * 16) * DM + col0;
#pragma unroll
                for (int n = 0; n < 2; ++n) { f32x4* p = (f32x4*)(rowp + n * 16); f32x4 hv = *p; const f32x4 va = acc[ai][0][m][n], vg = acc[ai][1][m][n];
#pragma unroll
                    for (int i = 0; i < 4; ++i) hv[i] += va[i] / (1.f + __expf(-vg[i]));
                    *p = hv; } }
    }
};

struct EpiS5A {
    static constexpr bool PERM = true, AFTER_DRAIN = false;
    float* YI; float* E;
    __device__ __forceinline__ void operator()(const f32x4 (&acc)[2][2][4][2], const Unit& u, int wr, int wc, int fr, int fq) const {
        const int g = u.pn >> 1, nt = u.pn & 1;
        const int cl0 = wc * 32 + 8 * fq;
        float* base = nt == 0 ? YI + (size_t)(cl0 >> 4) * DM + g * 16 + (cl0 & 15) : E + (size_t)g * 256 + cl0;
        const size_t nstride = 16 * DM;
        const size_t bjstep = nt == 0 ? (size_t)8 * DM : (size_t)HALF;
#pragma unroll
        for (int ai = 0; ai < 2; ++ai)
#pragma unroll
            for (int m = 0; m < 4; ++m) { int n = u.pm * BM + ai * HALF + wr * 64 + m * 16 + fr; n = n < 1039 ? n : 1039;
                float* p = base + (size_t)n * nstride;
#pragma unroll
                for (int bj = 0; bj < 2; ++bj) { *(f32x4*)(p + bj * bjstep) = acc[ai][bj][m][0]; *(f32x4*)(p + bj * bjstep + 4) = acc[ai][bj][m][1]; } }
    }
};
struct EpiS5C {
    static constexpr bool PERM = true, AFTER_DRAIN = false;
    const float* YI; const bf16_t* Uu; const float* dvec; bf16_t* O;
    __device__ __forceinline__ void operator()(const f32x4 (&acc)[2][2][4][2], const Unit& u, int wr, int wc, int fr, int fq) const {
        const int g = u.pn;
        const int cl0 = wc * 32 + 8 * fq, ch = g * 16 + (cl0 & 15);
        const size_t off0 = (size_t)(cl0 >> 4) * DM + ch;
        const f32x4 d0 = *(const f32x4*)(dvec + ch), d1 = *(const f32x4*)(dvec + ch + 4);
#pragma unroll
        for (int ai = 0; ai < 2; ++ai)
#pragma unroll
            for (int m = 0; m < 4; ++m) { int n = u.pm * BM + ai * HALF + wr * 64 + m * 16 + fr; n = n < 1039 ? n : 1039;
#pragma unroll
                for (int bj = 0; bj < 2; ++bj) {
                    const size_t off = off0 + (size_t)n * (16 * DM) + (size_t)bj * (8 * DM);
                    const f32x4 y0 = *(const f32x4*)(YI + off), y1 = *(const f32x4*)(YI + off + 4);
                    const u32x4 uv = *(const u32x4*)(Uu + off);
                    float y[8];
#pragma unroll
                    for (int q = 0; q < 4; ++q) { y[q] = acc[ai][bj][m][0][q] + y0[q] + d0[q] * (q & 1 ? __uint_as_float(uv[q >> 1] & 0xffff0000u) : __uint_as_float(uv[q >> 1] << 16));
                        y[4 + q] = acc[ai][bj][m][1][q] + y1[q] + d1[q] * (q & 1 ? __uint_as_float(uv[2 + (q >> 1)] & 0xffff0000u) : __uint_as_float(uv[2 + (q >> 1)] << 16)); }
#pragma unroll
                    for (int q = 0; q < 8; ++q) { const float z = 1.5957691216f * (y[q] + 0.044715f * y[q] * y[q] * y[q]); y[q] = y[q] / (1.f + __expf(-z)); }
                    u32x4 w; w.x = cvt_pk_bf16(y[0], y[1]); w.y = cvt_pk_bf16(y[2], y[3]); w.z = cvt_pk_bf16(y[4], y[5]); w.w = cvt_pk_bf16(y[6], y[7]);
                    *(u32x4*)(O + off) = w; }
                asm volatile("" ::: "memory"); }
    }
};

template <class Epi, class Sched, bool ALIGN_EPI = false, bool SP2 = false>
__device__ __forceinline__ void gemm_phase(PG8_LAS unsigned char* lds, const int K, const Sched& S, const Epi& E) {
    int tid_ = threadIdx.x; asm volatile("" : "+v"(tid_));
    const int tid = tid_, wid = __builtin_amdgcn_readfirstlane(tid >> 6), lane = tid & 63, wr = wid >> 2, wc = wid & 3, fr = lane & 15, fq = lane >> 4;
    const int nt = K / BK;
    unsigned voffA[2], voffB[2];
#pragma unroll
    for (int i = 0; i < 2; ++i) { int R, C; stage_rc(tid * 16 + i * 8192, R, C); const int Rb = Epi::PERM ? ((R & ~31) + perm32(R & 31)) : R;
        voffA[i] = Sched::GATHER_A ? (unsigned)(((16 * R + (C >> 4)) * 1024 + (C & 15)) * 2) : (unsigned)(R * K + C) * 2u; voffB[i] = (unsigned)(Rb * K + C) * 2u; }
    const size_t kstep = (size_t)(BK * 2);
    const size_t hstep = (size_t)HALF * K * 2;
    const size_t kstepA = Sched::GATHER_A ? (size_t)(4 * 1024 * 2) : kstep, hstepA = Sched::GATHER_A ? (size_t)HALF * 16 * 1024 * 2 : hstep;
    const unsigned ldsw = (unsigned)wid * 1024u;
    const int aoff = lds_byte(wr * 64 + fr, fq * 8), boff = lds_byte(wc * 32 + fr, fq * 8);
#define PG8_SA(b, h) (((b) * 2 + (h)) * HTB)
#define PG8_SB(b, h) ((4 + (b) * 2 + (h)) * HTB)
#define PG8_STAGE(bufoff, gbase, voff) do { _Pragma("unroll") for (int _i = 0; _i < 2; ++_i) \
        __builtin_amdgcn_global_load_lds((const unsigned*)((const char*)(gbase) + (voff)[_i]), (PG8_LAS unsigned*)(lds + (bufoff) + ldsw + _i * 8192), 16, 0, 0); } while (0)
#define PG8_LDA(dst, b, h) do { _Pragma("unroll") for (int m = 0; m < 4; ++m) _Pragma("unroll") for (int k = 0; k < 2; ++k) dst[m][k] = *(const PG8_LAS bf16x8*)(lds + PG8_SA(b, h) + aoff + m * 2048 + k * 1024); } while (0)
#define PG8_LDB(dst, b, h) do { _Pragma("unroll") for (int n = 0; n < 2; ++n) _Pragma("unroll") for (int k = 0; k < 2; ++k) dst[n][k] = *(const PG8_LAS bf16x8*)(lds + PG8_SB(b, h) + boff + n * 2048 + k * 1024); } while (0)
#define PG8_MMA(ai, bj, At, Bt) do { __builtin_amdgcn_s_setprio(1); _Pragma("unroll") for (int m = 0; m < 4; ++m) _Pragma("unroll") for (int n = 0; n < 2; ++n) _Pragma("unroll") for (int k = 0; k < 2; ++k) \
        acc[ai][bj][m][n] = __builtin_amdgcn_mfma_f32_16x16x32_bf16(Bt[n][k], At[m][k], acc[ai][bj][m][n], 0, 0, 0); __builtin_amdgcn_s_setprio(0); } while (0)
#define PG8_WAIT_V(n) asm volatile("s_waitcnt vmcnt(" #n ")" ::: "memory")
#define PG8_WAIT_L(n) asm volatile("s_waitcnt lgkmcnt(" #n ")" ::: "memory")
#define PG8_BAR __builtin_amdgcn_s_barrier()
#define PG8_SCHED __builtin_amdgcn_sched_barrier(0)
    Unit cur, nxt; int ui = 0;
    if (!S.next(0, cur)) return;
    f32x4 acc[2][2][4][2];
#pragma unroll
    for (int a = 0; a < 2; ++a)
#pragma unroll
        for (int b = 0; b < 2; ++b)
#pragma unroll
            for (int m = 0; m < 4; ++m)
#pragma unroll
                for (int n = 0; n < 2; ++n) acc[a][b][m][n] = (f32x4){0.f, 0.f, 0.f, 0.f};
    bf16x8 At[4][2], B0[2][2], B1[2][2];
    const char* cA = cur.A; const char* cB = cur.B;
    S.a_ready(cur);
    if constexpr (SP2) {
        PG8_STAGE(PG8_SB(0, 0), cB, voffB); PG8_STAGE(PG8_SB(0, 1), cB + hstep, voffB); PG8_STAGE(PG8_SA(0, 0), cA, voffA); PG8_STAGE(PG8_SA(0, 1), cA + hstepA, voffA);
        if (wr == 1) PG8_BAR;
        PG8_WAIT_V(2); PG8_BAR;
        PG8_STAGE(PG8_SB(1, 0), cB + kstep, voffB); PG8_STAGE(PG8_SA(1, 0), cA + kstepA, voffA); PG8_STAGE(PG8_SB(1, 1), cB + hstep + kstep, voffB);
        PG8_WAIT_V(6); PG8_BAR;
    } else {
        PG8_STAGE(PG8_SB(0, 0), cB, voffB); PG8_STAGE(PG8_SA(0, 0), cA, voffA); PG8_STAGE(PG8_SB(0, 1), cB + hstep, voffB); PG8_STAGE(PG8_SA(0, 1), cA + hstepA, voffA);
        if (wr == 1) PG8_BAR;
        PG8_WAIT_V(4); PG8_BAR;
        PG8_STAGE(PG8_SB(1, 0), cB + kstep, voffB); PG8_STAGE(PG8_SA(1, 0), cA + kstepA, voffA); PG8_STAGE(PG8_SB(1, 1), cB + hstep + kstep, voffB);
        PG8_WAIT_V(6); PG8_BAR;
    }
    for (;;) {
        const bool has_next = S.next(ui + 1, nxt);
        const char* nA = has_next ? nxt.A : cA; const char* nB = has_next ? nxt.B : cB;
        for (int t = 0; t < nt; t += 2) {
            const bool last = (t == nt - 2);
            const char* a1 = cA + (size_t)(t + 1) * kstepA;
            const char* a2 = last ? nA : cA + (size_t)(t + 2) * kstepA; const char* b2 = last ? nB : cB + (size_t)(t + 2) * kstep;
            const char* a3 = a2 + kstepA; const char* b3 = b2 + kstep;
            if (last && has_next) S.a_ready(nxt);
            if constexpr (SP2) {
            PG8_LDB(B0, 0, 0); PG8_LDB(B1, 0, 1); PG8_SCHED; PG8_LDA(At, 0, 0); PG8_STAGE(PG8_SA(1, 1), a1 + hstepA, voffA);
            PG8_WAIT_V(8); PG8_WAIT_L(0); PG8_BAR; PG8_MMA(0, 0, At, B0); PG8_MMA(0, 1, At, B1); PG8_BAR; PG8_SCHED;
            PG8_LDA(At, 0, 1); PG8_STAGE(PG8_SB(0, 0), b2, voffB); PG8_STAGE(PG8_SB(0, 1), b2 + hstep, voffB); PG8_STAGE(PG8_SA(0, 0), a2, voffA);
            PG8_WAIT_V(8); PG8_WAIT_L(0); PG8_BAR; PG8_MMA(1, 0, At, B0); PG8_MMA(1, 1, At, B1); PG8_BAR; PG8_SCHED;
            PG8_LDB(B0, 1, 0); PG8_LDB(B1, 1, 1); PG8_SCHED; PG8_LDA(At, 1, 0); PG8_STAGE(PG8_SA(0, 1), a2 + hstepA, voffA);
            PG8_WAIT_V(8); PG8_WAIT_L(0); PG8_BAR; PG8_MMA(0, 0, At, B0); PG8_MMA(0, 1, At, B1); PG8_BAR; PG8_SCHED;
            PG8_LDA(At, 1, 1); PG8_STAGE(PG8_SB(1, 0), b3, voffB); PG8_STAGE(PG8_SB(1, 1), b3 + hstep, voffB); PG8_STAGE(PG8_SA(1, 0), a3, voffA);
            PG8_WAIT_V(8); PG8_WAIT_L(0); PG8_BAR; PG8_MMA(1, 0, At, B0); PG8_MMA(1, 1, At, B1); PG8_BAR; PG8_SCHED;
            } else {
            PG8_LDB(B0, 0, 0); PG8_SCHED; PG8_LDA(At, 0, 0); PG8_STAGE(PG8_SA(1, 1), a1 + hstepA, voffA);
            PG8_WAIT_L(8); PG8_BAR; PG8_WAIT_L(0); PG8_MMA(0, 0, At, B0); PG8_BAR; PG8_SCHED;
            PG8_LDB(B1, 0, 1); PG8_STAGE(PG8_SB(0, 0), b2, voffB);
            PG8_BAR; PG8_WAIT_L(0); PG8_MMA(0, 1, At, B1); PG8_BAR;
            PG8_LDA(At, 0, 1); PG8_STAGE(PG8_SA(0, 0), a2, voffA);
            PG8_BAR; PG8_WAIT_L(0); PG8_MMA(1, 0, At, B0); PG8_BAR; PG8_SCHED;
            PG8_STAGE(PG8_SB(0, 1), b2 + hstep, voffB);
            PG8_WAIT_V(6); PG8_BAR; PG8_MMA(1, 1, At, B1); PG8_BAR;
            PG8_LDB(B0, 1, 0); PG8_SCHED; PG8_LDA(At, 1, 0); PG8_STAGE(PG8_SA(0, 1), a2 + hstepA, voffA);
            PG8_WAIT_L(8); PG8_BAR; PG8_WAIT_L(0); PG8_MMA(0, 0, At, B0); PG8_BAR; PG8_SCHED;
            PG8_LDB(B1, 1, 1); PG8_STAGE(PG8_SB(1, 0), b3, voffB);
            PG8_BAR; PG8_WAIT_L(0); PG8_MMA(0, 1, At, B1); PG8_BAR;
            PG8_LDA(At, 1, 1); PG8_STAGE(PG8_SA(1, 0), a3, voffA);
            PG8_BAR; PG8_WAIT_L(0); PG8_MMA(1, 0, At, B0); PG8_BAR; PG8_SCHED;
            PG8_STAGE(PG8_SB(1, 1), b3 + hstep, voffB);
            PG8_WAIT_V(6); PG8_BAR; PG8_MMA(1, 1, At, B1); PG8_BAR;
            }
        }
        if constexpr (ALIGN_EPI) { if (wr == 0) PG8_BAR; }
        if constexpr (!Epi::AFTER_DRAIN) { E(acc, cur, wr, wc, fr, fq); S.done(cur); }
        if (!has_next) break;
#pragma unroll
        for (int a = 0; a < 2; ++a)
#pragma unroll
            for (int b = 0; b < 2; ++b)
#pragma unroll
                for (int m = 0; m < 4; ++m)
#pragma unroll
                    for (int n = 0; n < 2; ++n) acc[a][b][m][n] = (f32x4){0.f, 0.f, 0.f, 0.f};
        cur = nxt; cA = nA; cB = nB; ++ui;
        if constexpr (ALIGN_EPI) { if (wr == 1) PG8_BAR; }
    }
    PG8_WAIT_V(0);
    if constexpr (!ALIGN_EPI) { if (wr == 0) PG8_BAR; }
    PG8_BAR;
    if constexpr (Epi::AFTER_DRAIN) { E.fused(acc, cur, wr, wc, fr, fq, lds, wid, lane); S.done(cur); }
#undef PG8_SA
#undef PG8_SB
#undef PG8_STAGE
#undef PG8_LDA
#undef PG8_LDB
#undef PG8_MMA
#undef PG8_WAIT_V
#undef PG8_WAIT_L
#undef PG8_BAR
#undef PG8_SCHED
}
}

#define PHASE_PROLOGUE \
    int tid_ = threadIdx.x; asm volatile("" : "+v"(tid_)); const int tid = tid_, lane = tid & 63, wave = tid >> 6; \
    const int G = GRID, bid = blockIdx.x; \
    const int gw = bid * 8 + wave, NGW = G * 8; \
    unsigned char* ws = P.ws; \
    float* H = (float*)(ws + WS_H); \
    bf16_t* HN = (bf16_t*)(ws + WS_HN); \
    bf16_t* A2 = (bf16_t*)(ws + WS_A2); \
    bf16_t* Qb = (bf16_t*)(ws + WS_Q); bf16_t* Kb = (bf16_t*)(ws + WS_K); bf16_t* Vb = (bf16_t*)(ws + WS_V); \
    bf16_t* REST = (bf16_t*)(ws + WS_REST); \
    bf16_t* YFB = (bf16_t*)(ws + WS_YFB); \
    bf16_t* Rr = (bf16_t*)(ws + WS_R); bf16_t* VV = (bf16_t*)(ws + WS_VV); bf16_t* KK = (bf16_t*)(ws + WS_KK); \
    bf16_t* KKA = (bf16_t*)(ws + WS_KKA); bf16_t* KD = (bf16_t*)(ws + WS_KD); \
    float* Wd = (float*)(ws + WS_W); \
    bf16_t* Gg = (bf16_t*)(ws + WS_G); bf16_t* KR = (bf16_t*)(ws + WS_KR); bf16_t* LOW = (bf16_t*)(ws + WS_LOW); \
    float* BC = (float*)(ws + WS_BC); \
    bf16_t* AA = (bf16_t*)(ws + WS_AA); \
    bf16_t* HB = (bf16_t*)(ws + WS_HB); bf16_t* YB = (bf16_t*)(ws + WS_YB); \
    bf16_t* XB = (bf16_t*)(ws + WS_XB); int* EID = (int*)(ws + WS_EID); int* POS = (int*)(ws + WS_POS); int* DEST = (int*)(ws + WS_DEST); \
    float* GATE = (float*)(ws + WS_GATE); \
    float* YI = (float*)(ws + WS_YI); float* S5E = (float*)(ws + WS_E); bf16_t* CAR = (bf16_t*)(ws + WS_CAR); bf16_t* BTA = (bf16_t*)(ws + WS_BTA); bf16_t* BTC = (bf16_t*)(ws + WS_BTC); \
    unsigned* CTL = (unsigned*)(ws + WS_CTL); \
    bf16_t* WTIN = (bf16_t*)(ws + WS_WTIN); bf16_t* WTOUT = (bf16_t*)(ws + WS_WTOUT); bf16_t* WTGLU = (bf16_t*)(ws + WS_WTGLU); bf16_t* WT13 = (bf16_t*)(ws + WS_WT13); bf16_t* WT2 = (bf16_t*)(ws + WS_WT2); \
    const int vcu = (G % 8 == 0) ? (bid % 8) * (G / 8) + bid / 8 : bid; \
    const float* x = P.in[0]; const float* meta = P.in[1]; const float* norm_mix = P.in[2]; const float* norm_ffn = P.in[3]; const float* norm_final = P.in[4]; \
    const float* w_in = P.in[5]; const float* w_out = P.in[6]; const float* rpb = P.in[7]; const float* mu = P.in[8]; \
    const float* w0 = P.in[9]; const float* w_up = P.in[10]; const float* a0 = P.in[11]; const float* a_up = P.in[12]; const float* g_up = P.in[13]; \
    const float* k_k = P.in[14]; const float* k_a = P.in[15]; const float* r_k = P.in[16]; const float* lnx_g = P.in[17]; const float* lnx_b = P.in[18]; \
    const float* s5_b_re = P.in[19]; const float* s5_b_im = P.in[20]; const float* s5_lre = P.in[21]; const float* s5_lim = P.in[22]; const float* s5_ls = P.in[23]; \
    const float* s5_c_re = P.in[24]; const float* s5_c_im = P.in[25]; const float* s5_d = P.in[26]; const float* w_glu = P.in[27]; \
    const float* moe_wg = P.in[28]; const float* moe_bg = P.in[29]; const float* moe_we = P.in[30]; const float* moe_be = P.in[31]; \
    const float* moe_w1 = P.in[32]; const float* moe_w3 = P.in[33]; const float* moe_w2 = P.in[34];


__device__ __forceinline__ void transpose_item(const float* W, int N, int K, int k0, int n0, bf16_t* dstrow0, int lane) {
    const int nq = lane & 15, kb = lane >> 4;
    const float* src = W + (size_t)(k0 + 16 * kb) * N + n0 + 4 * nq;
    f32x4 v[16];
#pragma unroll
    for (int kk = 0; kk < 16; ++kk) v[kk] = *(const f32x4*)(src + (size_t)kk * N);
#pragma unroll
    for (int i = 0; i < 4; ++i) {
        bf16_t* d = dstrow0 + (size_t)(4 * nq + i) * K + k0 + 16 * kb;
        u32x4 lo, hi;
        lo.x = pk2(v[0][i], v[1][i]); lo.y = pk2(v[2][i], v[3][i]); lo.z = pk2(v[4][i], v[5][i]); lo.w = pk2(v[6][i], v[7][i]);
        hi.x = pk2(v[8][i], v[9][i]); hi.y = pk2(v[10][i], v[11][i]); hi.z = pk2(v[12][i], v[13][i]); hi.w = pk2(v[14][i], v[15][i]);
        *(u32x4*)d = lo; *(u32x4*)(d + 8) = hi;
    }
}
#define CONV_DENSE_ITEMS (832 + 256 + 512)
__device__ __forceinline__ void conv_dense_item(CParams& P, int it, int lane) {
    unsigned char* ws = P.ws;
    if (it < 832) { const int kb = it / 52, nb = it % 52; transpose_item(P.in[5], INCOLS, DM, kb * 64, nb * 64, (bf16_t*)(ws + WS_WTIN) + (size_t)nb * 64 * DM, lane); return; }
    it -= 832;
    if (it < 256) { const int kb = it / 16, nb = it % 16; transpose_item(P.in[6], DM, DM, kb * 64, nb * 64, (bf16_t*)(ws + WS_WTOUT) + (size_t)nb * 64 * DM, lane); return; }
    it -= 256;
    { const int kb = it / 32, nb = it % 32, n = nb * 64, half = n >> 10, c = n & 1023, row = (c >> 7) * 256 + half * 128 + (c & 127);
      transpose_item(P.in[27], 2 * DM, DM, kb * 64, n, (bf16_t*)(ws + WS_WTGLU) + (size_t)row * DM, lane); }
}
#define CONV_MOE_ITEMS (NEXP * 384)
__device__ __forceinline__ void conv_moe_item(CParams& P, int l, int it, int lane) {
    unsigned char* ws = P.ws;
    const int e = it / 384; int r = it % 384;
    if (r < 256) { const int which = r >> 7; r &= 127; const int kb = r >> 3, nb = r & 7, n = nb * 64, row = (n >> 7) * 256 + which * 128 + (n & 127);
        const float* W = (which ? P.in[33] : P.in[32]) + ((size_t)(l * NEXP + e) * DM) * DFF;
        transpose_item(W, DFF, DM, kb * 64, n, (bf16_t*)(ws + WS_WT13) + ((size_t)e * DM + row) * DM, lane); return; }
    r -= 256;
    { const int kb = r >> 4, nb = r & 15; const float* W = P.in[34] + ((size_t)(l * NEXP + e) * DFF) * DM;
      transpose_item(W, DM, DFF, kb * 64, nb * 64, (bf16_t*)(ws + WS_WT2) + ((size_t)e * DM + nb * 64) * DFF, lane); }
}

template <int MODE>
__device__ __forceinline__ void meta_gemm(const bf16_t* A, const bf16_t* Bt, float* Hrows, int task, int lane) {
    const int fr = lane & 15, fq = lane >> 4, c = task * 16 + fr;
    const bf16_t* b0 = MODE == 0 ? Bt + (size_t)c * DM : Bt + (size_t)((c >> 7) * 256 + (c & 127)) * DM;
    const bf16_t* b1 = b0 + (size_t)128 * DM;
    f32x4 acc0[2], acc1[2];
    acc0[0] = acc0[1] = acc1[0] = acc1[1] = (f32x4){0.f, 0.f, 0.f, 0.f};
#pragma unroll 4
    for (int kt = 0; kt < 32; ++kt) {
        const int ko = kt * 32 + fq * 8;
        const bf16x8 a0 = *(const bf16x8*)(A + (size_t)fr * DM + ko), a1 = *(const bf16x8*)(A + (size_t)(16 + fr) * DM + ko);
        const bf16x8 bv = *(const bf16x8*)(b0 + ko);
        acc0[0] = __builtin_amdgcn_mfma_f32_16x16x32_bf16(a0, bv, acc0[0], 0, 0, 0);
        acc0[1] = __builtin_amdgcn_mfma_f32_16x16x32_bf16(a1, bv, acc0[1], 0, 0, 0);
        if (MODE == 1) { const bf16x8 bg = *(const bf16x8*)(b1 + ko);
            acc1[0] = __builtin_amdgcn_mfma_f32_16x16x32_bf16(a0, bg, acc1[0], 0, 0, 0);
            acc1[1] = __builtin_amdgcn_mfma_f32_16x16x32_bf16(a1, bg, acc1[1], 0, 0, 0); }
    }
#pragma unroll
    for (int mi = 0; mi < 2; ++mi)
#pragma unroll
        for (int j = 0; j < 4; ++j) { float* p = Hrows + (size_t)(mi * 16 + fq * 4 + j) * DM + c;
            if (MODE == 0) *p += acc0[mi][j]; else *p += acc0[mi][j] / (1.f + __expf(-acc1[mi][j])); }
}
__device__ __forceinline__ void phase_0(CParams& P, unsigned char* lds, const int ph) {
    PHASE_PROLOGUE
            for (int row = gw; row < NT; row += NGW) {
                const float* src = row < NMAIN ? x + (size_t)row * DM : meta + (size_t)((row - NMAIN) & 15) * DM;
                f32x4 v[4];
#pragma unroll
                for (int j = 0; j < 4; ++j) { v[j] = ((const f32x4*)src)[lane + 64 * j]; ((f32x4*)(H + (size_t)row * DM))[lane + 64 * j] = v[j]; }
                store_norm_bf16(v, norm_mix, HN + (size_t)row * DM, lane);
            }
    for (int it = gw; it < CONV_DENSE_ITEMS; it += NGW) conv_dense_item(P, it, lane);
    for (int it = gw; it < CONV_MOE_ITEMS; it += NGW) conv_moe_item(P, 0, it, lane);
}

__device__ __forceinline__ void phase_1(CParams& P, unsigned char* lds, const int ph) {
    PHASE_PROLOGUE
    pg8::ProjOrder S; S.init(HN, WTIN, bid);
    pg8::EpiProj E{Qb, Kb, Vb, REST};
    pg8::gemm_phase<pg8::EpiProj, pg8::ProjOrder, true, true>((PG8_LAS unsigned char*)lds, DM, S, E);
}

__device__ __forceinline__ void phase_2(CParams& P, unsigned char* lds, const int ph) {
    PHASE_PROLOGUE
    float* sb = (float*)lds;
    for (int i = tid; i < 8 * 465; i += 512) sb[i] = rpb[i];
    __syncthreads();
    const bf16_t* VT = Vb;
    const int fr = lane & 15, fq = lane >> 4;
    for (int u = gw; u < 8192 + 16; u += NGW) {
        const bool metaq = u >= 8192;
        int b, h, r = 0, qb = 0;
        if (!metaq) { qb = u & 3; r = (u >> 2) & 127; h = (u >> 9) & 7; b = u >> 12; } else { const int m = u - 8192; b = m >> 3; h = m & 7; }
        const int c = qb * 16 + fr;
        const int qrow = metaq ? NMAIN + b * NMETA + fr : b * SEQ + r * 64 + c;
        const int R0 = min(max(r - 4, 0), 120), cs = qb == 0 ? 0 : (qb == 1 ? 8 : (qb == 2 ? 24 : 32));
        const int C0 = min(max(c - 8, 0), 48);
        bf16x8 qf0 = *(const bf16x8*)(Qb + (size_t)qrow * 512 + h * 64 + fq * 8), qf1 = *(const bf16x8*)(Qb + (size_t)qrow * 512 + h * 64 + 32 + fq * 8);
        f32x4 sacc[17];
        const f32x4 zero4 = (f32x4){0.f, 0.f, 0.f, 0.f};
        if (!metaq) {
#pragma unroll
            for (int kt = 0; kt < 16; ++kt) {
                const int krow0 = b * SEQ + (R0 + (kt >> 1)) * 64 + cs + 16 * (kt & 1);
                const bf16_t* kp = Kb + (size_t)(krow0 + fr) * 512 + h * 64 + fq * 8;
                const bf16x8 a0 = *(const bf16x8*)kp, a1 = *(const bf16x8*)(kp + 32);
                f32x4 acc = __builtin_amdgcn_mfma_f32_16x16x32_bf16(a0, qf0, zero4, 0, 0, 0);
                sacc[kt] = __builtin_amdgcn_mfma_f32_16x16x32_bf16(a1, qf1, acc, 0, 0, 0);
            }
        } else {
#pragma unroll
            for (int kt = 0; kt < 16; ++kt) sacc[kt] = zero4;
        }
        {
            const bf16_t* kp = Kb + (size_t)(NMAIN + b * NMETA + fr) * 512 + h * 64 + fq * 8;
            const bf16x8 a0 = *(const bf16x8*)kp, a1 = *(const bf16x8*)(kp + 32);
            f32x4 acc = __builtin_amdgcn_mfma_f32_16x16x32_bf16(a0, qf0, zero4, 0, 0, 0);
            sacc[16] = __builtin_amdgcn_mfma_f32_16x16x32_bf16(a1, qf1, acc, 0, 0, 0);
        }
        float mx = -1e30f;
#pragma unroll
        for (int kt = 0; kt < 16; ++kt) {
            const int dr = R0 + (kt >> 1) - r + 7;
#pragma unroll
            for (int j = 0; j < 4; ++j) {
                const int kc = cs + 16 * (kt & 1) + 4 * fq + j;
                const bool inb = !metaq && kc >= C0 && kc < C0 + 16;
                const int dc = min(max(kc - c + 15, 0), 30);
                const float s = inb ? sacc[kt][j] * 0.125f + sb[(h * 15 + dr) * 31 + dc] : -1e30f;
                sacc[kt][j] = s; mx = fmaxf(mx, s);
            }
        }
#pragma unroll
        for (int j = 0; j < 4; ++j) { const float s = sacc[16][j] * 0.125f; sacc[16][j] = s; mx = fmaxf(mx, s); }
        mx = fmaxf(mx, __shfl_xor(mx, 16)); mx = fmaxf(mx, __shfl_xor(mx, 32));
        float sum = 0.f;
#pragma unroll
        for (int kt = 0; kt < 17; ++kt)
#pragma unroll
            for (int j = 0; j < 4; ++j) { const float pv = __expf(sacc[kt][j] - mx); sacc[kt][j] = pv; sum += pv; }
        sum += __shfl_xor(sum, 16); sum += __shfl_xor(sum, 32);
        f32x4 o[4] = {zero4, zero4, zero4, zero4};
        if (!metaq) {
#pragma unroll
            for (int kr = 0; kr < 8; ++kr) {
                union { bf16x8 v; unsigned u[4]; } bf;
                bf.u[0] = pk2(sacc[2 * kr][0], sacc[2 * kr][1]); bf.u[1] = pk2(sacc[2 * kr][2], sacc[2 * kr][3]);
                bf.u[2] = pk2(sacc[2 * kr + 1][0], sacc[2 * kr + 1][1]); bf.u[3] = pk2(sacc[2 * kr + 1][2], sacc[2 * kr + 1][3]);
                const size_t tok0 = (size_t)b * SEQ + (R0 + kr) * 64 + cs + 4 * fq;
#pragma unroll
                for (int dt = 0; dt < 4; ++dt) {
                    const bf16_t* vp = VT + (size_t)(h * 64 + dt * 16 + fr) * NTP + tok0;
                    union { bf16x8 v; u32x2 h2[2]; } af;
                    af.h2[0] = *(const u32x2*)vp; af.h2[1] = *(const u32x2*)(vp + 16);
                    o[dt] = __builtin_amdgcn_mfma_f32_16x16x32_bf16(af.v, bf.v, o[dt], 0, 0, 0);
                }
            }
        }
        {
            union { bf16x8 v; unsigned u[4]; } bf;
            bf.u[0] = pk2(sacc[16][0], sacc[16][1]); bf.u[1] = pk2(sacc[16][2], sacc[16][3]); bf.u[2] = 0u; bf.u[3] = 0u;
            const size_t tokm = (size_t)NMAIN + b * NMETA + 4 * fq;
#pragma unroll
            for (int dt = 0; dt < 4; ++dt) {
                const bf16_t* vp = VT + (size_t)(h * 64 + dt * 16 + fr) * NTP + tokm;
                union { bf16x8 v; u32x2 h2[2]; } af;
                af.h2[0] = *(const u32x2*)vp; af.h2[1] = (u32x2){0u, 0u};
                o[dt] = __builtin_amdgcn_mfma_f32_16x16x32_bf16(af.v, bf.v, o[dt], 0, 0, 0);
            }
        }
        const float inv = 1.f / sum;
#pragma unroll
        for (int dt = 0; dt < 4; ++dt) {
            u32x2 ov; ov.x = pk2(o[dt][0] * inv, o[dt][1] * inv); ov.y = pk2(o[dt][2] * inv, o[dt][3] * inv);
            *(u32x2*)(A2 + (size_t)qrow * DM + h * 64 + dt * 16 + 4 * fq) = ov;
        }
    }
    __syncthreads();
}

__device__ __forceinline__ void phase_3(CParams& P, unsigned char* lds, const int ph) {
    PHASE_PROLOGUE
            for (int tk = gw; tk < NT; tk += NGW) {
                const int b = tk / LSEQ, p = tk % LSEQ, row = rowof(b, p);
                const bool hp = p > 0, hn = p + 1 < LSEQ;
                const int rowp = hp ? rowof(b, p - 1) : row, rown = hn ? rowof(b, p + 1) : row;
#pragma unroll
                for (int j = 0; j < 7; ++j) {
                    const int c = 4 * lane + 256 * j;
                    const u32x2 vc = *(const u32x2*)(REST + (size_t)row * RESTC + c);
                    u32x2 vp = *(const u32x2*)(REST + (size_t)rowp * RESTC + c);
                    u32x2 vn = *(const u32x2*)(REST + (size_t)rown * RESTC + c);
                    if (!hp) { vp.x = 0; vp.y = 0; }
                    if (!hn) { vn.x = 0; vn.y = 0; }
                    const f32x4 m4 = *(const f32x4*)(mu + c);
                    float pc[4] = {bflo(vc.x), bfhi(vc.x), bflo(vc.y), bfhi(vc.y)};
                    float pp[4] = {bflo(vp.x), bfhi(vp.x), bflo(vp.y), bfhi(vp.y)};
                    float pn[4] = {bflo(vn.x), bfhi(vn.x), bflo(vn.y), bfhi(vn.y)};
                    float o[4];
#pragma unroll
                    for (int i = 0; i < 4; ++i) o[i] = pc[i] + m4[i] * (0.5f * (pp[i] + pn[i]) - pc[i]);
                    if (j == 6) {
                        if (lane < 16) { for (int i = 0; i < 4; ++i) o[i] = tanhf(o[i]); }
                        else if (lane >= 32) { for (int i = 0; i < 4; ++i) o[i] = sigmoidf_(o[i]); }
                    }
                    u32x2 ov; ov.x = pk2(o[0], o[1]); ov.y = pk2(o[2], o[3]);
                    bf16_t* dst = j < 2 ? Rr + (size_t)row * 512 + c : (j < 4 ? KR + (size_t)row * 512 + (c - 512) : (j < 6 ? VV + (size_t)row * 512 + (c - 1024) : LOW + (size_t)row * 256 + (c - 1536)));
                    *(u32x2*)dst = ov;
                }
            }
}


__device__ __forceinline__ void phase_4(CParams& P, unsigned char* lds, const int ph) {
    PHASE_PROLOGUE
            const int nrt = (NT + 127) / 128;
            const int nunits = nrt * 4 * 5;
            for (int u = bid; u < nunits; u += G) {
                const int which = u / (nrt * 4), rem = u % (nrt * 4), rt = rem / 4, ct = rem % 4;
                f32x4 acc[4][2];
                const int koff = which < 2 ? 0 : (which < 4 ? 64 : 128), KK_ = which < 4 ? 64 : 128;
                const float* Bsrc = which < 2 ? w_up + (size_t)which * 64 * 512 : (which < 4 ? a_up + (size_t)(which - 2) * 64 * 512 : g_up);
                gemm_tile(lds, KK_, 512,
                          [&](int r) { int row = rt * 128 + r; if (row >= NT) row = NT - 1; return LOW + (size_t)row * 256 + koff; },
                          [&](int n) { return Bsrc + ct * 128 + n; }, acc);
                ACC_FOREACH(acc, { const int row = rt * 128 + rl, col = ct * 128 + cl; if (row < NT) {
                    if (which < 2) { const float wl = w0[which * 512 + col] + val; Wd[((size_t)which * NT + row) * 512 + col] = __expf(-0.6065306597f * sigmoidf_(wl)); }
                    else if (which < 4) { const int d = which - 2; AA[((size_t)d * NT + row) * 512 + col] = (bf16_t)f2bf(sigmoidf_(a0[d * 512 + col] + val)); }
                    else Gg[(size_t)row * 512 + col] = (bf16_t)f2bf(val); } });
            }
}


__device__ __forceinline__ void phase_5(CParams& P, unsigned char* lds, const int ph) {
    PHASE_PROLOGUE
            for (int row = gw; row < NT; row += NGW) {
                const int c0 = lane * 8;
                const u32x4 krv = *(const u32x4*)(KR + (size_t)row * 512 + c0);
                const u32x4 rv = *(const u32x4*)(Rr + (size_t)row * 512 + c0);
                float kr[8], rr[8], kkv[8];
#pragma unroll
                for (int i = 0; i < 4; ++i) { kr[2 * i] = bflo(krv[i]); kr[2 * i + 1] = bfhi(krv[i]); rr[2 * i] = bflo(rv[i]); rr[2 * i + 1] = bfhi(rv[i]); }
                float ss = 0.f;
#pragma unroll
                for (int i = 0; i < 8; ++i) { kkv[i] = kr[i] * k_k[c0 + i]; ss += kkv[i] * kkv[i]; }
                ss += __shfl_xor(ss, 1); ss += __shfl_xor(ss, 2); ss += __shfl_xor(ss, 4);
                const float inv = 1.f / fmaxf(sqrtf(ss), 1e-12f);
#pragma unroll
                for (int i = 0; i < 8; ++i) kkv[i] *= inv;
                u32x4 o; o.x = pk2(kkv[0], kkv[1]); o.y = pk2(kkv[2], kkv[3]); o.z = pk2(kkv[4], kkv[5]); o.w = pk2(kkv[6], kkv[7]);
                *(u32x4*)(KK + (size_t)row * 512 + c0) = o;
                float bsum = 0.f;
#pragma unroll
                for (int d = 0; d < 2; ++d) {
                    const u32x4 av = *(const u32x4*)(AA + ((size_t)d * NT + row) * 512 + c0);
                    float a[8], kka[8], kd[8];
#pragma unroll
                    for (int i = 0; i < 4; ++i) { a[2 * i] = bflo(av[i]); a[2 * i + 1] = bfhi(av[i]); }
#pragma unroll
                    for (int i = 0; i < 8; ++i) { kka[i] = kkv[i] * a[i]; kd[i] = kr[i] * (1.f + (a[i] - 1.f) * k_a[c0 + i]); bsum += rr[i] * kd[i] * r_k[c0 + i]; }
                    u32x4 o1; o1.x = pk2(kka[0], kka[1]); o1.y = pk2(kka[2], kka[3]); o1.z = pk2(kka[4], kka[5]); o1.w = pk2(kka[6], kka[7]);
                    *(u32x4*)(KKA + ((size_t)d * NT + row) * 512 + c0) = o1;
                    u32x4 o2; o2.x = pk2(kd[0], kd[1]); o2.y = pk2(kd[2], kd[3]); o2.z = pk2(kd[4], kd[5]); o2.w = pk2(kd[6], kd[7]);
                    *(u32x4*)(KD + ((size_t)d * NT + row) * 512 + c0) = o2;
                }
                bsum += __shfl_xor(bsum, 1); bsum += __shfl_xor(bsum, 2); bsum += __shfl_xor(bsum, 4);
                if ((lane & 7) == 0) BC[(size_t)row * 8 + (lane >> 3)] = bsum;
            }
}


struct ScanIn { f32x4 w; u32x2 kk, ka, kd, r; unsigned short vv; };
__device__ __forceinline__ void phase_6(CParams& P, unsigned char* lds, const int ph) {
    PHASE_PROLOGUE
    constexpr int U = 8;
    for (int cw = bid * 2 + wave; wave < 2 && cw < 512; cw += G * 2) {
        const int chain = cw >> 4, rg = cw & 15, d = chain >> 4, b = (chain >> 3) & 1, h = chain & 7;
        const int rr_ = lane >> 4, kq = lane & 15, vi = rg * 4 + rr_;
        float s0 = 0.f, s1 = 0.f, s2 = 0.f, s3 = 0.f;
        const float* Wp = Wd + (size_t)d * NT * 512 + h * 64 + 4 * kq;
        const bf16_t* KKp = KK + h * 64 + 4 * kq;
        const bf16_t* KKAp = KKA + (size_t)d * NT * 512 + h * 64 + 4 * kq;
        const bf16_t* KDp = KD + (size_t)d * NT * 512 + h * 64 + 4 * kq;
        const bf16_t* Rp = Rr + h * 64 + 4 * kq;
        const bf16_t* Vp = VV + h * 64 + vi;
        bf16_t* Yp = YFB + (size_t)d * NT * 512 + h * 64 + vi;
        ScanIn nxt[U];
#define SCAN_LOAD(dst, s_) do { const int p_ = d ? LSEQ - 1 - (s_) : (s_); const size_t o_ = (size_t)rowof(b, p_) * 512; \
            dst.w = *(const f32x4*)(Wp + o_); dst.kk = *(const u32x2*)(KKp + o_); dst.ka = *(const u32x2*)(KKAp + o_); dst.kd = *(const u32x2*)(KDp + o_); dst.r = *(const u32x2*)(Rp + o_); dst.vv = Vp[o_]; } while (0)
#pragma unroll
        for (int q = 0; q < U; ++q) SCAN_LOAD(nxt[q], q);
        for (int s = 0; s < LSEQ; s += U) {
            ScanIn cur[U];
#pragma unroll
            for (int q = 0; q < U; ++q) cur[q] = nxt[q];
            if (s + U < LSEQ) {
#pragma unroll
                for (int q = 0; q < U; ++q) SCAN_LOAD(nxt[q], s + U + q);
            }
#pragma unroll
            for (int q = 0; q < U; ++q) {
                const ScanIn& c = cur[q];
                const float vv = bf2f(c.vv);
                float dot = s0 * bflo(c.kk.x) + s1 * bfhi(c.kk.x) + s2 * bflo(c.kk.y) + s3 * bfhi(c.kk.y);
                const float t0 = s0 * c.w[0] + vv * bflo(c.kd.x), t1 = s1 * c.w[1] + vv * bfhi(c.kd.x), t2 = s2 * c.w[2] + vv * bflo(c.kd.y), t3 = s3 * c.w[3] + vv * bfhi(c.kd.y);
                dot = row16_sum(dot);
                s0 = t0 - dot * bflo(c.ka.x); s1 = t1 - dot * bfhi(c.ka.x); s2 = t2 - dot * bflo(c.ka.y); s3 = t3 - dot * bfhi(c.ka.y);
                float y = s0 * bflo(c.r.x) + s1 * bfhi(c.r.x) + s2 * bflo(c.r.y) + s3 * bfhi(c.r.y);
                y = row16_sum(y);
                const int p_ = d ? LSEQ - 1 - (s + q) : (s + q);
                if (kq == 0) Yp[(size_t)rowof(b, p_) * 512] = (bf16_t)f2bf(y);
            }
        }
#undef SCAN_LOAD
    }
}

__device__ __forceinline__ void phase_7(CParams& P, unsigned char* lds, const int ph) {
    PHASE_PROLOGUE
            for (int row = gw; row < NT; row += NGW) {
                const int c0 = lane * 8;
                const u32x4 yf = *(const u32x4*)(YFB + (size_t)row * 512 + c0);
                const u32x4 yb = *(const u32x4*)(YFB + ((size_t)NT + row) * 512 + c0);
                const u32x4 vv = *(const u32x4*)(VV + (size_t)row * 512 + c0);
                const u32x4 gg = *(const u32x4*)(Gg + (size_t)row * 512 + c0);
                float y[8], v[8], g[8];
#pragma unroll
                for (int i = 0; i < 4; ++i) { y[2 * i] = bflo(yf[i]) + bflo(yb[i]); y[2 * i + 1] = bfhi(yf[i]) + bfhi(yb[i]); v[2 * i] = bflo(vv[i]); v[2 * i + 1] = bfhi(vv[i]); g[2 * i] = bflo(gg[i]); g[2 * i + 1] = bfhi(gg[i]); }
                float sm = 0.f;
#pragma unroll
                for (int i = 0; i < 8; ++i) sm += y[i];
                sm += __shfl_xor(sm, 1); sm += __shfl_xor(sm, 2); sm += __shfl_xor(sm, 4);
                const float mean = sm * (1.f / 64.f);
                float vr = 0.f;
#pragma unroll
                for (int i = 0; i < 8; ++i) { const float dlt = y[i] - mean; vr += dlt * dlt; }
                vr += __shfl_xor(vr, 1); vr += __shfl_xor(vr, 2); vr += __shfl_xor(vr, 4);
                const float rstd = rsqrtf(vr * (1.f / 64.f) + 64e-5f);
                const float bc = BC[(size_t)row * 8 + (lane >> 3)];
                float o[8];
#pragma unroll
                for (int i = 0; i < 8; ++i) o[i] = ((y[i] - mean) * rstd * lnx_g[c0 + i] + lnx_b[c0 + i] + bc * v[i]) * g[i];
                u32x4 ov; ov.x = pk2(o[0], o[1]); ov.y = pk2(o[2], o[3]); ov.z = pk2(o[4], o[5]); ov.w = pk2(o[6], o[7]);
                *(u32x4*)(A2 + (size_t)row * DM + 512 + c0) = ov;
            }
}


__device__ __forceinline__ void phase_8(CParams& P, unsigned char* lds, const int ph) {
    PHASE_PROLOGUE
    if (gw < 64) meta_gemm<0>(A2 + (size_t)NMAIN * DM, WTOUT, H + (size_t)NMAIN * DM, gw, lane);
    pg8::DenseOrder S; S.init(A2, WTOUT, NMAIN, DM, DM, G, bid);
    pg8::EpiResidual E{H};
    pg8::gemm_phase<pg8::EpiResidual, pg8::DenseOrder, true, true>((PG8_LAS unsigned char*)lds, DM, S, E);
}

__device__ __forceinline__ void phase_9(CParams& P, unsigned char* lds, const int ph) {
    PHASE_PROLOGUE
            const int l = ph == 9 ? 0 : 1;
                    unsigned* cnt = CTL + CW_CNT(l);
            const float* wg = moe_wg + (size_t)l * DM * 4; const float* bg = moe_bg + l * 4;
            for (int row = gw; row < NT; row += NGW) {
                f32x4 v[4]; float ss = 0.f;
#pragma unroll
                for (int j = 0; j < 4; ++j) { v[j] = ((const f32x4*)(H + (size_t)row * DM))[lane + 64 * j]; ss += v[j][0] * v[j][0] + v[j][1] * v[j][1] + v[j][2] * v[j][2] + v[j][3] * v[j][3]; }
                ss = wave_sum(ss);
                const float rstd = rsqrtf(ss * (1.f / DM) + 1e-6f);
                float lg[4] = {0.f, 0.f, 0.f, 0.f};
#pragma unroll
                for (int j = 0; j < 4; ++j) {
                    const f32x4 g = ((const f32x4*)(norm_ffn + l * DM))[lane + 64 * j];
#pragma unroll
                    for (int i = 0; i < 4; ++i) v[j][i] = v[j][i] * rstd * g[i];
                    u32x2 o; o.x = pk2(v[j][0], v[j][1]); o.y = pk2(v[j][2], v[j][3]);
                    ((u32x2*)(HN + (size_t)row * DM))[lane + 64 * j] = o;
#pragma unroll
                    for (int i = 0; i < 4; ++i) { const f32x4 w = *(const f32x4*)(wg + (size_t)(4 * (lane + 64 * j) + i) * 4);
                        lg[0] += v[j][i] * w[0]; lg[1] += v[j][i] * w[1]; lg[2] += v[j][i] * w[2]; lg[3] += v[j][i] * w[3]; }
                }
#pragma unroll
                for (int q = 0; q < 4; ++q) lg[q] = wave_sum(lg[q]) + bg[q];
                int grp = 0; float mx = lg[0];
#pragma unroll
                for (int q = 1; q < 4; ++q) if (lg[q] > mx) { mx = lg[q]; grp = q; }
                float den = 0.f;
#pragma unroll
                for (int q = 0; q < 4; ++q) den += __expf(lg[q] - mx);
                const float pgrp = 1.f / den;
                const float* we = moe_we + ((size_t)(l * 4 + grp) * DM) * 8;
                float le[8] = {0.f, 0.f, 0.f, 0.f, 0.f, 0.f, 0.f, 0.f};
#pragma unroll
                for (int j = 0; j < 4; ++j)
#pragma unroll
                    for (int i = 0; i < 4; ++i) { const float* wr_ = we + (size_t)(4 * (lane + 64 * j) + i) * 8; const f32x4 wa = *(const f32x4*)wr_, wb = *(const f32x4*)(wr_ + 4);
                        le[0] += v[j][i] * wa[0]; le[1] += v[j][i] * wa[1]; le[2] += v[j][i] * wa[2]; le[3] += v[j][i] * wa[3];
                        le[4] += v[j][i] * wb[0]; le[5] += v[j][i] * wb[1]; le[6] += v[j][i] * wb[2]; le[7] += v[j][i] * wb[3]; }
#pragma unroll
                for (int q = 0; q < 8; ++q) le[q] = wave_sum(le[q]) + moe_be[(l * 4 + grp) * 8 + q];
                int i1 = 0; float m1 = le[0];
#pragma unroll
                for (int q = 1; q < 8; ++q) if (le[q] > m1) { m1 = le[q]; i1 = q; }
                int i2 = -1; float m2 = -3.0e38f;
#pragma unroll
                for (int q = 0; q < 8; ++q) if (q != i1 && le[q] > m2) { m2 = le[q]; i2 = q; }
                const float e2 = __expf(m2 - m1);
                const float g1 = pgrp / (1.f + e2), g2 = pgrp * e2 / (1.f + e2);
                if (lane == 0) {
                    const int ea = grp * 8 + i1, eb = grp * 8 + i2;
                    const unsigned pa = atomicAdd(cnt + ea, 1u), pb = atomicAdd(cnt + eb, 1u);
                    EID[row * 2] = ea; EID[row * 2 + 1] = eb; POS[row * 2] = (int)pa; POS[row * 2 + 1] = (int)pb;
                    GATE[row * 2] = g1; GATE[row * 2 + 1] = g2;
                }
            }
}


__device__ __forceinline__ void phase_10(CParams& P, unsigned char* lds, const int ph) {
    PHASE_PROLOGUE
    const int l = ph == 10 ? 0 : 1;
    int* ps = (int*)(lds + LDS_TAB);
    if (tid == 0) { int acc_ = 0; for (int e = 0; e < NEXP; ++e) { ps[e] = acc_; const int c = (int)CTL[CW_CNT(l) + e]; acc_ += (c + MOE_RT - 1) / MOE_RT * MOE_RT; } ps[NEXP] = acc_; }
    __syncthreads();
    for (int row = gw; row < NT; row += NGW) {
        const u32x4 v0 = ((const u32x4*)(HN + (size_t)row * DM))[lane], v1 = ((const u32x4*)(HN + (size_t)row * DM))[lane + 64];
#pragma unroll
        for (int k = 0; k < 2; ++k) {
            const int dest = ps[EID[row * 2 + k]] + POS[row * 2 + k];
            if (lane == 0) DEST[row * 2 + k] = dest;
            ((u32x4*)(XB + (size_t)dest * DM))[lane] = v0; ((u32x4*)(XB + (size_t)dest * DM))[lane + 64] = v1;
        }
    }
    __syncthreads();
}

__device__ __forceinline__ void phase_11(CParams& P, unsigned char* lds, const int ph) {
    PHASE_PROLOGUE
    const int l = ph == 11 ? 0 : 1;
    int* et = (int*)(lds + LDS_TAB);
    if (tid == 0) { int acc_ = 0; for (int e = 0; e < NEXP; ++e) { const int c = (int)CTL[CW_CNT(l) + e], n = (c + MOE_RT - 1) / MOE_RT; for (int q = 0; q < n; ++q) et[1 + acc_ + q] = e; acc_ += n; } et[0] = acc_; }
    __syncthreads();
    pg8::MoeOrder S{et + 1, et[0], vcu, (const char*)XB, (const char*)WT13, 256u * DM * 2u, 256u * DM * 2u, (unsigned)DM * DM * 2u};
    pg8::EpiSwiglu E{HB};
    pg8::gemm_phase<pg8::EpiSwiglu, pg8::MoeOrder, true, true>((PG8_LAS unsigned char*)lds, DM, S, E);
    __syncthreads();
}

__device__ __forceinline__ void phase_12(CParams& P, unsigned char* lds, const int ph) {
    PHASE_PROLOGUE
    const int l = ph == 12 ? 0 : 1;
    int* et = (int*)(lds + LDS_TAB);
    if (tid == 0) { int acc_ = 0; for (int e = 0; e < NEXP; ++e) { const int c = (int)CTL[CW_CNT(l) + e], n = (c + MOE_RT - 1) / MOE_RT; for (int q = 0; q < n; ++q) et[1 + acc_ + q] = e; acc_ += n; } et[0] = acc_; }
    __syncthreads();
    pg8::MoeOrder S{et + 1, et[0], vcu, (const char*)HB, (const char*)WT2, 256u * DFF * 2u, 256u * DFF * 2u, (unsigned)DM * DFF * 2u};
    pg8::EpiBf16Plain E{YB, DM};
    pg8::gemm_phase<pg8::EpiBf16Plain, pg8::MoeOrder, true, true>((PG8_LAS unsigned char*)lds, DFF, S, E);
    __syncthreads();
}

__device__ __forceinline__ void phase_13(CParams& P, unsigned char* lds, const int ph) {
    PHASE_PROLOGUE
            const bool fin = ph == 21;
            for (int row = gw; row < NT; row += NGW) {
                const int d0 = DEST[row * 2], d1 = DEST[row * 2 + 1];
                const float g0 = GATE[row * 2], g1 = GATE[row * 2 + 1];
                f32x4 v[4];
#pragma unroll
                for (int j = 0; j < 4; ++j) {
                    v[j] = ((const f32x4*)(H + (size_t)row * DM))[lane + 64 * j];
                    const u32x2 ya = ((const u32x2*)(YB + (size_t)d0 * DM))[lane + 64 * j];
                    const u32x2 yb = ((const u32x2*)(YB + (size_t)d1 * DM))[lane + 64 * j];
                    v[j][0] += g0 * bflo(ya.x) + g1 * bflo(yb.x); v[j][1] += g0 * bfhi(ya.x) + g1 * bfhi(yb.x);
                    v[j][2] += g0 * bflo(ya.y) + g1 * bflo(yb.y); v[j][3] += g0 * bfhi(ya.y) + g1 * bfhi(yb.y);
                }
                if (!fin) {
#pragma unroll
                    for (int j = 0; j < 4; ++j) ((f32x4*)(H + (size_t)row * DM))[lane + 64 * j] = v[j];
                    store_norm_bf16(v, norm_mix + DM, HN + (size_t)row * DM, lane);
                } else if (row < NMAIN) {
                    float ss = 0.f;
#pragma unroll
                    for (int j = 0; j < 4; ++j) ss += v[j][0] * v[j][0] + v[j][1] * v[j][1] + v[j][2] * v[j][2] + v[j][3] * v[j][3];
                    ss = wave_sum(ss);
                    const float rstd = rsqrtf(ss * (1.f / DM) + 1e-6f);
#pragma unroll
                    for (int j = 0; j < 4; ++j) { const f32x4 g = ((const f32x4*)norm_final)[lane + 64 * j]; f32x4 o;
                        o[0] = v[j][0] * rstd * g[0]; o[1] = v[j][1] * rstd * g[1]; o[2] = v[j][2] * rstd * g[2]; o[3] = v[j][3] * rstd * g[3];
                        ((f32x4*)(P.out + (size_t)row * DM))[lane + 64 * j] = o; }
                }
            }
    if (!fin) { for (int it = gw; it < CONV_MOE_ITEMS; it += NGW) conv_moe_item(P, 1, it, lane); }
}

__device__ __forceinline__ void phase_14(CParams& P, unsigned char* lds, const int ph) {
    PHASE_PROLOGUE
    float* pwr = (float*)lds; float* pwi = pwr + 2176; float* bbr = pwi + 2176; float* bbi = bbr + 2048; float* ccr = bbi + 2048; float* cci = ccr + 2048; float* kf = cci + 2048; float* kb = kf + 4096;
    for (int g = bid; g < 64; g += G) {
        if (tid < 128) {
            const int d = tid >> 6, p = tid & 63;
            const float step = __expf(s5_ls[d * 64 + g]);
            const float lr = s5_lre[(d * 64 + g) * 64 + p], li = s5_lim[(d * 64 + g) * 64 + p];
            const float mag = expf(lr * step);
            const float abr = mag * cosf(li * step), abi = mag * sinf(li * step);
            const float den = lr * lr + li * li;
            const float zr = ((abr - 1.f) * lr + abi * li) / den, zi = (abi * lr - (abr - 1.f) * li) / den;
            float pr = 1.f, pi = 0.f;
            for (int t = 0; t < 17; ++t) { pwr[(d * 64 + p) * 17 + t] = pr; pwi[(d * 64 + p) * 17 + t] = pi; const float nr = pr * abr - pi * abi; pi = pr * abi + pi * abr; pr = nr; }
            for (int i = 0; i < 16; ++i) { const float br = s5_b_re[((size_t)(g * 64 + p)) * 16 + i], bi = s5_b_im[((size_t)(g * 64 + p)) * 16 + i];
                bbr[(d * 64 + p) * 16 + i] = zr * br - zi * bi; bbi[(d * 64 + p) * 16 + i] = zr * bi + zi * br; }
        }
        for (int idx = tid; idx < 2048; idx += 512) { const int d = idx >> 10, i = (idx >> 6) & 15, p = idx & 63;
            ccr[idx] = s5_c_re[((size_t)(d * 64 + g) * 16 + i) * 64 + p]; cci[idx] = s5_c_im[((size_t)(d * 64 + g) * 16 + i) * 64 + p]; }
        __syncthreads();
        {
            const int d = tid >> 8, tau = (tid >> 4) & 15, i = tid & 15;
            float acc[16];
#pragma unroll
            for (int q = 0; q < 16; ++q) acc[q] = 0.f;
            for (int p = 0; p < 64; ++p) {
                const float cr = ccr[(d * 16 + i) * 64 + p], ci = cci[(d * 16 + i) * 64 + p], pr = pwr[(d * 64 + p) * 17 + tau], pi = pwi[(d * 64 + p) * 17 + tau];
                const float xr = cr * pr - ci * pi, xi = cr * pi + ci * pr;
#pragma unroll
                for (int q = 0; q < 16; ++q) acc[q] += xr * bbr[(d * 64 + p) * 16 + q] - xi * bbi[(d * 64 + p) * 16 + q];
            }
            float* kt = (d ? kb : kf) + (tau * 16 + i) * 16;
#pragma unroll
            for (int q = 0; q < 16; ++q) kt[q] = acc[q];
        }
        __syncthreads();
        unsigned* bta = (unsigned*)(BTA + (size_t)g * 512 * 256);
        for (int idx = tid; idx < 512 * 128; idx += 512) {
            const int row = idx >> 7, col = (idx & 127) * 2;
            float v[2];
#pragma unroll
            for (int e = 0; e < 2; ++e) {
                const int cc_ = col + e, j = cc_ >> 4, ip = cc_ & 15;
                if (row < 256) { const int t = row >> 4, i = row & 15;
                    v[e] = j < t ? kf[((t - j) * 16 + i) * 16 + ip] : (j > t ? kb[((j - t) * 16 + i) * 16 + ip] : kf[i * 16 + ip] + kb[i * 16 + ip]); }
                else { const int kp = row - 256, d = kp >> 7, part = (kp >> 6) & 1, p = kp & 63, tau = d == 0 ? 15 - j : j;
                    const float pr = pwr[(d * 64 + p) * 17 + tau], pi = pwi[(d * 64 + p) * 17 + tau], br = bbr[(d * 64 + p) * 16 + ip], bi = bbi[(d * 64 + p) * 16 + ip];
                    v[e] = part ? pr * bi + pi * br : pr * br - pi * bi; }
            }
            bta[idx] = pk2(v[0], v[1]);
        }
        unsigned* btc = (unsigned*)(BTC + (size_t)g * 256 * 256);
        for (int idx = tid; idx < 256 * 128; idx += 512) {
            const int row = idx >> 7, col = (idx & 127) * 2, t = row >> 4, i = row & 15;
            float v[2];
#pragma unroll
            for (int e = 0; e < 2; ++e) {
                const int k = col + e, d = k >> 7, part = (k >> 6) & 1, p = k & 63, tau = d == 0 ? t + 1 : 16 - t;
                const float cr = ccr[(d * 16 + i) * 64 + p], ci = cci[(d * 16 + i) * 64 + p], pr = pwr[(d * 64 + p) * 17 + tau], pi = pwi[(d * 64 + p) * 17 + tau];
                v[e] = part ? -(cr * pi + ci * pr) : cr * pr - ci * pi;
            }
            btc[idx] = pk2(v[0], v[1]);
        }
        __syncthreads();
    }
}

__device__ __forceinline__ void phase_15(CParams& P, unsigned char* lds, const int ph) {
    PHASE_PROLOGUE
    pg8::S5OrderA S{vcu, (const char*)HN, (const char*)BTA};
    pg8::EpiS5A E{YI, S5E};
    int Kr = 256; asm volatile("" : "+s"(Kr));
    pg8::gemm_phase<pg8::EpiS5A, pg8::S5OrderA, true, true>((PG8_LAS unsigned char*)lds, Kr, S, E);
}

__device__ __forceinline__ void phase_16(CParams& P, unsigned char* lds, const int ph) {
    PHASE_PROLOGUE
    for (int i = bid * 512 + tid; i < NB * 64 * 2 * 64; i += G * 512) {
        const int p = i & 63, d = (i >> 6) & 1, g = (i >> 7) & 63, b = i >> 13;
        const float step = __expf(s5_ls[d * 64 + g]);
        const float lr = s5_lre[(d * 64 + g) * 64 + p], li = s5_lim[(d * 64 + g) * 64 + p];
        const float mag = expf(lr * step);
        const float abr = mag * cosf(li * step), abi = mag * sinf(li * step);
        float ar = 1.f, ai = 0.f;
        for (int t = 0; t < 16; ++t) { const float nr = ar * abr - ai * abi; ai = ar * abi + ai * abr; ar = nr; }
        const float* Ep = S5E + (size_t)g * 256 + d * 128 + p;
        bf16_t* Cp = CAR + (size_t)g * 1280 * 256 + d * 128 + p;
        float sr = 0.f, si = 0.f;
        for (int q0 = 0; q0 < 513; q0 += 9) {
            float er[9], ei[9]; int nn[9];
#pragma unroll
            for (int k = 0; k < 9; ++k) { const int q = q0 + k, c = d ? 512 - q : q; nn[k] = c == 0 ? 1024 + b : b * 512 + c - 1; er[k] = Ep[(size_t)nn[k] * 64 * 256]; ei[k] = Ep[(size_t)nn[k] * 64 * 256 + 64]; }
#pragma unroll
            for (int k = 0; k < 9; ++k) { Cp[(size_t)nn[k] * 256] = (bf16_t)f2bf(sr); Cp[(size_t)nn[k] * 256 + 64] = (bf16_t)f2bf(si);
                const float nr = ar * sr - ai * si + er[k]; si = ar * si + ai * sr + ei[k]; sr = nr; }
        }
    }
}

__device__ __forceinline__ void phase_22(CParams& P, unsigned char* lds, const int ph) {
    PHASE_PROLOGUE
    pg8::S5OrderC S{vcu, (const char*)CAR, (const char*)BTC};
    pg8::EpiS5C E{YI, HN, s5_d, A2};
    int Kr = 256; asm volatile("" : "+s"(Kr));
    pg8::gemm_phase<pg8::EpiS5C, pg8::S5OrderC, true, true>((PG8_LAS unsigned char*)lds, Kr, S, E);
}

__device__ __forceinline__ void phase_23(CParams& P, unsigned char* lds, const int ph) {
    PHASE_PROLOGUE
    if (gw < 64) meta_gemm<1>(A2 + (size_t)NMAIN * DM, WTGLU, H + (size_t)NMAIN * DM, gw, lane);
    pg8::DenseOrder S; S.init(A2, WTGLU, NMAIN, 2 * DM, DM, G, bid);
    pg8::EpiGlu E{H};
    pg8::gemm_phase<pg8::EpiGlu, pg8::DenseOrder, true, true>((PG8_LAS unsigned char*)lds, DM, S, E);
}
#define LAS __attribute__((address_space(3)))
#define CW_BAR 4096
#define XB_TMO      128
#define XB_XCNT(j)  (256  + 64 * (j))
#define XB_XSUB(j)  (1280 + 64 * (j))
#define XB_XGEN(j)  (2304 + 64 * (j))
#define XB_TOP      3328
#define XB_TOPGEN   3392
#define XCD_BAR_WORDS 3456
#define XB_SPIN_CAP (1u << 22)
__device__ __forceinline__ unsigned xb_ld(unsigned* p)              { return __hip_atomic_load(p, __ATOMIC_RELAXED, __HIP_MEMORY_SCOPE_AGENT); }
__device__ __forceinline__ unsigned xb_add(unsigned* p, unsigned v) { return __hip_atomic_fetch_add(p, v, __ATOMIC_RELAXED, __HIP_MEMORY_SCOPE_AGENT); }
__device__ __forceinline__ unsigned xb_xcc_id() { return (unsigned)__builtin_amdgcn_s_getreg((3 << 11) | 20) & 0xFu; }
#define XB_SPIN(cond, bar) do { unsigned _sp = 0; while (cond) { __builtin_amdgcn_s_sleep(1); \
    if ((++_sp & 255u) == 0u) { if (xb_ld(&(bar)[XB_TMO])) break; if (_sp > XB_SPIN_CAP) { atomicAdd(&(bar)[XB_TMO], 1u); break; } } } } while (0)
struct XcdBarrier { unsigned* bar; unsigned x; volatile LAS unsigned* st; };
__device__ __forceinline__ XcdBarrier xcd_barrier_post(unsigned* bar, volatile LAS unsigned* st) {
    XcdBarrier b; b.bar = bar; b.x = xb_xcc_id(); b.st = st;
    if (threadIdx.x == 0) (void)xb_add(&bar[XB_XCNT(b.x)], 1u);
    return b;
}
__device__ __forceinline__ void xcd_barrier_complete(unsigned* bar, unsigned x, unsigned& nloc, unsigned& nx) {
    const unsigned G = GRID;
    unsigned sum, cnt, mine, sp = 0u;
    for (;;) {
        sum = 0u; cnt = 0u; mine = 0u;
#pragma unroll
        for (unsigned j = 0; j < 16; ++j) { const unsigned c = xb_ld(&bar[XB_XCNT(j)]); sum += c; cnt += (c > 0u) ? 1u : 0u; mine = (j == x) ? c : mine; }
        if (sum == G) break;
        __builtin_amdgcn_s_sleep(1);
        if ((++sp & 255u) == 0u) { if (xb_ld(&bar[XB_TMO])) break; if (sp > XB_SPIN_CAP) { atomicAdd(&bar[XB_TMO], 1u); break; } }
    }
    nloc = mine > 0u ? mine : 1u; nx = cnt > 0u ? cnt : 1u;
}
__device__ __forceinline__ void xcd_barrier(const XcdBarrier& b) {
    asm volatile("s_waitcnt vmcnt(0)" ::: "memory");
    __syncthreads();
    if (threadIdx.x == 0) {
        unsigned* bar = b.bar;
        __builtin_amdgcn_s_waitcnt(0);
        unsigned nloc = b.st[0], nx = b.st[1];
        if (nloc == 0u) { xcd_barrier_complete(bar, b.x, nloc, nx); b.st[0] = nloc; b.st[1] = nx; }
        const unsigned old = xb_add(&bar[XB_XSUB(b.x)], 1u);
        const unsigned gen = old / nloc;
        if (old + 1u == (gen + 1u) * nloc) {
            __builtin_amdgcn_fence(__ATOMIC_RELEASE, "agent");
            asm volatile("s_waitcnt vmcnt(0)" ::: "memory");
            const unsigned og = xb_add(&bar[XB_TOP], 1u);
            const unsigned tg = og / nx;
            if (og + 1u == (tg + 1u) * nx) xb_add(&bar[XB_TOPGEN], 1u);
            else XB_SPIN(xb_ld(&bar[XB_TOPGEN]) == tg, bar);
            __builtin_amdgcn_fence(__ATOMIC_ACQUIRE, "agent");
            xb_add(&bar[XB_XGEN(b.x)], 1u);
            asm volatile("s_waitcnt vmcnt(0)" ::: "memory");
        } else {
            XB_SPIN(xb_ld(&bar[XB_XGEN(b.x)]) == gen, bar);
            __builtin_amdgcn_fence(__ATOMIC_ACQUIRE, "agent");
            asm volatile("s_waitcnt vmcnt(0)" ::: "memory");
        }
    }
    __syncthreads();
}


__global__ void __launch_bounds__(512, 2) mega(Params P_) {
    extern __shared__ __attribute__((aligned(16))) unsigned char lds[];
    volatile LAS unsigned* st = (volatile LAS unsigned*)(LAS unsigned char*)(lds + LDS_BARST);
    if (threadIdx.x < 16) st[threadIdx.x] = 0u;
    __syncthreads();
    CParams* pp = (CParams*)__builtin_amdgcn_kernarg_segment_ptr();
    (void)xcd_barrier_post((unsigned*)(pp->ws + WS_CTL) + CW_BAR, st);
#define GB do { XcdBarrier bar_; bar_.bar = (unsigned*)(pp->ws + WS_CTL) + CW_BAR; bar_.x = xb_xcc_id(); bar_.st = (volatile LAS unsigned*)(LAS unsigned char*)(lds + LDS_BARST); xcd_barrier(bar_); asm volatile("" : "+s"(pp)); } while (0)
#define P (*pp)
    asm volatile("" : "+s"(pp));
    phase_0(P, lds, 0); GB;
#if defined(PROBE_DUP) && PROBE_DUP == 0
    GB; phase_0(P, lds, 0); GB;
#endif
    phase_1(P, lds, 1); GB;
#if defined(PROBE_DUP) && PROBE_DUP == 1
    GB; phase_1(P, lds, 1); GB;
#endif
    phase_2(P, lds, 2); asm volatile("" : "+s"(pp));
#if defined(PROBE_DUP) && PROBE_DUP == 2
    GB; phase_2(P, lds, 2); GB;
#endif
    phase_3(P, lds, 3); GB;
#if defined(PROBE_DUP) && PROBE_DUP == 3
    GB; phase_3(P, lds, 3); GB;
#endif
    phase_4(P, lds, 4); GB;
#if defined(PROBE_DUP) && PROBE_DUP == 4
    GB; phase_4(P, lds, 4); GB;
#endif
    phase_5(P, lds, 5); GB;
#if defined(PROBE_DUP) && PROBE_DUP == 5
    GB; phase_5(P, lds, 5); GB;
#endif
    phase_6(P, lds, 6); GB;
#if defined(PROBE_DUP) && PROBE_DUP == 6
    GB; phase_6(P, lds, 6); GB;
#endif
    phase_7(P, lds, 7); GB;
#if defined(PROBE_DUP) && PROBE_DUP == 7
    GB; phase_7(P, lds, 7); GB;
#endif
    phase_8(P, lds, 8); GB;
#if defined(PROBE_DUP) && PROBE_DUP == 8
    GB; phase_8(P, lds, 8); GB;
#endif
    phase_9(P, lds, 9); GB;
#if defined(PROBE_DUP) && PROBE_DUP == 9
    GB; phase_9(P, lds, 9); GB;
#endif
    phase_10(P, lds, 10); GB;
#if defined(PROBE_DUP) && PROBE_DUP == 10
    GB; phase_10(P, lds, 10); GB;
#endif
    phase_11(P, lds, 11); GB;
#if defined(PROBE_DUP) && PROBE_DUP == 11
    GB; phase_11(P, lds, 11); GB;
#endif
    phase_12(P, lds, 12); GB;
#if defined(PROBE_DUP) && PROBE_DUP == 12
    GB; phase_12(P, lds, 12); GB;
#endif
    phase_13(P, lds, 13); GB;
#if defined(PROBE_DUP) && PROBE_DUP == 13
    GB; phase_13(P, lds, 13); GB;
#endif
    phase_14(P, lds, 14); GB;
#if defined(PROBE_DUP) && PROBE_DUP == 14
    GB; phase_14(P, lds, 14); GB;
#endif
    phase_15(P, lds, 15); GB;
#if defined(PROBE_DUP) && PROBE_DUP == 15
    GB; phase_15(P, lds, 15); GB;
#endif
    phase_16(P, lds, 16); GB;
#if defined(PROBE_DUP) && PROBE_DUP == 16
    GB; phase_14(P, lds, 16); GB;
#endif
    phase_22(P, lds, 22); GB;
#if defined(PROBE_DUP) && PROBE_DUP == 22
    GB; phase_22(P, lds, 22); GB;
#endif
    phase_23(P, lds, 23); GB;
#if defined(PROBE_DUP) && PROBE_DUP == 23
    GB; phase_23(P, lds, 23); GB;
#endif
    phase_9(P, lds, 17); GB;
#if defined(PROBE_DUP) && PROBE_DUP == 17
    GB; phase_9(P, lds, 17); GB;
#endif
    phase_10(P, lds, 18); GB;
#if defined(PROBE_DUP) && PROBE_DUP == 18
    GB; phase_10(P, lds, 18); GB;
#endif
    phase_11(P, lds, 19); GB;
#if defined(PROBE_DUP) && PROBE_DUP == 19
    GB; phase_11(P, lds, 19); GB;
#endif
    phase_12(P, lds, 20); GB;
#if defined(PROBE_DUP) && PROBE_DUP == 20
    GB; phase_12(P, lds, 20); GB;
#endif
    phase_13(P, lds, 21);
#if defined(PROBE_DUP) && PROBE_DUP == 21
    GB; phase_13(P, lds, 21); GB;
#endif
#undef P
#undef GB
}

extern "C" void kernel_launch(void* const* d_in, const int* in_sizes, int n_in, void* d_out, int out_size, void* d_ws, size_t ws_size, hipStream_t stream) {
    static int ready = 0;
    if (!ready) {
        if (n_in != 35 || ws_size < WS_TOTAL) { fprintf(stderr, "kernel_launch: unexpected n_in %d or ws_size %zu (need %zu)\n", n_in, ws_size, (size_t)WS_TOTAL); ready = -1; return; }
        if (hipFuncSetAttribute((const void*)mega, hipFuncAttributeMaxDynamicSharedMemorySize, LDS_BYTES) != hipSuccess) { fprintf(stderr, "kernel_launch: hipFuncSetAttribute failed\n"); ready = -1; return; }
        ready = 1;
    }
    if (ready < 0) return;
    (void)hipMemsetAsync((char*)d_ws + WS_CTL, 0, 1 * MiB, stream);
    Params P{};
    for (int i = 0; i < 35; ++i) P.in[i] = (const float*)d_in[i];
    P.out = (float*)d_out; P.ws = (unsigned char*)d_ws; P.ph_lo = 0; P.ph_hi = 0;
    hipLaunchKernelGGL(mega, dim3(GRID), dim3(512), LDS_BYTES, stream, P);
}
```

```cpp
#include <hip/hip_runtime.h>
#include <stdint.h>
#include <stdio.h>

#define DM 1024
#define NB 2
#define SEQ 8192
#define NMETA 16
#define LSEQ (SEQ + NMETA)
#define NMAIN (NB * SEQ)
#define NT (NB * LSEQ)
#define NTP 16640
#define INCOLS 3328
#define RESTC 1792
#define NEXP 32
#define DFF 512
#define S5TC 48
#define S5NC 171
#define MOE_RT 256
#define MOE_MAXROWS 41216

typedef unsigned short bf16_t;
typedef short bf16x8 __attribute__((ext_vector_type(8)));
typedef float f32x4 __attribute__((ext_vector_type(4)));
typedef unsigned u32x4 __attribute__((ext_vector_type(4)));
typedef unsigned u32x2 __attribute__((ext_vector_type(2)));

constexpr size_t MiB = 1u << 20;
constexpr size_t al64k(size_t x) { return (x + 65535) & ~(size_t)65535; }
constexpr size_t WS_CTL = 0;
constexpr size_t WS_H = 1 * MiB;
constexpr size_t WS_HN = WS_H + al64k((size_t)NT * DM * 4);
constexpr size_t WS_A2 = WS_HN + al64k((size_t)NTP * DM * 2);
constexpr size_t WS_WTIN = WS_A2 + al64k((size_t)NTP * DM * 2);
constexpr size_t WS_WTOUT = WS_WTIN + al64k((size_t)INCOLS * DM * 2);
constexpr size_t WS_WTGLU = WS_WTOUT + al64k((size_t)DM * DM * 2);
constexpr size_t WS_WT13 = WS_WTGLU + al64k((size_t)2 * DM * DM * 2);
constexpr size_t WS_WT2 = WS_WT13 + al64k((size_t)NEXP * DM * DM * 2);
constexpr size_t WS_BIG = WS_WT2 + al64k((size_t)NEXP * DM * DFF * 2);
constexpr size_t SZ_T512 = al64k((size_t)NT * 512 * 2);
constexpr size_t SZ_P512 = al64k((size_t)NTP * 512 * 2);
constexpr size_t WS_Q = WS_BIG;
constexpr size_t WS_K = WS_Q + SZ_P512;
constexpr size_t WS_V = WS_K + SZ_P512;
constexpr size_t WS_REST = WS_V + SZ_P512;
constexpr size_t WS_R = WS_REST + al64k((size_t)NTP * RESTC * 2);
constexpr size_t WS_KR = WS_R + SZ_T512;
constexpr size_t WS_VV = WS_KR + SZ_T512;
constexpr size_t WS_LOW = WS_VV + SZ_T512;
constexpr size_t WS_G = WS_LOW + al64k((size_t)NT * 256 * 2);
constexpr size_t WS_KK = WS_G + SZ_T512;
constexpr size_t WS_KKA = WS_KK + SZ_T512;
constexpr size_t WS_KD = WS_KKA + 2 * SZ_T512;
constexpr size_t WS_BC = WS_KD + 2 * SZ_T512;
constexpr size_t WS_MIXEND = WS_BC + al64k((size_t)NT * 8 * 4);
constexpr size_t WS_AA = WS_Q;
constexpr size_t WS_YFB = WS_Q;
constexpr size_t WS_W = WS_V;
static_assert(2 * SZ_T512 <= 2 * SZ_P512, "AA/YFB fit in Q|K");
static_assert((size_t)2 * NT * 512 * 4 <= SZ_P512 + al64k((size_t)NTP * RESTC * 2), "W fits in V|REST");
constexpr size_t WS_XB = WS_BIG;
constexpr size_t WS_HB = WS_XB + al64k((size_t)MOE_MAXROWS * DM * 2);
constexpr size_t WS_YB = WS_HB + al64k((size_t)MOE_MAXROWS * DFF * 2);
constexpr size_t WS_EID = WS_YB + al64k((size_t)MOE_MAXROWS * DM * 2);
constexpr size_t WS_POS = WS_EID + al64k((size_t)NT * 8);
constexpr size_t WS_DEST = WS_POS + al64k((size_t)NT * 8);
constexpr size_t WS_GATE = WS_DEST + al64k((size_t)NT * 8);
constexpr size_t WS_MOEEND = WS_GATE + al64k((size_t)NT * 8);
constexpr size_t WS_YI = WS_BIG;
constexpr size_t WS_E = WS_YI + al64k((size_t)NTP * DM * 4);
constexpr size_t WS_CAR = WS_E + al64k((size_t)1040 * 64 * 256 * 4);
constexpr size_t WS_BTA = WS_CAR + al64k((size_t)64 * 1280 * 256 * 2);
constexpr size_t WS_BTC = WS_BTA + al64k((size_t)64 * 512 * 256 * 2);
constexpr size_t WS_S5END = WS_BTC + al64k((size_t)64 * 256 * 256 * 2);
constexpr size_t cmax(size_t a, size_t b) { return a > b ? a : b; }
constexpr size_t WS_TOTAL = cmax(WS_MIXEND, cmax(WS_MOEEND, WS_S5END));
static_assert(WS_TOTAL <= 512 * MiB, "workspace map exceeds 512 MiB");

#define CW_CNT(l) (1024 + 64 * (l))

#define LDS_RING 131072
#define LDS_BARST (LDS_RING)
#define LDS_TAB (LDS_RING + 256)
#define LDS_BYTES 147456
#define GRID 256

struct Params {
    const float* in[35];
    float* out;
    unsigned char* ws;
    int ph_lo, ph_hi;
};
typedef const __attribute__((address_space(4))) Params CParams;

__device__ __forceinline__ float bf2f(bf16_t v) { return __uint_as_float(((unsigned)v) << 16); }
__device__ __forceinline__ unsigned f2bf(float f) { unsigned u = __float_as_uint(f); return (u + 0x7fffu + ((u >> 16) & 1u)) >> 16; }
__device__ __forceinline__ unsigned pk2(float lo, float hi) { return f2bf(lo) | (f2bf(hi) << 16); }
__device__ __forceinline__ float bflo(unsigned u) { return __uint_as_float(u << 16); }
__device__ __forceinline__ float bfhi(unsigned u) { return __uint_as_float(u & 0xffff0000u); }
__device__ __forceinline__ float wave_sum(float v) {
#pragma unroll
    for (int o = 1; o < 64; o <<= 1) v += __shfl_xor(v, o);
    return v;
}
__device__ __forceinline__ float wave_max(float v) {
#pragma unroll
    for (int o = 1; o < 64; o <<= 1) v = fmaxf(v, __shfl_xor(v, o));
    return v;
}
template <int CTRL> __device__ __forceinline__ float dppf(float v) { return __int_as_float(__builtin_amdgcn_update_dpp(0, __float_as_int(v), CTRL, 0xF, 0xF, true)); }
__device__ __forceinline__ float row16_sum(float v) { v += dppf<0xB1>(v); v += dppf<0x4E>(v); v += dppf<0x141>(v); v += dppf<0x140>(v); return v; }
__device__ __forceinline__ float sigmoidf_(float x) { return 1.f / (1.f + __expf(-x)); }
__device__ __forceinline__ int rowof(int b, int p) { return p < NMETA ? NMAIN + b * NMETA + p : b * SEQ + (p - NMETA); }

#define SA_STRIDE 40
template <class AF, class BF>
__device__ __forceinline__ void gemm_tile(unsigned char* lds, int K, int ldb, const AF& arow, const BF& bcol, f32x4 (&acc)[4][2]) {
    bf16_t* sA = (bf16_t*)lds;
    bf16_t* sB = (bf16_t*)(lds + 128 * SA_STRIDE * 2);
    const int tid = threadIdx.x, lane = tid & 63, wave = tid >> 6, wr = wave >> 2, wc = wave & 3, fr = lane & 15, fq = lane >> 4;
#pragma unroll
    for (int mi = 0; mi < 4; ++mi)
#pragma unroll
        for (int ni = 0; ni < 2; ++ni) acc[mi][ni] = (f32x4){0.f, 0.f, 0.f, 0.f};
    const int ar = tid >> 2, akc = (tid & 3) * 8;
    const bf16_t* ap = arow(ar) + akc;
    const int bnq = (tid & 31) * 4, bkp = (tid >> 5) * 2;
    const float* bp = bcol(bnq) + (size_t)bkp * ldb;
    const int nk = K / 32;
    u32x4 ra = *(const u32x4*)ap;
    f32x4 rb0 = *(const f32x4*)bp, rb1 = *(const f32x4*)(bp + ldb);
    for (int kt = 0; kt < nk; ++kt) {
        __syncthreads();
        *(u32x4*)(sA + ar * SA_STRIDE + akc) = ra;
        {
            unsigned* d = (unsigned*)(sB + bnq * SA_STRIDE + bkp);
            d[0 * (SA_STRIDE / 2)] = pk2(rb0[0], rb1[0]);
            d[1 * (SA_STRIDE / 2)] = pk2(rb0[1], rb1[1]);
            d[2 * (SA_STRIDE / 2)] = pk2(rb0[2], rb1[2]);
            d[3 * (SA_STRIDE / 2)] = pk2(rb0[3], rb1[3]);
        }
        __syncthreads();
        if (kt + 1 < nk) {
            ra = *(const u32x4*)(ap + (kt + 1) * 32);
            const float* q = bp + (size_t)(kt + 1) * 32 * ldb;
            rb0 = *(const f32x4*)q; rb1 = *(const f32x4*)(q + ldb);
        }
        bf16x8 a[4], b[2];
#pragma unroll
        for (int mi = 0; mi < 4; ++mi) a[mi] = *(const bf16x8*)(sA + (wr * 64 + mi * 16 + fr) * SA_STRIDE + fq * 8);
#pragma unroll
        for (int ni = 0; ni < 2; ++ni) b[ni] = *(const bf16x8*)(sB + (wc * 32 + ni * 16 + fr) * SA_STRIDE + fq * 8);
#pragma unroll
        for (int mi = 0; mi < 4; ++mi)
#pragma unroll
            for (int ni = 0; ni < 2; ++ni) acc[mi][ni] = __builtin_amdgcn_mfma_f32_16x16x32_bf16(a[mi], b[ni], acc[mi][ni], 0, 0, 0);
    }
    __syncthreads();
}
#define ACC_FOREACH(acc, ...) do { const int _l = threadIdx.x & 63, _w = threadIdx.x >> 6, _wr = _w >> 2, _wc = _w & 3, _fr = _l & 15, _fq = _l >> 4; \
    _Pragma("unroll") for (int _mi = 0; _mi < 4; ++_mi) _Pragma("unroll") for (int _ni = 0; _ni < 2; ++_ni) _Pragma("unroll") for (int _j = 0; _j < 4; ++_j) { \
        const int rl = _wr * 64 + _mi * 16 + _fq * 4 + _j, cl = _wc * 32 + _ni * 16 + _fr; const float val = acc[_mi][_ni][_j]; __VA_ARGS__ } } while (0)
#define ACC_FOREACH_PAIR(acc, ...) do { const int _l = threadIdx.x & 63, _w = threadIdx.x >> 6, _wr = _w >> 2, _wc = _w & 3, _fr = _l & 15, _fq = _l >> 4; \
    _Pragma("unroll") for (int _mi = 0; _mi < 4; ++_mi) _Pragma("unroll") for (int _j = 0; _j < 4; ++_j) { \
        const int rl = _wr * 64 + _mi * 16 + _fq * 4 + _j, co = _wc * 16 + _fr; const float va = acc[_mi][0][_j], vg = acc[_mi][1][_j]; __VA_ARGS__ } } while (0)

__device__ __forceinline__ void store_norm_bf16(const f32x4 (&v)[4], const float* gain, bf16_t* dst, int lane) {
    float ss = 0.f;
#pragma unroll
    for (int j = 0; j < 4; ++j) ss += v[j][0] * v[j][0] + v[j][1] * v[j][1] + v[j][2] * v[j][2] + v[j][3] * v[j][3];
    ss = wave_sum(ss);
    const float rstd = rsqrtf(ss * (1.f / DM) + 1e-6f);
#pragma unroll
    for (int j = 0; j < 4; ++j) {
        const f32x4 g = ((const f32x4*)gain)[lane + 64 * j];
        u32x2 o; o.x = pk2(v[j][0] * rstd * g[0], v[j][1] * rstd * g[1]); o.y = pk2(v[j][2] * rstd * g[2], v[j][3] * rstd * g[3]);
        ((u32x2*)dst)[lane + 64 * j] = o;
    }
}

namespace pg8 {
#define PG8_LAS __attribute__((address_space(3)))
constexpr int BM = 256, BK = 64, HALF = 128, HTB = HALF * BK * 2  , STAGE_BYTES = 8 * HTB, NXCD = 8, WGM = 8;
__host__ __device__ __forceinline__ int lds_byte(int r, int c) { const int st = (r >> 4) * 2 + (c >> 5), rr = r & 15, cc = c & 31, ob = rr * 64 + cc * 2; return st * 1024 + (ob ^ (((ob >> 9) & 1) << 5)); }
__host__ __device__ __forceinline__ void stage_rc(int b, int& R, int& C) { const int st = b / 1024, sb = b % 1024, swz = sb ^ (((sb >> 9) & 1) << 5); R = (st >> 1) * 16 + swz / 64; C = (st & 1) * 32 + (swz % 64) / 2; }
__host__ __device__ __forceinline__ int perm32(int rho) { const int n = rho >> 4, i = rho & 15; return 8 * (i >> 2) + 4 * n + (i & 3); }

struct Unit { int pm, pn; const char* A; const char* B; };

struct DenseOrder {
    static constexpr bool GATHER_A = false;
    int nM, nN, nwg, G, c; const char* A; const char* Bt; size_t tstep;
    __device__ void init(const bf16_t* A_, const bf16_t* Bt_, int M, int N, int K, int G_, int c_) { nM = M / BM; nN = N / BM; nwg = nM * nN; G = G_; c = c_; A = (const char*)A_; Bt = (const char*)Bt_; tstep = (size_t)BM * K * 2; }
    __device__ bool next(int i, Unit& u) const {
        const long L = (long)i * G + c; if (L >= nwg) return false;
        int wgid = (int)L; { const int q = nwg / NXCD, r = nwg % NXCD, xcd = wgid % NXCD, off = wgid / NXCD; wgid = (xcd < r ? xcd * (q + 1) : r * (q + 1) + (xcd - r) * q) + off; }
        const int nig = WGM * nN, gid = wgid / nig, fm = gid * WGM, gsz = (nM - fm) < WGM ? (nM - fm) : WGM;
        u.pm = fm + ((wgid % nig) % gsz); u.pn = (wgid % nig) / gsz; u.A = A + (size_t)u.pm * tstep; u.B = Bt + (size_t)u.pn * tstep; return true;
    }
    __device__ __forceinline__ void a_ready(const Unit&) const {}
    __device__ __forceinline__ void done(const Unit&) const {}
};
struct ProjOrder {
    static constexpr bool GATHER_A = false;
    DenseOrder D; const char* HNp; const char* WT;
    __device__ void init(const bf16_t* HN_, const bf16_t* WT_, int c_) { D.init(HN_, WT_, NTP, 13 * BM, DM, GRID, c_); HNp = (const char*)HN_; WT = (const char*)WT_; }
    __device__ bool next(int i, Unit& u) const {
        if (!D.next(i, u)) return false;
        const size_t ts = (size_t)BM * DM * 2;
        if (u.pn < 11) { const int wrow = u.pn < 4 ? u.pn : u.pn + 2; u.A = HNp + (size_t)u.pm * ts; u.B = WT + (size_t)wrow * ts; }
        else { u.A = WT + (size_t)(4 + (u.pn - 11)) * ts; u.B = HNp + (size_t)u.pm * ts; }
        return true;
    }
    __device__ __forceinline__ void a_ready(const Unit&) const {}
    __device__ __forceinline__ void done(const Unit&) const {}
};
struct MoeOrder {
    static constexpr bool GATHER_A = false;
    const int* et; int TT, vcu; const char* A; const char* Bt; unsigned tstepA, tstepB, estep;
    __device__ __forceinline__ bool next(int i, Unit& u) const {
        const int L = i * GRID + vcu; if (L >= TT * 4) return false;
        const int rt = L >> 2, ct = L & 3, e = et[rt];
        u.pm = rt; u.pn = ct; u.A = A + (size_t)rt * tstepA; u.B = Bt + (size_t)e * estep + (size_t)ct * tstepB; return true;
    }
    __device__ __forceinline__ void a_ready(const Unit&) const {}
    __device__ __forceinline__ void done(const Unit&) const {}
};

struct S5OrderA {
    static constexpr bool GATHER_A = true;
    int vcu; const char* U; const char* BTA;
    __device__ __forceinline__ bool next(int i, Unit& u) const {
        const int L = i * GRID + vcu; if (L >= 640) return false;
        const int g = L / 10, rem = L - g * 10, mt = rem >> 1, nt = rem & 1;
        u.pm = mt; u.pn = g * 2 + nt; u.A = U + ((size_t)mt * 256 * 16 * 1024 + g * 16) * 2; u.B = BTA + ((size_t)(g * 512 + nt * 256) * 256) * 2; return true;
    }
    __device__ __forceinline__ void a_ready(const Unit&) const {}
    __device__ __forceinline__ void done(const Unit&) const {}
};
struct S5OrderC {
    static constexpr bool GATHER_A = false;
    int vcu; const char* CAR; const char* BTC;
    __device__ __forceinline__ bool next(int i, Unit& u) const {
        const int L = i * GRID + vcu; if (L >= 320) return false;
        const int g = L / 5, mt = L - g * 5;
        u.pm = mt; u.pn = g; u.A = CAR + ((size_t)(g * 1280 + mt * 256) * 256) * 2; u.B = BTC + ((size_t)g * 256 * 256) * 2; return true;
    }
    __device__ __forceinline__ void a_ready(const Unit&) const {}
    __device__ __forceinline__ void done(const Unit&) const {}
};
__device__ __forceinline__ unsigned cvt_pk_bf16(float lo, float hi) { unsigned r; asm volatile("v_cvt_pk_bf16_f32 %0, %1, %2" : "=v"(r) : "v"(lo), "v"(hi)); return r; }

struct EpiProj {
    static constexpr bool PERM = true, AFTER_DRAIN = false;
    bf16_t *Q, *Kk, *VT, *REST;
    __device__ __forceinline__ void operator()(const f32x4 (&acc)[2][2][4][2], const Unit& u, int wr, int wc, int fr, int fq) const {
        bf16_t* base; int ldc; int row0, col0;
        if (u.pn < 11) { row0 = u.pm * BM + wr * 64 + fr; int colt;
            if (u.pn < 2) { base = Q; colt = u.pn * BM; ldc = 512; } else if (u.pn < 4) { base = Kk; colt = (u.pn - 2) * BM; ldc = 512; } else { base = REST; colt = (u.pn - 4) * BM; ldc = RESTC; }
            col0 = colt + wc * 32 + 8 * fq; }
        else { base = VT; ldc = NTP; row0 = (u.pn - 11) * BM + wr * 64 + fr; col0 = u.pm * BM + wc * 32 + 8 * fq; }
#pragma unroll
        for (int ai = 0; ai < 2; ++ai)
#pragma unroll
            for (int m = 0; m < 4; ++m) { bf16_t* rowp = base + (size_t)(row0 + ai * HALF + m * 16) * ldc + col0;
#pragma unroll
                for (int bj = 0; bj < 2; ++bj) { const f32x4 v0 = acc[ai][bj][m][0], v1 = acc[ai][bj][m][1];
                    u32x4 w; w.x = cvt_pk_bf16(v0[0], v0[1]); w.y = cvt_pk_bf16(v0[2], v0[3]); w.z = cvt_pk_bf16(v1[0], v1[1]); w.w = cvt_pk_bf16(v1[2], v1[3]);
                    *(u32x4*)(rowp + bj * HALF) = w; } }
    }
};
struct EpiBf16Plain {
    static constexpr bool PERM = true, AFTER_DRAIN = false;
    bf16_t* O; int ldc;
    __device__ __forceinline__ void operator()(const f32x4 (&acc)[2][2][4][2], const Unit& u, int wr, int wc, int fr, int fq) const {
        const int row0 = u.pm * BM + wr * 64 + fr; const int col0 = u.pn * BM + wc * 32 + 8 * fq;
#pragma unroll
        for (int ai = 0; ai < 2; ++ai)
#pragma unroll
            for (int m = 0; m < 4; ++m) { bf16_t* rowp = O + (size_t)(row0 + ai * HALF + m * 16) * ldc + col0;
#pragma unroll
                for (int bj = 0; bj < 2; ++bj) { const f32x4 v0 = acc[ai][bj][m][0], v1 = acc[ai][bj][m][1];
                    u32x4 w; w.x = cvt_pk_bf16(v0[0], v0[1]); w.y = cvt_pk_bf16(v0[2], v0[3]); w.z = cvt_pk_bf16(v1[0], v1[1]); w.w = cvt_pk_bf16(v1[2], v1[3]);
                    *(u32x4*)(rowp + bj * HALF) = w; } }
    }
};
struct EpiSwiglu {
    static constexpr bool PERM = true, AFTER_DRAIN = false;
    bf16_t* O;
    __device__ __forceinline__ void operator()(const f32x4 (&acc)[2][2][4][2], const Unit& u, int wr, int wc, int fr, int fq) const {
        const int row0 = u.pm * BM + wr * 64 + fr; const int col0 = u.pn * HALF + wc * 32 + 8 * fq;
#pragma unroll
        for (int ai = 0; ai < 2; ++ai)
#pragma unroll
            for (int m = 0; m < 4; ++m) {
                float o[8];
#pragma unroll
                for (int n = 0; n < 2; ++n)
#pragma unroll
                    for (int i = 0; i < 4; ++i) { const float va = acc[ai][0][m][n][i], vg = acc[ai][1][m][n][i]; o[4 * n + i] = va / (1.f + __expf(-va)) * vg; }
                u32x4 w; w.x = cvt_pk_bf16(o[0], o[1]); w.y = cvt_pk_bf16(o[2], o[3]); w.z = cvt_pk_bf16(o[4], o[5]); w.w = cvt_pk_bf16(o[6], o[7]);
                *(u32x4*)(O + (size_t)(row0 + ai * HALF + m * 16) * DFF + col0) = w; }
    }
};
struct EpiResidual {
    static constexpr bool PERM = false, AFTER_DRAIN = false;
    float* Hh;
    __device__ __forceinline__ void operator()(const f32x4 (&acc)[2][2][4][2], const Unit& u, int wr, int wc, int fr, int fq) const {
        const int row0 = u.pm * BM + wr * 64 + fr; const int col0 = u.pn * BM + wc * 32 + 4 * fq;
#pragma unroll
        for (int ai = 0; ai < 2; ++ai)
#pragma unroll
            for (int m = 0; m < 4; ++m) { float* rowp = Hh + (size_t)(row0 + ai * HALF + m * 16) * DM + col0;
#pragma unroll
                for (int bj = 0; bj < 2; ++bj)
#pragma unroll
                    for (int n = 0; n < 2; ++n) { f32x4* p = (f32x4*)(rowp + bj * HALF + n * 16); *p = *p + acc[ai][bj][m][n]; } }
    }
};
struct EpiGlu {
    static constexpr bool PERM = false, AFTER_DRAIN = false;
    float* Hh;
    __device__ __forceinline__ void operator()(const f32x4 (&acc)[2][2][4][2], const Unit& u, int wr, int wc, int fr, int fq) const {
        const int row0 = u.pm * BM + wr * 64 + fr; const int col0 = u.pn * HALF + wc * 32 + 4 * fq;
#pragma unroll
        for (int ai = 0; ai < 2; ++ai)
#pragma unroll
            for (int m = 0; m < 4; ++m) { float* rowp = Hh + (size_t)(row0 + ai * HALF + m * 16) * DM + col0;
#pragma unroll
                for (int n = 0; n < 2; ++n) { f32x4* p = (f32x4*)(rowp + n * 16); f32x4 hv = *p; const f32x4 va = acc[ai][0][m][n], vg = acc[ai][1][m][n];
#pragma unroll
                    for (int i = 0; i < 4; ++i) hv[i] += va[i] / (1.f + __expf(-vg[i]));
                    *p = hv; } }
    }
};

struct EpiS5A {
    static constexpr bool PERM = true, AFTER_DRAIN = false;
    float* YI; float* E;
    __device__ __forceinline__ void operator()(const f32x4 (&acc)[2][2][4][2], const Unit& u, int wr, int wc, int fr, int fq) const {
        const int g = u.pn >> 1, nt = u.pn & 1;
        const int cl0 = wc * 32 + 8 * fq;
        float* base = nt == 0 ? YI + (size_t)(cl0 >> 4) * DM + g * 16 + (cl0 & 15) : E + (size_t)g * 256 + cl0;
        const size_t nstride = 16 * DM;
        const size_t bjstep = nt == 0 ? (size_t)8 * DM : (size_t)HALF;
#pragma unroll
        for (int ai = 0; ai < 2; ++ai)
#pragma unroll
            for (int m = 0; m < 4; ++m) { int n = u.pm * BM + ai * HALF + wr * 64 + m * 16 + fr; n = n < 1039 ? n : 1039;
                float* p = base + (size_t)n * nstride;
#pragma unroll
                for (int bj = 0; bj < 2; ++bj) { *(f32x4*)(p + bj * bjstep) = acc[ai][bj][m][0]; *(f32x4*)(p + bj * bjstep + 4) = acc[ai][bj][m][1]; } }
    }
};
struct EpiS5C {
    static constexpr bool PERM = true, AFTER_DRAIN = false;
    const float* YI; const bf16_t* Uu; const float* dvec; bf16_t* O;
    __device__ __forceinline__ void operator()(const f32x4 (&acc)[2][2][4][2], const Unit& u, int wr, int wc, int fr, int fq) const {
        const int g = u.pn;
        const int cl0 = wc * 32 + 8 * fq, ch = g * 16 + (cl0 & 15);
        const size_t off0 = (size_t)(cl0 >> 4) * DM + ch;
        const f32x4 d0 = *(const f32x4*)(dvec + ch), d1 = *(const f32x4*)(dvec + ch + 4);
#pragma unroll
        for (int ai = 0; ai < 2; ++ai)
#pragma unroll
            for (int m = 0; m < 4; ++m) { int n = u.pm * BM + ai * HALF + wr * 64 + m * 16 + fr; n = n < 1039 ? n : 1039;
#pragma unroll
                for (int bj = 0; bj < 2; ++bj) {
                    const size_t off = off0 + (size_t)n * (16 * DM) + (size_t)bj * (8 * DM);
                    const f32x4 y0 = *(const f32x4*)(YI + off), y1 = *(const f32x4*)(YI + off + 4);
                    const u32x4 uv = *(const u32x4*)(Uu + off);
                    float y[8];
#pragma unroll
                    for (int q = 0; q < 4; ++q) { y[q] = acc[ai][bj][m][0][q] + y0[q] + d0[q] * (q & 1 ? __uint_as_float(uv[q >> 1] & 0xffff0000u) : __uint_as_float(uv[q >> 1] << 16));
                        y[4 + q] = acc[ai][bj][m][1][q] + y1[q] + d1[q] * (q & 1 ? __uint_as_float(uv[2 + (q >> 1)] & 0xffff0000u) : __uint_as_float(uv[2 + (q >> 1)] << 16)); }
#pragma unroll
                    for (int q = 0; q < 8; ++q) { const float z = 1.5957691216f * (y[q] + 0.044715f * y[q] * y[q] * y[q]); y[q] = y[q] / (1.f + __expf(-z)); }
                    u32x4 w; w.x = cvt_pk_bf16(y[0], y[1]); w.y = cvt_pk_bf16(y[2], y[3]); w.z = cvt_pk_bf16(y[4], y[5]); w.w = cvt_pk_bf16(y[6], y[7]);
                    *(u32x4*)(O + off) = w; }
                asm volatile("" ::: "memory"); }
    }
};

template <class Epi, class Sched, bool ALIGN_EPI = false, bool SP2 = false>
__device__ __forceinline__ void gemm_phase(PG8_LAS unsigned char* lds, const int K, const Sched& S, const Epi& E) {
    int tid_ = threadIdx.x; asm volatile("" : "+v"(tid_));
    const int tid = tid_, wid = __builtin_amdgcn_readfirstlane(tid >> 6), lane = tid & 63, wr = wid >> 2, wc = wid & 3, fr = lane & 15, fq = lane >> 4;
    const int nt = K / BK;
    unsigned voffA[2], voffB[2];
#pragma unroll
    for (int i = 0; i < 2; ++i) { int R, C; stage_rc(tid * 16 + i * 8192, R, C); const int Rb = Epi::PERM ? ((R & ~31) + perm32(R & 31)) : R;
        voffA[i] = Sched::GATHER_A ? (unsigned)(((16 * R + (C >> 4)) * 1024 + (C & 15)) * 2) : (unsigned)(R * K + C) * 2u; voffB[i] = (unsigned)(Rb * K + C) * 2u; }
    const size_t kstep = (size_t)(BK * 2);
    const size_t hstep = (size_t)HALF * K * 2;
    const size_t kstepA = Sched::GATHER_A ? (size_t)(4 * 1024 * 2) : kstep, hstepA = Sched::GATHER_A ? (size_t)HALF * 16 * 1024 * 2 : hstep;
    const unsigned ldsw = (unsigned)wid * 1024u;
    const int aoff = lds_byte(wr * 64 + fr, fq * 8), boff = lds_byte(wc * 32 + fr, fq * 8);
#define PG8_SA(b, h) (((b) * 2 + (h)) * HTB)
#define PG8_SB(b, h) ((4 + (b) * 2 + (h)) * HTB)
#define PG8_STAGE(bufoff, gbase, voff) do { _Pragma("unroll") for (int _i = 0; _i < 2; ++_i) \
        __builtin_amdgcn_global_load_lds((const unsigned*)((const char*)(gbase) + (voff)[_i]), (PG8_LAS unsigned*)(lds + (bufoff) + ldsw + _i * 8192), 16, 0, 0); } while (0)
#define PG8_LDA(dst, b, h) do { _Pragma("unroll") for (int m = 0; m < 4; ++m) _Pragma("unroll") for (int k = 0; k < 2; ++k) dst[m][k] = *(const PG8_LAS bf16x8*)(lds + PG8_SA(b, h) + aoff + m * 2048 + k * 1024); } while (0)
#define PG8_LDB(dst, b, h) do { _Pragma("unroll") for (int n = 0; n < 2; ++n) _Pragma("unroll") for (int k = 0; k < 2; ++k) dst[n][k] = *(const PG8_LAS bf16x8*)(lds + PG8_SB(b, h) + boff + n * 2048 + k * 1024); } while (0)
#define PG8_MMA(ai, bj, At, Bt) do { __builtin_amdgcn_s_setprio(1); _Pragma("unroll") for (int m = 0; m < 4; ++m) _Pragma("unroll") for (int n = 0; n < 2; ++n) _Pragma("unroll") for (int k = 0; k < 2; ++k) \
        acc[ai][bj][m][n] = __builtin_amdgcn_mfma_f32_16x16x32_bf16(Bt[n][k], At[m][k], acc[ai][bj][m][n], 0, 0, 0); __builtin_amdgcn_s_setprio(0); } while (0)
#define PG8_WAIT_V(n) asm volatile("s_waitcnt vmcnt(" #n ")" ::: "memory")
#define PG8_WAIT_L(n) asm volatile("s_waitcnt lgkmcnt(" #n ")" ::: "memory")
#define PG8_BAR __builtin_amdgcn_s_barrier()
#define PG8_SCHED __builtin_amdgcn_sched_barrier(0)
    Unit cur, nxt; int ui = 0;
    if (!S.next(0, cur)) return;
    f32x4 acc[2][2][4][2];
#pragma unroll
    for (int a = 0; a < 2; ++a)
#pragma unroll
        for (int b = 0; b < 2; ++b)
#pragma unroll
            for (int m = 0; m < 4; ++m)
#pragma unroll
                for (int n = 0; n < 2; ++n) acc[a][b][m][n] = (f32x4){0.f, 0.f, 0.f, 0.f};
    bf16x8 At[4][2], B0[2][2], B1[2][2];
    const char* cA = cur.A; const char* cB = cur.B;
    S.a_ready(cur);
    if constexpr (SP2) {
        PG8_STAGE(PG8_SB(0, 0), cB, voffB); PG8_STAGE(PG8_SB(0, 1), cB + hstep, voffB); PG8_STAGE(PG8_SA(0, 0), cA, voffA); PG8_STAGE(PG8_SA(0, 1), cA + hstepA, voffA);
        if (wr == 1) PG8_BAR;
        PG8_WAIT_V(2); PG8_BAR;
        PG8_STAGE(PG8_SB(1, 0), cB + kstep, voffB); PG8_STAGE(PG8_SA(1, 0), cA + kstepA, voffA); PG8_STAGE(PG8_SB(1, 1), cB + hstep + kstep, voffB);
        PG8_WAIT_V(6); PG8_BAR;
    } else {
        PG8_STAGE(PG8_SB(0, 0), cB, voffB); PG8_STAGE(PG8_SA(0, 0), cA, voffA); PG8_STAGE(PG8_SB(0, 1), cB + hstep, voffB); PG8_STAGE(PG8_SA(0, 1), cA + hstepA, voffA);
        if (wr == 1) PG8_BAR;
        PG8_WAIT_V(4); PG8_BAR;
        PG8_STAGE(PG8_SB(1, 0), cB + kstep, voffB); PG8_STAGE(PG8_SA(1, 0), cA + kstepA, voffA); PG8_STAGE(PG8_SB(1, 1), cB + hstep + kstep, voffB);
        PG8_WAIT_V(6); PG8_BAR;
    }
    for (;;) {
        const bool has_next = S.next(ui + 1, nxt);
        const char* nA = has_next ? nxt.A : cA; const char* nB = has_next ? nxt.B : cB;
        for (int t = 0; t < nt; t += 2) {
            const bool last = (t == nt - 2);
            const char* a1 = cA + (size_t)(t + 1) * kstepA;
            const char* a2 = last ? nA : cA + (size_t)(t + 2) * kstepA; const char* b2 = last ? nB : cB + (size_t)(t + 2) * kstep;
            const char* a3 = a2 + kstepA; const char* b3 = b2 + kstep;
            if (last && has_next) S.a_ready(nxt);
            if constexpr (SP2) {
            PG8_LDB(B0, 0, 0); PG8_LDB(B1, 0, 1); PG8_SCHED; PG8_LDA(At, 0, 0); PG8_STAGE(PG8_SA(1, 1), a1 + hstepA, voffA);
            PG8_WAIT_V(8); PG8_WAIT_L(0); PG8_BAR; PG8_MMA(0, 0, At, B0); PG8_MMA(0, 1, At, B1); PG8_BAR; PG8_SCHED;
            PG8_LDA(At, 0, 1); PG8_STAGE(PG8_SB(0, 0), b2, voffB); PG8_STAGE(PG8_SB(0, 1), b2 + hstep, voffB); PG8_STAGE(PG8_SA(0, 0), a2, voffA);
            PG8_WAIT_V(8); PG8_WAIT_L(0); PG8_BAR; PG8_MMA(1, 0, At, B0); PG8_MMA(1, 1, At, B1); PG8_BAR; PG8_SCHED;
            PG8_LDB(B0, 1, 0); PG8_LDB(B1, 1, 1); PG8_SCHED; PG8_LDA(At, 1, 0); PG8_STAGE(PG8_SA(0, 1), a2 + hstepA, voffA);
            PG8_WAIT_V(8); PG8_WAIT_L(0); PG8_BAR; PG8_MMA(0, 0, At, B0); PG8_MMA(0, 1, At, B1); PG8_BAR; PG8_SCHED;
            PG8_LDA(At, 1, 1); PG8_STAGE(PG8_SB(1, 0), b3, voffB); PG8_STAGE(PG8_SB(1, 1), b3 + hstep, voffB); PG8_STAGE(PG8_SA(1, 0), a3, voffA);
            PG8_WAIT_V(8); PG8_WAIT_L(0); PG8_BAR; PG8_MMA(1, 0, At, B0); PG8_MMA(1, 1, At, B1); PG8_BAR; PG8_SCHED;
            } else {
            PG8_LDB(B0, 0, 0); PG8_SCHED; PG8_LDA(At, 0, 0); PG8_STAGE(PG8_SA(1, 1), a1 + hstepA, voffA);
            PG8_WAIT_L(8); PG8_BAR; PG8_WAIT_L(0); PG8_MMA(0, 0, At, B0); PG8_BAR; PG8_SCHED;
            PG8_LDB(B1, 0, 1); PG8_STAGE(PG8_SB(0, 0), b2, voffB);
            PG8_BAR; PG8_WAIT_L(0); PG8_MMA(0, 1, At, B1); PG8_BAR;
            PG8_LDA(At, 0, 1); PG8_STAGE(PG8_SA(0, 0), a2, voffA);
            PG8_BAR; PG8_WAIT_L(0); PG8_MMA(1, 0, At, B0); PG8_BAR; PG8_SCHED;
            PG8_STAGE(PG8_SB(0, 1), b2 + hstep, voffB);
            PG8_WAIT_V(6); PG8_BAR; PG8_MMA(1, 1, At, B1); PG8_BAR;
            PG8_LDB(B0, 1, 0); PG8_SCHED; PG8_LDA(At, 1, 0); PG8_STAGE(PG8_SA(0, 1), a2 + hstepA, voffA);
            PG8_WAIT_L(8); PG8_BAR; PG8_WAIT_L(0); PG8_MMA(0, 0, At, B0); PG8_BAR; PG8_SCHED;
            PG8_LDB(B1, 1, 1); PG8_STAGE(PG8_SB(1, 0), b3, voffB);
            PG8_BAR; PG8_WAIT_L(0); PG8_MMA(0, 1, At, B1); PG8_BAR;
            PG8_LDA(At, 1, 1); PG8_STAGE(PG8_SA(1, 0), a3, voffA);
            PG8_BAR; PG8_WAIT_L(0); PG8_MMA(1, 0, At, B0); PG8_BAR; PG8_SCHED;
            PG8_STAGE(PG8_SB(1, 1), b3 + hstep, voffB);
            PG8_WAIT_V(6); PG8_BAR; PG8_MMA(1, 1, At, B1); PG8_BAR;
            }
        }
        if constexpr (ALIGN_EPI) { if (wr == 0) PG8_BAR; }
        if constexpr (!Epi::AFTER_DRAIN) { E(acc, cur, wr, wc, fr, fq); S.done(cur); }
        if (!has_next) break;
#pragma unroll
        for (int a = 0; a < 2; ++a)
#pragma unroll
            for (int b = 0; b < 2; ++b)
#pragma unroll
                for (int m = 0; m < 4; ++m)
#pragma unroll
                    for (int n = 0; n < 2; ++n) acc[a][b][m][n] = (f32x4){0.f, 0.f, 0.f, 0.f};
        cur = nxt; cA = nA; cB = nB; ++ui;
        if constexpr (ALIGN_EPI) { if (wr == 1) PG8_BAR; }
    }
    PG8_WAIT_V(0);
    if constexpr (!ALIGN_EPI) { if (wr == 0) PG8_BAR; }
    PG8_BAR;
    if constexpr (Epi::AFTER_DRAIN) { E.fused(acc, cur, wr, wc, fr, fq, lds, wid, lane); S.done(cur); }
#undef PG8_SA
#undef PG8_SB
#undef PG8_STAGE
#undef PG8_LDA
#undef PG8_LDB
#undef PG8_MMA
#undef PG8_WAIT_V
#undef PG8_WAIT_L
#undef PG8_BAR
#undef PG8_SCHED
}
}

#define PHASE_PROLOGUE \
    int tid_ = threadIdx.x; asm volatile("" : "+v"(tid_)); const int tid = tid_, lane = tid & 63, wave = tid >> 6; \
    const int G = GRID, bid = blockIdx.x; \
    const int gw = bid * 8 + wave, NGW = G * 8; \
    unsigned char* ws = P.ws; \
    float* H = (float*)(ws + WS_H); \
    bf16_t* HN = (bf16_t*)(ws + WS_HN); \
    bf16_t* A2 = (bf16_t*)(ws + WS_A2); \
    bf16_t* Qb = (bf16_t*)(ws + WS_Q); bf16_t* Kb = (bf16_t*)(ws + WS_K); bf16_t* Vb = (bf16_t*)(ws + WS_V); \
    bf16_t* REST = (bf16_t*)(ws + WS_REST); \
    bf16_t* YFB = (bf16_t*)(ws + WS_YFB); \
    bf16_t* Rr = (bf16_t*)(ws + WS_R); bf16_t* VV = (bf16_t*)(ws + WS_VV); bf16_t* KK = (bf16_t*)(ws + WS_KK); \
    bf16_t* KKA = (bf16_t*)(ws + WS_KKA); bf16_t* KD = (bf16_t*)(ws + WS_KD); \
    float* Wd = (float*)(ws + WS_W); \
    bf16_t* Gg = (bf16_t*)(ws + WS_G); bf16_t* KR = (bf16_t*)(ws + WS_KR); bf16_t* LOW = (bf16_t*)(ws + WS_LOW); \
    float* BC = (float*)(ws + WS_BC); \
    bf16_t* AA = (bf16_t*)(ws + WS_AA); \
    bf16_t* HB = (bf16_t*)(ws + WS_HB); bf16_t* YB = (bf16_t*)(ws + WS_YB); \
    bf16_t* XB = (bf16_t*)(ws + WS_XB); int* EID = (int*)(ws + WS_EID); int* POS = (int*)(ws + WS_POS); int* DEST = (int*)(ws + WS_DEST); \
    float* GATE = (float*)(ws + WS_GATE); \
    float* YI = (float*)(ws + WS_YI); float* S5E = (float*)(ws + WS_E); bf16_t* CAR = (bf16_t*)(ws + WS_CAR); bf16_t* BTA = (bf16_t*)(ws + WS_BTA); bf16_t* BTC = (bf16_t*)(ws + WS_BTC); \
    unsigned* CTL = (unsigned*)(ws + WS_CTL); \
    bf16_t* WTIN = (bf16_t*)(ws + WS_WTIN); bf16_t* WTOUT = (bf16_t*)(ws + WS_WTOUT); bf16_t* WTGLU = (bf16_t*)(ws + WS_WTGLU); bf16_t* WT13 = (bf16_t*)(ws + WS_WT13); bf16_t* WT2 = (bf16_t*)(ws + WS_WT2); \
    const int vcu = (G % 8 == 0) ? (bid % 8) * (G / 8) + bid / 8 : bid; \
    const float* x = P.in[0]; const float* meta = P.in[1]; const float* norm_mix = P.in[2]; const float* norm_ffn = P.in[3]; const float* norm_final = P.in[4]; \
    const float* w_in = P.in[5]; const float* w_out = P.in[6]; const float* rpb = P.in[7]; const float* mu = P.in[8]; \
    const float* w0 = P.in[9]; const float* w_up = P.in[10]; const float* a0 = P.in[11]; const float* a_up = P.in[12]; const float* g_up = P.in[13]; \
    const float* k_k = P.in[14]; const float* k_a = P.in[15]; const float* r_k = P.in[16]; const float* lnx_g = P.in[17]; const float* lnx_b = P.in[18]; \
    const float* s5_b_re = P.in[19]; const float* s5_b_im = P.in[20]; const float* s5_lre = P.in[21]; const float* s5_lim = P.in[22]; const float* s5_ls = P.in[23]; \
    const float* s5_c_re = P.in[24]; const float* s5_c_im = P.in[25]; const float* s5_d = P.in[26]; const float* w_glu = P.in[27]; \
    const float* moe_wg = P.in[28]; const float* moe_bg = P.in[29]; const float* moe_we = P.in[30]; const float* moe_be = P.in[31]; \
    const float* moe_w1 = P.in[32]; const float* moe_w3 = P.in[33]; const float* moe_w2 = P.in[34];


__device__ __forceinline__ void transpose_item(const float* W, int N, int K, int k0, int n0, bf16_t* dstrow0, int lane) {
    const int nq = lane & 15, kb = lane >> 4;
    const float* src = W + (size_t)(k0 + 16 * kb) * N + n0 + 4 * nq;
    f32x4 v[16];
#pragma unroll
    for (int kk = 0; kk < 16; ++kk) v[kk] = *(const f32x4*)(src + (size_t)kk * N);
#pragma unroll
    for (int i = 0; i < 4; ++i) {
        bf16_t* d = dstrow0 + (size_t)(4 * nq + i) * K + k0 + 16 * kb;
        u32x4 lo, hi;
        lo.x = pk2(v[0][i], v[1][i]); lo.y = pk2(v[2][i], v[3][i]); lo.z = pk2(v[4][i], v[5][i]); lo.w = pk2(v[6][i], v[7][i]);
        hi.x = pk2(v[8][i], v[9][i]); hi.y = pk2(v[10][i], v[11][i]); hi.z = pk2(v[12][i], v[13][i]); hi.w = pk2(v[14][i], v[15][i]);
        *(u32x4*)d = lo; *(u32x4*)(d + 8) = hi;
    }
}
#define CONV_DENSE_ITEMS (832 + 256 + 512)
__device__ __forceinline__ void conv_dense_item(CParams& P, int it, int lane) {
    unsigned char* ws = P.ws;
    if (it < 832) { const int kb = it / 52, nb = it % 52; transpose_item(P.in[5], INCOLS, DM, kb * 64, nb * 64, (bf16_t*)(ws + WS_WTIN) + (size_t)nb * 64 * DM, lane); return; }
    it -= 832;
    if (it < 256) { const int kb = it / 16, nb = it % 16; transpose_item(P.in[6], DM, DM, kb * 64, nb * 64, (bf16_t*)(ws + WS_WTOUT) + (size_t)nb * 64 * DM, lane); return; }
    it -= 256;
    { const int kb = it / 32, nb = it % 32, n = nb * 64, half = n >> 10, c = n & 1023, row = (c >> 7) * 256 + half * 128 + (c & 127);
      transpose_item(P.in[27], 2 * DM, DM, kb * 64, n, (bf16_t*)(ws + WS_WTGLU) + (size_t)row * DM, lane); }
}
#define CONV_MOE_ITEMS (NEXP * 384)
__device__ __forceinline__ void conv_moe_item(CParams& P, int l, int it, int lane) {
    unsigned char* ws = P.ws;
    const int e = it / 384; int r = it % 384;
    if (r < 256) { const int which = r >> 7; r &= 127; const int kb = r >> 3, nb = r & 7, n = nb * 64, row = (n >> 7) * 256 + which * 128 + (n & 127);
        const float* W = (which ? P.in[33] : P.in[32]) + ((size_t)(l * NEXP + e) * DM) * DFF;
        transpose_item(W, DFF, DM, kb * 64, n, (bf16_t*)(ws + WS_WT13) + ((size_t)e * DM + row) * DM, lane); return; }
    r -= 256;
    { const int kb = r >> 4, nb = r & 15; const float* W = P.in[34] + ((size_t)(l * NEXP + e) * DFF) * DM;
      transpose_item(W, DM, DFF, kb * 64, nb * 64, (bf16_t*)(ws + WS_WT2) + ((size_t)e * DM + nb * 64) * DFF, lane); }
}

template <int MODE>
__device__ __forceinline__ void meta_gemm(const bf16_t* A, const bf16_t* Bt, float* Hrows, int task, int lane) {
    const int fr = lane & 15, fq = lane >> 4, c = task * 16 + fr;
    const bf16_t* b0 = MODE == 0 ? Bt + (size_t)c * DM : Bt + (size_t)((c >> 7) * 256 + (c & 127)) * DM;
    const bf16_t* b1 = b0 + (size_t)128 * DM;
    f32x4 acc0[2], acc1[2];
    acc0[0] = acc0[1] = acc1[0] = acc1[1] = (f32x4){0.f, 0.f, 0.f, 0.f};
#pragma unroll 4
    for (int kt = 0; kt < 32; ++kt) {
        const int ko = kt * 32 + fq * 8;
        const bf16x8 a0 = *(const bf16x8*)(A + (size_t)fr * DM + ko), a1 = *(const bf16x8*)(A + (size_t)(16 + fr) * DM + ko);
        const bf16x8 bv = *(const bf16x8*)(b0 + ko);
        acc0[0] = __builtin_amdgcn_mfma_f32_16x16x32_bf16(a0, bv, acc0[0], 0, 0, 0);
        acc0[1] = __builtin_amdgcn_mfma_f32_16x16x32_bf16(a1, bv, acc0[1], 0, 0, 0);
        if (MODE == 1) { const bf16x8 bg = *(const bf16x8*)(b1 + ko);
            acc1[0] = __builtin_amdgcn_mfma_f32_16x16x32_bf16(a0, bg, acc1[0], 0, 0, 0);
            acc1[1] = __builtin_amdgcn_mfma_f32_16x16x32_bf16(a1, bg, acc1[1], 0, 0, 0); }
    }
#pragma unroll
    for (int mi = 0; mi < 2; ++mi)
#pragma unroll
        for (int j = 0; j < 4; ++j) { float* p = Hrows + (size_t)(mi * 16 + fq * 4 + j) * DM + c;
            if (MODE == 0) *p += acc0[mi][j]; else *p += acc0[mi][j] / (1.f + __expf(-acc1[mi][j])); }
}
__device__ __forceinline__ void phase_0(CParams& P, unsigned char* lds, const int ph) {
    PHASE_PROLOGUE
            for (int row = gw; row < NT; row += NGW) {
                const float* src = row < NMAIN ? x + (size_t)row * DM : meta + (size_t)((row - NMAIN) & 15) * DM;
                f32x4 v[4];
#pragma unroll
                for (int j = 0; j < 4; ++j) { v[j] = ((const f32x4*)src)[lane + 64 * j]; ((f32x4*)(H + (size_t)row * DM))[lane + 64 * j] = v[j]; }
                store_norm_bf16(v, norm_mix, HN + (size_t)row * DM, lane);
            }
    for (int it = gw; it < CONV_DENSE_ITEMS; it += NGW) conv_dense_item(P, it, lane);
    for (int it = gw; it < CONV_MOE_ITEMS; it += NGW) conv_moe_item(P, 0, it, lane);
}

__device__ __forceinline__ void phase_1(CParams& P, unsigned char* lds, const int ph) {
    PHASE_PROLOGUE
    pg8::ProjOrder S; S.init(HN, WTIN, bid);
    pg8::EpiProj E{Qb, Kb, Vb, REST};
    pg8::gemm_phase<pg8::EpiProj, pg8::ProjOrder, true, true>((PG8_LAS unsigned char*)lds, DM, S, E);
}

__device__ __forceinline__ void phase_2(CParams& P, unsigned char* lds, const int ph) {
    PHASE_PROLOGUE
    float* sb = (float*)lds;
    for (int i = tid; i < 8 * 465; i += 512) sb[i] = rpb[i];
    __syncthreads();
    const bf16_t* VT = Vb;
    const int fr = lane & 15, fq = lane >> 4;
    for (int u = gw; u < 8192 + 16; u += NGW) {
        const bool metaq = u >= 8192;
        int b, h, r = 0, qb = 0;
        if (!metaq) { qb = u & 3; r = (u >> 2) & 127; h = (u >> 9) & 7; b = u >> 12; } else { const int m = u - 8192; b = m >> 3; h = m & 7; }
        const int c = qb * 16 + fr;
        const int qrow = metaq ? NMAIN + b * NMETA + fr : b * SEQ + r * 64 + c;
        const int R0 = min(max(r - 4, 0), 120), cs = qb == 0 ? 0 : (qb == 1 ? 8 : (qb == 2 ? 24 : 32));
        const int C0 = min(max(c - 8, 0), 48);
        bf16x8 qf0 = *(const bf16x8*)(Qb + (size_t)qrow * 512 + h * 64 + fq * 8), qf1 = *(const bf16x8*)(Qb + (size_t)qrow * 512 + h * 64 + 32 + fq * 8);
        f32x4 sacc[17];
        const f32x4 zero4 = (f32x4){0.f, 0.f, 0.f, 0.f};
        if (!metaq) {
#pragma unroll
            for (int kt = 0; kt < 16; ++kt) {
                const int krow0 = b * SEQ + (R0 + (kt >> 1)) * 64 + cs + 16 * (kt & 1);
                const bf16_t* kp = Kb + (size_t)(krow0 + fr) * 512 + h * 64 + fq * 8;
                const bf16x8 a0 = *(const bf16x8*)kp, a1 = *(const bf16x8*)(kp + 32);
                f32x4 acc = __builtin_amdgcn_mfma_f32_16x16x32_bf16(a0, qf0, zero4, 0, 0, 0);
                sacc[kt] = __builtin_amdgcn_mfma_f32_16x16x32_bf16(a1, qf1, acc, 0, 0, 0);
            }
        } else {
#pragma unroll
            for (int kt = 0; kt < 16; ++kt) sacc[kt] = zero4;
        }
        {
            const bf16_t* kp = Kb + (size_t)(NMAIN + b * NMETA + fr) * 512 + h * 64 + fq * 8;
            const bf16x8 a0 = *(const bf16x8*)kp, a1 = *(const bf16x8*)(kp + 32);
            f32x4 acc = __builtin_amdgcn_mfma_f32_16x16x32_bf16(a0, qf0, zero4, 0, 0, 0);
            sacc[16] = __builtin_amdgcn_mfma_f32_16x16x32_bf16(a1, qf1, acc, 0, 0, 0);
        }
        float mx = -1e30f;
#pragma unroll
        for (int kt = 0; kt < 16; ++kt) {
            const int dr = R0 + (kt >> 1) - r + 7;
#pragma unroll
            for (int j = 0; j < 4; ++j) {
                const int kc = cs + 16 * (kt & 1) + 4 * fq + j;
                const bool inb = !metaq && kc >= C0 && kc < C0 + 16;
                const int dc = min(max(kc - c + 15, 0), 30);
                const float s = inb ? sacc[kt][j] * 0.125f + sb[(h * 15 + dr) * 31 + dc] : -1e30f;
                sacc[kt][j] = s; mx = fmaxf(mx, s);
            }
        }
#pragma unroll
        for (int j = 0; j < 4; ++j) { const float s = sacc[16][j] * 0.125f; sacc[16][j] = s; mx = fmaxf(mx, s); }
        mx = fmaxf(mx, __shfl_xor(mx, 16)); mx = fmaxf(mx, __shfl_xor(mx, 32));
        float sum = 0.f;
#pragma unroll
        for (int kt = 0; kt < 17; ++kt)
#pragma unroll
            for (int j = 0; j < 4; ++j) { const float pv = __expf(sacc[kt][j] - mx); sacc[kt][j] = pv; sum += pv; }
        sum += __shfl_xor(sum, 16); sum += __shfl_xor(sum, 32);
        f32x4 o[4] = {zero4, zero4, zero4, zero4};
        if (!metaq) {
#pragma unroll
            for (int kr = 0; kr < 8; ++kr) {
                union { bf16x8 v; unsigned u[4]; } bf;
                bf.u[0] = pk2(sacc[2 * kr][0], sacc[2 * kr][1]); bf.u[1] = pk2(sacc[2 * kr][2], sacc[2 * kr][3]);
                bf.u[2] = pk2(sacc[2 * kr + 1][0], sacc[2 * kr + 1][1]); bf.u[3] = pk2(sacc[2 * kr + 1][2], sacc[2 * kr + 1][3]);
                const size_t tok0 = (size_t)b * SEQ + (R0 + kr) * 64 + cs + 4 * fq;
#pragma unroll
                for (int dt = 0; dt < 4; ++dt) {
                    const bf16_t* vp = VT + (size_t)(h * 64 + dt * 16 + fr) * NTP + tok0;
                    union { bf16x8 v; u32x2 h2[2]; } af;
                    af.h2[0] = *(const u32x2*)vp; af.h2[1] = *(const u32x2*)(vp + 16);
                    o[dt] = __builtin_amdgcn_mfma_f32_16x16x32_bf16(af.v, bf.v, o[dt], 0, 0, 0);
                }
            }
        }
        {
            union { bf16x8 v; unsigned u[4]; } bf;
            bf.u[0] = pk2(sacc[16][0], sacc[16][1]); bf.u[1] = pk2(sacc[16][2], sacc[16][3]); bf.u[2] = 0u; bf.u[3] = 0u;
            const size_t tokm = (size_t)NMAIN + b * NMETA + 4 * fq;
#pragma unroll
            for (int dt = 0; dt < 4; ++dt) {
                const bf16_t* vp = VT + (size_t)(h * 64 + dt * 16 + fr) * NTP + tokm;
                union { bf16x8 v; u32x2 h2[2]; } af;
                af.h2[0] = *(const u32x2*)vp; af.h2[1] = (u32x2){0u, 0u};
                o[dt] = __builtin_amdgcn_mfma_f32_16x16x32_bf16(af.v, bf.v, o[dt], 0, 0, 0);
            }
        }
        const float inv = 1.f / sum;
#pragma unroll
        for (int dt = 0; dt < 4; ++dt) {
            u32x2 ov; ov.x = pk2(o[dt][0] * inv, o[dt][1] * inv); ov.y = pk2(o[dt][2] * inv, o[dt][3] * inv);
            *(u32x2*)(A2 + (size_t)qrow * DM + h * 64 + dt * 16 + 4 * fq) = ov;
        }
    }
    __syncthreads();
}

__device__ __forceinline__ void phase_3(CParams& P, unsigned char* lds, const int ph) {
    PHASE_PROLOGUE
            for (int tk = gw; tk < NT; tk += NGW) {
                const int b = tk / LSEQ, p = tk % LSEQ, row = rowof(b, p);
                const bool hp = p > 0, hn = p + 1 < LSEQ;
                const int rowp = hp ? rowof(b, p - 1) : row, rown = hn ? rowof(b, p + 1) : row;
#pragma unroll
                for (int j = 0; j < 7; ++j) {
                    const int c = 4 * lane + 256 * j;
                    const u32x2 vc = *(const u32x2*)(REST + (size_t)row * RESTC + c);
                    u32x2 vp = *(const u32x2*)(REST + (size_t)rowp * RESTC + c);
                    u32x2 vn = *(const u32x2*)(REST + (size_t)rown * RESTC + c);
                    if (!hp) { vp.x = 0; vp.y = 0; }
                    if (!hn) { vn.x = 0; vn.y = 0; }
                    const f32x4 m4 = *(const f32x4*)(mu + c);
                    float pc[4] = {bflo(vc.x), bfhi(vc.x), bflo(vc.y), bfhi(vc.y)};
                    float pp[4] = {bflo(vp.x), bfhi(vp.x), bflo(vp.y), bfhi(vp.y)};
                    float pn[4] = {bflo(vn.x), bfhi(vn.x), bflo(vn.y), bfhi(vn.y)};
                    float o[4];
#pragma unroll
                    for (int i = 0; i < 4; ++i) o[i] = pc[i] + m4[i] * (0.5f * (pp[i] + pn[i]) - pc[i]);
                    if (j == 6) {
                        if (lane < 16) { for (int i = 0; i < 4; ++i) o[i] = tanhf(o[i]); }
                        else if (lane >= 32) { for (int i = 0; i < 4; ++i) o[i] = sigmoidf_(o[i]); }
                    }
                    u32x2 ov; ov.x = pk2(o[0], o[1]); ov.y = pk2(o[2], o[3]);
                    bf16_t* dst = j < 2 ? Rr + (size_t)row * 512 + c : (j < 4 ? KR + (size_t)row * 512 + (c - 512) : (j < 6 ? VV + (size_t)row * 512 + (c - 1024) : LOW + (size_t)row * 256 + (c - 1536)));
                    *(u32x2*)dst = ov;
                }
            }
}


__device__ __forceinline__ void phase_4(CParams& P, unsigned char* lds, const int ph) {
    PHASE_PROLOGUE
            const int nrt = (NT + 127) / 128;
            const int nunits = nrt * 4 * 5;
            for (int u = bid; u < nunits; u += G) {
                const int which = u / (nrt * 4), rem = u % (nrt * 4), rt = rem / 4, ct = rem % 4;
                f32x4 acc[4][2];
                const int koff = which < 2 ? 0 : (which < 4 ? 64 : 128), KK_ = which < 4 ? 64 : 128;
                const float* Bsrc = which < 2 ? w_up + (size_t)which * 64 * 512 : (which < 4 ? a_up + (size_t)(which - 2) * 64 * 512 : g_up);
                gemm_tile(lds, KK_, 512,
                          [&](int r) { int row = rt * 128 + r; if (row >= NT) row = NT - 1; return LOW + (size_t)row * 256 + koff; },
                          [&](int n) { return Bsrc + ct * 128 + n; }, acc);
                ACC_FOREACH(acc, { const int row = rt * 128 + rl, col = ct * 128 + cl; if (row < NT) {
                    if (which < 2) { const float wl = w0[which * 512 + col] + val; Wd[((size_t)which * NT + row) * 512 + col] = __expf(-0.6065306597f * sigmoidf_(wl)); }
                    else if (which < 4) { const int d = which - 2; AA[((size_t)d * NT + row) * 512 + col] = (bf16_t)f2bf(sigmoidf_(a0[d * 512 + col] + val)); }
                    else Gg[(size_t)row * 512 + col] = (bf16_t)f2bf(val); } });
            }
}


__device__ __forceinline__ void phase_5(CParams& P, unsigned char* lds, const int ph) {
    PHASE_PROLOGUE
            for (int row = gw; row < NT; row += NGW) {
                const int c0 = lane * 8;
                const u32x4 krv = *(const u32x4*)(KR + (size_t)row * 512 + c0);
                const u32x4 rv = *(const u32x4*)(Rr + (size_t)row * 512 + c0);
                float kr[8], rr[8], kkv[8];
#pragma unroll
                for (int i = 0; i < 4; ++i) { kr[2 * i] = bflo(krv[i]); kr[2 * i + 1] = bfhi(krv[i]); rr[2 * i] = bflo(rv[i]); rr[2 * i + 1] = bfhi(rv[i]); }
                float ss = 0.f;
#pragma unroll
                for (int i = 0; i < 8; ++i) { kkv[i] = kr[i] * k_k[c0 + i]; ss += kkv[i] * kkv[i]; }
                ss += __shfl_xor(ss, 1); ss += __shfl_xor(ss, 2); ss += __shfl_xor(ss, 4);
                const float inv = 1.f / fmaxf(sqrtf(ss), 1e-12f);
#pragma unroll
                for (int i = 0; i < 8; ++i) kkv[i] *= inv;
                u32x4 o; o.x = pk2(kkv[0], kkv[1]); o.y = pk2(kkv[2], kkv[3]); o.z = pk2(kkv[4], kkv[5]); o.w = pk2(kkv[6], kkv[7]);
                *(u32x4*)(KK + (size_t)row * 512 + c0) = o;
                float bsum = 0.f;
#pragma unroll
                for (int d = 0; d < 2; ++d) {
                    const u32x4 av = *(const u32x4*)(AA + ((size_t)d * NT + row) * 512 + c0);
                    float a[8], kka[8], kd[8];
#pragma unroll
                    for (int i = 0; i < 4; ++i) { a[2 * i] = bflo(av[i]); a[2 * i + 1] = bfhi(av[i]); }
#pragma unroll
                    for (int i = 0; i < 8; ++i) { kka[i] = kkv[i] * a[i]; kd[i] = kr[i] * (1.f + (a[i] - 1.f) * k_a[c0 + i]); bsum += rr[i] * kd[i] * r_k[c0 + i]; }
                    u32x4 o1; o1.x = pk2(kka[0], kka[1]); o1.y = pk2(kka[2], kka[3]); o1.z = pk2(kka[4], kka[5]); o1.w = pk2(kka[6], kka[7]);
                    *(u32x4*)(KKA + ((size_t)d * NT + row) * 512 + c0) = o1;
                    u32x4 o2; o2.x = pk2(kd[0], kd[1]); o2.y = pk2(kd[2], kd[3]); o2.z = pk2(kd[4], kd[5]); o2.w = pk2(kd[6], kd[7]);
                    *(u32x4*)(KD + ((size_t)d * NT + row) * 512 + c0) = o2;
                }
                bsum += __shfl_xor(bsum, 1); bsum += __shfl_xor(bsum, 2); bsum += __shfl_xor(bsum, 4);
                if ((lane & 7) == 0) BC[(size_t)row * 8 + (lane >> 3)] = bsum;
            }
}


__device__ __forceinline__ void phase_6(CParams& P, unsigned char* lds, const int ph) {
    PHASE_PROLOGUE
    constexpr int TB = 16, NBLK = LSEQ / TB, BUFF = 5 * TB * 64 + 8 * TB;
    float* bufs = (float*)lds;
    float* ybuf = bufs + 2 * BUFF;
    const int chain = bid >> 3, rg = bid & 7, d = chain >> 4, b = (chain >> 3) & 1, h = chain & 7;
    const bool scanner = wave < 4, loader = (wave == 4 || wave == 5);
    const int lt = tid - 256, ls = lt >> 3, lp = lt & 7;
    const int rr = lane >> 5, kp = lane & 31, vrow = wave * 2 + rr;
    float s0 = 0.f, s1 = 0.f;
#define SCAN_STAGE(blk_, buf_) do { const int sidx_ = (blk_) * TB + ls, p_ = d ? LSEQ - 1 - sidx_ : sidx_; const size_t o_ = (size_t)rowof(b, p_) * 512 + h * 64 + lp * 8; \
        const f32x4 wa_ = *(const f32x4*)(Wd + (size_t)d * NT * 512 + o_), wb_ = *(const f32x4*)(Wd + (size_t)d * NT * 512 + o_ + 4); \
        const u32x4 kk_ = *(const u32x4*)(KK + o_), ka_ = *(const u32x4*)(KKA + (size_t)d * NT * 512 + o_), kd_ = *(const u32x4*)(KD + (size_t)d * NT * 512 + o_), r_ = *(const u32x4*)(Rr + o_); \
        const bf16_t vv_ = VV[(size_t)rowof(b, p_) * 512 + h * 64 + rg * 8 + lp]; \
        float* q_ = (buf_) + ls * 64 + lp * 8; \
        *(f32x4*)q_ = wa_; *(f32x4*)(q_ + 4) = wb_; \
        *(f32x4*)(q_ + TB * 64) = (f32x4){bflo(kk_[0]), bfhi(kk_[0]), bflo(kk_[1]), bfhi(kk_[1])}; *(f32x4*)(q_ + TB * 64 + 4) = (f32x4){bflo(kk_[2]), bfhi(kk_[2]), bflo(kk_[3]), bfhi(kk_[3])}; \
        *(f32x4*)(q_ + 2 * TB * 64) = (f32x4){bflo(ka_[0]), bfhi(ka_[0]), bflo(ka_[1]), bfhi(ka_[1])}; *(f32x4*)(q_ + 2 * TB * 64 + 4) = (f32x4){bflo(ka_[2]), bfhi(ka_[2]), bflo(ka_[3]), bfhi(ka_[3])}; \
        *(f32x4*)(q_ + 3 * TB * 64) = (f32x4){bflo(kd_[0]), bfhi(kd_[0]), bflo(kd_[1]), bfhi(kd_[1])}; *(f32x4*)(q_ + 3 * TB * 64 + 4) = (f32x4){bflo(kd_[2]), bfhi(kd_[2]), bflo(kd_[3]), bfhi(kd_[3])}; \
        *(f32x4*)(q_ + 4 * TB * 64) = (f32x4){bflo(r_[0]), bfhi(r_[0]), bflo(r_[1]), bfhi(r_[1])}; *(f32x4*)(q_ + 4 * TB * 64 + 4) = (f32x4){bflo(r_[2]), bfhi(r_[2]), bflo(r_[3]), bfhi(r_[3])}; \
        (buf_)[5 * TB * 64 + lp * TB + ls] = bf2f(vv_); } while (0)
#define SCAN_FLUSH(blk_) do { const int sidx_ = (blk_) * TB + ls, p_ = d ? LSEQ - 1 - sidx_ : sidx_; \
        YFB[((size_t)d * NT + rowof(b, p_)) * 512 + h * 64 + rg * 8 + lp] = (bf16_t)f2bf(ybuf[((blk_) & 1) * 8 * TB + lp * TB + ls]); } while (0)
    if (loader) SCAN_STAGE(0, bufs);
    __syncthreads();
    for (int blk = 0; blk < NBLK; ++blk) {
        if (loader) {
            if (blk + 1 < NBLK) SCAN_STAGE(blk + 1, bufs + ((blk + 1) & 1) * BUFF);
            if (blk > 0) SCAN_FLUSH(blk - 1);
        } else if (scanner) {
            const float* bf_ = bufs + (blk & 1) * BUFF + 2 * kp;
            float* yb = ybuf + (blk & 1) * 8 * TB + vrow * TB;
#pragma unroll
            for (int t = 0; t < TB; ++t) {
                typedef float f32x2_ __attribute__((ext_vector_type(2)));
                const f32x2_ w2 = *(const f32x2_*)(bf_ + t * 64), kk2 = *(const f32x2_*)(bf_ + (TB + t) * 64), ka2 = *(const f32x2_*)(bf_ + (2 * TB + t) * 64),
                             kd2 = *(const f32x2_*)(bf_ + (3 * TB + t) * 64), r2 = *(const f32x2_*)(bf_ + (4 * TB + t) * 64);
                const float vv = bufs[(blk & 1) * BUFF + 5 * TB * 64 + vrow * TB + t];
                float dot = s0 * kk2.x + s1 * kk2.y;
                const float t0 = s0 * w2.x + vv * kd2.x, t1 = s1 * w2.y + vv * kd2.y;
                dot = row16_sum(dot);
                { const unsigned xu = __float_as_uint(dot); const auto sw = __builtin_amdgcn_permlane16_swap(xu, xu, false, false); dot = __uint_as_float(sw[0]) + __uint_as_float(sw[1]); }
                s0 = t0 - dot * ka2.x; s1 = t1 - dot * ka2.y;
                float y = s0 * r2.x + s1 * r2.y;
                y = row16_sum(y);
                { const unsigned xu = __float_as_uint(y); const auto sw = __builtin_amdgcn_permlane16_swap(xu, xu, false, false); y = __uint_as_float(sw[0]) + __uint_as_float(sw[1]); }
                if (kp == 0) yb[t] = y;
            }
        }
        __syncthreads();
    }
    if (loader) SCAN_FLUSH(NBLK - 1);
    __syncthreads();
#undef SCAN_STAGE
#undef SCAN_FLUSH
}

__device__ __forceinline__ void phase_7(CParams& P, unsigned char* lds, const int ph) {
    PHASE_PROLOGUE
            for (int row = gw; row < NT; row += NGW) {
                const int c0 = lane * 8;
                const u32x4 yf = *(const u32x4*)(YFB + (size_t)row * 512 + c0);
                const u32x4 yb = *(const u32x4*)(YFB + ((size_t)NT + row) * 512 + c0);
                const u32x4 vv = *(const u32x4*)(VV + (size_t)row * 512 + c0);
                const u32x4 gg = *(const u32x4*)(Gg + (size_t)row * 512 + c0);
                float y[8], v[8], g[8];
#pragma unroll
                for (int i = 0; i < 4; ++i) { y[2 * i] = bflo(yf[i]) + bflo(yb[i]); y[2 * i + 1] = bfhi(yf[i]) + bfhi(yb[i]); v[2 * i] = bflo(vv[i]); v[2 * i + 1] = bfhi(vv[i]); g[2 * i] = bflo(gg[i]); g[2 * i + 1] = bfhi(gg[i]); }
                float sm = 0.f;
#pragma unroll
                for (int i = 0; i < 8; ++i) sm += y[i];
                sm += __shfl_xor(sm, 1); sm += __shfl_xor(sm, 2); sm += __shfl_xor(sm, 4);
                const float mean = sm * (1.f / 64.f);
                float vr = 0.f;
#pragma unroll
                for (int i = 0; i < 8; ++i) { const float dlt = y[i] - mean; vr += dlt * dlt; }
                vr += __shfl_xor(vr, 1); vr += __shfl_xor(vr, 2); vr += __shfl_xor(vr, 4);
                const float rstd = rsqrtf(vr * (1.f / 64.f) + 64e-5f);
                const float bc = BC[(size_t)row * 8 + (lane >> 3)];
                float o[8];
#pragma unroll
                for (int i = 0; i < 8; ++i) o[i] = ((y[i] - mean) * rstd * lnx_g[c0 + i] + lnx_b[c0 + i] + bc * v[i]) * g[i];
                u32x4 ov; ov.x = pk2(o[0], o[1]); ov.y = pk2(o[2], o[3]); ov.z = pk2(o[4], o[5]); ov.w = pk2(o[6], o[7]);
                *(u32x4*)(A2 + (size_t)row * DM + 512 + c0) = ov;
            }
}


__device__ __forceinline__ void phase_8(CParams& P, unsigned char* lds, const int ph) {
    PHASE_PROLOGUE
    if (gw < 64) meta_gemm<0>(A2 + (size_t)NMAIN * DM, WTOUT, H + (size_t)NMAIN * DM, gw, lane);
    pg8::DenseOrder S; S.init(A2, WTOUT, NMAIN, DM, DM, G, bid);
    pg8::EpiResidual E{H};
    pg8::gemm_phase<pg8::EpiResidual, pg8::DenseOrder, true, true>((PG8_LAS unsigned char*)lds, DM, S, E);
}

__device__ __forceinline__ void phase_9(CParams& P, unsigned char* lds, const int ph) {
    PHASE_PROLOGUE
            const int l = ph == 9 ? 0 : 1;
                    unsigned* cnt = CTL + CW_CNT(l);
            const float* wg = moe_wg + (size_t)l * DM * 4; const float* bg = moe_bg + l * 4;
            for (int row = gw; row < NT; row += NGW) {
                f32x4 v[4]; float ss = 0.f;
#pragma unroll
                for (int j = 0; j < 4; ++j) { v[j] = ((const f32x4*)(H + (size_t)row * DM))[lane + 64 * j]; ss += v[j][0] * v[j][0] + v[j][1] * v[j][1] + v[j][2] * v[j][2] + v[j][3] * v[j][3]; }
                ss = wave_sum(ss);
                const float rstd = rsqrtf(ss * (1.f / DM) + 1e-6f);
                float lg[4] = {0.f, 0.f, 0.f, 0.f};
#pragma unroll
                for (int j = 0; j < 4; ++j) {
                    const f32x4 g = ((const f32x4*)(norm_ffn + l * DM))[lane + 64 * j];
#pragma unroll
                    for (int i = 0; i < 4; ++i) v[j][i] = v[j][i] * rstd * g[i];
                    u32x2 o; o.x = pk2(v[j][0], v[j][1]); o.y = pk2(v[j][2], v[j][3]);
                    ((u32x2*)(HN + (size_t)row * DM))[lane + 64 * j] = o;
#pragma unroll
                    for (int i = 0; i < 4; ++i) { const f32x4 w = *(const f32x4*)(wg + (size_t)(4 * (lane + 64 * j) + i) * 4);
                        lg[0] += v[j][i] * w[0]; lg[1] += v[j][i] * w[1]; lg[2] += v[j][i] * w[2]; lg[3] += v[j][i] * w[3]; }
                }
#pragma unroll
                for (int q = 0; q < 4; ++q) lg[q] = wave_sum(lg[q]) + bg[q];
                int grp = 0; float mx = lg[0];
#pragma unroll
                for (int q = 1; q < 4; ++q) if (lg[q] > mx) { mx = lg[q]; grp = q; }
                float den = 0.f;
#pragma unroll
                for (int q = 0; q < 4; ++q) den += __expf(lg[q] - mx);
                const float pgrp = 1.f / den;
                const float* we = moe_we + ((size_t)(l * 4 + grp) * DM) * 8;
                float le[8] = {0.f, 0.f, 0.f, 0.f, 0.f, 0.f, 0.f, 0.f};
#pragma unroll
                for (int j = 0; j < 4; ++j)
#pragma unroll
                    for (int i = 0; i < 4; ++i) { const float* wr_ = we + (size_t)(4 * (lane + 64 * j) + i) * 8; const f32x4 wa = *(const f32x4*)wr_, wb = *(const f32x4*)(wr_ + 4);
                        le[0] += v[j][i] * wa[0]; le[1] += v[j][i] * wa[1]; le[2] += v[j][i] * wa[2]; le[3] += v[j][i] * wa[3];
                        le[4] += v[j][i] * wb[0]; le[5] += v[j][i] * wb[1]; le[6] += v[j][i] * wb[2]; le[7] += v[j][i] * wb[3]; }
#pragma unroll
                for (int q = 0; q < 8; ++q) le[q] = wave_sum(le[q]) + moe_be[(l * 4 + grp) * 8 + q];
                int i1 = 0; float m1 = le[0];
#pragma unroll
                for (int q = 1; q < 8; ++q) if (le[q] > m1) { m1 = le[q]; i1 = q; }
                int i2 = -1; float m2 = -3.0e38f;
#pragma unroll
                for (int q = 0; q < 8; ++q) if (q != i1 && le[q] > m2) { m2 = le[q]; i2 = q; }
                const float e2 = __expf(m2 - m1);
                const float g1 = pgrp / (1.f + e2), g2 = pgrp * e2 / (1.f + e2);
                if (lane == 0) {
                    const int ea = grp * 8 + i1, eb = grp * 8 + i2;
                    const unsigned pa = atomicAdd(cnt + ea, 1u), pb = atomicAdd(cnt + eb, 1u);
                    EID[row * 2] = ea; EID[row * 2 + 1] = eb; POS[row * 2] = (int)pa; POS[row * 2 + 1] = (int)pb;
                    GATE[row * 2] = g1; GATE[row * 2 + 1] = g2;
                }
            }
}


__device__ __forceinline__ void phase_10(CParams& P, unsigned char* lds, const int ph) {
    PHASE_PROLOGUE
    const int l = ph == 10 ? 0 : 1;
    int* ps = (int*)(lds + LDS_TAB);
    if (tid == 0) { int acc_ = 0; for (int e = 0; e < NEXP; ++e) { ps[e] = acc_; const int c = (int)CTL[CW_CNT(l) + e]; acc_ += (c + MOE_RT - 1) / MOE_RT * MOE_RT; } ps[NEXP] = acc_; }
    __syncthreads();
    for (int row = gw; row < NT; row += NGW) {
        const u32x4 v0 = ((const u32x4*)(HN + (size_t)row * DM))[lane], v1 = ((const u32x4*)(HN + (size_t)row * DM))[lane + 64];
#pragma unroll
        for (int k = 0; k < 2; ++k) {
            const int dest = ps[EID[row * 2 + k]] + POS[row * 2 + k];
            if (lane == 0) DEST[row * 2 + k] = dest;
            ((u32x4*)(XB + (size_t)dest * DM))[lane] = v0; ((u32x4*)(XB + (size_t)dest * DM))[lane + 64] = v1;
        }
    }
    __syncthreads();
}

__device__ __forceinline__ void phase_11(CParams& P, unsigned char* lds, const int ph) {
    PHASE_PROLOGUE
    const int l = ph == 11 ? 0 : 1;
    int* et = (int*)(lds + LDS_TAB);
    if (tid == 0) { int acc_ = 0; for (int e = 0; e < NEXP; ++e) { const int c = (int)CTL[CW_CNT(l) + e], n = (c + MOE_RT - 1) / MOE_RT; for (int q = 0; q < n; ++q) et[1 + acc_ + q] = e; acc_ += n; } et[0] = acc_; }
    __syncthreads();
    pg8::MoeOrder S{et + 1, et[0], vcu, (const char*)XB, (const char*)WT13, 256u * DM * 2u, 256u * DM * 2u, (unsigned)DM * DM * 2u};
    pg8::EpiSwiglu E{HB};
    pg8::gemm_phase<pg8::EpiSwiglu, pg8::MoeOrder, true, true>((PG8_LAS unsigned char*)lds, DM, S, E);
    __syncthreads();
}

__device__ __forceinline__ void phase_12(CParams& P, unsigned char* lds, const int ph) {
    PHASE_PROLOGUE
    const int l = ph == 12 ? 0 : 1;
    int* et = (int*)(lds + LDS_TAB);
    if (tid == 0) { int acc_ = 0; for (int e = 0; e < NEXP; ++e) { const int c = (int)CTL[CW_CNT(l) + e], n = (c + MOE_RT - 1) / MOE_RT; for (int q = 0; q < n; ++q) et[1 + acc_ + q] = e; acc_ += n; } et[0] = acc_; }
    __syncthreads();
    pg8::MoeOrder S{et + 1, et[0], vcu, (const char*)HB, (const char*)WT2, 256u * DFF * 2u, 256u * DFF * 2u, (unsigned)DM * DFF * 2u};
    pg8::EpiBf16Plain E{YB, DM};
    pg8::gemm_phase<pg8::EpiBf16Plain, pg8::MoeOrder, true, true>((PG8_LAS unsigned char*)lds, DFF, S, E);
    __syncthreads();
}

__device__ __forceinline__ void phase_13(CParams& P, unsigned char* lds, const int ph) {
    PHASE_PROLOGUE
            const bool fin = ph == 21;
            for (int row = gw; row < NT; row += NGW) {
                const int d0 = DEST[row * 2], d1 = DEST[row * 2 + 1];
                const float g0 = GATE[row * 2], g1 = GATE[row * 2 + 1];
                f32x4 v[4];
#pragma unroll
                for (int j = 0; j < 4; ++j) {
                    v[j] = ((const f32x4*)(H + (size_t)row * DM))[lane + 64 * j];
                    const u32x2 ya = ((const u32x2*)(YB + (size_t)d0 * DM))[lane + 64 * j];
                    const u32x2 yb = ((const u32x2*)(YB + (size_t)d1 * DM))[lane + 64 * j];
                    v[j][0] += g0 * bflo(ya.x) + g1 * bflo(yb.x); v[j][1] += g0 * bfhi(ya.x) + g1 * bfhi(yb.x);
                    v[j][2] += g0 * bflo(ya.y) + g1 * bflo(yb.y); v[j][3] += g0 * bfhi(ya.y) + g1 * bfhi(yb.y);
                }
                if (!fin) {
#pragma unroll
                    for (int j = 0; j < 4; ++j) ((f32x4*)(H + (size_t)row * DM))[lane + 64 * j] = v[j];
                    store_norm_bf16(v, norm_mix + DM, HN + (size_t)row * DM, lane);
                } else if (row < NMAIN) {
                    float ss = 0.f;
#pragma unroll
                    for (int j = 0; j < 4; ++j) ss += v[j][0] * v[j][0] + v[j][1] * v[j][1] + v[j][2] * v[j][2] + v[j][3] * v[j][3];
                    ss = wave_sum(ss);
                    const float rstd = rsqrtf(ss * (1.f / DM) + 1e-6f);
#pragma unroll
                    for (int j = 0; j < 4; ++j) { const f32x4 g = ((const f32x4*)norm_final)[lane + 64 * j]; f32x4 o;
                        o[0] = v[j][0] * rstd * g[0]; o[1] = v[j][1] * rstd * g[1]; o[2] = v[j][2] * rstd * g[2]; o[3] = v[j][3] * rstd * g[3];
                        ((f32x4*)(P.out + (size_t)row * DM))[lane + 64 * j] = o; }
                }
            }
    if (!fin) { for (int it = gw; it < CONV_MOE_ITEMS; it += NGW) conv_moe_item(P, 1, it, lane); }
}

__device__ __forceinline__ void phase_14(CParams& P, unsigned char* lds, const int ph) {
    PHASE_PROLOGUE
    float* pwr = (float*)lds; float* pwi = pwr + 2176; float* bbr = pwi + 2176; float* bbi = bbr + 2048; float* ccr = bbi + 2048; float* cci = ccr + 2048; float* kf = cci + 2048; float* kb = kf + 4096;
    for (int g = bid; g < 64; g += G) {
        if (tid < 128) {
            const int d = tid >> 6, p = tid & 63;
            const float step = __expf(s5_ls[d * 64 + g]);
            const float lr = s5_lre[(d * 64 + g) * 64 + p], li = s5_lim[(d * 64 + g) * 64 + p];
            const float mag = expf(lr * step);
            const float abr = mag * cosf(li * step), abi = mag * sinf(li * step);
            const float den = lr * lr + li * li;
            const float zr = ((abr - 1.f) * lr + abi * li) / den, zi = (abi * lr - (abr - 1.f) * li) / den;
            float pr = 1.f, pi = 0.f;
            for (int t = 0; t < 17; ++t) { pwr[(d * 64 + p) * 17 + t] = pr; pwi[(d * 64 + p) * 17 + t] = pi; const float nr = pr * abr - pi * abi; pi = pr * abi + pi * abr; pr = nr; }
            for (int i = 0; i < 16; ++i) { const float br = s5_b_re[((size_t)(g * 64 + p)) * 16 + i], bi = s5_b_im[((size_t)(g * 64 + p)) * 16 + i];
                bbr[(d * 64 + p) * 16 + i] = zr * br - zi * bi; bbi[(d * 64 + p) * 16 + i] = zr * bi + zi * br; }
        }
        for (int idx = tid; idx < 2048; idx += 512) { const int d = idx >> 10, i = (idx >> 6) & 15, p = idx & 63;
            ccr[idx] = s5_c_re[((size_t)(d * 64 + g) * 16 + i) * 64 + p]; cci[idx] = s5_c_im[((size_t)(d * 64 + g) * 16 + i) * 64 + p]; }
        __syncthreads();
        {
            const int d = tid >> 8, tau = (tid >> 4) & 15, i = tid & 15;
            float acc[16];
#pragma unroll
            for (int q = 0; q < 16; ++q) acc[q] = 0.f;
            for (int p = 0; p < 64; ++p) {
                const float cr = ccr[(d * 16 + i) * 64 + p], ci = cci[(d * 16 + i) * 64 + p], pr = pwr[(d * 64 + p) * 17 + tau], pi = pwi[(d * 64 + p) * 17 + tau];
                const float xr = cr * pr - ci * pi, xi = cr * pi + ci * pr;
#pragma unroll
                for (int q = 0; q < 16; ++q) acc[q] += xr * bbr[(d * 64 + p) * 16 + q] - xi * bbi[(d * 64 + p) * 16 + q];
            }
            float* kt = (d ? kb : kf) + (tau * 16 + i) * 16;
#pragma unroll
            for (int q = 0; q < 16; ++q) kt[q] = acc[q];
        }
        __syncthreads();
        unsigned* bta = (unsigned*)(BTA + (size_t)g * 512 * 256);
        for (int idx = tid; idx < 512 * 128; idx += 512) {
            const int row = idx >> 7, col = (idx & 127) * 2;
            float v[2];
#pragma unroll
            for (int e = 0; e < 2; ++e) {
                const int cc_ = col + e, j = cc_ >> 4, ip = cc_ & 15;
                if (row < 256) { const int t = row >> 4, i = row & 15;
                    v[e] = j < t ? kf[((t - j) * 16 + i) * 16 + ip] : (j > t ? kb[((j - t) * 16 + i) * 16 + ip] : kf[i * 16 + ip] + kb[i * 16 + ip]); }
                else { const int kp = row - 256, d = kp >> 7, part = (kp >> 6) & 1, p = kp & 63, tau = d == 0 ? 15 - j : j;
                    const float pr = pwr[(d * 64 + p) * 17 + tau], pi = pwi[(d * 64 + p) * 17 + tau], br = bbr[(d * 64 + p) * 16 + ip], bi = bbi[(d * 64 + p) * 16 + ip];
                    v[e] = part ? pr * bi + pi * br : pr * br - pi * bi; }
            }
            bta[idx] = pk2(v[0], v[1]);
        }
        unsigned* btc = (unsigned*)(BTC + (size_t)g * 256 * 256);
        for (int idx = tid; idx < 256 * 128; idx += 512) {
            const int row = idx >> 7, col = (idx & 127) * 2, t = row >> 4, i = row & 15;
            float v[2];
#pragma unroll
            for (int e = 0; e < 2; ++e) {
                const int k = col + e, d = k >> 7, part = (k >> 6) & 1, p = k & 63, tau = d == 0 ? t + 1 : 16 - t;
                const float cr = ccr[(d * 16 + i) * 64 + p], ci = cci[(d * 16 + i) * 64 + p], pr = pwr[(d * 64 + p) * 17 + tau], pi = pwi[(d * 64 + p) * 17 + tau];
                v[e] = part ? -(cr * pi + ci * pr) : cr * pr - ci * pi;
            }
            btc[idx] = pk2(v[0], v[1]);
        }
        __syncthreads();
    }
}

__device__ __forceinline__ void phase_15(CParams& P, unsigned char* lds, const int ph) {
    PHASE_PROLOGUE
    pg8::S5OrderA S{vcu, (const char*)HN, (const char*)BTA};
    pg8::EpiS5A E{YI, S5E};
    int Kr = 256; asm volatile("" : "+s"(Kr));
    pg8::gemm_phase<pg8::EpiS5A, pg8::S5OrderA, true, true>((PG8_LAS unsigned char*)lds, Kr, S, E);
}

__device__ __forceinline__ void phase_16(CParams& P, unsigned char* lds, const int ph) {
    PHASE_PROLOGUE
    for (int i = bid * 512 + tid; i < NB * 64 * 2 * 64; i += G * 512) {
        const int p = i & 63, d = (i >> 6) & 1, g = (i >> 7) & 63, b = i >> 13;
        const float step = __expf(s5_ls[d * 64 + g]);
        const float lr = s5_lre[(d * 64 + g) * 64 + p], li = s5_lim[(d * 64 + g) * 64 + p];
        const float mag = expf(lr * step);
        const float abr = mag * cosf(li * step), abi = mag * sinf(li * step);
        float ar = 1.f, ai = 0.f;
        for (int t = 0; t < 16; ++t) { const float nr = ar * abr - ai * abi; ai = ar * abi + ai * abr; ar = nr; }
        const float* Ep = S5E + (size_t)g * 256 + d * 128 + p;
        bf16_t* Cp = CAR + (size_t)g * 1280 * 256 + d * 128 + p;
        float sr = 0.f, si = 0.f;
        for (int q0 = 0; q0 < 513; q0 += 9) {
            float er[9], ei[9]; int nn[9];
#pragma unroll
            for (int k = 0; k < 9; ++k) { const int q = q0 + k, c = d ? 512 - q : q; nn[k] = c == 0 ? 1024 + b : b * 512 + c - 1; er[k] = Ep[(size_t)nn[k] * 64 * 256]; ei[k] = Ep[(size_t)nn[k] * 64 * 256 + 64]; }
#pragma unroll
            for (int k = 0; k < 9; ++k) { Cp[(size_t)nn[k] * 256] = (bf16_t)f2bf(sr); Cp[(size_t)nn[k] * 256 + 64] = (bf16_t)f2bf(si);
                const float nr = ar * sr - ai * si + er[k]; si = ar * si + ai * sr + ei[k]; sr = nr; }
        }
    }
}

__device__ __forceinline__ void phase_22(CParams& P, unsigned char* lds, const int ph) {
    PHASE_PROLOGUE
    pg8::S5OrderC S{vcu, (const char*)CAR, (const char*)BTC};
    pg8::EpiS5C E{YI, HN, s5_d, A2};
    int Kr = 256; asm volatile("" : "+s"(Kr));
    pg8::gemm_phase<pg8::EpiS5C, pg8::S5OrderC, true, true>((PG8_LAS unsigned char*)lds, Kr, S, E);
}

__device__ __forceinline__ void phase_23(CParams& P, unsigned char* lds, const int ph) {
    PHASE_PROLOGUE
    if (gw < 64) meta_gemm<1>(A2 + (size_t)NMAIN * DM, WTGLU, H + (size_t)NMAIN * DM, gw, lane);
    pg8::DenseOrder S; S.init(A2, WTGLU, NMAIN, 2 * DM, DM, G, bid);
    pg8::EpiGlu E{H};
    pg8::gemm_phase<pg8::EpiGlu, pg8::DenseOrder, true, true>((PG8_LAS unsigned char*)lds, DM, S, E);
}
#define LAS __attribute__((address_space(3)))
#define CW_BAR 4096
#define XB_TMO      128
#define XB_XCNT(j)  (256  + 64 * (j))
#define XB_XSUB(j)  (1280 + 64 * (j))
#define XB_XGEN(j)  (2304 + 64 * (j))
#define XB_TOP      3328
#define XB_TOPGEN   3392
#define XCD_BAR_WORDS 3456
#define XB_SPIN_CAP (1u << 22)
__device__ __forceinline__ unsigned xb_ld(unsigned* p)              { return __hip_atomic_load(p, __ATOMIC_RELAXED, __HIP_MEMORY_SCOPE_AGENT); }
__device__ __forceinline__ unsigned xb_add(unsigned* p, unsigned v) { return __hip_atomic_fetch_add(p, v, __ATOMIC_RELAXED, __HIP_MEMORY_SCOPE_AGENT); }
__device__ __forceinline__ unsigned xb_xcc_id() { return (unsigned)__builtin_amdgcn_s_getreg((3 << 11) | 20) & 0xFu; }
#define XB_SPIN(cond, bar) do { unsigned _sp = 0; while (cond) { __builtin_amdgcn_s_sleep(1); \
    if ((++_sp & 255u) == 0u) { if (xb_ld(&(bar)[XB_TMO])) break; if (_sp > XB_SPIN_CAP) { atomicAdd(&(bar)[XB_TMO], 1u); break; } } } } while (0)
struct XcdBarrier { unsigned* bar; unsigned x; volatile LAS unsigned* st; };
__device__ __forceinline__ XcdBarrier xcd_barrier_post(unsigned* bar, volatile LAS unsigned* st) {
    XcdBarrier b; b.bar = bar; b.x = xb_xcc_id(); b.st = st;
    if (threadIdx.x == 0) (void)xb_add(&bar[XB_XCNT(b.x)], 1u);
    return b;
}
__device__ __forceinline__ void xcd_barrier_complete(unsigned* bar, unsigned x, unsigned& nloc, unsigned& nx) {
    const unsigned G = GRID;
    unsigned sum, cnt, mine, sp = 0u;
    for (;;) {
        sum = 0u; cnt = 0u; mine = 0u;
#pragma unroll
        for (unsigned j = 0; j < 16; ++j) { const unsigned c = xb_ld(&bar[XB_XCNT(j)]); sum += c; cnt += (c > 0u) ? 1u : 0u; mine = (j == x) ? c : mine; }
        if (sum == G) break;
        __builtin_amdgcn_s_sleep(1);
        if ((++sp & 255u) == 0u) { if (xb_ld(&bar[XB_TMO])) break; if (sp > XB_SPIN_CAP) { atomicAdd(&bar[XB_TMO], 1u); break; } }
    }
    nloc = mine > 0u ? mine : 1u; nx = cnt > 0u ? cnt : 1u;
}
__device__ __forceinline__ void xcd_barrier(const XcdBarrier& b) {
    asm volatile("s_waitcnt vmcnt(0)" ::: "memory");
    __syncthreads();
    if (threadIdx.x == 0) {
        unsigned* bar = b.bar;
        __builtin_amdgcn_s_waitcnt(0);
        unsigned nloc = b.st[0], nx = b.st[1];
        if (nloc == 0u) { xcd_barrier_complete(bar, b.x, nloc, nx); b.st[0] = nloc; b.st[1] = nx; }
        const unsigned old = xb_add(&bar[XB_XSUB(b.x)], 1u);
        const unsigned gen = old / nloc;
        if (old + 1u == (gen + 1u) * nloc) {
            __builtin_amdgcn_fence(__ATOMIC_RELEASE, "agent");
            asm volatile("s_waitcnt vmcnt(0)" ::: "memory");
            const unsigned og = xb_add(&bar[XB_TOP], 1u);
            const unsigned tg = og / nx;
            if (og + 1u == (tg + 1u) * nx) xb_add(&bar[XB_TOPGEN], 1u);
            else XB_SPIN(xb_ld(&bar[XB_TOPGEN]) == tg, bar);
            __builtin_amdgcn_fence(__ATOMIC_ACQUIRE, "agent");
            xb_add(&bar[XB_XGEN(b.x)], 1u);
            asm volatile("s_waitcnt vmcnt(0)" ::: "memory");
        } else {
            XB_SPIN(xb_ld(&bar[XB_XGEN(b.x)]) == gen, bar);
            __builtin_amdgcn_fence(__ATOMIC_ACQUIRE, "agent");
            asm volatile("s_waitcnt vmcnt(0)" ::: "memory");
        }
    }
    __syncthreads();
}


__global__ void __launch_bounds__(512, 2) mega(Params P_) {
    extern __shared__ __attribute__((aligned(16))) unsigned char lds[];
    volatile LAS unsigned* st = (volatile LAS unsigned*)(LAS unsigned char*)(lds + LDS_BARST);
    if (threadIdx.x < 16) st[threadIdx.x] = 0u;
    __syncthreads();
    CParams* pp = (CParams*)__builtin_amdgcn_kernarg_segment_ptr();
    (void)xcd_barrier_post((unsigned*)(pp->ws + WS_CTL) + CW_BAR, st);
#define GB do { XcdBarrier bar_; bar_.bar = (unsigned*)(pp->ws + WS_CTL) + CW_BAR; bar_.x = xb_xcc_id(); bar_.st = (volatile LAS unsigned*)(LAS unsigned char*)(lds + LDS_BARST); xcd_barrier(bar_); asm volatile("" : "+s"(pp)); } while (0)
#define P (*pp)
    asm volatile("" : "+s"(pp));
    phase_0(P, lds, 0); GB;
#if defined(PROBE_PH) && PROBE_PH == 0
    { int nrep = PROBE_N; asm volatile("" : "+s"(nrep)); for (int rep = 0; rep < nrep; ++rep) { GB; phase_0(P, lds, 0); GB; } }
#endif
    phase_1(P, lds, 1); GB;
#if defined(PROBE_PH) && PROBE_PH == 1
    { int nrep = PROBE_N; asm volatile("" : "+s"(nrep)); for (int rep = 0; rep < nrep; ++rep) { GB; phase_1(P, lds, 1); GB; } }
#endif
    phase_2(P, lds, 2); asm volatile("" : "+s"(pp));
#if defined(PROBE_PH) && PROBE_PH == 2
    { int nrep = PROBE_N; asm volatile("" : "+s"(nrep)); for (int rep = 0; rep < nrep; ++rep) { GB; phase_2(P, lds, 2); GB; } }
#endif
    phase_3(P, lds, 3); GB;
#if defined(PROBE_PH) && PROBE_PH == 3
    { int nrep = PROBE_N; asm volatile("" : "+s"(nrep)); for (int rep = 0; rep < nrep; ++rep) { GB; phase_3(P, lds, 3); GB; } }
#endif
    phase_4(P, lds, 4); GB;
#if defined(PROBE_PH) && PROBE_PH == 4
    { int nrep = PROBE_N; asm volatile("" : "+s"(nrep)); for (int rep = 0; rep < nrep; ++rep) { GB; phase_4(P, lds, 4); GB; } }
#endif
    phase_5(P, lds, 5); GB;
#if defined(PROBE_PH) && PROBE_PH == 5
    { int nrep = PROBE_N; asm volatile("" : "+s"(nrep)); for (int rep = 0; rep < nrep; ++rep) { GB; phase_5(P, lds, 5); GB; } }
#endif
    phase_6(P, lds, 6); GB;
#if defined(PROBE_PH) && PROBE_PH == 6
    { int nrep = PROBE_N; asm volatile("" : "+s"(nrep)); for (int rep = 0; rep < nrep; ++rep) { GB; phase_6(P, lds, 6); GB; } }
#endif
    phase_7(P, lds, 7); GB;
#if defined(PROBE_PH) && PROBE_PH == 7
    { int nrep = PROBE_N; asm volatile("" : "+s"(nrep)); for (int rep = 0; rep < nrep; ++rep) { GB; phase_7(P, lds, 7); GB; } }
#endif
    phase_8(P, lds, 8); GB;
#if defined(PROBE_PH) && PROBE_PH == 8
    { int nrep = PROBE_N; asm volatile("" : "+s"(nrep)); for (int rep = 0; rep < nrep; ++rep) { GB; phase_8(P, lds, 8); GB; } }
#endif
    phase_9(P, lds, 9); GB;
#if defined(PROBE_PH) && PROBE_PH == 9
    { int nrep = PROBE_N; asm volatile("" : "+s"(nrep)); for (int rep = 0; rep < nrep; ++rep) { GB; phase_9(P, lds, 9); GB; } }
#endif
    phase_10(P, lds, 10); GB;
#if defined(PROBE_PH) && PROBE_PH == 10
    { int nrep = PROBE_N; asm volatile("" : "+s"(nrep)); for (int rep = 0; rep < nrep; ++rep) { GB; phase_10(P, lds, 10); GB; } }
#endif
    phase_11(P, lds, 11); GB;
#if defined(PROBE_PH) && PROBE_PH == 11
    { int nrep = PROBE_N; asm volatile("" : "+s"(nrep)); for (int rep = 0; rep < nrep; ++rep) { GB; phase_11(P, lds, 11); GB; } }
#endif
    phase_12(P, lds, 12); GB;
#if defined(PROBE_PH) && PROBE_PH == 12
    { int nrep = PROBE_N; asm volatile("" : "+s"(nrep)); for (int rep = 0; rep < nrep; ++rep) { GB; phase_12(P, lds, 12); GB; } }
#endif
    phase_13(P, lds, 13); GB;
#if defined(PROBE_PH) && PROBE_PH == 13
    { int nrep = PROBE_N; asm volatile("" : "+s"(nrep)); for (int rep = 0; rep < nrep; ++rep) { GB; phase_13(P, lds, 13); GB; } }
#endif
    phase_14(P, lds, 14); GB;
#if defined(PROBE_PH) && PROBE_PH == 14
    { int nrep = PROBE_N; asm volatile("" : "+s"(nrep)); for (int rep = 0; rep < nrep; ++rep) { GB; phase_14(P, lds, 14); GB; } }
#endif
    phase_15(P, lds, 15); GB;
#if defined(PROBE_PH) && PROBE_PH == 15
    { int nrep = PROBE_N; asm volatile("" : "+s"(nrep)); for (int rep = 0; rep < nrep; ++rep) { GB; phase_15(P, lds, 15); GB; } }
#endif
    phase_16(P, lds, 16); GB;
#if defined(PROBE_PH) && PROBE_PH == 16
    { int nrep = PROBE_N; asm volatile("" : "+s"(nrep)); for (int rep = 0; rep < nrep; ++rep) { GB; phase_16(P, lds, 16); GB; } }
#endif
    phase_22(P, lds, 22); GB;
#if defined(PROBE_PH) && PROBE_PH == 22
    { int nrep = PROBE_N; asm volatile("" : "+s"(nrep)); for (int rep = 0; rep < nrep; ++rep) { GB; phase_22(P, lds, 22); GB; } }
#endif
    phase_23(P, lds, 23); GB;
#if defined(PROBE_PH) && PROBE_PH == 23
    { int nrep = PROBE_N; asm volatile("" : "+s"(nrep)); for (int rep = 0; rep < nrep; ++rep) { GB; phase_23(P, lds, 23); GB; } }
#endif
    phase_9(P, lds, 17); GB;
#if defined(PROBE_PH) && PROBE_PH == 17
    { int nrep = PROBE_N; asm volatile("" : "+s"(nrep)); for (int rep = 0; rep < nrep; ++rep) { GB; phase_9(P, lds, 17); GB; } }
#endif
    phase_10(P, lds, 18); GB;
#if defined(PROBE_PH) && PROBE_PH == 18
    { int nrep = PROBE_N; asm volatile("" : "+s"(nrep)); for (int rep = 0; rep < nrep; ++rep) { GB; phase_10(P, lds, 18); GB; } }
#endif
    phase_11(P, lds, 19); GB;
#if defined(PROBE_PH) && PROBE_PH == 19
    { int nrep = PROBE_N; asm volatile("" : "+s"(nrep)); for (int rep = 0; rep < nrep; ++rep) { GB; phase_11(P, lds, 19); GB; } }
#endif
    phase_12(P, lds, 20); GB;
#if defined(PROBE_PH) && PROBE_PH == 20
    { int nrep = PROBE_N; asm volatile("" : "+s"(nrep)); for (int rep = 0; rep < nrep; ++rep) { GB; phase_12(P, lds, 20); GB; } }
#endif
    phase_13(P, lds, 21);
#if defined(PROBE_PH) && PROBE_PH == 21
    { int nrep = PROBE_N; asm volatile("" : "+s"(nrep)); for (int rep = 0; rep < nrep; ++rep) { GB; phase_13(P, lds, 21); GB; } }
#endif
#undef P
#undef GB
}

extern "C" void kernel_launch(void* const* d_in, const int* in_sizes, int n_in, void* d_out, int out_size, void* d_ws, size_t ws_size, hipStream_t stream) {
    static int ready = 0;
    if (!ready) {
        if (n_in != 35 || ws_size < WS_TOTAL) { fprintf(stderr, "kernel_launch: unexpected n_in %d or ws_size %zu (need %zu)\n", n_in, ws_size, (size_t)WS_TOTAL); ready = -1; return; }
        if (hipFuncSetAttribute((const void*)mega, hipFuncAttributeMaxDynamicSharedMemorySize, LDS_BYTES) != hipSuccess) { fprintf(stderr, "kernel_launch: hipFuncSetAttribute failed\n"); ready = -1; return; }
        ready = 1;
    }
    if (ready < 0) return;
    (void)hipMemsetAsync((char*)d_ws + WS_CTL, 0, 1 * MiB, stream);
    Params P{};
    for (int i = 0; i < 35; ++i) P.in[i] = (const float*)d_in[i];
    P.out = (float*)d_out; P.ws = (unsigned char*)d_ws; P.ph_lo = 0; P.ph_hi = 0;
    hipLaunchKernelGGL(mega, dim3(GRID), dim3(512), LDS_BYTES, stream, P);
}
```

```cpp
#include <hip/hip_runtime.h>
#include <stdint.h>
#include <stdio.h>

#define DM 1024
#define NB 2
#define SEQ 8192
#define NMETA 16
#define LSEQ (SEQ + NMETA)
#define NMAIN (NB * SEQ)
#define NT (NB * LSEQ)
#define NTP 16640
#define INCOLS 3328
#define RESTC 1792
#define NEXP 32
#define DFF 512
#define S5TC 48
#define S5NC 171
#define MOE_RT 256
#define MOE_MAXROWS 41216

typedef unsigned short bf16_t;
typedef short bf16x8 __attribute__((ext_vector_type(8)));
typedef float f32x4 __attribute__((ext_vector_type(4)));
typedef unsigned u32x4 __attribute__((ext_vector_type(4)));
typedef unsigned u32x2 __attribute__((ext_vector_type(2)));

constexpr size_t MiB = 1u << 20;
constexpr size_t al64k(size_t x) { return (x + 65535) & ~(size_t)65535; }
constexpr size_t WS_CTL = 0;
constexpr size_t WS_H = 1 * MiB;
constexpr size_t WS_HN = WS_H + al64k((size_t)NT * DM * 4);
constexpr size_t WS_A2 = WS_HN + al64k((size_t)NTP * DM * 2);
constexpr size_t WS_WTIN = WS_A2 + al64k((size_t)NTP * DM * 2);
constexpr size_t WS_WTOUT = WS_WTIN + al64k((size_t)INCOLS * DM * 2);
constexpr size_t WS_WTGLU = WS_WTOUT + al64k((size_t)DM * DM * 2);
constexpr size_t WS_WT13 = WS_WTGLU + al64k((size_t)2 * DM * DM * 2);
constexpr size_t WS_WT2 = WS_WT13 + al64k((size_t)NEXP * DM * DM * 2);
constexpr size_t WS_BIG = WS_WT2 + al64k((size_t)NEXP * DM * DFF * 2);
constexpr size_t SZ_T512 = al64k((size_t)NT * 512 * 2);
constexpr size_t SZ_P512 = al64k((size_t)NTP * 512 * 2);
constexpr size_t WS_Q = WS_BIG;
constexpr size_t WS_K = WS_Q + SZ_P512;
constexpr size_t WS_V = WS_K + SZ_P512;
constexpr size_t WS_REST = WS_V + SZ_P512;
constexpr size_t WS_R = WS_REST + al64k((size_t)NTP * RESTC * 2);
constexpr size_t WS_KR = WS_R + SZ_T512;
constexpr size_t WS_VV = WS_KR + SZ_T512;
constexpr size_t WS_LOW = WS_VV + SZ_T512;
constexpr size_t WS_G = WS_LOW + al64k((size_t)NT * 256 * 2);
constexpr size_t WS_KK = WS_G + SZ_T512;
constexpr size_t WS_KKA = WS_KK + SZ_T512;
constexpr size_t WS_KD = WS_KKA + 2 * SZ_T512;
constexpr size_t WS_BC = WS_KD + 2 * SZ_T512;
constexpr size_t WS_MIXEND = WS_BC + al64k((size_t)NT * 8 * 4);
constexpr size_t WS_AA = WS_Q;
constexpr size_t WS_YFB = WS_Q;
constexpr size_t WS_W = WS_V;
static_assert(2 * SZ_T512 <= 2 * SZ_P512, "AA/YFB fit in Q|K");
static_assert((size_t)2 * NT * 512 * 4 <= SZ_P512 + al64k((size_t)NTP * RESTC * 2), "W fits in V|REST");
constexpr size_t WS_XB = WS_BIG;
constexpr size_t WS_HB = WS_XB + al64k((size_t)MOE_MAXROWS * DM * 2);
constexpr size_t WS_YB = WS_HB + al64k((size_t)MOE_MAXROWS * DFF * 2);
constexpr size_t WS_EID = WS_YB + al64k((size_t)MOE_MAXROWS * DM * 2);
constexpr size_t WS_POS = WS_EID + al64k((size_t)NT * 8);
constexpr size_t WS_DEST = WS_POS + al64k((size_t)NT * 8);
constexpr size_t WS_GATE = WS_DEST + al64k((size_t)NT * 8);
constexpr size_t WS_MOEEND = WS_GATE + al64k((size_t)NT * 8);
constexpr size_t WS_YI = WS_BIG;
constexpr size_t WS_E = WS_YI + al64k((size_t)NTP * DM * 4);
constexpr size_t WS_CAR = WS_E + al64k((size_t)1040 * 64 * 256 * 4);
constexpr size_t WS_BTA = WS_CAR + al64k((size_t)64 * 1280 * 256 * 2);
constexpr size_t WS_BTC = WS_BTA + al64k((size_t)64 * 512 * 256 * 2);
constexpr size_t WS_S5END = WS_BTC + al64k((size_t)64 * 256 * 256 * 2);
constexpr size_t cmax(size_t a, size_t b) { return a > b ? a : b; }
constexpr size_t WS_TOTAL = cmax(WS_MIXEND, cmax(WS_MOEEND, WS_S5END));
static_assert(WS_TOTAL <= 512 * MiB, "workspace map exceeds 512 MiB");

#define CW_CNT(l) (1024 + 64 * (l))

#define LDS_RING 131072
#define LDS_BARST (LDS_RING)
#define LDS_TAB (LDS_RING + 256)
#define LDS_BYTES 147456
#define GRID 256

struct Params {
    const float* in[35];
    float* out;
    unsigned char* ws;
    int ph_lo, ph_hi;
};
typedef const __attribute__((address_space(4))) Params CParams;

__device__ __forceinline__ float bf2f(bf16_t v) { return __uint_as_float(((unsigned)v) << 16); }
__device__ __forceinline__ unsigned f2bf(float f) { unsigned u = __float_as_uint(f); return (u + 0x7fffu + ((u >> 16) & 1u)) >> 16; }
__device__ __forceinline__ unsigned pk2(float lo, float hi) { return f2bf(lo) | (f2bf(hi) << 16); }
__device__ __forceinline__ float bflo(unsigned u) { return __uint_as_float(u << 16); }
__device__ __forceinline__ float bfhi(unsigned u) { return __uint_as_float(u & 0xffff0000u); }
__device__ __forceinline__ float wave_sum(float v) {
#pragma unroll
    for (int o = 1; o < 64; o <<= 1) v += __shfl_xor(v, o);
    return v;
}
__device__ __forceinline__ float wave_max(float v) {
#pragma unroll
    for (int o = 1; o < 64; o <<= 1) v = fmaxf(v, __shfl_xor(v, o));
    return v;
}
template <int CTRL> __device__ __forceinline__ float dppf(float v) { return __int_as_float(__builtin_amdgcn_update_dpp(0, __float_as_int(v), CTRL, 0xF, 0xF, true)); }
__device__ __forceinline__ float row16_sum(float v) { v += dppf<0xB1>(v); v += dppf<0x4E>(v); v += dppf<0x141>(v); v += dppf<0x140>(v); return v; }
__device__ __forceinline__ float sigmoidf_(float x) { return 1.f / (1.f + __expf(-x)); }
__device__ __forceinline__ int rowof(int b, int p) { return p < NMETA ? NMAIN + b * NMETA + p : b * SEQ + (p - NMETA); }

#define SA_STRIDE 40
template <class AF, class BF>
__device__ __forceinline__ void gemm_tile(unsigned char* lds, int K, int ldb, const AF& arow, const BF& bcol, f32x4 (&acc)[4][2]) {
    bf16_t* sA = (bf16_t*)lds;
    bf16_t* sB = (bf16_t*)(lds + 128 * SA_STRIDE * 2);
    const int tid = threadIdx.x, lane = tid & 63, wave = tid >> 6, wr = wave >> 2, wc = wave & 3, fr = lane & 15, fq = lane >> 4;
#pragma unroll
    for (int mi = 0; mi < 4; ++mi)
#pragma unroll
        for (int ni = 0; ni < 2; ++ni) acc[mi][ni] = (f32x4){0.f, 0.f, 0.f, 0.f};
    const int ar = tid >> 2, akc = (tid & 3) * 8;
    const bf16_t* ap = arow(ar) + akc;
    const int bnq = (tid & 31) * 4, bkp = (tid >> 5) * 2;
    const float* bp = bcol(bnq) + (size_t)bkp * ldb;
    const int nk = K / 32;
    u32x4 ra = *(const u32x4*)ap;
    f32x4 rb0 = *(const f32x4*)bp, rb1 = *(const f32x4*)(bp + ldb);
    for (int kt = 0; kt < nk; ++kt) {
        __syncthreads();
        *(u32x4*)(sA + ar * SA_STRIDE + akc) = ra;
        {
            unsigned* d = (unsigned*)(sB + bnq * SA_STRIDE + bkp);
            d[0 * (SA_STRIDE / 2)] = pk2(rb0[0], rb1[0]);
            d[1 * (SA_STRIDE / 2)] = pk2(rb0[1], rb1[1]);
            d[2 * (SA_STRIDE / 2)] = pk2(rb0[2], rb1[2]);
            d[3 * (SA_STRIDE / 2)] = pk2(rb0[3], rb1[3]);
        }
        __syncthreads();
        if (kt + 1 < nk) {
            ra = *(const u32x4*)(ap + (kt + 1) * 32);
            const float* q = bp + (size_t)(kt + 1) * 32 * ldb;
            rb0 = *(const f32x4*)q; rb1 = *(const f32x4*)(q + ldb);
        }
        bf16x8 a[4], b[2];
#pragma unroll
        for (int mi = 0; mi < 4; ++mi) a[mi] = *(const bf16x8*)(sA + (wr * 64 + mi * 16 + fr) * SA_STRIDE + fq * 8);
#pragma unroll
        for (int ni = 0; ni < 2; ++ni) b[ni] = *(const bf16x8*)(sB + (wc * 32 + ni * 16 + fr) * SA_STRIDE + fq * 8);
#pragma unroll
        for (int mi = 0; mi < 4; ++mi)
#pragma unroll
            for (int ni = 0; ni < 2; ++ni) acc[mi][ni] = __builtin_amdgcn_mfma_f32_16x16x32_bf16(a[mi], b[ni], acc[mi][ni], 0, 0, 0);
    }
    __syncthreads();
}
#define ACC_FOREACH(acc, ...) do { const int _l = threadIdx.x & 63, _w = threadIdx.x >> 6, _wr = _w >> 2, _wc = _w & 3, _fr = _l & 15, _fq = _l >> 4; \
    _Pragma("unroll") for (int _mi = 0; _mi < 4; ++_mi) _Pragma("unroll") for (int _ni = 0; _ni < 2; ++_ni) _Pragma("unroll") for (int _j = 0; _j < 4; ++_j) { \
        const int rl = _wr * 64 + _mi * 16 + _fq * 4 + _j, cl = _wc * 32 + _ni * 16 + _fr; const float val = acc[_mi][_ni][_j]; __VA_ARGS__ } } while (0)
#define ACC_FOREACH_PAIR(acc, ...) do { const int _l = threadIdx.x & 63, _w = threadIdx.x >> 6, _wr = _w >> 2, _wc = _w & 3, _fr = _l & 15, _fq = _l >> 4; \
    _Pragma("unroll") for (int _mi = 0; _mi < 4; ++_mi) _Pragma("unroll") for (int _j = 0; _j < 4; ++_j) { \
        const int rl = _wr * 64 + _mi * 16 + _fq * 4 + _j, co = _wc * 16 + _fr; const float va = acc[_mi][0][_j], vg = acc[_mi][1][_j]; __VA_ARGS__ } } while (0)

__device__ __forceinline__ void store_norm_bf16(const f32x4 (&v)[4], const float* gain, bf16_t* dst, int lane) {
    float ss = 0.f;
#pragma unroll
    for (int j = 0; j < 4; ++j) ss += v[j][0] * v[j][0] + v[j][1] * v[j][1] + v[j][2] * v[j][2] + v[j][3] * v[j][3];
    ss = wave_sum(ss);
    const float rstd = rsqrtf(ss * (1.f / DM) + 1e-6f);
#pragma unroll
    for (int j = 0; j < 4; ++j) {
        const f32x4 g = ((const f32x4*)gain)[lane + 64 * j];
        u32x2 o; o.x = pk2(v[j][0] * rstd * g[0], v[j][1] * rstd * g[1]); o.y = pk2(v[j][2] * rstd * g[2], v[j][3] * rstd * g[3]);
        ((u32x2*)dst)[lane + 64 * j] = o;
    }
}

namespace pg8 {
#define PG8_LAS __attribute__((address_space(3)))
constexpr int BM = 256, BK = 64, HALF = 128, HTB = HALF * BK * 2  , STAGE_BYTES = 8 * HTB, NXCD = 8, WGM = 8;
__host__ __device__ __forceinline__ int lds_byte(int r, int c) { const int st = (r >> 4) * 2 + (c >> 5), rr = r & 15, cc = c & 31, ob = rr * 64 + cc * 2; return st * 1024 + (ob ^ (((ob >> 9) & 1) << 5)); }
__host__ __device__ __forceinline__ void stage_rc(int b, int& R, int& C) { const int st = b / 1024, sb = b % 1024, swz = sb ^ (((sb >> 9) & 1) << 5); R = (st >> 1) * 16 + swz / 64; C = (st & 1) * 32 + (swz % 64) / 2; }
__host__ __device__ __forceinline__ int perm32(int rho) { const int n = rho >> 4, i = rho & 15; return 8 * (i >> 2) + 4 * n + (i & 3); }

struct Unit { int pm, pn; const char* A; const char* B; };

struct DenseOrder {
    static constexpr bool GATHER_A = false;
    int nM, nN, nwg, G, c; const char* A; const char* Bt; size_t tstep;
    __device__ void init(const bf16_t* A_, const bf16_t* Bt_, int M, int N, int K, int G_, int c_) { nM = M / BM; nN = N / BM; nwg = nM * nN; G = G_; c = c_; A = (const char*)A_; Bt = (const char*)Bt_; tstep = (size_t)BM * K * 2; }
    __device__ bool next(int i, Unit& u) const {
        const long L = (long)i * G + c; if (L >= nwg) return false;
        int wgid = (int)L; { const int q = nwg / NXCD, r = nwg % NXCD, xcd = wgid % NXCD, off = wgid / NXCD; wgid = (xcd < r ? xcd * (q + 1) : r * (q + 1) + (xcd - r) * q) + off; }
        const int nig = WGM * nN, gid = wgid / nig, fm = gid * WGM, gsz = (nM - fm) < WGM ? (nM - fm) : WGM;
        u.pm = fm + ((wgid % nig) % gsz); u.pn = (wgid % nig) / gsz; u.A = A + (size_t)u.pm * tstep; u.B = Bt + (size_t)u.pn * tstep; return true;
    }
    __device__ __forceinline__ void a_ready(const Unit&) const {}
    __device__ __forceinline__ void done(const Unit&) const {}
};
struct ProjOrder {
    static constexpr bool GATHER_A = false;
    DenseOrder D; const char* HNp; const char* WT;
    __device__ void init(const bf16_t* HN_, const bf16_t* WT_, int c_) { D.init(HN_, WT_, NTP, 13 * BM, DM, GRID, c_); HNp = (const char*)HN_; WT = (const char*)WT_; }
    __device__ bool next(int i, Unit& u) const {
        if (!D.next(i, u)) return false;
        const size_t ts = (size_t)BM * DM * 2;
        if (u.pn < 11) { const int wrow = u.pn < 4 ? u.pn : u.pn + 2; u.A = HNp + (size_t)u.pm * ts; u.B = WT + (size_t)wrow * ts; }
        else { u.A = WT + (size_t)(4 + (u.pn - 11)) * ts; u.B = HNp + (size_t)u.pm * ts; }
        return true;
    }
    __device__ __forceinline__ void a_ready(const Unit&) const {}
    __device__ __forceinline__ void done(const Unit&) const {}
};
struct MoeOrder {
    static constexpr bool GATHER_A = false;
    const int* et; int TT, vcu; const char* A; const char* Bt; unsigned tstepA, tstepB, estep;
    __device__ __forceinline__ bool next(int i, Unit& u) const {
        const int L = i * GRID + vcu; if (L >= TT * 4) return false;
        const int rt = L >> 2, ct = L & 3, e = et[rt];
        u.pm = rt; u.pn = ct; u.A = A + (size_t)rt * tstepA; u.B = Bt + (size_t)e * estep + (size_t)ct * tstepB; return true;
    }
    __device__ __forceinline__ void a_ready(const Unit&) const {}
    __device__ __forceinline__ void done(const Unit&) const {}
};

struct S5OrderA {
    static constexpr bool GATHER_A = true;
    int vcu; const char* U; const char* BTA;
    __device__ __forceinline__ bool next(int i, Unit& u) const {
        const int L = i * GRID + vcu; if (L >= 640) return false;
        const int g = L / 10, rem = L - g * 10, mt = rem >> 1, nt = rem & 1;
        u.pm = mt; u.pn = g * 2 + nt; u.A = U + ((size_t)mt * 256 * 16 * 1024 + g * 16) * 2; u.B = BTA + ((size_t)(g * 512 + nt * 256) * 256) * 2; return true;
    }
    __device__ __forceinline__ void a_ready(const Unit&) const {}
    __device__ __forceinline__ void done(const Unit&) const {}
};
struct S5OrderC {
    static constexpr bool GATHER_A = false;
    int vcu; const char* CAR; const char* BTC;
    __device__ __forceinline__ bool next(int i, Unit& u) const {
        const int L = i * GRID + vcu; if (L >= 320) return false;
        const int g = L / 5, mt = L - g * 5;
        u.pm = mt; u.pn = g; u.A = CAR + ((size_t)(g * 1280 + mt * 256) * 256) * 2; u.B = BTC + ((size_t)g * 256 * 256) * 2; return true;
    }
    __device__ __forceinline__ void a_ready(const Unit&) const {}
    __device__ __forceinline__ void done(const Unit&) const {}
};
__device__ __forceinline__ unsigned cvt_pk_bf16(float lo, float hi) { unsigned r; asm volatile("v_cvt_pk_bf16_f32 %0, %1, %2" : "=v"(r) : "v"(lo), "v"(hi)); return r; }

struct EpiProj {
    static constexpr bool PERM = true, AFTER_DRAIN = false;
    bf16_t *Q, *Kk, *VT, *REST;
    __device__ __forceinline__ void operator()(const f32x4 (&acc)[2][2][4][2], const Unit& u, int wr, int wc, int fr, int fq) const {
        bf16_t* base; int ldc; int row0, col0;
        if (u.pn < 11) { row0 = u.pm * BM + wr * 64 + fr; int colt;
            if (u.pn < 2) { base = Q; colt = u.pn * BM; ldc = 512; } else if (u.pn < 4) { base = Kk; colt = (u.pn - 2) * BM; ldc = 512; } else { base = REST; colt = (u.pn - 4) * BM; ldc = RESTC; }
            col0 = colt + wc * 32 + 8 * fq; }
        else { base = VT; ldc = NTP; row0 = (u.pn - 11) * BM + wr * 64 + fr; col0 = u.pm * BM + wc * 32 + 8 * fq; }
#pragma unroll
        for (int ai = 0; ai < 2; ++ai)
#pragma unroll
            for (int m = 0; m < 4; ++m) { bf16_t* rowp = base + (size_t)(row0 + ai * HALF + m * 16) * ldc + col0;
#pragma unroll
                for (int bj = 0; bj < 2; ++bj) { const f32x4 v0 = acc[ai][bj][m][0], v1 = acc[ai][bj][m][1];
                    u32x4 w; w.x = cvt_pk_bf16(v0[0], v0[1]); w.y = cvt_pk_bf16(v0[2], v0[3]); w.z = cvt_pk_bf16(v1[0], v1[1]); w.w = cvt_pk_bf16(v1[2], v1[3]);
                    *(u32x4*)(rowp + bj * HALF) = w; } }
    }
};
struct EpiBf16Plain {
    static constexpr bool PERM = true, AFTER_DRAIN = false;
    bf16_t* O; int ldc;
    __device__ __forceinline__ void operator()(const f32x4 (&acc)[2][2][4][2], const Unit& u, int wr, int wc, int fr, int fq) const {
        const int row0 = u.pm * BM + wr * 64 + fr; const int col0 = u.pn * BM + wc * 32 + 8 * fq;
#pragma unroll
        for (int ai = 0; ai < 2; ++ai)
#pragma unroll
            for (int m = 0; m < 4; ++m) { bf16_t* rowp = O + (size_t)(row0 + ai * HALF + m * 16) * ldc + col0;
#pragma unroll
                for (int bj = 0; bj < 2; ++bj) { const f32x4 v0 = acc[ai][bj][m][0], v1 = acc[ai][bj][m][1];
                    u32x4 w; w.x = cvt_pk_bf16(v0[0], v0[1]); w.y = cvt_pk_bf16(v0[2], v0[3]); w.z = cvt_pk_bf16(v1[0], v1[1]); w.w = cvt_pk_bf16(v1[2], v1[3]);
                    *(u32x4*)(rowp + bj * HALF) = w; } }
    }
};
struct EpiSwiglu {
    static constexpr bool PERM = true, AFTER_DRAIN = false;
    bf16_t* O;
    __device__ __forceinline__ void operator()(const f32x4 (&acc)[2][2][4][2], const Unit& u, int wr, int wc, int fr, int fq) const {
        const int row0 = u.pm * BM + wr * 64 + fr; const int col0 = u.pn * HALF + wc * 32 + 8 * fq;
#pragma unroll
        for (int ai = 0; ai < 2; ++ai)
#pragma unroll
            for (int m = 0; m < 4; ++m) {
                float o[8];
#pragma unroll
                for (int n = 0; n < 2; ++n)
#pragma unroll
                    for (int i = 0; i < 4; ++i) { const float va = acc[ai][0][m][n][i], vg = acc[ai][1][m][n][i]; o[4 * n + i] = va / (1.f + __expf(-va)) * vg; }
                u32x4 w; w.x = cvt_pk_bf16(o[0], o[1]); w.y = cvt_pk_bf16(o[2], o[3]); w.z = cvt_pk_bf16(o[4], o[5]); w.w = cvt_pk_bf16(o[6], o[7]);
                *(u32x4*)(O + (size_t)(row0 + ai * HALF + m * 16) * DFF + col0) = w; }
    }
};
struct EpiResidual {
    static constexpr bool PERM = false, AFTER_DRAIN = false;
    float* Hh;
    __device__ __forceinline__ void operator()(const f32x4 (&acc)[2][2][4][2], const Unit& u, int wr, int wc, int fr, int fq) const {
        const int row0 = u.pm * BM + wr * 64 + fr; const int col0 = u.pn * BM + wc * 32 + 4 * fq;
#pragma unroll
        for (int ai = 0; ai < 2; ++ai)
#pragma unroll
            for (int m = 0; m < 4; ++m) { float* rowp = Hh + (size_t)(row0 + ai * HALF + m * 16) * DM + col0;
#pragma unroll
                for (int bj = 0; bj < 2; ++bj)
#pragma unroll
                    for (int n = 0; n < 2; ++n) { f32x4* p = (f32x4*)(rowp + bj * HALF + n * 16); *p = *p + acc[ai][bj][m][n]; } }
    }
};
struct EpiGlu {
    static constexpr bool PERM = false, AFTER_DRAIN = false;
    float* Hh;
    __device__ __forceinline__ void operator()(const f32x4 (&acc)[2][2][4][2], const Unit& u, int wr, int wc, int fr, int fq) const {
        const int row0 = u.pm * BM + wr * 64 + fr; const int col0 = u.pn * HALF + wc * 32 + 4 * fq;
#pragma unroll
        for (int ai = 0; ai < 2; ++ai)
#pragma unroll
            for (int m = 0; m < 4; ++m) { float* rowp = Hh + (size_t)(row0 + ai * HALF + m * 16) * DM + col0;
#pragma unroll
                for (int n = 0; n < 2; ++n) { f32x4* p = (f32x4*)(rowp + n * 16); f32x4 hv = *p; const f32x4 va = acc[ai][0][m][n], vg = acc[ai][1][m][n];
#pragma unroll
                    for (int i = 0; i < 4; ++i) hv[i] += va[i] / (1.f + __expf(-vg[i]));
                    *p = hv; } }
    }
};

struct EpiS5A {
    static constexpr bool PERM = true, AFTER_DRAIN = false;
    float* YI; float* E;
    __device__ __forceinline__ void operator()(const f32x4 (&acc)[2][2][4][2], const Unit& u, int wr, int wc, int fr, int fq) const {
        const int g = u.pn >> 1, nt = u.pn & 1;
        const int cl0 = wc * 32 + 8 * fq;
        float* base = nt == 0 ? YI + (size_t)(cl0 >> 4) * DM + g * 16 + (cl0 & 15) : E + (size_t)g * 256 + cl0;
        const size_t nstride = 16 * DM;
        const size_t bjstep = nt == 0 ? (size_t)8 * DM : (size_t)HALF;
#pragma unroll
        for (int ai = 0; ai < 2; ++ai)
#pragma unroll
            for (int m = 0; m < 4; ++m) { int n = u.pm * BM + ai * HALF + wr * 64 + m * 16 + fr; n = n < 1039 ? n : 1039;
                float* p = base + (size_t)n * nstride;
#pragma unroll
                for (int bj = 0; bj < 2; ++bj) { *(f32x4*)(p + bj * bjstep) = acc[ai][bj][m][0]; *(f32x4*)(p + bj * bjstep + 4) = acc[ai][bj][m][1]; } }
    }
};
struct EpiS5C {
    static constexpr bool PERM = true, AFTER_DRAIN = false;
    const float* YI; const bf16_t* Uu; const float* dvec; bf16_t* O;
    __device__ __forceinline__ void operator()(const f32x4 (&acc)[2][2][4][2], const Unit& u, int wr, int wc, int fr, int fq) const {
        const int g = u.pn;
        const int cl0 = wc * 32 + 8 * fq, ch = g * 16 + (cl0 & 15);
        const size_t off0 = (size_t)(cl0 >> 4) * DM + ch;
        const f32x4 d0 = *(const f32x4*)(dvec + ch), d1 = *(const f32x4*)(dvec + ch + 4);
#pragma unroll
        for (int ai = 0; ai < 2; ++ai)
#pragma unroll
            for (int m = 0; m < 4; ++m) { int n = u.pm * BM + ai * HALF + wr * 64 + m * 16 + fr; n = n < 1039 ? n : 1039;
#pragma unroll
                for (int bj = 0; bj < 2; ++bj) {
                    const size_t off = off0 + (size_t)n * (16 * DM) + (size_t)bj * (8 * DM);
                    const f32x4 y0 = *(const f32x4*)(YI + off), y1 = *(const f32x4*)(YI + off + 4);
                    const u32x4 uv = *(const u32x4*)(Uu + off);
                    float y[8];
#pragma unroll
                    for (int q = 0; q < 4; ++q) { y[q] = acc[ai][bj][m][0][q] + y0[q] + d0[q] * (q & 1 ? __uint_as_float(uv[q >> 1] & 0xffff0000u) : __uint_as_float(uv[q >> 1] << 16));
                        y[4 + q] = acc[ai][bj][m][1][q] + y1[q] + d1[q] * (q & 1 ? __uint_as_float(uv[2 + (q >> 1)] & 0xffff0000u) : __uint_as_float(uv[2 + (q >> 1)] << 16)); }
#pragma unroll
                    for (int q = 0; q < 8; ++q) { const float z = 1.5957691216f * (y[q] + 0.044715f * y[q] * y[q] * y[q]); y[q] = y[q] / (1.f + __expf(-z)); }
                    u32x4 w; w.x = cvt_pk_bf16(y[0], y[1]); w.y = cvt_pk_bf16(y[2], y[3]); w.z = cvt_pk_bf16(y[4], y[5]); w.w = cvt_pk_bf16(y[6], y[7]);
                    *(u32x4*)(O + off) = w; }
                asm volatile("" ::: "memory"); }
    }
};

template <class Epi, class Sched, bool ALIGN_EPI = false, bool SP2 = false>
__device__ __forceinline__ void gemm_phase(PG8_LAS unsigned char* lds, const int K, const Sched& S, const Epi& E) {
    int tid_ = threadIdx.x; asm volatile("" : "+v"(tid_));
    const int tid = tid_, wid = __builtin_amdgcn_readfirstlane(tid >> 6), lane = tid & 63, wr = wid >> 2, wc = wid & 3, fr = lane & 15, fq = lane >> 4;
    const int nt = K / BK;
    unsigned voffA[2], voffB[2];
#pragma unroll
    for (int i = 0; i < 2; ++i) { int R, C; stage_rc(tid * 16 + i * 8192, R, C); const int Rb = Epi::PERM ? ((R & ~31) + perm32(R & 31)) : R;
        voffA[i] = Sched::GATHER_A ? (unsigned)(((16 * R + (C >> 4)) * 1024 + (C & 15)) * 2) : (unsigned)(R * K + C) * 2u; voffB[i] = (unsigned)(Rb * K + C) * 2u; }
    const size_t kstep = (size_t)(BK * 2);
    const size_t hstep = (size_t)HALF * K * 2;
    const size_t kstepA = Sched::GATHER_A ? (size_t)(4 * 1024 * 2) : kstep, hstepA = Sched::GATHER_A ? (size_t)HALF * 16 * 1024 * 2 : hstep;
    const unsigned ldsw = (unsigned)wid * 1024u;
    const int aoff = lds_byte(wr * 64 + fr, fq * 8), boff = lds_byte(wc * 32 + fr, fq * 8);
#define PG8_SA(b, h) (((b) * 2 + (h)) * HTB)
#define PG8_SB(b, h) ((4 + (b) * 2 + (h)) * HTB)
#define PG8_STAGE(bufoff, gbase, voff) do { _Pragma("unroll") for (int _i = 0; _i < 2; ++_i) \
        __builtin_amdgcn_global_load_lds((const unsigned*)((const char*)(gbase) + (voff)[_i]), (PG8_LAS unsigned*)(lds + (bufoff) + ldsw + _i * 8192), 16, 0, 0); } while (0)
#define PG8_LDA(dst, b, h) do { _Pragma("unroll") for (int m = 0; m < 4; ++m) _Pragma("unroll") for (int k = 0; k < 2; ++k) dst[m][k] = *(const PG8_LAS bf16x8*)(lds + PG8_SA(b, h) + aoff + m * 2048 + k * 1024); } while (0)
#define PG8_LDB(dst, b, h) do { _Pragma("unroll") for (int n = 0; n < 2; ++n) _Pragma("unroll") for (int k = 0; k < 2; ++k) dst[n][k] = *(const PG8_LAS bf16x8*)(lds + PG8_SB(b, h) + boff + n * 2048 + k * 1024); } while (0)
#define PG8_MMA(ai, bj, At, Bt) do { __builtin_amdgcn_s_setprio(1); _Pragma("unroll") for (int m = 0; m < 4; ++m) _Pragma("unroll") for (int n = 0; n < 2; ++n) _Pragma("unroll") for (int k = 0; k < 2; ++k) \
        acc[ai][bj][m][n] = __builtin_amdgcn_mfma_f32_16x16x32_bf16(Bt[n][k], At[m][k], acc[ai][bj][m][n], 0, 0, 0); __builtin_amdgcn_s_setprio(0); } while (0)
#define PG8_WAIT_V(n) asm volatile("s_waitcnt vmcnt(" #n ")" ::: "memory")
#define PG8_WAIT_L(n) asm volatile("s_waitcnt lgkmcnt(" #n ")" ::: "memory")
#define PG8_BAR __builtin_amdgcn_s_barrier()
#define PG8_SCHED __builtin_amdgcn_sched_barrier(0)
    Unit cur, nxt; int ui = 0;
    if (!S.next(0, cur)) return;
    f32x4 acc[2][2][4][2];
#pragma unroll
    for (int a = 0; a < 2; ++a)
#pragma unroll
        for (int b = 0; b < 2; ++b)
#pragma unroll
            for (int m = 0; m < 4; ++m)
#pragma unroll
                for (int n = 0; n < 2; ++n) acc[a][b][m][n] = (f32x4){0.f, 0.f, 0.f, 0.f};
    bf16x8 At[4][2], B0[2][2], B1[2][2];
    const char* cA = cur.A; const char* cB = cur.B;
    S.a_ready(cur);
    if constexpr (SP2) {
        PG8_STAGE(PG8_SB(0, 0), cB, voffB); PG8_STAGE(PG8_SB(0, 1), cB + hstep, voffB); PG8_STAGE(PG8_SA(0, 0), cA, voffA); PG8_STAGE(PG8_SA(0, 1), cA + hstepA, voffA);
        if (wr == 1) PG8_BAR;
        PG8_WAIT_V(2); PG8_BAR;
        PG8_STAGE(PG8_SB(1, 0), cB + kstep, voffB); PG8_STAGE(PG8_SA(1, 0), cA + kstepA, voffA); PG8_STAGE(PG8_SB(1, 1), cB + hstep + kstep, voffB);
        PG8_WAIT_V(6); PG8_BAR;
    } else {
        PG8_STAGE(PG8_SB(0, 0), cB, voffB); PG8_STAGE(PG8_SA(0, 0), cA, voffA); PG8_STAGE(PG8_SB(0, 1), cB + hstep, voffB); PG8_STAGE(PG8_SA(0, 1), cA + hstepA, voffA);
        if (wr == 1) PG8_BAR;
        PG8_WAIT_V(4); PG8_BAR;
        PG8_STAGE(PG8_SB(1, 0), cB + kstep, voffB); PG8_STAGE(PG8_SA(1, 0), cA + kstepA, voffA); PG8_STAGE(PG8_SB(1, 1), cB + hstep + kstep, voffB);
        PG8_WAIT_V(6); PG8_BAR;
    }
    for (;;) {
        const bool has_next = S.next(ui + 1, nxt);
        const char* nA = has_next ? nxt.A : cA; const char* nB = has_next ? nxt.B : cB;
        for (int t = 0; t < nt; t += 2) {
            const bool last = (t == nt - 2);
            const char* a1 = cA + (size_t)(t + 1) * kstepA;
            const char* a2 = last ? nA : cA + (size_t)(t + 2) * kstepA; const char* b2 = last ? nB : cB + (size_t)(t + 2) * kstep;
            const char* a3 = a2 + kstepA; const char* b3 = b2 + kstep;
            if (last && has_next) S.a_ready(nxt);
            if constexpr (SP2) {
            PG8_LDB(B0, 0, 0); PG8_LDB(B1, 0, 1); PG8_SCHED; PG8_LDA(At, 0, 0); PG8_STAGE(PG8_SA(1, 1), a1 + hstepA, voffA);
            PG8_WAIT_V(8); PG8_WAIT_L(0); PG8_BAR; PG8_MMA(0, 0, At, B0); PG8_MMA(0, 1, At, B1); PG8_BAR; PG8_SCHED;
            PG8_LDA(At, 0, 1); PG8_STAGE(PG8_SB(0, 0), b2, voffB); PG8_STAGE(PG8_SB(0, 1), b2 + hstep, voffB); PG8_STAGE(PG8_SA(0, 0), a2, voffA);
            PG8_WAIT_V(8); PG8_WAIT_L(0); PG8_BAR; PG8_MMA(1, 0, At, B0); PG8_MMA(1, 1, At, B1); PG8_BAR; PG8_SCHED;
            PG8_LDB(B0, 1, 0); PG8_LDB(B1, 1, 1); PG8_SCHED; PG8_LDA(At, 1, 0); PG8_STAGE(PG8_SA(0, 1), a2 + hstepA, voffA);
            PG8_WAIT_V(8); PG8_WAIT_L(0); PG8_BAR; PG8_MMA(0, 0, At, B0); PG8_MMA(0, 1, At, B1); PG8_BAR; PG8_SCHED;
            PG8_LDA(At, 1, 1); PG8_STAGE(PG8_SB(1, 0), b3, voffB); PG8_STAGE(PG8_SB(1, 1), b3 + hstep, voffB); PG8_STAGE(PG8_SA(1, 0), a3, voffA);
            PG8_WAIT_V(8); PG8_WAIT_L(0); PG8_BAR; PG8_MMA(1, 0, At, B0); PG8_MMA(1, 1, At, B1); PG8_BAR; PG8_SCHED;
            } else {
            PG8_LDB(B0, 0, 0); PG8_SCHED; PG8_LDA(At, 0, 0); PG8_STAGE(PG8_SA(1, 1), a1 + hstepA, voffA);
            PG8_WAIT_L(8); PG8_BAR; PG8_WAIT_L(0); PG8_MMA(0, 0, At, B0); PG8_BAR; PG8_SCHED;
            PG8_LDB(B1, 0, 1); PG8_STAGE(PG8_SB(0, 0), b2, voffB);
            PG8_BAR; PG8_WAIT_L(0); PG8_MMA(0, 1, At, B1); PG8_BAR;
            PG8_LDA(At, 0, 1); PG8_STAGE(PG8_SA(0, 0), a2, voffA);
            PG8_BAR; PG8_WAIT_L(0); PG8_MMA(1, 0, At, B0); PG8_BAR; PG8_SCHED;
            PG8_STAGE(PG8_SB(0, 1), b2 + hstep, voffB);
            PG8_WAIT_V(6); PG8_BAR; PG8_MMA(1, 1, At, B1); PG8_BAR;
            PG8_LDB(B0, 1, 0); PG8_SCHED; PG8_LDA(At, 1, 0); PG8_STAGE(PG8_SA(0, 1), a2 + hstepA, voffA);
            PG8_WAIT_L(8); PG8_BAR; PG8_WAIT_L(0); PG8_MMA(0, 0, At, B0); PG8_BAR; PG8_SCHED;
            PG8_LDB(B1, 1, 1); PG8_STAGE(PG8_SB(1, 0), b3, voffB);
            PG8_BAR; PG8_WAIT_L(0); PG8_MMA(0, 1, At, B1); PG8_BAR;
            PG8_LDA(At, 1, 1); PG8_STAGE(PG8_SA(1, 0), a3, voffA);
            PG8_BAR; PG8_WAIT_L(0); PG8_MMA(1, 0, At, B0); PG8_BAR; PG8_SCHED;
            PG8_STAGE(PG8_SB(1, 1), b3 + hstep, voffB);
            PG8_WAIT_V(6); PG8_BAR; PG8_MMA(1, 1, At, B1); PG8_BAR;
            }
        }
        if constexpr (ALIGN_EPI) { if (wr == 0) PG8_BAR; }
        if constexpr (!Epi::AFTER_DRAIN) { E(acc, cur, wr, wc, fr, fq); S.done(cur); }
        if (!has_next) break;
#pragma unroll
        for (int a = 0; a < 2; ++a)
#pragma unroll
            for (int b = 0; b < 2; ++b)
#pragma unroll
                for (int m = 0; m < 4; ++m)
#pragma unroll
                    for (int n = 0; n < 2; ++n) acc[a][b][m][n] = (f32x4){0.f, 0.f, 0.f, 0.f};
        cur = nxt; cA = nA; cB = nB; ++ui;
        if constexpr (ALIGN_EPI) { if (wr == 1) PG8_BAR; }
    }
    PG8_WAIT_V(0);
    if constexpr (!ALIGN_EPI) { if (wr == 0) PG8_BAR; }
    PG8_BAR;
    if constexpr (Epi::AFTER_DRAIN) { E.fused(acc, cur, wr, wc, fr, fq, lds, wid, lane); S.done(cur); }
#undef PG8_SA
#undef PG8_SB
#undef PG8_STAGE
#undef PG8_LDA
#undef PG8_LDB
#undef PG8_MMA
#undef PG8_WAIT_V
#undef PG8_WAIT_L
#undef PG8_BAR
#undef PG8_SCHED
}
}

#define PHASE_PROLOGUE \
    int tid_ = threadIdx.x; asm volatile("" : "+v"(tid_)); const int tid = tid_, lane = tid & 63, wave = tid >> 6; \
    const int G = GRID, bid = blockIdx.x; \
    const int gw = bid * 8 + wave, NGW = G * 8; \
    unsigned char* ws = P.ws; \
    float* H = (float*)(ws + WS_H); \
    bf16_t* HN = (bf16_t*)(ws + WS_HN); \
    bf16_t* A2 = (bf16_t*)(ws + WS_A2); \
    bf16_t* Qb = (bf16_t*)(ws + WS_Q); bf16_t* Kb = (bf16_t*)(ws + WS_K); bf16_t* Vb = (bf16_t*)(ws + WS_V); \
    bf16_t* REST = (bf16_t*)(ws + WS_REST); \
    bf16_t* YFB = (bf16_t*)(ws + WS_YFB); \
    bf16_t* Rr = (bf16_t*)(ws + WS_R); bf16_t* VV = (bf16_t*)(ws + WS_VV); bf16_t* KK = (bf16_t*)(ws + WS_KK); \
    bf16_t* KKA = (bf16_t*)(ws + WS_KKA); bf16_t* KD = (bf16_t*)(ws + WS_KD); \
    float* Wd = (float*)(ws + WS_W); \
    bf16_t* Gg = (bf16_t*)(ws + WS_G); bf16_t* KR = (bf16_t*)(ws + WS_KR); bf16_t* LOW = (bf16_t*)(ws + WS_LOW); \
    float* BC = (float*)(ws + WS_BC); \
    bf16_t* AA = (bf16_t*)(ws + WS_AA); \
    bf16_t* HB = (bf16_t*)(ws + WS_HB); bf16_t* YB = (bf16_t*)(ws + WS_YB); \
    bf16_t* XB = (bf16_t*)(ws + WS_XB); int* EID = (int*)(ws + WS_EID); int* POS = (int*)(ws + WS_POS); int* DEST = (int*)(ws + WS_DEST); \
    float* GATE = (float*)(ws + WS_GATE); \
    float* YI = (float*)(ws + WS_YI); float* S5E = (float*)(ws + WS_E); bf16_t* CAR = (bf16_t*)(ws + WS_CAR); bf16_t* BTA = (bf16_t*)(ws + WS_BTA); bf16_t* BTC = (bf16_t*)(ws + WS_BTC); \
    unsigned* CTL = (unsigned*)(ws + WS_CTL); \
    bf16_t* WTIN = (bf16_t*)(ws + WS_WTIN); bf16_t* WTOUT = (bf16_t*)(ws + WS_WTOUT); bf16_t* WTGLU = (bf16_t*)(ws + WS_WTGLU); bf16_t* WT13 = (bf16_t*)(ws + WS_WT13); bf16_t* WT2 = (bf16_t*)(ws + WS_WT2); \
    const int vcu = (G % 8 == 0) ? (bid % 8) * (G / 8) + bid / 8 : bid; \
    const float* x = P.in[0]; const float* meta = P.in[1]; const float* norm_mix = P.in[2]; const float* norm_ffn = P.in[3]; const float* norm_final = P.in[4]; \
    const float* w_in = P.in[5]; const float* w_out = P.in[6]; const float* rpb = P.in[7]; const float* mu = P.in[8]; \
    const float* w0 = P.in[9]; const float* w_up = P.in[10]; const float* a0 = P.in[11]; const float* a_up = P.in[12]; const float* g_up = P.in[13]; \
    const float* k_k = P.in[14]; const float* k_a = P.in[15]; const float* r_k = P.in[16]; const float* lnx_g = P.in[17]; const float* lnx_b = P.in[18]; \
    const float* s5_b_re = P.in[19]; const float* s5_b_im = P.in[20]; const float* s5_lre = P.in[21]; const float* s5_lim = P.in[22]; const float* s5_ls = P.in[23]; \
    const float* s5_c_re = P.in[24]; const float* s5_c_im = P.in[25]; const float* s5_d = P.in[26]; const float* w_glu = P.in[27]; \
    const float* moe_wg = P.in[28]; const float* moe_bg = P.in[29]; const float* moe_we = P.in[30]; const float* moe_be = P.in[31]; \
    const float* moe_w1 = P.in[32]; const float* moe_w3 = P.in[33]; const float* moe_w2 = P.in[34];


__device__ __forceinline__ void transpose_item(const float* W, int N, int K, int k0, int n0, bf16_t* dstrow0, int lane) {
    const int nq = lane & 15, kb = lane >> 4;
    const float* src = W + (size_t)(k0 + 16 * kb) * N + n0 + 4 * nq;
    f32x4 v[16];
#pragma unroll
    for (int kk = 0; kk < 16; ++kk) v[kk] = *(const f32x4*)(src + (size_t)kk * N);
#pragma unroll
    for (int i = 0; i < 4; ++i) {
        bf16_t* d = dstrow0 + (size_t)(4 * nq + i) * K + k0 + 16 * kb;
        u32x4 lo, hi;
        lo.x = pk2(v[0][i], v[1][i]); lo.y = pk2(v[2][i], v[3][i]); lo.z = pk2(v[4][i], v[5][i]); lo.w = pk2(v[6][i], v[7][i]);
        hi.x = pk2(v[8][i], v[9][i]); hi.y = pk2(v[10][i], v[11][i]); hi.z = pk2(v[12][i], v[13][i]); hi.w = pk2(v[14][i], v[15][i]);
        *(u32x4*)d = lo; *(u32x4*)(d + 8) = hi;
    }
}
#define CONV_DENSE_ITEMS (832 + 256 + 512)
__device__ __forceinline__ void conv_dense_item(CParams& P, int it, int lane) {
    unsigned char* ws = P.ws;
    if (it < 832) { const int kb = it / 52, nb = it % 52; transpose_item(P.in[5], INCOLS, DM, kb * 64, nb * 64, (bf16_t*)(ws + WS_WTIN) + (size_t)nb * 64 * DM, lane); return; }
    it -= 832;
    if (it < 256) { const int kb = it / 16, nb = it % 16; transpose_item(P.in[6], DM, DM, kb * 64, nb * 64, (bf16_t*)(ws + WS_WTOUT) + (size_t)nb * 64 * DM, lane); return; }
    it -= 256;
    { const int kb = it / 32, nb = it % 32, n = nb * 64, half = n >> 10, c = n & 1023, row = (c >> 7) * 256 + half * 128 + (c & 127);
      transpose_item(P.in[27], 2 * DM, DM, kb * 64, n, (bf16_t*)(ws + WS_WTGLU) + (size_t)row * DM, lane); }
}
#define CONV_MOE_ITEMS (NEXP * 384)
__device__ __forceinline__ void conv_moe_item(CParams& P, int l, int it, int lane) {
    unsigned char* ws = P.ws;
    const int e = it / 384; int r = it % 384;
    if (r < 256) { const int which = r >> 7; r &= 127; const int kb = r >> 3, nb = r & 7, n = nb * 64, row = (n >> 7) * 256 + which * 128 + (n & 127);
        const float* W = (which ? P.in[33] : P.in[32]) + ((size_t)(l * NEXP + e) * DM) * DFF;
        transpose_item(W, DFF, DM, kb * 64, n, (bf16_t*)(ws + WS_WT13) + ((size_t)e * DM + row) * DM, lane); return; }
    r -= 256;
    { const int kb = r >> 4, nb = r & 15; const float* W = P.in[34] + ((size_t)(l * NEXP + e) * DFF) * DM;
      transpose_item(W, DM, DFF, kb * 64, nb * 64, (bf16_t*)(ws + WS_WT2) + ((size_t)e * DM + nb * 64) * DFF, lane); }
}

template <int MODE>
__device__ __forceinline__ void meta_gemm(const bf16_t* A, const bf16_t* Bt, float* Hrows, int task, int lane) {
    const int fr = lane & 15, fq = lane >> 4, c = task * 16 + fr;
    const bf16_t* b0 = MODE == 0 ? Bt + (size_t)c * DM : Bt + (size_t)((c >> 7) * 256 + (c & 127)) * DM;
    const bf16_t* b1 = b0 + (size_t)128 * DM;
    f32x4 acc0[2], acc1[2];
    acc0[0] = acc0[1] = acc1[0] = acc1[1] = (f32x4){0.f, 0.f, 0.f, 0.f};
#pragma unroll 4
    for (int kt = 0; kt < 32; ++kt) {
        const int ko = kt * 32 + fq * 8;
        const bf16x8 a0 = *(const bf16x8*)(A + (size_t)fr * DM + ko), a1 = *(const bf16x8*)(A + (size_t)(16 + fr) * DM + ko);
        const bf16x8 bv = *(const bf16x8*)(b0 + ko);
        acc0[0] = __builtin_amdgcn_mfma_f32_16x16x32_bf16(a0, bv, acc0[0], 0, 0, 0);
        acc0[1] = __builtin_amdgcn_mfma_f32_16x16x32_bf16(a1, bv, acc0[1], 0, 0, 0);
        if (MODE == 1) { const bf16x8 bg = *(const bf16x8*)(b1 + ko);
            acc1[0] = __builtin_amdgcn_mfma_f32_16x16x32_bf16(a0, bg, acc1[0], 0, 0, 0);
            acc1[1] = __builtin_amdgcn_mfma_f32_16x16x32_bf16(a1, bg, acc1[1], 0, 0, 0); }
    }
#pragma unroll
    for (int mi = 0; mi < 2; ++mi)
#pragma unroll
        for (int j = 0; j < 4; ++j) { float* p = Hrows + (size_t)(mi * 16 + fq * 4 + j) * DM + c;
            if (MODE == 0) *p += acc0[mi][j]; else *p += acc0[mi][j] / (1.f + __expf(-acc1[mi][j])); }
}
__device__ __forceinline__ void phase_0(CParams& P, unsigned char* lds, const int ph) {
    PHASE_PROLOGUE
            for (int row = gw; row < NT; row += NGW) {
                const float* src = row < NMAIN ? x + (size_t)row * DM : meta + (size_t)((row - NMAIN) & 15) * DM;
                f32x4 v[4];
#pragma unroll
                for (int j = 0; j < 4; ++j) { v[j] = ((const f32x4*)src)[lane + 64 * j]; ((f32x4*)(H + (size_t)row * DM))[lane + 64 * j] = v[j]; }
                store_norm_bf16(v, norm_mix, HN + (size_t)row * DM, lane);
            }
    for (int it = gw; it < CONV_DENSE_ITEMS; it += NGW) conv_dense_item(P, it, lane);
    for (int it = gw; it < CONV_MOE_ITEMS; it += NGW) conv_moe_item(P, 0, it, lane);
}

__device__ __forceinline__ void phase_1(CParams& P, unsigned char* lds, const int ph) {
    PHASE_PROLOGUE
    pg8::ProjOrder S; S.init(HN, WTIN, bid);
    pg8::EpiProj E{Qb, Kb, Vb, REST};
    pg8::gemm_phase<pg8::EpiProj, pg8::ProjOrder, true, true>((PG8_LAS unsigned char*)lds, DM, S, E);
}

__device__ __forceinline__ void phase_2(CParams& P, unsigned char* lds, const int ph) {
    PHASE_PROLOGUE
    float* sb = (float*)lds;
    for (int i = tid; i < 8 * 465; i += 512) sb[i] = rpb[i];
    __syncthreads();
    const bf16_t* VT = Vb;
    const int fr = lane & 15, fq = lane >> 4;
    for (int u = gw; u < 8192 + 16; u += NGW) {
        const bool metaq = u >= 8192;
        int b, h, r = 0, qb = 0;
        if (!metaq) { qb = u & 3; r = (u >> 2) & 127; h = (u >> 9) & 7; b = u >> 12; } else { const int m = u - 8192; b = m >> 3; h = m & 7; }
        const int c = qb * 16 + fr;
        const int qrow = metaq ? NMAIN + b * NMETA + fr : b * SEQ + r * 64 + c;
        const int R0 = min(max(r - 4, 0), 120), cs = qb == 0 ? 0 : (qb == 1 ? 8 : (qb == 2 ? 24 : 32));
        const int C0 = min(max(c - 8, 0), 48);
        bf16x8 qf0 = *(const bf16x8*)(Qb + (size_t)qrow * 512 + h * 64 + fq * 8), qf1 = *(const bf16x8*)(Qb + (size_t)qrow * 512 + h * 64 + 32 + fq * 8);
        f32x4 sacc[17];
        const f32x4 zero4 = (f32x4){0.f, 0.f, 0.f, 0.f};
        if (!metaq) {
#pragma unroll
            for (int kt = 0; kt < 16; ++kt) {
                const int krow0 = b * SEQ + (R0 + (kt >> 1)) * 64 + cs + 16 * (kt & 1);
                const bf16_t* kp = Kb + (size_t)(krow0 + fr) * 512 + h * 64 + fq * 8;
                const bf16x8 a0 = *(const bf16x8*)kp, a1 = *(const bf16x8*)(kp + 32);
                f32x4 acc = __builtin_amdgcn_mfma_f32_16x16x32_bf16(a0, qf0, zero4, 0, 0, 0);
                sacc[kt] = __builtin_amdgcn_mfma_f32_16x16x32_bf16(a1, qf1, acc, 0, 0, 0);
            }
        } else {
#pragma unroll
            for (int kt = 0; kt < 16; ++kt) sacc[kt] = zero4;
        }
        {
            const bf16_t* kp = Kb + (size_t)(NMAIN + b * NMETA + fr) * 512 + h * 64 + fq * 8;
            const bf16x8 a0 = *(const bf16x8*)kp, a1 = *(const bf16x8*)(kp + 32);
            f32x4 acc = __builtin_amdgcn_mfma_f32_16x16x32_bf16(a0, qf0, zero4, 0, 0, 0);
            sacc[16] = __builtin_amdgcn_mfma_f32_16x16x32_bf16(a1, qf1, acc, 0, 0, 0);
        }
        float mx = -1e30f;
#pragma unroll
        for (int kt = 0; kt < 16; ++kt) {
            const int dr = R0 + (kt >> 1) - r + 7;
#pragma unroll
            for (int j = 0; j < 4; ++j) {
                const int kc = cs + 16 * (kt & 1) + 4 * fq + j;
                const bool inb = !metaq && kc >= C0 && kc < C0 + 16;
                const int dc = min(max(kc - c + 15, 0), 30);
                const float s = inb ? sacc[kt][j] * 0.125f + sb[(h * 15 + dr) * 31 + dc] : -1e30f;
                sacc[kt][j] = s; mx = fmaxf(mx, s);
            }
        }
#pragma unroll
        for (int j = 0; j < 4; ++j) { const float s = sacc[16][j] * 0.125f; sacc[16][j] = s; mx = fmaxf(mx, s); }
        mx = fmaxf(mx, __shfl_xor(mx, 16)); mx = fmaxf(mx, __shfl_xor(mx, 32));
        float sum = 0.f;
#pragma unroll
        for (int kt = 0; kt < 17; ++kt)
#pragma unroll
            for (int j = 0; j < 4; ++j) { const float pv = __expf(sacc[kt][j] - mx); sacc[kt][j] = pv; sum += pv; }
        sum += __shfl_xor(sum, 16); sum += __shfl_xor(sum, 32);
        f32x4 o[4] = {zero4, zero4, zero4, zero4};
        if (!metaq) {
#pragma unroll
            for (int kr = 0; kr < 8; ++kr) {
                union { bf16x8 v; unsigned u[4]; } bf;
                bf.u[0] = pk2(sacc[2 * kr][0], sacc[2 * kr][1]); bf.u[1] = pk2(sacc[2 * kr][2], sacc[2 * kr][3]);
                bf.u[2] = pk2(sacc[2 * kr + 1][0], sacc[2 * kr + 1][1]); bf.u[3] = pk2(sacc[2 * kr + 1][2], sacc[2 * kr + 1][3]);
                const size_t tok0 = (size_t)b * SEQ + (R0 + kr) * 64 + cs + 4 * fq;
#pragma unroll
                for (int dt = 0; dt < 4; ++dt) {
                    const bf16_t* vp = VT + (size_t)(h * 64 + dt * 16 + fr) * NTP + tok0;
                    union { bf16x8 v; u32x2 h2[2]; } af;
                    af.h2[0] = *(const u32x2*)vp; af.h2[1] = *(const u32x2*)(vp + 16);
                    o[dt] = __builtin_amdgcn_mfma_f32_16x16x32_bf16(af.v, bf.v, o[dt], 0, 0, 0);
                }
            }
        }
        {
            union { bf16x8 v; unsigned u[4]; } bf;
            bf.u[0] = pk2(sacc[16][0], sacc[16][1]); bf.u[1] = pk2(sacc[16][2], sacc[16][3]); bf.u[2] = 0u; bf.u[3] = 0u;
            const size_t tokm = (size_t)NMAIN + b * NMETA + 4 * fq;
#pragma unroll
            for (int dt = 0; dt < 4; ++dt) {
                const bf16_t* vp = VT + (size_t)(h * 64 + dt * 16 + fr) * NTP + tokm;
                union { bf16x8 v; u32x2 h2[2]; } af;
                af.h2[0] = *(const u32x2*)vp; af.h2[1] = (u32x2){0u, 0u};
                o[dt] = __builtin_amdgcn_mfma_f32_16x16x32_bf16(af.v, bf.v, o[dt], 0, 0, 0);
            }
        }
        const float inv = 1.f / sum;
#pragma unroll
        for (int dt = 0; dt < 4; ++dt) {
            u32x2 ov; ov.x = pk2(o[dt][0] * inv, o[dt][1] * inv); ov.y = pk2(o[dt][2] * inv, o[dt][3] * inv);
            *(u32x2*)(A2 + (size_t)qrow * DM + h * 64 + dt * 16 + 4 * fq) = ov;
        }
    }
    __syncthreads();
}

__device__ __forceinline__ void phase_3(CParams& P, unsigned char* lds, const int ph) {
    PHASE_PROLOGUE
            for (int tk = gw; tk < NT; tk += NGW) {
                const int b = tk / LSEQ, p = tk % LSEQ, row = rowof(b, p);
                const bool hp = p > 0, hn = p + 1 < LSEQ;
                const int rowp = hp ? rowof(b, p - 1) : row, rown = hn ? rowof(b, p + 1) : row;
#pragma unroll
                for (int j = 0; j < 7; ++j) {
                    const int c = 4 * lane + 256 * j;
                    const u32x2 vc = *(const u32x2*)(REST + (size_t)row * RESTC + c);
                    u32x2 vp = *(const u32x2*)(REST + (size_t)rowp * RESTC + c);
                    u32x2 vn = *(const u32x2*)(REST + (size_t)rown * RESTC + c);
                    if (!hp) { vp.x = 0; vp.y = 0; }
                    if (!hn) { vn.x = 0; vn.y = 0; }
                    const f32x4 m4 = *(const f32x4*)(mu + c);
                    float pc[4] = {bflo(vc.x), bfhi(vc.x), bflo(vc.y), bfhi(vc.y)};
                    float pp[4] = {bflo(vp.x), bfhi(vp.x), bflo(vp.y), bfhi(vp.y)};
                    float pn[4] = {bflo(vn.x), bfhi(vn.x), bflo(vn.y), bfhi(vn.y)};
                    float o[4];
#pragma unroll
                    for (int i = 0; i < 4; ++i) o[i] = pc[i] + m4[i] * (0.5f * (pp[i] + pn[i]) - pc[i]);
                    if (j == 6) {
                        if (lane < 16) { for (int i = 0; i < 4; ++i) o[i] = tanhf(o[i]); }
                        else if (lane >= 32) { for (int i = 0; i < 4; ++i) o[i] = sigmoidf_(o[i]); }
                    }
                    u32x2 ov; ov.x = pk2(o[0], o[1]); ov.y = pk2(o[2], o[3]);
                    bf16_t* dst = j < 2 ? Rr + (size_t)row * 512 + c : (j < 4 ? KR + (size_t)row * 512 + (c - 512) : (j < 6 ? VV + (size_t)row * 512 + (c - 1024) : LOW + (size_t)row * 256 + (c - 1536)));
                    *(u32x2*)dst = ov;
                }
            }
}


__device__ __forceinline__ void phase_4(CParams& P, unsigned char* lds, const int ph) {
    PHASE_PROLOGUE
            const int nrt = (NT + 127) / 128;
            const int nunits = nrt * 4 * 5;
            for (int u = bid; u < nunits; u += G) {
                const int which = u / (nrt * 4), rem = u % (nrt * 4), rt = rem / 4, ct = rem % 4;
                f32x4 acc[4][2];
                const int koff = which < 2 ? 0 : (which < 4 ? 64 : 128), KK_ = which < 4 ? 64 : 128;
                const float* Bsrc = which < 2 ? w_up + (size_t)which * 64 * 512 : (which < 4 ? a_up + (size_t)(which - 2) * 64 * 512 : g_up);
                gemm_tile(lds, KK_, 512,
                          [&](int r) { int row = rt * 128 + r; if (row >= NT) row = NT - 1; return LOW + (size_t)row * 256 + koff; },
                          [&](int n) { return Bsrc + ct * 128 + n; }, acc);
                ACC_FOREACH(acc, { const int row = rt * 128 + rl, col = ct * 128 + cl; if (row < NT) {
                    if (which < 2) { const float wl = w0[which * 512 + col] + val; Wd[((size_t)which * NT + row) * 512 + col] = __expf(-0.6065306597f * sigmoidf_(wl)); }
                    else if (which < 4) { const int d = which - 2; AA[((size_t)d * NT + row) * 512 + col] = (bf16_t)f2bf(sigmoidf_(a0[d * 512 + col] + val)); }
                    else Gg[(size_t)row * 512 + col] = (bf16_t)f2bf(val); } });
            }
}


__device__ __forceinline__ void phase_5(CParams& P, unsigned char* lds, const int ph) {
    PHASE_PROLOGUE
            for (int row = gw; row < NT; row += NGW) {
                const int c0 = lane * 8;
                const u32x4 krv = *(const u32x4*)(KR + (size_t)row * 512 + c0);
                const u32x4 rv = *(const u32x4*)(Rr + (size_t)row * 512 + c0);
                float kr[8], rr[8], kkv[8];
#pragma unroll
                for (int i = 0; i < 4; ++i) { kr[2 * i] = bflo(krv[i]); kr[2 * i + 1] = bfhi(krv[i]); rr[2 * i] = bflo(rv[i]); rr[2 * i + 1] = bfhi(rv[i]); }
                float ss = 0.f;
#pragma unroll
                for (int i = 0; i < 8; ++i) { kkv[i] = kr[i] * k_k[c0 + i]; ss += kkv[i] * kkv[i]; }
                ss += __shfl_xor(ss, 1); ss += __shfl_xor(ss, 2); ss += __shfl_xor(ss, 4);
                const float inv = 1.f / fmaxf(sqrtf(ss), 1e-12f);
#pragma unroll
                for (int i = 0; i < 8; ++i) kkv[i] *= inv;
                u32x4 o; o.x = pk2(kkv[0], kkv[1]); o.y = pk2(kkv[2], kkv[3]); o.z = pk2(kkv[4], kkv[5]); o.w = pk2(kkv[6], kkv[7]);
                *(u32x4*)(KK + (size_t)row * 512 + c0) = o;
                float bsum = 0.f;
#pragma unroll
                for (int d = 0; d < 2; ++d) {
                    const u32x4 av = *(const u32x4*)(AA + ((size_t)d * NT + row) * 512 + c0);
                    float a[8], kka[8], kd[8];
#pragma unroll
                    for (int i = 0; i < 4; ++i) { a[2 * i] = bflo(av[i]); a[2 * i + 1] = bfhi(av[i]); }
#pragma unroll
                    for (int i = 0; i < 8; ++i) { kka[i] = kkv[i] * a[i]; kd[i] = kr[i] * (1.f + (a[i] - 1.f) * k_a[c0 + i]); bsum += rr[i] * kd[i] * r_k[c0 + i]; }
                    u32x4 o1; o1.x = pk2(kka[0], kka[1]); o1.y = pk2(kka[2], kka[3]); o1.z = pk2(kka[4], kka[5]); o1.w = pk2(kka[6], kka[7]);
                    *(u32x4*)(KKA + ((size_t)d * NT + row) * 512 + c0) = o1;
                    u32x4 o2; o2.x = pk2(kd[0], kd[1]); o2.y = pk2(kd[2], kd[3]); o2.z = pk2(kd[4], kd[5]); o2.w = pk2(kd[6], kd[7]);
                    *(u32x4*)(KD + ((size_t)d * NT + row) * 512 + c0) = o2;
                }
                bsum += __shfl_xor(bsum, 1); bsum += __shfl_xor(bsum, 2); bsum += __shfl_xor(bsum, 4);
                if ((lane & 7) == 0) BC[(size_t)row * 8 + (lane >> 3)] = bsum;
            }
}


__device__ __forceinline__ void phase_6(CParams& P, unsigned char* lds, const int ph) {
    PHASE_PROLOGUE
    constexpr int TB = 16, NBLK = LSEQ / TB, BUFF = 5 * TB * 64 + 8 * TB;
    float* bufs = (float*)lds;
    float* ybuf = bufs + 2 * BUFF;
    const int chain = bid >> 3, rg = bid & 7, d = chain >> 4, b = (chain >> 3) & 1, h = chain & 7;
    const bool scanner = wave < 4, loader = (wave == 4 || wave == 5);
    const int lt = tid - 256, ls = lt >> 3, lp = lt & 7;
    const int rr = lane >> 5, kp = lane & 31, vrow = wave * 2 + rr;
    float s0 = 0.f, s1 = 0.f;
#define SCAN_STAGE(blk_, buf_) do { const int sidx_ = (blk_) * TB + ls, p_ = d ? LSEQ - 1 - sidx_ : sidx_; const size_t o_ = (size_t)rowof(b, p_) * 512 + h * 64 + lp * 8; \
        const f32x4 wa_ = *(const f32x4*)(Wd + (size_t)d * NT * 512 + o_), wb_ = *(const f32x4*)(Wd + (size_t)d * NT * 512 + o_ + 4); \
        const u32x4 kk_ = *(const u32x4*)(KK + o_), ka_ = *(const u32x4*)(KKA + (size_t)d * NT * 512 + o_), kd_ = *(const u32x4*)(KD + (size_t)d * NT * 512 + o_), r_ = *(const u32x4*)(Rr + o_); \
        const bf16_t vv_ = VV[(size_t)rowof(b, p_) * 512 + h * 64 + rg * 8 + lp]; \
        float* q_ = (buf_) + ls * 64 + lp * 8; \
        *(f32x4*)q_ = wa_; *(f32x4*)(q_ + 4) = wb_; \
        *(f32x4*)(q_ + TB * 64) = (f32x4){bflo(kk_[0]), bfhi(kk_[0]), bflo(kk_[1]), bfhi(kk_[1])}; *(f32x4*)(q_ + TB * 64 + 4) = (f32x4){bflo(kk_[2]), bfhi(kk_[2]), bflo(kk_[3]), bfhi(kk_[3])}; \
        *(f32x4*)(q_ + 2 * TB * 64) = (f32x4){bflo(ka_[0]), bfhi(ka_[0]), bflo(ka_[1]), bfhi(ka_[1])}; *(f32x4*)(q_ + 2 * TB * 64 + 4) = (f32x4){bflo(ka_[2]), bfhi(ka_[2]), bflo(ka_[3]), bfhi(ka_[3])}; \
        *(f32x4*)(q_ + 3 * TB * 64) = (f32x4){bflo(kd_[0]), bfhi(kd_[0]), bflo(kd_[1]), bfhi(kd_[1])}; *(f32x4*)(q_ + 3 * TB * 64 + 4) = (f32x4){bflo(kd_[2]), bfhi(kd_[2]), bflo(kd_[3]), bfhi(kd_[3])}; \
        *(f32x4*)(q_ + 4 * TB * 64) = (f32x4){bflo(r_[0]), bfhi(r_[0]), bflo(r_[1]), bfhi(r_[1])}; *(f32x4*)(q_ + 4 * TB * 64 + 4) = (f32x4){bflo(r_[2]), bfhi(r_[2]), bflo(r_[3]), bfhi(r_[3])}; \
        (buf_)[5 * TB * 64 + lp * TB + ls] = bf2f(vv_); } while (0)
#define SCAN_FLUSH(blk_) do { const int sidx_ = (blk_) * TB + ls, p_ = d ? LSEQ - 1 - sidx_ : sidx_; \
        YFB[((size_t)d * NT + rowof(b, p_)) * 512 + h * 64 + rg * 8 + lp] = (bf16_t)f2bf(ybuf[((blk_) & 1) * 8 * TB + lp * TB + ls]); } while (0)
    if (loader) SCAN_STAGE(0, bufs);
    __syncthreads();
    for (int blk = 0; blk < NBLK; ++blk) {
        if (loader) {
            if (blk + 1 < NBLK) SCAN_STAGE(blk + 1, bufs + ((blk + 1) & 1) * BUFF);
            if (blk > 0) SCAN_FLUSH(blk - 1);
        } else if (scanner) {
            const float* bf_ = bufs + (blk & 1) * BUFF + 2 * kp;
            float yreg = 0.f;
#pragma unroll
            for (int t = 0; t < TB; ++t) {
                typedef float f32x2_ __attribute__((ext_vector_type(2)));
                const f32x2_ w2 = *(const f32x2_*)(bf_ + t * 64), kk2 = *(const f32x2_*)(bf_ + (TB + t) * 64), ka2 = *(const f32x2_*)(bf_ + (2 * TB + t) * 64),
                             kd2 = *(const f32x2_*)(bf_ + (3 * TB + t) * 64), r2 = *(const f32x2_*)(bf_ + (4 * TB + t) * 64);
                const float vv = bufs[(blk & 1) * BUFF + 5 * TB * 64 + vrow * TB + t];
                float dot = s0 * kk2.x + s1 * kk2.y;
                const float t0 = s0 * w2.x + vv * kd2.x, t1 = s1 * w2.y + vv * kd2.y;
                dot = row16_sum(dot);
                { const unsigned xu = __float_as_uint(dot); const auto sw = __builtin_amdgcn_permlane16_swap(xu, xu, false, false); dot = __uint_as_float(sw[0]) + __uint_as_float(sw[1]); }
                s0 = t0 - dot * ka2.x; s1 = t1 - dot * ka2.y;
                float y = s0 * r2.x + s1 * r2.y;
                y = row16_sum(y);
                { const unsigned xu = __float_as_uint(y); const auto sw = __builtin_amdgcn_permlane16_swap(xu, xu, false, false); y = __uint_as_float(sw[0]) + __uint_as_float(sw[1]); }
                yreg = kp == t ? y : yreg;
            }
            if (kp < TB) ybuf[(blk & 1) * 8 * TB + vrow * TB + kp] = yreg;
        }
        __syncthreads();
    }
    if (loader) SCAN_FLUSH(NBLK - 1);
    __syncthreads();
#undef SCAN_STAGE
#undef SCAN_FLUSH
}

__device__ __forceinline__ void phase_7(CParams& P, unsigned char* lds, const int ph) {
    PHASE_PROLOGUE
            for (int row = gw; row < NT; row += NGW) {
                const int c0 = lane * 8;
                const u32x4 yf = *(const u32x4*)(YFB + (size_t)row * 512 + c0);
                const u32x4 yb = *(const u32x4*)(YFB + ((size_t)NT + row) * 512 + c0);
                const u32x4 vv = *(const u32x4*)(VV + (size_t)row * 512 + c0);
                const u32x4 gg = *(const u32x4*)(Gg + (size_t)row * 512 + c0);
                float y[8], v[8], g[8];
#pragma unroll
                for (int i = 0; i < 4; ++i) { y[2 * i] = bflo(yf[i]) + bflo(yb[i]); y[2 * i + 1] = bfhi(yf[i]) + bfhi(yb[i]); v[2 * i] = bflo(vv[i]); v[2 * i + 1] = bfhi(vv[i]); g[2 * i] = bflo(gg[i]); g[2 * i + 1] = bfhi(gg[i]); }
                float sm = 0.f;
#pragma unroll
                for (int i = 0; i < 8; ++i) sm += y[i];
                sm += __shfl_xor(sm, 1); sm += __shfl_xor(sm, 2); sm += __shfl_xor(sm, 4);
                const float mean = sm * (1.f / 64.f);
                float vr = 0.f;
#pragma unroll
                for (int i = 0; i < 8; ++i) { const float dlt = y[i] - mean; vr += dlt * dlt; }
                vr += __shfl_xor(vr, 1); vr += __shfl_xor(vr, 2); vr += __shfl_xor(vr, 4);
                const float rstd = rsqrtf(vr * (1.f / 64.f) + 64e-5f);
                const float bc = BC[(size_t)row * 8 + (lane >> 3)];
                float o[8];
#pragma unroll
                for (int i = 0; i < 8; ++i) o[i] = ((y[i] - mean) * rstd * lnx_g[c0 + i] + lnx_b[c0 + i] + bc * v[i]) * g[i];
                u32x4 ov; ov.x = pk2(o[0], o[1]); ov.y = pk2(o[2], o[3]); ov.z = pk2(o[4], o[5]); ov.w = pk2(o[6], o[7]);
                *(u32x4*)(A2 + (size_t)row * DM + 512 + c0) = ov;
            }
}


__device__ __forceinline__ void phase_8(CParams& P, unsigned char* lds, const int ph) {
    PHASE_PROLOGUE
    if (gw < 64) meta_gemm<0>(A2 + (size_t)NMAIN * DM, WTOUT, H + (size_t)NMAIN * DM, gw, lane);
    pg8::DenseOrder S; S.init(A2, WTOUT, NMAIN, DM, DM, G, bid);
    pg8::EpiResidual E{H};
    pg8::gemm_phase<pg8::EpiResidual, pg8::DenseOrder, true, true>((PG8_LAS unsigned char*)lds, DM, S, E);
}

__device__ __forceinline__ void phase_9(CParams& P, unsigned char* lds, const int ph) {
    PHASE_PROLOGUE
            const int l = ph == 9 ? 0 : 1;
                    unsigned* cnt = CTL + CW_CNT(l);
            const float* wg = moe_wg + (size_t)l * DM * 4; const float* bg = moe_bg + l * 4;
            for (int row = gw; row < NT; row += NGW) {
                f32x4 v[4]; float ss = 0.f;
#pragma unroll
                for (int j = 0; j < 4; ++j) { v[j] = ((const f32x4*)(H + (size_t)row * DM))[lane + 64 * j]; ss += v[j][0] * v[j][0] + v[j][1] * v[j][1] + v[j][2] * v[j][2] + v[j][3] * v[j][3]; }
                ss = wave_sum(ss);
                const float rstd = rsqrtf(ss * (1.f / DM) + 1e-6f);
                float lg[4] = {0.f, 0.f, 0.f, 0.f};
#pragma unroll
                for (int j = 0; j < 4; ++j) {
                    const f32x4 g = ((const f32x4*)(norm_ffn + l * DM))[lane + 64 * j];
#pragma unroll
                    for (int i = 0; i < 4; ++i) v[j][i] = v[j][i] * rstd * g[i];
                    u32x2 o; o.x = pk2(v[j][0], v[j][1]); o.y = pk2(v[j][2], v[j][3]);
                    ((u32x2*)(HN + (size_t)row * DM))[lane + 64 * j] = o;
#pragma unroll
                    for (int i = 0; i < 4; ++i) { const f32x4 w = *(const f32x4*)(wg + (size_t)(4 * (lane + 64 * j) + i) * 4);
                        lg[0] += v[j][i] * w[0]; lg[1] += v[j][i] * w[1]; lg[2] += v[j][i] * w[2]; lg[3] += v[j][i] * w[3]; }
                }
#pragma unroll
                for (int q = 0; q < 4; ++q) lg[q] = wave_sum(lg[q]) + bg[q];
                int grp = 0; float mx = lg[0];
#pragma unroll
                for (int q = 1; q < 4; ++q) if (lg[q] > mx) { mx = lg[q]; grp = q; }
                float den = 0.f;
#pragma unroll
                for (int q = 0; q < 4; ++q) den += __expf(lg[q] - mx);
                const float pgrp = 1.f / den;
                const float* we = moe_we + ((size_t)(l * 4 + grp) * DM) * 8;
                float le[8] = {0.f, 0.f, 0.f, 0.f, 0.f, 0.f, 0.f, 0.f};
#pragma unroll
                for (int j = 0; j < 4; ++j)
#pragma unroll
                    for (int i = 0; i < 4; ++i) { const float* wr_ = we + (size_t)(4 * (lane + 64 * j) + i) * 8; const f32x4 wa = *(const f32x4*)wr_, wb = *(const f32x4*)(wr_ + 4);
                        le[0] += v[j][i] * wa[0]; le[1] += v[j][i] * wa[1]; le[2] += v[j][i] * wa[2]; le[3] += v[j][i] * wa[3];
                        le[4] += v[j][i] * wb[0]; le[5] += v[j][i] * wb[1]; le[6] += v[j][i] * wb[2]; le[7] += v[j][i] * wb[3]; }
#pragma unroll
                for (int q = 0; q < 8; ++q) le[q] = wave_sum(le[q]) + moe_be[(l * 4 + grp) * 8 + q];
                int i1 = 0; float m1 = le[0];
#pragma unroll
                for (int q = 1; q < 8; ++q) if (le[q] > m1) { m1 = le[q]; i1 = q; }
                int i2 = -1; float m2 = -3.0e38f;
#pragma unroll
                for (int q = 0; q < 8; ++q) if (q != i1 && le[q] > m2) { m2 = le[q]; i2 = q; }
                const float e2 = __expf(m2 - m1);
                const float g1 = pgrp / (1.f + e2), g2 = pgrp * e2 / (1.f + e2);
                if (lane == 0) {
                    const int ea = grp * 8 + i1, eb = grp * 8 + i2;
                    const unsigned pa = atomicAdd(cnt + ea, 1u), pb = atomicAdd(cnt + eb, 1u);
                    EID[row * 2] = ea; EID[row * 2 + 1] = eb; POS[row * 2] = (int)pa; POS[row * 2 + 1] = (int)pb;
                    GATE[row * 2] = g1; GATE[row * 2 + 1] = g2;
                }
            }
}


__device__ __forceinline__ void phase_10(CParams& P, unsigned char* lds, const int ph) {
    PHASE_PROLOGUE
    const int l = ph == 10 ? 0 : 1;
    int* ps = (int*)(lds + LDS_TAB);
    if (tid == 0) { int acc_ = 0; for (int e = 0; e < NEXP; ++e) { ps[e] = acc_; const int c = (int)CTL[CW_CNT(l) + e]; acc_ += (c + MOE_RT - 1) / MOE_RT * MOE_RT; } ps[NEXP] = acc_; }
    __syncthreads();
    for (int row = gw; row < NT; row += NGW) {
        const u32x4 v0 = ((const u32x4*)(HN + (size_t)row * DM))[lane], v1 = ((const u32x4*)(HN + (size_t)row * DM))[lane + 64];
#pragma unroll
        for (int k = 0; k < 2; ++k) {
            const int dest = ps[EID[row * 2 + k]] + POS[row * 2 + k];
            if (lane == 0) DEST[row * 2 + k] = dest;
            ((u32x4*)(XB + (size_t)dest * DM))[lane] = v0; ((u32x4*)(XB + (size_t)dest * DM))[lane + 64] = v1;
        }
    }
    __syncthreads();
}

__device__ __forceinline__ void phase_11(CParams& P, unsigned char* lds, const int ph) {
    PHASE_PROLOGUE
    const int l = ph == 11 ? 0 : 1;
    int* et = (int*)(lds + LDS_TAB);
    if (tid == 0) { int acc_ = 0; for (int e = 0; e < NEXP; ++e) { const int c = (int)CTL[CW_CNT(l) + e], n = (c + MOE_RT - 1) / MOE_RT; for (int q = 0; q < n; ++q) et[1 + acc_ + q] = e; acc_ += n; } et[0] = acc_; }
    __syncthreads();
    pg8::MoeOrder S{et + 1, et[0], vcu, (const char*)XB, (const char*)WT13, 256u * DM * 2u, 256u * DM * 2u, (unsigned)DM * DM * 2u};
    pg8::EpiSwiglu E{HB};
    pg8::gemm_phase<pg8::EpiSwiglu, pg8::MoeOrder, true, true>((PG8_LAS unsigned char*)lds, DM, S, E);
    __syncthreads();
}

__device__ __forceinline__ void phase_12(CParams& P, unsigned char* lds, const int ph) {
    PHASE_PROLOGUE
    const int l = ph == 12 ? 0 : 1;
    int* et = (int*)(lds + LDS_TAB);
    if (tid == 0) { int acc_ = 0; for (int e = 0; e < NEXP; ++e) { const int c = (int)CTL[CW_CNT(l) + e], n = (c + MOE_RT - 1) / MOE_RT; for (int q = 0; q < n; ++q) et[1 + acc_ + q] = e; acc_ += n; } et[0] = acc_; }
    __syncthreads();
    pg8::MoeOrder S{et + 1, et[0], vcu, (const char*)HB, (const char*)WT2, 256u * DFF * 2u, 256u * DFF * 2u, (unsigned)DM * DFF * 2u};
    pg8::EpiBf16Plain E{YB, DM};
    pg8::gemm_phase<pg8::EpiBf16Plain, pg8::MoeOrder, true, true>((PG8_LAS unsigned char*)lds, DFF, S, E);
    __syncthreads();
}

__device__ __forceinline__ void phase_13(CParams& P, unsigned char* lds, const int ph) {
    PHASE_PROLOGUE
            const bool fin = ph == 21;
            for (int row = gw; row < NT; row += NGW) {
                const int d0 = DEST[row * 2], d1 = DEST[row * 2 + 1];
                const float g0 = GATE[row * 2], g1 = GATE[row * 2 + 1];
                f32x4 v[4];
#pragma unroll
                for (int j = 0; j < 4; ++j) {
                    v[j] = ((const f32x4*)(H + (size_t)row * DM))[lane + 64 * j];
                    const u32x2 ya = ((const u32x2*)(YB + (size_t)d0 * DM))[lane + 64 * j];
                    const u32x2 yb = ((const u32x2*)(YB + (size_t)d1 * DM))[lane + 64 * j];
                    v[j][0] += g0 * bflo(ya.x) + g1 * bflo(yb.x); v[j][1] += g0 * bfhi(ya.x) + g1 * bfhi(yb.x);
                    v[j][2] += g0 * bflo(ya.y) + g1 * bflo(yb.y); v[j][3] += g0 * bfhi(ya.y) + g1 * bfhi(yb.y);
                }
                if (!fin) {
#pragma unroll
                    for (int j = 0; j < 4; ++j) ((f32x4*)(H + (size_t)row * DM))[lane + 64 * j] = v[j];
                    store_norm_bf16(v, norm_mix + DM, HN + (size_t)row * DM, lane);
                } else if (row < NMAIN) {
                    float ss = 0.f;
#pragma unroll
                    for (int j = 0; j < 4; ++j) ss += v[j][0] * v[j][0] + v[j][1] * v[j][1] + v[j][2] * v[j][2] + v[j][3] * v[j][3];
                    ss = wave_sum(ss);
                    const float rstd = rsqrtf(ss * (1.f / DM) + 1e-6f);
#pragma unroll
                    for (int j = 0; j < 4; ++j) { const f32x4 g = ((const f32x4*)norm_final)[lane + 64 * j]; f32x4 o;
                        o[0] = v[j][0] * rstd * g[0]; o[1] = v[j][1] * rstd * g[1]; o[2] = v[j][2] * rstd * g[2]; o[3] = v[j][3] * rstd * g[3];
                        ((f32x4*)(P.out + (size_t)row * DM))[lane + 64 * j] = o; }
                }
            }
    if (!fin) { for (int it = gw; it < CONV_MOE_ITEMS; it += NGW) conv_moe_item(P, 1, it, lane); }
}

__device__ __forceinline__ void phase_14(CParams& P, unsigned char* lds, const int ph) {
    PHASE_PROLOGUE
    float* pwr = (float*)lds; float* pwi = pwr + 2176; float* bbr = pwi + 2176; float* bbi = bbr + 2048; float* ccr = bbi + 2048; float* cci = ccr + 2048; float* kf = cci + 2048; float* kb = kf + 4096;
    for (int g = bid; g < 64; g += G) {
        if (tid < 128) {
            const int d = tid >> 6, p = tid & 63;
            const float step = __expf(s5_ls[d * 64 + g]);
            const float lr = s5_lre[(d * 64 + g) * 64 + p], li = s5_lim[(d * 64 + g) * 64 + p];
            const float mag = expf(lr * step);
            const float abr = mag * cosf(li * step), abi = mag * sinf(li * step);
            const float den = lr * lr + li * li;
            const float zr = ((abr - 1.f) * lr + abi * li) / den, zi = (abi * lr - (abr - 1.f) * li) / den;
            float pr = 1.f, pi = 0.f;
            for (int t = 0; t < 17; ++t) { pwr[(d * 64 + p) * 17 + t] = pr; pwi[(d * 64 + p) * 17 + t] = pi; const float nr = pr * abr - pi * abi; pi = pr * abi + pi * abr; pr = nr; }
            for (int i = 0; i < 16; ++i) { const float br = s5_b_re[((size_t)(g * 64 + p)) * 16 + i], bi = s5_b_im[((size_t)(g * 64 + p)) * 16 + i];
                bbr[(d * 64 + p) * 16 + i] = zr * br - zi * bi; bbi[(d * 64 + p) * 16 + i] = zr * bi + zi * br; }
        }
        for (int idx = tid; idx < 2048; idx += 512) { const int d = idx >> 10, i = (idx >> 6) & 15, p = idx & 63;
            ccr[idx] = s5_c_re[((size_t)(d * 64 + g) * 16 + i) * 64 + p]; cci[idx] = s5_c_im[((size_t)(d * 64 + g) * 16 + i) * 64 + p]; }
        __syncthreads();
        {
            const int d = tid >> 8, tau = (tid >> 4) & 15, i = tid & 15;
            float acc[16];
#pragma unroll
            for (int q = 0; q < 16; ++q) acc[q] = 0.f;
            for (int p = 0; p < 64; ++p) {
                const float cr = ccr[(d * 16 + i) * 64 + p], ci = cci[(d * 16 + i) * 64 + p], pr = pwr[(d * 64 + p) * 17 + tau], pi = pwi[(d * 64 + p) * 17 + tau];
                const float xr = cr * pr - ci * pi, xi = cr * pi + ci * pr;
#pragma unroll
                for (int q = 0; q < 16; ++q) acc[q] += xr * bbr[(d * 64 + p) * 16 + q] - xi * bbi[(d * 64 + p) * 16 + q];
            }
            float* kt = (d ? kb : kf) + (tau * 16 + i) * 16;
#pragma unroll
            for (int q = 0; q < 16; ++q) kt[q] = acc[q];
        }
        __syncthreads();
        unsigned* bta = (unsigned*)(BTA + (size_t)g * 512 * 256);
        for (int idx = tid; idx < 512 * 128; idx += 512) {
            const int row = idx >> 7, col = (idx & 127) * 2;
            float v[2];
#pragma unroll
            for (int e = 0; e < 2; ++e) {
                const int cc_ = col + e, j = cc_ >> 4, ip = cc_ & 15;
                if (row < 256) { const int t = row >> 4, i = row & 15;
                    v[e] = j < t ? kf[((t - j) * 16 + i) * 16 + ip] : (j > t ? kb[((j - t) * 16 + i) * 16 + ip] : kf[i * 16 + ip] + kb[i * 16 + ip]); }
                else { const int kp = row - 256, d = kp >> 7, part = (kp >> 6) & 1, p = kp & 63, tau = d == 0 ? 15 - j : j;
                    const float pr = pwr[(d * 64 + p) * 17 + tau], pi = pwi[(d * 64 + p) * 17 + tau], br = bbr[(d * 64 + p) * 16 + ip], bi = bbi[(d * 64 + p) * 16 + ip];
                    v[e] = part ? pr * bi + pi * br : pr * br - pi * bi; }
            }
            bta[idx] = pk2(v[0], v[1]);
        }
        unsigned* btc = (unsigned*)(BTC + (size_t)g * 256 * 256);
        for (int idx = tid; idx < 256 * 128; idx += 512) {
            const int row = idx >> 7, col = (idx & 127) * 2, t = row >> 4, i = row & 15;
            float v[2];
#pragma unroll
            for (int e = 0; e < 2; ++e) {
                const int k = col + e, d = k >> 7, part = (k >> 6) & 1, p = k & 63, tau = d == 0 ? t + 1 : 16 - t;
                const float cr = ccr[(d * 16 + i) * 64 + p], ci = cci[(d * 16 + i) * 64 + p], pr = pwr[(d * 64 + p) * 17 + tau], pi = pwi[(d * 64 + p) * 17 + tau];
                v[e] = part ? -(cr * pi + ci * pr) : cr * pr - ci * pi;
            }
            btc[idx] = pk2(v[0], v[1]);
        }
        __syncthreads();
    }
}

__device__ __forceinline__ void phase_15(CParams& P, unsigned char* lds, const int ph) {
    PHASE_PROLOGUE
    pg8::S5OrderA S{vcu, (const char*)HN, (const char*)BTA};
    pg8::EpiS5A E{YI, S5E};
    int Kr = 256; asm volatile("" : "+s"(Kr));
    pg8::gemm_phase<pg8::EpiS5A, pg8::S5OrderA, true, true>((PG8_LAS unsigned char*)lds, Kr, S, E);
}

__device__ __forceinline__ void phase_16(CParams& P, unsigned char* lds, const int ph) {
    PHASE_PROLOGUE
    for (int i = bid * 512 + tid; i < NB * 64 * 2 * 64; i += G * 512) {
        const int p = i & 63, d = (i >> 6) & 1, g = (i >> 7) & 63, b = i >> 13;
        const float step = __expf(s5_ls[d * 64 + g]);
        const float lr = s5_lre[(d * 64 + g) * 64 + p], li = s5_lim[(d * 64 + g) * 64 + p];
        const float mag = expf(lr * step);
        const float abr = mag * cosf(li * step), abi = mag * sinf(li * step);
        float ar = 1.f, ai = 0.f;
        for (int t = 0; t < 16; ++t) { const float nr = ar * abr - ai * abi; ai = ar * abi + ai * abr; ar = nr; }
        const float* Ep = S5E + (size_t)g * 256 + d * 128 + p;
        bf16_t* Cp = CAR + (size_t)g * 1280 * 256 + d * 128 + p;
        float sr = 0.f, si = 0.f;
        for (int q0 = 0; q0 < 513; q0 += 9) {
            float er[9], ei[9]; int nn[9];
#pragma unroll
            for (int k = 0; k < 9; ++k) { const int q = q0 + k, c = d ? 512 - q : q; nn[k] = c == 0 ? 1024 + b : b * 512 + c - 1; er[k] = Ep[(size_t)nn[k] * 64 * 256]; ei[k] = Ep[(size_t)nn[k] * 64 * 256 + 64]; }
#pragma unroll
            for (int k = 0; k < 9; ++k) { Cp[(size_t)nn[k] * 256] = (bf16_t)f2bf(sr); Cp[(size_t)nn[k] * 256 + 64] = (bf16_t)f2bf(si);
                const float nr = ar * sr - ai * si + er[k]; si = ar * si + ai * sr + ei[k]; sr = nr; }
        }
    }
}

__device__ __forceinline__ void phase_22(CParams& P, unsigned char* lds, const int ph) {
    PHASE_PROLOGUE
    pg8::S5OrderC S{vcu, (const char*)CAR, (const char*)BTC};
    pg8::EpiS5C E{YI, HN, s5_d, A2};
    int Kr = 256; asm volatile("" : "+s"(Kr));
    pg8::gemm_phase<pg8::EpiS5C, pg8::S5OrderC, true, true>((PG8_LAS unsigned char*)lds, Kr, S, E);
}

__device__ __forceinline__ void phase_23(CParams& P, unsigned char* lds, const int ph) {
    PHASE_PROLOGUE
    if (gw < 64) meta_gemm<1>(A2 + (size_t)NMAIN * DM, WTGLU, H + (size_t)NMAIN * DM, gw, lane);
    pg8::DenseOrder S; S.init(A2, WTGLU, NMAIN, 2 * DM, DM, G, bid);
    pg8::EpiGlu E{H};
    pg8::gemm_phase<pg8::EpiGlu, pg8::DenseOrder, true, true>((PG8_LAS unsigned char*)lds, DM, S, E);
}
#define LAS __attribute__((address_space(3)))
#define CW_BAR 4096
#define XB_TMO      128
#define XB_XCNT(j)  (256  + 64 * (j))
#define XB_XSUB(j)  (1280 + 64 * (j))
#define XB_XGEN(j)  (2304 + 64 * (j))
#define XB_TOP      3328
#define XB_TOPGEN   3392
#define XCD_BAR_WORDS 3456
#define XB_SPIN_CAP (1u << 22)
__device__ __forceinline__ unsigned xb_ld(unsigned* p)              { return __hip_atomic_load(p, __ATOMIC_RELAXED, __HIP_MEMORY_SCOPE_AGENT); }
__device__ __forceinline__ unsigned xb_add(unsigned* p, unsigned v) { return __hip_atomic_fetch_add(p, v, __ATOMIC_RELAXED, __HIP_MEMORY_SCOPE_AGENT); }
__device__ __forceinline__ unsigned xb_xcc_id() { return (unsigned)__builtin_amdgcn_s_getreg((3 << 11) | 20) & 0xFu; }
#define XB_SPIN(cond, bar) do { unsigned _sp = 0; while (cond) { __builtin_amdgcn_s_sleep(1); \
    if ((++_sp & 255u) == 0u) { if (xb_ld(&(bar)[XB_TMO])) break; if (_sp > XB_SPIN_CAP) { atomicAdd(&(bar)[XB_TMO], 1u); break; } } } } while (0)
struct XcdBarrier { unsigned* bar; unsigned x; volatile LAS unsigned* st; };
__device__ __forceinline__ XcdBarrier xcd_barrier_post(unsigned* bar, volatile LAS unsigned* st) {
    XcdBarrier b; b.bar = bar; b.x = xb_xcc_id(); b.st = st;
    if (threadIdx.x == 0) (void)xb_add(&bar[XB_XCNT(b.x)], 1u);
    return b;
}
__device__ __forceinline__ void xcd_barrier_complete(unsigned* bar, unsigned x, unsigned& nloc, unsigned& nx) {
    const unsigned G = GRID;
    unsigned sum, cnt, mine, sp = 0u;
    for (;;) {
        sum = 0u; cnt = 0u; mine = 0u;
#pragma unroll
        for (unsigned j = 0; j < 16; ++j) { const unsigned c = xb_ld(&bar[XB_XCNT(j)]); sum += c; cnt += (c > 0u) ? 1u : 0u; mine = (j == x) ? c : mine; }
        if (sum == G) break;
        __builtin_amdgcn_s_sleep(1);
        if ((++sp & 255u) == 0u) { if (xb_ld(&bar[XB_TMO])) break; if (sp > XB_SPIN_CAP) { atomicAdd(&bar[XB_TMO], 1u); break; } }
    }
    nloc = mine > 0u ? mine : 1u; nx = cnt > 0u ? cnt : 1u;
}
__device__ __forceinline__ void xcd_barrier(const XcdBarrier& b) {
    asm volatile("s_waitcnt vmcnt(0)" ::: "memory");
    __syncthreads();
    if (threadIdx.x == 0) {
        unsigned* bar = b.bar;
        __builtin_amdgcn_s_waitcnt(0);
        unsigned nloc = b.st[0], nx = b.st[1];
        if (nloc == 0u) { xcd_barrier_complete(bar, b.x, nloc, nx); b.st[0] = nloc; b.st[1] = nx; }
        const unsigned old = xb_add(&bar[XB_XSUB(b.x)], 1u);
        const unsigned gen = old / nloc;
        if (old + 1u == (gen + 1u) * nloc) {
            __builtin_amdgcn_fence(__ATOMIC_RELEASE, "agent");
            asm volatile("s_waitcnt vmcnt(0)" ::: "memory");
            const unsigned og = xb_add(&bar[XB_TOP], 1u);
            const unsigned tg = og / nx;
            if (og + 1u == (tg + 1u) * nx) xb_add(&bar[XB_TOPGEN], 1u);
            else XB_SPIN(xb_ld(&bar[XB_TOPGEN]) == tg, bar);
            __builtin_amdgcn_fence(__ATOMIC_ACQUIRE, "agent");
            xb_add(&bar[XB_XGEN(b.x)], 1u);
            asm volatile("s_waitcnt vmcnt(0)" ::: "memory");
        } else {
            XB_SPIN(xb_ld(&bar[XB_XGEN(b.x)]) == gen, bar);
            __builtin_amdgcn_fence(__ATOMIC_ACQUIRE, "agent");
            asm volatile("s_waitcnt vmcnt(0)" ::: "memory");
        }
    }
    __syncthreads();
}


__global__ void __launch_bounds__(512, 2) mega(Params P_) {
    extern __shared__ __attribute__((aligned(16))) unsigned char lds[];
    volatile LAS unsigned* st = (volatile LAS unsigned*)(LAS unsigned char*)(lds + LDS_BARST);
    if (threadIdx.x < 16) st[threadIdx.x] = 0u;
    __syncthreads();
    CParams* pp = (CParams*)__builtin_amdgcn_kernarg_segment_ptr();
    (void)xcd_barrier_post((unsigned*)(pp->ws + WS_CTL) + CW_BAR, st);
#define GB do { XcdBarrier bar_; bar_.bar = (unsigned*)(pp->ws + WS_CTL) + CW_BAR; bar_.x = xb_xcc_id(); bar_.st = (volatile LAS unsigned*)(LAS unsigned char*)(lds + LDS_BARST); xcd_barrier(bar_); asm volatile("" : "+s"(pp)); } while (0)
#define P (*pp)
    asm volatile("" : "+s"(pp));
    phase_0(P, lds, 0); GB;
#if defined(PROBE_PH) && PROBE_PH == 0
    { int nrep = PROBE_N; asm volatile("" : "+s"(nrep)); for (int rep = 0; rep < nrep; ++rep) { GB; phase_0(P, lds, 0); GB; } }
#endif
    phase_1(P, lds, 1); GB;
#if defined(PROBE_PH) && PROBE_PH == 1
    { int nrep = PROBE_N; asm volatile("" : "+s"(nrep)); for (int rep = 0; rep < nrep; ++rep) { GB; phase_1(P, lds, 1); GB; } }
#endif
    phase_2(P, lds, 2); asm volatile("" : "+s"(pp));
#if defined(PROBE_PH) && PROBE_PH == 2
    { int nrep = PROBE_N; asm volatile("" : "+s"(nrep)); for (int rep = 0; rep < nrep; ++rep) { GB; phase_2(P, lds, 2); GB; } }
#endif
    phase_3(P, lds, 3); GB;
#if defined(PROBE_PH) && PROBE_PH == 3
    { int nrep = PROBE_N; asm volatile("" : "+s"(nrep)); for (int rep = 0; rep < nrep; ++rep) { GB; phase_3(P, lds, 3); GB; } }
#endif
    phase_4(P, lds, 4); GB;
#if defined(PROBE_PH) && PROBE_PH == 4
    { int nrep = PROBE_N; asm volatile("" : "+s"(nrep)); for (int rep = 0; rep < nrep; ++rep) { GB; phase_4(P, lds, 4); GB; } }
#endif
    phase_5(P, lds, 5); GB;
#if defined(PROBE_PH) && PROBE_PH == 5
    { int nrep = PROBE_N; asm volatile("" : "+s"(nrep)); for (int rep = 0; rep < nrep; ++rep) { GB; phase_5(P, lds, 5); GB; } }
#endif
    phase_6(P, lds, 6); GB;
#if defined(PROBE_PH) && PROBE_PH == 6
    { int nrep = PROBE_N; asm volatile("" : "+s"(nrep)); for (int rep = 0; rep < nrep; ++rep) { GB; phase_6(P, lds, 6); GB; } }
#endif
    phase_7(P, lds, 7); GB;
#if defined(PROBE_PH) && PROBE_PH == 7
    { int nrep = PROBE_N; asm volatile("" : "+s"(nrep)); for (int rep = 0; rep < nrep; ++rep) { GB; phase_7(P, lds, 7); GB; } }
#endif
    phase_8(P, lds, 8); GB;
#if defined(PROBE_PH) && PROBE_PH == 8
    { int nrep = PROBE_N; asm volatile("" : "+s"(nrep)); for (int rep = 0; rep < nrep; ++rep) { GB; phase_8(P, lds, 8); GB; } }
#endif
    phase_9(P, lds, 9); GB;
#if defined(PROBE_PH) && PROBE_PH == 9
    { int nrep = PROBE_N; asm volatile("" : "+s"(nrep)); for (int rep = 0; rep < nrep; ++rep) { GB; phase_9(P, lds, 9); GB; } }
#endif
    phase_10(P, lds, 10); GB;
#if defined(PROBE_PH) && PROBE_PH == 10
    { int nrep = PROBE_N; asm volatile("" : "+s"(nrep)); for (int rep = 0; rep < nrep; ++rep) { GB; phase_10(P, lds, 10); GB; } }
#endif
    phase_11(P, lds, 11); GB;
#if defined(PROBE_PH) && PROBE_PH == 11
    { int nrep = PROBE_N; asm volatile("" : "+s"(nrep)); for (int rep = 0; rep < nrep; ++rep) { GB; phase_11(P, lds, 11); GB; } }
#endif
    phase_12(P, lds, 12); GB;
#if defined(PROBE_PH) && PROBE_PH == 12
    { int nrep = PROBE_N; asm volatile("" : "+s"(nrep)); for (int rep = 0; rep < nrep; ++rep) { GB; phase_12(P, lds, 12); GB; } }
#endif
    phase_13(P, lds, 13); GB;
#if defined(PROBE_PH) && PROBE_PH == 13
    { int nrep = PROBE_N; asm volatile("" : "+s"(nrep)); for (int rep = 0; rep < nrep; ++rep) { GB; phase_13(P, lds, 13); GB; } }
#endif
    phase_14(P, lds, 14); GB;
#if defined(PROBE_PH) && PROBE_PH == 14
    { int nrep = PROBE_N; asm volatile("" : "+s"(nrep)); for (int rep = 0; rep < nrep; ++rep) { GB; phase_14(P, lds, 14); GB; } }
#endif
    phase_15(P, lds, 15); GB;
#if defined(PROBE_PH) && PROBE_PH == 15
    { int nrep = PROBE_N; asm volatile("" : "+s"(nrep)); for (int rep = 0; rep < nrep; ++rep) { GB; phase_15(P, lds, 15); GB; } }
#endif
    phase_16(P, lds, 16); GB;
#if defined(PROBE_PH) && PROBE_PH == 16
    { int nrep = PROBE_N; asm volatile("" : "+s"(nrep)); for (int rep = 0; rep < nrep; ++rep) { GB; phase_16(P, lds, 16); GB; } }
#endif
    phase_22(P, lds, 22); GB;
#if defined(PROBE_PH) && PROBE_PH == 22
    { int nrep = PROBE_N; asm volatile("" : "+s"(nrep)); for (int rep = 0; rep < nrep; ++rep) { GB; phase_22(P, lds, 22); GB; } }
#endif
    phase_23(P, lds, 23); GB;
#if defined(PROBE_PH) && PROBE_PH == 23
    { int nrep = PROBE_N; asm volatile("" : "+s"(nrep)); for (int rep = 0; rep < nrep; ++rep) { GB; phase_23(P, lds, 23); GB; } }
#endif
    phase_9(P, lds, 17); GB;
#if defined(PROBE_PH) && PROBE_PH == 17
    { int nrep = PROBE_N; asm volatile("" : "+s"(nrep)); for (int rep = 0; rep < nrep; ++rep) { GB; phase_9(P, lds, 17); GB; } }
#endif
    phase_10(P, lds, 18); GB;
#if defined(PROBE_PH) && PROBE_PH == 18
    { int nrep = PROBE_N; asm volatile("" : "+s"(nrep)); for (int rep = 0; rep < nrep; ++rep) { GB; phase_10(P, lds, 18); GB; } }
#endif
    phase_11(P, lds, 19); GB;
#if defined(PROBE_PH) && PROBE_PH == 19
    { int nrep = PROBE_N; asm volatile("" : "+s"(nrep)); for (int rep = 0; rep < nrep; ++rep) { GB; phase_11(P, lds, 19); GB; } }
#endif
    phase_12(P, lds, 20); GB;
#if defined(PROBE_PH) && PROBE_PH == 20
    { int nrep = PROBE_N; asm volatile("" : "+s"(nrep)); for (int rep = 0; rep < nrep; ++rep) { GB; phase_12(P, lds, 20); GB; } }
#endif
    phase_13(P, lds, 21);
#if defined(PROBE_PH) && PROBE_PH == 21
    { int nrep = PROBE_N; asm volatile("" : "+s"(nrep)); for (int rep = 0; rep < nrep; ++rep) { GB; phase_13(P, lds, 21); GB; } }
#endif
#undef P
#undef GB
}

extern "C" void kernel_launch(void* const* d_in, const int* in_sizes, int n_in, void* d_out, int out_size, void* d_ws, size_t ws_size, hipStream_t stream) {
    static int ready = 0;
    if (!ready) {
        if (n_in != 35 || ws_size < WS_TOTAL) { fprintf(stderr, "kernel_launch: unexpected n_in %d or ws_size %zu (need %zu)\n", n_in, ws_size, (size_t)WS_TOTAL); ready = -1; return; }
        if (hipFuncSetAttribute((const void*)mega, hipFuncAttributeMaxDynamicSharedMemorySize, LDS_BYTES) != hipSuccess) { fprintf(stderr, "kernel_launch: hipFuncSetAttribute failed\n"); ready = -1; return; }
        ready = 1;
    }
    if (ready < 0) return;
    (void)hipMemsetAsync((char*)d_ws + WS_CTL, 0, 1 * MiB, stream);
    Params P{};
    for (int i = 0; i < 35; ++i) P.in[i] = (const float*)d_in[i];
    P.out = (float*)d_out; P.ws = (unsigned char*)d_ws; P.ph_lo = 0; P.ph_hi = 0;
    hipLaunchKernelGGL(mega, dim3(GRID), dim3(512), LDS_BYTES, stream, P);
}
```

```cpp
#include <hip/hip_runtime.h>
#include <stdint.h>
#include <stdio.h>

#define DM 1024
#define NB 2
#define SEQ 8192
#define NMETA 16
#define LSEQ (SEQ + NMETA)
#define NMAIN (NB * SEQ)
#define NT (NB * LSEQ)
#define NTP 16640
#define INCOLS 3328
#define RESTC 1792
#define NEXP 32
#define DFF 512
#define S5TC 48
#define S5NC 171
#define MOE_RT 256
#define MOE_MAXROWS 41216

typedef unsigned short bf16_t;
typedef short bf16x8 __attribute__((ext_vector_type(8)));
typedef float f32x4 __attribute__((ext_vector_type(4)));
typedef unsigned u32x4 __attribute__((ext_vector_type(4)));
typedef unsigned u32x2 __attribute__((ext_vector_type(2)));

constexpr size_t MiB = 1u << 20;
constexpr size_t al64k(size_t x) { return (x + 65535) & ~(size_t)65535; }
constexpr size_t WS_CTL = 0;
constexpr size_t WS_H = 1 * MiB;
constexpr size_t WS_HN = WS_H + al64k((size_t)NT * DM * 4);
constexpr size_t WS_A2 = WS_HN + al64k((size_t)NTP * DM * 2);
constexpr size_t WS_WTIN = WS_A2 + al64k((size_t)NTP * DM * 2);
constexpr size_t WS_WTOUT = WS_WTIN + al64k((size_t)INCOLS * DM * 2);
constexpr size_t WS_WTGLU = WS_WTOUT + al64k((size_t)DM * DM * 2);
constexpr size_t WS_BIG = WS_WTGLU + al64k((size_t)2 * DM * DM * 2);
constexpr size_t SZ_T512 = al64k((size_t)NT * 512 * 2);
constexpr size_t SZ_P512 = al64k((size_t)NTP * 512 * 2);
constexpr int RW_NCH = 129, RW_UNITS = 32 * RW_NCH;
constexpr size_t SZ_RWOP = al64k((size_t)RW_UNITS * 4096 * 2);
constexpr size_t WS_Q = WS_BIG;
constexpr size_t WS_K = WS_Q + SZ_P512;
constexpr size_t WS_V = WS_K + SZ_P512;
constexpr size_t WS_REST = WS_V + SZ_P512;
constexpr size_t WS_KR = WS_REST + al64k((size_t)NTP * RESTC * 2);
constexpr size_t WS_LOW = WS_KR + SZ_T512;
constexpr size_t WS_AA = WS_LOW + al64k((size_t)NT * 256 * 2);
constexpr size_t WS_XEND = WS_AA + 2 * SZ_T512;
constexpr size_t WS_PP = WS_BIG;
constexpr size_t WS_QT = WS_PP + SZ_RWOP;
constexpr size_t WS_YT = WS_QT + SZ_RWOP;
constexpr size_t WS_ZT = WS_YT + SZ_RWOP;
constexpr size_t WS_YFB = WS_ZT + SZ_RWOP;
static_assert(WS_YFB + 2 * SZ_T512 <= WS_XEND, "scan operators + YFB fit in region X");
constexpr size_t WS_R = WS_XEND;
constexpr size_t WS_VV = WS_R + SZ_T512;
constexpr size_t WS_G = WS_VV + SZ_T512;
constexpr size_t WS_KK = WS_G + SZ_T512;
constexpr size_t WS_KKA = WS_KK + SZ_T512;
constexpr size_t WS_KD = WS_KKA + 2 * SZ_T512;
constexpr size_t WS_W = WS_KD + 2 * SZ_T512;
constexpr size_t WS_BC = WS_W + 2 * SZ_T512;
constexpr size_t WS_MIXEND = WS_BC + al64k((size_t)NT * 8 * 4);
constexpr size_t WS_XB = WS_BIG;
constexpr size_t WS_HB = WS_XB + al64k((size_t)MOE_MAXROWS * DM * 2);
constexpr size_t WS_YB = WS_HB + al64k((size_t)MOE_MAXROWS * DFF * 2);
constexpr size_t WS_WT13 = WS_YB + al64k((size_t)MOE_MAXROWS * DM * 2);
constexpr size_t WS_WT2 = WS_WT13 + al64k((size_t)NEXP * DM * DM * 2);
constexpr size_t WS_EID = WS_WT2 + al64k((size_t)NEXP * DM * DFF * 2);
constexpr size_t WS_POS = WS_EID + al64k((size_t)NT * 8);
constexpr size_t WS_DEST = WS_POS + al64k((size_t)NT * 8);
constexpr size_t WS_GATE = WS_DEST + al64k((size_t)NT * 8);
constexpr size_t WS_MOEEND = WS_GATE + al64k((size_t)NT * 8);
constexpr size_t WS_YI = WS_BIG;
constexpr size_t WS_E = WS_YI + al64k((size_t)NTP * DM * 4);
constexpr size_t WS_CAR = WS_E + al64k((size_t)1040 * 64 * 256 * 4);
constexpr size_t WS_BTA = WS_CAR + al64k((size_t)64 * 1280 * 256 * 2);
constexpr size_t WS_BTC = WS_BTA + al64k((size_t)64 * 512 * 256 * 2);
constexpr size_t WS_S5END = WS_BTC + al64k((size_t)64 * 256 * 256 * 2);
constexpr size_t cmax(size_t a, size_t b) { return a > b ? a : b; }
constexpr size_t WS_TOTAL = cmax(WS_MIXEND, cmax(WS_MOEEND, WS_S5END));
static_assert(WS_TOTAL <= 512 * MiB, "workspace map exceeds 512 MiB");

#define CW_CNT(l) (1024 + 64 * (l))

#define LDS_RING 131072
#define LDS_BARST (LDS_RING)
#define LDS_TAB (LDS_RING + 256)
#define LDS_BYTES 147456
#define GRID 256

struct Params {
    const float* in[35];
    float* out;
    unsigned char* ws;
    int ph_lo, ph_hi;
};
typedef const __attribute__((address_space(4))) Params CParams;

__device__ __forceinline__ float bf2f(bf16_t v) { return __uint_as_float(((unsigned)v) << 16); }
__device__ __forceinline__ unsigned f2bf(float f) { unsigned u = __float_as_uint(f); return (u + 0x7fffu + ((u >> 16) & 1u)) >> 16; }
__device__ __forceinline__ unsigned pk2(float lo, float hi) { return f2bf(lo) | (f2bf(hi) << 16); }
__device__ __forceinline__ float bflo(unsigned u) { return __uint_as_float(u << 16); }
__device__ __forceinline__ float bfhi(unsigned u) { return __uint_as_float(u & 0xffff0000u); }
__device__ __forceinline__ float wave_sum(float v) {
#pragma unroll
    for (int o = 1; o < 64; o <<= 1) v += __shfl_xor(v, o);
    return v;
}
__device__ __forceinline__ float wave_max(float v) {
#pragma unroll
    for (int o = 1; o < 64; o <<= 1) v = fmaxf(v, __shfl_xor(v, o));
    return v;
}
template <int CTRL> __device__ __forceinline__ float dppf(float v) { return __int_as_float(__builtin_amdgcn_update_dpp(0, __float_as_int(v), CTRL, 0xF, 0xF, true)); }
__device__ __forceinline__ float row16_sum(float v) { v += dppf<0xB1>(v); v += dppf<0x4E>(v); v += dppf<0x141>(v); v += dppf<0x140>(v); return v; }
__device__ __forceinline__ float sigmoidf_(float x) { return 1.f / (1.f + __expf(-x)); }
__device__ __forceinline__ int rowof(int b, int p) { return p < NMETA ? NMAIN + b * NMETA + p : b * SEQ + (p - NMETA); }

#define SA_STRIDE 40
template <class AF, class BF>
__device__ __forceinline__ void gemm_tile(unsigned char* lds, int K, int ldb, const AF& arow, const BF& bcol, f32x4 (&acc)[4][2]) {
    bf16_t* sA = (bf16_t*)lds;
    bf16_t* sB = (bf16_t*)(lds + 128 * SA_STRIDE * 2);
    const int tid = threadIdx.x, lane = tid & 63, wave = tid >> 6, wr = wave >> 2, wc = wave & 3, fr = lane & 15, fq = lane >> 4;
#pragma unroll
    for (int mi = 0; mi < 4; ++mi)
#pragma unroll
        for (int ni = 0; ni < 2; ++ni) acc[mi][ni] = (f32x4){0.f, 0.f, 0.f, 0.f};
    const int ar = tid >> 2, akc = (tid & 3) * 8;
    const bf16_t* ap = arow(ar) + akc;
    const int bnq = (tid & 31) * 4, bkp = (tid >> 5) * 2;
    const float* bp = bcol(bnq) + (size_t)bkp * ldb;
    const int nk = K / 32;
    u32x4 ra = *(const u32x4*)ap;
    f32x4 rb0 = *(const f32x4*)bp, rb1 = *(const f32x4*)(bp + ldb);
    for (int kt = 0; kt < nk; ++kt) {
        __syncthreads();
        *(u32x4*)(sA + ar * SA_STRIDE + akc) = ra;
        {
            unsigned* d = (unsigned*)(sB + bnq * SA_STRIDE + bkp);
            d[0 * (SA_STRIDE / 2)] = pk2(rb0[0], rb1[0]);
            d[1 * (SA_STRIDE / 2)] = pk2(rb0[1], rb1[1]);
            d[2 * (SA_STRIDE / 2)] = pk2(rb0[2], rb1[2]);
            d[3 * (SA_STRIDE / 2)] = pk2(rb0[3], rb1[3]);
        }
        __syncthreads();
        if (kt + 1 < nk) {
            ra = *(const u32x4*)(ap + (kt + 1) * 32);
            const float* q = bp + (size_t)(kt + 1) * 32 * ldb;
            rb0 = *(const f32x4*)q; rb1 = *(const f32x4*)(q + ldb);
        }
        bf16x8 a[4], b[2];
#pragma unroll
        for (int mi = 0; mi < 4; ++mi) a[mi] = *(const bf16x8*)(sA + (wr * 64 + mi * 16 + fr) * SA_STRIDE + fq * 8);
#pragma unroll
        for (int ni = 0; ni < 2; ++ni) b[ni] = *(const bf16x8*)(sB + (wc * 32 + ni * 16 + fr) * SA_STRIDE + fq * 8);
#pragma unroll
        for (int mi = 0; mi < 4; ++mi)
#pragma unroll
            for (int ni = 0; ni < 2; ++ni) acc[mi][ni] = __builtin_amdgcn_mfma_f32_16x16x32_bf16(a[mi], b[ni], acc[mi][ni], 0, 0, 0);
    }
    __syncthreads();
}
#define ACC_FOREACH(acc, ...) do { const int _l = threadIdx.x & 63, _w = threadIdx.x >> 6, _wr = _w >> 2, _wc = _w & 3, _fr = _l & 15, _fq = _l >> 4; \
    _Pragma("unroll") for (int _mi = 0; _mi < 4; ++_mi) _Pragma("unroll") for (int _ni = 0; _ni < 2; ++_ni) _Pragma("unroll") for (int _j = 0; _j < 4; ++_j) { \
        const int rl = _wr * 64 + _mi * 16 + _fq * 4 + _j, cl = _wc * 32 + _ni * 16 + _fr; const float val = acc[_mi][_ni][_j]; __VA_ARGS__ } } while (0)
#define ACC_FOREACH_PAIR(acc, ...) do { const int _l = threadIdx.x & 63, _w = threadIdx.x >> 6, _wr = _w >> 2, _wc = _w & 3, _fr = _l & 15, _fq = _l >> 4; \
    _Pragma("unroll") for (int _mi = 0; _mi < 4; ++_mi) _Pragma("unroll") for (int _j = 0; _j < 4; ++_j) { \
        const int rl = _wr * 64 + _mi * 16 + _fq * 4 + _j, co = _wc * 16 + _fr; const float va = acc[_mi][0][_j], vg = acc[_mi][1][_j]; __VA_ARGS__ } } while (0)

__device__ __forceinline__ void store_norm_bf16(const f32x4 (&v)[4], const float* gain, bf16_t* dst, int lane) {
    float ss = 0.f;
#pragma unroll
    for (int j = 0; j < 4; ++j) ss += v[j][0] * v[j][0] + v[j][1] * v[j][1] + v[j][2] * v[j][2] + v[j][3] * v[j][3];
    ss = wave_sum(ss);
    const float rstd = rsqrtf(ss * (1.f / DM) + 1e-6f);
#pragma unroll
    for (int j = 0; j < 4; ++j) {
        const f32x4 g = ((const f32x4*)gain)[lane + 64 * j];
        u32x2 o; o.x = pk2(v[j][0] * rstd * g[0], v[j][1] * rstd * g[1]); o.y = pk2(v[j][2] * rstd * g[2], v[j][3] * rstd * g[3]);
        ((u32x2*)dst)[lane + 64 * j] = o;
    }
}

namespace pg8 {
#define PG8_LAS __attribute__((address_space(3)))
constexpr int BM = 256, BK = 64, HALF = 128, HTB = HALF * BK * 2  , STAGE_BYTES = 8 * HTB, NXCD = 8, WGM = 8;
__host__ __device__ __forceinline__ int lds_byte(int r, int c) { const int st = (r >> 4) * 2 + (c >> 5), rr = r & 15, cc = c & 31, ob = rr * 64 + cc * 2; return st * 1024 + (ob ^ (((ob >> 9) & 1) << 5)); }
__host__ __device__ __forceinline__ void stage_rc(int b, int& R, int& C) { const int st = b / 1024, sb = b % 1024, swz = sb ^ (((sb >> 9) & 1) << 5); R = (st >> 1) * 16 + swz / 64; C = (st & 1) * 32 + (swz % 64) / 2; }
__host__ __device__ __forceinline__ int perm32(int rho) { const int n = rho >> 4, i = rho & 15; return 8 * (i >> 2) + 4 * n + (i & 3); }

struct Unit { int pm, pn; const char* A; const char* B; };

struct DenseOrder {
    static constexpr bool GATHER_A = false;
    int nM, nN, nwg, G, c; const char* A; const char* Bt; size_t tstep;
    __device__ void init(const bf16_t* A_, const bf16_t* Bt_, int M, int N, int K, int G_, int c_) { nM = M / BM; nN = N / BM; nwg = nM * nN; G = G_; c = c_; A = (const char*)A_; Bt = (const char*)Bt_; tstep = (size_t)BM * K * 2; }
    __device__ bool next(int i, Unit& u) const {
        const long L = (long)i * G + c; if (L >= nwg) return false;
        int wgid = (int)L; { const int q = nwg / NXCD, r = nwg % NXCD, xcd = wgid % NXCD, off = wgid / NXCD; wgid = (xcd < r ? xcd * (q + 1) : r * (q + 1) + (xcd - r) * q) + off; }
        const int nig = WGM * nN, gid = wgid / nig, fm = gid * WGM, gsz = (nM - fm) < WGM ? (nM - fm) : WGM;
        u.pm = fm + ((wgid % nig) % gsz); u.pn = (wgid % nig) / gsz; u.A = A + (size_t)u.pm * tstep; u.B = Bt + (size_t)u.pn * tstep; return true;
    }
    __device__ __forceinline__ void a_ready(const Unit&) const {}
    __device__ __forceinline__ void done(const Unit&) const {}
};
struct ProjOrder {
    static constexpr bool GATHER_A = false;
    DenseOrder D; const char* HNp; const char* WT;
    __device__ void init(const bf16_t* HN_, const bf16_t* WT_, int c_) { D.init(HN_, WT_, NTP, 13 * BM, DM, GRID, c_); HNp = (const char*)HN_; WT = (const char*)WT_; }
    __device__ bool next(int i, Unit& u) const {
        if (!D.next(i, u)) return false;
        const size_t ts = (size_t)BM * DM * 2;
        if (u.pn < 11) { const int wrow = u.pn < 4 ? u.pn : u.pn + 2; u.A = HNp + (size_t)u.pm * ts; u.B = WT + (size_t)wrow * ts; }
        else { u.A = WT + (size_t)(4 + (u.pn - 11)) * ts; u.B = HNp + (size_t)u.pm * ts; }
        return true;
    }
    __device__ __forceinline__ void a_ready(const Unit&) const {}
    __device__ __forceinline__ void done(const Unit&) const {}
};
struct MoeOrder {
    static constexpr bool GATHER_A = false;
    const int* et; int TT, vcu; const char* A; const char* Bt; unsigned tstepA, tstepB, estep;
    __device__ __forceinline__ bool next(int i, Unit& u) const {
        const int L = i * GRID + vcu; if (L >= TT * 4) return false;
        const int rt = L >> 2, ct = L & 3, e = et[rt];
        u.pm = rt; u.pn = ct; u.A = A + (size_t)rt * tstepA; u.B = Bt + (size_t)e * estep + (size_t)ct * tstepB; return true;
    }
    __device__ __forceinline__ void a_ready(const Unit&) const {}
    __device__ __forceinline__ void done(const Unit&) const {}
};

struct S5OrderA {
    static constexpr bool GATHER_A = true;
    int vcu; const char* U; const char* BTA;
    __device__ __forceinline__ bool next(int i, Unit& u) const {
        const int L = i * GRID + vcu; if (L >= 640) return false;
        const int g = L / 10, rem = L - g * 10, mt = rem >> 1, nt = rem & 1;
        u.pm = mt; u.pn = g * 2 + nt; u.A = U + ((size_t)mt * 256 * 16 * 1024 + g * 16) * 2; u.B = BTA + ((size_t)(g * 512 + nt * 256) * 256) * 2; return true;
    }
    __device__ __forceinline__ void a_ready(const Unit&) const {}
    __device__ __forceinline__ void done(const Unit&) const {}
};
struct S5OrderC {
    static constexpr bool GATHER_A = false;
    int vcu; const char* CAR; const char* BTC;
    __device__ __forceinline__ bool next(int i, Unit& u) const {
        const int L = i * GRID + vcu; if (L >= 320) return false;
        const int g = L / 5, mt = L - g * 5;
        u.pm = mt; u.pn = g; u.A = CAR + ((size_t)(g * 1280 + mt * 256) * 256) * 2; u.B = BTC + ((size_t)g * 256 * 256) * 2; return true;
    }
    __device__ __forceinline__ void a_ready(const Unit&) const {}
    __device__ __forceinline__ void done(const Unit&) const {}
};
__device__ __forceinline__ unsigned cvt_pk_bf16(float lo, float hi) { unsigned r; asm volatile("v_cvt_pk_bf16_f32 %0, %1, %2" : "=v"(r) : "v"(lo), "v"(hi)); return r; }

struct EpiProj {
    static constexpr bool PERM = true, AFTER_DRAIN = false;
    bf16_t *Q, *Kk, *VT, *REST;
    __device__ __forceinline__ void operator()(const f32x4 (&acc)[2][2][4][2], const Unit& u, int wr, int wc, int fr, int fq) const {
        bf16_t* base; int ldc; int row0, col0;
        if (u.pn < 11) { row0 = u.pm * BM + wr * 64 + fr; int colt;
            if (u.pn < 2) { base = Q; colt = u.pn * BM; ldc = 512; } else if (u.pn < 4) { base = Kk; colt = (u.pn - 2) * BM; ldc = 512; } else { base = REST; colt = (u.pn - 4) * BM; ldc = RESTC; }
            col0 = colt + wc * 32 + 8 * fq; }
        else { base = VT; ldc = NTP; row0 = (u.pn - 11) * BM + wr * 64 + fr; col0 = u.pm * BM + wc * 32 + 8 * fq; }
#pragma unroll
        for (int ai = 0; ai < 2; ++ai)
#pragma unroll
            for (int m = 0; m < 4; ++m) { bf16_t* rowp = base + (size_t)(row0 + ai * HALF + m * 16) * ldc + col0;
#pragma unroll
                for (int bj = 0; bj < 2; ++bj) { const f32x4 v0 = acc[ai][bj][m][0], v1 = acc[ai][bj][m][1];
                    u32x4 w; w.x = cvt_pk_bf16(v0[0], v0[1]); w.y = cvt_pk_bf16(v0[2], v0[3]); w.z = cvt_pk_bf16(v1[0], v1[1]); w.w = cvt_pk_bf16(v1[2], v1[3]);
                    *(u32x4*)(rowp + bj * HALF) = w; } }
    }
};
struct EpiBf16Plain {
    static constexpr bool PERM = true, AFTER_DRAIN = false;
    bf16_t* O; int ldc;
    __device__ __forceinline__ void operator()(const f32x4 (&acc)[2][2][4][2], const Unit& u, int wr, int wc, int fr, int fq) const {
        const int row0 = u.pm * BM + wr * 64 + fr; const int col0 = u.pn * BM + wc * 32 + 8 * fq;
#pragma unroll
        for (int ai = 0; ai < 2; ++ai)
#pragma unroll
            for (int m = 0; m < 4; ++m) { bf16_t* rowp = O + (size_t)(row0 + ai * HALF + m * 16) * ldc + col0;
#pragma unroll
                for (int bj = 0; bj < 2; ++bj) { const f32x4 v0 = acc[ai][bj][m][0], v1 = acc[ai][bj][m][1];
                    u32x4 w; w.x = cvt_pk_bf16(v0[0], v0[1]); w.y = cvt_pk_bf16(v0[2], v0[3]); w.z = cvt_pk_bf16(v1[0], v1[1]); w.w = cvt_pk_bf16(v1[2], v1[3]);
                    *(u32x4*)(rowp + bj * HALF) = w; } }
    }
};
struct EpiSwiglu {
    static constexpr bool PERM = true, AFTER_DRAIN = false;
    bf16_t* O;
    __device__ __forceinline__ void operator()(const f32x4 (&acc)[2][2][4][2], const Unit& u, int wr, int wc, int fr, int fq) const {
        const int row0 = u.pm * BM + wr * 64 + fr; const int col0 = u.pn * HALF + wc * 32 + 8 * fq;
#pragma unroll
        for (int ai = 0; ai < 2; ++ai)
#pragma unroll
            for (int m = 0; m < 4; ++m) {
                float o[8];
#pragma unroll
                for (int n = 0; n < 2; ++n)
#pragma unroll
                    for (int i = 0; i < 4; ++i) { const float va = acc[ai][0][m][n][i], vg = acc[ai][1][m][n][i]; o[4 * n + i] = va / (1.f + __expf(-va)) * vg; }
                u32x4 w; w.x = cvt_pk_bf16(o[0], o[1]); w.y = cvt_pk_bf16(o[2], o[3]); w.z = cvt_pk_bf16(o[4], o[5]); w.w = cvt_pk_bf16(o[6], o[7]);
                *(u32x4*)(O + (size_t)(row0 + ai * HALF + m * 16) * DFF + col0) = w; }
    }
};
struct EpiResidual {
    static constexpr bool PERM = false, AFTER_DRAIN = false;
    float* Hh;
    __device__ __forceinline__ void operator()(const f32x4 (&acc)[2][2][4][2], const Unit& u, int wr, int wc, int fr, int fq) const {
        const int row0 = u.pm * BM + wr * 64 + fr; const int col0 = u.pn * BM + wc * 32 + 4 * fq;
#pragma unroll
        for (int ai = 0; ai < 2; ++ai)
#pragma unroll
            for (int m = 0; m < 4; ++m) { float* rowp = Hh + (size_t)(row0 + ai * HALF + m * 16) * DM + col0;
#pragma unroll
                for (int bj = 0; bj < 2; ++bj)
#pragma unroll
                    for (int n = 0; n < 2; ++n) { f32x4* p = (f32x4*)(rowp + bj * HALF + n * 16); *p = *p + acc[ai][bj][m][n]; } }
    }
};
struct EpiGlu {
    static constexpr bool PERM = false, AFTER_DRAIN = false;
    float* Hh;
    __device__ __forceinline__ void operator()(const f32x4 (&acc)[2][2][4][2], const Unit& u, int wr, int wc, int fr, int fq) const {
        const int row0 = u.pm * BM + wr * 64 + fr; const int col0 = u.pn * HALF + wc * 32 + 4 * fq;
#pragma unroll
        for (int ai = 0; ai < 2; ++ai)
#pragma unroll
            for (int m = 0; m < 4; ++m) { float* rowp = Hh + (size_t)(row0 + ai * HALF + m * 16) * DM + col0;
#pragma unroll
                for (int n = 0; n < 2; ++n) { f32x4* p = (f32x4*)(rowp + n * 16); f32x4 hv = *p; const f32x4 va = acc[ai][0][m][n], vg = acc[ai][1][m][n];
#pragma unroll
                    for (int i = 0; i < 4; ++i) hv[i] += va[i] / (1.f + __expf(-vg[i]));
                    *p = hv; } }
    }
};

struct EpiS5A {
    static constexpr bool PERM = true, AFTER_DRAIN = false;
    float* YI; float* E;
    __device__ __forceinline__ void operator()(const f32x4 (&acc)[2][2][4][2], const Unit& u, int wr, int wc, int fr, int fq) const {
        const int g = u.pn >> 1, nt = u.pn & 1;
        const int cl0 = wc * 32 + 8 * fq;
        float* base = nt == 0 ? YI + (size_t)(cl0 >> 4) * DM + g * 16 + (cl0 & 15) : E + (size_t)g * 256 + cl0;
        const size_t nstride = 16 * DM;
        const size_t bjstep = nt == 0 ? (size_t)8 * DM : (size_t)HALF;
#pragma unroll
        for (int ai = 0; ai < 2; ++ai)
#pragma unroll
            for (int m = 0; m < 4; ++m) { int n = u.pm * BM + ai * HALF + wr * 64 + m * 16 + fr; n = n < 1039 ? n : 1039;
                float* p = base + (size_t)n * nstride;
#pragma unroll
                for (int bj = 0; bj < 2; ++bj) { *(f32x4*)(p + bj * bjstep) = acc[ai][bj][m][0]; *(f32x4*)(p + bj * bjstep + 4) = acc[ai][bj][m][1]; } }
    }
};
struct EpiS5C {
    static constexpr bool PERM = true, AFTER_DRAIN = false;
    const float* YI; const bf16_t* Uu; const float* dvec; bf16_t* O;
    __device__ __forceinline__ void operator()(const f32x4 (&acc)[2][2][4][2], const Unit& u, int wr, int wc, int fr, int fq) const {
        const int g = u.pn;
        const int cl0 = wc * 32 + 8 * fq, ch = g * 16 + (cl0 & 15);
        const size_t off0 = (size_t)(cl0 >> 4) * DM + ch;
        const f32x4 d0 = *(const f32x4*)(dvec + ch), d1 = *(const f32x4*)(dvec + ch + 4);
#pragma unroll
        for (int ai = 0; ai < 2; ++ai)
#pragma unroll
            for (int m = 0; m < 4; ++m) { int n = u.pm * BM + ai * HALF + wr * 64 + m * 16 + fr; n = n < 1039 ? n : 1039;
#pragma unroll
                for (int bj = 0; bj < 2; ++bj) {
                    const size_t off = off0 + (size_t)n * (16 * DM) + (size_t)bj * (8 * DM);
                    const f32x4 y0 = *(const f32x4*)(YI + off), y1 = *(const f32x4*)(YI + off + 4);
                    const u32x4 uv = *(const u32x4*)(Uu + off);
                    float y[8];
#pragma unroll
                    for (int q = 0; q < 4; ++q) { y[q] = acc[ai][bj][m][0][q] + y0[q] + d0[q] * (q & 1 ? __uint_as_float(uv[q >> 1] & 0xffff0000u) : __uint_as_float(uv[q >> 1] << 16));
                        y[4 + q] = acc[ai][bj][m][1][q] + y1[q] + d1[q] * (q & 1 ? __uint_as_float(uv[2 + (q >> 1)] & 0xffff0000u) : __uint_as_float(uv[2 + (q >> 1)] << 16)); }
#pragma unroll
                    for (int q = 0; q < 8; ++q) { const float z = 1.5957691216f * (y[q] + 0.044715f * y[q] * y[q] * y[q]); y[q] = y[q] / (1.f + __expf(-z)); }
                    u32x4 w; w.x = cvt_pk_bf16(y[0], y[1]); w.y = cvt_pk_bf16(y[2], y[3]); w.z = cvt_pk_bf16(y[4], y[5]); w.w = cvt_pk_bf16(y[6], y[7]);
                    *(u32x4*)(O + off) = w; }
                asm volatile("" ::: "memory"); }
    }
};

template <class Epi, class Sched, bool ALIGN_EPI = false, bool SP2 = false>
__device__ __forceinline__ void gemm_phase(PG8_LAS unsigned char* lds, const int K, const Sched& S, const Epi& E) {
    int tid_ = threadIdx.x; asm volatile("" : "+v"(tid_));
    const int tid = tid_, wid = __builtin_amdgcn_readfirstlane(tid >> 6), lane = tid & 63, wr = wid >> 2, wc = wid & 3, fr = lane & 15, fq = lane >> 4;
    const int nt = K / BK;
    unsigned voffA[2], voffB[2];
#pragma unroll
    for (int i = 0; i < 2; ++i) { int R, C; stage_rc(tid * 16 + i * 8192, R, C); const int Rb = Epi::PERM ? ((R & ~31) + perm32(R & 31)) : R;
        voffA[i] = Sched::GATHER_A ? (unsigned)(((16 * R + (C >> 4)) * 1024 + (C & 15)) * 2) : (unsigned)(R * K + C) * 2u; voffB[i] = (unsigned)(Rb * K + C) * 2u; }
    const size_t kstep = (size_t)(BK * 2);
    const size_t hstep = (size_t)HALF * K * 2;
    const size_t kstepA = Sched::GATHER_A ? (size_t)(4 * 1024 * 2) : kstep, hstepA = Sched::GATHER_A ? (size_t)HALF * 16 * 1024 * 2 : hstep;
    const unsigned ldsw = (unsigned)wid * 1024u;
    const int aoff = lds_byte(wr * 64 + fr, fq * 8), boff = lds_byte(wc * 32 + fr, fq * 8);
#define PG8_SA(b, h) (((b) * 2 + (h)) * HTB)
#define PG8_SB(b, h) ((4 + (b) * 2 + (h)) * HTB)
#define PG8_STAGE(bufoff, gbase, voff) do { _Pragma("unroll") for (int _i = 0; _i < 2; ++_i) \
        __builtin_amdgcn_global_load_lds((const unsigned*)((const char*)(gbase) + (voff)[_i]), (PG8_LAS unsigned*)(lds + (bufoff) + ldsw + _i * 8192), 16, 0, 0); } while (0)
#define PG8_LDA(dst, b, h) do { _Pragma("unroll") for (int m = 0; m < 4; ++m) _Pragma("unroll") for (int k = 0; k < 2; ++k) dst[m][k] = *(const PG8_LAS bf16x8*)(lds + PG8_SA(b, h) + aoff + m * 2048 + k * 1024); } while (0)
#define PG8_LDB(dst, b, h) do { _Pragma("unroll") for (int n = 0; n < 2; ++n) _Pragma("unroll") for (int k = 0; k < 2; ++k) dst[n][k] = *(const PG8_LAS bf16x8*)(lds + PG8_SB(b, h) + boff + n * 2048 + k * 1024); } while (0)
#define PG8_MMA(ai, bj, At, Bt) do { __builtin_amdgcn_s_setprio(1); _Pragma("unroll") for (int m = 0; m < 4; ++m) _Pragma("unroll") for (int n = 0; n < 2; ++n) _Pragma("unroll") for (int k = 0; k < 2; ++k) \
        acc[ai][bj][m][n] = __builtin_amdgcn_mfma_f32_16x16x32_bf16(Bt[n][k], At[m][k], acc[ai][bj][m][n], 0, 0, 0); __builtin_amdgcn_s_setprio(0); } while (0)
#define PG8_WAIT_V(n) asm volatile("s_waitcnt vmcnt(" #n ")" ::: "memory")
#define PG8_WAIT_L(n) asm volatile("s_waitcnt lgkmcnt(" #n ")" ::: "memory")
#define PG8_BAR __builtin_amdgcn_s_barrier()
#define PG8_SCHED __builtin_amdgcn_sched_barrier(0)
    Unit cur, nxt; int ui = 0;
    if (!S.next(0, cur)) return;
    f32x4 acc[2][2][4][2];
#pragma unroll
    for (int a = 0; a < 2; ++a)
#pragma unroll
        for (int b = 0; b < 2; ++b)
#pragma unroll
            for (int m = 0; m < 4; ++m)
#pragma unroll
                for (int n = 0; n < 2; ++n) acc[a][b][m][n] = (f32x4){0.f, 0.f, 0.f, 0.f};
    bf16x8 At[4][2], B0[2][2], B1[2][2];
    const char* cA = cur.A; const char* cB = cur.B;
    S.a_ready(cur);
    if constexpr (SP2) {
        PG8_STAGE(PG8_SB(0, 0), cB, voffB); PG8_STAGE(PG8_SB(0, 1), cB + hstep, voffB); PG8_STAGE(PG8_SA(0, 0), cA, voffA); PG8_STAGE(PG8_SA(0, 1), cA + hstepA, voffA);
        if (wr == 1) PG8_BAR;
        PG8_WAIT_V(2); PG8_BAR;
        PG8_STAGE(PG8_SB(1, 0), cB + kstep, voffB); PG8_STAGE(PG8_SA(1, 0), cA + kstepA, voffA); PG8_STAGE(PG8_SB(1, 1), cB + hstep + kstep, voffB);
        PG8_WAIT_V(6); PG8_BAR;
    } else {
        PG8_STAGE(PG8_SB(0, 0), cB, voffB); PG8_STAGE(PG8_SA(0, 0), cA, voffA); PG8_STAGE(PG8_SB(0, 1), cB + hstep, voffB); PG8_STAGE(PG8_SA(0, 1), cA + hstepA, voffA);
        if (wr == 1) PG8_BAR;
        PG8_WAIT_V(4); PG8_BAR;
        PG8_STAGE(PG8_SB(1, 0), cB + kstep, voffB); PG8_STAGE(PG8_SA(1, 0), cA + kstepA, voffA); PG8_STAGE(PG8_SB(1, 1), cB + hstep + kstep, voffB);
        PG8_WAIT_V(6); PG8_BAR;
    }
    for (;;) {
        const bool has_next = S.next(ui + 1, nxt);
        const char* nA = has_next ? nxt.A : cA; const char* nB = has_next ? nxt.B : cB;
        for (int t = 0; t < nt; t += 2) {
            const bool last = (t == nt - 2);
            const char* a1 = cA + (size_t)(t + 1) * kstepA;
            const char* a2 = last ? nA : cA + (size_t)(t + 2) * kstepA; const char* b2 = last ? nB : cB + (size_t)(t + 2) * kstep;
            const char* a3 = a2 + kstepA; const char* b3 = b2 + kstep;
            if (last && has_next) S.a_ready(nxt);
            if constexpr (SP2) {
            PG8_LDB(B0, 0, 0); PG8_LDB(B1, 0, 1); PG8_SCHED; PG8_LDA(At, 0, 0); PG8_STAGE(PG8_SA(1, 1), a1 + hstepA, voffA);
            PG8_WAIT_V(8); PG8_WAIT_L(0); PG8_BAR; PG8_MMA(0, 0, At, B0); PG8_MMA(0, 1, At, B1); PG8_BAR; PG8_SCHED;
            PG8_LDA(At, 0, 1); PG8_STAGE(PG8_SB(0, 0), b2, voffB); PG8_STAGE(PG8_SB(0, 1), b2 + hstep, voffB); PG8_STAGE(PG8_SA(0, 0), a2, voffA);
            PG8_WAIT_V(8); PG8_WAIT_L(0); PG8_BAR; PG8_MMA(1, 0, At, B0); PG8_MMA(1, 1, At, B1); PG8_BAR; PG8_SCHED;
            PG8_LDB(B0, 1, 0); PG8_LDB(B1, 1, 1); PG8_SCHED; PG8_LDA(At, 1, 0); PG8_STAGE(PG8_SA(0, 1), a2 + hstepA, voffA);
            PG8_WAIT_V(8); PG8_WAIT_L(0); PG8_BAR; PG8_MMA(0, 0, At, B0); PG8_MMA(0, 1, At, B1); PG8_BAR; PG8_SCHED;
            PG8_LDA(At, 1, 1); PG8_STAGE(PG8_SB(1, 0), b3, voffB); PG8_STAGE(PG8_SB(1, 1), b3 + hstep, voffB); PG8_STAGE(PG8_SA(1, 0), a3, voffA);
            PG8_WAIT_V(8); PG8_WAIT_L(0); PG8_BAR; PG8_MMA(1, 0, At, B0); PG8_MMA(1, 1, At, B1); PG8_BAR; PG8_SCHED;
            } else {
            PG8_LDB(B0, 0, 0); PG8_SCHED; PG8_LDA(At, 0, 0); PG8_STAGE(PG8_SA(1, 1), a1 + hstepA, voffA);
            PG8_WAIT_L(8); PG8_BAR; PG8_WAIT_L(0); PG8_MMA(0, 0, At, B0); PG8_BAR; PG8_SCHED;
            PG8_LDB(B1, 0, 1); PG8_STAGE(PG8_SB(0, 0), b2, voffB);
            PG8_BAR; PG8_WAIT_L(0); PG8_MMA(0, 1, At, B1); PG8_BAR;
            PG8_LDA(At, 0, 1); PG8_STAGE(PG8_SA(0, 0), a2, voffA);
            PG8_BAR; PG8_WAIT_L(0); PG8_MMA(1, 0, At, B0); PG8_BAR; PG8_SCHED;
            PG8_STAGE(PG8_SB(0, 1), b2 + hstep, voffB);
            PG8_WAIT_V(6); PG8_BAR; PG8_MMA(1, 1, At, B1); PG8_BAR;
            PG8_LDB(B0, 1, 0); PG8_SCHED; PG8_LDA(At, 1, 0); PG8_STAGE(PG8_SA(0, 1), a2 + hstepA, voffA);
            PG8_WAIT_L(8); PG8_BAR; PG8_WAIT_L(0); PG8_MMA(0, 0, At, B0); PG8_BAR; PG8_SCHED;
            PG8_LDB(B1, 1, 1); PG8_STAGE(PG8_SB(1, 0), b3, voffB);
            PG8_BAR; PG8_WAIT_L(0); PG8_MMA(0, 1, At, B1); PG8_BAR;
            PG8_LDA(At, 1, 1); PG8_STAGE(PG8_SA(1, 0), a3, voffA);
            PG8_BAR; PG8_WAIT_L(0); PG8_MMA(1, 0, At, B0); PG8_BAR; PG8_SCHED;
            PG8_STAGE(PG8_SB(1, 1), b3 + hstep, voffB);
            PG8_WAIT_V(6); PG8_BAR; PG8_MMA(1, 1, At, B1); PG8_BAR;
            }
        }
        if constexpr (ALIGN_EPI) { if (wr == 0) PG8_BAR; }
        if constexpr (!Epi::AFTER_DRAIN) { E(acc, cur, wr, wc, fr, fq); S.done(cur); }
        if (!has_next) break;
#pragma unroll
        for (int a = 0; a < 2; ++a)
#pragma unroll
            for (int b = 0; b < 2; ++b)
#pragma unroll
                for (int m = 0; m < 4; ++m)
#pragma unroll
                    for (int n = 0; n < 2; ++n) acc[a][b][m][n] = (f32x4){0.f, 0.f, 0.f, 0.f};
        cur = nxt; cA = nA; cB = nB; ++ui;
        if constexpr (ALIGN_EPI) { if (wr == 1) PG8_BAR; }
    }
    PG8_WAIT_V(0);
    if constexpr (!ALIGN_EPI) { if (wr == 0) PG8_BAR; }
    PG8_BAR;
    if constexpr (Epi::AFTER_DRAIN) { E.fused(acc, cur, wr, wc, fr, fq, lds, wid, lane); S.done(cur); }
#undef PG8_SA
#undef PG8_SB
#undef PG8_STAGE
#undef PG8_LDA
#undef PG8_LDB
#undef PG8_MMA
#undef PG8_WAIT_V
#undef PG8_WAIT_L
#undef PG8_BAR
#undef PG8_SCHED
}
}

#define PHASE_PROLOGUE \
    int tid_ = threadIdx.x; asm volatile("" : "+v"(tid_)); const int tid = tid_, lane = tid & 63, wave = tid >> 6; \
    const int G = GRID, bid = blockIdx.x; \
    const int gw = bid * 8 + wave, NGW = G * 8; \
    unsigned char* ws = P.ws; \
    float* H = (float*)(ws + WS_H); \
    bf16_t* HN = (bf16_t*)(ws + WS_HN); \
    bf16_t* A2 = (bf16_t*)(ws + WS_A2); \
    bf16_t* Qb = (bf16_t*)(ws + WS_Q); bf16_t* Kb = (bf16_t*)(ws + WS_K); bf16_t* Vb = (bf16_t*)(ws + WS_V); \
    bf16_t* REST = (bf16_t*)(ws + WS_REST); \
    bf16_t* YFB = (bf16_t*)(ws + WS_YFB); \
    bf16_t* Rr = (bf16_t*)(ws + WS_R); bf16_t* VV = (bf16_t*)(ws + WS_VV); bf16_t* KK = (bf16_t*)(ws + WS_KK); \
    bf16_t* KKA = (bf16_t*)(ws + WS_KKA); bf16_t* KD = (bf16_t*)(ws + WS_KD); \
    _Float16* LW = (_Float16*)(ws + WS_W); bf16_t* PP = (bf16_t*)(ws + WS_PP); bf16_t* QT = (bf16_t*)(ws + WS_QT); bf16_t* YT = (bf16_t*)(ws + WS_YT); bf16_t* ZT = (bf16_t*)(ws + WS_ZT); \
    bf16_t* Gg = (bf16_t*)(ws + WS_G); bf16_t* KR = (bf16_t*)(ws + WS_KR); bf16_t* LOW = (bf16_t*)(ws + WS_LOW); \
    float* BC = (float*)(ws + WS_BC); \
    bf16_t* AA = (bf16_t*)(ws + WS_AA); \
    bf16_t* HB = (bf16_t*)(ws + WS_HB); bf16_t* YB = (bf16_t*)(ws + WS_YB); \
    bf16_t* XB = (bf16_t*)(ws + WS_XB); int* EID = (int*)(ws + WS_EID); int* POS = (int*)(ws + WS_POS); int* DEST = (int*)(ws + WS_DEST); \
    float* GATE = (float*)(ws + WS_GATE); \
    float* YI = (float*)(ws + WS_YI); float* S5E = (float*)(ws + WS_E); bf16_t* CAR = (bf16_t*)(ws + WS_CAR); bf16_t* BTA = (bf16_t*)(ws + WS_BTA); bf16_t* BTC = (bf16_t*)(ws + WS_BTC); \
    unsigned* CTL = (unsigned*)(ws + WS_CTL); \
    bf16_t* WTIN = (bf16_t*)(ws + WS_WTIN); bf16_t* WTOUT = (bf16_t*)(ws + WS_WTOUT); bf16_t* WTGLU = (bf16_t*)(ws + WS_WTGLU); bf16_t* WT13 = (bf16_t*)(ws + WS_WT13); bf16_t* WT2 = (bf16_t*)(ws + WS_WT2); \
    const int vcu = (G % 8 == 0) ? (bid % 8) * (G / 8) + bid / 8 : bid; \
    const float* x = P.in[0]; const float* meta = P.in[1]; const float* norm_mix = P.in[2]; const float* norm_ffn = P.in[3]; const float* norm_final = P.in[4]; \
    const float* w_in = P.in[5]; const float* w_out = P.in[6]; const float* rpb = P.in[7]; const float* mu = P.in[8]; \
    const float* w0 = P.in[9]; const float* w_up = P.in[10]; const float* a0 = P.in[11]; const float* a_up = P.in[12]; const float* g_up = P.in[13]; \
    const float* k_k = P.in[14]; const float* k_a = P.in[15]; const float* r_k = P.in[16]; const float* lnx_g = P.in[17]; const float* lnx_b = P.in[18]; \
    const float* s5_b_re = P.in[19]; const float* s5_b_im = P.in[20]; const float* s5_lre = P.in[21]; const float* s5_lim = P.in[22]; const float* s5_ls = P.in[23]; \
    const float* s5_c_re = P.in[24]; const float* s5_c_im = P.in[25]; const float* s5_d = P.in[26]; const float* w_glu = P.in[27]; \
    const float* moe_wg = P.in[28]; const float* moe_bg = P.in[29]; const float* moe_we = P.in[30]; const float* moe_be = P.in[31]; \
    const float* moe_w1 = P.in[32]; const float* moe_w3 = P.in[33]; const float* moe_w2 = P.in[34];


__device__ __forceinline__ void transpose_item(const float* W, int N, int K, int k0, int n0, bf16_t* dstrow0, int lane) {
    const int nq = lane & 15, kb = lane >> 4;
    const float* src = W + (size_t)(k0 + 16 * kb) * N + n0 + 4 * nq;
    f32x4 v[16];
#pragma unroll
    for (int kk = 0; kk < 16; ++kk) v[kk] = *(const f32x4*)(src + (size_t)kk * N);
#pragma unroll
    for (int i = 0; i < 4; ++i) {
        bf16_t* d = dstrow0 + (size_t)(4 * nq + i) * K + k0 + 16 * kb;
        u32x4 lo, hi;
        lo.x = pk2(v[0][i], v[1][i]); lo.y = pk2(v[2][i], v[3][i]); lo.z = pk2(v[4][i], v[5][i]); lo.w = pk2(v[6][i], v[7][i]);
        hi.x = pk2(v[8][i], v[9][i]); hi.y = pk2(v[10][i], v[11][i]); hi.z = pk2(v[12][i], v[13][i]); hi.w = pk2(v[14][i], v[15][i]);
        *(u32x4*)d = lo; *(u32x4*)(d + 8) = hi;
    }
}
#define CONV_DENSE_ITEMS (832 + 256 + 512)
__device__ __forceinline__ void conv_dense_item(CParams& P, int it, int lane) {
    unsigned char* ws = P.ws;
    if (it < 832) { const int kb = it / 52, nb = it % 52; transpose_item(P.in[5], INCOLS, DM, kb * 64, nb * 64, (bf16_t*)(ws + WS_WTIN) + (size_t)nb * 64 * DM, lane); return; }
    it -= 832;
    if (it < 256) { const int kb = it / 16, nb = it % 16; transpose_item(P.in[6], DM, DM, kb * 64, nb * 64, (bf16_t*)(ws + WS_WTOUT) + (size_t)nb * 64 * DM, lane); return; }
    it -= 256;
    { const int kb = it / 32, nb = it % 32, n = nb * 64, half = n >> 10, c = n & 1023, row = (c >> 7) * 256 + half * 128 + (c & 127);
      transpose_item(P.in[27], 2 * DM, DM, kb * 64, n, (bf16_t*)(ws + WS_WTGLU) + (size_t)row * DM, lane); }
}
#define CONV_MOE_ITEMS (NEXP * 384)
__device__ __forceinline__ void conv_moe_item(CParams& P, int l, int it, int lane) {
    unsigned char* ws = P.ws;
    const int e = it / 384; int r = it % 384;
    if (r < 256) { const int which = r >> 7; r &= 127; const int kb = r >> 3, nb = r & 7, n = nb * 64, row = (n >> 7) * 256 + which * 128 + (n & 127);
        const float* W = (which ? P.in[33] : P.in[32]) + ((size_t)(l * NEXP + e) * DM) * DFF;
        transpose_item(W, DFF, DM, kb * 64, n, (bf16_t*)(ws + WS_WT13) + ((size_t)e * DM + row) * DM, lane); return; }
    r -= 256;
    { const int kb = r >> 4, nb = r & 15; const float* W = P.in[34] + ((size_t)(l * NEXP + e) * DFF) * DM;
      transpose_item(W, DM, DFF, kb * 64, nb * 64, (bf16_t*)(ws + WS_WT2) + ((size_t)e * DM + nb * 64) * DFF, lane); }
}

template <int MODE>
__device__ __forceinline__ void meta_gemm(const bf16_t* A, const bf16_t* Bt, float* Hrows, int task, int lane) {
    const int fr = lane & 15, fq = lane >> 4, c = task * 16 + fr;
    const bf16_t* b0 = MODE == 0 ? Bt + (size_t)c * DM : Bt + (size_t)((c >> 7) * 256 + (c & 127)) * DM;
    const bf16_t* b1 = b0 + (size_t)128 * DM;
    f32x4 acc0[2], acc1[2];
    acc0[0] = acc0[1] = acc1[0] = acc1[1] = (f32x4){0.f, 0.f, 0.f, 0.f};
#pragma unroll 4
    for (int kt = 0; kt < 32; ++kt) {
        const int ko = kt * 32 + fq * 8;
        const bf16x8 a0 = *(const bf16x8*)(A + (size_t)fr * DM + ko), a1 = *(const bf16x8*)(A + (size_t)(16 + fr) * DM + ko);
        const bf16x8 bv = *(const bf16x8*)(b0 + ko);
        acc0[0] = __builtin_amdgcn_mfma_f32_16x16x32_bf16(a0, bv, acc0[0], 0, 0, 0);
        acc0[1] = __builtin_amdgcn_mfma_f32_16x16x32_bf16(a1, bv, acc0[1], 0, 0, 0);
        if (MODE == 1) { const bf16x8 bg = *(const bf16x8*)(b1 + ko);
            acc1[0] = __builtin_amdgcn_mfma_f32_16x16x32_bf16(a0, bg, acc1[0], 0, 0, 0);
            acc1[1] = __builtin_amdgcn_mfma_f32_16x16x32_bf16(a1, bg, acc1[1], 0, 0, 0); }
    }
#pragma unroll
    for (int mi = 0; mi < 2; ++mi)
#pragma unroll
        for (int j = 0; j < 4; ++j) { float* p = Hrows + (size_t)(mi * 16 + fq * 4 + j) * DM + c;
            if (MODE == 0) *p += acc0[mi][j]; else *p += acc0[mi][j] / (1.f + __expf(-acc1[mi][j])); }
}
__device__ __forceinline__ void phase_0(CParams& P, unsigned char* lds, const int ph) {
    PHASE_PROLOGUE
            for (int row = gw; row < NT; row += NGW) {
                const float* src = row < NMAIN ? x + (size_t)row * DM : meta + (size_t)((row - NMAIN) & 15) * DM;
                f32x4 v[4];
#pragma unroll
                for (int j = 0; j < 4; ++j) { v[j] = ((const f32x4*)src)[lane + 64 * j]; ((f32x4*)(H + (size_t)row * DM))[lane + 64 * j] = v[j]; }
                store_norm_bf16(v, norm_mix, HN + (size_t)row * DM, lane);
            }
    for (int it = gw; it < CONV_DENSE_ITEMS; it += NGW) conv_dense_item(P, it, lane);
}

__device__ __forceinline__ void phase_1(CParams& P, unsigned char* lds, const int ph) {
    PHASE_PROLOGUE
    pg8::ProjOrder S; S.init(HN, WTIN, bid);
    pg8::EpiProj E{Qb, Kb, Vb, REST};
    pg8::gemm_phase<pg8::EpiProj, pg8::ProjOrder, true, true>((PG8_LAS unsigned char*)lds, DM, S, E);
}

__device__ __forceinline__ void phase_2(CParams& P, unsigned char* lds, const int ph) {
    PHASE_PROLOGUE
    float* sb = (float*)lds;
    for (int i = tid; i < 8 * 465; i += 512) sb[i] = rpb[i];
    __syncthreads();
    const bf16_t* VT = Vb;
    const int fr = lane & 15, fq = lane >> 4;
    for (int u = gw; u < 8192 + 16; u += NGW) {
        const bool metaq = u >= 8192;
        int b, h, r = 0, qb = 0;
        if (!metaq) { qb = u & 3; r = (u >> 2) & 127; h = (u >> 9) & 7; b = u >> 12; } else { const int m = u - 8192; b = m >> 3; h = m & 7; }
        const int c = qb * 16 + fr;
        const int qrow = metaq ? NMAIN + b * NMETA + fr : b * SEQ + r * 64 + c;
        const int R0 = min(max(r - 4, 0), 120), cs = qb == 0 ? 0 : (qb == 1 ? 8 : (qb == 2 ? 24 : 32));
        const int C0 = min(max(c - 8, 0), 48);
        bf16x8 qf0 = *(const bf16x8*)(Qb + (size_t)qrow * 512 + h * 64 + fq * 8), qf1 = *(const bf16x8*)(Qb + (size_t)qrow * 512 + h * 64 + 32 + fq * 8);
        f32x4 sacc[17];
        const f32x4 zero4 = (f32x4){0.f, 0.f, 0.f, 0.f};
        if (!metaq) {
#pragma unroll
            for (int kt = 0; kt < 16; ++kt) {
                const int krow0 = b * SEQ + (R0 + (kt >> 1)) * 64 + cs + 16 * (kt & 1);
                const bf16_t* kp = Kb + (size_t)(krow0 + fr) * 512 + h * 64 + fq * 8;
                const bf16x8 a0 = *(const bf16x8*)kp, a1 = *(const bf16x8*)(kp + 32);
                f32x4 acc = __builtin_amdgcn_mfma_f32_16x16x32_bf16(a0, qf0, zero4, 0, 0, 0);
                sacc[kt] = __builtin_amdgcn_mfma_f32_16x16x32_bf16(a1, qf1, acc, 0, 0, 0);
            }
        } else {
#pragma unroll
            for (int kt = 0; kt < 16; ++kt) sacc[kt] = zero4;
        }
        {
            const bf16_t* kp = Kb + (size_t)(NMAIN + b * NMETA + fr) * 512 + h * 64 + fq * 8;
            const bf16x8 a0 = *(const bf16x8*)kp, a1 = *(const bf16x8*)(kp + 32);
            f32x4 acc = __builtin_amdgcn_mfma_f32_16x16x32_bf16(a0, qf0, zero4, 0, 0, 0);
            sacc[16] = __builtin_amdgcn_mfma_f32_16x16x32_bf16(a1, qf1, acc, 0, 0, 0);
        }
        float mx = -1e30f;
#pragma unroll
        for (int kt = 0; kt < 16; ++kt) {
            const int dr = R0 + (kt >> 1) - r + 7;
#pragma unroll
            for (int j = 0; j < 4; ++j) {
                const int kc = cs + 16 * (kt & 1) + 4 * fq + j;
                const bool inb = !metaq && kc >= C0 && kc < C0 + 16;
                const int dc = min(max(kc - c + 15, 0), 30);
                const float s = inb ? sacc[kt][j] * 0.125f + sb[(h * 15 + dr) * 31 + dc] : -1e30f;
                sacc[kt][j] = s; mx = fmaxf(mx, s);
            }
        }
#pragma unroll
        for (int j = 0; j < 4; ++j) { const float s = sacc[16][j] * 0.125f; sacc[16][j] = s; mx = fmaxf(mx, s); }
        mx = fmaxf(mx, __shfl_xor(mx, 16)); mx = fmaxf(mx, __shfl_xor(mx, 32));
        float sum = 0.f;
#pragma unroll
        for (int kt = 0; kt < 17; ++kt)
#pragma unroll
            for (int j = 0; j < 4; ++j) { const float pv = __expf(sacc[kt][j] - mx); sacc[kt][j] = pv; sum += pv; }
        sum += __shfl_xor(sum, 16); sum += __shfl_xor(sum, 32);
        f32x4 o[4] = {zero4, zero4, zero4, zero4};
        if (!metaq) {
#pragma unroll
            for (int kr = 0; kr < 8; ++kr) {
                union { bf16x8 v; unsigned u[4]; } bf;
                bf.u[0] = pk2(sacc[2 * kr][0], sacc[2 * kr][1]); bf.u[1] = pk2(sacc[2 * kr][2], sacc[2 * kr][3]);
                bf.u[2] = pk2(sacc[2 * kr + 1][0], sacc[2 * kr + 1][1]); bf.u[3] = pk2(sacc[2 * kr + 1][2], sacc[2 * kr + 1][3]);
                const size_t tok0 = (size_t)b * SEQ + (R0 + kr) * 64 + cs + 4 * fq;
#pragma unroll
                for (int dt = 0; dt < 4; ++dt) {
                    const bf16_t* vp = VT + (size_t)(h * 64 + dt * 16 + fr) * NTP + tok0;
                    union { bf16x8 v; u32x2 h2[2]; } af;
                    af.h2[0] = *(const u32x2*)vp; af.h2[1] = *(const u32x2*)(vp + 16);
                    o[dt] = __builtin_amdgcn_mfma_f32_16x16x32_bf16(af.v, bf.v, o[dt], 0, 0, 0);
                }
            }
        }
        {
            union { bf16x8 v; unsigned u[4]; } bf;
            bf.u[0] = pk2(sacc[16][0], sacc[16][1]); bf.u[1] = pk2(sacc[16][2], sacc[16][3]); bf.u[2] = 0u; bf.u[3] = 0u;
            const size_t tokm = (size_t)NMAIN + b * NMETA + 4 * fq;
#pragma unroll
            for (int dt = 0; dt < 4; ++dt) {
                const bf16_t* vp = VT + (size_t)(h * 64 + dt * 16 + fr) * NTP + tokm;
                union { bf16x8 v; u32x2 h2[2]; } af;
                af.h2[0] = *(const u32x2*)vp; af.h2[1] = (u32x2){0u, 0u};
                o[dt] = __builtin_amdgcn_mfma_f32_16x16x32_bf16(af.v, bf.v, o[dt], 0, 0, 0);
            }
        }
        const float inv = 1.f / sum;
#pragma unroll
        for (int dt = 0; dt < 4; ++dt) {
            u32x2 ov; ov.x = pk2(o[dt][0] * inv, o[dt][1] * inv); ov.y = pk2(o[dt][2] * inv, o[dt][3] * inv);
            *(u32x2*)(A2 + (size_t)qrow * DM + h * 64 + dt * 16 + 4 * fq) = ov;
        }
    }
    __syncthreads();
}

__device__ __forceinline__ void phase_3(CParams& P, unsigned char* lds, const int ph) {
    PHASE_PROLOGUE
            for (int tk = gw; tk < NT; tk += NGW) {
                const int b = tk / LSEQ, p = tk % LSEQ, row = rowof(b, p);
                const bool hp = p > 0, hn = p + 1 < LSEQ;
                const int rowp = hp ? rowof(b, p - 1) : row, rown = hn ? rowof(b, p + 1) : row;
#pragma unroll
                for (int j = 0; j < 7; ++j) {
                    const int c = 4 * lane + 256 * j;
                    const u32x2 vc = *(const u32x2*)(REST + (size_t)row * RESTC + c);
                    u32x2 vp = *(const u32x2*)(REST + (size_t)rowp * RESTC + c);
                    u32x2 vn = *(const u32x2*)(REST + (size_t)rown * RESTC + c);
                    if (!hp) { vp.x = 0; vp.y = 0; }
                    if (!hn) { vn.x = 0; vn.y = 0; }
                    const f32x4 m4 = *(const f32x4*)(mu + c);
                    float pc[4] = {bflo(vc.x), bfhi(vc.x), bflo(vc.y), bfhi(vc.y)};
                    float pp[4] = {bflo(vp.x), bfhi(vp.x), bflo(vp.y), bfhi(vp.y)};
                    float pn[4] = {bflo(vn.x), bfhi(vn.x), bflo(vn.y), bfhi(vn.y)};
                    float o[4];
#pragma unroll
                    for (int i = 0; i < 4; ++i) o[i] = pc[i] + m4[i] * (0.5f * (pp[i] + pn[i]) - pc[i]);
                    if (j == 6) {
                        if (lane < 16) { for (int i = 0; i < 4; ++i) o[i] = tanhf(o[i]); }
                        else if (lane >= 32) { for (int i = 0; i < 4; ++i) o[i] = sigmoidf_(o[i]); }
                    }
                    u32x2 ov; ov.x = pk2(o[0], o[1]); ov.y = pk2(o[2], o[3]);
                    bf16_t* dst = j < 2 ? Rr + (size_t)row * 512 + c : (j < 4 ? KR + (size_t)row * 512 + (c - 512) : (j < 6 ? VV + (size_t)row * 512 + (c - 1024) : LOW + (size_t)row * 256 + (c - 1536)));
                    *(u32x2*)dst = ov;
                }
            }
}


__device__ __forceinline__ void phase_4(CParams& P, unsigned char* lds, const int ph) {
    PHASE_PROLOGUE
            const int nrt = (NT + 127) / 128;
            const int nunits = nrt * 4 * 5;
            for (int u = bid; u < nunits; u += G) {
                const int which = u / (nrt * 4), rem = u % (nrt * 4), rt = rem / 4, ct = rem % 4;
                f32x4 acc[4][2];
                const int koff = which < 2 ? 0 : (which < 4 ? 64 : 128), KK_ = which < 4 ? 64 : 128;
                const float* Bsrc = which < 2 ? w_up + (size_t)which * 64 * 512 : (which < 4 ? a_up + (size_t)(which - 2) * 64 * 512 : g_up);
                gemm_tile(lds, KK_, 512,
                          [&](int r) { int row = rt * 128 + r; if (row >= NT) row = NT - 1; return LOW + (size_t)row * 256 + koff; },
                          [&](int n) { return Bsrc + ct * 128 + n; }, acc);
                ACC_FOREACH(acc, { const int row = rt * 128 + rl, col = ct * 128 + cl; if (row < NT) {
                    if (which < 2) { const float wl = w0[which * 512 + col] + val; LW[((size_t)which * NT + row) * 512 + col] = (_Float16)(-0.6065306597f * sigmoidf_(wl)); }
                    else if (which < 4) { const int d = which - 2; AA[((size_t)d * NT + row) * 512 + col] = (bf16_t)f2bf(sigmoidf_(a0[d * 512 + col] + val)); }
                    else Gg[(size_t)row * 512 + col] = (bf16_t)f2bf(val); } });
            }
}


__device__ __forceinline__ void phase_5(CParams& P, unsigned char* lds, const int ph) {
    PHASE_PROLOGUE
            for (int row = gw; row < NT; row += NGW) {
                const int c0 = lane * 8;
                const u32x4 krv = *(const u32x4*)(KR + (size_t)row * 512 + c0);
                const u32x4 rv = *(const u32x4*)(Rr + (size_t)row * 512 + c0);
                float kr[8], rr[8], kkv[8];
#pragma unroll
                for (int i = 0; i < 4; ++i) { kr[2 * i] = bflo(krv[i]); kr[2 * i + 1] = bfhi(krv[i]); rr[2 * i] = bflo(rv[i]); rr[2 * i + 1] = bfhi(rv[i]); }
                float ss = 0.f;
#pragma unroll
                for (int i = 0; i < 8; ++i) { kkv[i] = kr[i] * k_k[c0 + i]; ss += kkv[i] * kkv[i]; }
                ss += __shfl_xor(ss, 1); ss += __shfl_xor(ss, 2); ss += __shfl_xor(ss, 4);
                const float inv = 1.f / fmaxf(sqrtf(ss), 1e-12f);
#pragma unroll
                for (int i = 0; i < 8; ++i) kkv[i] *= inv;
                u32x4 o; o.x = pk2(kkv[0], kkv[1]); o.y = pk2(kkv[2], kkv[3]); o.z = pk2(kkv[4], kkv[5]); o.w = pk2(kkv[6], kkv[7]);
                *(u32x4*)(KK + (size_t)row * 512 + c0) = o;
                float bsum = 0.f;
#pragma unroll
                for (int d = 0; d < 2; ++d) {
                    const u32x4 av = *(const u32x4*)(AA + ((size_t)d * NT + row) * 512 + c0);
                    float a[8], kka[8], kd[8];
#pragma unroll
                    for (int i = 0; i < 4; ++i) { a[2 * i] = bflo(av[i]); a[2 * i + 1] = bfhi(av[i]); }
#pragma unroll
                    for (int i = 0; i < 8; ++i) { kka[i] = kkv[i] * a[i]; kd[i] = kr[i] * (1.f + (a[i] - 1.f) * k_a[c0 + i]); bsum += rr[i] * kd[i] * r_k[c0 + i]; }
                    u32x4 o1; o1.x = pk2(kka[0], kka[1]); o1.y = pk2(kka[2], kka[3]); o1.z = pk2(kka[4], kka[5]); o1.w = pk2(kka[6], kka[7]);
                    *(u32x4*)(KKA + ((size_t)d * NT + row) * 512 + c0) = o1;
                    u32x4 o2; o2.x = pk2(kd[0], kd[1]); o2.y = pk2(kd[2], kd[3]); o2.z = pk2(kd[4], kd[5]); o2.w = pk2(kd[6], kd[7]);
                    *(u32x4*)(KD + ((size_t)d * NT + row) * 512 + c0) = o2;
                }
                bsum += __shfl_xor(bsum, 1); bsum += __shfl_xor(bsum, 2); bsum += __shfl_xor(bsum, 4);
                if ((lane & 7) == 0) BC[(size_t)row * 8 + (lane >> 3)] = bsum;
            }
}


#define RWS 72
__device__ __forceinline__ bf16x8 rw_frag(const bf16_t* M, int row, int kofs) { return *(const bf16x8*)(M + row * RWS + kofs); }
__device__ __forceinline__ f32x4 rw_tile(const bf16_t* Am, int ra, const bf16_t* Bm, int rb, int fr, int fq) {
    f32x4 acc = (f32x4){0.f, 0.f, 0.f, 0.f};
    acc = __builtin_amdgcn_mfma_f32_16x16x32_bf16(rw_frag(Am, ra + fr, 8 * fq), rw_frag(Bm, rb + fr, 8 * fq), acc, 0, 0, 0);
    acc = __builtin_amdgcn_mfma_f32_16x16x32_bf16(rw_frag(Am, ra + fr, 32 + 8 * fq), rw_frag(Bm, rb + fr, 32 + 8 * fq), acc, 0, 0, 0);
    return acc;
}
__device__ __forceinline__ void phase_6(CParams& P, unsigned char* lds, const int ph) {
    PHASE_PROLOGUE
    float* Gs = (float*)lds;
    bf16_t* A_rm = (bf16_t*)(lds + 16384); bf16_t* R_rm = A_rm + 64 * RWS; bf16_t* B_rm = R_rm + 64 * RWS; bf16_t* K_rm = B_rm + 64 * RWS;
    bf16_t* B_tr = K_rm + 64 * RWS; bf16_t* K_tr = B_tr + 64 * RWS; bf16_t* V_tr = K_tr + 64 * RWS;
    bf16_t* MAK = V_tr + 64 * RWS; bf16_t* MRB = MAK + 64 * RWS; bf16_t* MRK = MRB + 64 * RWS;
    float* G1 = (float*)(MRK + 64 * RWS);
    float* BT = G1 + 4096; float* OFF = BT + 512; float* GC = OFF + 512;
    bf16_t* X1_tr = A_rm; bf16_t* X2_tr = K_rm;
    for (int i = tid; i < 3 * 64 * RWS / 2; i += 512) ((unsigned*)MAK)[i] = 0u;
    __syncthreads();
    const int fr = lane & 15, fq = lane >> 4;
    for (int u = bid; u < RW_UNITS; u += G) {
        const int chain = u / RW_NCH, c = u - chain * RW_NCH, d = chain >> 4, b = (chain >> 3) & 1, h = chain & 7;
        const int t0 = tid >> 3, kp = (tid & 7) * 8;
        float lw[8], kk[8], ka[8], kd[8], rr[8]; u32x4 vv;
        {
            const int s = c * 64 + t0; const bool valid = s < LSEQ;
            const int p = d ? LSEQ - 1 - s : s; const size_t o = (size_t)rowof(b, valid ? p : 0) * 512 + h * 64 + kp;
            const u32x4 lwv = *(const u32x4*)(LW + (size_t)d * NT * 512 + o), kkv = *(const u32x4*)(KK + o), kav = *(const u32x4*)(KKA + (size_t)d * NT * 512 + o),
                        kdv = *(const u32x4*)(KD + (size_t)d * NT * 512 + o), rv = *(const u32x4*)(Rr + o);
            vv = *(const u32x4*)(VV + o);
#pragma unroll
            for (int i = 0; i < 4; ++i) {
                union { unsigned u; _Float16 hh[2]; } cv; cv.u = lwv[i];
                lw[2 * i] = valid ? (float)cv.hh[0] : 0.f; lw[2 * i + 1] = valid ? (float)cv.hh[1] : 0.f;
                kk[2 * i] = valid ? bflo(kkv[i]) : 0.f; kk[2 * i + 1] = valid ? bfhi(kkv[i]) : 0.f;
                ka[2 * i] = valid ? bflo(kav[i]) : 0.f; ka[2 * i + 1] = valid ? bfhi(kav[i]) : 0.f;
                kd[2 * i] = valid ? bflo(kdv[i]) : 0.f; kd[2 * i + 1] = valid ? bfhi(kdv[i]) : 0.f;
                rr[2 * i] = valid ? bflo(rv[i]) : 0.f; rr[2 * i + 1] = valid ? bfhi(rv[i]) : 0.f;
                if (!valid) vv[i] = 0u;
            }
        }
        *(f32x4*)(Gs + t0 * 64 + kp) = (f32x4){lw[0], lw[1], lw[2], lw[3]}; *(f32x4*)(Gs + t0 * 64 + kp + 4) = (f32x4){lw[4], lw[5], lw[6], lw[7]};
        __syncthreads();
        { const int k = tid & 63, w = tid >> 6; float acc = 0.f;
#pragma unroll
          for (int i = 0; i < 8; ++i) { acc += Gs[(8 * w + i) * 64 + k]; Gs[(8 * w + i) * 64 + k] = acc; }
          BT[w * 64 + k] = acc; }
        __syncthreads();
        { const int k = tid & 63, w = tid >> 6; float off = 0.f; for (int w2 = 0; w2 < w; ++w2) off += BT[w2 * 64 + k]; OFF[w * 64 + k] = off; }
        __syncthreads();
        {
            float va[8], vr[8], vb[8], vk[8];
#pragma unroll
            for (int i = 0; i < 8; ++i) {
                const float g = Gs[t0 * 64 + kp + i] + OFF[(t0 >> 3) * 64 + kp + i];
                const float eg = __expf(g), egm1 = __expf(g - lw[i]), einv = __expf(-g);
                va[i] = kk[i] * egm1; vr[i] = rr[i] * eg; vb[i] = ka[i] * einv; vk[i] = kd[i] * einv;
                if (t0 == 63) GC[kp + i] = eg;
            }
            u32x4 w4;
            w4.x = pk2(va[0], va[1]); w4.y = pk2(va[2], va[3]); w4.z = pk2(va[4], va[5]); w4.w = pk2(va[6], va[7]); *(u32x4*)(A_rm + t0 * RWS + kp) = w4;
            w4.x = pk2(vr[0], vr[1]); w4.y = pk2(vr[2], vr[3]); w4.z = pk2(vr[4], vr[5]); w4.w = pk2(vr[6], vr[7]); *(u32x4*)(R_rm + t0 * RWS + kp) = w4;
            w4.x = pk2(vb[0], vb[1]); w4.y = pk2(vb[2], vb[3]); w4.z = pk2(vb[4], vb[5]); w4.w = pk2(vb[6], vb[7]); *(u32x4*)(B_rm + t0 * RWS + kp) = w4;
            w4.x = pk2(vk[0], vk[1]); w4.y = pk2(vk[2], vk[3]); w4.z = pk2(vk[4], vk[5]); w4.w = pk2(vk[6], vk[7]); *(u32x4*)(K_rm + t0 * RWS + kp) = w4;
#pragma unroll
            for (int i = 0; i < 8; ++i) { B_tr[(kp + i) * RWS + t0] = (bf16_t)f2bf(vb[i]); K_tr[(kp + i) * RWS + t0] = (bf16_t)f2bf(vk[i]);
                V_tr[(kp + i) * RWS + t0] = (bf16_t)((i & 1) ? (vv[i >> 1] >> 16) : (vv[i >> 1] & 0xffffu)); }
        }
        __syncthreads();
        float* MABQ = Gs;
        for (int q = wave; q < 40; q += 8) {
            const int m = q / 10, e = q - m * 10, ti = e >= 6 ? 3 : (e >= 3 ? 2 : (e >= 1 ? 1 : 0)), tj = e - (ti * (ti + 1)) / 2;
            const f32x4 acc = rw_tile(m < 2 ? A_rm : R_rm, 16 * ti, (m & 1) ? K_rm : B_rm, 16 * tj, fr, fq);
            bf16_t* Mm = m == 1 ? MAK : (m == 2 ? MRB : MRK);
#pragma unroll
            for (int j = 0; j < 4; ++j) { const int t = 16 * ti + 4 * fq + j, i = 16 * tj + fr; const bool keep = m < 2 ? (i < t) : (i <= t); const float val = keep ? acc[j] : 0.f;
                if (m == 0) MABQ[((i & 3) * 64 + t) * 16 + (i >> 2)] = val; else Mm[t * RWS + i] = (bf16_t)f2bf(val); }
        }
        __syncthreads();
        for (int q = wave; q < 16; q += 8) { const int ti = q >> 2, tv = q & 3; const f32x4 acc = rw_tile(MAK, 16 * ti, V_tr, 16 * tv, fr, fq);
#pragma unroll
            for (int j = 0; j < 4; ++j) G1[(16 * ti + 4 * fq + j) * 64 + 16 * tv + fr] = acc[j]; }
        __syncthreads();
        {
            const int col = tid >> 2, q = tid & 3;
            float xs[16];
#pragma unroll
            for (int m = 0; m < 16; ++m) xs[m] = 0.f;
#pragma unroll
            for (int t = 0; t < 64; ++t) {
                float part = 0.f;
#pragma unroll
                for (int jg = 0; jg <= (t >> 4); ++jg) { const f32x4 mv = *(const f32x4*)(MABQ + (q * 64 + t) * 16 + 4 * jg);
                    part += mv[0] * xs[4 * jg] + mv[1] * xs[4 * jg + 1] + mv[2] * xs[4 * jg + 2] + mv[3] * xs[4 * jg + 3]; }
                part += dppf<0xB1>(part); part += dppf<0x4E>(part);
                const float rhs = col < 64 ? bf2f(A_rm[t * RWS + col]) : G1[t * 64 + col - 64];
                const float xt = rhs - part;
                xs[t >> 2] = (t & 3) == q ? xt : xs[t >> 2];
            }
            __syncthreads();
            bf16_t* Xm = (col < 64 ? X1_tr : X2_tr) + (col & 63) * RWS + q;
#pragma unroll
            for (int m = 0; m < 16; ++m) Xm[4 * m] = (bf16_t)f2bf(xs[m]);
        }
        __syncthreads();
        for (int q = wave; q < 64; q += 8) {
            const int kind = q >> 4, ta = (q >> 2) & 3, tb = q & 3;
            u32x2 o;
            if (kind == 0) {
                const f32x4 acc = rw_tile(X1_tr, 16 * ta, B_tr, 16 * tb, fr, fq);
                const int k = 16 * tb + fr, kq = 16 * ta + 4 * fq; const float gc = GC[k];
                float v[4];
#pragma unroll
                for (int j = 0; j < 4; ++j) v[j] = gc * ((kq + j == k ? 1.f : 0.f) - acc[j]);
                o.x = pk2(v[0], v[1]); o.y = pk2(v[2], v[3]);
                *(u32x2*)(PP + (size_t)u * 4096 + k * 64 + kq) = o;
            } else if (kind == 1) {
                const f32x4 acc = rw_tile(X1_tr, 16 * ta, MRB, 16 * tb, fr, fq);
                const int t = 16 * tb + fr, k0 = 16 * ta + 4 * fq;
                const u32x2 rv = *(const u32x2*)(R_rm + t * RWS + k0);
                o.x = pk2(bflo(rv.x) - acc[0], bfhi(rv.x) - acc[1]); o.y = pk2(bflo(rv.y) - acc[2], bfhi(rv.y) - acc[3]);
                *(u32x2*)(YT + (size_t)u * 4096 + t * 64 + k0) = o;
            } else if (kind == 2) {
                const f32x4 a1 = rw_tile(K_tr, 16 * ta, V_tr, 16 * tb, fr, fq), a2 = rw_tile(B_tr, 16 * ta, X2_tr, 16 * tb, fr, fq);
                const int v_ = 16 * tb + fr, k0 = 16 * ta + 4 * fq;
                const f32x4 gc = *(const f32x4*)(GC + k0);
                o.x = pk2(gc[0] * (a1[0] - a2[0]), gc[1] * (a1[1] - a2[1])); o.y = pk2(gc[2] * (a1[2] - a2[2]), gc[3] * (a1[3] - a2[3]));
                *(u32x2*)(QT + (size_t)u * 4096 + v_ * 64 + k0) = o;
            } else {
                const f32x4 a1 = rw_tile(MRK, 16 * ta, V_tr, 16 * tb, fr, fq), a2 = rw_tile(MRB, 16 * ta, X2_tr, 16 * tb, fr, fq);
                const int v_ = 16 * tb + fr, t0_ = 16 * ta + 4 * fq;
                o.x = pk2(a1[0] - a2[0], a1[1] - a2[1]); o.y = pk2(a1[2] - a2[2], a1[3] - a2[3]);
                *(u32x2*)(ZT + (size_t)u * 4096 + v_ * 64 + t0_) = o;
            }
        }
        __syncthreads();
    }
}

__device__ __forceinline__ void phase_60(CParams& P, unsigned char* lds, const int ph) {
    PHASE_PROLOGUE
    if (wave == 0 && bid < 128) {
        const int chain = bid >> 2, vb = bid & 3, d = chain >> 4, b = (chain >> 3) & 1, h = chain & 7;
        const int fr = lane & 15, fq = lane >> 4;
        const f32x4 zero4 = (f32x4){0.f, 0.f, 0.f, 0.f};
        f32x4 S[4] = {zero4, zero4, zero4, zero4};
        const size_t cb = (size_t)chain * RW_NCH * 4096;
        const bf16_t* Pp = PP + cb + fr * 64 + 4 * fq; const bf16_t* Yp = YT + cb + fr * 64 + 4 * fq;
        const bf16_t* Qp = QT + cb + (16 * vb + fr) * 64 + 4 * fq; const bf16_t* Zp = ZT + cb + (16 * vb + fr) * 64 + 4 * fq;
        u32x2 npl[4][2], nph[4][2], nyl[4][2], nyh[4][2], nq[4], nz[4];
#define RW2_LOAD(c_) do { const size_t co_ = (size_t)(c_) * 4096; _Pragma("unroll") for (int a_ = 0; a_ < 4; ++a_) { _Pragma("unroll") for (int ks_ = 0; ks_ < 2; ++ks_) { \
            npl[a_][ks_] = *(const u32x2*)(Pp + co_ + a_ * 1024 + 32 * ks_); nph[a_][ks_] = *(const u32x2*)(Pp + co_ + a_ * 1024 + 32 * ks_ + 16); \
            nyl[a_][ks_] = *(const u32x2*)(Yp + co_ + a_ * 1024 + 32 * ks_); nyh[a_][ks_] = *(const u32x2*)(Yp + co_ + a_ * 1024 + 32 * ks_ + 16); } \
            nq[a_] = *(const u32x2*)(Qp + co_ + 16 * a_); nz[a_] = *(const u32x2*)(Zp + co_ + 16 * a_); } } while (0)
        RW2_LOAD(0);
        for (int c = 0; c < RW_NCH; ++c) {
            u32x2 pl[4][2], phh[4][2], yl[4][2], yh[4][2], cq[4], cz[4];
#pragma unroll
            for (int a_ = 0; a_ < 4; ++a_) { pl[a_][0] = npl[a_][0]; pl[a_][1] = npl[a_][1]; phh[a_][0] = nph[a_][0]; phh[a_][1] = nph[a_][1];
                yl[a_][0] = nyl[a_][0]; yl[a_][1] = nyl[a_][1]; yh[a_][0] = nyh[a_][0]; yh[a_][1] = nyh[a_][1]; cq[a_] = nq[a_]; cz[a_] = nz[a_]; }
            if (c + 1 < RW_NCH) RW2_LOAD(c + 1);
            union { bf16x8 v; unsigned u[4]; } bs[2];
#pragma unroll
            for (int ks = 0; ks < 2; ++ks) { bs[ks].u[0] = pk2(S[2 * ks][0], S[2 * ks][1]); bs[ks].u[1] = pk2(S[2 * ks][2], S[2 * ks][3]);
                bs[ks].u[2] = pk2(S[2 * ks + 1][0], S[2 * ks + 1][1]); bs[ks].u[3] = pk2(S[2 * ks + 1][2], S[2 * ks + 1][3]); }
#pragma unroll
            for (int tt = 0; tt < 4; ++tt) {
                f32x4 acc = (f32x4){bflo(cz[tt].x), bfhi(cz[tt].x), bflo(cz[tt].y), bfhi(cz[tt].y)};
#pragma unroll
                for (int ks = 0; ks < 2; ++ks) { union { bf16x8 v; u32x2 h2[2]; } af; af.h2[0] = yl[tt][ks]; af.h2[1] = yh[tt][ks];
                    acc = __builtin_amdgcn_mfma_f32_16x16x32_bf16(af.v, bs[ks].v, acc, 0, 0, 0); }
#pragma unroll
                for (int j = 0; j < 4; ++j) { const int s = c * 64 + 16 * tt + 4 * fq + j;
                    if (s < LSEQ) { const int p = d ? LSEQ - 1 - s : s; YFB[((size_t)d * NT + rowof(b, p)) * 512 + h * 64 + 16 * vb + fr] = (bf16_t)f2bf(acc[j]); } }
            }
            f32x4 Sn[4];
#pragma unroll
            for (int kt = 0; kt < 4; ++kt) {
                f32x4 acc = (f32x4){bflo(cq[kt].x), bfhi(cq[kt].x), bflo(cq[kt].y), bfhi(cq[kt].y)};
#pragma unroll
                for (int ks = 0; ks < 2; ++ks) { union { bf16x8 v; u32x2 h2[2]; } af; af.h2[0] = pl[kt][ks]; af.h2[1] = phh[kt][ks];
                    acc = __builtin_amdgcn_mfma_f32_16x16x32_bf16(af.v, bs[ks].v, acc, 0, 0, 0); }
                Sn[kt] = acc;
            }
#pragma unroll
            for (int kt = 0; kt < 4; ++kt) S[kt] = Sn[kt];
        }
#undef RW2_LOAD
    }
}

__device__ __forceinline__ void phase_7(CParams& P, unsigned char* lds, const int ph) {
    PHASE_PROLOGUE
            for (int row = gw; row < NT; row += NGW) {
                const int c0 = lane * 8;
                const u32x4 yf = *(const u32x4*)(YFB + (size_t)row * 512 + c0);
                const u32x4 yb = *(const u32x4*)(YFB + ((size_t)NT + row) * 512 + c0);
                const u32x4 vv = *(const u32x4*)(VV + (size_t)row * 512 + c0);
                const u32x4 gg = *(const u32x4*)(Gg + (size_t)row * 512 + c0);
                float y[8], v[8], g[8];
#pragma unroll
                for (int i = 0; i < 4; ++i) { y[2 * i] = bflo(yf[i]) + bflo(yb[i]); y[2 * i + 1] = bfhi(yf[i]) + bfhi(yb[i]); v[2 * i] = bflo(vv[i]); v[2 * i + 1] = bfhi(vv[i]); g[2 * i] = bflo(gg[i]); g[2 * i + 1] = bfhi(gg[i]); }
                float sm = 0.f;
#pragma unroll
                for (int i = 0; i < 8; ++i) sm += y[i];
                sm += __shfl_xor(sm, 1); sm += __shfl_xor(sm, 2); sm += __shfl_xor(sm, 4);
                const float mean = sm * (1.f / 64.f);
                float vr = 0.f;
#pragma unroll
                for (int i = 0; i < 8; ++i) { const float dlt = y[i] - mean; vr += dlt * dlt; }
                vr += __shfl_xor(vr, 1); vr += __shfl_xor(vr, 2); vr += __shfl_xor(vr, 4);
                const float rstd = rsqrtf(vr * (1.f / 64.f) + 64e-5f);
                const float bc = BC[(size_t)row * 8 + (lane >> 3)];
                float o[8];
#pragma unroll
                for (int i = 0; i < 8; ++i) o[i] = ((y[i] - mean) * rstd * lnx_g[c0 + i] + lnx_b[c0 + i] + bc * v[i]) * g[i];
                u32x4 ov; ov.x = pk2(o[0], o[1]); ov.y = pk2(o[2], o[3]); ov.z = pk2(o[4], o[5]); ov.w = pk2(o[6], o[7]);
                *(u32x4*)(A2 + (size_t)row * DM + 512 + c0) = ov;
            }
}


__device__ __forceinline__ void phase_8(CParams& P, unsigned char* lds, const int ph) {
    PHASE_PROLOGUE
    if (gw < 64) meta_gemm<0>(A2 + (size_t)NMAIN * DM, WTOUT, H + (size_t)NMAIN * DM, gw, lane);
    pg8::DenseOrder S; S.init(A2, WTOUT, NMAIN, DM, DM, G, bid);
    pg8::EpiResidual E{H};
    pg8::gemm_phase<pg8::EpiResidual, pg8::DenseOrder, true, true>((PG8_LAS unsigned char*)lds, DM, S, E);
}

__device__ __forceinline__ void phase_9(CParams& P, unsigned char* lds, const int ph) {
    PHASE_PROLOGUE
            const int l = ph == 9 ? 0 : 1;
                    unsigned* cnt = CTL + CW_CNT(l);
            const float* wg = moe_wg + (size_t)l * DM * 4; const float* bg = moe_bg + l * 4;
            for (int row = gw; row < NT; row += NGW) {
                f32x4 v[4]; float ss = 0.f;
#pragma unroll
                for (int j = 0; j < 4; ++j) { v[j] = ((const f32x4*)(H + (size_t)row * DM))[lane + 64 * j]; ss += v[j][0] * v[j][0] + v[j][1] * v[j][1] + v[j][2] * v[j][2] + v[j][3] * v[j][3]; }
                ss = wave_sum(ss);
                const float rstd = rsqrtf(ss * (1.f / DM) + 1e-6f);
                float lg[4] = {0.f, 0.f, 0.f, 0.f};
#pragma unroll
                for (int j = 0; j < 4; ++j) {
                    const f32x4 g = ((const f32x4*)(norm_ffn + l * DM))[lane + 64 * j];
#pragma unroll
                    for (int i = 0; i < 4; ++i) v[j][i] = v[j][i] * rstd * g[i];
                    u32x2 o; o.x = pk2(v[j][0], v[j][1]); o.y = pk2(v[j][2], v[j][3]);
                    ((u32x2*)(HN + (size_t)row * DM))[lane + 64 * j] = o;
#pragma unroll
                    for (int i = 0; i < 4; ++i) { const f32x4 w = *(const f32x4*)(wg + (size_t)(4 * (lane + 64 * j) + i) * 4);
                        lg[0] += v[j][i] * w[0]; lg[1] += v[j][i] * w[1]; lg[2] += v[j][i] * w[2]; lg[3] += v[j][i] * w[3]; }
                }
#pragma unroll
                for (int q = 0; q < 4; ++q) lg[q] = wave_sum(lg[q]) + bg[q];
                int grp = 0; float mx = lg[0];
#pragma unroll
                for (int q = 1; q < 4; ++q) if (lg[q] > mx) { mx = lg[q]; grp = q; }
                float den = 0.f;
#pragma unroll
                for (int q = 0; q < 4; ++q) den += __expf(lg[q] - mx);
                const float pgrp = 1.f / den;
                const float* we = moe_we + ((size_t)(l * 4 + grp) * DM) * 8;
                float le[8] = {0.f, 0.f, 0.f, 0.f, 0.f, 0.f, 0.f, 0.f};
#pragma unroll
                for (int j = 0; j < 4; ++j)
#pragma unroll
                    for (int i = 0; i < 4; ++i) { const float* wr_ = we + (size_t)(4 * (lane + 64 * j) + i) * 8; const f32x4 wa = *(const f32x4*)wr_, wb = *(const f32x4*)(wr_ + 4);
                        le[0] += v[j][i] * wa[0]; le[1] += v[j][i] * wa[1]; le[2] += v[j][i] * wa[2]; le[3] += v[j][i] * wa[3];
                        le[4] += v[j][i] * wb[0]; le[5] += v[j][i] * wb[1]; le[6] += v[j][i] * wb[2]; le[7] += v[j][i] * wb[3]; }
#pragma unroll
                for (int q = 0; q < 8; ++q) le[q] = wave_sum(le[q]) + moe_be[(l * 4 + grp) * 8 + q];
                int i1 = 0; float m1 = le[0];
#pragma unroll
                for (int q = 1; q < 8; ++q) if (le[q] > m1) { m1 = le[q]; i1 = q; }
                int i2 = -1; float m2 = -3.0e38f;
#pragma unroll
                for (int q = 0; q < 8; ++q) if (q != i1 && le[q] > m2) { m2 = le[q]; i2 = q; }
                const float e2 = __expf(m2 - m1);
                const float g1 = pgrp / (1.f + e2), g2 = pgrp * e2 / (1.f + e2);
                if (lane == 0) {
                    const int ea = grp * 8 + i1, eb = grp * 8 + i2;
                    const unsigned pa = atomicAdd(cnt + ea, 1u), pb = atomicAdd(cnt + eb, 1u);
                    EID[row * 2] = ea; EID[row * 2 + 1] = eb; POS[row * 2] = (int)pa; POS[row * 2 + 1] = (int)pb;
                    GATE[row * 2] = g1; GATE[row * 2 + 1] = g2;
                }
            }
    for (int it = gw; it < CONV_MOE_ITEMS; it += NGW) conv_moe_item(P, l, it, lane);
}


__device__ __forceinline__ void phase_10(CParams& P, unsigned char* lds, const int ph) {
    PHASE_PROLOGUE
    const int l = ph == 10 ? 0 : 1;
    int* ps = (int*)(lds + LDS_TAB);
    if (tid == 0) { int acc_ = 0; for (int e = 0; e < NEXP; ++e) { ps[e] = acc_; const int c = (int)CTL[CW_CNT(l) + e]; acc_ += (c + MOE_RT - 1) / MOE_RT * MOE_RT; } ps[NEXP] = acc_; }
    __syncthreads();
    for (int row = gw; row < NT; row += NGW) {
        const u32x4 v0 = ((const u32x4*)(HN + (size_t)row * DM))[lane], v1 = ((const u32x4*)(HN + (size_t)row * DM))[lane + 64];
#pragma unroll
        for (int k = 0; k < 2; ++k) {
            const int dest = ps[EID[row * 2 + k]] + POS[row * 2 + k];
            if (lane == 0) DEST[row * 2 + k] = dest;
            ((u32x4*)(XB + (size_t)dest * DM))[lane] = v0; ((u32x4*)(XB + (size_t)dest * DM))[lane + 64] = v1;
        }
    }
    __syncthreads();
}

__device__ __forceinline__ void phase_11(CParams& P, unsigned char* lds, const int ph) {
    PHASE_PROLOGUE
    const int l = ph == 11 ? 0 : 1;
    int* et = (int*)(lds + LDS_TAB);
    if (tid == 0) { int acc_ = 0; for (int e = 0; e < NEXP; ++e) { const int c = (int)CTL[CW_CNT(l) + e], n = (c + MOE_RT - 1) / MOE_RT; for (int q = 0; q < n; ++q) et[1 + acc_ + q] = e; acc_ += n; } et[0] = acc_; }
    __syncthreads();
    pg8::MoeOrder S{et + 1, et[0], vcu, (const char*)XB, (const char*)WT13, 256u * DM * 2u, 256u * DM * 2u, (unsigned)DM * DM * 2u};
    pg8::EpiSwiglu E{HB};
    pg8::gemm_phase<pg8::EpiSwiglu, pg8::MoeOrder, true, true>((PG8_LAS unsigned char*)lds, DM, S, E);
    __syncthreads();
}

__device__ __forceinline__ void phase_12(CParams& P, unsigned char* lds, const int ph) {
    PHASE_PROLOGUE
    const int l = ph == 12 ? 0 : 1;
    int* et = (int*)(lds + LDS_TAB);
    if (tid == 0) { int acc_ = 0; for (int e = 0; e < NEXP; ++e) { const int c = (int)CTL[CW_CNT(l) + e], n = (c + MOE_RT - 1) / MOE_RT; for (int q = 0; q < n; ++q) et[1 + acc_ + q] = e; acc_ += n; } et[0] = acc_; }
    __syncthreads();
    pg8::MoeOrder S{et + 1, et[0], vcu, (const char*)HB, (const char*)WT2, 256u * DFF * 2u, 256u * DFF * 2u, (unsigned)DM * DFF * 2u};
    pg8::EpiBf16Plain E{YB, DM};
    pg8::gemm_phase<pg8::EpiBf16Plain, pg8::MoeOrder, true, true>((PG8_LAS unsigned char*)lds, DFF, S, E);
    __syncthreads();
}

__device__ __forceinline__ void phase_13(CParams& P, unsigned char* lds, const int ph) {
    PHASE_PROLOGUE
            const bool fin = ph == 21;
            for (int row = gw; row < NT; row += NGW) {
                const int d0 = DEST[row * 2], d1 = DEST[row * 2 + 1];
                const float g0 = GATE[row * 2], g1 = GATE[row * 2 + 1];
                f32x4 v[4];
#pragma unroll
                for (int j = 0; j < 4; ++j) {
                    v[j] = ((const f32x4*)(H + (size_t)row * DM))[lane + 64 * j];
                    const u32x2 ya = ((const u32x2*)(YB + (size_t)d0 * DM))[lane + 64 * j];
                    const u32x2 yb = ((const u32x2*)(YB + (size_t)d1 * DM))[lane + 64 * j];
                    v[j][0] += g0 * bflo(ya.x) + g1 * bflo(yb.x); v[j][1] += g0 * bfhi(ya.x) + g1 * bfhi(yb.x);
                    v[j][2] += g0 * bflo(ya.y) + g1 * bflo(yb.y); v[j][3] += g0 * bfhi(ya.y) + g1 * bfhi(yb.y);
                }
                if (!fin) {
#pragma unroll
                    for (int j = 0; j < 4; ++j) ((f32x4*)(H + (size_t)row * DM))[lane + 64 * j] = v[j];
                    store_norm_bf16(v, norm_mix + DM, HN + (size_t)row * DM, lane);
                } else if (row < NMAIN) {
                    float ss = 0.f;
#pragma unroll
                    for (int j = 0; j < 4; ++j) ss += v[j][0] * v[j][0] + v[j][1] * v[j][1] + v[j][2] * v[j][2] + v[j][3] * v[j][3];
                    ss = wave_sum(ss);
                    const float rstd = rsqrtf(ss * (1.f / DM) + 1e-6f);
#pragma unroll
                    for (int j = 0; j < 4; ++j) { const f32x4 g = ((const f32x4*)norm_final)[lane + 64 * j]; f32x4 o;
                        o[0] = v[j][0] * rstd * g[0]; o[1] = v[j][1] * rstd * g[1]; o[2] = v[j][2] * rstd * g[2]; o[3] = v[j][3] * rstd * g[3];
                        ((f32x4*)(P.out + (size_t)row * DM))[lane + 64 * j] = o; }
                }
            }
}

__device__ __forceinline__ void phase_14(CParams& P, unsigned char* lds, const int ph) {
    PHASE_PROLOGUE
    float* pwr = (float*)lds; float* pwi = pwr + 2176; float* bbr = pwi + 2176; float* bbi = bbr + 2048; float* ccr = bbi + 2048; float* cci = ccr + 2048; float* kf = cci + 2048; float* kb = kf + 4096;
    for (int g = bid; g < 64; g += G) {
        if (tid < 128) {
            const int d = tid >> 6, p = tid & 63;
            const float step = __expf(s5_ls[d * 64 + g]);
            const float lr = s5_lre[(d * 64 + g) * 64 + p], li = s5_lim[(d * 64 + g) * 64 + p];
            const float mag = expf(lr * step);
            const float abr = mag * cosf(li * step), abi = mag * sinf(li * step);
            const float den = lr * lr + li * li;
            const float zr = ((abr - 1.f) * lr + abi * li) / den, zi = (abi * lr - (abr - 1.f) * li) / den;
            float pr = 1.f, pi = 0.f;
            for (int t = 0; t < 17; ++t) { pwr[(d * 64 + p) * 17 + t] = pr; pwi[(d * 64 + p) * 17 + t] = pi; const float nr = pr * abr - pi * abi; pi = pr * abi + pi * abr; pr = nr; }
            for (int i = 0; i < 16; ++i) { const float br = s5_b_re[((size_t)(g * 64 + p)) * 16 + i], bi = s5_b_im[((size_t)(g * 64 + p)) * 16 + i];
                bbr[(d * 64 + p) * 16 + i] = zr * br - zi * bi; bbi[(d * 64 + p) * 16 + i] = zr * bi + zi * br; }
        }
        for (int idx = tid; idx < 2048; idx += 512) { const int d = idx >> 10, i = (idx >> 6) & 15, p = idx & 63;
            ccr[idx] = s5_c_re[((size_t)(d * 64 + g) * 16 + i) * 64 + p]; cci[idx] = s5_c_im[((size_t)(d * 64 + g) * 16 + i) * 64 + p]; }
        __syncthreads();
        {
            const int d = tid >> 8, tau = (tid >> 4) & 15, i = tid & 15;
            float acc[16];
#pragma unroll
            for (int q = 0; q < 16; ++q) acc[q] = 0.f;
            for (int p = 0; p < 64; ++p) {
                const float cr = ccr[(d * 16 + i) * 64 + p], ci = cci[(d * 16 + i) * 64 + p], pr = pwr[(d * 64 + p) * 17 + tau], pi = pwi[(d * 64 + p) * 17 + tau];
                const float xr = cr * pr - ci * pi, xi = cr * pi + ci * pr;
#pragma unroll
                for (int q = 0; q < 16; ++q) acc[q] += xr * bbr[(d * 64 + p) * 16 + q] - xi * bbi[(d * 64 + p) * 16 + q];
            }
            float* kt = (d ? kb : kf) + (tau * 16 + i) * 16;
#pragma unroll
            for (int q = 0; q < 16; ++q) kt[q] = acc[q];
        }
        __syncthreads();
        unsigned* bta = (unsigned*)(BTA + (size_t)g * 512 * 256);
        for (int idx = tid; idx < 512 * 128; idx += 512) {
            const int row = idx >> 7, col = (idx & 127) * 2;
            float v[2];
#pragma unroll
            for (int e = 0; e < 2; ++e) {
                const int cc_ = col + e, j = cc_ >> 4, ip = cc_ & 15;
                if (row < 256) { const int t = row >> 4, i = row & 15;
                    v[e] = j < t ? kf[((t - j) * 16 + i) * 16 + ip] : (j > t ? kb[((j - t) * 16 + i) * 16 + ip] : kf[i * 16 + ip] + kb[i * 16 + ip]); }
                else { const int kp = row - 256, d = kp >> 7, part = (kp >> 6) & 1, p = kp & 63, tau = d == 0 ? 15 - j : j;
                    const float pr = pwr[(d * 64 + p) * 17 + tau], pi = pwi[(d * 64 + p) * 17 + tau], br = bbr[(d * 64 + p) * 16 + ip], bi = bbi[(d * 64 + p) * 16 + ip];
                    v[e] = part ? pr * bi + pi * br : pr * br - pi * bi; }
            }
            bta[idx] = pk2(v[0], v[1]);
        }
        unsigned* btc = (unsigned*)(BTC + (size_t)g * 256 * 256);
        for (int idx = tid; idx < 256 * 128; idx += 512) {
            const int row = idx >> 7, col = (idx & 127) * 2, t = row >> 4, i = row & 15;
            float v[2];
#pragma unroll
            for (int e = 0; e < 2; ++e) {
                const int k = col + e, d = k >> 7, part = (k >> 6) & 1, p = k & 63, tau = d == 0 ? t + 1 : 16 - t;
                const float cr = ccr[(d * 16 + i) * 64 + p], ci = cci[(d * 16 + i) * 64 + p], pr = pwr[(d * 64 + p) * 17 + tau], pi = pwi[(d * 64 + p) * 17 + tau];
                v[e] = part ? -(cr * pi + ci * pr) : cr * pr - ci * pi;
            }
            btc[idx] = pk2(v[0], v[1]);
        }
        __syncthreads();
    }
}

__device__ __forceinline__ void phase_15(CParams& P, unsigned char* lds, const int ph) {
    PHASE_PROLOGUE
    pg8::S5OrderA S{vcu, (const char*)HN, (const char*)BTA};
    pg8::EpiS5A E{YI, S5E};
    int Kr = 256; asm volatile("" : "+s"(Kr));
    pg8::gemm_phase<pg8::EpiS5A, pg8::S5OrderA, true, true>((PG8_LAS unsigned char*)lds, Kr, S, E);
}

__device__ __forceinline__ void phase_16(CParams& P, unsigned char* lds, const int ph) {
    PHASE_PROLOGUE
    for (int i = bid * 512 + tid; i < NB * 64 * 2 * 64; i += G * 512) {
        const int p = i & 63, d = (i >> 6) & 1, g = (i >> 7) & 63, b = i >> 13;
        const float step = __expf(s5_ls[d * 64 + g]);
        const float lr = s5_lre[(d * 64 + g) * 64 + p], li = s5_lim[(d * 64 + g) * 64 + p];
        const float mag = expf(lr * step);
        const float abr = mag * cosf(li * step), abi = mag * sinf(li * step);
        float ar = 1.f, ai = 0.f;
        for (int t = 0; t < 16; ++t) { const float nr = ar * abr - ai * abi; ai = ar * abi + ai * abr; ar = nr; }
        const float* Ep = S5E + (size_t)g * 256 + d * 128 + p;
        bf16_t* Cp = CAR + (size_t)g * 1280 * 256 + d * 128 + p;
        float sr = 0.f, si = 0.f;
        for (int q0 = 0; q0 < 513; q0 += 9) {
            float er[9], ei[9]; int nn[9];
#pragma unroll
            for (int k = 0; k < 9; ++k) { const int q = q0 + k, c = d ? 512 - q : q; nn[k] = c == 0 ? 1024 + b : b * 512 + c - 1; er[k] = Ep[(size_t)nn[k] * 64 * 256]; ei[k] = Ep[(size_t)nn[k] * 64 * 256 + 64]; }
#pragma unroll
            for (int k = 0; k < 9; ++k) { Cp[(size_t)nn[k] * 256] = (bf16_t)f2bf(sr); Cp[(size_t)nn[k] * 256 + 64] = (bf16_t)f2bf(si);
                const float nr = ar * sr - ai * si + er[k]; si = ar * si + ai * sr + ei[k]; sr = nr; }
        }
    }
}

__device__ __forceinline__ void phase_22(CParams& P, unsigned char* lds, const int ph) {
    PHASE_PROLOGUE
    pg8::S5OrderC S{vcu, (const char*)CAR, (const char*)BTC};
    pg8::EpiS5C E{YI, HN, s5_d, A2};
    int Kr = 256; asm volatile("" : "+s"(Kr));
    pg8::gemm_phase<pg8::EpiS5C, pg8::S5OrderC, true, true>((PG8_LAS unsigned char*)lds, Kr, S, E);
}

__device__ __forceinline__ void phase_23(CParams& P, unsigned char* lds, const int ph) {
    PHASE_PROLOGUE
    if (gw < 64) meta_gemm<1>(A2 + (size_t)NMAIN * DM, WTGLU, H + (size_t)NMAIN * DM, gw, lane);
    pg8::DenseOrder S; S.init(A2, WTGLU, NMAIN, 2 * DM, DM, G, bid);
    pg8::EpiGlu E{H};
    pg8::gemm_phase<pg8::EpiGlu, pg8::DenseOrder, true, true>((PG8_LAS unsigned char*)lds, DM, S, E);
}
#define LAS __attribute__((address_space(3)))
#define CW_BAR 4096
#define XB_TMO      128
#define XB_XCNT(j)  (256  + 64 * (j))
#define XB_XSUB(j)  (1280 + 64 * (j))
#define XB_XGEN(j)  (2304 + 64 * (j))
#define XB_TOP      3328
#define XB_TOPGEN   3392
#define XCD_BAR_WORDS 3456
#define XB_SPIN_CAP (1u << 22)
__device__ __forceinline__ unsigned xb_ld(unsigned* p)              { return __hip_atomic_load(p, __ATOMIC_RELAXED, __HIP_MEMORY_SCOPE_AGENT); }
__device__ __forceinline__ unsigned xb_add(unsigned* p, unsigned v) { return __hip_atomic_fetch_add(p, v, __ATOMIC_RELAXED, __HIP_MEMORY_SCOPE_AGENT); }
__device__ __forceinline__ unsigned xb_xcc_id() { return (unsigned)__builtin_amdgcn_s_getreg((3 << 11) | 20) & 0xFu; }
#define XB_SPIN(cond, bar) do { unsigned _sp = 0; while (cond) { __builtin_amdgcn_s_sleep(1); \
    if ((++_sp & 255u) == 0u) { if (xb_ld(&(bar)[XB_TMO])) break; if (_sp > XB_SPIN_CAP) { atomicAdd(&(bar)[XB_TMO], 1u); break; } } } } while (0)
struct XcdBarrier { unsigned* bar; unsigned x; volatile LAS unsigned* st; };
__device__ __forceinline__ XcdBarrier xcd_barrier_post(unsigned* bar, volatile LAS unsigned* st) {
    XcdBarrier b; b.bar = bar; b.x = xb_xcc_id(); b.st = st;
    if (threadIdx.x == 0) (void)xb_add(&bar[XB_XCNT(b.x)], 1u);
    return b;
}
__device__ __forceinline__ void xcd_barrier_complete(unsigned* bar, unsigned x, unsigned& nloc, unsigned& nx) {
    const unsigned G = GRID;
    unsigned sum, cnt, mine, sp = 0u;
    for (;;) {
        sum = 0u; cnt = 0u; mine = 0u;
#pragma unroll
        for (unsigned j = 0; j < 16; ++j) { const unsigned c = xb_ld(&bar[XB_XCNT(j)]); sum += c; cnt += (c > 0u) ? 1u : 0u; mine = (j == x) ? c : mine; }
        if (sum == G) break;
        __builtin_amdgcn_s_sleep(1);
        if ((++sp & 255u) == 0u) { if (xb_ld(&bar[XB_TMO])) break; if (sp > XB_SPIN_CAP) { atomicAdd(&bar[XB_TMO], 1u); break; } }
    }
    nloc = mine > 0u ? mine : 1u; nx = cnt > 0u ? cnt : 1u;
}
__device__ __forceinline__ void xcd_barrier(const XcdBarrier& b) {
    asm volatile("s_waitcnt vmcnt(0)" ::: "memory");
    __syncthreads();
    if (threadIdx.x == 0) {
        unsigned* bar = b.bar;
        __builtin_amdgcn_s_waitcnt(0);
        unsigned nloc = b.st[0], nx = b.st[1];
        if (nloc == 0u) { xcd_barrier_complete(bar, b.x, nloc, nx); b.st[0] = nloc; b.st[1] = nx; }
        const unsigned old = xb_add(&bar[XB_XSUB(b.x)], 1u);
        const unsigned gen = old / nloc;
        if (old + 1u == (gen + 1u) * nloc) {
            __builtin_amdgcn_fence(__ATOMIC_RELEASE, "agent");
            asm volatile("s_waitcnt vmcnt(0)" ::: "memory");
            const unsigned og = xb_add(&bar[XB_TOP], 1u);
            const unsigned tg = og / nx;
            if (og + 1u == (tg + 1u) * nx) xb_add(&bar[XB_TOPGEN], 1u);
            else XB_SPIN(xb_ld(&bar[XB_TOPGEN]) == tg, bar);
            __builtin_amdgcn_fence(__ATOMIC_ACQUIRE, "agent");
            xb_add(&bar[XB_XGEN(b.x)], 1u);
            asm volatile("s_waitcnt vmcnt(0)" ::: "memory");
        } else {
            XB_SPIN(xb_ld(&bar[XB_XGEN(b.x)]) == gen, bar);
            __builtin_amdgcn_fence(__ATOMIC_ACQUIRE, "agent");
            asm volatile("s_waitcnt vmcnt(0)" ::: "memory");
        }
    }
    __syncthreads();
}


__global__ void __launch_bounds__(512, 2) mega(Params P_) {
    extern __shared__ __attribute__((aligned(16))) unsigned char lds[];
    volatile LAS unsigned* st = (volatile LAS unsigned*)(LAS unsigned char*)(lds + LDS_BARST);
    if (threadIdx.x < 16) st[threadIdx.x] = 0u;
    __syncthreads();
    CParams* pp = (CParams*)__builtin_amdgcn_kernarg_segment_ptr();
    (void)xcd_barrier_post((unsigned*)(pp->ws + WS_CTL) + CW_BAR, st);
#define GB do { XcdBarrier bar_; bar_.bar = (unsigned*)(pp->ws + WS_CTL) + CW_BAR; bar_.x = xb_xcc_id(); bar_.st = (volatile LAS unsigned*)(LAS unsigned char*)(lds + LDS_BARST); xcd_barrier(bar_); asm volatile("" : "+s"(pp)); } while (0)
#define P (*pp)
    asm volatile("" : "+s"(pp));
    phase_0(P, lds, 0); GB;
#if defined(PROBE_PH) && PROBE_PH == 0
    { int nrep = PROBE_N; asm volatile("" : "+s"(nrep)); for (int rep = 0; rep < nrep; ++rep) { GB; phase_0(P, lds, 0); GB; } }
#endif
    phase_1(P, lds, 1); GB;
#if defined(PROBE_PH) && PROBE_PH == 1
    { int nrep = PROBE_N; asm volatile("" : "+s"(nrep)); for (int rep = 0; rep < nrep; ++rep) { GB; phase_1(P, lds, 1); GB; } }
#endif
    phase_2(P, lds, 2); asm volatile("" : "+s"(pp));
#if defined(PROBE_PH) && PROBE_PH == 2
    { int nrep = PROBE_N; asm volatile("" : "+s"(nrep)); for (int rep = 0; rep < nrep; ++rep) { GB; phase_2(P, lds, 2); GB; } }
#endif
    phase_3(P, lds, 3); GB;
#if defined(PROBE_PH) && PROBE_PH == 3
    { int nrep = PROBE_N; asm volatile("" : "+s"(nrep)); for (int rep = 0; rep < nrep; ++rep) { GB; phase_3(P, lds, 3); GB; } }
#endif
    phase_4(P, lds, 4); GB;
#if defined(PROBE_PH) && PROBE_PH == 4
    { int nrep = PROBE_N; asm volatile("" : "+s"(nrep)); for (int rep = 0; rep < nrep; ++rep) { GB; phase_4(P, lds, 4); GB; } }
#endif
    phase_5(P, lds, 5); GB;
#if defined(PROBE_PH) && PROBE_PH == 5
    { int nrep = PROBE_N; asm volatile("" : "+s"(nrep)); for (int rep = 0; rep < nrep; ++rep) { GB; phase_5(P, lds, 5); GB; } }
#endif
    phase_6(P, lds, 6); GB;
    phase_60(P, lds, 60); GB;
#if defined(PROBE_PH) && PROBE_PH == 6
    { int nrep = PROBE_N; asm volatile("" : "+s"(nrep)); for (int rep = 0; rep < nrep; ++rep) { GB; phase_6(P, lds, 6); GB; } }
#endif
    phase_7(P, lds, 7); GB;
#if defined(PROBE_PH) && PROBE_PH == 7
    { int nrep = PROBE_N; asm volatile("" : "+s"(nrep)); for (int rep = 0; rep < nrep; ++rep) { GB; phase_7(P, lds, 7); GB; } }
#endif
    phase_8(P, lds, 8); GB;
#if defined(PROBE_PH) && PROBE_PH == 8
    { int nrep = PROBE_N; asm volatile("" : "+s"(nrep)); for (int rep = 0; rep < nrep; ++rep) { GB; phase_8(P, lds, 8); GB; } }
#endif
    phase_9(P, lds, 9); GB;
#if defined(PROBE_PH) && PROBE_PH == 9
    { int nrep = PROBE_N; asm volatile("" : "+s"(nrep)); for (int rep = 0; rep < nrep; ++rep) { GB; phase_9(P, lds, 9); GB; } }
#endif
    phase_10(P, lds, 10); GB;
#if defined(PROBE_PH) && PROBE_PH == 10
    { int nrep = PROBE_N; asm volatile("" : "+s"(nrep)); for (int rep = 0; rep < nrep; ++rep) { GB; phase_10(P, lds, 10); GB; } }
#endif
    phase_11(P, lds, 11); GB;
#if defined(PROBE_PH) && PROBE_PH == 11
    { int nrep = PROBE_N; asm volatile("" : "+s"(nrep)); for (int rep = 0; rep < nrep; ++rep) { GB; phase_11(P, lds, 11); GB; } }
#endif
    phase_12(P, lds, 12); GB;
#if defined(PROBE_PH) && PROBE_PH == 12
    { int nrep = PROBE_N; asm volatile("" : "+s"(nrep)); for (int rep = 0; rep < nrep; ++rep) { GB; phase_12(P, lds, 12); GB; } }
#endif
    phase_13(P, lds, 13); GB;
#if defined(PROBE_PH) && PROBE_PH == 13
    { int nrep = PROBE_N; asm volatile("" : "+s"(nrep)); for (int rep = 0; rep < nrep; ++rep) { GB; phase_13(P, lds, 13); GB; } }
#endif
    phase_14(P, lds, 14); GB;
#if defined(PROBE_PH) && PROBE_PH == 14
    { int nrep = PROBE_N; asm volatile("" : "+s"(nrep)); for (int rep = 0; rep < nrep; ++rep) { GB; phase_14(P, lds, 14); GB; } }
#endif
    phase_15(P, lds, 15); GB;
#if defined(PROBE_PH) && PROBE_PH == 15
    { int nrep = PROBE_N; asm volatile("" : "+s"(nrep)); for (int rep = 0; rep < nrep; ++rep) { GB; phase_15(P, lds, 15); GB; } }
#endif
    phase_16(P, lds, 16); GB;
#if defined(PROBE_PH) && PROBE_PH == 16
    { int nrep = PROBE_N; asm volatile("" : "+s"(nrep)); for (int rep = 0; rep < nrep; ++rep) { GB; phase_16(P, lds, 16); GB; } }
#endif
    phase_22(P, lds, 22); GB;
#if defined(PROBE_PH) && PROBE_PH == 22
    { int nrep = PROBE_N; asm volatile("" : "+s"(nrep)); for (int rep = 0; rep < nrep; ++rep) { GB; phase_22(P, lds, 22); GB; } }
#endif
    phase_23(P, lds, 23); GB;
#if defined(PROBE_PH) && PROBE_PH == 23
    { int nrep = PROBE_N; asm volatile("" : "+s"(nrep)); for (int rep = 0; rep < nrep; ++rep) { GB; phase_23(P, lds, 23); GB; } }
#endif
    phase_9(P, lds, 17); GB;
#if defined(PROBE_PH) && PROBE_PH == 17
    { int nrep = PROBE_N; asm volatile("" : "+s"(nrep)); for (int rep = 0; rep < nrep; ++rep) { GB; phase_9(P, lds, 17); GB; } }
#endif
    phase_10(P, lds, 18); GB;
#if defined(PROBE_PH) && PROBE_PH == 18
    { int nrep = PROBE_N; asm volatile("" : "+s"(nrep)); for (int rep = 0; rep < nrep; ++rep) { GB; phase_10(P, lds, 18); GB; } }
#endif
    phase_11(P, lds, 19); GB;
#if defined(PROBE_PH) && PROBE_PH == 19
    { int nrep = PROBE_N; asm volatile("" : "+s"(nrep)); for (int rep = 0; rep < nrep; ++rep) { GB; phase_11(P, lds, 19); GB; } }
#endif
    phase_12(P, lds, 20); GB;
#if defined(PROBE_PH) && PROBE_PH == 20
    { int nrep = PROBE_N; asm volatile("" : "+s"(nrep)); for (int rep = 0; rep < nrep; ++rep) { GB; phase_12(P, lds, 20); GB; } }
#endif
    phase_13(P, lds, 21);
#if defined(PROBE_PH) && PROBE_PH == 21
    { int nrep = PROBE_N; asm volatile("" : "+s"(nrep)); for (int rep = 0; rep < nrep; ++rep) { GB; phase_13(P, lds, 21); GB; } }
#endif
#undef P
#undef GB
}

extern "C" void kernel_launch(void* const* d_in, const int* in_sizes, int n_in, void* d_out, int out_size, void* d_ws, size_t ws_size, hipStream_t stream) {
    static int ready = 0;
    if (!ready) {
        if (n_in != 35 || ws_size < WS_TOTAL) { fprintf(stderr, "kernel_launch: unexpected n_in %d or ws_size %zu (need %zu)\n", n_in, ws_size, (size_t)WS_TOTAL); ready = -1; return; }
        if (hipFuncSetAttribute((const void*)mega, hipFuncAttributeMaxDynamicSharedMemorySize, LDS_BYTES) != hipSuccess) { fprintf(stderr, "kernel_launch: hipFuncSetAttribute failed\n"); ready = -1; return; }
        ready = 1;
    }
    if (ready < 0) return;
    (void)hipMemsetAsync((char*)d_ws + WS_CTL, 0, 1 * MiB, stream);
    Params P{};
    for (int i = 0; i < 35; ++i) P.in[i] = (const float*)d_in[i];
    P.out = (float*)d_out; P.ws = (unsigned char*)d_ws; P.ph_lo = 0; P.ph_hi = 0;
    hipLaunchKernelGGL(mega, dim3(GRID), dim3(512), LDS_BYTES, stream, P);
}
```

```cpp
#include <hip/hip_runtime.h>
#include <stdint.h>
#include <stdio.h>

#define DM 1024
#define NB 2
#define SEQ 8192
#define NMETA 16
#define LSEQ (SEQ + NMETA)
#define NMAIN (NB * SEQ)
#define NT (NB * LSEQ)
#define NTP 16640
#define INCOLS 3328
#define RESTC 1792
#define NEXP 32
#define DFF 512
#define S5TC 48
#define S5NC 171
#define MOE_RT 256
#define MOE_MAXROWS 41216

typedef unsigned short bf16_t;
typedef short bf16x8 __attribute__((ext_vector_type(8)));
typedef float f32x4 __attribute__((ext_vector_type(4)));
typedef unsigned u32x4 __attribute__((ext_vector_type(4)));
typedef unsigned u32x2 __attribute__((ext_vector_type(2)));

constexpr size_t MiB = 1u << 20;
constexpr size_t al64k(size_t x) { return (x + 65535) & ~(size_t)65535; }
constexpr size_t WS_CTL = 0;
constexpr size_t WS_H = 1 * MiB;
constexpr size_t WS_HN = WS_H + al64k((size_t)NT * DM * 4);
constexpr size_t WS_A2 = WS_HN + al64k((size_t)NTP * DM * 2);
constexpr size_t WS_WTIN = WS_A2 + al64k((size_t)NTP * DM * 2);
constexpr size_t WS_WTOUT = WS_WTIN + al64k((size_t)INCOLS * DM * 2);
constexpr size_t WS_WTGLU = WS_WTOUT + al64k((size_t)DM * DM * 2);
constexpr size_t WS_BIG = WS_WTGLU + al64k((size_t)2 * DM * DM * 2);
constexpr size_t SZ_T512 = al64k((size_t)NT * 512 * 2);
constexpr size_t SZ_P512 = al64k((size_t)NTP * 512 * 2);
constexpr int RW_NCH = 129, RW_UNITS = 32 * RW_NCH;
constexpr size_t SZ_RWOP = al64k((size_t)RW_UNITS * 4096 * 2);
constexpr size_t WS_Q = WS_BIG;
constexpr size_t WS_K = WS_Q + SZ_P512;
constexpr size_t WS_V = WS_K + SZ_P512;
constexpr size_t WS_REST = WS_V + SZ_P512;
constexpr size_t WS_KR = WS_REST + al64k((size_t)NTP * RESTC * 2);
constexpr size_t WS_LOW = WS_KR + SZ_T512;
constexpr size_t WS_AA = WS_LOW + al64k((size_t)NT * 256 * 2);
constexpr size_t WS_XEND = WS_AA + 2 * SZ_T512;
constexpr size_t WS_PP = WS_BIG;
constexpr size_t WS_QT = WS_PP + SZ_RWOP;
constexpr size_t WS_YT = WS_QT + SZ_RWOP;
constexpr size_t WS_ZT = WS_YT + SZ_RWOP;
constexpr size_t WS_YFB = WS_ZT + SZ_RWOP;
static_assert(WS_YFB + 2 * SZ_T512 <= WS_XEND, "scan operators + YFB fit in region X");
constexpr size_t WS_R = WS_XEND;
constexpr size_t WS_VV = WS_R + SZ_T512;
constexpr size_t WS_G = WS_VV + SZ_T512;
constexpr size_t WS_KK = WS_G + SZ_T512;
constexpr size_t WS_KKA = WS_KK + SZ_T512;
constexpr size_t WS_KD = WS_KKA + 2 * SZ_T512;
constexpr size_t WS_W = WS_KD + 2 * SZ_T512;
constexpr size_t WS_BC = WS_W + 2 * SZ_T512;
constexpr size_t WS_MIXEND = WS_BC + al64k((size_t)NT * 8 * 4);
constexpr size_t WS_XB = WS_BIG;
constexpr size_t WS_HB = WS_XB + al64k((size_t)MOE_MAXROWS * DM * 2);
constexpr size_t WS_YB = WS_HB + al64k((size_t)MOE_MAXROWS * DFF * 2);
constexpr size_t WS_WT13 = WS_YB + al64k((size_t)MOE_MAXROWS * DM * 2);
constexpr size_t WS_WT2 = WS_WT13 + al64k((size_t)NEXP * DM * DM * 2);
constexpr size_t WS_EID = WS_WT2 + al64k((size_t)NEXP * DM * DFF * 2);
constexpr size_t WS_POS = WS_EID + al64k((size_t)NT * 8);
constexpr size_t WS_DEST = WS_POS + al64k((size_t)NT * 8);
constexpr size_t WS_GATE = WS_DEST + al64k((size_t)NT * 8);
constexpr size_t WS_MOEEND = WS_GATE + al64k((size_t)NT * 8);
constexpr size_t WS_YI = WS_BIG;
constexpr size_t WS_E = WS_YI + al64k((size_t)NTP * DM * 4);
constexpr size_t WS_CAR = WS_E + al64k((size_t)1040 * 64 * 256 * 4);
constexpr size_t WS_BTA = WS_CAR + al64k((size_t)64 * 1280 * 256 * 2);
constexpr size_t WS_BTC = WS_BTA + al64k((size_t)64 * 512 * 256 * 2);
constexpr size_t WS_S5END = WS_BTC + al64k((size_t)64 * 256 * 256 * 2);
constexpr size_t cmax(size_t a, size_t b) { return a > b ? a : b; }
constexpr size_t WS_TOTAL = cmax(WS_MIXEND, cmax(WS_MOEEND, WS_S5END));
static_assert(WS_TOTAL <= 512 * MiB, "workspace map exceeds 512 MiB");

#define CW_CNT(l) (1024 + 64 * (l))

#define LDS_BYTES 163840
#define LDS_BARST (LDS_BYTES - 1024)
#define LDS_TAB (LDS_BYTES - 768)
#define LDS_RING (LDS_BYTES - 1024)
#define GRID 256

struct Params {
    const float* in[35];
    float* out;
    unsigned char* ws;
    int ph_lo, ph_hi;
};
typedef const __attribute__((address_space(4))) Params CParams;

__device__ __forceinline__ float bf2f(bf16_t v) { return __uint_as_float(((unsigned)v) << 16); }
typedef float f32x2c_ __attribute__((ext_vector_type(2)));
typedef __bf16 bf16x2c_ __attribute__((ext_vector_type(2)));
__device__ __forceinline__ unsigned pk2(float lo, float hi) { const f32x2c_ f = {lo, hi}; const bf16x2c_ b = __builtin_convertvector(f, bf16x2c_); return __builtin_bit_cast(unsigned, b); }
__device__ __forceinline__ unsigned f2bf(float f) { return (unsigned)__builtin_bit_cast(unsigned short, (__bf16)f); }
__device__ __forceinline__ float bflo(unsigned u) { return __uint_as_float(u << 16); }
__device__ __forceinline__ float bfhi(unsigned u) { return __uint_as_float(u & 0xffff0000u); }
__device__ __forceinline__ float wave_sum(float v) {
#pragma unroll
    for (int o = 1; o < 64; o <<= 1) v += __shfl_xor(v, o);
    return v;
}
__device__ __forceinline__ float wave_max(float v) {
#pragma unroll
    for (int o = 1; o < 64; o <<= 1) v = fmaxf(v, __shfl_xor(v, o));
    return v;
}
template <int CTRL> __device__ __forceinline__ float dppf(float v) { return __int_as_float(__builtin_amdgcn_update_dpp(0, __float_as_int(v), CTRL, 0xF, 0xF, true)); }
__device__ __forceinline__ float row16_sum(float v) { v += dppf<0xB1>(v); v += dppf<0x4E>(v); v += dppf<0x141>(v); v += dppf<0x140>(v); return v; }
__device__ __forceinline__ float sigmoidf_(float x) { return __builtin_amdgcn_rcpf(1.f + __expf(-x)); }
__device__ __forceinline__ int rowof(int b, int p) { return p < NMETA ? NMAIN + b * NMETA + p : b * SEQ + (p - NMETA); }

#define SA_STRIDE 40
template <class AF, class BF>
__device__ __forceinline__ void gemm_tile(unsigned char* lds, int K, int ldb, const AF& arow, const BF& bcol, f32x4 (&acc)[4][2]) {
    bf16_t* sA = (bf16_t*)lds;
    bf16_t* sB = (bf16_t*)(lds + 128 * SA_STRIDE * 2);
    const int tid = threadIdx.x, lane = tid & 63, wave = tid >> 6, wr = wave >> 2, wc = wave & 3, fr = lane & 15, fq = lane >> 4;
#pragma unroll
    for (int mi = 0; mi < 4; ++mi)
#pragma unroll
        for (int ni = 0; ni < 2; ++ni) acc[mi][ni] = (f32x4){0.f, 0.f, 0.f, 0.f};
    const int ar = tid >> 2, akc = (tid & 3) * 8;
    const bf16_t* ap = arow(ar) + akc;
    const int bnq = (tid & 31) * 4, bkp = (tid >> 5) * 2;
    const float* bp = bcol(bnq) + (size_t)bkp * ldb;
    const int nk = K / 32;
    u32x4 ra = *(const u32x4*)ap;
    f32x4 rb0 = *(const f32x4*)bp, rb1 = *(const f32x4*)(bp + ldb);
    for (int kt = 0; kt < nk; ++kt) {
        __syncthreads();
        *(u32x4*)(sA + ar * SA_STRIDE + akc) = ra;
        {
            unsigned* d = (unsigned*)(sB + bnq * SA_STRIDE + bkp);
            d[0 * (SA_STRIDE / 2)] = pk2(rb0[0], rb1[0]);
            d[1 * (SA_STRIDE / 2)] = pk2(rb0[1], rb1[1]);
            d[2 * (SA_STRIDE / 2)] = pk2(rb0[2], rb1[2]);
            d[3 * (SA_STRIDE / 2)] = pk2(rb0[3], rb1[3]);
        }
        __syncthreads();
        if (kt + 1 < nk) {
            ra = *(const u32x4*)(ap + (kt + 1) * 32);
            const float* q = bp + (size_t)(kt + 1) * 32 * ldb;
            rb0 = *(const f32x4*)q; rb1 = *(const f32x4*)(q + ldb);
        }
        bf16x8 a[4], b[2];
#pragma unroll
        for (int mi = 0; mi < 4; ++mi) a[mi] = *(const bf16x8*)(sA + (wr * 64 + mi * 16 + fr) * SA_STRIDE + fq * 8);
#pragma unroll
        for (int ni = 0; ni < 2; ++ni) b[ni] = *(const bf16x8*)(sB + (wc * 32 + ni * 16 + fr) * SA_STRIDE + fq * 8);
#pragma unroll
        for (int mi = 0; mi < 4; ++mi)
#pragma unroll
            for (int ni = 0; ni < 2; ++ni) acc[mi][ni] = __builtin_amdgcn_mfma_f32_16x16x32_bf16(a[mi], b[ni], acc[mi][ni], 0, 0, 0);
    }
    __syncthreads();
}
#define ACC_FOREACH(acc, ...) do { const int _l = threadIdx.x & 63, _w = threadIdx.x >> 6, _wr = _w >> 2, _wc = _w & 3, _fr = _l & 15, _fq = _l >> 4; \
    _Pragma("unroll") for (int _mi = 0; _mi < 4; ++_mi) _Pragma("unroll") for (int _ni = 0; _ni < 2; ++_ni) _Pragma("unroll") for (int _j = 0; _j < 4; ++_j) { \
        const int rl = _wr * 64 + _mi * 16 + _fq * 4 + _j, cl = _wc * 32 + _ni * 16 + _fr; const float val = acc[_mi][_ni][_j]; __VA_ARGS__ } } while (0)
#define ACC_FOREACH_PAIR(acc, ...) do { const int _l = threadIdx.x & 63, _w = threadIdx.x >> 6, _wr = _w >> 2, _wc = _w & 3, _fr = _l & 15, _fq = _l >> 4; \
    _Pragma("unroll") for (int _mi = 0; _mi < 4; ++_mi) _Pragma("unroll") for (int _j = 0; _j < 4; ++_j) { \
        const int rl = _wr * 64 + _mi * 16 + _fq * 4 + _j, co = _wc * 16 + _fr; const float va = acc[_mi][0][_j], vg = acc[_mi][1][_j]; __VA_ARGS__ } } while (0)

__device__ __forceinline__ void store_norm_bf16(const f32x4 (&v)[4], const float* gain, bf16_t* dst, int lane) {
    float ss = 0.f;
#pragma unroll
    for (int j = 0; j < 4; ++j) ss += v[j][0] * v[j][0] + v[j][1] * v[j][1] + v[j][2] * v[j][2] + v[j][3] * v[j][3];
    ss = wave_sum(ss);
    const float rstd = rsqrtf(ss * (1.f / DM) + 1e-6f);
#pragma unroll
    for (int j = 0; j < 4; ++j) {
        const f32x4 g = ((const f32x4*)gain)[lane + 64 * j];
        u32x2 o; o.x = pk2(v[j][0] * rstd * g[0], v[j][1] * rstd * g[1]); o.y = pk2(v[j][2] * rstd * g[2], v[j][3] * rstd * g[3]);
        ((u32x2*)dst)[lane + 64 * j] = o;
    }
}

namespace pg8 {
#define PG8_LAS __attribute__((address_space(3)))
constexpr int BM = 256, BK = 64, HALF = 128, HTB = HALF * BK * 2  , STAGE_BYTES = 8 * HTB, NXCD = 8, WGM = 8;
__host__ __device__ __forceinline__ int lds_byte(int r, int c) { const int st = (r >> 4) * 2 + (c >> 5), rr = r & 15, cc = c & 31, ob = rr * 64 + cc * 2; return st * 1024 + (ob ^ (((ob >> 9) & 1) << 5)); }
__host__ __device__ __forceinline__ void stage_rc(int b, int& R, int& C) { const int st = b / 1024, sb = b % 1024, swz = sb ^ (((sb >> 9) & 1) << 5); R = (st >> 1) * 16 + swz / 64; C = (st & 1) * 32 + (swz % 64) / 2; }
__host__ __device__ __forceinline__ int perm32(int rho) { const int n = rho >> 4, i = rho & 15; return 8 * (i >> 2) + 4 * n + (i & 3); }

struct Unit { int pm, pn; const char* A; const char* B; };

struct DenseOrder {
    static constexpr bool GATHER_A = false;
    int nM, nN, nwg, G, c; const char* A; const char* Bt; size_t tstep;
    __device__ void init(const bf16_t* A_, const bf16_t* Bt_, int M, int N, int K, int G_, int c_) { nM = M / BM; nN = N / BM; nwg = nM * nN; G = G_; c = c_; A = (const char*)A_; Bt = (const char*)Bt_; tstep = (size_t)BM * K * 2; }
    __device__ bool next(int i, Unit& u) const {
        const long L = (long)i * G + c; if (L >= nwg) return false;
        int wgid = (int)L; { const int q = nwg / NXCD, r = nwg % NXCD, xcd = wgid % NXCD, off = wgid / NXCD; wgid = (xcd < r ? xcd * (q + 1) : r * (q + 1) + (xcd - r) * q) + off; }
        const int nig = WGM * nN, gid = wgid / nig, fm = gid * WGM, gsz = (nM - fm) < WGM ? (nM - fm) : WGM;
        u.pm = fm + ((wgid % nig) % gsz); u.pn = (wgid % nig) / gsz; u.A = A + (size_t)u.pm * tstep; u.B = Bt + (size_t)u.pn * tstep; return true;
    }
    __device__ __forceinline__ void a_ready(const Unit&) const {}
    __device__ __forceinline__ void done(const Unit&) const {}
};
struct ProjOrder {
    static constexpr bool GATHER_A = false;
    DenseOrder D; const char* HNp; const char* WT;
    __device__ void init(const bf16_t* HN_, const bf16_t* WT_, int c_) { D.init(HN_, WT_, NTP, 13 * BM, DM, GRID, c_); HNp = (const char*)HN_; WT = (const char*)WT_; }
    __device__ bool next(int i, Unit& u) const {
        if (!D.next(i, u)) return false;
        const size_t ts = (size_t)BM * DM * 2;
        if (u.pn < 11) { const int wrow = u.pn < 4 ? u.pn : u.pn + 2; u.A = HNp + (size_t)u.pm * ts; u.B = WT + (size_t)wrow * ts; }
        else { u.A = WT + (size_t)(4 + (u.pn - 11)) * ts; u.B = HNp + (size_t)u.pm * ts; }
        return true;
    }
    __device__ __forceinline__ void a_ready(const Unit&) const {}
    __device__ __forceinline__ void done(const Unit&) const {}
};
struct MoeOrder {
    static constexpr bool GATHER_A = false;
    const int* et; int TT, vcu; const char* A; const char* Bt; unsigned tstepA, tstepB, estep;
    __device__ __forceinline__ bool next(int i, Unit& u) const {
        const int L = i * GRID + vcu; if (L >= TT * 4) return false;
        const int rt = L >> 2, ct = L & 3, e = et[rt];
        u.pm = rt; u.pn = ct; u.A = A + (size_t)rt * tstepA; u.B = Bt + (size_t)e * estep + (size_t)ct * tstepB; return true;
    }
    __device__ __forceinline__ void a_ready(const Unit&) const {}
    __device__ __forceinline__ void done(const Unit&) const {}
};

struct S5OrderA {
    static constexpr bool GATHER_A = true;
    int vcu; const char* U; const char* BTA;
    __device__ __forceinline__ bool next(int i, Unit& u) const {
        const int L = i * GRID + vcu; if (L >= 640) return false;
        const int g = L / 10, rem = L - g * 10, mt = rem >> 1, nt = rem & 1;
        u.pm = mt; u.pn = g * 2 + nt; u.A = U + ((size_t)mt * 256 * 16 * 1024 + g * 16) * 2; u.B = BTA + ((size_t)(g * 512 + nt * 256) * 256) * 2; return true;
    }
    __device__ __forceinline__ void a_ready(const Unit&) const {}
    __device__ __forceinline__ void done(const Unit&) const {}
};
struct S5OrderC {
    static constexpr bool GATHER_A = false;
    int vcu; const char* CAR; const char* BTC;
    __device__ __forceinline__ bool next(int i, Unit& u) const {
        const int L = i * GRID + vcu; if (L >= 320) return false;
        const int g = L / 5, mt = L - g * 5;
        u.pm = mt; u.pn = g; u.A = CAR + ((size_t)(g * 1280 + mt * 256) * 256) * 2; u.B = BTC + ((size_t)g * 256 * 256) * 2; return true;
    }
    __device__ __forceinline__ void a_ready(const Unit&) const {}
    __device__ __forceinline__ void done(const Unit&) const {}
};
__device__ __forceinline__ unsigned cvt_pk_bf16(float lo, float hi) { return pk2(lo, hi); }

struct EpiProj {
    static constexpr bool PERM = true, AFTER_DRAIN = false;
    bf16_t *Q, *Kk, *VT, *REST;
    __device__ __forceinline__ void operator()(const f32x4 (&acc)[2][2][4][2], const Unit& u, int wr, int wc, int fr, int fq) const {
        bf16_t* base; int ldc; int row0, col0;
        if (u.pn < 11) { row0 = u.pm * BM + wr * 64 + fr; int colt;
            if (u.pn < 2) { base = Q; colt = u.pn * BM; ldc = 512; } else if (u.pn < 4) { base = Kk; colt = (u.pn - 2) * BM; ldc = 512; } else { base = REST; colt = (u.pn - 4) * BM; ldc = RESTC; }
            col0 = colt + wc * 32 + 8 * fq; }
        else { base = VT; ldc = NTP; row0 = (u.pn - 11) * BM + wr * 64 + fr; col0 = u.pm * BM + wc * 32 + 8 * fq; }
#pragma unroll
        for (int ai = 0; ai < 2; ++ai)
#pragma unroll
            for (int m = 0; m < 4; ++m) { bf16_t* rowp = base + (size_t)(row0 + ai * HALF + m * 16) * ldc + col0;
#pragma unroll
                for (int bj = 0; bj < 2; ++bj) { const f32x4 v0 = acc[ai][bj][m][0], v1 = acc[ai][bj][m][1];
                    u32x4 w; w.x = cvt_pk_bf16(v0[0], v0[1]); w.y = cvt_pk_bf16(v0[2], v0[3]); w.z = cvt_pk_bf16(v1[0], v1[1]); w.w = cvt_pk_bf16(v1[2], v1[3]);
                    *(u32x4*)(rowp + bj * HALF) = w; } }
    }
};
struct EpiBf16Plain {
    static constexpr bool PERM = true, AFTER_DRAIN = false;
    bf16_t* O; int ldc;
    __device__ __forceinline__ void operator()(const f32x4 (&acc)[2][2][4][2], const Unit& u, int wr, int wc, int fr, int fq) const {
        const int row0 = u.pm * BM + wr * 64 + fr; const int col0 = u.pn * BM + wc * 32 + 8 * fq;
#pragma unroll
        for (int ai = 0; ai < 2; ++ai)
#pragma unroll
            for (int m = 0; m < 4; ++m) { bf16_t* rowp = O + (size_t)(row0 + ai * HALF + m * 16) * ldc + col0;
#pragma unroll
                for (int bj = 0; bj < 2; ++bj) { const f32x4 v0 = acc[ai][bj][m][0], v1 = acc[ai][bj][m][1];
                    u32x4 w; w.x = cvt_pk_bf16(v0[0], v0[1]); w.y = cvt_pk_bf16(v0[2], v0[3]); w.z = cvt_pk_bf16(v1[0], v1[1]); w.w = cvt_pk_bf16(v1[2], v1[3]);
                    *(u32x4*)(rowp + bj * HALF) = w; } }
    }
};
struct EpiSwiglu {
    static constexpr bool PERM = true, AFTER_DRAIN = false;
    bf16_t* O;
    __device__ __forceinline__ void operator()(const f32x4 (&acc)[2][2][4][2], const Unit& u, int wr, int wc, int fr, int fq) const {
        const int row0 = u.pm * BM + wr * 64 + fr; const int col0 = u.pn * HALF + wc * 32 + 8 * fq;
#pragma unroll
        for (int ai = 0; ai < 2; ++ai)
#pragma unroll
            for (int m = 0; m < 4; ++m) {
                float o[8];
#pragma unroll
                for (int n = 0; n < 2; ++n)
#pragma unroll
                    for (int i = 0; i < 4; ++i) { const float va = acc[ai][0][m][n][i], vg = acc[ai][1][m][n][i]; o[4 * n + i] = va * __builtin_amdgcn_rcpf(1.f + __expf(-va)) * vg; }
                u32x4 w; w.x = cvt_pk_bf16(o[0], o[1]); w.y = cvt_pk_bf16(o[2], o[3]); w.z = cvt_pk_bf16(o[4], o[5]); w.w = cvt_pk_bf16(o[6], o[7]);
                *(u32x4*)(O + (size_t)(row0 + ai * HALF + m * 16) * DFF + col0) = w; }
    }
};
struct EpiResidual {
    static constexpr bool PERM = false, AFTER_DRAIN = false;
    float* Hh;
    __device__ __forceinline__ void operator()(const f32x4 (&acc)[2][2][4][2], const Unit& u, int wr, int wc, int fr, int fq) const {
        const int row0 = u.pm * BM + wr * 64 + fr; const int col0 = u.pn * BM + wc * 32 + 4 * fq;
#pragma unroll
        for (int ai = 0; ai < 2; ++ai)
#pragma unroll
            for (int m = 0; m < 4; ++m) { float* rowp = Hh + (size_t)(row0 + ai * HALF + m * 16) * DM + col0;
#pragma unroll
                for (int bj = 0; bj < 2; ++bj)
#pragma unroll
                    for (int n = 0; n < 2; ++n) { f32x4* p = (f32x4*)(rowp + bj * HALF + n * 16); *p = *p + acc[ai][bj][m][n]; } }
    }
};
struct EpiGlu {
    static constexpr bool PERM = false, AFTER_DRAIN = false;
    float* Hh;
    __device__ __forceinline__ void operator()(const f32x4 (&acc)[2][2][4][2], const Unit& u, int wr, int wc, int fr, int fq) const {
        const int row0 = u.pm * BM + wr * 64 + fr; const int col0 = u.pn * HALF + wc * 32 + 4 * fq;
#pragma unroll
        for (int ai = 0; ai < 2; ++ai)
#pragma unroll
            for (int m = 0; m < 4; ++m) { float* rowp = Hh + (size_t)(row0 + ai * HALF + m * 16) * DM + col0;
#pragma unroll
                for (int n = 0; n < 2; ++n) { f32x4* p = (f32x4*)(rowp + n * 16); f32x4 hv = *p; const f32x4 va = acc[ai][0][m][n], vg = acc[ai][1][m][n];
#pragma unroll
                    for (int i = 0; i < 4; ++i) hv[i] += va[i] * __builtin_amdgcn_rcpf(1.f + __expf(-vg[i]));
                    *p = hv; } }
    }
};

struct EpiS5A {
    static constexpr bool PERM = true, AFTER_DRAIN = false;
    float* YI; float* E;
    __device__ __forceinline__ void operator()(const f32x4 (&acc)[2][2][4][2], const Unit& u, int wr, int wc, int fr, int fq) const {
        const int g = u.pn >> 1, nt = u.pn & 1;
        const int cl0 = wc * 32 + 8 * fq;
        float* base = nt == 0 ? YI + (size_t)(cl0 >> 4) * DM + g * 16 + (cl0 & 15) : E + (size_t)g * 256 + cl0;
        const size_t nstride = 16 * DM;
        const size_t bjstep = nt == 0 ? (size_t)8 * DM : (size_t)HALF;
#pragma unroll
        for (int ai = 0; ai < 2; ++ai)
#pragma unroll
            for (int m = 0; m < 4; ++m) { int n = u.pm * BM + ai * HALF + wr * 64 + m * 16 + fr; n = n < 1039 ? n : 1039;
                float* p = base + (size_t)n * nstride;
#pragma unroll
                for (int bj = 0; bj < 2; ++bj) { *(f32x4*)(p + bj * bjstep) = acc[ai][bj][m][0]; *(f32x4*)(p + bj * bjstep + 4) = acc[ai][bj][m][1]; } }
    }
};
struct EpiS5C {
    static constexpr bool PERM = true, AFTER_DRAIN = false;
    const float* YI; const bf16_t* Uu; const float* dvec; bf16_t* O;
    __device__ __forceinline__ void operator()(const f32x4 (&acc)[2][2][4][2], const Unit& u, int wr, int wc, int fr, int fq) const {
        const int g = u.pn;
        const int cl0 = wc * 32 + 8 * fq, ch = g * 16 + (cl0 & 15);
        const size_t off0 = (size_t)(cl0 >> 4) * DM + ch;
        const f32x4 d0 = *(const f32x4*)(dvec + ch), d1 = *(const f32x4*)(dvec + ch + 4);
#pragma unroll
        for (int ai = 0; ai < 2; ++ai)
#pragma unroll
            for (int m = 0; m < 4; ++m) { int n = u.pm * BM + ai * HALF + wr * 64 + m * 16 + fr; n = n < 1039 ? n : 1039;
#pragma unroll
                for (int bj = 0; bj < 2; ++bj) {
                    const size_t off = off0 + (size_t)n * (16 * DM) + (size_t)bj * (8 * DM);
                    const f32x4 y0 = *(const f32x4*)(YI + off), y1 = *(const f32x4*)(YI + off + 4);
                    const u32x4 uv = *(const u32x4*)(Uu + off);
                    float y[8];
#pragma unroll
                    for (int q = 0; q < 4; ++q) { y[q] = acc[ai][bj][m][0][q] + y0[q] + d0[q] * (q & 1 ? __uint_as_float(uv[q >> 1] & 0xffff0000u) : __uint_as_float(uv[q >> 1] << 16));
                        y[4 + q] = acc[ai][bj][m][1][q] + y1[q] + d1[q] * (q & 1 ? __uint_as_float(uv[2 + (q >> 1)] & 0xffff0000u) : __uint_as_float(uv[2 + (q >> 1)] << 16)); }
#pragma unroll
                    for (int q = 0; q < 8; ++q) { const float z = 1.5957691216f * (y[q] + 0.044715f * y[q] * y[q] * y[q]); y[q] = y[q] * __builtin_amdgcn_rcpf(1.f + __expf(-z)); }
                    u32x4 w; w.x = cvt_pk_bf16(y[0], y[1]); w.y = cvt_pk_bf16(y[2], y[3]); w.z = cvt_pk_bf16(y[4], y[5]); w.w = cvt_pk_bf16(y[6], y[7]);
                    *(u32x4*)(O + off) = w; }
                asm volatile("" ::: "memory"); }
    }
};

template <class Epi, class Sched, bool ALIGN_EPI = false, bool SP2 = false>
__device__ __forceinline__ void gemm_phase(PG8_LAS unsigned char* lds, const int K, const Sched& S, const Epi& E) {
    int tid_ = threadIdx.x; asm volatile("" : "+v"(tid_));
    const int tid = tid_, wid = __builtin_amdgcn_readfirstlane(tid >> 6), lane = tid & 63, wr = wid >> 2, wc = wid & 3, fr = lane & 15, fq = lane >> 4;
    const int nt = K / BK;
    unsigned voffA[2], voffB[2];
#pragma unroll
    for (int i = 0; i < 2; ++i) { int R, C; stage_rc(tid * 16 + i * 8192, R, C); const int Rb = Epi::PERM ? ((R & ~31) + perm32(R & 31)) : R;
        voffA[i] = Sched::GATHER_A ? (unsigned)(((16 * R + (C >> 4)) * 1024 + (C & 15)) * 2) : (unsigned)(R * K + C) * 2u; voffB[i] = (unsigned)(Rb * K + C) * 2u; }
    const size_t kstep = (size_t)(BK * 2);
    const size_t hstep = (size_t)HALF * K * 2;
    const size_t kstepA = Sched::GATHER_A ? (size_t)(4 * 1024 * 2) : kstep, hstepA = Sched::GATHER_A ? (size_t)HALF * 16 * 1024 * 2 : hstep;
    const unsigned ldsw = (unsigned)wid * 1024u;
    const int aoff = lds_byte(wr * 64 + fr, fq * 8), boff = lds_byte(wc * 32 + fr, fq * 8);
#define PG8_SA(b, h) (((b) * 2 + (h)) * HTB)
#define PG8_SB(b, h) ((4 + (b) * 2 + (h)) * HTB)
#define PG8_STAGE(bufoff, gbase, voff) do { _Pragma("unroll") for (int _i = 0; _i < 2; ++_i) \
        __builtin_amdgcn_global_load_lds((const unsigned*)((const char*)(gbase) + (voff)[_i]), (PG8_LAS unsigned*)(lds + (bufoff) + ldsw + _i * 8192), 16, 0, 0); } while (0)
#define PG8_LDA(dst, b, h) do { _Pragma("unroll") for (int m = 0; m < 4; ++m) _Pragma("unroll") for (int k = 0; k < 2; ++k) dst[m][k] = *(const PG8_LAS bf16x8*)(lds + PG8_SA(b, h) + aoff + m * 2048 + k * 1024); } while (0)
#define PG8_LDB(dst, b, h) do { _Pragma("unroll") for (int n = 0; n < 2; ++n) _Pragma("unroll") for (int k = 0; k < 2; ++k) dst[n][k] = *(const PG8_LAS bf16x8*)(lds + PG8_SB(b, h) + boff + n * 2048 + k * 1024); } while (0)
#define PG8_MMA(ai, bj, At, Bt) do { __builtin_amdgcn_s_setprio(1); _Pragma("unroll") for (int m = 0; m < 4; ++m) _Pragma("unroll") for (int n = 0; n < 2; ++n) _Pragma("unroll") for (int k = 0; k < 2; ++k) \
        acc[ai][bj][m][n] = __builtin_amdgcn_mfma_f32_16x16x32_bf16(Bt[n][k], At[m][k], acc[ai][bj][m][n], 0, 0, 0); __builtin_amdgcn_s_setprio(0); } while (0)
#define PG8_WAIT_V(n) asm volatile("s_waitcnt vmcnt(" #n ")" ::: "memory")
#define PG8_WAIT_L(n) asm volatile("s_waitcnt lgkmcnt(" #n ")" ::: "memory")
#define PG8_BAR __builtin_amdgcn_s_barrier()
#define PG8_SCHED __builtin_amdgcn_sched_barrier(0)
    Unit cur, nxt; int ui = 0;
    if (!S.next(0, cur)) return;
    f32x4 acc[2][2][4][2];
#pragma unroll
    for (int a = 0; a < 2; ++a)
#pragma unroll
        for (int b = 0; b < 2; ++b)
#pragma unroll
            for (int m = 0; m < 4; ++m)
#pragma unroll
                for (int n = 0; n < 2; ++n) acc[a][b][m][n] = (f32x4){0.f, 0.f, 0.f, 0.f};
    bf16x8 At[4][2], B0[2][2], B1[2][2];
    const char* cA = cur.A; const char* cB = cur.B;
    S.a_ready(cur);
    if constexpr (SP2) {
        PG8_STAGE(PG8_SB(0, 0), cB, voffB); PG8_STAGE(PG8_SB(0, 1), cB + hstep, voffB); PG8_STAGE(PG8_SA(0, 0), cA, voffA); PG8_STAGE(PG8_SA(0, 1), cA + hstepA, voffA);
        if (wr == 1) PG8_BAR;
        PG8_WAIT_V(2); PG8_BAR;
        PG8_STAGE(PG8_SB(1, 0), cB + kstep, voffB); PG8_STAGE(PG8_SA(1, 0), cA + kstepA, voffA); PG8_STAGE(PG8_SB(1, 1), cB + hstep + kstep, voffB);
        PG8_WAIT_V(6); PG8_BAR;
    } else {
        PG8_STAGE(PG8_SB(0, 0), cB, voffB); PG8_STAGE(PG8_SA(0, 0), cA, voffA); PG8_STAGE(PG8_SB(0, 1), cB + hstep, voffB); PG8_STAGE(PG8_SA(0, 1), cA + hstepA, voffA);
        if (wr == 1) PG8_BAR;
        PG8_WAIT_V(4); PG8_BAR;
        PG8_STAGE(PG8_SB(1, 0), cB + kstep, voffB); PG8_STAGE(PG8_SA(1, 0), cA + kstepA, voffA); PG8_STAGE(PG8_SB(1, 1), cB + hstep + kstep, voffB);
        PG8_WAIT_V(6); PG8_BAR;
    }
    for (;;) {
        const bool has_next = S.next(ui + 1, nxt);
        const char* nA = has_next ? nxt.A : cA; const char* nB = has_next ? nxt.B : cB;
        for (int t = 0; t < nt; t += 2) {
            const bool last = (t == nt - 2);
            const char* a1 = cA + (size_t)(t + 1) * kstepA;
            const char* a2 = last ? nA : cA + (size_t)(t + 2) * kstepA; const char* b2 = last ? nB : cB + (size_t)(t + 2) * kstep;
            const char* a3 = a2 + kstepA; const char* b3 = b2 + kstep;
            if (last && has_next) S.a_ready(nxt);
            if constexpr (SP2) {
            PG8_LDB(B0, 0, 0); PG8_LDB(B1, 0, 1); PG8_SCHED; PG8_LDA(At, 0, 0); PG8_STAGE(PG8_SA(1, 1), a1 + hstepA, voffA);
            PG8_WAIT_V(8); PG8_WAIT_L(0); PG8_BAR; PG8_MMA(0, 0, At, B0); PG8_MMA(0, 1, At, B1); PG8_BAR; PG8_SCHED;
            PG8_LDA(At, 0, 1); PG8_STAGE(PG8_SB(0, 0), b2, voffB); PG8_STAGE(PG8_SB(0, 1), b2 + hstep, voffB); PG8_STAGE(PG8_SA(0, 0), a2, voffA);
            PG8_WAIT_V(8); PG8_WAIT_L(0); PG8_BAR; PG8_MMA(1, 0, At, B0); PG8_MMA(1, 1, At, B1); PG8_BAR; PG8_SCHED;
            PG8_LDB(B0, 1, 0); PG8_LDB(B1, 1, 1); PG8_SCHED; PG8_LDA(At, 1, 0); PG8_STAGE(PG8_SA(0, 1), a2 + hstepA, voffA);
            PG8_WAIT_V(8); PG8_WAIT_L(0); PG8_BAR; PG8_MMA(0, 0, At, B0); PG8_MMA(0, 1, At, B1); PG8_BAR; PG8_SCHED;
            PG8_LDA(At, 1, 1); PG8_STAGE(PG8_SB(1, 0), b3, voffB); PG8_STAGE(PG8_SB(1, 1), b3 + hstep, voffB); PG8_STAGE(PG8_SA(1, 0), a3, voffA);
            PG8_WAIT_V(8); PG8_WAIT_L(0); PG8_BAR; PG8_MMA(1, 0, At, B0); PG8_MMA(1, 1, At, B1); PG8_BAR; PG8_SCHED;
            } else {
            PG8_LDB(B0, 0, 0); PG8_SCHED; PG8_LDA(At, 0, 0); PG8_STAGE(PG8_SA(1, 1), a1 + hstepA, voffA);
            PG8_WAIT_L(8); PG8_BAR; PG8_WAIT_L(0); PG8_MMA(0, 0, At, B0); PG8_BAR; PG8_SCHED;
            PG8_LDB(B1, 0, 1); PG8_STAGE(PG8_SB(0, 0), b2, voffB);
            PG8_BAR; PG8_WAIT_L(0); PG8_MMA(0, 1, At, B1); PG8_BAR;
            PG8_LDA(At, 0, 1); PG8_STAGE(PG8_SA(0, 0), a2, voffA);
            PG8_BAR; PG8_WAIT_L(0); PG8_MMA(1, 0, At, B0); PG8_BAR; PG8_SCHED;
            PG8_STAGE(PG8_SB(0, 1), b2 + hstep, voffB);
            PG8_WAIT_V(6); PG8_BAR; PG8_MMA(1, 1, At, B1); PG8_BAR;
            PG8_LDB(B0, 1, 0); PG8_SCHED; PG8_LDA(At, 1, 0); PG8_STAGE(PG8_SA(0, 1), a2 + hstepA, voffA);
            PG8_WAIT_L(8); PG8_BAR; PG8_WAIT_L(0); PG8_MMA(0, 0, At, B0); PG8_BAR; PG8_SCHED;
            PG8_LDB(B1, 1, 1); PG8_STAGE(PG8_SB(1, 0), b3, voffB);
            PG8_BAR; PG8_WAIT_L(0); PG8_MMA(0, 1, At, B1); PG8_BAR;
            PG8_LDA(At, 1, 1); PG8_STAGE(PG8_SA(1, 0), a3, voffA);
            PG8_BAR; PG8_WAIT_L(0); PG8_MMA(1, 0, At, B0); PG8_BAR; PG8_SCHED;
            PG8_STAGE(PG8_SB(1, 1), b3 + hstep, voffB);
            PG8_WAIT_V(6); PG8_BAR; PG8_MMA(1, 1, At, B1); PG8_BAR;
            }
        }
        if constexpr (ALIGN_EPI) { if (wr == 0) PG8_BAR; }
        if constexpr (!Epi::AFTER_DRAIN) { E(acc, cur, wr, wc, fr, fq); S.done(cur); }
        if (!has_next) break;
#pragma unroll
        for (int a = 0; a < 2; ++a)
#pragma unroll
            for (int b = 0; b < 2; ++b)
#pragma unroll
                for (int m = 0; m < 4; ++m)
#pragma unroll
                    for (int n = 0; n < 2; ++n) acc[a][b][m][n] = (f32x4){0.f, 0.f, 0.f, 0.f};
        cur = nxt; cA = nA; cB = nB; ++ui;
        if constexpr (ALIGN_EPI) { if (wr == 1) PG8_BAR; }
    }
    PG8_WAIT_V(0);
    if constexpr (!ALIGN_EPI) { if (wr == 0) PG8_BAR; }
    PG8_BAR;
    if constexpr (Epi::AFTER_DRAIN) { E.fused(acc, cur, wr, wc, fr, fq, lds, wid, lane); S.done(cur); }
#undef PG8_SA
#undef PG8_SB
#undef PG8_STAGE
#undef PG8_LDA
#undef PG8_LDB
#undef PG8_MMA
#undef PG8_WAIT_V
#undef PG8_WAIT_L
#undef PG8_BAR
#undef PG8_SCHED
}
}

#define PHASE_PROLOGUE \
    int tid_ = threadIdx.x; asm volatile("" : "+v"(tid_)); const int tid = tid_, lane = tid & 63, wave = tid >> 6; \
    const int G = GRID, bid = blockIdx.x; \
    const int gw = bid * 8 + wave, NGW = G * 8; \
    unsigned char* ws = P.ws; \
    float* H = (float*)(ws + WS_H); \
    bf16_t* HN = (bf16_t*)(ws + WS_HN); \
    bf16_t* A2 = (bf16_t*)(ws + WS_A2); \
    bf16_t* Qb = (bf16_t*)(ws + WS_Q); bf16_t* Kb = (bf16_t*)(ws + WS_K); bf16_t* Vb = (bf16_t*)(ws + WS_V); \
    bf16_t* REST = (bf16_t*)(ws + WS_REST); \
    bf16_t* YFB = (bf16_t*)(ws + WS_YFB); \
    bf16_t* Rr = (bf16_t*)(ws + WS_R); bf16_t* VV = (bf16_t*)(ws + WS_VV); bf16_t* KK = (bf16_t*)(ws + WS_KK); \
    bf16_t* KKA = (bf16_t*)(ws + WS_KKA); bf16_t* KD = (bf16_t*)(ws + WS_KD); \
    _Float16* LW = (_Float16*)(ws + WS_W); bf16_t* PP = (bf16_t*)(ws + WS_PP); bf16_t* QT = (bf16_t*)(ws + WS_QT); bf16_t* YT = (bf16_t*)(ws + WS_YT); bf16_t* ZT = (bf16_t*)(ws + WS_ZT); \
    bf16_t* Gg = (bf16_t*)(ws + WS_G); bf16_t* KR = (bf16_t*)(ws + WS_KR); bf16_t* LOW = (bf16_t*)(ws + WS_LOW); \
    float* BC = (float*)(ws + WS_BC); \
    bf16_t* AA = (bf16_t*)(ws + WS_AA); \
    bf16_t* HB = (bf16_t*)(ws + WS_HB); bf16_t* YB = (bf16_t*)(ws + WS_YB); \
    bf16_t* XB = (bf16_t*)(ws + WS_XB); int* EID = (int*)(ws + WS_EID); int* POS = (int*)(ws + WS_POS); int* DEST = (int*)(ws + WS_DEST); \
    float* GATE = (float*)(ws + WS_GATE); \
    float* YI = (float*)(ws + WS_YI); float* S5E = (float*)(ws + WS_E); bf16_t* CAR = (bf16_t*)(ws + WS_CAR); bf16_t* BTA = (bf16_t*)(ws + WS_BTA); bf16_t* BTC = (bf16_t*)(ws + WS_BTC); \
    unsigned* CTL = (unsigned*)(ws + WS_CTL); \
    bf16_t* WTIN = (bf16_t*)(ws + WS_WTIN); bf16_t* WTOUT = (bf16_t*)(ws + WS_WTOUT); bf16_t* WTGLU = (bf16_t*)(ws + WS_WTGLU); bf16_t* WT13 = (bf16_t*)(ws + WS_WT13); bf16_t* WT2 = (bf16_t*)(ws + WS_WT2); \
    const int vcu = (G % 8 == 0) ? (bid % 8) * (G / 8) + bid / 8 : bid; \
    const float* x = P.in[0]; const float* meta = P.in[1]; const float* norm_mix = P.in[2]; const float* norm_ffn = P.in[3]; const float* norm_final = P.in[4]; \
    const float* w_in = P.in[5]; const float* w_out = P.in[6]; const float* rpb = P.in[7]; const float* mu = P.in[8]; \
    const float* w0 = P.in[9]; const float* w_up = P.in[10]; const float* a0 = P.in[11]; const float* a_up = P.in[12]; const float* g_up = P.in[13]; \
    const float* k_k = P.in[14]; const float* k_a = P.in[15]; const float* r_k = P.in[16]; const float* lnx_g = P.in[17]; const float* lnx_b = P.in[18]; \
    const float* s5_b_re = P.in[19]; const float* s5_b_im = P.in[20]; const float* s5_lre = P.in[21]; const float* s5_lim = P.in[22]; const float* s5_ls = P.in[23]; \
    const float* s5_c_re = P.in[24]; const float* s5_c_im = P.in[25]; const float* s5_d = P.in[26]; const float* w_glu = P.in[27]; \
    const float* moe_wg = P.in[28]; const float* moe_bg = P.in[29]; const float* moe_we = P.in[30]; const float* moe_be = P.in[31]; \
    const float* moe_w1 = P.in[32]; const float* moe_w3 = P.in[33]; const float* moe_w2 = P.in[34];


__device__ __forceinline__ void transpose_item(const float* W, int N, int K, int k0, int n0, bf16_t* dstrow0, int lane) {
    const int nq = lane & 15, kb = lane >> 4;
    const float* src = W + (size_t)(k0 + 16 * kb) * N + n0 + 4 * nq;
    f32x4 v[16];
#pragma unroll
    for (int kk = 0; kk < 16; ++kk) v[kk] = *(const f32x4*)(src + (size_t)kk * N);
#pragma unroll
    for (int i = 0; i < 4; ++i) {
        bf16_t* d = dstrow0 + (size_t)(4 * nq + i) * K + k0 + 16 * kb;
        u32x4 lo, hi;
        lo.x = pk2(v[0][i], v[1][i]); lo.y = pk2(v[2][i], v[3][i]); lo.z = pk2(v[4][i], v[5][i]); lo.w = pk2(v[6][i], v[7][i]);
        hi.x = pk2(v[8][i], v[9][i]); hi.y = pk2(v[10][i], v[11][i]); hi.z = pk2(v[12][i], v[13][i]); hi.w = pk2(v[14][i], v[15][i]);
        *(u32x4*)d = lo; *(u32x4*)(d + 8) = hi;
    }
}
#define CONV_DENSE_ITEMS (832 + 256 + 512)
__device__ __forceinline__ void conv_dense_item(CParams& P, int it, int lane) {
    unsigned char* ws = P.ws;
    if (it < 832) { const int kb = it / 52, nb = it % 52; transpose_item(P.in[5], INCOLS, DM, kb * 64, nb * 64, (bf16_t*)(ws + WS_WTIN) + (size_t)nb * 64 * DM, lane); return; }
    it -= 832;
    if (it < 256) { const int kb = it / 16, nb = it % 16; transpose_item(P.in[6], DM, DM, kb * 64, nb * 64, (bf16_t*)(ws + WS_WTOUT) + (size_t)nb * 64 * DM, lane); return; }
    it -= 256;
    { const int kb = it / 32, nb = it % 32, n = nb * 64, half = n >> 10, c = n & 1023, row = (c >> 7) * 256 + half * 128 + (c & 127);
      transpose_item(P.in[27], 2 * DM, DM, kb * 64, n, (bf16_t*)(ws + WS_WTGLU) + (size_t)row * DM, lane); }
}
#define CONV_MOE_ITEMS (NEXP * 384)
__device__ __forceinline__ void conv_moe_item(CParams& P, int l, int it, int lane) {
    unsigned char* ws = P.ws;
    const int e = it / 384; int r = it % 384;
    if (r < 256) { const int which = r >> 7; r &= 127; const int kb = r >> 3, nb = r & 7, n = nb * 64, row = (n >> 7) * 256 + which * 128 + (n & 127);
        const float* W = (which ? P.in[33] : P.in[32]) + ((size_t)(l * NEXP + e) * DM) * DFF;
        transpose_item(W, DFF, DM, kb * 64, n, (bf16_t*)(ws + WS_WT13) + ((size_t)e * DM + row) * DM, lane); return; }
    r -= 256;
    { const int kb = r >> 4, nb = r & 15; const float* W = P.in[34] + ((size_t)(l * NEXP + e) * DFF) * DM;
      transpose_item(W, DM, DFF, kb * 64, nb * 64, (bf16_t*)(ws + WS_WT2) + ((size_t)e * DM + nb * 64) * DFF, lane); }
}

template <int MODE>
__device__ __forceinline__ void meta_gemm(const bf16_t* A, const bf16_t* Bt, float* Hrows, int task, int lane) {
    const int fr = lane & 15, fq = lane >> 4, c = task * 16 + fr;
    const bf16_t* b0 = MODE == 0 ? Bt + (size_t)c * DM : Bt + (size_t)((c >> 7) * 256 + (c & 127)) * DM;
    const bf16_t* b1 = b0 + (size_t)128 * DM;
    f32x4 acc0[2], acc1[2];
    acc0[0] = acc0[1] = acc1[0] = acc1[1] = (f32x4){0.f, 0.f, 0.f, 0.f};
#pragma unroll 4
    for (int kt = 0; kt < 32; ++kt) {
        const int ko = kt * 32 + fq * 8;
        const bf16x8 a0 = *(const bf16x8*)(A + (size_t)fr * DM + ko), a1 = *(const bf16x8*)(A + (size_t)(16 + fr) * DM + ko);
        const bf16x8 bv = *(const bf16x8*)(b0 + ko);
        acc0[0] = __builtin_amdgcn_mfma_f32_16x16x32_bf16(a0, bv, acc0[0], 0, 0, 0);
        acc0[1] = __builtin_amdgcn_mfma_f32_16x16x32_bf16(a1, bv, acc0[1], 0, 0, 0);
        if (MODE == 1) { const bf16x8 bg = *(const bf16x8*)(b1 + ko);
            acc1[0] = __builtin_amdgcn_mfma_f32_16x16x32_bf16(a0, bg, acc1[0], 0, 0, 0);
            acc1[1] = __builtin_amdgcn_mfma_f32_16x16x32_bf16(a1, bg, acc1[1], 0, 0, 0); }
    }
#pragma unroll
    for (int mi = 0; mi < 2; ++mi)
#pragma unroll
        for (int j = 0; j < 4; ++j) { float* p = Hrows + (size_t)(mi * 16 + fq * 4 + j) * DM + c;
            if (MODE == 0) *p += acc0[mi][j]; else *p += acc0[mi][j] * __builtin_amdgcn_rcpf(1.f + __expf(-acc1[mi][j])); }
}
__device__ __forceinline__ void phase_0(CParams& P, unsigned char* lds, const int ph) {
    PHASE_PROLOGUE
            for (int row = gw; row < NT; row += NGW) {
                const float* src = row < NMAIN ? x + (size_t)row * DM : meta + (size_t)((row - NMAIN) & 15) * DM;
                f32x4 v[4];
#pragma unroll
                for (int j = 0; j < 4; ++j) { v[j] = ((const f32x4*)src)[lane + 64 * j]; ((f32x4*)(H + (size_t)row * DM))[lane + 64 * j] = v[j]; }
                store_norm_bf16(v, norm_mix, HN + (size_t)row * DM, lane);
            }
    for (int it = gw; it < CONV_DENSE_ITEMS; it += NGW) conv_dense_item(P, it, lane);
}

__device__ __forceinline__ void phase_1(CParams& P, unsigned char* lds, const int ph) {
    PHASE_PROLOGUE
    pg8::ProjOrder S; S.init(HN, WTIN, bid);
    pg8::EpiProj E{Qb, Kb, Vb, REST};
    pg8::gemm_phase<pg8::EpiProj, pg8::ProjOrder, true, true>((PG8_LAS unsigned char*)lds, DM, S, E);
}

__device__ __forceinline__ void phase_2(CParams& P, unsigned char* lds, const int ph) {
    PHASE_PROLOGUE
    float* sb = (float*)lds;
    for (int i = tid; i < 8 * 465; i += 512) sb[i] = rpb[i];
    __syncthreads();
    const bf16_t* VT = Vb;
    const int fr = lane & 15, fq = lane >> 4;
    for (int u = gw; u < 8192 + 16; u += NGW) {
        const bool metaq = u >= 8192;
        int b, h, r = 0, qb = 0;
        if (!metaq) { qb = u & 3; r = (u >> 2) & 127; h = (u >> 9) & 7; b = u >> 12; } else { const int m = u - 8192; b = m >> 3; h = m & 7; }
        const int c = qb * 16 + fr;
        const int qrow = metaq ? NMAIN + b * NMETA + fr : b * SEQ + r * 64 + c;
        const int R0 = min(max(r - 4, 0), 120), cs = qb == 0 ? 0 : (qb == 1 ? 8 : (qb == 2 ? 24 : 32));
        const int C0 = min(max(c - 8, 0), 48);
        bf16x8 qf0 = *(const bf16x8*)(Qb + (size_t)qrow * 512 + h * 64 + fq * 8), qf1 = *(const bf16x8*)(Qb + (size_t)qrow * 512 + h * 64 + 32 + fq * 8);
        f32x4 sacc[17];
        const f32x4 zero4 = (f32x4){0.f, 0.f, 0.f, 0.f};
        if (!metaq) {
#pragma unroll
            for (int kt = 0; kt < 16; ++kt) {
                const int krow0 = b * SEQ + (R0 + (kt >> 1)) * 64 + cs + 16 * (kt & 1);
                const bf16_t* kp = Kb + (size_t)(krow0 + fr) * 512 + h * 64 + fq * 8;
                const bf16x8 a0 = *(const bf16x8*)kp, a1 = *(const bf16x8*)(kp + 32);
                f32x4 acc = __builtin_amdgcn_mfma_f32_16x16x32_bf16(a0, qf0, zero4, 0, 0, 0);
                sacc[kt] = __builtin_amdgcn_mfma_f32_16x16x32_bf16(a1, qf1, acc, 0, 0, 0);
            }
        } else {
#pragma unroll
            for (int kt = 0; kt < 16; ++kt) sacc[kt] = zero4;
        }
        {
            const bf16_t* kp = Kb + (size_t)(NMAIN + b * NMETA + fr) * 512 + h * 64 + fq * 8;
            const bf16x8 a0 = *(const bf16x8*)kp, a1 = *(const bf16x8*)(kp + 32);
            f32x4 acc = __builtin_amdgcn_mfma_f32_16x16x32_bf16(a0, qf0, zero4, 0, 0, 0);
            sacc[16] = __builtin_amdgcn_mfma_f32_16x16x32_bf16(a1, qf1, acc, 0, 0, 0);
        }
        float mx = -1e30f;
#pragma unroll
        for (int kt = 0; kt < 16; ++kt) {
            const int dr = R0 + (kt >> 1) - r + 7;
#pragma unroll
            for (int j = 0; j < 4; ++j) {
                const int kc = cs + 16 * (kt & 1) + 4 * fq + j;
                const bool inb = !metaq && kc >= C0 && kc < C0 + 16;
                const int dc = min(max(kc - c + 15, 0), 30);
                const float s = inb ? sacc[kt][j] * 0.125f + sb[(h * 15 + dr) * 31 + dc] : -1e30f;
                sacc[kt][j] = s; mx = fmaxf(mx, s);
            }
        }
#pragma unroll
        for (int j = 0; j < 4; ++j) { const float s = sacc[16][j] * 0.125f; sacc[16][j] = s; mx = fmaxf(mx, s); }
        mx = fmaxf(mx, __shfl_xor(mx, 16)); mx = fmaxf(mx, __shfl_xor(mx, 32));
        float sum = 0.f;
#pragma unroll
        for (int kt = 0; kt < 17; ++kt)
#pragma unroll
            for (int j = 0; j < 4; ++j) { const float pv = __expf(sacc[kt][j] - mx); sacc[kt][j] = pv; sum += pv; }
        sum += __shfl_xor(sum, 16); sum += __shfl_xor(sum, 32);
        f32x4 o[4] = {zero4, zero4, zero4, zero4};
        if (!metaq) {
#pragma unroll
            for (int kr = 0; kr < 8; ++kr) {
                union { bf16x8 v; unsigned u[4]; } bf;
                bf.u[0] = pk2(sacc[2 * kr][0], sacc[2 * kr][1]); bf.u[1] = pk2(sacc[2 * kr][2], sacc[2 * kr][3]);
                bf.u[2] = pk2(sacc[2 * kr + 1][0], sacc[2 * kr + 1][1]); bf.u[3] = pk2(sacc[2 * kr + 1][2], sacc[2 * kr + 1][3]);
                const size_t tok0 = (size_t)b * SEQ + (R0 + kr) * 64 + cs + 4 * fq;
#pragma unroll
                for (int dt = 0; dt < 4; ++dt) {
                    const bf16_t* vp = VT + (size_t)(h * 64 + dt * 16 + fr) * NTP + tok0;
                    union { bf16x8 v; u32x2 h2[2]; } af;
                    af.h2[0] = *(const u32x2*)vp; af.h2[1] = *(const u32x2*)(vp + 16);
                    o[dt] = __builtin_amdgcn_mfma_f32_16x16x32_bf16(af.v, bf.v, o[dt], 0, 0, 0);
                }
            }
        }
        {
            union { bf16x8 v; unsigned u[4]; } bf;
            bf.u[0] = pk2(sacc[16][0], sacc[16][1]); bf.u[1] = pk2(sacc[16][2], sacc[16][3]); bf.u[2] = 0u; bf.u[3] = 0u;
            const size_t tokm = (size_t)NMAIN + b * NMETA + 4 * fq;
#pragma unroll
            for (int dt = 0; dt < 4; ++dt) {
                const bf16_t* vp = VT + (size_t)(h * 64 + dt * 16 + fr) * NTP + tokm;
                union { bf16x8 v; u32x2 h2[2]; } af;
                af.h2[0] = *(const u32x2*)vp; af.h2[1] = (u32x2){0u, 0u};
                o[dt] = __builtin_amdgcn_mfma_f32_16x16x32_bf16(af.v, bf.v, o[dt], 0, 0, 0);
            }
        }
        const float inv = 1.f / sum;
#pragma unroll
        for (int dt = 0; dt < 4; ++dt) {
            u32x2 ov; ov.x = pk2(o[dt][0] * inv, o[dt][1] * inv); ov.y = pk2(o[dt][2] * inv, o[dt][3] * inv);
            *(u32x2*)(A2 + (size_t)qrow * DM + h * 64 + dt * 16 + 4 * fq) = ov;
        }
    }
    __syncthreads();
}

__device__ __forceinline__ void phase_3(CParams& P, unsigned char* lds, const int ph) {
    PHASE_PROLOGUE
            for (int tk = gw; tk < NT; tk += NGW) {
                const int b = tk / LSEQ, p = tk % LSEQ, row = rowof(b, p);
                const bool hp = p > 0, hn = p + 1 < LSEQ;
                const int rowp = hp ? rowof(b, p - 1) : row, rown = hn ? rowof(b, p + 1) : row;
#pragma unroll
                for (int j = 0; j < 7; ++j) {
                    const int c = 4 * lane + 256 * j;
                    const u32x2 vc = *(const u32x2*)(REST + (size_t)row * RESTC + c);
                    u32x2 vp = *(const u32x2*)(REST + (size_t)rowp * RESTC + c);
                    u32x2 vn = *(const u32x2*)(REST + (size_t)rown * RESTC + c);
                    if (!hp) { vp.x = 0; vp.y = 0; }
                    if (!hn) { vn.x = 0; vn.y = 0; }
                    const f32x4 m4 = *(const f32x4*)(mu + c);
                    float pc[4] = {bflo(vc.x), bfhi(vc.x), bflo(vc.y), bfhi(vc.y)};
                    float pp[4] = {bflo(vp.x), bfhi(vp.x), bflo(vp.y), bfhi(vp.y)};
                    float pn[4] = {bflo(vn.x), bfhi(vn.x), bflo(vn.y), bfhi(vn.y)};
                    float o[4];
#pragma unroll
                    for (int i = 0; i < 4; ++i) o[i] = pc[i] + m4[i] * (0.5f * (pp[i] + pn[i]) - pc[i]);
                    if (j == 6) {
                        if (lane < 16) { for (int i = 0; i < 4; ++i) o[i] = tanhf(o[i]); }
                        else if (lane >= 32) { for (int i = 0; i < 4; ++i) o[i] = sigmoidf_(o[i]); }
                    }
                    u32x2 ov; ov.x = pk2(o[0], o[1]); ov.y = pk2(o[2], o[3]);
                    bf16_t* dst = j < 2 ? Rr + (size_t)row * 512 + c : (j < 4 ? KR + (size_t)row * 512 + (c - 512) : (j < 6 ? VV + (size_t)row * 512 + (c - 1024) : LOW + (size_t)row * 256 + (c - 1536)));
                    *(u32x2*)dst = ov;
                }
            }
}


__device__ __forceinline__ void phase_4(CParams& P, unsigned char* lds, const int ph) {
    PHASE_PROLOGUE
            const int nrt = (NT + 127) / 128;
            const int nunits = nrt * 4 * 5;
            for (int u = bid; u < nunits; u += G) {
                const int which = u / (nrt * 4), rem = u % (nrt * 4), rt = rem / 4, ct = rem % 4;
                f32x4 acc[4][2];
                const int koff = which < 2 ? 0 : (which < 4 ? 64 : 128), KK_ = which < 4 ? 64 : 128;
                const float* Bsrc = which < 2 ? w_up + (size_t)which * 64 * 512 : (which < 4 ? a_up + (size_t)(which - 2) * 64 * 512 : g_up);
                gemm_tile(lds, KK_, 512,
                          [&](int r) { int row = rt * 128 + r; if (row >= NT) row = NT - 1; return LOW + (size_t)row * 256 + koff; },
                          [&](int n) { return Bsrc + ct * 128 + n; }, acc);
                ACC_FOREACH(acc, { const int row = rt * 128 + rl, col = ct * 128 + cl; if (row < NT) {
                    if (which < 2) { const float wl = w0[which * 512 + col] + val; LW[((size_t)which * NT + row) * 512 + col] = (_Float16)(-0.6065306597f * sigmoidf_(wl)); }
                    else if (which < 4) { const int d = which - 2; AA[((size_t)d * NT + row) * 512 + col] = (bf16_t)f2bf(sigmoidf_(a0[d * 512 + col] + val)); }
                    else Gg[(size_t)row * 512 + col] = (bf16_t)f2bf(val); } });
            }
}


__device__ __forceinline__ void phase_5(CParams& P, unsigned char* lds, const int ph) {
    PHASE_PROLOGUE
            for (int row = gw; row < NT; row += NGW) {
                const int c0 = lane * 8;
                const u32x4 krv = *(const u32x4*)(KR + (size_t)row * 512 + c0);
                const u32x4 rv = *(const u32x4*)(Rr + (size_t)row * 512 + c0);
                float kr[8], rr[8], kkv[8];
#pragma unroll
                for (int i = 0; i < 4; ++i) { kr[2 * i] = bflo(krv[i]); kr[2 * i + 1] = bfhi(krv[i]); rr[2 * i] = bflo(rv[i]); rr[2 * i + 1] = bfhi(rv[i]); }
                float ss = 0.f;
#pragma unroll
                for (int i = 0; i < 8; ++i) { kkv[i] = kr[i] * k_k[c0 + i]; ss += kkv[i] * kkv[i]; }
                ss += __shfl_xor(ss, 1); ss += __shfl_xor(ss, 2); ss += __shfl_xor(ss, 4);
                const float inv = 1.f / fmaxf(sqrtf(ss), 1e-12f);
#pragma unroll
                for (int i = 0; i < 8; ++i) kkv[i] *= inv;
                u32x4 o; o.x = pk2(kkv[0], kkv[1]); o.y = pk2(kkv[2], kkv[3]); o.z = pk2(kkv[4], kkv[5]); o.w = pk2(kkv[6], kkv[7]);
                *(u32x4*)(KK + (size_t)row * 512 + c0) = o;
                float bsum = 0.f;
#pragma unroll
                for (int d = 0; d < 2; ++d) {
                    const u32x4 av = *(const u32x4*)(AA + ((size_t)d * NT + row) * 512 + c0);
                    float a[8], kka[8], kd[8];
#pragma unroll
                    for (int i = 0; i < 4; ++i) { a[2 * i] = bflo(av[i]); a[2 * i + 1] = bfhi(av[i]); }
#pragma unroll
                    for (int i = 0; i < 8; ++i) { kka[i] = kkv[i] * a[i]; kd[i] = kr[i] * (1.f + (a[i] - 1.f) * k_a[c0 + i]); bsum += rr[i] * kd[i] * r_k[c0 + i]; }
                    u32x4 o1; o1.x = pk2(kka[0], kka[1]); o1.y = pk2(kka[2], kka[3]); o1.z = pk2(kka[4], kka[5]); o1.w = pk2(kka[6], kka[7]);
                    *(u32x4*)(KKA + ((size_t)d * NT + row) * 512 + c0) = o1;
                    u32x4 o2; o2.x = pk2(kd[0], kd[1]); o2.y = pk2(kd[2], kd[3]); o2.z = pk2(kd[4], kd[5]); o2.w = pk2(kd[6], kd[7]);
                    *(u32x4*)(KD + ((size_t)d * NT + row) * 512 + c0) = o2;
                }
                bsum += __shfl_xor(bsum, 1); bsum += __shfl_xor(bsum, 2); bsum += __shfl_xor(bsum, 4);
                if ((lane & 7) == 0) BC[(size_t)row * 8 + (lane >> 3)] = bsum;
            }
}


#define RWS 72
__device__ __forceinline__ bf16x8 rw_frag(const bf16_t* M, int row, int kofs) { return *(const bf16x8*)(M + row * RWS + kofs); }
__device__ __forceinline__ f32x4 rw_tile(const bf16_t* Am, int ra, const bf16_t* Bm, int rb, int fr, int fq) {
    f32x4 acc = (f32x4){0.f, 0.f, 0.f, 0.f};
    acc = __builtin_amdgcn_mfma_f32_16x16x32_bf16(rw_frag(Am, ra + fr, 8 * fq), rw_frag(Bm, rb + fr, 8 * fq), acc, 0, 0, 0);
    acc = __builtin_amdgcn_mfma_f32_16x16x32_bf16(rw_frag(Am, ra + fr, 32 + 8 * fq), rw_frag(Bm, rb + fr, 32 + 8 * fq), acc, 0, 0, 0);
    return acc;
}
__device__ __forceinline__ void phase_6(CParams& P, unsigned char* lds, const int ph) {
    PHASE_PROLOGUE
    float* Gs = (float*)lds;
    bf16_t* A_rm = (bf16_t*)(lds + 16384); bf16_t* R_rm = A_rm + 64 * RWS; bf16_t* B_rm = R_rm + 64 * RWS; bf16_t* K_rm = B_rm + 64 * RWS;
    bf16_t* B_tr = K_rm + 64 * RWS; bf16_t* K_tr = B_tr + 64 * RWS; bf16_t* V_tr = K_tr + 64 * RWS;
    bf16_t* MAK = V_tr + 64 * RWS; bf16_t* MRB = MAK + 64 * RWS; bf16_t* MRK = MRB + 64 * RWS;
    float* RHS = (float*)(MRK + 64 * RWS);
    float* BT = RHS + 8192; float* OFF = BT + 512; float* GC = OFF + 512;
    bf16_t* X1_tr = A_rm; bf16_t* X2_tr = K_rm;
    for (int i = tid; i < 3 * 64 * RWS / 2; i += 512) ((unsigned*)MAK)[i] = 0u;
    __syncthreads();
    const int fr = lane & 15, fq = lane >> 4;
    for (int u = bid; u < RW_UNITS; u += G) {
        const int chain = u / RW_NCH, c = u - chain * RW_NCH, d = chain >> 4, b = (chain >> 3) & 1, h = chain & 7;
        const int t0 = tid >> 3, kp = (tid & 7) * 8;
        float lw[8], kk[8], ka[8], kd[8], rr[8]; u32x4 vv;
        {
            const int s = c * 64 + t0; const bool valid = s < LSEQ;
            const int p = d ? LSEQ - 1 - s : s; const size_t o = (size_t)rowof(b, valid ? p : 0) * 512 + h * 64 + kp;
            const u32x4 lwv = *(const u32x4*)(LW + (size_t)d * NT * 512 + o), kkv = *(const u32x4*)(KK + o), kav = *(const u32x4*)(KKA + (size_t)d * NT * 512 + o),
                        kdv = *(const u32x4*)(KD + (size_t)d * NT * 512 + o), rv = *(const u32x4*)(Rr + o);
            vv = *(const u32x4*)(VV + o);
#pragma unroll
            for (int i = 0; i < 4; ++i) {
                union { unsigned u; _Float16 hh[2]; } cv; cv.u = lwv[i];
                lw[2 * i] = valid ? (float)cv.hh[0] : 0.f; lw[2 * i + 1] = valid ? (float)cv.hh[1] : 0.f;
                kk[2 * i] = valid ? bflo(kkv[i]) : 0.f; kk[2 * i + 1] = valid ? bfhi(kkv[i]) : 0.f;
                ka[2 * i] = valid ? bflo(kav[i]) : 0.f; ka[2 * i + 1] = valid ? bfhi(kav[i]) : 0.f;
                kd[2 * i] = valid ? bflo(kdv[i]) : 0.f; kd[2 * i + 1] = valid ? bfhi(kdv[i]) : 0.f;
                rr[2 * i] = valid ? bflo(rv[i]) : 0.f; rr[2 * i + 1] = valid ? bfhi(rv[i]) : 0.f;
                if (!valid) vv[i] = 0u;
            }
        }
        *(f32x4*)(Gs + t0 * 64 + kp) = (f32x4){lw[0], lw[1], lw[2], lw[3]}; *(f32x4*)(Gs + t0 * 64 + kp + 4) = (f32x4){lw[4], lw[5], lw[6], lw[7]};
        __syncthreads();
        { const int k = tid & 63, w = tid >> 6; float acc = 0.f;
#pragma unroll
          for (int i = 0; i < 8; ++i) { acc += Gs[(8 * w + i) * 64 + k]; Gs[(8 * w + i) * 64 + k] = acc; }
          BT[w * 64 + k] = acc; }
        __syncthreads();
        { const int k = tid & 63, w = tid >> 6; float off = 0.f; for (int w2 = 0; w2 < w; ++w2) off += BT[w2 * 64 + k]; OFF[w * 64 + k] = off; }
        __syncthreads();
        {
            float va[8], vr[8], vb[8], vk[8];
#pragma unroll
            for (int i = 0; i < 8; ++i) {
                const float g = Gs[t0 * 64 + kp + i] + OFF[(t0 >> 3) * 64 + kp + i];
                const float eg = __expf(g), egm1 = __expf(g - lw[i]), einv = __expf(-g);
                va[i] = kk[i] * egm1; vr[i] = rr[i] * eg; vb[i] = ka[i] * einv; vk[i] = kd[i] * einv;
                if (t0 == 63) GC[kp + i] = eg;
            }
            *(f32x4*)(RHS + t0 * 128 + kp) = (f32x4){va[0], va[1], va[2], va[3]}; *(f32x4*)(RHS + t0 * 128 + kp + 4) = (f32x4){va[4], va[5], va[6], va[7]};
            u32x4 w4;
            w4.x = pk2(va[0], va[1]); w4.y = pk2(va[2], va[3]); w4.z = pk2(va[4], va[5]); w4.w = pk2(va[6], va[7]); *(u32x4*)(A_rm + t0 * RWS + kp) = w4;
            w4.x = pk2(vr[0], vr[1]); w4.y = pk2(vr[2], vr[3]); w4.z = pk2(vr[4], vr[5]); w4.w = pk2(vr[6], vr[7]); *(u32x4*)(R_rm + t0 * RWS + kp) = w4;
            w4.x = pk2(vb[0], vb[1]); w4.y = pk2(vb[2], vb[3]); w4.z = pk2(vb[4], vb[5]); w4.w = pk2(vb[6], vb[7]); *(u32x4*)(B_rm + t0 * RWS + kp) = w4;
            w4.x = pk2(vk[0], vk[1]); w4.y = pk2(vk[2], vk[3]); w4.z = pk2(vk[4], vk[5]); w4.w = pk2(vk[6], vk[7]); *(u32x4*)(K_rm + t0 * RWS + kp) = w4;
#pragma unroll
            for (int i = 0; i < 8; ++i) { B_tr[(kp + i) * RWS + t0] = (bf16_t)f2bf(vb[i]); K_tr[(kp + i) * RWS + t0] = (bf16_t)f2bf(vk[i]);
                V_tr[(kp + i) * RWS + t0] = (bf16_t)((i & 1) ? (vv[i >> 1] >> 16) : (vv[i >> 1] & 0xffffu)); }
        }
        __syncthreads();
        float* MABQ = Gs;
#ifndef RW1_REP1
#define RW1_REP1 1
#endif
        for (int rep_ = 0; rep_ < RW1_REP1; ++rep_)
        for (int q = wave; q < 40; q += 8) {
            const int m = q / 10, e = q - m * 10, ti = e >= 6 ? 3 : (e >= 3 ? 2 : (e >= 1 ? 1 : 0)), tj = e - (ti * (ti + 1)) / 2;
            const f32x4 acc = rw_tile(m < 2 ? A_rm : R_rm, 16 * ti, (m & 1) ? K_rm : B_rm, 16 * tj, fr, fq);
            bf16_t* Mm = m == 1 ? MAK : (m == 2 ? MRB : MRK);
#pragma unroll
            for (int j = 0; j < 4; ++j) { const int t = 16 * ti + 4 * fq + j, i = 16 * tj + fr; const bool keep = m < 2 ? (i < t) : (i <= t); const float val = keep ? acc[j] : 0.f;
                if (m == 0) MABQ[((i & 3) * 64 + t) * 16 + (i >> 2)] = val; else Mm[t * RWS + i] = (bf16_t)f2bf(val); }
        }
        __syncthreads();
        for (int q = wave; q < 16; q += 8) { const int ti = q >> 2, tv = q & 3; const f32x4 acc = rw_tile(MAK, 16 * ti, V_tr, 16 * tv, fr, fq);
#pragma unroll
            for (int j = 0; j < 4; ++j) RHS[(16 * ti + 4 * fq + j) * 128 + 64 + 16 * tv + fr] = acc[j]; }
        __syncthreads();
        {
            const int col = tid >> 2, q = tid & 3;
            float xs[16];
#ifndef RW1_REP3
#define RW1_REP3 1
#endif
            for (int rep_ = 0; rep_ < RW1_REP3; ++rep_) {
#pragma unroll
            for (int m = 0; m < 16; ++m) xs[m] = 0.f;
            asm volatile("" ::: "memory");
#pragma unroll
            for (int t = 0; t < 64; ++t) {
                float part = 0.f;
#pragma unroll
                for (int jg = 0; jg <= (t >> 4); ++jg) { const f32x4 mv = *(const f32x4*)(MABQ + (q * 64 + t) * 16 + 4 * jg);
                    part += mv[0] * xs[4 * jg] + mv[1] * xs[4 * jg + 1] + mv[2] * xs[4 * jg + 2] + mv[3] * xs[4 * jg + 3]; }
                part += dppf<0xB1>(part); part += dppf<0x4E>(part);
                const float xt = RHS[t * 128 + col] - part;
                xs[t >> 2] = (t & 3) == q ? xt : xs[t >> 2];
            }
            }
            __syncthreads();
            bf16_t* Xm = (col < 64 ? X1_tr : X2_tr) + (col & 63) * RWS + q;
#pragma unroll
            for (int m = 0; m < 16; ++m) Xm[4 * m] = (bf16_t)f2bf(xs[m]);
        }
        __syncthreads();
#ifndef RW1_REP5
#define RW1_REP5 1
#endif
        for (int rep_ = 0; rep_ < RW1_REP5; ++rep_)
        for (int q = wave; q < 64; q += 8) {
            const int kind = q >> 4, ta = (q >> 2) & 3, tb = q & 3;
            u32x2 o;
            if (kind == 0) {
                const f32x4 acc = rw_tile(X1_tr, 16 * ta, B_tr, 16 * tb, fr, fq);
                const int k = 16 * tb + fr, kq = 16 * ta + 4 * fq; const float gc = GC[k];
                float v[4];
#pragma unroll
                for (int j = 0; j < 4; ++j) v[j] = gc * ((kq + j == k ? 1.f : 0.f) - acc[j]);
                o.x = pk2(v[0], v[1]); o.y = pk2(v[2], v[3]);
                *(u32x2*)(PP + (size_t)u * 4096 + k * 64 + 32 * (ta >> 1) + 8 * fq + 4 * (ta & 1)) = o;
            } else if (kind == 1) {
                const f32x4 acc = rw_tile(X1_tr, 16 * ta, MRB, 16 * tb, fr, fq);
                const int t = 16 * tb + fr, k0 = 16 * ta + 4 * fq;
                const u32x2 rv = *(const u32x2*)(R_rm + t * RWS + k0);
                o.x = pk2(bflo(rv.x) - acc[0], bfhi(rv.x) - acc[1]); o.y = pk2(bflo(rv.y) - acc[2], bfhi(rv.y) - acc[3]);
                *(u32x2*)(YT + (size_t)u * 4096 + t * 64 + 32 * (ta >> 1) + 8 * fq + 4 * (ta & 1)) = o;
            } else if (kind == 2) {
                const f32x4 a1 = rw_tile(K_tr, 16 * ta, V_tr, 16 * tb, fr, fq), a2 = rw_tile(B_tr, 16 * ta, X2_tr, 16 * tb, fr, fq);
                const int v_ = 16 * tb + fr, k0 = 16 * ta + 4 * fq;
                const f32x4 gc = *(const f32x4*)(GC + k0);
                o.x = pk2(gc[0] * (a1[0] - a2[0]), gc[1] * (a1[1] - a2[1])); o.y = pk2(gc[2] * (a1[2] - a2[2]), gc[3] * (a1[3] - a2[3]));
                *(u32x2*)(QT + (size_t)u * 4096 + v_ * 64 + k0) = o;
            } else {
                const f32x4 a1 = rw_tile(MRK, 16 * ta, V_tr, 16 * tb, fr, fq), a2 = rw_tile(MRB, 16 * ta, X2_tr, 16 * tb, fr, fq);
                const int v_ = 16 * tb + fr, t0_ = 16 * ta + 4 * fq;
                o.x = pk2(a1[0] - a2[0], a1[1] - a2[1]); o.y = pk2(a1[2] - a2[2], a1[3] - a2[3]);
                *(u32x2*)(ZT + (size_t)u * 4096 + v_ * 64 + t0_) = o;
            }
        }
        __syncthreads();
    }
}

__device__ __forceinline__ void phase_60(CParams& P, unsigned char* lds, const int ph) {
    PHASE_PROLOGUE
    if (bid < 32) {
        const int chain = bid, d = chain >> 4, b = (chain >> 3) & 1, h = chain & 7;
        const int fr = lane & 15, fq = lane >> 4;
        constexpr int MATB = 64 * RWS * 2, SLOT = 4 * MATB;
        const bool comp = wave < 4; const int vb = wave & 3, lm = wave & 3;
        const unsigned char* src = (const unsigned char*)(lm == 0 ? PP : (lm == 1 ? YT : (lm == 2 ? QT : ZT))) + (size_t)chain * RW_NCH * 8192 + lane * 16;
        u32x4 R0[8], R1[8], R2[8];
#define RW2_LD(Rx, c_) do { _Pragma("unroll") for (int i_ = 0; i_ < 8; ++i_) Rx[i_] = *(const u32x4*)(src + (size_t)(c_) * 8192 + i_ * 1024); } while (0)
#define RW2_ST(Rx, c_) do { unsigned char* dst_ = lds + ((c_) & 3) * SLOT + lm * MATB; _Pragma("unroll") for (int i_ = 0; i_ < 8; ++i_) { const int p_ = lane + 64 * i_; *(u32x4*)(dst_ + (p_ >> 3) * (RWS * 2) + (p_ & 7) * 16) = Rx[i_]; } } while (0)
        const f32x4 zero4 = (f32x4){0.f, 0.f, 0.f, 0.f};
        f32x4 S[4] = {zero4, zero4, zero4, zero4};
#define RW2_COMPUTE(c_) do { const bf16_t* sl_ = (const bf16_t*)(lds + ((c_) & 3) * SLOT); const bf16_t* sP = sl_; const bf16_t* sY = sl_ + 64 * RWS; const bf16_t* sQ = sl_ + 2 * 64 * RWS; const bf16_t* sZ = sl_ + 3 * 64 * RWS; \
            union { bf16x8 v; unsigned u[4]; } bs[2]; \
            _Pragma("unroll") for (int ks = 0; ks < 2; ++ks) { bs[ks].u[0] = pk2(S[2 * ks][0], S[2 * ks][1]); bs[ks].u[1] = pk2(S[2 * ks][2], S[2 * ks][3]); \
                bs[ks].u[2] = pk2(S[2 * ks + 1][0], S[2 * ks + 1][1]); bs[ks].u[3] = pk2(S[2 * ks + 1][2], S[2 * ks + 1][3]); } \
            _Pragma("unroll") for (int tt = 0; tt < 4; ++tt) { \
                const u32x2 z2 = *(const u32x2*)(sZ + (16 * vb + fr) * RWS + 16 * tt + 4 * fq); \
                f32x4 acc = (f32x4){bflo(z2.x), bfhi(z2.x), bflo(z2.y), bfhi(z2.y)}; \
                acc = __builtin_amdgcn_mfma_f32_16x16x32_bf16(*(const bf16x8*)(sY + (16 * tt + fr) * RWS + 8 * fq), bs[0].v, acc, 0, 0, 0); \
                acc = __builtin_amdgcn_mfma_f32_16x16x32_bf16(*(const bf16x8*)(sY + (16 * tt + fr) * RWS + 32 + 8 * fq), bs[1].v, acc, 0, 0, 0); \
                _Pragma("unroll") for (int j = 0; j < 4; ++j) { const int s_ = (c_) * 64 + 16 * tt + 4 * fq + j; \
                    if (s_ < LSEQ) { const int p_ = d ? LSEQ - 1 - s_ : s_; YFB[((size_t)d * NT + rowof(b, p_)) * 512 + h * 64 + 16 * vb + fr] = (bf16_t)f2bf(acc[j]); } } } \
            f32x4 Sn[4]; \
            _Pragma("unroll") for (int kt = 0; kt < 4; ++kt) { \
                const u32x2 q2 = *(const u32x2*)(sQ + (16 * vb + fr) * RWS + 16 * kt + 4 * fq); \
                f32x4 acc = (f32x4){bflo(q2.x), bfhi(q2.x), bflo(q2.y), bfhi(q2.y)}; \
                acc = __builtin_amdgcn_mfma_f32_16x16x32_bf16(*(const bf16x8*)(sP + (16 * kt + fr) * RWS + 8 * fq), bs[0].v, acc, 0, 0, 0); \
                acc = __builtin_amdgcn_mfma_f32_16x16x32_bf16(*(const bf16x8*)(sP + (16 * kt + fr) * RWS + 32 + 8 * fq), bs[1].v, acc, 0, 0, 0); \
                Sn[kt] = acc; } \
            _Pragma("unroll") for (int kt = 0; kt < 4; ++kt) S[kt] = Sn[kt]; } while (0)
        if (!comp) { RW2_LD(R0, 0); RW2_ST(R0, 0); RW2_LD(R0, 1); RW2_LD(R1, 2); RW2_LD(R2, 3); }
        __syncthreads();
#define RW2_BAR() do { asm volatile("s_waitcnt lgkmcnt(0)" ::: "memory"); __builtin_amdgcn_s_barrier(); asm volatile("" ::: "memory"); } while (0)
        for (int c = 0; c < RW_NCH; c += 3) {
            if (!comp) { if (c + 1 < RW_NCH) RW2_ST(R0, c + 1); if (c + 4 < RW_NCH) RW2_LD(R0, c + 4); } else RW2_COMPUTE(c);
            RW2_BAR();
            if (!comp) { if (c + 2 < RW_NCH) RW2_ST(R1, c + 2); if (c + 5 < RW_NCH) RW2_LD(R1, c + 5); } else RW2_COMPUTE(c + 1);
            RW2_BAR();
            if (!comp) { if (c + 3 < RW_NCH) RW2_ST(R2, c + 3); if (c + 6 < RW_NCH) RW2_LD(R2, c + 6); } else RW2_COMPUTE(c + 2);
            RW2_BAR();
        }
#undef RW2_LD
#undef RW2_ST
#undef RW2_COMPUTE
#undef RW2_BAR
    }
}

__device__ __forceinline__ void phase_7(CParams& P, unsigned char* lds, const int ph) {
    PHASE_PROLOGUE
            for (int row = gw; row < NT; row += NGW) {
                const int c0 = lane * 8;
                const u32x4 yf = *(const u32x4*)(YFB + (size_t)row * 512 + c0);
                const u32x4 yb = *(const u32x4*)(YFB + ((size_t)NT + row) * 512 + c0);
                const u32x4 vv = *(const u32x4*)(VV + (size_t)row * 512 + c0);
                const u32x4 gg = *(const u32x4*)(Gg + (size_t)row * 512 + c0);
                float y[8], v[8], g[8];
#pragma unroll
                for (int i = 0; i < 4; ++i) { y[2 * i] = bflo(yf[i]) + bflo(yb[i]); y[2 * i + 1] = bfhi(yf[i]) + bfhi(yb[i]); v[2 * i] = bflo(vv[i]); v[2 * i + 1] = bfhi(vv[i]); g[2 * i] = bflo(gg[i]); g[2 * i + 1] = bfhi(gg[i]); }
                float sm = 0.f;
#pragma unroll
                for (int i = 0; i < 8; ++i) sm += y[i];
                sm += __shfl_xor(sm, 1); sm += __shfl_xor(sm, 2); sm += __shfl_xor(sm, 4);
                const float mean = sm * (1.f / 64.f);
                float vr = 0.f;
#pragma unroll
                for (int i = 0; i < 8; ++i) { const float dlt = y[i] - mean; vr += dlt * dlt; }
                vr += __shfl_xor(vr, 1); vr += __shfl_xor(vr, 2); vr += __shfl_xor(vr, 4);
                const float rstd = rsqrtf(vr * (1.f / 64.f) + 64e-5f);
                const float bc = BC[(size_t)row * 8 + (lane >> 3)];
                float o[8];
#pragma unroll
                for (int i = 0; i < 8; ++i) o[i] = ((y[i] - mean) * rstd * lnx_g[c0 + i] + lnx_b[c0 + i] + bc * v[i]) * g[i];
                u32x4 ov; ov.x = pk2(o[0], o[1]); ov.y = pk2(o[2], o[3]); ov.z = pk2(o[4], o[5]); ov.w = pk2(o[6], o[7]);
                *(u32x4*)(A2 + (size_t)row * DM + 512 + c0) = ov;
            }
}


__device__ __forceinline__ void phase_8(CParams& P, unsigned char* lds, const int ph) {
    PHASE_PROLOGUE
    if (gw < 64) meta_gemm<0>(A2 + (size_t)NMAIN * DM, WTOUT, H + (size_t)NMAIN * DM, gw, lane);
    pg8::DenseOrder S; S.init(A2, WTOUT, NMAIN, DM, DM, G, bid);
    pg8::EpiResidual E{H};
    pg8::gemm_phase<pg8::EpiResidual, pg8::DenseOrder, true, true>((PG8_LAS unsigned char*)lds, DM, S, E);
}

__device__ __forceinline__ void phase_9(CParams& P, unsigned char* lds, const int ph) {
    PHASE_PROLOGUE
            const int l = ph == 9 ? 0 : 1;
                    unsigned* cnt = CTL + CW_CNT(l);
            const float* wg = moe_wg + (size_t)l * DM * 4; const float* bg = moe_bg + l * 4;
            for (int row = gw; row < NT; row += NGW) {
                f32x4 v[4]; float ss = 0.f;
#pragma unroll
                for (int j = 0; j < 4; ++j) { v[j] = ((const f32x4*)(H + (size_t)row * DM))[lane + 64 * j]; ss += v[j][0] * v[j][0] + v[j][1] * v[j][1] + v[j][2] * v[j][2] + v[j][3] * v[j][3]; }
                ss = wave_sum(ss);
                const float rstd = rsqrtf(ss * (1.f / DM) + 1e-6f);
                float lg[4] = {0.f, 0.f, 0.f, 0.f};
#pragma unroll
                for (int j = 0; j < 4; ++j) {
                    const f32x4 g = ((const f32x4*)(norm_ffn + l * DM))[lane + 64 * j];
#pragma unroll
                    for (int i = 0; i < 4; ++i) v[j][i] = v[j][i] * rstd * g[i];
                    u32x2 o; o.x = pk2(v[j][0], v[j][1]); o.y = pk2(v[j][2], v[j][3]);
                    ((u32x2*)(HN + (size_t)row * DM))[lane + 64 * j] = o;
#pragma unroll
                    for (int i = 0; i < 4; ++i) { const f32x4 w = *(const f32x4*)(wg + (size_t)(4 * (lane + 64 * j) + i) * 4);
                        lg[0] += v[j][i] * w[0]; lg[1] += v[j][i] * w[1]; lg[2] += v[j][i] * w[2]; lg[3] += v[j][i] * w[3]; }
                }
#pragma unroll
                for (int q = 0; q < 4; ++q) lg[q] = wave_sum(lg[q]) + bg[q];
                int grp = 0; float mx = lg[0];
#pragma unroll
                for (int q = 1; q < 4; ++q) if (lg[q] > mx) { mx = lg[q]; grp = q; }
                float den = 0.f;
#pragma unroll
                for (int q = 0; q < 4; ++q) den += __expf(lg[q] - mx);
                const float pgrp = 1.f / den;
                const float* we = moe_we + ((size_t)(l * 4 + grp) * DM) * 8;
                float le[8] = {0.f, 0.f, 0.f, 0.f, 0.f, 0.f, 0.f, 0.f};
#pragma unroll
                for (int j = 0; j < 4; ++j)
#pragma unroll
                    for (int i = 0; i < 4; ++i) { const float* wr_ = we + (size_t)(4 * (lane + 64 * j) + i) * 8; const f32x4 wa = *(const f32x4*)wr_, wb = *(const f32x4*)(wr_ + 4);
                        le[0] += v[j][i] * wa[0]; le[1] += v[j][i] * wa[1]; le[2] += v[j][i] * wa[2]; le[3] += v[j][i] * wa[3];
                        le[4] += v[j][i] * wb[0]; le[5] += v[j][i] * wb[1]; le[6] += v[j][i] * wb[2]; le[7] += v[j][i] * wb[3]; }
#pragma unroll
                for (int q = 0; q < 8; ++q) le[q] = wave_sum(le[q]) + moe_be[(l * 4 + grp) * 8 + q];
                int i1 = 0; float m1 = le[0];
#pragma unroll
                for (int q = 1; q < 8; ++q) if (le[q] > m1) { m1 = le[q]; i1 = q; }
                int i2 = (i1 + 1) & 7; float m2 = -3.0e38f;
#pragma unroll
                for (int q = 0; q < 8; ++q) if (q != i1 && le[q] > m2) { m2 = le[q]; i2 = q; }
                const float e2 = __expf(m2 - m1);
                const float g1 = pgrp / (1.f + e2), g2 = pgrp * e2 / (1.f + e2);
                if (lane == 0) {
                    const int ea = grp * 8 + i1, eb = grp * 8 + i2;
                    const unsigned pa = atomicAdd(cnt + ea, 1u), pb = atomicAdd(cnt + eb, 1u);
                    EID[row * 2] = ea; EID[row * 2 + 1] = eb; POS[row * 2] = (int)pa; POS[row * 2 + 1] = (int)pb;
                    GATE[row * 2] = g1; GATE[row * 2 + 1] = g2;
                }
            }
    for (int it = gw; it < CONV_MOE_ITEMS; it += NGW) conv_moe_item(P, l, it, lane);
}


__device__ __forceinline__ void phase_10(CParams& P, unsigned char* lds, const int ph) {
    PHASE_PROLOGUE
    const int l = ph == 10 ? 0 : 1;
    int* ps = (int*)(lds + LDS_TAB);
    if (tid == 0) { int acc_ = 0; for (int e = 0; e < NEXP; ++e) { ps[e] = acc_; const int c = (int)CTL[CW_CNT(l) + e]; acc_ += (c + MOE_RT - 1) / MOE_RT * MOE_RT; } ps[NEXP] = acc_; }
    __syncthreads();
    for (int row = gw; row < NT; row += NGW) {
        const u32x4 v0 = ((const u32x4*)(HN + (size_t)row * DM))[lane], v1 = ((const u32x4*)(HN + (size_t)row * DM))[lane + 64];
#pragma unroll
        for (int k = 0; k < 2; ++k) {
            const int dest = ps[EID[row * 2 + k]] + POS[row * 2 + k];
            if (lane == 0) DEST[row * 2 + k] = dest;
            ((u32x4*)(XB + (size_t)dest * DM))[lane] = v0; ((u32x4*)(XB + (size_t)dest * DM))[lane + 64] = v1;
        }
    }
    __syncthreads();
}

__device__ __forceinline__ void phase_11(CParams& P, unsigned char* lds, const int ph) {
    PHASE_PROLOGUE
    const int l = ph == 11 ? 0 : 1;
    int* et = (int*)(lds + LDS_TAB);
    if (tid == 0) { int acc_ = 0; for (int e = 0; e < NEXP; ++e) { const int c = (int)CTL[CW_CNT(l) + e], n = (c + MOE_RT - 1) / MOE_RT; for (int q = 0; q < n; ++q) et[1 + acc_ + q] = e; acc_ += n; } et[0] = acc_; }
    __syncthreads();
    pg8::MoeOrder S{et + 1, et[0], vcu, (const char*)XB, (const char*)WT13, 256u * DM * 2u, 256u * DM * 2u, (unsigned)DM * DM * 2u};
    pg8::EpiSwiglu E{HB};
    pg8::gemm_phase<pg8::EpiSwiglu, pg8::MoeOrder, true, true>((PG8_LAS unsigned char*)lds, DM, S, E);
    __syncthreads();
}

__device__ __forceinline__ void phase_12(CParams& P, unsigned char* lds, const int ph) {
    PHASE_PROLOGUE
    const int l = ph == 12 ? 0 : 1;
    int* et = (int*)(lds + LDS_TAB);
    if (tid == 0) { int acc_ = 0; for (int e = 0; e < NEXP; ++e) { const int c = (int)CTL[CW_CNT(l) + e], n = (c + MOE_RT - 1) / MOE_RT; for (int q = 0; q < n; ++q) et[1 + acc_ + q] = e; acc_ += n; } et[0] = acc_; }
    __syncthreads();
    pg8::MoeOrder S{et + 1, et[0], vcu, (const char*)HB, (const char*)WT2, 256u * DFF * 2u, 256u * DFF * 2u, (unsigned)DM * DFF * 2u};
    pg8::EpiBf16Plain E{YB, DM};
    pg8::gemm_phase<pg8::EpiBf16Plain, pg8::MoeOrder, true, true>((PG8_LAS unsigned char*)lds, DFF, S, E);
    __syncthreads();
}

__device__ __forceinline__ void phase_13(CParams& P, unsigned char* lds, const int ph) {
    PHASE_PROLOGUE
            const bool fin = ph == 21;
            for (int row = gw; row < NT; row += NGW) {
                const int d0 = DEST[row * 2], d1 = DEST[row * 2 + 1];
                const float g0 = GATE[row * 2], g1 = GATE[row * 2 + 1];
                f32x4 v[4];
#pragma unroll
                for (int j = 0; j < 4; ++j) {
                    v[j] = ((const f32x4*)(H + (size_t)row * DM))[lane + 64 * j];
                    const u32x2 ya = ((const u32x2*)(YB + (size_t)d0 * DM))[lane + 64 * j];
                    const u32x2 yb = ((const u32x2*)(YB + (size_t)d1 * DM))[lane + 64 * j];
                    v[j][0] += g0 * bflo(ya.x) + g1 * bflo(yb.x); v[j][1] += g0 * bfhi(ya.x) + g1 * bfhi(yb.x);
                    v[j][2] += g0 * bflo(ya.y) + g1 * bflo(yb.y); v[j][3] += g0 * bfhi(ya.y) + g1 * bfhi(yb.y);
                }
                if (!fin) {
#pragma unroll
                    for (int j = 0; j < 4; ++j) ((f32x4*)(H + (size_t)row * DM))[lane + 64 * j] = v[j];
                    store_norm_bf16(v, norm_mix + DM, HN + (size_t)row * DM, lane);
                } else if (row < NMAIN) {
                    float ss = 0.f;
#pragma unroll
                    for (int j = 0; j < 4; ++j) ss += v[j][0] * v[j][0] + v[j][1] * v[j][1] + v[j][2] * v[j][2] + v[j][3] * v[j][3];
                    ss = wave_sum(ss);
                    const float rstd = rsqrtf(ss * (1.f / DM) + 1e-6f);
#pragma unroll
                    for (int j = 0; j < 4; ++j) { const f32x4 g = ((const f32x4*)norm_final)[lane + 64 * j]; f32x4 o;
                        o[0] = v[j][0] * rstd * g[0]; o[1] = v[j][1] * rstd * g[1]; o[2] = v[j][2] * rstd * g[2]; o[3] = v[j][3] * rstd * g[3];
                        ((f32x4*)(P.out + (size_t)row * DM))[lane + 64 * j] = o; }
                }
            }
}

__device__ __forceinline__ void phase_14(CParams& P, unsigned char* lds, const int ph) {
    PHASE_PROLOGUE
    float* pwr = (float*)lds; float* pwi = pwr + 2176; float* bbr = pwi + 2176; float* bbi = bbr + 2048; float* ccr = bbi + 2048; float* cci = ccr + 2048; float* kf = cci + 2048; float* kb = kf + 4096;
    for (int g = bid; g < 64; g += G) {
        if (tid < 128) {
            const int d = tid >> 6, p = tid & 63;
            const float step = __expf(s5_ls[d * 64 + g]);
            const float lr = s5_lre[(d * 64 + g) * 64 + p], li = s5_lim[(d * 64 + g) * 64 + p];
            const float mag = expf(lr * step);
            const float abr = mag * cosf(li * step), abi = mag * sinf(li * step);
            const float den = lr * lr + li * li;
            const float zr = ((abr - 1.f) * lr + abi * li) / den, zi = (abi * lr - (abr - 1.f) * li) / den;
            float pr = 1.f, pi = 0.f;
            for (int t = 0; t < 17; ++t) { pwr[(d * 64 + p) * 17 + t] = pr; pwi[(d * 64 + p) * 17 + t] = pi; const float nr = pr * abr - pi * abi; pi = pr * abi + pi * abr; pr = nr; }
            for (int i = 0; i < 16; ++i) { const float br = s5_b_re[((size_t)(g * 64 + p)) * 16 + i], bi = s5_b_im[((size_t)(g * 64 + p)) * 16 + i];
                bbr[(d * 64 + p) * 16 + i] = zr * br - zi * bi; bbi[(d * 64 + p) * 16 + i] = zr * bi + zi * br; }
        }
        for (int idx = tid; idx < 2048; idx += 512) { const int d = idx >> 10, i = (idx >> 6) & 15, p = idx & 63;
            ccr[idx] = s5_c_re[((size_t)(d * 64 + g) * 16 + i) * 64 + p]; cci[idx] = s5_c_im[((size_t)(d * 64 + g) * 16 + i) * 64 + p]; }
        __syncthreads();
        {
            const int d = tid >> 8, tau = (tid >> 4) & 15, i = tid & 15;
            float acc[16];
#pragma unroll
            for (int q = 0; q < 16; ++q) acc[q] = 0.f;
            for (int p = 0; p < 64; ++p) {
                const float cr = ccr[(d * 16 + i) * 64 + p], ci = cci[(d * 16 + i) * 64 + p], pr = pwr[(d * 64 + p) * 17 + tau], pi = pwi[(d * 64 + p) * 17 + tau];
                const float xr = cr * pr - ci * pi, xi = cr * pi + ci * pr;
#pragma unroll
                for (int q = 0; q < 16; ++q) acc[q] += xr * bbr[(d * 64 + p) * 16 + q] - xi * bbi[(d * 64 + p) * 16 + q];
            }
            float* kt = (d ? kb : kf) + (tau * 16 + i) * 16;
#pragma unroll
            for (int q = 0; q < 16; ++q) kt[q] = acc[q];
        }
        __syncthreads();
        unsigned* bta = (unsigned*)(BTA + (size_t)g * 512 * 256);
        for (int idx = tid; idx < 512 * 128; idx += 512) {
            const int row = idx >> 7, col = (idx & 127) * 2;
            float v[2];
#pragma unroll
            for (int e = 0; e < 2; ++e) {
                const int cc_ = col + e, j = cc_ >> 4, ip = cc_ & 15;
                if (row < 256) { const int t = row >> 4, i = row & 15;
                    v[e] = j < t ? kf[((t - j) * 16 + i) * 16 + ip] : (j > t ? kb[((j - t) * 16 + i) * 16 + ip] : kf[i * 16 + ip] + kb[i * 16 + ip]); }
                else { const int kp = row - 256, d = kp >> 7, part = (kp >> 6) & 1, p = kp & 63, tau = d == 0 ? 15 - j : j;
                    const float pr = pwr[(d * 64 + p) * 17 + tau], pi = pwi[(d * 64 + p) * 17 + tau], br = bbr[(d * 64 + p) * 16 + ip], bi = bbi[(d * 64 + p) * 16 + ip];
                    v[e] = part ? pr * bi + pi * br : pr * br - pi * bi; }
            }
            bta[idx] = pk2(v[0], v[1]);
        }
        unsigned* btc = (unsigned*)(BTC + (size_t)g * 256 * 256);
        for (int idx = tid; idx < 256 * 128; idx += 512) {
            const int row = idx >> 7, col = (idx & 127) * 2, t = row >> 4, i = row & 15;
            float v[2];
#pragma unroll
            for (int e = 0; e < 2; ++e) {
                const int k = col + e, d = k >> 7, part = (k >> 6) & 1, p = k & 63, tau = d == 0 ? t + 1 : 16 - t;
                const float cr = ccr[(d * 16 + i) * 64 + p], ci = cci[(d * 16 + i) * 64 + p], pr = pwr[(d * 64 + p) * 17 + tau], pi = pwi[(d * 64 + p) * 17 + tau];
                v[e] = part ? -(cr * pi + ci * pr) : cr * pr - ci * pi;
            }
            btc[idx] = pk2(v[0], v[1]);
        }
        __syncthreads();
    }
}

__device__ __forceinline__ void phase_15(CParams& P, unsigned char* lds, const int ph) {
    PHASE_PROLOGUE
    pg8::S5OrderA S{vcu, (const char*)HN, (const char*)BTA};
    pg8::EpiS5A E{YI, S5E};
    int Kr = 256; asm volatile("" : "+s"(Kr));
    pg8::gemm_phase<pg8::EpiS5A, pg8::S5OrderA, true, true>((PG8_LAS unsigned char*)lds, Kr, S, E);
}

__device__ __forceinline__ void phase_16(CParams& P, unsigned char* lds, const int ph) {
    PHASE_PROLOGUE
    for (int i = bid * 512 + tid; i < NB * 64 * 2 * 64; i += G * 512) {
        const int p = i & 63, d = (i >> 6) & 1, g = (i >> 7) & 63, b = i >> 13;
        const float step = __expf(s5_ls[d * 64 + g]);
        const float lr = s5_lre[(d * 64 + g) * 64 + p], li = s5_lim[(d * 64 + g) * 64 + p];
        const float mag = expf(lr * step);
        const float abr = mag * cosf(li * step), abi = mag * sinf(li * step);
        float ar = 1.f, ai = 0.f;
        for (int t = 0; t < 16; ++t) { const float nr = ar * abr - ai * abi; ai = ar * abi + ai * abr; ar = nr; }
        const float* Ep = S5E + (size_t)g * 256 + d * 128 + p;
        bf16_t* Cp = CAR + (size_t)g * 1280 * 256 + d * 128 + p;
        float sr = 0.f, si = 0.f;
        for (int q0 = 0; q0 < 513; q0 += 9) {
            float er[9], ei[9]; int nn[9];
#pragma unroll
            for (int k = 0; k < 9; ++k) { const int q = q0 + k, c = d ? 512 - q : q; nn[k] = c == 0 ? 1024 + b : b * 512 + c - 1; er[k] = Ep[(size_t)nn[k] * 64 * 256]; ei[k] = Ep[(size_t)nn[k] * 64 * 256 + 64]; }
#pragma unroll
            for (int k = 0; k < 9; ++k) { Cp[(size_t)nn[k] * 256] = (bf16_t)f2bf(sr); Cp[(size_t)nn[k] * 256 + 64] = (bf16_t)f2bf(si);
                const float nr = ar * sr - ai * si + er[k]; si = ar * si + ai * sr + ei[k]; sr = nr; }
        }
    }
}

__device__ __forceinline__ void phase_22(CParams& P, unsigned char* lds, const int ph) {
    PHASE_PROLOGUE
    pg8::S5OrderC S{vcu, (const char*)CAR, (const char*)BTC};
    pg8::EpiS5C E{YI, HN, s5_d, A2};
    int Kr = 256; asm volatile("" : "+s"(Kr));
    pg8::gemm_phase<pg8::EpiS5C, pg8::S5OrderC, true, true>((PG8_LAS unsigned char*)lds, Kr, S, E);
}

__device__ __forceinline__ void phase_23(CParams& P, unsigned char* lds, const int ph) {
    PHASE_PROLOGUE
    if (gw < 64) meta_gemm<1>(A2 + (size_t)NMAIN * DM, WTGLU, H + (size_t)NMAIN * DM, gw, lane);
    pg8::DenseOrder S; S.init(A2, WTGLU, NMAIN, 2 * DM, DM, G, bid);
    pg8::EpiGlu E{H};
    pg8::gemm_phase<pg8::EpiGlu, pg8::DenseOrder, true, true>((PG8_LAS unsigned char*)lds, DM, S, E);
}
#define LAS __attribute__((address_space(3)))
#define CW_BAR 4096
#define XB_TMO      128
#define XB_XCNT(j)  (256  + 64 * (j))
#define XB_XSUB(j)  (1280 + 64 * (j))
#define XB_XGEN(j)  (2304 + 64 * (j))
#define XB_TOP      3328
#define XB_TOPGEN   3392
#define XCD_BAR_WORDS 3456
#define XB_SPIN_CAP (1u << 22)
__device__ __forceinline__ unsigned xb_ld(unsigned* p)              { return __hip_atomic_load(p, __ATOMIC_RELAXED, __HIP_MEMORY_SCOPE_AGENT); }
__device__ __forceinline__ unsigned xb_add(unsigned* p, unsigned v) { return __hip_atomic_fetch_add(p, v, __ATOMIC_RELAXED, __HIP_MEMORY_SCOPE_AGENT); }
__device__ __forceinline__ unsigned xb_xcc_id() { return (unsigned)__builtin_amdgcn_s_getreg((3 << 11) | 20) & 0xFu; }
#define XB_SPIN(cond, bar) do { unsigned _sp = 0; while (cond) { __builtin_amdgcn_s_sleep(1); \
    if ((++_sp & 255u) == 0u) { if (xb_ld(&(bar)[XB_TMO])) break; if (_sp > XB_SPIN_CAP) { atomicAdd(&(bar)[XB_TMO], 1u); break; } } } } while (0)
struct XcdBarrier { unsigned* bar; unsigned x; volatile LAS unsigned* st; };
__device__ __forceinline__ XcdBarrier xcd_barrier_post(unsigned* bar, volatile LAS unsigned* st) {
    XcdBarrier b; b.bar = bar; b.x = xb_xcc_id(); b.st = st;
    if (threadIdx.x == 0) (void)xb_add(&bar[XB_XCNT(b.x)], 1u);
    return b;
}
__device__ __forceinline__ void xcd_barrier_complete(unsigned* bar, unsigned x, unsigned& nloc, unsigned& nx) {
    const unsigned G = GRID;
    unsigned sum, cnt, mine, sp = 0u;
    for (;;) {
        sum = 0u; cnt = 0u; mine = 0u;
#pragma unroll
        for (unsigned j = 0; j < 16; ++j) { const unsigned c = xb_ld(&bar[XB_XCNT(j)]); sum += c; cnt += (c > 0u) ? 1u : 0u; mine = (j == x) ? c : mine; }
        if (sum == G) break;
        __builtin_amdgcn_s_sleep(1);
        if ((++sp & 255u) == 0u) { if (xb_ld(&bar[XB_TMO])) break; if (sp > XB_SPIN_CAP) { atomicAdd(&bar[XB_TMO], 1u); break; } }
    }
    nloc = mine > 0u ? mine : 1u; nx = cnt > 0u ? cnt : 1u;
}
__device__ __forceinline__ void xcd_barrier(const XcdBarrier& b) {
    asm volatile("s_waitcnt vmcnt(0)" ::: "memory");
    __syncthreads();
    if (threadIdx.x == 0) {
        unsigned* bar = b.bar;
        __builtin_amdgcn_s_waitcnt(0);
        unsigned nloc = b.st[0], nx = b.st[1];
        if (nloc == 0u) { xcd_barrier_complete(bar, b.x, nloc, nx); b.st[0] = nloc; b.st[1] = nx; }
        const unsigned old = xb_add(&bar[XB_XSUB(b.x)], 1u);
        const unsigned gen = old / nloc;
        if (old + 1u == (gen + 1u) * nloc) {
            __builtin_amdgcn_fence(__ATOMIC_RELEASE, "agent");
            asm volatile("s_waitcnt vmcnt(0)" ::: "memory");
            const unsigned og = xb_add(&bar[XB_TOP], 1u);
            const unsigned tg = og / nx;
            if (og + 1u == (tg + 1u) * nx) xb_add(&bar[XB_TOPGEN], 1u);
            else XB_SPIN(xb_ld(&bar[XB_TOPGEN]) == tg, bar);
            __builtin_amdgcn_fence(__ATOMIC_ACQUIRE, "agent");
            xb_add(&bar[XB_XGEN(b.x)], 1u);
            asm volatile("s_waitcnt vmcnt(0)" ::: "memory");
        } else {
            XB_SPIN(xb_ld(&bar[XB_XGEN(b.x)]) == gen, bar);
            __builtin_amdgcn_fence(__ATOMIC_ACQUIRE, "agent");
            asm volatile("s_waitcnt vmcnt(0)" ::: "memory");
        }
    }
    __syncthreads();
}


__global__ void __launch_bounds__(512, 2) mega(Params P_) {
    extern __shared__ __attribute__((aligned(16))) unsigned char lds[];
    volatile LAS unsigned* st = (volatile LAS unsigned*)(LAS unsigned char*)(lds + LDS_BARST);
    if (threadIdx.x < 16) st[threadIdx.x] = 0u;
    __syncthreads();
    CParams* pp = (CParams*)__builtin_amdgcn_kernarg_segment_ptr();
    (void)xcd_barrier_post((unsigned*)(pp->ws + WS_CTL) + CW_BAR, st);
#define GB do { XcdBarrier bar_; bar_.bar = (unsigned*)(pp->ws + WS_CTL) + CW_BAR; bar_.x = xb_xcc_id(); bar_.st = (volatile LAS unsigned*)(LAS unsigned char*)(lds + LDS_BARST); xcd_barrier(bar_); asm volatile("" : "+s"(pp)); } while (0)
#define P (*pp)
    asm volatile("" : "+s"(pp));
    phase_0(P, lds, 0); GB;
#if defined(PROBE_PH) && PROBE_PH == 0
    { int nrep = PROBE_N; asm volatile("" : "+s"(nrep)); for (int rep = 0; rep < nrep; ++rep) { GB; phase_0(P, lds, 0); GB; } }
#endif
    phase_1(P, lds, 1); GB;
#if defined(PROBE_PH) && PROBE_PH == 1
    { int nrep = PROBE_N; asm volatile("" : "+s"(nrep)); for (int rep = 0; rep < nrep; ++rep) { GB; phase_1(P, lds, 1); GB; } }
#endif
    phase_2(P, lds, 2); asm volatile("" : "+s"(pp));
#if defined(PROBE_PH) && PROBE_PH == 2
    { int nrep = PROBE_N; asm volatile("" : "+s"(nrep)); for (int rep = 0; rep < nrep; ++rep) { GB; phase_2(P, lds, 2); GB; } }
#endif
    phase_3(P, lds, 3); GB;
#if defined(PROBE_PH) && PROBE_PH == 3
    { int nrep = PROBE_N; asm volatile("" : "+s"(nrep)); for (int rep = 0; rep < nrep; ++rep) { GB; phase_3(P, lds, 3); GB; } }
#endif
    phase_4(P, lds, 4); GB;
#if defined(PROBE_PH) && PROBE_PH == 4
    { int nrep = PROBE_N; asm volatile("" : "+s"(nrep)); for (int rep = 0; rep < nrep; ++rep) { GB; phase_4(P, lds, 4); GB; } }
#endif
    phase_5(P, lds, 5); GB;
#if defined(PROBE_PH) && PROBE_PH == 5
    { int nrep = PROBE_N; asm volatile("" : "+s"(nrep)); for (int rep = 0; rep < nrep; ++rep) { GB; phase_5(P, lds, 5); GB; } }
#endif
    phase_6(P, lds, 6); GB;
    phase_60(P, lds, 60); GB;
#if defined(PROBE_PH) && PROBE_PH == 60
    { int nrep = PROBE_N; asm volatile("" : "+s"(nrep)); for (int rep = 0; rep < nrep; ++rep) { GB; phase_60(P, lds, 60); GB; } }
#endif
#if defined(PROBE_PH) && PROBE_PH == 6
    { int nrep = PROBE_N; asm volatile("" : "+s"(nrep)); for (int rep = 0; rep < nrep; ++rep) { GB; phase_6(P, lds, 6); GB; } }
#endif
    phase_7(P, lds, 7); GB;
#if defined(PROBE_PH) && PROBE_PH == 7
    { int nrep = PROBE_N; asm volatile("" : "+s"(nrep)); for (int rep = 0; rep < nrep; ++rep) { GB; phase_7(P, lds, 7); GB; } }
#endif
    phase_8(P, lds, 8); GB;
#if defined(PROBE_PH) && PROBE_PH == 8
    { int nrep = PROBE_N; asm volatile("" : "+s"(nrep)); for (int rep = 0; rep < nrep; ++rep) { GB; phase_8(P, lds, 8); GB; } }
#endif
    phase_9(P, lds, 9); GB;
#if defined(PROBE_PH) && PROBE_PH == 9
    { int nrep = PROBE_N; asm volatile("" : "+s"(nrep)); for (int rep = 0; rep < nrep; ++rep) { GB; phase_9(P, lds, 9); GB; } }
#endif
    phase_10(P, lds, 10); GB;
#if defined(PROBE_PH) && PROBE_PH == 10
    { int nrep = PROBE_N; asm volatile("" : "+s"(nrep)); for (int rep = 0; rep < nrep; ++rep) { GB; phase_10(P, lds, 10); GB; } }
#endif
    phase_11(P, lds, 11); GB;
#if defined(PROBE_PH) && PROBE_PH == 11
    { int nrep = PROBE_N; asm volatile("" : "+s"(nrep)); for (int rep = 0; rep < nrep; ++rep) { GB; phase_11(P, lds, 11); GB; } }
#endif
    phase_12(P, lds, 12); GB;
#if defined(PROBE_PH) && PROBE_PH == 12
    { int nrep = PROBE_N; asm volatile("" : "+s"(nrep)); for (int rep = 0; rep < nrep; ++rep) { GB; phase_12(P, lds, 12); GB; } }
#endif
    phase_13(P, lds, 13); GB;
#if defined(PROBE_PH) && PROBE_PH == 13
    { int nrep = PROBE_N; asm volatile("" : "+s"(nrep)); for (int rep = 0; rep < nrep; ++rep) { GB; phase_13(P, lds, 13); GB; } }
#endif
    phase_14(P, lds, 14); GB;
#if defined(PROBE_PH) && PROBE_PH == 14
    { int nrep = PROBE_N; asm volatile("" : "+s"(nrep)); for (int rep = 0; rep < nrep; ++rep) { GB; phase_14(P, lds, 14); GB; } }
#endif
    phase_15(P, lds, 15); GB;
#if defined(PROBE_PH) && PROBE_PH == 15
    { int nrep = PROBE_N; asm volatile("" : "+s"(nrep)); for (int rep = 0; rep < nrep; ++rep) { GB; phase_15(P, lds, 15); GB; } }
#endif
    phase_16(P, lds, 16); GB;
#if defined(PROBE_PH) && PROBE_PH == 16
    { int nrep = PROBE_N; asm volatile("" : "+s"(nrep)); for (int rep = 0; rep < nrep; ++rep) { GB; phase_16(P, lds, 16); GB; } }
#endif
    phase_22(P, lds, 22); GB;
#if defined(PROBE_PH) && PROBE_PH == 22
    { int nrep = PROBE_N; asm volatile("" : "+s"(nrep)); for (int rep = 0; rep < nrep; ++rep) { GB; phase_22(P, lds, 22); GB; } }
#endif
    phase_23(P, lds, 23); GB;
#if defined(PROBE_PH) && PROBE_PH == 23
    { int nrep = PROBE_N; asm volatile("" : "+s"(nrep)); for (int rep = 0; rep < nrep; ++rep) { GB; phase_23(P, lds, 23); GB; } }
#endif
    phase_9(P, lds, 17); GB;
#if defined(PROBE_PH) && PROBE_PH == 17
    { int nrep = PROBE_N; asm volatile("" : "+s"(nrep)); for (int rep = 0; rep < nrep; ++rep) { GB; phase_9(P, lds, 17); GB; } }
#endif
    phase_10(P, lds, 18); GB;
#if defined(PROBE_PH) && PROBE_PH == 18
    { int nrep = PROBE_N; asm volatile("" : "+s"(nrep)); for (int rep = 0; rep < nrep; ++rep) { GB; phase_10(P, lds, 18); GB; } }
#endif
    phase_11(P, lds, 19); GB;
#if defined(PROBE_PH) && PROBE_PH == 19
    { int nrep = PROBE_N; asm volatile("" : "+s"(nrep)); for (int rep = 0; rep < nrep; ++rep) { GB; phase_11(P, lds, 19); GB; } }
#endif
    phase_12(P, lds, 20); GB;
#if defined(PROBE_PH) && PROBE_PH == 20
    { int nrep = PROBE_N; asm volatile("" : "+s"(nrep)); for (int rep = 0; rep < nrep; ++rep) { GB; phase_12(P, lds, 20); GB; } }
#endif
    phase_13(P, lds, 21);
#if defined(PROBE_PH) && PROBE_PH == 21
    { int nrep = PROBE_N; asm volatile("" : "+s"(nrep)); for (int rep = 0; rep < nrep; ++rep) { GB; phase_13(P, lds, 21); GB; } }
#endif
#undef P
#undef GB
}

extern "C" void kernel_launch(void* const* d_in, const int* in_sizes, int n_in, void* d_out, int out_size, void* d_ws, size_t ws_size, hipStream_t stream) {
    static int ready = 0;
    if (!ready) {
        if (n_in != 35 || ws_size < WS_TOTAL) { fprintf(stderr, "kernel_launch: unexpected n_in %d or ws_size %zu (need %zu)\n", n_in, ws_size, (size_t)WS_TOTAL); ready = -1; return; }
        if (hipFuncSetAttribute((const void*)mega, hipFuncAttributeMaxDynamicSharedMemorySize, LDS_BYTES) != hipSuccess) { fprintf(stderr, "kernel_launch: hipFuncSetAttribute failed\n"); ready = -1; return; }
        ready = 1;
    }
    if (ready < 0) return;
    (void)hipMemsetAsync((char*)d_ws + WS_CTL, 0, 1 * MiB, stream);
    Params P{};
    for (int i = 0; i < 35; ++i) P.in[i] = (const float*)d_in[i];
    P.out = (float*)d_out; P.ws = (unsigned char*)d_ws; P.ph_lo = 0; P.ph_hi = 0;
    hipLaunchKernelGGL(mega, dim3(GRID), dim3(512), LDS_BYTES, stream, P);
}
```

```cpp
#include <hip/hip_runtime.h>
#include <stdint.h>
#include <stdio.h>

#define DM 1024
#define NB 2
#define SEQ 8192
#define NMETA 16
#define LSEQ (SEQ + NMETA)
#define NMAIN (NB * SEQ)
#define NT (NB * LSEQ)
#define NTP 16640
#define INCOLS 3328
#define RESTC 1792
#define NEXP 32
#define DFF 512
#define S5TC 48
#define S5NC 171
#define MOE_RT 256
#define MOE_MAXROWS 41216

typedef unsigned short bf16_t;
typedef short bf16x8 __attribute__((ext_vector_type(8)));
typedef float f32x4 __attribute__((ext_vector_type(4)));
typedef unsigned u32x4 __attribute__((ext_vector_type(4)));
typedef unsigned u32x2 __attribute__((ext_vector_type(2)));

constexpr size_t MiB = 1u << 20;
constexpr size_t al64k(size_t x) { return (x + 65535) & ~(size_t)65535; }
constexpr size_t WS_CTL = 0;
constexpr size_t WS_H = 1 * MiB;
constexpr size_t WS_HN = WS_H + al64k((size_t)NT * DM * 4);
constexpr size_t WS_A2 = WS_HN + al64k((size_t)NTP * DM * 2);
constexpr size_t WS_WTIN = WS_A2 + al64k((size_t)NTP * DM * 2);
constexpr size_t WS_WTOUT = WS_WTIN + al64k((size_t)INCOLS * DM * 2);
constexpr size_t WS_WTGLU = WS_WTOUT + al64k((size_t)DM * DM * 2);
constexpr size_t WS_BIG = WS_WTGLU + al64k((size_t)2 * DM * DM * 2);
constexpr size_t SZ_T512 = al64k((size_t)NT * 512 * 2);
constexpr size_t SZ_P512 = al64k((size_t)NTP * 512 * 2);
constexpr int RW_NCH = 129, RW_UNITS = 32 * RW_NCH;
constexpr size_t SZ_RWOP = al64k((size_t)RW_UNITS * 4096 * 2);
constexpr size_t WS_Q = WS_BIG;
constexpr size_t WS_K = WS_Q + SZ_P512;
constexpr size_t WS_V = WS_K + SZ_P512;
constexpr size_t WS_REST = WS_V + SZ_P512;
constexpr size_t WS_KR = WS_REST + al64k((size_t)NTP * RESTC * 2);
constexpr size_t WS_LOW = WS_KR + SZ_T512;
constexpr size_t WS_AA = WS_LOW + al64k((size_t)NT * 256 * 2);
constexpr size_t WS_XEND = WS_AA + 2 * SZ_T512;
constexpr size_t WS_PP = WS_BIG;
constexpr size_t WS_QT = WS_PP + SZ_RWOP;
constexpr size_t WS_YT = WS_QT + SZ_RWOP;
constexpr size_t WS_ZT = WS_YT + SZ_RWOP;
constexpr size_t WS_YFB = WS_ZT + SZ_RWOP;
static_assert(WS_YFB + 2 * SZ_T512 <= WS_XEND, "scan operators + YFB fit in region X");
constexpr size_t WS_R = WS_XEND;
constexpr size_t WS_VV = WS_R + SZ_T512;
constexpr size_t WS_G = WS_VV + SZ_T512;
constexpr size_t WS_KK = WS_G + SZ_T512;
constexpr size_t WS_KKA = WS_KK + SZ_T512;
constexpr size_t WS_KD = WS_KKA + 2 * SZ_T512;
constexpr size_t WS_W = WS_KD + 2 * SZ_T512;
constexpr size_t WS_BC = WS_W + 2 * SZ_T512;
constexpr size_t WS_MIXEND = WS_BC + al64k((size_t)NT * 8 * 4);
constexpr size_t WS_XB = WS_BIG;
constexpr size_t WS_HB = WS_XB + al64k((size_t)MOE_MAXROWS * DM * 2);
constexpr size_t WS_YB = WS_HB + al64k((size_t)MOE_MAXROWS * DFF * 2);
constexpr size_t WS_WT13 = WS_YB + al64k((size_t)MOE_MAXROWS * DM * 2);
constexpr size_t WS_WT2 = WS_WT13 + al64k((size_t)NEXP * DM * DM * 2);
constexpr size_t WS_EID = WS_WT2 + al64k((size_t)NEXP * DM * DFF * 2);
constexpr size_t WS_POS = WS_EID + al64k((size_t)NT * 8);
constexpr size_t WS_DEST = WS_POS + al64k((size_t)NT * 8);
constexpr size_t WS_GATE = WS_DEST + al64k((size_t)NT * 8);
constexpr size_t WS_MOEEND = WS_GATE + al64k((size_t)NT * 8);
constexpr size_t WS_YI = WS_BIG;
constexpr size_t WS_E = WS_YI + al64k((size_t)NTP * DM * 4);
constexpr size_t WS_CAR = WS_E + al64k((size_t)1040 * 64 * 256 * 4);
constexpr size_t WS_BTA = WS_CAR + al64k((size_t)64 * 1280 * 256 * 2);
constexpr size_t WS_BTC = WS_BTA + al64k((size_t)64 * 512 * 256 * 2);
constexpr size_t WS_S5END = WS_BTC + al64k((size_t)64 * 256 * 256 * 2);
constexpr size_t cmax(size_t a, size_t b) { return a > b ? a : b; }
constexpr size_t WS_TOTAL = cmax(WS_MIXEND, cmax(WS_MOEEND, WS_S5END));
static_assert(WS_TOTAL <= 512 * MiB, "workspace map exceeds 512 MiB");

#define CW_CNT(l) (1024 + 64 * (l))

#define LDS_BYTES 163840
#define LDS_BARST (LDS_BYTES - 1024)
#define LDS_TAB (LDS_BYTES - 768)
#define LDS_RING (LDS_BYTES - 1024)
#define GRID 256

struct Params {
    const float* in[35];
    float* out;
    unsigned char* ws;
    int ph_lo, ph_hi;
};
typedef const __attribute__((address_space(4))) Params CParams;

__device__ __forceinline__ float bf2f(bf16_t v) { return __uint_as_float(((unsigned)v) << 16); }
typedef float f32x2c_ __attribute__((ext_vector_type(2)));
typedef __bf16 bf16x2c_ __attribute__((ext_vector_type(2)));
__device__ __forceinline__ unsigned pk2(float lo, float hi) { const f32x2c_ f = {lo, hi}; const bf16x2c_ b = __builtin_convertvector(f, bf16x2c_); return __builtin_bit_cast(unsigned, b); }
__device__ __forceinline__ unsigned f2bf(float f) { return (unsigned)__builtin_bit_cast(unsigned short, (__bf16)f); }
__device__ __forceinline__ float bflo(unsigned u) { return __uint_as_float(u << 16); }
__device__ __forceinline__ float bfhi(unsigned u) { return __uint_as_float(u & 0xffff0000u); }
__device__ __forceinline__ float wave_sum(float v) {
#pragma unroll
    for (int o = 1; o < 64; o <<= 1) v += __shfl_xor(v, o);
    return v;
}
__device__ __forceinline__ float wave_max(float v) {
#pragma unroll
    for (int o = 1; o < 64; o <<= 1) v = fmaxf(v, __shfl_xor(v, o));
    return v;
}
template <int CTRL> __device__ __forceinline__ float dppf(float v) { return __int_as_float(__builtin_amdgcn_update_dpp(0, __float_as_int(v), CTRL, 0xF, 0xF, true)); }
__device__ __forceinline__ float row16_sum(float v) { v += dppf<0xB1>(v); v += dppf<0x4E>(v); v += dppf<0x141>(v); v += dppf<0x140>(v); return v; }
__device__ __forceinline__ float sigmoidf_(float x) { return __builtin_amdgcn_rcpf(1.f + __expf(-x)); }
__device__ __forceinline__ int rowof(int b, int p) { return p < NMETA ? NMAIN + b * NMETA + p : b * SEQ + (p - NMETA); }

#define SA_STRIDE 40
template <class AF, class BF>
__device__ __forceinline__ void gemm_tile(unsigned char* lds, int K, int ldb, const AF& arow, const BF& bcol, f32x4 (&acc)[4][2]) {
    bf16_t* sA = (bf16_t*)lds;
    bf16_t* sB = (bf16_t*)(lds + 128 * SA_STRIDE * 2);
    const int tid = threadIdx.x, lane = tid & 63, wave = tid >> 6, wr = wave >> 2, wc = wave & 3, fr = lane & 15, fq = lane >> 4;
#pragma unroll
    for (int mi = 0; mi < 4; ++mi)
#pragma unroll
        for (int ni = 0; ni < 2; ++ni) acc[mi][ni] = (f32x4){0.f, 0.f, 0.f, 0.f};
    const int ar = tid >> 2, akc = (tid & 3) * 8;
    const bf16_t* ap = arow(ar) + akc;
    const int bnq = (tid & 31) * 4, bkp = (tid >> 5) * 2;
    const float* bp = bcol(bnq) + (size_t)bkp * ldb;
    const int nk = K / 32;
    u32x4 ra = *(const u32x4*)ap;
    f32x4 rb0 = *(const f32x4*)bp, rb1 = *(const f32x4*)(bp + ldb);
    for (int kt = 0; kt < nk; ++kt) {
        __syncthreads();
        *(u32x4*)(sA + ar * SA_STRIDE + akc) = ra;
        {
            unsigned* d = (unsigned*)(sB + bnq * SA_STRIDE + bkp);
            d[0 * (SA_STRIDE / 2)] = pk2(rb0[0], rb1[0]);
            d[1 * (SA_STRIDE / 2)] = pk2(rb0[1], rb1[1]);
            d[2 * (SA_STRIDE / 2)] = pk2(rb0[2], rb1[2]);
            d[3 * (SA_STRIDE / 2)] = pk2(rb0[3], rb1[3]);
        }
        __syncthreads();
        if (kt + 1 < nk) {
            ra = *(const u32x4*)(ap + (kt + 1) * 32);
            const float* q = bp + (size_t)(kt + 1) * 32 * ldb;
            rb0 = *(const f32x4*)q; rb1 = *(const f32x4*)(q + ldb);
        }
        bf16x8 a[4], b[2];
#pragma unroll
        for (int mi = 0; mi < 4; ++mi) a[mi] = *(const bf16x8*)(sA + (wr * 64 + mi * 16 + fr) * SA_STRIDE + fq * 8);
#pragma unroll
        for (int ni = 0; ni < 2; ++ni) b[ni] = *(const bf16x8*)(sB + (wc * 32 + ni * 16 + fr) * SA_STRIDE + fq * 8);
#pragma unroll
        for (int mi = 0; mi < 4; ++mi)
#pragma unroll
            for (int ni = 0; ni < 2; ++ni) acc[mi][ni] = __builtin_amdgcn_mfma_f32_16x16x32_bf16(a[mi], b[ni], acc[mi][ni], 0, 0, 0);
    }
    __syncthreads();
}
#define ACC_FOREACH(acc, ...) do { const int _l = threadIdx.x & 63, _w = threadIdx.x >> 6, _wr = _w >> 2, _wc = _w & 3, _fr = _l & 15, _fq = _l >> 4; \
    _Pragma("unroll") for (int _mi = 0; _mi < 4; ++_mi) _Pragma("unroll") for (int _ni = 0; _ni < 2; ++_ni) _Pragma("unroll") for (int _j = 0; _j < 4; ++_j) { \
        const int rl = _wr * 64 + _mi * 16 + _fq * 4 + _j, cl = _wc * 32 + _ni * 16 + _fr; const float val = acc[_mi][_ni][_j]; __VA_ARGS__ } } while (0)
#define ACC_FOREACH_PAIR(acc, ...) do { const int _l = threadIdx.x & 63, _w = threadIdx.x >> 6, _wr = _w >> 2, _wc = _w & 3, _fr = _l & 15, _fq = _l >> 4; \
    _Pragma("unroll") for (int _mi = 0; _mi < 4; ++_mi) _Pragma("unroll") for (int _j = 0; _j < 4; ++_j) { \
        const int rl = _wr * 64 + _mi * 16 + _fq * 4 + _j, co = _wc * 16 + _fr; const float va = acc[_mi][0][_j], vg = acc[_mi][1][_j]; __VA_ARGS__ } } while (0)

__device__ __forceinline__ void store_norm_bf16(const f32x4 (&v)[4], const float* gain, bf16_t* dst, int lane) {
    float ss = 0.f;
#pragma unroll
    for (int j = 0; j < 4; ++j) ss += v[j][0] * v[j][0] + v[j][1] * v[j][1] + v[j][2] * v[j][2] + v[j][3] * v[j][3];
    ss = wave_sum(ss);
    const float rstd = rsqrtf(ss * (1.f / DM) + 1e-6f);
#pragma unroll
    for (int j = 0; j < 4; ++j) {
        const f32x4 g = ((const f32x4*)gain)[lane + 64 * j];
        u32x2 o; o.x = pk2(v[j][0] * rstd * g[0], v[j][1] * rstd * g[1]); o.y = pk2(v[j][2] * rstd * g[2], v[j][3] * rstd * g[3]);
        ((u32x2*)dst)[lane + 64 * j] = o;
    }
}

namespace pg8 {
#define PG8_LAS __attribute__((address_space(3)))
constexpr int BM = 256, BK = 64, HALF = 128, HTB = HALF * BK * 2  , STAGE_BYTES = 8 * HTB, NXCD = 8, WGM = 8;
__host__ __device__ __forceinline__ int lds_byte(int r, int c) { const int st = (r >> 4) * 2 + (c >> 5), rr = r & 15, cc = c & 31, ob = rr * 64 + cc * 2; return st * 1024 + (ob ^ (((ob >> 9) & 1) << 5)); }
__host__ __device__ __forceinline__ void stage_rc(int b, int& R, int& C) { const int st = b / 1024, sb = b % 1024, swz = sb ^ (((sb >> 9) & 1) << 5); R = (st >> 1) * 16 + swz / 64; C = (st & 1) * 32 + (swz % 64) / 2; }
__host__ __device__ __forceinline__ int perm32(int rho) { const int n = rho >> 4, i = rho & 15; return 8 * (i >> 2) + 4 * n + (i & 3); }

struct Unit { int pm, pn; const char* A; const char* B; };

struct DenseOrder {
    static constexpr bool GATHER_A = false;
    int nM, nN, nwg, G, c; const char* A; const char* Bt; size_t tstep;
    __device__ void init(const bf16_t* A_, const bf16_t* Bt_, int M, int N, int K, int G_, int c_) { nM = M / BM; nN = N / BM; nwg = nM * nN; G = G_; c = c_; A = (const char*)A_; Bt = (const char*)Bt_; tstep = (size_t)BM * K * 2; }
    __device__ bool next(int i, Unit& u) const {
        const long L = (long)i * G + c; if (L >= nwg) return false;
        int wgid = (int)L; { const int q = nwg / NXCD, r = nwg % NXCD, xcd = wgid % NXCD, off = wgid / NXCD; wgid = (xcd < r ? xcd * (q + 1) : r * (q + 1) + (xcd - r) * q) + off; }
        const int nig = WGM * nN, gid = wgid / nig, fm = gid * WGM, gsz = (nM - fm) < WGM ? (nM - fm) : WGM;
        u.pm = fm + ((wgid % nig) % gsz); u.pn = (wgid % nig) / gsz; u.A = A + (size_t)u.pm * tstep; u.B = Bt + (size_t)u.pn * tstep; return true;
    }
    __device__ __forceinline__ void a_ready(const Unit&) const {}
    __device__ __forceinline__ void done(const Unit&) const {}
};
struct ProjOrder {
    static constexpr bool GATHER_A = false;
    DenseOrder D; const char* HNp; const char* WT;
    __device__ void init(const bf16_t* HN_, const bf16_t* WT_, int c_) { D.init(HN_, WT_, NTP, 13 * BM, DM, GRID, c_); HNp = (const char*)HN_; WT = (const char*)WT_; }
    __device__ bool next(int i, Unit& u) const {
        if (!D.next(i, u)) return false;
        const size_t ts = (size_t)BM * DM * 2;
        if (u.pn < 11) { const int wrow = u.pn < 4 ? u.pn : u.pn + 2; u.A = HNp + (size_t)u.pm * ts; u.B = WT + (size_t)wrow * ts; }
        else { u.A = WT + (size_t)(4 + (u.pn - 11)) * ts; u.B = HNp + (size_t)u.pm * ts; }
        return true;
    }
    __device__ __forceinline__ void a_ready(const Unit&) const {}
    __device__ __forceinline__ void done(const Unit&) const {}
};
struct MoeOrder {
    static constexpr bool GATHER_A = false;
    const int* et; int TT, vcu; const char* A; const char* Bt; unsigned tstepA, tstepB, estep;
    __device__ __forceinline__ bool next(int i, Unit& u) const {
        const int L = i * GRID + vcu; if (L >= TT * 4) return false;
        const int rt = L >> 2, ct = L & 3, e = et[rt];
        u.pm = rt; u.pn = ct; u.A = A + (size_t)rt * tstepA; u.B = Bt + (size_t)e * estep + (size_t)ct * tstepB; return true;
    }
    __device__ __forceinline__ void a_ready(const Unit&) const {}
    __device__ __forceinline__ void done(const Unit&) const {}
};

struct S5OrderA {
    static constexpr bool GATHER_A = true;
    int vcu; const char* U; const char* BTA;
    __device__ __forceinline__ bool next(int i, Unit& u) const {
        const int L = i * GRID + vcu; if (L >= 640) return false;
        const int g = L / 10, rem = L - g * 10, mt = rem >> 1, nt = rem & 1;
        u.pm = mt; u.pn = g * 2 + nt; u.A = U + ((size_t)mt * 256 * 16 * 1024 + g * 16) * 2; u.B = BTA + ((size_t)(g * 512 + nt * 256) * 256) * 2; return true;
    }
    __device__ __forceinline__ void a_ready(const Unit&) const {}
    __device__ __forceinline__ void done(const Unit&) const {}
};
struct S5OrderC {
    static constexpr bool GATHER_A = false;
    int vcu; const char* CAR; const char* BTC;
    __device__ __forceinline__ bool next(int i, Unit& u) const {
        const int L = i * GRID + vcu; if (L >= 320) return false;
        const int g = L / 5, mt = L - g * 5;
        u.pm = mt; u.pn = g; u.A = CAR + ((size_t)(g * 1280 + mt * 256) * 256) * 2; u.B = BTC + ((size_t)g * 256 * 256) * 2; return true;
    }
    __device__ __forceinline__ void a_ready(const Unit&) const {}
    __device__ __forceinline__ void done(const Unit&) const {}
};
__device__ __forceinline__ unsigned cvt_pk_bf16(float lo, float hi) { return pk2(lo, hi); }

struct EpiProj {
    static constexpr bool PERM = true, AFTER_DRAIN = false;
    bf16_t *Q, *Kk, *VT, *REST;
    __device__ __forceinline__ void operator()(const f32x4 (&acc)[2][2][4][2], const Unit& u, int wr, int wc, int fr, int fq) const {
        bf16_t* base; int ldc; int row0, col0;
        if (u.pn < 11) { row0 = u.pm * BM + wr * 64 + fr; int colt;
            if (u.pn < 2) { base = Q; colt = u.pn * BM; ldc = 512; } else if (u.pn < 4) { base = Kk; colt = (u.pn - 2) * BM; ldc = 512; } else { base = REST; colt = (u.pn - 4) * BM; ldc = RESTC; }
            col0 = colt + wc * 32 + 8 * fq; }
        else { base = VT; ldc = NTP; row0 = (u.pn - 11) * BM + wr * 64 + fr; col0 = u.pm * BM + wc * 32 + 8 * fq; }
#pragma unroll
        for (int ai = 0; ai < 2; ++ai)
#pragma unroll
            for (int m = 0; m < 4; ++m) { bf16_t* rowp = base + (size_t)(row0 + ai * HALF + m * 16) * ldc + col0;
#pragma unroll
                for (int bj = 0; bj < 2; ++bj) { const f32x4 v0 = acc[ai][bj][m][0], v1 = acc[ai][bj][m][1];
                    u32x4 w; w.x = cvt_pk_bf16(v0[0], v0[1]); w.y = cvt_pk_bf16(v0[2], v0[3]); w.z = cvt_pk_bf16(v1[0], v1[1]); w.w = cvt_pk_bf16(v1[2], v1[3]);
                    *(u32x4*)(rowp + bj * HALF) = w; } }
    }
};
struct EpiBf16Plain {
    static constexpr bool PERM = true, AFTER_DRAIN = false;
    bf16_t* O; int ldc;
    __device__ __forceinline__ void operator()(const f32x4 (&acc)[2][2][4][2], const Unit& u, int wr, int wc, int fr, int fq) const {
        const int row0 = u.pm * BM + wr * 64 + fr; const int col0 = u.pn * BM + wc * 32 + 8 * fq;
#pragma unroll
        for (int ai = 0; ai < 2; ++ai)
#pragma unroll
            for (int m = 0; m < 4; ++m) { bf16_t* rowp = O + (size_t)(row0 + ai * HALF + m * 16) * ldc + col0;
#pragma unroll
                for (int bj = 0; bj < 2; ++bj) { const f32x4 v0 = acc[ai][bj][m][0], v1 = acc[ai][bj][m][1];
                    u32x4 w; w.x = cvt_pk_bf16(v0[0], v0[1]); w.y = cvt_pk_bf16(v0[2], v0[3]); w.z = cvt_pk_bf16(v1[0], v1[1]); w.w = cvt_pk_bf16(v1[2], v1[3]);
                    *(u32x4*)(rowp + bj * HALF) = w; } }
    }
};
struct EpiSwiglu {
    static constexpr bool PERM = true, AFTER_DRAIN = false;
    bf16_t* O;
    __device__ __forceinline__ void operator()(const f32x4 (&acc)[2][2][4][2], const Unit& u, int wr, int wc, int fr, int fq) const {
        const int row0 = u.pm * BM + wr * 64 + fr; const int col0 = u.pn * HALF + wc * 32 + 8 * fq;
#pragma unroll
        for (int ai = 0; ai < 2; ++ai)
#pragma unroll
            for (int m = 0; m < 4; ++m) {
                float o[8];
#pragma unroll
                for (int n = 0; n < 2; ++n)
#pragma unroll
                    for (int i = 0; i < 4; ++i) { const float va = acc[ai][0][m][n][i], vg = acc[ai][1][m][n][i]; o[4 * n + i] = va * __builtin_amdgcn_rcpf(1.f + __expf(-va)) * vg; }
                u32x4 w; w.x = cvt_pk_bf16(o[0], o[1]); w.y = cvt_pk_bf16(o[2], o[3]); w.z = cvt_pk_bf16(o[4], o[5]); w.w = cvt_pk_bf16(o[6], o[7]);
                *(u32x4*)(O + (size_t)(row0 + ai * HALF + m * 16) * DFF + col0) = w; }
    }
};
struct EpiResidual {
    static constexpr bool PERM = false, AFTER_DRAIN = false;
    float* Hh;
    __device__ __forceinline__ void operator()(const f32x4 (&acc)[2][2][4][2], const Unit& u, int wr, int wc, int fr, int fq) const {
        const int row0 = u.pm * BM + wr * 64 + fr; const int col0 = u.pn * BM + wc * 32 + 4 * fq;
#pragma unroll
        for (int ai = 0; ai < 2; ++ai)
#pragma unroll
            for (int m = 0; m < 4; ++m) { float* rowp = Hh + (size_t)(row0 + ai * HALF + m * 16) * DM + col0;
#pragma unroll
                for (int bj = 0; bj < 2; ++bj)
#pragma unroll
                    for (int n = 0; n < 2; ++n) { f32x4* p = (f32x4*)(rowp + bj * HALF + n * 16); *p = *p + acc[ai][bj][m][n]; } }
    }
};
struct EpiGlu {
    static constexpr bool PERM = false, AFTER_DRAIN = false;
    float* Hh;
    __device__ __forceinline__ void operator()(const f32x4 (&acc)[2][2][4][2], const Unit& u, int wr, int wc, int fr, int fq) const {
        const int row0 = u.pm * BM + wr * 64 + fr; const int col0 = u.pn * HALF + wc * 32 + 4 * fq;
#pragma unroll
        for (int ai = 0; ai < 2; ++ai)
#pragma unroll
            for (int m = 0; m < 4; ++m) { float* rowp = Hh + (size_t)(row0 + ai * HALF + m * 16) * DM + col0;
#pragma unroll
                for (int n = 0; n < 2; ++n) { f32x4* p = (f32x4*)(rowp + n * 16); f32x4 hv = *p; const f32x4 va = acc[ai][0][m][n], vg = acc[ai][1][m][n];
#pragma unroll
                    for (int i = 0; i < 4; ++i) hv[i] += va[i] * __builtin_amdgcn_rcpf(1.f + __expf(-vg[i]));
                    *p = hv; } }
    }
};

struct EpiS5A {
    static constexpr bool PERM = true, AFTER_DRAIN = false;
    float* YI; float* E;
    __device__ __forceinline__ void operator()(const f32x4 (&acc)[2][2][4][2], const Unit& u, int wr, int wc, int fr, int fq) const {
        const int g = u.pn >> 1, nt = u.pn & 1;
        const int cl0 = wc * 32 + 8 * fq;
        float* base = nt == 0 ? YI + (size_t)(cl0 >> 4) * DM + g * 16 + (cl0 & 15) : E + (size_t)g * 256 + cl0;
        const size_t nstride = 16 * DM;
        const size_t bjstep = nt == 0 ? (size_t)8 * DM : (size_t)HALF;
#pragma unroll
        for (int ai = 0; ai < 2; ++ai)
#pragma unroll
            for (int m = 0; m < 4; ++m) { int n = u.pm * BM + ai * HALF + wr * 64 + m * 16 + fr; n = n < 1039 ? n : 1039;
                float* p = base + (size_t)n * nstride;
#pragma unroll
                for (int bj = 0; bj < 2; ++bj) { *(f32x4*)(p + bj * bjstep) = acc[ai][bj][m][0]; *(f32x4*)(p + bj * bjstep + 4) = acc[ai][bj][m][1]; } }
    }
};
struct EpiS5C {
    static constexpr bool PERM = true, AFTER_DRAIN = false;
    const float* YI; const bf16_t* Uu; const float* dvec; bf16_t* O;
    __device__ __forceinline__ void operator()(const f32x4 (&acc)[2][2][4][2], const Unit& u, int wr, int wc, int fr, int fq) const {
        const int g = u.pn;
        const int cl0 = wc * 32 + 8 * fq, ch = g * 16 + (cl0 & 15);
        const size_t off0 = (size_t)(cl0 >> 4) * DM + ch;
        const f32x4 d0 = *(const f32x4*)(dvec + ch), d1 = *(const f32x4*)(dvec + ch + 4);
#pragma unroll
        for (int ai = 0; ai < 2; ++ai)
#pragma unroll
            for (int m = 0; m < 4; ++m) { int n = u.pm * BM + ai * HALF + wr * 64 + m * 16 + fr; n = n < 1039 ? n : 1039;
#pragma unroll
                for (int bj = 0; bj < 2; ++bj) {
                    const size_t off = off0 + (size_t)n * (16 * DM) + (size_t)bj * (8 * DM);
                    const f32x4 y0 = *(const f32x4*)(YI + off), y1 = *(const f32x4*)(YI + off + 4);
                    const u32x4 uv = *(const u32x4*)(Uu + off);
                    float y[8];
#pragma unroll
                    for (int q = 0; q < 4; ++q) { y[q] = acc[ai][bj][m][0][q] + y0[q] + d0[q] * (q & 1 ? __uint_as_float(uv[q >> 1] & 0xffff0000u) : __uint_as_float(uv[q >> 1] << 16));
                        y[4 + q] = acc[ai][bj][m][1][q] + y1[q] + d1[q] * (q & 1 ? __uint_as_float(uv[2 + (q >> 1)] & 0xffff0000u) : __uint_as_float(uv[2 + (q >> 1)] << 16)); }
#pragma unroll
                    for (int q = 0; q < 8; ++q) { const float z = 1.5957691216f * (y[q] + 0.044715f * y[q] * y[q] * y[q]); y[q] = y[q] * __builtin_amdgcn_rcpf(1.f + __expf(-z)); }
                    u32x4 w; w.x = cvt_pk_bf16(y[0], y[1]); w.y = cvt_pk_bf16(y[2], y[3]); w.z = cvt_pk_bf16(y[4], y[5]); w.w = cvt_pk_bf16(y[6], y[7]);
                    *(u32x4*)(O + off) = w; }
                asm volatile("" ::: "memory"); }
    }
};

template <class Epi, class Sched, bool ALIGN_EPI = false, bool SP2 = false>
__device__ __forceinline__ void gemm_phase(PG8_LAS unsigned char* lds, const int K, const Sched& S, const Epi& E) {
    int tid_ = threadIdx.x; asm volatile("" : "+v"(tid_));
    const int tid = tid_, wid = __builtin_amdgcn_readfirstlane(tid >> 6), lane = tid & 63, wr = wid >> 2, wc = wid & 3, fr = lane & 15, fq = lane >> 4;
    const int nt = K / BK;
    unsigned voffA[2], voffB[2];
#pragma unroll
    for (int i = 0; i < 2; ++i) { int R, C; stage_rc(tid * 16 + i * 8192, R, C); const int Rb = Epi::PERM ? ((R & ~31) + perm32(R & 31)) : R;
        voffA[i] = Sched::GATHER_A ? (unsigned)(((16 * R + (C >> 4)) * 1024 + (C & 15)) * 2) : (unsigned)(R * K + C) * 2u; voffB[i] = (unsigned)(Rb * K + C) * 2u; }
    const size_t kstep = (size_t)(BK * 2);
    const size_t hstep = (size_t)HALF * K * 2;
    const size_t kstepA = Sched::GATHER_A ? (size_t)(4 * 1024 * 2) : kstep, hstepA = Sched::GATHER_A ? (size_t)HALF * 16 * 1024 * 2 : hstep;
    const unsigned ldsw = (unsigned)wid * 1024u;
    const int aoff = lds_byte(wr * 64 + fr, fq * 8), boff = lds_byte(wc * 32 + fr, fq * 8);
#define PG8_SA(b, h) (((b) * 2 + (h)) * HTB)
#define PG8_SB(b, h) ((4 + (b) * 2 + (h)) * HTB)
#define PG8_STAGE(bufoff, gbase, voff) do { _Pragma("unroll") for (int _i = 0; _i < 2; ++_i) \
        __builtin_amdgcn_global_load_lds((const unsigned*)((const char*)(gbase) + (voff)[_i]), (PG8_LAS unsigned*)(lds + (bufoff) + ldsw + _i * 8192), 16, 0, 0); } while (0)
#define PG8_LDA(dst, b, h) do { _Pragma("unroll") for (int m = 0; m < 4; ++m) _Pragma("unroll") for (int k = 0; k < 2; ++k) dst[m][k] = *(const PG8_LAS bf16x8*)(lds + PG8_SA(b, h) + aoff + m * 2048 + k * 1024); } while (0)
#define PG8_LDB(dst, b, h) do { _Pragma("unroll") for (int n = 0; n < 2; ++n) _Pragma("unroll") for (int k = 0; k < 2; ++k) dst[n][k] = *(const PG8_LAS bf16x8*)(lds + PG8_SB(b, h) + boff + n * 2048 + k * 1024); } while (0)
#define PG8_MMA(ai, bj, At, Bt) do { __builtin_amdgcn_s_setprio(1); _Pragma("unroll") for (int m = 0; m < 4; ++m) _Pragma("unroll") for (int n = 0; n < 2; ++n) _Pragma("unroll") for (int k = 0; k < 2; ++k) \
        acc[ai][bj][m][n] = __builtin_amdgcn_mfma_f32_16x16x32_bf16(Bt[n][k], At[m][k], acc[ai][bj][m][n], 0, 0, 0); __builtin_amdgcn_s_setprio(0); } while (0)
#define PG8_WAIT_V(n) asm volatile("s_waitcnt vmcnt(" #n ")" ::: "memory")
#define PG8_WAIT_L(n) asm volatile("s_waitcnt lgkmcnt(" #n ")" ::: "memory")
#define PG8_BAR __builtin_amdgcn_s_barrier()
#define PG8_SCHED __builtin_amdgcn_sched_barrier(0)
    Unit cur, nxt; int ui = 0;
    if (!S.next(0, cur)) return;
    f32x4 acc[2][2][4][2];
#pragma unroll
    for (int a = 0; a < 2; ++a)
#pragma unroll
        for (int b = 0; b < 2; ++b)
#pragma unroll
            for (int m = 0; m < 4; ++m)
#pragma unroll
                for (int n = 0; n < 2; ++n) acc[a][b][m][n] = (f32x4){0.f, 0.f, 0.f, 0.f};
    bf16x8 At[4][2], B0[2][2], B1[2][2];
    const char* cA = cur.A; const char* cB = cur.B;
    S.a_ready(cur);
    if constexpr (SP2) {
        PG8_STAGE(PG8_SB(0, 0), cB, voffB); PG8_STAGE(PG8_SB(0, 1), cB + hstep, voffB); PG8_STAGE(PG8_SA(0, 0), cA, voffA); PG8_STAGE(PG8_SA(0, 1), cA + hstepA, voffA);
        if (wr == 1) PG8_BAR;
        PG8_WAIT_V(2); PG8_BAR;
        PG8_STAGE(PG8_SB(1, 0), cB + kstep, voffB); PG8_STAGE(PG8_SA(1, 0), cA + kstepA, voffA); PG8_STAGE(PG8_SB(1, 1), cB + hstep + kstep, voffB);
        PG8_WAIT_V(6); PG8_BAR;
    } else {
        PG8_STAGE(PG8_SB(0, 0), cB, voffB); PG8_STAGE(PG8_SA(0, 0), cA, voffA); PG8_STAGE(PG8_SB(0, 1), cB + hstep, voffB); PG8_STAGE(PG8_SA(0, 1), cA + hstepA, voffA);
        if (wr == 1) PG8_BAR;
        PG8_WAIT_V(4); PG8_BAR;
        PG8_STAGE(PG8_SB(1, 0), cB + kstep, voffB); PG8_STAGE(PG8_SA(1, 0), cA + kstepA, voffA); PG8_STAGE(PG8_SB(1, 1), cB + hstep + kstep, voffB);
        PG8_WAIT_V(6); PG8_BAR;
    }
    for (;;) {
        const bool has_next = S.next(ui + 1, nxt);
        const char* nA = has_next ? nxt.A : cA; const char* nB = has_next ? nxt.B : cB;
        for (int t = 0; t < nt; t += 2) {
            const bool last = (t == nt - 2);
            const char* a1 = cA + (size_t)(t + 1) * kstepA;
            const char* a2 = last ? nA : cA + (size_t)(t + 2) * kstepA; const char* b2 = last ? nB : cB + (size_t)(t + 2) * kstep;
            const char* a3 = a2 + kstepA; const char* b3 = b2 + kstep;
            if (last && has_next) S.a_ready(nxt);
            if constexpr (SP2) {
            PG8_LDB(B0, 0, 0); PG8_LDB(B1, 0, 1); PG8_SCHED; PG8_LDA(At, 0, 0); PG8_STAGE(PG8_SA(1, 1), a1 + hstepA, voffA);
            PG8_WAIT_V(8); PG8_WAIT_L(0); PG8_BAR; PG8_MMA(0, 0, At, B0); PG8_MMA(0, 1, At, B1); PG8_BAR; PG8_SCHED;
            PG8_LDA(At, 0, 1); PG8_STAGE(PG8_SB(0, 0), b2, voffB); PG8_STAGE(PG8_SB(0, 1), b2 + hstep, voffB); PG8_STAGE(PG8_SA(0, 0), a2, voffA);
            PG8_WAIT_V(8); PG8_WAIT_L(0); PG8_BAR; PG8_MMA(1, 0, At, B0); PG8_MMA(1, 1, At, B1); PG8_BAR; PG8_SCHED;
            PG8_LDB(B0, 1, 0); PG8_LDB(B1, 1, 1); PG8_SCHED; PG8_LDA(At, 1, 0); PG8_STAGE(PG8_SA(0, 1), a2 + hstepA, voffA);
            PG8_WAIT_V(8); PG8_WAIT_L(0); PG8_BAR; PG8_MMA(0, 0, At, B0); PG8_MMA(0, 1, At, B1); PG8_BAR; PG8_SCHED;
            PG8_LDA(At, 1, 1); PG8_STAGE(PG8_SB(1, 0), b3, voffB); PG8_STAGE(PG8_SB(1, 1), b3 + hstep, voffB); PG8_STAGE(PG8_SA(1, 0), a3, voffA);
            PG8_WAIT_V(8); PG8_WAIT_L(0); PG8_BAR; PG8_MMA(1, 0, At, B0); PG8_MMA(1, 1, At, B1); PG8_BAR; PG8_SCHED;
            } else {
            PG8_LDB(B0, 0, 0); PG8_SCHED; PG8_LDA(At, 0, 0); PG8_STAGE(PG8_SA(1, 1), a1 + hstepA, voffA);
            PG8_WAIT_L(8); PG8_BAR; PG8_WAIT_L(0); PG8_MMA(0, 0, At, B0); PG8_BAR; PG8_SCHED;
            PG8_LDB(B1, 0, 1); PG8_STAGE(PG8_SB(0, 0), b2, voffB);
            PG8_BAR; PG8_WAIT_L(0); PG8_MMA(0, 1, At, B1); PG8_BAR;
            PG8_LDA(At, 0, 1); PG8_STAGE(PG8_SA(0, 0), a2, voffA);
            PG8_BAR; PG8_WAIT_L(0); PG8_MMA(1, 0, At, B0); PG8_BAR; PG8_SCHED;
            PG8_STAGE(PG8_SB(0, 1), b2 + hstep, voffB);
            PG8_WAIT_V(6); PG8_BAR; PG8_MMA(1, 1, At, B1); PG8_BAR;
            PG8_LDB(B0, 1, 0); PG8_SCHED; PG8_LDA(At, 1, 0); PG8_STAGE(PG8_SA(0, 1), a2 + hstepA, voffA);
            PG8_WAIT_L(8); PG8_BAR; PG8_WAIT_L(0); PG8_MMA(0, 0, At, B0); PG8_BAR; PG8_SCHED;
            PG8_LDB(B1, 1, 1); PG8_STAGE(PG8_SB(1, 0), b3, voffB);
            PG8_BAR; PG8_WAIT_L(0); PG8_MMA(0, 1, At, B1); PG8_BAR;
            PG8_LDA(At, 1, 1); PG8_STAGE(PG8_SA(1, 0), a3, voffA);
            PG8_BAR; PG8_WAIT_L(0); PG8_MMA(1, 0, At, B0); PG8_BAR; PG8_SCHED;
            PG8_STAGE(PG8_SB(1, 1), b3 + hstep, voffB);
            PG8_WAIT_V(6); PG8_BAR; PG8_MMA(1, 1, At, B1); PG8_BAR;
            }
        }
        if constexpr (ALIGN_EPI) { if (wr == 0) PG8_BAR; }
        if constexpr (!Epi::AFTER_DRAIN) { E(acc, cur, wr, wc, fr, fq); S.done(cur); }
        if (!has_next) break;
#pragma unroll
        for (int a = 0; a < 2; ++a)
#pragma unroll
            for (int b = 0; b < 2; ++b)
#pragma unroll
                for (int m = 0; m < 4; ++m)
#pragma unroll
                    for (int n = 0; n < 2; ++n) acc[a][b][m][n] = (f32x4){0.f, 0.f, 0.f, 0.f};
        cur = nxt; cA = nA; cB = nB; ++ui;
        if constexpr (ALIGN_EPI) { if (wr == 1) PG8_BAR; }
    }
    PG8_WAIT_V(0);
    if constexpr (!ALIGN_EPI) { if (wr == 0) PG8_BAR; }
    PG8_BAR;
    if constexpr (Epi::AFTER_DRAIN) { E.fused(acc, cur, wr, wc, fr, fq, lds, wid, lane); S.done(cur); }
#undef PG8_SA
#undef PG8_SB
#undef PG8_STAGE
#undef PG8_LDA
#undef PG8_LDB
#undef PG8_MMA
#undef PG8_WAIT_V
#undef PG8_WAIT_L
#undef PG8_BAR
#undef PG8_SCHED
}
}

#define PHASE_PROLOGUE \
    int tid_ = threadIdx.x; asm volatile("" : "+v"(tid_)); const int tid = tid_, lane = tid & 63, wave = tid >> 6; \
    const int G = GRID, bid = blockIdx.x; \
    const int gw = bid * 8 + wave, NGW = G * 8; \
    unsigned char* ws = P.ws; \
    float* H = (float*)(ws + WS_H); \
    bf16_t* HN = (bf16_t*)(ws + WS_HN); \
    bf16_t* A2 = (bf16_t*)(ws + WS_A2); \
    bf16_t* Qb = (bf16_t*)(ws + WS_Q); bf16_t* Kb = (bf16_t*)(ws + WS_K); bf16_t* Vb = (bf16_t*)(ws + WS_V); \
    bf16_t* REST = (bf16_t*)(ws + WS_REST); \
    bf16_t* YFB = (bf16_t*)(ws + WS_YFB); \
    bf16_t* Rr = (bf16_t*)(ws + WS_R); bf16_t* VV = (bf16_t*)(ws + WS_VV); bf16_t* KK = (bf16_t*)(ws + WS_KK); \
    bf16_t* KKA = (bf16_t*)(ws + WS_KKA); bf16_t* KD = (bf16_t*)(ws + WS_KD); \
    _Float16* LW = (_Float16*)(ws + WS_W); bf16_t* PP = (bf16_t*)(ws + WS_PP); bf16_t* QT = (bf16_t*)(ws + WS_QT); bf16_t* YT = (bf16_t*)(ws + WS_YT); bf16_t* ZT = (bf16_t*)(ws + WS_ZT); \
    bf16_t* Gg = (bf16_t*)(ws + WS_G); bf16_t* KR = (bf16_t*)(ws + WS_KR); bf16_t* LOW = (bf16_t*)(ws + WS_LOW); \
    float* BC = (float*)(ws + WS_BC); \
    bf16_t* AA = (bf16_t*)(ws + WS_AA); \
    bf16_t* HB = (bf16_t*)(ws + WS_HB); bf16_t* YB = (bf16_t*)(ws + WS_YB); \
    bf16_t* XB = (bf16_t*)(ws + WS_XB); int* EID = (int*)(ws + WS_EID); int* POS = (int*)(ws + WS_POS); int* DEST = (int*)(ws + WS_DEST); \
    float* GATE = (float*)(ws + WS_GATE); \
    float* YI = (float*)(ws + WS_YI); float* S5E = (float*)(ws + WS_E); bf16_t* CAR = (bf16_t*)(ws + WS_CAR); bf16_t* BTA = (bf16_t*)(ws + WS_BTA); bf16_t* BTC = (bf16_t*)(ws + WS_BTC); \
    unsigned* CTL = (unsigned*)(ws + WS_CTL); \
    bf16_t* WTIN = (bf16_t*)(ws + WS_WTIN); bf16_t* WTOUT = (bf16_t*)(ws + WS_WTOUT); bf16_t* WTGLU = (bf16_t*)(ws + WS_WTGLU); bf16_t* WT13 = (bf16_t*)(ws + WS_WT13); bf16_t* WT2 = (bf16_t*)(ws + WS_WT2); \
    const int vcu = (G % 8 == 0) ? (bid % 8) * (G / 8) + bid / 8 : bid; \
    const float* x = P.in[0]; const float* meta = P.in[1]; const float* norm_mix = P.in[2]; const float* norm_ffn = P.in[3]; const float* norm_final = P.in[4]; \
    const float* w_in = P.in[5]; const float* w_out = P.in[6]; const float* rpb = P.in[7]; const float* mu = P.in[8]; \
    const float* w0 = P.in[9]; const float* w_up = P.in[10]; const float* a0 = P.in[11]; const float* a_up = P.in[12]; const float* g_up = P.in[13]; \
    const float* k_k = P.in[14]; const float* k_a = P.in[15]; const float* r_k = P.in[16]; const float* lnx_g = P.in[17]; const float* lnx_b = P.in[18]; \
    const float* s5_b_re = P.in[19]; const float* s5_b_im = P.in[20]; const float* s5_lre = P.in[21]; const float* s5_lim = P.in[22]; const float* s5_ls = P.in[23]; \
    const float* s5_c_re = P.in[24]; const float* s5_c_im = P.in[25]; const float* s5_d = P.in[26]; const float* w_glu = P.in[27]; \
    const float* moe_wg = P.in[28]; const float* moe_bg = P.in[29]; const float* moe_we = P.in[30]; const float* moe_be = P.in[31]; \
    const float* moe_w1 = P.in[32]; const float* moe_w3 = P.in[33]; const float* moe_w2 = P.in[34];


__device__ __forceinline__ void transpose_item(const float* W, int N, int K, int k0, int n0, bf16_t* dstrow0, int lane) {
    const int nq = lane & 15, kb = lane >> 4;
    const float* src = W + (size_t)(k0 + 16 * kb) * N + n0 + 4 * nq;
    f32x4 v[16];
#pragma unroll
    for (int kk = 0; kk < 16; ++kk) v[kk] = *(const f32x4*)(src + (size_t)kk * N);
#pragma unroll
    for (int i = 0; i < 4; ++i) {
        bf16_t* d = dstrow0 + (size_t)(4 * nq + i) * K + k0 + 16 * kb;
        u32x4 lo, hi;
        lo.x = pk2(v[0][i], v[1][i]); lo.y = pk2(v[2][i], v[3][i]); lo.z = pk2(v[4][i], v[5][i]); lo.w = pk2(v[6][i], v[7][i]);
        hi.x = pk2(v[8][i], v[9][i]); hi.y = pk2(v[10][i], v[11][i]); hi.z = pk2(v[12][i], v[13][i]); hi.w = pk2(v[14][i], v[15][i]);
        *(u32x4*)d = lo; *(u32x4*)(d + 8) = hi;
    }
}
#define CONV_DENSE_ITEMS (832 + 256 + 512)
__device__ __forceinline__ void conv_dense_item(CParams& P, int it, int lane) {
    unsigned char* ws = P.ws;
    if (it < 832) { const int kb = it / 52, nb = it % 52; transpose_item(P.in[5], INCOLS, DM, kb * 64, nb * 64, (bf16_t*)(ws + WS_WTIN) + (size_t)nb * 64 * DM, lane); return; }
    it -= 832;
    if (it < 256) { const int kb = it / 16, nb = it % 16; transpose_item(P.in[6], DM, DM, kb * 64, nb * 64, (bf16_t*)(ws + WS_WTOUT) + (size_t)nb * 64 * DM, lane); return; }
    it -= 256;
    { const int kb = it / 32, nb = it % 32, n = nb * 64, half = n >> 10, c = n & 1023, row = (c >> 7) * 256 + half * 128 + (c & 127);
      transpose_item(P.in[27], 2 * DM, DM, kb * 64, n, (bf16_t*)(ws + WS_WTGLU) + (size_t)row * DM, lane); }
}
#define CONV_MOE_ITEMS (NEXP * 384)
__device__ __forceinline__ void conv_moe_item(CParams& P, int l, int it, int lane) {
    unsigned char* ws = P.ws;
    const int e = it / 384; int r = it % 384;
    if (r < 256) { const int which = r >> 7; r &= 127; const int kb = r >> 3, nb = r & 7, n = nb * 64, row = (n >> 7) * 256 + which * 128 + (n & 127);
        const float* W = (which ? P.in[33] : P.in[32]) + ((size_t)(l * NEXP + e) * DM) * DFF;
        transpose_item(W, DFF, DM, kb * 64, n, (bf16_t*)(ws + WS_WT13) + ((size_t)e * DM + row) * DM, lane); return; }
    r -= 256;
    { const int kb = r >> 4, nb = r & 15; const float* W = P.in[34] + ((size_t)(l * NEXP + e) * DFF) * DM;
      transpose_item(W, DM, DFF, kb * 64, nb * 64, (bf16_t*)(ws + WS_WT2) + ((size_t)e * DM + nb * 64) * DFF, lane); }
}

template <int MODE>
__device__ __forceinline__ void meta_gemm(const bf16_t* A, const bf16_t* Bt, float* Hrows, int task, int lane) {
    const int fr = lane & 15, fq = lane >> 4, c = task * 16 + fr;
    const bf16_t* b0 = MODE == 0 ? Bt + (size_t)c * DM : Bt + (size_t)((c >> 7) * 256 + (c & 127)) * DM;
    const bf16_t* b1 = b0 + (size_t)128 * DM;
    f32x4 acc0[2], acc1[2];
    acc0[0] = acc0[1] = acc1[0] = acc1[1] = (f32x4){0.f, 0.f, 0.f, 0.f};
#pragma unroll 4
    for (int kt = 0; kt < 32; ++kt) {
        const int ko = kt * 32 + fq * 8;
        const bf16x8 a0 = *(const bf16x8*)(A + (size_t)fr * DM + ko), a1 = *(const bf16x8*)(A + (size_t)(16 + fr) * DM + ko);
        const bf16x8 bv = *(const bf16x8*)(b0 + ko);
        acc0[0] = __builtin_amdgcn_mfma_f32_16x16x32_bf16(a0, bv, acc0[0], 0, 0, 0);
        acc0[1] = __builtin_amdgcn_mfma_f32_16x16x32_bf16(a1, bv, acc0[1], 0, 0, 0);
        if (MODE == 1) { const bf16x8 bg = *(const bf16x8*)(b1 + ko);
            acc1[0] = __builtin_amdgcn_mfma_f32_16x16x32_bf16(a0, bg, acc1[0], 0, 0, 0);
            acc1[1] = __builtin_amdgcn_mfma_f32_16x16x32_bf16(a1, bg, acc1[1], 0, 0, 0); }
    }
#pragma unroll
    for (int mi = 0; mi < 2; ++mi)
#pragma unroll
        for (int j = 0; j < 4; ++j) { float* p = Hrows + (size_t)(mi * 16 + fq * 4 + j) * DM + c;
            if (MODE == 0) *p += acc0[mi][j]; else *p += acc0[mi][j] * __builtin_amdgcn_rcpf(1.f + __expf(-acc1[mi][j])); }
}
__device__ __forceinline__ void phase_0(CParams& P, unsigned char* lds, const int ph) {
    PHASE_PROLOGUE
            for (int row = gw; row < NT; row += NGW) {
                const float* src = row < NMAIN ? x + (size_t)row * DM : meta + (size_t)((row - NMAIN) & 15) * DM;
                f32x4 v[4];
#pragma unroll
                for (int j = 0; j < 4; ++j) { v[j] = ((const f32x4*)src)[lane + 64 * j]; ((f32x4*)(H + (size_t)row * DM))[lane + 64 * j] = v[j]; }
                store_norm_bf16(v, norm_mix, HN + (size_t)row * DM, lane);
            }
    for (int it = gw; it < CONV_DENSE_ITEMS; it += NGW) conv_dense_item(P, it, lane);
}

__device__ __forceinline__ void phase_1(CParams& P, unsigned char* lds, const int ph) {
    PHASE_PROLOGUE
    pg8::ProjOrder S; S.init(HN, WTIN, bid);
    pg8::EpiProj E{Qb, Kb, Vb, REST};
    pg8::gemm_phase<pg8::EpiProj, pg8::ProjOrder, true, true>((PG8_LAS unsigned char*)lds, DM, S, E);
}

__device__ __forceinline__ void phase_2(CParams& P, unsigned char* lds, const int ph) {
    PHASE_PROLOGUE
    float* sb = (float*)lds;
    for (int i = tid; i < 8 * 465; i += 512) sb[i] = rpb[i];
    __syncthreads();
    const bf16_t* VT = Vb;
    const int fr = lane & 15, fq = lane >> 4;
    for (int u = gw; u < 8192 + 16; u += NGW) {
        const bool metaq = u >= 8192;
        int b, h, r = 0, qb = 0;
        if (!metaq) { qb = u & 3; r = (u >> 2) & 127; h = (u >> 9) & 7; b = u >> 12; } else { const int m = u - 8192; b = m >> 3; h = m & 7; }
        const int c = qb * 16 + fr;
        const int qrow = metaq ? NMAIN + b * NMETA + fr : b * SEQ + r * 64 + c;
        const int R0 = min(max(r - 4, 0), 120), cs = qb == 0 ? 0 : (qb == 1 ? 8 : (qb == 2 ? 24 : 32));
        const int C0 = min(max(c - 8, 0), 48);
        bf16x8 qf0 = *(const bf16x8*)(Qb + (size_t)qrow * 512 + h * 64 + fq * 8), qf1 = *(const bf16x8*)(Qb + (size_t)qrow * 512 + h * 64 + 32 + fq * 8);
        f32x4 sacc[17];
        const f32x4 zero4 = (f32x4){0.f, 0.f, 0.f, 0.f};
        if (!metaq) {
#pragma unroll
            for (int kt = 0; kt < 16; ++kt) {
                const int krow0 = b * SEQ + (R0 + (kt >> 1)) * 64 + cs + 16 * (kt & 1);
                const bf16_t* kp = Kb + (size_t)(krow0 + fr) * 512 + h * 64 + fq * 8;
                const bf16x8 a0 = *(const bf16x8*)kp, a1 = *(const bf16x8*)(kp + 32);
                f32x4 acc = __builtin_amdgcn_mfma_f32_16x16x32_bf16(a0, qf0, zero4, 0, 0, 0);
                sacc[kt] = __builtin_amdgcn_mfma_f32_16x16x32_bf16(a1, qf1, acc, 0, 0, 0);
            }
        } else {
#pragma unroll
            for (int kt = 0; kt < 16; ++kt) sacc[kt] = zero4;
        }
        {
            const bf16_t* kp = Kb + (size_t)(NMAIN + b * NMETA + fr) * 512 + h * 64 + fq * 8;
            const bf16x8 a0 = *(const bf16x8*)kp, a1 = *(const bf16x8*)(kp + 32);
            f32x4 acc = __builtin_amdgcn_mfma_f32_16x16x32_bf16(a0, qf0, zero4, 0, 0, 0);
            sacc[16] = __builtin_amdgcn_mfma_f32_16x16x32_bf16(a1, qf1, acc, 0, 0, 0);
        }
        float mx = -1e30f;
#pragma unroll
        for (int kt = 0; kt < 16; ++kt) {
            const int dr = R0 + (kt >> 1) - r + 7;
#pragma unroll
            for (int j = 0; j < 4; ++j) {
                const int kc = cs + 16 * (kt & 1) + 4 * fq + j;
                const bool inb = !metaq && kc >= C0 && kc < C0 + 16;
                const int dc = min(max(kc - c + 15, 0), 30);
                const float s = inb ? sacc[kt][j] * 0.125f + sb[(h * 15 + dr) * 31 + dc] : -1e30f;
                sacc[kt][j] = s; mx = fmaxf(mx, s);
            }
        }
#pragma unroll
        for (int j = 0; j < 4; ++j) { const float s = sacc[16][j] * 0.125f; sacc[16][j] = s; mx = fmaxf(mx, s); }
        mx = fmaxf(mx, __shfl_xor(mx, 16)); mx = fmaxf(mx, __shfl_xor(mx, 32));
        float sum = 0.f;
#pragma unroll
        for (int kt = 0; kt < 17; ++kt)
#pragma unroll
            for (int j = 0; j < 4; ++j) { const float pv = __expf(sacc[kt][j] - mx); sacc[kt][j] = pv; sum += pv; }
        sum += __shfl_xor(sum, 16); sum += __shfl_xor(sum, 32);
        f32x4 o[4] = {zero4, zero4, zero4, zero4};
        if (!metaq) {
#pragma unroll
            for (int kr = 0; kr < 8; ++kr) {
                union { bf16x8 v; unsigned u[4]; } bf;
                bf.u[0] = pk2(sacc[2 * kr][0], sacc[2 * kr][1]); bf.u[1] = pk2(sacc[2 * kr][2], sacc[2 * kr][3]);
                bf.u[2] = pk2(sacc[2 * kr + 1][0], sacc[2 * kr + 1][1]); bf.u[3] = pk2(sacc[2 * kr + 1][2], sacc[2 * kr + 1][3]);
                const size_t tok0 = (size_t)b * SEQ + (R0 + kr) * 64 + cs + 4 * fq;
#pragma unroll
                for (int dt = 0; dt < 4; ++dt) {
                    const bf16_t* vp = VT + (size_t)(h * 64 + dt * 16 + fr) * NTP + tok0;
                    union { bf16x8 v; u32x2 h2[2]; } af;
                    af.h2[0] = *(const u32x2*)vp; af.h2[1] = *(const u32x2*)(vp + 16);
                    o[dt] = __builtin_amdgcn_mfma_f32_16x16x32_bf16(af.v, bf.v, o[dt], 0, 0, 0);
                }
            }
        }
        {
            union { bf16x8 v; unsigned u[4]; } bf;
            bf.u[0] = pk2(sacc[16][0], sacc[16][1]); bf.u[1] = pk2(sacc[16][2], sacc[16][3]); bf.u[2] = 0u; bf.u[3] = 0u;
            const size_t tokm = (size_t)NMAIN + b * NMETA + 4 * fq;
#pragma unroll
            for (int dt = 0; dt < 4; ++dt) {
                const bf16_t* vp = VT + (size_t)(h * 64 + dt * 16 + fr) * NTP + tokm;
                union { bf16x8 v; u32x2 h2[2]; } af;
                af.h2[0] = *(const u32x2*)vp; af.h2[1] = (u32x2){0u, 0u};
                o[dt] = __builtin_amdgcn_mfma_f32_16x16x32_bf16(af.v, bf.v, o[dt], 0, 0, 0);
            }
        }
        const float inv = 1.f / sum;
#pragma unroll
        for (int dt = 0; dt < 4; ++dt) {
            u32x2 ov; ov.x = pk2(o[dt][0] * inv, o[dt][1] * inv); ov.y = pk2(o[dt][2] * inv, o[dt][3] * inv);
            *(u32x2*)(A2 + (size_t)qrow * DM + h * 64 + dt * 16 + 4 * fq) = ov;
        }
    }
    __syncthreads();
}

__device__ __forceinline__ void phase_3(CParams& P, unsigned char* lds, const int ph) {
    PHASE_PROLOGUE
            for (int tk = gw; tk < NT; tk += NGW) {
                const int b = tk / LSEQ, p = tk % LSEQ, row = rowof(b, p);
                const bool hp = p > 0, hn = p + 1 < LSEQ;
                const int rowp = hp ? rowof(b, p - 1) : row, rown = hn ? rowof(b, p + 1) : row;
#pragma unroll
                for (int j = 0; j < 7; ++j) {
                    const int c = 4 * lane + 256 * j;
                    const u32x2 vc = *(const u32x2*)(REST + (size_t)row * RESTC + c);
                    u32x2 vp = *(const u32x2*)(REST + (size_t)rowp * RESTC + c);
                    u32x2 vn = *(const u32x2*)(REST + (size_t)rown * RESTC + c);
                    if (!hp) { vp.x = 0; vp.y = 0; }
                    if (!hn) { vn.x = 0; vn.y = 0; }
                    const f32x4 m4 = *(const f32x4*)(mu + c);
                    float pc[4] = {bflo(vc.x), bfhi(vc.x), bflo(vc.y), bfhi(vc.y)};
                    float pp[4] = {bflo(vp.x), bfhi(vp.x), bflo(vp.y), bfhi(vp.y)};
                    float pn[4] = {bflo(vn.x), bfhi(vn.x), bflo(vn.y), bfhi(vn.y)};
                    float o[4];
#pragma unroll
                    for (int i = 0; i < 4; ++i) o[i] = pc[i] + m4[i] * (0.5f * (pp[i] + pn[i]) - pc[i]);
                    if (j == 6) {
                        if (lane < 16) { for (int i = 0; i < 4; ++i) o[i] = tanhf(o[i]); }
                        else if (lane >= 32) { for (int i = 0; i < 4; ++i) o[i] = sigmoidf_(o[i]); }
                    }
                    u32x2 ov; ov.x = pk2(o[0], o[1]); ov.y = pk2(o[2], o[3]);
                    bf16_t* dst = j < 2 ? Rr + (size_t)row * 512 + c : (j < 4 ? KR + (size_t)row * 512 + (c - 512) : (j < 6 ? VV + (size_t)row * 512 + (c - 1024) : LOW + (size_t)row * 256 + (c - 1536)));
                    *(u32x2*)dst = ov;
                }
            }
}


__device__ __forceinline__ void phase_4(CParams& P, unsigned char* lds, const int ph) {
    PHASE_PROLOGUE
            const int nrt = (NT + 127) / 128;
            const int nunits = nrt * 4 * 5;
            for (int u = bid; u < nunits; u += G) {
                const int which = u / (nrt * 4), rem = u % (nrt * 4), rt = rem / 4, ct = rem % 4;
                f32x4 acc[4][2];
                const int koff = which < 2 ? 0 : (which < 4 ? 64 : 128), KK_ = which < 4 ? 64 : 128;
                const float* Bsrc = which < 2 ? w_up + (size_t)which * 64 * 512 : (which < 4 ? a_up + (size_t)(which - 2) * 64 * 512 : g_up);
                gemm_tile(lds, KK_, 512,
                          [&](int r) { int row = rt * 128 + r; if (row >= NT) row = NT - 1; return LOW + (size_t)row * 256 + koff; },
                          [&](int n) { return Bsrc + ct * 128 + n; }, acc);
                ACC_FOREACH(acc, { const int row = rt * 128 + rl, col = ct * 128 + cl; if (row < NT) {
                    if (which < 2) { const float wl = w0[which * 512 + col] + val; LW[((size_t)which * NT + row) * 512 + col] = (_Float16)(-0.6065306597f * sigmoidf_(wl)); }
                    else if (which < 4) { const int d = which - 2; AA[((size_t)d * NT + row) * 512 + col] = (bf16_t)f2bf(sigmoidf_(a0[d * 512 + col] + val)); }
                    else Gg[(size_t)row * 512 + col] = (bf16_t)f2bf(val); } });
            }
}


__device__ __forceinline__ void phase_5(CParams& P, unsigned char* lds, const int ph) {
    PHASE_PROLOGUE
            for (int row = gw; row < NT; row += NGW) {
                const int c0 = lane * 8;
                const u32x4 krv = *(const u32x4*)(KR + (size_t)row * 512 + c0);
                const u32x4 rv = *(const u32x4*)(Rr + (size_t)row * 512 + c0);
                float kr[8], rr[8], kkv[8];
#pragma unroll
                for (int i = 0; i < 4; ++i) { kr[2 * i] = bflo(krv[i]); kr[2 * i + 1] = bfhi(krv[i]); rr[2 * i] = bflo(rv[i]); rr[2 * i + 1] = bfhi(rv[i]); }
                float ss = 0.f;
#pragma unroll
                for (int i = 0; i < 8; ++i) { kkv[i] = kr[i] * k_k[c0 + i]; ss += kkv[i] * kkv[i]; }
                ss += __shfl_xor(ss, 1); ss += __shfl_xor(ss, 2); ss += __shfl_xor(ss, 4);
                const float inv = 1.f / fmaxf(sqrtf(ss), 1e-12f);
#pragma unroll
                for (int i = 0; i < 8; ++i) kkv[i] *= inv;
                u32x4 o; o.x = pk2(kkv[0], kkv[1]); o.y = pk2(kkv[2], kkv[3]); o.z = pk2(kkv[4], kkv[5]); o.w = pk2(kkv[6], kkv[7]);
                *(u32x4*)(KK + (size_t)row * 512 + c0) = o;
                float bsum = 0.f;
#pragma unroll
                for (int d = 0; d < 2; ++d) {
                    const u32x4 av = *(const u32x4*)(AA + ((size_t)d * NT + row) * 512 + c0);
                    float a[8], kka[8], kd[8];
#pragma unroll
                    for (int i = 0; i < 4; ++i) { a[2 * i] = bflo(av[i]); a[2 * i + 1] = bfhi(av[i]); }
#pragma unroll
                    for (int i = 0; i < 8; ++i) { kka[i] = kkv[i] * a[i]; kd[i] = kr[i] * (1.f + (a[i] - 1.f) * k_a[c0 + i]); bsum += rr[i] * kd[i] * r_k[c0 + i]; }
                    u32x4 o1; o1.x = pk2(kka[0], kka[1]); o1.y = pk2(kka[2], kka[3]); o1.z = pk2(kka[4], kka[5]); o1.w = pk2(kka[6], kka[7]);
                    *(u32x4*)(KKA + ((size_t)d * NT + row) * 512 + c0) = o1;
                    u32x4 o2; o2.x = pk2(kd[0], kd[1]); o2.y = pk2(kd[2], kd[3]); o2.z = pk2(kd[4], kd[5]); o2.w = pk2(kd[6], kd[7]);
                    *(u32x4*)(KD + ((size_t)d * NT + row) * 512 + c0) = o2;
                }
                bsum += __shfl_xor(bsum, 1); bsum += __shfl_xor(bsum, 2); bsum += __shfl_xor(bsum, 4);
                if ((lane & 7) == 0) BC[(size_t)row * 8 + (lane >> 3)] = bsum;
            }
}


#define RWS 72
__device__ __forceinline__ bf16x8 rw_frag(const bf16_t* M, int row, int kofs) { return *(const bf16x8*)(M + row * RWS + kofs); }
__device__ __forceinline__ f32x4 rw_tile(const bf16_t* Am, int ra, const bf16_t* Bm, int rb, int fr, int fq) {
    f32x4 acc = (f32x4){0.f, 0.f, 0.f, 0.f};
    acc = __builtin_amdgcn_mfma_f32_16x16x32_bf16(rw_frag(Am, ra + fr, 8 * fq), rw_frag(Bm, rb + fr, 8 * fq), acc, 0, 0, 0);
    acc = __builtin_amdgcn_mfma_f32_16x16x32_bf16(rw_frag(Am, ra + fr, 32 + 8 * fq), rw_frag(Bm, rb + fr, 32 + 8 * fq), acc, 0, 0, 0);
    return acc;
}
__device__ __forceinline__ void phase_6(CParams& P, unsigned char* lds, const int ph) {
    PHASE_PROLOGUE
    float* Gs = (float*)lds;
    bf16_t* A_rm = (bf16_t*)(lds + 16384); bf16_t* R_rm = A_rm + 64 * RWS; bf16_t* B_rm = R_rm + 64 * RWS; bf16_t* K_rm = B_rm + 64 * RWS;
    bf16_t* B_tr = K_rm + 64 * RWS; bf16_t* K_tr = B_tr + 64 * RWS; bf16_t* V_tr = K_tr + 64 * RWS;
    bf16_t* MAK = V_tr + 64 * RWS; bf16_t* MRB = MAK + 64 * RWS; bf16_t* MRK = MRB + 64 * RWS;
    bf16_t* MABr = MRK + 64 * RWS;
    float* RHS = (float*)(MABr + 64 * RWS);
    float* BT = RHS + 8192; float* OFF = BT + 512; float* GC = OFF + 512;
    bf16_t* X1_tr = A_rm; bf16_t* X2_tr = K_rm;
    for (int i = tid; i < 4 * 64 * RWS / 2; i += 512) ((unsigned*)MAK)[i] = 0u;
    __syncthreads();
    const int fr = lane & 15, fq = lane >> 4;
    for (int u = bid; u < RW_UNITS; u += G) {
        const int chain = u / RW_NCH, c = u - chain * RW_NCH, d = chain >> 4, b = (chain >> 3) & 1, h = chain & 7;
        const int t0 = tid >> 3, kp = (tid & 7) * 8;
        float lw[8], kk[8], ka[8], kd[8], rr[8]; u32x4 vv;
        {
            const int s = c * 64 + t0; const bool valid = s < LSEQ;
            const int p = d ? LSEQ - 1 - s : s; const size_t o = (size_t)rowof(b, valid ? p : 0) * 512 + h * 64 + kp;
            const u32x4 lwv = *(const u32x4*)(LW + (size_t)d * NT * 512 + o), kkv = *(const u32x4*)(KK + o), kav = *(const u32x4*)(KKA + (size_t)d * NT * 512 + o),
                        kdv = *(const u32x4*)(KD + (size_t)d * NT * 512 + o), rv = *(const u32x4*)(Rr + o);
            vv = *(const u32x4*)(VV + o);
#pragma unroll
            for (int i = 0; i < 4; ++i) {
                union { unsigned u; _Float16 hh[2]; } cv; cv.u = lwv[i];
                lw[2 * i] = valid ? (float)cv.hh[0] : 0.f; lw[2 * i + 1] = valid ? (float)cv.hh[1] : 0.f;
                kk[2 * i] = valid ? bflo(kkv[i]) : 0.f; kk[2 * i + 1] = valid ? bfhi(kkv[i]) : 0.f;
                ka[2 * i] = valid ? bflo(kav[i]) : 0.f; ka[2 * i + 1] = valid ? bfhi(kav[i]) : 0.f;
                kd[2 * i] = valid ? bflo(kdv[i]) : 0.f; kd[2 * i + 1] = valid ? bfhi(kdv[i]) : 0.f;
                rr[2 * i] = valid ? bflo(rv[i]) : 0.f; rr[2 * i + 1] = valid ? bfhi(rv[i]) : 0.f;
                if (!valid) vv[i] = 0u;
            }
        }
        *(f32x4*)(Gs + t0 * 64 + kp) = (f32x4){lw[0], lw[1], lw[2], lw[3]}; *(f32x4*)(Gs + t0 * 64 + kp + 4) = (f32x4){lw[4], lw[5], lw[6], lw[7]};
        __syncthreads();
        { const int k = tid & 63, w = tid >> 6; float acc = 0.f;
#pragma unroll
          for (int i = 0; i < 8; ++i) { acc += Gs[(8 * w + i) * 64 + k]; Gs[(8 * w + i) * 64 + k] = acc; }
          BT[w * 64 + k] = acc; }
        __syncthreads();
        { const int k = tid & 63, w = tid >> 6; float off = 0.f; for (int w2 = 0; w2 < w; ++w2) off += BT[w2 * 64 + k]; OFF[w * 64 + k] = off; }
        __syncthreads();
        {
            float va[8], vr[8], vb[8], vk[8];
#pragma unroll
            for (int i = 0; i < 8; ++i) {
                const float g = Gs[t0 * 64 + kp + i] + OFF[(t0 >> 3) * 64 + kp + i];
                const float eg = __expf(g), egm1 = __expf(g - lw[i]), einv = __expf(-g);
                va[i] = kk[i] * egm1; vr[i] = rr[i] * eg; vb[i] = ka[i] * einv; vk[i] = kd[i] * einv;
                if (t0 == 63) GC[kp + i] = eg;
            }
            *(f32x4*)(RHS + t0 * 128 + kp) = (f32x4){va[0], va[1], va[2], va[3]}; *(f32x4*)(RHS + t0 * 128 + kp + 4) = (f32x4){va[4], va[5], va[6], va[7]};
            u32x4 w4;
            w4.x = pk2(va[0], va[1]); w4.y = pk2(va[2], va[3]); w4.z = pk2(va[4], va[5]); w4.w = pk2(va[6], va[7]); *(u32x4*)(A_rm + t0 * RWS + kp) = w4;
            w4.x = pk2(vr[0], vr[1]); w4.y = pk2(vr[2], vr[3]); w4.z = pk2(vr[4], vr[5]); w4.w = pk2(vr[6], vr[7]); *(u32x4*)(R_rm + t0 * RWS + kp) = w4;
            w4.x = pk2(vb[0], vb[1]); w4.y = pk2(vb[2], vb[3]); w4.z = pk2(vb[4], vb[5]); w4.w = pk2(vb[6], vb[7]); *(u32x4*)(B_rm + t0 * RWS + kp) = w4;
            w4.x = pk2(vk[0], vk[1]); w4.y = pk2(vk[2], vk[3]); w4.z = pk2(vk[4], vk[5]); w4.w = pk2(vk[6], vk[7]); *(u32x4*)(K_rm + t0 * RWS + kp) = w4;
#pragma unroll
            for (int i = 0; i < 8; ++i) { B_tr[(kp + i) * RWS + t0] = (bf16_t)f2bf(vb[i]); K_tr[(kp + i) * RWS + t0] = (bf16_t)f2bf(vk[i]);
                V_tr[(kp + i) * RWS + t0] = (bf16_t)((i & 1) ? (vv[i >> 1] >> 16) : (vv[i >> 1] & 0xffffu)); }
        }
        __syncthreads();
        float* DQ = Gs; bf16_t* TB = (bf16_t*)BT;
#ifndef RW1_REP1
#define RW1_REP1 1
#endif
        for (int rep_ = 0; rep_ < RW1_REP1; ++rep_)
        for (int q = wave; q < 40; q += 8) {
            const int m = q / 10, e = q - m * 10, ti = e >= 6 ? 3 : (e >= 3 ? 2 : (e >= 1 ? 1 : 0)), tj = e - (ti * (ti + 1)) / 2;
            const f32x4 acc = rw_tile(m < 2 ? A_rm : R_rm, 16 * ti, (m & 1) ? K_rm : B_rm, 16 * tj, fr, fq);
            bf16_t* Mm = m == 1 ? MAK : (m == 2 ? MRB : MRK);
#pragma unroll
            for (int j = 0; j < 4; ++j) { const int t = 16 * ti + 4 * fq + j, i = 16 * tj + fr; const bool keep = m < 2 ? (i < t) : (i <= t); const float val = keep ? acc[j] : 0.f;
                if (m == 0) { MABr[t * RWS + i] = (bf16_t)f2bf(val); if (ti == tj) DQ[((ti * 16 + (t & 15)) * 4 + (fr & 3)) * 4 + (fr >> 2)] = val; }
                else Mm[t * RWS + i] = (bf16_t)f2bf(val); }
        }
        __syncthreads();
        if (wave >= 4) {
            for (int q = wave - 4; q < 16; q += 4) { const int ti = q >> 2, tv = q & 3; const f32x4 acc = rw_tile(MAK, 16 * ti, V_tr, 16 * tv, fr, fq);
#pragma unroll
                for (int j = 0; j < 4; ++j) RHS[(16 * ti + 4 * fq + j) * 128 + 64 + 16 * tv + fr] = acc[j]; }
        } else {
            const int bb = wave, cc = lane >> 2, q = lane & 3;
            float xs[4] = {0.f, 0.f, 0.f, 0.f};
#pragma unroll
            for (int tl = 0; tl < 16; ++tl) {
                const f32x4 mv = *(const f32x4*)(DQ + ((bb * 16 + tl) * 4 + q) * 4);
                float part = mv[0] * xs[0] + mv[1] * xs[1] + mv[2] * xs[2] + mv[3] * xs[3];
                part += dppf<0xB1>(part); part += dppf<0x4E>(part);
                const float xt = (tl == cc ? 1.f : 0.f) - part;
                xs[tl >> 2] = (tl & 3) == q ? xt : xs[tl >> 2];
            }
#pragma unroll
            for (int m = 0; m < 4; ++m) TB[(bb * 16 + 4 * m + q) * 16 + cc] = (bf16_t)f2bf(xs[m]);
        }
        __syncthreads();
        {
            const int c0 = 16 * wave;
            f32x4 X[4];
            const f32x4 zero4 = (f32x4){0.f, 0.f, 0.f, 0.f};
#define RW1_PACK(lo_, hi_, v_) do { union { bf16x8 v; unsigned u[4]; } t_; t_.u[0] = pk2(lo_[0], lo_[1]); t_.u[1] = pk2(lo_[2], lo_[3]); t_.u[2] = pk2(hi_[0], hi_[1]); t_.u[3] = pk2(hi_[2], hi_[3]); v_ = t_.v; } while (0)
#define RW1_LDA(base_, row0_, ca_, cb_, useb_, v_) do { union { bf16x8 v; u32x2 h2[2]; } t_; t_.h2[0] = *(const u32x2*)((base_) + ((row0_) + fr) * RWS + (ca_) + 4 * fq); \
            t_.h2[1] = (useb_) ? *(const u32x2*)((base_) + ((row0_) + fr) * RWS + (cb_) + 4 * fq) : (u32x2){0u, 0u}; v_ = t_.v; } while (0)
#pragma unroll
            for (int bq = 0; bq < 4; ++bq) {
                f32x4 acc;
#pragma unroll
                for (int j = 0; j < 4; ++j) acc[j] = -RHS[(16 * bq + 4 * fq + j) * 128 + c0 + fr];
                bf16x8 af, bfv;
                if (bq >= 1) { RW1_LDA(MABr, 16 * bq, 0, 16, bq >= 2, af); if (bq >= 2) RW1_PACK(X[0], X[1], bfv); else RW1_PACK(X[0], zero4, bfv);
                    acc = __builtin_amdgcn_mfma_f32_16x16x32_bf16(af, bfv, acc, 0, 0, 0); }
                if (bq == 3) { RW1_LDA(MABr, 48, 32, 0, false, af); RW1_PACK(X[2], zero4, bfv); acc = __builtin_amdgcn_mfma_f32_16x16x32_bf16(af, bfv, acc, 0, 0, 0); }
                const f32x4 wv = (f32x4){-acc[0], -acc[1], -acc[2], -acc[3]};
                { union { bf16x8 v; u32x2 h2[2]; } t_; t_.h2[0] = *(const u32x2*)(TB + (bq * 16 + fr) * 16 + 4 * fq); t_.h2[1] = (u32x2){0u, 0u}; af = t_.v; }
                RW1_PACK(wv, zero4, bfv);
                X[bq] = __builtin_amdgcn_mfma_f32_16x16x32_bf16(af, bfv, zero4, 0, 0, 0);
                bf16_t* Xm = (wave < 4 ? X1_tr : X2_tr) + ((c0 & 63) + fr) * RWS + 16 * bq + 4 * fq;
                u32x2 o; o.x = pk2(X[bq][0], X[bq][1]); o.y = pk2(X[bq][2], X[bq][3]);
                *(u32x2*)Xm = o;
            }
#undef RW1_PACK
#undef RW1_LDA
        }
        __syncthreads();
#ifndef RW1_REP5
#define RW1_REP5 1
#endif
        for (int rep_ = 0; rep_ < RW1_REP5; ++rep_)
        for (int q = wave; q < 64; q += 8) {
            const int kind = q >> 4, ta = (q >> 2) & 3, tb = q & 3;
            u32x2 o;
            if (kind == 0) {
                const f32x4 acc = rw_tile(X1_tr, 16 * ta, B_tr, 16 * tb, fr, fq);
                const int k = 16 * tb + fr, kq = 16 * ta + 4 * fq; const float gc = GC[k];
                float v[4];
#pragma unroll
                for (int j = 0; j < 4; ++j) v[j] = gc * ((kq + j == k ? 1.f : 0.f) - acc[j]);
                o.x = pk2(v[0], v[1]); o.y = pk2(v[2], v[3]);
                *(u32x2*)(PP + (size_t)u * 4096 + k * 64 + 32 * (ta >> 1) + 8 * fq + 4 * (ta & 1)) = o;
            } else if (kind == 1) {
                const f32x4 acc = rw_tile(X1_tr, 16 * ta, MRB, 16 * tb, fr, fq);
                const int t = 16 * tb + fr, k0 = 16 * ta + 4 * fq;
                const u32x2 rv = *(const u32x2*)(R_rm + t * RWS + k0);
                o.x = pk2(bflo(rv.x) - acc[0], bfhi(rv.x) - acc[1]); o.y = pk2(bflo(rv.y) - acc[2], bfhi(rv.y) - acc[3]);
                *(u32x2*)(YT + (size_t)u * 4096 + t * 64 + 32 * (ta >> 1) + 8 * fq + 4 * (ta & 1)) = o;
            } else if (kind == 2) {
                const f32x4 a1 = rw_tile(K_tr, 16 * ta, V_tr, 16 * tb, fr, fq), a2 = rw_tile(B_tr, 16 * ta, X2_tr, 16 * tb, fr, fq);
                const int v_ = 16 * tb + fr, k0 = 16 * ta + 4 * fq;
                const f32x4 gc = *(const f32x4*)(GC + k0);
                o.x = pk2(gc[0] * (a1[0] - a2[0]), gc[1] * (a1[1] - a2[1])); o.y = pk2(gc[2] * (a1[2] - a2[2]), gc[3] * (a1[3] - a2[3]));
                *(u32x2*)(QT + (size_t)u * 4096 + v_ * 64 + k0) = o;
            } else {
                const f32x4 a1 = rw_tile(MRK, 16 * ta, V_tr, 16 * tb, fr, fq), a2 = rw_tile(MRB, 16 * ta, X2_tr, 16 * tb, fr, fq);
                const int v_ = 16 * tb + fr, t0_ = 16 * ta + 4 * fq;
                o.x = pk2(a1[0] - a2[0], a1[1] - a2[1]); o.y = pk2(a1[2] - a2[2], a1[3] - a2[3]);
                *(u32x2*)(ZT + (size_t)u * 4096 + v_ * 64 + t0_) = o;
            }
        }
        __syncthreads();
    }
}

__device__ __forceinline__ void phase_60(CParams& P, unsigned char* lds, const int ph) {
    PHASE_PROLOGUE
    if (bid < 32) {
        const int chain = bid, d = chain >> 4, b = (chain >> 3) & 1, h = chain & 7;
        const int fr = lane & 15, fq = lane >> 4;
        constexpr int MATB = 64 * RWS * 2, SLOT = 4 * MATB;
        const bool comp = wave < 4; const int vb = wave & 3, lm = wave & 3;
        const unsigned char* src = (const unsigned char*)(lm == 0 ? PP : (lm == 1 ? YT : (lm == 2 ? QT : ZT))) + (size_t)chain * RW_NCH * 8192 + lane * 16;
        u32x4 R0[8], R1[8], R2[8];
#define RW2_LD(Rx, c_) do { _Pragma("unroll") for (int i_ = 0; i_ < 8; ++i_) Rx[i_] = *(const u32x4*)(src + (size_t)(c_) * 8192 + i_ * 1024); } while (0)
#define RW2_ST(Rx, c_) do { unsigned char* dst_ = lds + ((c_) & 3) * SLOT + lm * MATB; _Pragma("unroll") for (int i_ = 0; i_ < 8; ++i_) { const int p_ = lane + 64 * i_; *(u32x4*)(dst_ + (p_ >> 3) * (RWS * 2) + (p_ & 7) * 16) = Rx[i_]; } } while (0)
        const f32x4 zero4 = (f32x4){0.f, 0.f, 0.f, 0.f};
        f32x4 S[4] = {zero4, zero4, zero4, zero4};
#define RW2_COMPUTE(c_) do { const bf16_t* sl_ = (const bf16_t*)(lds + ((c_) & 3) * SLOT); const bf16_t* sP = sl_; const bf16_t* sY = sl_ + 64 * RWS; const bf16_t* sQ = sl_ + 2 * 64 * RWS; const bf16_t* sZ = sl_ + 3 * 64 * RWS; \
            union { bf16x8 v; unsigned u[4]; } bs[2]; \
            _Pragma("unroll") for (int ks = 0; ks < 2; ++ks) { bs[ks].u[0] = pk2(S[2 * ks][0], S[2 * ks][1]); bs[ks].u[1] = pk2(S[2 * ks][2], S[2 * ks][3]); \
                bs[ks].u[2] = pk2(S[2 * ks + 1][0], S[2 * ks + 1][1]); bs[ks].u[3] = pk2(S[2 * ks + 1][2], S[2 * ks + 1][3]); } \
            _Pragma("unroll") for (int tt = 0; tt < 4; ++tt) { \
                const u32x2 z2 = *(const u32x2*)(sZ + (16 * vb + fr) * RWS + 16 * tt + 4 * fq); \
                f32x4 acc = (f32x4){bflo(z2.x), bfhi(z2.x), bflo(z2.y), bfhi(z2.y)}; \
                acc = __builtin_amdgcn_mfma_f32_16x16x32_bf16(*(const bf16x8*)(sY + (16 * tt + fr) * RWS + 8 * fq), bs[0].v, acc, 0, 0, 0); \
                acc = __builtin_amdgcn_mfma_f32_16x16x32_bf16(*(const bf16x8*)(sY + (16 * tt + fr) * RWS + 32 + 8 * fq), bs[1].v, acc, 0, 0, 0); \
                _Pragma("unroll") for (int j = 0; j < 4; ++j) { const int s_ = (c_) * 64 + 16 * tt + 4 * fq + j; \
                    if (s_ < LSEQ) { const int p_ = d ? LSEQ - 1 - s_ : s_; YFB[((size_t)d * NT + rowof(b, p_)) * 512 + h * 64 + 16 * vb + fr] = (bf16_t)f2bf(acc[j]); } } } \
            f32x4 Sn[4]; \
            _Pragma("unroll") for (int kt = 0; kt < 4; ++kt) { \
                const u32x2 q2 = *(const u32x2*)(sQ + (16 * vb + fr) * RWS + 16 * kt + 4 * fq); \
                f32x4 acc = (f32x4){bflo(q2.x), bfhi(q2.x), bflo(q2.y), bfhi(q2.y)}; \
                acc = __builtin_amdgcn_mfma_f32_16x16x32_bf16(*(const bf16x8*)(sP + (16 * kt + fr) * RWS + 8 * fq), bs[0].v, acc, 0, 0, 0); \
                acc = __builtin_amdgcn_mfma_f32_16x16x32_bf16(*(const bf16x8*)(sP + (16 * kt + fr) * RWS + 32 + 8 * fq), bs[1].v, acc, 0, 0, 0); \
                Sn[kt] = acc; } \
            _Pragma("unroll") for (int kt = 0; kt < 4; ++kt) S[kt] = Sn[kt]; } while (0)
        if (!comp) { RW2_LD(R0, 0); RW2_ST(R0, 0); RW2_LD(R0, 1); RW2_LD(R1, 2); RW2_LD(R2, 3); }
        __syncthreads();
#define RW2_BAR() do { asm volatile("s_waitcnt lgkmcnt(0)" ::: "memory"); __builtin_amdgcn_s_barrier(); asm volatile("" ::: "memory"); } while (0)
        for (int c = 0; c < RW_NCH; c += 3) {
            if (!comp) { if (c + 1 < RW_NCH) RW2_ST(R0, c + 1); if (c + 4 < RW_NCH) RW2_LD(R0, c + 4); } else RW2_COMPUTE(c);
            RW2_BAR();
            if (!comp) { if (c + 2 < RW_NCH) RW2_ST(R1, c + 2); if (c + 5 < RW_NCH) RW2_LD(R1, c + 5); } else RW2_COMPUTE(c + 1);
            RW2_BAR();
            if (!comp) { if (c + 3 < RW_NCH) RW2_ST(R2, c + 3); if (c + 6 < RW_NCH) RW2_LD(R2, c + 6); } else RW2_COMPUTE(c + 2);
            RW2_BAR();
        }
#undef RW2_LD
#undef RW2_ST
#undef RW2_COMPUTE
#undef RW2_BAR
    }
}

__device__ __forceinline__ void phase_7(CParams& P, unsigned char* lds, const int ph) {
    PHASE_PROLOGUE
            for (int row = gw; row < NT; row += NGW) {
                const int c0 = lane * 8;
                const u32x4 yf = *(const u32x4*)(YFB + (size_t)row * 512 + c0);
                const u32x4 yb = *(const u32x4*)(YFB + ((size_t)NT + row) * 512 + c0);
                const u32x4 vv = *(const u32x4*)(VV + (size_t)row * 512 + c0);
                const u32x4 gg = *(const u32x4*)(Gg + (size_t)row * 512 + c0);
                float y[8], v[8], g[8];
#pragma unroll
                for (int i = 0; i < 4; ++i) { y[2 * i] = bflo(yf[i]) + bflo(yb[i]); y[2 * i + 1] = bfhi(yf[i]) + bfhi(yb[i]); v[2 * i] = bflo(vv[i]); v[2 * i + 1] = bfhi(vv[i]); g[2 * i] = bflo(gg[i]); g[2 * i + 1] = bfhi(gg[i]); }
                float sm = 0.f;
#pragma unroll
                for (int i = 0; i < 8; ++i) sm += y[i];
                sm += __shfl_xor(sm, 1); sm += __shfl_xor(sm, 2); sm += __shfl_xor(sm, 4);
                const float mean = sm * (1.f / 64.f);
                float vr = 0.f;
#pragma unroll
                for (int i = 0; i < 8; ++i) { const float dlt = y[i] - mean; vr += dlt * dlt; }
                vr += __shfl_xor(vr, 1); vr += __shfl_xor(vr, 2); vr += __shfl_xor(vr, 4);
                const float rstd = rsqrtf(vr * (1.f / 64.f) + 64e-5f);
                const float bc = BC[(size_t)row * 8 + (lane >> 3)];
                float o[8];
#pragma unroll
                for (int i = 0; i < 8; ++i) o[i] = ((y[i] - mean) * rstd * lnx_g[c0 + i] + lnx_b[c0 + i] + bc * v[i]) * g[i];
                u32x4 ov; ov.x = pk2(o[0], o[1]); ov.y = pk2(o[2], o[3]); ov.z = pk2(o[4], o[5]); ov.w = pk2(o[6], o[7]);
                *(u32x4*)(A2 + (size_t)row * DM + 512 + c0) = ov;
            }
}


__device__ __forceinline__ void phase_8(CParams& P, unsigned char* lds, const int ph) {
    PHASE_PROLOGUE
    if (gw < 64) meta_gemm<0>(A2 + (size_t)NMAIN * DM, WTOUT, H + (size_t)NMAIN * DM, gw, lane);
    pg8::DenseOrder S; S.init(A2, WTOUT, NMAIN, DM, DM, G, bid);
    pg8::EpiResidual E{H};
    pg8::gemm_phase<pg8::EpiResidual, pg8::DenseOrder, true, true>((PG8_LAS unsigned char*)lds, DM, S, E);
}

__device__ __forceinline__ void phase_9(CParams& P, unsigned char* lds, const int ph) {
    PHASE_PROLOGUE
            const int l = ph == 9 ? 0 : 1;
                    unsigned* cnt = CTL + CW_CNT(l);
            const float* wg = moe_wg + (size_t)l * DM * 4; const float* bg = moe_bg + l * 4;
            for (int row = gw; row < NT; row += NGW) {
                f32x4 v[4]; float ss = 0.f;
#pragma unroll
                for (int j = 0; j < 4; ++j) { v[j] = ((const f32x4*)(H + (size_t)row * DM))[lane + 64 * j]; ss += v[j][0] * v[j][0] + v[j][1] * v[j][1] + v[j][2] * v[j][2] + v[j][3] * v[j][3]; }
                ss = wave_sum(ss);
                const float rstd = rsqrtf(ss * (1.f / DM) + 1e-6f);
                float lg[4] = {0.f, 0.f, 0.f, 0.f};
#pragma unroll
                for (int j = 0; j < 4; ++j) {
                    const f32x4 g = ((const f32x4*)(norm_ffn + l * DM))[lane + 64 * j];
#pragma unroll
                    for (int i = 0; i < 4; ++i) v[j][i] = v[j][i] * rstd * g[i];
                    u32x2 o; o.x = pk2(v[j][0], v[j][1]); o.y = pk2(v[j][2], v[j][3]);
                    ((u32x2*)(HN + (size_t)row * DM))[lane + 64 * j] = o;
#pragma unroll
                    for (int i = 0; i < 4; ++i) { const f32x4 w = *(const f32x4*)(wg + (size_t)(4 * (lane + 64 * j) + i) * 4);
                        lg[0] += v[j][i] * w[0]; lg[1] += v[j][i] * w[1]; lg[2] += v[j][i] * w[2]; lg[3] += v[j][i] * w[3]; }
                }
#pragma unroll
                for (int q = 0; q < 4; ++q) lg[q] = wave_sum(lg[q]) + bg[q];
                int grp = 0; float mx = lg[0];
#pragma unroll
                for (int q = 1; q < 4; ++q) if (lg[q] > mx) { mx = lg[q]; grp = q; }
                float den = 0.f;
#pragma unroll
                for (int q = 0; q < 4; ++q) den += __expf(lg[q] - mx);
                const float pgrp = 1.f / den;
                const float* we = moe_we + ((size_t)(l * 4 + grp) * DM) * 8;
                float le[8] = {0.f, 0.f, 0.f, 0.f, 0.f, 0.f, 0.f, 0.f};
#pragma unroll
                for (int j = 0; j < 4; ++j)
#pragma unroll
                    for (int i = 0; i < 4; ++i) { const float* wr_ = we + (size_t)(4 * (lane + 64 * j) + i) * 8; const f32x4 wa = *(const f32x4*)wr_, wb = *(const f32x4*)(wr_ + 4);
                        le[0] += v[j][i] * wa[0]; le[1] += v[j][i] * wa[1]; le[2] += v[j][i] * wa[2]; le[3] += v[j][i] * wa[3];
                        le[4] += v[j][i] * wb[0]; le[5] += v[j][i] * wb[1]; le[6] += v[j][i] * wb[2]; le[7] += v[j][i] * wb[3]; }
#pragma unroll
                for (int q = 0; q < 8; ++q) le[q] = wave_sum(le[q]) + moe_be[(l * 4 + grp) * 8 + q];
                int i1 = 0; float m1 = le[0];
#pragma unroll
                for (int q = 1; q < 8; ++q) if (le[q] > m1) { m1 = le[q]; i1 = q; }
                int i2 = (i1 + 1) & 7; float m2 = -3.0e38f;
#pragma unroll
                for (int q = 0; q < 8; ++q) if (q != i1 && le[q] > m2) { m2 = le[q]; i2 = q; }
                const float e2 = __expf(m2 - m1);
                const float g1 = pgrp / (1.f + e2), g2 = pgrp * e2 / (1.f + e2);
                if (lane == 0) {
                    const int ea = grp * 8 + i1, eb = grp * 8 + i2;
                    const unsigned pa = atomicAdd(cnt + ea, 1u), pb = atomicAdd(cnt + eb, 1u);
                    EID[row * 2] = ea; EID[row * 2 + 1] = eb; POS[row * 2] = (int)pa; POS[row * 2 + 1] = (int)pb;
                    GATE[row * 2] = g1; GATE[row * 2 + 1] = g2;
                }
            }
    for (int it = gw; it < CONV_MOE_ITEMS; it += NGW) conv_moe_item(P, l, it, lane);
}


__device__ __forceinline__ void phase_10(CParams& P, unsigned char* lds, const int ph) {
    PHASE_PROLOGUE
    const int l = ph == 10 ? 0 : 1;
    int* ps = (int*)(lds + LDS_TAB);
    if (tid == 0) { int acc_ = 0; for (int e = 0; e < NEXP; ++e) { ps[e] = acc_; const int c = (int)CTL[CW_CNT(l) + e]; acc_ += (c + MOE_RT - 1) / MOE_RT * MOE_RT; } ps[NEXP] = acc_; }
    __syncthreads();
    for (int row = gw; row < NT; row += NGW) {
        const u32x4 v0 = ((const u32x4*)(HN + (size_t)row * DM))[lane], v1 = ((const u32x4*)(HN + (size_t)row * DM))[lane + 64];
#pragma unroll
        for (int k = 0; k < 2; ++k) {
            const int dest = ps[EID[row * 2 + k]] + POS[row * 2 + k];
            if (lane == 0) DEST[row * 2 + k] = dest;
            ((u32x4*)(XB + (size_t)dest * DM))[lane] = v0; ((u32x4*)(XB + (size_t)dest * DM))[lane + 64] = v1;
        }
    }
    __syncthreads();
}

__device__ __forceinline__ void phase_11(CParams& P, unsigned char* lds, const int ph) {
    PHASE_PROLOGUE
    const int l = ph == 11 ? 0 : 1;
    int* et = (int*)(lds + LDS_TAB);
    if (tid == 0) { int acc_ = 0; for (int e = 0; e < NEXP; ++e) { const int c = (int)CTL[CW_CNT(l) + e], n = (c + MOE_RT - 1) / MOE_RT; for (int q = 0; q < n; ++q) et[1 + acc_ + q] = e; acc_ += n; } et[0] = acc_; }
    __syncthreads();
    pg8::MoeOrder S{et + 1, et[0], vcu, (const char*)XB, (const char*)WT13, 256u * DM * 2u, 256u * DM * 2u, (unsigned)DM * DM * 2u};
    pg8::EpiSwiglu E{HB};
    pg8::gemm_phase<pg8::EpiSwiglu, pg8::MoeOrder, true, true>((PG8_LAS unsigned char*)lds, DM, S, E);
    __syncthreads();
}

__device__ __forceinline__ void phase_12(CParams& P, unsigned char* lds, const int ph) {
    PHASE_PROLOGUE
    const int l = ph == 12 ? 0 : 1;
    int* et = (int*)(lds + LDS_TAB);
    if (tid == 0) { int acc_ = 0; for (int e = 0; e < NEXP; ++e) { const int c = (int)CTL[CW_CNT(l) + e], n = (c + MOE_RT - 1) / MOE_RT; for (int q = 0; q < n; ++q) et[1 + acc_ + q] = e; acc_ += n; } et[0] = acc_; }
    __syncthreads();
    pg8::MoeOrder S{et + 1, et[0], vcu, (const char*)HB, (const char*)WT2, 256u * DFF * 2u, 256u * DFF * 2u, (unsigned)DM * DFF * 2u};
    pg8::EpiBf16Plain E{YB, DM};
    pg8::gemm_phase<pg8::EpiBf16Plain, pg8::MoeOrder, true, true>((PG8_LAS unsigned char*)lds, DFF, S, E);
    __syncthreads();
}

__device__ __forceinline__ void phase_13(CParams& P, unsigned char* lds, const int ph) {
    PHASE_PROLOGUE
            const bool fin = ph == 21;
            for (int row = gw; row < NT; row += NGW) {
                const int d0 = DEST[row * 2], d1 = DEST[row * 2 + 1];
                const float g0 = GATE[row * 2], g1 = GATE[row * 2 + 1];
                f32x4 v[4];
#pragma unroll
                for (int j = 0; j < 4; ++j) {
                    v[j] = ((const f32x4*)(H + (size_t)row * DM))[lane + 64 * j];
                    const u32x2 ya = ((const u32x2*)(YB + (size_t)d0 * DM))[lane + 64 * j];
                    const u32x2 yb = ((const u32x2*)(YB + (size_t)d1 * DM))[lane + 64 * j];
                    v[j][0] += g0 * bflo(ya.x) + g1 * bflo(yb.x); v[j][1] += g0 * bfhi(ya.x) + g1 * bfhi(yb.x);
                    v[j][2] += g0 * bflo(ya.y) + g1 * bflo(yb.y); v[j][3] += g0 * bfhi(ya.y) + g1 * bfhi(yb.y);
                }
                if (!fin) {
#pragma unroll
                    for (int j = 0; j < 4; ++j) ((f32x4*)(H + (size_t)row * DM))[lane + 64 * j] = v[j];
                    store_norm_bf16(v, norm_mix + DM, HN + (size_t)row * DM, lane);
                } else if (row < NMAIN) {
                    float ss = 0.f;
#pragma unroll
                    for (int j = 0; j < 4; ++j) ss += v[j][0] * v[j][0] + v[j][1] * v[j][1] + v[j][2] * v[j][2] + v[j][3] * v[j][3];
                    ss = wave_sum(ss);
                    const float rstd = rsqrtf(ss * (1.f / DM) + 1e-6f);
#pragma unroll
                    for (int j = 0; j < 4; ++j) { const f32x4 g = ((const f32x4*)norm_final)[lane + 64 * j]; f32x4 o;
                        o[0] = v[j][0] * rstd * g[0]; o[1] = v[j][1] * rstd * g[1]; o[2] = v[j][2] * rstd * g[2]; o[3] = v[j][3] * rstd * g[3];
                        ((f32x4*)(P.out + (size_t)row * DM))[lane + 64 * j] = o; }
                }
            }
}

__device__ __forceinline__ void phase_14(CParams& P, unsigned char* lds, const int ph) {
    PHASE_PROLOGUE
    float* pwr = (float*)lds; float* pwi = pwr + 2176; float* bbr = pwi + 2176; float* bbi = bbr + 2048; float* ccr = bbi + 2048; float* cci = ccr + 2048; float* kf = cci + 2048; float* kb = kf + 4096;
    for (int g = bid; g < 64; g += G) {
        if (tid < 128) {
            const int d = tid >> 6, p = tid & 63;
            const float step = __expf(s5_ls[d * 64 + g]);
            const float lr = s5_lre[(d * 64 + g) * 64 + p], li = s5_lim[(d * 64 + g) * 64 + p];
            const float mag = expf(lr * step);
            const float abr = mag * cosf(li * step), abi = mag * sinf(li * step);
            const float den = lr * lr + li * li;
            const float zr = ((abr - 1.f) * lr + abi * li) / den, zi = (abi * lr - (abr - 1.f) * li) / den;
            float pr = 1.f, pi = 0.f;
            for (int t = 0; t < 17; ++t) { pwr[(d * 64 + p) * 17 + t] = pr; pwi[(d * 64 + p) * 17 + t] = pi; const float nr = pr * abr - pi * abi; pi = pr * abi + pi * abr; pr = nr; }
            for (int i = 0; i < 16; ++i) { const float br = s5_b_re[((size_t)(g * 64 + p)) * 16 + i], bi = s5_b_im[((size_t)(g * 64 + p)) * 16 + i];
                bbr[(d * 64 + p) * 16 + i] = zr * br - zi * bi; bbi[(d * 64 + p) * 16 + i] = zr * bi + zi * br; }
        }
        for (int idx = tid; idx < 2048; idx += 512) { const int d = idx >> 10, i = (idx >> 6) & 15, p = idx & 63;
            ccr[idx] = s5_c_re[((size_t)(d * 64 + g) * 16 + i) * 64 + p]; cci[idx] = s5_c_im[((size_t)(d * 64 + g) * 16 + i) * 64 + p]; }
        __syncthreads();
        {
            const int d = tid >> 8, tau = (tid >> 4) & 15, i = tid & 15;
            float acc[16];
#pragma unroll
            for (int q = 0; q < 16; ++q) acc[q] = 0.f;
            for (int p = 0; p < 64; ++p) {
                const float cr = ccr[(d * 16 + i) * 64 + p], ci = cci[(d * 16 + i) * 64 + p], pr = pwr[(d * 64 + p) * 17 + tau], pi = pwi[(d * 64 + p) * 17 + tau];
                const float xr = cr * pr - ci * pi, xi = cr * pi + ci * pr;
#pragma unroll
                for (int q = 0; q < 16; ++q) acc[q] += xr * bbr[(d * 64 + p) * 16 + q] - xi * bbi[(d * 64 + p) * 16 + q];
            }
            float* kt = (d ? kb : kf) + (tau * 16 + i) * 16;
#pragma unroll
            for (int q = 0; q < 16; ++q) kt[q] = acc[q];
        }
        __syncthreads();
        unsigned* bta = (unsigned*)(BTA + (size_t)g * 512 * 256);
        for (int idx = tid; idx < 512 * 128; idx += 512) {
            const int row = idx >> 7, col = (idx & 127) * 2;
            float v[2];
#pragma unroll
            for (int e = 0; e < 2; ++e) {
                const int cc_ = col + e, j = cc_ >> 4, ip = cc_ & 15;
                if (row < 256) { const int t = row >> 4, i = row & 15;
                    v[e] = j < t ? kf[((t - j) * 16 + i) * 16 + ip] : (j > t ? kb[((j - t) * 16 + i) * 16 + ip] : kf[i * 16 + ip] + kb[i * 16 + ip]); }
                else { const int kp = row - 256, d = kp >> 7, part = (kp >> 6) & 1, p = kp & 63, tau = d == 0 ? 15 - j : j;
                    const float pr = pwr[(d * 64 + p) * 17 + tau], pi = pwi[(d * 64 + p) * 17 + tau], br = bbr[(d * 64 + p) * 16 + ip], bi = bbi[(d * 64 + p) * 16 + ip];
                    v[e] = part ? pr * bi + pi * br : pr * br - pi * bi; }
            }
            bta[idx] = pk2(v[0], v[1]);
        }
        unsigned* btc = (unsigned*)(BTC + (size_t)g * 256 * 256);
        for (int idx = tid; idx < 256 * 128; idx += 512) {
            const int row = idx >> 7, col = (idx & 127) * 2, t = row >> 4, i = row & 15;
            float v[2];
#pragma unroll
            for (int e = 0; e < 2; ++e) {
                const int k = col + e, d = k >> 7, part = (k >> 6) & 1, p = k & 63, tau = d == 0 ? t + 1 : 16 - t;
                const float cr = ccr[(d * 16 + i) * 64 + p], ci = cci[(d * 16 + i) * 64 + p], pr = pwr[(d * 64 + p) * 17 + tau], pi = pwi[(d * 64 + p) * 17 + tau];
                v[e] = part ? -(cr * pi + ci * pr) : cr * pr - ci * pi;
            }
            btc[idx] = pk2(v[0], v[1]);
        }
        __syncthreads();
    }
}

__device__ __forceinline__ void phase_15(CParams& P, unsigned char* lds, const int ph) {
    PHASE_PROLOGUE
    pg8::S5OrderA S{vcu, (const char*)HN, (const char*)BTA};
    pg8::EpiS5A E{YI, S5E};
    int Kr = 256; asm volatile("" : "+s"(Kr));
    pg8::gemm_phase<pg8::EpiS5A, pg8::S5OrderA, true, true>((PG8_LAS unsigned char*)lds, Kr, S, E);
}

__device__ __forceinline__ void phase_16(CParams& P, unsigned char* lds, const int ph) {
    PHASE_PROLOGUE
    for (int i = bid * 512 + tid; i < NB * 64 * 2 * 64; i += G * 512) {
        const int p = i & 63, d = (i >> 6) & 1, g = (i >> 7) & 63, b = i >> 13;
        const float step = __expf(s5_ls[d * 64 + g]);
        const float lr = s5_lre[(d * 64 + g) * 64 + p], li = s5_lim[(d * 64 + g) * 64 + p];
        const float mag = expf(lr * step);
        const float abr = mag * cosf(li * step), abi = mag * sinf(li * step);
        float ar = 1.f, ai = 0.f;
        for (int t = 0; t < 16; ++t) { const float nr = ar * abr - ai * abi; ai = ar * abi + ai * abr; ar = nr; }
        const float* Ep = S5E + (size_t)g * 256 + d * 128 + p;
        bf16_t* Cp = CAR + (size_t)g * 1280 * 256 + d * 128 + p;
        float sr = 0.f, si = 0.f;
        for (int q0 = 0; q0 < 513; q0 += 9) {
            float er[9], ei[9]; int nn[9];
#pragma unroll
            for (int k = 0; k < 9; ++k) { const int q = q0 + k, c = d ? 512 - q : q; nn[k] = c == 0 ? 1024 + b : b * 512 + c - 1; er[k] = Ep[(size_t)nn[k] * 64 * 256]; ei[k] = Ep[(size_t)nn[k] * 64 * 256 + 64]; }
#pragma unroll
            for (int k = 0; k < 9; ++k) { Cp[(size_t)nn[k] * 256] = (bf16_t)f2bf(sr); Cp[(size_t)nn[k] * 256 + 64] = (bf16_t)f2bf(si);
                const float nr = ar * sr - ai * si + er[k]; si = ar * si + ai * sr + ei[k]; sr = nr; }
        }
    }
}

__device__ __forceinline__ void phase_22(CParams& P, unsigned char* lds, const int ph) {
    PHASE_PROLOGUE
    pg8::S5OrderC S{vcu, (const char*)CAR, (const char*)BTC};
    pg8::EpiS5C E{YI, HN, s5_d, A2};
    int Kr = 256; asm volatile("" : "+s"(Kr));
    pg8::gemm_phase<pg8::EpiS5C, pg8::S5OrderC, true, true>((PG8_LAS unsigned char*)lds, Kr, S, E);
}

__device__ __forceinline__ void phase_23(CParams& P, unsigned char* lds, const int ph) {
    PHASE_PROLOGUE
    if (gw < 64) meta_gemm<1>(A2 + (size_t)NMAIN * DM, WTGLU, H + (size_t)NMAIN * DM, gw, lane);
    pg8::DenseOrder S; S.init(A2, WTGLU, NMAIN, 2 * DM, DM, G, bid);
    pg8::EpiGlu E{H};
    pg8::gemm_phase<pg8::EpiGlu, pg8::DenseOrder, true, true>((PG8_LAS unsigned char*)lds, DM, S, E);
}
#define LAS __attribute__((address_space(3)))
#define CW_BAR 4096
#define XB_TMO      128
#define XB_XCNT(j)  (256  + 64 * (j))
#define XB_XSUB(j)  (1280 + 64 * (j))
#define XB_XGEN(j)  (2304 + 64 * (j))
#define XB_TOP      3328
#define XB_TOPGEN   3392
#define XCD_BAR_WORDS 3456
#define XB_SPIN_CAP (1u << 22)
__device__ __forceinline__ unsigned xb_ld(unsigned* p)              { return __hip_atomic_load(p, __ATOMIC_RELAXED, __HIP_MEMORY_SCOPE_AGENT); }
__device__ __forceinline__ unsigned xb_add(unsigned* p, unsigned v) { return __hip_atomic_fetch_add(p, v, __ATOMIC_RELAXED, __HIP_MEMORY_SCOPE_AGENT); }
__device__ __forceinline__ unsigned xb_xcc_id() { return (unsigned)__builtin_amdgcn_s_getreg((3 << 11) | 20) & 0xFu; }
#define XB_SPIN(cond, bar) do { unsigned _sp = 0; while (cond) { __builtin_amdgcn_s_sleep(1); \
    if ((++_sp & 255u) == 0u) { if (xb_ld(&(bar)[XB_TMO])) break; if (_sp > XB_SPIN_CAP) { atomicAdd(&(bar)[XB_TMO], 1u); break; } } } } while (0)
struct XcdBarrier { unsigned* bar; unsigned x; volatile LAS unsigned* st; };
__device__ __forceinline__ XcdBarrier xcd_barrier_post(unsigned* bar, volatile LAS unsigned* st) {
    XcdBarrier b; b.bar = bar; b.x = xb_xcc_id(); b.st = st;
    if (threadIdx.x == 0) (void)xb_add(&bar[XB_XCNT(b.x)], 1u);
    return b;
}
__device__ __forceinline__ void xcd_barrier_complete(unsigned* bar, unsigned x, unsigned& nloc, unsigned& nx) {
    const unsigned G = GRID;
    unsigned sum, cnt, mine, sp = 0u;
    for (;;) {
        sum = 0u; cnt = 0u; mine = 0u;
#pragma unroll
        for (unsigned j = 0; j < 16; ++j) { const unsigned c = xb_ld(&bar[XB_XCNT(j)]); sum += c; cnt += (c > 0u) ? 1u : 0u; mine = (j == x) ? c : mine; }
        if (sum == G) break;
        __builtin_amdgcn_s_sleep(1);
        if ((++sp & 255u) == 0u) { if (xb_ld(&bar[XB_TMO])) break; if (sp > XB_SPIN_CAP) { atomicAdd(&bar[XB_TMO], 1u); break; } }
    }
    nloc = mine > 0u ? mine : 1u; nx = cnt > 0u ? cnt : 1u;
}
__device__ __forceinline__ void xcd_barrier(const XcdBarrier& b) {
    asm volatile("s_waitcnt vmcnt(0)" ::: "memory");
    __syncthreads();
    if (threadIdx.x == 0) {
        unsigned* bar = b.bar;
        __builtin_amdgcn_s_waitcnt(0);
        unsigned nloc = b.st[0], nx = b.st[1];
        if (nloc == 0u) { xcd_barrier_complete(bar, b.x, nloc, nx); b.st[0] = nloc; b.st[1] = nx; }
        const unsigned old = xb_add(&bar[XB_XSUB(b.x)], 1u);
        const unsigned gen = old / nloc;
        if (old + 1u == (gen + 1u) * nloc) {
            __builtin_amdgcn_fence(__ATOMIC_RELEASE, "agent");
            asm volatile("s_waitcnt vmcnt(0)" ::: "memory");
            const unsigned og = xb_add(&bar[XB_TOP], 1u);
            const unsigned tg = og / nx;
            if (og + 1u == (tg + 1u) * nx) xb_add(&bar[XB_TOPGEN], 1u);
            else XB_SPIN(xb_ld(&bar[XB_TOPGEN]) == tg, bar);
            __builtin_amdgcn_fence(__ATOMIC_ACQUIRE, "agent");
            xb_add(&bar[XB_XGEN(b.x)], 1u);
            asm volatile("s_waitcnt vmcnt(0)" ::: "memory");
        } else {
            XB_SPIN(xb_ld(&bar[XB_XGEN(b.x)]) == gen, bar);
            __builtin_amdgcn_fence(__ATOMIC_ACQUIRE, "agent");
            asm volatile("s_waitcnt vmcnt(0)" ::: "memory");
        }
    }
    __syncthreads();
}


__global__ void __launch_bounds__(512, 2) mega(Params P_) {
    extern __shared__ __attribute__((aligned(16))) unsigned char lds[];
    volatile LAS unsigned* st = (volatile LAS unsigned*)(LAS unsigned char*)(lds + LDS_BARST);
    if (threadIdx.x < 16) st[threadIdx.x] = 0u;
    __syncthreads();
    CParams* pp = (CParams*)__builtin_amdgcn_kernarg_segment_ptr();
    (void)xcd_barrier_post((unsigned*)(pp->ws + WS_CTL) + CW_BAR, st);
#define GB do { XcdBarrier bar_; bar_.bar = (unsigned*)(pp->ws + WS_CTL) + CW_BAR; bar_.x = xb_xcc_id(); bar_.st = (volatile LAS unsigned*)(LAS unsigned char*)(lds + LDS_BARST); xcd_barrier(bar_); asm volatile("" : "+s"(pp)); } while (0)
#define P (*pp)
    asm volatile("" : "+s"(pp));
    phase_0(P, lds, 0); GB;
#if defined(PROBE_PH) && PROBE_PH == 0
    { int nrep = PROBE_N; asm volatile("" : "+s"(nrep)); for (int rep = 0; rep < nrep; ++rep) { GB; phase_0(P, lds, 0); GB; } }
#endif
    phase_1(P, lds, 1); GB;
#if defined(PROBE_PH) && PROBE_PH == 1
    { int nrep = PROBE_N; asm volatile("" : "+s"(nrep)); for (int rep = 0; rep < nrep; ++rep) { GB; phase_1(P, lds, 1); GB; } }
#endif
    phase_2(P, lds, 2); asm volatile("" : "+s"(pp));
#if defined(PROBE_PH) && PROBE_PH == 2
    { int nrep = PROBE_N; asm volatile("" : "+s"(nrep)); for (int rep = 0; rep < nrep; ++rep) { GB; phase_2(P, lds, 2); GB; } }
#endif
    phase_3(P, lds, 3); GB;
#if defined(PROBE_PH) && PROBE_PH == 3
    { int nrep = PROBE_N; asm volatile("" : "+s"(nrep)); for (int rep = 0; rep < nrep; ++rep) { GB; phase_3(P, lds, 3); GB; } }
#endif
    phase_4(P, lds, 4); GB;
#if defined(PROBE_PH) && PROBE_PH == 4
    { int nrep = PROBE_N; asm volatile("" : "+s"(nrep)); for (int rep = 0; rep < nrep; ++rep) { GB; phase_4(P, lds, 4); GB; } }
#endif
    phase_5(P, lds, 5); GB;
#if defined(PROBE_PH) && PROBE_PH == 5
    { int nrep = PROBE_N; asm volatile("" : "+s"(nrep)); for (int rep = 0; rep < nrep; ++rep) { GB; phase_5(P, lds, 5); GB; } }
#endif
    phase_6(P, lds, 6); GB;
    phase_60(P, lds, 60); GB;
#if defined(PROBE_PH) && PROBE_PH == 60
    { int nrep = PROBE_N; asm volatile("" : "+s"(nrep)); for (int rep = 0; rep < nrep; ++rep) { GB; phase_60(P, lds, 60); GB; } }
#endif
#if defined(PROBE_PH) && PROBE_PH == 6
    { int nrep = PROBE_N; asm volatile("" : "+s"(nrep)); for (int rep = 0; rep < nrep; ++rep) { GB; phase_6(P, lds, 6); GB; } }
#endif
    phase_7(P, lds, 7); GB;
#if defined(PROBE_PH) && PROBE_PH == 7
    { int nrep = PROBE_N; asm volatile("" : "+s"(nrep)); for (int rep = 0; rep < nrep; ++rep) { GB; phase_7(P, lds, 7); GB; } }
#endif
    phase_8(P, lds, 8); GB;
#if defined(PROBE_PH) && PROBE_PH == 8
    { int nrep = PROBE_N; asm volatile("" : "+s"(nrep)); for (int rep = 0; rep < nrep; ++rep) { GB; phase_8(P, lds, 8); GB; } }
#endif
    phase_9(P, lds, 9); GB;
#if defined(PROBE_PH) && PROBE_PH == 9
    { int nrep = PROBE_N; asm volatile("" : "+s"(nrep)); for (int rep = 0; rep < nrep; ++rep) { GB; phase_9(P, lds, 9); GB; } }
#endif
    phase_10(P, lds, 10); GB;
#if defined(PROBE_PH) && PROBE_PH == 10
    { int nrep = PROBE_N; asm volatile("" : "+s"(nrep)); for (int rep = 0; rep < nrep; ++rep) { GB; phase_10(P, lds, 10); GB; } }
#endif
    phase_11(P, lds, 11); GB;
#if defined(PROBE_PH) && PROBE_PH == 11
    { int nrep = PROBE_N; asm volatile("" : "+s"(nrep)); for (int rep = 0; rep < nrep; ++rep) { GB; phase_11(P, lds, 11); GB; } }
#endif
    phase_12(P, lds, 12); GB;
#if defined(PROBE_PH) && PROBE_PH == 12
    { int nrep = PROBE_N; asm volatile("" : "+s"(nrep)); for (int rep = 0; rep < nrep; ++rep) { GB; phase_12(P, lds, 12); GB; } }
#endif
    phase_13(P, lds, 13); GB;
#if defined(PROBE_PH) && PROBE_PH == 13
    { int nrep = PROBE_N; asm volatile("" : "+s"(nrep)); for (int rep = 0; rep < nrep; ++rep) { GB; phase_13(P, lds, 13); GB; } }
#endif
    phase_14(P, lds, 14); GB;
#if defined(PROBE_PH) && PROBE_PH == 14
    { int nrep = PROBE_N; asm volatile("" : "+s"(nrep)); for (int rep = 0; rep < nrep; ++rep) { GB; phase_14(P, lds, 14); GB; } }
#endif
    phase_15(P, lds, 15); GB;
#if defined(PROBE_PH) && PROBE_PH == 15
    { int nrep = PROBE_N; asm volatile("" : "+s"(nrep)); for (int rep = 0; rep < nrep; ++rep) { GB; phase_15(P, lds, 15); GB; } }
#endif
    phase_16(P, lds, 16); GB;
#if defined(PROBE_PH) && PROBE_PH == 16
    { int nrep = PROBE_N; asm volatile("" : "+s"(nrep)); for (int rep = 0; rep < nrep; ++rep) { GB; phase_16(P, lds, 16); GB; } }
#endif
    phase_22(P, lds, 22); GB;
#if defined(PROBE_PH) && PROBE_PH == 22
    { int nrep = PROBE_N; asm volatile("" : "+s"(nrep)); for (int rep = 0; rep < nrep; ++rep) { GB; phase_22(P, lds, 22); GB; } }
#endif
    phase_23(P, lds, 23); GB;
#if defined(PROBE_PH) && PROBE_PH == 23
    { int nrep = PROBE_N; asm volatile("" : "+s"(nrep)); for (int rep = 0; rep < nrep; ++rep) { GB; phase_23(P, lds, 23); GB; } }
#endif
    phase_9(P, lds, 17); GB;
#if defined(PROBE_PH) && PROBE_PH == 17
    { int nrep = PROBE_N; asm volatile("" : "+s"(nrep)); for (int rep = 0; rep < nrep; ++rep) { GB; phase_9(P, lds, 17); GB; } }
#endif
    phase_10(P, lds, 18); GB;
#if defined(PROBE_PH) && PROBE_PH == 18
    { int nrep = PROBE_N; asm volatile("" : "+s"(nrep)); for (int rep = 0; rep < nrep; ++rep) { GB; phase_10(P, lds, 18); GB; } }
#endif
    phase_11(P, lds, 19); GB;
#if defined(PROBE_PH) && PROBE_PH == 19
    { int nrep = PROBE_N; asm volatile("" : "+s"(nrep)); for (int rep = 0; rep < nrep; ++rep) { GB; phase_11(P, lds, 19); GB; } }
#endif
    phase_12(P, lds, 20); GB;
#if defined(PROBE_PH) && PROBE_PH == 20
    { int nrep = PROBE_N; asm volatile("" : "+s"(nrep)); for (int rep = 0; rep < nrep; ++rep) { GB; phase_12(P, lds, 20); GB; } }
#endif
    phase_13(P, lds, 21);
#if defined(PROBE_PH) && PROBE_PH == 21
    { int nrep = PROBE_N; asm volatile("" : "+s"(nrep)); for (int rep = 0; rep < nrep; ++rep) { GB; phase_13(P, lds, 21); GB; } }
#endif
#undef P
#undef GB
}

extern "C" void kernel_launch(void* const* d_in, const int* in_sizes, int n_in, void* d_out, int out_size, void* d_ws, size_t ws_size, hipStream_t stream) {
    static int ready = 0;
    if (!ready) {
        if (n_in != 35 || ws_size < WS_TOTAL) { fprintf(stderr, "kernel_launch: unexpected n_in %d or ws_size %zu (need %zu)\n", n_in, ws_size, (size_t)WS_TOTAL); ready = -1; return; }
        if (hipFuncSetAttribute((const void*)mega, hipFuncAttributeMaxDynamicSharedMemorySize, LDS_BYTES) != hipSuccess) { fprintf(stderr, "kernel_launch: hipFuncSetAttribute failed\n"); ready = -1; return; }
        ready = 1;
    }
    if (ready < 0) return;
    (void)hipMemsetAsync((char*)d_ws + WS_CTL, 0, 1 * MiB, stream);
    Params P{};
    for (int i = 0; i < 35; ++i) P.in[i] = (const float*)d_in[i];
    P.out = (float*)d_out; P.ws = (unsigned char*)d_ws; P.ph_lo = 0; P.ph_hi = 0;
    hipLaunchKernelGGL(mega, dim3(GRID), dim3(512), LDS_BYTES, stream, P);
}
```

```cpp
#include <hip/hip_runtime.h>
#include <stdint.h>
#include <stdio.h>

#define DM 1024
#define NB 2
#define SEQ 8192
#define NMETA 16
#define LSEQ (SEQ + NMETA)
#define NMAIN (NB * SEQ)
#define NT (NB * LSEQ)
#define NTP 16640
#define INCOLS 3328
#define RESTC 1792
#define NEXP 32
#define DFF 512
#define S5TC 48
#define S5NC 171
#define MOE_RT 256
#define MOE_MAXROWS 41216

typedef unsigned short bf16_t;
typedef short bf16x8 __attribute__((ext_vector_type(8)));
typedef float f32x4 __attribute__((ext_vector_type(4)));
typedef unsigned u32x4 __attribute__((ext_vector_type(4)));
typedef unsigned u32x2 __attribute__((ext_vector_type(2)));

constexpr size_t MiB = 1u << 20;
constexpr size_t al64k(size_t x) { return (x + 65535) & ~(size_t)65535; }
constexpr size_t WS_CTL = 0;
constexpr size_t WS_H = 1 * MiB;
constexpr size_t WS_HN = WS_H + al64k((size_t)NT * DM * 4);
constexpr size_t WS_A2 = WS_HN + al64k((size_t)NTP * DM * 2);
constexpr size_t WS_WTIN = WS_A2 + al64k((size_t)NTP * DM * 2);
constexpr size_t WS_WTOUT = WS_WTIN + al64k((size_t)INCOLS * DM * 2);
constexpr size_t WS_WTGLU = WS_WTOUT + al64k((size_t)DM * DM * 2);
constexpr size_t WS_LRT = WS_WTGLU + al64k((size_t)2 * DM * DM * 2);
constexpr size_t WS_BIG = WS_LRT + al64k((size_t)(2 * 512 * 64 * 2 + 512 * 128) * 2);
constexpr size_t SZ_T512 = al64k((size_t)NT * 512 * 2);
constexpr size_t SZ_P512 = al64k((size_t)NTP * 512 * 2);
constexpr int RW_NCH = 129, RW_UNITS = 32 * RW_NCH;
constexpr size_t SZ_RWOP = al64k((size_t)RW_UNITS * 4096 * 2);
constexpr size_t WS_Q = WS_BIG;
constexpr size_t WS_K = WS_Q + SZ_P512;
constexpr size_t WS_V = WS_K + SZ_P512;
constexpr size_t WS_REST = WS_V + SZ_P512;
constexpr size_t WS_KR = WS_REST + al64k((size_t)NTP * RESTC * 2);
constexpr size_t WS_LOW = WS_KR + SZ_T512;
constexpr size_t WS_AA = WS_LOW + al64k((size_t)NT * 256 * 2);
constexpr size_t WS_XEND = WS_AA + 2 * SZ_T512;
constexpr size_t WS_PP = WS_BIG;
constexpr size_t WS_QT = WS_PP + SZ_RWOP;
constexpr size_t WS_YT = WS_QT + SZ_RWOP;
constexpr size_t WS_ZT = WS_YT + SZ_RWOP;
constexpr size_t WS_YFB = WS_ZT + SZ_RWOP;
static_assert(WS_YFB + 2 * SZ_T512 <= WS_XEND, "scan operators + YFB fit in region X");
constexpr size_t WS_R = WS_XEND;
constexpr size_t WS_VV = WS_R + SZ_T512;
constexpr size_t WS_G = WS_VV + SZ_T512;
constexpr size_t WS_KK = WS_G + SZ_T512;
constexpr size_t WS_KKA = WS_KK + SZ_T512;
constexpr size_t WS_KD = WS_KKA + 2 * SZ_T512;
constexpr size_t WS_W = WS_KD + 2 * SZ_T512;
constexpr size_t WS_BC = WS_W + 2 * SZ_T512;
constexpr size_t WS_MIXEND = WS_BC + al64k((size_t)NT * 8 * 4);
constexpr size_t WS_XB = WS_BIG;
constexpr size_t WS_HB = WS_XB + al64k((size_t)MOE_MAXROWS * DM * 2);
constexpr size_t WS_YB = WS_HB + al64k((size_t)MOE_MAXROWS * DFF * 2);
constexpr size_t WS_WT13 = WS_YB + al64k((size_t)MOE_MAXROWS * DM * 2);
constexpr size_t WS_WT2 = WS_WT13 + al64k((size_t)NEXP * DM * DM * 2);
constexpr size_t WS_EID = WS_WT2 + al64k((size_t)NEXP * DM * DFF * 2);
constexpr size_t WS_POS = WS_EID + al64k((size_t)NT * 8);
constexpr size_t WS_DEST = WS_POS + al64k((size_t)NT * 8);
constexpr size_t WS_GATE = WS_DEST + al64k((size_t)NT * 8);
constexpr size_t WS_MOEEND = WS_GATE + al64k((size_t)NT * 8);
constexpr size_t WS_YI = WS_BIG;
constexpr size_t WS_E = WS_YI + al64k((size_t)NTP * DM * 4);
constexpr size_t WS_CAR = WS_E + al64k((size_t)1040 * 64 * 256 * 4);
constexpr size_t WS_BTA = WS_CAR + al64k((size_t)64 * 1280 * 256 * 2);
constexpr size_t WS_BTC = WS_BTA + al64k((size_t)64 * 512 * 256 * 2);
constexpr size_t WS_S5END = WS_BTC + al64k((size_t)64 * 256 * 256 * 2);
constexpr size_t cmax(size_t a, size_t b) { return a > b ? a : b; }
constexpr size_t WS_TOTAL = cmax(WS_MIXEND, cmax(WS_MOEEND, WS_S5END));
static_assert(WS_TOTAL <= 512 * MiB, "workspace map exceeds 512 MiB");

#define CW_CNT(l) (1024 + 64 * (l))

#define LDS_BYTES 163840
#define LDS_BARST (LDS_BYTES - 1024)
#define LDS_TAB (LDS_BYTES - 768)
#define LDS_RING (LDS_BYTES - 1024)
#define GRID 256

struct Params {
    const float* in[35];
    float* out;
    unsigned char* ws;
    int ph_lo, ph_hi;
};
typedef const __attribute__((address_space(4))) Params CParams;

__device__ __forceinline__ float bf2f(bf16_t v) { return __uint_as_float(((unsigned)v) << 16); }
typedef float f32x2c_ __attribute__((ext_vector_type(2)));
typedef __bf16 bf16x2c_ __attribute__((ext_vector_type(2)));
__device__ __forceinline__ unsigned pk2(float lo, float hi) { const f32x2c_ f = {lo, hi}; const bf16x2c_ b = __builtin_convertvector(f, bf16x2c_); return __builtin_bit_cast(unsigned, b); }
__device__ __forceinline__ unsigned f2bf(float f) { return (unsigned)__builtin_bit_cast(unsigned short, (__bf16)f); }
__device__ __forceinline__ float bflo(unsigned u) { return __uint_as_float(u << 16); }
__device__ __forceinline__ float bfhi(unsigned u) { return __uint_as_float(u & 0xffff0000u); }
__device__ __forceinline__ float wave_sum(float v) {
#pragma unroll
    for (int o = 1; o < 64; o <<= 1) v += __shfl_xor(v, o);
    return v;
}
__device__ __forceinline__ float wave_max(float v) {
#pragma unroll
    for (int o = 1; o < 64; o <<= 1) v = fmaxf(v, __shfl_xor(v, o));
    return v;
}
template <int CTRL> __device__ __forceinline__ float dppf(float v) { return __int_as_float(__builtin_amdgcn_update_dpp(0, __float_as_int(v), CTRL, 0xF, 0xF, true)); }
__device__ __forceinline__ float row16_sum(float v) { v += dppf<0xB1>(v); v += dppf<0x4E>(v); v += dppf<0x141>(v); v += dppf<0x140>(v); return v; }
__device__ __forceinline__ float sigmoidf_(float x) { return __builtin_amdgcn_rcpf(1.f + __expf(-x)); }
__device__ __forceinline__ int rowof(int b, int p) { return p < NMETA ? NMAIN + b * NMETA + p : b * SEQ + (p - NMETA); }

#define SA_STRIDE 40
template <class AF, class BF>
__device__ __forceinline__ void gemm_tile(unsigned char* lds, int K, int ldb, const AF& arow, const BF& bcol, f32x4 (&acc)[4][2]) {
    bf16_t* sA = (bf16_t*)lds;
    bf16_t* sB = (bf16_t*)(lds + 128 * SA_STRIDE * 2);
    const int tid = threadIdx.x, lane = tid & 63, wave = tid >> 6, wr = wave >> 2, wc = wave & 3, fr = lane & 15, fq = lane >> 4;
#pragma unroll
    for (int mi = 0; mi < 4; ++mi)
#pragma unroll
        for (int ni = 0; ni < 2; ++ni) acc[mi][ni] = (f32x4){0.f, 0.f, 0.f, 0.f};
    const int ar = tid >> 2, akc = (tid & 3) * 8;
    const bf16_t* ap = arow(ar) + akc;
    const int bnq = (tid & 31) * 4, bkp = (tid >> 5) * 2;
    const float* bp = bcol(bnq) + (size_t)bkp * ldb;
    const int nk = K / 32;
    u32x4 ra = *(const u32x4*)ap;
    f32x4 rb0 = *(const f32x4*)bp, rb1 = *(const f32x4*)(bp + ldb);
    for (int kt = 0; kt < nk; ++kt) {
        __syncthreads();
        *(u32x4*)(sA + ar * SA_STRIDE + akc) = ra;
        {
            unsigned* d = (unsigned*)(sB + bnq * SA_STRIDE + bkp);
            d[0 * (SA_STRIDE / 2)] = pk2(rb0[0], rb1[0]);
            d[1 * (SA_STRIDE / 2)] = pk2(rb0[1], rb1[1]);
            d[2 * (SA_STRIDE / 2)] = pk2(rb0[2], rb1[2]);
            d[3 * (SA_STRIDE / 2)] = pk2(rb0[3], rb1[3]);
        }
        __syncthreads();
        if (kt + 1 < nk) {
            ra = *(const u32x4*)(ap + (kt + 1) * 32);
            const float* q = bp + (size_t)(kt + 1) * 32 * ldb;
            rb0 = *(const f32x4*)q; rb1 = *(const f32x4*)(q + ldb);
        }
        bf16x8 a[4], b[2];
#pragma unroll
        for (int mi = 0; mi < 4; ++mi) a[mi] = *(const bf16x8*)(sA + (wr * 64 + mi * 16 + fr) * SA_STRIDE + fq * 8);
#pragma unroll
        for (int ni = 0; ni < 2; ++ni) b[ni] = *(const bf16x8*)(sB + (wc * 32 + ni * 16 + fr) * SA_STRIDE + fq * 8);
#pragma unroll
        for (int mi = 0; mi < 4; ++mi)
#pragma unroll
            for (int ni = 0; ni < 2; ++ni) acc[mi][ni] = __builtin_amdgcn_mfma_f32_16x16x32_bf16(a[mi], b[ni], acc[mi][ni], 0, 0, 0);
    }
    __syncthreads();
}
#define ACC_FOREACH(acc, ...) do { const int _l = threadIdx.x & 63, _w = threadIdx.x >> 6, _wr = _w >> 2, _wc = _w & 3, _fr = _l & 15, _fq = _l >> 4; \
    _Pragma("unroll") for (int _mi = 0; _mi < 4; ++_mi) _Pragma("unroll") for (int _ni = 0; _ni < 2; ++_ni) _Pragma("unroll") for (int _j = 0; _j < 4; ++_j) { \
        const int rl = _wr * 64 + _mi * 16 + _fq * 4 + _j, cl = _wc * 32 + _ni * 16 + _fr; const float val = acc[_mi][_ni][_j]; __VA_ARGS__ } } while (0)
#define ACC_FOREACH_PAIR(acc, ...) do { const int _l = threadIdx.x & 63, _w = threadIdx.x >> 6, _wr = _w >> 2, _wc = _w & 3, _fr = _l & 15, _fq = _l >> 4; \
    _Pragma("unroll") for (int _mi = 0; _mi < 4; ++_mi) _Pragma("unroll") for (int _j = 0; _j < 4; ++_j) { \
        const int rl = _wr * 64 + _mi * 16 + _fq * 4 + _j, co = _wc * 16 + _fr; const float va = acc[_mi][0][_j], vg = acc[_mi][1][_j]; __VA_ARGS__ } } while (0)

__device__ __forceinline__ void store_norm_bf16(const f32x4 (&v)[4], const float* gain, bf16_t* dst, int lane) {
    float ss = 0.f;
#pragma unroll
    for (int j = 0; j < 4; ++j) ss += v[j][0] * v[j][0] + v[j][1] * v[j][1] + v[j][2] * v[j][2] + v[j][3] * v[j][3];
    ss = wave_sum(ss);
    const float rstd = rsqrtf(ss * (1.f / DM) + 1e-6f);
#pragma unroll
    for (int j = 0; j < 4; ++j) {
        const f32x4 g = ((const f32x4*)gain)[lane + 64 * j];
        u32x2 o; o.x = pk2(v[j][0] * rstd * g[0], v[j][1] * rstd * g[1]); o.y = pk2(v[j][2] * rstd * g[2], v[j][3] * rstd * g[3]);
        ((u32x2*)dst)[lane + 64 * j] = o;
    }
}

namespace pg8 {
#define PG8_LAS __attribute__((address_space(3)))
constexpr int BM = 256, BK = 64, HALF = 128, HTB = HALF * BK * 2  , STAGE_BYTES = 8 * HTB, NXCD = 8, WGM = 8;
__host__ __device__ __forceinline__ int lds_byte(int r, int c) { const int st = (r >> 4) * 2 + (c >> 5), rr = r & 15, cc = c & 31, ob = rr * 64 + cc * 2; return st * 1024 + (ob ^ (((ob >> 9) & 1) << 5)); }
__host__ __device__ __forceinline__ void stage_rc(int b, int& R, int& C) { const int st = b / 1024, sb = b % 1024, swz = sb ^ (((sb >> 9) & 1) << 5); R = (st >> 1) * 16 + swz / 64; C = (st & 1) * 32 + (swz % 64) / 2; }
__host__ __device__ __forceinline__ int perm32(int rho) { const int n = rho >> 4, i = rho & 15; return 8 * (i >> 2) + 4 * n + (i & 3); }

struct Unit { int pm, pn; const char* A; const char* B; };

struct DenseOrder {
    static constexpr bool GATHER_A = false;
    int nM, nN, nwg, G, c; const char* A; const char* Bt; size_t tstep;
    __device__ void init(const bf16_t* A_, const bf16_t* Bt_, int M, int N, int K, int G_, int c_) { nM = M / BM; nN = N / BM; nwg = nM * nN; G = G_; c = c_; A = (const char*)A_; Bt = (const char*)Bt_; tstep = (size_t)BM * K * 2; }
    __device__ bool next(int i, Unit& u) const {
        const long L = (long)i * G + c; if (L >= nwg) return false;
        int wgid = (int)L; { const int q = nwg / NXCD, r = nwg % NXCD, xcd = wgid % NXCD, off = wgid / NXCD; wgid = (xcd < r ? xcd * (q + 1) : r * (q + 1) + (xcd - r) * q) + off; }
        const int nig = WGM * nN, gid = wgid / nig, fm = gid * WGM, gsz = (nM - fm) < WGM ? (nM - fm) : WGM;
        u.pm = fm + ((wgid % nig) % gsz); u.pn = (wgid % nig) / gsz; u.A = A + (size_t)u.pm * tstep; u.B = Bt + (size_t)u.pn * tstep; return true;
    }
    __device__ __forceinline__ void a_ready(const Unit&) const {}
    __device__ __forceinline__ void done(const Unit&) const {}
};
struct ProjOrder {
    static constexpr bool GATHER_A = false;
    DenseOrder D; const char* HNp; const char* WT;
    __device__ void init(const bf16_t* HN_, const bf16_t* WT_, int c_) { D.init(HN_, WT_, NTP, 13 * BM, DM, GRID, c_); HNp = (const char*)HN_; WT = (const char*)WT_; }
    __device__ bool next(int i, Unit& u) const {
        if (!D.next(i, u)) return false;
        const size_t ts = (size_t)BM * DM * 2;
        if (u.pn < 11) { const int wrow = u.pn < 4 ? u.pn : u.pn + 2; u.A = HNp + (size_t)u.pm * ts; u.B = WT + (size_t)wrow * ts; }
        else { u.A = WT + (size_t)(4 + (u.pn - 11)) * ts; u.B = HNp + (size_t)u.pm * ts; }
        return true;
    }
    __device__ __forceinline__ void a_ready(const Unit&) const {}
    __device__ __forceinline__ void done(const Unit&) const {}
};
struct MoeOrder {
    static constexpr bool GATHER_A = false;
    const int* et; int TT, vcu; const char* A; const char* Bt; unsigned tstepA, tstepB, estep;
    __device__ __forceinline__ bool next(int i, Unit& u) const {
        const int L = i * GRID + vcu; if (L >= TT * 4) return false;
        const int rt = L >> 2, ct = L & 3, e = et[rt];
        u.pm = rt; u.pn = ct; u.A = A + (size_t)rt * tstepA; u.B = Bt + (size_t)e * estep + (size_t)ct * tstepB; return true;
    }
    __device__ __forceinline__ void a_ready(const Unit&) const {}
    __device__ __forceinline__ void done(const Unit&) const {}
};

struct S5OrderA {
    static constexpr bool GATHER_A = true;
    int vcu; const char* U; const char* BTA;
    __device__ __forceinline__ bool next(int i, Unit& u) const {
        const int L = i * GRID + vcu; if (L >= 640) return false;
        const int g = L / 10, rem = L - g * 10, mt = rem >> 1, nt = rem & 1;
        u.pm = mt; u.pn = g * 2 + nt; u.A = U + ((size_t)mt * 256 * 16 * 1024 + g * 16) * 2; u.B = BTA + ((size_t)(g * 512 + nt * 256) * 256) * 2; return true;
    }
    __device__ __forceinline__ void a_ready(const Unit&) const {}
    __device__ __forceinline__ void done(const Unit&) const {}
};
struct S5OrderC {
    static constexpr bool GATHER_A = false;
    int vcu; const char* CAR; const char* BTC;
    __device__ __forceinline__ bool next(int i, Unit& u) const {
        const int L = i * GRID + vcu; if (L >= 320) return false;
        const int g = L / 5, mt = L - g * 5;
        u.pm = mt; u.pn = g; u.A = CAR + ((size_t)(g * 1280 + mt * 256) * 256) * 2; u.B = BTC + ((size_t)g * 256 * 256) * 2; return true;
    }
    __device__ __forceinline__ void a_ready(const Unit&) const {}
    __device__ __forceinline__ void done(const Unit&) const {}
};
__device__ __forceinline__ unsigned cvt_pk_bf16(float lo, float hi) { return pk2(lo, hi); }

struct EpiProj {
    static constexpr bool PERM = true, AFTER_DRAIN = false;
    bf16_t *Q, *Kk, *VT, *REST;
    __device__ __forceinline__ void operator()(const f32x4 (&acc)[2][2][4][2], const Unit& u, int wr, int wc, int fr, int fq) const {
        bf16_t* base; int ldc; int row0, col0;
        if (u.pn < 11) { row0 = u.pm * BM + wr * 64 + fr; int colt;
            if (u.pn < 2) { base = Q; colt = u.pn * BM; ldc = 512; } else if (u.pn < 4) { base = Kk; colt = (u.pn - 2) * BM; ldc = 512; } else { base = REST; colt = (u.pn - 4) * BM; ldc = RESTC; }
            col0 = colt + wc * 32 + 8 * fq; }
        else { base = VT; ldc = NTP; row0 = (u.pn - 11) * BM + wr * 64 + fr; col0 = u.pm * BM + wc * 32 + 8 * fq; }
#pragma unroll
        for (int ai = 0; ai < 2; ++ai)
#pragma unroll
            for (int m = 0; m < 4; ++m) { bf16_t* rowp = base + (size_t)(row0 + ai * HALF + m * 16) * ldc + col0;
#pragma unroll
                for (int bj = 0; bj < 2; ++bj) { const f32x4 v0 = acc[ai][bj][m][0], v1 = acc[ai][bj][m][1];
                    u32x4 w; w.x = cvt_pk_bf16(v0[0], v0[1]); w.y = cvt_pk_bf16(v0[2], v0[3]); w.z = cvt_pk_bf16(v1[0], v1[1]); w.w = cvt_pk_bf16(v1[2], v1[3]);
                    *(u32x4*)(rowp + bj * HALF) = w; } }
    }
};
struct EpiBf16Plain {
    static constexpr bool PERM = true, AFTER_DRAIN = false;
    bf16_t* O; int ldc;
    __device__ __forceinline__ void operator()(const f32x4 (&acc)[2][2][4][2], const Unit& u, int wr, int wc, int fr, int fq) const {
        const int row0 = u.pm * BM + wr * 64 + fr; const int col0 = u.pn * BM + wc * 32 + 8 * fq;
#pragma unroll
        for (int ai = 0; ai < 2; ++ai)
#pragma unroll
            for (int m = 0; m < 4; ++m) { bf16_t* rowp = O + (size_t)(row0 + ai * HALF + m * 16) * ldc + col0;
#pragma unroll
                for (int bj = 0; bj < 2; ++bj) { const f32x4 v0 = acc[ai][bj][m][0], v1 = acc[ai][bj][m][1];
                    u32x4 w; w.x = cvt_pk_bf16(v0[0], v0[1]); w.y = cvt_pk_bf16(v0[2], v0[3]); w.z = cvt_pk_bf16(v1[0], v1[1]); w.w = cvt_pk_bf16(v1[2], v1[3]);
                    *(u32x4*)(rowp + bj * HALF) = w; } }
    }
};
struct EpiSwiglu {
    static constexpr bool PERM = true, AFTER_DRAIN = false;
    bf16_t* O;
    __device__ __forceinline__ void operator()(const f32x4 (&acc)[2][2][4][2], const Unit& u, int wr, int wc, int fr, int fq) const {
        const int row0 = u.pm * BM + wr * 64 + fr; const int col0 = u.pn * HALF + wc * 32 + 8 * fq;
#pragma unroll
        for (int ai = 0; ai < 2; ++ai)
#pragma unroll
            for (int m = 0; m < 4; ++m) {
                float o[8];
#pragma unroll
                for (int n = 0; n < 2; ++n)
#pragma unroll
                    for (int i = 0; i < 4; ++i) { const float va = acc[ai][0][m][n][i], vg = acc[ai][1][m][n][i]; o[4 * n + i] = va * __builtin_amdgcn_rcpf(1.f + __expf(-va)) * vg; }
                u32x4 w; w.x = cvt_pk_bf16(o[0], o[1]); w.y = cvt_pk_bf16(o[2], o[3]); w.z = cvt_pk_bf16(o[4], o[5]); w.w = cvt_pk_bf16(o[6], o[7]);
                *(u32x4*)(O + (size_t)(row0 + ai * HALF + m * 16) * DFF + col0) = w; }
    }
};
struct EpiResidual {
    static constexpr bool PERM = false, AFTER_DRAIN = false;
    float* Hh;
    __device__ __forceinline__ void operator()(const f32x4 (&acc)[2][2][4][2], const Unit& u, int wr, int wc, int fr, int fq) const {
        const int row0 = u.pm * BM + wr * 64 + fr; const int col0 = u.pn * BM + wc * 32 + 4 * fq;
#pragma unroll
        for (int ai = 0; ai < 2; ++ai)
#pragma unroll
            for (int m = 0; m < 4; ++m) { float* rowp = Hh + (size_t)(row0 + ai * HALF + m * 16) * DM + col0;
#pragma unroll
                for (int bj = 0; bj < 2; ++bj)
#pragma unroll
                    for (int n = 0; n < 2; ++n) { f32x4* p = (f32x4*)(rowp + bj * HALF + n * 16); *p = *p + acc[ai][bj][m][n]; } }
    }
};
struct EpiGlu {
    static constexpr bool PERM = false, AFTER_DRAIN = false;
    float* Hh;
    __device__ __forceinline__ void operator()(const f32x4 (&acc)[2][2][4][2], const Unit& u, int wr, int wc, int fr, int fq) const {
        const int row0 = u.pm * BM + wr * 64 + fr; const int col0 = u.pn * HALF + wc * 32 + 4 * fq;
#pragma unroll
        for (int ai = 0; ai < 2; ++ai)
#pragma unroll
            for (int m = 0; m < 4; ++m) { float* rowp = Hh + (size_t)(row0 + ai * HALF + m * 16) * DM + col0;
#pragma unroll
                for (int n = 0; n < 2; ++n) { f32x4* p = (f32x4*)(rowp + n * 16); f32x4 hv = *p; const f32x4 va = acc[ai][0][m][n], vg = acc[ai][1][m][n];
#pragma unroll
                    for (int i = 0; i < 4; ++i) hv[i] += va[i] * __builtin_amdgcn_rcpf(1.f + __expf(-vg[i]));
                    *p = hv; } }
    }
};

struct EpiS5A {
    static constexpr bool PERM = true, AFTER_DRAIN = false;
    float* YI; float* E;
    __device__ __forceinline__ void operator()(const f32x4 (&acc)[2][2][4][2], const Unit& u, int wr, int wc, int fr, int fq) const {
        const int g = u.pn >> 1, nt = u.pn & 1;
        const int cl0 = wc * 32 + 8 * fq;
        float* base = nt == 0 ? YI + (size_t)(cl0 >> 4) * DM + g * 16 + (cl0 & 15) : E + (size_t)g * 256 + cl0;
        const size_t nstride = 16 * DM;
        const size_t bjstep = nt == 0 ? (size_t)8 * DM : (size_t)HALF;
#pragma unroll
        for (int ai = 0; ai < 2; ++ai)
#pragma unroll
            for (int m = 0; m < 4; ++m) { int n = u.pm * BM + ai * HALF + wr * 64 + m * 16 + fr; n = n < 1039 ? n : 1039;
                float* p = base + (size_t)n * nstride;
#pragma unroll
                for (int bj = 0; bj < 2; ++bj) { *(f32x4*)(p + bj * bjstep) = acc[ai][bj][m][0]; *(f32x4*)(p + bj * bjstep + 4) = acc[ai][bj][m][1]; } }
    }
};
struct EpiS5C {
    static constexpr bool PERM = true, AFTER_DRAIN = false;
    const float* YI; const bf16_t* Uu; const float* dvec; bf16_t* O;
    __device__ __forceinline__ void operator()(const f32x4 (&acc)[2][2][4][2], const Unit& u, int wr, int wc, int fr, int fq) const {
        const int g = u.pn;
        const int cl0 = wc * 32 + 8 * fq, ch = g * 16 + (cl0 & 15);
        const size_t off0 = (size_t)(cl0 >> 4) * DM + ch;
        const f32x4 d0 = *(const f32x4*)(dvec + ch), d1 = *(const f32x4*)(dvec + ch + 4);
#pragma unroll
        for (int ai = 0; ai < 2; ++ai)
#pragma unroll
            for (int m = 0; m < 4; ++m) { int n = u.pm * BM + ai * HALF + wr * 64 + m * 16 + fr; n = n < 1039 ? n : 1039;
#pragma unroll
                for (int bj = 0; bj < 2; ++bj) {
                    const size_t off = off0 + (size_t)n * (16 * DM) + (size_t)bj * (8 * DM);
                    const f32x4 y0 = *(const f32x4*)(YI + off), y1 = *(const f32x4*)(YI + off + 4);
                    const u32x4 uv = *(const u32x4*)(Uu + off);
                    float y[8];
#pragma unroll
                    for (int q = 0; q < 4; ++q) { y[q] = acc[ai][bj][m][0][q] + y0[q] + d0[q] * (q & 1 ? __uint_as_float(uv[q >> 1] & 0xffff0000u) : __uint_as_float(uv[q >> 1] << 16));
                        y[4 + q] = acc[ai][bj][m][1][q] + y1[q] + d1[q] * (q & 1 ? __uint_as_float(uv[2 + (q >> 1)] & 0xffff0000u) : __uint_as_float(uv[2 + (q >> 1)] << 16)); }
#pragma unroll
                    for (int q = 0; q < 8; ++q) { const float z = 1.5957691216f * (y[q] + 0.044715f * y[q] * y[q] * y[q]); y[q] = y[q] * __builtin_amdgcn_rcpf(1.f + __expf(-z)); }
                    u32x4 w; w.x = cvt_pk_bf16(y[0], y[1]); w.y = cvt_pk_bf16(y[2], y[3]); w.z = cvt_pk_bf16(y[4], y[5]); w.w = cvt_pk_bf16(y[6], y[7]);
                    *(u32x4*)(O + off) = w; }
                asm volatile("" ::: "memory"); }
    }
};

template <class Epi, class Sched, bool ALIGN_EPI = false, bool SP2 = false>
__device__ __forceinline__ void gemm_phase(PG8_LAS unsigned char* lds, const int K, const Sched& S, const Epi& E) {
    int tid_ = threadIdx.x; asm volatile("" : "+v"(tid_));
    const int tid = tid_, wid = __builtin_amdgcn_readfirstlane(tid >> 6), lane = tid & 63, wr = wid >> 2, wc = wid & 3, fr = lane & 15, fq = lane >> 4;
    const int nt = K / BK;
    unsigned voffA[2], voffB[2];
#pragma unroll
    for (int i = 0; i < 2; ++i) { int R, C; stage_rc(tid * 16 + i * 8192, R, C); const int Rb = Epi::PERM ? ((R & ~31) + perm32(R & 31)) : R;
        voffA[i] = Sched::GATHER_A ? (unsigned)(((16 * R + (C >> 4)) * 1024 + (C & 15)) * 2) : (unsigned)(R * K + C) * 2u; voffB[i] = (unsigned)(Rb * K + C) * 2u; }
    const size_t kstep = (size_t)(BK * 2);
    const size_t hstep = (size_t)HALF * K * 2;
    const size_t kstepA = Sched::GATHER_A ? (size_t)(4 * 1024 * 2) : kstep, hstepA = Sched::GATHER_A ? (size_t)HALF * 16 * 1024 * 2 : hstep;
    const unsigned ldsw = (unsigned)wid * 1024u;
    const int aoff = lds_byte(wr * 64 + fr, fq * 8), boff = lds_byte(wc * 32 + fr, fq * 8);
#define PG8_SA(b, h) (((b) * 2 + (h)) * HTB)
#define PG8_SB(b, h) ((4 + (b) * 2 + (h)) * HTB)
#define PG8_STAGE(bufoff, gbase, voff) do { _Pragma("unroll") for (int _i = 0; _i < 2; ++_i) \
        __builtin_amdgcn_global_load_lds((const unsigned*)((const char*)(gbase) + (voff)[_i]), (PG8_LAS unsigned*)(lds + (bufoff) + ldsw + _i * 8192), 16, 0, 0); } while (0)
#define PG8_LDA(dst, b, h) do { _Pragma("unroll") for (int m = 0; m < 4; ++m) _Pragma("unroll") for (int k = 0; k < 2; ++k) dst[m][k] = *(const PG8_LAS bf16x8*)(lds + PG8_SA(b, h) + aoff + m * 2048 + k * 1024); } while (0)
#define PG8_LDB(dst, b, h) do { _Pragma("unroll") for (int n = 0; n < 2; ++n) _Pragma("unroll") for (int k = 0; k < 2; ++k) dst[n][k] = *(const PG8_LAS bf16x8*)(lds + PG8_SB(b, h) + boff + n * 2048 + k * 1024); } while (0)
#define PG8_MMA(ai, bj, At, Bt) do { __builtin_amdgcn_s_setprio(1); _Pragma("unroll") for (int m = 0; m < 4; ++m) _Pragma("unroll") for (int n = 0; n < 2; ++n) _Pragma("unroll") for (int k = 0; k < 2; ++k) \
        acc[ai][bj][m][n] = __builtin_amdgcn_mfma_f32_16x16x32_bf16(Bt[n][k], At[m][k], acc[ai][bj][m][n], 0, 0, 0); __builtin_amdgcn_s_setprio(0); } while (0)
#define PG8_WAIT_V(n) asm volatile("s_waitcnt vmcnt(" #n ")" ::: "memory")
#define PG8_WAIT_L(n) asm volatile("s_waitcnt lgkmcnt(" #n ")" ::: "memory")
#define PG8_BAR __builtin_amdgcn_s_barrier()
#define PG8_SCHED __builtin_amdgcn_sched_barrier(0)
    Unit cur, nxt; int ui = 0;
    if (!S.next(0, cur)) return;
    f32x4 acc[2][2][4][2];
#pragma unroll
    for (int a = 0; a < 2; ++a)
#pragma unroll
        for (int b = 0; b < 2; ++b)
#pragma unroll
            for (int m = 0; m < 4; ++m)
#pragma unroll
                for (int n = 0; n < 2; ++n) acc[a][b][m][n] = (f32x4){0.f, 0.f, 0.f, 0.f};
    bf16x8 At[4][2], B0[2][2], B1[2][2];
    const char* cA = cur.A; const char* cB = cur.B;
    S.a_ready(cur);
    if constexpr (SP2) {
        PG8_STAGE(PG8_SB(0, 0), cB, voffB); PG8_STAGE(PG8_SB(0, 1), cB + hstep, voffB); PG8_STAGE(PG8_SA(0, 0), cA, voffA); PG8_STAGE(PG8_SA(0, 1), cA + hstepA, voffA);
        if (wr == 1) PG8_BAR;
        PG8_WAIT_V(2); PG8_BAR;
        PG8_STAGE(PG8_SB(1, 0), cB + kstep, voffB); PG8_STAGE(PG8_SA(1, 0), cA + kstepA, voffA); PG8_STAGE(PG8_SB(1, 1), cB + hstep + kstep, voffB);
        PG8_WAIT_V(6); PG8_BAR;
    } else {
        PG8_STAGE(PG8_SB(0, 0), cB, voffB); PG8_STAGE(PG8_SA(0, 0), cA, voffA); PG8_STAGE(PG8_SB(0, 1), cB + hstep, voffB); PG8_STAGE(PG8_SA(0, 1), cA + hstepA, voffA);
        if (wr == 1) PG8_BAR;
        PG8_WAIT_V(4); PG8_BAR;
        PG8_STAGE(PG8_SB(1, 0), cB + kstep, voffB); PG8_STAGE(PG8_SA(1, 0), cA + kstepA, voffA); PG8_STAGE(PG8_SB(1, 1), cB + hstep + kstep, voffB);
        PG8_WAIT_V(6); PG8_BAR;
    }
    for (;;) {
        const bool has_next = S.next(ui + 1, nxt);
        const char* nA = has_next ? nxt.A : cA; const char* nB = has_next ? nxt.B : cB;
        for (int t = 0; t < nt; t += 2) {
            const bool last = (t == nt - 2);
            const char* a1 = cA + (size_t)(t + 1) * kstepA;
            const char* a2 = last ? nA : cA + (size_t)(t + 2) * kstepA; const char* b2 = last ? nB : cB + (size_t)(t + 2) * kstep;
            const char* a3 = a2 + kstepA; const char* b3 = b2 + kstep;
            if (last && has_next) S.a_ready(nxt);
            if constexpr (SP2) {
            PG8_LDB(B0, 0, 0); PG8_LDB(B1, 0, 1); PG8_SCHED; PG8_LDA(At, 0, 0); PG8_STAGE(PG8_SA(1, 1), a1 + hstepA, voffA);
            PG8_WAIT_V(8); PG8_WAIT_L(0); PG8_BAR; PG8_MMA(0, 0, At, B0); PG8_MMA(0, 1, At, B1); PG8_BAR; PG8_SCHED;
            PG8_LDA(At, 0, 1); PG8_STAGE(PG8_SB(0, 0), b2, voffB); PG8_STAGE(PG8_SB(0, 1), b2 + hstep, voffB); PG8_STAGE(PG8_SA(0, 0), a2, voffA);
            PG8_WAIT_V(8); PG8_WAIT_L(0); PG8_BAR; PG8_MMA(1, 0, At, B0); PG8_MMA(1, 1, At, B1); PG8_BAR; PG8_SCHED;
            PG8_LDB(B0, 1, 0); PG8_LDB(B1, 1, 1); PG8_SCHED; PG8_LDA(At, 1, 0); PG8_STAGE(PG8_SA(0, 1), a2 + hstepA, voffA);
            PG8_WAIT_V(8); PG8_WAIT_L(0); PG8_BAR; PG8_MMA(0, 0, At, B0); PG8_MMA(0, 1, At, B1); PG8_BAR; PG8_SCHED;
            PG8_LDA(At, 1, 1); PG8_STAGE(PG8_SB(1, 0), b3, voffB); PG8_STAGE(PG8_SB(1, 1), b3 + hstep, voffB); PG8_STAGE(PG8_SA(1, 0), a3, voffA);
            PG8_WAIT_V(8); PG8_WAIT_L(0); PG8_BAR; PG8_MMA(1, 0, At, B0); PG8_MMA(1, 1, At, B1); PG8_BAR; PG8_SCHED;
            } else {
            PG8_LDB(B0, 0, 0); PG8_SCHED; PG8_LDA(At, 0, 0); PG8_STAGE(PG8_SA(1, 1), a1 + hstepA, voffA);
            PG8_WAIT_L(8); PG8_BAR; PG8_WAIT_L(0); PG8_MMA(0, 0, At, B0); PG8_BAR; PG8_SCHED;
            PG8_LDB(B1, 0, 1); PG8_STAGE(PG8_SB(0, 0), b2, voffB);
            PG8_BAR; PG8_WAIT_L(0); PG8_MMA(0, 1, At, B1); PG8_BAR;
            PG8_LDA(At, 0, 1); PG8_STAGE(PG8_SA(0, 0), a2, voffA);
            PG8_BAR; PG8_WAIT_L(0); PG8_MMA(1, 0, At, B0); PG8_BAR; PG8_SCHED;
            PG8_STAGE(PG8_SB(0, 1), b2 + hstep, voffB);
            PG8_WAIT_V(6); PG8_BAR; PG8_MMA(1, 1, At, B1); PG8_BAR;
            PG8_LDB(B0, 1, 0); PG8_SCHED; PG8_LDA(At, 1, 0); PG8_STAGE(PG8_SA(0, 1), a2 + hstepA, voffA);
            PG8_WAIT_L(8); PG8_BAR; PG8_WAIT_L(0); PG8_MMA(0, 0, At, B0); PG8_BAR; PG8_SCHED;
            PG8_LDB(B1, 1, 1); PG8_STAGE(PG8_SB(1, 0), b3, voffB);
            PG8_BAR; PG8_WAIT_L(0); PG8_MMA(0, 1, At, B1); PG8_BAR;
            PG8_LDA(At, 1, 1); PG8_STAGE(PG8_SA(1, 0), a3, voffA);
            PG8_BAR; PG8_WAIT_L(0); PG8_MMA(1, 0, At, B0); PG8_BAR; PG8_SCHED;
            PG8_STAGE(PG8_SB(1, 1), b3 + hstep, voffB);
            PG8_WAIT_V(6); PG8_BAR; PG8_MMA(1, 1, At, B1); PG8_BAR;
            }
        }
        if constexpr (ALIGN_EPI) { if (wr == 0) PG8_BAR; }
        if constexpr (!Epi::AFTER_DRAIN) { E(acc, cur, wr, wc, fr, fq); S.done(cur); }
        if (!has_next) break;
#pragma unroll
        for (int a = 0; a < 2; ++a)
#pragma unroll
            for (int b = 0; b < 2; ++b)
#pragma unroll
                for (int m = 0; m < 4; ++m)
#pragma unroll
                    for (int n = 0; n < 2; ++n) acc[a][b][m][n] = (f32x4){0.f, 0.f, 0.f, 0.f};
        cur = nxt; cA = nA; cB = nB; ++ui;
        if constexpr (ALIGN_EPI) { if (wr == 1) PG8_BAR; }
    }
    PG8_WAIT_V(0);
    if constexpr (!ALIGN_EPI) { if (wr == 0) PG8_BAR; }
    PG8_BAR;
    if constexpr (Epi::AFTER_DRAIN) { E.fused(acc, cur, wr, wc, fr, fq, lds, wid, lane); S.done(cur); }
#undef PG8_SA
#undef PG8_SB
#undef PG8_STAGE
#undef PG8_LDA
#undef PG8_LDB
#undef PG8_MMA
#undef PG8_WAIT_V
#undef PG8_WAIT_L
#undef PG8_BAR
#undef PG8_SCHED
}
}

#define PHASE_PROLOGUE \
    int tid_ = threadIdx.x; asm volatile("" : "+v"(tid_)); const int tid = tid_, lane = tid & 63, wave = tid >> 6; \
    const int G = GRID, bid = blockIdx.x; \
    const int gw = bid * 8 + wave, NGW = G * 8; \
    unsigned char* ws = P.ws; \
    float* H = (float*)(ws + WS_H); \
    bf16_t* HN = (bf16_t*)(ws + WS_HN); \
    bf16_t* A2 = (bf16_t*)(ws + WS_A2); \
    bf16_t* Qb = (bf16_t*)(ws + WS_Q); bf16_t* Kb = (bf16_t*)(ws + WS_K); bf16_t* Vb = (bf16_t*)(ws + WS_V); \
    bf16_t* REST = (bf16_t*)(ws + WS_REST); \
    bf16_t* YFB = (bf16_t*)(ws + WS_YFB); \
    bf16_t* Rr = (bf16_t*)(ws + WS_R); bf16_t* VV = (bf16_t*)(ws + WS_VV); bf16_t* KK = (bf16_t*)(ws + WS_KK); \
    bf16_t* KKA = (bf16_t*)(ws + WS_KKA); bf16_t* KD = (bf16_t*)(ws + WS_KD); \
    _Float16* LW = (_Float16*)(ws + WS_W); bf16_t* PP = (bf16_t*)(ws + WS_PP); bf16_t* QT = (bf16_t*)(ws + WS_QT); bf16_t* YT = (bf16_t*)(ws + WS_YT); bf16_t* ZT = (bf16_t*)(ws + WS_ZT); \
    bf16_t* Gg = (bf16_t*)(ws + WS_G); bf16_t* KR = (bf16_t*)(ws + WS_KR); bf16_t* LOW = (bf16_t*)(ws + WS_LOW); \
    float* BC = (float*)(ws + WS_BC); \
    bf16_t* AA = (bf16_t*)(ws + WS_AA); \
    bf16_t* HB = (bf16_t*)(ws + WS_HB); bf16_t* YB = (bf16_t*)(ws + WS_YB); \
    bf16_t* XB = (bf16_t*)(ws + WS_XB); int* EID = (int*)(ws + WS_EID); int* POS = (int*)(ws + WS_POS); int* DEST = (int*)(ws + WS_DEST); \
    float* GATE = (float*)(ws + WS_GATE); \
    float* YI = (float*)(ws + WS_YI); float* S5E = (float*)(ws + WS_E); bf16_t* CAR = (bf16_t*)(ws + WS_CAR); bf16_t* BTA = (bf16_t*)(ws + WS_BTA); bf16_t* BTC = (bf16_t*)(ws + WS_BTC); \
    unsigned* CTL = (unsigned*)(ws + WS_CTL); \
    bf16_t* WTIN = (bf16_t*)(ws + WS_WTIN); bf16_t* WTOUT = (bf16_t*)(ws + WS_WTOUT); bf16_t* WTGLU = (bf16_t*)(ws + WS_WTGLU); bf16_t* WT13 = (bf16_t*)(ws + WS_WT13); bf16_t* WT2 = (bf16_t*)(ws + WS_WT2); \
    const int vcu = (G % 8 == 0) ? (bid % 8) * (G / 8) + bid / 8 : bid; \
    const float* x = P.in[0]; const float* meta = P.in[1]; const float* norm_mix = P.in[2]; const float* norm_ffn = P.in[3]; const float* norm_final = P.in[4]; \
    const float* w_in = P.in[5]; const float* w_out = P.in[6]; const float* rpb = P.in[7]; const float* mu = P.in[8]; \
    const float* w0 = P.in[9]; const float* w_up = P.in[10]; const float* a0 = P.in[11]; const float* a_up = P.in[12]; const float* g_up = P.in[13]; \
    const float* k_k = P.in[14]; const float* k_a = P.in[15]; const float* r_k = P.in[16]; const float* lnx_g = P.in[17]; const float* lnx_b = P.in[18]; \
    const float* s5_b_re = P.in[19]; const float* s5_b_im = P.in[20]; const float* s5_lre = P.in[21]; const float* s5_lim = P.in[22]; const float* s5_ls = P.in[23]; \
    const float* s5_c_re = P.in[24]; const float* s5_c_im = P.in[25]; const float* s5_d = P.in[26]; const float* w_glu = P.in[27]; \
    const float* moe_wg = P.in[28]; const float* moe_bg = P.in[29]; const float* moe_we = P.in[30]; const float* moe_be = P.in[31]; \
    const float* moe_w1 = P.in[32]; const float* moe_w3 = P.in[33]; const float* moe_w2 = P.in[34];


__device__ __forceinline__ void transpose_item(const float* W, int N, int K, int k0, int n0, bf16_t* dstrow0, int lane) {
    const int nq = lane & 15, kb = lane >> 4;
    const float* src = W + (size_t)(k0 + 16 * kb) * N + n0 + 4 * nq;
    f32x4 v[16];
#pragma unroll
    for (int kk = 0; kk < 16; ++kk) v[kk] = *(const f32x4*)(src + (size_t)kk * N);
#pragma unroll
    for (int i = 0; i < 4; ++i) {
        bf16_t* d = dstrow0 + (size_t)(4 * nq + i) * K + k0 + 16 * kb;
        u32x4 lo, hi;
        lo.x = pk2(v[0][i], v[1][i]); lo.y = pk2(v[2][i], v[3][i]); lo.z = pk2(v[4][i], v[5][i]); lo.w = pk2(v[6][i], v[7][i]);
        hi.x = pk2(v[8][i], v[9][i]); hi.y = pk2(v[10][i], v[11][i]); hi.z = pk2(v[12][i], v[13][i]); hi.w = pk2(v[14][i], v[15][i]);
        *(u32x4*)d = lo; *(u32x4*)(d + 8) = hi;
    }
}
#define CONV_DENSE_ITEMS (832 + 256 + 512 + 48)
__device__ __forceinline__ void conv_dense_item(CParams& P, int it, int lane) {
    unsigned char* ws = P.ws;
    if (it < 832) { const int kb = it / 52, nb = it % 52; transpose_item(P.in[5], INCOLS, DM, kb * 64, nb * 64, (bf16_t*)(ws + WS_WTIN) + (size_t)nb * 64 * DM, lane); return; }
    it -= 832;
    if (it < 256) { const int kb = it / 16, nb = it % 16; transpose_item(P.in[6], DM, DM, kb * 64, nb * 64, (bf16_t*)(ws + WS_WTOUT) + (size_t)nb * 64 * DM, lane); return; }
    it -= 256;
    if (it < 512) { const int kb = it / 32, nb = it % 32, n = nb * 64, half = n >> 10, c = n & 1023, row = (c >> 7) * 256 + half * 128 + (c & 127);
      transpose_item(P.in[27], 2 * DM, DM, kb * 64, n, (bf16_t*)(ws + WS_WTGLU) + (size_t)row * DM, lane); return; }
    it -= 512;
    bf16_t* lrt = (bf16_t*)(ws + WS_LRT);
    if (it < 16) { const int d = it >> 3, nb = it & 7; transpose_item(P.in[10] + (size_t)d * 64 * 512, 512, 64, 0, nb * 64, lrt + ((size_t)d * 512 + nb * 64) * 64, lane); return; }
    it -= 16;
    if (it < 16) { const int d = it >> 3, nb = it & 7; transpose_item(P.in[12] + (size_t)d * 64 * 512, 512, 64, 0, nb * 64, lrt + (size_t)2 * 512 * 64 + ((size_t)d * 512 + nb * 64) * 64, lane); return; }
    it -= 16;
    { const int kb = it >> 3, nb = it & 7; transpose_item(P.in[13], 512, 128, kb * 64, nb * 64, lrt + (size_t)4 * 512 * 64 + (size_t)nb * 64 * 128, lane); }
}
#define CONV_MOE_ITEMS (NEXP * 384)
__device__ __forceinline__ void conv_moe_item(CParams& P, int l, int it, int lane) {
    unsigned char* ws = P.ws;
    const int e = it / 384; int r = it % 384;
    if (r < 256) { const int which = r >> 7; r &= 127; const int kb = r >> 3, nb = r & 7, n = nb * 64, row = (n >> 7) * 256 + which * 128 + (n & 127);
        const float* W = (which ? P.in[33] : P.in[32]) + ((size_t)(l * NEXP + e) * DM) * DFF;
        transpose_item(W, DFF, DM, kb * 64, n, (bf16_t*)(ws + WS_WT13) + ((size_t)e * DM + row) * DM, lane); return; }
    r -= 256;
    { const int kb = r >> 4, nb = r & 15; const float* W = P.in[34] + ((size_t)(l * NEXP + e) * DFF) * DM;
      transpose_item(W, DM, DFF, kb * 64, nb * 64, (bf16_t*)(ws + WS_WT2) + ((size_t)e * DM + nb * 64) * DFF, lane); }
}

template <int MODE>
__device__ __forceinline__ void meta_gemm(const bf16_t* A, const bf16_t* Bt, float* Hrows, int task, int lane) {
    const int fr = lane & 15, fq = lane >> 4, c = task * 16 + fr;
    const bf16_t* b0 = MODE == 0 ? Bt + (size_t)c * DM : Bt + (size_t)((c >> 7) * 256 + (c & 127)) * DM;
    const bf16_t* b1 = b0 + (size_t)128 * DM;
    f32x4 acc0[2], acc1[2];
    acc0[0] = acc0[1] = acc1[0] = acc1[1] = (f32x4){0.f, 0.f, 0.f, 0.f};
#pragma unroll 4
    for (int kt = 0; kt < 32; ++kt) {
        const int ko = kt * 32 + fq * 8;
        const bf16x8 a0 = *(const bf16x8*)(A + (size_t)fr * DM + ko), a1 = *(const bf16x8*)(A + (size_t)(16 + fr) * DM + ko);
        const bf16x8 bv = *(const bf16x8*)(b0 + ko);
        acc0[0] = __builtin_amdgcn_mfma_f32_16x16x32_bf16(a0, bv, acc0[0], 0, 0, 0);
        acc0[1] = __builtin_amdgcn_mfma_f32_16x16x32_bf16(a1, bv, acc0[1], 0, 0, 0);
        if (MODE == 1) { const bf16x8 bg = *(const bf16x8*)(b1 + ko);
            acc1[0] = __builtin_amdgcn_mfma_f32_16x16x32_bf16(a0, bg, acc1[0], 0, 0, 0);
            acc1[1] = __builtin_amdgcn_mfma_f32_16x16x32_bf16(a1, bg, acc1[1], 0, 0, 0); }
    }
#pragma unroll
    for (int mi = 0; mi < 2; ++mi)
#pragma unroll
        for (int j = 0; j < 4; ++j) { float* p = Hrows + (size_t)(mi * 16 + fq * 4 + j) * DM + c;
            if (MODE == 0) *p += acc0[mi][j]; else *p += acc0[mi][j] * __builtin_amdgcn_rcpf(1.f + __expf(-acc1[mi][j])); }
}
__device__ __forceinline__ void phase_0(CParams& P, unsigned char* lds, const int ph) {
    PHASE_PROLOGUE
            for (int row = gw; row < NT; row += NGW) {
                const float* src = row < NMAIN ? x + (size_t)row * DM : meta + (size_t)((row - NMAIN) & 15) * DM;
                f32x4 v[4];
#pragma unroll
                for (int j = 0; j < 4; ++j) { v[j] = ((const f32x4*)src)[lane + 64 * j]; ((f32x4*)(H + (size_t)row * DM))[lane + 64 * j] = v[j]; }
                store_norm_bf16(v, norm_mix, HN + (size_t)row * DM, lane);
            }
    for (int it = gw; it < CONV_DENSE_ITEMS; it += NGW) conv_dense_item(P, it, lane);
}

__device__ __forceinline__ void phase_1(CParams& P, unsigned char* lds, const int ph) {
    PHASE_PROLOGUE
    pg8::ProjOrder S; S.init(HN, WTIN, bid);
    pg8::EpiProj E{Qb, Kb, Vb, REST};
    pg8::gemm_phase<pg8::EpiProj, pg8::ProjOrder, true, true>((PG8_LAS unsigned char*)lds, DM, S, E);
}

__device__ __forceinline__ void phase_2(CParams& P, unsigned char* lds, const int ph) {
    PHASE_PROLOGUE
    float* sb = (float*)lds;
    for (int i = tid; i < 8 * 465; i += 512) sb[i] = rpb[i];
    __syncthreads();
    const bf16_t* VT = Vb;
    const int fr = lane & 15, fq = lane >> 4;
    for (int u = gw; u < 8192 + 16; u += NGW) {
        const bool metaq = u >= 8192;
        int b, h, r = 0, qb = 0;
        if (!metaq) { qb = u & 3; r = (u >> 2) & 127; h = (u >> 9) & 7; b = u >> 12; } else { const int m = u - 8192; b = m >> 3; h = m & 7; }
        const int c = qb * 16 + fr;
        const int qrow = metaq ? NMAIN + b * NMETA + fr : b * SEQ + r * 64 + c;
        const int R0 = min(max(r - 4, 0), 120), cs = qb == 0 ? 0 : (qb == 1 ? 8 : (qb == 2 ? 24 : 32));
        const int C0 = min(max(c - 8, 0), 48);
        bf16x8 qf0 = *(const bf16x8*)(Qb + (size_t)qrow * 512 + h * 64 + fq * 8), qf1 = *(const bf16x8*)(Qb + (size_t)qrow * 512 + h * 64 + 32 + fq * 8);
        f32x4 sacc[17];
        const f32x4 zero4 = (f32x4){0.f, 0.f, 0.f, 0.f};
        if (!metaq) {
#pragma unroll
            for (int kt = 0; kt < 16; ++kt) {
                const int krow0 = b * SEQ + (R0 + (kt >> 1)) * 64 + cs + 16 * (kt & 1);
                const bf16_t* kp = Kb + (size_t)(krow0 + fr) * 512 + h * 64 + fq * 8;
                const bf16x8 a0 = *(const bf16x8*)kp, a1 = *(const bf16x8*)(kp + 32);
                f32x4 acc = __builtin_amdgcn_mfma_f32_16x16x32_bf16(a0, qf0, zero4, 0, 0, 0);
                sacc[kt] = __builtin_amdgcn_mfma_f32_16x16x32_bf16(a1, qf1, acc, 0, 0, 0);
            }
        } else {
#pragma unroll
            for (int kt = 0; kt < 16; ++kt) sacc[kt] = zero4;
        }
        {
            const bf16_t* kp = Kb + (size_t)(NMAIN + b * NMETA + fr) * 512 + h * 64 + fq * 8;
            const bf16x8 a0 = *(const bf16x8*)kp, a1 = *(const bf16x8*)(kp + 32);
            f32x4 acc = __builtin_amdgcn_mfma_f32_16x16x32_bf16(a0, qf0, zero4, 0, 0, 0);
            sacc[16] = __builtin_amdgcn_mfma_f32_16x16x32_bf16(a1, qf1, acc, 0, 0, 0);
        }
        float mx = -1e30f;
#pragma unroll
        for (int kt = 0; kt < 16; ++kt) {
            const int dr = R0 + (kt >> 1) - r + 7;
#pragma unroll
            for (int j = 0; j < 4; ++j) {
                const int kc = cs + 16 * (kt & 1) + 4 * fq + j;
                const bool inb = !metaq && kc >= C0 && kc < C0 + 16;
                const int dc = min(max(kc - c + 15, 0), 30);
                const float s = inb ? sacc[kt][j] * 0.125f + sb[(h * 15 + dr) * 31 + dc] : -1e30f;
                sacc[kt][j] = s; mx = fmaxf(mx, s);
            }
        }
#pragma unroll
        for (int j = 0; j < 4; ++j) { const float s = sacc[16][j] * 0.125f; sacc[16][j] = s; mx = fmaxf(mx, s); }
        mx = fmaxf(mx, __shfl_xor(mx, 16)); mx = fmaxf(mx, __shfl_xor(mx, 32));
        float sum = 0.f;
#pragma unroll
        for (int kt = 0; kt < 17; ++kt)
#pragma unroll
            for (int j = 0; j < 4; ++j) { const float pv = __expf(sacc[kt][j] - mx); sacc[kt][j] = pv; sum += pv; }
        sum += __shfl_xor(sum, 16); sum += __shfl_xor(sum, 32);
        f32x4 o[4] = {zero4, zero4, zero4, zero4};
        if (!metaq) {
#pragma unroll
            for (int kr = 0; kr < 8; ++kr) {
                union { bf16x8 v; unsigned u[4]; } bf;
                bf.u[0] = pk2(sacc[2 * kr][0], sacc[2 * kr][1]); bf.u[1] = pk2(sacc[2 * kr][2], sacc[2 * kr][3]);
                bf.u[2] = pk2(sacc[2 * kr + 1][0], sacc[2 * kr + 1][1]); bf.u[3] = pk2(sacc[2 * kr + 1][2], sacc[2 * kr + 1][3]);
                const size_t tok0 = (size_t)b * SEQ + (R0 + kr) * 64 + cs + 4 * fq;
#pragma unroll
                for (int dt = 0; dt < 4; ++dt) {
                    const bf16_t* vp = VT + (size_t)(h * 64 + dt * 16 + fr) * NTP + tok0;
                    union { bf16x8 v; u32x2 h2[2]; } af;
                    af.h2[0] = *(const u32x2*)vp; af.h2[1] = *(const u32x2*)(vp + 16);
                    o[dt] = __builtin_amdgcn_mfma_f32_16x16x32_bf16(af.v, bf.v, o[dt], 0, 0, 0);
                }
            }
        }
        {
            union { bf16x8 v; unsigned u[4]; } bf;
            bf.u[0] = pk2(sacc[16][0], sacc[16][1]); bf.u[1] = pk2(sacc[16][2], sacc[16][3]); bf.u[2] = 0u; bf.u[3] = 0u;
            const size_t tokm = (size_t)NMAIN + b * NMETA + 4 * fq;
#pragma unroll
            for (int dt = 0; dt < 4; ++dt) {
                const bf16_t* vp = VT + (size_t)(h * 64 + dt * 16 + fr) * NTP + tokm;
                union { bf16x8 v; u32x2 h2[2]; } af;
                af.h2[0] = *(const u32x2*)vp; af.h2[1] = (u32x2){0u, 0u};
                o[dt] = __builtin_amdgcn_mfma_f32_16x16x32_bf16(af.v, bf.v, o[dt], 0, 0, 0);
            }
        }
        const float inv = 1.f / sum;
#pragma unroll
        for (int dt = 0; dt < 4; ++dt) {
            u32x2 ov; ov.x = pk2(o[dt][0] * inv, o[dt][1] * inv); ov.y = pk2(o[dt][2] * inv, o[dt][3] * inv);
            *(u32x2*)(A2 + (size_t)qrow * DM + h * 64 + dt * 16 + 4 * fq) = ov;
        }
    }
    __syncthreads();
}

__device__ __forceinline__ void phase_3(CParams& P, unsigned char* lds, const int ph) {
    PHASE_PROLOGUE
            for (int tk = gw; tk < NT; tk += NGW) {
                const int b = tk / LSEQ, p = tk % LSEQ, row = rowof(b, p);
                const bool hp = p > 0, hn = p + 1 < LSEQ;
                const int rowp = hp ? rowof(b, p - 1) : row, rown = hn ? rowof(b, p + 1) : row;
#pragma unroll
                for (int j = 0; j < 7; ++j) {
                    const int c = 4 * lane + 256 * j;
                    const u32x2 vc = *(const u32x2*)(REST + (size_t)row * RESTC + c);
                    u32x2 vp = *(const u32x2*)(REST + (size_t)rowp * RESTC + c);
                    u32x2 vn = *(const u32x2*)(REST + (size_t)rown * RESTC + c);
                    if (!hp) { vp.x = 0; vp.y = 0; }
                    if (!hn) { vn.x = 0; vn.y = 0; }
                    const f32x4 m4 = *(const f32x4*)(mu + c);
                    float pc[4] = {bflo(vc.x), bfhi(vc.x), bflo(vc.y), bfhi(vc.y)};
                    float pp[4] = {bflo(vp.x), bfhi(vp.x), bflo(vp.y), bfhi(vp.y)};
                    float pn[4] = {bflo(vn.x), bfhi(vn.x), bflo(vn.y), bfhi(vn.y)};
                    float o[4];
#pragma unroll
                    for (int i = 0; i < 4; ++i) o[i] = pc[i] + m4[i] * (0.5f * (pp[i] + pn[i]) - pc[i]);
                    if (j == 6) {
                        if (lane < 16) { for (int i = 0; i < 4; ++i) o[i] = tanhf(o[i]); }
                        else if (lane >= 32) { for (int i = 0; i < 4; ++i) o[i] = sigmoidf_(o[i]); }
                    }
                    u32x2 ov; ov.x = pk2(o[0], o[1]); ov.y = pk2(o[2], o[3]);
                    bf16_t* dst = j < 2 ? Rr + (size_t)row * 512 + c : (j < 4 ? KR + (size_t)row * 512 + (c - 512) : (j < 6 ? VV + (size_t)row * 512 + (c - 1024) : LOW + (size_t)row * 256 + (c - 1536)));
                    *(u32x2*)dst = ov;
                }
            }
}


__device__ __forceinline__ void phase_4(CParams& P, unsigned char* lds, const int ph) {
    PHASE_PROLOGUE
    constexpr int AST = 264, SST = 136;
    bf16_t* As = (bf16_t*)lds;
    unsigned short* stg = (unsigned short*)(lds + 64 * AST * 2);
    const bf16_t* lrt = (const bf16_t*)(ws + WS_LRT);
    const int fr = lane & 15, fq = lane >> 4;
    const int nrt = (NT + 63) / 64;
    for (int u = bid; u < nrt; u += G) {
        for (int i = tid; i < 64 * 32; i += 512) { const int r = i >> 5, pc = (i & 31) * 8; int row = u * 64 + r; if (row >= NT) row = NT - 1;
            *(u32x4*)(As + r * AST + pc) = *(const u32x4*)(LOW + (size_t)row * 256 + pc); }
        __syncthreads();
#define P4_LOADB(t_, bv_, bias_) do { const int wh_ = (t_) >> 2, ct_ = (t_) & 3, Kw_ = wh_ < 4 ? 64 : 128, col_ = ct_ * 128 + 16 * wave + fr; \
            const bf16_t* Wt_ = lrt + (wh_ < 4 ? (size_t)wh_ * 512 * 64 : (size_t)4 * 512 * 64) + (size_t)col_ * Kw_ + 8 * fq; \
            bv_[0] = *(const bf16x8*)Wt_; bv_[1] = *(const bf16x8*)(Wt_ + 32); if (wh_ == 4) { bv_[2] = *(const bf16x8*)(Wt_ + 64); bv_[3] = *(const bf16x8*)(Wt_ + 96); } \
            bias_ = wh_ < 2 ? w0[wh_ * 512 + col_] : (wh_ < 4 ? a0[(wh_ - 2) * 512 + col_] : 0.f); } while (0)
        bf16x8 bnx[4]; float biasn;
        P4_LOADB(0, bnx, biasn);
#pragma unroll 1
        for (int t = 0; t < 20; ++t) {
            const int which = t >> 2, ct = t & 3;
            const int koff = which < 2 ? 0 : (which < 4 ? 64 : 128);
            bf16x8 bcur[4]; bcur[0] = bnx[0]; bcur[1] = bnx[1]; bcur[2] = bnx[2]; bcur[3] = bnx[3];
            const float bias = biasn;
            if (t + 1 < 20) P4_LOADB(t + 1, bnx, biasn);
            const f32x4 zero4 = (f32x4){0.f, 0.f, 0.f, 0.f};
            f32x4 acc[4] = {zero4, zero4, zero4, zero4};
#pragma unroll
            for (int ks = 0; ks < 4; ++ks) {
                if (ks < 2 || which == 4) {
#pragma unroll
                    for (int rt = 0; rt < 4; ++rt) acc[rt] = __builtin_amdgcn_mfma_f32_16x16x32_bf16(*(const bf16x8*)(As + (16 * rt + fr) * AST + koff + 32 * ks + 8 * fq), bcur[ks], acc[rt], 0, 0, 0);
                }
            }
            unsigned short* sg = stg + (t & 1) * 64 * SST + 16 * wave + fr;
#pragma unroll
            for (int rt = 0; rt < 4; ++rt)
#pragma unroll
                for (int j = 0; j < 4; ++j) { const float val = acc[rt][j] + bias; unsigned short o;
                    if (which < 2) { const _Float16 hv = (_Float16)(-0.6065306597f * sigmoidf_(val)); o = __builtin_bit_cast(unsigned short, hv); }
                    else if (which < 4) o = (unsigned short)f2bf(sigmoidf_(val));
                    else o = (unsigned short)f2bf(val);
                    sg[(16 * rt + 4 * fq + j) * SST] = o; }
            __syncthreads();
            {
                unsigned short* dst = which < 2 ? (unsigned short*)LW + (size_t)which * NT * 512 : (which < 4 ? (unsigned short*)AA + (size_t)(which - 2) * NT * 512 : (unsigned short*)Gg);
                const int r = tid >> 3, pc = (tid & 7) * 16, row = u * 64 + r;
                const unsigned short* sp = stg + (t & 1) * 64 * SST + r * SST + pc;
                if (row < NT) { *(u32x4*)(dst + (size_t)row * 512 + ct * 128 + pc) = *(const u32x4*)sp; *(u32x4*)(dst + (size_t)row * 512 + ct * 128 + pc + 8) = *(const u32x4*)(sp + 8); }
            }
        }
        __syncthreads();
#undef P4_LOADB
    }
}


__device__ __forceinline__ void phase_5(CParams& P, unsigned char* lds, const int ph) {
    PHASE_PROLOGUE
            for (int row = gw; row < NT; row += NGW) {
                const int c0 = lane * 8;
                const u32x4 krv = *(const u32x4*)(KR + (size_t)row * 512 + c0);
                const u32x4 rv = *(const u32x4*)(Rr + (size_t)row * 512 + c0);
                float kr[8], rr[8], kkv[8];
#pragma unroll
                for (int i = 0; i < 4; ++i) { kr[2 * i] = bflo(krv[i]); kr[2 * i + 1] = bfhi(krv[i]); rr[2 * i] = bflo(rv[i]); rr[2 * i + 1] = bfhi(rv[i]); }
                float ss = 0.f;
#pragma unroll
                for (int i = 0; i < 8; ++i) { kkv[i] = kr[i] * k_k[c0 + i]; ss += kkv[i] * kkv[i]; }
                ss += __shfl_xor(ss, 1); ss += __shfl_xor(ss, 2); ss += __shfl_xor(ss, 4);
                const float inv = 1.f / fmaxf(sqrtf(ss), 1e-12f);
#pragma unroll
                for (int i = 0; i < 8; ++i) kkv[i] *= inv;
                u32x4 o; o.x = pk2(kkv[0], kkv[1]); o.y = pk2(kkv[2], kkv[3]); o.z = pk2(kkv[4], kkv[5]); o.w = pk2(kkv[6], kkv[7]);
                *(u32x4*)(KK + (size_t)row * 512 + c0) = o;
                float bsum = 0.f;
#pragma unroll
                for (int d = 0; d < 2; ++d) {
                    const u32x4 av = *(const u32x4*)(AA + ((size_t)d * NT + row) * 512 + c0);
                    float a[8], kka[8], kd[8];
#pragma unroll
                    for (int i = 0; i < 4; ++i) { a[2 * i] = bflo(av[i]); a[2 * i + 1] = bfhi(av[i]); }
#pragma unroll
                    for (int i = 0; i < 8; ++i) { kka[i] = kkv[i] * a[i]; kd[i] = kr[i] * (1.f + (a[i] - 1.f) * k_a[c0 + i]); bsum += rr[i] * kd[i] * r_k[c0 + i]; }
                    u32x4 o1; o1.x = pk2(kka[0], kka[1]); o1.y = pk2(kka[2], kka[3]); o1.z = pk2(kka[4], kka[5]); o1.w = pk2(kka[6], kka[7]);
                    *(u32x4*)(KKA + ((size_t)d * NT + row) * 512 + c0) = o1;
                    u32x4 o2; o2.x = pk2(kd[0], kd[1]); o2.y = pk2(kd[2], kd[3]); o2.z = pk2(kd[4], kd[5]); o2.w = pk2(kd[6], kd[7]);
                    *(u32x4*)(KD + ((size_t)d * NT + row) * 512 + c0) = o2;
                }
                bsum += __shfl_xor(bsum, 1); bsum += __shfl_xor(bsum, 2); bsum += __shfl_xor(bsum, 4);
                if ((lane & 7) == 0) BC[(size_t)row * 8 + (lane >> 3)] = bsum;
            }
}


#define RWS 72
__device__ __forceinline__ bf16x8 rw_frag(const bf16_t* M, int row, int kofs) { return *(const bf16x8*)(M + row * RWS + kofs); }
__device__ __forceinline__ f32x4 rw_tile(const bf16_t* Am, int ra, const bf16_t* Bm, int rb, int fr, int fq) {
    f32x4 acc = (f32x4){0.f, 0.f, 0.f, 0.f};
    acc = __builtin_amdgcn_mfma_f32_16x16x32_bf16(rw_frag(Am, ra + fr, 8 * fq), rw_frag(Bm, rb + fr, 8 * fq), acc, 0, 0, 0);
    acc = __builtin_amdgcn_mfma_f32_16x16x32_bf16(rw_frag(Am, ra + fr, 32 + 8 * fq), rw_frag(Bm, rb + fr, 32 + 8 * fq), acc, 0, 0, 0);
    return acc;
}
__device__ __forceinline__ void phase_6(CParams& P, unsigned char* lds, const int ph) {
    PHASE_PROLOGUE
    float* Gs = (float*)lds;
    bf16_t* A_rm = (bf16_t*)(lds + 16384); bf16_t* R_rm = A_rm + 64 * RWS; bf16_t* B_rm = R_rm + 64 * RWS; bf16_t* K_rm = B_rm + 64 * RWS;
    bf16_t* B_tr = K_rm + 64 * RWS; bf16_t* K_tr = B_tr + 64 * RWS; bf16_t* V_tr = K_tr + 64 * RWS;
    bf16_t* MAK = V_tr + 64 * RWS; bf16_t* MRB = MAK + 64 * RWS; bf16_t* MRK = MRB + 64 * RWS;
    bf16_t* MABr = MRK + 64 * RWS;
    float* RHS = (float*)(MABr + 64 * RWS);
    float* BT = RHS + 8192; float* OFF = BT + 512; float* GC = OFF + 512;
    bf16_t* X1_tr = A_rm; bf16_t* X2_tr = K_rm;
    for (int i = tid; i < 4 * 64 * RWS / 2; i += 512) ((unsigned*)MAK)[i] = 0u;
    __syncthreads();
    const int fr = lane & 15, fq = lane >> 4;
    for (int u = bid; u < RW_UNITS; u += G) {
        const int chain = u / RW_NCH, c = u - chain * RW_NCH, d = chain >> 4, b = (chain >> 3) & 1, h = chain & 7;
        const int t0 = tid >> 3, kp = (tid & 7) * 8;
        float lw[8], kk[8], ka[8], kd[8], rr[8]; u32x4 vv;
        {
            const int s = c * 64 + t0; const bool valid = s < LSEQ;
            const int p = d ? LSEQ - 1 - s : s; const size_t o = (size_t)rowof(b, valid ? p : 0) * 512 + h * 64 + kp;
            const u32x4 lwv = *(const u32x4*)(LW + (size_t)d * NT * 512 + o), kkv = *(const u32x4*)(KK + o), kav = *(const u32x4*)(KKA + (size_t)d * NT * 512 + o),
                        kdv = *(const u32x4*)(KD + (size_t)d * NT * 512 + o), rv = *(const u32x4*)(Rr + o);
            vv = *(const u32x4*)(VV + o);
#pragma unroll
            for (int i = 0; i < 4; ++i) {
                union { unsigned u; _Float16 hh[2]; } cv; cv.u = lwv[i];
                lw[2 * i] = valid ? (float)cv.hh[0] : 0.f; lw[2 * i + 1] = valid ? (float)cv.hh[1] : 0.f;
                kk[2 * i] = valid ? bflo(kkv[i]) : 0.f; kk[2 * i + 1] = valid ? bfhi(kkv[i]) : 0.f;
                ka[2 * i] = valid ? bflo(kav[i]) : 0.f; ka[2 * i + 1] = valid ? bfhi(kav[i]) : 0.f;
                kd[2 * i] = valid ? bflo(kdv[i]) : 0.f; kd[2 * i + 1] = valid ? bfhi(kdv[i]) : 0.f;
                rr[2 * i] = valid ? bflo(rv[i]) : 0.f; rr[2 * i + 1] = valid ? bfhi(rv[i]) : 0.f;
                if (!valid) vv[i] = 0u;
            }
        }
        *(f32x4*)(Gs + t0 * 64 + kp) = (f32x4){lw[0], lw[1], lw[2], lw[3]}; *(f32x4*)(Gs + t0 * 64 + kp + 4) = (f32x4){lw[4], lw[5], lw[6], lw[7]};
        __syncthreads();
        { const int k = tid & 63, w = tid >> 6; float acc = 0.f;
#pragma unroll
          for (int i = 0; i < 8; ++i) { acc += Gs[(8 * w + i) * 64 + k]; Gs[(8 * w + i) * 64 + k] = acc; }
          BT[w * 64 + k] = acc; }
        __syncthreads();
        { const int k = tid & 63, w = tid >> 6; float off = 0.f; for (int w2 = 0; w2 < w; ++w2) off += BT[w2 * 64 + k]; OFF[w * 64 + k] = off; }
        __syncthreads();
        {
            float va[8], vr[8], vb[8], vk[8];
#pragma unroll
            for (int i = 0; i < 8; ++i) {
                const float g = Gs[t0 * 64 + kp + i] + OFF[(t0 >> 3) * 64 + kp + i];
                const float eg = __expf(g), egm1 = __expf(g - lw[i]), einv = __expf(-g);
                va[i] = kk[i] * egm1; vr[i] = rr[i] * eg; vb[i] = ka[i] * einv; vk[i] = kd[i] * einv;
                if (t0 == 63) GC[kp + i] = eg;
            }
            *(f32x4*)(RHS + t0 * 128 + kp) = (f32x4){va[0], va[1], va[2], va[3]}; *(f32x4*)(RHS + t0 * 128 + kp + 4) = (f32x4){va[4], va[5], va[6], va[7]};
            u32x4 w4;
            w4.x = pk2(va[0], va[1]); w4.y = pk2(va[2], va[3]); w4.z = pk2(va[4], va[5]); w4.w = pk2(va[6], va[7]); *(u32x4*)(A_rm + t0 * RWS + kp) = w4;
            w4.x = pk2(vr[0], vr[1]); w4.y = pk2(vr[2], vr[3]); w4.z = pk2(vr[4], vr[5]); w4.w = pk2(vr[6], vr[7]); *(u32x4*)(R_rm + t0 * RWS + kp) = w4;
            w4.x = pk2(vb[0], vb[1]); w4.y = pk2(vb[2], vb[3]); w4.z = pk2(vb[4], vb[5]); w4.w = pk2(vb[6], vb[7]); *(u32x4*)(B_rm + t0 * RWS + kp) = w4;
            w4.x = pk2(vk[0], vk[1]); w4.y = pk2(vk[2], vk[3]); w4.z = pk2(vk[4], vk[5]); w4.w = pk2(vk[6], vk[7]); *(u32x4*)(K_rm + t0 * RWS + kp) = w4;
#pragma unroll
            for (int i = 0; i < 8; ++i) { B_tr[(kp + i) * RWS + t0] = (bf16_t)f2bf(vb[i]); K_tr[(kp + i) * RWS + t0] = (bf16_t)f2bf(vk[i]);
                V_tr[(kp + i) * RWS + t0] = (bf16_t)((i & 1) ? (vv[i >> 1] >> 16) : (vv[i >> 1] & 0xffffu)); }
        }
        __syncthreads();
        float* DQ = Gs; bf16_t* TB = (bf16_t*)BT;
#ifndef RW1_REP1
#define RW1_REP1 1
#endif
        for (int rep_ = 0; rep_ < RW1_REP1; ++rep_)
        for (int q = wave; q < 40; q += 8) {
            const int m = q / 10, e = q - m * 10, ti = e >= 6 ? 3 : (e >= 3 ? 2 : (e >= 1 ? 1 : 0)), tj = e - (ti * (ti + 1)) / 2;
            const f32x4 acc = rw_tile(m < 2 ? A_rm : R_rm, 16 * ti, (m & 1) ? K_rm : B_rm, 16 * tj, fr, fq);
            bf16_t* Mm = m == 1 ? MAK : (m == 2 ? MRB : MRK);
#pragma unroll
            for (int j = 0; j < 4; ++j) { const int t = 16 * ti + 4 * fq + j, i = 16 * tj + fr; const bool keep = m < 2 ? (i < t) : (i <= t); const float val = keep ? acc[j] : 0.f;
                if (m == 0) { MABr[t * RWS + i] = (bf16_t)f2bf(val); if (ti == tj) DQ[((ti * 16 + (t & 15)) * 4 + (fr & 3)) * 4 + (fr >> 2)] = val; }
                else Mm[t * RWS + i] = (bf16_t)f2bf(val); }
        }
        __syncthreads();
        if (wave >= 4) {
            for (int q = wave - 4; q < 16; q += 4) { const int ti = q >> 2, tv = q & 3; const f32x4 acc = rw_tile(MAK, 16 * ti, V_tr, 16 * tv, fr, fq);
#pragma unroll
                for (int j = 0; j < 4; ++j) RHS[(16 * ti + 4 * fq + j) * 128 + 64 + 16 * tv + fr] = acc[j]; }
        } else {
            const int bb = wave, cc = lane >> 2, q = lane & 3;
            float xs[4] = {0.f, 0.f, 0.f, 0.f};
#pragma unroll
            for (int tl = 0; tl < 16; ++tl) {
                const f32x4 mv = *(const f32x4*)(DQ + ((bb * 16 + tl) * 4 + q) * 4);
                float part = mv[0] * xs[0] + mv[1] * xs[1] + mv[2] * xs[2] + mv[3] * xs[3];
                part += dppf<0xB1>(part); part += dppf<0x4E>(part);
                const float xt = (tl == cc ? 1.f : 0.f) - part;
                xs[tl >> 2] = (tl & 3) == q ? xt : xs[tl >> 2];
            }
#pragma unroll
            for (int m = 0; m < 4; ++m) TB[(bb * 16 + 4 * m + q) * 16 + cc] = (bf16_t)f2bf(xs[m]);
        }
        __syncthreads();
        {
            const int c0 = 16 * wave;
            f32x4 X[4];
            const f32x4 zero4 = (f32x4){0.f, 0.f, 0.f, 0.f};
#define RW1_PACK(lo_, hi_, v_) do { union { bf16x8 v; unsigned u[4]; } t_; t_.u[0] = pk2(lo_[0], lo_[1]); t_.u[1] = pk2(lo_[2], lo_[3]); t_.u[2] = pk2(hi_[0], hi_[1]); t_.u[3] = pk2(hi_[2], hi_[3]); v_ = t_.v; } while (0)
#define RW1_LDA(base_, row0_, ca_, cb_, useb_, v_) do { union { bf16x8 v; u32x2 h2[2]; } t_; t_.h2[0] = *(const u32x2*)((base_) + ((row0_) + fr) * RWS + (ca_) + 4 * fq); \
            t_.h2[1] = (useb_) ? *(const u32x2*)((base_) + ((row0_) + fr) * RWS + (cb_) + 4 * fq) : (u32x2){0u, 0u}; v_ = t_.v; } while (0)
#pragma unroll
            for (int bq = 0; bq < 4; ++bq) {
                f32x4 acc;
#pragma unroll
                for (int j = 0; j < 4; ++j) acc[j] = -RHS[(16 * bq + 4 * fq + j) * 128 + c0 + fr];
                bf16x8 af, bfv;
                if (bq >= 1) { RW1_LDA(MABr, 16 * bq, 0, 16, bq >= 2, af); if (bq >= 2) RW1_PACK(X[0], X[1], bfv); else RW1_PACK(X[0], zero4, bfv);
                    acc = __builtin_amdgcn_mfma_f32_16x16x32_bf16(af, bfv, acc, 0, 0, 0); }
                if (bq == 3) { RW1_LDA(MABr, 48, 32, 0, false, af); RW1_PACK(X[2], zero4, bfv); acc = __builtin_amdgcn_mfma_f32_16x16x32_bf16(af, bfv, acc, 0, 0, 0); }
                const f32x4 wv = (f32x4){-acc[0], -acc[1], -acc[2], -acc[3]};
                { union { bf16x8 v; u32x2 h2[2]; } t_; t_.h2[0] = *(const u32x2*)(TB + (bq * 16 + fr) * 16 + 4 * fq); t_.h2[1] = (u32x2){0u, 0u}; af = t_.v; }
                RW1_PACK(wv, zero4, bfv);
                X[bq] = __builtin_amdgcn_mfma_f32_16x16x32_bf16(af, bfv, zero4, 0, 0, 0);
                bf16_t* Xm = (wave < 4 ? X1_tr : X2_tr) + ((c0 & 63) + fr) * RWS + 16 * bq + 4 * fq;
                u32x2 o; o.x = pk2(X[bq][0], X[bq][1]); o.y = pk2(X[bq][2], X[bq][3]);
                *(u32x2*)Xm = o;
            }
#undef RW1_PACK
#undef RW1_LDA
        }
        __syncthreads();
#ifndef RW1_REP5
#define RW1_REP5 1
#endif
        for (int rep_ = 0; rep_ < RW1_REP5; ++rep_)
        for (int q = wave; q < 64; q += 8) {
            const int kind = q >> 4, ta = (q >> 2) & 3, tb = q & 3;
            u32x2 o;
            if (kind == 0) {
                const f32x4 acc = rw_tile(X1_tr, 16 * ta, B_tr, 16 * tb, fr, fq);
                const int k = 16 * tb + fr, kq = 16 * ta + 4 * fq; const float gc = GC[k];
                float v[4];
#pragma unroll
                for (int j = 0; j < 4; ++j) v[j] = gc * ((kq + j == k ? 1.f : 0.f) - acc[j]);
                o.x = pk2(v[0], v[1]); o.y = pk2(v[2], v[3]);
                *(u32x2*)(PP + (size_t)u * 4096 + k * 64 + 32 * (ta >> 1) + 8 * fq + 4 * (ta & 1)) = o;
            } else if (kind == 1) {
                const f32x4 acc = rw_tile(X1_tr, 16 * ta, MRB, 16 * tb, fr, fq);
                const int t = 16 * tb + fr, k0 = 16 * ta + 4 * fq;
                const u32x2 rv = *(const u32x2*)(R_rm + t * RWS + k0);
                o.x = pk2(bflo(rv.x) - acc[0], bfhi(rv.x) - acc[1]); o.y = pk2(bflo(rv.y) - acc[2], bfhi(rv.y) - acc[3]);
                *(u32x2*)(YT + (size_t)u * 4096 + t * 64 + 32 * (ta >> 1) + 8 * fq + 4 * (ta & 1)) = o;
            } else if (kind == 2) {
                const f32x4 a1 = rw_tile(K_tr, 16 * ta, V_tr, 16 * tb, fr, fq), a2 = rw_tile(B_tr, 16 * ta, X2_tr, 16 * tb, fr, fq);
                const int v_ = 16 * tb + fr, k0 = 16 * ta + 4 * fq;
                const f32x4 gc = *(const f32x4*)(GC + k0);
                o.x = pk2(gc[0] * (a1[0] - a2[0]), gc[1] * (a1[1] - a2[1])); o.y = pk2(gc[2] * (a1[2] - a2[2]), gc[3] * (a1[3] - a2[3]));
                *(u32x2*)(QT + (size_t)u * 4096 + v_ * 64 + k0) = o;
            } else {
                const f32x4 a1 = rw_tile(MRK, 16 * ta, V_tr, 16 * tb, fr, fq), a2 = rw_tile(MRB, 16 * ta, X2_tr, 16 * tb, fr, fq);
                const int v_ = 16 * tb + fr, t0_ = 16 * ta + 4 * fq;
                o.x = pk2(a1[0] - a2[0], a1[1] - a2[1]); o.y = pk2(a1[2] - a2[2], a1[3] - a2[3]);
                *(u32x2*)(ZT + (size_t)u * 4096 + v_ * 64 + t0_) = o;
            }
        }
        __syncthreads();
    }
}

__device__ __forceinline__ void phase_60(CParams& P, unsigned char* lds, const int ph) {
    PHASE_PROLOGUE
    if (bid < 32) {
        const int chain = bid, d = chain >> 4, b = (chain >> 3) & 1, h = chain & 7;
        const int fr = lane & 15, fq = lane >> 4;
        constexpr int MATB = 64 * RWS * 2, SLOT = 4 * MATB;
        bf16_t* ybuf = (bf16_t*)(lds + 3 * SLOT);
        const bool comp = wave < 4; const int vb = wave & 3, lm = wave & 3;
        const unsigned char* src = (const unsigned char*)(lm == 0 ? PP : (lm == 1 ? YT : (lm == 2 ? QT : ZT))) + (size_t)chain * RW_NCH * 8192 + lane * 16;
        u32x4 R0[8], R1[8], R2[8];
#define RW2_LD(Rx, c_) do { _Pragma("unroll") for (int i_ = 0; i_ < 8; ++i_) Rx[i_] = *(const u32x4*)(src + (size_t)(c_) * 8192 + i_ * 1024); } while (0)
#define RW2_ST(Rx, c_) do { unsigned char* dst_ = lds + ((c_) % 3) * SLOT + lm * MATB; _Pragma("unroll") for (int i_ = 0; i_ < 8; ++i_) { const int p_ = lane + 64 * i_; *(u32x4*)(dst_ + (p_ >> 3) * (RWS * 2) + (p_ & 7) * 16) = Rx[i_]; } } while (0)
#define RW2_FLUSH(c_) do { const int tl_ = 16 * lm + (lane >> 2), s_ = (c_) * 64 + tl_; const bf16_t* yb_ = ybuf + ((c_) & 1) * 64 * RWS + tl_ * RWS + 16 * (lane & 3); \
            const u32x4 y0_ = *(const u32x4*)yb_, y1_ = *(const u32x4*)(yb_ + 8); \
            if (s_ < LSEQ) { const int p_ = d ? LSEQ - 1 - s_ : s_; bf16_t* g_ = YFB + ((size_t)d * NT + rowof(b, p_)) * 512 + h * 64 + 16 * (lane & 3); *(u32x4*)g_ = y0_; *(u32x4*)(g_ + 8) = y1_; } } while (0)
        const f32x4 zero4 = (f32x4){0.f, 0.f, 0.f, 0.f};
        f32x4 S[4] = {zero4, zero4, zero4, zero4};
#define RW2_COMPUTE(c_) do { const bf16_t* sl_ = (const bf16_t*)(lds + ((c_) % 3) * SLOT); const bf16_t* sP = sl_; const bf16_t* sY = sl_ + 64 * RWS; const bf16_t* sQ = sl_ + 2 * 64 * RWS; const bf16_t* sZ = sl_ + 3 * 64 * RWS; \
            bf16_t* yo_ = ybuf + ((c_) & 1) * 64 * RWS + 16 * vb + fr; \
            union { bf16x8 v; unsigned u[4]; } bs[2]; \
            _Pragma("unroll") for (int ks = 0; ks < 2; ++ks) { bs[ks].u[0] = pk2(S[2 * ks][0], S[2 * ks][1]); bs[ks].u[1] = pk2(S[2 * ks][2], S[2 * ks][3]); \
                bs[ks].u[2] = pk2(S[2 * ks + 1][0], S[2 * ks + 1][1]); bs[ks].u[3] = pk2(S[2 * ks + 1][2], S[2 * ks + 1][3]); } \
            _Pragma("unroll") for (int tt = 0; tt < 4; ++tt) { \
                const u32x2 z2 = *(const u32x2*)(sZ + (16 * vb + fr) * RWS + 16 * tt + 4 * fq); \
                f32x4 acc = (f32x4){bflo(z2.x), bfhi(z2.x), bflo(z2.y), bfhi(z2.y)}; \
                acc = __builtin_amdgcn_mfma_f32_16x16x32_bf16(*(const bf16x8*)(sY + (16 * tt + fr) * RWS + 8 * fq), bs[0].v, acc, 0, 0, 0); \
                acc = __builtin_amdgcn_mfma_f32_16x16x32_bf16(*(const bf16x8*)(sY + (16 * tt + fr) * RWS + 32 + 8 * fq), bs[1].v, acc, 0, 0, 0); \
                _Pragma("unroll") for (int j = 0; j < 4; ++j) yo_[(16 * tt + 4 * fq + j) * RWS] = (bf16_t)f2bf(acc[j]); } \
            f32x4 Sn[4]; \
            _Pragma("unroll") for (int kt = 0; kt < 4; ++kt) { \
                const u32x2 q2 = *(const u32x2*)(sQ + (16 * vb + fr) * RWS + 16 * kt + 4 * fq); \
                f32x4 acc = (f32x4){bflo(q2.x), bfhi(q2.x), bflo(q2.y), bfhi(q2.y)}; \
                acc = __builtin_amdgcn_mfma_f32_16x16x32_bf16(*(const bf16x8*)(sP + (16 * kt + fr) * RWS + 8 * fq), bs[0].v, acc, 0, 0, 0); \
                acc = __builtin_amdgcn_mfma_f32_16x16x32_bf16(*(const bf16x8*)(sP + (16 * kt + fr) * RWS + 32 + 8 * fq), bs[1].v, acc, 0, 0, 0); \
                Sn[kt] = acc; } \
            _Pragma("unroll") for (int kt = 0; kt < 4; ++kt) S[kt] = Sn[kt]; } while (0)
#define RW2_BAR() do { asm volatile("s_waitcnt lgkmcnt(0)" ::: "memory"); __builtin_amdgcn_s_barrier(); asm volatile("" ::: "memory"); } while (0)
        if (!comp) { RW2_LD(R0, 0); RW2_ST(R0, 0); RW2_LD(R0, 1); RW2_LD(R1, 2); RW2_LD(R2, 3); }
        __syncthreads();
        for (int c = 0; c < RW_NCH; c += 3) {
            if (!comp) { if (c + 1 < RW_NCH) RW2_ST(R0, c + 1); if (c + 4 < RW_NCH) RW2_LD(R0, c + 4); if (c > 0) RW2_FLUSH(c - 1); } else RW2_COMPUTE(c);
            RW2_BAR();
            if (!comp) { if (c + 2 < RW_NCH) RW2_ST(R1, c + 2); if (c + 5 < RW_NCH) RW2_LD(R1, c + 5); RW2_FLUSH(c); } else RW2_COMPUTE(c + 1);
            RW2_BAR();
            if (!comp) { if (c + 3 < RW_NCH) RW2_ST(R2, c + 3); if (c + 6 < RW_NCH) RW2_LD(R2, c + 6); RW2_FLUSH(c + 1); } else RW2_COMPUTE(c + 2);
            RW2_BAR();
        }
        if (!comp) RW2_FLUSH(RW_NCH - 1);
#undef RW2_LD
#undef RW2_ST
#undef RW2_FLUSH
#undef RW2_COMPUTE
#undef RW2_BAR
    }
}

__device__ __forceinline__ void phase_7(CParams& P, unsigned char* lds, const int ph) {
    PHASE_PROLOGUE
            for (int row = gw; row < NT; row += NGW) {
                const int c0 = lane * 8;
                const u32x4 yf = *(const u32x4*)(YFB + (size_t)row * 512 + c0);
                const u32x4 yb = *(const u32x4*)(YFB + ((size_t)NT + row) * 512 + c0);
                const u32x4 vv = *(const u32x4*)(VV + (size_t)row * 512 + c0);
                const u32x4 gg = *(const u32x4*)(Gg + (size_t)row * 512 + c0);
                float y[8], v[8], g[8];
#pragma unroll
                for (int i = 0; i < 4; ++i) { y[2 * i] = bflo(yf[i]) + bflo(yb[i]); y[2 * i + 1] = bfhi(yf[i]) + bfhi(yb[i]); v[2 * i] = bflo(vv[i]); v[2 * i + 1] = bfhi(vv[i]); g[2 * i] = bflo(gg[i]); g[2 * i + 1] = bfhi(gg[i]); }
                float sm = 0.f;
#pragma unroll
                for (int i = 0; i < 8; ++i) sm += y[i];
                sm += __shfl_xor(sm, 1); sm += __shfl_xor(sm, 2); sm += __shfl_xor(sm, 4);
                const float mean = sm * (1.f / 64.f);
                float vr = 0.f;
#pragma unroll
                for (int i = 0; i < 8; ++i) { const float dlt = y[i] - mean; vr += dlt * dlt; }
                vr += __shfl_xor(vr, 1); vr += __shfl_xor(vr, 2); vr += __shfl_xor(vr, 4);
                const float rstd = rsqrtf(vr * (1.f / 64.f) + 64e-5f);
                const float bc = BC[(size_t)row * 8 + (lane >> 3)];
                float o[8];
#pragma unroll
                for (int i = 0; i < 8; ++i) o[i] = ((y[i] - mean) * rstd * lnx_g[c0 + i] + lnx_b[c0 + i] + bc * v[i]) * g[i];
                u32x4 ov; ov.x = pk2(o[0], o[1]); ov.y = pk2(o[2], o[3]); ov.z = pk2(o[4], o[5]); ov.w = pk2(o[6], o[7]);
                *(u32x4*)(A2 + (size_t)row * DM + 512 + c0) = ov;
            }
}


__device__ __forceinline__ void phase_8(CParams& P, unsigned char* lds, const int ph) {
    PHASE_PROLOGUE
    if (gw < 64) meta_gemm<0>(A2 + (size_t)NMAIN * DM, WTOUT, H + (size_t)NMAIN * DM, gw, lane);
    pg8::DenseOrder S; S.init(A2, WTOUT, NMAIN, DM, DM, G, bid);
    pg8::EpiResidual E{H};
    pg8::gemm_phase<pg8::EpiResidual, pg8::DenseOrder, true, true>((PG8_LAS unsigned char*)lds, DM, S, E);
}

__device__ __forceinline__ void phase_9(CParams& P, unsigned char* lds, const int ph) {
    PHASE_PROLOGUE
            const int l = ph == 9 ? 0 : 1;
                    unsigned* cnt = CTL + CW_CNT(l);
            const float* wg = moe_wg + (size_t)l * DM * 4; const float* bg = moe_bg + l * 4;
            for (int row = gw; row < NT; row += NGW) {
                f32x4 v[4]; float ss = 0.f;
#pragma unroll
                for (int j = 0; j < 4; ++j) { v[j] = ((const f32x4*)(H + (size_t)row * DM))[lane + 64 * j]; ss += v[j][0] * v[j][0] + v[j][1] * v[j][1] + v[j][2] * v[j][2] + v[j][3] * v[j][3]; }
                ss = wave_sum(ss);
                const float rstd = rsqrtf(ss * (1.f / DM) + 1e-6f);
                float lg[4] = {0.f, 0.f, 0.f, 0.f};
#pragma unroll
                for (int j = 0; j < 4; ++j) {
                    const f32x4 g = ((const f32x4*)(norm_ffn + l * DM))[lane + 64 * j];
#pragma unroll
                    for (int i = 0; i < 4; ++i) v[j][i] = v[j][i] * rstd * g[i];
                    u32x2 o; o.x = pk2(v[j][0], v[j][1]); o.y = pk2(v[j][2], v[j][3]);
                    ((u32x2*)(HN + (size_t)row * DM))[lane + 64 * j] = o;
#pragma unroll
                    for (int i = 0; i < 4; ++i) { const f32x4 w = *(const f32x4*)(wg + (size_t)(4 * (lane + 64 * j) + i) * 4);
                        lg[0] += v[j][i] * w[0]; lg[1] += v[j][i] * w[1]; lg[2] += v[j][i] * w[2]; lg[3] += v[j][i] * w[3]; }
                }
#pragma unroll
                for (int q = 0; q < 4; ++q) lg[q] = wave_sum(lg[q]) + bg[q];
                int grp = 0; float mx = lg[0];
#pragma unroll
                for (int q = 1; q < 4; ++q) if (lg[q] > mx) { mx = lg[q]; grp = q; }
                float den = 0.f;
#pragma unroll
                for (int q = 0; q < 4; ++q) den += __expf(lg[q] - mx);
                const float pgrp = 1.f / den;
                const float* we = moe_we + ((size_t)(l * 4 + grp) * DM) * 8;
                float le[8] = {0.f, 0.f, 0.f, 0.f, 0.f, 0.f, 0.f, 0.f};
#pragma unroll
                for (int j = 0; j < 4; ++j)
#pragma unroll
                    for (int i = 0; i < 4; ++i) { const float* wr_ = we + (size_t)(4 * (lane + 64 * j) + i) * 8; const f32x4 wa = *(const f32x4*)wr_, wb = *(const f32x4*)(wr_ + 4);
                        le[0] += v[j][i] * wa[0]; le[1] += v[j][i] * wa[1]; le[2] += v[j][i] * wa[2]; le[3] += v[j][i] * wa[3];
                        le[4] += v[j][i] * wb[0]; le[5] += v[j][i] * wb[1]; le[6] += v[j][i] * wb[2]; le[7] += v[j][i] * wb[3]; }
#pragma unroll
                for (int q = 0; q < 8; ++q) le[q] = wave_sum(le[q]) + moe_be[(l * 4 + grp) * 8 + q];
                int i1 = 0; float m1 = le[0];
#pragma unroll
                for (int q = 1; q < 8; ++q) if (le[q] > m1) { m1 = le[q]; i1 = q; }
                int i2 = (i1 + 1) & 7; float m2 = -3.0e38f;
#pragma unroll
                for (int q = 0; q < 8; ++q) if (q != i1 && le[q] > m2) { m2 = le[q]; i2 = q; }
                const float e2 = __expf(m2 - m1);
                const float g1 = pgrp / (1.f + e2), g2 = pgrp * e2 / (1.f + e2);
                if (lane == 0) {
                    const int ea = grp * 8 + i1, eb = grp * 8 + i2;
                    const unsigned pa = atomicAdd(cnt + ea, 1u), pb = atomicAdd(cnt + eb, 1u);
                    EID[row * 2] = ea; EID[row * 2 + 1] = eb; POS[row * 2] = (int)pa; POS[row * 2 + 1] = (int)pb;
                    GATE[row * 2] = g1; GATE[row * 2 + 1] = g2;
                }
            }
    for (int it = gw; it < CONV_MOE_ITEMS; it += NGW) conv_moe_item(P, l, it, lane);
}


__device__ __forceinline__ void phase_10(CParams& P, unsigned char* lds, const int ph) {
    PHASE_PROLOGUE
    const int l = ph == 10 ? 0 : 1;
    int* ps = (int*)(lds + LDS_TAB);
    if (tid == 0) { int acc_ = 0; for (int e = 0; e < NEXP; ++e) { ps[e] = acc_; const int c = (int)CTL[CW_CNT(l) + e]; acc_ += (c + MOE_RT - 1) / MOE_RT * MOE_RT; } ps[NEXP] = acc_; }
    __syncthreads();
    for (int row = gw; row < NT; row += NGW) {
        const u32x4 v0 = ((const u32x4*)(HN + (size_t)row * DM))[lane], v1 = ((const u32x4*)(HN + (size_t)row * DM))[lane + 64];
#pragma unroll
        for (int k = 0; k < 2; ++k) {
            const int dest = ps[EID[row * 2 + k]] + POS[row * 2 + k];
            if (lane == 0) DEST[row * 2 + k] = dest;
            ((u32x4*)(XB + (size_t)dest * DM))[lane] = v0; ((u32x4*)(XB + (size_t)dest * DM))[lane + 64] = v1;
        }
    }
    __syncthreads();
}

__device__ __forceinline__ void phase_11(CParams& P, unsigned char* lds, const int ph) {
    PHASE_PROLOGUE
    const int l = ph == 11 ? 0 : 1;
    int* et = (int*)(lds + LDS_TAB);
    if (tid == 0) { int acc_ = 0; for (int e = 0; e < NEXP; ++e) { const int c = (int)CTL[CW_CNT(l) + e], n = (c + MOE_RT - 1) / MOE_RT; for (int q = 0; q < n; ++q) et[1 + acc_ + q] = e; acc_ += n; } et[0] = acc_; }
    __syncthreads();
    pg8::MoeOrder S{et + 1, et[0], vcu, (const char*)XB, (const char*)WT13, 256u * DM * 2u, 256u * DM * 2u, (unsigned)DM * DM * 2u};
    pg8::EpiSwiglu E{HB};
    pg8::gemm_phase<pg8::EpiSwiglu, pg8::MoeOrder, true, true>((PG8_LAS unsigned char*)lds, DM, S, E);
    __syncthreads();
}

__device__ __forceinline__ void phase_12(CParams& P, unsigned char* lds, const int ph) {
    PHASE_PROLOGUE
    const int l = ph == 12 ? 0 : 1;
    int* et = (int*)(lds + LDS_TAB);
    if (tid == 0) { int acc_ = 0; for (int e = 0; e < NEXP; ++e) { const int c = (int)CTL[CW_CNT(l) + e], n = (c + MOE_RT - 1) / MOE_RT; for (int q = 0; q < n; ++q) et[1 + acc_ + q] = e; acc_ += n; } et[0] = acc_; }
    __syncthreads();
    pg8::MoeOrder S{et + 1, et[0], vcu, (const char*)HB, (const char*)WT2, 256u * DFF * 2u, 256u * DFF * 2u, (unsigned)DM * DFF * 2u};
    pg8::EpiBf16Plain E{YB, DM};
    pg8::gemm_phase<pg8::EpiBf16Plain, pg8::MoeOrder, true, true>((PG8_LAS unsigned char*)lds, DFF, S, E);
    __syncthreads();
}

__device__ __forceinline__ void phase_13(CParams& P, unsigned char* lds, const int ph) {
    PHASE_PROLOGUE
            const bool fin = ph == 21;
            for (int row = gw; row < NT; row += NGW) {
                const int d0 = DEST[row * 2], d1 = DEST[row * 2 + 1];
                const float g0 = GATE[row * 2], g1 = GATE[row * 2 + 1];
                f32x4 v[4];
#pragma unroll
                for (int j = 0; j < 4; ++j) {
                    v[j] = ((const f32x4*)(H + (size_t)row * DM))[lane + 64 * j];
                    const u32x2 ya = ((const u32x2*)(YB + (size_t)d0 * DM))[lane + 64 * j];
                    const u32x2 yb = ((const u32x2*)(YB + (size_t)d1 * DM))[lane + 64 * j];
                    v[j][0] += g0 * bflo(ya.x) + g1 * bflo(yb.x); v[j][1] += g0 * bfhi(ya.x) + g1 * bfhi(yb.x);
                    v[j][2] += g0 * bflo(ya.y) + g1 * bflo(yb.y); v[j][3] += g0 * bfhi(ya.y) + g1 * bfhi(yb.y);
                }
                if (!fin) {
#pragma unroll
                    for (int j = 0; j < 4; ++j) ((f32x4*)(H + (size_t)row * DM))[lane + 64 * j] = v[j];
                    store_norm_bf16(v, norm_mix + DM, HN + (size_t)row * DM, lane);
                } else if (row < NMAIN) {
                    float ss = 0.f;
#pragma unroll
                    for (int j = 0; j < 4; ++j) ss += v[j][0] * v[j][0] + v[j][1] * v[j][1] + v[j][2] * v[j][2] + v[j][3] * v[j][3];
                    ss = wave_sum(ss);
                    const float rstd = rsqrtf(ss * (1.f / DM) + 1e-6f);
#pragma unroll
                    for (int j = 0; j < 4; ++j) { const f32x4 g = ((const f32x4*)norm_final)[lane + 64 * j]; f32x4 o;
                        o[0] = v[j][0] * rstd * g[0]; o[1] = v[j][1] * rstd * g[1]; o[2] = v[j][2] * rstd * g[2]; o[3] = v[j][3] * rstd * g[3];
                        ((f32x4*)(P.out + (size_t)row * DM))[lane + 64 * j] = o; }
                }
            }
}

__device__ __forceinline__ void phase_14(CParams& P, unsigned char* lds, const int ph) {
    PHASE_PROLOGUE
    float* pwr = (float*)lds; float* pwi = pwr + 2176; float* bbr = pwi + 2176; float* bbi = bbr + 2048; float* ccr = bbi + 2048; float* cci = ccr + 2048; float* kf = cci + 2048; float* kb = kf + 4096;
    for (int gu = bid; gu < 256; gu += G) {
        const int g = gu >> 2, part = gu & 3;
        if (tid < 128) {
            const int d = tid >> 6, p = tid & 63;
            const float step = __expf(s5_ls[d * 64 + g]);
            const float lr = s5_lre[(d * 64 + g) * 64 + p], li = s5_lim[(d * 64 + g) * 64 + p];
            const float mag = expf(lr * step);
            const float abr = mag * cosf(li * step), abi = mag * sinf(li * step);
            const float den = lr * lr + li * li;
            const float zr = ((abr - 1.f) * lr + abi * li) / den, zi = (abi * lr - (abr - 1.f) * li) / den;
            float pr = 1.f, pi = 0.f;
            for (int t = 0; t < 17; ++t) { pwr[(d * 64 + p) * 17 + t] = pr; pwi[(d * 64 + p) * 17 + t] = pi; const float nr = pr * abr - pi * abi; pi = pr * abi + pi * abr; pr = nr; }
            for (int i = 0; i < 16; ++i) { const float br = s5_b_re[((size_t)(g * 64 + p)) * 16 + i], bi = s5_b_im[((size_t)(g * 64 + p)) * 16 + i];
                bbr[(d * 64 + p) * 16 + i] = zr * br - zi * bi; bbi[(d * 64 + p) * 16 + i] = zr * bi + zi * br; }
        }
        for (int idx = tid; idx < 2048; idx += 512) { const int d = idx >> 10, i = (idx >> 6) & 15, p = idx & 63;
            ccr[idx] = s5_c_re[((size_t)(d * 64 + g) * 16 + i) * 64 + p]; cci[idx] = s5_c_im[((size_t)(d * 64 + g) * 16 + i) * 64 + p]; }
        __syncthreads();
        {
            const int d = tid >> 8, tau = (tid >> 4) & 15, i = tid & 15;
            float acc[16];
#pragma unroll
            for (int q = 0; q < 16; ++q) acc[q] = 0.f;
            for (int p = 0; p < 64; ++p) {
                const float cr = ccr[(d * 16 + i) * 64 + p], ci = cci[(d * 16 + i) * 64 + p], pr = pwr[(d * 64 + p) * 17 + tau], pi = pwi[(d * 64 + p) * 17 + tau];
                const float xr = cr * pr - ci * pi, xi = cr * pi + ci * pr;
#pragma unroll
                for (int q = 0; q < 16; ++q) acc[q] += xr * bbr[(d * 64 + p) * 16 + q] - xi * bbi[(d * 64 + p) * 16 + q];
            }
            float* kt = (d ? kb : kf) + (tau * 16 + i) * 16;
#pragma unroll
            for (int q = 0; q < 16; ++q) kt[q] = acc[q];
        }
        __syncthreads();
        unsigned* bta = (unsigned*)(BTA + (size_t)g * 512 * 256);
        for (int idx = part * 128 * 128 + tid; idx < (part + 1) * 128 * 128; idx += 512) {
            const int row = idx >> 7, col = (idx & 127) * 2;
            float v[2];
#pragma unroll
            for (int e = 0; e < 2; ++e) {
                const int cc_ = col + e, j = cc_ >> 4, ip = cc_ & 15;
                if (row < 256) { const int t = row >> 4, i = row & 15;
                    v[e] = j < t ? kf[((t - j) * 16 + i) * 16 + ip] : (j > t ? kb[((j - t) * 16 + i) * 16 + ip] : kf[i * 16 + ip] + kb[i * 16 + ip]); }
                else { const int kp = row - 256, d = kp >> 7, part = (kp >> 6) & 1, p = kp & 63, tau = d == 0 ? 15 - j : j;
                    const float pr = pwr[(d * 64 + p) * 17 + tau], pi = pwi[(d * 64 + p) * 17 + tau], br = bbr[(d * 64 + p) * 16 + ip], bi = bbi[(d * 64 + p) * 16 + ip];
                    v[e] = part ? pr * bi + pi * br : pr * br - pi * bi; }
            }
            bta[idx] = pk2(v[0], v[1]);
        }
        unsigned* btc = (unsigned*)(BTC + (size_t)g * 256 * 256);
        for (int idx = part * 64 * 128 + tid; idx < (part + 1) * 64 * 128; idx += 512) {
            const int row = idx >> 7, col = (idx & 127) * 2, t = row >> 4, i = row & 15;
            float v[2];
#pragma unroll
            for (int e = 0; e < 2; ++e) {
                const int k = col + e, d = k >> 7, part = (k >> 6) & 1, p = k & 63, tau = d == 0 ? t + 1 : 16 - t;
                const float cr = ccr[(d * 16 + i) * 64 + p], ci = cci[(d * 16 + i) * 64 + p], pr = pwr[(d * 64 + p) * 17 + tau], pi = pwi[(d * 64 + p) * 17 + tau];
                v[e] = part ? -(cr * pi + ci * pr) : cr * pr - ci * pi;
            }
            btc[idx] = pk2(v[0], v[1]);
        }
        __syncthreads();
    }
}

__device__ __forceinline__ void phase_15(CParams& P, unsigned char* lds, const int ph) {
    PHASE_PROLOGUE
    pg8::S5OrderA S{vcu, (const char*)HN, (const char*)BTA};
    pg8::EpiS5A E{YI, S5E};
    int Kr = 256; asm volatile("" : "+s"(Kr));
    pg8::gemm_phase<pg8::EpiS5A, pg8::S5OrderA, true, true>((PG8_LAS unsigned char*)lds, Kr, S, E);
}

__device__ __forceinline__ void phase_16(CParams& P, unsigned char* lds, const int ph) {
    PHASE_PROLOGUE
    for (int i = bid * 512 + tid; i < NB * 64 * 2 * 64; i += G * 512) {
        const int p = i & 63, d = (i >> 6) & 1, g = (i >> 7) & 63, b = i >> 13;
        const float step = __expf(s5_ls[d * 64 + g]);
        const float lr = s5_lre[(d * 64 + g) * 64 + p], li = s5_lim[(d * 64 + g) * 64 + p];
        const float mag = expf(lr * step);
        const float abr = mag * cosf(li * step), abi = mag * sinf(li * step);
        float ar = 1.f, ai = 0.f;
        for (int t = 0; t < 16; ++t) { const float nr = ar * abr - ai * abi; ai = ar * abi + ai * abr; ar = nr; }
        const float* Ep = S5E + (size_t)g * 256 + d * 128 + p;
        bf16_t* Cp = CAR + (size_t)g * 1280 * 256 + d * 128 + p;
        float sr = 0.f, si = 0.f;
        for (int q0 = 0; q0 < 513; q0 += 9) {
            float er[9], ei[9]; int nn[9];
#pragma unroll
            for (int k = 0; k < 9; ++k) { const int q = q0 + k, c = d ? 512 - q : q; nn[k] = c == 0 ? 1024 + b : b * 512 + c - 1; er[k] = Ep[(size_t)nn[k] * 64 * 256]; ei[k] = Ep[(size_t)nn[k] * 64 * 256 + 64]; }
#pragma unroll
            for (int k = 0; k < 9; ++k) { Cp[(size_t)nn[k] * 256] = (bf16_t)f2bf(sr); Cp[(size_t)nn[k] * 256 + 64] = (bf16_t)f2bf(si);
                const float nr = ar * sr - ai * si + er[k]; si = ar * si + ai * sr + ei[k]; sr = nr; }
        }
    }
}

__device__ __forceinline__ void phase_22(CParams& P, unsigned char* lds, const int ph) {
    PHASE_PROLOGUE
    pg8::S5OrderC S{vcu, (const char*)CAR, (const char*)BTC};
    pg8::EpiS5C E{YI, HN, s5_d, A2};
    int Kr = 256; asm volatile("" : "+s"(Kr));
    pg8::gemm_phase<pg8::EpiS5C, pg8::S5OrderC, true, true>((PG8_LAS unsigned char*)lds, Kr, S, E);
}

__device__ __forceinline__ void phase_23(CParams& P, unsigned char* lds, const int ph) {
    PHASE_PROLOGUE
    if (gw < 64) meta_gemm<1>(A2 + (size_t)NMAIN * DM, WTGLU, H + (size_t)NMAIN * DM, gw, lane);
    pg8::DenseOrder S; S.init(A2, WTGLU, NMAIN, 2 * DM, DM, G, bid);
    pg8::EpiGlu E{H};
    pg8::gemm_phase<pg8::EpiGlu, pg8::DenseOrder, true, true>((PG8_LAS unsigned char*)lds, DM, S, E);
}
#define LAS __attribute__((address_space(3)))
#define CW_BAR 4096
#define XB_TMO      128
#define XB_XCNT(j)  (256  + 64 * (j))
#define XB_XSUB(j)  (1280 + 64 * (j))
#define XB_XGEN(j)  (2304 + 64 * (j))
#define XB_TOP      3328
#define XB_TOPGEN   3392
#define XCD_BAR_WORDS 3456
#define XB_SPIN_CAP (1u << 22)
__device__ __forceinline__ unsigned xb_ld(unsigned* p)              { return __hip_atomic_load(p, __ATOMIC_RELAXED, __HIP_MEMORY_SCOPE_AGENT); }
__device__ __forceinline__ unsigned xb_add(unsigned* p, unsigned v) { return __hip_atomic_fetch_add(p, v, __ATOMIC_RELAXED, __HIP_MEMORY_SCOPE_AGENT); }
__device__ __forceinline__ unsigned xb_xcc_id() { return (unsigned)__builtin_amdgcn_s_getreg((3 << 11) | 20) & 0xFu; }
#define XB_SPIN(cond, bar) do { unsigned _sp = 0; while (cond) { __builtin_amdgcn_s_sleep(1); \
    if ((++_sp & 255u) == 0u) { if (xb_ld(&(bar)[XB_TMO])) break; if (_sp > XB_SPIN_CAP) { atomicAdd(&(bar)[XB_TMO], 1u); break; } } } } while (0)
struct XcdBarrier { unsigned* bar; unsigned x; volatile LAS unsigned* st; };
__device__ __forceinline__ XcdBarrier xcd_barrier_post(unsigned* bar, volatile LAS unsigned* st) {
    XcdBarrier b; b.bar = bar; b.x = xb_xcc_id(); b.st = st;
    if (threadIdx.x == 0) (void)xb_add(&bar[XB_XCNT(b.x)], 1u);
    return b;
}
__device__ __forceinline__ void xcd_barrier_complete(unsigned* bar, unsigned x, unsigned& nloc, unsigned& nx) {
    const unsigned G = GRID;
    unsigned sum, cnt, mine, sp = 0u;
    for (;;) {
        sum = 0u; cnt = 0u; mine = 0u;
#pragma unroll
        for (unsigned j = 0; j < 16; ++j) { const unsigned c = xb_ld(&bar[XB_XCNT(j)]); sum += c; cnt += (c > 0u) ? 1u : 0u; mine = (j == x) ? c : mine; }
        if (sum == G) break;
        __builtin_amdgcn_s_sleep(1);
        if ((++sp & 255u) == 0u) { if (xb_ld(&bar[XB_TMO])) break; if (sp > XB_SPIN_CAP) { atomicAdd(&bar[XB_TMO], 1u); break; } }
    }
    nloc = mine > 0u ? mine : 1u; nx = cnt > 0u ? cnt : 1u;
}
__device__ __forceinline__ void xcd_barrier(const XcdBarrier& b) {
    asm volatile("s_waitcnt vmcnt(0)" ::: "memory");
    __syncthreads();
    if (threadIdx.x == 0) {
        unsigned* bar = b.bar;
        __builtin_amdgcn_s_waitcnt(0);
        unsigned nloc = b.st[0], nx = b.st[1];
        if (nloc == 0u) { xcd_barrier_complete(bar, b.x, nloc, nx); b.st[0] = nloc; b.st[1] = nx; }
        const unsigned old = xb_add(&bar[XB_XSUB(b.x)], 1u);
        const unsigned gen = old / nloc;
        if (old + 1u == (gen + 1u) * nloc) {
            __builtin_amdgcn_fence(__ATOMIC_RELEASE, "agent");
            asm volatile("s_waitcnt vmcnt(0)" ::: "memory");
            const unsigned og = xb_add(&bar[XB_TOP], 1u);
            const unsigned tg = og / nx;
            if (og + 1u == (tg + 1u) * nx) xb_add(&bar[XB_TOPGEN], 1u);
            else XB_SPIN(xb_ld(&bar[XB_TOPGEN]) == tg, bar);
            __builtin_amdgcn_fence(__ATOMIC_ACQUIRE, "agent");
            xb_add(&bar[XB_XGEN(b.x)], 1u);
            asm volatile("s_waitcnt vmcnt(0)" ::: "memory");
        } else {
            XB_SPIN(xb_ld(&bar[XB_XGEN(b.x)]) == gen, bar);
            __builtin_amdgcn_fence(__ATOMIC_ACQUIRE, "agent");
            asm volatile("s_waitcnt vmcnt(0)" ::: "memory");
        }
    }
    __syncthreads();
}


__global__ void __launch_bounds__(512, 2) mega(Params P_) {
    extern __shared__ __attribute__((aligned(16))) unsigned char lds[];
    volatile LAS unsigned* st = (volatile LAS unsigned*)(LAS unsigned char*)(lds + LDS_BARST);
    if (threadIdx.x < 16) st[threadIdx.x] = 0u;
    __syncthreads();
    CParams* pp = (CParams*)__builtin_amdgcn_kernarg_segment_ptr();
    (void)xcd_barrier_post((unsigned*)(pp->ws + WS_CTL) + CW_BAR, st);
#define GB do { XcdBarrier bar_; bar_.bar = (unsigned*)(pp->ws + WS_CTL) + CW_BAR; bar_.x = xb_xcc_id(); bar_.st = (volatile LAS unsigned*)(LAS unsigned char*)(lds + LDS_BARST); xcd_barrier(bar_); asm volatile("" : "+s"(pp)); } while (0)
#define P (*pp)
    asm volatile("" : "+s"(pp));
    phase_0(P, lds, 0); GB;
#if defined(PROBE_PH) && PROBE_PH == 0
    { int nrep = PROBE_N; asm volatile("" : "+s"(nrep)); for (int rep = 0; rep < nrep; ++rep) { GB; phase_0(P, lds, 0); GB; } }
#endif
    phase_1(P, lds, 1); GB;
#if defined(PROBE_PH) && PROBE_PH == 1
    { int nrep = PROBE_N; asm volatile("" : "+s"(nrep)); for (int rep = 0; rep < nrep; ++rep) { GB; phase_1(P, lds, 1); GB; } }
#endif
    phase_2(P, lds, 2); asm volatile("" : "+s"(pp));
#if defined(PROBE_PH) && PROBE_PH == 2
    { int nrep = PROBE_N; asm volatile("" : "+s"(nrep)); for (int rep = 0; rep < nrep; ++rep) { GB; phase_2(P, lds, 2); GB; } }
#endif
    phase_3(P, lds, 3); GB;
#if defined(PROBE_PH) && PROBE_PH == 3
    { int nrep = PROBE_N; asm volatile("" : "+s"(nrep)); for (int rep = 0; rep < nrep; ++rep) { GB; phase_3(P, lds, 3); GB; } }
#endif
    phase_4(P, lds, 4); GB;
#if defined(PROBE_PH) && PROBE_PH == 4
    { int nrep = PROBE_N; asm volatile("" : "+s"(nrep)); for (int rep = 0; rep < nrep; ++rep) { GB; phase_4(P, lds, 4); GB; } }
#endif
    phase_5(P, lds, 5); GB;
#if defined(PROBE_PH) && PROBE_PH == 5
    { int nrep = PROBE_N; asm volatile("" : "+s"(nrep)); for (int rep = 0; rep < nrep; ++rep) { GB; phase_5(P, lds, 5); GB; } }
#endif
    phase_6(P, lds, 6); GB;
    phase_60(P, lds, 60); GB;
#if defined(PROBE_PH) && PROBE_PH == 60
    { int nrep = PROBE_N; asm volatile("" : "+s"(nrep)); for (int rep = 0; rep < nrep; ++rep) { GB; phase_60(P, lds, 60); GB; } }
#endif
#if defined(PROBE_PH) && PROBE_PH == 6
    { int nrep = PROBE_N; asm volatile("" : "+s"(nrep)); for (int rep = 0; rep < nrep; ++rep) { GB; phase_6(P, lds, 6); GB; } }
#endif
    phase_7(P, lds, 7); GB;
#if defined(PROBE_PH) && PROBE_PH == 7
    { int nrep = PROBE_N; asm volatile("" : "+s"(nrep)); for (int rep = 0; rep < nrep; ++rep) { GB; phase_7(P, lds, 7); GB; } }
#endif
    phase_8(P, lds, 8); GB;
#if defined(PROBE_PH) && PROBE_PH == 8
    { int nrep = PROBE_N; asm volatile("" : "+s"(nrep)); for (int rep = 0; rep < nrep; ++rep) { GB; phase_8(P, lds, 8); GB; } }
#endif
    phase_9(P, lds, 9); GB;
#if defined(PROBE_PH) && PROBE_PH == 9
    { int nrep = PROBE_N; asm volatile("" : "+s"(nrep)); for (int rep = 0; rep < nrep; ++rep) { GB; phase_9(P, lds, 9); GB; } }
#endif
    phase_10(P, lds, 10); GB;
#if defined(PROBE_PH) && PROBE_PH == 10
    { int nrep = PROBE_N; asm volatile("" : "+s"(nrep)); for (int rep = 0; rep < nrep; ++rep) { GB; phase_10(P, lds, 10); GB; } }
#endif
    phase_11(P, lds, 11); GB;
#if defined(PROBE_PH) && PROBE_PH == 11
    { int nrep = PROBE_N; asm volatile("" : "+s"(nrep)); for (int rep = 0; rep < nrep; ++rep) { GB; phase_11(P, lds, 11); GB; } }
#endif
    phase_12(P, lds, 12); GB;
#if defined(PROBE_PH) && PROBE_PH == 12
    { int nrep = PROBE_N; asm volatile("" : "+s"(nrep)); for (int rep = 0; rep < nrep; ++rep) { GB; phase_12(P, lds, 12); GB; } }
#endif
    phase_13(P, lds, 13); GB;
#if defined(PROBE_PH) && PROBE_PH == 13
    { int nrep = PROBE_N; asm volatile("" : "+s"(nrep)); for (int rep = 0; rep < nrep; ++rep) { GB; phase_13(P, lds, 13); GB; } }
#endif
    phase_14(P, lds, 14); GB;
#if defined(PROBE_PH) && PROBE_PH == 14
    { int nrep = PROBE_N; asm volatile("" : "+s"(nrep)); for (int rep = 0; rep < nrep; ++rep) { GB; phase_14(P, lds, 14); GB; } }
#endif
    phase_15(P, lds, 15); GB;
#if defined(PROBE_PH) && PROBE_PH == 15
    { int nrep = PROBE_N; asm volatile("" : "+s"(nrep)); for (int rep = 0; rep < nrep; ++rep) { GB; phase_15(P, lds, 15); GB; } }
#endif
    phase_16(P, lds, 16); GB;
#if defined(PROBE_PH) && PROBE_PH == 16
    { int nrep = PROBE_N; asm volatile("" : "+s"(nrep)); for (int rep = 0; rep < nrep; ++rep) { GB; phase_16(P, lds, 16); GB; } }
#endif
    phase_22(P, lds, 22); GB;
#if defined(PROBE_PH) && PROBE_PH == 22
    { int nrep = PROBE_N; asm volatile("" : "+s"(nrep)); for (int rep = 0; rep < nrep; ++rep) { GB; phase_22(P, lds, 22); GB; } }
#endif
    phase_23(P, lds, 23); GB;
#if defined(PROBE_PH) && PROBE_PH == 23
    { int nrep = PROBE_N; asm volatile("" : "+s"(nrep)); for (int rep = 0; rep < nrep; ++rep) { GB; phase_23(P, lds, 23); GB; } }
#endif
    phase_9(P, lds, 17); GB;
#if defined(PROBE_PH) && PROBE_PH == 17
    { int nrep = PROBE_N; asm volatile("" : "+s"(nrep)); for (int rep = 0; rep < nrep; ++rep) { GB; phase_9(P, lds, 17); GB; } }
#endif
    phase_10(P, lds, 18); GB;
#if defined(PROBE_PH) && PROBE_PH == 18
    { int nrep = PROBE_N; asm volatile("" : "+s"(nrep)); for (int rep = 0; rep < nrep; ++rep) { GB; phase_10(P, lds, 18); GB; } }
#endif
    phase_11(P, lds, 19); GB;
#if defined(PROBE_PH) && PROBE_PH == 19
    { int nrep = PROBE_N; asm volatile("" : "+s"(nrep)); for (int rep = 0; rep < nrep; ++rep) { GB; phase_11(P, lds, 19); GB; } }
#endif
    phase_12(P, lds, 20); GB;
#if defined(PROBE_PH) && PROBE_PH == 20
    { int nrep = PROBE_N; asm volatile("" : "+s"(nrep)); for (int rep = 0; rep < nrep; ++rep) { GB; phase_12(P, lds, 20); GB; } }
#endif
    phase_13(P, lds, 21);
#if defined(PROBE_PH) && PROBE_PH == 21
    { int nrep = PROBE_N; asm volatile("" : "+s"(nrep)); for (int rep = 0; rep < nrep; ++rep) { GB; phase_13(P, lds, 21); GB; } }
#endif
#undef P
#undef GB
}

extern "C" void kernel_launch(void* const* d_in, const int* in_sizes, int n_in, void* d_out, int out_size, void* d_ws, size_t ws_size, hipStream_t stream) {
    static int ready = 0;
    if (!ready) {
        if (n_in != 35 || ws_size < WS_TOTAL) { fprintf(stderr, "kernel_launch: unexpected n_in %d or ws_size %zu (need %zu)\n", n_in, ws_size, (size_t)WS_TOTAL); ready = -1; return; }
        if (hipFuncSetAttribute((const void*)mega, hipFuncAttributeMaxDynamicSharedMemorySize, LDS_BYTES) != hipSuccess) { fprintf(stderr, "kernel_launch: hipFuncSetAttribute failed\n"); ready = -1; return; }
        ready = 1;
    }
    if (ready < 0) return;
    (void)hipMemsetAsync((char*)d_ws + WS_CTL, 0, 1 * MiB, stream);
    Params P{};
    for (int i = 0; i < 35; ++i) P.in[i] = (const float*)d_in[i];
    P.out = (float*)d_out; P.ws = (unsigned char*)d_ws; P.ph_lo = 0; P.ph_hi = 0;
    hipLaunchKernelGGL(mega, dim3(GRID), dim3(512), LDS_BYTES, stream, P);
}
```

```cpp
#include <hip/hip_runtime.h>
#include <stdint.h>
#include <stdio.h>

#define DM 1024
#define NB 2
#define SEQ 8192
#define NMETA 16
#define LSEQ (SEQ + NMETA)
#define NMAIN (NB * SEQ)
#define NT (NB * LSEQ)
#define NTP 16640
#define INCOLS 3328
#define RESTC 1792
#define NEXP 32
#define DFF 512
#define S5TC 48
#define S5NC 171
#define MOE_RT 256
#define MOE_MAXROWS 41216

typedef unsigned short bf16_t;
typedef short bf16x8 __attribute__((ext_vector_type(8)));
typedef float f32x4 __attribute__((ext_vector_type(4)));
typedef unsigned u32x4 __attribute__((ext_vector_type(4)));
typedef unsigned u32x2 __attribute__((ext_vector_type(2)));

constexpr size_t MiB = 1u << 20;
constexpr size_t cmax2(size_t a, size_t b) { return a > b ? a : b; }
constexpr size_t al64k(size_t x) { return (x + 65535) & ~(size_t)65535; }
constexpr size_t WS_CTL = 0;
constexpr size_t WS_H = 1 * MiB;
constexpr size_t WS_HN = WS_H + al64k((size_t)NT * DM * 4);
constexpr size_t WS_A2 = WS_HN + al64k((size_t)NTP * DM * 2);
constexpr size_t WS_WTIN = WS_A2 + al64k((size_t)NTP * DM * 2);
constexpr size_t WS_WTOUT = WS_WTIN + al64k((size_t)INCOLS * DM * 2);
constexpr size_t WS_WTGLU = WS_WTOUT + al64k((size_t)DM * DM * 2);
constexpr size_t WS_LRT = WS_WTGLU + al64k((size_t)2 * DM * DM * 2);
constexpr size_t WS_BIG = WS_LRT + al64k((size_t)(2 * 512 * 64 * 2 + 512 * 128) * 2);
constexpr size_t SZ_T512 = al64k((size_t)NT * 512 * 2);
constexpr size_t SZ_P512 = al64k((size_t)NTP * 512 * 2);
constexpr int RW_NCH = 129, RW_UNITS = 32 * RW_NCH;
constexpr size_t SZ_RWOP = al64k((size_t)RW_UNITS * 4096 * 2);
constexpr size_t WS_Q = WS_BIG;
constexpr size_t WS_K = WS_Q + SZ_P512;
constexpr size_t WS_V = WS_K + SZ_P512;
constexpr size_t WS_REST = WS_V + SZ_P512;
constexpr size_t WS_KR = WS_REST + al64k((size_t)NTP * RESTC * 2);
constexpr size_t WS_LOW = WS_KR + SZ_T512;
constexpr size_t WS_AA = WS_LOW + al64k((size_t)NT * 256 * 2);
constexpr size_t WS_XEARLY = WS_AA + 2 * SZ_T512;
constexpr size_t WS_PP = WS_REST;
constexpr size_t WS_QT = WS_PP + SZ_RWOP;
constexpr size_t WS_YT = WS_QT + SZ_RWOP;
constexpr size_t WS_ZT = WS_YT + SZ_RWOP;
constexpr size_t WS_XEND = cmax2(WS_XEARLY, WS_ZT + SZ_RWOP);
constexpr size_t WS_R = WS_XEND;
constexpr size_t WS_VV = WS_R + SZ_T512;
constexpr size_t WS_G = WS_VV + SZ_T512;
constexpr size_t WS_KK = WS_G + SZ_T512;
constexpr size_t WS_KKA = WS_KK + SZ_T512;
constexpr size_t WS_KD = WS_KKA + 2 * SZ_T512;
constexpr size_t WS_W = WS_KD + 2 * SZ_T512;
constexpr size_t WS_BC = WS_W + 2 * SZ_T512;
constexpr size_t WS_MIXEND = WS_BC + al64k((size_t)NT * 8 * 4);
constexpr size_t WS_YFB = WS_KK;
constexpr size_t WS_XB = WS_BIG;
constexpr size_t WS_HB = WS_XB + al64k((size_t)MOE_MAXROWS * DM * 2);
constexpr size_t WS_YB = WS_HB + al64k((size_t)MOE_MAXROWS * DFF * 2);
constexpr size_t WS_WT13 = WS_YB + al64k((size_t)MOE_MAXROWS * DM * 2);
constexpr size_t WS_WT2 = WS_WT13 + al64k((size_t)NEXP * DM * DM * 2);
constexpr size_t WS_EID = WS_WT2 + al64k((size_t)NEXP * DM * DFF * 2);
constexpr size_t WS_POS = WS_EID + al64k((size_t)NT * 8);
constexpr size_t WS_DEST = WS_POS + al64k((size_t)NT * 8);
constexpr size_t WS_GATE = WS_DEST + al64k((size_t)NT * 8);
constexpr size_t WS_MOEEND = WS_GATE + al64k((size_t)NT * 8);
constexpr size_t WS_YI = WS_BIG;
constexpr size_t WS_E = WS_YI + al64k((size_t)NTP * DM * 4);
constexpr size_t WS_CAR = WS_E + al64k((size_t)1040 * 64 * 256 * 4);
constexpr size_t WS_BTA = WS_CAR + al64k((size_t)64 * 1280 * 256 * 2);
constexpr size_t WS_BTC = WS_BTA + al64k((size_t)64 * 512 * 256 * 2);
constexpr size_t WS_S5END = WS_BTC + al64k((size_t)64 * 256 * 256 * 2);
constexpr size_t cmax(size_t a, size_t b) { return a > b ? a : b; }
constexpr size_t WS_TOTAL = cmax(WS_MIXEND, cmax(WS_MOEEND, WS_S5END));
static_assert(WS_TOTAL <= 512 * MiB, "workspace map exceeds 512 MiB");

#define CW_CNT(l) (1024 + 64 * (l))

#define LDS_BYTES 163840
#define LDS_BARST (LDS_BYTES - 1024)
#define LDS_TAB (LDS_BYTES - 768)
#define LDS_RING (LDS_BYTES - 1024)
#define GRID 256

struct Params {
    const float* in[35];
    float* out;
    unsigned char* ws;
    int ph_lo, ph_hi;
};
typedef const __attribute__((address_space(4))) Params CParams;

__device__ __forceinline__ float bf2f(bf16_t v) { return __uint_as_float(((unsigned)v) << 16); }
typedef float f32x2c_ __attribute__((ext_vector_type(2)));
typedef __bf16 bf16x2c_ __attribute__((ext_vector_type(2)));
__device__ __forceinline__ unsigned pk2(float lo, float hi) { const f32x2c_ f = {lo, hi}; const bf16x2c_ b = __builtin_convertvector(f, bf16x2c_); return __builtin_bit_cast(unsigned, b); }
__device__ __forceinline__ unsigned f2bf(float f) { return (unsigned)__builtin_bit_cast(unsigned short, (__bf16)f); }
__device__ __forceinline__ float bflo(unsigned u) { return __uint_as_float(u << 16); }
__device__ __forceinline__ float bfhi(unsigned u) { return __uint_as_float(u & 0xffff0000u); }
__device__ __forceinline__ float wave_sum(float v) {
#pragma unroll
    for (int o = 1; o < 64; o <<= 1) v += __shfl_xor(v, o);
    return v;
}
__device__ __forceinline__ float wave_max(float v) {
#pragma unroll
    for (int o = 1; o < 64; o <<= 1) v = fmaxf(v, __shfl_xor(v, o));
    return v;
}
template <int CTRL> __device__ __forceinline__ float dppf(float v) { return __int_as_float(__builtin_amdgcn_update_dpp(0, __float_as_int(v), CTRL, 0xF, 0xF, true)); }
__device__ __forceinline__ float row16_sum(float v) { v += dppf<0xB1>(v); v += dppf<0x4E>(v); v += dppf<0x141>(v); v += dppf<0x140>(v); return v; }
__device__ __forceinline__ float sigmoidf_(float x) { return __builtin_amdgcn_rcpf(1.f + __expf(-x)); }
__device__ __forceinline__ int rowof(int b, int p) { return p < NMETA ? NMAIN + b * NMETA + p : b * SEQ + (p - NMETA); }

#define SA_STRIDE 40
template <class AF, class BF>
__device__ __forceinline__ void gemm_tile(unsigned char* lds, int K, int ldb, const AF& arow, const BF& bcol, f32x4 (&acc)[4][2]) {
    bf16_t* sA = (bf16_t*)lds;
    bf16_t* sB = (bf16_t*)(lds + 128 * SA_STRIDE * 2);
    const int tid = threadIdx.x, lane = tid & 63, wave = tid >> 6, wr = wave >> 2, wc = wave & 3, fr = lane & 15, fq = lane >> 4;
#pragma unroll
    for (int mi = 0; mi < 4; ++mi)
#pragma unroll
        for (int ni = 0; ni < 2; ++ni) acc[mi][ni] = (f32x4){0.f, 0.f, 0.f, 0.f};
    const int ar = tid >> 2, akc = (tid & 3) * 8;
    const bf16_t* ap = arow(ar) + akc;
    const int bnq = (tid & 31) * 4, bkp = (tid >> 5) * 2;
    const float* bp = bcol(bnq) + (size_t)bkp * ldb;
    const int nk = K / 32;
    u32x4 ra = *(const u32x4*)ap;
    f32x4 rb0 = *(const f32x4*)bp, rb1 = *(const f32x4*)(bp + ldb);
    for (int kt = 0; kt < nk; ++kt) {
        __syncthreads();
        *(u32x4*)(sA + ar * SA_STRIDE + akc) = ra;
        {
            unsigned* d = (unsigned*)(sB + bnq * SA_STRIDE + bkp);
            d[0 * (SA_STRIDE / 2)] = pk2(rb0[0], rb1[0]);
            d[1 * (SA_STRIDE / 2)] = pk2(rb0[1], rb1[1]);
            d[2 * (SA_STRIDE / 2)] = pk2(rb0[2], rb1[2]);
            d[3 * (SA_STRIDE / 2)] = pk2(rb0[3], rb1[3]);
        }
        __syncthreads();
        if (kt + 1 < nk) {
            ra = *(const u32x4*)(ap + (kt + 1) * 32);
            const float* q = bp + (size_t)(kt + 1) * 32 * ldb;
            rb0 = *(const f32x4*)q; rb1 = *(const f32x4*)(q + ldb);
        }
        bf16x8 a[4], b[2];
#pragma unroll
        for (int mi = 0; mi < 4; ++mi) a[mi] = *(const bf16x8*)(sA + (wr * 64 + mi * 16 + fr) * SA_STRIDE + fq * 8);
#pragma unroll
        for (int ni = 0; ni < 2; ++ni) b[ni] = *(const bf16x8*)(sB + (wc * 32 + ni * 16 + fr) * SA_STRIDE + fq * 8);
#pragma unroll
        for (int mi = 0; mi < 4; ++mi)
#pragma unroll
            for (int ni = 0; ni < 2; ++ni) acc[mi][ni] = __builtin_amdgcn_mfma_f32_16x16x32_bf16(a[mi], b[ni], acc[mi][ni], 0, 0, 0);
    }
    __syncthreads();
}
#define ACC_FOREACH(acc, ...) do { const int _l = threadIdx.x & 63, _w = threadIdx.x >> 6, _wr = _w >> 2, _wc = _w & 3, _fr = _l & 15, _fq = _l >> 4; \
    _Pragma("unroll") for (int _mi = 0; _mi < 4; ++_mi) _Pragma("unroll") for (int _ni = 0; _ni < 2; ++_ni) _Pragma("unroll") for (int _j = 0; _j < 4; ++_j) { \
        const int rl = _wr * 64 + _mi * 16 + _fq * 4 + _j, cl = _wc * 32 + _ni * 16 + _fr; const float val = acc[_mi][_ni][_j]; __VA_ARGS__ } } while (0)
#define ACC_FOREACH_PAIR(acc, ...) do { const int _l = threadIdx.x & 63, _w = threadIdx.x >> 6, _wr = _w >> 2, _wc = _w & 3, _fr = _l & 15, _fq = _l >> 4; \
    _Pragma("unroll") for (int _mi = 0; _mi < 4; ++_mi) _Pragma("unroll") for (int _j = 0; _j < 4; ++_j) { \
        const int rl = _wr * 64 + _mi * 16 + _fq * 4 + _j, co = _wc * 16 + _fr; const float va = acc[_mi][0][_j], vg = acc[_mi][1][_j]; __VA_ARGS__ } } while (0)

__device__ __forceinline__ void store_norm_bf16(const f32x4 (&v)[4], const float* gain, bf16_t* dst, int lane) {
    float ss = 0.f;
#pragma unroll
    for (int j = 0; j < 4; ++j) ss += v[j][0] * v[j][0] + v[j][1] * v[j][1] + v[j][2] * v[j][2] + v[j][3] * v[j][3];
    ss = wave_sum(ss);
    const float rstd = rsqrtf(ss * (1.f / DM) + 1e-6f);
#pragma unroll
    for (int j = 0; j < 4; ++j) {
        const f32x4 g = ((const f32x4*)gain)[lane + 64 * j];
        u32x2 o; o.x = pk2(v[j][0] * rstd * g[0], v[j][1] * rstd * g[1]); o.y = pk2(v[j][2] * rstd * g[2], v[j][3] * rstd * g[3]);
        ((u32x2*)dst)[lane + 64 * j] = o;
    }
}

namespace pg8 {
#define PG8_LAS __attribute__((address_space(3)))
constexpr int BM = 256, BK = 64, HALF = 128, HTB = HALF * BK * 2  , STAGE_BYTES = 8 * HTB, NXCD = 8, WGM = 8;
__host__ __device__ __forceinline__ int lds_byte(int r, int c) { const int st = (r >> 4) * 2 + (c >> 5), rr = r & 15, cc = c & 31, ob = rr * 64 + cc * 2; return st * 1024 + (ob ^ (((ob >> 9) & 1) << 5)); }
__host__ __device__ __forceinline__ void stage_rc(int b, int& R, int& C) { const int st = b / 1024, sb = b % 1024, swz = sb ^ (((sb >> 9) & 1) << 5); R = (st >> 1) * 16 + swz / 64; C = (st & 1) * 32 + (swz % 64) / 2; }
__host__ __device__ __forceinline__ int perm32(int rho) { const int n = rho >> 4, i = rho & 15; return 8 * (i >> 2) + 4 * n + (i & 3); }

struct Unit { int pm, pn; const char* A; const char* B; };

struct DenseOrder {
    static constexpr bool GATHER_A = false;
    int nM, nN, nwg, G, c; const char* A; const char* Bt; size_t tstep;
    __device__ void init(const bf16_t* A_, const bf16_t* Bt_, int M, int N, int K, int G_, int c_) { nM = M / BM; nN = N / BM; nwg = nM * nN; G = G_; c = c_; A = (const char*)A_; Bt = (const char*)Bt_; tstep = (size_t)BM * K * 2; }
    __device__ bool next(int i, Unit& u) const {
        const long L = (long)i * G + c; if (L >= nwg) return false;
        int wgid = (int)L; { const int q = nwg / NXCD, r = nwg % NXCD, xcd = wgid % NXCD, off = wgid / NXCD; wgid = (xcd < r ? xcd * (q + 1) : r * (q + 1) + (xcd - r) * q) + off; }
        const int nig = WGM * nN, gid = wgid / nig, fm = gid * WGM, gsz = (nM - fm) < WGM ? (nM - fm) : WGM;
        u.pm = fm + ((wgid % nig) % gsz); u.pn = (wgid % nig) / gsz; u.A = A + (size_t)u.pm * tstep; u.B = Bt + (size_t)u.pn * tstep; return true;
    }
    __device__ __forceinline__ void a_ready(const Unit&) const {}
    __device__ __forceinline__ void done(const Unit&) const {}
};
struct ProjOrder {
    static constexpr bool GATHER_A = false;
    DenseOrder D; const char* HNp; const char* WT;
    __device__ void init(const bf16_t* HN_, const bf16_t* WT_, int c_) { D.init(HN_, WT_, NTP, 13 * BM, DM, GRID, c_); HNp = (const char*)HN_; WT = (const char*)WT_; }
    __device__ bool next(int i, Unit& u) const {
        if (!D.next(i, u)) return false;
        const size_t ts = (size_t)BM * DM * 2;
        if (u.pn < 11) { const int wrow = u.pn < 4 ? u.pn : u.pn + 2; u.A = HNp + (size_t)u.pm * ts; u.B = WT + (size_t)wrow * ts; }
        else { u.A = WT + (size_t)(4 + (u.pn - 11)) * ts; u.B = HNp + (size_t)u.pm * ts; }
        return true;
    }
    __device__ __forceinline__ void a_ready(const Unit&) const {}
    __device__ __forceinline__ void done(const Unit&) const {}
};
struct MoeOrder {
    static constexpr bool GATHER_A = false;
    const int* et; int TT, vcu; const char* A; const char* Bt; unsigned tstepA, tstepB, estep;
    __device__ __forceinline__ bool next(int i, Unit& u) const {
        const int L = i * GRID + vcu; if (L >= TT * 4) return false;
        const int rt = L >> 2, ct = L & 3, e = et[rt];
        u.pm = rt; u.pn = ct; u.A = A + (size_t)rt * tstepA; u.B = Bt + (size_t)e * estep + (size_t)ct * tstepB; return true;
    }
    __device__ __forceinline__ void a_ready(const Unit&) const {}
    __device__ __forceinline__ void done(const Unit&) const {}
};

struct S5OrderA {
    static constexpr bool GATHER_A = true;
    int vcu; const char* U; const char* BTA;
    __device__ __forceinline__ bool next(int i, Unit& u) const {
        const int L = i * GRID + vcu; if (L >= 640) return false;
        const int g = L / 10, rem = L - g * 10, mt = rem >> 1, nt = rem & 1;
        u.pm = mt; u.pn = g * 2 + nt; u.A = U + ((size_t)mt * 256 * 16 * 1024 + g * 16) * 2; u.B = BTA + ((size_t)(g * 512 + nt * 256) * 256) * 2; return true;
    }
    __device__ __forceinline__ void a_ready(const Unit&) const {}
    __device__ __forceinline__ void done(const Unit&) const {}
};
struct S5OrderC {
    static constexpr bool GATHER_A = false;
    int vcu; const char* CAR; const char* BTC;
    __device__ __forceinline__ bool next(int i, Unit& u) const {
        const int L = i * GRID + vcu; if (L >= 320) return false;
        const int g = L / 5, mt = L - g * 5;
        u.pm = mt; u.pn = g; u.A = CAR + ((size_t)(g * 1280 + mt * 256) * 256) * 2; u.B = BTC + ((size_t)g * 256 * 256) * 2; return true;
    }
    __device__ __forceinline__ void a_ready(const Unit&) const {}
    __device__ __forceinline__ void done(const Unit&) const {}
};
__device__ __forceinline__ unsigned cvt_pk_bf16(float lo, float hi) { return pk2(lo, hi); }

struct EpiProj {
    static constexpr bool PERM = true, AFTER_DRAIN = false;
    bf16_t *Q, *Kk, *VT, *REST;
    __device__ __forceinline__ void operator()(const f32x4 (&acc)[2][2][4][2], const Unit& u, int wr, int wc, int fr, int fq) const {
        bf16_t* base; int ldc; int row0, col0;
        if (u.pn < 11) { row0 = u.pm * BM + wr * 64 + fr; int colt;
            if (u.pn < 2) { base = Q; colt = u.pn * BM; ldc = 512; } else if (u.pn < 4) { base = Kk; colt = (u.pn - 2) * BM; ldc = 512; } else { base = REST; colt = (u.pn - 4) * BM; ldc = RESTC; }
            col0 = colt + wc * 32 + 8 * fq; }
        else { base = VT; ldc = NTP; row0 = (u.pn - 11) * BM + wr * 64 + fr; col0 = u.pm * BM + wc * 32 + 8 * fq; }
#pragma unroll
        for (int ai = 0; ai < 2; ++ai)
#pragma unroll
            for (int m = 0; m < 4; ++m) { bf16_t* rowp = base + (size_t)(row0 + ai * HALF + m * 16) * ldc + col0;
#pragma unroll
                for (int bj = 0; bj < 2; ++bj) { const f32x4 v0 = acc[ai][bj][m][0], v1 = acc[ai][bj][m][1];
                    u32x4 w; w.x = cvt_pk_bf16(v0[0], v0[1]); w.y = cvt_pk_bf16(v0[2], v0[3]); w.z = cvt_pk_bf16(v1[0], v1[1]); w.w = cvt_pk_bf16(v1[2], v1[3]);
                    *(u32x4*)(rowp + bj * HALF) = w; } }
    }
};
struct EpiBf16Plain {
    static constexpr bool PERM = true, AFTER_DRAIN = false;
    bf16_t* O; int ldc;
    __device__ __forceinline__ void operator()(const f32x4 (&acc)[2][2][4][2], const Unit& u, int wr, int wc, int fr, int fq) const {
        const int row0 = u.pm * BM + wr * 64 + fr; const int col0 = u.pn * BM + wc * 32 + 8 * fq;
#pragma unroll
        for (int ai = 0; ai < 2; ++ai)
#pragma unroll
            for (int m = 0; m < 4; ++m) { bf16_t* rowp = O + (size_t)(row0 + ai * HALF + m * 16) * ldc + col0;
#pragma unroll
                for (int bj = 0; bj < 2; ++bj) { const f32x4 v0 = acc[ai][bj][m][0], v1 = acc[ai][bj][m][1];
                    u32x4 w; w.x = cvt_pk_bf16(v0[0], v0[1]); w.y = cvt_pk_bf16(v0[2], v0[3]); w.z = cvt_pk_bf16(v1[0], v1[1]); w.w = cvt_pk_bf16(v1[2], v1[3]);
                    *(u32x4*)(rowp + bj * HALF) = w; } }
    }
};
struct EpiSwiglu {
    static constexpr bool PERM = true, AFTER_DRAIN = false;
    bf16_t* O;
    __device__ __forceinline__ void operator()(const f32x4 (&acc)[2][2][4][2], const Unit& u, int wr, int wc, int fr, int fq) const {
        const int row0 = u.pm * BM + wr * 64 + fr; const int col0 = u.pn * HALF + wc * 32 + 8 * fq;
#pragma unroll
        for (int ai = 0; ai < 2; ++ai)
#pragma unroll
            for (int m = 0; m < 4; ++m) {
                float o[8];
#pragma unroll
                for (int n = 0; n < 2; ++n)
#pragma unroll
                    for (int i = 0; i < 4; ++i) { const float va = acc[ai][0][m][n][i], vg = acc[ai][1][m][n][i]; o[4 * n + i] = va * __builtin_amdgcn_rcpf(1.f + __expf(-va)) * vg; }
                u32x4 w; w.x = cvt_pk_bf16(o[0], o[1]); w.y = cvt_pk_bf16(o[2], o[3]); w.z = cvt_pk_bf16(o[4], o[5]); w.w = cvt_pk_bf16(o[6], o[7]);
                *(u32x4*)(O + (size_t)(row0 + ai * HALF + m * 16) * DFF + col0) = w; }
    }
};
struct EpiResidual {
    static constexpr bool PERM = false, AFTER_DRAIN = false;
    float* Hh;
    __device__ __forceinline__ void operator()(const f32x4 (&acc)[2][2][4][2], const Unit& u, int wr, int wc, int fr, int fq) const {
        const int row0 = u.pm * BM + wr * 64 + fr; const int col0 = u.pn * BM + wc * 32 + 4 * fq;
#pragma unroll
        for (int ai = 0; ai < 2; ++ai)
#pragma unroll
            for (int m = 0; m < 4; ++m) { float* rowp = Hh + (size_t)(row0 + ai * HALF + m * 16) * DM + col0;
#pragma unroll
                for (int bj = 0; bj < 2; ++bj)
#pragma unroll
                    for (int n = 0; n < 2; ++n) { f32x4* p = (f32x4*)(rowp + bj * HALF + n * 16); *p = *p + acc[ai][bj][m][n]; } }
    }
};
struct EpiGlu {
    static constexpr bool PERM = false, AFTER_DRAIN = false;
    float* Hh;
    __device__ __forceinline__ void operator()(const f32x4 (&acc)[2][2][4][2], const Unit& u, int wr, int wc, int fr, int fq) const {
        const int row0 = u.pm * BM + wr * 64 + fr; const int col0 = u.pn * HALF + wc * 32 + 4 * fq;
#pragma unroll
        for (int ai = 0; ai < 2; ++ai)
#pragma unroll
            for (int m = 0; m < 4; ++m) { float* rowp = Hh + (size_t)(row0 + ai * HALF + m * 16) * DM + col0;
#pragma unroll
                for (int n = 0; n < 2; ++n) { f32x4* p = (f32x4*)(rowp + n * 16); f32x4 hv = *p; const f32x4 va = acc[ai][0][m][n], vg = acc[ai][1][m][n];
#pragma unroll
                    for (int i = 0; i < 4; ++i) hv[i] += va[i] * __builtin_amdgcn_rcpf(1.f + __expf(-vg[i]));
                    *p = hv; } }
    }
};

struct EpiS5A {
    static constexpr bool PERM = true, AFTER_DRAIN = false;
    float* YI; float* E;
    __device__ __forceinline__ void operator()(const f32x4 (&acc)[2][2][4][2], const Unit& u, int wr, int wc, int fr, int fq) const {
        const int g = u.pn >> 1, nt = u.pn & 1;
        const int cl0 = wc * 32 + 8 * fq;
        float* base = nt == 0 ? YI + (size_t)(cl0 >> 4) * DM + g * 16 + (cl0 & 15) : E + (size_t)g * 256 + cl0;
        const size_t nstride = 16 * DM;
        const size_t bjstep = nt == 0 ? (size_t)8 * DM : (size_t)HALF;
#pragma unroll
        for (int ai = 0; ai < 2; ++ai)
#pragma unroll
            for (int m = 0; m < 4; ++m) { int n = u.pm * BM + ai * HALF + wr * 64 + m * 16 + fr; n = n < 1039 ? n : 1039;
                float* p = base + (size_t)n * nstride;
#pragma unroll
                for (int bj = 0; bj < 2; ++bj) { *(f32x4*)(p + bj * bjstep) = acc[ai][bj][m][0]; *(f32x4*)(p + bj * bjstep + 4) = acc[ai][bj][m][1]; } }
    }
};
struct EpiS5C {
    static constexpr bool PERM = true, AFTER_DRAIN = false;
    const float* YI; const bf16_t* Uu; const float* dvec; bf16_t* O;
    __device__ __forceinline__ void operator()(const f32x4 (&acc)[2][2][4][2], const Unit& u, int wr, int wc, int fr, int fq) const {
        const int g = u.pn;
        const int cl0 = wc * 32 + 8 * fq, ch = g * 16 + (cl0 & 15);
        const size_t off0 = (size_t)(cl0 >> 4) * DM + ch;
        const f32x4 d0 = *(const f32x4*)(dvec + ch), d1 = *(const f32x4*)(dvec + ch + 4);
#pragma unroll
        for (int ai = 0; ai < 2; ++ai)
#pragma unroll
            for (int m = 0; m < 4; ++m) { int n = u.pm * BM + ai * HALF + wr * 64 + m * 16 + fr; n = n < 1039 ? n : 1039;
#pragma unroll
                for (int bj = 0; bj < 2; ++bj) {
                    const size_t off = off0 + (size_t)n * (16 * DM) + (size_t)bj * (8 * DM);
                    const f32x4 y0 = *(const f32x4*)(YI + off), y1 = *(const f32x4*)(YI + off + 4);
                    const u32x4 uv = *(const u32x4*)(Uu + off);
                    float y[8];
#pragma unroll
                    for (int q = 0; q < 4; ++q) { y[q] = acc[ai][bj][m][0][q] + y0[q] + d0[q] * (q & 1 ? __uint_as_float(uv[q >> 1] & 0xffff0000u) : __uint_as_float(uv[q >> 1] << 16));
                        y[4 + q] = acc[ai][bj][m][1][q] + y1[q] + d1[q] * (q & 1 ? __uint_as_float(uv[2 + (q >> 1)] & 0xffff0000u) : __uint_as_float(uv[2 + (q >> 1)] << 16)); }
#pragma unroll
                    for (int q = 0; q < 8; ++q) { const float z = 1.5957691216f * (y[q] + 0.044715f * y[q] * y[q] * y[q]); y[q] = y[q] * __builtin_amdgcn_rcpf(1.f + __expf(-z)); }
                    u32x4 w; w.x = cvt_pk_bf16(y[0], y[1]); w.y = cvt_pk_bf16(y[2], y[3]); w.z = cvt_pk_bf16(y[4], y[5]); w.w = cvt_pk_bf16(y[6], y[7]);
                    *(u32x4*)(O + off) = w; }
                asm volatile("" ::: "memory"); }
    }
};

template <class Epi, class Sched, bool ALIGN_EPI = false, bool SP2 = false>
__device__ __forceinline__ void gemm_phase(PG8_LAS unsigned char* lds, const int K, const Sched& S, const Epi& E) {
    int tid_ = threadIdx.x; asm volatile("" : "+v"(tid_));
    const int tid = tid_, wid = __builtin_amdgcn_readfirstlane(tid >> 6), lane = tid & 63, wr = wid >> 2, wc = wid & 3, fr = lane & 15, fq = lane >> 4;
    const int nt = K / BK;
    unsigned voffA[2], voffB[2];
#pragma unroll
    for (int i = 0; i < 2; ++i) { int R, C; stage_rc(tid * 16 + i * 8192, R, C); const int Rb = Epi::PERM ? ((R & ~31) + perm32(R & 31)) : R;
        voffA[i] = Sched::GATHER_A ? (unsigned)(((16 * R + (C >> 4)) * 1024 + (C & 15)) * 2) : (unsigned)(R * K + C) * 2u; voffB[i] = (unsigned)(Rb * K + C) * 2u; }
    const size_t kstep = (size_t)(BK * 2);
    const size_t hstep = (size_t)HALF * K * 2;
    const size_t kstepA = Sched::GATHER_A ? (size_t)(4 * 1024 * 2) : kstep, hstepA = Sched::GATHER_A ? (size_t)HALF * 16 * 1024 * 2 : hstep;
    const unsigned ldsw = (unsigned)wid * 1024u;
    const int aoff = lds_byte(wr * 64 + fr, fq * 8), boff = lds_byte(wc * 32 + fr, fq * 8);
#define PG8_SA(b, h) (((b) * 2 + (h)) * HTB)
#define PG8_SB(b, h) ((4 + (b) * 2 + (h)) * HTB)
#define PG8_STAGE(bufoff, gbase, voff) do { _Pragma("unroll") for (int _i = 0; _i < 2; ++_i) \
        __builtin_amdgcn_global_load_lds((const unsigned*)((const char*)(gbase) + (voff)[_i]), (PG8_LAS unsigned*)(lds + (bufoff) + ldsw + _i * 8192), 16, 0, 0); } while (0)
#define PG8_LDA(dst, b, h) do { _Pragma("unroll") for (int m = 0; m < 4; ++m) _Pragma("unroll") for (int k = 0; k < 2; ++k) dst[m][k] = *(const PG8_LAS bf16x8*)(lds + PG8_SA(b, h) + aoff + m * 2048 + k * 1024); } while (0)
#define PG8_LDB(dst, b, h) do { _Pragma("unroll") for (int n = 0; n < 2; ++n) _Pragma("unroll") for (int k = 0; k < 2; ++k) dst[n][k] = *(const PG8_LAS bf16x8*)(lds + PG8_SB(b, h) + boff + n * 2048 + k * 1024); } while (0)
#define PG8_MMA(ai, bj, At, Bt) do { __builtin_amdgcn_s_setprio(1); _Pragma("unroll") for (int m = 0; m < 4; ++m) _Pragma("unroll") for (int n = 0; n < 2; ++n) _Pragma("unroll") for (int k = 0; k < 2; ++k) \
        acc[ai][bj][m][n] = __builtin_amdgcn_mfma_f32_16x16x32_bf16(Bt[n][k], At[m][k], acc[ai][bj][m][n], 0, 0, 0); __builtin_amdgcn_s_setprio(0); } while (0)
#define PG8_WAIT_V(n) asm volatile("s_waitcnt vmcnt(" #n ")" ::: "memory")
#define PG8_WAIT_L(n) asm volatile("s_waitcnt lgkmcnt(" #n ")" ::: "memory")
#define PG8_BAR __builtin_amdgcn_s_barrier()
#define PG8_SCHED __builtin_amdgcn_sched_barrier(0)
    Unit cur, nxt; int ui = 0;
    if (!S.next(0, cur)) return;
    f32x4 acc[2][2][4][2];
#pragma unroll
    for (int a = 0; a < 2; ++a)
#pragma unroll
        for (int b = 0; b < 2; ++b)
#pragma unroll
            for (int m = 0; m < 4; ++m)
#pragma unroll
                for (int n = 0; n < 2; ++n) acc[a][b][m][n] = (f32x4){0.f, 0.f, 0.f, 0.f};
    bf16x8 At[4][2], B0[2][2], B1[2][2];
    const char* cA = cur.A; const char* cB = cur.B;
    S.a_ready(cur);
    if constexpr (SP2) {
        PG8_STAGE(PG8_SB(0, 0), cB, voffB); PG8_STAGE(PG8_SB(0, 1), cB + hstep, voffB); PG8_STAGE(PG8_SA(0, 0), cA, voffA); PG8_STAGE(PG8_SA(0, 1), cA + hstepA, voffA);
        if (wr == 1) PG8_BAR;
        PG8_WAIT_V(2); PG8_BAR;
        PG8_STAGE(PG8_SB(1, 0), cB + kstep, voffB); PG8_STAGE(PG8_SA(1, 0), cA + kstepA, voffA); PG8_STAGE(PG8_SB(1, 1), cB + hstep + kstep, voffB);
        PG8_WAIT_V(6); PG8_BAR;
    } else {
        PG8_STAGE(PG8_SB(0, 0), cB, voffB); PG8_STAGE(PG8_SA(0, 0), cA, voffA); PG8_STAGE(PG8_SB(0, 1), cB + hstep, voffB); PG8_STAGE(PG8_SA(0, 1), cA + hstepA, voffA);
        if (wr == 1) PG8_BAR;
        PG8_WAIT_V(4); PG8_BAR;
        PG8_STAGE(PG8_SB(1, 0), cB + kstep, voffB); PG8_STAGE(PG8_SA(1, 0), cA + kstepA, voffA); PG8_STAGE(PG8_SB(1, 1), cB + hstep + kstep, voffB);
        PG8_WAIT_V(6); PG8_BAR;
    }
    for (;;) {
        const bool has_next = S.next(ui + 1, nxt);
        const char* nA = has_next ? nxt.A : cA; const char* nB = has_next ? nxt.B : cB;
        for (int t = 0; t < nt; t += 2) {
            const bool last = (t == nt - 2);
            const char* a1 = cA + (size_t)(t + 1) * kstepA;
            const char* a2 = last ? nA : cA + (size_t)(t + 2) * kstepA; const char* b2 = last ? nB : cB + (size_t)(t + 2) * kstep;
            const char* a3 = a2 + kstepA; const char* b3 = b2 + kstep;
            if (last && has_next) S.a_ready(nxt);
            if constexpr (SP2) {
            PG8_LDB(B0, 0, 0); PG8_LDB(B1, 0, 1); PG8_SCHED; PG8_LDA(At, 0, 0); PG8_STAGE(PG8_SA(1, 1), a1 + hstepA, voffA);
            PG8_WAIT_V(8); PG8_WAIT_L(0); PG8_BAR; PG8_MMA(0, 0, At, B0); PG8_MMA(0, 1, At, B1); PG8_BAR; PG8_SCHED;
            PG8_LDA(At, 0, 1); PG8_STAGE(PG8_SB(0, 0), b2, voffB); PG8_STAGE(PG8_SB(0, 1), b2 + hstep, voffB); PG8_STAGE(PG8_SA(0, 0), a2, voffA);
            PG8_WAIT_V(8); PG8_WAIT_L(0); PG8_BAR; PG8_MMA(1, 0, At, B0); PG8_MMA(1, 1, At, B1); PG8_BAR; PG8_SCHED;
            PG8_LDB(B0, 1, 0); PG8_LDB(B1, 1, 1); PG8_SCHED; PG8_LDA(At, 1, 0); PG8_STAGE(PG8_SA(0, 1), a2 + hstepA, voffA);
            PG8_WAIT_V(8); PG8_WAIT_L(0); PG8_BAR; PG8_MMA(0, 0, At, B0); PG8_MMA(0, 1, At, B1); PG8_BAR; PG8_SCHED;
            PG8_LDA(At, 1, 1); PG8_STAGE(PG8_SB(1, 0), b3, voffB); PG8_STAGE(PG8_SB(1, 1), b3 + hstep, voffB); PG8_STAGE(PG8_SA(1, 0), a3, voffA);
            PG8_WAIT_V(8); PG8_WAIT_L(0); PG8_BAR; PG8_MMA(1, 0, At, B0); PG8_MMA(1, 1, At, B1); PG8_BAR; PG8_SCHED;
            } else {
            PG8_LDB(B0, 0, 0); PG8_SCHED; PG8_LDA(At, 0, 0); PG8_STAGE(PG8_SA(1, 1), a1 + hstepA, voffA);
            PG8_WAIT_L(8); PG8_BAR; PG8_WAIT_L(0); PG8_MMA(0, 0, At, B0); PG8_BAR; PG8_SCHED;
            PG8_LDB(B1, 0, 1); PG8_STAGE(PG8_SB(0, 0), b2, voffB);
            PG8_BAR; PG8_WAIT_L(0); PG8_MMA(0, 1, At, B1); PG8_BAR;
            PG8_LDA(At, 0, 1); PG8_STAGE(PG8_SA(0, 0), a2, voffA);
            PG8_BAR; PG8_WAIT_L(0); PG8_MMA(1, 0, At, B0); PG8_BAR; PG8_SCHED;
            PG8_STAGE(PG8_SB(0, 1), b2 + hstep, voffB);
            PG8_WAIT_V(6); PG8_BAR; PG8_MMA(1, 1, At, B1); PG8_BAR;
            PG8_LDB(B0, 1, 0); PG8_SCHED; PG8_LDA(At, 1, 0); PG8_STAGE(PG8_SA(0, 1), a2 + hstepA, voffA);
            PG8_WAIT_L(8); PG8_BAR; PG8_WAIT_L(0); PG8_MMA(0, 0, At, B0); PG8_BAR; PG8_SCHED;
            PG8_LDB(B1, 1, 1); PG8_STAGE(PG8_SB(1, 0), b3, voffB);
            PG8_BAR; PG8_WAIT_L(0); PG8_MMA(0, 1, At, B1); PG8_BAR;
            PG8_LDA(At, 1, 1); PG8_STAGE(PG8_SA(1, 0), a3, voffA);
            PG8_BAR; PG8_WAIT_L(0); PG8_MMA(1, 0, At, B0); PG8_BAR; PG8_SCHED;
            PG8_STAGE(PG8_SB(1, 1), b3 + hstep, voffB);
            PG8_WAIT_V(6); PG8_BAR; PG8_MMA(1, 1, At, B1); PG8_BAR;
            }
        }
        if constexpr (ALIGN_EPI) { if (wr == 0) PG8_BAR; }
        if constexpr (!Epi::AFTER_DRAIN) { E(acc, cur, wr, wc, fr, fq); S.done(cur); }
        if (!has_next) break;
#pragma unroll
        for (int a = 0; a < 2; ++a)
#pragma unroll
            for (int b = 0; b < 2; ++b)
#pragma unroll
                for (int m = 0; m < 4; ++m)
#pragma unroll
                    for (int n = 0; n < 2; ++n) acc[a][b][m][n] = (f32x4){0.f, 0.f, 0.f, 0.f};
        cur = nxt; cA = nA; cB = nB; ++ui;
        if constexpr (ALIGN_EPI) { if (wr == 1) PG8_BAR; }
    }
    PG8_WAIT_V(0);
    if constexpr (!ALIGN_EPI) { if (wr == 0) PG8_BAR; }
    PG8_BAR;
    if constexpr (Epi::AFTER_DRAIN) { E.fused(acc, cur, wr, wc, fr, fq, lds, wid, lane); S.done(cur); }
#undef PG8_SA
#undef PG8_SB
#undef PG8_STAGE
#undef PG8_LDA
#undef PG8_LDB
#undef PG8_MMA
#undef PG8_WAIT_V
#undef PG8_WAIT_L
#undef PG8_BAR
#undef PG8_SCHED
}
}

#define PHASE_PROLOGUE \
    int tid_ = threadIdx.x; asm volatile("" : "+v"(tid_)); const int tid = tid_, lane = tid & 63, wave = tid >> 6; \
    const int G = GRID, bid = blockIdx.x; \
    const int gw = bid * 8 + wave, NGW = G * 8; \
    unsigned char* ws = P.ws; \
    float* H = (float*)(ws + WS_H); \
    bf16_t* HN = (bf16_t*)(ws + WS_HN); \
    bf16_t* A2 = (bf16_t*)(ws + WS_A2); \
    bf16_t* Qb = (bf16_t*)(ws + WS_Q); bf16_t* Kb = (bf16_t*)(ws + WS_K); bf16_t* Vb = (bf16_t*)(ws + WS_V); \
    bf16_t* REST = (bf16_t*)(ws + WS_REST); \
    bf16_t* YFB = (bf16_t*)(ws + WS_YFB); \
    bf16_t* Rr = (bf16_t*)(ws + WS_R); bf16_t* VV = (bf16_t*)(ws + WS_VV); bf16_t* KK = (bf16_t*)(ws + WS_KK); \
    bf16_t* KKA = (bf16_t*)(ws + WS_KKA); bf16_t* KD = (bf16_t*)(ws + WS_KD); \
    _Float16* LW = (_Float16*)(ws + WS_W); bf16_t* PP = (bf16_t*)(ws + WS_PP); bf16_t* QT = (bf16_t*)(ws + WS_QT); bf16_t* YT = (bf16_t*)(ws + WS_YT); bf16_t* ZT = (bf16_t*)(ws + WS_ZT); \
    bf16_t* Gg = (bf16_t*)(ws + WS_G); bf16_t* KR = (bf16_t*)(ws + WS_KR); bf16_t* LOW = (bf16_t*)(ws + WS_LOW); \
    float* BC = (float*)(ws + WS_BC); \
    bf16_t* AA = (bf16_t*)(ws + WS_AA); \
    bf16_t* HB = (bf16_t*)(ws + WS_HB); bf16_t* YB = (bf16_t*)(ws + WS_YB); \
    bf16_t* XB = (bf16_t*)(ws + WS_XB); int* EID = (int*)(ws + WS_EID); int* POS = (int*)(ws + WS_POS); int* DEST = (int*)(ws + WS_DEST); \
    float* GATE = (float*)(ws + WS_GATE); \
    float* YI = (float*)(ws + WS_YI); float* S5E = (float*)(ws + WS_E); bf16_t* CAR = (bf16_t*)(ws + WS_CAR); bf16_t* BTA = (bf16_t*)(ws + WS_BTA); bf16_t* BTC = (bf16_t*)(ws + WS_BTC); \
    unsigned* CTL = (unsigned*)(ws + WS_CTL); \
    bf16_t* WTIN = (bf16_t*)(ws + WS_WTIN); bf16_t* WTOUT = (bf16_t*)(ws + WS_WTOUT); bf16_t* WTGLU = (bf16_t*)(ws + WS_WTGLU); bf16_t* WT13 = (bf16_t*)(ws + WS_WT13); bf16_t* WT2 = (bf16_t*)(ws + WS_WT2); \
    const int vcu = (G % 8 == 0) ? (bid % 8) * (G / 8) + bid / 8 : bid; \
    const float* x = P.in[0]; const float* meta = P.in[1]; const float* norm_mix = P.in[2]; const float* norm_ffn = P.in[3]; const float* norm_final = P.in[4]; \
    const float* w_in = P.in[5]; const float* w_out = P.in[6]; const float* rpb = P.in[7]; const float* mu = P.in[8]; \
    const float* w0 = P.in[9]; const float* w_up = P.in[10]; const float* a0 = P.in[11]; const float* a_up = P.in[12]; const float* g_up = P.in[13]; \
    const float* k_k = P.in[14]; const float* k_a = P.in[15]; const float* r_k = P.in[16]; const float* lnx_g = P.in[17]; const float* lnx_b = P.in[18]; \
    const float* s5_b_re = P.in[19]; const float* s5_b_im = P.in[20]; const float* s5_lre = P.in[21]; const float* s5_lim = P.in[22]; const float* s5_ls = P.in[23]; \
    const float* s5_c_re = P.in[24]; const float* s5_c_im = P.in[25]; const float* s5_d = P.in[26]; const float* w_glu = P.in[27]; \
    const float* moe_wg = P.in[28]; const float* moe_bg = P.in[29]; const float* moe_we = P.in[30]; const float* moe_be = P.in[31]; \
    const float* moe_w1 = P.in[32]; const float* moe_w3 = P.in[33]; const float* moe_w2 = P.in[34];


__device__ __forceinline__ void transpose_item(const float* W, int N, int K, int k0, int n0, bf16_t* dstrow0, int lane) {
    const int nq = lane & 15, kb = lane >> 4;
    const float* src = W + (size_t)(k0 + 16 * kb) * N + n0 + 4 * nq;
    f32x4 v[16];
#pragma unroll
    for (int kk = 0; kk < 16; ++kk) v[kk] = *(const f32x4*)(src + (size_t)kk * N);
#pragma unroll
    for (int i = 0; i < 4; ++i) {
        bf16_t* d = dstrow0 + (size_t)(4 * nq + i) * K + k0 + 16 * kb;
        u32x4 lo, hi;
        lo.x = pk2(v[0][i], v[1][i]); lo.y = pk2(v[2][i], v[3][i]); lo.z = pk2(v[4][i], v[5][i]); lo.w = pk2(v[6][i], v[7][i]);
        hi.x = pk2(v[8][i], v[9][i]); hi.y = pk2(v[10][i], v[11][i]); hi.z = pk2(v[12][i], v[13][i]); hi.w = pk2(v[14][i], v[15][i]);
        *(u32x4*)d = lo; *(u32x4*)(d + 8) = hi;
    }
}
#define CONV_DENSE_ITEMS (832 + 256 + 512 + 48)
__device__ __forceinline__ void conv_dense_item(CParams& P, int it, int lane) {
    unsigned char* ws = P.ws;
    if (it < 832) { const int kb = it / 52, nb = it % 52; transpose_item(P.in[5], INCOLS, DM, kb * 64, nb * 64, (bf16_t*)(ws + WS_WTIN) + (size_t)nb * 64 * DM, lane); return; }
    it -= 832;
    if (it < 256) { const int kb = it / 16, nb = it % 16; transpose_item(P.in[6], DM, DM, kb * 64, nb * 64, (bf16_t*)(ws + WS_WTOUT) + (size_t)nb * 64 * DM, lane); return; }
    it -= 256;
    if (it < 512) { const int kb = it / 32, nb = it % 32, n = nb * 64, half = n >> 10, c = n & 1023, row = (c >> 7) * 256 + half * 128 + (c & 127);
      transpose_item(P.in[27], 2 * DM, DM, kb * 64, n, (bf16_t*)(ws + WS_WTGLU) + (size_t)row * DM, lane); return; }
    it -= 512;
    bf16_t* lrt = (bf16_t*)(ws + WS_LRT);
    if (it < 16) { const int d = it >> 3, nb = it & 7; transpose_item(P.in[10] + (size_t)d * 64 * 512, 512, 64, 0, nb * 64, lrt + ((size_t)d * 512 + nb * 64) * 64, lane); return; }
    it -= 16;
    if (it < 16) { const int d = it >> 3, nb = it & 7; transpose_item(P.in[12] + (size_t)d * 64 * 512, 512, 64, 0, nb * 64, lrt + (size_t)2 * 512 * 64 + ((size_t)d * 512 + nb * 64) * 64, lane); return; }
    it -= 16;
    { const int kb = it >> 3, nb = it & 7; transpose_item(P.in[13], 512, 128, kb * 64, nb * 64, lrt + (size_t)4 * 512 * 64 + (size_t)nb * 64 * 128, lane); }
}
#define CONV_MOE_ITEMS (NEXP * 384)
__device__ __forceinline__ void conv_moe_item(CParams& P, int l, int it, int lane) {
    unsigned char* ws = P.ws;
    const int e = it / 384; int r = it % 384;
    if (r < 256) { const int which = r >> 7; r &= 127; const int kb = r >> 3, nb = r & 7, n = nb * 64, row = (n >> 7) * 256 + which * 128 + (n & 127);
        const float* W = (which ? P.in[33] : P.in[32]) + ((size_t)(l * NEXP + e) * DM) * DFF;
        transpose_item(W, DFF, DM, kb * 64, n, (bf16_t*)(ws + WS_WT13) + ((size_t)e * DM + row) * DM, lane); return; }
    r -= 256;
    { const int kb = r >> 4, nb = r & 15; const float* W = P.in[34] + ((size_t)(l * NEXP + e) * DFF) * DM;
      transpose_item(W, DM, DFF, kb * 64, nb * 64, (bf16_t*)(ws + WS_WT2) + ((size_t)e * DM + nb * 64) * DFF, lane); }
}

template <int MODE>
__device__ __forceinline__ void meta_gemm(const bf16_t* A, const bf16_t* Bt, float* Hrows, int task, int lane) {
    const int fr = lane & 15, fq = lane >> 4, c = task * 16 + fr;
    const bf16_t* b0 = MODE == 0 ? Bt + (size_t)c * DM : Bt + (size_t)((c >> 7) * 256 + (c & 127)) * DM;
    const bf16_t* b1 = b0 + (size_t)128 * DM;
    f32x4 acc0[2], acc1[2];
    acc0[0] = acc0[1] = acc1[0] = acc1[1] = (f32x4){0.f, 0.f, 0.f, 0.f};
#pragma unroll 4
    for (int kt = 0; kt < 32; ++kt) {
        const int ko = kt * 32 + fq * 8;
        const bf16x8 a0 = *(const bf16x8*)(A + (size_t)fr * DM + ko), a1 = *(const bf16x8*)(A + (size_t)(16 + fr) * DM + ko);
        const bf16x8 bv = *(const bf16x8*)(b0 + ko);
        acc0[0] = __builtin_amdgcn_mfma_f32_16x16x32_bf16(a0, bv, acc0[0], 0, 0, 0);
        acc0[1] = __builtin_amdgcn_mfma_f32_16x16x32_bf16(a1, bv, acc0[1], 0, 0, 0);
        if (MODE == 1) { const bf16x8 bg = *(const bf16x8*)(b1 + ko);
            acc1[0] = __builtin_amdgcn_mfma_f32_16x16x32_bf16(a0, bg, acc1[0], 0, 0, 0);
            acc1[1] = __builtin_amdgcn_mfma_f32_16x16x32_bf16(a1, bg, acc1[1], 0, 0, 0); }
    }
#pragma unroll
    for (int mi = 0; mi < 2; ++mi)
#pragma unroll
        for (int j = 0; j < 4; ++j) { float* p = Hrows + (size_t)(mi * 16 + fq * 4 + j) * DM + c;
            if (MODE == 0) *p += acc0[mi][j]; else *p += acc0[mi][j] * __builtin_amdgcn_rcpf(1.f + __expf(-acc1[mi][j])); }
}
__device__ __forceinline__ void phase_0(CParams& P, unsigned char* lds, const int ph) {
    PHASE_PROLOGUE
            for (int row = gw; row < NT; row += NGW) {
                const float* src = row < NMAIN ? x + (size_t)row * DM : meta + (size_t)((row - NMAIN) & 15) * DM;
                f32x4 v[4];
#pragma unroll
                for (int j = 0; j < 4; ++j) { v[j] = ((const f32x4*)src)[lane + 64 * j]; ((f32x4*)(H + (size_t)row * DM))[lane + 64 * j] = v[j]; }
                store_norm_bf16(v, norm_mix, HN + (size_t)row * DM, lane);
            }
    for (int it = gw; it < CONV_DENSE_ITEMS; it += NGW) conv_dense_item(P, it, lane);
}

__device__ __forceinline__ void phase_1(CParams& P, unsigned char* lds, const int ph) {
    PHASE_PROLOGUE
    pg8::ProjOrder S; S.init(HN, WTIN, bid);
    pg8::EpiProj E{Qb, Kb, Vb, REST};
    pg8::gemm_phase<pg8::EpiProj, pg8::ProjOrder, true, true>((PG8_LAS unsigned char*)lds, DM, S, E);
}

__device__ __forceinline__ void na_units(CParams& P, unsigned char* lds, const int first, const int stride) {
    PHASE_PROLOGUE
    float* sb = (float*)lds;
    for (int i = tid; i < 8 * 465; i += 512) sb[i] = rpb[i];
    __syncthreads();
    const bf16_t* VT = Vb;
    const int fr = lane & 15, fq = lane >> 4;
    for (int u = first; u < 8192 + 16; u += stride) {
        const bool metaq = u >= 8192;
        int b, h, r = 0, qb = 0;
        if (!metaq) { qb = u & 3; r = (u >> 2) & 127; h = (u >> 9) & 7; b = u >> 12; } else { const int m = u - 8192; b = m >> 3; h = m & 7; }
        const int c = qb * 16 + fr;
        const int qrow = metaq ? NMAIN + b * NMETA + fr : b * SEQ + r * 64 + c;
        const int R0 = min(max(r - 4, 0), 120), cs = qb == 0 ? 0 : (qb == 1 ? 8 : (qb == 2 ? 24 : 32));
        const int C0 = min(max(c - 8, 0), 48);
        bf16x8 qf0 = *(const bf16x8*)(Qb + (size_t)qrow * 512 + h * 64 + fq * 8), qf1 = *(const bf16x8*)(Qb + (size_t)qrow * 512 + h * 64 + 32 + fq * 8);
        f32x4 sacc[17];
        const f32x4 zero4 = (f32x4){0.f, 0.f, 0.f, 0.f};
        if (!metaq) {
#pragma unroll
            for (int kt = 0; kt < 16; ++kt) {
                const int krow0 = b * SEQ + (R0 + (kt >> 1)) * 64 + cs + 16 * (kt & 1);
                const bf16_t* kp = Kb + (size_t)(krow0 + fr) * 512 + h * 64 + fq * 8;
                const bf16x8 a0 = *(const bf16x8*)kp, a1 = *(const bf16x8*)(kp + 32);
                f32x4 acc = __builtin_amdgcn_mfma_f32_16x16x32_bf16(a0, qf0, zero4, 0, 0, 0);
                sacc[kt] = __builtin_amdgcn_mfma_f32_16x16x32_bf16(a1, qf1, acc, 0, 0, 0);
            }
        } else {
#pragma unroll
            for (int kt = 0; kt < 16; ++kt) sacc[kt] = zero4;
        }
        {
            const bf16_t* kp = Kb + (size_t)(NMAIN + b * NMETA + fr) * 512 + h * 64 + fq * 8;
            const bf16x8 a0 = *(const bf16x8*)kp, a1 = *(const bf16x8*)(kp + 32);
            f32x4 acc = __builtin_amdgcn_mfma_f32_16x16x32_bf16(a0, qf0, zero4, 0, 0, 0);
            sacc[16] = __builtin_amdgcn_mfma_f32_16x16x32_bf16(a1, qf1, acc, 0, 0, 0);
        }
        float mx = -1e30f;
#pragma unroll
        for (int kt = 0; kt < 16; ++kt) {
            const int dr = R0 + (kt >> 1) - r + 7;
#pragma unroll
            for (int j = 0; j < 4; ++j) {
                const int kc = cs + 16 * (kt & 1) + 4 * fq + j;
                const bool inb = !metaq && kc >= C0 && kc < C0 + 16;
                const int dc = min(max(kc - c + 15, 0), 30);
                const float s = inb ? sacc[kt][j] * 0.125f + sb[(h * 15 + dr) * 31 + dc] : -1e30f;
                sacc[kt][j] = s; mx = fmaxf(mx, s);
            }
        }
#pragma unroll
        for (int j = 0; j < 4; ++j) { const float s = sacc[16][j] * 0.125f; sacc[16][j] = s; mx = fmaxf(mx, s); }
        mx = fmaxf(mx, __shfl_xor(mx, 16)); mx = fmaxf(mx, __shfl_xor(mx, 32));
        float sum = 0.f;
#pragma unroll
        for (int kt = 0; kt < 17; ++kt)
#pragma unroll
            for (int j = 0; j < 4; ++j) { const float pv = __expf(sacc[kt][j] - mx); sacc[kt][j] = pv; sum += pv; }
        sum += __shfl_xor(sum, 16); sum += __shfl_xor(sum, 32);
        f32x4 o[4] = {zero4, zero4, zero4, zero4};
        if (!metaq) {
#pragma unroll
            for (int kr = 0; kr < 8; ++kr) {
                union { bf16x8 v; unsigned u[4]; } bf;
                bf.u[0] = pk2(sacc[2 * kr][0], sacc[2 * kr][1]); bf.u[1] = pk2(sacc[2 * kr][2], sacc[2 * kr][3]);
                bf.u[2] = pk2(sacc[2 * kr + 1][0], sacc[2 * kr + 1][1]); bf.u[3] = pk2(sacc[2 * kr + 1][2], sacc[2 * kr + 1][3]);
                const size_t tok0 = (size_t)b * SEQ + (R0 + kr) * 64 + cs + 4 * fq;
#pragma unroll
                for (int dt = 0; dt < 4; ++dt) {
                    const bf16_t* vp = VT + (size_t)(h * 64 + dt * 16 + fr) * NTP + tok0;
                    union { bf16x8 v; u32x2 h2[2]; } af;
                    af.h2[0] = *(const u32x2*)vp; af.h2[1] = *(const u32x2*)(vp + 16);
                    o[dt] = __builtin_amdgcn_mfma_f32_16x16x32_bf16(af.v, bf.v, o[dt], 0, 0, 0);
                }
            }
        }
        {
            union { bf16x8 v; unsigned u[4]; } bf;
            bf.u[0] = pk2(sacc[16][0], sacc[16][1]); bf.u[1] = pk2(sacc[16][2], sacc[16][3]); bf.u[2] = 0u; bf.u[3] = 0u;
            const size_t tokm = (size_t)NMAIN + b * NMETA + 4 * fq;
#pragma unroll
            for (int dt = 0; dt < 4; ++dt) {
                const bf16_t* vp = VT + (size_t)(h * 64 + dt * 16 + fr) * NTP + tokm;
                union { bf16x8 v; u32x2 h2[2]; } af;
                af.h2[0] = *(const u32x2*)vp; af.h2[1] = (u32x2){0u, 0u};
                o[dt] = __builtin_amdgcn_mfma_f32_16x16x32_bf16(af.v, bf.v, o[dt], 0, 0, 0);
            }
        }
        const float inv = 1.f / sum;
#pragma unroll
        for (int dt = 0; dt < 4; ++dt) {
            u32x2 ov; ov.x = pk2(o[dt][0] * inv, o[dt][1] * inv); ov.y = pk2(o[dt][2] * inv, o[dt][3] * inv);
            *(u32x2*)(A2 + (size_t)qrow * DM + h * 64 + dt * 16 + 4 * fq) = ov;
        }
    }
    __syncthreads();
}

__device__ __forceinline__ void phase_3(CParams& P, unsigned char* lds, const int ph) {
    PHASE_PROLOGUE
            for (int tk = gw; tk < NT; tk += NGW) {
                const int b = tk / LSEQ, p = tk % LSEQ, row = rowof(b, p);
                const bool hp = p > 0, hn = p + 1 < LSEQ;
                const int rowp = hp ? rowof(b, p - 1) : row, rown = hn ? rowof(b, p + 1) : row;
#pragma unroll
                for (int j = 0; j < 7; ++j) {
                    const int c = 4 * lane + 256 * j;
                    const u32x2 vc = *(const u32x2*)(REST + (size_t)row * RESTC + c);
                    u32x2 vp = *(const u32x2*)(REST + (size_t)rowp * RESTC + c);
                    u32x2 vn = *(const u32x2*)(REST + (size_t)rown * RESTC + c);
                    if (!hp) { vp.x = 0; vp.y = 0; }
                    if (!hn) { vn.x = 0; vn.y = 0; }
                    const f32x4 m4 = *(const f32x4*)(mu + c);
                    float pc[4] = {bflo(vc.x), bfhi(vc.x), bflo(vc.y), bfhi(vc.y)};
                    float pp[4] = {bflo(vp.x), bfhi(vp.x), bflo(vp.y), bfhi(vp.y)};
                    float pn[4] = {bflo(vn.x), bfhi(vn.x), bflo(vn.y), bfhi(vn.y)};
                    float o[4];
#pragma unroll
                    for (int i = 0; i < 4; ++i) o[i] = pc[i] + m4[i] * (0.5f * (pp[i] + pn[i]) - pc[i]);
                    if (j == 6) {
                        if (lane < 16) { for (int i = 0; i < 4; ++i) o[i] = tanhf(o[i]); }
                        else if (lane >= 32) { for (int i = 0; i < 4; ++i) o[i] = sigmoidf_(o[i]); }
                    }
                    u32x2 ov; ov.x = pk2(o[0], o[1]); ov.y = pk2(o[2], o[3]);
                    bf16_t* dst = j < 2 ? Rr + (size_t)row * 512 + c : (j < 4 ? KR + (size_t)row * 512 + (c - 512) : (j < 6 ? VV + (size_t)row * 512 + (c - 1024) : LOW + (size_t)row * 256 + (c - 1536)));
                    *(u32x2*)dst = ov;
                }
            }
}


__device__ __forceinline__ void phase_4(CParams& P, unsigned char* lds, const int ph) {
    PHASE_PROLOGUE
    constexpr int AST = 264, SST = 136;
    bf16_t* As = (bf16_t*)lds;
    unsigned short* stg = (unsigned short*)(lds + 64 * AST * 2);
    const bf16_t* lrt = (const bf16_t*)(ws + WS_LRT);
    const int fr = lane & 15, fq = lane >> 4;
    const int nrt = (NT + 63) / 64;
    for (int u = bid; u < nrt; u += G) {
        for (int i = tid; i < 64 * 32; i += 512) { const int r = i >> 5, pc = (i & 31) * 8; int row = u * 64 + r; if (row >= NT) row = NT - 1;
            *(u32x4*)(As + r * AST + pc) = *(const u32x4*)(LOW + (size_t)row * 256 + pc); }
        __syncthreads();
#define P4_LOADB(t_, bv_, bias_) do { const int wh_ = (t_) >> 2, ct_ = (t_) & 3, Kw_ = wh_ < 4 ? 64 : 128, col_ = ct_ * 128 + 16 * wave + fr; \
            const bf16_t* Wt_ = lrt + (wh_ < 4 ? (size_t)wh_ * 512 * 64 : (size_t)4 * 512 * 64) + (size_t)col_ * Kw_ + 8 * fq; \
            bv_[0] = *(const bf16x8*)Wt_; bv_[1] = *(const bf16x8*)(Wt_ + 32); if (wh_ == 4) { bv_[2] = *(const bf16x8*)(Wt_ + 64); bv_[3] = *(const bf16x8*)(Wt_ + 96); } \
            bias_ = wh_ < 2 ? w0[wh_ * 512 + col_] : (wh_ < 4 ? a0[(wh_ - 2) * 512 + col_] : 0.f); } while (0)
        bf16x8 bnx[4]; float biasn;
        P4_LOADB(0, bnx, biasn);
#pragma unroll 1
        for (int t = 0; t < 20; ++t) {
            const int which = t >> 2, ct = t & 3;
            const int koff = which < 2 ? 0 : (which < 4 ? 64 : 128);
            bf16x8 bcur[4]; bcur[0] = bnx[0]; bcur[1] = bnx[1]; bcur[2] = bnx[2]; bcur[3] = bnx[3];
            const float bias = biasn;
            if (t + 1 < 20) P4_LOADB(t + 1, bnx, biasn);
            const f32x4 zero4 = (f32x4){0.f, 0.f, 0.f, 0.f};
            f32x4 acc[4] = {zero4, zero4, zero4, zero4};
#pragma unroll
            for (int ks = 0; ks < 4; ++ks) {
                if (ks < 2 || which == 4) {
#pragma unroll
                    for (int rt = 0; rt < 4; ++rt) acc[rt] = __builtin_amdgcn_mfma_f32_16x16x32_bf16(*(const bf16x8*)(As + (16 * rt + fr) * AST + koff + 32 * ks + 8 * fq), bcur[ks], acc[rt], 0, 0, 0);
                }
            }
            unsigned short* sg = stg + (t & 1) * 64 * SST + 16 * wave + fr;
#pragma unroll
            for (int rt = 0; rt < 4; ++rt)
#pragma unroll
                for (int j = 0; j < 4; ++j) { const float val = acc[rt][j] + bias; unsigned short o;
                    if (which < 2) { const _Float16 hv = (_Float16)(-0.6065306597f * sigmoidf_(val)); o = __builtin_bit_cast(unsigned short, hv); }
                    else if (which < 4) o = (unsigned short)f2bf(sigmoidf_(val));
                    else o = (unsigned short)f2bf(val);
                    sg[(16 * rt + 4 * fq + j) * SST] = o; }
            __syncthreads();
            {
                unsigned short* dst = which < 2 ? (unsigned short*)LW + (size_t)which * NT * 512 : (which < 4 ? (unsigned short*)AA + (size_t)(which - 2) * NT * 512 : (unsigned short*)Gg);
                const int r = tid >> 3, pc = (tid & 7) * 16, row = u * 64 + r;
                const unsigned short* sp = stg + (t & 1) * 64 * SST + r * SST + pc;
                if (row < NT) { *(u32x4*)(dst + (size_t)row * 512 + ct * 128 + pc) = *(const u32x4*)sp; *(u32x4*)(dst + (size_t)row * 512 + ct * 128 + pc + 8) = *(const u32x4*)(sp + 8); }
            }
        }
        __syncthreads();
#undef P4_LOADB
    }
}


__device__ __forceinline__ void phase_5(CParams& P, unsigned char* lds, const int ph) {
    PHASE_PROLOGUE
            for (int row = gw; row < NT; row += NGW) {
                const int c0 = lane * 8;
                const u32x4 krv = *(const u32x4*)(KR + (size_t)row * 512 + c0);
                const u32x4 rv = *(const u32x4*)(Rr + (size_t)row * 512 + c0);
                float kr[8], rr[8], kkv[8];
#pragma unroll
                for (int i = 0; i < 4; ++i) { kr[2 * i] = bflo(krv[i]); kr[2 * i + 1] = bfhi(krv[i]); rr[2 * i] = bflo(rv[i]); rr[2 * i + 1] = bfhi(rv[i]); }
                float ss = 0.f;
#pragma unroll
                for (int i = 0; i < 8; ++i) { kkv[i] = kr[i] * k_k[c0 + i]; ss += kkv[i] * kkv[i]; }
                ss += __shfl_xor(ss, 1); ss += __shfl_xor(ss, 2); ss += __shfl_xor(ss, 4);
                const float inv = 1.f / fmaxf(sqrtf(ss), 1e-12f);
#pragma unroll
                for (int i = 0; i < 8; ++i) kkv[i] *= inv;
                u32x4 o; o.x = pk2(kkv[0], kkv[1]); o.y = pk2(kkv[2], kkv[3]); o.z = pk2(kkv[4], kkv[5]); o.w = pk2(kkv[6], kkv[7]);
                *(u32x4*)(KK + (size_t)row * 512 + c0) = o;
                float bsum = 0.f;
#pragma unroll
                for (int d = 0; d < 2; ++d) {
                    const u32x4 av = *(const u32x4*)(AA + ((size_t)d * NT + row) * 512 + c0);
                    float a[8], kka[8], kd[8];
#pragma unroll
                    for (int i = 0; i < 4; ++i) { a[2 * i] = bflo(av[i]); a[2 * i + 1] = bfhi(av[i]); }
#pragma unroll
                    for (int i = 0; i < 8; ++i) { kka[i] = kkv[i] * a[i]; kd[i] = kr[i] * (1.f + (a[i] - 1.f) * k_a[c0 + i]); bsum += rr[i] * kd[i] * r_k[c0 + i]; }
                    u32x4 o1; o1.x = pk2(kka[0], kka[1]); o1.y = pk2(kka[2], kka[3]); o1.z = pk2(kka[4], kka[5]); o1.w = pk2(kka[6], kka[7]);
                    *(u32x4*)(KKA + ((size_t)d * NT + row) * 512 + c0) = o1;
                    u32x4 o2; o2.x = pk2(kd[0], kd[1]); o2.y = pk2(kd[2], kd[3]); o2.z = pk2(kd[4], kd[5]); o2.w = pk2(kd[6], kd[7]);
                    *(u32x4*)(KD + ((size_t)d * NT + row) * 512 + c0) = o2;
                }
                bsum += __shfl_xor(bsum, 1); bsum += __shfl_xor(bsum, 2); bsum += __shfl_xor(bsum, 4);
                if ((lane & 7) == 0) BC[(size_t)row * 8 + (lane >> 3)] = bsum;
            }
}


#define RWS 72
__device__ __forceinline__ bf16x8 rw_frag(const bf16_t* M, int row, int kofs) { return *(const bf16x8*)(M + row * RWS + kofs); }
__device__ __forceinline__ f32x4 rw_tile(const bf16_t* Am, int ra, const bf16_t* Bm, int rb, int fr, int fq) {
    f32x4 acc = (f32x4){0.f, 0.f, 0.f, 0.f};
    acc = __builtin_amdgcn_mfma_f32_16x16x32_bf16(rw_frag(Am, ra + fr, 8 * fq), rw_frag(Bm, rb + fr, 8 * fq), acc, 0, 0, 0);
    acc = __builtin_amdgcn_mfma_f32_16x16x32_bf16(rw_frag(Am, ra + fr, 32 + 8 * fq), rw_frag(Bm, rb + fr, 32 + 8 * fq), acc, 0, 0, 0);
    return acc;
}
__device__ __forceinline__ void phase_6(CParams& P, unsigned char* lds, const int ph) {
    PHASE_PROLOGUE
    float* Gs = (float*)lds;
    bf16_t* A_rm = (bf16_t*)(lds + 16384); bf16_t* R_rm = A_rm + 64 * RWS; bf16_t* B_rm = R_rm + 64 * RWS; bf16_t* K_rm = B_rm + 64 * RWS;
    bf16_t* B_tr = K_rm + 64 * RWS; bf16_t* K_tr = B_tr + 64 * RWS; bf16_t* V_tr = K_tr + 64 * RWS;
    bf16_t* MAK = V_tr + 64 * RWS; bf16_t* MRB = MAK + 64 * RWS; bf16_t* MRK = MRB + 64 * RWS;
    bf16_t* MABr = MRK + 64 * RWS;
    float* RHS = (float*)(MABr + 64 * RWS);
    float* BT = RHS + 8192; float* OFF = BT + 512; float* GC = OFF + 512;
    bf16_t* X1_tr = A_rm; bf16_t* X2_tr = K_rm;
    for (int i = tid; i < 4 * 64 * RWS / 2; i += 512) ((unsigned*)MAK)[i] = 0u;
    __syncthreads();
    const int fr = lane & 15, fq = lane >> 4;
    for (int u = bid; u < RW_UNITS; u += G) {
        const int chain = u / RW_NCH, c = u - chain * RW_NCH, d = chain >> 4, b = (chain >> 3) & 1, h = chain & 7;
        const int t0 = tid >> 3, kp = (tid & 7) * 8;
        float lw[8], kk[8], ka[8], kd[8], rr[8]; u32x4 vv;
        {
            const int s = c * 64 + t0; const bool valid = s < LSEQ;
            const int p = d ? LSEQ - 1 - s : s; const size_t o = (size_t)rowof(b, valid ? p : 0) * 512 + h * 64 + kp;
            const u32x4 lwv = *(const u32x4*)(LW + (size_t)d * NT * 512 + o), kkv = *(const u32x4*)(KK + o), kav = *(const u32x4*)(KKA + (size_t)d * NT * 512 + o),
                        kdv = *(const u32x4*)(KD + (size_t)d * NT * 512 + o), rv = *(const u32x4*)(Rr + o);
            vv = *(const u32x4*)(VV + o);
#pragma unroll
            for (int i = 0; i < 4; ++i) {
                union { unsigned u; _Float16 hh[2]; } cv; cv.u = lwv[i];
                lw[2 * i] = valid ? (float)cv.hh[0] : 0.f; lw[2 * i + 1] = valid ? (float)cv.hh[1] : 0.f;
                kk[2 * i] = valid ? bflo(kkv[i]) : 0.f; kk[2 * i + 1] = valid ? bfhi(kkv[i]) : 0.f;
                ka[2 * i] = valid ? bflo(kav[i]) : 0.f; ka[2 * i + 1] = valid ? bfhi(kav[i]) : 0.f;
                kd[2 * i] = valid ? bflo(kdv[i]) : 0.f; kd[2 * i + 1] = valid ? bfhi(kdv[i]) : 0.f;
                rr[2 * i] = valid ? bflo(rv[i]) : 0.f; rr[2 * i + 1] = valid ? bfhi(rv[i]) : 0.f;
                if (!valid) vv[i] = 0u;
            }
        }
        *(f32x4*)(Gs + t0 * 64 + kp) = (f32x4){lw[0], lw[1], lw[2], lw[3]}; *(f32x4*)(Gs + t0 * 64 + kp + 4) = (f32x4){lw[4], lw[5], lw[6], lw[7]};
        __syncthreads();
        { const int k = tid & 63, w = tid >> 6; float acc = 0.f;
#pragma unroll
          for (int i = 0; i < 8; ++i) { acc += Gs[(8 * w + i) * 64 + k]; Gs[(8 * w + i) * 64 + k] = acc; }
          BT[w * 64 + k] = acc; }
        __syncthreads();
        { const int k = tid & 63, w = tid >> 6; float off = 0.f; for (int w2 = 0; w2 < w; ++w2) off += BT[w2 * 64 + k]; OFF[w * 64 + k] = off; }
        __syncthreads();
        {
            float va[8], vr[8], vb[8], vk[8];
#pragma unroll
            for (int i = 0; i < 8; ++i) {
                const float g = Gs[t0 * 64 + kp + i] + OFF[(t0 >> 3) * 64 + kp + i];
                const float eg = __expf(g), egm1 = __expf(g - lw[i]), einv = __expf(-g);
                va[i] = kk[i] * egm1; vr[i] = rr[i] * eg; vb[i] = ka[i] * einv; vk[i] = kd[i] * einv;
                if (t0 == 63) GC[kp + i] = eg;
            }
            *(f32x4*)(RHS + t0 * 128 + kp) = (f32x4){va[0], va[1], va[2], va[3]}; *(f32x4*)(RHS + t0 * 128 + kp + 4) = (f32x4){va[4], va[5], va[6], va[7]};
            u32x4 w4;
            w4.x = pk2(va[0], va[1]); w4.y = pk2(va[2], va[3]); w4.z = pk2(va[4], va[5]); w4.w = pk2(va[6], va[7]); *(u32x4*)(A_rm + t0 * RWS + kp) = w4;
            w4.x = pk2(vr[0], vr[1]); w4.y = pk2(vr[2], vr[3]); w4.z = pk2(vr[4], vr[5]); w4.w = pk2(vr[6], vr[7]); *(u32x4*)(R_rm + t0 * RWS + kp) = w4;
            w4.x = pk2(vb[0], vb[1]); w4.y = pk2(vb[2], vb[3]); w4.z = pk2(vb[4], vb[5]); w4.w = pk2(vb[6], vb[7]); *(u32x4*)(B_rm + t0 * RWS + kp) = w4;
            w4.x = pk2(vk[0], vk[1]); w4.y = pk2(vk[2], vk[3]); w4.z = pk2(vk[4], vk[5]); w4.w = pk2(vk[6], vk[7]); *(u32x4*)(K_rm + t0 * RWS + kp) = w4;
#pragma unroll
            for (int i = 0; i < 8; ++i) { B_tr[(kp + i) * RWS + t0] = (bf16_t)f2bf(vb[i]); K_tr[(kp + i) * RWS + t0] = (bf16_t)f2bf(vk[i]);
                V_tr[(kp + i) * RWS + t0] = (bf16_t)((i & 1) ? (vv[i >> 1] >> 16) : (vv[i >> 1] & 0xffffu)); }
        }
        __syncthreads();
        float* DQ = Gs; bf16_t* TB = (bf16_t*)BT;
#ifndef RW1_REP1
#define RW1_REP1 1
#endif
        for (int rep_ = 0; rep_ < RW1_REP1; ++rep_)
        for (int q = wave; q < 40; q += 8) {
            const int m = q / 10, e = q - m * 10, ti = e >= 6 ? 3 : (e >= 3 ? 2 : (e >= 1 ? 1 : 0)), tj = e - (ti * (ti + 1)) / 2;
            const f32x4 acc = rw_tile(m < 2 ? A_rm : R_rm, 16 * ti, (m & 1) ? K_rm : B_rm, 16 * tj, fr, fq);
            bf16_t* Mm = m == 1 ? MAK : (m == 2 ? MRB : MRK);
#pragma unroll
            for (int j = 0; j < 4; ++j) { const int t = 16 * ti + 4 * fq + j, i = 16 * tj + fr; const bool keep = m < 2 ? (i < t) : (i <= t); const float val = keep ? acc[j] : 0.f;
                if (m == 0) { MABr[t * RWS + i] = (bf16_t)f2bf(val); if (ti == tj) DQ[((ti * 16 + (t & 15)) * 4 + (fr & 3)) * 4 + (fr >> 2)] = val; }
                else Mm[t * RWS + i] = (bf16_t)f2bf(val); }
        }
        __syncthreads();
        if (wave >= 4) {
            for (int q = wave - 4; q < 16; q += 4) { const int ti = q >> 2, tv = q & 3; const f32x4 acc = rw_tile(MAK, 16 * ti, V_tr, 16 * tv, fr, fq);
#pragma unroll
                for (int j = 0; j < 4; ++j) RHS[(16 * ti + 4 * fq + j) * 128 + 64 + 16 * tv + fr] = acc[j]; }
        } else {
            const int bb = wave, cc = lane >> 2, q = lane & 3;
            float xs[4] = {0.f, 0.f, 0.f, 0.f};
#pragma unroll
            for (int tl = 0; tl < 16; ++tl) {
                const f32x4 mv = *(const f32x4*)(DQ + ((bb * 16 + tl) * 4 + q) * 4);
                float part = mv[0] * xs[0] + mv[1] * xs[1] + mv[2] * xs[2] + mv[3] * xs[3];
                part += dppf<0xB1>(part); part += dppf<0x4E>(part);
                const float xt = (tl == cc ? 1.f : 0.f) - part;
                xs[tl >> 2] = (tl & 3) == q ? xt : xs[tl >> 2];
            }
#pragma unroll
            for (int m = 0; m < 4; ++m) TB[(bb * 16 + 4 * m + q) * 16 + cc] = (bf16_t)f2bf(xs[m]);
        }
        __syncthreads();
        {
            const int c0 = 16 * wave;
            f32x4 X[4];
            const f32x4 zero4 = (f32x4){0.f, 0.f, 0.f, 0.f};
#define RW1_PACK(lo_, hi_, v_) do { union { bf16x8 v; unsigned u[4]; } t_; t_.u[0] = pk2(lo_[0], lo_[1]); t_.u[1] = pk2(lo_[2], lo_[3]); t_.u[2] = pk2(hi_[0], hi_[1]); t_.u[3] = pk2(hi_[2], hi_[3]); v_ = t_.v; } while (0)
#define RW1_LDA(base_, row0_, ca_, cb_, useb_, v_) do { union { bf16x8 v; u32x2 h2[2]; } t_; t_.h2[0] = *(const u32x2*)((base_) + ((row0_) + fr) * RWS + (ca_) + 4 * fq); \
            t_.h2[1] = (useb_) ? *(const u32x2*)((base_) + ((row0_) + fr) * RWS + (cb_) + 4 * fq) : (u32x2){0u, 0u}; v_ = t_.v; } while (0)
#pragma unroll
            for (int bq = 0; bq < 4; ++bq) {
                f32x4 acc;
#pragma unroll
                for (int j = 0; j < 4; ++j) acc[j] = -RHS[(16 * bq + 4 * fq + j) * 128 + c0 + fr];
                bf16x8 af, bfv;
                if (bq >= 1) { RW1_LDA(MABr, 16 * bq, 0, 16, bq >= 2, af); if (bq >= 2) RW1_PACK(X[0], X[1], bfv); else RW1_PACK(X[0], zero4, bfv);
                    acc = __builtin_amdgcn_mfma_f32_16x16x32_bf16(af, bfv, acc, 0, 0, 0); }
                if (bq == 3) { RW1_LDA(MABr, 48, 32, 0, false, af); RW1_PACK(X[2], zero4, bfv); acc = __builtin_amdgcn_mfma_f32_16x16x32_bf16(af, bfv, acc, 0, 0, 0); }
                const f32x4 wv = (f32x4){-acc[0], -acc[1], -acc[2], -acc[3]};
                { union { bf16x8 v; u32x2 h2[2]; } t_; t_.h2[0] = *(const u32x2*)(TB + (bq * 16 + fr) * 16 + 4 * fq); t_.h2[1] = (u32x2){0u, 0u}; af = t_.v; }
                RW1_PACK(wv, zero4, bfv);
                X[bq] = __builtin_amdgcn_mfma_f32_16x16x32_bf16(af, bfv, zero4, 0, 0, 0);
                bf16_t* Xm = (wave < 4 ? X1_tr : X2_tr) + ((c0 & 63) + fr) * RWS + 16 * bq + 4 * fq;
                u32x2 o; o.x = pk2(X[bq][0], X[bq][1]); o.y = pk2(X[bq][2], X[bq][3]);
                *(u32x2*)Xm = o;
            }
#undef RW1_PACK
#undef RW1_LDA
        }
        __syncthreads();
#ifndef RW1_REP5
#define RW1_REP5 1
#endif
        for (int rep_ = 0; rep_ < RW1_REP5; ++rep_)
        for (int q = wave; q < 64; q += 8) {
            const int kind = q >> 4, ta = (q >> 2) & 3, tb = q & 3;
            u32x2 o;
            if (kind == 0) {
                const f32x4 acc = rw_tile(X1_tr, 16 * ta, B_tr, 16 * tb, fr, fq);
                const int k = 16 * tb + fr, kq = 16 * ta + 4 * fq; const float gc = GC[k];
                float v[4];
#pragma unroll
                for (int j = 0; j < 4; ++j) v[j] = gc * ((kq + j == k ? 1.f : 0.f) - acc[j]);
                o.x = pk2(v[0], v[1]); o.y = pk2(v[2], v[3]);
                *(u32x2*)(PP + (size_t)u * 4096 + k * 64 + 32 * (ta >> 1) + 8 * fq + 4 * (ta & 1)) = o;
            } else if (kind == 1) {
                const f32x4 acc = rw_tile(X1_tr, 16 * ta, MRB, 16 * tb, fr, fq);
                const int t = 16 * tb + fr, k0 = 16 * ta + 4 * fq;
                const u32x2 rv = *(const u32x2*)(R_rm + t * RWS + k0);
                o.x = pk2(bflo(rv.x) - acc[0], bfhi(rv.x) - acc[1]); o.y = pk2(bflo(rv.y) - acc[2], bfhi(rv.y) - acc[3]);
                *(u32x2*)(YT + (size_t)u * 4096 + t * 64 + 32 * (ta >> 1) + 8 * fq + 4 * (ta & 1)) = o;
            } else if (kind == 2) {
                const f32x4 a1 = rw_tile(K_tr, 16 * ta, V_tr, 16 * tb, fr, fq), a2 = rw_tile(B_tr, 16 * ta, X2_tr, 16 * tb, fr, fq);
                const int v_ = 16 * tb + fr, k0 = 16 * ta + 4 * fq;
                const f32x4 gc = *(const f32x4*)(GC + k0);
                o.x = pk2(gc[0] * (a1[0] - a2[0]), gc[1] * (a1[1] - a2[1])); o.y = pk2(gc[2] * (a1[2] - a2[2]), gc[3] * (a1[3] - a2[3]));
                *(u32x2*)(QT + (size_t)u * 4096 + v_ * 64 + k0) = o;
            } else {
                const f32x4 a1 = rw_tile(MRK, 16 * ta, V_tr, 16 * tb, fr, fq), a2 = rw_tile(MRB, 16 * ta, X2_tr, 16 * tb, fr, fq);
                const int v_ = 16 * tb + fr, t0_ = 16 * ta + 4 * fq;
                o.x = pk2(a1[0] - a2[0], a1[1] - a2[1]); o.y = pk2(a1[2] - a2[2], a1[3] - a2[3]);
                *(u32x2*)(ZT + (size_t)u * 4096 + v_ * 64 + t0_) = o;
            }
        }
        __syncthreads();
    }
}

__device__ __forceinline__ void phase_60(CParams& P, unsigned char* lds, const int ph) {
    PHASE_PROLOGUE
    if (bid < 32) {
        const int chain = bid, d = chain >> 4, b = (chain >> 3) & 1, h = chain & 7;
        const int fr = lane & 15, fq = lane >> 4;
        constexpr int MATB = 64 * RWS * 2, SLOT = 4 * MATB;
        bf16_t* ybuf = (bf16_t*)(lds + 3 * SLOT);
        const bool comp = wave < 4; const int vb = wave & 3, lm = wave & 3;
        const unsigned char* src = (const unsigned char*)(lm == 0 ? PP : (lm == 1 ? YT : (lm == 2 ? QT : ZT))) + (size_t)chain * RW_NCH * 8192 + lane * 16;
        u32x4 R0[8], R1[8], R2[8];
#define RW2_LD(Rx, c_) do { _Pragma("unroll") for (int i_ = 0; i_ < 8; ++i_) Rx[i_] = *(const u32x4*)(src + (size_t)(c_) * 8192 + i_ * 1024); } while (0)
#define RW2_ST(Rx, c_) do { unsigned char* dst_ = lds + ((c_) % 3) * SLOT + lm * MATB; _Pragma("unroll") for (int i_ = 0; i_ < 8; ++i_) { const int p_ = lane + 64 * i_; *(u32x4*)(dst_ + (p_ >> 3) * (RWS * 2) + (p_ & 7) * 16) = Rx[i_]; } } while (0)
#define RW2_FLUSH(c_) do { const int tl_ = 16 * lm + (lane >> 2), s_ = (c_) * 64 + tl_; const bf16_t* yb_ = ybuf + ((c_) & 1) * 64 * RWS + tl_ * RWS + 16 * (lane & 3); \
            const u32x4 y0_ = *(const u32x4*)yb_, y1_ = *(const u32x4*)(yb_ + 8); \
            if (s_ < LSEQ) { const int p_ = d ? LSEQ - 1 - s_ : s_; bf16_t* g_ = YFB + ((size_t)d * NT + rowof(b, p_)) * 512 + h * 64 + 16 * (lane & 3); *(u32x4*)g_ = y0_; *(u32x4*)(g_ + 8) = y1_; } } while (0)
        const f32x4 zero4 = (f32x4){0.f, 0.f, 0.f, 0.f};
        f32x4 S[4] = {zero4, zero4, zero4, zero4};
#define RW2_COMPUTE(c_) do { const bf16_t* sl_ = (const bf16_t*)(lds + ((c_) % 3) * SLOT); const bf16_t* sP = sl_; const bf16_t* sY = sl_ + 64 * RWS; const bf16_t* sQ = sl_ + 2 * 64 * RWS; const bf16_t* sZ = sl_ + 3 * 64 * RWS; \
            bf16_t* yo_ = ybuf + ((c_) & 1) * 64 * RWS + 16 * vb + fr; \
            union { bf16x8 v; unsigned u[4]; } bs[2]; \
            _Pragma("unroll") for (int ks = 0; ks < 2; ++ks) { bs[ks].u[0] = pk2(S[2 * ks][0], S[2 * ks][1]); bs[ks].u[1] = pk2(S[2 * ks][2], S[2 * ks][3]); \
                bs[ks].u[2] = pk2(S[2 * ks + 1][0], S[2 * ks + 1][1]); bs[ks].u[3] = pk2(S[2 * ks + 1][2], S[2 * ks + 1][3]); } \
            _Pragma("unroll") for (int tt = 0; tt < 4; ++tt) { \
                const u32x2 z2 = *(const u32x2*)(sZ + (16 * vb + fr) * RWS + 16 * tt + 4 * fq); \
                f32x4 acc = (f32x4){bflo(z2.x), bfhi(z2.x), bflo(z2.y), bfhi(z2.y)}; \
                acc = __builtin_amdgcn_mfma_f32_16x16x32_bf16(*(const bf16x8*)(sY + (16 * tt + fr) * RWS + 8 * fq), bs[0].v, acc, 0, 0, 0); \
                acc = __builtin_amdgcn_mfma_f32_16x16x32_bf16(*(const bf16x8*)(sY + (16 * tt + fr) * RWS + 32 + 8 * fq), bs[1].v, acc, 0, 0, 0); \
                _Pragma("unroll") for (int j = 0; j < 4; ++j) yo_[(16 * tt + 4 * fq + j) * RWS] = (bf16_t)f2bf(acc[j]); } \
            f32x4 Sn[4]; \
            _Pragma("unroll") for (int kt = 0; kt < 4; ++kt) { \
                const u32x2 q2 = *(const u32x2*)(sQ + (16 * vb + fr) * RWS + 16 * kt + 4 * fq); \
                f32x4 acc = (f32x4){bflo(q2.x), bfhi(q2.x), bflo(q2.y), bfhi(q2.y)}; \
                acc = __builtin_amdgcn_mfma_f32_16x16x32_bf16(*(const bf16x8*)(sP + (16 * kt + fr) * RWS + 8 * fq), bs[0].v, acc, 0, 0, 0); \
                acc = __builtin_amdgcn_mfma_f32_16x16x32_bf16(*(const bf16x8*)(sP + (16 * kt + fr) * RWS + 32 + 8 * fq), bs[1].v, acc, 0, 0, 0); \
                Sn[kt] = acc; } \
            _Pragma("unroll") for (int kt = 0; kt < 4; ++kt) S[kt] = Sn[kt]; } while (0)
#define RW2_BAR() do { asm volatile("s_waitcnt lgkmcnt(0)" ::: "memory"); __builtin_amdgcn_s_barrier(); asm volatile("" ::: "memory"); } while (0)
        if (!comp) { RW2_LD(R0, 0); RW2_ST(R0, 0); RW2_LD(R0, 1); RW2_LD(R1, 2); RW2_LD(R2, 3); }
        __syncthreads();
        for (int c = 0; c < RW_NCH; c += 3) {
            if (!comp) { if (c + 1 < RW_NCH) RW2_ST(R0, c + 1); if (c + 4 < RW_NCH) RW2_LD(R0, c + 4); if (c > 0) RW2_FLUSH(c - 1); } else RW2_COMPUTE(c);
            RW2_BAR();
            if (!comp) { if (c + 2 < RW_NCH) RW2_ST(R1, c + 2); if (c + 5 < RW_NCH) RW2_LD(R1, c + 5); RW2_FLUSH(c); } else RW2_COMPUTE(c + 1);
            RW2_BAR();
            if (!comp) { if (c + 3 < RW_NCH) RW2_ST(R2, c + 3); if (c + 6 < RW_NCH) RW2_LD(R2, c + 6); RW2_FLUSH(c + 1); } else RW2_COMPUTE(c + 2);
            RW2_BAR();
        }
        if (!comp) RW2_FLUSH(RW_NCH - 1);
#undef RW2_LD
#undef RW2_ST
#undef RW2_FLUSH
#undef RW2_COMPUTE
#undef RW2_BAR
    } else {
        na_units(P, lds, (bid - 32) * 8 + (threadIdx.x >> 6), (G - 32) * 8);
    }
}

__device__ __forceinline__ void phase_7(CParams& P, unsigned char* lds, const int ph) {
    PHASE_PROLOGUE
            for (int row = gw; row < NT; row += NGW) {
                const int c0 = lane * 8;
                const u32x4 yf = *(const u32x4*)(YFB + (size_t)row * 512 + c0);
                const u32x4 yb = *(const u32x4*)(YFB + ((size_t)NT + row) * 512 + c0);
                const u32x4 vv = *(const u32x4*)(VV + (size_t)row * 512 + c0);
                const u32x4 gg = *(const u32x4*)(Gg + (size_t)row * 512 + c0);
                float y[8], v[8], g[8];
#pragma unroll
                for (int i = 0; i < 4; ++i) { y[2 * i] = bflo(yf[i]) + bflo(yb[i]); y[2 * i + 1] = bfhi(yf[i]) + bfhi(yb[i]); v[2 * i] = bflo(vv[i]); v[2 * i + 1] = bfhi(vv[i]); g[2 * i] = bflo(gg[i]); g[2 * i + 1] = bfhi(gg[i]); }
                float sm = 0.f;
#pragma unroll
                for (int i = 0; i < 8; ++i) sm += y[i];
                sm += __shfl_xor(sm, 1); sm += __shfl_xor(sm, 2); sm += __shfl_xor(sm, 4);
                const float mean = sm * (1.f / 64.f);
                float vr = 0.f;
#pragma unroll
                for (int i = 0; i < 8; ++i) { const float dlt = y[i] - mean; vr += dlt * dlt; }
                vr += __shfl_xor(vr, 1); vr += __shfl_xor(vr, 2); vr += __shfl_xor(vr, 4);
                const float rstd = rsqrtf(vr * (1.f / 64.f) + 64e-5f);
                const float bc = BC[(size_t)row * 8 + (lane >> 3)];
                float o[8];
#pragma unroll
                for (int i = 0; i < 8; ++i) o[i] = ((y[i] - mean) * rstd * lnx_g[c0 + i] + lnx_b[c0 + i] + bc * v[i]) * g[i];
                u32x4 ov; ov.x = pk2(o[0], o[1]); ov.y = pk2(o[2], o[3]); ov.z = pk2(o[4], o[5]); ov.w = pk2(o[6], o[7]);
                *(u32x4*)(A2 + (size_t)row * DM + 512 + c0) = ov;
            }
}


__device__ __forceinline__ void phase_8(CParams& P, unsigned char* lds, const int ph) {
    PHASE_PROLOGUE
    if (gw < 64) meta_gemm<0>(A2 + (size_t)NMAIN * DM, WTOUT, H + (size_t)NMAIN * DM, gw, lane);
    pg8::DenseOrder S; S.init(A2, WTOUT, NMAIN, DM, DM, G, bid);
    pg8::EpiResidual E{H};
    pg8::gemm_phase<pg8::EpiResidual, pg8::DenseOrder, true, true>((PG8_LAS unsigned char*)lds, DM, S, E);
}

__device__ __forceinline__ void phase_9(CParams& P, unsigned char* lds, const int ph) {
    PHASE_PROLOGUE
            const int l = ph == 9 ? 0 : 1;
                    unsigned* cnt = CTL + CW_CNT(l);
            const float* wg = moe_wg + (size_t)l * DM * 4; const float* bg = moe_bg + l * 4;
            for (int row = gw; row < NT; row += NGW) {
                f32x4 v[4]; float ss = 0.f;
#pragma unroll
                for (int j = 0; j < 4; ++j) { v[j] = ((const f32x4*)(H + (size_t)row * DM))[lane + 64 * j]; ss += v[j][0] * v[j][0] + v[j][1] * v[j][1] + v[j][2] * v[j][2] + v[j][3] * v[j][3]; }
                ss = wave_sum(ss);
                const float rstd = rsqrtf(ss * (1.f / DM) + 1e-6f);
                float lg[4] = {0.f, 0.f, 0.f, 0.f};
#pragma unroll
                for (int j = 0; j < 4; ++j) {
                    const f32x4 g = ((const f32x4*)(norm_ffn + l * DM))[lane + 64 * j];
#pragma unroll
                    for (int i = 0; i < 4; ++i) v[j][i] = v[j][i] * rstd * g[i];
                    u32x2 o; o.x = pk2(v[j][0], v[j][1]); o.y = pk2(v[j][2], v[j][3]);
                    ((u32x2*)(HN + (size_t)row * DM))[lane + 64 * j] = o;
#pragma unroll
                    for (int i = 0; i < 4; ++i) { const f32x4 w = *(const f32x4*)(wg + (size_t)(4 * (lane + 64 * j) + i) * 4);
                        lg[0] += v[j][i] * w[0]; lg[1] += v[j][i] * w[1]; lg[2] += v[j][i] * w[2]; lg[3] += v[j][i] * w[3]; }
                }
#pragma unroll
                for (int q = 0; q < 4; ++q) lg[q] = wave_sum(lg[q]) + bg[q];
                int grp = 0; float mx = lg[0];
#pragma unroll
                for (int q = 1; q < 4; ++q) if (lg[q] > mx) { mx = lg[q]; grp = q; }
                float den = 0.f;
#pragma unroll
                for (int q = 0; q < 4; ++q) den += __expf(lg[q] - mx);
                const float pgrp = 1.f / den;
                const float* we = moe_we + ((size_t)(l * 4 + grp) * DM) * 8;
                float le[8] = {0.f, 0.f, 0.f, 0.f, 0.f, 0.f, 0.f, 0.f};
#pragma unroll
                for (int j = 0; j < 4; ++j)
#pragma unroll
                    for (int i = 0; i < 4; ++i) { const float* wr_ = we + (size_t)(4 * (lane + 64 * j) + i) * 8; const f32x4 wa = *(const f32x4*)wr_, wb = *(const f32x4*)(wr_ + 4);
                        le[0] += v[j][i] * wa[0]; le[1] += v[j][i] * wa[1]; le[2] += v[j][i] * wa[2]; le[3] += v[j][i] * wa[3];
                        le[4] += v[j][i] * wb[0]; le[5] += v[j][i] * wb[1]; le[6] += v[j][i] * wb[2]; le[7] += v[j][i] * wb[3]; }
#pragma unroll
                for (int q = 0; q < 8; ++q) le[q] = wave_sum(le[q]) + moe_be[(l * 4 + grp) * 8 + q];
                int i1 = 0; float m1 = le[0];
#pragma unroll
                for (int q = 1; q < 8; ++q) if (le[q] > m1) { m1 = le[q]; i1 = q; }
                int i2 = (i1 + 1) & 7; float m2 = -3.0e38f;
#pragma unroll
                for (int q = 0; q < 8; ++q) if (q != i1 && le[q] > m2) { m2 = le[q]; i2 = q; }
                const float e2 = __expf(m2 - m1);
                const float g1 = pgrp / (1.f + e2), g2 = pgrp * e2 / (1.f + e2);
                if (lane == 0) {
                    const int ea = grp * 8 + i1, eb = grp * 8 + i2;
                    const unsigned pa = atomicAdd(cnt + ea, 1u), pb = atomicAdd(cnt + eb, 1u);
                    EID[row * 2] = ea; EID[row * 2 + 1] = eb; POS[row * 2] = (int)pa; POS[row * 2 + 1] = (int)pb;
                    GATE[row * 2] = g1; GATE[row * 2 + 1] = g2;
                }
            }
    for (int it = gw; it < CONV_MOE_ITEMS; it += NGW) conv_moe_item(P, l, it, lane);
}


__device__ __forceinline__ void phase_10(CParams& P, unsigned char* lds, const int ph) {
    PHASE_PROLOGUE
    const int l = ph == 10 ? 0 : 1;
    int* ps = (int*)(lds + LDS_TAB);
    if (tid == 0) { int acc_ = 0; for (int e = 0; e < NEXP; ++e) { ps[e] = acc_; const int c = (int)CTL[CW_CNT(l) + e]; acc_ += (c + MOE_RT - 1) / MOE_RT * MOE_RT; } ps[NEXP] = acc_; }
    __syncthreads();
    for (int row = gw; row < NT; row += NGW) {
        const u32x4 v0 = ((const u32x4*)(HN + (size_t)row * DM))[lane], v1 = ((const u32x4*)(HN + (size_t)row * DM))[lane + 64];
#pragma unroll
        for (int k = 0; k < 2; ++k) {
            const int dest = ps[EID[row * 2 + k]] + POS[row * 2 + k];
            if (lane == 0) DEST[row * 2 + k] = dest;
            ((u32x4*)(XB + (size_t)dest * DM))[lane] = v0; ((u32x4*)(XB + (size_t)dest * DM))[lane + 64] = v1;
        }
    }
    __syncthreads();
}

__device__ __forceinline__ void phase_11(CParams& P, unsigned char* lds, const int ph) {
    PHASE_PROLOGUE
    const int l = ph == 11 ? 0 : 1;
    int* et = (int*)(lds + LDS_TAB);
    if (tid == 0) { int acc_ = 0; for (int e = 0; e < NEXP; ++e) { const int c = (int)CTL[CW_CNT(l) + e], n = (c + MOE_RT - 1) / MOE_RT; for (int q = 0; q < n; ++q) et[1 + acc_ + q] = e; acc_ += n; } et[0] = acc_; }
    __syncthreads();
    pg8::MoeOrder S{et + 1, et[0], vcu, (const char*)XB, (const char*)WT13, 256u * DM * 2u, 256u * DM * 2u, (unsigned)DM * DM * 2u};
    pg8::EpiSwiglu E{HB};
    pg8::gemm_phase<pg8::EpiSwiglu, pg8::MoeOrder, true, true>((PG8_LAS unsigned char*)lds, DM, S, E);
    __syncthreads();
}

__device__ __forceinline__ void phase_12(CParams& P, unsigned char* lds, const int ph) {
    PHASE_PROLOGUE
    const int l = ph == 12 ? 0 : 1;
    int* et = (int*)(lds + LDS_TAB);
    if (tid == 0) { int acc_ = 0; for (int e = 0; e < NEXP; ++e) { const int c = (int)CTL[CW_CNT(l) + e], n = (c + MOE_RT - 1) / MOE_RT; for (int q = 0; q < n; ++q) et[1 + acc_ + q] = e; acc_ += n; } et[0] = acc_; }
    __syncthreads();
    pg8::MoeOrder S{et + 1, et[0], vcu, (const char*)HB, (const char*)WT2, 256u * DFF * 2u, 256u * DFF * 2u, (unsigned)DM * DFF * 2u};
    pg8::EpiBf16Plain E{YB, DM};
    pg8::gemm_phase<pg8::EpiBf16Plain, pg8::MoeOrder, true, true>((PG8_LAS unsigned char*)lds, DFF, S, E);
    __syncthreads();
}

__device__ __forceinline__ void phase_13(CParams& P, unsigned char* lds, const int ph) {
    PHASE_PROLOGUE
            const bool fin = ph == 21;
            for (int row = gw; row < NT; row += NGW) {
                const int d0 = DEST[row * 2], d1 = DEST[row * 2 + 1];
                const float g0 = GATE[row * 2], g1 = GATE[row * 2 + 1];
                f32x4 v[4];
#pragma unroll
                for (int j = 0; j < 4; ++j) {
                    v[j] = ((const f32x4*)(H + (size_t)row * DM))[lane + 64 * j];
                    const u32x2 ya = ((const u32x2*)(YB + (size_t)d0 * DM))[lane + 64 * j];
                    const u32x2 yb = ((const u32x2*)(YB + (size_t)d1 * DM))[lane + 64 * j];
                    v[j][0] += g0 * bflo(ya.x) + g1 * bflo(yb.x); v[j][1] += g0 * bfhi(ya.x) + g1 * bfhi(yb.x);
                    v[j][2] += g0 * bflo(ya.y) + g1 * bflo(yb.y); v[j][3] += g0 * bfhi(ya.y) + g1 * bfhi(yb.y);
                }
                if (!fin) {
#pragma unroll
                    for (int j = 0; j < 4; ++j) ((f32x4*)(H + (size_t)row * DM))[lane + 64 * j] = v[j];
                    store_norm_bf16(v, norm_mix + DM, HN + (size_t)row * DM, lane);
                } else if (row < NMAIN) {
                    float ss = 0.f;
#pragma unroll
                    for (int j = 0; j < 4; ++j) ss += v[j][0] * v[j][0] + v[j][1] * v[j][1] + v[j][2] * v[j][2] + v[j][3] * v[j][3];
                    ss = wave_sum(ss);
                    const float rstd = rsqrtf(ss * (1.f / DM) + 1e-6f);
#pragma unroll
                    for (int j = 0; j < 4; ++j) { const f32x4 g = ((const f32x4*)norm_final)[lane + 64 * j]; f32x4 o;
                        o[0] = v[j][0] * rstd * g[0]; o[1] = v[j][1] * rstd * g[1]; o[2] = v[j][2] * rstd * g[2]; o[3] = v[j][3] * rstd * g[3];
                        ((f32x4*)(P.out + (size_t)row * DM))[lane + 64 * j] = o; }
                }
            }
}

__device__ __forceinline__ void phase_14(CParams& P, unsigned char* lds, const int ph) {
    PHASE_PROLOGUE
    float* pwr = (float*)lds; float* pwi = pwr + 2176; float* bbr = pwi + 2176; float* bbi = bbr + 2048; float* ccr = bbi + 2048; float* cci = ccr + 2048; float* kf = cci + 2048; float* kb = kf + 4096;
    for (int gu = bid; gu < 256; gu += G) {
        const int g = gu >> 2, part = gu & 3;
        if (tid < 128) {
            const int d = tid >> 6, p = tid & 63;
            const float step = __expf(s5_ls[d * 64 + g]);
            const float lr = s5_lre[(d * 64 + g) * 64 + p], li = s5_lim[(d * 64 + g) * 64 + p];
            const float mag = expf(lr * step);
            const float abr = mag * cosf(li * step), abi = mag * sinf(li * step);
            const float den = lr * lr + li * li;
            const float zr = ((abr - 1.f) * lr + abi * li) / den, zi = (abi * lr - (abr - 1.f) * li) / den;
            float pr = 1.f, pi = 0.f;
            for (int t = 0; t < 17; ++t) { pwr[(d * 64 + p) * 17 + t] = pr; pwi[(d * 64 + p) * 17 + t] = pi; const float nr = pr * abr - pi * abi; pi = pr * abi + pi * abr; pr = nr; }
            for (int i = 0; i < 16; ++i) { const float br = s5_b_re[((size_t)(g * 64 + p)) * 16 + i], bi = s5_b_im[((size_t)(g * 64 + p)) * 16 + i];
                bbr[(d * 64 + p) * 16 + i] = zr * br - zi * bi; bbi[(d * 64 + p) * 16 + i] = zr * bi + zi * br; }
        }
        for (int idx = tid; idx < 2048; idx += 512) { const int d = idx >> 10, i = (idx >> 6) & 15, p = idx & 63;
            ccr[idx] = s5_c_re[((size_t)(d * 64 + g) * 16 + i) * 64 + p]; cci[idx] = s5_c_im[((size_t)(d * 64 + g) * 16 + i) * 64 + p]; }
        __syncthreads();
        {
            const int d = tid >> 8, tau = (tid >> 4) & 15, i = tid & 15;
            float acc[16];
#pragma unroll
            for (int q = 0; q < 16; ++q) acc[q] = 0.f;
            for (int p = 0; p < 64; ++p) {
                const float cr = ccr[(d * 16 + i) * 64 + p], ci = cci[(d * 16 + i) * 64 + p], pr = pwr[(d * 64 + p) * 17 + tau], pi = pwi[(d * 64 + p) * 17 + tau];
                const float xr = cr * pr - ci * pi, xi = cr * pi + ci * pr;
#pragma unroll
                for (int q = 0; q < 16; ++q) acc[q] += xr * bbr[(d * 64 + p) * 16 + q] - xi * bbi[(d * 64 + p) * 16 + q];
            }
            float* kt = (d ? kb : kf) + (tau * 16 + i) * 16;
#pragma unroll
            for (int q = 0; q < 16; ++q) kt[q] = acc[q];
        }
        __syncthreads();
        unsigned* bta = (unsigned*)(BTA + (size_t)g * 512 * 256);
        for (int idx = part * 128 * 128 + tid; idx < (part + 1) * 128 * 128; idx += 512) {
            const int row = idx >> 7, col = (idx & 127) * 2;
            float v[2];
#pragma unroll
            for (int e = 0; e < 2; ++e) {
                const int cc_ = col + e, j = cc_ >> 4, ip = cc_ & 15;
                if (row < 256) { const int t = row >> 4, i = row & 15;
                    v[e] = j < t ? kf[((t - j) * 16 + i) * 16 + ip] : (j > t ? kb[((j - t) * 16 + i) * 16 + ip] : kf[i * 16 + ip] + kb[i * 16 + ip]); }
                else { const int kp = row - 256, d = kp >> 7, part = (kp >> 6) & 1, p = kp & 63, tau = d == 0 ? 15 - j : j;
                    const float pr = pwr[(d * 64 + p) * 17 + tau], pi = pwi[(d * 64 + p) * 17 + tau], br = bbr[(d * 64 + p) * 16 + ip], bi = bbi[(d * 64 + p) * 16 + ip];
                    v[e] = part ? pr * bi + pi * br : pr * br - pi * bi; }
            }
            bta[idx] = pk2(v[0], v[1]);
        }
        unsigned* btc = (unsigned*)(BTC + (size_t)g * 256 * 256);
        for (int idx = part * 64 * 128 + tid; idx < (part + 1) * 64 * 128; idx += 512) {
            const int row = idx >> 7, col = (idx & 127) * 2, t = row >> 4, i = row & 15;
            float v[2];
#pragma unroll
            for (int e = 0; e < 2; ++e) {
                const int k = col + e, d = k >> 7, part = (k >> 6) & 1, p = k & 63, tau = d == 0 ? t + 1 : 16 - t;
                const float cr = ccr[(d * 16 + i) * 64 + p], ci = cci[(d * 16 + i) * 64 + p], pr = pwr[(d * 64 + p) * 17 + tau], pi = pwi[(d * 64 + p) * 17 + tau];
                v[e] = part ? -(cr * pi + ci * pr) : cr * pr - ci * pi;
            }
            btc[idx] = pk2(v[0], v[1]);
        }
        __syncthreads();
    }
}

__device__ __forceinline__ void phase_15(CParams& P, unsigned char* lds, const int ph) {
    PHASE_PROLOGUE
    pg8::S5OrderA S{vcu, (const char*)HN, (const char*)BTA};
    pg8::EpiS5A E{YI, S5E};
    int Kr = 256; asm volatile("" : "+s"(Kr));
    pg8::gemm_phase<pg8::EpiS5A, pg8::S5OrderA, true, true>((PG8_LAS unsigned char*)lds, Kr, S, E);
}

__device__ __forceinline__ void phase_16(CParams& P, unsigned char* lds, const int ph) {
    PHASE_PROLOGUE
    for (int i = bid * 512 + tid; i < NB * 64 * 2 * 64; i += G * 512) {
        const int p = i & 63, d = (i >> 6) & 1, g = (i >> 7) & 63, b = i >> 13;
        const float step = __expf(s5_ls[d * 64 + g]);
        const float lr = s5_lre[(d * 64 + g) * 64 + p], li = s5_lim[(d * 64 + g) * 64 + p];
        const float mag = expf(lr * step);
        const float abr = mag * cosf(li * step), abi = mag * sinf(li * step);
        float ar = 1.f, ai = 0.f;
        for (int t = 0; t < 16; ++t) { const float nr = ar * abr - ai * abi; ai = ar * abi + ai * abr; ar = nr; }
        const float* Ep = S5E + (size_t)g * 256 + d * 128 + p;
        bf16_t* Cp = CAR + (size_t)g * 1280 * 256 + d * 128 + p;
        float sr = 0.f, si = 0.f;
        for (int q0 = 0; q0 < 513; q0 += 9) {
            float er[9], ei[9]; int nn[9];
#pragma unroll
            for (int k = 0; k < 9; ++k) { const int q = q0 + k, c = d ? 512 - q : q; nn[k] = c == 0 ? 1024 + b : b * 512 + c - 1; er[k] = Ep[(size_t)nn[k] * 64 * 256]; ei[k] = Ep[(size_t)nn[k] * 64 * 256 + 64]; }
#pragma unroll
            for (int k = 0; k < 9; ++k) { Cp[(size_t)nn[k] * 256] = (bf16_t)f2bf(sr); Cp[(size_t)nn[k] * 256 + 64] = (bf16_t)f2bf(si);
                const float nr = ar * sr - ai * si + er[k]; si = ar * si + ai * sr + ei[k]; sr = nr; }
        }
    }
}

__device__ __forceinline__ void phase_22(CParams& P, unsigned char* lds, const int ph) {
    PHASE_PROLOGUE
    pg8::S5OrderC S{vcu, (const char*)CAR, (const char*)BTC};
    pg8::EpiS5C E{YI, HN, s5_d, A2};
    int Kr = 256; asm volatile("" : "+s"(Kr));
    pg8::gemm_phase<pg8::EpiS5C, pg8::S5OrderC, true, true>((PG8_LAS unsigned char*)lds, Kr, S, E);
}

__device__ __forceinline__ void phase_23(CParams& P, unsigned char* lds, const int ph) {
    PHASE_PROLOGUE
    if (gw < 64) meta_gemm<1>(A2 + (size_t)NMAIN * DM, WTGLU, H + (size_t)NMAIN * DM, gw, lane);
    pg8::DenseOrder S; S.init(A2, WTGLU, NMAIN, 2 * DM, DM, G, bid);
    pg8::EpiGlu E{H};
    pg8::gemm_phase<pg8::EpiGlu, pg8::DenseOrder, true, true>((PG8_LAS unsigned char*)lds, DM, S, E);
}
#define LAS __attribute__((address_space(3)))
#define CW_BAR 4096
#define XB_TMO      128
#define XB_XCNT(j)  (256  + 64 * (j))
#define XB_XSUB(j)  (1280 + 64 * (j))
#define XB_XGEN(j)  (2304 + 64 * (j))
#define XB_TOP      3328
#define XB_TOPGEN   3392
#define XCD_BAR_WORDS 3456
#define XB_SPIN_CAP (1u << 22)
__device__ __forceinline__ unsigned xb_ld(unsigned* p)              { return __hip_atomic_load(p, __ATOMIC_RELAXED, __HIP_MEMORY_SCOPE_AGENT); }
__device__ __forceinline__ unsigned xb_add(unsigned* p, unsigned v) { return __hip_atomic_fetch_add(p, v, __ATOMIC_RELAXED, __HIP_MEMORY_SCOPE_AGENT); }
__device__ __forceinline__ unsigned xb_xcc_id() { return (unsigned)__builtin_amdgcn_s_getreg((3 << 11) | 20) & 0xFu; }
#define XB_SPIN(cond, bar) do { unsigned _sp = 0; while (cond) { __builtin_amdgcn_s_sleep(1); \
    if ((++_sp & 255u) == 0u) { if (xb_ld(&(bar)[XB_TMO])) break; if (_sp > XB_SPIN_CAP) { atomicAdd(&(bar)[XB_TMO], 1u); break; } } } } while (0)
struct XcdBarrier { unsigned* bar; unsigned x; volatile LAS unsigned* st; };
__device__ __forceinline__ XcdBarrier xcd_barrier_post(unsigned* bar, volatile LAS unsigned* st) {
    XcdBarrier b; b.bar = bar; b.x = xb_xcc_id(); b.st = st;
    if (threadIdx.x == 0) (void)xb_add(&bar[XB_XCNT(b.x)], 1u);
    return b;
}
__device__ __forceinline__ void xcd_barrier_complete(unsigned* bar, unsigned x, unsigned& nloc, unsigned& nx) {
    const unsigned G = GRID;
    unsigned sum, cnt, mine, sp = 0u;
    for (;;) {
        sum = 0u; cnt = 0u; mine = 0u;
#pragma unroll
        for (unsigned j = 0; j < 16; ++j) { const unsigned c = xb_ld(&bar[XB_XCNT(j)]); sum += c; cnt += (c > 0u) ? 1u : 0u; mine = (j == x) ? c : mine; }
        if (sum == G) break;
        __builtin_amdgcn_s_sleep(1);
        if ((++sp & 255u) == 0u) { if (xb_ld(&bar[XB_TMO])) break; if (sp > XB_SPIN_CAP) { atomicAdd(&bar[XB_TMO], 1u); break; } }
    }
    nloc = mine > 0u ? mine : 1u; nx = cnt > 0u ? cnt : 1u;
}
__device__ __forceinline__ void xcd_barrier(const XcdBarrier& b) {
    asm volatile("s_waitcnt vmcnt(0)" ::: "memory");
    __syncthreads();
    if (threadIdx.x == 0) {
        unsigned* bar = b.bar;
        __builtin_amdgcn_s_waitcnt(0);
        unsigned nloc = b.st[0], nx = b.st[1];
        if (nloc == 0u) { xcd_barrier_complete(bar, b.x, nloc, nx); b.st[0] = nloc; b.st[1] = nx; }
        const unsigned old = xb_add(&bar[XB_XSUB(b.x)], 1u);
        const unsigned gen = old / nloc;
        if (old + 1u == (gen + 1u) * nloc) {
            __builtin_amdgcn_fence(__ATOMIC_RELEASE, "agent");
            asm volatile("s_waitcnt vmcnt(0)" ::: "memory");
            const unsigned og = xb_add(&bar[XB_TOP], 1u);
            const unsigned tg = og / nx;
            if (og + 1u == (tg + 1u) * nx) xb_add(&bar[XB_TOPGEN], 1u);
            else XB_SPIN(xb_ld(&bar[XB_TOPGEN]) == tg, bar);
            __builtin_amdgcn_fence(__ATOMIC_ACQUIRE, "agent");
            xb_add(&bar[XB_XGEN(b.x)], 1u);
            asm volatile("s_waitcnt vmcnt(0)" ::: "memory");
        } else {
            XB_SPIN(xb_ld(&bar[XB_XGEN(b.x)]) == gen, bar);
            __builtin_amdgcn_fence(__ATOMIC_ACQUIRE, "agent");
            asm volatile("s_waitcnt vmcnt(0)" ::: "memory");
        }
    }
    __syncthreads();
}


__global__ void __launch_bounds__(512, 2) mega(Params P_) {
    extern __shared__ __attribute__((aligned(16))) unsigned char lds[];
    volatile LAS unsigned* st = (volatile LAS unsigned*)(LAS unsigned char*)(lds + LDS_BARST);
    if (threadIdx.x < 16) st[threadIdx.x] = 0u;
    __syncthreads();
    CParams* pp = (CParams*)__builtin_amdgcn_kernarg_segment_ptr();
    (void)xcd_barrier_post((unsigned*)(pp->ws + WS_CTL) + CW_BAR, st);
#define GB do { XcdBarrier bar_; bar_.bar = (unsigned*)(pp->ws + WS_CTL) + CW_BAR; bar_.x = xb_xcc_id(); bar_.st = (volatile LAS unsigned*)(LAS unsigned char*)(lds + LDS_BARST); xcd_barrier(bar_); asm volatile("" : "+s"(pp)); } while (0)
#define P (*pp)
    asm volatile("" : "+s"(pp));
    phase_0(P, lds, 0); GB;
#if defined(PROBE_PH) && PROBE_PH == 0
    { int nrep = PROBE_N; asm volatile("" : "+s"(nrep)); for (int rep = 0; rep < nrep; ++rep) { GB; phase_0(P, lds, 0); GB; } }
#endif
    phase_1(P, lds, 1); GB;
#if defined(PROBE_PH) && PROBE_PH == 1
    { int nrep = PROBE_N; asm volatile("" : "+s"(nrep)); for (int rep = 0; rep < nrep; ++rep) { GB; phase_1(P, lds, 1); GB; } }
#endif
    phase_3(P, lds, 3); GB;
#if defined(PROBE_PH) && PROBE_PH == 3
    { int nrep = PROBE_N; asm volatile("" : "+s"(nrep)); for (int rep = 0; rep < nrep; ++rep) { GB; phase_3(P, lds, 3); GB; } }
#endif
    phase_4(P, lds, 4); GB;
#if defined(PROBE_PH) && PROBE_PH == 4
    { int nrep = PROBE_N; asm volatile("" : "+s"(nrep)); for (int rep = 0; rep < nrep; ++rep) { GB; phase_4(P, lds, 4); GB; } }
#endif
    phase_5(P, lds, 5); GB;
#if defined(PROBE_PH) && PROBE_PH == 5
    { int nrep = PROBE_N; asm volatile("" : "+s"(nrep)); for (int rep = 0; rep < nrep; ++rep) { GB; phase_5(P, lds, 5); GB; } }
#endif
    phase_6(P, lds, 6); GB;
    phase_60(P, lds, 60); GB;
#if defined(PROBE_PH) && PROBE_PH == 60
    { int nrep = PROBE_N; asm volatile("" : "+s"(nrep)); for (int rep = 0; rep < nrep; ++rep) { GB; phase_60(P, lds, 60); GB; } }
#endif
#if defined(PROBE_PH) && PROBE_PH == 6
    { int nrep = PROBE_N; asm volatile("" : "+s"(nrep)); for (int rep = 0; rep < nrep; ++rep) { GB; phase_6(P, lds, 6); GB; } }
#endif
    phase_7(P, lds, 7); GB;
#if defined(PROBE_PH) && PROBE_PH == 7
    { int nrep = PROBE_N; asm volatile("" : "+s"(nrep)); for (int rep = 0; rep < nrep; ++rep) { GB; phase_7(P, lds, 7); GB; } }
#endif
    phase_8(P, lds, 8); GB;
#if defined(PROBE_PH) && PROBE_PH == 8
    { int nrep = PROBE_N; asm volatile("" : "+s"(nrep)); for (int rep = 0; rep < nrep; ++rep) { GB; phase_8(P, lds, 8); GB; } }
#endif
    phase_9(P, lds, 9); GB;
#if defined(PROBE_PH) && PROBE_PH == 9
    { int nrep = PROBE_N; asm volatile("" : "+s"(nrep)); for (int rep = 0; rep < nrep; ++rep) { GB; phase_9(P, lds, 9); GB; } }
#endif
    phase_10(P, lds, 10); GB;
#if defined(PROBE_PH) && PROBE_PH == 10
    { int nrep = PROBE_N; asm volatile("" : "+s"(nrep)); for (int rep = 0; rep < nrep; ++rep) { GB; phase_10(P, lds, 10); GB; } }
#endif
    phase_11(P, lds, 11); GB;
#if defined(PROBE_PH) && PROBE_PH == 11
    { int nrep = PROBE_N; asm volatile("" : "+s"(nrep)); for (int rep = 0; rep < nrep; ++rep) { GB; phase_11(P, lds, 11); GB; } }
#endif
    phase_12(P, lds, 12); GB;
#if defined(PROBE_PH) && PROBE_PH == 12
    { int nrep = PROBE_N; asm volatile("" : "+s"(nrep)); for (int rep = 0; rep < nrep; ++rep) { GB; phase_12(P, lds, 12); GB; } }
#endif
    phase_13(P, lds, 13); GB;
#if defined(PROBE_PH) && PROBE_PH == 13
    { int nrep = PROBE_N; asm volatile("" : "+s"(nrep)); for (int rep = 0; rep < nrep; ++rep) { GB; phase_13(P, lds, 13); GB; } }
#endif
    phase_14(P, lds, 14); GB;
#if defined(PROBE_PH) && PROBE_PH == 14
    { int nrep = PROBE_N; asm volatile("" : "+s"(nrep)); for (int rep = 0; rep < nrep; ++rep) { GB; phase_14(P, lds, 14); GB; } }
#endif
    phase_15(P, lds, 15); GB;
#if defined(PROBE_PH) && PROBE_PH == 15
    { int nrep = PROBE_N; asm volatile("" : "+s"(nrep)); for (int rep = 0; rep < nrep; ++rep) { GB; phase_15(P, lds, 15); GB; } }
#endif
    phase_16(P, lds, 16); GB;
#if defined(PROBE_PH) && PROBE_PH == 16
    { int nrep = PROBE_N; asm volatile("" : "+s"(nrep)); for (int rep = 0; rep < nrep; ++rep) { GB; phase_16(P, lds, 16); GB; } }
#endif
    phase_22(P, lds, 22); GB;
#if defined(PROBE_PH) && PROBE_PH == 22
    { int nrep = PROBE_N; asm volatile("" : "+s"(nrep)); for (int rep = 0; rep < nrep; ++rep) { GB; phase_22(P, lds, 22); GB; } }
#endif
    phase_23(P, lds, 23); GB;
#if defined(PROBE_PH) && PROBE_PH == 23
    { int nrep = PROBE_N; asm volatile("" : "+s"(nrep)); for (int rep = 0; rep < nrep; ++rep) { GB; phase_23(P, lds, 23); GB; } }
#endif
    phase_9(P, lds, 17); GB;
#if defined(PROBE_PH) && PROBE_PH == 17
    { int nrep = PROBE_N; asm volatile("" : "+s"(nrep)); for (int rep = 0; rep < nrep; ++rep) { GB; phase_9(P, lds, 17); GB; } }
#endif
    phase_10(P, lds, 18); GB;
#if defined(PROBE_PH) && PROBE_PH == 18
    { int nrep = PROBE_N; asm volatile("" : "+s"(nrep)); for (int rep = 0; rep < nrep; ++rep) { GB; phase_10(P, lds, 18); GB; } }
#endif
    phase_11(P, lds, 19); GB;
#if defined(PROBE_PH) && PROBE_PH == 19
    { int nrep = PROBE_N; asm volatile("" : "+s"(nrep)); for (int rep = 0; rep < nrep; ++rep) { GB; phase_11(P, lds, 19); GB; } }
#endif
    phase_12(P, lds, 20); GB;
#if defined(PROBE_PH) && PROBE_PH == 20
    { int nrep = PROBE_N; asm volatile("" : "+s"(nrep)); for (int rep = 0; rep < nrep; ++rep) { GB; phase_12(P, lds, 20); GB; } }
#endif
    phase_13(P, lds, 21);
#if defined(PROBE_PH) && PROBE_PH == 21
    { int nrep = PROBE_N; asm volatile("" : "+s"(nrep)); for (int rep = 0; rep < nrep; ++rep) { GB; phase_13(P, lds, 21); GB; } }
#endif
#undef P
#undef GB
}

extern "C" void kernel_launch(void* const* d_in, const int* in_sizes, int n_in, void* d_out, int out_size, void* d_ws, size_t ws_size, hipStream_t stream) {
    static int ready = 0;
    if (!ready) {
        if (n_in != 35 || ws_size < WS_TOTAL) { fprintf(stderr, "kernel_launch: unexpected n_in %d or ws_size %zu (need %zu)\n", n_in, ws_size, (size_t)WS_TOTAL); ready = -1; return; }
        if (hipFuncSetAttribute((const void*)mega, hipFuncAttributeMaxDynamicSharedMemorySize, LDS_BYTES) != hipSuccess) { fprintf(stderr, "kernel_launch: hipFuncSetAttribute failed\n"); ready = -1; return; }
        ready = 1;
    }
    if (ready < 0) return;
    (void)hipMemsetAsync((char*)d_ws + WS_CTL, 0, 1 * MiB, stream);
    Params P{};
    for (int i = 0; i < 35; ++i) P.in[i] = (const float*)d_in[i];
    P.out = (float*)d_out; P.ws = (unsigned char*)d_ws; P.ph_lo = 0; P.ph_hi = 0;
    hipLaunchKernelGGL(mega, dim3(GRID), dim3(512), LDS_BYTES, stream, P);
}
```

```cpp
#include <hip/hip_runtime.h>
#include <stdint.h>
#include <stdio.h>

#define DM 1024
#define NB 2
#define SEQ 8192
#define NMETA 16
#define LSEQ (SEQ + NMETA)
#define NMAIN (NB * SEQ)
#define NT (NB * LSEQ)
#define NTP 16640
#define INCOLS 3328
#define RESTC 1792
#define NEXP 32
#define DFF 512
#define S5TC 48
#define S5NC 171
#define MOE_RT 256
#define MOE_MAXROWS 41216

typedef unsigned short bf16_t;
typedef short bf16x8 __attribute__((ext_vector_type(8)));
typedef float f32x4 __attribute__((ext_vector_type(4)));
typedef unsigned u32x4 __attribute__((ext_vector_type(4)));
typedef unsigned u32x2 __attribute__((ext_vector_type(2)));

constexpr size_t MiB = 1u << 20;
constexpr size_t cmax2(size_t a, size_t b) { return a > b ? a : b; }
constexpr size_t al64k(size_t x) { return (x + 65535) & ~(size_t)65535; }
constexpr size_t WS_CTL = 0;
constexpr size_t WS_H = 1 * MiB;
constexpr size_t WS_HN = WS_H + al64k((size_t)NT * DM * 4);
constexpr size_t WS_A2 = WS_HN + al64k((size_t)NTP * DM * 2);
constexpr size_t WS_WTIN = WS_A2 + al64k((size_t)NTP * DM * 2);
constexpr size_t WS_WTOUT = WS_WTIN + al64k((size_t)INCOLS * DM * 2);
constexpr size_t WS_WTGLU = WS_WTOUT + al64k((size_t)DM * DM * 2);
constexpr size_t WS_LRT = WS_WTGLU + al64k((size_t)2 * DM * DM * 2);
constexpr size_t WS_BIG = WS_LRT + al64k((size_t)(2 * 512 * 64 * 2 + 512 * 128) * 2);
constexpr size_t SZ_T512 = al64k((size_t)NT * 512 * 2);
constexpr size_t SZ_P512 = al64k((size_t)NTP * 512 * 2);
constexpr int RW_NCH = 129, RW_UNITS = 32 * RW_NCH;
constexpr size_t SZ_RWOP = al64k((size_t)RW_UNITS * 4096 * 2);
constexpr size_t WS_Q = WS_BIG;
constexpr size_t WS_K = WS_Q + SZ_P512;
constexpr size_t WS_V = WS_K + SZ_P512;
constexpr size_t WS_REST = WS_V + SZ_P512;
constexpr size_t WS_KR = WS_REST + al64k((size_t)NTP * RESTC * 2);
constexpr size_t WS_LOW = WS_KR + SZ_T512;
constexpr size_t WS_AA = WS_LOW + al64k((size_t)NT * 256 * 2);
constexpr size_t WS_XEARLY = WS_AA + 2 * SZ_T512;
constexpr size_t WS_PP = WS_REST;
constexpr size_t WS_QT = WS_PP + SZ_RWOP;
constexpr size_t WS_YT = WS_QT + SZ_RWOP;
constexpr size_t WS_ZT = WS_YT + SZ_RWOP;
constexpr size_t WS_XEND = cmax2(WS_XEARLY, WS_ZT + SZ_RWOP);
constexpr size_t WS_R = WS_XEND;
constexpr size_t WS_VV = WS_R + SZ_T512;
constexpr size_t WS_G = WS_VV + SZ_T512;
constexpr size_t WS_KK = WS_G + SZ_T512;
constexpr size_t WS_KKA = WS_KK + SZ_T512;
constexpr size_t WS_KD = WS_KKA + 2 * SZ_T512;
constexpr size_t WS_W = WS_KD + 2 * SZ_T512;
constexpr size_t WS_BC = WS_W + 2 * SZ_T512;
constexpr size_t WS_MIXEND = WS_BC + al64k((size_t)NT * 8 * 4);
constexpr size_t WS_YFB = WS_KK;
constexpr size_t WS_XB = WS_BIG;
constexpr size_t WS_HB = WS_XB + al64k((size_t)MOE_MAXROWS * DM * 2);
constexpr size_t WS_YB = WS_HB + al64k((size_t)MOE_MAXROWS * DFF * 2);
constexpr size_t WS_WT13 = WS_YB + al64k((size_t)MOE_MAXROWS * DM * 2);
constexpr size_t WS_WT2 = WS_WT13 + al64k((size_t)NEXP * DM * DM * 2);
constexpr size_t WS_EID = WS_WT2 + al64k((size_t)NEXP * DM * DFF * 2);
constexpr size_t WS_POS = WS_EID + al64k((size_t)NT * 8);
constexpr size_t WS_DEST = WS_POS + al64k((size_t)NT * 8);
constexpr size_t WS_GATE = WS_DEST + al64k((size_t)NT * 8);
constexpr size_t WS_MOEEND = WS_GATE + al64k((size_t)NT * 8);
constexpr size_t WS_YI = WS_BIG;
constexpr size_t WS_E = WS_YI + al64k((size_t)NTP * DM * 2);
constexpr size_t WS_CAR = WS_E + al64k((size_t)1040 * 64 * 256 * 2);
constexpr size_t WS_BTA = WS_CAR + al64k((size_t)64 * 1280 * 256 * 2);
constexpr size_t WS_BTC = WS_BTA + al64k((size_t)64 * 512 * 256 * 2);
constexpr size_t WS_S5END = WS_BTC + al64k((size_t)64 * 256 * 256 * 2);
constexpr size_t cmax(size_t a, size_t b) { return a > b ? a : b; }
constexpr size_t WS_TOTAL = cmax(WS_MIXEND, cmax(WS_MOEEND, WS_S5END));
static_assert(WS_TOTAL <= 512 * MiB, "workspace map exceeds 512 MiB");

#define CW_CNT(l) (1024 + 64 * (l))

#define LDS_BYTES 163840
#define LDS_BARST (LDS_BYTES - 1024)
#define LDS_TAB (LDS_BYTES - 768)
#define LDS_RING (LDS_BYTES - 1024)
#define GRID 256

struct Params {
    const float* in[35];
    float* out;
    unsigned char* ws;
    int ph_lo, ph_hi;
};
typedef const __attribute__((address_space(4))) Params CParams;

__device__ __forceinline__ float bf2f(bf16_t v) { return __uint_as_float(((unsigned)v) << 16); }
typedef float f32x2c_ __attribute__((ext_vector_type(2)));
typedef __bf16 bf16x2c_ __attribute__((ext_vector_type(2)));
__device__ __forceinline__ unsigned pk2(float lo, float hi) { const f32x2c_ f = {lo, hi}; const bf16x2c_ b = __builtin_convertvector(f, bf16x2c_); return __builtin_bit_cast(unsigned, b); }
__device__ __forceinline__ unsigned f2bf(float f) { return (unsigned)__builtin_bit_cast(unsigned short, (__bf16)f); }
__device__ __forceinline__ float bflo(unsigned u) { return __uint_as_float(u << 16); }
__device__ __forceinline__ float bfhi(unsigned u) { return __uint_as_float(u & 0xffff0000u); }
__device__ __forceinline__ float wave_sum(float v) {
#pragma unroll
    for (int o = 1; o < 64; o <<= 1) v += __shfl_xor(v, o);
    return v;
}
__device__ __forceinline__ float wave_max(float v) {
#pragma unroll
    for (int o = 1; o < 64; o <<= 1) v = fmaxf(v, __shfl_xor(v, o));
    return v;
}
template <int CTRL> __device__ __forceinline__ float dppf(float v) { return __int_as_float(__builtin_amdgcn_update_dpp(0, __float_as_int(v), CTRL, 0xF, 0xF, true)); }
__device__ __forceinline__ float row16_sum(float v) { v += dppf<0xB1>(v); v += dppf<0x4E>(v); v += dppf<0x141>(v); v += dppf<0x140>(v); return v; }
__device__ __forceinline__ float sigmoidf_(float x) { return __builtin_amdgcn_rcpf(1.f + __expf(-x)); }
__device__ __forceinline__ int rowof(int b, int p) { return p < NMETA ? NMAIN + b * NMETA + p : b * SEQ + (p - NMETA); }

#define SA_STRIDE 40
template <class AF, class BF>
__device__ __forceinline__ void gemm_tile(unsigned char* lds, int K, int ldb, const AF& arow, const BF& bcol, f32x4 (&acc)[4][2]) {
    bf16_t* sA = (bf16_t*)lds;
    bf16_t* sB = (bf16_t*)(lds + 128 * SA_STRIDE * 2);
    const int tid = threadIdx.x, lane = tid & 63, wave = tid >> 6, wr = wave >> 2, wc = wave & 3, fr = lane & 15, fq = lane >> 4;
#pragma unroll
    for (int mi = 0; mi < 4; ++mi)
#pragma unroll
        for (int ni = 0; ni < 2; ++ni) acc[mi][ni] = (f32x4){0.f, 0.f, 0.f, 0.f};
    const int ar = tid >> 2, akc = (tid & 3) * 8;
    const bf16_t* ap = arow(ar) + akc;
    const int bnq = (tid & 31) * 4, bkp = (tid >> 5) * 2;
    const float* bp = bcol(bnq) + (size_t)bkp * ldb;
    const int nk = K / 32;
    u32x4 ra = *(const u32x4*)ap;
    f32x4 rb0 = *(const f32x4*)bp, rb1 = *(const f32x4*)(bp + ldb);
    for (int kt = 0; kt < nk; ++kt) {
        __syncthreads();
        *(u32x4*)(sA + ar * SA_STRIDE + akc) = ra;
        {
            unsigned* d = (unsigned*)(sB + bnq * SA_STRIDE + bkp);
            d[0 * (SA_STRIDE / 2)] = pk2(rb0[0], rb1[0]);
            d[1 * (SA_STRIDE / 2)] = pk2(rb0[1], rb1[1]);
            d[2 * (SA_STRIDE / 2)] = pk2(rb0[2], rb1[2]);
            d[3 * (SA_STRIDE / 2)] = pk2(rb0[3], rb1[3]);
        }
        __syncthreads();
        if (kt + 1 < nk) {
            ra = *(const u32x4*)(ap + (kt + 1) * 32);
            const float* q = bp + (size_t)(kt + 1) * 32 * ldb;
            rb0 = *(const f32x4*)q; rb1 = *(const f32x4*)(q + ldb);
        }
        bf16x8 a[4], b[2];
#pragma unroll
        for (int mi = 0; mi < 4; ++mi) a[mi] = *(const bf16x8*)(sA + (wr * 64 + mi * 16 + fr) * SA_STRIDE + fq * 8);
#pragma unroll
        for (int ni = 0; ni < 2; ++ni) b[ni] = *(const bf16x8*)(sB + (wc * 32 + ni * 16 + fr) * SA_STRIDE + fq * 8);
#pragma unroll
        for (int mi = 0; mi < 4; ++mi)
#pragma unroll
            for (int ni = 0; ni < 2; ++ni) acc[mi][ni] = __builtin_amdgcn_mfma_f32_16x16x32_bf16(a[mi], b[ni], acc[mi][ni], 0, 0, 0);
    }
    __syncthreads();
}
#define ACC_FOREACH(acc, ...) do { const int _l = threadIdx.x & 63, _w = threadIdx.x >> 6, _wr = _w >> 2, _wc = _w & 3, _fr = _l & 15, _fq = _l >> 4; \
    _Pragma("unroll") for (int _mi = 0; _mi < 4; ++_mi) _Pragma("unroll") for (int _ni = 0; _ni < 2; ++_ni) _Pragma("unroll") for (int _j = 0; _j < 4; ++_j) { \
        const int rl = _wr * 64 + _mi * 16 + _fq * 4 + _j, cl = _wc * 32 + _ni * 16 + _fr; const float val = acc[_mi][_ni][_j]; __VA_ARGS__ } } while (0)
#define ACC_FOREACH_PAIR(acc, ...) do { const int _l = threadIdx.x & 63, _w = threadIdx.x >> 6, _wr = _w >> 2, _wc = _w & 3, _fr = _l & 15, _fq = _l >> 4; \
    _Pragma("unroll") for (int _mi = 0; _mi < 4; ++_mi) _Pragma("unroll") for (int _j = 0; _j < 4; ++_j) { \
        const int rl = _wr * 64 + _mi * 16 + _fq * 4 + _j, co = _wc * 16 + _fr; const float va = acc[_mi][0][_j], vg = acc[_mi][1][_j]; __VA_ARGS__ } } while (0)

__device__ __forceinline__ void store_norm_bf16(const f32x4 (&v)[4], const float* gain, bf16_t* dst, int lane) {
    float ss = 0.f;
#pragma unroll
    for (int j = 0; j < 4; ++j) ss += v[j][0] * v[j][0] + v[j][1] * v[j][1] + v[j][2] * v[j][2] + v[j][3] * v[j][3];
    ss = wave_sum(ss);
    const float rstd = rsqrtf(ss * (1.f / DM) + 1e-6f);
#pragma unroll
    for (int j = 0; j < 4; ++j) {
        const f32x4 g = ((const f32x4*)gain)[lane + 64 * j];
        u32x2 o; o.x = pk2(v[j][0] * rstd * g[0], v[j][1] * rstd * g[1]); o.y = pk2(v[j][2] * rstd * g[2], v[j][3] * rstd * g[3]);
        ((u32x2*)dst)[lane + 64 * j] = o;
    }
}

namespace pg8 {
#define PG8_LAS __attribute__((address_space(3)))
constexpr int BM = 256, BK = 64, HALF = 128, HTB = HALF * BK * 2  , STAGE_BYTES = 8 * HTB, NXCD = 8, WGM = 8;
__host__ __device__ __forceinline__ int lds_byte(int r, int c) { const int st = (r >> 4) * 2 + (c >> 5), rr = r & 15, cc = c & 31, ob = rr * 64 + cc * 2; return st * 1024 + (ob ^ (((ob >> 9) & 1) << 5)); }
__host__ __device__ __forceinline__ void stage_rc(int b, int& R, int& C) { const int st = b / 1024, sb = b % 1024, swz = sb ^ (((sb >> 9) & 1) << 5); R = (st >> 1) * 16 + swz / 64; C = (st & 1) * 32 + (swz % 64) / 2; }
__host__ __device__ __forceinline__ int perm32(int rho) { const int n = rho >> 4, i = rho & 15; return 8 * (i >> 2) + 4 * n + (i & 3); }

struct Unit { int pm, pn; const char* A; const char* B; };

struct DenseOrder {
    static constexpr bool GATHER_A = false;
    int nM, nN, nwg, G, c; const char* A; const char* Bt; size_t tstep;
    __device__ void init(const bf16_t* A_, const bf16_t* Bt_, int M, int N, int K, int G_, int c_) { nM = M / BM; nN = N / BM; nwg = nM * nN; G = G_; c = c_; A = (const char*)A_; Bt = (const char*)Bt_; tstep = (size_t)BM * K * 2; }
    __device__ bool next(int i, Unit& u) const {
        const long L = (long)i * G + c; if (L >= nwg) return false;
        int wgid = (int)L; { const int q = nwg / NXCD, r = nwg % NXCD, xcd = wgid % NXCD, off = wgid / NXCD; wgid = (xcd < r ? xcd * (q + 1) : r * (q + 1) + (xcd - r) * q) + off; }
        const int nig = WGM * nN, gid = wgid / nig, fm = gid * WGM, gsz = (nM - fm) < WGM ? (nM - fm) : WGM;
        u.pm = fm + ((wgid % nig) % gsz); u.pn = (wgid % nig) / gsz; u.A = A + (size_t)u.pm * tstep; u.B = Bt + (size_t)u.pn * tstep; return true;
    }
    __device__ __forceinline__ void a_ready(const Unit&) const {}
    __device__ __forceinline__ void done(const Unit&) const {}
};
struct ProjOrder {
    static constexpr bool GATHER_A = false;
    DenseOrder D; const char* HNp; const char* WT;
    __device__ void init(const bf16_t* HN_, const bf16_t* WT_, int c_) { D.init(HN_, WT_, NTP, 13 * BM, DM, GRID, c_); HNp = (const char*)HN_; WT = (const char*)WT_; }
    __device__ bool next(int i, Unit& u) const {
        if (!D.next(i, u)) return false;
        const size_t ts = (size_t)BM * DM * 2;
        if (u.pn < 11) { const int wrow = u.pn < 4 ? u.pn : u.pn + 2; u.A = HNp + (size_t)u.pm * ts; u.B = WT + (size_t)wrow * ts; }
        else { u.A = WT + (size_t)(4 + (u.pn - 11)) * ts; u.B = HNp + (size_t)u.pm * ts; }
        return true;
    }
    __device__ __forceinline__ void a_ready(const Unit&) const {}
    __device__ __forceinline__ void done(const Unit&) const {}
};
struct MoeOrder {
    static constexpr bool GATHER_A = false;
    const int* et; int TT, vcu; const char* A; const char* Bt; unsigned tstepA, tstepB, estep;
    __device__ __forceinline__ bool next(int i, Unit& u) const {
        const int L = i * GRID + vcu; if (L >= TT * 4) return false;
        const int rt = L >> 2, ct = L & 3, e = et[rt];
        u.pm = rt; u.pn = ct; u.A = A + (size_t)rt * tstepA; u.B = Bt + (size_t)e * estep + (size_t)ct * tstepB; return true;
    }
    __device__ __forceinline__ void a_ready(const Unit&) const {}
    __device__ __forceinline__ void done(const Unit&) const {}
};

struct S5OrderA {
    static constexpr bool GATHER_A = true;
    int vcu; const char* U; const char* BTA;
    __device__ __forceinline__ bool next(int i, Unit& u) const {
        const int L = i * GRID + vcu; if (L >= 640) return false;
        const int g = L / 10, rem = L - g * 10, mt = rem >> 1, nt = rem & 1;
        u.pm = mt; u.pn = g * 2 + nt; u.A = U + ((size_t)mt * 256 * 16 * 1024 + g * 16) * 2; u.B = BTA + ((size_t)(g * 512 + nt * 256) * 256) * 2; return true;
    }
    __device__ __forceinline__ void a_ready(const Unit&) const {}
    __device__ __forceinline__ void done(const Unit&) const {}
};
struct S5OrderC {
    static constexpr bool GATHER_A = false;
    int vcu; const char* CAR; const char* BTC;
    __device__ __forceinline__ bool next(int i, Unit& u) const {
        const int L = i * GRID + vcu; if (L >= 320) return false;
        const int g = L / 5, mt = L - g * 5;
        u.pm = mt; u.pn = g; u.A = CAR + ((size_t)(g * 1280 + mt * 256) * 256) * 2; u.B = BTC + ((size_t)g * 256 * 256) * 2; return true;
    }
    __device__ __forceinline__ void a_ready(const Unit&) const {}
    __device__ __forceinline__ void done(const Unit&) const {}
};
__device__ __forceinline__ unsigned cvt_pk_bf16(float lo, float hi) { return pk2(lo, hi); }

struct EpiProj {
    static constexpr bool PERM = true, AFTER_DRAIN = false;
    bf16_t *Q, *Kk, *VT, *REST;
    __device__ __forceinline__ void operator()(const f32x4 (&acc)[2][2][4][2], const Unit& u, int wr, int wc, int fr, int fq) const {
        bf16_t* base; int ldc; int row0, col0;
        if (u.pn < 11) { row0 = u.pm * BM + wr * 64 + fr; int colt;
            if (u.pn < 2) { base = Q; colt = u.pn * BM; ldc = 512; } else if (u.pn < 4) { base = Kk; colt = (u.pn - 2) * BM; ldc = 512; } else { base = REST; colt = (u.pn - 4) * BM; ldc = RESTC; }
            col0 = colt + wc * 32 + 8 * fq; }
        else { base = VT; ldc = NTP; row0 = (u.pn - 11) * BM + wr * 64 + fr; col0 = u.pm * BM + wc * 32 + 8 * fq; }
#pragma unroll
        for (int ai = 0; ai < 2; ++ai)
#pragma unroll
            for (int m = 0; m < 4; ++m) { bf16_t* rowp = base + (size_t)(row0 + ai * HALF + m * 16) * ldc + col0;
#pragma unroll
                for (int bj = 0; bj < 2; ++bj) { const f32x4 v0 = acc[ai][bj][m][0], v1 = acc[ai][bj][m][1];
                    u32x4 w; w.x = cvt_pk_bf16(v0[0], v0[1]); w.y = cvt_pk_bf16(v0[2], v0[3]); w.z = cvt_pk_bf16(v1[0], v1[1]); w.w = cvt_pk_bf16(v1[2], v1[3]);
                    *(u32x4*)(rowp + bj * HALF) = w; } }
    }
};
struct EpiBf16Plain {
    static constexpr bool PERM = true, AFTER_DRAIN = false;
    bf16_t* O; int ldc;
    __device__ __forceinline__ void operator()(const f32x4 (&acc)[2][2][4][2], const Unit& u, int wr, int wc, int fr, int fq) const {
        const int row0 = u.pm * BM + wr * 64 + fr; const int col0 = u.pn * BM + wc * 32 + 8 * fq;
#pragma unroll
        for (int ai = 0; ai < 2; ++ai)
#pragma unroll
            for (int m = 0; m < 4; ++m) { bf16_t* rowp = O + (size_t)(row0 + ai * HALF + m * 16) * ldc + col0;
#pragma unroll
                for (int bj = 0; bj < 2; ++bj) { const f32x4 v0 = acc[ai][bj][m][0], v1 = acc[ai][bj][m][1];
                    u32x4 w; w.x = cvt_pk_bf16(v0[0], v0[1]); w.y = cvt_pk_bf16(v0[2], v0[3]); w.z = cvt_pk_bf16(v1[0], v1[1]); w.w = cvt_pk_bf16(v1[2], v1[3]);
                    *(u32x4*)(rowp + bj * HALF) = w; } }
    }
};
struct EpiSwiglu {
    static constexpr bool PERM = true, AFTER_DRAIN = false;
    bf16_t* O;
    __device__ __forceinline__ void operator()(const f32x4 (&acc)[2][2][4][2], const Unit& u, int wr, int wc, int fr, int fq) const {
        const int row0 = u.pm * BM + wr * 64 + fr; const int col0 = u.pn * HALF + wc * 32 + 8 * fq;
#pragma unroll
        for (int ai = 0; ai < 2; ++ai)
#pragma unroll
            for (int m = 0; m < 4; ++m) {
                float o[8];
#pragma unroll
                for (int n = 0; n < 2; ++n)
#pragma unroll
                    for (int i = 0; i < 4; ++i) { const float va = acc[ai][0][m][n][i], vg = acc[ai][1][m][n][i]; o[4 * n + i] = va * __builtin_amdgcn_rcpf(1.f + __expf(-va)) * vg; }
                u32x4 w; w.x = cvt_pk_bf16(o[0], o[1]); w.y = cvt_pk_bf16(o[2], o[3]); w.z = cvt_pk_bf16(o[4], o[5]); w.w = cvt_pk_bf16(o[6], o[7]);
                *(u32x4*)(O + (size_t)(row0 + ai * HALF + m * 16) * DFF + col0) = w; }
    }
};
struct EpiResidual {
    static constexpr bool PERM = false, AFTER_DRAIN = false;
    float* Hh;
    __device__ __forceinline__ void operator()(const f32x4 (&acc)[2][2][4][2], const Unit& u, int wr, int wc, int fr, int fq) const {
        const int row0 = u.pm * BM + wr * 64 + fr; const int col0 = u.pn * BM + wc * 32 + 4 * fq;
#pragma unroll
        for (int ai = 0; ai < 2; ++ai)
#pragma unroll
            for (int m = 0; m < 4; ++m) { float* rowp = Hh + (size_t)(row0 + ai * HALF + m * 16) * DM + col0;
#pragma unroll
                for (int bj = 0; bj < 2; ++bj)
#pragma unroll
                    for (int n = 0; n < 2; ++n) { f32x4* p = (f32x4*)(rowp + bj * HALF + n * 16); *p = *p + acc[ai][bj][m][n]; } }
    }
};
struct EpiGlu {
    static constexpr bool PERM = false, AFTER_DRAIN = false;
    float* Hh;
    __device__ __forceinline__ void operator()(const f32x4 (&acc)[2][2][4][2], const Unit& u, int wr, int wc, int fr, int fq) const {
        const int row0 = u.pm * BM + wr * 64 + fr; const int col0 = u.pn * HALF + wc * 32 + 4 * fq;
#pragma unroll
        for (int ai = 0; ai < 2; ++ai)
#pragma unroll
            for (int m = 0; m < 4; ++m) { float* rowp = Hh + (size_t)(row0 + ai * HALF + m * 16) * DM + col0;
#pragma unroll
                for (int n = 0; n < 2; ++n) { f32x4* p = (f32x4*)(rowp + n * 16); f32x4 hv = *p; const f32x4 va = acc[ai][0][m][n], vg = acc[ai][1][m][n];
#pragma unroll
                    for (int i = 0; i < 4; ++i) hv[i] += va[i] * __builtin_amdgcn_rcpf(1.f + __expf(-vg[i]));
                    *p = hv; } }
    }
};

struct EpiS5A {
    static constexpr bool PERM = true, AFTER_DRAIN = false;
    bf16_t* YI; bf16_t* E;
    __device__ __forceinline__ void operator()(const f32x4 (&acc)[2][2][4][2], const Unit& u, int wr, int wc, int fr, int fq) const {
        const int g = u.pn >> 1, nt = u.pn & 1;
        const int cl0 = wc * 32 + 8 * fq;
        bf16_t* base = nt == 0 ? YI + (size_t)(cl0 >> 4) * DM + g * 16 + (cl0 & 15) : E + (size_t)g * 256 + cl0;
        const size_t nstride = 16 * DM;
        const size_t bjstep = nt == 0 ? (size_t)8 * DM : (size_t)HALF;
#pragma unroll
        for (int ai = 0; ai < 2; ++ai)
#pragma unroll
            for (int m = 0; m < 4; ++m) { int n = u.pm * BM + ai * HALF + wr * 64 + m * 16 + fr; n = n < 1039 ? n : 1039;
                bf16_t* p = base + (size_t)n * nstride;
#pragma unroll
                for (int bj = 0; bj < 2; ++bj) { const f32x4 v0 = acc[ai][bj][m][0], v1 = acc[ai][bj][m][1];
                    u32x4 w; w.x = cvt_pk_bf16(v0[0], v0[1]); w.y = cvt_pk_bf16(v0[2], v0[3]); w.z = cvt_pk_bf16(v1[0], v1[1]); w.w = cvt_pk_bf16(v1[2], v1[3]);
                    *(u32x4*)(p + bj * bjstep) = w; } }
    }
};
struct EpiS5C {
    static constexpr bool PERM = true, AFTER_DRAIN = false;
    const bf16_t* YI; const bf16_t* Uu; const float* dvec; bf16_t* O;
    __device__ __forceinline__ void operator()(const f32x4 (&acc)[2][2][4][2], const Unit& u, int wr, int wc, int fr, int fq) const {
        const int g = u.pn;
        const int cl0 = wc * 32 + 8 * fq, ch = g * 16 + (cl0 & 15);
        const size_t off0 = (size_t)(cl0 >> 4) * DM + ch;
        const f32x4 d0 = *(const f32x4*)(dvec + ch), d1 = *(const f32x4*)(dvec + ch + 4);
#pragma unroll
        for (int ai = 0; ai < 2; ++ai)
#pragma unroll
            for (int m = 0; m < 4; ++m) { int n = u.pm * BM + ai * HALF + wr * 64 + m * 16 + fr; n = n < 1039 ? n : 1039;
#pragma unroll
                for (int bj = 0; bj < 2; ++bj) {
                    const size_t off = off0 + (size_t)n * (16 * DM) + (size_t)bj * (8 * DM);
                    const u32x4 yv = *(const u32x4*)(YI + off);
                    const f32x4 y0 = (f32x4){__uint_as_float(yv[0] << 16), __uint_as_float(yv[0] & 0xffff0000u), __uint_as_float(yv[1] << 16), __uint_as_float(yv[1] & 0xffff0000u)},
                                y1 = (f32x4){__uint_as_float(yv[2] << 16), __uint_as_float(yv[2] & 0xffff0000u), __uint_as_float(yv[3] << 16), __uint_as_float(yv[3] & 0xffff0000u)};
                    const u32x4 uv = *(const u32x4*)(Uu + off);
                    float y[8];
#pragma unroll
                    for (int q = 0; q < 4; ++q) { y[q] = acc[ai][bj][m][0][q] + y0[q] + d0[q] * (q & 1 ? __uint_as_float(uv[q >> 1] & 0xffff0000u) : __uint_as_float(uv[q >> 1] << 16));
                        y[4 + q] = acc[ai][bj][m][1][q] + y1[q] + d1[q] * (q & 1 ? __uint_as_float(uv[2 + (q >> 1)] & 0xffff0000u) : __uint_as_float(uv[2 + (q >> 1)] << 16)); }
#pragma unroll
                    for (int q = 0; q < 8; ++q) { const float z = 1.5957691216f * (y[q] + 0.044715f * y[q] * y[q] * y[q]); y[q] = y[q] * __builtin_amdgcn_rcpf(1.f + __expf(-z)); }
                    u32x4 w; w.x = cvt_pk_bf16(y[0], y[1]); w.y = cvt_pk_bf16(y[2], y[3]); w.z = cvt_pk_bf16(y[4], y[5]); w.w = cvt_pk_bf16(y[6], y[7]);
                    *(u32x4*)(O + off) = w; }
                asm volatile("" ::: "memory"); }
    }
};

template <class Epi, class Sched, bool ALIGN_EPI = false, bool SP2 = false>
__device__ __forceinline__ void gemm_phase(PG8_LAS unsigned char* lds, const int K, const Sched& S, const Epi& E) {
    int tid_ = threadIdx.x; asm volatile("" : "+v"(tid_));
    const int tid = tid_, wid = __builtin_amdgcn_readfirstlane(tid >> 6), lane = tid & 63, wr = wid >> 2, wc = wid & 3, fr = lane & 15, fq = lane >> 4;
    const int nt = K / BK;
    unsigned voffA[2], voffB[2];
#pragma unroll
    for (int i = 0; i < 2; ++i) { int R, C; stage_rc(tid * 16 + i * 8192, R, C); const int Rb = Epi::PERM ? ((R & ~31) + perm32(R & 31)) : R;
        voffA[i] = Sched::GATHER_A ? (unsigned)(((16 * R + (C >> 4)) * 1024 + (C & 15)) * 2) : (unsigned)(R * K + C) * 2u; voffB[i] = (unsigned)(Rb * K + C) * 2u; }
    const size_t kstep = (size_t)(BK * 2);
    const size_t hstep = (size_t)HALF * K * 2;
    const size_t kstepA = Sched::GATHER_A ? (size_t)(4 * 1024 * 2) : kstep, hstepA = Sched::GATHER_A ? (size_t)HALF * 16 * 1024 * 2 : hstep;
    const unsigned ldsw = (unsigned)wid * 1024u;
    const int aoff = lds_byte(wr * 64 + fr, fq * 8), boff = lds_byte(wc * 32 + fr, fq * 8);
#define PG8_SA(b, h) (((b) * 2 + (h)) * HTB)
#define PG8_SB(b, h) ((4 + (b) * 2 + (h)) * HTB)
#define PG8_STAGE(bufoff, gbase, voff) do { _Pragma("unroll") for (int _i = 0; _i < 2; ++_i) \
        __builtin_amdgcn_global_load_lds((const unsigned*)((const char*)(gbase) + (voff)[_i]), (PG8_LAS unsigned*)(lds + (bufoff) + ldsw + _i * 8192), 16, 0, 0); } while (0)
#define PG8_LDA(dst, b, h) do { _Pragma("unroll") for (int m = 0; m < 4; ++m) _Pragma("unroll") for (int k = 0; k < 2; ++k) dst[m][k] = *(const PG8_LAS bf16x8*)(lds + PG8_SA(b, h) + aoff + m * 2048 + k * 1024); } while (0)
#define PG8_LDB(dst, b, h) do { _Pragma("unroll") for (int n = 0; n < 2; ++n) _Pragma("unroll") for (int k = 0; k < 2; ++k) dst[n][k] = *(const PG8_LAS bf16x8*)(lds + PG8_SB(b, h) + boff + n * 2048 + k * 1024); } while (0)
#define PG8_MMA(ai, bj, At, Bt) do { __builtin_amdgcn_s_setprio(1); _Pragma("unroll") for (int m = 0; m < 4; ++m) _Pragma("unroll") for (int n = 0; n < 2; ++n) _Pragma("unroll") for (int k = 0; k < 2; ++k) \
        acc[ai][bj][m][n] = __builtin_amdgcn_mfma_f32_16x16x32_bf16(Bt[n][k], At[m][k], acc[ai][bj][m][n], 0, 0, 0); __builtin_amdgcn_s_setprio(0); } while (0)
#define PG8_WAIT_V(n) asm volatile("s_waitcnt vmcnt(" #n ")" ::: "memory")
#define PG8_WAIT_L(n) asm volatile("s_waitcnt lgkmcnt(" #n ")" ::: "memory")
#define PG8_BAR __builtin_amdgcn_s_barrier()
#define PG8_SCHED __builtin_amdgcn_sched_barrier(0)
    Unit cur, nxt; int ui = 0;
    if (!S.next(0, cur)) return;
    f32x4 acc[2][2][4][2];
#pragma unroll
    for (int a = 0; a < 2; ++a)
#pragma unroll
        for (int b = 0; b < 2; ++b)
#pragma unroll
            for (int m = 0; m < 4; ++m)
#pragma unroll
                for (int n = 0; n < 2; ++n) acc[a][b][m][n] = (f32x4){0.f, 0.f, 0.f, 0.f};
    bf16x8 At[4][2], B0[2][2], B1[2][2];
    const char* cA = cur.A; const char* cB = cur.B;
    S.a_ready(cur);
    if constexpr (SP2) {
        PG8_STAGE(PG8_SB(0, 0), cB, voffB); PG8_STAGE(PG8_SB(0, 1), cB + hstep, voffB); PG8_STAGE(PG8_SA(0, 0), cA, voffA); PG8_STAGE(PG8_SA(0, 1), cA + hstepA, voffA);
        if (wr == 1) PG8_BAR;
        PG8_WAIT_V(2); PG8_BAR;
        PG8_STAGE(PG8_SB(1, 0), cB + kstep, voffB); PG8_STAGE(PG8_SA(1, 0), cA + kstepA, voffA); PG8_STAGE(PG8_SB(1, 1), cB + hstep + kstep, voffB);
        PG8_WAIT_V(6); PG8_BAR;
    } else {
        PG8_STAGE(PG8_SB(0, 0), cB, voffB); PG8_STAGE(PG8_SA(0, 0), cA, voffA); PG8_STAGE(PG8_SB(0, 1), cB + hstep, voffB); PG8_STAGE(PG8_SA(0, 1), cA + hstepA, voffA);
        if (wr == 1) PG8_BAR;
        PG8_WAIT_V(4); PG8_BAR;
        PG8_STAGE(PG8_SB(1, 0), cB + kstep, voffB); PG8_STAGE(PG8_SA(1, 0), cA + kstepA, voffA); PG8_STAGE(PG8_SB(1, 1), cB + hstep + kstep, voffB);
        PG8_WAIT_V(6); PG8_BAR;
    }
    for (;;) {
        const bool has_next = S.next(ui + 1, nxt);
        const char* nA = has_next ? nxt.A : cA; const char* nB = has_next ? nxt.B : cB;
        for (int t = 0; t < nt; t += 2) {
            const bool last = (t == nt - 2);
            const char* a1 = cA + (size_t)(t + 1) * kstepA;
            const char* a2 = last ? nA : cA + (size_t)(t + 2) * kstepA; const char* b2 = last ? nB : cB + (size_t)(t + 2) * kstep;
            const char* a3 = a2 + kstepA; const char* b3 = b2 + kstep;
            if (last && has_next) S.a_ready(nxt);
            if constexpr (SP2) {
            PG8_LDB(B0, 0, 0); PG8_LDB(B1, 0, 1); PG8_SCHED; PG8_LDA(At, 0, 0); PG8_STAGE(PG8_SA(1, 1), a1 + hstepA, voffA);
            PG8_WAIT_V(8); PG8_WAIT_L(0); PG8_BAR; PG8_MMA(0, 0, At, B0); PG8_MMA(0, 1, At, B1); PG8_BAR; PG8_SCHED;
            PG8_LDA(At, 0, 1); PG8_STAGE(PG8_SB(0, 0), b2, voffB); PG8_STAGE(PG8_SB(0, 1), b2 + hstep, voffB); PG8_STAGE(PG8_SA(0, 0), a2, voffA);
            PG8_WAIT_V(8); PG8_WAIT_L(0); PG8_BAR; PG8_MMA(1, 0, At, B0); PG8_MMA(1, 1, At, B1); PG8_BAR; PG8_SCHED;
            PG8_LDB(B0, 1, 0); PG8_LDB(B1, 1, 1); PG8_SCHED; PG8_LDA(At, 1, 0); PG8_STAGE(PG8_SA(0, 1), a2 + hstepA, voffA);
            PG8_WAIT_V(8); PG8_WAIT_L(0); PG8_BAR; PG8_MMA(0, 0, At, B0); PG8_MMA(0, 1, At, B1); PG8_BAR; PG8_SCHED;
            PG8_LDA(At, 1, 1); PG8_STAGE(PG8_SB(1, 0), b3, voffB); PG8_STAGE(PG8_SB(1, 1), b3 + hstep, voffB); PG8_STAGE(PG8_SA(1, 0), a3, voffA);
            PG8_WAIT_V(8); PG8_WAIT_L(0); PG8_BAR; PG8_MMA(1, 0, At, B0); PG8_MMA(1, 1, At, B1); PG8_BAR; PG8_SCHED;
            } else {
            PG8_LDB(B0, 0, 0); PG8_SCHED; PG8_LDA(At, 0, 0); PG8_STAGE(PG8_SA(1, 1), a1 + hstepA, voffA);
            PG8_WAIT_L(8); PG8_BAR; PG8_WAIT_L(0); PG8_MMA(0, 0, At, B0); PG8_BAR; PG8_SCHED;
            PG8_LDB(B1, 0, 1); PG8_STAGE(PG8_SB(0, 0), b2, voffB);
            PG8_BAR; PG8_WAIT_L(0); PG8_MMA(0, 1, At, B1); PG8_BAR;
            PG8_LDA(At, 0, 1); PG8_STAGE(PG8_SA(0, 0), a2, voffA);
            PG8_BAR; PG8_WAIT_L(0); PG8_MMA(1, 0, At, B0); PG8_BAR; PG8_SCHED;
            PG8_STAGE(PG8_SB(0, 1), b2 + hstep, voffB);
            PG8_WAIT_V(6); PG8_BAR; PG8_MMA(1, 1, At, B1); PG8_BAR;
            PG8_LDB(B0, 1, 0); PG8_SCHED; PG8_LDA(At, 1, 0); PG8_STAGE(PG8_SA(0, 1), a2 + hstepA, voffA);
            PG8_WAIT_L(8); PG8_BAR; PG8_WAIT_L(0); PG8_MMA(0, 0, At, B0); PG8_BAR; PG8_SCHED;
            PG8_LDB(B1, 1, 1); PG8_STAGE(PG8_SB(1, 0), b3, voffB);
            PG8_BAR; PG8_WAIT_L(0); PG8_MMA(0, 1, At, B1); PG8_BAR;
            PG8_LDA(At, 1, 1); PG8_STAGE(PG8_SA(1, 0), a3, voffA);
            PG8_BAR; PG8_WAIT_L(0); PG8_MMA(1, 0, At, B0); PG8_BAR; PG8_SCHED;
            PG8_STAGE(PG8_SB(1, 1), b3 + hstep, voffB);
            PG8_WAIT_V(6); PG8_BAR; PG8_MMA(1, 1, At, B1); PG8_BAR;
            }
        }
        if constexpr (ALIGN_EPI) { if (wr == 0) PG8_BAR; }
        if constexpr (!Epi::AFTER_DRAIN) { E(acc, cur, wr, wc, fr, fq); S.done(cur); }
        if (!has_next) break;
#pragma unroll
        for (int a = 0; a < 2; ++a)
#pragma unroll
            for (int b = 0; b < 2; ++b)
#pragma unroll
                for (int m = 0; m < 4; ++m)
#pragma unroll
                    for (int n = 0; n < 2; ++n) acc[a][b][m][n] = (f32x4){0.f, 0.f, 0.f, 0.f};
        cur = nxt; cA = nA; cB = nB; ++ui;
        if constexpr (ALIGN_EPI) { if (wr == 1) PG8_BAR; }
    }
    PG8_WAIT_V(0);
    if constexpr (!ALIGN_EPI) { if (wr == 0) PG8_BAR; }
    PG8_BAR;
    if constexpr (Epi::AFTER_DRAIN) { E.fused(acc, cur, wr, wc, fr, fq, lds, wid, lane); S.done(cur); }
#undef PG8_SA
#undef PG8_SB
#undef PG8_STAGE
#undef PG8_LDA
#undef PG8_LDB
#undef PG8_MMA
#undef PG8_WAIT_V
#undef PG8_WAIT_L
#undef PG8_BAR
#undef PG8_SCHED
}
}

#define PHASE_PROLOGUE \
    int tid_ = threadIdx.x; asm volatile("" : "+v"(tid_)); const int tid = tid_, lane = tid & 63, wave = tid >> 6; \
    const int G = GRID, bid = blockIdx.x; \
    const int gw = bid * 8 + wave, NGW = G * 8; \
    unsigned char* ws = P.ws; \
    float* H = (float*)(ws + WS_H); \
    bf16_t* HN = (bf16_t*)(ws + WS_HN); \
    bf16_t* A2 = (bf16_t*)(ws + WS_A2); \
    bf16_t* Qb = (bf16_t*)(ws + WS_Q); bf16_t* Kb = (bf16_t*)(ws + WS_K); bf16_t* Vb = (bf16_t*)(ws + WS_V); \
    bf16_t* REST = (bf16_t*)(ws + WS_REST); \
    bf16_t* YFB = (bf16_t*)(ws + WS_YFB); \
    bf16_t* Rr = (bf16_t*)(ws + WS_R); bf16_t* VV = (bf16_t*)(ws + WS_VV); bf16_t* KK = (bf16_t*)(ws + WS_KK); \
    bf16_t* KKA = (bf16_t*)(ws + WS_KKA); bf16_t* KD = (bf16_t*)(ws + WS_KD); \
    _Float16* LW = (_Float16*)(ws + WS_W); bf16_t* PP = (bf16_t*)(ws + WS_PP); bf16_t* QT = (bf16_t*)(ws + WS_QT); bf16_t* YT = (bf16_t*)(ws + WS_YT); bf16_t* ZT = (bf16_t*)(ws + WS_ZT); \
    bf16_t* Gg = (bf16_t*)(ws + WS_G); bf16_t* KR = (bf16_t*)(ws + WS_KR); bf16_t* LOW = (bf16_t*)(ws + WS_LOW); \
    float* BC = (float*)(ws + WS_BC); \
    bf16_t* AA = (bf16_t*)(ws + WS_AA); \
    bf16_t* HB = (bf16_t*)(ws + WS_HB); bf16_t* YB = (bf16_t*)(ws + WS_YB); \
    bf16_t* XB = (bf16_t*)(ws + WS_XB); int* EID = (int*)(ws + WS_EID); int* POS = (int*)(ws + WS_POS); int* DEST = (int*)(ws + WS_DEST); \
    float* GATE = (float*)(ws + WS_GATE); \
    bf16_t* YI = (bf16_t*)(ws + WS_YI); bf16_t* S5E = (bf16_t*)(ws + WS_E); bf16_t* CAR = (bf16_t*)(ws + WS_CAR); bf16_t* BTA = (bf16_t*)(ws + WS_BTA); bf16_t* BTC = (bf16_t*)(ws + WS_BTC); \
    unsigned* CTL = (unsigned*)(ws + WS_CTL); \
    bf16_t* WTIN = (bf16_t*)(ws + WS_WTIN); bf16_t* WTOUT = (bf16_t*)(ws + WS_WTOUT); bf16_t* WTGLU = (bf16_t*)(ws + WS_WTGLU); bf16_t* WT13 = (bf16_t*)(ws + WS_WT13); bf16_t* WT2 = (bf16_t*)(ws + WS_WT2); \
    const int vcu = (G % 8 == 0) ? (bid % 8) * (G / 8) + bid / 8 : bid; \
    const float* x = P.in[0]; const float* meta = P.in[1]; const float* norm_mix = P.in[2]; const float* norm_ffn = P.in[3]; const float* norm_final = P.in[4]; \
    const float* w_in = P.in[5]; const float* w_out = P.in[6]; const float* rpb = P.in[7]; const float* mu = P.in[8]; \
    const float* w0 = P.in[9]; const float* w_up = P.in[10]; const float* a0 = P.in[11]; const float* a_up = P.in[12]; const float* g_up = P.in[13]; \
    const float* k_k = P.in[14]; const float* k_a = P.in[15]; const float* r_k = P.in[16]; const float* lnx_g = P.in[17]; const float* lnx_b = P.in[18]; \
    const float* s5_b_re = P.in[19]; const float* s5_b_im = P.in[20]; const float* s5_lre = P.in[21]; const float* s5_lim = P.in[22]; const float* s5_ls = P.in[23]; \
    const float* s5_c_re = P.in[24]; const float* s5_c_im = P.in[25]; const float* s5_d = P.in[26]; const float* w_glu = P.in[27]; \
    const float* moe_wg = P.in[28]; const float* moe_bg = P.in[29]; const float* moe_we = P.in[30]; const float* moe_be = P.in[31]; \
    const float* moe_w1 = P.in[32]; const float* moe_w3 = P.in[33]; const float* moe_w2 = P.in[34];


__device__ __forceinline__ void transpose_item(const float* W, int N, int K, int k0, int n0, bf16_t* dstrow0, int lane) {
    const int nq = lane & 15, kb = lane >> 4;
    const float* src = W + (size_t)(k0 + 16 * kb) * N + n0 + 4 * nq;
    f32x4 v[16];
#pragma unroll
    for (int kk = 0; kk < 16; ++kk) v[kk] = *(const f32x4*)(src + (size_t)kk * N);
#pragma unroll
    for (int i = 0; i < 4; ++i) {
        bf16_t* d = dstrow0 + (size_t)(4 * nq + i) * K + k0 + 16 * kb;
        u32x4 lo, hi;
        lo.x = pk2(v[0][i], v[1][i]); lo.y = pk2(v[2][i], v[3][i]); lo.z = pk2(v[4][i], v[5][i]); lo.w = pk2(v[6][i], v[7][i]);
        hi.x = pk2(v[8][i], v[9][i]); hi.y = pk2(v[10][i], v[11][i]); hi.z = pk2(v[12][i], v[13][i]); hi.w = pk2(v[14][i], v[15][i]);
        *(u32x4*)d = lo; *(u32x4*)(d + 8) = hi;
    }
}
#define CONV_DENSE_ITEMS (832 + 256 + 512 + 48)
__device__ __forceinline__ void conv_dense_item(CParams& P, int it, int lane) {
    unsigned char* ws = P.ws;
    if (it < 832) { const int kb = it / 52, nb = it % 52; transpose_item(P.in[5], INCOLS, DM, kb * 64, nb * 64, (bf16_t*)(ws + WS_WTIN) + (size_t)nb * 64 * DM, lane); return; }
    it -= 832;
    if (it < 256) { const int kb = it / 16, nb = it % 16; transpose_item(P.in[6], DM, DM, kb * 64, nb * 64, (bf16_t*)(ws + WS_WTOUT) + (size_t)nb * 64 * DM, lane); return; }
    it -= 256;
    if (it < 512) { const int kb = it / 32, nb = it % 32, n = nb * 64, half = n >> 10, c = n & 1023, row = (c >> 7) * 256 + half * 128 + (c & 127);
      transpose_item(P.in[27], 2 * DM, DM, kb * 64, n, (bf16_t*)(ws + WS_WTGLU) + (size_t)row * DM, lane); return; }
    it -= 512;
    bf16_t* lrt = (bf16_t*)(ws + WS_LRT);
    if (it < 16) { const int d = it >> 3, nb = it & 7; transpose_item(P.in[10] + (size_t)d * 64 * 512, 512, 64, 0, nb * 64, lrt + ((size_t)d * 512 + nb * 64) * 64, lane); return; }
    it -= 16;
    if (it < 16) { const int d = it >> 3, nb = it & 7; transpose_item(P.in[12] + (size_t)d * 64 * 512, 512, 64, 0, nb * 64, lrt + (size_t)2 * 512 * 64 + ((size_t)d * 512 + nb * 64) * 64, lane); return; }
    it -= 16;
    { const int kb = it >> 3, nb = it & 7; transpose_item(P.in[13], 512, 128, kb * 64, nb * 64, lrt + (size_t)4 * 512 * 64 + (size_t)nb * 64 * 128, lane); }
}
#define CONV_MOE_ITEMS (NEXP * 384)
__device__ __forceinline__ void conv_moe_item(CParams& P, int l, int it, int lane) {
    unsigned char* ws = P.ws;
    const int e = it / 384; int r = it % 384;
    if (r < 256) { const int which = r >> 7; r &= 127; const int kb = r >> 3, nb = r & 7, n = nb * 64, row = (n >> 7) * 256 + which * 128 + (n & 127);
        const float* W = (which ? P.in[33] : P.in[32]) + ((size_t)(l * NEXP + e) * DM) * DFF;
        transpose_item(W, DFF, DM, kb * 64, n, (bf16_t*)(ws + WS_WT13) + ((size_t)e * DM + row) * DM, lane); return; }
    r -= 256;
    { const int kb = r >> 4, nb = r & 15; const float* W = P.in[34] + ((size_t)(l * NEXP + e) * DFF) * DM;
      transpose_item(W, DM, DFF, kb * 64, nb * 64, (bf16_t*)(ws + WS_WT2) + ((size_t)e * DM + nb * 64) * DFF, lane); }
}

template <int MODE>
__device__ __forceinline__ void meta_gemm(const bf16_t* A, const bf16_t* Bt, float* Hrows, int task, int lane) {
    const int fr = lane & 15, fq = lane >> 4, c = task * 16 + fr;
    const bf16_t* b0 = MODE == 0 ? Bt + (size_t)c * DM : Bt + (size_t)((c >> 7) * 256 + (c & 127)) * DM;
    const bf16_t* b1 = b0 + (size_t)128 * DM;
    f32x4 acc0[2], acc1[2];
    acc0[0] = acc0[1] = acc1[0] = acc1[1] = (f32x4){0.f, 0.f, 0.f, 0.f};
#pragma unroll 4
    for (int kt = 0; kt < 32; ++kt) {
        const int ko = kt * 32 + fq * 8;
        const bf16x8 a0 = *(const bf16x8*)(A + (size_t)fr * DM + ko), a1 = *(const bf16x8*)(A + (size_t)(16 + fr) * DM + ko);
        const bf16x8 bv = *(const bf16x8*)(b0 + ko);
        acc0[0] = __builtin_amdgcn_mfma_f32_16x16x32_bf16(a0, bv, acc0[0], 0, 0, 0);
        acc0[1] = __builtin_amdgcn_mfma_f32_16x16x32_bf16(a1, bv, acc0[1], 0, 0, 0);
        if (MODE == 1) { const bf16x8 bg = *(const bf16x8*)(b1 + ko);
            acc1[0] = __builtin_amdgcn_mfma_f32_16x16x32_bf16(a0, bg, acc1[0], 0, 0, 0);
            acc1[1] = __builtin_amdgcn_mfma_f32_16x16x32_bf16(a1, bg, acc1[1], 0, 0, 0); }
    }
#pragma unroll
    for (int mi = 0; mi < 2; ++mi)
#pragma unroll
        for (int j = 0; j < 4; ++j) { float* p = Hrows + (size_t)(mi * 16 + fq * 4 + j) * DM + c;
            if (MODE == 0) *p += acc0[mi][j]; else *p += acc0[mi][j] * __builtin_amdgcn_rcpf(1.f + __expf(-acc1[mi][j])); }
}
__device__ __forceinline__ void phase_0(CParams& P, unsigned char* lds, const int ph) {
    PHASE_PROLOGUE
            for (int row = gw; row < NT; row += NGW) {
                const float* src = row < NMAIN ? x + (size_t)row * DM : meta + (size_t)((row - NMAIN) & 15) * DM;
                f32x4 v[4];
#pragma unroll
                for (int j = 0; j < 4; ++j) { v[j] = ((const f32x4*)src)[lane + 64 * j]; ((f32x4*)(H + (size_t)row * DM))[lane + 64 * j] = v[j]; }
                store_norm_bf16(v, norm_mix, HN + (size_t)row * DM, lane);
            }
    for (int it = gw; it < CONV_DENSE_ITEMS; it += NGW) conv_dense_item(P, it, lane);
}

__device__ __forceinline__ void phase_1(CParams& P, unsigned char* lds, const int ph) {
    PHASE_PROLOGUE
    pg8::ProjOrder S; S.init(HN, WTIN, bid);
    pg8::EpiProj E{Qb, Kb, Vb, REST};
    pg8::gemm_phase<pg8::EpiProj, pg8::ProjOrder, true, true>((PG8_LAS unsigned char*)lds, DM, S, E);
}

__device__ __forceinline__ void na_units(CParams& P, unsigned char* lds, const int first, const int stride) {
    PHASE_PROLOGUE
    float* sb = (float*)lds;
    for (int i = tid; i < 8 * 465; i += 512) sb[i] = rpb[i];
    __syncthreads();
    const bf16_t* VT = Vb;
    const int fr = lane & 15, fq = lane >> 4;
    for (int u = first; u < 8192 + 16; u += stride) {
        const bool metaq = u >= 8192;
        int b, h, r = 0, qb = 0;
        if (!metaq) { qb = u & 3; r = (u >> 2) & 127; h = (u >> 9) & 7; b = u >> 12; } else { const int m = u - 8192; b = m >> 3; h = m & 7; }
        const int c = qb * 16 + fr;
        const int qrow = metaq ? NMAIN + b * NMETA + fr : b * SEQ + r * 64 + c;
        const int R0 = min(max(r - 4, 0), 120), cs = qb == 0 ? 0 : (qb == 1 ? 8 : (qb == 2 ? 24 : 32));
        const int C0 = min(max(c - 8, 0), 48);
        bf16x8 qf0 = *(const bf16x8*)(Qb + (size_t)qrow * 512 + h * 64 + fq * 8), qf1 = *(const bf16x8*)(Qb + (size_t)qrow * 512 + h * 64 + 32 + fq * 8);
        f32x4 sacc[17];
        const f32x4 zero4 = (f32x4){0.f, 0.f, 0.f, 0.f};
        if (!metaq) {
#pragma unroll
            for (int kt = 0; kt < 16; ++kt) {
                const int krow0 = b * SEQ + (R0 + (kt >> 1)) * 64 + cs + 16 * (kt & 1);
                const bf16_t* kp = Kb + (size_t)(krow0 + fr) * 512 + h * 64 + fq * 8;
                const bf16x8 a0 = *(const bf16x8*)kp, a1 = *(const bf16x8*)(kp + 32);
                f32x4 acc = __builtin_amdgcn_mfma_f32_16x16x32_bf16(a0, qf0, zero4, 0, 0, 0);
                sacc[kt] = __builtin_amdgcn_mfma_f32_16x16x32_bf16(a1, qf1, acc, 0, 0, 0);
            }
        } else {
#pragma unroll
            for (int kt = 0; kt < 16; ++kt) sacc[kt] = zero4;
        }
        {
            const bf16_t* kp = Kb + (size_t)(NMAIN + b * NMETA + fr) * 512 + h * 64 + fq * 8;
            const bf16x8 a0 = *(const bf16x8*)kp, a1 = *(const bf16x8*)(kp + 32);
            f32x4 acc = __builtin_amdgcn_mfma_f32_16x16x32_bf16(a0, qf0, zero4, 0, 0, 0);
            sacc[16] = __builtin_amdgcn_mfma_f32_16x16x32_bf16(a1, qf1, acc, 0, 0, 0);
        }
        float mx = -1e30f;
#pragma unroll
        for (int kt = 0; kt < 16; ++kt) {
            const int dr = R0 + (kt >> 1) - r + 7;
#pragma unroll
            for (int j = 0; j < 4; ++j) {
                const int kc = cs + 16 * (kt & 1) + 4 * fq + j;
                const bool inb = !metaq && kc >= C0 && kc < C0 + 16;
                const int dc = min(max(kc - c + 15, 0), 30);
                const float s = inb ? sacc[kt][j] * 0.125f + sb[(h * 15 + dr) * 31 + dc] : -1e30f;
                sacc[kt][j] = s; mx = fmaxf(mx, s);
            }
        }
#pragma unroll
        for (int j = 0; j < 4; ++j) { const float s = sacc[16][j] * 0.125f; sacc[16][j] = s; mx = fmaxf(mx, s); }
        mx = fmaxf(mx, __shfl_xor(mx, 16)); mx = fmaxf(mx, __shfl_xor(mx, 32));
        float sum = 0.f;
#pragma unroll
        for (int kt = 0; kt < 17; ++kt)
#pragma unroll
            for (int j = 0; j < 4; ++j) { const float pv = __expf(sacc[kt][j] - mx); sacc[kt][j] = pv; sum += pv; }
        sum += __shfl_xor(sum, 16); sum += __shfl_xor(sum, 32);
        f32x4 o[4] = {zero4, zero4, zero4, zero4};
        if (!metaq) {
#pragma unroll
            for (int kr = 0; kr < 8; ++kr) {
                union { bf16x8 v; unsigned u[4]; } bf;
                bf.u[0] = pk2(sacc[2 * kr][0], sacc[2 * kr][1]); bf.u[1] = pk2(sacc[2 * kr][2], sacc[2 * kr][3]);
                bf.u[2] = pk2(sacc[2 * kr + 1][0], sacc[2 * kr + 1][1]); bf.u[3] = pk2(sacc[2 * kr + 1][2], sacc[2 * kr + 1][3]);
                const size_t tok0 = (size_t)b * SEQ + (R0 + kr) * 64 + cs + 4 * fq;
#pragma unroll
                for (int dt = 0; dt < 4; ++dt) {
                    const bf16_t* vp = VT + (size_t)(h * 64 + dt * 16 + fr) * NTP + tok0;
                    union { bf16x8 v; u32x2 h2[2]; } af;
                    af.h2[0] = *(const u32x2*)vp; af.h2[1] = *(const u32x2*)(vp + 16);
                    o[dt] = __builtin_amdgcn_mfma_f32_16x16x32_bf16(af.v, bf.v, o[dt], 0, 0, 0);
                }
            }
        }
        {
            union { bf16x8 v; unsigned u[4]; } bf;
            bf.u[0] = pk2(sacc[16][0], sacc[16][1]); bf.u[1] = pk2(sacc[16][2], sacc[16][3]); bf.u[2] = 0u; bf.u[3] = 0u;
            const size_t tokm = (size_t)NMAIN + b * NMETA + 4 * fq;
#pragma unroll
            for (int dt = 0; dt < 4; ++dt) {
                const bf16_t* vp = VT + (size_t)(h * 64 + dt * 16 + fr) * NTP + tokm;
                union { bf16x8 v; u32x2 h2[2]; } af;
                af.h2[0] = *(const u32x2*)vp; af.h2[1] = (u32x2){0u, 0u};
                o[dt] = __builtin_amdgcn_mfma_f32_16x16x32_bf16(af.v, bf.v, o[dt], 0, 0, 0);
            }
        }
        const float inv = 1.f / sum;
#pragma unroll
        for (int dt = 0; dt < 4; ++dt) {
            u32x2 ov; ov.x = pk2(o[dt][0] * inv, o[dt][1] * inv); ov.y = pk2(o[dt][2] * inv, o[dt][3] * inv);
            *(u32x2*)(A2 + (size_t)qrow * DM + h * 64 + dt * 16 + 4 * fq) = ov;
        }
    }
    __syncthreads();
}

__device__ __forceinline__ void phase_3(CParams& P, unsigned char* lds, const int ph) {
    PHASE_PROLOGUE
            for (int tk = gw; tk < NT; tk += NGW) {
                const int b = tk / LSEQ, p = tk % LSEQ, row = rowof(b, p);
                const bool hp = p > 0, hn = p + 1 < LSEQ;
                const int rowp = hp ? rowof(b, p - 1) : row, rown = hn ? rowof(b, p + 1) : row;
#pragma unroll
                for (int j = 0; j < 7; ++j) {
                    const int c = 4 * lane + 256 * j;
                    const u32x2 vc = *(const u32x2*)(REST + (size_t)row * RESTC + c);
                    u32x2 vp = *(const u32x2*)(REST + (size_t)rowp * RESTC + c);
                    u32x2 vn = *(const u32x2*)(REST + (size_t)rown * RESTC + c);
                    if (!hp) { vp.x = 0; vp.y = 0; }
                    if (!hn) { vn.x = 0; vn.y = 0; }
                    const f32x4 m4 = *(const f32x4*)(mu + c);
                    float pc[4] = {bflo(vc.x), bfhi(vc.x), bflo(vc.y), bfhi(vc.y)};
                    float pp[4] = {bflo(vp.x), bfhi(vp.x), bflo(vp.y), bfhi(vp.y)};
                    float pn[4] = {bflo(vn.x), bfhi(vn.x), bflo(vn.y), bfhi(vn.y)};
                    float o[4];
#pragma unroll
                    for (int i = 0; i < 4; ++i) o[i] = pc[i] + m4[i] * (0.5f * (pp[i] + pn[i]) - pc[i]);
                    if (j == 6) {
                        if (lane < 16) { for (int i = 0; i < 4; ++i) o[i] = tanhf(o[i]); }
                        else if (lane >= 32) { for (int i = 0; i < 4; ++i) o[i] = sigmoidf_(o[i]); }
                    }
                    u32x2 ov; ov.x = pk2(o[0], o[1]); ov.y = pk2(o[2], o[3]);
                    bf16_t* dst = j < 2 ? Rr + (size_t)row * 512 + c : (j < 4 ? KR + (size_t)row * 512 + (c - 512) : (j < 6 ? VV + (size_t)row * 512 + (c - 1024) : LOW + (size_t)row * 256 + (c - 1536)));
                    *(u32x2*)dst = ov;
                }
            }
}


__device__ __forceinline__ void phase_4(CParams& P, unsigned char* lds, const int ph) {
    PHASE_PROLOGUE
    constexpr int AST = 264, SST = 136;
    bf16_t* As = (bf16_t*)lds;
    unsigned short* stg = (unsigned short*)(lds + 64 * AST * 2);
    const bf16_t* lrt = (const bf16_t*)(ws + WS_LRT);
    const int fr = lane & 15, fq = lane >> 4;
    const int nrt = (NT + 63) / 64;
    for (int u = bid; u < nrt; u += G) {
        for (int i = tid; i < 64 * 32; i += 512) { const int r = i >> 5, pc = (i & 31) * 8; int row = u * 64 + r; if (row >= NT) row = NT - 1;
            *(u32x4*)(As + r * AST + pc) = *(const u32x4*)(LOW + (size_t)row * 256 + pc); }
        __syncthreads();
#define P4_LOADB(t_, bv_, bias_) do { const int wh_ = (t_) >> 2, ct_ = (t_) & 3, Kw_ = wh_ < 4 ? 64 : 128, col_ = ct_ * 128 + 16 * wave + fr; \
            const bf16_t* Wt_ = lrt + (wh_ < 4 ? (size_t)wh_ * 512 * 64 : (size_t)4 * 512 * 64) + (size_t)col_ * Kw_ + 8 * fq; \
            bv_[0] = *(const bf16x8*)Wt_; bv_[1] = *(const bf16x8*)(Wt_ + 32); if (wh_ == 4) { bv_[2] = *(const bf16x8*)(Wt_ + 64); bv_[3] = *(const bf16x8*)(Wt_ + 96); } \
            bias_ = wh_ < 2 ? w0[wh_ * 512 + col_] : (wh_ < 4 ? a0[(wh_ - 2) * 512 + col_] : 0.f); } while (0)
        bf16x8 bnx[4]; float biasn;
        P4_LOADB(0, bnx, biasn);
#pragma unroll 1
        for (int t = 0; t < 20; ++t) {
            const int which = t >> 2, ct = t & 3;
            const int koff = which < 2 ? 0 : (which < 4 ? 64 : 128);
            bf16x8 bcur[4]; bcur[0] = bnx[0]; bcur[1] = bnx[1]; bcur[2] = bnx[2]; bcur[3] = bnx[3];
            const float bias = biasn;
            if (t + 1 < 20) P4_LOADB(t + 1, bnx, biasn);
            const f32x4 zero4 = (f32x4){0.f, 0.f, 0.f, 0.f};
            f32x4 acc[4] = {zero4, zero4, zero4, zero4};
#pragma unroll
            for (int ks = 0; ks < 4; ++ks) {
                if (ks < 2 || which == 4) {
#pragma unroll
                    for (int rt = 0; rt < 4; ++rt) acc[rt] = __builtin_amdgcn_mfma_f32_16x16x32_bf16(*(const bf16x8*)(As + (16 * rt + fr) * AST + koff + 32 * ks + 8 * fq), bcur[ks], acc[rt], 0, 0, 0);
                }
            }
            unsigned short* sg = stg + (t & 1) * 64 * SST + 16 * wave + fr;
#pragma unroll
            for (int rt = 0; rt < 4; ++rt)
#pragma unroll
                for (int j = 0; j < 4; ++j) { const float val = acc[rt][j] + bias; unsigned short o;
                    if (which < 2) { const _Float16 hv = (_Float16)(-0.6065306597f * sigmoidf_(val)); o = __builtin_bit_cast(unsigned short, hv); }
                    else if (which < 4) o = (unsigned short)f2bf(sigmoidf_(val));
                    else o = (unsigned short)f2bf(val);
                    sg[(16 * rt + 4 * fq + j) * SST] = o; }
            __syncthreads();
            {
                unsigned short* dst = which < 2 ? (unsigned short*)LW + (size_t)which * NT * 512 : (which < 4 ? (unsigned short*)AA + (size_t)(which - 2) * NT * 512 : (unsigned short*)Gg);
                const int r = tid >> 3, pc = (tid & 7) * 16, row = u * 64 + r;
                const unsigned short* sp = stg + (t & 1) * 64 * SST + r * SST + pc;
                if (row < NT) { *(u32x4*)(dst + (size_t)row * 512 + ct * 128 + pc) = *(const u32x4*)sp; *(u32x4*)(dst + (size_t)row * 512 + ct * 128 + pc + 8) = *(const u32x4*)(sp + 8); }
            }
        }
        __syncthreads();
#undef P4_LOADB
    }
}


__device__ __forceinline__ void phase_5(CParams& P, unsigned char* lds, const int ph) {
    PHASE_PROLOGUE
            for (int row = gw; row < NT; row += NGW) {
                const int c0 = lane * 8;
                const u32x4 krv = *(const u32x4*)(KR + (size_t)row * 512 + c0);
                const u32x4 rv = *(const u32x4*)(Rr + (size_t)row * 512 + c0);
                float kr[8], rr[8], kkv[8];
#pragma unroll
                for (int i = 0; i < 4; ++i) { kr[2 * i] = bflo(krv[i]); kr[2 * i + 1] = bfhi(krv[i]); rr[2 * i] = bflo(rv[i]); rr[2 * i + 1] = bfhi(rv[i]); }
                float ss = 0.f;
#pragma unroll
                for (int i = 0; i < 8; ++i) { kkv[i] = kr[i] * k_k[c0 + i]; ss += kkv[i] * kkv[i]; }
                ss += __shfl_xor(ss, 1); ss += __shfl_xor(ss, 2); ss += __shfl_xor(ss, 4);
                const float inv = 1.f / fmaxf(sqrtf(ss), 1e-12f);
#pragma unroll
                for (int i = 0; i < 8; ++i) kkv[i] *= inv;
                u32x4 o; o.x = pk2(kkv[0], kkv[1]); o.y = pk2(kkv[2], kkv[3]); o.z = pk2(kkv[4], kkv[5]); o.w = pk2(kkv[6], kkv[7]);
                *(u32x4*)(KK + (size_t)row * 512 + c0) = o;
                float bsum = 0.f;
#pragma unroll
                for (int d = 0; d < 2; ++d) {
                    const u32x4 av = *(const u32x4*)(AA + ((size_t)d * NT + row) * 512 + c0);
                    float a[8], kka[8], kd[8];
#pragma unroll
                    for (int i = 0; i < 4; ++i) { a[2 * i] = bflo(av[i]); a[2 * i + 1] = bfhi(av[i]); }
#pragma unroll
                    for (int i = 0; i < 8; ++i) { kka[i] = kkv[i] * a[i]; kd[i] = kr[i] * (1.f + (a[i] - 1.f) * k_a[c0 + i]); bsum += rr[i] * kd[i] * r_k[c0 + i]; }
                    u32x4 o1; o1.x = pk2(kka[0], kka[1]); o1.y = pk2(kka[2], kka[3]); o1.z = pk2(kka[4], kka[5]); o1.w = pk2(kka[6], kka[7]);
                    *(u32x4*)(KKA + ((size_t)d * NT + row) * 512 + c0) = o1;
                    u32x4 o2; o2.x = pk2(kd[0], kd[1]); o2.y = pk2(kd[2], kd[3]); o2.z = pk2(kd[4], kd[5]); o2.w = pk2(kd[6], kd[7]);
                    *(u32x4*)(KD + ((size_t)d * NT + row) * 512 + c0) = o2;
                }
                bsum += __shfl_xor(bsum, 1); bsum += __shfl_xor(bsum, 2); bsum += __shfl_xor(bsum, 4);
                if ((lane & 7) == 0) BC[(size_t)row * 8 + (lane >> 3)] = bsum;
            }
}


#define RWS 72
__device__ __forceinline__ bf16x8 rw_frag(const bf16_t* M, int row, int kofs) { return *(const bf16x8*)(M + row * RWS + kofs); }
__device__ __forceinline__ f32x4 rw_tile(const bf16_t* Am, int ra, const bf16_t* Bm, int rb, int fr, int fq) {
    f32x4 acc = (f32x4){0.f, 0.f, 0.f, 0.f};
    acc = __builtin_amdgcn_mfma_f32_16x16x32_bf16(rw_frag(Am, ra + fr, 8 * fq), rw_frag(Bm, rb + fr, 8 * fq), acc, 0, 0, 0);
    acc = __builtin_amdgcn_mfma_f32_16x16x32_bf16(rw_frag(Am, ra + fr, 32 + 8 * fq), rw_frag(Bm, rb + fr, 32 + 8 * fq), acc, 0, 0, 0);
    return acc;
}
__device__ __forceinline__ void phase_6(CParams& P, unsigned char* lds, const int ph) {
    PHASE_PROLOGUE
    constexpr int GST = 68, RST = 132;
    float* Gs = (float*)lds;
    bf16_t* A_rm = (bf16_t*)(lds + 64 * GST * 4); bf16_t* R_rm = A_rm + 64 * RWS; bf16_t* B_rm = R_rm + 64 * RWS; bf16_t* K_rm = B_rm + 64 * RWS;
    bf16_t* B_tr = K_rm + 64 * RWS; bf16_t* K_tr = B_tr + 64 * RWS; bf16_t* V_tr = K_tr + 64 * RWS;
    bf16_t* MAK = V_tr + 64 * RWS; bf16_t* MRB = MAK + 64 * RWS; bf16_t* MRK = MRB + 64 * RWS;
    bf16_t* MABr = MRK + 64 * RWS;
    float* RHS = (float*)(MABr + 64 * RWS);
    float* BT = RHS + 64 * RST; float* OFF = BT + 512; float* GC = OFF + 512;
    bf16_t* X1_tr = A_rm; bf16_t* X2_tr = K_rm;
    for (int i = tid; i < 4 * 64 * RWS / 2; i += 512) ((unsigned*)MAK)[i] = 0u;
    __syncthreads();
    const int fr = lane & 15, fq = lane >> 4;
#define RW1_BAR() do { asm volatile("s_waitcnt lgkmcnt(0)" ::: "memory"); __builtin_amdgcn_s_barrier(); asm volatile("" ::: "memory"); } while (0)
    const int t0 = tid & 63, kp = (tid >> 6) * 8;
    u32x4 nlw, nkk, nka, nkd, nrv, nvv;
#define RW1_LOAD(u_) do { const int ch_ = (u_) / RW_NCH, c_ = (u_) - ch_ * RW_NCH, d_ = ch_ >> 4, b_ = (ch_ >> 3) & 1, h_ = ch_ & 7, s_ = c_ * 64 + t0; \
        const int p_ = d_ ? LSEQ - 1 - s_ : s_; const size_t o_ = (size_t)rowof(b_, s_ < LSEQ ? p_ : 0) * 512 + h_ * 64 + kp; \
        nlw = *(const u32x4*)(LW + (size_t)d_ * NT * 512 + o_); nkk = *(const u32x4*)(KK + o_); nka = *(const u32x4*)(KKA + (size_t)d_ * NT * 512 + o_); \
        nkd = *(const u32x4*)(KD + (size_t)d_ * NT * 512 + o_); nrv = *(const u32x4*)(Rr + o_); nvv = *(const u32x4*)(VV + o_); } while (0)
    if (bid < RW_UNITS) RW1_LOAD(bid);
    for (int u = bid; u < RW_UNITS; u += G) {
        const int chain = u / RW_NCH, c = u - chain * RW_NCH;
        float lw[8], kk[8], ka[8], kd[8], rr[8]; u32x4 vv;
        {
            const bool valid = c * 64 + t0 < LSEQ;
            vv = nvv;
#pragma unroll
            for (int i = 0; i < 4; ++i) {
                union { unsigned u; _Float16 hh[2]; } cv; cv.u = nlw[i];
                lw[2 * i] = valid ? (float)cv.hh[0] : 0.f; lw[2 * i + 1] = valid ? (float)cv.hh[1] : 0.f;
                kk[2 * i] = valid ? bflo(nkk[i]) : 0.f; kk[2 * i + 1] = valid ? bfhi(nkk[i]) : 0.f;
                ka[2 * i] = valid ? bflo(nka[i]) : 0.f; ka[2 * i + 1] = valid ? bfhi(nka[i]) : 0.f;
                kd[2 * i] = valid ? bflo(nkd[i]) : 0.f; kd[2 * i + 1] = valid ? bfhi(nkd[i]) : 0.f;
                rr[2 * i] = valid ? bflo(nrv[i]) : 0.f; rr[2 * i + 1] = valid ? bfhi(nrv[i]) : 0.f;
                if (!valid) vv[i] = 0u;
            }
        }
        if (u + G < RW_UNITS) RW1_LOAD(u + G);
        *(f32x4*)(Gs + t0 * GST + kp) = (f32x4){lw[0], lw[1], lw[2], lw[3]}; *(f32x4*)(Gs + t0 * GST + kp + 4) = (f32x4){lw[4], lw[5], lw[6], lw[7]};
        RW1_BAR();
        { const int k = tid & 63, w = tid >> 6; float acc = 0.f;
#pragma unroll
          for (int i = 0; i < 8; ++i) { acc += Gs[(8 * w + i) * GST + k]; Gs[(8 * w + i) * GST + k] = acc; }
          BT[w * 64 + k] = acc; }
        RW1_BAR();
        { const int k = tid & 63, w = tid >> 6; float off = 0.f; for (int w2 = 0; w2 < w; ++w2) off += BT[w2 * 64 + k]; OFF[w * 64 + k] = off; }
        RW1_BAR();
#ifndef RW1_REP0
#define RW1_REP0 1
#endif
        for (int rep0_ = 0; rep0_ < RW1_REP0; ++rep0_) {
        {
            float va[8], vr[8], vb[8], vk[8];
            const f32x4 g0_ = *(const f32x4*)(Gs + t0 * GST + kp), g1_ = *(const f32x4*)(Gs + t0 * GST + kp + 4), o0_ = *(const f32x4*)(OFF + (t0 >> 3) * 64 + kp), o1_ = *(const f32x4*)(OFF + (t0 >> 3) * 64 + kp + 4);
            const float gg_[8] = {g0_[0] + o0_[0], g0_[1] + o0_[1], g0_[2] + o0_[2], g0_[3] + o0_[3], g1_[0] + o1_[0], g1_[1] + o1_[1], g1_[2] + o1_[2], g1_[3] + o1_[3]};
#pragma unroll
            for (int i = 0; i < 8; ++i) {
                const float g = gg_[i];
                const float eg = __expf(g), egm1 = __expf(g - lw[i]), einv = __expf(-g);
                va[i] = kk[i] * egm1; vr[i] = rr[i] * eg; vb[i] = ka[i] * einv; vk[i] = kd[i] * einv;
                if (t0 == 63) GC[kp + i] = eg;
            }
            *(f32x4*)(RHS + t0 * RST + kp) = (f32x4){va[0], va[1], va[2], va[3]}; *(f32x4*)(RHS + t0 * RST + kp + 4) = (f32x4){va[4], va[5], va[6], va[7]};
            u32x4 w4;
            w4.x = pk2(va[0], va[1]); w4.y = pk2(va[2], va[3]); w4.z = pk2(va[4], va[5]); w4.w = pk2(va[6], va[7]); *(u32x4*)(A_rm + t0 * RWS + kp) = w4;
            w4.x = pk2(vr[0], vr[1]); w4.y = pk2(vr[2], vr[3]); w4.z = pk2(vr[4], vr[5]); w4.w = pk2(vr[6], vr[7]); *(u32x4*)(R_rm + t0 * RWS + kp) = w4;
            w4.x = pk2(vb[0], vb[1]); w4.y = pk2(vb[2], vb[3]); w4.z = pk2(vb[4], vb[5]); w4.w = pk2(vb[6], vb[7]); *(u32x4*)(B_rm + t0 * RWS + kp) = w4;
            w4.x = pk2(vk[0], vk[1]); w4.y = pk2(vk[2], vk[3]); w4.z = pk2(vk[4], vk[5]); w4.w = pk2(vk[6], vk[7]); *(u32x4*)(K_rm + t0 * RWS + kp) = w4;
#pragma unroll
            for (int i = 0; i < 8; ++i) { B_tr[(kp + i) * RWS + t0] = (bf16_t)f2bf(vb[i]); K_tr[(kp + i) * RWS + t0] = (bf16_t)f2bf(vk[i]);
                V_tr[(kp + i) * RWS + t0] = (bf16_t)((i & 1) ? (vv[i >> 1] >> 16) : (vv[i >> 1] & 0xffffu)); }
        }
        RW1_BAR();
        }
        float* DQ = Gs; bf16_t* TB = (bf16_t*)BT;
#ifndef RW1_REP1
#define RW1_REP1 1
#endif
        for (int rep_ = 0; rep_ < RW1_REP1; ++rep_)
        for (int q = wave; q < 40; q += 8) {
            const int m = q / 10, e = q - m * 10, ti = e >= 6 ? 3 : (e >= 3 ? 2 : (e >= 1 ? 1 : 0)), tj = e - (ti * (ti + 1)) / 2;
            const f32x4 acc = rw_tile(m < 2 ? A_rm : R_rm, 16 * ti, (m & 1) ? K_rm : B_rm, 16 * tj, fr, fq);
            bf16_t* Mm = m == 1 ? MAK : (m == 2 ? MRB : MRK);
#pragma unroll
            for (int j = 0; j < 4; ++j) { const int t = 16 * ti + 4 * fq + j, i = 16 * tj + fr; const bool keep = m < 2 ? (i < t) : (i <= t); const float val = keep ? acc[j] : 0.f;
                if (m == 0) { MABr[t * RWS + i] = (bf16_t)f2bf(val); if (ti == tj) DQ[((ti * 16 + (t & 15)) * 4 + (fr & 3)) * 4 + (fr >> 2)] = val; }
                else Mm[t * RWS + i] = (bf16_t)f2bf(val); }
        }
        RW1_BAR();
#ifndef RW1_REP23
#define RW1_REP23 1
#endif
        for (int rep23_ = 0; rep23_ < RW1_REP23; ++rep23_) {
        if (wave >= 4) {
            for (int q = wave - 4; q < 16; q += 4) { const int ti = q >> 2, tv = q & 3; const f32x4 acc = rw_tile(MAK, 16 * ti, V_tr, 16 * tv, fr, fq);
#pragma unroll
                for (int j = 0; j < 4; ++j) RHS[(16 * ti + 4 * fq + j) * RST + 64 + 16 * tv + fr] = acc[j]; }
        } else {
            const int bb = wave, cc = lane >> 2, q = lane & 3;
            float xs[4] = {0.f, 0.f, 0.f, 0.f};
#pragma unroll
            for (int tl = 0; tl < 16; ++tl) {
                const f32x4 mv = *(const f32x4*)(DQ + ((bb * 16 + tl) * 4 + q) * 4);
                float part = mv[0] * xs[0] + mv[1] * xs[1] + mv[2] * xs[2] + mv[3] * xs[3];
                part += dppf<0xB1>(part); part += dppf<0x4E>(part);
                const float xt = (tl == cc ? 1.f : 0.f) - part;
                xs[tl >> 2] = (tl & 3) == q ? xt : xs[tl >> 2];
            }
#pragma unroll
            for (int m = 0; m < 4; ++m) TB[(bb * 16 + 4 * m + q) * 16 + cc] = (bf16_t)f2bf(xs[m]);
        }
        RW1_BAR();
        {
            const int c0 = 16 * wave;
            f32x4 X[4];
            const f32x4 zero4 = (f32x4){0.f, 0.f, 0.f, 0.f};
#define RW1_PACK(lo_, hi_, v_) do { union { bf16x8 v; unsigned u[4]; } t_; t_.u[0] = pk2(lo_[0], lo_[1]); t_.u[1] = pk2(lo_[2], lo_[3]); t_.u[2] = pk2(hi_[0], hi_[1]); t_.u[3] = pk2(hi_[2], hi_[3]); v_ = t_.v; } while (0)
#define RW1_LDA(base_, row0_, ca_, cb_, useb_, v_) do { union { bf16x8 v; u32x2 h2[2]; } t_; t_.h2[0] = *(const u32x2*)((base_) + ((row0_) + fr) * RWS + (ca_) + 4 * fq); \
            t_.h2[1] = (useb_) ? *(const u32x2*)((base_) + ((row0_) + fr) * RWS + (cb_) + 4 * fq) : (u32x2){0u, 0u}; v_ = t_.v; } while (0)
#pragma unroll
            for (int bq = 0; bq < 4; ++bq) {
                f32x4 acc;
#pragma unroll
                for (int j = 0; j < 4; ++j) acc[j] = -RHS[(16 * bq + 4 * fq + j) * RST + c0 + fr];
                bf16x8 af, bfv;
                if (bq >= 1) { RW1_LDA(MABr, 16 * bq, 0, 16, bq >= 2, af); if (bq >= 2) RW1_PACK(X[0], X[1], bfv); else RW1_PACK(X[0], zero4, bfv);
                    acc = __builtin_amdgcn_mfma_f32_16x16x32_bf16(af, bfv, acc, 0, 0, 0); }
                if (bq == 3) { RW1_LDA(MABr, 48, 32, 0, false, af); RW1_PACK(X[2], zero4, bfv); acc = __builtin_amdgcn_mfma_f32_16x16x32_bf16(af, bfv, acc, 0, 0, 0); }
                const f32x4 wv = (f32x4){-acc[0], -acc[1], -acc[2], -acc[3]};
                { union { bf16x8 v; u32x2 h2[2]; } t_; t_.h2[0] = *(const u32x2*)(TB + (bq * 16 + fr) * 16 + 4 * fq); t_.h2[1] = (u32x2){0u, 0u}; af = t_.v; }
                RW1_PACK(wv, zero4, bfv);
                X[bq] = __builtin_amdgcn_mfma_f32_16x16x32_bf16(af, bfv, zero4, 0, 0, 0);
                bf16_t* Xm = (wave < 4 ? X1_tr : X2_tr) + ((c0 & 63) + fr) * RWS + 16 * bq + 4 * fq;
                u32x2 o; o.x = pk2(X[bq][0], X[bq][1]); o.y = pk2(X[bq][2], X[bq][3]);
                *(u32x2*)Xm = o;
            }
#undef RW1_PACK
#undef RW1_LDA
        }
        RW1_BAR();
        }
#ifndef RW1_REP5
#define RW1_REP5 1
#endif
        for (int rep_ = 0; rep_ < RW1_REP5; ++rep_)
        for (int q = wave; q < 64; q += 8) {
            const int kind = q >> 4, ta = (q >> 2) & 3, tb = q & 3;
            u32x2 o;
            if (kind == 0) {
                const f32x4 acc = rw_tile(X1_tr, 16 * ta, B_tr, 16 * tb, fr, fq);
                const int k = 16 * tb + fr, kq = 16 * ta + 4 * fq; const float gc = GC[k];
                float v[4];
#pragma unroll
                for (int j = 0; j < 4; ++j) v[j] = gc * ((kq + j == k ? 1.f : 0.f) - acc[j]);
                o.x = pk2(v[0], v[1]); o.y = pk2(v[2], v[3]);
                *(u32x2*)(PP + (size_t)u * 4096 + k * 64 + 32 * (ta >> 1) + 8 * fq + 4 * (ta & 1)) = o;
            } else if (kind == 1) {
                const f32x4 acc = rw_tile(X1_tr, 16 * ta, MRB, 16 * tb, fr, fq);
                const int t = 16 * tb + fr, k0 = 16 * ta + 4 * fq;
                const u32x2 rv = *(const u32x2*)(R_rm + t * RWS + k0);
                o.x = pk2(bflo(rv.x) - acc[0], bfhi(rv.x) - acc[1]); o.y = pk2(bflo(rv.y) - acc[2], bfhi(rv.y) - acc[3]);
                *(u32x2*)(YT + (size_t)u * 4096 + t * 64 + 32 * (ta >> 1) + 8 * fq + 4 * (ta & 1)) = o;
            } else if (kind == 2) {
                const f32x4 a1 = rw_tile(K_tr, 16 * ta, V_tr, 16 * tb, fr, fq), a2 = rw_tile(B_tr, 16 * ta, X2_tr, 16 * tb, fr, fq);
                const int v_ = 16 * tb + fr, k0 = 16 * ta + 4 * fq;
                const f32x4 gc = *(const f32x4*)(GC + k0);
                o.x = pk2(gc[0] * (a1[0] - a2[0]), gc[1] * (a1[1] - a2[1])); o.y = pk2(gc[2] * (a1[2] - a2[2]), gc[3] * (a1[3] - a2[3]));
                *(u32x2*)(QT + (size_t)u * 4096 + v_ * 64 + k0) = o;
            } else {
                const f32x4 a1 = rw_tile(MRK, 16 * ta, V_tr, 16 * tb, fr, fq), a2 = rw_tile(MRB, 16 * ta, X2_tr, 16 * tb, fr, fq);
                const int v_ = 16 * tb + fr, t0_ = 16 * ta + 4 * fq;
                o.x = pk2(a1[0] - a2[0], a1[1] - a2[1]); o.y = pk2(a1[2] - a2[2], a1[3] - a2[3]);
                *(u32x2*)(ZT + (size_t)u * 4096 + v_ * 64 + t0_) = o;
            }
        }
        RW1_BAR();
    }
#undef RW1_LOAD
#undef RW1_BAR
}

__device__ __forceinline__ void phase_60(CParams& P, unsigned char* lds, const int ph) {
    PHASE_PROLOGUE
    if (bid < 32) {
        const int chain = bid, d = chain >> 4, b = (chain >> 3) & 1, h = chain & 7;
        const int fr = lane & 15, fq = lane >> 4;
        constexpr int MATB = 64 * RWS * 2, SLOT = 4 * MATB;
        bf16_t* ybuf = (bf16_t*)(lds + 3 * SLOT);
        const bool comp = wave < 4; const int vb = wave & 3, lm = wave & 3;
        const unsigned char* src = (const unsigned char*)(lm == 0 ? PP : (lm == 1 ? YT : (lm == 2 ? QT : ZT))) + (size_t)chain * RW_NCH * 8192 + lane * 16;
        u32x4 R0[8], R1[8], R2[8];
#define RW2_LD(Rx, c_) do { _Pragma("unroll") for (int i_ = 0; i_ < 8; ++i_) Rx[i_] = *(const u32x4*)(src + (size_t)(c_) * 8192 + i_ * 1024); } while (0)
#define RW2_ST(Rx, c_) do { unsigned char* dst_ = lds + ((c_) % 3) * SLOT + lm * MATB; _Pragma("unroll") for (int i_ = 0; i_ < 8; ++i_) { const int p_ = lane + 64 * i_; *(u32x4*)(dst_ + (p_ >> 3) * (RWS * 2) + (p_ & 7) * 16) = Rx[i_]; } } while (0)
#define RW2_FLUSH(c_) do { const int tl_ = 16 * lm + (lane >> 2), s_ = (c_) * 64 + tl_; const bf16_t* yb_ = ybuf + ((c_) & 1) * 64 * RWS + tl_ * RWS + 16 * (lane & 3); \
            const u32x4 y0_ = *(const u32x4*)yb_, y1_ = *(const u32x4*)(yb_ + 8); \
            if (s_ < LSEQ) { const int p_ = d ? LSEQ - 1 - s_ : s_; bf16_t* g_ = YFB + ((size_t)d * NT + rowof(b, p_)) * 512 + h * 64 + 16 * (lane & 3); *(u32x4*)g_ = y0_; *(u32x4*)(g_ + 8) = y1_; } } while (0)
        const f32x4 zero4 = (f32x4){0.f, 0.f, 0.f, 0.f};
        f32x4 S[4] = {zero4, zero4, zero4, zero4};
#define RW2_COMPUTE(c_) do { const bf16_t* sl_ = (const bf16_t*)(lds + ((c_) % 3) * SLOT); const bf16_t* sP = sl_; const bf16_t* sY = sl_ + 64 * RWS; const bf16_t* sQ = sl_ + 2 * 64 * RWS; const bf16_t* sZ = sl_ + 3 * 64 * RWS; \
            bf16_t* yo_ = ybuf + ((c_) & 1) * 64 * RWS + 16 * vb + fr; \
            union { bf16x8 v; unsigned u[4]; } bs[2]; \
            _Pragma("unroll") for (int ks = 0; ks < 2; ++ks) { bs[ks].u[0] = pk2(S[2 * ks][0], S[2 * ks][1]); bs[ks].u[1] = pk2(S[2 * ks][2], S[2 * ks][3]); \
                bs[ks].u[2] = pk2(S[2 * ks + 1][0], S[2 * ks + 1][1]); bs[ks].u[3] = pk2(S[2 * ks + 1][2], S[2 * ks + 1][3]); } \
            _Pragma("unroll") for (int tt = 0; tt < 4; ++tt) { \
                const u32x2 z2 = *(const u32x2*)(sZ + (16 * vb + fr) * RWS + 16 * tt + 4 * fq); \
                f32x4 acc = (f32x4){bflo(z2.x), bfhi(z2.x), bflo(z2.y), bfhi(z2.y)}; \
                acc = __builtin_amdgcn_mfma_f32_16x16x32_bf16(*(const bf16x8*)(sY + (16 * tt + fr) * RWS + 8 * fq), bs[0].v, acc, 0, 0, 0); \
                acc = __builtin_amdgcn_mfma_f32_16x16x32_bf16(*(const bf16x8*)(sY + (16 * tt + fr) * RWS + 32 + 8 * fq), bs[1].v, acc, 0, 0, 0); \
                _Pragma("unroll") for (int j = 0; j < 4; ++j) yo_[(16 * tt + 4 * fq + j) * RWS] = (bf16_t)f2bf(acc[j]); } \
            f32x4 Sn[4]; \
            _Pragma("unroll") for (int kt = 0; kt < 4; ++kt) { \
                const u32x2 q2 = *(const u32x2*)(sQ + (16 * vb + fr) * RWS + 16 * kt + 4 * fq); \
                f32x4 acc = (f32x4){bflo(q2.x), bfhi(q2.x), bflo(q2.y), bfhi(q2.y)}; \
                acc = __builtin_amdgcn_mfma_f32_16x16x32_bf16(*(const bf16x8*)(sP + (16 * kt + fr) * RWS + 8 * fq), bs[0].v, acc, 0, 0, 0); \
                acc = __builtin_amdgcn_mfma_f32_16x16x32_bf16(*(const bf16x8*)(sP + (16 * kt + fr) * RWS + 32 + 8 * fq), bs[1].v, acc, 0, 0, 0); \
                Sn[kt] = acc; } \
            _Pragma("unroll") for (int kt = 0; kt < 4; ++kt) S[kt] = Sn[kt]; } while (0)
#define RW2_BAR() do { asm volatile("s_waitcnt lgkmcnt(0)" ::: "memory"); __builtin_amdgcn_s_barrier(); asm volatile("" ::: "memory"); } while (0)
        if (!comp) { RW2_LD(R0, 0); RW2_ST(R0, 0); RW2_LD(R0, 1); RW2_LD(R1, 2); RW2_LD(R2, 3); }
        __syncthreads();
        for (int c = 0; c < RW_NCH; c += 3) {
            if (!comp) { if (c + 1 < RW_NCH) RW2_ST(R0, c + 1); if (c + 4 < RW_NCH) RW2_LD(R0, c + 4); if (c > 0) RW2_FLUSH(c - 1); } else RW2_COMPUTE(c);
            RW2_BAR();
            if (!comp) { if (c + 2 < RW_NCH) RW2_ST(R1, c + 2); if (c + 5 < RW_NCH) RW2_LD(R1, c + 5); RW2_FLUSH(c); } else RW2_COMPUTE(c + 1);
            RW2_BAR();
            if (!comp) { if (c + 3 < RW_NCH) RW2_ST(R2, c + 3); if (c + 6 < RW_NCH) RW2_LD(R2, c + 6); RW2_FLUSH(c + 1); } else RW2_COMPUTE(c + 2);
            RW2_BAR();
        }
        if (!comp) RW2_FLUSH(RW_NCH - 1);
#undef RW2_LD
#undef RW2_ST
#undef RW2_FLUSH
#undef RW2_COMPUTE
#undef RW2_BAR
    } else {
        na_units(P, lds, (bid - 32) * 8 + (threadIdx.x >> 6), (G - 32) * 8);
    }
}

__device__ __forceinline__ void phase_7(CParams& P, unsigned char* lds, const int ph) {
    PHASE_PROLOGUE
            for (int row = gw; row < NT; row += NGW) {
                const int c0 = lane * 8;
                const u32x4 yf = *(const u32x4*)(YFB + (size_t)row * 512 + c0);
                const u32x4 yb = *(const u32x4*)(YFB + ((size_t)NT + row) * 512 + c0);
                const u32x4 vv = *(const u32x4*)(VV + (size_t)row * 512 + c0);
                const u32x4 gg = *(const u32x4*)(Gg + (size_t)row * 512 + c0);
                float y[8], v[8], g[8];
#pragma unroll
                for (int i = 0; i < 4; ++i) { y[2 * i] = bflo(yf[i]) + bflo(yb[i]); y[2 * i + 1] = bfhi(yf[i]) + bfhi(yb[i]); v[2 * i] = bflo(vv[i]); v[2 * i + 1] = bfhi(vv[i]); g[2 * i] = bflo(gg[i]); g[2 * i + 1] = bfhi(gg[i]); }
                float sm = 0.f;
#pragma unroll
                for (int i = 0; i < 8; ++i) sm += y[i];
                sm += __shfl_xor(sm, 1); sm += __shfl_xor(sm, 2); sm += __shfl_xor(sm, 4);
                const float mean = sm * (1.f / 64.f);
                float vr = 0.f;
#pragma unroll
                for (int i = 0; i < 8; ++i) { const float dlt = y[i] - mean; vr += dlt * dlt; }
                vr += __shfl_xor(vr, 1); vr += __shfl_xor(vr, 2); vr += __shfl_xor(vr, 4);
                const float rstd = rsqrtf(vr * (1.f / 64.f) + 64e-5f);
                const float bc = BC[(size_t)row * 8 + (lane >> 3)];
                float o[8];
#pragma unroll
                for (int i = 0; i < 8; ++i) o[i] = ((y[i] - mean) * rstd * lnx_g[c0 + i] + lnx_b[c0 + i] + bc * v[i]) * g[i];
                u32x4 ov; ov.x = pk2(o[0], o[1]); ov.y = pk2(o[2], o[3]); ov.z = pk2(o[4], o[5]); ov.w = pk2(o[6], o[7]);
                *(u32x4*)(A2 + (size_t)row * DM + 512 + c0) = ov;
            }
}


__device__ __forceinline__ void phase_8(CParams& P, unsigned char* lds, const int ph) {
    PHASE_PROLOGUE
    if (gw < 64) meta_gemm<0>(A2 + (size_t)NMAIN * DM, WTOUT, H + (size_t)NMAIN * DM, gw, lane);
    pg8::DenseOrder S; S.init(A2, WTOUT, NMAIN, DM, DM, G, bid);
    pg8::EpiResidual E{H};
    pg8::gemm_phase<pg8::EpiResidual, pg8::DenseOrder, true, true>((PG8_LAS unsigned char*)lds, DM, S, E);
}

__device__ __forceinline__ void phase_9(CParams& P, unsigned char* lds, const int ph) {
    PHASE_PROLOGUE
            const int l = ph == 9 ? 0 : 1;
                    unsigned* cnt = CTL + CW_CNT(l);
            const float* wg = moe_wg + (size_t)l * DM * 4; const float* bg = moe_bg + l * 4;
            for (int row = gw; row < NT; row += NGW) {
                f32x4 v[4]; float ss = 0.f;
#pragma unroll
                for (int j = 0; j < 4; ++j) { v[j] = ((const f32x4*)(H + (size_t)row * DM))[lane + 64 * j]; ss += v[j][0] * v[j][0] + v[j][1] * v[j][1] + v[j][2] * v[j][2] + v[j][3] * v[j][3]; }
                ss = wave_sum(ss);
                const float rstd = rsqrtf(ss * (1.f / DM) + 1e-6f);
                float lg[4] = {0.f, 0.f, 0.f, 0.f};
#pragma unroll
                for (int j = 0; j < 4; ++j) {
                    const f32x4 g = ((const f32x4*)(norm_ffn + l * DM))[lane + 64 * j];
#pragma unroll
                    for (int i = 0; i < 4; ++i) v[j][i] = v[j][i] * rstd * g[i];
                    u32x2 o; o.x = pk2(v[j][0], v[j][1]); o.y = pk2(v[j][2], v[j][3]);
                    ((u32x2*)(HN + (size_t)row * DM))[lane + 64 * j] = o;
#pragma unroll
                    for (int i = 0; i < 4; ++i) { const f32x4 w = *(const f32x4*)(wg + (size_t)(4 * (lane + 64 * j) + i) * 4);
                        lg[0] += v[j][i] * w[0]; lg[1] += v[j][i] * w[1]; lg[2] += v[j][i] * w[2]; lg[3] += v[j][i] * w[3]; }
                }
#pragma unroll
                for (int q = 0; q < 4; ++q) lg[q] = wave_sum(lg[q]) + bg[q];
                int grp = 0; float mx = lg[0];
#pragma unroll
                for (int q = 1; q < 4; ++q) if (lg[q] > mx) { mx = lg[q]; grp = q; }
                float den = 0.f;
#pragma unroll
                for (int q = 0; q < 4; ++q) den += __expf(lg[q] - mx);
                const float pgrp = 1.f / den;
                const float* we = moe_we + ((size_t)(l * 4 + grp) * DM) * 8;
                float le[8] = {0.f, 0.f, 0.f, 0.f, 0.f, 0.f, 0.f, 0.f};
#pragma unroll
                for (int j = 0; j < 4; ++j)
#pragma unroll
                    for (int i = 0; i < 4; ++i) { const float* wr_ = we + (size_t)(4 * (lane + 64 * j) + i) * 8; const f32x4 wa = *(const f32x4*)wr_, wb = *(const f32x4*)(wr_ + 4);
                        le[0] += v[j][i] * wa[0]; le[1] += v[j][i] * wa[1]; le[2] += v[j][i] * wa[2]; le[3] += v[j][i] * wa[3];
                        le[4] += v[j][i] * wb[0]; le[5] += v[j][i] * wb[1]; le[6] += v[j][i] * wb[2]; le[7] += v[j][i] * wb[3]; }
#pragma unroll
                for (int q = 0; q < 8; ++q) le[q] = wave_sum(le[q]) + moe_be[(l * 4 + grp) * 8 + q];
                int i1 = 0; float m1 = le[0];
#pragma unroll
                for (int q = 1; q < 8; ++q) if (le[q] > m1) { m1 = le[q]; i1 = q; }
                int i2 = (i1 + 1) & 7; float m2 = -3.0e38f;
#pragma unroll
                for (int q = 0; q < 8; ++q) if (q != i1 && le[q] > m2) { m2 = le[q]; i2 = q; }
                const float e2 = __expf(m2 - m1);
                const float g1 = pgrp / (1.f + e2), g2 = pgrp * e2 / (1.f + e2);
                if (lane == 0) {
                    const int ea = grp * 8 + i1, eb = grp * 8 + i2;
                    const unsigned pa = atomicAdd(cnt + ea, 1u), pb = atomicAdd(cnt + eb, 1u);
                    EID[row * 2] = ea; EID[row * 2 + 1] = eb; POS[row * 2] = (int)pa; POS[row * 2 + 1] = (int)pb;
                    GATE[row * 2] = g1; GATE[row * 2 + 1] = g2;
                }
            }
    for (int it = gw; it < CONV_MOE_ITEMS; it += NGW) conv_moe_item(P, l, it, lane);
}


__device__ __forceinline__ void phase_10(CParams& P, unsigned char* lds, const int ph) {
    PHASE_PROLOGUE
    const int l = ph == 10 ? 0 : 1;
    int* ps = (int*)(lds + LDS_TAB);
    if (tid == 0) { int acc_ = 0; for (int e = 0; e < NEXP; ++e) { ps[e] = acc_; const int c = (int)CTL[CW_CNT(l) + e]; acc_ += (c + MOE_RT - 1) / MOE_RT * MOE_RT; } ps[NEXP] = acc_; }
    __syncthreads();
    for (int row = gw; row < NT; row += NGW) {
        const u32x4 v0 = ((const u32x4*)(HN + (size_t)row * DM))[lane], v1 = ((const u32x4*)(HN + (size_t)row * DM))[lane + 64];
#pragma unroll
        for (int k = 0; k < 2; ++k) {
            const int dest = ps[EID[row * 2 + k]] + POS[row * 2 + k];
            if (lane == 0) DEST[row * 2 + k] = dest;
            ((u32x4*)(XB + (size_t)dest * DM))[lane] = v0; ((u32x4*)(XB + (size_t)dest * DM))[lane + 64] = v1;
        }
    }
    __syncthreads();
}

__device__ __forceinline__ void phase_11(CParams& P, unsigned char* lds, const int ph) {
    PHASE_PROLOGUE
    const int l = ph == 11 ? 0 : 1;
    int* et = (int*)(lds + LDS_TAB);
    if (tid == 0) { int acc_ = 0; for (int e = 0; e < NEXP; ++e) { const int c = (int)CTL[CW_CNT(l) + e], n = (c + MOE_RT - 1) / MOE_RT; for (int q = 0; q < n; ++q) et[1 + acc_ + q] = e; acc_ += n; } et[0] = acc_; }
    __syncthreads();
    pg8::MoeOrder S{et + 1, et[0], vcu, (const char*)XB, (const char*)WT13, 256u * DM * 2u, 256u * DM * 2u, (unsigned)DM * DM * 2u};
    pg8::EpiSwiglu E{HB};
    pg8::gemm_phase<pg8::EpiSwiglu, pg8::MoeOrder, true, true>((PG8_LAS unsigned char*)lds, DM, S, E);
    __syncthreads();
}

__device__ __forceinline__ void phase_12(CParams& P, unsigned char* lds, const int ph) {
    PHASE_PROLOGUE
    const int l = ph == 12 ? 0 : 1;
    int* et = (int*)(lds + LDS_TAB);
    if (tid == 0) { int acc_ = 0; for (int e = 0; e < NEXP; ++e) { const int c = (int)CTL[CW_CNT(l) + e], n = (c + MOE_RT - 1) / MOE_RT; for (int q = 0; q < n; ++q) et[1 + acc_ + q] = e; acc_ += n; } et[0] = acc_; }
    __syncthreads();
    pg8::MoeOrder S{et + 1, et[0], vcu, (const char*)HB, (const char*)WT2, 256u * DFF * 2u, 256u * DFF * 2u, (unsigned)DM * DFF * 2u};
    pg8::EpiBf16Plain E{YB, DM};
    pg8::gemm_phase<pg8::EpiBf16Plain, pg8::MoeOrder, true, true>((PG8_LAS unsigned char*)lds, DFF, S, E);
    __syncthreads();
}

__device__ __forceinline__ void phase_13(CParams& P, unsigned char* lds, const int ph) {
    PHASE_PROLOGUE
            const bool fin = ph == 21;
            for (int row = gw; row < NT; row += NGW) {
                const int d0 = DEST[row * 2], d1 = DEST[row * 2 + 1];
                const float g0 = GATE[row * 2], g1 = GATE[row * 2 + 1];
                f32x4 v[4];
#pragma unroll
                for (int j = 0; j < 4; ++j) {
                    v[j] = ((const f32x4*)(H + (size_t)row * DM))[lane + 64 * j];
                    const u32x2 ya = ((const u32x2*)(YB + (size_t)d0 * DM))[lane + 64 * j];
                    const u32x2 yb = ((const u32x2*)(YB + (size_t)d1 * DM))[lane + 64 * j];
                    v[j][0] += g0 * bflo(ya.x) + g1 * bflo(yb.x); v[j][1] += g0 * bfhi(ya.x) + g1 * bfhi(yb.x);
                    v[j][2] += g0 * bflo(ya.y) + g1 * bflo(yb.y); v[j][3] += g0 * bfhi(ya.y) + g1 * bfhi(yb.y);
                }
                if (!fin) {
#pragma unroll
                    for (int j = 0; j < 4; ++j) ((f32x4*)(H + (size_t)row * DM))[lane + 64 * j] = v[j];
                    store_norm_bf16(v, norm_mix + DM, HN + (size_t)row * DM, lane);
                } else if (row < NMAIN) {
                    float ss = 0.f;
#pragma unroll
                    for (int j = 0; j < 4; ++j) ss += v[j][0] * v[j][0] + v[j][1] * v[j][1] + v[j][2] * v[j][2] + v[j][3] * v[j][3];
                    ss = wave_sum(ss);
                    const float rstd = rsqrtf(ss * (1.f / DM) + 1e-6f);
#pragma unroll
                    for (int j = 0; j < 4; ++j) { const f32x4 g = ((const f32x4*)norm_final)[lane + 64 * j]; f32x4 o;
                        o[0] = v[j][0] * rstd * g[0]; o[1] = v[j][1] * rstd * g[1]; o[2] = v[j][2] * rstd * g[2]; o[3] = v[j][3] * rstd * g[3];
                        ((f32x4*)(P.out + (size_t)row * DM))[lane + 64 * j] = o; }
                }
            }
}

__device__ __forceinline__ void phase_14(CParams& P, unsigned char* lds, const int ph) {
    PHASE_PROLOGUE
    float* pwr = (float*)lds; float* pwi = pwr + 2176; float* bbr = pwi + 2176; float* bbi = bbr + 2048; float* ccr = bbi + 2048; float* cci = ccr + 2048; float* kf = cci + 2048; float* kb = kf + 4096;
    for (int gu = bid; gu < 256; gu += G) {
        const int g = gu >> 2, part = gu & 3;
        if (tid < 128) {
            const int d = tid >> 6, p = tid & 63;
            const float step = __expf(s5_ls[d * 64 + g]);
            const float lr = s5_lre[(d * 64 + g) * 64 + p], li = s5_lim[(d * 64 + g) * 64 + p];
            const float mag = expf(lr * step);
            const float abr = mag * cosf(li * step), abi = mag * sinf(li * step);
            const float den = lr * lr + li * li;
            const float zr = ((abr - 1.f) * lr + abi * li) / den, zi = (abi * lr - (abr - 1.f) * li) / den;
            float pr = 1.f, pi = 0.f;
            for (int t = 0; t < 17; ++t) { pwr[(d * 64 + p) * 17 + t] = pr; pwi[(d * 64 + p) * 17 + t] = pi; const float nr = pr * abr - pi * abi; pi = pr * abi + pi * abr; pr = nr; }
            for (int i = 0; i < 16; ++i) { const float br = s5_b_re[((size_t)(g * 64 + p)) * 16 + i], bi = s5_b_im[((size_t)(g * 64 + p)) * 16 + i];
                bbr[(d * 64 + p) * 16 + i] = zr * br - zi * bi; bbi[(d * 64 + p) * 16 + i] = zr * bi + zi * br; }
        }
        for (int idx = tid; idx < 2048; idx += 512) { const int d = idx >> 10, i = (idx >> 6) & 15, p = idx & 63;
            ccr[idx] = s5_c_re[((size_t)(d * 64 + g) * 16 + i) * 64 + p]; cci[idx] = s5_c_im[((size_t)(d * 64 + g) * 16 + i) * 64 + p]; }
        __syncthreads();
        {
            const int d = tid >> 8, tau = (tid >> 4) & 15, i = tid & 15;
            float acc[16];
#pragma unroll
            for (int q = 0; q < 16; ++q) acc[q] = 0.f;
            for (int p = 0; p < 64; ++p) {
                const float cr = ccr[(d * 16 + i) * 64 + p], ci = cci[(d * 16 + i) * 64 + p], pr = pwr[(d * 64 + p) * 17 + tau], pi = pwi[(d * 64 + p) * 17 + tau];
                const float xr = cr * pr - ci * pi, xi = cr * pi + ci * pr;
#pragma unroll
                for (int q = 0; q < 16; ++q) acc[q] += xr * bbr[(d * 64 + p) * 16 + q] - xi * bbi[(d * 64 + p) * 16 + q];
            }
            float* kt = (d ? kb : kf) + (tau * 16 + i) * 16;
#pragma unroll
            for (int q = 0; q < 16; ++q) kt[q] = acc[q];
        }
        __syncthreads();
        unsigned* bta = (unsigned*)(BTA + (size_t)g * 512 * 256);
        for (int idx = part * 128 * 128 + tid; idx < (part + 1) * 128 * 128; idx += 512) {
            const int row = idx >> 7, col = (idx & 127) * 2;
            float v[2];
#pragma unroll
            for (int e = 0; e < 2; ++e) {
                const int cc_ = col + e, j = cc_ >> 4, ip = cc_ & 15;
                if (row < 256) { const int t = row >> 4, i = row & 15;
                    v[e] = j < t ? kf[((t - j) * 16 + i) * 16 + ip] : (j > t ? kb[((j - t) * 16 + i) * 16 + ip] : kf[i * 16 + ip] + kb[i * 16 + ip]); }
                else { const int kp = row - 256, d = kp >> 7, part = (kp >> 6) & 1, p = kp & 63, tau = d == 0 ? 15 - j : j;
                    const float pr = pwr[(d * 64 + p) * 17 + tau], pi = pwi[(d * 64 + p) * 17 + tau], br = bbr[(d * 64 + p) * 16 + ip], bi = bbi[(d * 64 + p) * 16 + ip];
                    v[e] = part ? pr * bi + pi * br : pr * br - pi * bi; }
            }
            bta[idx] = pk2(v[0], v[1]);
        }
        unsigned* btc = (unsigned*)(BTC + (size_t)g * 256 * 256);
        for (int idx = part * 64 * 128 + tid; idx < (part + 1) * 64 * 128; idx += 512) {
            const int row = idx >> 7, col = (idx & 127) * 2, t = row >> 4, i = row & 15;
            float v[2];
#pragma unroll
            for (int e = 0; e < 2; ++e) {
                const int k = col + e, d = k >> 7, part = (k >> 6) & 1, p = k & 63, tau = d == 0 ? t + 1 : 16 - t;
                const float cr = ccr[(d * 16 + i) * 64 + p], ci = cci[(d * 16 + i) * 64 + p], pr = pwr[(d * 64 + p) * 17 + tau], pi = pwi[(d * 64 + p) * 17 + tau];
                v[e] = part ? -(cr * pi + ci * pr) : cr * pr - ci * pi;
            }
            btc[idx] = pk2(v[0], v[1]);
        }
        __syncthreads();
    }
}

__device__ __forceinline__ void phase_15(CParams& P, unsigned char* lds, const int ph) {
    PHASE_PROLOGUE
    pg8::S5OrderA S{vcu, (const char*)HN, (const char*)BTA};
    pg8::EpiS5A E{YI, S5E};
    int Kr = 256; asm volatile("" : "+s"(Kr));
    pg8::gemm_phase<pg8::EpiS5A, pg8::S5OrderA, true, true>((PG8_LAS unsigned char*)lds, Kr, S, E);
}

__device__ __forceinline__ void phase_16(CParams& P, unsigned char* lds, const int ph) {
    PHASE_PROLOGUE
    float* Ls = (float*)lds;
    for (int wg = bid; wg < NB * 64 * 2; wg += G) {
        const int d = wg & 1, g = (wg >> 1) & 63, b = wg >> 7, p = lane;
        const float step = __expf(s5_ls[d * 64 + g]);
        const float lr = s5_lre[(d * 64 + g) * 64 + p], li = s5_lim[(d * 64 + g) * 64 + p];
        const float mag = expf(lr * step);
        const float abr = mag * cosf(li * step), abi = mag * sinf(li * step);
        float ar = 1.f, ai = 0.f;
        for (int t = 0; t < 16; ++t) { const float nr = ar * abr - ai * abi; ai = ar * abi + ai * abr; ar = nr; }
        float Ar = 1.f, Ai = 0.f;
        for (int t = 0; t < 64; ++t) { const float nr = Ar * ar - Ai * ai; Ai = Ar * ai + Ai * ar; Ar = nr; }
        const bf16_t* Ep = S5E + (size_t)g * 256 + d * 128 + p;
        bf16_t* Cp = CAR + (size_t)g * 1280 * 256 + d * 128 + p;
        const int q0 = 64 * wave;
#define S5_N(q_) ({ const int c_ = d ? 512 - (q_) : (q_); c_ == 0 ? 1024 + b : b * 512 + c_ - 1; })
        float sr = 0.f, si = 0.f;
#pragma unroll 1
        for (int hb = 0; hb < 2; ++hb) {
            float er[32], ei[32];
#pragma unroll
            for (int k = 0; k < 32; ++k) { const int n = S5_N(q0 + 32 * hb + k); er[k] = bf2f(Ep[(size_t)n * 64 * 256]); ei[k] = bf2f(Ep[(size_t)n * 64 * 256 + 64]); }
#pragma unroll
            for (int k = 0; k < 32; ++k) { const float nr = ar * sr - ai * si + er[k]; si = ar * si + ai * sr + ei[k]; sr = nr; }
        }
        Ls[(wave * 64 + p) * 2] = sr; Ls[(wave * 64 + p) * 2 + 1] = si;
        __syncthreads();
        sr = 0.f; si = 0.f;
        for (int w2 = 0; w2 < wave; ++w2) { const float l0 = Ls[(w2 * 64 + p) * 2], l1 = Ls[(w2 * 64 + p) * 2 + 1]; const float nr = Ar * sr - Ai * si + l0; si = Ar * si + Ai * sr + l1; sr = nr; }
#pragma unroll 1
        for (int hb = 0; hb < 2; ++hb) {
            float er[32], ei[32]; int nn[32];
#pragma unroll
            for (int k = 0; k < 32; ++k) { nn[k] = S5_N(q0 + 32 * hb + k); er[k] = bf2f(Ep[(size_t)nn[k] * 64 * 256]); ei[k] = bf2f(Ep[(size_t)nn[k] * 64 * 256 + 64]); }
#pragma unroll
            for (int k = 0; k < 32; ++k) { Cp[(size_t)nn[k] * 256] = (bf16_t)f2bf(sr); Cp[(size_t)nn[k] * 256 + 64] = (bf16_t)f2bf(si);
                const float nr = ar * sr - ai * si + er[k]; si = ar * si + ai * sr + ei[k]; sr = nr; }
        }
        if (wave == 7) { const int n = S5_N(512); Cp[(size_t)n * 256] = (bf16_t)f2bf(sr); Cp[(size_t)n * 256 + 64] = (bf16_t)f2bf(si); }
#undef S5_N
        __syncthreads();
    }
}

__device__ __forceinline__ void phase_22(CParams& P, unsigned char* lds, const int ph) {
    PHASE_PROLOGUE
    pg8::S5OrderC S{vcu, (const char*)CAR, (const char*)BTC};
    pg8::EpiS5C E{YI, HN, s5_d, A2};
    int Kr = 256; asm volatile("" : "+s"(Kr));
    pg8::gemm_phase<pg8::EpiS5C, pg8::S5OrderC, true, true>((PG8_LAS unsigned char*)lds, Kr, S, E);
}

__device__ __forceinline__ void phase_23(CParams& P, unsigned char* lds, const int ph) {
    PHASE_PROLOGUE
    if (gw < 64) meta_gemm<1>(A2 + (size_t)NMAIN * DM, WTGLU, H + (size_t)NMAIN * DM, gw, lane);
    pg8::DenseOrder S; S.init(A2, WTGLU, NMAIN, 2 * DM, DM, G, bid);
    pg8::EpiGlu E{H};
    pg8::gemm_phase<pg8::EpiGlu, pg8::DenseOrder, true, true>((PG8_LAS unsigned char*)lds, DM, S, E);
}
#define LAS __attribute__((address_space(3)))
#define CW_BAR 4096
#define XB_TMO      128
#define XB_XCNT(j)  (256  + 64 * (j))
#define XB_XSUB(j)  (1280 + 64 * (j))
#define XB_XGEN(j)  (2304 + 64 * (j))
#define XB_TOP      3328
#define XB_TOPGEN   3392
#define XCD_BAR_WORDS 3456
#define XB_SPIN_CAP (1u << 22)
__device__ __forceinline__ unsigned xb_ld(unsigned* p)              { return __hip_atomic_load(p, __ATOMIC_RELAXED, __HIP_MEMORY_SCOPE_AGENT); }
__device__ __forceinline__ unsigned xb_add(unsigned* p, unsigned v) { return __hip_atomic_fetch_add(p, v, __ATOMIC_RELAXED, __HIP_MEMORY_SCOPE_AGENT); }
__device__ __forceinline__ unsigned xb_xcc_id() { return (unsigned)__builtin_amdgcn_s_getreg((3 << 11) | 20) & 0xFu; }
#define XB_SPIN(cond, bar) do { unsigned _sp = 0; while (cond) { __builtin_amdgcn_s_sleep(1); \
    if ((++_sp & 255u) == 0u) { if (xb_ld(&(bar)[XB_TMO])) break; if (_sp > XB_SPIN_CAP) { atomicAdd(&(bar)[XB_TMO], 1u); break; } } } } while (0)
struct XcdBarrier { unsigned* bar; unsigned x; volatile LAS unsigned* st; };
__device__ __forceinline__ XcdBarrier xcd_barrier_post(unsigned* bar, volatile LAS unsigned* st) {
    XcdBarrier b; b.bar = bar; b.x = xb_xcc_id(); b.st = st;
    if (threadIdx.x == 0) (void)xb_add(&bar[XB_XCNT(b.x)], 1u);
    return b;
}
__device__ __forceinline__ void xcd_barrier_complete(unsigned* bar, unsigned x, unsigned& nloc, unsigned& nx) {
    const unsigned G = GRID;
    unsigned sum, cnt, mine, sp = 0u;
    for (;;) {
        sum = 0u; cnt = 0u; mine = 0u;
#pragma unroll
        for (unsigned j = 0; j < 16; ++j) { const unsigned c = xb_ld(&bar[XB_XCNT(j)]); sum += c; cnt += (c > 0u) ? 1u : 0u; mine = (j == x) ? c : mine; }
        if (sum == G) break;
        __builtin_amdgcn_s_sleep(1);
        if ((++sp & 255u) == 0u) { if (xb_ld(&bar[XB_TMO])) break; if (sp > XB_SPIN_CAP) { atomicAdd(&bar[XB_TMO], 1u); break; } }
    }
    nloc = mine > 0u ? mine : 1u; nx = cnt > 0u ? cnt : 1u;
}
__device__ __forceinline__ void xcd_barrier(const XcdBarrier& b) {
    asm volatile("s_waitcnt vmcnt(0)" ::: "memory");
    __syncthreads();
    if (threadIdx.x == 0) {
        unsigned* bar = b.bar;
        __builtin_amdgcn_s_waitcnt(0);
        unsigned nloc = b.st[0], nx = b.st[1];
        if (nloc == 0u) { xcd_barrier_complete(bar, b.x, nloc, nx); b.st[0] = nloc; b.st[1] = nx; }
        const unsigned old = xb_add(&bar[XB_XSUB(b.x)], 1u);
        const unsigned gen = old / nloc;
        if (old + 1u == (gen + 1u) * nloc) {
            __builtin_amdgcn_fence(__ATOMIC_RELEASE, "agent");
            asm volatile("s_waitcnt vmcnt(0)" ::: "memory");
            const unsigned og = xb_add(&bar[XB_TOP], 1u);
            const unsigned tg = og / nx;
            if (og + 1u == (tg + 1u) * nx) xb_add(&bar[XB_TOPGEN], 1u);
            else XB_SPIN(xb_ld(&bar[XB_TOPGEN]) == tg, bar);
            __builtin_amdgcn_fence(__ATOMIC_ACQUIRE, "agent");
            xb_add(&bar[XB_XGEN(b.x)], 1u);
            asm volatile("s_waitcnt vmcnt(0)" ::: "memory");
        } else {
            XB_SPIN(xb_ld(&bar[XB_XGEN(b.x)]) == gen, bar);
            __builtin_amdgcn_fence(__ATOMIC_ACQUIRE, "agent");
            asm volatile("s_waitcnt vmcnt(0)" ::: "memory");
        }
    }
    __syncthreads();
}


__global__ void __launch_bounds__(512, 2) mega(Params P_) {
    extern __shared__ __attribute__((aligned(16))) unsigned char lds[];
    volatile LAS unsigned* st = (volatile LAS unsigned*)(LAS unsigned char*)(lds + LDS_BARST);
    if (threadIdx.x < 16) st[threadIdx.x] = 0u;
    __syncthreads();
    CParams* pp = (CParams*)__builtin_amdgcn_kernarg_segment_ptr();
    (void)xcd_barrier_post((unsigned*)(pp->ws + WS_CTL) + CW_BAR, st);
#define GB do { XcdBarrier bar_; bar_.bar = (unsigned*)(pp->ws + WS_CTL) + CW_BAR; bar_.x = xb_xcc_id(); bar_.st = (volatile LAS unsigned*)(LAS unsigned char*)(lds + LDS_BARST); xcd_barrier(bar_); asm volatile("" : "+s"(pp)); } while (0)
#define P (*pp)
    asm volatile("" : "+s"(pp));
    phase_0(P, lds, 0); GB;
#if defined(PROBE_PH) && PROBE_PH == 0
    { int nrep = PROBE_N; asm volatile("" : "+s"(nrep)); for (int rep = 0; rep < nrep; ++rep) { GB; phase_0(P, lds, 0); GB; } }
#endif
    phase_1(P, lds, 1); GB;
#if defined(PROBE_PH) && PROBE_PH == 1
    { int nrep = PROBE_N; asm volatile("" : "+s"(nrep)); for (int rep = 0; rep < nrep; ++rep) { GB; phase_1(P, lds, 1); GB; } }
#endif
    phase_3(P, lds, 3); GB;
#if defined(PROBE_PH) && PROBE_PH == 3
    { int nrep = PROBE_N; asm volatile("" : "+s"(nrep)); for (int rep = 0; rep < nrep; ++rep) { GB; phase_3(P, lds, 3); GB; } }
#endif
    phase_4(P, lds, 4); GB;
#if defined(PROBE_PH) && PROBE_PH == 4
    { int nrep = PROBE_N; asm volatile("" : "+s"(nrep)); for (int rep = 0; rep < nrep; ++rep) { GB; phase_4(P, lds, 4); GB; } }
#endif
    phase_5(P, lds, 5); GB;
#if defined(PROBE_PH) && PROBE_PH == 5
    { int nrep = PROBE_N; asm volatile("" : "+s"(nrep)); for (int rep = 0; rep < nrep; ++rep) { GB; phase_5(P, lds, 5); GB; } }
#endif
    phase_6(P, lds, 6); GB;
    phase_60(P, lds, 60); GB;
#if defined(PROBE_PH) && PROBE_PH == 60
    { int nrep = PROBE_N; asm volatile("" : "+s"(nrep)); for (int rep = 0; rep < nrep; ++rep) { GB; phase_60(P, lds, 60); GB; } }
#endif
#if defined(PROBE_PH) && PROBE_PH == 6
    { int nrep = PROBE_N; asm volatile("" : "+s"(nrep)); for (int rep = 0; rep < nrep; ++rep) { GB; phase_6(P, lds, 6); GB; } }
#endif
    phase_7(P, lds, 7); GB;
#if defined(PROBE_PH) && PROBE_PH == 7
    { int nrep = PROBE_N; asm volatile("" : "+s"(nrep)); for (int rep = 0; rep < nrep; ++rep) { GB; phase_7(P, lds, 7); GB; } }
#endif
    phase_8(P, lds, 8); GB;
#if defined(PROBE_PH) && PROBE_PH == 8
    { int nrep = PROBE_N; asm volatile("" : "+s"(nrep)); for (int rep = 0; rep < nrep; ++rep) { GB; phase_8(P, lds, 8); GB; } }
#endif
    phase_9(P, lds, 9); GB;
#if defined(PROBE_PH) && PROBE_PH == 9
    { int nrep = PROBE_N; asm volatile("" : "+s"(nrep)); for (int rep = 0; rep < nrep; ++rep) { GB; phase_9(P, lds, 9); GB; } }
#endif
    phase_10(P, lds, 10); GB;
#if defined(PROBE_PH) && PROBE_PH == 10
    { int nrep = PROBE_N; asm volatile("" : "+s"(nrep)); for (int rep = 0; rep < nrep; ++rep) { GB; phase_10(P, lds, 10); GB; } }
#endif
    phase_11(P, lds, 11); GB;
#if defined(PROBE_PH) && PROBE_PH == 11
    { int nrep = PROBE_N; asm volatile("" : "+s"(nrep)); for (int rep = 0; rep < nrep; ++rep) { GB; phase_11(P, lds, 11); GB; } }
#endif
    phase_12(P, lds, 12); GB;
#if defined(PROBE_PH) && PROBE_PH == 12
    { int nrep = PROBE_N; asm volatile("" : "+s"(nrep)); for (int rep = 0; rep < nrep; ++rep) { GB; phase_12(P, lds, 12); GB; } }
#endif
    phase_13(P, lds, 13); GB;
#if defined(PROBE_PH) && PROBE_PH == 13
    { int nrep = PROBE_N; asm volatile("" : "+s"(nrep)); for (int rep = 0; rep < nrep; ++rep) { GB; phase_13(P, lds, 13); GB; } }
#endif
    phase_14(P, lds, 14); GB;
#if defined(PROBE_PH) && PROBE_PH == 14
    { int nrep = PROBE_N; asm volatile("" : "+s"(nrep)); for (int rep = 0; rep < nrep; ++rep) { GB; phase_14(P, lds, 14); GB; } }
#endif
    phase_15(P, lds, 15); GB;
#if defined(PROBE_PH) && PROBE_PH == 15
    { int nrep = PROBE_N; asm volatile("" : "+s"(nrep)); for (int rep = 0; rep < nrep; ++rep) { GB; phase_15(P, lds, 15); GB; } }
#endif
    phase_16(P, lds, 16); GB;
#if defined(PROBE_PH) && PROBE_PH == 16
    { int nrep = PROBE_N; asm volatile("" : "+s"(nrep)); for (int rep = 0; rep < nrep; ++rep) { GB; phase_16(P, lds, 16); GB; } }
#endif
    phase_22(P, lds, 22); GB;
#if defined(PROBE_PH) && PROBE_PH == 22
    { int nrep = PROBE_N; asm volatile("" : "+s"(nrep)); for (int rep = 0; rep < nrep; ++rep) { GB; phase_22(P, lds, 22); GB; } }
#endif
    phase_23(P, lds, 23); GB;
#if defined(PROBE_PH) && PROBE_PH == 23
    { int nrep = PROBE_N; asm volatile("" : "+s"(nrep)); for (int rep = 0; rep < nrep; ++rep) { GB; phase_23(P, lds, 23); GB; } }
#endif
    phase_9(P, lds, 17); GB;
#if defined(PROBE_PH) && PROBE_PH == 17
    { int nrep = PROBE_N; asm volatile("" : "+s"(nrep)); for (int rep = 0; rep < nrep; ++rep) { GB; phase_9(P, lds, 17); GB; } }
#endif
    phase_10(P, lds, 18); GB;
#if defined(PROBE_PH) && PROBE_PH == 18
    { int nrep = PROBE_N; asm volatile("" : "+s"(nrep)); for (int rep = 0; rep < nrep; ++rep) { GB; phase_10(P, lds, 18); GB; } }
#endif
    phase_11(P, lds, 19); GB;
#if defined(PROBE_PH) && PROBE_PH == 19
    { int nrep = PROBE_N; asm volatile("" : "+s"(nrep)); for (int rep = 0; rep < nrep; ++rep) { GB; phase_11(P, lds, 19); GB; } }
#endif
    phase_12(P, lds, 20); GB;
#if defined(PROBE_PH) && PROBE_PH == 20
    { int nrep = PROBE_N; asm volatile("" : "+s"(nrep)); for (int rep = 0; rep < nrep; ++rep) { GB; phase_12(P, lds, 20); GB; } }
#endif
    phase_13(P, lds, 21);
#if defined(PROBE_PH) && PROBE_PH == 21
    { int nrep = PROBE_N; asm volatile("" : "+s"(nrep)); for (int rep = 0; rep < nrep; ++rep) { GB; phase_13(P, lds, 21); GB; } }
#endif
#undef P
#undef GB
}

extern "C" void kernel_launch(void* const* d_in, const int* in_sizes, int n_in, void* d_out, int out_size, void* d_ws, size_t ws_size, hipStream_t stream) {
    static int ready = 0;
    if (!ready) {
        if (n_in != 35 || ws_size < WS_TOTAL) { fprintf(stderr, "kernel_launch: unexpected n_in %d or ws_size %zu (need %zu)\n", n_in, ws_size, (size_t)WS_TOTAL); ready = -1; return; }
        if (hipFuncSetAttribute((const void*)mega, hipFuncAttributeMaxDynamicSharedMemorySize, LDS_BYTES) != hipSuccess) { fprintf(stderr, "kernel_launch: hipFuncSetAttribute failed\n"); ready = -1; return; }
        ready = 1;
    }
    if (ready < 0) return;
    (void)hipMemsetAsync((char*)d_ws + WS_CTL, 0, 1 * MiB, stream);
    Params P{};
    for (int i = 0; i < 35; ++i) P.in[i] = (const float*)d_in[i];
    P.out = (float*)d_out; P.ws = (unsigned char*)d_ws; P.ph_lo = 0; P.ph_hi = 0;
    hipLaunchKernelGGL(mega, dim3(GRID), dim3(512), LDS_BYTES, stream, P);
}
```

```cpp
#include <hip/hip_runtime.h>
#include <stdint.h>
#include <stdio.h>

#define DM 1024
#define NB 2
#define SEQ 8192
#define NMETA 16
#define LSEQ (SEQ + NMETA)
#define NMAIN (NB * SEQ)
#define NT (NB * LSEQ)
#define NTP 16640
#define INCOLS 3328
#define RESTC 1792
#define NEXP 32
#define DFF 512
#define S5TC 48
#define S5NC 171
#define MOE_RT 256
#define MOE_MAXROWS 41216

typedef unsigned short bf16_t;
typedef short bf16x8 __attribute__((ext_vector_type(8)));
typedef float f32x4 __attribute__((ext_vector_type(4)));
typedef unsigned u32x4 __attribute__((ext_vector_type(4)));
typedef unsigned u32x2 __attribute__((ext_vector_type(2)));

constexpr size_t MiB = 1u << 20;
constexpr size_t cmax2(size_t a, size_t b) { return a > b ? a : b; }
constexpr size_t al64k(size_t x) { return (x + 65535) & ~(size_t)65535; }
constexpr size_t WS_CTL = 0;
constexpr size_t WS_H = 1 * MiB;
constexpr size_t WS_HN = WS_H + al64k((size_t)NT * DM * 4);
constexpr size_t WS_A2 = WS_HN + al64k((size_t)NTP * DM * 2);
constexpr size_t WS_WTIN = WS_A2 + al64k((size_t)NTP * DM * 2);
constexpr size_t WS_WTOUT = WS_WTIN + al64k((size_t)INCOLS * DM * 2);
constexpr size_t WS_WTGLU = WS_WTOUT + al64k((size_t)DM * DM * 2);
constexpr size_t WS_LRT = WS_WTGLU + al64k((size_t)2 * DM * DM * 2);
constexpr size_t WS_BIG = WS_LRT + al64k((size_t)(2 * 512 * 64 * 2 + 512 * 128) * 2);
constexpr size_t SZ_T512 = al64k((size_t)NT * 512 * 2);
constexpr size_t SZ_P512 = al64k((size_t)NTP * 512 * 2);
constexpr int RW_NCH = 129, RW_UNITS = 32 * RW_NCH;
constexpr size_t SZ_RWOP = al64k((size_t)RW_UNITS * 4096 * 2);
constexpr size_t WS_Q = WS_BIG;
constexpr size_t WS_K = WS_Q + SZ_P512;
constexpr size_t WS_V = WS_K + SZ_P512;
constexpr size_t WS_REST = WS_V + SZ_P512;
constexpr size_t WS_KR = WS_REST + al64k((size_t)NTP * RESTC * 2);
constexpr size_t WS_LOW = WS_KR + SZ_T512;
constexpr size_t WS_AA = WS_LOW + al64k((size_t)NT * 256 * 2);
constexpr size_t WS_XEARLY = WS_AA + 2 * SZ_T512;
constexpr size_t WS_PP = WS_REST;
constexpr size_t WS_QT = WS_PP + SZ_RWOP;
constexpr size_t WS_YT = WS_QT + SZ_RWOP;
constexpr size_t WS_ZT = WS_YT + SZ_RWOP;
constexpr size_t WS_XEND = cmax2(WS_XEARLY, WS_ZT + SZ_RWOP);
constexpr size_t WS_R = WS_XEND;
constexpr size_t WS_VV = WS_R + SZ_T512;
constexpr size_t WS_G = WS_VV + SZ_T512;
constexpr size_t WS_KK = WS_G + SZ_T512;
constexpr size_t WS_KKA = WS_KK + SZ_T512;
constexpr size_t WS_KD = WS_KKA + 2 * SZ_T512;
constexpr size_t WS_W = WS_KD + 2 * SZ_T512;
constexpr size_t WS_BC = WS_W + 2 * SZ_T512;
constexpr size_t WS_MIXEND = WS_BC + al64k((size_t)NT * 8 * 4);
constexpr size_t WS_YFB = WS_KK;
constexpr size_t WS_ROWTOK = WS_BIG;
constexpr size_t WS_HB = WS_ROWTOK + al64k((size_t)MOE_MAXROWS * 4);
constexpr size_t WS_YB = WS_HB + al64k((size_t)MOE_MAXROWS * DFF * 2);
constexpr size_t WS_WT13 = WS_YB + al64k((size_t)MOE_MAXROWS * DM * 2);
constexpr size_t WS_WT2 = WS_WT13 + al64k((size_t)NEXP * DM * DM * 2);
constexpr size_t WS_EID = WS_WT2 + al64k((size_t)NEXP * DM * DFF * 2);
constexpr size_t WS_POS = WS_EID + al64k((size_t)NT * 8);
constexpr size_t WS_DEST = WS_POS + al64k((size_t)NT * 8);
constexpr size_t WS_GATE = WS_DEST + al64k((size_t)NT * 8);
constexpr size_t WS_MOEEND = WS_GATE + al64k((size_t)NT * 8);
constexpr size_t WS_YI = WS_BIG;
constexpr size_t WS_E = WS_YI + al64k((size_t)NTP * DM * 2);
constexpr size_t WS_CAR = WS_E + al64k((size_t)1040 * 64 * 256 * 2);
constexpr size_t WS_BTA = WS_CAR + al64k((size_t)64 * 1280 * 256 * 2);
constexpr size_t WS_BTC = WS_BTA + al64k((size_t)64 * 512 * 256 * 2);
constexpr size_t WS_S5END = WS_BTC + al64k((size_t)64 * 256 * 256 * 2);
constexpr size_t cmax(size_t a, size_t b) { return a > b ? a : b; }
constexpr size_t WS_TOTAL = cmax(WS_MIXEND, cmax(WS_MOEEND, WS_S5END));
static_assert(WS_TOTAL <= 512 * MiB, "workspace map exceeds 512 MiB");

#define CW_CNT(l) (1024 + 64 * (l))

#define LDS_BYTES 163840
#define LDS_BARST (LDS_BYTES - 1024)
#define LDS_TAB (LDS_BYTES - 768)
#define LDS_RING (LDS_BYTES - 1024)
#define GRID 256

struct Params {
    const float* in[35];
    float* out;
    unsigned char* ws;
    int ph_lo, ph_hi;
};
typedef const __attribute__((address_space(4))) Params CParams;

__device__ __forceinline__ float bf2f(bf16_t v) { return __uint_as_float(((unsigned)v) << 16); }
typedef float f32x2c_ __attribute__((ext_vector_type(2)));
typedef __bf16 bf16x2c_ __attribute__((ext_vector_type(2)));
__device__ __forceinline__ unsigned pk2(float lo, float hi) { const f32x2c_ f = {lo, hi}; const bf16x2c_ b = __builtin_convertvector(f, bf16x2c_); return __builtin_bit_cast(unsigned, b); }
__device__ __forceinline__ unsigned f2bf(float f) { return (unsigned)__builtin_bit_cast(unsigned short, (__bf16)f); }
__device__ __forceinline__ float bflo(unsigned u) { return __uint_as_float(u << 16); }
__device__ __forceinline__ float bfhi(unsigned u) { return __uint_as_float(u & 0xffff0000u); }
__device__ __forceinline__ float wave_sum(float v) {
#pragma unroll
    for (int o = 1; o < 64; o <<= 1) v += __shfl_xor(v, o);
    return v;
}
__device__ __forceinline__ float wave_max(float v) {
#pragma unroll
    for (int o = 1; o < 64; o <<= 1) v = fmaxf(v, __shfl_xor(v, o));
    return v;
}
template <int CTRL> __device__ __forceinline__ float dppf(float v) { return __int_as_float(__builtin_amdgcn_update_dpp(0, __float_as_int(v), CTRL, 0xF, 0xF, true)); }
__device__ __forceinline__ float row16_sum(float v) { v += dppf<0xB1>(v); v += dppf<0x4E>(v); v += dppf<0x141>(v); v += dppf<0x140>(v); return v; }
__device__ __forceinline__ float sigmoidf_(float x) { return __builtin_amdgcn_rcpf(1.f + __expf(-x)); }
__device__ __forceinline__ int rowof(int b, int p) { return p < NMETA ? NMAIN + b * NMETA + p : b * SEQ + (p - NMETA); }

#define SA_STRIDE 40
template <class AF, class BF>
__device__ __forceinline__ void gemm_tile(unsigned char* lds, int K, int ldb, const AF& arow, const BF& bcol, f32x4 (&acc)[4][2]) {
    bf16_t* sA = (bf16_t*)lds;
    bf16_t* sB = (bf16_t*)(lds + 128 * SA_STRIDE * 2);
    const int tid = threadIdx.x, lane = tid & 63, wave = tid >> 6, wr = wave >> 2, wc = wave & 3, fr = lane & 15, fq = lane >> 4;
#pragma unroll
    for (int mi = 0; mi < 4; ++mi)
#pragma unroll
        for (int ni = 0; ni < 2; ++ni) acc[mi][ni] = (f32x4){0.f, 0.f, 0.f, 0.f};
    const int ar = tid >> 2, akc = (tid & 3) * 8;
    const bf16_t* ap = arow(ar) + akc;
    const int bnq = (tid & 31) * 4, bkp = (tid >> 5) * 2;
    const float* bp = bcol(bnq) + (size_t)bkp * ldb;
    const int nk = K / 32;
    u32x4 ra = *(const u32x4*)ap;
    f32x4 rb0 = *(const f32x4*)bp, rb1 = *(const f32x4*)(bp + ldb);
    for (int kt = 0; kt < nk; ++kt) {
        __syncthreads();
        *(u32x4*)(sA + ar * SA_STRIDE + akc) = ra;
        {
            unsigned* d = (unsigned*)(sB + bnq * SA_STRIDE + bkp);
            d[0 * (SA_STRIDE / 2)] = pk2(rb0[0], rb1[0]);
            d[1 * (SA_STRIDE / 2)] = pk2(rb0[1], rb1[1]);
            d[2 * (SA_STRIDE / 2)] = pk2(rb0[2], rb1[2]);
            d[3 * (SA_STRIDE / 2)] = pk2(rb0[3], rb1[3]);
        }
        __syncthreads();
        if (kt + 1 < nk) {
            ra = *(const u32x4*)(ap + (kt + 1) * 32);
            const float* q = bp + (size_t)(kt + 1) * 32 * ldb;
            rb0 = *(const f32x4*)q; rb1 = *(const f32x4*)(q + ldb);
        }
        bf16x8 a[4], b[2];
#pragma unroll
        for (int mi = 0; mi < 4; ++mi) a[mi] = *(const bf16x8*)(sA + (wr * 64 + mi * 16 + fr) * SA_STRIDE + fq * 8);
#pragma unroll
        for (int ni = 0; ni < 2; ++ni) b[ni] = *(const bf16x8*)(sB + (wc * 32 + ni * 16 + fr) * SA_STRIDE + fq * 8);
#pragma unroll
        for (int mi = 0; mi < 4; ++mi)
#pragma unroll
            for (int ni = 0; ni < 2; ++ni) acc[mi][ni] = __builtin_amdgcn_mfma_f32_16x16x32_bf16(a[mi], b[ni], acc[mi][ni], 0, 0, 0);
    }
    __syncthreads();
}
#define ACC_FOREACH(acc, ...) do { const int _l = threadIdx.x & 63, _w = threadIdx.x >> 6, _wr = _w >> 2, _wc = _w & 3, _fr = _l & 15, _fq = _l >> 4; \
    _Pragma("unroll") for (int _mi = 0; _mi < 4; ++_mi) _Pragma("unroll") for (int _ni = 0; _ni < 2; ++_ni) _Pragma("unroll") for (int _j = 0; _j < 4; ++_j) { \
        const int rl = _wr * 64 + _mi * 16 + _fq * 4 + _j, cl = _wc * 32 + _ni * 16 + _fr; const float val = acc[_mi][_ni][_j]; __VA_ARGS__ } } while (0)
#define ACC_FOREACH_PAIR(acc, ...) do { const int _l = threadIdx.x & 63, _w = threadIdx.x >> 6, _wr = _w >> 2, _wc = _w & 3, _fr = _l & 15, _fq = _l >> 4; \
    _Pragma("unroll") for (int _mi = 0; _mi < 4; ++_mi) _Pragma("unroll") for (int _j = 0; _j < 4; ++_j) { \
        const int rl = _wr * 64 + _mi * 16 + _fq * 4 + _j, co = _wc * 16 + _fr; const float va = acc[_mi][0][_j], vg = acc[_mi][1][_j]; __VA_ARGS__ } } while (0)

__device__ __forceinline__ void store_norm_bf16(const f32x4 (&v)[4], const float* gain, bf16_t* dst, int lane) {
    float ss = 0.f;
#pragma unroll
    for (int j = 0; j < 4; ++j) ss += v[j][0] * v[j][0] + v[j][1] * v[j][1] + v[j][2] * v[j][2] + v[j][3] * v[j][3];
    ss = wave_sum(ss);
    const float rstd = rsqrtf(ss * (1.f / DM) + 1e-6f);
#pragma unroll
    for (int j = 0; j < 4; ++j) {
        const f32x4 g = ((const f32x4*)gain)[lane + 64 * j];
        u32x2 o; o.x = pk2(v[j][0] * rstd * g[0], v[j][1] * rstd * g[1]); o.y = pk2(v[j][2] * rstd * g[2], v[j][3] * rstd * g[3]);
        ((u32x2*)dst)[lane + 64 * j] = o;
    }
}

namespace pg8 {
#define PG8_LAS __attribute__((address_space(3)))
constexpr int BM = 256, BK = 64, HALF = 128, HTB = HALF * BK * 2  , STAGE_BYTES = 8 * HTB, NXCD = 8, WGM = 8;
__host__ __device__ __forceinline__ int lds_byte(int r, int c) { const int st = (r >> 4) * 2 + (c >> 5), rr = r & 15, cc = c & 31, ob = rr * 64 + cc * 2; return st * 1024 + (ob ^ (((ob >> 9) & 1) << 5)); }
__host__ __device__ __forceinline__ void stage_rc(int b, int& R, int& C) { const int st = b / 1024, sb = b % 1024, swz = sb ^ (((sb >> 9) & 1) << 5); R = (st >> 1) * 16 + swz / 64; C = (st & 1) * 32 + (swz % 64) / 2; }
__host__ __device__ __forceinline__ int perm32(int rho) { const int n = rho >> 4, i = rho & 15; return 8 * (i >> 2) + 4 * n + (i & 3); }

struct Unit { int pm, pn; const char* A; const char* B; };

struct DenseOrder {
    static constexpr bool GATHER_ROWS = false;
    static constexpr bool GATHER_A = false;
    int nM, nN, nwg, G, c; const char* A; const char* Bt; size_t tstep;
    __device__ void init(const bf16_t* A_, const bf16_t* Bt_, int M, int N, int K, int G_, int c_) { nM = M / BM; nN = N / BM; nwg = nM * nN; G = G_; c = c_; A = (const char*)A_; Bt = (const char*)Bt_; tstep = (size_t)BM * K * 2; }
    __device__ bool next(int i, Unit& u) const {
        const long L = (long)i * G + c; if (L >= nwg) return false;
        int wgid = (int)L; { const int q = nwg / NXCD, r = nwg % NXCD, xcd = wgid % NXCD, off = wgid / NXCD; wgid = (xcd < r ? xcd * (q + 1) : r * (q + 1) + (xcd - r) * q) + off; }
        const int nig = WGM * nN, gid = wgid / nig, fm = gid * WGM, gsz = (nM - fm) < WGM ? (nM - fm) : WGM;
        u.pm = fm + ((wgid % nig) % gsz); u.pn = (wgid % nig) / gsz; u.A = A + (size_t)u.pm * tstep; u.B = Bt + (size_t)u.pn * tstep; return true;
    }
    __device__ __forceinline__ void a_ready(const Unit&) const {}
    __device__ __forceinline__ void done(const Unit&) const {}
};
struct ProjOrder {
    static constexpr bool GATHER_ROWS = false;
    static constexpr bool GATHER_A = false;
    DenseOrder D; const char* HNp; const char* WT;
    __device__ void init(const bf16_t* HN_, const bf16_t* WT_, int c_) { D.init(HN_, WT_, NTP, 13 * BM, DM, GRID, c_); HNp = (const char*)HN_; WT = (const char*)WT_; }
    __device__ bool next(int i, Unit& u) const {
        if (!D.next(i, u)) return false;
        const size_t ts = (size_t)BM * DM * 2;
        if (u.pn < 11) { const int wrow = u.pn < 4 ? u.pn : u.pn + 2; u.A = HNp + (size_t)u.pm * ts; u.B = WT + (size_t)wrow * ts; }
        else { u.A = WT + (size_t)(4 + (u.pn - 11)) * ts; u.B = HNp + (size_t)u.pm * ts; }
        return true;
    }
    __device__ __forceinline__ void a_ready(const Unit&) const {}
    __device__ __forceinline__ void done(const Unit&) const {}
};
template <bool GATHER> struct MoeOrder {
    static constexpr bool GATHER_ROWS = GATHER;
    static constexpr bool GATHER_A = false;
    const int* et; int TT, vcu; const char* A; const char* Bt; unsigned tstepA, tstepB, estep; const int* rowidx;
    __device__ __forceinline__ bool next(int i, Unit& u) const {
        const int L = i * GRID + vcu; if (L >= TT * 4) return false;
        const int rt = L >> 2, ct = L & 3, e = et[rt];
        u.pm = rt; u.pn = ct; u.A = GATHER ? A : A + (size_t)rt * tstepA; u.B = Bt + (size_t)e * estep + (size_t)ct * tstepB; return true;
    }
    __device__ __forceinline__ void a_ready(const Unit&) const {}
    __device__ __forceinline__ void done(const Unit&) const {}
};

struct S5OrderA {
    static constexpr bool GATHER_ROWS = false;
    static constexpr bool GATHER_A = true;
    int vcu; const char* U; const char* BTA;
    __device__ __forceinline__ bool next(int i, Unit& u) const {
        const int L = i * GRID + vcu; if (L >= 640) return false;
        const int g = L / 10, rem = L - g * 10, mt = rem >> 1, nt = rem & 1;
        u.pm = mt; u.pn = g * 2 + nt; u.A = U + ((size_t)mt * 256 * 16 * 1024 + g * 16) * 2; u.B = BTA + ((size_t)(g * 512 + nt * 256) * 256) * 2; return true;
    }
    __device__ __forceinline__ void a_ready(const Unit&) const {}
    __device__ __forceinline__ void done(const Unit&) const {}
};
struct S5OrderC {
    static constexpr bool GATHER_ROWS = false;
    static constexpr bool GATHER_A = false;
    int vcu; const char* CAR; const char* BTC;
    __device__ __forceinline__ bool next(int i, Unit& u) const {
        const int L = i * GRID + vcu; if (L >= 320) return false;
        const int g = L / 5, mt = L - g * 5;
        u.pm = mt; u.pn = g; u.A = CAR + ((size_t)(g * 1280 + mt * 256) * 256) * 2; u.B = BTC + ((size_t)g * 256 * 256) * 2; return true;
    }
    __device__ __forceinline__ void a_ready(const Unit&) const {}
    __device__ __forceinline__ void done(const Unit&) const {}
};
__device__ __forceinline__ unsigned cvt_pk_bf16(float lo, float hi) { return pk2(lo, hi); }

struct EpiProj {
    static constexpr bool PERM = true, AFTER_DRAIN = false;
    bf16_t *Q, *Kk, *VT, *REST;
    __device__ __forceinline__ void operator()(const f32x4 (&acc)[2][2][4][2], const Unit& u, int wr, int wc, int fr, int fq) const {
        bf16_t* base; int ldc; int row0, col0;
        if (u.pn < 11) { row0 = u.pm * BM + wr * 64 + fr; int colt;
            if (u.pn < 2) { base = Q; colt = u.pn * BM; ldc = 512; } else if (u.pn < 4) { base = Kk; colt = (u.pn - 2) * BM; ldc = 512; } else { base = REST; colt = (u.pn - 4) * BM; ldc = RESTC; }
            col0 = colt + wc * 32 + 8 * fq; }
        else { base = VT; ldc = NTP; row0 = (u.pn - 11) * BM + wr * 64 + fr; col0 = u.pm * BM + wc * 32 + 8 * fq; }
#pragma unroll
        for (int ai = 0; ai < 2; ++ai)
#pragma unroll
            for (int m = 0; m < 4; ++m) { bf16_t* rowp = base + (size_t)(row0 + ai * HALF + m * 16) * ldc + col0;
#pragma unroll
                for (int bj = 0; bj < 2; ++bj) { const f32x4 v0 = acc[ai][bj][m][0], v1 = acc[ai][bj][m][1];
                    u32x4 w; w.x = cvt_pk_bf16(v0[0], v0[1]); w.y = cvt_pk_bf16(v0[2], v0[3]); w.z = cvt_pk_bf16(v1[0], v1[1]); w.w = cvt_pk_bf16(v1[2], v1[3]);
                    *(u32x4*)(rowp + bj * HALF) = w; } }
    }
};
struct EpiBf16Plain {
    static constexpr bool PERM = true, AFTER_DRAIN = false;
    bf16_t* O; int ldc;
    __device__ __forceinline__ void operator()(const f32x4 (&acc)[2][2][4][2], const Unit& u, int wr, int wc, int fr, int fq) const {
        const int row0 = u.pm * BM + wr * 64 + fr; const int col0 = u.pn * BM + wc * 32 + 8 * fq;
#pragma unroll
        for (int ai = 0; ai < 2; ++ai)
#pragma unroll
            for (int m = 0; m < 4; ++m) { bf16_t* rowp = O + (size_t)(row0 + ai * HALF + m * 16) * ldc + col0;
#pragma unroll
                for (int bj = 0; bj < 2; ++bj) { const f32x4 v0 = acc[ai][bj][m][0], v1 = acc[ai][bj][m][1];
                    u32x4 w; w.x = cvt_pk_bf16(v0[0], v0[1]); w.y = cvt_pk_bf16(v0[2], v0[3]); w.z = cvt_pk_bf16(v1[0], v1[1]); w.w = cvt_pk_bf16(v1[2], v1[3]);
                    *(u32x4*)(rowp + bj * HALF) = w; } }
    }
};
struct EpiSwiglu {
    static constexpr bool PERM = true, AFTER_DRAIN = false;
    bf16_t* O;
    __device__ __forceinline__ void operator()(const f32x4 (&acc)[2][2][4][2], const Unit& u, int wr, int wc, int fr, int fq) const {
        const int row0 = u.pm * BM + wr * 64 + fr; const int col0 = u.pn * HALF + wc * 32 + 8 * fq;
#pragma unroll
        for (int ai = 0; ai < 2; ++ai)
#pragma unroll
            for (int m = 0; m < 4; ++m) {
                float o[8];
#pragma unroll
                for (int n = 0; n < 2; ++n)
#pragma unroll
                    for (int i = 0; i < 4; ++i) { const float va = acc[ai][0][m][n][i], vg = acc[ai][1][m][n][i]; o[4 * n + i] = va * __builtin_amdgcn_rcpf(1.f + __expf(-va)) * vg; }
                u32x4 w; w.x = cvt_pk_bf16(o[0], o[1]); w.y = cvt_pk_bf16(o[2], o[3]); w.z = cvt_pk_bf16(o[4], o[5]); w.w = cvt_pk_bf16(o[6], o[7]);
                *(u32x4*)(O + (size_t)(row0 + ai * HALF + m * 16) * DFF + col0) = w; }
    }
};
struct EpiResidual {
    static constexpr bool PERM = false, AFTER_DRAIN = false;
    float* Hh;
    __device__ __forceinline__ void operator()(const f32x4 (&acc)[2][2][4][2], const Unit& u, int wr, int wc, int fr, int fq) const {
        const int row0 = u.pm * BM + wr * 64 + fr; const int col0 = u.pn * BM + wc * 32 + 4 * fq;
#pragma unroll
        for (int ai = 0; ai < 2; ++ai)
#pragma unroll
            for (int m = 0; m < 4; ++m) { float* rowp = Hh + (size_t)(row0 + ai * HALF + m * 16) * DM + col0;
#pragma unroll
                for (int bj = 0; bj < 2; ++bj)
#pragma unroll
                    for (int n = 0; n < 2; ++n) { f32x4* p = (f32x4*)(rowp + bj * HALF + n * 16); *p = *p + acc[ai][bj][m][n]; } }
    }
};
struct EpiGlu {
    static constexpr bool PERM = false, AFTER_DRAIN = false;
    float* Hh;
    __device__ __forceinline__ void operator()(const f32x4 (&acc)[2][2][4][2], const Unit& u, int wr, int wc, int fr, int fq) const {
        const int row0 = u.pm * BM + wr * 64 + fr; const int col0 = u.pn * HALF + wc * 32 + 4 * fq;
#pragma unroll
        for (int ai = 0; ai < 2; ++ai)
#pragma unroll
            for (int m = 0; m < 4; ++m) { float* rowp = Hh + (size_t)(row0 + ai * HALF + m * 16) * DM + col0;
#pragma unroll
                for (int n = 0; n < 2; ++n) { f32x4* p = (f32x4*)(rowp + n * 16); f32x4 hv = *p; const f32x4 va = acc[ai][0][m][n], vg = acc[ai][1][m][n];
#pragma unroll
                    for (int i = 0; i < 4; ++i) hv[i] += va[i] * __builtin_amdgcn_rcpf(1.f + __expf(-vg[i]));
                    *p = hv; } }
    }
};

struct EpiS5A {
    static constexpr bool PERM = true, AFTER_DRAIN = false;
    bf16_t* YI; bf16_t* E;
    __device__ __forceinline__ void operator()(const f32x4 (&acc)[2][2][4][2], const Unit& u, int wr, int wc, int fr, int fq) const {
        const int g = u.pn >> 1, nt = u.pn & 1;
        const int cl0 = wc * 32 + 8 * fq;
        bf16_t* base = nt == 0 ? YI + (size_t)(cl0 >> 4) * DM + g * 16 + (cl0 & 15) : E + (size_t)g * 256 + cl0;
        const size_t nstride = 16 * DM;
        const size_t bjstep = nt == 0 ? (size_t)8 * DM : (size_t)HALF;
#pragma unroll
        for (int ai = 0; ai < 2; ++ai)
#pragma unroll
            for (int m = 0; m < 4; ++m) { int n = u.pm * BM + ai * HALF + wr * 64 + m * 16 + fr; n = n < 1039 ? n : 1039;
                bf16_t* p = base + (size_t)n * nstride;
#pragma unroll
                for (int bj = 0; bj < 2; ++bj) { const f32x4 v0 = acc[ai][bj][m][0], v1 = acc[ai][bj][m][1];
                    u32x4 w; w.x = cvt_pk_bf16(v0[0], v0[1]); w.y = cvt_pk_bf16(v0[2], v0[3]); w.z = cvt_pk_bf16(v1[0], v1[1]); w.w = cvt_pk_bf16(v1[2], v1[3]);
                    *(u32x4*)(p + bj * bjstep) = w; } }
    }
};
struct EpiS5C {
    static constexpr bool PERM = true, AFTER_DRAIN = false;
    const bf16_t* YI; const bf16_t* Uu; const float* dvec; bf16_t* O;
    __device__ __forceinline__ void operator()(const f32x4 (&acc)[2][2][4][2], const Unit& u, int wr, int wc, int fr, int fq) const {
        const int g = u.pn;
        const int cl0 = wc * 32 + 8 * fq, ch = g * 16 + (cl0 & 15);
        const size_t off0 = (size_t)(cl0 >> 4) * DM + ch;
        const f32x4 d0 = *(const f32x4*)(dvec + ch), d1 = *(const f32x4*)(dvec + ch + 4);
#pragma unroll
        for (int ai = 0; ai < 2; ++ai)
#pragma unroll
            for (int m = 0; m < 4; ++m) { int n = u.pm * BM + ai * HALF + wr * 64 + m * 16 + fr; n = n < 1039 ? n : 1039;
#pragma unroll
                for (int bj = 0; bj < 2; ++bj) {
                    const size_t off = off0 + (size_t)n * (16 * DM) + (size_t)bj * (8 * DM);
                    const u32x4 yv = *(const u32x4*)(YI + off);
                    const f32x4 y0 = (f32x4){__uint_as_float(yv[0] << 16), __uint_as_float(yv[0] & 0xffff0000u), __uint_as_float(yv[1] << 16), __uint_as_float(yv[1] & 0xffff0000u)},
                                y1 = (f32x4){__uint_as_float(yv[2] << 16), __uint_as_float(yv[2] & 0xffff0000u), __uint_as_float(yv[3] << 16), __uint_as_float(yv[3] & 0xffff0000u)};
                    const u32x4 uv = *(const u32x4*)(Uu + off);
                    float y[8];
#pragma unroll
                    for (int q = 0; q < 4; ++q) { y[q] = acc[ai][bj][m][0][q] + y0[q] + d0[q] * (q & 1 ? __uint_as_float(uv[q >> 1] & 0xffff0000u) : __uint_as_float(uv[q >> 1] << 16));
                        y[4 + q] = acc[ai][bj][m][1][q] + y1[q] + d1[q] * (q & 1 ? __uint_as_float(uv[2 + (q >> 1)] & 0xffff0000u) : __uint_as_float(uv[2 + (q >> 1)] << 16)); }
#pragma unroll
                    for (int q = 0; q < 8; ++q) { const float z = 1.5957691216f * (y[q] + 0.044715f * y[q] * y[q] * y[q]); y[q] = y[q] * __builtin_amdgcn_rcpf(1.f + __expf(-z)); }
                    u32x4 w; w.x = cvt_pk_bf16(y[0], y[1]); w.y = cvt_pk_bf16(y[2], y[3]); w.z = cvt_pk_bf16(y[4], y[5]); w.w = cvt_pk_bf16(y[6], y[7]);
                    *(u32x4*)(O + off) = w; }
                asm volatile("" ::: "memory"); }
    }
};

template <class Epi, class Sched, bool ALIGN_EPI = false, bool SP2 = false>
__device__ __forceinline__ void gemm_phase(PG8_LAS unsigned char* lds, const int K, const Sched& S, const Epi& E) {
    int tid_ = threadIdx.x; asm volatile("" : "+v"(tid_));
    const int tid = tid_, wid = __builtin_amdgcn_readfirstlane(tid >> 6), lane = tid & 63, wr = wid >> 2, wc = wid & 3, fr = lane & 15, fq = lane >> 4;
    const int nt = K / BK;
    unsigned vA0[2], vA1[2], nA0[2], nA1[2], voffB[2];
#pragma unroll
    for (int i = 0; i < 2; ++i) { int R, C; stage_rc(tid * 16 + i * 8192, R, C); const int Rb = Epi::PERM ? ((R & ~31) + perm32(R & 31)) : R;
        vA0[i] = Sched::GATHER_A ? (unsigned)(((16 * R + (C >> 4)) * 1024 + (C & 15)) * 2) : (unsigned)(R * K + C) * 2u; voffB[i] = (unsigned)(Rb * K + C) * 2u; }
    const size_t kstep = (size_t)(BK * 2);
    const size_t hstep = (size_t)HALF * K * 2;
    const size_t kstepA = Sched::GATHER_A ? (size_t)(4 * 1024 * 2) : kstep, hstepA = Sched::GATHER_A ? (size_t)HALF * 16 * 1024 * 2 : hstep;
#define PG8_ROWOFFS(u_, d0_, d1_) do { _Pragma("unroll") for (int i_ = 0; i_ < 2; ++i_) { int R_, C_; stage_rc(tid * 16 + i_ * 8192, R_, C_); \
        d0_[i_] = (unsigned)(S.rowidx[(u_).pm * BM + R_] * K + C_) * 2u; d1_[i_] = (unsigned)(S.rowidx[(u_).pm * BM + HALF + R_] * K + C_) * 2u; } } while (0)
#define PG8_STAGE_A(bufoff, gbase, h_, nx_) do { _Pragma("unroll") for (int _i = 0; _i < 2; ++_i) { const unsigned vo_ = (nx_) ? ((h_) ? nA1[_i] : nA0[_i]) : ((h_) ? vA1[_i] : vA0[_i]); \
        __builtin_amdgcn_global_load_lds((const unsigned*)((const char*)(gbase) + vo_), (PG8_LAS unsigned*)(lds + (bufoff) + ldsw + _i * 8192), 16, 0, 0); } } while (0)
    const unsigned ldsw = (unsigned)wid * 1024u;
    const int aoff = lds_byte(wr * 64 + fr, fq * 8), boff = lds_byte(wc * 32 + fr, fq * 8);
#define PG8_SA(b, h) (((b) * 2 + (h)) * HTB)
#define PG8_SB(b, h) ((4 + (b) * 2 + (h)) * HTB)
#define PG8_STAGE(bufoff, gbase, voff) do { _Pragma("unroll") for (int _i = 0; _i < 2; ++_i) \
        __builtin_amdgcn_global_load_lds((const unsigned*)((const char*)(gbase) + (voff)[_i]), (PG8_LAS unsigned*)(lds + (bufoff) + ldsw + _i * 8192), 16, 0, 0); } while (0)
#define PG8_LDA(dst, b, h) do { _Pragma("unroll") for (int m = 0; m < 4; ++m) _Pragma("unroll") for (int k = 0; k < 2; ++k) dst[m][k] = *(const PG8_LAS bf16x8*)(lds + PG8_SA(b, h) + aoff + m * 2048 + k * 1024); } while (0)
#define PG8_LDB(dst, b, h) do { _Pragma("unroll") for (int n = 0; n < 2; ++n) _Pragma("unroll") for (int k = 0; k < 2; ++k) dst[n][k] = *(const PG8_LAS bf16x8*)(lds + PG8_SB(b, h) + boff + n * 2048 + k * 1024); } while (0)
#define PG8_MMA(ai, bj, At, Bt) do { __builtin_amdgcn_s_setprio(1); _Pragma("unroll") for (int m = 0; m < 4; ++m) _Pragma("unroll") for (int n = 0; n < 2; ++n) _Pragma("unroll") for (int k = 0; k < 2; ++k) \
        acc[ai][bj][m][n] = __builtin_amdgcn_mfma_f32_16x16x32_bf16(Bt[n][k], At[m][k], acc[ai][bj][m][n], 0, 0, 0); __builtin_amdgcn_s_setprio(0); } while (0)
#define PG8_WAIT_V(n) asm volatile("s_waitcnt vmcnt(" #n ")" ::: "memory")
#define PG8_WAIT_L(n) asm volatile("s_waitcnt lgkmcnt(" #n ")" ::: "memory")
#define PG8_BAR __builtin_amdgcn_s_barrier()
#define PG8_SCHED __builtin_amdgcn_sched_barrier(0)
    Unit cur, nxt; int ui = 0;
    if (!S.next(0, cur)) return;
    f32x4 acc[2][2][4][2];
#pragma unroll
    for (int a = 0; a < 2; ++a)
#pragma unroll
        for (int b = 0; b < 2; ++b)
#pragma unroll
            for (int m = 0; m < 4; ++m)
#pragma unroll
                for (int n = 0; n < 2; ++n) acc[a][b][m][n] = (f32x4){0.f, 0.f, 0.f, 0.f};
    bf16x8 At[4][2], B0[2][2], B1[2][2];
    const char* cA = cur.A; const char* cB = cur.B;
    if constexpr (Sched::GATHER_ROWS) { PG8_ROWOFFS(cur, vA0, vA1); }
    else {
#pragma unroll
        for (int i = 0; i < 2; ++i) vA1[i] = vA0[i] + (unsigned)hstepA;
    }
#pragma unroll
    for (int i = 0; i < 2; ++i) { nA0[i] = vA0[i]; nA1[i] = vA1[i]; }
    S.a_ready(cur);
    if constexpr (SP2) {
        PG8_STAGE(PG8_SB(0, 0), cB, voffB); PG8_STAGE(PG8_SB(0, 1), cB + hstep, voffB); PG8_STAGE_A(PG8_SA(0, 0), cA, 0, false); PG8_STAGE_A(PG8_SA(0, 1), cA, 1, false);
        if (wr == 1) PG8_BAR;
        PG8_WAIT_V(2); PG8_BAR;
        PG8_STAGE(PG8_SB(1, 0), cB + kstep, voffB); PG8_STAGE_A(PG8_SA(1, 0), cA + kstepA, 0, false); PG8_STAGE(PG8_SB(1, 1), cB + hstep + kstep, voffB);
        PG8_WAIT_V(6); PG8_BAR;
    } else {
        PG8_STAGE(PG8_SB(0, 0), cB, voffB); PG8_STAGE_A(PG8_SA(0, 0), cA, 0, false); PG8_STAGE(PG8_SB(0, 1), cB + hstep, voffB); PG8_STAGE_A(PG8_SA(0, 1), cA, 1, false);
        if (wr == 1) PG8_BAR;
        PG8_WAIT_V(4); PG8_BAR;
        PG8_STAGE(PG8_SB(1, 0), cB + kstep, voffB); PG8_STAGE_A(PG8_SA(1, 0), cA + kstepA, 0, false); PG8_STAGE(PG8_SB(1, 1), cB + hstep + kstep, voffB);
        PG8_WAIT_V(6); PG8_BAR;
    }
    for (;;) {
        const bool has_next = S.next(ui + 1, nxt);
        if constexpr (Sched::GATHER_ROWS) { if (has_next) PG8_ROWOFFS(nxt, nA0, nA1); }
        const char* nA = has_next ? nxt.A : cA; const char* nB = has_next ? nxt.B : cB;
        for (int t = 0; t < nt; t += 2) {
            const bool last = (t == nt - 2);
            const char* a1 = cA + (size_t)(t + 1) * kstepA;
            const char* a2 = last ? nA : cA + (size_t)(t + 2) * kstepA; const char* b2 = last ? nB : cB + (size_t)(t + 2) * kstep;
            const char* a3 = a2 + kstepA; const char* b3 = b2 + kstep;
            if (last && has_next) S.a_ready(nxt);
            if constexpr (SP2) {
            PG8_LDB(B0, 0, 0); PG8_LDB(B1, 0, 1); PG8_SCHED; PG8_LDA(At, 0, 0); PG8_STAGE_A(PG8_SA(1, 1), a1, 1, false);
            PG8_WAIT_V(8); PG8_WAIT_L(0); PG8_BAR; PG8_MMA(0, 0, At, B0); PG8_MMA(0, 1, At, B1); PG8_BAR; PG8_SCHED;
            PG8_LDA(At, 0, 1); PG8_STAGE(PG8_SB(0, 0), b2, voffB); PG8_STAGE(PG8_SB(0, 1), b2 + hstep, voffB); PG8_STAGE_A(PG8_SA(0, 0), a2, 0, last);
            PG8_WAIT_V(8); PG8_WAIT_L(0); PG8_BAR; PG8_MMA(1, 0, At, B0); PG8_MMA(1, 1, At, B1); PG8_BAR; PG8_SCHED;
            PG8_LDB(B0, 1, 0); PG8_LDB(B1, 1, 1); PG8_SCHED; PG8_LDA(At, 1, 0); PG8_STAGE_A(PG8_SA(0, 1), a2, 1, last);
            PG8_WAIT_V(8); PG8_WAIT_L(0); PG8_BAR; PG8_MMA(0, 0, At, B0); PG8_MMA(0, 1, At, B1); PG8_BAR; PG8_SCHED;
            PG8_LDA(At, 1, 1); PG8_STAGE(PG8_SB(1, 0), b3, voffB); PG8_STAGE(PG8_SB(1, 1), b3 + hstep, voffB); PG8_STAGE_A(PG8_SA(1, 0), a3, 0, last);
            PG8_WAIT_V(8); PG8_WAIT_L(0); PG8_BAR; PG8_MMA(1, 0, At, B0); PG8_MMA(1, 1, At, B1); PG8_BAR; PG8_SCHED;
            } else {
            PG8_LDB(B0, 0, 0); PG8_SCHED; PG8_LDA(At, 0, 0); PG8_STAGE_A(PG8_SA(1, 1), a1, 1, false);
            PG8_WAIT_L(8); PG8_BAR; PG8_WAIT_L(0); PG8_MMA(0, 0, At, B0); PG8_BAR; PG8_SCHED;
            PG8_LDB(B1, 0, 1); PG8_STAGE(PG8_SB(0, 0), b2, voffB);
            PG8_BAR; PG8_WAIT_L(0); PG8_MMA(0, 1, At, B1); PG8_BAR;
            PG8_LDA(At, 0, 1); PG8_STAGE_A(PG8_SA(0, 0), a2, 0, last);
            PG8_BAR; PG8_WAIT_L(0); PG8_MMA(1, 0, At, B0); PG8_BAR; PG8_SCHED;
            PG8_STAGE(PG8_SB(0, 1), b2 + hstep, voffB);
            PG8_WAIT_V(6); PG8_BAR; PG8_MMA(1, 1, At, B1); PG8_BAR;
            PG8_LDB(B0, 1, 0); PG8_SCHED; PG8_LDA(At, 1, 0); PG8_STAGE_A(PG8_SA(0, 1), a2, 1, last);
            PG8_WAIT_L(8); PG8_BAR; PG8_WAIT_L(0); PG8_MMA(0, 0, At, B0); PG8_BAR; PG8_SCHED;
            PG8_LDB(B1, 1, 1); PG8_STAGE(PG8_SB(1, 0), b3, voffB);
            PG8_BAR; PG8_WAIT_L(0); PG8_MMA(0, 1, At, B1); PG8_BAR;
            PG8_LDA(At, 1, 1); PG8_STAGE_A(PG8_SA(1, 0), a3, 0, last);
            PG8_BAR; PG8_WAIT_L(0); PG8_MMA(1, 0, At, B0); PG8_BAR; PG8_SCHED;
            PG8_STAGE(PG8_SB(1, 1), b3 + hstep, voffB);
            PG8_WAIT_V(6); PG8_BAR; PG8_MMA(1, 1, At, B1); PG8_BAR;
            }
        }
        if constexpr (ALIGN_EPI) { if (wr == 0) PG8_BAR; }
        if constexpr (!Epi::AFTER_DRAIN) { E(acc, cur, wr, wc, fr, fq); S.done(cur); }
        if (!has_next) break;
#pragma unroll
        for (int a = 0; a < 2; ++a)
#pragma unroll
            for (int b = 0; b < 2; ++b)
#pragma unroll
                for (int m = 0; m < 4; ++m)
#pragma unroll
                    for (int n = 0; n < 2; ++n) acc[a][b][m][n] = (f32x4){0.f, 0.f, 0.f, 0.f};
        cur = nxt; cA = nA; cB = nB; ++ui;
        if constexpr (Sched::GATHER_ROWS) {
#pragma unroll
            for (int i = 0; i < 2; ++i) { vA0[i] = nA0[i]; vA1[i] = nA1[i]; } }
        if constexpr (ALIGN_EPI) { if (wr == 1) PG8_BAR; }
    }
    PG8_WAIT_V(0);
    if constexpr (!ALIGN_EPI) { if (wr == 0) PG8_BAR; }
    PG8_BAR;
    if constexpr (Epi::AFTER_DRAIN) { E.fused(acc, cur, wr, wc, fr, fq, lds, wid, lane); S.done(cur); }
#undef PG8_SA
#undef PG8_SB
#undef PG8_STAGE
#undef PG8_STAGE_A
#undef PG8_ROWOFFS
#undef PG8_LDA
#undef PG8_LDB
#undef PG8_MMA
#undef PG8_WAIT_V
#undef PG8_WAIT_L
#undef PG8_BAR
#undef PG8_SCHED
}
}

#define PHASE_PROLOGUE \
    int tid_ = threadIdx.x; asm volatile("" : "+v"(tid_)); const int tid = tid_, lane = tid & 63, wave = tid >> 6; \
    const int G = GRID, bid = blockIdx.x; \
    const int gw = bid * 8 + wave, NGW = G * 8; \
    unsigned char* ws = P.ws; \
    float* H = (float*)(ws + WS_H); \
    bf16_t* HN = (bf16_t*)(ws + WS_HN); \
    bf16_t* A2 = (bf16_t*)(ws + WS_A2); \
    bf16_t* Qb = (bf16_t*)(ws + WS_Q); bf16_t* Kb = (bf16_t*)(ws + WS_K); bf16_t* Vb = (bf16_t*)(ws + WS_V); \
    bf16_t* REST = (bf16_t*)(ws + WS_REST); \
    bf16_t* YFB = (bf16_t*)(ws + WS_YFB); \
    bf16_t* Rr = (bf16_t*)(ws + WS_R); bf16_t* VV = (bf16_t*)(ws + WS_VV); bf16_t* KK = (bf16_t*)(ws + WS_KK); \
    bf16_t* KKA = (bf16_t*)(ws + WS_KKA); bf16_t* KD = (bf16_t*)(ws + WS_KD); \
    _Float16* LW = (_Float16*)(ws + WS_W); bf16_t* PP = (bf16_t*)(ws + WS_PP); bf16_t* QT = (bf16_t*)(ws + WS_QT); bf16_t* YT = (bf16_t*)(ws + WS_YT); bf16_t* ZT = (bf16_t*)(ws + WS_ZT); \
    bf16_t* Gg = (bf16_t*)(ws + WS_G); bf16_t* KR = (bf16_t*)(ws + WS_KR); bf16_t* LOW = (bf16_t*)(ws + WS_LOW); \
    float* BC = (float*)(ws + WS_BC); \
    bf16_t* AA = (bf16_t*)(ws + WS_AA); \
    bf16_t* HB = (bf16_t*)(ws + WS_HB); bf16_t* YB = (bf16_t*)(ws + WS_YB); \
    int* ROWTOK = (int*)(ws + WS_ROWTOK); int* EID = (int*)(ws + WS_EID); int* POS = (int*)(ws + WS_POS); int* DEST = (int*)(ws + WS_DEST); \
    float* GATE = (float*)(ws + WS_GATE); \
    bf16_t* YI = (bf16_t*)(ws + WS_YI); bf16_t* S5E = (bf16_t*)(ws + WS_E); bf16_t* CAR = (bf16_t*)(ws + WS_CAR); bf16_t* BTA = (bf16_t*)(ws + WS_BTA); bf16_t* BTC = (bf16_t*)(ws + WS_BTC); \
    unsigned* CTL = (unsigned*)(ws + WS_CTL); \
    bf16_t* WTIN = (bf16_t*)(ws + WS_WTIN); bf16_t* WTOUT = (bf16_t*)(ws + WS_WTOUT); bf16_t* WTGLU = (bf16_t*)(ws + WS_WTGLU); bf16_t* WT13 = (bf16_t*)(ws + WS_WT13); bf16_t* WT2 = (bf16_t*)(ws + WS_WT2); \
    const int vcu = (G % 8 == 0) ? (bid % 8) * (G / 8) + bid / 8 : bid; \
    const float* x = P.in[0]; const float* meta = P.in[1]; const float* norm_mix = P.in[2]; const float* norm_ffn = P.in[3]; const float* norm_final = P.in[4]; \
    const float* w_in = P.in[5]; const float* w_out = P.in[6]; const float* rpb = P.in[7]; const float* mu = P.in[8]; \
    const float* w0 = P.in[9]; const float* w_up = P.in[10]; const float* a0 = P.in[11]; const float* a_up = P.in[12]; const float* g_up = P.in[13]; \
    const float* k_k = P.in[14]; const float* k_a = P.in[15]; const float* r_k = P.in[16]; const float* lnx_g = P.in[17]; const float* lnx_b = P.in[18]; \
    const float* s5_b_re = P.in[19]; const float* s5_b_im = P.in[20]; const float* s5_lre = P.in[21]; const float* s5_lim = P.in[22]; const float* s5_ls = P.in[23]; \
    const float* s5_c_re = P.in[24]; const float* s5_c_im = P.in[25]; const float* s5_d = P.in[26]; const float* w_glu = P.in[27]; \
    const float* moe_wg = P.in[28]; const float* moe_bg = P.in[29]; const float* moe_we = P.in[30]; const float* moe_be = P.in[31]; \
    const float* moe_w1 = P.in[32]; const float* moe_w3 = P.in[33]; const float* moe_w2 = P.in[34];


__device__ __forceinline__ void transpose_half(const float* W, int N, int K, int k0, int n0, bf16_t* dstrow0, int lane) {
    const int kb = lane & 7, nq = lane >> 3;
    const float* src = W + (size_t)(k0 + 8 * kb) * N + n0 + 4 * nq;
    f32x4 v[8];
#pragma unroll
    for (int kk = 0; kk < 8; ++kk) v[kk] = *(const f32x4*)(src + (size_t)kk * N);
#pragma unroll
    for (int i = 0; i < 4; ++i) {
        u32x4 o; o.x = pk2(v[0][i], v[1][i]); o.y = pk2(v[2][i], v[3][i]); o.z = pk2(v[4][i], v[5][i]); o.w = pk2(v[6][i], v[7][i]);
        *(u32x4*)(dstrow0 + (size_t)(4 * nq + i) * K + k0 + 8 * kb) = o;
    }
}
__device__ __forceinline__ void transpose_item(const float* W, int N, int K, int k0, int n0, bf16_t* dstrow0, int lane) {
    transpose_half(W, N, K, k0, n0, dstrow0, lane);
    transpose_half(W, N, K, k0, n0 + 32, dstrow0 + (size_t)32 * K, lane);
}
#define CONV_DENSE_ITEMS (832 + 256 + 512 + 48)
__device__ __forceinline__ void conv_dense_item(CParams& P, int it, int lane) {
    unsigned char* ws = P.ws;
    if (it < 832) { const int kb = it / 52, nb = it % 52; transpose_item(P.in[5], INCOLS, DM, kb * 64, nb * 64, (bf16_t*)(ws + WS_WTIN) + (size_t)nb * 64 * DM, lane); return; }
    it -= 832;
    if (it < 256) { const int kb = it / 16, nb = it % 16; transpose_item(P.in[6], DM, DM, kb * 64, nb * 64, (bf16_t*)(ws + WS_WTOUT) + (size_t)nb * 64 * DM, lane); return; }
    it -= 256;
    if (it < 512) { const int kb = it / 32, nb = it % 32, n = nb * 64, half = n >> 10, c = n & 1023, row = (c >> 7) * 256 + half * 128 + (c & 127);
      transpose_item(P.in[27], 2 * DM, DM, kb * 64, n, (bf16_t*)(ws + WS_WTGLU) + (size_t)row * DM, lane); return; }
    it -= 512;
    bf16_t* lrt = (bf16_t*)(ws + WS_LRT);
    if (it < 16) { const int d = it >> 3, nb = it & 7; transpose_item(P.in[10] + (size_t)d * 64 * 512, 512, 64, 0, nb * 64, lrt + ((size_t)d * 512 + nb * 64) * 64, lane); return; }
    it -= 16;
    if (it < 16) { const int d = it >> 3, nb = it & 7; transpose_item(P.in[12] + (size_t)d * 64 * 512, 512, 64, 0, nb * 64, lrt + (size_t)2 * 512 * 64 + ((size_t)d * 512 + nb * 64) * 64, lane); return; }
    it -= 16;
    { const int kb = it >> 3, nb = it & 7; transpose_item(P.in[13], 512, 128, kb * 64, nb * 64, lrt + (size_t)4 * 512 * 64 + (size_t)nb * 64 * 128, lane); }
}
#define CONV_MOE_ITEMS (NEXP * 384)
__device__ __forceinline__ void conv_moe_item(CParams& P, int l, int it, int lane) {
    unsigned char* ws = P.ws;
    const int e = it / 384; int r = it % 384;
    if (r < 256) { const int which = r >> 7; r &= 127; const int kb = r >> 3, nb = r & 7, n = nb * 64, row = (n >> 7) * 256 + which * 128 + (n & 127);
        const float* W = (which ? P.in[33] : P.in[32]) + ((size_t)(l * NEXP + e) * DM) * DFF;
        transpose_item(W, DFF, DM, kb * 64, n, (bf16_t*)(ws + WS_WT13) + ((size_t)e * DM + row) * DM, lane); return; }
    r -= 256;
    { const int kb = r >> 4, nb = r & 15; const float* W = P.in[34] + ((size_t)(l * NEXP + e) * DFF) * DM;
      transpose_item(W, DM, DFF, kb * 64, nb * 64, (bf16_t*)(ws + WS_WT2) + ((size_t)e * DM + nb * 64) * DFF, lane); }
}

template <int MODE>
__device__ __forceinline__ void meta_gemm(const bf16_t* A, const bf16_t* Bt, float* Hrows, int task, int lane) {
    const int fr = lane & 15, fq = lane >> 4, c = task * 16 + fr;
    const bf16_t* b0 = MODE == 0 ? Bt + (size_t)c * DM : Bt + (size_t)((c >> 7) * 256 + (c & 127)) * DM;
    const bf16_t* b1 = b0 + (size_t)128 * DM;
    f32x4 acc0[2], acc1[2];
    acc0[0] = acc0[1] = acc1[0] = acc1[1] = (f32x4){0.f, 0.f, 0.f, 0.f};
#pragma unroll 4
    for (int kt = 0; kt < 32; ++kt) {
        const int ko = kt * 32 + fq * 8;
        const bf16x8 a0 = *(const bf16x8*)(A + (size_t)fr * DM + ko), a1 = *(const bf16x8*)(A + (size_t)(16 + fr) * DM + ko);
        const bf16x8 bv = *(const bf16x8*)(b0 + ko);
        acc0[0] = __builtin_amdgcn_mfma_f32_16x16x32_bf16(a0, bv, acc0[0], 0, 0, 0);
        acc0[1] = __builtin_amdgcn_mfma_f32_16x16x32_bf16(a1, bv, acc0[1], 0, 0, 0);
        if (MODE == 1) { const bf16x8 bg = *(const bf16x8*)(b1 + ko);
            acc1[0] = __builtin_amdgcn_mfma_f32_16x16x32_bf16(a0, bg, acc1[0], 0, 0, 0);
            acc1[1] = __builtin_amdgcn_mfma_f32_16x16x32_bf16(a1, bg, acc1[1], 0, 0, 0); }
    }
#pragma unroll
    for (int mi = 0; mi < 2; ++mi)
#pragma unroll
        for (int j = 0; j < 4; ++j) { float* p = Hrows + (size_t)(mi * 16 + fq * 4 + j) * DM + c;
            if (MODE == 0) *p += acc0[mi][j]; else *p += acc0[mi][j] * __builtin_amdgcn_rcpf(1.f + __expf(-acc1[mi][j])); }
}
__device__ __forceinline__ void phase_0(CParams& P, unsigned char* lds, const int ph) {
    PHASE_PROLOGUE
            for (int row = gw; row < NT; row += NGW) {
                const float* src = row < NMAIN ? x + (size_t)row * DM : meta + (size_t)((row - NMAIN) & 15) * DM;
                f32x4 v[4];
#pragma unroll
                for (int j = 0; j < 4; ++j) { v[j] = ((const f32x4*)src)[lane + 64 * j]; ((f32x4*)(H + (size_t)row * DM))[lane + 64 * j] = v[j]; }
                store_norm_bf16(v, norm_mix, HN + (size_t)row * DM, lane);
            }
    for (int it = gw; it < CONV_DENSE_ITEMS; it += NGW) conv_dense_item(P, it, lane);
}

__device__ __forceinline__ void phase_1(CParams& P, unsigned char* lds, const int ph) {
    PHASE_PROLOGUE
    pg8::ProjOrder S; S.init(HN, WTIN, bid);
    pg8::EpiProj E{Qb, Kb, Vb, REST};
    pg8::gemm_phase<pg8::EpiProj, pg8::ProjOrder, true, true>((PG8_LAS unsigned char*)lds, DM, S, E);
}

__device__ __forceinline__ void na_units(CParams& P, unsigned char* lds, const int first, const int stride) {
    PHASE_PROLOGUE
    float* sb = (float*)lds;
    for (int i = tid; i < 8 * 465; i += 512) sb[i] = rpb[i];
    __syncthreads();
    const bf16_t* VT = Vb;
    const int fr = lane & 15, fq = lane >> 4;
    for (int u = first; u < 8192 + 16; u += stride) {
        const bool metaq = u >= 8192;
        int b, h, r = 0, qb = 0;
        if (!metaq) { qb = u & 3; r = (u >> 2) & 127; h = (u >> 9) & 7; b = u >> 12; } else { const int m = u - 8192; b = m >> 3; h = m & 7; }
        const int c = qb * 16 + fr;
        const int qrow = metaq ? NMAIN + b * NMETA + fr : b * SEQ + r * 64 + c;
        const int R0 = min(max(r - 4, 0), 120), cs = qb == 0 ? 0 : (qb == 1 ? 8 : (qb == 2 ? 24 : 32));
        const int C0 = min(max(c - 8, 0), 48);
        bf16x8 qf0 = *(const bf16x8*)(Qb + (size_t)qrow * 512 + h * 64 + fq * 8), qf1 = *(const bf16x8*)(Qb + (size_t)qrow * 512 + h * 64 + 32 + fq * 8);
        f32x4 sacc[17];
        const f32x4 zero4 = (f32x4){0.f, 0.f, 0.f, 0.f};
        if (!metaq) {
#pragma unroll
            for (int kt = 0; kt < 16; ++kt) {
                const int krow0 = b * SEQ + (R0 + (kt >> 1)) * 64 + cs + 16 * (kt & 1);
                const bf16_t* kp = Kb + (size_t)(krow0 + fr) * 512 + h * 64 + fq * 8;
                const bf16x8 a0 = *(const bf16x8*)kp, a1 = *(const bf16x8*)(kp + 32);
                f32x4 acc = __builtin_amdgcn_mfma_f32_16x16x32_bf16(a0, qf0, zero4, 0, 0, 0);
                sacc[kt] = __builtin_amdgcn_mfma_f32_16x16x32_bf16(a1, qf1, acc, 0, 0, 0);
            }
        } else {
#pragma unroll
            for (int kt = 0; kt < 16; ++kt) sacc[kt] = zero4;
        }
        {
            const bf16_t* kp = Kb + (size_t)(NMAIN + b * NMETA + fr) * 512 + h * 64 + fq * 8;
            const bf16x8 a0 = *(const bf16x8*)kp, a1 = *(const bf16x8*)(kp + 32);
            f32x4 acc = __builtin_amdgcn_mfma_f32_16x16x32_bf16(a0, qf0, zero4, 0, 0, 0);
            sacc[16] = __builtin_amdgcn_mfma_f32_16x16x32_bf16(a1, qf1, acc, 0, 0, 0);
        }
        float mx = -1e30f;
#pragma unroll
        for (int kt = 0; kt < 16; ++kt) {
            const int dr = R0 + (kt >> 1) - r + 7;
#pragma unroll
            for (int j = 0; j < 4; ++j) {
                const int kc = cs + 16 * (kt & 1) + 4 * fq + j;
                const bool inb = !metaq && kc >= C0 && kc < C0 + 16;
                const int dc = min(max(kc - c + 15, 0), 30);
                const float s = inb ? sacc[kt][j] * 0.125f + sb[(h * 15 + dr) * 31 + dc] : -1e30f;
                sacc[kt][j] = s; mx = fmaxf(mx, s);
            }
        }
#pragma unroll
        for (int j = 0; j < 4; ++j) { const float s = sacc[16][j] * 0.125f; sacc[16][j] = s; mx = fmaxf(mx, s); }
        mx = fmaxf(mx, __shfl_xor(mx, 16)); mx = fmaxf(mx, __shfl_xor(mx, 32));
        float sum = 0.f;
#pragma unroll
        for (int kt = 0; kt < 17; ++kt)
#pragma unroll
            for (int j = 0; j < 4; ++j) { const float pv = __expf(sacc[kt][j] - mx); sacc[kt][j] = pv; sum += pv; }
        sum += __shfl_xor(sum, 16); sum += __shfl_xor(sum, 32);
        f32x4 o[4] = {zero4, zero4, zero4, zero4};
        if (!metaq) {
#pragma unroll
            for (int kr = 0; kr < 8; ++kr) {
                union { bf16x8 v; unsigned u[4]; } bf;
                bf.u[0] = pk2(sacc[2 * kr][0], sacc[2 * kr][1]); bf.u[1] = pk2(sacc[2 * kr][2], sacc[2 * kr][3]);
                bf.u[2] = pk2(sacc[2 * kr + 1][0], sacc[2 * kr + 1][1]); bf.u[3] = pk2(sacc[2 * kr + 1][2], sacc[2 * kr + 1][3]);
                const size_t tok0 = (size_t)b * SEQ + (R0 + kr) * 64 + cs + 4 * fq;
#pragma unroll
                for (int dt = 0; dt < 4; ++dt) {
                    const bf16_t* vp = VT + (size_t)(h * 64 + dt * 16 + fr) * NTP + tok0;
                    union { bf16x8 v; u32x2 h2[2]; } af;
                    af.h2[0] = *(const u32x2*)vp; af.h2[1] = *(const u32x2*)(vp + 16);
                    o[dt] = __builtin_amdgcn_mfma_f32_16x16x32_bf16(af.v, bf.v, o[dt], 0, 0, 0);
                }
            }
        }
        {
            union { bf16x8 v; unsigned u[4]; } bf;
            bf.u[0] = pk2(sacc[16][0], sacc[16][1]); bf.u[1] = pk2(sacc[16][2], sacc[16][3]); bf.u[2] = 0u; bf.u[3] = 0u;
            const size_t tokm = (size_t)NMAIN + b * NMETA + 4 * fq;
#pragma unroll
            for (int dt = 0; dt < 4; ++dt) {
                const bf16_t* vp = VT + (size_t)(h * 64 + dt * 16 + fr) * NTP + tokm;
                union { bf16x8 v; u32x2 h2[2]; } af;
                af.h2[0] = *(const u32x2*)vp; af.h2[1] = (u32x2){0u, 0u};
                o[dt] = __builtin_amdgcn_mfma_f32_16x16x32_bf16(af.v, bf.v, o[dt], 0, 0, 0);
            }
        }
        const float inv = 1.f / sum;
#pragma unroll
        for (int dt = 0; dt < 4; ++dt) {
            u32x2 ov; ov.x = pk2(o[dt][0] * inv, o[dt][1] * inv); ov.y = pk2(o[dt][2] * inv, o[dt][3] * inv);
            *(u32x2*)(A2 + (size_t)qrow * DM + h * 64 + dt * 16 + 4 * fq) = ov;
        }
    }
    __syncthreads();
}

__device__ __forceinline__ void phase_3(CParams& P, unsigned char* lds, const int ph) {
    PHASE_PROLOGUE
            for (int tk = gw; tk < NT; tk += NGW) {
                const int b = tk / LSEQ, p = tk % LSEQ, row = rowof(b, p);
                const bool hp = p > 0, hn = p + 1 < LSEQ;
                const int rowp = hp ? rowof(b, p - 1) : row, rown = hn ? rowof(b, p + 1) : row;
#pragma unroll
                for (int j = 0; j < 7; ++j) {
                    const int c = 4 * lane + 256 * j;
                    const u32x2 vc = *(const u32x2*)(REST + (size_t)row * RESTC + c);
                    u32x2 vp = *(const u32x2*)(REST + (size_t)rowp * RESTC + c);
                    u32x2 vn = *(const u32x2*)(REST + (size_t)rown * RESTC + c);
                    if (!hp) { vp.x = 0; vp.y = 0; }
                    if (!hn) { vn.x = 0; vn.y = 0; }
                    const f32x4 m4 = *(const f32x4*)(mu + c);
                    float pc[4] = {bflo(vc.x), bfhi(vc.x), bflo(vc.y), bfhi(vc.y)};
                    float pp[4] = {bflo(vp.x), bfhi(vp.x), bflo(vp.y), bfhi(vp.y)};
                    float pn[4] = {bflo(vn.x), bfhi(vn.x), bflo(vn.y), bfhi(vn.y)};
                    float o[4];
#pragma unroll
                    for (int i = 0; i < 4; ++i) o[i] = pc[i] + m4[i] * (0.5f * (pp[i] + pn[i]) - pc[i]);
                    if (j == 6) {
                        if (lane < 16) { for (int i = 0; i < 4; ++i) o[i] = tanhf(o[i]); }
                        else if (lane >= 32) { for (int i = 0; i < 4; ++i) o[i] = sigmoidf_(o[i]); }
                    }
                    u32x2 ov; ov.x = pk2(o[0], o[1]); ov.y = pk2(o[2], o[3]);
                    bf16_t* dst = j < 2 ? Rr + (size_t)row * 512 + c : (j < 4 ? KR + (size_t)row * 512 + (c - 512) : (j < 6 ? VV + (size_t)row * 512 + (c - 1024) : LOW + (size_t)row * 256 + (c - 1536)));
                    *(u32x2*)dst = ov;
                }
            }
}


__device__ __forceinline__ void phase_4(CParams& P, unsigned char* lds, const int ph) {
    PHASE_PROLOGUE
    constexpr int AST = 264, SST = 136;
    bf16_t* As = (bf16_t*)lds;
    unsigned short* stg = (unsigned short*)(lds + 64 * AST * 2);
    const bf16_t* lrt = (const bf16_t*)(ws + WS_LRT);
    const int fr = lane & 15, fq = lane >> 4;
    const int nrt = (NT + 63) / 64;
    for (int u = bid; u < nrt; u += G) {
        for (int i = tid; i < 64 * 32; i += 512) { const int r = i >> 5, pc = (i & 31) * 8; int row = u * 64 + r; if (row >= NT) row = NT - 1;
            *(u32x4*)(As + r * AST + pc) = *(const u32x4*)(LOW + (size_t)row * 256 + pc); }
        __syncthreads();
#define P4_LOADB(t_, bv_, bias_) do { const int wh_ = (t_) >> 2, ct_ = (t_) & 3, Kw_ = wh_ < 4 ? 64 : 128, col_ = ct_ * 128 + 16 * wave + fr; \
            const bf16_t* Wt_ = lrt + (wh_ < 4 ? (size_t)wh_ * 512 * 64 : (size_t)4 * 512 * 64) + (size_t)col_ * Kw_ + 8 * fq; \
            bv_[0] = *(const bf16x8*)Wt_; bv_[1] = *(const bf16x8*)(Wt_ + 32); if (wh_ == 4) { bv_[2] = *(const bf16x8*)(Wt_ + 64); bv_[3] = *(const bf16x8*)(Wt_ + 96); } \
            bias_ = wh_ < 2 ? w0[wh_ * 512 + col_] : (wh_ < 4 ? a0[(wh_ - 2) * 512 + col_] : 0.f); } while (0)
        bf16x8 bnx[4]; float biasn;
        P4_LOADB(0, bnx, biasn);
#pragma unroll 1
        for (int t = 0; t < 20; ++t) {
            const int which = t >> 2, ct = t & 3;
            const int koff = which < 2 ? 0 : (which < 4 ? 64 : 128);
            bf16x8 bcur[4]; bcur[0] = bnx[0]; bcur[1] = bnx[1]; bcur[2] = bnx[2]; bcur[3] = bnx[3];
            const float bias = biasn;
            if (t + 1 < 20) P4_LOADB(t + 1, bnx, biasn);
            const f32x4 zero4 = (f32x4){0.f, 0.f, 0.f, 0.f};
            f32x4 acc[4] = {zero4, zero4, zero4, zero4};
#pragma unroll
            for (int ks = 0; ks < 4; ++ks) {
                if (ks < 2 || which == 4) {
#pragma unroll
                    for (int rt = 0; rt < 4; ++rt) acc[rt] = __builtin_amdgcn_mfma_f32_16x16x32_bf16(*(const bf16x8*)(As + (16 * rt + fr) * AST + koff + 32 * ks + 8 * fq), bcur[ks], acc[rt], 0, 0, 0);
                }
            }
            unsigned short* sg = stg + (t & 1) * 64 * SST + 16 * wave + fr;
#pragma unroll
            for (int rt = 0; rt < 4; ++rt)
#pragma unroll
                for (int j = 0; j < 4; ++j) { const float val = acc[rt][j] + bias; unsigned short o;
                    if (which < 2) { const _Float16 hv = (_Float16)(-0.6065306597f * sigmoidf_(val)); o = __builtin_bit_cast(unsigned short, hv); }
                    else if (which < 4) o = (unsigned short)f2bf(sigmoidf_(val));
                    else o = (unsigned short)f2bf(val);
                    sg[(16 * rt + 4 * fq + j) * SST] = o; }
            __syncthreads();
            {
                unsigned short* dst = which < 2 ? (unsigned short*)LW + (size_t)which * NT * 512 : (which < 4 ? (unsigned short*)AA + (size_t)(which - 2) * NT * 512 : (unsigned short*)Gg);
                const int r = tid >> 3, pc = (tid & 7) * 16, row = u * 64 + r;
                const unsigned short* sp = stg + (t & 1) * 64 * SST + r * SST + pc;
                if (row < NT) { *(u32x4*)(dst + (size_t)row * 512 + ct * 128 + pc) = *(const u32x4*)sp; *(u32x4*)(dst + (size_t)row * 512 + ct * 128 + pc + 8) = *(const u32x4*)(sp + 8); }
            }
        }
        __syncthreads();
#undef P4_LOADB
    }
}


__device__ __forceinline__ void phase_5(CParams& P, unsigned char* lds, const int ph) {
    PHASE_PROLOGUE
            for (int row = gw; row < NT; row += NGW) {
                const int c0 = lane * 8;
                const u32x4 krv = *(const u32x4*)(KR + (size_t)row * 512 + c0);
                const u32x4 rv = *(const u32x4*)(Rr + (size_t)row * 512 + c0);
                float kr[8], rr[8], kkv[8];
#pragma unroll
                for (int i = 0; i < 4; ++i) { kr[2 * i] = bflo(krv[i]); kr[2 * i + 1] = bfhi(krv[i]); rr[2 * i] = bflo(rv[i]); rr[2 * i + 1] = bfhi(rv[i]); }
                float ss = 0.f;
#pragma unroll
                for (int i = 0; i < 8; ++i) { kkv[i] = kr[i] * k_k[c0 + i]; ss += kkv[i] * kkv[i]; }
                ss += __shfl_xor(ss, 1); ss += __shfl_xor(ss, 2); ss += __shfl_xor(ss, 4);
                const float inv = 1.f / fmaxf(sqrtf(ss), 1e-12f);
#pragma unroll
                for (int i = 0; i < 8; ++i) kkv[i] *= inv;
                u32x4 o; o.x = pk2(kkv[0], kkv[1]); o.y = pk2(kkv[2], kkv[3]); o.z = pk2(kkv[4], kkv[5]); o.w = pk2(kkv[6], kkv[7]);
                *(u32x4*)(KK + (size_t)row * 512 + c0) = o;
                float bsum = 0.f;
#pragma unroll
                for (int d = 0; d < 2; ++d) {
                    const u32x4 av = *(const u32x4*)(AA + ((size_t)d * NT + row) * 512 + c0);
                    float a[8], kka[8], kd[8];
#pragma unroll
                    for (int i = 0; i < 4; ++i) { a[2 * i] = bflo(av[i]); a[2 * i + 1] = bfhi(av[i]); }
#pragma unroll
                    for (int i = 0; i < 8; ++i) { kka[i] = kkv[i] * a[i]; kd[i] = kr[i] * (1.f + (a[i] - 1.f) * k_a[c0 + i]); bsum += rr[i] * kd[i] * r_k[c0 + i]; }
                    u32x4 o1; o1.x = pk2(kka[0], kka[1]); o1.y = pk2(kka[2], kka[3]); o1.z = pk2(kka[4], kka[5]); o1.w = pk2(kka[6], kka[7]);
                    *(u32x4*)(KKA + ((size_t)d * NT + row) * 512 + c0) = o1;
                    u32x4 o2; o2.x = pk2(kd[0], kd[1]); o2.y = pk2(kd[2], kd[3]); o2.z = pk2(kd[4], kd[5]); o2.w = pk2(kd[6], kd[7]);
                    *(u32x4*)(KD + ((size_t)d * NT + row) * 512 + c0) = o2;
                }
                bsum += __shfl_xor(bsum, 1); bsum += __shfl_xor(bsum, 2); bsum += __shfl_xor(bsum, 4);
                if ((lane & 7) == 0) BC[(size_t)row * 8 + (lane >> 3)] = bsum;
            }
}


#define RWS 72
__device__ __forceinline__ bf16x8 rw_frag(const bf16_t* M, int row, int kofs) { return *(const bf16x8*)(M + row * RWS + kofs); }
__device__ __forceinline__ f32x4 rw_tile(const bf16_t* Am, int ra, const bf16_t* Bm, int rb, int fr, int fq) {
    f32x4 acc = (f32x4){0.f, 0.f, 0.f, 0.f};
    acc = __builtin_amdgcn_mfma_f32_16x16x32_bf16(rw_frag(Am, ra + fr, 8 * fq), rw_frag(Bm, rb + fr, 8 * fq), acc, 0, 0, 0);
    acc = __builtin_amdgcn_mfma_f32_16x16x32_bf16(rw_frag(Am, ra + fr, 32 + 8 * fq), rw_frag(Bm, rb + fr, 32 + 8 * fq), acc, 0, 0, 0);
    return acc;
}
__device__ __forceinline__ void phase_6(CParams& P, unsigned char* lds, const int ph) {
    PHASE_PROLOGUE
    constexpr int GST = 68, RST = 132;
    float* Gs = (float*)lds;
    bf16_t* A_rm = (bf16_t*)(lds + 64 * GST * 4); bf16_t* R_rm = A_rm + 64 * RWS; bf16_t* B_rm = R_rm + 64 * RWS; bf16_t* K_rm = B_rm + 64 * RWS;
    bf16_t* B_tr = K_rm + 64 * RWS; bf16_t* K_tr = B_tr + 64 * RWS; bf16_t* V_tr = K_tr + 64 * RWS;
    bf16_t* MAK = V_tr + 64 * RWS; bf16_t* MRB = MAK + 64 * RWS; bf16_t* MRK = MRB + 64 * RWS;
    bf16_t* MABr = MRK + 64 * RWS;
    float* RHS = (float*)(MABr + 64 * RWS);
    float* BT = RHS + 64 * RST; float* OFF = BT + 512; float* GC = OFF + 512;
    bf16_t* X1_tr = A_rm; bf16_t* X2_tr = K_rm;
    for (int i = tid; i < 4 * 64 * RWS / 2; i += 512) ((unsigned*)MAK)[i] = 0u;
    __syncthreads();
    const int fr = lane & 15, fq = lane >> 4;
#define RW1_BAR() do { asm volatile("s_waitcnt lgkmcnt(0)" ::: "memory"); __builtin_amdgcn_s_barrier(); asm volatile("" ::: "memory"); } while (0)
    const int t0 = tid & 63, kp = (tid >> 6) * 8;
    u32x4 nlw, nkk, nka, nkd, nrv, nvv;
#define RW1_LOAD(u_) do { const int ch_ = (u_) / RW_NCH, c_ = (u_) - ch_ * RW_NCH, d_ = ch_ >> 4, b_ = (ch_ >> 3) & 1, h_ = ch_ & 7, s_ = c_ * 64 + t0; \
        const int p_ = d_ ? LSEQ - 1 - s_ : s_; const size_t o_ = (size_t)rowof(b_, s_ < LSEQ ? p_ : 0) * 512 + h_ * 64 + kp; \
        nlw = *(const u32x4*)(LW + (size_t)d_ * NT * 512 + o_); nkk = *(const u32x4*)(KK + o_); nka = *(const u32x4*)(KKA + (size_t)d_ * NT * 512 + o_); \
        nkd = *(const u32x4*)(KD + (size_t)d_ * NT * 512 + o_); nrv = *(const u32x4*)(Rr + o_); nvv = *(const u32x4*)(VV + o_); } while (0)
    if (bid < RW_UNITS) RW1_LOAD(bid);
    for (int u = bid; u < RW_UNITS; u += G) {
        const int chain = u / RW_NCH, c = u - chain * RW_NCH;
        float lw[8], kk[8], ka[8], kd[8], rr[8]; u32x4 vv;
        {
            const bool valid = c * 64 + t0 < LSEQ;
            vv = nvv;
#pragma unroll
            for (int i = 0; i < 4; ++i) {
                union { unsigned u; _Float16 hh[2]; } cv; cv.u = nlw[i];
                lw[2 * i] = valid ? (float)cv.hh[0] : 0.f; lw[2 * i + 1] = valid ? (float)cv.hh[1] : 0.f;
                kk[2 * i] = valid ? bflo(nkk[i]) : 0.f; kk[2 * i + 1] = valid ? bfhi(nkk[i]) : 0.f;
                ka[2 * i] = valid ? bflo(nka[i]) : 0.f; ka[2 * i + 1] = valid ? bfhi(nka[i]) : 0.f;
                kd[2 * i] = valid ? bflo(nkd[i]) : 0.f; kd[2 * i + 1] = valid ? bfhi(nkd[i]) : 0.f;
                rr[2 * i] = valid ? bflo(nrv[i]) : 0.f; rr[2 * i + 1] = valid ? bfhi(nrv[i]) : 0.f;
                if (!valid) vv[i] = 0u;
            }
        }
        if (u + G < RW_UNITS) RW1_LOAD(u + G);
        *(f32x4*)(Gs + t0 * GST + kp) = (f32x4){lw[0], lw[1], lw[2], lw[3]}; *(f32x4*)(Gs + t0 * GST + kp + 4) = (f32x4){lw[4], lw[5], lw[6], lw[7]};
        RW1_BAR();
        { const int k = tid & 63, w = tid >> 6; float acc = 0.f;
#pragma unroll
          for (int i = 0; i < 8; ++i) { acc += Gs[(8 * w + i) * GST + k]; Gs[(8 * w + i) * GST + k] = acc; }
          BT[w * 64 + k] = acc; }
        RW1_BAR();
        { const int k = tid & 63, w = tid >> 6; float off = 0.f; for (int w2 = 0; w2 < w; ++w2) off += BT[w2 * 64 + k]; OFF[w * 64 + k] = off; }
        RW1_BAR();
#ifndef RW1_REP0
#define RW1_REP0 1
#endif
        for (int rep0_ = 0; rep0_ < RW1_REP0; ++rep0_) {
        {
            float va[8], vr[8], vb[8], vk[8];
            const f32x4 g0_ = *(const f32x4*)(Gs + t0 * GST + kp), g1_ = *(const f32x4*)(Gs + t0 * GST + kp + 4), o0_ = *(const f32x4*)(OFF + (t0 >> 3) * 64 + kp), o1_ = *(const f32x4*)(OFF + (t0 >> 3) * 64 + kp + 4);
            const float gg_[8] = {g0_[0] + o0_[0], g0_[1] + o0_[1], g0_[2] + o0_[2], g0_[3] + o0_[3], g1_[0] + o1_[0], g1_[1] + o1_[1], g1_[2] + o1_[2], g1_[3] + o1_[3]};
#pragma unroll
            for (int i = 0; i < 8; ++i) {
                const float g = gg_[i];
                const float eg = __expf(g), egm1 = __expf(g - lw[i]), einv = __expf(-g);
                va[i] = kk[i] * egm1; vr[i] = rr[i] * eg; vb[i] = ka[i] * einv; vk[i] = kd[i] * einv;
                if (t0 == 63) GC[kp + i] = eg;
            }
            *(f32x4*)(RHS + t0 * RST + kp) = (f32x4){va[0], va[1], va[2], va[3]}; *(f32x4*)(RHS + t0 * RST + kp + 4) = (f32x4){va[4], va[5], va[6], va[7]};
            u32x4 w4;
            w4.x = pk2(va[0], va[1]); w4.y = pk2(va[2], va[3]); w4.z = pk2(va[4], va[5]); w4.w = pk2(va[6], va[7]); *(u32x4*)(A_rm + t0 * RWS + kp) = w4;
            w4.x = pk2(vr[0], vr[1]); w4.y = pk2(vr[2], vr[3]); w4.z = pk2(vr[4], vr[5]); w4.w = pk2(vr[6], vr[7]); *(u32x4*)(R_rm + t0 * RWS + kp) = w4;
            w4.x = pk2(vb[0], vb[1]); w4.y = pk2(vb[2], vb[3]); w4.z = pk2(vb[4], vb[5]); w4.w = pk2(vb[6], vb[7]); *(u32x4*)(B_rm + t0 * RWS + kp) = w4;
            w4.x = pk2(vk[0], vk[1]); w4.y = pk2(vk[2], vk[3]); w4.z = pk2(vk[4], vk[5]); w4.w = pk2(vk[6], vk[7]); *(u32x4*)(K_rm + t0 * RWS + kp) = w4;
#pragma unroll
            for (int i = 0; i < 8; ++i) { B_tr[(kp + i) * RWS + t0] = (bf16_t)f2bf(vb[i]); K_tr[(kp + i) * RWS + t0] = (bf16_t)f2bf(vk[i]);
                V_tr[(kp + i) * RWS + t0] = (bf16_t)((i & 1) ? (vv[i >> 1] >> 16) : (vv[i >> 1] & 0xffffu)); }
        }
        RW1_BAR();
        }
        float* DQ = Gs; bf16_t* TB = (bf16_t*)BT;
#ifndef RW1_REP1
#define RW1_REP1 1
#endif
        for (int rep_ = 0; rep_ < RW1_REP1; ++rep_)
        for (int q = wave; q < 40; q += 8) {
            const int m = q / 10, e = q - m * 10, ti = e >= 6 ? 3 : (e >= 3 ? 2 : (e >= 1 ? 1 : 0)), tj = e - (ti * (ti + 1)) / 2;
            const f32x4 acc = rw_tile(m < 2 ? A_rm : R_rm, 16 * ti, (m & 1) ? K_rm : B_rm, 16 * tj, fr, fq);
            bf16_t* Mm = m == 1 ? MAK : (m == 2 ? MRB : MRK);
#pragma unroll
            for (int j = 0; j < 4; ++j) { const int t = 16 * ti + 4 * fq + j, i = 16 * tj + fr; const bool keep = m < 2 ? (i < t) : (i <= t); const float val = keep ? acc[j] : 0.f;
                if (m == 0) { MABr[t * RWS + i] = (bf16_t)f2bf(val); if (ti == tj) DQ[((ti * 16 + (t & 15)) * 4 + (fr & 3)) * 4 + (fr >> 2)] = val; }
                else Mm[t * RWS + i] = (bf16_t)f2bf(val); }
        }
        RW1_BAR();
#ifndef RW1_REP23
#define RW1_REP23 1
#endif
        for (int rep23_ = 0; rep23_ < RW1_REP23; ++rep23_) {
        if (wave >= 4) {
            for (int q = wave - 4; q < 16; q += 4) { const int ti = q >> 2, tv = q & 3; const f32x4 acc = rw_tile(MAK, 16 * ti, V_tr, 16 * tv, fr, fq);
#pragma unroll
                for (int j = 0; j < 4; ++j) RHS[(16 * ti + 4 * fq + j) * RST + 64 + 16 * tv + fr] = acc[j]; }
        } else {
            const int bb = wave, cc = lane >> 2, q = lane & 3;
            float xs[4] = {0.f, 0.f, 0.f, 0.f};
#pragma unroll
            for (int tl = 0; tl < 16; ++tl) {
                const f32x4 mv = *(const f32x4*)(DQ + ((bb * 16 + tl) * 4 + q) * 4);
                float part = mv[0] * xs[0] + mv[1] * xs[1] + mv[2] * xs[2] + mv[3] * xs[3];
                part += dppf<0xB1>(part); part += dppf<0x4E>(part);
                const float xt = (tl == cc ? 1.f : 0.f) - part;
                xs[tl >> 2] = (tl & 3) == q ? xt : xs[tl >> 2];
            }
#pragma unroll
            for (int m = 0; m < 4; ++m) TB[(bb * 16 + 4 * m + q) * 16 + cc] = (bf16_t)f2bf(xs[m]);
        }
        RW1_BAR();
        {
            const int c0 = 16 * wave;
            f32x4 X[4];
            const f32x4 zero4 = (f32x4){0.f, 0.f, 0.f, 0.f};
#define RW1_PACK(lo_, hi_, v_) do { union { bf16x8 v; unsigned u[4]; } t_; t_.u[0] = pk2(lo_[0], lo_[1]); t_.u[1] = pk2(lo_[2], lo_[3]); t_.u[2] = pk2(hi_[0], hi_[1]); t_.u[3] = pk2(hi_[2], hi_[3]); v_ = t_.v; } while (0)
#define RW1_LDA(base_, row0_, ca_, cb_, useb_, v_) do { union { bf16x8 v; u32x2 h2[2]; } t_; t_.h2[0] = *(const u32x2*)((base_) + ((row0_) + fr) * RWS + (ca_) + 4 * fq); \
            t_.h2[1] = (useb_) ? *(const u32x2*)((base_) + ((row0_) + fr) * RWS + (cb_) + 4 * fq) : (u32x2){0u, 0u}; v_ = t_.v; } while (0)
#pragma unroll
            for (int bq = 0; bq < 4; ++bq) {
                f32x4 acc;
#pragma unroll
                for (int j = 0; j < 4; ++j) acc[j] = -RHS[(16 * bq + 4 * fq + j) * RST + c0 + fr];
                bf16x8 af, bfv;
                if (bq >= 1) { RW1_LDA(MABr, 16 * bq, 0, 16, bq >= 2, af); if (bq >= 2) RW1_PACK(X[0], X[1], bfv); else RW1_PACK(X[0], zero4, bfv);
                    acc = __builtin_amdgcn_mfma_f32_16x16x32_bf16(af, bfv, acc, 0, 0, 0); }
                if (bq == 3) { RW1_LDA(MABr, 48, 32, 0, false, af); RW1_PACK(X[2], zero4, bfv); acc = __builtin_amdgcn_mfma_f32_16x16x32_bf16(af, bfv, acc, 0, 0, 0); }
                const f32x4 wv = (f32x4){-acc[0], -acc[1], -acc[2], -acc[3]};
                { union { bf16x8 v; u32x2 h2[2]; } t_; t_.h2[0] = *(const u32x2*)(TB + (bq * 16 + fr) * 16 + 4 * fq); t_.h2[1] = (u32x2){0u, 0u}; af = t_.v; }
                RW1_PACK(wv, zero4, bfv);
                X[bq] = __builtin_amdgcn_mfma_f32_16x16x32_bf16(af, bfv, zero4, 0, 0, 0);
                bf16_t* Xm = (wave < 4 ? X1_tr : X2_tr) + ((c0 & 63) + fr) * RWS + 16 * bq + 4 * fq;
                u32x2 o; o.x = pk2(X[bq][0], X[bq][1]); o.y = pk2(X[bq][2], X[bq][3]);
                *(u32x2*)Xm = o;
            }
#undef RW1_PACK
#undef RW1_LDA
        }
        RW1_BAR();
        }
#ifndef RW1_REP5
#define RW1_REP5 1
#endif
        for (int rep_ = 0; rep_ < RW1_REP5; ++rep_)
        for (int q = wave; q < 64; q += 8) {
            const int kind = q >> 4, ta = (q >> 2) & 3, tb = q & 3;
            u32x2 o;
            if (kind == 0) {
                const f32x4 acc = rw_tile(X1_tr, 16 * ta, B_tr, 16 * tb, fr, fq);
                const int k = 16 * tb + fr, kq = 16 * ta + 4 * fq; const float gc = GC[k];
                float v[4];
#pragma unroll
                for (int j = 0; j < 4; ++j) v[j] = gc * ((kq + j == k ? 1.f : 0.f) - acc[j]);
                o.x = pk2(v[0], v[1]); o.y = pk2(v[2], v[3]);
                *(u32x2*)(PP + (size_t)u * 4096 + k * 64 + 32 * (ta >> 1) + 8 * fq + 4 * (ta & 1)) = o;
            } else if (kind == 1) {
                const f32x4 acc = rw_tile(X1_tr, 16 * ta, MRB, 16 * tb, fr, fq);
                const int t = 16 * tb + fr, k0 = 16 * ta + 4 * fq;
                const u32x2 rv = *(const u32x2*)(R_rm + t * RWS + k0);
                o.x = pk2(bflo(rv.x) - acc[0], bfhi(rv.x) - acc[1]); o.y = pk2(bflo(rv.y) - acc[2], bfhi(rv.y) - acc[3]);
                *(u32x2*)(YT + (size_t)u * 4096 + t * 64 + 32 * (ta >> 1) + 8 * fq + 4 * (ta & 1)) = o;
            } else if (kind == 2) {
                const f32x4 a1 = rw_tile(K_tr, 16 * ta, V_tr, 16 * tb, fr, fq), a2 = rw_tile(B_tr, 16 * ta, X2_tr, 16 * tb, fr, fq);
                const int v_ = 16 * tb + fr, k0 = 16 * ta + 4 * fq;
                const f32x4 gc = *(const f32x4*)(GC + k0);
                o.x = pk2(gc[0] * (a1[0] - a2[0]), gc[1] * (a1[1] - a2[1])); o.y = pk2(gc[2] * (a1[2] - a2[2]), gc[3] * (a1[3] - a2[3]));
                *(u32x2*)(QT + (size_t)u * 4096 + v_ * 64 + k0) = o;
            } else {
                const f32x4 a1 = rw_tile(MRK, 16 * ta, V_tr, 16 * tb, fr, fq), a2 = rw_tile(MRB, 16 * ta, X2_tr, 16 * tb, fr, fq);
                const int v_ = 16 * tb + fr, t0_ = 16 * ta + 4 * fq;
                o.x = pk2(a1[0] - a2[0], a1[1] - a2[1]); o.y = pk2(a1[2] - a2[2], a1[3] - a2[3]);
                *(u32x2*)(ZT + (size_t)u * 4096 + v_ * 64 + t0_) = o;
            }
        }
        RW1_BAR();
    }
#undef RW1_LOAD
#undef RW1_BAR
}

__device__ __forceinline__ void phase_60(CParams& P, unsigned char* lds, const int ph) {
    PHASE_PROLOGUE
    if (bid < 32) {
        const int chain = bid, d = chain >> 4, b = (chain >> 3) & 1, h = chain & 7;
        const int fr = lane & 15, fq = lane >> 4;
        constexpr int MATB = 64 * RWS * 2, SLOT = 4 * MATB;
        bf16_t* ybuf = (bf16_t*)(lds + 3 * SLOT);
        const bool comp = wave < 4; const int vb = wave & 3, lm = wave & 3;
        const unsigned char* src = (const unsigned char*)(lm == 0 ? PP : (lm == 1 ? YT : (lm == 2 ? QT : ZT))) + (size_t)chain * RW_NCH * 8192 + lane * 16;
        u32x4 R0[8], R1[8], R2[8];
#define RW2_LD(Rx, c_) do { _Pragma("unroll") for (int i_ = 0; i_ < 8; ++i_) Rx[i_] = *(const u32x4*)(src + (size_t)(c_) * 8192 + i_ * 1024); } while (0)
#define RW2_ST(Rx, c_) do { unsigned char* dst_ = lds + ((c_) % 3) * SLOT + lm * MATB; _Pragma("unroll") for (int i_ = 0; i_ < 8; ++i_) { const int p_ = lane + 64 * i_; *(u32x4*)(dst_ + (p_ >> 3) * (RWS * 2) + (p_ & 7) * 16) = Rx[i_]; } } while (0)
#define RW2_FLUSH(c_) do { const int tl_ = 16 * lm + (lane >> 2), s_ = (c_) * 64 + tl_; const bf16_t* yb_ = ybuf + ((c_) & 1) * 64 * RWS + tl_ * RWS + 16 * (lane & 3); \
            const u32x4 y0_ = *(const u32x4*)yb_, y1_ = *(const u32x4*)(yb_ + 8); \
            if (s_ < LSEQ) { const int p_ = d ? LSEQ - 1 - s_ : s_; bf16_t* g_ = YFB + ((size_t)d * NT + rowof(b, p_)) * 512 + h * 64 + 16 * (lane & 3); *(u32x4*)g_ = y0_; *(u32x4*)(g_ + 8) = y1_; } } while (0)
        const f32x4 zero4 = (f32x4){0.f, 0.f, 0.f, 0.f};
        f32x4 S[4] = {zero4, zero4, zero4, zero4};
#define RW2_COMPUTE(c_) do { const bf16_t* sl_ = (const bf16_t*)(lds + ((c_) % 3) * SLOT); const bf16_t* sP = sl_; const bf16_t* sY = sl_ + 64 * RWS; const bf16_t* sQ = sl_ + 2 * 64 * RWS; const bf16_t* sZ = sl_ + 3 * 64 * RWS; \
            bf16_t* yo_ = ybuf + ((c_) & 1) * 64 * RWS + 16 * vb + fr; \
            union { bf16x8 v; unsigned u[4]; } bs[2]; \
            _Pragma("unroll") for (int ks = 0; ks < 2; ++ks) { bs[ks].u[0] = pk2(S[2 * ks][0], S[2 * ks][1]); bs[ks].u[1] = pk2(S[2 * ks][2], S[2 * ks][3]); \
                bs[ks].u[2] = pk2(S[2 * ks + 1][0], S[2 * ks + 1][1]); bs[ks].u[3] = pk2(S[2 * ks + 1][2], S[2 * ks + 1][3]); } \
            _Pragma("unroll") for (int tt = 0; tt < 4; ++tt) { \
                const u32x2 z2 = *(const u32x2*)(sZ + (16 * vb + fr) * RWS + 16 * tt + 4 * fq); \
                f32x4 acc = (f32x4){bflo(z2.x), bfhi(z2.x), bflo(z2.y), bfhi(z2.y)}; \
                acc = __builtin_amdgcn_mfma_f32_16x16x32_bf16(*(const bf16x8*)(sY + (16 * tt + fr) * RWS + 8 * fq), bs[0].v, acc, 0, 0, 0); \
                acc = __builtin_amdgcn_mfma_f32_16x16x32_bf16(*(const bf16x8*)(sY + (16 * tt + fr) * RWS + 32 + 8 * fq), bs[1].v, acc, 0, 0, 0); \
                _Pragma("unroll") for (int j = 0; j < 4; ++j) yo_[(16 * tt + 4 * fq + j) * RWS] = (bf16_t)f2bf(acc[j]); } \
            f32x4 Sn[4]; \
            _Pragma("unroll") for (int kt = 0; kt < 4; ++kt) { \
                const u32x2 q2 = *(const u32x2*)(sQ + (16 * vb + fr) * RWS + 16 * kt + 4 * fq); \
                f32x4 acc = (f32x4){bflo(q2.x), bfhi(q2.x), bflo(q2.y), bfhi(q2.y)}; \
                acc = __builtin_amdgcn_mfma_f32_16x16x32_bf16(*(const bf16x8*)(sP + (16 * kt + fr) * RWS + 8 * fq), bs[0].v, acc, 0, 0, 0); \
                acc = __builtin_amdgcn_mfma_f32_16x16x32_bf16(*(const bf16x8*)(sP + (16 * kt + fr) * RWS + 32 + 8 * fq), bs[1].v, acc, 0, 0, 0); \
                Sn[kt] = acc; } \
            _Pragma("unroll") for (int kt = 0; kt < 4; ++kt) S[kt] = Sn[kt]; } while (0)
#define RW2_BAR() do { asm volatile("s_waitcnt lgkmcnt(0)" ::: "memory"); __builtin_amdgcn_s_barrier(); asm volatile("" ::: "memory"); } while (0)
        if (!comp) { RW2_LD(R0, 0); RW2_ST(R0, 0); RW2_LD(R0, 1); RW2_LD(R1, 2); RW2_LD(R2, 3); }
        __syncthreads();
        for (int c = 0; c < RW_NCH; c += 3) {
            if (!comp) { if (c + 1 < RW_NCH) RW2_ST(R0, c + 1); if (c + 4 < RW_NCH) RW2_LD(R0, c + 4); if (c > 0) RW2_FLUSH(c - 1); } else RW2_COMPUTE(c);
            RW2_BAR();
            if (!comp) { if (c + 2 < RW_NCH) RW2_ST(R1, c + 2); if (c + 5 < RW_NCH) RW2_LD(R1, c + 5); RW2_FLUSH(c); } else RW2_COMPUTE(c + 1);
            RW2_BAR();
            if (!comp) { if (c + 3 < RW_NCH) RW2_ST(R2, c + 3); if (c + 6 < RW_NCH) RW2_LD(R2, c + 6); RW2_FLUSH(c + 1); } else RW2_COMPUTE(c + 2);
            RW2_BAR();
        }
        if (!comp) RW2_FLUSH(RW_NCH - 1);
#undef RW2_LD
#undef RW2_ST
#undef RW2_FLUSH
#undef RW2_COMPUTE
#undef RW2_BAR
    } else {
        na_units(P, lds, (bid - 32) * 8 + (threadIdx.x >> 6), (G - 32) * 8);
    }
}

__device__ __forceinline__ void phase_7(CParams& P, unsigned char* lds, const int ph) {
    PHASE_PROLOGUE
            for (int row = gw; row < NT; row += NGW) {
                const int c0 = lane * 8;
                const u32x4 yf = *(const u32x4*)(YFB + (size_t)row * 512 + c0);
                const u32x4 yb = *(const u32x4*)(YFB + ((size_t)NT + row) * 512 + c0);
                const u32x4 vv = *(const u32x4*)(VV + (size_t)row * 512 + c0);
                const u32x4 gg = *(const u32x4*)(Gg + (size_t)row * 512 + c0);
                float y[8], v[8], g[8];
#pragma unroll
                for (int i = 0; i < 4; ++i) { y[2 * i] = bflo(yf[i]) + bflo(yb[i]); y[2 * i + 1] = bfhi(yf[i]) + bfhi(yb[i]); v[2 * i] = bflo(vv[i]); v[2 * i + 1] = bfhi(vv[i]); g[2 * i] = bflo(gg[i]); g[2 * i + 1] = bfhi(gg[i]); }
                float sm = 0.f;
#pragma unroll
                for (int i = 0; i < 8; ++i) sm += y[i];
                sm += __shfl_xor(sm, 1); sm += __shfl_xor(sm, 2); sm += __shfl_xor(sm, 4);
                const float mean = sm * (1.f / 64.f);
                float vr = 0.f;
#pragma unroll
                for (int i = 0; i < 8; ++i) { const float dlt = y[i] - mean; vr += dlt * dlt; }
                vr += __shfl_xor(vr, 1); vr += __shfl_xor(vr, 2); vr += __shfl_xor(vr, 4);
                const float rstd = rsqrtf(vr * (1.f / 64.f) + 64e-5f);
                const float bc = BC[(size_t)row * 8 + (lane >> 3)];
                float o[8];
#pragma unroll
                for (int i = 0; i < 8; ++i) o[i] = ((y[i] - mean) * rstd * lnx_g[c0 + i] + lnx_b[c0 + i] + bc * v[i]) * g[i];
                u32x4 ov; ov.x = pk2(o[0], o[1]); ov.y = pk2(o[2], o[3]); ov.z = pk2(o[4], o[5]); ov.w = pk2(o[6], o[7]);
                *(u32x4*)(A2 + (size_t)row * DM + 512 + c0) = ov;
            }
}


__device__ __forceinline__ void phase_8(CParams& P, unsigned char* lds, const int ph) {
    PHASE_PROLOGUE
    if (gw < 64) meta_gemm<0>(A2 + (size_t)NMAIN * DM, WTOUT, H + (size_t)NMAIN * DM, gw, lane);
    pg8::DenseOrder S; S.init(A2, WTOUT, NMAIN, DM, DM, G, bid);
    pg8::EpiResidual E{H};
    pg8::gemm_phase<pg8::EpiResidual, pg8::DenseOrder, true, true>((PG8_LAS unsigned char*)lds, DM, S, E);
}

__device__ __forceinline__ void phase_9(CParams& P, unsigned char* lds, const int ph) {
    PHASE_PROLOGUE
            const int l = ph == 9 ? 0 : 1;
                    for (int i = bid * 512 + tid; i < MOE_MAXROWS; i += G * 512) ROWTOK[i] = 0;
    unsigned* cnt = CTL + CW_CNT(l);
            const float* wg = moe_wg + (size_t)l * DM * 4; const float* bg = moe_bg + l * 4;
            for (int row = gw; row < NT; row += NGW) {
                f32x4 v[4]; float ss = 0.f;
#pragma unroll
                for (int j = 0; j < 4; ++j) { v[j] = ((const f32x4*)(H + (size_t)row * DM))[lane + 64 * j]; ss += v[j][0] * v[j][0] + v[j][1] * v[j][1] + v[j][2] * v[j][2] + v[j][3] * v[j][3]; }
                ss = wave_sum(ss);
                const float rstd = rsqrtf(ss * (1.f / DM) + 1e-6f);
                float lg[4] = {0.f, 0.f, 0.f, 0.f};
#pragma unroll
                for (int j = 0; j < 4; ++j) {
                    const f32x4 g = ((const f32x4*)(norm_ffn + l * DM))[lane + 64 * j];
#pragma unroll
                    for (int i = 0; i < 4; ++i) v[j][i] = v[j][i] * rstd * g[i];
                    u32x2 o; o.x = pk2(v[j][0], v[j][1]); o.y = pk2(v[j][2], v[j][3]);
                    ((u32x2*)(HN + (size_t)row * DM))[lane + 64 * j] = o;
#pragma unroll
                    for (int i = 0; i < 4; ++i) { const f32x4 w = *(const f32x4*)(wg + (size_t)(4 * (lane + 64 * j) + i) * 4);
                        lg[0] += v[j][i] * w[0]; lg[1] += v[j][i] * w[1]; lg[2] += v[j][i] * w[2]; lg[3] += v[j][i] * w[3]; }
                }
#pragma unroll
                for (int q = 0; q < 4; ++q) lg[q] = wave_sum(lg[q]) + bg[q];
                int grp = 0; float mx = lg[0];
#pragma unroll
                for (int q = 1; q < 4; ++q) if (lg[q] > mx) { mx = lg[q]; grp = q; }
                float den = 0.f;
#pragma unroll
                for (int q = 0; q < 4; ++q) den += __expf(lg[q] - mx);
                const float pgrp = 1.f / den;
                const float* we = moe_we + ((size_t)(l * 4 + grp) * DM) * 8;
                float le[8] = {0.f, 0.f, 0.f, 0.f, 0.f, 0.f, 0.f, 0.f};
#pragma unroll
                for (int j = 0; j < 4; ++j)
#pragma unroll
                    for (int i = 0; i < 4; ++i) { const float* wr_ = we + (size_t)(4 * (lane + 64 * j) + i) * 8; const f32x4 wa = *(const f32x4*)wr_, wb = *(const f32x4*)(wr_ + 4);
                        le[0] += v[j][i] * wa[0]; le[1] += v[j][i] * wa[1]; le[2] += v[j][i] * wa[2]; le[3] += v[j][i] * wa[3];
                        le[4] += v[j][i] * wb[0]; le[5] += v[j][i] * wb[1]; le[6] += v[j][i] * wb[2]; le[7] += v[j][i] * wb[3]; }
#pragma unroll
                for (int q = 0; q < 8; ++q) le[q] = wave_sum(le[q]) + moe_be[(l * 4 + grp) * 8 + q];
                int i1 = 0; float m1 = le[0];
#pragma unroll
                for (int q = 1; q < 8; ++q) if (le[q] > m1) { m1 = le[q]; i1 = q; }
                int i2 = (i1 + 1) & 7; float m2 = -3.0e38f;
#pragma unroll
                for (int q = 0; q < 8; ++q) if (q != i1 && le[q] > m2) { m2 = le[q]; i2 = q; }
                const float e2 = __expf(m2 - m1);
                const float g1 = pgrp / (1.f + e2), g2 = pgrp * e2 / (1.f + e2);
                if (lane == 0) {
                    const int ea = grp * 8 + i1, eb = grp * 8 + i2;
                    const unsigned pa = atomicAdd(cnt + ea, 1u), pb = atomicAdd(cnt + eb, 1u);
                    EID[row * 2] = ea; EID[row * 2 + 1] = eb; POS[row * 2] = (int)pa; POS[row * 2 + 1] = (int)pb;
                    GATE[row * 2] = g1; GATE[row * 2 + 1] = g2;
                }
            }
    for (int it = gw; it < CONV_MOE_ITEMS; it += NGW) conv_moe_item(P, l, it, lane);
}


__device__ __forceinline__ void phase_10(CParams& P, unsigned char* lds, const int ph) {
    PHASE_PROLOGUE
    const int l = ph == 10 ? 0 : 1;
    int* ps = (int*)(lds + LDS_TAB);
    if (tid == 0) { int acc_ = 0; for (int e = 0; e < NEXP; ++e) { ps[e] = acc_; const int c = (int)CTL[CW_CNT(l) + e]; acc_ += (c + MOE_RT - 1) / MOE_RT * MOE_RT; } ps[NEXP] = acc_; }
    __syncthreads();
    for (int i = bid * 512 + tid; i < NT * 2; i += G * 512) { const int dest = ps[EID[i]] + POS[i]; DEST[i] = dest; ROWTOK[dest] = i >> 1; }
    __syncthreads();
}

__device__ __forceinline__ void phase_11(CParams& P, unsigned char* lds, const int ph) {
    PHASE_PROLOGUE
    const int l = ph == 11 ? 0 : 1;
    int* et = (int*)(lds + LDS_TAB);
    if (tid == 0) { int acc_ = 0; for (int e = 0; e < NEXP; ++e) { const int c = (int)CTL[CW_CNT(l) + e], n = (c + MOE_RT - 1) / MOE_RT; for (int q = 0; q < n; ++q) et[1 + acc_ + q] = e; acc_ += n; } et[0] = acc_; }
    __syncthreads();
    pg8::MoeOrder<true> S{et + 1, et[0], vcu, (const char*)HN, (const char*)WT13, 256u * DM * 2u, 256u * DM * 2u, (unsigned)DM * DM * 2u, ROWTOK};
    pg8::EpiSwiglu E{HB};
    pg8::gemm_phase<pg8::EpiSwiglu, pg8::MoeOrder<true>, true, true>((PG8_LAS unsigned char*)lds, DM, S, E);
    __syncthreads();
}

__device__ __forceinline__ void phase_12(CParams& P, unsigned char* lds, const int ph) {
    PHASE_PROLOGUE
    const int l = ph == 12 ? 0 : 1;
    int* et = (int*)(lds + LDS_TAB);
    if (tid == 0) { int acc_ = 0; for (int e = 0; e < NEXP; ++e) { const int c = (int)CTL[CW_CNT(l) + e], n = (c + MOE_RT - 1) / MOE_RT; for (int q = 0; q < n; ++q) et[1 + acc_ + q] = e; acc_ += n; } et[0] = acc_; }
    __syncthreads();
    pg8::MoeOrder<false> S{et + 1, et[0], vcu, (const char*)HB, (const char*)WT2, 256u * DFF * 2u, 256u * DFF * 2u, (unsigned)DM * DFF * 2u, nullptr};
    pg8::EpiBf16Plain E{YB, DM};
    pg8::gemm_phase<pg8::EpiBf16Plain, pg8::MoeOrder<false>, true, true>((PG8_LAS unsigned char*)lds, DFF, S, E);
    __syncthreads();
}

__device__ __forceinline__ void phase_13(CParams& P, unsigned char* lds, const int ph) {
    PHASE_PROLOGUE
            const bool fin = ph == 21;
            for (int row = gw; row < NT; row += NGW) {
                const int d0 = DEST[row * 2], d1 = DEST[row * 2 + 1];
                const float g0 = GATE[row * 2], g1 = GATE[row * 2 + 1];
                f32x4 v[4];
#pragma unroll
                for (int j = 0; j < 4; ++j) {
                    v[j] = ((const f32x4*)(H + (size_t)row * DM))[lane + 64 * j];
                    const u32x2 ya = ((const u32x2*)(YB + (size_t)d0 * DM))[lane + 64 * j];
                    const u32x2 yb = ((const u32x2*)(YB + (size_t)d1 * DM))[lane + 64 * j];
                    v[j][0] += g0 * bflo(ya.x) + g1 * bflo(yb.x); v[j][1] += g0 * bfhi(ya.x) + g1 * bfhi(yb.x);
                    v[j][2] += g0 * bflo(ya.y) + g1 * bflo(yb.y); v[j][3] += g0 * bfhi(ya.y) + g1 * bfhi(yb.y);
                }
                if (!fin) {
#pragma unroll
                    for (int j = 0; j < 4; ++j) ((f32x4*)(H + (size_t)row * DM))[lane + 64 * j] = v[j];
                    store_norm_bf16(v, norm_mix + DM, HN + (size_t)row * DM, lane);
                } else if (row < NMAIN) {
                    float ss = 0.f;
#pragma unroll
                    for (int j = 0; j < 4; ++j) ss += v[j][0] * v[j][0] + v[j][1] * v[j][1] + v[j][2] * v[j][2] + v[j][3] * v[j][3];
                    ss = wave_sum(ss);
                    const float rstd = rsqrtf(ss * (1.f / DM) + 1e-6f);
#pragma unroll
                    for (int j = 0; j < 4; ++j) { const f32x4 g = ((const f32x4*)norm_final)[lane + 64 * j]; f32x4 o;
                        o[0] = v[j][0] * rstd * g[0]; o[1] = v[j][1] * rstd * g[1]; o[2] = v[j][2] * rstd * g[2]; o[3] = v[j][3] * rstd * g[3];
                        ((f32x4*)(P.out + (size_t)row * DM))[lane + 64 * j] = o; }
                }
            }
}

__device__ __forceinline__ void phase_14(CParams& P, unsigned char* lds, const int ph) {
    PHASE_PROLOGUE
    float* pwr = (float*)lds; float* pwi = pwr + 2176; float* bbr = pwi + 2176; float* bbi = bbr + 2048; float* ccr = bbi + 2048; float* cci = ccr + 2048; float* kf = cci + 2048; float* kb = kf + 4096;
    for (int gu = bid; gu < 256; gu += G) {
        const int g = gu >> 2, part = gu & 3;
        if (tid < 128) {
            const int d = tid >> 6, p = tid & 63;
            const float step = __expf(s5_ls[d * 64 + g]);
            const float lr = s5_lre[(d * 64 + g) * 64 + p], li = s5_lim[(d * 64 + g) * 64 + p];
            const float mag = expf(lr * step);
            const float abr = mag * cosf(li * step), abi = mag * sinf(li * step);
            const float den = lr * lr + li * li;
            const float zr = ((abr - 1.f) * lr + abi * li) / den, zi = (abi * lr - (abr - 1.f) * li) / den;
            float pr = 1.f, pi = 0.f;
            for (int t = 0; t < 17; ++t) { pwr[(d * 64 + p) * 17 + t] = pr; pwi[(d * 64 + p) * 17 + t] = pi; const float nr = pr * abr - pi * abi; pi = pr * abi + pi * abr; pr = nr; }
            for (int i = 0; i < 16; ++i) { const float br = s5_b_re[((size_t)(g * 64 + p)) * 16 + i], bi = s5_b_im[((size_t)(g * 64 + p)) * 16 + i];
                bbr[(d * 64 + p) * 16 + i] = zr * br - zi * bi; bbi[(d * 64 + p) * 16 + i] = zr * bi + zi * br; }
        }
        for (int idx = tid; idx < 2048; idx += 512) { const int d = idx >> 10, i = (idx >> 6) & 15, p = idx & 63;
            ccr[(d * 64 + p) * 16 + i] = s5_c_re[((size_t)(d * 64 + g) * 16 + i) * 64 + p]; cci[(d * 64 + p) * 16 + i] = s5_c_im[((size_t)(d * 64 + g) * 16 + i) * 64 + p]; }
        __syncthreads();
        {
            const int d = tid >> 8, tau = (tid >> 4) & 15, i = tid & 15;
            float acc[16];
#pragma unroll
            for (int q = 0; q < 16; ++q) acc[q] = 0.f;
            for (int p = 0; p < 64; ++p) {
                const float cr = ccr[(d * 64 + p) * 16 + i], ci = cci[(d * 64 + p) * 16 + i], pr = pwr[(d * 64 + p) * 17 + tau], pi = pwi[(d * 64 + p) * 17 + tau];
                const float xr = cr * pr - ci * pi, xi = cr * pi + ci * pr;
#pragma unroll
                for (int q = 0; q < 16; ++q) acc[q] += xr * bbr[(d * 64 + p) * 16 + q] - xi * bbi[(d * 64 + p) * 16 + q];
            }
            float* kt = (d ? kb : kf) + (tau * 16 + i) * 16;
#pragma unroll
            for (int q = 0; q < 16; ++q) kt[q] = acc[q];
        }
        __syncthreads();
        unsigned* bta = (unsigned*)(BTA + (size_t)g * 512 * 256);
        for (int idx = part * 128 * 128 + tid; idx < (part + 1) * 128 * 128; idx += 512) {
            const int row = idx >> 7, col = (idx & 127) * 2;
            float v[2];
#pragma unroll
            for (int e = 0; e < 2; ++e) {
                const int cc_ = col + e, j = cc_ >> 4, ip = cc_ & 15;
                if (row < 256) { const int t = row >> 4, i = row & 15;
                    v[e] = j < t ? kf[((t - j) * 16 + i) * 16 + ip] : (j > t ? kb[((j - t) * 16 + i) * 16 + ip] : kf[i * 16 + ip] + kb[i * 16 + ip]); }
                else { const int kp = row - 256, d = kp >> 7, part = (kp >> 6) & 1, p = kp & 63, tau = d == 0 ? 15 - j : j;
                    const float pr = pwr[(d * 64 + p) * 17 + tau], pi = pwi[(d * 64 + p) * 17 + tau], br = bbr[(d * 64 + p) * 16 + ip], bi = bbi[(d * 64 + p) * 16 + ip];
                    v[e] = part ? pr * bi + pi * br : pr * br - pi * bi; }
            }
            bta[idx] = pk2(v[0], v[1]);
        }
        unsigned* btc = (unsigned*)(BTC + (size_t)g * 256 * 256);
        for (int idx = part * 64 * 128 + tid; idx < (part + 1) * 64 * 128; idx += 512) {
            const int row = idx >> 7, col = (idx & 127) * 2, t = row >> 4, i = row & 15;
            float v[2];
#pragma unroll
            for (int e = 0; e < 2; ++e) {
                const int k = col + e, d = k >> 7, part = (k >> 6) & 1, p = k & 63, tau = d == 0 ? t + 1 : 16 - t;
                const float cr = ccr[(d * 64 + p) * 16 + i], ci = cci[(d * 64 + p) * 16 + i], pr = pwr[(d * 64 + p) * 17 + tau], pi = pwi[(d * 64 + p) * 17 + tau];
                v[e] = part ? -(cr * pi + ci * pr) : cr * pr - ci * pi;
            }
            btc[idx] = pk2(v[0], v[1]);
        }
        __syncthreads();
    }
}

__device__ __forceinline__ void phase_15(CParams& P, unsigned char* lds, const int ph) {
    PHASE_PROLOGUE
    pg8::S5OrderA S{vcu, (const char*)HN, (const char*)BTA};
    pg8::EpiS5A E{YI, S5E};
    int Kr = 256; asm volatile("" : "+s"(Kr));
    pg8::gemm_phase<pg8::EpiS5A, pg8::S5OrderA, true, true>((PG8_LAS unsigned char*)lds, Kr, S, E);
}

__device__ __forceinline__ void phase_16(CParams& P, unsigned char* lds, const int ph) {
    PHASE_PROLOGUE
    float* Ls = (float*)lds;
    for (int wg = bid; wg < NB * 64 * 2; wg += G) {
        const int d = wg & 1, g = (wg >> 1) & 63, b = wg >> 7, p = lane;
        const float step = __expf(s5_ls[d * 64 + g]);
        const float lr = s5_lre[(d * 64 + g) * 64 + p], li = s5_lim[(d * 64 + g) * 64 + p];
        const float mag = expf(lr * step);
        const float abr = mag * cosf(li * step), abi = mag * sinf(li * step);
        float ar = 1.f, ai = 0.f;
        for (int t = 0; t < 16; ++t) { const float nr = ar * abr - ai * abi; ai = ar * abi + ai * abr; ar = nr; }
        float Ar = 1.f, Ai = 0.f;
        for (int t = 0; t < 64; ++t) { const float nr = Ar * ar - Ai * ai; Ai = Ar * ai + Ai * ar; Ar = nr; }
        const bf16_t* Ep = S5E + (size_t)g * 256 + d * 128 + p;
        bf16_t* Cp = CAR + (size_t)g * 1280 * 256 + d * 128 + p;
        const int q0 = 64 * wave;
#define S5_N(q_) ({ const int c_ = d ? 512 - (q_) : (q_); c_ == 0 ? 1024 + b : b * 512 + c_ - 1; })
        float sr = 0.f, si = 0.f;
#pragma unroll 1
        for (int hb = 0; hb < 2; ++hb) {
            float er[32], ei[32];
#pragma unroll
            for (int k = 0; k < 32; ++k) { const int n = S5_N(q0 + 32 * hb + k); er[k] = bf2f(Ep[(size_t)n * 64 * 256]); ei[k] = bf2f(Ep[(size_t)n * 64 * 256 + 64]); }
#pragma unroll
            for (int k = 0; k < 32; ++k) { const float nr = ar * sr - ai * si + er[k]; si = ar * si + ai * sr + ei[k]; sr = nr; }
        }
        Ls[(wave * 64 + p) * 2] = sr; Ls[(wave * 64 + p) * 2 + 1] = si;
        __syncthreads();
        sr = 0.f; si = 0.f;
        for (int w2 = 0; w2 < wave; ++w2) { const float l0 = Ls[(w2 * 64 + p) * 2], l1 = Ls[(w2 * 64 + p) * 2 + 1]; const float nr = Ar * sr - Ai * si + l0; si = Ar * si + Ai * sr + l1; sr = nr; }
#pragma unroll 1
        for (int hb = 0; hb < 2; ++hb) {
            float er[32], ei[32]; int nn[32];
#pragma unroll
            for (int k = 0; k < 32; ++k) { nn[k] = S5_N(q0 + 32 * hb + k); er[k] = bf2f(Ep[(size_t)nn[k] * 64 * 256]); ei[k] = bf2f(Ep[(size_t)nn[k] * 64 * 256 + 64]); }
#pragma unroll
            for (int k = 0; k < 32; ++k) { Cp[(size_t)nn[k] * 256] = (bf16_t)f2bf(sr); Cp[(size_t)nn[k] * 256 + 64] = (bf16_t)f2bf(si);
                const float nr = ar * sr - ai * si + er[k]; si = ar * si + ai * sr + ei[k]; sr = nr; }
        }
        if (wave == 7) { const int n = S5_N(512); Cp[(size_t)n * 256] = (bf16_t)f2bf(sr); Cp[(size_t)n * 256 + 64] = (bf16_t)f2bf(si); }
#undef S5_N
        __syncthreads();
    }
}

__device__ __forceinline__ void phase_22(CParams& P, unsigned char* lds, const int ph) {
    PHASE_PROLOGUE
    pg8::S5OrderC S{vcu, (const char*)CAR, (const char*)BTC};
    pg8::EpiS5C E{YI, HN, s5_d, A2};
    int Kr = 256; asm volatile("" : "+s"(Kr));
    pg8::gemm_phase<pg8::EpiS5C, pg8::S5OrderC, true, true>((PG8_LAS unsigned char*)lds, Kr, S, E);
}

__device__ __forceinline__ void phase_23(CParams& P, unsigned char* lds, const int ph) {
    PHASE_PROLOGUE
    if (gw < 64) meta_gemm<1>(A2 + (size_t)NMAIN * DM, WTGLU, H + (size_t)NMAIN * DM, gw, lane);
    pg8::DenseOrder S; S.init(A2, WTGLU, NMAIN, 2 * DM, DM, G, bid);
    pg8::EpiGlu E{H};
    pg8::gemm_phase<pg8::EpiGlu, pg8::DenseOrder, true, true>((PG8_LAS unsigned char*)lds, DM, S, E);
}
#define LAS __attribute__((address_space(3)))
#define CW_BAR 4096
#define XB_TMO      128
#define XB_XCNT(j)  (256  + 64 * (j))
#define XB_XSUB(j)  (1280 + 64 * (j))
#define XB_XGEN(j)  (2304 + 64 * (j))
#define XB_TOP      3328
#define XB_TOPGEN   3392
#define XCD_BAR_WORDS 3456
#define XB_SPIN_CAP (1u << 22)
__device__ __forceinline__ unsigned xb_ld(unsigned* p)              { return __hip_atomic_load(p, __ATOMIC_RELAXED, __HIP_MEMORY_SCOPE_AGENT); }
__device__ __forceinline__ unsigned xb_add(unsigned* p, unsigned v) { return __hip_atomic_fetch_add(p, v, __ATOMIC_RELAXED, __HIP_MEMORY_SCOPE_AGENT); }
__device__ __forceinline__ unsigned xb_xcc_id() { return (unsigned)__builtin_amdgcn_s_getreg((3 << 11) | 20) & 0xFu; }
#define XB_SPIN(cond, bar) do { unsigned _sp = 0; while (cond) { __builtin_amdgcn_s_sleep(1); \
    if ((++_sp & 255u) == 0u) { if (xb_ld(&(bar)[XB_TMO])) break; if (_sp > XB_SPIN_CAP) { atomicAdd(&(bar)[XB_TMO], 1u); break; } } } } while (0)
struct XcdBarrier { unsigned* bar; unsigned x; volatile LAS unsigned* st; };
__device__ __forceinline__ XcdBarrier xcd_barrier_post(unsigned* bar, volatile LAS unsigned* st) {
    XcdBarrier b; b.bar = bar; b.x = xb_xcc_id(); b.st = st;
    if (threadIdx.x == 0) (void)xb_add(&bar[XB_XCNT(b.x)], 1u);
    return b;
}
__device__ __forceinline__ void xcd_barrier_complete(unsigned* bar, unsigned x, unsigned& nloc, unsigned& nx) {
    const unsigned G = GRID;
    unsigned sum, cnt, mine, sp = 0u;
    for (;;) {
        sum = 0u; cnt = 0u; mine = 0u;
#pragma unroll
        for (unsigned j = 0; j < 16; ++j) { const unsigned c = xb_ld(&bar[XB_XCNT(j)]); sum += c; cnt += (c > 0u) ? 1u : 0u; mine = (j == x) ? c : mine; }
        if (sum == G) break;
        __builtin_amdgcn_s_sleep(1);
        if ((++sp & 255u) == 0u) { if (xb_ld(&bar[XB_TMO])) break; if (sp > XB_SPIN_CAP) { atomicAdd(&bar[XB_TMO], 1u); break; } }
    }
    nloc = mine > 0u ? mine : 1u; nx = cnt > 0u ? cnt : 1u;
}
__device__ __forceinline__ void xcd_barrier(const XcdBarrier& b) {
    asm volatile("s_waitcnt vmcnt(0)" ::: "memory");
    __syncthreads();
    if (threadIdx.x == 0) {
        unsigned* bar = b.bar;
        __builtin_amdgcn_s_waitcnt(0);
        unsigned nloc = b.st[0], nx = b.st[1];
        if (nloc == 0u) { xcd_barrier_complete(bar, b.x, nloc, nx); b.st[0] = nloc; b.st[1] = nx; }
        const unsigned old = xb_add(&bar[XB_XSUB(b.x)], 1u);
        const unsigned gen = old / nloc;
        if (old + 1u == (gen + 1u) * nloc) {
            __builtin_amdgcn_fence(__ATOMIC_RELEASE, "agent");
            asm volatile("s_waitcnt vmcnt(0)" ::: "memory");
            const unsigned og = xb_add(&bar[XB_TOP], 1u);
            const unsigned tg = og / nx;
            if (og + 1u == (tg + 1u) * nx) xb_add(&bar[XB_TOPGEN], 1u);
            else XB_SPIN(xb_ld(&bar[XB_TOPGEN]) == tg, bar);
            __builtin_amdgcn_fence(__ATOMIC_ACQUIRE, "agent");
            xb_add(&bar[XB_XGEN(b.x)], 1u);
            asm volatile("s_waitcnt vmcnt(0)" ::: "memory");
        } else {
            XB_SPIN(xb_ld(&bar[XB_XGEN(b.x)]) == gen, bar);
            __builtin_amdgcn_fence(__ATOMIC_ACQUIRE, "agent");
            asm volatile("s_waitcnt vmcnt(0)" ::: "memory");
        }
    }
    __syncthreads();
}


__global__ void __launch_bounds__(512, 2) mega(Params P_) {
    extern __shared__ __attribute__((aligned(16))) unsigned char lds[];
    volatile LAS unsigned* st = (volatile LAS unsigned*)(LAS unsigned char*)(lds + LDS_BARST);
    if (threadIdx.x < 16) st[threadIdx.x] = 0u;
    __syncthreads();
    CParams* pp = (CParams*)__builtin_amdgcn_kernarg_segment_ptr();
    (void)xcd_barrier_post((unsigned*)(pp->ws + WS_CTL) + CW_BAR, st);
#define GB do { XcdBarrier bar_; bar_.bar = (unsigned*)(pp->ws + WS_CTL) + CW_BAR; bar_.x = xb_xcc_id(); bar_.st = (volatile LAS unsigned*)(LAS unsigned char*)(lds + LDS_BARST); xcd_barrier(bar_); asm volatile("" : "+s"(pp)); } while (0)
#define P (*pp)
    asm volatile("" : "+s"(pp));
    phase_0(P, lds, 0); GB;
#if defined(PROBE_PH) && PROBE_PH == 0
    { int nrep = PROBE_N; asm volatile("" : "+s"(nrep)); for (int rep = 0; rep < nrep; ++rep) { GB; phase_0(P, lds, 0); GB; } }
#endif
    phase_1(P, lds, 1); GB;
#if defined(PROBE_PH) && PROBE_PH == 1
    { int nrep = PROBE_N; asm volatile("" : "+s"(nrep)); for (int rep = 0; rep < nrep; ++rep) { GB; phase_1(P, lds, 1); GB; } }
#endif
    phase_3(P, lds, 3); GB;
#if defined(PROBE_PH) && PROBE_PH == 3
    { int nrep = PROBE_N; asm volatile("" : "+s"(nrep)); for (int rep = 0; rep < nrep; ++rep) { GB; phase_3(P, lds, 3); GB; } }
#endif
    phase_4(P, lds, 4); GB;
#if defined(PROBE_PH) && PROBE_PH == 4
    { int nrep = PROBE_N; asm volatile("" : "+s"(nrep)); for (int rep = 0; rep < nrep; ++rep) { GB; phase_4(P, lds, 4); GB; } }
#endif
    phase_5(P, lds, 5); GB;
#if defined(PROBE_PH) && PROBE_PH == 5
    { int nrep = PROBE_N; asm volatile("" : "+s"(nrep)); for (int rep = 0; rep < nrep; ++rep) { GB; phase_5(P, lds, 5); GB; } }
#endif
    phase_6(P, lds, 6); GB;
    phase_60(P, lds, 60); GB;
#if defined(PROBE_PH) && PROBE_PH == 60
    { int nrep = PROBE_N; asm volatile("" : "+s"(nrep)); for (int rep = 0; rep < nrep; ++rep) { GB; phase_60(P, lds, 60); GB; } }
#endif
#if defined(PROBE_PH) && PROBE_PH == 6
    { int nrep = PROBE_N; asm volatile("" : "+s"(nrep)); for (int rep = 0; rep < nrep; ++rep) { GB; phase_6(P, lds, 6); GB; } }
#endif
    phase_7(P, lds, 7); GB;
#if defined(PROBE_PH) && PROBE_PH == 7
    { int nrep = PROBE_N; asm volatile("" : "+s"(nrep)); for (int rep = 0; rep < nrep; ++rep) { GB; phase_7(P, lds, 7); GB; } }
#endif
    phase_8(P, lds, 8); GB;
#if defined(PROBE_PH) && PROBE_PH == 8
    { int nrep = PROBE_N; asm volatile("" : "+s"(nrep)); for (int rep = 0; rep < nrep; ++rep) { GB; phase_8(P, lds, 8); GB; } }
#endif
    phase_9(P, lds, 9); GB;
#if defined(PROBE_PH) && PROBE_PH == 9
    { int nrep = PROBE_N; asm volatile("" : "+s"(nrep)); for (int rep = 0; rep < nrep; ++rep) { GB; phase_9(P, lds, 9); GB; } }
#endif
    phase_10(P, lds, 10); GB;
#if defined(PROBE_PH) && PROBE_PH == 10
    { int nrep = PROBE_N; asm volatile("" : "+s"(nrep)); for (int rep = 0; rep < nrep; ++rep) { GB; phase_10(P, lds, 10); GB; } }
#endif
    phase_11(P, lds, 11); GB;
#if defined(PROBE_PH) && PROBE_PH == 11
    { int nrep = PROBE_N; asm volatile("" : "+s"(nrep)); for (int rep = 0; rep < nrep; ++rep) { GB; phase_11(P, lds, 11); GB; } }
#endif
    phase_12(P, lds, 12); GB;
#if defined(PROBE_PH) && PROBE_PH == 12
    { int nrep = PROBE_N; asm volatile("" : "+s"(nrep)); for (int rep = 0; rep < nrep; ++rep) { GB; phase_12(P, lds, 12); GB; } }
#endif
    phase_13(P, lds, 13); GB;
#if defined(PROBE_PH) && PROBE_PH == 13
    { int nrep = PROBE_N; asm volatile("" : "+s"(nrep)); for (int rep = 0; rep < nrep; ++rep) { GB; phase_13(P, lds, 13); GB; } }
#endif
    phase_14(P, lds, 14); GB;
#if defined(PROBE_PH) && PROBE_PH == 14
    { int nrep = PROBE_N; asm volatile("" : "+s"(nrep)); for (int rep = 0; rep < nrep; ++rep) { GB; phase_14(P, lds, 14); GB; } }
#endif
    phase_15(P, lds, 15); GB;
#if defined(PROBE_PH) && PROBE_PH == 15
    { int nrep = PROBE_N; asm volatile("" : "+s"(nrep)); for (int rep = 0; rep < nrep; ++rep) { GB; phase_15(P, lds, 15); GB; } }
#endif
    phase_16(P, lds, 16); GB;
#if defined(PROBE_PH) && PROBE_PH == 16
    { int nrep = PROBE_N; asm volatile("" : "+s"(nrep)); for (int rep = 0; rep < nrep; ++rep) { GB; phase_16(P, lds, 16); GB; } }
#endif
    phase_22(P, lds, 22); GB;
#if defined(PROBE_PH) && PROBE_PH == 22
    { int nrep = PROBE_N; asm volatile("" : "+s"(nrep)); for (int rep = 0; rep < nrep; ++rep) { GB; phase_22(P, lds, 22); GB; } }
#endif
    phase_23(P, lds, 23); GB;
#if defined(PROBE_PH) && PROBE_PH == 23
    { int nrep = PROBE_N; asm volatile("" : "+s"(nrep)); for (int rep = 0; rep < nrep; ++rep) { GB; phase_23(P, lds, 23); GB; } }
#endif
    phase_9(P, lds, 17); GB;
#if defined(PROBE_PH) && PROBE_PH == 17
    { int nrep = PROBE_N; asm volatile("" : "+s"(nrep)); for (int rep = 0; rep < nrep; ++rep) { GB; phase_9(P, lds, 17); GB; } }
#endif
    phase_10(P, lds, 18); GB;
#if defined(PROBE_PH) && PROBE_PH == 18
    { int nrep = PROBE_N; asm volatile("" : "+s"(nrep)); for (int rep = 0; rep < nrep; ++rep) { GB; phase_10(P, lds, 18); GB; } }
#endif
    phase_11(P, lds, 19); GB;
#if defined(PROBE_PH) && PROBE_PH == 19
    { int nrep = PROBE_N; asm volatile("" : "+s"(nrep)); for (int rep = 0; rep < nrep; ++rep) { GB; phase_11(P, lds, 19); GB; } }
#endif
    phase_12(P, lds, 20); GB;
#if defined(PROBE_PH) && PROBE_PH == 20
    { int nrep = PROBE_N; asm volatile("" : "+s"(nrep)); for (int rep = 0; rep < nrep; ++rep) { GB; phase_12(P, lds, 20); GB; } }
#endif
    phase_13(P, lds, 21);
#if defined(PROBE_PH) && PROBE_PH == 21
    { int nrep = PROBE_N; asm volatile("" : "+s"(nrep)); for (int rep = 0; rep < nrep; ++rep) { GB; phase_13(P, lds, 21); GB; } }
#endif
#undef P
#undef GB
}

extern "C" void kernel_launch(void* const* d_in, const int* in_sizes, int n_in, void* d_out, int out_size, void* d_ws, size_t ws_size, hipStream_t stream) {
    static int ready = 0;
    if (!ready) {
        if (n_in != 35 || ws_size < WS_TOTAL) { fprintf(stderr, "kernel_launch: unexpected n_in %d or ws_size %zu (need %zu)\n", n_in, ws_size, (size_t)WS_TOTAL); ready = -1; return; }
        if (hipFuncSetAttribute((const void*)mega, hipFuncAttributeMaxDynamicSharedMemorySize, LDS_BYTES) != hipSuccess) { fprintf(stderr, "kernel_launch: hipFuncSetAttribute failed\n"); ready = -1; return; }
        ready = 1;
    }
    if (ready < 0) return;
    (void)hipMemsetAsync((char*)d_ws + WS_CTL, 0, 1 * MiB, stream);
    Params P{};
    for (int i = 0; i < 35; ++i) P.in[i] = (const float*)d_in[i];
    P.out = (float*)d_out; P.ws = (unsigned char*)d_ws; P.ph_lo = 0; P.ph_hi = 0;
    hipLaunchKernelGGL(mega, dim3(GRID), dim3(512), LDS_BYTES, stream, P);
}
```

```cpp
#include <hip/hip_runtime.h>
#include <stdint.h>
#include <stdio.h>

#define DM 1024
#define NB 2
#define SEQ 8192
#define NMETA 16
#define LSEQ (SEQ + NMETA)
#define NMAIN (NB * SEQ)
#define NT (NB * LSEQ)
#define NTP 16640
#define INCOLS 3328
#define RESTC 1792
#define NEXP 32
#define DFF 512
#define S5TC 48
#define S5NC 171
#define MOE_RT 256
#define MOE_MAXROWS 41216

typedef unsigned short bf16_t;
typedef short bf16x8 __attribute__((ext_vector_type(8)));
typedef float f32x4 __attribute__((ext_vector_type(4)));
typedef unsigned u32x4 __attribute__((ext_vector_type(4)));
typedef unsigned u32x2 __attribute__((ext_vector_type(2)));

constexpr size_t MiB = 1u << 20;
constexpr size_t cmax2(size_t a, size_t b) { return a > b ? a : b; }
constexpr size_t al64k(size_t x) { return (x + 65535) & ~(size_t)65535; }
constexpr size_t WS_CTL = 0;
constexpr size_t WS_H = 1 * MiB;
constexpr size_t WS_HN = WS_H + al64k((size_t)NT * DM * 2);
constexpr size_t WS_A2 = WS_HN + al64k((size_t)NTP * DM * 2);
constexpr size_t WS_WTIN = WS_A2 + al64k((size_t)NTP * DM * 2);
constexpr size_t WS_WTOUT = WS_WTIN + al64k((size_t)INCOLS * DM * 2);
constexpr size_t WS_WTGLU = WS_WTOUT + al64k((size_t)DM * DM * 2);
constexpr size_t WS_LRT = WS_WTGLU + al64k((size_t)2 * DM * DM * 2);
constexpr size_t WS_BIG = WS_LRT + al64k((size_t)(2 * 512 * 64 * 2 + 512 * 128) * 2);
constexpr size_t SZ_T512 = al64k((size_t)NT * 512 * 2);
constexpr size_t SZ_P512 = al64k((size_t)NTP * 512 * 2);
constexpr int RW_NCH = 129, RW_UNITS = 32 * RW_NCH;
constexpr size_t SZ_RWOP = al64k((size_t)RW_UNITS * 4096 * 2);
constexpr size_t WS_Q = WS_BIG;
constexpr size_t WS_K = WS_Q + SZ_P512;
constexpr size_t WS_V = WS_K + SZ_P512;
constexpr size_t WS_REST = WS_V + SZ_P512;
constexpr size_t WS_KR = WS_REST + al64k((size_t)NTP * RESTC * 2);
constexpr size_t WS_LOW = WS_KR + SZ_T512;
constexpr size_t WS_AA = WS_LOW + al64k((size_t)NT * 256 * 2);
constexpr size_t WS_XEARLY = WS_AA + 2 * SZ_T512;
constexpr size_t WS_PP = WS_REST;
constexpr size_t WS_QT = WS_PP + SZ_RWOP;
constexpr size_t WS_YT = WS_QT + SZ_RWOP;
constexpr size_t WS_ZT = WS_YT + SZ_RWOP;
constexpr size_t WS_XEND = cmax2(WS_XEARLY, WS_ZT + SZ_RWOP);
constexpr size_t WS_R = WS_XEND;
constexpr size_t WS_VV = WS_R + SZ_T512;
constexpr size_t WS_G = WS_VV + SZ_T512;
constexpr size_t WS_KK = WS_G + SZ_T512;
constexpr size_t WS_KKA = WS_KK + SZ_T512;
constexpr size_t WS_KD = WS_KKA + 2 * SZ_T512;
constexpr size_t WS_W = WS_KD + 2 * SZ_T512;
constexpr size_t WS_BC = WS_W + 2 * SZ_T512;
constexpr size_t WS_MIXEND = WS_BC + al64k((size_t)NT * 8 * 4);
constexpr size_t WS_YFB = WS_KK;
constexpr size_t WS_ROWTOK = WS_BIG;
constexpr size_t WS_HB = WS_ROWTOK + al64k((size_t)MOE_MAXROWS * 4);
constexpr size_t WS_YB = WS_HB + al64k((size_t)MOE_MAXROWS * DFF * 2);
constexpr size_t WS_WT13 = WS_YB + al64k((size_t)MOE_MAXROWS * DM * 2);
constexpr size_t WS_WT2 = WS_WT13 + al64k((size_t)NEXP * DM * DM * 2);
constexpr size_t WS_EID = WS_WT2 + al64k((size_t)NEXP * DM * DFF * 2);
constexpr size_t WS_POS = WS_EID + al64k((size_t)NT * 8);
constexpr size_t WS_DEST = WS_POS + al64k((size_t)NT * 8);
constexpr size_t WS_GATE = WS_DEST + al64k((size_t)NT * 8);
constexpr size_t WS_MOEEND = WS_GATE + al64k((size_t)NT * 8);
constexpr size_t WS_YI = WS_BIG;
constexpr size_t WS_E = WS_YI + al64k((size_t)NTP * DM * 2);
constexpr size_t WS_CAR = WS_E + al64k((size_t)1040 * 64 * 256 * 2);
constexpr size_t WS_BTA = WS_CAR + al64k((size_t)64 * 1280 * 256 * 2);
constexpr size_t WS_BTC = WS_BTA + al64k((size_t)64 * 512 * 256 * 2);
constexpr size_t WS_S5END = WS_BTC + al64k((size_t)64 * 256 * 256 * 2);
constexpr size_t cmax(size_t a, size_t b) { return a > b ? a : b; }
constexpr size_t WS_TOTAL = cmax(WS_MIXEND, cmax(WS_MOEEND, WS_S5END));
static_assert(WS_TOTAL <= 512 * MiB, "workspace map exceeds 512 MiB");

#define CW_CNT(l) (1024 + 64 * (l))

#define LDS_BYTES 163840
#define LDS_BARST (LDS_BYTES - 1024)
#define LDS_TAB (LDS_BYTES - 768)
#define LDS_RING (LDS_BYTES - 1024)
#define GRID 256

struct Params {
    const float* in[35];
    float* out;
    unsigned char* ws;
    int ph_lo, ph_hi;
};
typedef const __attribute__((address_space(4))) Params CParams;

__device__ __forceinline__ float bf2f(bf16_t v) { return __uint_as_float(((unsigned)v) << 16); }
typedef float f32x2c_ __attribute__((ext_vector_type(2)));
typedef __bf16 bf16x2c_ __attribute__((ext_vector_type(2)));
__device__ __forceinline__ unsigned pk2(float lo, float hi) { const f32x2c_ f = {lo, hi}; const bf16x2c_ b = __builtin_convertvector(f, bf16x2c_); return __builtin_bit_cast(unsigned, b); }
__device__ __forceinline__ unsigned f2bf(float f) { return (unsigned)__builtin_bit_cast(unsigned short, (__bf16)f); }
__device__ __forceinline__ float bflo(unsigned u) { return __uint_as_float(u << 16); }
__device__ __forceinline__ float bfhi(unsigned u) { return __uint_as_float(u & 0xffff0000u); }
__device__ __forceinline__ float wave_sum(float v) {
#pragma unroll
    for (int o = 1; o < 64; o <<= 1) v += __shfl_xor(v, o);
    return v;
}
__device__ __forceinline__ float wave_max(float v) {
#pragma unroll
    for (int o = 1; o < 64; o <<= 1) v = fmaxf(v, __shfl_xor(v, o));
    return v;
}
template <int CTRL> __device__ __forceinline__ float dppf(float v) { return __int_as_float(__builtin_amdgcn_update_dpp(0, __float_as_int(v), CTRL, 0xF, 0xF, true)); }
__device__ __forceinline__ float row16_sum(float v) { v += dppf<0xB1>(v); v += dppf<0x4E>(v); v += dppf<0x141>(v); v += dppf<0x140>(v); return v; }
__device__ __forceinline__ float sigmoidf_(float x) { return __builtin_amdgcn_rcpf(1.f + __expf(-x)); }
__device__ __forceinline__ int rowof(int b, int p) { return p < NMETA ? NMAIN + b * NMETA + p : b * SEQ + (p - NMETA); }

#define SA_STRIDE 40
template <class AF, class BF>
__device__ __forceinline__ void gemm_tile(unsigned char* lds, int K, int ldb, const AF& arow, const BF& bcol, f32x4 (&acc)[4][2]) {
    bf16_t* sA = (bf16_t*)lds;
    bf16_t* sB = (bf16_t*)(lds + 128 * SA_STRIDE * 2);
    const int tid = threadIdx.x, lane = tid & 63, wave = tid >> 6, wr = wave >> 2, wc = wave & 3, fr = lane & 15, fq = lane >> 4;
#pragma unroll
    for (int mi = 0; mi < 4; ++mi)
#pragma unroll
        for (int ni = 0; ni < 2; ++ni) acc[mi][ni] = (f32x4){0.f, 0.f, 0.f, 0.f};
    const int ar = tid >> 2, akc = (tid & 3) * 8;
    const bf16_t* ap = arow(ar) + akc;
    const int bnq = (tid & 31) * 4, bkp = (tid >> 5) * 2;
    const float* bp = bcol(bnq) + (size_t)bkp * ldb;
    const int nk = K / 32;
    u32x4 ra = *(const u32x4*)ap;
    f32x4 rb0 = *(const f32x4*)bp, rb1 = *(const f32x4*)(bp + ldb);
    for (int kt = 0; kt < nk; ++kt) {
        __syncthreads();
        *(u32x4*)(sA + ar * SA_STRIDE + akc) = ra;
        {
            unsigned* d = (unsigned*)(sB + bnq * SA_STRIDE + bkp);
            d[0 * (SA_STRIDE / 2)] = pk2(rb0[0], rb1[0]);
            d[1 * (SA_STRIDE / 2)] = pk2(rb0[1], rb1[1]);
            d[2 * (SA_STRIDE / 2)] = pk2(rb0[2], rb1[2]);
            d[3 * (SA_STRIDE / 2)] = pk2(rb0[3], rb1[3]);
        }
        __syncthreads();
        if (kt + 1 < nk) {
            ra = *(const u32x4*)(ap + (kt + 1) * 32);
            const float* q = bp + (size_t)(kt + 1) * 32 * ldb;
            rb0 = *(const f32x4*)q; rb1 = *(const f32x4*)(q + ldb);
        }
        bf16x8 a[4], b[2];
#pragma unroll
        for (int mi = 0; mi < 4; ++mi) a[mi] = *(const bf16x8*)(sA + (wr * 64 + mi * 16 + fr) * SA_STRIDE + fq * 8);
#pragma unroll
        for (int ni = 0; ni < 2; ++ni) b[ni] = *(const bf16x8*)(sB + (wc * 32 + ni * 16 + fr) * SA_STRIDE + fq * 8);
#pragma unroll
        for (int mi = 0; mi < 4; ++mi)
#pragma unroll
            for (int ni = 0; ni < 2; ++ni) acc[mi][ni] = __builtin_amdgcn_mfma_f32_16x16x32_bf16(a[mi], b[ni], acc[mi][ni], 0, 0, 0);
    }
    __syncthreads();
}
#define ACC_FOREACH(acc, ...) do { const int _l = threadIdx.x & 63, _w = threadIdx.x >> 6, _wr = _w >> 2, _wc = _w & 3, _fr = _l & 15, _fq = _l >> 4; \
    _Pragma("unroll") for (int _mi = 0; _mi < 4; ++_mi) _Pragma("unroll") for (int _ni = 0; _ni < 2; ++_ni) _Pragma("unroll") for (int _j = 0; _j < 4; ++_j) { \
        const int rl = _wr * 64 + _mi * 16 + _fq * 4 + _j, cl = _wc * 32 + _ni * 16 + _fr; const float val = acc[_mi][_ni][_j]; __VA_ARGS__ } } while (0)
#define ACC_FOREACH_PAIR(acc, ...) do { const int _l = threadIdx.x & 63, _w = threadIdx.x >> 6, _wr = _w >> 2, _wc = _w & 3, _fr = _l & 15, _fq = _l >> 4; \
    _Pragma("unroll") for (int _mi = 0; _mi < 4; ++_mi) _Pragma("unroll") for (int _j = 0; _j < 4; ++_j) { \
        const int rl = _wr * 64 + _mi * 16 + _fq * 4 + _j, co = _wc * 16 + _fr; const float va = acc[_mi][0][_j], vg = acc[_mi][1][_j]; __VA_ARGS__ } } while (0)

__device__ __forceinline__ void store_norm_bf16(const f32x4 (&v)[4], const float* gain, bf16_t* dst, int lane) {
    float ss = 0.f;
#pragma unroll
    for (int j = 0; j < 4; ++j) ss += v[j][0] * v[j][0] + v[j][1] * v[j][1] + v[j][2] * v[j][2] + v[j][3] * v[j][3];
    ss = wave_sum(ss);
    const float rstd = rsqrtf(ss * (1.f / DM) + 1e-6f);
#pragma unroll
    for (int j = 0; j < 4; ++j) {
        const f32x4 g = ((const f32x4*)gain)[lane + 64 * j];
        u32x2 o; o.x = pk2(v[j][0] * rstd * g[0], v[j][1] * rstd * g[1]); o.y = pk2(v[j][2] * rstd * g[2], v[j][3] * rstd * g[3]);
        ((u32x2*)dst)[lane + 64 * j] = o;
    }
}


__device__ __forceinline__ f32x4 ldrow_bf16(const bf16_t* row, int lane, int j) { const u32x2 u = ((const u32x2*)row)[lane + 64 * j]; return (f32x4){bflo(u.x), bfhi(u.x), bflo(u.y), bfhi(u.y)}; }
__device__ __forceinline__ void strow_bf16(bf16_t* row, int lane, int j, const f32x4 v) { u32x2 o; o.x = pk2(v[0], v[1]); o.y = pk2(v[2], v[3]); ((u32x2*)row)[lane + 64 * j] = o; }
namespace pg8 {
#define PG8_LAS __attribute__((address_space(3)))
constexpr int BM = 256, BK = 64, HALF = 128, HTB = HALF * BK * 2  , STAGE_BYTES = 8 * HTB, NXCD = 8, WGM = 8;
__host__ __device__ __forceinline__ int lds_byte(int r, int c) { const int st = (r >> 4) * 2 + (c >> 5), rr = r & 15, cc = c & 31, ob = rr * 64 + cc * 2; return st * 1024 + (ob ^ (((ob >> 9) & 1) << 5)); }
__host__ __device__ __forceinline__ void stage_rc(int b, int& R, int& C) { const int st = b / 1024, sb = b % 1024, swz = sb ^ (((sb >> 9) & 1) << 5); R = (st >> 1) * 16 + swz / 64; C = (st & 1) * 32 + (swz % 64) / 2; }
__host__ __device__ __forceinline__ int perm32(int rho) { const int n = rho >> 4, i = rho & 15; return 8 * (i >> 2) + 4 * n + (i & 3); }

struct Unit { int pm, pn; const char* A; const char* B; };

struct DenseOrder {
    static constexpr bool GATHER_ROWS = false;
    static constexpr bool GATHER_A = false;
    int nM, nN, nwg, G, c; const char* A; const char* Bt; size_t tstep;
    __device__ void init(const bf16_t* A_, const bf16_t* Bt_, int M, int N, int K, int G_, int c_) { nM = M / BM; nN = N / BM; nwg = nM * nN; G = G_; c = c_; A = (const char*)A_; Bt = (const char*)Bt_; tstep = (size_t)BM * K * 2; }
    __device__ bool next(int i, Unit& u) const {
        const long L = (long)i * G + c; if (L >= nwg) return false;
        int wgid = (int)L; { const int q = nwg / NXCD, r = nwg % NXCD, xcd = wgid % NXCD, off = wgid / NXCD; wgid = (xcd < r ? xcd * (q + 1) : r * (q + 1) + (xcd - r) * q) + off; }
        const int nig = WGM * nN, gid = wgid / nig, fm = gid * WGM, gsz = (nM - fm) < WGM ? (nM - fm) : WGM;
        u.pm = fm + ((wgid % nig) % gsz); u.pn = (wgid % nig) / gsz; u.A = A + (size_t)u.pm * tstep; u.B = Bt + (size_t)u.pn * tstep; return true;
    }
    __device__ __forceinline__ void a_ready(const Unit&) const {}
    __device__ __forceinline__ void done(const Unit&) const {}
};
struct ProjOrder {
    static constexpr bool GATHER_ROWS = false;
    static constexpr bool GATHER_A = false;
    DenseOrder D; const char* HNp; const char* WT;
    __device__ void init(const bf16_t* HN_, const bf16_t* WT_, int c_) { D.init(HN_, WT_, NTP, 13 * BM, DM, GRID, c_); HNp = (const char*)HN_; WT = (const char*)WT_; }
    __device__ bool next(int i, Unit& u) const {
        if (!D.next(i, u)) return false;
        const size_t ts = (size_t)BM * DM * 2;
        if (u.pn < 11) { const int wrow = u.pn < 4 ? u.pn : u.pn + 2; u.A = HNp + (size_t)u.pm * ts; u.B = WT + (size_t)wrow * ts; }
        else { u.A = WT + (size_t)(4 + (u.pn - 11)) * ts; u.B = HNp + (size_t)u.pm * ts; }
        return true;
    }
    __device__ __forceinline__ void a_ready(const Unit&) const {}
    __device__ __forceinline__ void done(const Unit&) const {}
};
template <bool GATHER> struct MoeOrder {
    static constexpr bool GATHER_ROWS = GATHER;
    static constexpr bool GATHER_A = false;
    const int* et; int TT, vcu; const char* A; const char* Bt; unsigned tstepA, tstepB, estep; const int* rowidx;
    __device__ __forceinline__ bool next(int i, Unit& u) const {
        const int L = i * GRID + vcu; if (L >= TT * 4) return false;
        const int rt = L >> 2, ct = L & 3, e = et[rt];
        u.pm = rt; u.pn = ct; u.A = GATHER ? A : A + (size_t)rt * tstepA; u.B = Bt + (size_t)e * estep + (size_t)ct * tstepB; return true;
    }
    __device__ __forceinline__ void a_ready(const Unit&) const {}
    __device__ __forceinline__ void done(const Unit&) const {}
};

struct S5OrderA {
    static constexpr bool GATHER_ROWS = false;
    static constexpr bool GATHER_A = true;
    int vcu; const char* U; const char* BTA;
    __device__ __forceinline__ bool next(int i, Unit& u) const {
        const int L = i * GRID + vcu; if (L >= 640) return false;
        const int g = L / 10, rem = L - g * 10, mt = rem >> 1, nt = rem & 1;
        u.pm = mt; u.pn = g * 2 + nt; u.A = U + ((size_t)mt * 256 * 16 * 1024 + g * 16) * 2; u.B = BTA + ((size_t)(g * 512 + nt * 256) * 256) * 2; return true;
    }
    __device__ __forceinline__ void a_ready(const Unit&) const {}
    __device__ __forceinline__ void done(const Unit&) const {}
};
struct S5OrderC {
    static constexpr bool GATHER_ROWS = false;
    static constexpr bool GATHER_A = false;
    int vcu; const char* CAR; const char* BTC;
    __device__ __forceinline__ bool next(int i, Unit& u) const {
        const int L = i * GRID + vcu; if (L >= 320) return false;
        const int g = L / 5, mt = L - g * 5;
        u.pm = mt; u.pn = g; u.A = CAR + ((size_t)(g * 1280 + mt * 256) * 256) * 2; u.B = BTC + ((size_t)g * 256 * 256) * 2; return true;
    }
    __device__ __forceinline__ void a_ready(const Unit&) const {}
    __device__ __forceinline__ void done(const Unit&) const {}
};
__device__ __forceinline__ unsigned cvt_pk_bf16(float lo, float hi) { return pk2(lo, hi); }

struct EpiProj {
    static constexpr bool PERM = true, AFTER_DRAIN = false;
    bf16_t *Q, *Kk, *VT, *REST;
    __device__ __forceinline__ void operator()(const f32x4 (&acc)[2][2][4][2], const Unit& u, int wr, int wc, int fr, int fq) const {
        bf16_t* base; int ldc; int row0, col0;
        if (u.pn < 11) { row0 = u.pm * BM + wr * 64 + fr; int colt;
            if (u.pn < 2) { base = Q; colt = u.pn * BM; ldc = 512; } else if (u.pn < 4) { base = Kk; colt = (u.pn - 2) * BM; ldc = 512; } else { base = REST; colt = (u.pn - 4) * BM; ldc = RESTC; }
            col0 = colt + wc * 32 + 8 * fq; }
        else { base = VT; ldc = NTP; row0 = (u.pn - 11) * BM + wr * 64 + fr; col0 = u.pm * BM + wc * 32 + 8 * fq; }
#pragma unroll
        for (int ai = 0; ai < 2; ++ai)
#pragma unroll
            for (int m = 0; m < 4; ++m) { bf16_t* rowp = base + (size_t)(row0 + ai * HALF + m * 16) * ldc + col0;
#pragma unroll
                for (int bj = 0; bj < 2; ++bj) { const f32x4 v0 = acc[ai][bj][m][0], v1 = acc[ai][bj][m][1];
                    u32x4 w; w.x = cvt_pk_bf16(v0[0], v0[1]); w.y = cvt_pk_bf16(v0[2], v0[3]); w.z = cvt_pk_bf16(v1[0], v1[1]); w.w = cvt_pk_bf16(v1[2], v1[3]);
                    *(u32x4*)(rowp + bj * HALF) = w; } }
    }
};
struct EpiBf16Plain {
    static constexpr bool PERM = true, AFTER_DRAIN = false;
    bf16_t* O; int ldc;
    __device__ __forceinline__ void operator()(const f32x4 (&acc)[2][2][4][2], const Unit& u, int wr, int wc, int fr, int fq) const {
        const int row0 = u.pm * BM + wr * 64 + fr; const int col0 = u.pn * BM + wc * 32 + 8 * fq;
#pragma unroll
        for (int ai = 0; ai < 2; ++ai)
#pragma unroll
            for (int m = 0; m < 4; ++m) { bf16_t* rowp = O + (size_t)(row0 + ai * HALF + m * 16) * ldc + col0;
#pragma unroll
                for (int bj = 0; bj < 2; ++bj) { const f32x4 v0 = acc[ai][bj][m][0], v1 = acc[ai][bj][m][1];
                    u32x4 w; w.x = cvt_pk_bf16(v0[0], v0[1]); w.y = cvt_pk_bf16(v0[2], v0[3]); w.z = cvt_pk_bf16(v1[0], v1[1]); w.w = cvt_pk_bf16(v1[2], v1[3]);
                    *(u32x4*)(rowp + bj * HALF) = w; } }
    }
};
struct EpiSwiglu {
    static constexpr bool PERM = true, AFTER_DRAIN = false;
    bf16_t* O;
    __device__ __forceinline__ void operator()(const f32x4 (&acc)[2][2][4][2], const Unit& u, int wr, int wc, int fr, int fq) const {
        const int row0 = u.pm * BM + wr * 64 + fr; const int col0 = u.pn * HALF + wc * 32 + 8 * fq;
#pragma unroll
        for (int ai = 0; ai < 2; ++ai)
#pragma unroll
            for (int m = 0; m < 4; ++m) {
                float o[8];
#pragma unroll
                for (int n = 0; n < 2; ++n)
#pragma unroll
                    for (int i = 0; i < 4; ++i) { const float va = acc[ai][0][m][n][i], vg = acc[ai][1][m][n][i]; o[4 * n + i] = va * __builtin_amdgcn_rcpf(1.f + __expf(-va)) * vg; }
                u32x4 w; w.x = cvt_pk_bf16(o[0], o[1]); w.y = cvt_pk_bf16(o[2], o[3]); w.z = cvt_pk_bf16(o[4], o[5]); w.w = cvt_pk_bf16(o[6], o[7]);
                *(u32x4*)(O + (size_t)(row0 + ai * HALF + m * 16) * DFF + col0) = w; }
    }
};
struct EpiResidual {
    static constexpr bool PERM = true, AFTER_DRAIN = false;
    bf16_t* Hh;
    __device__ __forceinline__ void operator()(const f32x4 (&acc)[2][2][4][2], const Unit& u, int wr, int wc, int fr, int fq) const {
        const int row0 = u.pm * BM + wr * 64 + fr; const int col0 = u.pn * BM + wc * 32 + 8 * fq;
#pragma unroll
        for (int ai = 0; ai < 2; ++ai)
#pragma unroll
            for (int m = 0; m < 4; ++m) { bf16_t* rowp = Hh + (size_t)(row0 + ai * HALF + m * 16) * DM + col0;
#pragma unroll
                for (int bj = 0; bj < 2; ++bj) { u32x4* p = (u32x4*)(rowp + bj * HALF); const u32x4 hv = *p; const f32x4 v0 = acc[ai][bj][m][0], v1 = acc[ai][bj][m][1];
                    u32x4 w; w.x = cvt_pk_bf16(__uint_as_float(hv.x << 16) + v0[0], __uint_as_float(hv.x & 0xffff0000u) + v0[1]); w.y = cvt_pk_bf16(__uint_as_float(hv.y << 16) + v0[2], __uint_as_float(hv.y & 0xffff0000u) + v0[3]);
                    w.z = cvt_pk_bf16(__uint_as_float(hv.z << 16) + v1[0], __uint_as_float(hv.z & 0xffff0000u) + v1[1]); w.w = cvt_pk_bf16(__uint_as_float(hv.w << 16) + v1[2], __uint_as_float(hv.w & 0xffff0000u) + v1[3]);
                    *p = w; } }
    }
};
struct EpiGlu {
    static constexpr bool PERM = true, AFTER_DRAIN = false;
    bf16_t* Hh;
    __device__ __forceinline__ void operator()(const f32x4 (&acc)[2][2][4][2], const Unit& u, int wr, int wc, int fr, int fq) const {
        const int row0 = u.pm * BM + wr * 64 + fr; const int col0 = u.pn * HALF + wc * 32 + 8 * fq;
#pragma unroll
        for (int ai = 0; ai < 2; ++ai)
#pragma unroll
            for (int m = 0; m < 4; ++m) { u32x4* p = (u32x4*)(Hh + (size_t)(row0 + ai * HALF + m * 16) * DM + col0); const u32x4 hv = *p;
                float o[8];
#pragma unroll
                for (int n = 0; n < 2; ++n)
#pragma unroll
                    for (int i = 0; i < 4; ++i) { const unsigned hw = hv[2 * n + (i >> 1)]; const float hcur = (i & 1) ? __uint_as_float(hw & 0xffff0000u) : __uint_as_float(hw << 16);
                        o[4 * n + i] = hcur + acc[ai][0][m][n][i] * __builtin_amdgcn_rcpf(1.f + __expf(-acc[ai][1][m][n][i])); }
                u32x4 w; w.x = cvt_pk_bf16(o[0], o[1]); w.y = cvt_pk_bf16(o[2], o[3]); w.z = cvt_pk_bf16(o[4], o[5]); w.w = cvt_pk_bf16(o[6], o[7]);
                *p = w; }
    }
};
struct EpiS5A {
    static constexpr bool PERM = true, AFTER_DRAIN = false;
    bf16_t* YI; bf16_t* E;
    __device__ __forceinline__ void operator()(const f32x4 (&acc)[2][2][4][2], const Unit& u, int wr, int wc, int fr, int fq) const {
        const int g = u.pn >> 1, nt = u.pn & 1;
        const int cl0 = wc * 32 + 8 * fq;
        bf16_t* base = nt == 0 ? YI + (size_t)(cl0 >> 4) * DM + g * 16 + (cl0 & 15) : E + (size_t)g * 256 + cl0;
        const size_t nstride = 16 * DM;
        const size_t bjstep = nt == 0 ? (size_t)8 * DM : (size_t)HALF;
#pragma unroll
        for (int ai = 0; ai < 2; ++ai)
#pragma unroll
            for (int m = 0; m < 4; ++m) { int n = u.pm * BM + ai * HALF + wr * 64 + m * 16 + fr; n = n < 1039 ? n : 1039;
                bf16_t* p = base + (size_t)n * nstride;
#pragma unroll
                for (int bj = 0; bj < 2; ++bj) { const f32x4 v0 = acc[ai][bj][m][0], v1 = acc[ai][bj][m][1];
                    u32x4 w; w.x = cvt_pk_bf16(v0[0], v0[1]); w.y = cvt_pk_bf16(v0[2], v0[3]); w.z = cvt_pk_bf16(v1[0], v1[1]); w.w = cvt_pk_bf16(v1[2], v1[3]);
                    *(u32x4*)(p + bj * bjstep) = w; } }
    }
};
struct EpiS5C {
    static constexpr bool PERM = true, AFTER_DRAIN = false;
    const bf16_t* YI; const bf16_t* Uu; const float* dvec; bf16_t* O;
    __device__ __forceinline__ void operator()(const f32x4 (&acc)[2][2][4][2], const Unit& u, int wr, int wc, int fr, int fq) const {
        const int g = u.pn;
        const int cl0 = wc * 32 + 8 * fq, ch = g * 16 + (cl0 & 15);
        const size_t off0 = (size_t)(cl0 >> 4) * DM + ch;
        const f32x4 d0 = *(const f32x4*)(dvec + ch), d1 = *(const f32x4*)(dvec + ch + 4);
#pragma unroll
        for (int ai = 0; ai < 2; ++ai)
#pragma unroll
            for (int m = 0; m < 4; ++m) { int n = u.pm * BM + ai * HALF + wr * 64 + m * 16 + fr; n = n < 1039 ? n : 1039;
#pragma unroll
                for (int bj = 0; bj < 2; ++bj) {
                    const size_t off = off0 + (size_t)n * (16 * DM) + (size_t)bj * (8 * DM);
                    const u32x4 yv = *(const u32x4*)(YI + off);
                    const f32x4 y0 = (f32x4){__uint_as_float(yv[0] << 16), __uint_as_float(yv[0] & 0xffff0000u), __uint_as_float(yv[1] << 16), __uint_as_float(yv[1] & 0xffff0000u)},
                                y1 = (f32x4){__uint_as_float(yv[2] << 16), __uint_as_float(yv[2] & 0xffff0000u), __uint_as_float(yv[3] << 16), __uint_as_float(yv[3] & 0xffff0000u)};
                    const u32x4 uv = *(const u32x4*)(Uu + off);
                    float y[8];
#pragma unroll
                    for (int q = 0; q < 4; ++q) { y[q] = acc[ai][bj][m][0][q] + y0[q] + d0[q] * (q & 1 ? __uint_as_float(uv[q >> 1] & 0xffff0000u) : __uint_as_float(uv[q >> 1] << 16));
                        y[4 + q] = acc[ai][bj][m][1][q] + y1[q] + d1[q] * (q & 1 ? __uint_as_float(uv[2 + (q >> 1)] & 0xffff0000u) : __uint_as_float(uv[2 + (q >> 1)] << 16)); }
#pragma unroll
                    for (int q = 0; q < 8; ++q) { const float z = 1.5957691216f * (y[q] + 0.044715f * y[q] * y[q] * y[q]); y[q] = y[q] * __builtin_amdgcn_rcpf(1.f + __expf(-z)); }
                    u32x4 w; w.x = cvt_pk_bf16(y[0], y[1]); w.y = cvt_pk_bf16(y[2], y[3]); w.z = cvt_pk_bf16(y[4], y[5]); w.w = cvt_pk_bf16(y[6], y[7]);
                    *(u32x4*)(O + off) = w; }
                asm volatile("" ::: "memory"); }
    }
};

template <class Epi, class Sched, bool ALIGN_EPI = false, bool SP2 = false>
__device__ __forceinline__ void gemm_phase(PG8_LAS unsigned char* lds, const int K, const Sched& S, const Epi& E) {
    int tid_ = threadIdx.x; asm volatile("" : "+v"(tid_));
    const int tid = tid_, wid = __builtin_amdgcn_readfirstlane(tid >> 6), lane = tid & 63, wr = wid >> 2, wc = wid & 3, fr = lane & 15, fq = lane >> 4;
    const int nt = K / BK;
    unsigned vA0[2], vA1[2], nA0[2], nA1[2], voffB[2];
#pragma unroll
    for (int i = 0; i < 2; ++i) { int R, C; stage_rc(tid * 16 + i * 8192, R, C); const int Rb = Epi::PERM ? ((R & ~31) + perm32(R & 31)) : R;
        vA0[i] = Sched::GATHER_A ? (unsigned)(((16 * R + (C >> 4)) * 1024 + (C & 15)) * 2) : (unsigned)(R * K + C) * 2u; voffB[i] = (unsigned)(Rb * K + C) * 2u; }
    const size_t kstep = (size_t)(BK * 2);
    const size_t hstep = (size_t)HALF * K * 2;
    const size_t kstepA = Sched::GATHER_A ? (size_t)(4 * 1024 * 2) : kstep, hstepA = Sched::GATHER_A ? (size_t)HALF * 16 * 1024 * 2 : hstep;
#define PG8_ROWOFFS(u_, d0_, d1_) do { _Pragma("unroll") for (int i_ = 0; i_ < 2; ++i_) { int R_, C_; stage_rc(tid * 16 + i_ * 8192, R_, C_); \
        d0_[i_] = (unsigned)(S.rowidx[(u_).pm * BM + R_] * K + C_) * 2u; d1_[i_] = (unsigned)(S.rowidx[(u_).pm * BM + HALF + R_] * K + C_) * 2u; } } while (0)
#define PG8_STAGE_A(bufoff, gbase, h_, nx_) do { _Pragma("unroll") for (int _i = 0; _i < 2; ++_i) { const unsigned vo_ = (nx_) ? ((h_) ? nA1[_i] : nA0[_i]) : ((h_) ? vA1[_i] : vA0[_i]); \
        __builtin_amdgcn_global_load_lds((const unsigned*)((const char*)(gbase) + vo_), (PG8_LAS unsigned*)(lds + (bufoff) + ldsw + _i * 8192), 16, 0, 0); } } while (0)
    const unsigned ldsw = (unsigned)wid * 1024u;
    const int aoff = lds_byte(wr * 64 + fr, fq * 8), boff = lds_byte(wc * 32 + fr, fq * 8);
#define PG8_SA(b, h) (((b) * 2 + (h)) * HTB)
#define PG8_SB(b, h) ((4 + (b) * 2 + (h)) * HTB)
#define PG8_STAGE(bufoff, gbase, voff) do { _Pragma("unroll") for (int _i = 0; _i < 2; ++_i) \
        __builtin_amdgcn_global_load_lds((const unsigned*)((const char*)(gbase) + (voff)[_i]), (PG8_LAS unsigned*)(lds + (bufoff) + ldsw + _i * 8192), 16, 0, 0); } while (0)
#define PG8_LDA(dst, b, h) do { _Pragma("unroll") for (int m = 0; m < 4; ++m) _Pragma("unroll") for (int k = 0; k < 2; ++k) dst[m][k] = *(const PG8_LAS bf16x8*)(lds + PG8_SA(b, h) + aoff + m * 2048 + k * 1024); } while (0)
#define PG8_LDB(dst, b, h) do { _Pragma("unroll") for (int n = 0; n < 2; ++n) _Pragma("unroll") for (int k = 0; k < 2; ++k) dst[n][k] = *(const PG8_LAS bf16x8*)(lds + PG8_SB(b, h) + boff + n * 2048 + k * 1024); } while (0)
#define PG8_MMA(ai, bj, At, Bt) do { __builtin_amdgcn_s_setprio(1); _Pragma("unroll") for (int m = 0; m < 4; ++m) _Pragma("unroll") for (int n = 0; n < 2; ++n) _Pragma("unroll") for (int k = 0; k < 2; ++k) \
        acc[ai][bj][m][n] = __builtin_amdgcn_mfma_f32_16x16x32_bf16(Bt[n][k], At[m][k], acc[ai][bj][m][n], 0, 0, 0); __builtin_amdgcn_s_setprio(0); } while (0)
#define PG8_WAIT_V(n) asm volatile("s_waitcnt vmcnt(" #n ")" ::: "memory")
#define PG8_WAIT_L(n) asm volatile("s_waitcnt lgkmcnt(" #n ")" ::: "memory")
#define PG8_BAR __builtin_amdgcn_s_barrier()
#define PG8_SCHED __builtin_amdgcn_sched_barrier(0)
    Unit cur, nxt; int ui = 0;
    if (!S.next(0, cur)) return;
    f32x4 acc[2][2][4][2];
#pragma unroll
    for (int a = 0; a < 2; ++a)
#pragma unroll
        for (int b = 0; b < 2; ++b)
#pragma unroll
            for (int m = 0; m < 4; ++m)
#pragma unroll
                for (int n = 0; n < 2; ++n) acc[a][b][m][n] = (f32x4){0.f, 0.f, 0.f, 0.f};
    bf16x8 At[4][2], B0[2][2], B1[2][2];
    const char* cA = cur.A; const char* cB = cur.B;
    if constexpr (Sched::GATHER_ROWS) { PG8_ROWOFFS(cur, vA0, vA1); }
    else {
#pragma unroll
        for (int i = 0; i < 2; ++i) vA1[i] = vA0[i] + (unsigned)hstepA;
    }
#pragma unroll
    for (int i = 0; i < 2; ++i) { nA0[i] = vA0[i]; nA1[i] = vA1[i]; }
    S.a_ready(cur);
    if constexpr (SP2) {
        PG8_STAGE(PG8_SB(0, 0), cB, voffB); PG8_STAGE(PG8_SB(0, 1), cB + hstep, voffB); PG8_STAGE_A(PG8_SA(0, 0), cA, 0, false); PG8_STAGE_A(PG8_SA(0, 1), cA, 1, false);
        if (wr == 1) PG8_BAR;
        PG8_WAIT_V(2); PG8_BAR;
        PG8_STAGE(PG8_SB(1, 0), cB + kstep, voffB); PG8_STAGE_A(PG8_SA(1, 0), cA + kstepA, 0, false); PG8_STAGE(PG8_SB(1, 1), cB + hstep + kstep, voffB);
        PG8_WAIT_V(6); PG8_BAR;
    } else {
        PG8_STAGE(PG8_SB(0, 0), cB, voffB); PG8_STAGE_A(PG8_SA(0, 0), cA, 0, false); PG8_STAGE(PG8_SB(0, 1), cB + hstep, voffB); PG8_STAGE_A(PG8_SA(0, 1), cA, 1, false);
        if (wr == 1) PG8_BAR;
        PG8_WAIT_V(4); PG8_BAR;
        PG8_STAGE(PG8_SB(1, 0), cB + kstep, voffB); PG8_STAGE_A(PG8_SA(1, 0), cA + kstepA, 0, false); PG8_STAGE(PG8_SB(1, 1), cB + hstep + kstep, voffB);
        PG8_WAIT_V(6); PG8_BAR;
    }
    for (;;) {
        const bool has_next = S.next(ui + 1, nxt);
        if constexpr (Sched::GATHER_ROWS) { if (has_next) PG8_ROWOFFS(nxt, nA0, nA1); }
        const char* nA = has_next ? nxt.A : cA; const char* nB = has_next ? nxt.B : cB;
        for (int t = 0; t < nt; t += 2) {
            const bool last = (t == nt - 2);
            const char* a1 = cA + (size_t)(t + 1) * kstepA;
            const char* a2 = last ? nA : cA + (size_t)(t + 2) * kstepA; const char* b2 = last ? nB : cB + (size_t)(t + 2) * kstep;
            const char* a3 = a2 + kstepA; const char* b3 = b2 + kstep;
            if (last && has_next) S.a_ready(nxt);
            if constexpr (SP2) {
            PG8_LDB(B0, 0, 0); PG8_LDB(B1, 0, 1); PG8_SCHED; PG8_LDA(At, 0, 0); PG8_STAGE_A(PG8_SA(1, 1), a1, 1, false);
            PG8_WAIT_V(8); PG8_WAIT_L(0); PG8_BAR; PG8_MMA(0, 0, At, B0); PG8_MMA(0, 1, At, B1); PG8_BAR; PG8_SCHED;
            PG8_LDA(At, 0, 1); PG8_STAGE(PG8_SB(0, 0), b2, voffB); PG8_STAGE(PG8_SB(0, 1), b2 + hstep, voffB); PG8_STAGE_A(PG8_SA(0, 0), a2, 0, last);
            PG8_WAIT_V(8); PG8_WAIT_L(0); PG8_BAR; PG8_MMA(1, 0, At, B0); PG8_MMA(1, 1, At, B1); PG8_BAR; PG8_SCHED;
            PG8_LDB(B0, 1, 0); PG8_LDB(B1, 1, 1); PG8_SCHED; PG8_LDA(At, 1, 0); PG8_STAGE_A(PG8_SA(0, 1), a2, 1, last);
            PG8_WAIT_V(8); PG8_WAIT_L(0); PG8_BAR; PG8_MMA(0, 0, At, B0); PG8_MMA(0, 1, At, B1); PG8_BAR; PG8_SCHED;
            PG8_LDA(At, 1, 1); PG8_STAGE(PG8_SB(1, 0), b3, voffB); PG8_STAGE(PG8_SB(1, 1), b3 + hstep, voffB); PG8_STAGE_A(PG8_SA(1, 0), a3, 0, last);
            PG8_WAIT_V(8); PG8_WAIT_L(0); PG8_BAR; PG8_MMA(1, 0, At, B0); PG8_MMA(1, 1, At, B1); PG8_BAR; PG8_SCHED;
            } else {
            PG8_LDB(B0, 0, 0); PG8_SCHED; PG8_LDA(At, 0, 0); PG8_STAGE_A(PG8_SA(1, 1), a1, 1, false);
            PG8_WAIT_L(8); PG8_BAR; PG8_WAIT_L(0); PG8_MMA(0, 0, At, B0); PG8_BAR; PG8_SCHED;
            PG8_LDB(B1, 0, 1); PG8_STAGE(PG8_SB(0, 0), b2, voffB);
            PG8_BAR; PG8_WAIT_L(0); PG8_MMA(0, 1, At, B1); PG8_BAR;
            PG8_LDA(At, 0, 1); PG8_STAGE_A(PG8_SA(0, 0), a2, 0, last);
            PG8_BAR; PG8_WAIT_L(0); PG8_MMA(1, 0, At, B0); PG8_BAR; PG8_SCHED;
            PG8_STAGE(PG8_SB(0, 1), b2 + hstep, voffB);
            PG8_WAIT_V(6); PG8_BAR; PG8_MMA(1, 1, At, B1); PG8_BAR;
            PG8_LDB(B0, 1, 0); PG8_SCHED; PG8_LDA(At, 1, 0); PG8_STAGE_A(PG8_SA(0, 1), a2, 1, last);
            PG8_WAIT_L(8); PG8_BAR; PG8_WAIT_L(0); PG8_MMA(0, 0, At, B0); PG8_BAR; PG8_SCHED;
            PG8_LDB(B1, 1, 1); PG8_STAGE(PG8_SB(1, 0), b3, voffB);
            PG8_BAR; PG8_WAIT_L(0); PG8_MMA(0, 1, At, B1); PG8_BAR;
            PG8_LDA(At, 1, 1); PG8_STAGE_A(PG8_SA(1, 0), a3, 0, last);
            PG8_BAR; PG8_WAIT_L(0); PG8_MMA(1, 0, At, B0); PG8_BAR; PG8_SCHED;
            PG8_STAGE(PG8_SB(1, 1), b3 + hstep, voffB);
            PG8_WAIT_V(6); PG8_BAR; PG8_MMA(1, 1, At, B1); PG8_BAR;
            }
        }
        if constexpr (ALIGN_EPI) { if (wr == 0) PG8_BAR; }
        if constexpr (!Epi::AFTER_DRAIN) { E(acc, cur, wr, wc, fr, fq); S.done(cur); }
        if (!has_next) break;
#pragma unroll
        for (int a = 0; a < 2; ++a)
#pragma unroll
            for (int b = 0; b < 2; ++b)
#pragma unroll
                for (int m = 0; m < 4; ++m)
#pragma unroll
                    for (int n = 0; n < 2; ++n) acc[a][b][m][n] = (f32x4){0.f, 0.f, 0.f, 0.f};
        cur = nxt; cA = nA; cB = nB; ++ui;
        if constexpr (Sched::GATHER_ROWS) {
#pragma unroll
            for (int i = 0; i < 2; ++i) { vA0[i] = nA0[i]; vA1[i] = nA1[i]; } }
        if constexpr (ALIGN_EPI) { if (wr == 1) PG8_BAR; }
    }
    PG8_WAIT_V(0);
    if constexpr (!ALIGN_EPI) { if (wr == 0) PG8_BAR; }
    PG8_BAR;
    if constexpr (Epi::AFTER_DRAIN) { E.fused(acc, cur, wr, wc, fr, fq, lds, wid, lane); S.done(cur); }
#undef PG8_SA
#undef PG8_SB
#undef PG8_STAGE
#undef PG8_STAGE_A
#undef PG8_ROWOFFS
#undef PG8_LDA
#undef PG8_LDB
#undef PG8_MMA
#undef PG8_WAIT_V
#undef PG8_WAIT_L
#undef PG8_BAR
#undef PG8_SCHED
}
}

#define PHASE_PROLOGUE \
    int tid_ = threadIdx.x; asm volatile("" : "+v"(tid_)); const int tid = tid_, lane = tid & 63, wave = tid >> 6; \
    const int G = GRID, bid = blockIdx.x; \
    const int gw = bid * 8 + wave, NGW = G * 8; \
    unsigned char* ws = P.ws; \
    bf16_t* H = (bf16_t*)(ws + WS_H); \
    bf16_t* HN = (bf16_t*)(ws + WS_HN); \
    bf16_t* A2 = (bf16_t*)(ws + WS_A2); \
    bf16_t* Qb = (bf16_t*)(ws + WS_Q); bf16_t* Kb = (bf16_t*)(ws + WS_K); bf16_t* Vb = (bf16_t*)(ws + WS_V); \
    bf16_t* REST = (bf16_t*)(ws + WS_REST); \
    bf16_t* YFB = (bf16_t*)(ws + WS_YFB); \
    bf16_t* Rr = (bf16_t*)(ws + WS_R); bf16_t* VV = (bf16_t*)(ws + WS_VV); bf16_t* KK = (bf16_t*)(ws + WS_KK); \
    bf16_t* KKA = (bf16_t*)(ws + WS_KKA); bf16_t* KD = (bf16_t*)(ws + WS_KD); \
    _Float16* LW = (_Float16*)(ws + WS_W); bf16_t* PP = (bf16_t*)(ws + WS_PP); bf16_t* QT = (bf16_t*)(ws + WS_QT); bf16_t* YT = (bf16_t*)(ws + WS_YT); bf16_t* ZT = (bf16_t*)(ws + WS_ZT); \
    bf16_t* Gg = (bf16_t*)(ws + WS_G); bf16_t* KR = (bf16_t*)(ws + WS_KR); bf16_t* LOW = (bf16_t*)(ws + WS_LOW); \
    float* BC = (float*)(ws + WS_BC); \
    bf16_t* AA = (bf16_t*)(ws + WS_AA); \
    bf16_t* HB = (bf16_t*)(ws + WS_HB); bf16_t* YB = (bf16_t*)(ws + WS_YB); \
    int* ROWTOK = (int*)(ws + WS_ROWTOK); int* EID = (int*)(ws + WS_EID); int* POS = (int*)(ws + WS_POS); int* DEST = (int*)(ws + WS_DEST); \
    float* GATE = (float*)(ws + WS_GATE); \
    bf16_t* YI = (bf16_t*)(ws + WS_YI); bf16_t* S5E = (bf16_t*)(ws + WS_E); bf16_t* CAR = (bf16_t*)(ws + WS_CAR); bf16_t* BTA = (bf16_t*)(ws + WS_BTA); bf16_t* BTC = (bf16_t*)(ws + WS_BTC); \
    unsigned* CTL = (unsigned*)(ws + WS_CTL); \
    bf16_t* WTIN = (bf16_t*)(ws + WS_WTIN); bf16_t* WTOUT = (bf16_t*)(ws + WS_WTOUT); bf16_t* WTGLU = (bf16_t*)(ws + WS_WTGLU); bf16_t* WT13 = (bf16_t*)(ws + WS_WT13); bf16_t* WT2 = (bf16_t*)(ws + WS_WT2); \
    const int vcu = (G % 8 == 0) ? (bid % 8) * (G / 8) + bid / 8 : bid; \
    const float* x = P.in[0]; const float* meta = P.in[1]; const float* norm_mix = P.in[2]; const float* norm_ffn = P.in[3]; const float* norm_final = P.in[4]; \
    const float* w_in = P.in[5]; const float* w_out = P.in[6]; const float* rpb = P.in[7]; const float* mu = P.in[8]; \
    const float* w0 = P.in[9]; const float* w_up = P.in[10]; const float* a0 = P.in[11]; const float* a_up = P.in[12]; const float* g_up = P.in[13]; \
    const float* k_k = P.in[14]; const float* k_a = P.in[15]; const float* r_k = P.in[16]; const float* lnx_g = P.in[17]; const float* lnx_b = P.in[18]; \
    const float* s5_b_re = P.in[19]; const float* s5_b_im = P.in[20]; const float* s5_lre = P.in[21]; const float* s5_lim = P.in[22]; const float* s5_ls = P.in[23]; \
    const float* s5_c_re = P.in[24]; const float* s5_c_im = P.in[25]; const float* s5_d = P.in[26]; const float* w_glu = P.in[27]; \
    const float* moe_wg = P.in[28]; const float* moe_bg = P.in[29]; const float* moe_we = P.in[30]; const float* moe_be = P.in[31]; \
    const float* moe_w1 = P.in[32]; const float* moe_w3 = P.in[33]; const float* moe_w2 = P.in[34];


__device__ __forceinline__ void transpose_half(const float* W, int N, int K, int k0, int n0, bf16_t* dstrow0, int lane) {
    const int kb = lane & 7, nq = lane >> 3;
    const float* src = W + (size_t)(k0 + 8 * kb) * N + n0 + 4 * nq;
    f32x4 v[8];
#pragma unroll
    for (int kk = 0; kk < 8; ++kk) v[kk] = *(const f32x4*)(src + (size_t)kk * N);
#pragma unroll
    for (int i = 0; i < 4; ++i) {
        u32x4 o; o.x = pk2(v[0][i], v[1][i]); o.y = pk2(v[2][i], v[3][i]); o.z = pk2(v[4][i], v[5][i]); o.w = pk2(v[6][i], v[7][i]);
        *(u32x4*)(dstrow0 + (size_t)(4 * nq + i) * K + k0 + 8 * kb) = o;
    }
}
__device__ __forceinline__ void transpose_item(const float* W, int N, int K, int k0, int n0, bf16_t* dstrow0, int lane) {
    transpose_half(W, N, K, k0, n0, dstrow0, lane);
    transpose_half(W, N, K, k0, n0 + 32, dstrow0 + (size_t)32 * K, lane);
}
#define CONV_DENSE_ITEMS (832 + 256 + 512 + 48)
__device__ __forceinline__ void conv_dense_item(CParams& P, int it, int lane) {
    unsigned char* ws = P.ws;
    if (it < 832) { const int kb = it / 52, nb = it % 52; transpose_item(P.in[5], INCOLS, DM, kb * 64, nb * 64, (bf16_t*)(ws + WS_WTIN) + (size_t)nb * 64 * DM, lane); return; }
    it -= 832;
    if (it < 256) { const int kb = it / 16, nb = it % 16; transpose_item(P.in[6], DM, DM, kb * 64, nb * 64, (bf16_t*)(ws + WS_WTOUT) + (size_t)nb * 64 * DM, lane); return; }
    it -= 256;
    if (it < 512) { const int kb = it / 32, nb = it % 32, n = nb * 64, half = n >> 10, c = n & 1023, row = (c >> 7) * 256 + half * 128 + (c & 127);
      transpose_item(P.in[27], 2 * DM, DM, kb * 64, n, (bf16_t*)(ws + WS_WTGLU) + (size_t)row * DM, lane); return; }
    it -= 512;
    bf16_t* lrt = (bf16_t*)(ws + WS_LRT);
    if (it < 16) { const int d = it >> 3, nb = it & 7; transpose_item(P.in[10] + (size_t)d * 64 * 512, 512, 64, 0, nb * 64, lrt + ((size_t)d * 512 + nb * 64) * 64, lane); return; }
    it -= 16;
    if (it < 16) { const int d = it >> 3, nb = it & 7; transpose_item(P.in[12] + (size_t)d * 64 * 512, 512, 64, 0, nb * 64, lrt + (size_t)2 * 512 * 64 + ((size_t)d * 512 + nb * 64) * 64, lane); return; }
    it -= 16;
    { const int kb = it >> 3, nb = it & 7; transpose_item(P.in[13], 512, 128, kb * 64, nb * 64, lrt + (size_t)4 * 512 * 64 + (size_t)nb * 64 * 128, lane); }
}
#define CONV_MOE_ITEMS (NEXP * 384)
__device__ __forceinline__ void conv_moe_item(CParams& P, int l, int it, int lane) {
    unsigned char* ws = P.ws;
    const int e = it / 384; int r = it % 384;
    if (r < 256) { const int which = r >> 7; r &= 127; const int kb = r >> 3, nb = r & 7, n = nb * 64, row = (n >> 7) * 256 + which * 128 + (n & 127);
        const float* W = (which ? P.in[33] : P.in[32]) + ((size_t)(l * NEXP + e) * DM) * DFF;
        transpose_item(W, DFF, DM, kb * 64, n, (bf16_t*)(ws + WS_WT13) + ((size_t)e * DM + row) * DM, lane); return; }
    r -= 256;
    { const int kb = r >> 4, nb = r & 15; const float* W = P.in[34] + ((size_t)(l * NEXP + e) * DFF) * DM;
      transpose_item(W, DM, DFF, kb * 64, nb * 64, (bf16_t*)(ws + WS_WT2) + ((size_t)e * DM + nb * 64) * DFF, lane); }
}

template <int MODE>
__device__ __forceinline__ void meta_gemm(const bf16_t* A, const bf16_t* Bt, bf16_t* Hrows, int task, int lane) {
    const int fr = lane & 15, fq = lane >> 4, c = task * 16 + fr;
    const bf16_t* b0 = MODE == 0 ? Bt + (size_t)c * DM : Bt + (size_t)((c >> 7) * 256 + (c & 127)) * DM;
    const bf16_t* b1 = b0 + (size_t)128 * DM;
    f32x4 acc0[2], acc1[2];
    acc0[0] = acc0[1] = acc1[0] = acc1[1] = (f32x4){0.f, 0.f, 0.f, 0.f};
#pragma unroll 4
    for (int kt = 0; kt < 32; ++kt) {
        const int ko = kt * 32 + fq * 8;
        const bf16x8 a0 = *(const bf16x8*)(A + (size_t)fr * DM + ko), a1 = *(const bf16x8*)(A + (size_t)(16 + fr) * DM + ko);
        const bf16x8 bv = *(const bf16x8*)(b0 + ko);
        acc0[0] = __builtin_amdgcn_mfma_f32_16x16x32_bf16(a0, bv, acc0[0], 0, 0, 0);
        acc0[1] = __builtin_amdgcn_mfma_f32_16x16x32_bf16(a1, bv, acc0[1], 0, 0, 0);
        if (MODE == 1) { const bf16x8 bg = *(const bf16x8*)(b1 + ko);
            acc1[0] = __builtin_amdgcn_mfma_f32_16x16x32_bf16(a0, bg, acc1[0], 0, 0, 0);
            acc1[1] = __builtin_amdgcn_mfma_f32_16x16x32_bf16(a1, bg, acc1[1], 0, 0, 0); }
    }
#pragma unroll
    for (int mi = 0; mi < 2; ++mi)
#pragma unroll
        for (int j = 0; j < 4; ++j) { bf16_t* p = Hrows + (size_t)(mi * 16 + fq * 4 + j) * DM + c;
            const float add = MODE == 0 ? acc0[mi][j] : acc0[mi][j] * __builtin_amdgcn_rcpf(1.f + __expf(-acc1[mi][j]));
            *p = (bf16_t)f2bf(bf2f(*p) + add); }
}
__device__ __forceinline__ void phase_0(CParams& P, unsigned char* lds, const int ph) {
    PHASE_PROLOGUE
            for (int row = gw; row < NT; row += NGW) {
                const float* src = row < NMAIN ? x + (size_t)row * DM : meta + (size_t)((row - NMAIN) & 15) * DM;
                f32x4 v[4];
#pragma unroll
                for (int j = 0; j < 4; ++j) { v[j] = ((const f32x4*)src)[lane + 64 * j]; strow_bf16(H + (size_t)row * DM, lane, j, v[j]); }
                store_norm_bf16(v, norm_mix, HN + (size_t)row * DM, lane);
            }
    for (int it = gw; it < CONV_DENSE_ITEMS; it += NGW) conv_dense_item(P, it, lane);
}

__device__ __forceinline__ void phase_1(CParams& P, unsigned char* lds, const int ph) {
    PHASE_PROLOGUE
    pg8::ProjOrder S; S.init(HN, WTIN, bid);
    pg8::EpiProj E{Qb, Kb, Vb, REST};
    pg8::gemm_phase<pg8::EpiProj, pg8::ProjOrder, true, true>((PG8_LAS unsigned char*)lds, DM, S, E);
}

__device__ __forceinline__ void na_units(CParams& P, unsigned char* lds, const int first, const int stride) {
    PHASE_PROLOGUE
    float* sb = (float*)lds;
    for (int i = tid; i < 8 * 465; i += 512) sb[i] = rpb[i];
    __syncthreads();
    const bf16_t* VT = Vb;
    const int fr = lane & 15, fq = lane >> 4;
    for (int u = first; u < 8192 + 16; u += stride) {
        const bool metaq = u >= 8192;
        int b, h, r = 0, qb = 0;
        if (!metaq) { qb = u & 3; r = (u >> 2) & 127; h = (u >> 9) & 7; b = u >> 12; } else { const int m = u - 8192; b = m >> 3; h = m & 7; }
        const int c = qb * 16 + fr;
        const int qrow = metaq ? NMAIN + b * NMETA + fr : b * SEQ + r * 64 + c;
        const int R0 = min(max(r - 4, 0), 120), cs = qb == 0 ? 0 : (qb == 1 ? 8 : (qb == 2 ? 24 : 32));
        const int C0 = min(max(c - 8, 0), 48);
        bf16x8 qf0 = *(const bf16x8*)(Qb + (size_t)qrow * 512 + h * 64 + fq * 8), qf1 = *(const bf16x8*)(Qb + (size_t)qrow * 512 + h * 64 + 32 + fq * 8);
        f32x4 sacc[17];
        const f32x4 zero4 = (f32x4){0.f, 0.f, 0.f, 0.f};
        if (!metaq) {
#pragma unroll
            for (int kt = 0; kt < 16; ++kt) {
                const int krow0 = b * SEQ + (R0 + (kt >> 1)) * 64 + cs + 16 * (kt & 1);
                const bf16_t* kp = Kb + (size_t)(krow0 + fr) * 512 + h * 64 + fq * 8;
                const bf16x8 a0 = *(const bf16x8*)kp, a1 = *(const bf16x8*)(kp + 32);
                f32x4 acc = __builtin_amdgcn_mfma_f32_16x16x32_bf16(a0, qf0, zero4, 0, 0, 0);
                sacc[kt] = __builtin_amdgcn_mfma_f32_16x16x32_bf16(a1, qf1, acc, 0, 0, 0);
            }
        } else {
#pragma unroll
            for (int kt = 0; kt < 16; ++kt) sacc[kt] = zero4;
        }
        {
            const bf16_t* kp = Kb + (size_t)(NMAIN + b * NMETA + fr) * 512 + h * 64 + fq * 8;
            const bf16x8 a0 = *(const bf16x8*)kp, a1 = *(const bf16x8*)(kp + 32);
            f32x4 acc = __builtin_amdgcn_mfma_f32_16x16x32_bf16(a0, qf0, zero4, 0, 0, 0);
            sacc[16] = __builtin_amdgcn_mfma_f32_16x16x32_bf16(a1, qf1, acc, 0, 0, 0);
        }
        float mx = -1e30f;
#pragma unroll
        for (int kt = 0; kt < 16; ++kt) {
            const int dr = R0 + (kt >> 1) - r + 7;
#pragma unroll
            for (int j = 0; j < 4; ++j) {
                const int kc = cs + 16 * (kt & 1) + 4 * fq + j;
                const bool inb = !metaq && kc >= C0 && kc < C0 + 16;
                const int dc = min(max(kc - c + 15, 0), 30);
                const float s = inb ? sacc[kt][j] * 0.125f + sb[(h * 15 + dr) * 31 + dc] : -1e30f;
                sacc[kt][j] = s; mx = fmaxf(mx, s);
            }
        }
#pragma unroll
        for (int j = 0; j < 4; ++j) { const float s = sacc[16][j] * 0.125f; sacc[16][j] = s; mx = fmaxf(mx, s); }
        mx = fmaxf(mx, __shfl_xor(mx, 16)); mx = fmaxf(mx, __shfl_xor(mx, 32));
        float sum = 0.f;
#pragma unroll
        for (int kt = 0; kt < 17; ++kt)
#pragma unroll
            for (int j = 0; j < 4; ++j) { const float pv = __expf(sacc[kt][j] - mx); sacc[kt][j] = pv; sum += pv; }
        sum += __shfl_xor(sum, 16); sum += __shfl_xor(sum, 32);
        f32x4 o[4] = {zero4, zero4, zero4, zero4};
        if (!metaq) {
#pragma unroll
            for (int kr = 0; kr < 8; ++kr) {
                union { bf16x8 v; unsigned u[4]; } bf;
                bf.u[0] = pk2(sacc[2 * kr][0], sacc[2 * kr][1]); bf.u[1] = pk2(sacc[2 * kr][2], sacc[2 * kr][3]);
                bf.u[2] = pk2(sacc[2 * kr + 1][0], sacc[2 * kr + 1][1]); bf.u[3] = pk2(sacc[2 * kr + 1][2], sacc[2 * kr + 1][3]);
                const size_t tok0 = (size_t)b * SEQ + (R0 + kr) * 64 + cs + 4 * fq;
#pragma unroll
                for (int dt = 0; dt < 4; ++dt) {
                    const bf16_t* vp = VT + (size_t)(h * 64 + dt * 16 + fr) * NTP + tok0;
                    union { bf16x8 v; u32x2 h2[2]; } af;
                    af.h2[0] = *(const u32x2*)vp; af.h2[1] = *(const u32x2*)(vp + 16);
                    o[dt] = __builtin_amdgcn_mfma_f32_16x16x32_bf16(af.v, bf.v, o[dt], 0, 0, 0);
                }
            }
        }
        {
            union { bf16x8 v; unsigned u[4]; } bf;
            bf.u[0] = pk2(sacc[16][0], sacc[16][1]); bf.u[1] = pk2(sacc[16][2], sacc[16][3]); bf.u[2] = 0u; bf.u[3] = 0u;
            const size_t tokm = (size_t)NMAIN + b * NMETA + 4 * fq;
#pragma unroll
            for (int dt = 0; dt < 4; ++dt) {
                const bf16_t* vp = VT + (size_t)(h * 64 + dt * 16 + fr) * NTP + tokm;
                union { bf16x8 v; u32x2 h2[2]; } af;
                af.h2[0] = *(const u32x2*)vp; af.h2[1] = (u32x2){0u, 0u};
                o[dt] = __builtin_amdgcn_mfma_f32_16x16x32_bf16(af.v, bf.v, o[dt], 0, 0, 0);
            }
        }
        const float inv = 1.f / sum;
#pragma unroll
        for (int dt = 0; dt < 4; ++dt) {
            u32x2 ov; ov.x = pk2(o[dt][0] * inv, o[dt][1] * inv); ov.y = pk2(o[dt][2] * inv, o[dt][3] * inv);
            *(u32x2*)(A2 + (size_t)qrow * DM + h * 64 + dt * 16 + 4 * fq) = ov;
        }
    }
    __syncthreads();
}

__device__ __forceinline__ void phase_3(CParams& P, unsigned char* lds, const int ph) {
    PHASE_PROLOGUE
            for (int tk = gw; tk < NT; tk += NGW) {
                const int b = tk / LSEQ, p = tk % LSEQ, row = rowof(b, p);
                const bool hp = p > 0, hn = p + 1 < LSEQ;
                const int rowp = hp ? rowof(b, p - 1) : row, rown = hn ? rowof(b, p + 1) : row;
#pragma unroll
                for (int j = 0; j < 7; ++j) {
                    const int c = 4 * lane + 256 * j;
                    const u32x2 vc = *(const u32x2*)(REST + (size_t)row * RESTC + c);
                    u32x2 vp = *(const u32x2*)(REST + (size_t)rowp * RESTC + c);
                    u32x2 vn = *(const u32x2*)(REST + (size_t)rown * RESTC + c);
                    if (!hp) { vp.x = 0; vp.y = 0; }
                    if (!hn) { vn.x = 0; vn.y = 0; }
                    const f32x4 m4 = *(const f32x4*)(mu + c);
                    float pc[4] = {bflo(vc.x), bfhi(vc.x), bflo(vc.y), bfhi(vc.y)};
                    float pp[4] = {bflo(vp.x), bfhi(vp.x), bflo(vp.y), bfhi(vp.y)};
                    float pn[4] = {bflo(vn.x), bfhi(vn.x), bflo(vn.y), bfhi(vn.y)};
                    float o[4];
#pragma unroll
                    for (int i = 0; i < 4; ++i) o[i] = pc[i] + m4[i] * (0.5f * (pp[i] + pn[i]) - pc[i]);
                    if (j == 6) {
                        if (lane < 16) { for (int i = 0; i < 4; ++i) o[i] = tanhf(o[i]); }
                        else if (lane >= 32) { for (int i = 0; i < 4; ++i) o[i] = sigmoidf_(o[i]); }
                    }
                    u32x2 ov; ov.x = pk2(o[0], o[1]); ov.y = pk2(o[2], o[3]);
                    bf16_t* dst = j < 2 ? Rr + (size_t)row * 512 + c : (j < 4 ? KR + (size_t)row * 512 + (c - 512) : (j < 6 ? VV + (size_t)row * 512 + (c - 1024) : LOW + (size_t)row * 256 + (c - 1536)));
                    *(u32x2*)dst = ov;
                }
            }
}


__device__ __forceinline__ void phase_4(CParams& P, unsigned char* lds, const int ph) {
    PHASE_PROLOGUE
    constexpr int AST = 264, SST = 136;
    bf16_t* As = (bf16_t*)lds;
    unsigned short* stg = (unsigned short*)(lds + 64 * AST * 2);
    const bf16_t* lrt = (const bf16_t*)(ws + WS_LRT);
    const int fr = lane & 15, fq = lane >> 4;
    const int nrt = (NT + 63) / 64;
    for (int u = bid; u < nrt; u += G) {
        for (int i = tid; i < 64 * 32; i += 512) { const int r = i >> 5, pc = (i & 31) * 8; int row = u * 64 + r; if (row >= NT) row = NT - 1;
            *(u32x4*)(As + r * AST + pc) = *(const u32x4*)(LOW + (size_t)row * 256 + pc); }
        __syncthreads();
#define P4_LOADB(t_, bv_, bias_) do { const int wh_ = (t_) >> 2, ct_ = (t_) & 3, Kw_ = wh_ < 4 ? 64 : 128, col_ = ct_ * 128 + 16 * wave + fr; \
            const bf16_t* Wt_ = lrt + (wh_ < 4 ? (size_t)wh_ * 512 * 64 : (size_t)4 * 512 * 64) + (size_t)col_ * Kw_ + 8 * fq; \
            bv_[0] = *(const bf16x8*)Wt_; bv_[1] = *(const bf16x8*)(Wt_ + 32); if (wh_ == 4) { bv_[2] = *(const bf16x8*)(Wt_ + 64); bv_[3] = *(const bf16x8*)(Wt_ + 96); } \
            bias_ = wh_ < 2 ? w0[wh_ * 512 + col_] : (wh_ < 4 ? a0[(wh_ - 2) * 512 + col_] : 0.f); } while (0)
        bf16x8 bnx[4]; float biasn;
        P4_LOADB(0, bnx, biasn);
#pragma unroll 1
        for (int t = 0; t < 20; ++t) {
            const int which = t >> 2, ct = t & 3;
            const int koff = which < 2 ? 0 : (which < 4 ? 64 : 128);
            bf16x8 bcur[4]; bcur[0] = bnx[0]; bcur[1] = bnx[1]; bcur[2] = bnx[2]; bcur[3] = bnx[3];
            const float bias = biasn;
            if (t + 1 < 20) P4_LOADB(t + 1, bnx, biasn);
            const f32x4 zero4 = (f32x4){0.f, 0.f, 0.f, 0.f};
            f32x4 acc[4] = {zero4, zero4, zero4, zero4};
#pragma unroll
            for (int ks = 0; ks < 4; ++ks) {
                if (ks < 2 || which == 4) {
#pragma unroll
                    for (int rt = 0; rt < 4; ++rt) acc[rt] = __builtin_amdgcn_mfma_f32_16x16x32_bf16(*(const bf16x8*)(As + (16 * rt + fr) * AST + koff + 32 * ks + 8 * fq), bcur[ks], acc[rt], 0, 0, 0);
                }
            }
            unsigned short* sg = stg + (t & 1) * 64 * SST + 16 * wave + fr;
#pragma unroll
            for (int rt = 0; rt < 4; ++rt)
#pragma unroll
                for (int j = 0; j < 4; ++j) { const float val = acc[rt][j] + bias; unsigned short o;
                    if (which < 2) { const _Float16 hv = (_Float16)(-0.6065306597f * sigmoidf_(val)); o = __builtin_bit_cast(unsigned short, hv); }
                    else if (which < 4) o = (unsigned short)f2bf(sigmoidf_(val));
                    else o = (unsigned short)f2bf(val);
                    sg[(16 * rt + 4 * fq + j) * SST] = o; }
            __syncthreads();
            {
                unsigned short* dst = which < 2 ? (unsigned short*)LW + (size_t)which * NT * 512 : (which < 4 ? (unsigned short*)AA + (size_t)(which - 2) * NT * 512 : (unsigned short*)Gg);
                const int r = tid >> 3, pc = (tid & 7) * 16, row = u * 64 + r;
                const unsigned short* sp = stg + (t & 1) * 64 * SST + r * SST + pc;
                if (row < NT) { *(u32x4*)(dst + (size_t)row * 512 + ct * 128 + pc) = *(const u32x4*)sp; *(u32x4*)(dst + (size_t)row * 512 + ct * 128 + pc + 8) = *(const u32x4*)(sp + 8); }
            }
        }
        __syncthreads();
#undef P4_LOADB
    }
}


__device__ __forceinline__ void phase_5(CParams& P, unsigned char* lds, const int ph) {
    PHASE_PROLOGUE
            for (int row = gw; row < NT; row += NGW) {
                const int c0 = lane * 8;
                const u32x4 krv = *(const u32x4*)(KR + (size_t)row * 512 + c0);
                const u32x4 rv = *(const u32x4*)(Rr + (size_t)row * 512 + c0);
                float kr[8], rr[8], kkv[8];
#pragma unroll
                for (int i = 0; i < 4; ++i) { kr[2 * i] = bflo(krv[i]); kr[2 * i + 1] = bfhi(krv[i]); rr[2 * i] = bflo(rv[i]); rr[2 * i + 1] = bfhi(rv[i]); }
                float ss = 0.f;
#pragma unroll
                for (int i = 0; i < 8; ++i) { kkv[i] = kr[i] * k_k[c0 + i]; ss += kkv[i] * kkv[i]; }
                ss += __shfl_xor(ss, 1); ss += __shfl_xor(ss, 2); ss += __shfl_xor(ss, 4);
                const float inv = 1.f / fmaxf(sqrtf(ss), 1e-12f);
#pragma unroll
                for (int i = 0; i < 8; ++i) kkv[i] *= inv;
                u32x4 o; o.x = pk2(kkv[0], kkv[1]); o.y = pk2(kkv[2], kkv[3]); o.z = pk2(kkv[4], kkv[5]); o.w = pk2(kkv[6], kkv[7]);
                *(u32x4*)(KK + (size_t)row * 512 + c0) = o;
                float bsum = 0.f;
#pragma unroll
                for (int d = 0; d < 2; ++d) {
                    const u32x4 av = *(const u32x4*)(AA + ((size_t)d * NT + row) * 512 + c0);
                    float a[8], kka[8], kd[8];
#pragma unroll
                    for (int i = 0; i < 4; ++i) { a[2 * i] = bflo(av[i]); a[2 * i + 1] = bfhi(av[i]); }
#pragma unroll
                    for (int i = 0; i < 8; ++i) { kka[i] = kkv[i] * a[i]; kd[i] = kr[i] * (1.f + (a[i] - 1.f) * k_a[c0 + i]); bsum += rr[i] * kd[i] * r_k[c0 + i]; }
                    u32x4 o1; o1.x = pk2(kka[0], kka[1]); o1.y = pk2(kka[2], kka[3]); o1.z = pk2(kka[4], kka[5]); o1.w = pk2(kka[6], kka[7]);
                    *(u32x4*)(KKA + ((size_t)d * NT + row) * 512 + c0) = o1;
                    u32x4 o2; o2.x = pk2(kd[0], kd[1]); o2.y = pk2(kd[2], kd[3]); o2.z = pk2(kd[4], kd[5]); o2.w = pk2(kd[6], kd[7]);
                    *(u32x4*)(KD + ((size_t)d * NT + row) * 512 + c0) = o2;
                }
                bsum += __shfl_xor(bsum, 1); bsum += __shfl_xor(bsum, 2); bsum += __shfl_xor(bsum, 4);
                if ((lane & 7) == 0) BC[(size_t)row * 8 + (lane >> 3)] = bsum;
            }
}


#define RWS 72
__device__ __forceinline__ bf16x8 rw_frag(const bf16_t* M, int row, int kofs) { return *(const bf16x8*)(M + row * RWS + kofs); }
__device__ __forceinline__ f32x4 rw_tile(const bf16_t* Am, int ra, const bf16_t* Bm, int rb, int fr, int fq) {
    f32x4 acc = (f32x4){0.f, 0.f, 0.f, 0.f};
    acc = __builtin_amdgcn_mfma_f32_16x16x32_bf16(rw_frag(Am, ra + fr, 8 * fq), rw_frag(Bm, rb + fr, 8 * fq), acc, 0, 0, 0);
    acc = __builtin_amdgcn_mfma_f32_16x16x32_bf16(rw_frag(Am, ra + fr, 32 + 8 * fq), rw_frag(Bm, rb + fr, 32 + 8 * fq), acc, 0, 0, 0);
    return acc;
}
__device__ __forceinline__ void phase_6(CParams& P, unsigned char* lds, const int ph) {
    PHASE_PROLOGUE
    constexpr int GST = 68, RST = 132;
    float* Gs = (float*)lds;
    bf16_t* A_rm = (bf16_t*)(lds + 64 * GST * 4); bf16_t* R_rm = A_rm + 64 * RWS; bf16_t* B_rm = R_rm + 64 * RWS; bf16_t* K_rm = B_rm + 64 * RWS;
    bf16_t* B_tr = K_rm + 64 * RWS; bf16_t* K_tr = B_tr + 64 * RWS; bf16_t* V_tr = K_tr + 64 * RWS;
    bf16_t* MAK = V_tr + 64 * RWS; bf16_t* MRB = MAK + 64 * RWS; bf16_t* MRK = MRB + 64 * RWS;
    bf16_t* MABr = MRK + 64 * RWS;
    float* RHS = (float*)(MABr + 64 * RWS);
    float* BT = RHS + 64 * RST; float* OFF = BT + 512; float* GC = OFF + 512;
    bf16_t* X1_tr = A_rm; bf16_t* X2_tr = K_rm;
    for (int i = tid; i < 4 * 64 * RWS / 2; i += 512) ((unsigned*)MAK)[i] = 0u;
    __syncthreads();
    const int fr = lane & 15, fq = lane >> 4;
#define RW1_BAR() do { asm volatile("s_waitcnt lgkmcnt(0)" ::: "memory"); __builtin_amdgcn_s_barrier(); asm volatile("" ::: "memory"); } while (0)
    const int t0 = tid & 63, kp = (tid >> 6) * 8;
    u32x4 nlw, nkk, nka, nkd, nrv, nvv;
#define RW1_LOAD(u_) do { const int ch_ = (u_) / RW_NCH, c_ = (u_) - ch_ * RW_NCH, d_ = ch_ >> 4, b_ = (ch_ >> 3) & 1, h_ = ch_ & 7, s_ = c_ * 64 + t0; \
        const int p_ = d_ ? LSEQ - 1 - s_ : s_; const size_t o_ = (size_t)rowof(b_, s_ < LSEQ ? p_ : 0) * 512 + h_ * 64 + kp; \
        nlw = *(const u32x4*)(LW + (size_t)d_ * NT * 512 + o_); nkk = *(const u32x4*)(KK + o_); nka = *(const u32x4*)(KKA + (size_t)d_ * NT * 512 + o_); \
        nkd = *(const u32x4*)(KD + (size_t)d_ * NT * 512 + o_); nrv = *(const u32x4*)(Rr + o_); nvv = *(const u32x4*)(VV + o_); } while (0)
    if (bid < RW_UNITS) RW1_LOAD(bid);
    for (int u = bid; u < RW_UNITS; u += G) {
        const int chain = u / RW_NCH, c = u - chain * RW_NCH;
        float lw[8], kk[8], ka[8], kd[8], rr[8]; u32x4 vv;
        {
            const bool valid = c * 64 + t0 < LSEQ;
            vv = nvv;
#pragma unroll
            for (int i = 0; i < 4; ++i) {
                union { unsigned u; _Float16 hh[2]; } cv; cv.u = nlw[i];
                lw[2 * i] = valid ? (float)cv.hh[0] : 0.f; lw[2 * i + 1] = valid ? (float)cv.hh[1] : 0.f;
                kk[2 * i] = valid ? bflo(nkk[i]) : 0.f; kk[2 * i + 1] = valid ? bfhi(nkk[i]) : 0.f;
                ka[2 * i] = valid ? bflo(nka[i]) : 0.f; ka[2 * i + 1] = valid ? bfhi(nka[i]) : 0.f;
                kd[2 * i] = valid ? bflo(nkd[i]) : 0.f; kd[2 * i + 1] = valid ? bfhi(nkd[i]) : 0.f;
                rr[2 * i] = valid ? bflo(nrv[i]) : 0.f; rr[2 * i + 1] = valid ? bfhi(nrv[i]) : 0.f;
                if (!valid) vv[i] = 0u;
            }
        }
        if (u + G < RW_UNITS) RW1_LOAD(u + G);
        *(f32x4*)(Gs + t0 * GST + kp) = (f32x4){lw[0], lw[1], lw[2], lw[3]}; *(f32x4*)(Gs + t0 * GST + kp + 4) = (f32x4){lw[4], lw[5], lw[6], lw[7]};
        RW1_BAR();
        { const int k = tid & 63, w = tid >> 6; float acc = 0.f;
#pragma unroll
          for (int i = 0; i < 8; ++i) { acc += Gs[(8 * w + i) * GST + k]; Gs[(8 * w + i) * GST + k] = acc; }
          BT[w * 64 + k] = acc; }
        RW1_BAR();
        { const int k = tid & 63, w = tid >> 6; float off = 0.f; for (int w2 = 0; w2 < w; ++w2) off += BT[w2 * 64 + k]; OFF[w * 64 + k] = off; }
        RW1_BAR();
#ifndef RW1_REP0
#define RW1_REP0 1
#endif
        for (int rep0_ = 0; rep0_ < RW1_REP0; ++rep0_) {
        {
            float va[8], vr[8], vb[8], vk[8];
            const f32x4 g0_ = *(const f32x4*)(Gs + t0 * GST + kp), g1_ = *(const f32x4*)(Gs + t0 * GST + kp + 4), o0_ = *(const f32x4*)(OFF + (t0 >> 3) * 64 + kp), o1_ = *(const f32x4*)(OFF + (t0 >> 3) * 64 + kp + 4);
            const float gg_[8] = {g0_[0] + o0_[0], g0_[1] + o0_[1], g0_[2] + o0_[2], g0_[3] + o0_[3], g1_[0] + o1_[0], g1_[1] + o1_[1], g1_[2] + o1_[2], g1_[3] + o1_[3]};
#pragma unroll
            for (int i = 0; i < 8; ++i) {
                const float g = gg_[i];
                const float eg = __expf(g), egm1 = __expf(g - lw[i]), einv = __expf(-g);
                va[i] = kk[i] * egm1; vr[i] = rr[i] * eg; vb[i] = ka[i] * einv; vk[i] = kd[i] * einv;
                if (t0 == 63) GC[kp + i] = eg;
            }
            *(f32x4*)(RHS + t0 * RST + kp) = (f32x4){va[0], va[1], va[2], va[3]}; *(f32x4*)(RHS + t0 * RST + kp + 4) = (f32x4){va[4], va[5], va[6], va[7]};
            u32x4 w4;
            w4.x = pk2(va[0], va[1]); w4.y = pk2(va[2], va[3]); w4.z = pk2(va[4], va[5]); w4.w = pk2(va[6], va[7]); *(u32x4*)(A_rm + t0 * RWS + kp) = w4;
            w4.x = pk2(vr[0], vr[1]); w4.y = pk2(vr[2], vr[3]); w4.z = pk2(vr[4], vr[5]); w4.w = pk2(vr[6], vr[7]); *(u32x4*)(R_rm + t0 * RWS + kp) = w4;
            w4.x = pk2(vb[0], vb[1]); w4.y = pk2(vb[2], vb[3]); w4.z = pk2(vb[4], vb[5]); w4.w = pk2(vb[6], vb[7]); *(u32x4*)(B_rm + t0 * RWS + kp) = w4;
            w4.x = pk2(vk[0], vk[1]); w4.y = pk2(vk[2], vk[3]); w4.z = pk2(vk[4], vk[5]); w4.w = pk2(vk[6], vk[7]); *(u32x4*)(K_rm + t0 * RWS + kp) = w4;
#pragma unroll
            for (int i = 0; i < 8; ++i) { B_tr[(kp + i) * RWS + t0] = (bf16_t)f2bf(vb[i]); K_tr[(kp + i) * RWS + t0] = (bf16_t)f2bf(vk[i]);
                V_tr[(kp + i) * RWS + t0] = (bf16_t)((i & 1) ? (vv[i >> 1] >> 16) : (vv[i >> 1] & 0xffffu)); }
        }
        RW1_BAR();
        }
        float* DQ = Gs; bf16_t* TB = (bf16_t*)BT;
#ifndef RW1_REP1
#define RW1_REP1 1
#endif
        for (int rep_ = 0; rep_ < RW1_REP1; ++rep_)
        for (int q = wave; q < 40; q += 8) {
            const int m = q / 10, e = q - m * 10, ti = e >= 6 ? 3 : (e >= 3 ? 2 : (e >= 1 ? 1 : 0)), tj = e - (ti * (ti + 1)) / 2;
            const f32x4 acc = rw_tile(m < 2 ? A_rm : R_rm, 16 * ti, (m & 1) ? K_rm : B_rm, 16 * tj, fr, fq);
            bf16_t* Mm = m == 1 ? MAK : (m == 2 ? MRB : MRK);
#pragma unroll
            for (int j = 0; j < 4; ++j) { const int t = 16 * ti + 4 * fq + j, i = 16 * tj + fr; const bool keep = m < 2 ? (i < t) : (i <= t); const float val = keep ? acc[j] : 0.f;
                if (m == 0) { MABr[t * RWS + i] = (bf16_t)f2bf(val); if (ti == tj) DQ[((ti * 16 + (t & 15)) * 4 + (fr & 3)) * 4 + (fr >> 2)] = val; }
                else Mm[t * RWS + i] = (bf16_t)f2bf(val); }
        }
        RW1_BAR();
#ifndef RW1_REP23
#define RW1_REP23 1
#endif
        for (int rep23_ = 0; rep23_ < RW1_REP23; ++rep23_) {
        if (wave >= 4) {
            for (int q = wave - 4; q < 16; q += 4) { const int ti = q >> 2, tv = q & 3; const f32x4 acc = rw_tile(MAK, 16 * ti, V_tr, 16 * tv, fr, fq);
#pragma unroll
                for (int j = 0; j < 4; ++j) RHS[(16 * ti + 4 * fq + j) * RST + 64 + 16 * tv + fr] = acc[j]; }
        } else {
            const int bb = wave, cc = lane >> 2, q = lane & 3;
            float xs[4] = {0.f, 0.f, 0.f, 0.f};
#pragma unroll
            for (int tl = 0; tl < 16; ++tl) {
                const f32x4 mv = *(const f32x4*)(DQ + ((bb * 16 + tl) * 4 + q) * 4);
                float part = mv[0] * xs[0] + mv[1] * xs[1] + mv[2] * xs[2] + mv[3] * xs[3];
                part += dppf<0xB1>(part); part += dppf<0x4E>(part);
                const float xt = (tl == cc ? 1.f : 0.f) - part;
                xs[tl >> 2] = (tl & 3) == q ? xt : xs[tl >> 2];
            }
#pragma unroll
            for (int m = 0; m < 4; ++m) TB[(bb * 16 + 4 * m + q) * 16 + cc] = (bf16_t)f2bf(xs[m]);
        }
        RW1_BAR();
        {
            const int c0 = 16 * wave;
            f32x4 X[4];
            const f32x4 zero4 = (f32x4){0.f, 0.f, 0.f, 0.f};
#define RW1_PACK(lo_, hi_, v_) do { union { bf16x8 v; unsigned u[4]; } t_; t_.u[0] = pk2(lo_[0], lo_[1]); t_.u[1] = pk2(lo_[2], lo_[3]); t_.u[2] = pk2(hi_[0], hi_[1]); t_.u[3] = pk2(hi_[2], hi_[3]); v_ = t_.v; } while (0)
#define RW1_LDA(base_, row0_, ca_, cb_, useb_, v_) do { union { bf16x8 v; u32x2 h2[2]; } t_; t_.h2[0] = *(const u32x2*)((base_) + ((row0_) + fr) * RWS + (ca_) + 4 * fq); \
            t_.h2[1] = (useb_) ? *(const u32x2*)((base_) + ((row0_) + fr) * RWS + (cb_) + 4 * fq) : (u32x2){0u, 0u}; v_ = t_.v; } while (0)
#pragma unroll
            for (int bq = 0; bq < 4; ++bq) {
                f32x4 acc;
#pragma unroll
                for (int j = 0; j < 4; ++j) acc[j] = -RHS[(16 * bq + 4 * fq + j) * RST + c0 + fr];
                bf16x8 af, bfv;
                if (bq >= 1) { RW1_LDA(MABr, 16 * bq, 0, 16, bq >= 2, af); if (bq >= 2) RW1_PACK(X[0], X[1], bfv); else RW1_PACK(X[0], zero4, bfv);
                    acc = __builtin_amdgcn_mfma_f32_16x16x32_bf16(af, bfv, acc, 0, 0, 0); }
                if (bq == 3) { RW1_LDA(MABr, 48, 32, 0, false, af); RW1_PACK(X[2], zero4, bfv); acc = __builtin_amdgcn_mfma_f32_16x16x32_bf16(af, bfv, acc, 0, 0, 0); }
                const f32x4 wv = (f32x4){-acc[0], -acc[1], -acc[2], -acc[3]};
                { union { bf16x8 v; u32x2 h2[2]; } t_; t_.h2[0] = *(const u32x2*)(TB + (bq * 16 + fr) * 16 + 4 * fq); t_.h2[1] = (u32x2){0u, 0u}; af = t_.v; }
                RW1_PACK(wv, zero4, bfv);
                X[bq] = __builtin_amdgcn_mfma_f32_16x16x32_bf16(af, bfv, zero4, 0, 0, 0);
                bf16_t* Xm = (wave < 4 ? X1_tr : X2_tr) + ((c0 & 63) + fr) * RWS + 16 * bq + 4 * fq;
                u32x2 o; o.x = pk2(X[bq][0], X[bq][1]); o.y = pk2(X[bq][2], X[bq][3]);
                *(u32x2*)Xm = o;
            }
#undef RW1_PACK
#undef RW1_LDA
        }
        RW1_BAR();
        }
#ifndef RW1_REP5
#define RW1_REP5 1
#endif
        for (int rep_ = 0; rep_ < RW1_REP5; ++rep_)
        for (int q = wave; q < 64; q += 8) {
            const int kind = q >> 4, ta = (q >> 2) & 3, tb = q & 3;
            u32x2 o;
            if (kind == 0) {
                const f32x4 acc = rw_tile(X1_tr, 16 * ta, B_tr, 16 * tb, fr, fq);
                const int k = 16 * tb + fr, kq = 16 * ta + 4 * fq; const float gc = GC[k];
                float v[4];
#pragma unroll
                for (int j = 0; j < 4; ++j) v[j] = gc * ((kq + j == k ? 1.f : 0.f) - acc[j]);
                o.x = pk2(v[0], v[1]); o.y = pk2(v[2], v[3]);
                *(u32x2*)(PP + (size_t)u * 4096 + k * 64 + 32 * (ta >> 1) + 8 * fq + 4 * (ta & 1)) = o;
            } else if (kind == 1) {
                const f32x4 acc = rw_tile(X1_tr, 16 * ta, MRB, 16 * tb, fr, fq);
                const int t = 16 * tb + fr, k0 = 16 * ta + 4 * fq;
                const u32x2 rv = *(const u32x2*)(R_rm + t * RWS + k0);
                o.x = pk2(bflo(rv.x) - acc[0], bfhi(rv.x) - acc[1]); o.y = pk2(bflo(rv.y) - acc[2], bfhi(rv.y) - acc[3]);
                *(u32x2*)(YT + (size_t)u * 4096 + t * 64 + 32 * (ta >> 1) + 8 * fq + 4 * (ta & 1)) = o;
            } else if (kind == 2) {
                const f32x4 a1 = rw_tile(K_tr, 16 * ta, V_tr, 16 * tb, fr, fq), a2 = rw_tile(B_tr, 16 * ta, X2_tr, 16 * tb, fr, fq);
                const int v_ = 16 * tb + fr, k0 = 16 * ta + 4 * fq;
                const f32x4 gc = *(const f32x4*)(GC + k0);
                o.x = pk2(gc[0] * (a1[0] - a2[0]), gc[1] * (a1[1] - a2[1])); o.y = pk2(gc[2] * (a1[2] - a2[2]), gc[3] * (a1[3] - a2[3]));
                *(u32x2*)(QT + (size_t)u * 4096 + v_ * 64 + k0) = o;
            } else {
                const f32x4 a1 = rw_tile(MRK, 16 * ta, V_tr, 16 * tb, fr, fq), a2 = rw_tile(MRB, 16 * ta, X2_tr, 16 * tb, fr, fq);
                const int v_ = 16 * tb + fr, t0_ = 16 * ta + 4 * fq;
                o.x = pk2(a1[0] - a2[0], a1[1] - a2[1]); o.y = pk2(a1[2] - a2[2], a1[3] - a2[3]);
                *(u32x2*)(ZT + (size_t)u * 4096 + v_ * 64 + t0_) = o;
            }
        }
        RW1_BAR();
    }
#undef RW1_LOAD
#undef RW1_BAR
}

__device__ __forceinline__ void phase_60(CParams& P, unsigned char* lds, const int ph) {
    PHASE_PROLOGUE
    if (bid < 32) {
        const int chain = bid, d = chain >> 4, b = (chain >> 3) & 1, h = chain & 7;
        const int fr = lane & 15, fq = lane >> 4;
        constexpr int MATB = 64 * RWS * 2, SLOT = 4 * MATB;
        bf16_t* ybuf = (bf16_t*)(lds + 3 * SLOT);
        const bool comp = wave < 4; const int vb = wave & 3, lm = wave & 3;
        const unsigned char* src = (const unsigned char*)(lm == 0 ? PP : (lm == 1 ? YT : (lm == 2 ? QT : ZT))) + (size_t)chain * RW_NCH * 8192 + lane * 16;
        u32x4 R0[8], R1[8], R2[8];
#define RW2_LD(Rx, c_) do { _Pragma("unroll") for (int i_ = 0; i_ < 8; ++i_) Rx[i_] = *(const u32x4*)(src + (size_t)(c_) * 8192 + i_ * 1024); } while (0)
#define RW2_ST(Rx, c_) do { unsigned char* dst_ = lds + ((c_) % 3) * SLOT + lm * MATB; _Pragma("unroll") for (int i_ = 0; i_ < 8; ++i_) { const int p_ = lane + 64 * i_; *(u32x4*)(dst_ + (p_ >> 3) * (RWS * 2) + (p_ & 7) * 16) = Rx[i_]; } } while (0)
#define RW2_FLUSH(c_) do { const int tl_ = 16 * lm + (lane >> 2), s_ = (c_) * 64 + tl_; const bf16_t* yb_ = ybuf + ((c_) & 1) * 64 * RWS + tl_ * RWS + 16 * (lane & 3); \
            const u32x4 y0_ = *(const u32x4*)yb_, y1_ = *(const u32x4*)(yb_ + 8); \
            if (s_ < LSEQ) { const int p_ = d ? LSEQ - 1 - s_ : s_; bf16_t* g_ = YFB + ((size_t)d * NT + rowof(b, p_)) * 512 + h * 64 + 16 * (lane & 3); *(u32x4*)g_ = y0_; *(u32x4*)(g_ + 8) = y1_; } } while (0)
        const f32x4 zero4 = (f32x4){0.f, 0.f, 0.f, 0.f};
        f32x4 S[4] = {zero4, zero4, zero4, zero4};
#define RW2_COMPUTE(c_) do { const bf16_t* sl_ = (const bf16_t*)(lds + ((c_) % 3) * SLOT); const bf16_t* sP = sl_; const bf16_t* sY = sl_ + 64 * RWS; const bf16_t* sQ = sl_ + 2 * 64 * RWS; const bf16_t* sZ = sl_ + 3 * 64 * RWS; \
            bf16_t* yo_ = ybuf + ((c_) & 1) * 64 * RWS + 16 * vb + fr; \
            union { bf16x8 v; unsigned u[4]; } bs[2]; \
            _Pragma("unroll") for (int ks = 0; ks < 2; ++ks) { bs[ks].u[0] = pk2(S[2 * ks][0], S[2 * ks][1]); bs[ks].u[1] = pk2(S[2 * ks][2], S[2 * ks][3]); \
                bs[ks].u[2] = pk2(S[2 * ks + 1][0], S[2 * ks + 1][1]); bs[ks].u[3] = pk2(S[2 * ks + 1][2], S[2 * ks + 1][3]); } \
            _Pragma("unroll") for (int tt = 0; tt < 4; ++tt) { \
                const u32x2 z2 = *(const u32x2*)(sZ + (16 * vb + fr) * RWS + 16 * tt + 4 * fq); \
                f32x4 acc = (f32x4){bflo(z2.x), bfhi(z2.x), bflo(z2.y), bfhi(z2.y)}; \
                acc = __builtin_amdgcn_mfma_f32_16x16x32_bf16(*(const bf16x8*)(sY + (16 * tt + fr) * RWS + 8 * fq), bs[0].v, acc, 0, 0, 0); \
                acc = __builtin_amdgcn_mfma_f32_16x16x32_bf16(*(const bf16x8*)(sY + (16 * tt + fr) * RWS + 32 + 8 * fq), bs[1].v, acc, 0, 0, 0); \
                _Pragma("unroll") for (int j = 0; j < 4; ++j) yo_[(16 * tt + 4 * fq + j) * RWS] = (bf16_t)f2bf(acc[j]); } \
            f32x4 Sn[4]; \
            _Pragma("unroll") for (int kt = 0; kt < 4; ++kt) { \
                const u32x2 q2 = *(const u32x2*)(sQ + (16 * vb + fr) * RWS + 16 * kt + 4 * fq); \
                f32x4 acc = (f32x4){bflo(q2.x), bfhi(q2.x), bflo(q2.y), bfhi(q2.y)}; \
                acc = __builtin_amdgcn_mfma_f32_16x16x32_bf16(*(const bf16x8*)(sP + (16 * kt + fr) * RWS + 8 * fq), bs[0].v, acc, 0, 0, 0); \
                acc = __builtin_amdgcn_mfma_f32_16x16x32_bf16(*(const bf16x8*)(sP + (16 * kt + fr) * RWS + 32 + 8 * fq), bs[1].v, acc, 0, 0, 0); \
                Sn[kt] = acc; } \
            _Pragma("unroll") for (int kt = 0; kt < 4; ++kt) S[kt] = Sn[kt]; } while (0)
#define RW2_BAR() do { asm volatile("s_waitcnt lgkmcnt(0)" ::: "memory"); __builtin_amdgcn_s_barrier(); asm volatile("" ::: "memory"); } while (0)
        if (!comp) { RW2_LD(R0, 0); RW2_ST(R0, 0); RW2_LD(R0, 1); RW2_LD(R1, 2); RW2_LD(R2, 3); }
        __syncthreads();
        for (int c = 0; c < RW_NCH; c += 3) {
            if (!comp) { if (c + 1 < RW_NCH) RW2_ST(R0, c + 1); if (c + 4 < RW_NCH) RW2_LD(R0, c + 4); if (c > 0) RW2_FLUSH(c - 1); } else RW2_COMPUTE(c);
            RW2_BAR();
            if (!comp) { if (c + 2 < RW_NCH) RW2_ST(R1, c + 2); if (c + 5 < RW_NCH) RW2_LD(R1, c + 5); RW2_FLUSH(c); } else RW2_COMPUTE(c + 1);
            RW2_BAR();
            if (!comp) { if (c + 3 < RW_NCH) RW2_ST(R2, c + 3); if (c + 6 < RW_NCH) RW2_LD(R2, c + 6); RW2_FLUSH(c + 1); } else RW2_COMPUTE(c + 2);
            RW2_BAR();
        }
        if (!comp) RW2_FLUSH(RW_NCH - 1);
#undef RW2_LD
#undef RW2_ST
#undef RW2_FLUSH
#undef RW2_COMPUTE
#undef RW2_BAR
    } else {
        na_units(P, lds, (bid - 32) * 8 + (threadIdx.x >> 6), (G - 32) * 8);
    }
}

__device__ __forceinline__ void phase_7(CParams& P, unsigned char* lds, const int ph) {
    PHASE_PROLOGUE
            for (int row = gw; row < NT; row += NGW) {
                const int c0 = lane * 8;
                const u32x4 yf = *(const u32x4*)(YFB + (size_t)row * 512 + c0);
                const u32x4 yb = *(const u32x4*)(YFB + ((size_t)NT + row) * 512 + c0);
                const u32x4 vv = *(const u32x4*)(VV + (size_t)row * 512 + c0);
                const u32x4 gg = *(const u32x4*)(Gg + (size_t)row * 512 + c0);
                float y[8], v[8], g[8];
#pragma unroll
                for (int i = 0; i < 4; ++i) { y[2 * i] = bflo(yf[i]) + bflo(yb[i]); y[2 * i + 1] = bfhi(yf[i]) + bfhi(yb[i]); v[2 * i] = bflo(vv[i]); v[2 * i + 1] = bfhi(vv[i]); g[2 * i] = bflo(gg[i]); g[2 * i + 1] = bfhi(gg[i]); }
                float sm = 0.f;
#pragma unroll
                for (int i = 0; i < 8; ++i) sm += y[i];
                sm += __shfl_xor(sm, 1); sm += __shfl_xor(sm, 2); sm += __shfl_xor(sm, 4);
                const float mean = sm * (1.f / 64.f);
                float vr = 0.f;
#pragma unroll
                for (int i = 0; i < 8; ++i) { const float dlt = y[i] - mean; vr += dlt * dlt; }
                vr += __shfl_xor(vr, 1); vr += __shfl_xor(vr, 2); vr += __shfl_xor(vr, 4);
                const float rstd = rsqrtf(vr * (1.f / 64.f) + 64e-5f);
                const float bc = BC[(size_t)row * 8 + (lane >> 3)];
                float o[8];
#pragma unroll
                for (int i = 0; i < 8; ++i) o[i] = ((y[i] - mean) * rstd * lnx_g[c0 + i] + lnx_b[c0 + i] + bc * v[i]) * g[i];
                u32x4 ov; ov.x = pk2(o[0], o[1]); ov.y = pk2(o[2], o[3]); ov.z = pk2(o[4], o[5]); ov.w = pk2(o[6], o[7]);
                *(u32x4*)(A2 + (size_t)row * DM + 512 + c0) = ov;
            }
}


__device__ __forceinline__ void phase_8(CParams& P, unsigned char* lds, const int ph) {
    PHASE_PROLOGUE
    if (gw < 64) meta_gemm<0>(A2 + (size_t)NMAIN * DM, WTOUT, H + (size_t)NMAIN * DM, gw, lane);
    pg8::DenseOrder S; S.init(A2, WTOUT, NMAIN, DM, DM, G, bid);
    pg8::EpiResidual E{H};
    pg8::gemm_phase<pg8::EpiResidual, pg8::DenseOrder, true, true>((PG8_LAS unsigned char*)lds, DM, S, E);
}

__device__ __forceinline__ void phase_9(CParams& P, unsigned char* lds, const int ph) {
    PHASE_PROLOGUE
            const int l = ph == 9 ? 0 : 1;
                    for (int i = bid * 512 + tid; i < MOE_MAXROWS; i += G * 512) ROWTOK[i] = 0;
    unsigned* cnt = CTL + CW_CNT(l);
            const float* wg = moe_wg + (size_t)l * DM * 4; const float* bg = moe_bg + l * 4;
            for (int row = gw; row < NT; row += NGW) {
                f32x4 v[4]; float ss = 0.f;
#pragma unroll
                for (int j = 0; j < 4; ++j) { v[j] = ldrow_bf16(H + (size_t)row * DM, lane, j); ss += v[j][0] * v[j][0] + v[j][1] * v[j][1] + v[j][2] * v[j][2] + v[j][3] * v[j][3]; }
                ss = wave_sum(ss);
                const float rstd = rsqrtf(ss * (1.f / DM) + 1e-6f);
                float lg[4] = {0.f, 0.f, 0.f, 0.f};
#pragma unroll
                for (int j = 0; j < 4; ++j) {
                    const f32x4 g = ((const f32x4*)(norm_ffn + l * DM))[lane + 64 * j];
#pragma unroll
                    for (int i = 0; i < 4; ++i) v[j][i] = v[j][i] * rstd * g[i];
                    u32x2 o; o.x = pk2(v[j][0], v[j][1]); o.y = pk2(v[j][2], v[j][3]);
                    ((u32x2*)(HN + (size_t)row * DM))[lane + 64 * j] = o;
#pragma unroll
                    for (int i = 0; i < 4; ++i) { const f32x4 w = *(const f32x4*)(wg + (size_t)(4 * (lane + 64 * j) + i) * 4);
                        lg[0] += v[j][i] * w[0]; lg[1] += v[j][i] * w[1]; lg[2] += v[j][i] * w[2]; lg[3] += v[j][i] * w[3]; }
                }
#pragma unroll
                for (int q = 0; q < 4; ++q) lg[q] = wave_sum(lg[q]) + bg[q];
                int grp = 0; float mx = lg[0];
#pragma unroll
                for (int q = 1; q < 4; ++q) if (lg[q] > mx) { mx = lg[q]; grp = q; }
                float den = 0.f;
#pragma unroll
                for (int q = 0; q < 4; ++q) den += __expf(lg[q] - mx);
                const float pgrp = 1.f / den;
                const float* we = moe_we + ((size_t)(l * 4 + grp) * DM) * 8;
                float le[8] = {0.f, 0.f, 0.f, 0.f, 0.f, 0.f, 0.f, 0.f};
#pragma unroll
                for (int j = 0; j < 4; ++j)
#pragma unroll
                    for (int i = 0; i < 4; ++i) { const float* wr_ = we + (size_t)(4 * (lane + 64 * j) + i) * 8; const f32x4 wa = *(const f32x4*)wr_, wb = *(const f32x4*)(wr_ + 4);
                        le[0] += v[j][i] * wa[0]; le[1] += v[j][i] * wa[1]; le[2] += v[j][i] * wa[2]; le[3] += v[j][i] * wa[3];
                        le[4] += v[j][i] * wb[0]; le[5] += v[j][i] * wb[1]; le[6] += v[j][i] * wb[2]; le[7] += v[j][i] * wb[3]; }
#pragma unroll
                for (int q = 0; q < 8; ++q) le[q] = wave_sum(le[q]) + moe_be[(l * 4 + grp) * 8 + q];
                int i1 = 0; float m1 = le[0];
#pragma unroll
                for (int q = 1; q < 8; ++q) if (le[q] > m1) { m1 = le[q]; i1 = q; }
                int i2 = (i1 + 1) & 7; float m2 = -3.0e38f;
#pragma unroll
                for (int q = 0; q < 8; ++q) if (q != i1 && le[q] > m2) { m2 = le[q]; i2 = q; }
                const float e2 = __expf(m2 - m1);
                const float g1 = pgrp / (1.f + e2), g2 = pgrp * e2 / (1.f + e2);
                if (lane == 0) {
                    const int ea = grp * 8 + i1, eb = grp * 8 + i2;
                    const unsigned pa = atomicAdd(cnt + ea, 1u), pb = atomicAdd(cnt + eb, 1u);
                    EID[row * 2] = ea; EID[row * 2 + 1] = eb; POS[row * 2] = (int)pa; POS[row * 2 + 1] = (int)pb;
                    GATE[row * 2] = g1; GATE[row * 2 + 1] = g2;
                }
            }
    for (int it = gw; it < CONV_MOE_ITEMS; it += NGW) conv_moe_item(P, l, it, lane);
}


__device__ __forceinline__ void phase_10(CParams& P, unsigned char* lds, const int ph) {
    PHASE_PROLOGUE
    const int l = ph == 10 ? 0 : 1;
    int* ps = (int*)(lds + LDS_TAB);
    if (tid == 0) { int acc_ = 0; for (int e = 0; e < NEXP; ++e) { ps[e] = acc_; const int c = (int)CTL[CW_CNT(l) + e]; acc_ += (c + MOE_RT - 1) / MOE_RT * MOE_RT; } ps[NEXP] = acc_; }
    __syncthreads();
    for (int i = bid * 512 + tid; i < NT * 2; i += G * 512) { const int dest = ps[EID[i]] + POS[i]; DEST[i] = dest; ROWTOK[dest] = i >> 1; }
    __syncthreads();
}

__device__ __forceinline__ void phase_11(CParams& P, unsigned char* lds, const int ph) {
    PHASE_PROLOGUE
    const int l = ph == 11 ? 0 : 1;
    int* et = (int*)(lds + LDS_TAB);
    if (tid == 0) { int acc_ = 0; for (int e = 0; e < NEXP; ++e) { const int c = (int)CTL[CW_CNT(l) + e], n = (c + MOE_RT - 1) / MOE_RT; for (int q = 0; q < n; ++q) et[1 + acc_ + q] = e; acc_ += n; } et[0] = acc_; }
    __syncthreads();
    pg8::MoeOrder<true> S{et + 1, et[0], vcu, (const char*)HN, (const char*)WT13, 256u * DM * 2u, 256u * DM * 2u, (unsigned)DM * DM * 2u, ROWTOK};
    pg8::EpiSwiglu E{HB};
    pg8::gemm_phase<pg8::EpiSwiglu, pg8::MoeOrder<true>, true, true>((PG8_LAS unsigned char*)lds, DM, S, E);
    __syncthreads();
}

__device__ __forceinline__ void phase_12(CParams& P, unsigned char* lds, const int ph) {
    PHASE_PROLOGUE
    const int l = ph == 12 ? 0 : 1;
    int* et = (int*)(lds + LDS_TAB);
    if (tid == 0) { int acc_ = 0; for (int e = 0; e < NEXP; ++e) { const int c = (int)CTL[CW_CNT(l) + e], n = (c + MOE_RT - 1) / MOE_RT; for (int q = 0; q < n; ++q) et[1 + acc_ + q] = e; acc_ += n; } et[0] = acc_; }
    __syncthreads();
    pg8::MoeOrder<false> S{et + 1, et[0], vcu, (const char*)HB, (const char*)WT2, 256u * DFF * 2u, 256u * DFF * 2u, (unsigned)DM * DFF * 2u, nullptr};
    pg8::EpiBf16Plain E{YB, DM};
    pg8::gemm_phase<pg8::EpiBf16Plain, pg8::MoeOrder<false>, true, true>((PG8_LAS unsigned char*)lds, DFF, S, E);
    __syncthreads();
}

__device__ __forceinline__ void phase_13(CParams& P, unsigned char* lds, const int ph) {
    PHASE_PROLOGUE
            const bool fin = ph == 21;
            for (int row = gw; row < NT; row += NGW) {
                const int d0 = DEST[row * 2], d1 = DEST[row * 2 + 1];
                const float g0 = GATE[row * 2], g1 = GATE[row * 2 + 1];
                f32x4 v[4];
#pragma unroll
                for (int j = 0; j < 4; ++j) {
                    v[j] = ldrow_bf16(H + (size_t)row * DM, lane, j);
                    const u32x2 ya = ((const u32x2*)(YB + (size_t)d0 * DM))[lane + 64 * j];
                    const u32x2 yb = ((const u32x2*)(YB + (size_t)d1 * DM))[lane + 64 * j];
                    v[j][0] += g0 * bflo(ya.x) + g1 * bflo(yb.x); v[j][1] += g0 * bfhi(ya.x) + g1 * bfhi(yb.x);
                    v[j][2] += g0 * bflo(ya.y) + g1 * bflo(yb.y); v[j][3] += g0 * bfhi(ya.y) + g1 * bfhi(yb.y);
                }
                if (!fin) {
#pragma unroll
                    for (int j = 0; j < 4; ++j) strow_bf16(H + (size_t)row * DM, lane, j, v[j]);
                    store_norm_bf16(v, norm_mix + DM, HN + (size_t)row * DM, lane);
                } else if (row < NMAIN) {
                    float ss = 0.f;
#pragma unroll
                    for (int j = 0; j < 4; ++j) ss += v[j][0] * v[j][0] + v[j][1] * v[j][1] + v[j][2] * v[j][2] + v[j][3] * v[j][3];
                    ss = wave_sum(ss);
                    const float rstd = rsqrtf(ss * (1.f / DM) + 1e-6f);
#pragma unroll
                    for (int j = 0; j < 4; ++j) { const f32x4 g = ((const f32x4*)norm_final)[lane + 64 * j]; f32x4 o;
                        o[0] = v[j][0] * rstd * g[0]; o[1] = v[j][1] * rstd * g[1]; o[2] = v[j][2] * rstd * g[2]; o[3] = v[j][3] * rstd * g[3];
                        ((f32x4*)(P.out + (size_t)row * DM))[lane + 64 * j] = o; }
                }
            }
}

__device__ __forceinline__ void phase_14(CParams& P, unsigned char* lds, const int ph) {
    PHASE_PROLOGUE
    float* pwr = (float*)lds; float* pwi = pwr + 2176; float* bbr = pwi + 2176; float* bbi = bbr + 2048; float* ccr = bbi + 2048; float* cci = ccr + 2048; float* kf = cci + 2048; float* kb = kf + 4096;
    for (int gu = bid; gu < 256; gu += G) {
        const int g = gu >> 2, part = gu & 3;
        if (tid < 128) {
            const int d = tid >> 6, p = tid & 63;
            const float step = __expf(s5_ls[d * 64 + g]);
            const float lr = s5_lre[(d * 64 + g) * 64 + p], li = s5_lim[(d * 64 + g) * 64 + p];
            const float mag = expf(lr * step);
            const float abr = mag * cosf(li * step), abi = mag * sinf(li * step);
            const float den = lr * lr + li * li;
            const float zr = ((abr - 1.f) * lr + abi * li) / den, zi = (abi * lr - (abr - 1.f) * li) / den;
            float pr = 1.f, pi = 0.f;
            for (int t = 0; t < 17; ++t) { pwr[(d * 64 + p) * 17 + t] = pr; pwi[(d * 64 + p) * 17 + t] = pi; const float nr = pr * abr - pi * abi; pi = pr * abi + pi * abr; pr = nr; }
            for (int i = 0; i < 16; ++i) { const float br = s5_b_re[((size_t)(g * 64 + p)) * 16 + i], bi = s5_b_im[((size_t)(g * 64 + p)) * 16 + i];
                bbr[(d * 64 + p) * 16 + i] = zr * br - zi * bi; bbi[(d * 64 + p) * 16 + i] = zr * bi + zi * br; }
        }
        for (int idx = tid; idx < 2048; idx += 512) { const int d = idx >> 10, i = (idx >> 6) & 15, p = idx & 63;
            ccr[(d * 64 + p) * 16 + i] = s5_c_re[((size_t)(d * 64 + g) * 16 + i) * 64 + p]; cci[(d * 64 + p) * 16 + i] = s5_c_im[((size_t)(d * 64 + g) * 16 + i) * 64 + p]; }
        __syncthreads();
        {
            const int d = tid >> 8, tau = (tid >> 4) & 15, i = tid & 15;
            float acc[16];
#pragma unroll
            for (int q = 0; q < 16; ++q) acc[q] = 0.f;
            for (int p = 0; p < 64; ++p) {
                const float cr = ccr[(d * 64 + p) * 16 + i], ci = cci[(d * 64 + p) * 16 + i], pr = pwr[(d * 64 + p) * 17 + tau], pi = pwi[(d * 64 + p) * 17 + tau];
                const float xr = cr * pr - ci * pi, xi = cr * pi + ci * pr;
#pragma unroll
                for (int q = 0; q < 16; ++q) acc[q] += xr * bbr[(d * 64 + p) * 16 + q] - xi * bbi[(d * 64 + p) * 16 + q];
            }
            float* kt = (d ? kb : kf) + (tau * 16 + i) * 16;
#pragma unroll
            for (int q = 0; q < 16; ++q) kt[q] = acc[q];
        }
        __syncthreads();
        unsigned* bta = (unsigned*)(BTA + (size_t)g * 512 * 256);
        for (int idx = part * 128 * 128 + tid; idx < (part + 1) * 128 * 128; idx += 512) {
            const int row = idx >> 7, col = (idx & 127) * 2;
            float v[2];
#pragma unroll
            for (int e = 0; e < 2; ++e) {
                const int cc_ = col + e, j = cc_ >> 4, ip = cc_ & 15;
                if (row < 256) { const int t = row >> 4, i = row & 15;
                    v[e] = j < t ? kf[((t - j) * 16 + i) * 16 + ip] : (j > t ? kb[((j - t) * 16 + i) * 16 + ip] : kf[i * 16 + ip] + kb[i * 16 + ip]); }
                else { const int kp = row - 256, d = kp >> 7, part = (kp >> 6) & 1, p = kp & 63, tau = d == 0 ? 15 - j : j;
                    const float pr = pwr[(d * 64 + p) * 17 + tau], pi = pwi[(d * 64 + p) * 17 + tau], br = bbr[(d * 64 + p) * 16 + ip], bi = bbi[(d * 64 + p) * 16 + ip];
                    v[e] = part ? pr * bi + pi * br : pr * br - pi * bi; }
            }
            bta[idx] = pk2(v[0], v[1]);
        }
        unsigned* btc = (unsigned*)(BTC + (size_t)g * 256 * 256);
        for (int idx = part * 64 * 128 + tid; idx < (part + 1) * 64 * 128; idx += 512) {
            const int row = idx >> 7, col = (idx & 127) * 2, t = row >> 4, i = row & 15;
            float v[2];
#pragma unroll
            for (int e = 0; e < 2; ++e) {
                const int k = col + e, d = k >> 7, part = (k >> 6) & 1, p = k & 63, tau = d == 0 ? t + 1 : 16 - t;
                const float cr = ccr[(d * 64 + p) * 16 + i], ci = cci[(d * 64 + p) * 16 + i], pr = pwr[(d * 64 + p) * 17 + tau], pi = pwi[(d * 64 + p) * 17 + tau];
                v[e] = part ? -(cr * pi + ci * pr) : cr * pr - ci * pi;
            }
            btc[idx] = pk2(v[0], v[1]);
        }
        __syncthreads();
    }
}

__device__ __forceinline__ void phase_15(CParams& P, unsigned char* lds, const int ph) {
    PHASE_PROLOGUE
    pg8::S5OrderA S{vcu, (const char*)HN, (const char*)BTA};
    pg8::EpiS5A E{YI, S5E};
    int Kr = 256; asm volatile("" : "+s"(Kr));
    pg8::gemm_phase<pg8::EpiS5A, pg8::S5OrderA, true, true>((PG8_LAS unsigned char*)lds, Kr, S, E);
}

__device__ __forceinline__ void phase_16(CParams& P, unsigned char* lds, const int ph) {
    PHASE_PROLOGUE
    float* Ls = (float*)lds;
    for (int wg = bid; wg < NB * 64 * 2; wg += G) {
        const int d = wg & 1, g = (wg >> 1) & 63, b = wg >> 7, p = lane;
        const float step = __expf(s5_ls[d * 64 + g]);
        const float lr = s5_lre[(d * 64 + g) * 64 + p], li = s5_lim[(d * 64 + g) * 64 + p];
        const float mag = expf(lr * step);
        const float abr = mag * cosf(li * step), abi = mag * sinf(li * step);
        float ar = 1.f, ai = 0.f;
        for (int t = 0; t < 16; ++t) { const float nr = ar * abr - ai * abi; ai = ar * abi + ai * abr; ar = nr; }
        float Ar = 1.f, Ai = 0.f;
        for (int t = 0; t < 64; ++t) { const float nr = Ar * ar - Ai * ai; Ai = Ar * ai + Ai * ar; Ar = nr; }
        const bf16_t* Ep = S5E + (size_t)g * 256 + d * 128 + p;
        bf16_t* Cp = CAR + (size_t)g * 1280 * 256 + d * 128 + p;
        const int q0 = 64 * wave;
#define S5_N(q_) ({ const int c_ = d ? 512 - (q_) : (q_); c_ == 0 ? 1024 + b : b * 512 + c_ - 1; })
        float sr = 0.f, si = 0.f;
#pragma unroll 1
        for (int hb = 0; hb < 2; ++hb) {
            float er[32], ei[32];
#pragma unroll
            for (int k = 0; k < 32; ++k) { const int n = S5_N(q0 + 32 * hb + k); er[k] = bf2f(Ep[(size_t)n * 64 * 256]); ei[k] = bf2f(Ep[(size_t)n * 64 * 256 + 64]); }
#pragma unroll
            for (int k = 0; k < 32; ++k) { const float nr = ar * sr - ai * si + er[k]; si = ar * si + ai * sr + ei[k]; sr = nr; }
        }
        Ls[(wave * 64 + p) * 2] = sr; Ls[(wave * 64 + p) * 2 + 1] = si;
        __syncthreads();
        sr = 0.f; si = 0.f;
        for (int w2 = 0; w2 < wave; ++w2) { const float l0 = Ls[(w2 * 64 + p) * 2], l1 = Ls[(w2 * 64 + p) * 2 + 1]; const float nr = Ar * sr - Ai * si + l0; si = Ar * si + Ai * sr + l1; sr = nr; }
#pragma unroll 1
        for (int hb = 0; hb < 2; ++hb) {
            float er[32], ei[32]; int nn[32];
#pragma unroll
            for (int k = 0; k < 32; ++k) { nn[k] = S5_N(q0 + 32 * hb + k); er[k] = bf2f(Ep[(size_t)nn[k] * 64 * 256]); ei[k] = bf2f(Ep[(size_t)nn[k] * 64 * 256 + 64]); }
#pragma unroll
            for (int k = 0; k < 32; ++k) { Cp[(size_t)nn[k] * 256] = (bf16_t)f2bf(sr); Cp[(size_t)nn[k] * 256 + 64] = (bf16_t)f2bf(si);
                const float nr = ar * sr - ai * si + er[k]; si = ar * si + ai * sr + ei[k]; sr = nr; }
        }
        if (wave == 7) { const int n = S5_N(512); Cp[(size_t)n * 256] = (bf16_t)f2bf(sr); Cp[(size_t)n * 256 + 64] = (bf16_t)f2bf(si); }
#undef S5_N
        __syncthreads();
    }
}

__device__ __forceinline__ void phase_22(CParams& P, unsigned char* lds, const int ph) {
    PHASE_PROLOGUE
    pg8::S5OrderC S{vcu, (const char*)CAR, (const char*)BTC};
    pg8::EpiS5C E{YI, HN, s5_d, A2};
    int Kr = 256; asm volatile("" : "+s"(Kr));
    pg8::gemm_phase<pg8::EpiS5C, pg8::S5OrderC, true, true>((PG8_LAS unsigned char*)lds, Kr, S, E);
}

__device__ __forceinline__ void phase_23(CParams& P, unsigned char* lds, const int ph) {
    PHASE_PROLOGUE
    if (gw < 64) meta_gemm<1>(A2 + (size_t)NMAIN * DM, WTGLU, H + (size_t)NMAIN * DM, gw, lane);
    pg8::DenseOrder S; S.init(A2, WTGLU, NMAIN, 2 * DM, DM, G, bid);
    pg8::EpiGlu E{H};
    pg8::gemm_phase<pg8::EpiGlu, pg8::DenseOrder, true, true>((PG8_LAS unsigned char*)lds, DM, S, E);
}
#define LAS __attribute__((address_space(3)))
#define CW_BAR 4096
#define XB_TMO      128
#define XB_XCNT(j)  (256  + 64 * (j))
#define XB_XSUB(j)  (1280 + 64 * (j))
#define XB_XGEN(j)  (2304 + 64 * (j))
#define XB_TOP      3328
#define XB_TOPGEN   3392
#define XCD_BAR_WORDS 3456
#define XB_SPIN_CAP (1u << 22)
__device__ __forceinline__ unsigned xb_ld(unsigned* p)              { return __hip_atomic_load(p, __ATOMIC_RELAXED, __HIP_MEMORY_SCOPE_AGENT); }
__device__ __forceinline__ unsigned xb_add(unsigned* p, unsigned v) { return __hip_atomic_fetch_add(p, v, __ATOMIC_RELAXED, __HIP_MEMORY_SCOPE_AGENT); }
__device__ __forceinline__ unsigned xb_xcc_id() { return (unsigned)__builtin_amdgcn_s_getreg((3 << 11) | 20) & 0xFu; }
#define XB_SPIN(cond, bar) do { unsigned _sp = 0; while (cond) { __builtin_amdgcn_s_sleep(1); \
    if ((++_sp & 255u) == 0u) { if (xb_ld(&(bar)[XB_TMO])) break; if (_sp > XB_SPIN_CAP) { atomicAdd(&(bar)[XB_TMO], 1u); break; } } } } while (0)
struct XcdBarrier { unsigned* bar; unsigned x; volatile LAS unsigned* st; };
__device__ __forceinline__ XcdBarrier xcd_barrier_post(unsigned* bar, volatile LAS unsigned* st) {
    XcdBarrier b; b.bar = bar; b.x = xb_xcc_id(); b.st = st;
    if (threadIdx.x == 0) (void)xb_add(&bar[XB_XCNT(b.x)], 1u);
    return b;
}
__device__ __forceinline__ void xcd_barrier_complete(unsigned* bar, unsigned x, unsigned& nloc, unsigned& nx) {
    const unsigned G = GRID;
    unsigned sum, cnt, mine, sp = 0u;
    for (;;) {
        sum = 0u; cnt = 0u; mine = 0u;
#pragma unroll
        for (unsigned j = 0; j < 16; ++j) { const unsigned c = xb_ld(&bar[XB_XCNT(j)]); sum += c; cnt += (c > 0u) ? 1u : 0u; mine = (j == x) ? c : mine; }
        if (sum == G) break;
        __builtin_amdgcn_s_sleep(1);
        if ((++sp & 255u) == 0u) { if (xb_ld(&bar[XB_TMO])) break; if (sp > XB_SPIN_CAP) { atomicAdd(&bar[XB_TMO], 1u); break; } }
    }
    nloc = mine > 0u ? mine : 1u; nx = cnt > 0u ? cnt : 1u;
}
__device__ __forceinline__ void xcd_barrier(const XcdBarrier& b) {
    asm volatile("s_waitcnt vmcnt(0)" ::: "memory");
    __syncthreads();
    if (threadIdx.x == 0) {
        unsigned* bar = b.bar;
        __builtin_amdgcn_s_waitcnt(0);
        unsigned nloc = b.st[0], nx = b.st[1];
        if (nloc == 0u) { xcd_barrier_complete(bar, b.x, nloc, nx); b.st[0] = nloc; b.st[1] = nx; }
        const unsigned old = xb_add(&bar[XB_XSUB(b.x)], 1u);
        const unsigned gen = old / nloc;
        if (old + 1u == (gen + 1u) * nloc) {
            __builtin_amdgcn_fence(__ATOMIC_RELEASE, "agent");
            asm volatile("s_waitcnt vmcnt(0)" ::: "memory");
            const unsigned og = xb_add(&bar[XB_TOP], 1u);
            const unsigned tg = og / nx;
            if (og + 1u == (tg + 1u) * nx) xb_add(&bar[XB_TOPGEN], 1u);
            else XB_SPIN(xb_ld(&bar[XB_TOPGEN]) == tg, bar);
            __builtin_amdgcn_fence(__ATOMIC_ACQUIRE, "agent");
            xb_add(&bar[XB_XGEN(b.x)], 1u);
            asm volatile("s_waitcnt vmcnt(0)" ::: "memory");
        } else {
            XB_SPIN(xb_ld(&bar[XB_XGEN(b.x)]) == gen, bar);
            __builtin_amdgcn_fence(__ATOMIC_ACQUIRE, "agent");
            asm volatile("s_waitcnt vmcnt(0)" ::: "memory");
        }
    }
    __syncthreads();
}


__global__ void __launch_bounds__(512, 2) mega(Params P_) {
    extern __shared__ __attribute__((aligned(16))) unsigned char lds[];
    volatile LAS unsigned* st = (volatile LAS unsigned*)(LAS unsigned char*)(lds + LDS_BARST);
    if (threadIdx.x < 16) st[threadIdx.x] = 0u;
    __syncthreads();
    CParams* pp = (CParams*)__builtin_amdgcn_kernarg_segment_ptr();
    (void)xcd_barrier_post((unsigned*)(pp->ws + WS_CTL) + CW_BAR, st);
#define GB do { XcdBarrier bar_; bar_.bar = (unsigned*)(pp->ws + WS_CTL) + CW_BAR; bar_.x = xb_xcc_id(); bar_.st = (volatile LAS unsigned*)(LAS unsigned char*)(lds + LDS_BARST); xcd_barrier(bar_); asm volatile("" : "+s"(pp)); } while (0)
#define P (*pp)
    asm volatile("" : "+s"(pp));
    phase_0(P, lds, 0); GB;
#if defined(PROBE_PH) && PROBE_PH == 0
    { int nrep = PROBE_N; asm volatile("" : "+s"(nrep)); for (int rep = 0; rep < nrep; ++rep) { GB; phase_0(P, lds, 0); GB; } }
#endif
    phase_1(P, lds, 1); GB;
#if defined(PROBE_PH) && PROBE_PH == 1
    { int nrep = PROBE_N; asm volatile("" : "+s"(nrep)); for (int rep = 0; rep < nrep; ++rep) { GB; phase_1(P, lds, 1); GB; } }
#endif
    phase_3(P, lds, 3); GB;
#if defined(PROBE_PH) && PROBE_PH == 3
    { int nrep = PROBE_N; asm volatile("" : "+s"(nrep)); for (int rep = 0; rep < nrep; ++rep) { GB; phase_3(P, lds, 3); GB; } }
#endif
    phase_4(P, lds, 4); GB;
#if defined(PROBE_PH) && PROBE_PH == 4
    { int nrep = PROBE_N; asm volatile("" : "+s"(nrep)); for (int rep = 0; rep < nrep; ++rep) { GB; phase_4(P, lds, 4); GB; } }
#endif
    phase_5(P, lds, 5); GB;
#if defined(PROBE_PH) && PROBE_PH == 5
    { int nrep = PROBE_N; asm volatile("" : "+s"(nrep)); for (int rep = 0; rep < nrep; ++rep) { GB; phase_5(P, lds, 5); GB; } }
#endif
    phase_6(P, lds, 6); GB;
    phase_60(P, lds, 60); GB;
#if defined(PROBE_PH) && PROBE_PH == 60
    { int nrep = PROBE_N; asm volatile("" : "+s"(nrep)); for (int rep = 0; rep < nrep; ++rep) { GB; phase_60(P, lds, 60); GB; } }
#endif
#if defined(PROBE_PH) && PROBE_PH == 6
    { int nrep = PROBE_N; asm volatile("" : "+s"(nrep)); for (int rep = 0; rep < nrep; ++rep) { GB; phase_6(P, lds, 6); GB; } }
#endif
    phase_7(P, lds, 7); GB;
#if defined(PROBE_PH) && PROBE_PH == 7
    { int nrep = PROBE_N; asm volatile("" : "+s"(nrep)); for (int rep = 0; rep < nrep; ++rep) { GB; phase_7(P, lds, 7); GB; } }
#endif
    phase_8(P, lds, 8); GB;
#if defined(PROBE_PH) && PROBE_PH == 8
    { int nrep = PROBE_N; asm volatile("" : "+s"(nrep)); for (int rep = 0; rep < nrep; ++rep) { GB; phase_8(P, lds, 8); GB; } }
#endif
    phase_9(P, lds, 9); GB;
#if defined(PROBE_PH) && PROBE_PH == 9
    { int nrep = PROBE_N; asm volatile("" : "+s"(nrep)); for (int rep = 0; rep < nrep; ++rep) { GB; phase_9(P, lds, 9); GB; } }
#endif
    phase_10(P, lds, 10); GB;
#if defined(PROBE_PH) && PROBE_PH == 10
    { int nrep = PROBE_N; asm volatile("" : "+s"(nrep)); for (int rep = 0; rep < nrep; ++rep) { GB; phase_10(P, lds, 10); GB; } }
#endif
    phase_11(P, lds, 11); GB;
#if defined(PROBE_PH) && PROBE_PH == 11
    { int nrep = PROBE_N; asm volatile("" : "+s"(nrep)); for (int rep = 0; rep < nrep; ++rep) { GB; phase_11(P, lds, 11); GB; } }
#endif
    phase_12(P, lds, 12); GB;
#if defined(PROBE_PH) && PROBE_PH == 12
    { int nrep = PROBE_N; asm volatile("" : "+s"(nrep)); for (int rep = 0; rep < nrep; ++rep) { GB; phase_12(P, lds, 12); GB; } }
#endif
    phase_13(P, lds, 13); GB;
#if defined(PROBE_PH) && PROBE_PH == 13
    { int nrep = PROBE_N; asm volatile("" : "+s"(nrep)); for (int rep = 0; rep < nrep; ++rep) { GB; phase_13(P, lds, 13); GB; } }
#endif
    phase_14(P, lds, 14); GB;
#if defined(PROBE_PH) && PROBE_PH == 14
    { int nrep = PROBE_N; asm volatile("" : "+s"(nrep)); for (int rep = 0; rep < nrep; ++rep) { GB; phase_14(P, lds, 14); GB; } }
#endif
    phase_15(P, lds, 15); GB;
#if defined(PROBE_PH) && PROBE_PH == 15
    { int nrep = PROBE_N; asm volatile("" : "+s"(nrep)); for (int rep = 0; rep < nrep; ++rep) { GB; phase_15(P, lds, 15); GB; } }
#endif
    phase_16(P, lds, 16); GB;
#if defined(PROBE_PH) && PROBE_PH == 16
    { int nrep = PROBE_N; asm volatile("" : "+s"(nrep)); for (int rep = 0; rep < nrep; ++rep) { GB; phase_16(P, lds, 16); GB; } }
#endif
    phase_22(P, lds, 22); GB;
#if defined(PROBE_PH) && PROBE_PH == 22
    { int nrep = PROBE_N; asm volatile("" : "+s"(nrep)); for (int rep = 0; rep < nrep; ++rep) { GB; phase_22(P, lds, 22); GB; } }
#endif
    phase_23(P, lds, 23); GB;
#if defined(PROBE_PH) && PROBE_PH == 23
    { int nrep = PROBE_N; asm volatile("" : "+s"(nrep)); for (int rep = 0; rep < nrep; ++rep) { GB; phase_23(P, lds, 23); GB; } }
#endif
    phase_9(P, lds, 17); GB;
#if defined(PROBE_PH) && PROBE_PH == 17
    { int nrep = PROBE_N; asm volatile("" : "+s"(nrep)); for (int rep = 0; rep < nrep; ++rep) { GB; phase_9(P, lds, 17); GB; } }
#endif
    phase_10(P, lds, 18); GB;
#if defined(PROBE_PH) && PROBE_PH == 18
    { int nrep = PROBE_N; asm volatile("" : "+s"(nrep)); for (int rep = 0; rep < nrep; ++rep) { GB; phase_10(P, lds, 18); GB; } }
#endif
    phase_11(P, lds, 19); GB;
#if defined(PROBE_PH) && PROBE_PH == 19
    { int nrep = PROBE_N; asm volatile("" : "+s"(nrep)); for (int rep = 0; rep < nrep; ++rep) { GB; phase_11(P, lds, 19); GB; } }
#endif
    phase_12(P, lds, 20); GB;
#if defined(PROBE_PH) && PROBE_PH == 20
    { int nrep = PROBE_N; asm volatile("" : "+s"(nrep)); for (int rep = 0; rep < nrep; ++rep) { GB; phase_12(P, lds, 20); GB; } }
#endif
    phase_13(P, lds, 21);
#if defined(PROBE_PH) && PROBE_PH == 21
    { int nrep = PROBE_N; asm volatile("" : "+s"(nrep)); for (int rep = 0; rep < nrep; ++rep) { GB; phase_13(P, lds, 21); GB; } }
#endif
#undef P
#undef GB
}

extern "C" void kernel_launch(void* const* d_in, const int* in_sizes, int n_in, void* d_out, int out_size, void* d_ws, size_t ws_size, hipStream_t stream) {
    static int ready = 0;
    if (!ready) {
        if (n_in != 35 || ws_size < WS_TOTAL) { fprintf(stderr, "kernel_launch: unexpected n_in %d or ws_size %zu (need %zu)\n", n_in, ws_size, (size_t)WS_TOTAL); ready = -1; return; }
        if (hipFuncSetAttribute((const void*)mega, hipFuncAttributeMaxDynamicSharedMemorySize, LDS_BYTES) != hipSuccess) { fprintf(stderr, "kernel_launch: hipFuncSetAttribute failed\n"); ready = -1; return; }
        ready = 1;
    }
    if (ready < 0) return;
    (void)hipMemsetAsync((char*)d_ws + WS_CTL, 0, 1 * MiB, stream);
    Params P{};
    for (int i = 0; i < 35; ++i) P.in[i] = (const float*)d_in[i];
    P.out = (float*)d_out; P.ws = (unsigned char*)d_ws; P.ph_lo = 0; P.ph_hi = 0;
    hipLaunchKernelGGL(mega, dim3(GRID), dim3(512), LDS_BYTES, stream, P);
}
```

```cpp
#include <hip/hip_runtime.h>
#include <stdint.h>
#include <stdio.h>

#define DM 1024
#define NB 2
#define SEQ 8192
#define NMETA 16
#define LSEQ (SEQ + NMETA)
#define NMAIN (NB * SEQ)
#define NT (NB * LSEQ)
#define NTP 16640
#define INCOLS 3328
#define RESTC 1792
#define NEXP 32
#define DFF 512
#define S5TC 48
#define S5NC 171
#define MOE_RT 256
#define MOE_MAXROWS 41216

typedef unsigned short bf16_t;
typedef short bf16x8 __attribute__((ext_vector_type(8)));
typedef float f32x4 __attribute__((ext_vector_type(4)));
typedef unsigned u32x4 __attribute__((ext_vector_type(4)));
typedef unsigned u32x2 __attribute__((ext_vector_type(2)));

constexpr size_t MiB = 1u << 20;
constexpr size_t cmax2(size_t a, size_t b) { return a > b ? a : b; }
constexpr size_t al64k(size_t x) { return (x + 65535) & ~(size_t)65535; }
constexpr size_t WS_CTL = 0;
constexpr size_t WS_H = 1 * MiB;
constexpr size_t WS_HN = WS_H + al64k((size_t)NT * DM * 2);
constexpr size_t WS_A2 = WS_HN + al64k((size_t)NTP * DM * 2);
constexpr size_t WS_WTIN = WS_A2 + al64k((size_t)NTP * DM * 2);
constexpr size_t WS_WTOUT = WS_WTIN + al64k((size_t)INCOLS * DM * 2);
constexpr size_t WS_WTGLU = WS_WTOUT + al64k((size_t)DM * DM * 2);
constexpr size_t WS_LRT = WS_WTGLU + al64k((size_t)2 * DM * DM * 2);
constexpr size_t WS_BIG = WS_LRT + al64k((size_t)(2 * 512 * 64 * 2 + 512 * 128) * 2);
constexpr size_t SZ_T512 = al64k((size_t)NT * 512 * 2);
constexpr size_t SZ_P512 = al64k((size_t)NTP * 512 * 2);
constexpr int RW_NCH = 129, RW_UNITS = 32 * RW_NCH;
constexpr size_t SZ_RWOP = al64k((size_t)RW_UNITS * 4096 * 2);
constexpr size_t WS_Q = WS_BIG;
constexpr size_t WS_K = WS_Q + SZ_P512;
constexpr size_t WS_V = WS_K + SZ_P512;
constexpr size_t WS_REST = WS_V + SZ_P512;
constexpr size_t WS_KR = WS_REST + al64k((size_t)NTP * RESTC * 2);
constexpr size_t WS_LOW = WS_KR + SZ_T512;
constexpr size_t WS_AA = WS_LOW + al64k((size_t)NT * 256 * 2);
constexpr size_t WS_XEARLY = WS_AA + 2 * SZ_T512;
constexpr size_t WS_PP = WS_REST;
constexpr size_t WS_QT = WS_PP + SZ_RWOP;
constexpr size_t WS_YT = WS_QT + SZ_RWOP;
constexpr size_t WS_ZT = WS_YT + SZ_RWOP;
constexpr size_t WS_XEND = cmax2(WS_XEARLY, WS_ZT + SZ_RWOP);
constexpr size_t WS_R = WS_XEND;
constexpr size_t WS_VV = WS_R + SZ_T512;
constexpr size_t WS_G = WS_VV + SZ_T512;
constexpr size_t WS_KK = WS_G + SZ_T512;
constexpr size_t WS_KKA = WS_KK + SZ_T512;
constexpr size_t WS_KD = WS_KKA + 2 * SZ_T512;
constexpr size_t WS_W = WS_KD + 2 * SZ_T512;
constexpr size_t WS_BC = WS_W + 2 * SZ_T512;
constexpr size_t WS_MIXEND = WS_BC + al64k((size_t)NT * 8 * 4);
constexpr size_t WS_YFB = WS_KK;
constexpr size_t WS_ROWTOK = WS_BIG;
constexpr size_t WS_HB = WS_ROWTOK + al64k((size_t)MOE_MAXROWS * 4);
constexpr size_t WS_YB = WS_HB + al64k((size_t)MOE_MAXROWS * DFF * 2);
constexpr size_t WS_WT13 = WS_YB + al64k((size_t)MOE_MAXROWS * DM * 2);
constexpr size_t WS_WT2 = WS_WT13 + al64k((size_t)NEXP * DM * DM * 2);
constexpr size_t WS_EID = WS_WT2 + al64k((size_t)NEXP * DM * DFF * 2);
constexpr size_t WS_POS = WS_EID + al64k((size_t)NT * 8);
constexpr size_t WS_DEST = WS_POS + al64k((size_t)NT * 8);
constexpr size_t WS_GATE = WS_DEST + al64k((size_t)NT * 8);
constexpr size_t WS_MOEEND = WS_GATE + al64k((size_t)NT * 8);
constexpr size_t WS_YI = WS_BIG;
constexpr size_t WS_E = WS_YI + al64k((size_t)NTP * DM * 2);
constexpr size_t WS_CAR = WS_E + al64k((size_t)1040 * 64 * 256 * 2);
constexpr size_t WS_BTA = WS_CAR + al64k((size_t)64 * 1280 * 256 * 2);
constexpr size_t WS_BTC = WS_BTA + al64k((size_t)64 * 512 * 256 * 2);
constexpr size_t WS_S5END = WS_BTC + al64k((size_t)64 * 256 * 256 * 2);
constexpr size_t cmax(size_t a, size_t b) { return a > b ? a : b; }
constexpr size_t WS_TOTAL = cmax(WS_MIXEND, cmax(WS_MOEEND, WS_S5END));
static_assert(WS_TOTAL <= 512 * MiB, "workspace map exceeds 512 MiB");

#define CW_CNT(l) (1024 + 64 * (l))

#define LDS_BYTES 163840
#define LDS_BARST (LDS_BYTES - 1024)
#define LDS_TAB (LDS_BYTES - 768)
#define LDS_RING (LDS_BYTES - 1024)
#define GRID 256

struct Params {
    const float* in[35];
    float* out;
    unsigned char* ws;
    int ph_lo, ph_hi;
};
typedef const __attribute__((address_space(4))) Params CParams;

__device__ __forceinline__ float bf2f(bf16_t v) { return __uint_as_float(((unsigned)v) << 16); }
typedef float f32x2c_ __attribute__((ext_vector_type(2)));
typedef __bf16 bf16x2c_ __attribute__((ext_vector_type(2)));
__device__ __forceinline__ unsigned pk2(float lo, float hi) { const f32x2c_ f = {lo, hi}; const bf16x2c_ b = __builtin_convertvector(f, bf16x2c_); return __builtin_bit_cast(unsigned, b); }
__device__ __forceinline__ unsigned f2bf(float f) { return (unsigned)__builtin_bit_cast(unsigned short, (__bf16)f); }
__device__ __forceinline__ float bflo(unsigned u) { return __uint_as_float(u << 16); }
__device__ __forceinline__ float bfhi(unsigned u) { return __uint_as_float(u & 0xffff0000u); }
__device__ __forceinline__ float wave_sum(float v) {
#pragma unroll
    for (int o = 1; o < 64; o <<= 1) v += __shfl_xor(v, o);
    return v;
}
__device__ __forceinline__ float wave_max(float v) {
#pragma unroll
    for (int o = 1; o < 64; o <<= 1) v = fmaxf(v, __shfl_xor(v, o));
    return v;
}
template <int CTRL> __device__ __forceinline__ float dppf(float v) { return __int_as_float(__builtin_amdgcn_update_dpp(0, __float_as_int(v), CTRL, 0xF, 0xF, true)); }
__device__ __forceinline__ float row16_sum(float v) { v += dppf<0xB1>(v); v += dppf<0x4E>(v); v += dppf<0x141>(v); v += dppf<0x140>(v); return v; }
__device__ __forceinline__ float sigmoidf_(float x) { return __builtin_amdgcn_rcpf(1.f + __expf(-x)); }
__device__ __forceinline__ int rowof(int b, int p) { return p < NMETA ? NMAIN + b * NMETA + p : b * SEQ + (p - NMETA); }

#define SA_STRIDE 40
template <class AF, class BF>
__device__ __forceinline__ void gemm_tile(unsigned char* lds, int K, int ldb, const AF& arow, const BF& bcol, f32x4 (&acc)[4][2]) {
    bf16_t* sA = (bf16_t*)lds;
    bf16_t* sB = (bf16_t*)(lds + 128 * SA_STRIDE * 2);
    const int tid = threadIdx.x, lane = tid & 63, wave = tid >> 6, wr = wave >> 2, wc = wave & 3, fr = lane & 15, fq = lane >> 4;
#pragma unroll
    for (int mi = 0; mi < 4; ++mi)
#pragma unroll
        for (int ni = 0; ni < 2; ++ni) acc[mi][ni] = (f32x4){0.f, 0.f, 0.f, 0.f};
    const int ar = tid >> 2, akc = (tid & 3) * 8;
    const bf16_t* ap = arow(ar) + akc;
    const int bnq = (tid & 31) * 4, bkp = (tid >> 5) * 2;
    const float* bp = bcol(bnq) + (size_t)bkp * ldb;
    const int nk = K / 32;
    u32x4 ra = *(const u32x4*)ap;
    f32x4 rb0 = *(const f32x4*)bp, rb1 = *(const f32x4*)(bp + ldb);
    for (int kt = 0; kt < nk; ++kt) {
        __syncthreads();
        *(u32x4*)(sA + ar * SA_STRIDE + akc) = ra;
        {
            unsigned* d = (unsigned*)(sB + bnq * SA_STRIDE + bkp);
            d[0 * (SA_STRIDE / 2)] = pk2(rb0[0], rb1[0]);
            d[1 * (SA_STRIDE / 2)] = pk2(rb0[1], rb1[1]);
            d[2 * (SA_STRIDE / 2)] = pk2(rb0[2], rb1[2]);
            d[3 * (SA_STRIDE / 2)] = pk2(rb0[3], rb1[3]);
        }
        __syncthreads();
        if (kt + 1 < nk) {
            ra = *(const u32x4*)(ap + (kt + 1) * 32);
            const float* q = bp + (size_t)(kt + 1) * 32 * ldb;
            rb0 = *(const f32x4*)q; rb1 = *(const f32x4*)(q + ldb);
        }
        bf16x8 a[4], b[2];
#pragma unroll
        for (int mi = 0; mi < 4; ++mi) a[mi] = *(const bf16x8*)(sA + (wr * 64 + mi * 16 + fr) * SA_STRIDE + fq * 8);
#pragma unroll
        for (int ni = 0; ni < 2; ++ni) b[ni] = *(const bf16x8*)(sB + (wc * 32 + ni * 16 + fr) * SA_STRIDE + fq * 8);
#pragma unroll
        for (int mi = 0; mi < 4; ++mi)
#pragma unroll
            for (int ni = 0; ni < 2; ++ni) acc[mi][ni] = __builtin_amdgcn_mfma_f32_16x16x32_bf16(a[mi], b[ni], acc[mi][ni], 0, 0, 0);
    }
    __syncthreads();
}
#define ACC_FOREACH(acc, ...) do { const int _l = threadIdx.x & 63, _w = threadIdx.x >> 6, _wr = _w >> 2, _wc = _w & 3, _fr = _l & 15, _fq = _l >> 4; \
    _Pragma("unroll") for (int _mi = 0; _mi < 4; ++_mi) _Pragma("unroll") for (int _ni = 0; _ni < 2; ++_ni) _Pragma("unroll") for (int _j = 0; _j < 4; ++_j) { \
        const int rl = _wr * 64 + _mi * 16 + _fq * 4 + _j, cl = _wc * 32 + _ni * 16 + _fr; const float val = acc[_mi][_ni][_j]; __VA_ARGS__ } } while (0)
#define ACC_FOREACH_PAIR(acc, ...) do { const int _l = threadIdx.x & 63, _w = threadIdx.x >> 6, _wr = _w >> 2, _wc = _w & 3, _fr = _l & 15, _fq = _l >> 4; \
    _Pragma("unroll") for (int _mi = 0; _mi < 4; ++_mi) _Pragma("unroll") for (int _j = 0; _j < 4; ++_j) { \
        const int rl = _wr * 64 + _mi * 16 + _fq * 4 + _j, co = _wc * 16 + _fr; const float va = acc[_mi][0][_j], vg = acc[_mi][1][_j]; __VA_ARGS__ } } while (0)

__device__ __forceinline__ void store_norm_bf16(const f32x4 (&v)[4], const float* gain, bf16_t* dst, int lane) {
    float ss = 0.f;
#pragma unroll
    for (int j = 0; j < 4; ++j) ss += v[j][0] * v[j][0] + v[j][1] * v[j][1] + v[j][2] * v[j][2] + v[j][3] * v[j][3];
    ss = wave_sum(ss);
    const float rstd = rsqrtf(ss * (1.f / DM) + 1e-6f);
#pragma unroll
    for (int j = 0; j < 4; ++j) {
        const f32x4 g = ((const f32x4*)gain)[lane + 64 * j];
        u32x2 o; o.x = pk2(v[j][0] * rstd * g[0], v[j][1] * rstd * g[1]); o.y = pk2(v[j][2] * rstd * g[2], v[j][3] * rstd * g[3]);
        ((u32x2*)dst)[lane + 64 * j] = o;
    }
}


__device__ __forceinline__ f32x4 ldrow_bf16(const bf16_t* row, int lane, int j) { const u32x2 u = ((const u32x2*)row)[lane + 64 * j]; return (f32x4){bflo(u.x), bfhi(u.x), bflo(u.y), bfhi(u.y)}; }
__device__ __forceinline__ void strow_bf16(bf16_t* row, int lane, int j, const f32x4 v) { u32x2 o; o.x = pk2(v[0], v[1]); o.y = pk2(v[2], v[3]); ((u32x2*)row)[lane + 64 * j] = o; }
namespace pg8 {
#define PG8_LAS __attribute__((address_space(3)))
constexpr int BM = 256, BK = 64, HALF = 128, HTB = HALF * BK * 2  , STAGE_BYTES = 8 * HTB, NXCD = 8, WGM = 8;
__host__ __device__ __forceinline__ int lds_byte(int r, int c) { const int st = (r >> 4) * 2 + (c >> 5), rr = r & 15, cc = c & 31, ob = rr * 64 + cc * 2; return st * 1024 + (ob ^ (((ob >> 9) & 1) << 5)); }
__host__ __device__ __forceinline__ void stage_rc(int b, int& R, int& C) { const int st = b / 1024, sb = b % 1024, swz = sb ^ (((sb >> 9) & 1) << 5); R = (st >> 1) * 16 + swz / 64; C = (st & 1) * 32 + (swz % 64) / 2; }
__host__ __device__ __forceinline__ int perm32(int rho) { const int n = rho >> 4, i = rho & 15; return 8 * (i >> 2) + 4 * n + (i & 3); }

struct Unit { int pm, pn; const char* A; const char* B; };

struct DenseOrder {
    static constexpr bool GATHER_ROWS = false;
    static constexpr bool GATHER_A = false;
    int nM, nN, nwg, G, c; const char* A; const char* Bt; size_t tstep;
    __device__ void init(const bf16_t* A_, const bf16_t* Bt_, int M, int N, int K, int G_, int c_) { nM = M / BM; nN = N / BM; nwg = nM * nN; G = G_; c = c_; A = (const char*)A_; Bt = (const char*)Bt_; tstep = (size_t)BM * K * 2; }
    __device__ bool next(int i, Unit& u) const {
        const long L = (long)i * G + c; if (L >= nwg) return false;
        int wgid = (int)L; { const int q = nwg / NXCD, r = nwg % NXCD, xcd = wgid % NXCD, off = wgid / NXCD; wgid = (xcd < r ? xcd * (q + 1) : r * (q + 1) + (xcd - r) * q) + off; }
        const int nig = WGM * nN, gid = wgid / nig, fm = gid * WGM, gsz = (nM - fm) < WGM ? (nM - fm) : WGM;
        u.pm = fm + ((wgid % nig) % gsz); u.pn = (wgid % nig) / gsz; u.A = A + (size_t)u.pm * tstep; u.B = Bt + (size_t)u.pn * tstep; return true;
    }
    __device__ __forceinline__ void a_ready(const Unit&) const {}
    __device__ __forceinline__ void done(const Unit&) const {}
};
struct ProjOrder {
    static constexpr bool GATHER_ROWS = false;
    static constexpr bool GATHER_A = false;
    DenseOrder D; const char* HNp; const char* WT;
    __device__ void init(const bf16_t* HN_, const bf16_t* WT_, int c_) { D.init(HN_, WT_, NTP, 13 * BM, DM, GRID, c_); HNp = (const char*)HN_; WT = (const char*)WT_; }
    __device__ bool next(int i, Unit& u) const {
        if (!D.next(i, u)) return false;
        const size_t ts = (size_t)BM * DM * 2;
        if (u.pn < 11) { const int wrow = u.pn < 4 ? u.pn : u.pn + 2; u.A = HNp + (size_t)u.pm * ts; u.B = WT + (size_t)wrow * ts; }
        else { u.A = WT + (size_t)(4 + (u.pn - 11)) * ts; u.B = HNp + (size_t)u.pm * ts; }
        return true;
    }
    __device__ __forceinline__ void a_ready(const Unit&) const {}
    __device__ __forceinline__ void done(const Unit&) const {}
};
template <bool GATHER> struct MoeOrder {
    static constexpr bool GATHER_ROWS = GATHER;
    static constexpr bool GATHER_A = false;
    const int* et; int TT, vcu; const char* A; const char* Bt; unsigned tstepA, tstepB, estep; const int* rowidx;
    __device__ __forceinline__ bool next(int i, Unit& u) const {
        const int L = i * GRID + vcu; if (L >= TT * 4) return false;
        const int rt = L >> 2, ct = L & 3, e = et[rt];
        u.pm = rt; u.pn = ct; u.A = GATHER ? A : A + (size_t)rt * tstepA; u.B = Bt + (size_t)e * estep + (size_t)ct * tstepB; return true;
    }
    __device__ __forceinline__ void a_ready(const Unit&) const {}
    __device__ __forceinline__ void done(const Unit&) const {}
};

struct S5OrderA {
    static constexpr bool GATHER_ROWS = false;
    static constexpr bool GATHER_A = true;
    int vcu; const char* U; const char* BTA;
    __device__ __forceinline__ bool next(int i, Unit& u) const {
        const int L = i * GRID + vcu; if (L >= 640) return false;
        const int g = L / 10, rem = L - g * 10, mt = rem >> 1, nt = rem & 1;
        u.pm = mt; u.pn = g * 2 + nt; u.A = U + ((size_t)mt * 256 * 16 * 1024 + g * 16) * 2; u.B = BTA + ((size_t)(g * 512 + nt * 256) * 256) * 2; return true;
    }
    __device__ __forceinline__ void a_ready(const Unit&) const {}
    __device__ __forceinline__ void done(const Unit&) const {}
};
struct S5OrderC {
    static constexpr bool GATHER_ROWS = false;
    static constexpr bool GATHER_A = false;
    int vcu; const char* CAR; const char* BTC;
    __device__ __forceinline__ bool next(int i, Unit& u) const {
        const int L = i * GRID + vcu; if (L >= 320) return false;
        const int g = L / 5, mt = L - g * 5;
        u.pm = mt; u.pn = g; u.A = CAR + ((size_t)(g * 1280 + mt * 256) * 256) * 2; u.B = BTC + ((size_t)g * 256 * 256) * 2; return true;
    }
    __device__ __forceinline__ void a_ready(const Unit&) const {}
    __device__ __forceinline__ void done(const Unit&) const {}
};
__device__ __forceinline__ unsigned cvt_pk_bf16(float lo, float hi) { return pk2(lo, hi); }

struct EpiProj {
    static constexpr bool PERM = true, AFTER_DRAIN = false;
    bf16_t *Q, *Kk, *VT, *REST;
    __device__ __forceinline__ void operator()(const f32x4 (&acc)[2][2][4][2], const Unit& u, int wr, int wc, int fr, int fq) const {
        bf16_t* base; int ldc; int row0, col0;
        if (u.pn < 11) { row0 = u.pm * BM + wr * 64 + fr; int colt;
            if (u.pn < 2) { base = Q; colt = u.pn * BM; ldc = 512; } else if (u.pn < 4) { base = Kk; colt = (u.pn - 2) * BM; ldc = 512; } else { base = REST; colt = (u.pn - 4) * BM; ldc = RESTC; }
            col0 = colt + wc * 32 + 8 * fq; }
        else { base = VT; ldc = NTP; row0 = (u.pn - 11) * BM + wr * 64 + fr; col0 = u.pm * BM + wc * 32 + 8 * fq; }
#pragma unroll
        for (int ai = 0; ai < 2; ++ai)
#pragma unroll
            for (int m = 0; m < 4; ++m) { bf16_t* rowp = base + (size_t)(row0 + ai * HALF + m * 16) * ldc + col0;
#pragma unroll
                for (int bj = 0; bj < 2; ++bj) { const f32x4 v0 = acc[ai][bj][m][0], v1 = acc[ai][bj][m][1];
                    u32x4 w; w.x = cvt_pk_bf16(v0[0], v0[1]); w.y = cvt_pk_bf16(v0[2], v0[3]); w.z = cvt_pk_bf16(v1[0], v1[1]); w.w = cvt_pk_bf16(v1[2], v1[3]);
                    *(u32x4*)(rowp + bj * HALF) = w; } }
    }
};
struct EpiBf16Plain {
    static constexpr bool PERM = true, AFTER_DRAIN = false;
    bf16_t* O; int ldc;
    __device__ __forceinline__ void operator()(const f32x4 (&acc)[2][2][4][2], const Unit& u, int wr, int wc, int fr, int fq) const {
        const int row0 = u.pm * BM + wr * 64 + fr; const int col0 = u.pn * BM + wc * 32 + 8 * fq;
#pragma unroll
        for (int ai = 0; ai < 2; ++ai)
#pragma unroll
            for (int m = 0; m < 4; ++m) { bf16_t* rowp = O + (size_t)(row0 + ai * HALF + m * 16) * ldc + col0;
#pragma unroll
                for (int bj = 0; bj < 2; ++bj) { const f32x4 v0 = acc[ai][bj][m][0], v1 = acc[ai][bj][m][1];
                    u32x4 w; w.x = cvt_pk_bf16(v0[0], v0[1]); w.y = cvt_pk_bf16(v0[2], v0[3]); w.z = cvt_pk_bf16(v1[0], v1[1]); w.w = cvt_pk_bf16(v1[2], v1[3]);
                    *(u32x4*)(rowp + bj * HALF) = w; } }
    }
};
struct EpiSwiglu {
    static constexpr bool PERM = true, AFTER_DRAIN = false;
    bf16_t* O;
    __device__ __forceinline__ void operator()(const f32x4 (&acc)[2][2][4][2], const Unit& u, int wr, int wc, int fr, int fq) const {
        const int row0 = u.pm * BM + wr * 64 + fr; const int col0 = u.pn * HALF + wc * 32 + 8 * fq;
#pragma unroll
        for (int ai = 0; ai < 2; ++ai)
#pragma unroll
            for (int m = 0; m < 4; ++m) {
                float o[8];
#pragma unroll
                for (int n = 0; n < 2; ++n)
#pragma unroll
                    for (int i = 0; i < 4; ++i) { const float va = acc[ai][0][m][n][i], vg = acc[ai][1][m][n][i]; o[4 * n + i] = va * __builtin_amdgcn_rcpf(1.f + __expf(-va)) * vg; }
                u32x4 w; w.x = cvt_pk_bf16(o[0], o[1]); w.y = cvt_pk_bf16(o[2], o[3]); w.z = cvt_pk_bf16(o[4], o[5]); w.w = cvt_pk_bf16(o[6], o[7]);
                *(u32x4*)(O + (size_t)(row0 + ai * HALF + m * 16) * DFF + col0) = w; }
    }
};
struct EpiResidual {
    static constexpr bool PERM = true, AFTER_DRAIN = false;
    bf16_t* Hh;
    __device__ __forceinline__ void operator()(const f32x4 (&acc)[2][2][4][2], const Unit& u, int wr, int wc, int fr, int fq) const {
        const int row0 = u.pm * BM + wr * 64 + fr; const int col0 = u.pn * BM + wc * 32 + 8 * fq;
#pragma unroll
        for (int ai = 0; ai < 2; ++ai)
#pragma unroll
            for (int m = 0; m < 4; ++m) { bf16_t* rowp = Hh + (size_t)(row0 + ai * HALF + m * 16) * DM + col0;
#pragma unroll
                for (int bj = 0; bj < 2; ++bj) { u32x4* p = (u32x4*)(rowp + bj * HALF); const u32x4 hv = *p; const f32x4 v0 = acc[ai][bj][m][0], v1 = acc[ai][bj][m][1];
                    u32x4 w; w.x = cvt_pk_bf16(__uint_as_float(hv.x << 16) + v0[0], __uint_as_float(hv.x & 0xffff0000u) + v0[1]); w.y = cvt_pk_bf16(__uint_as_float(hv.y << 16) + v0[2], __uint_as_float(hv.y & 0xffff0000u) + v0[3]);
                    w.z = cvt_pk_bf16(__uint_as_float(hv.z << 16) + v1[0], __uint_as_float(hv.z & 0xffff0000u) + v1[1]); w.w = cvt_pk_bf16(__uint_as_float(hv.w << 16) + v1[2], __uint_as_float(hv.w & 0xffff0000u) + v1[3]);
                    *p = w; } }
    }
};
struct EpiGlu {
    static constexpr bool PERM = true, AFTER_DRAIN = false;
    bf16_t* Hh;
    __device__ __forceinline__ void operator()(const f32x4 (&acc)[2][2][4][2], const Unit& u, int wr, int wc, int fr, int fq) const {
        const int row0 = u.pm * BM + wr * 64 + fr; const int col0 = u.pn * HALF + wc * 32 + 8 * fq;
#pragma unroll
        for (int ai = 0; ai < 2; ++ai)
#pragma unroll
            for (int m = 0; m < 4; ++m) { u32x4* p = (u32x4*)(Hh + (size_t)(row0 + ai * HALF + m * 16) * DM + col0); const u32x4 hv = *p;
                float o[8];
#pragma unroll
                for (int n = 0; n < 2; ++n)
#pragma unroll
                    for (int i = 0; i < 4; ++i) { const unsigned hw = hv[2 * n + (i >> 1)]; const float hcur = (i & 1) ? __uint_as_float(hw & 0xffff0000u) : __uint_as_float(hw << 16);
                        o[4 * n + i] = hcur + acc[ai][0][m][n][i] * __builtin_amdgcn_rcpf(1.f + __expf(-acc[ai][1][m][n][i])); }
                u32x4 w; w.x = cvt_pk_bf16(o[0], o[1]); w.y = cvt_pk_bf16(o[2], o[3]); w.z = cvt_pk_bf16(o[4], o[5]); w.w = cvt_pk_bf16(o[6], o[7]);
                *p = w; }
    }
};
struct EpiS5A {
    static constexpr bool PERM = true, AFTER_DRAIN = false;
    bf16_t* YI; bf16_t* E;
    __device__ __forceinline__ void operator()(const f32x4 (&acc)[2][2][4][2], const Unit& u, int wr, int wc, int fr, int fq) const {
        const int g = u.pn >> 1, nt = u.pn & 1;
        const int cl0 = wc * 32 + 8 * fq;
        bf16_t* base = nt == 0 ? YI + (size_t)(cl0 >> 4) * DM + g * 16 + (cl0 & 15) : E + (size_t)g * 256 + cl0;
        const size_t nstride = 16 * DM;
        const size_t bjstep = nt == 0 ? (size_t)8 * DM : (size_t)HALF;
#pragma unroll
        for (int ai = 0; ai < 2; ++ai)
#pragma unroll
            for (int m = 0; m < 4; ++m) { int n = u.pm * BM + ai * HALF + wr * 64 + m * 16 + fr; n = n < 1039 ? n : 1039;
                bf16_t* p = base + (size_t)n * nstride;
#pragma unroll
                for (int bj = 0; bj < 2; ++bj) { const f32x4 v0 = acc[ai][bj][m][0], v1 = acc[ai][bj][m][1];
                    u32x4 w; w.x = cvt_pk_bf16(v0[0], v0[1]); w.y = cvt_pk_bf16(v0[2], v0[3]); w.z = cvt_pk_bf16(v1[0], v1[1]); w.w = cvt_pk_bf16(v1[2], v1[3]);
                    *(u32x4*)(p + bj * bjstep) = w; } }
    }
};
struct EpiS5C {
    static constexpr bool PERM = true, AFTER_DRAIN = false;
    const bf16_t* YI; const bf16_t* Uu; const float* dvec; bf16_t* O;
    __device__ __forceinline__ void operator()(const f32x4 (&acc)[2][2][4][2], const Unit& u, int wr, int wc, int fr, int fq) const {
        const int g = u.pn;
        const int cl0 = wc * 32 + 8 * fq, ch = g * 16 + (cl0 & 15);
        const size_t off0 = (size_t)(cl0 >> 4) * DM + ch;
        const f32x4 d0 = *(const f32x4*)(dvec + ch), d1 = *(const f32x4*)(dvec + ch + 4);
#pragma unroll
        for (int ai = 0; ai < 2; ++ai)
#pragma unroll
            for (int m = 0; m < 4; ++m) { int n = u.pm * BM + ai * HALF + wr * 64 + m * 16 + fr; n = n < 1039 ? n : 1039;
#pragma unroll
                for (int bj = 0; bj < 2; ++bj) {
                    const size_t off = off0 + (size_t)n * (16 * DM) + (size_t)bj * (8 * DM);
                    const u32x4 yv = *(const u32x4*)(YI + off);
                    const f32x4 y0 = (f32x4){__uint_as_float(yv[0] << 16), __uint_as_float(yv[0] & 0xffff0000u), __uint_as_float(yv[1] << 16), __uint_as_float(yv[1] & 0xffff0000u)},
                                y1 = (f32x4){__uint_as_float(yv[2] << 16), __uint_as_float(yv[2] & 0xffff0000u), __uint_as_float(yv[3] << 16), __uint_as_float(yv[3] & 0xffff0000u)};
                    const u32x4 uv = *(const u32x4*)(Uu + off);
                    float y[8];
#pragma unroll
                    for (int q = 0; q < 4; ++q) { y[q] = acc[ai][bj][m][0][q] + y0[q] + d0[q] * (q & 1 ? __uint_as_float(uv[q >> 1] & 0xffff0000u) : __uint_as_float(uv[q >> 1] << 16));
                        y[4 + q] = acc[ai][bj][m][1][q] + y1[q] + d1[q] * (q & 1 ? __uint_as_float(uv[2 + (q >> 1)] & 0xffff0000u) : __uint_as_float(uv[2 + (q >> 1)] << 16)); }
#pragma unroll
                    for (int q = 0; q < 8; ++q) { const float z = 1.5957691216f * (y[q] + 0.044715f * y[q] * y[q] * y[q]); y[q] = y[q] * __builtin_amdgcn_rcpf(1.f + __expf(-z)); }
                    u32x4 w; w.x = cvt_pk_bf16(y[0], y[1]); w.y = cvt_pk_bf16(y[2], y[3]); w.z = cvt_pk_bf16(y[4], y[5]); w.w = cvt_pk_bf16(y[6], y[7]);
                    *(u32x4*)(O + off) = w; }
                asm volatile("" ::: "memory"); }
    }
};

template <class Epi, class Sched, bool ALIGN_EPI = false, bool SP2 = false>
__device__ __forceinline__ void gemm_phase(PG8_LAS unsigned char* lds, const int K, const Sched& S, const Epi& E) {
    int tid_ = threadIdx.x; asm volatile("" : "+v"(tid_));
    const int tid = tid_, wid = __builtin_amdgcn_readfirstlane(tid >> 6), lane = tid & 63, wr = wid >> 2, wc = wid & 3, fr = lane & 15, fq = lane >> 4;
    const int nt = K / BK;
    unsigned vA0[2], vA1[2], nA0[2], nA1[2], voffB[2];
#pragma unroll
    for (int i = 0; i < 2; ++i) { int R, C; stage_rc(tid * 16 + i * 8192, R, C); const int Rb = Epi::PERM ? ((R & ~31) + perm32(R & 31)) : R;
        vA0[i] = Sched::GATHER_A ? (unsigned)(((16 * R + (C >> 4)) * 1024 + (C & 15)) * 2) : (unsigned)(R * K + C) * 2u; voffB[i] = (unsigned)(Rb * K + C) * 2u; }
    const size_t kstep = (size_t)(BK * 2);
    const size_t hstep = (size_t)HALF * K * 2;
    const size_t kstepA = Sched::GATHER_A ? (size_t)(4 * 1024 * 2) : kstep, hstepA = Sched::GATHER_A ? (size_t)HALF * 16 * 1024 * 2 : hstep;
#define PG8_ROWOFFS(u_, d0_, d1_) do { _Pragma("unroll") for (int i_ = 0; i_ < 2; ++i_) { int R_, C_; stage_rc(tid * 16 + i_ * 8192, R_, C_); \
        d0_[i_] = (unsigned)(S.rowidx[(u_).pm * BM + R_] * K + C_) * 2u; d1_[i_] = (unsigned)(S.rowidx[(u_).pm * BM + HALF + R_] * K + C_) * 2u; } } while (0)
#define PG8_STAGE_A(bufoff, gbase, h_, nx_) do { _Pragma("unroll") for (int _i = 0; _i < 2; ++_i) { const unsigned vo_ = (nx_) ? ((h_) ? nA1[_i] : nA0[_i]) : ((h_) ? vA1[_i] : vA0[_i]); \
        __builtin_amdgcn_global_load_lds((const unsigned*)((const char*)(gbase) + vo_), (PG8_LAS unsigned*)(lds + (bufoff) + ldsw + _i * 8192), 16, 0, 0); } } while (0)
    const unsigned ldsw = (unsigned)wid * 1024u;
    const int aoff = lds_byte(wr * 64 + fr, fq * 8), boff = lds_byte(wc * 32 + fr, fq * 8);
#define PG8_SA(b, h) (((b) * 2 + (h)) * HTB)
#define PG8_SB(b, h) ((4 + (b) * 2 + (h)) * HTB)
#define PG8_STAGE(bufoff, gbase, voff) do { _Pragma("unroll") for (int _i = 0; _i < 2; ++_i) \
        __builtin_amdgcn_global_load_lds((const unsigned*)((const char*)(gbase) + (voff)[_i]), (PG8_LAS unsigned*)(lds + (bufoff) + ldsw + _i * 8192), 16, 0, 0); } while (0)
#define PG8_LDA(dst, b, h) do { _Pragma("unroll") for (int m = 0; m < 4; ++m) _Pragma("unroll") for (int k = 0; k < 2; ++k) dst[m][k] = *(const PG8_LAS bf16x8*)(lds + PG8_SA(b, h) + aoff + m * 2048 + k * 1024); } while (0)
#define PG8_LDB(dst, b, h) do { _Pragma("unroll") for (int n = 0; n < 2; ++n) _Pragma("unroll") for (int k = 0; k < 2; ++k) dst[n][k] = *(const PG8_LAS bf16x8*)(lds + PG8_SB(b, h) + boff + n * 2048 + k * 1024); } while (0)
#define PG8_MMA(ai, bj, At, Bt) do { __builtin_amdgcn_s_setprio(1); _Pragma("unroll") for (int m = 0; m < 4; ++m) _Pragma("unroll") for (int n = 0; n < 2; ++n) _Pragma("unroll") for (int k = 0; k < 2; ++k) \
        acc[ai][bj][m][n] = __builtin_amdgcn_mfma_f32_16x16x32_bf16(Bt[n][k], At[m][k], acc[ai][bj][m][n], 0, 0, 0); __builtin_amdgcn_s_setprio(0); } while (0)
#define PG8_WAIT_V(n) asm volatile("s_waitcnt vmcnt(" #n ")" ::: "memory")
#define PG8_WAIT_L(n) asm volatile("s_waitcnt lgkmcnt(" #n ")" ::: "memory")
#define PG8_BAR __builtin_amdgcn_s_barrier()
#define PG8_SCHED __builtin_amdgcn_sched_barrier(0)
    Unit cur, nxt; int ui = 0;
    if (!S.next(0, cur)) return;
    f32x4 acc[2][2][4][2];
#pragma unroll
    for (int a = 0; a < 2; ++a)
#pragma unroll
        for (int b = 0; b < 2; ++b)
#pragma unroll
            for (int m = 0; m < 4; ++m)
#pragma unroll
                for (int n = 0; n < 2; ++n) acc[a][b][m][n] = (f32x4){0.f, 0.f, 0.f, 0.f};
    bf16x8 At[4][2], B0[2][2], B1[2][2];
    const char* cA = cur.A; const char* cB = cur.B;
    if constexpr (Sched::GATHER_ROWS) { PG8_ROWOFFS(cur, vA0, vA1); }
    else {
#pragma unroll
        for (int i = 0; i < 2; ++i) vA1[i] = vA0[i] + (unsigned)hstepA;
    }
#pragma unroll
    for (int i = 0; i < 2; ++i) { nA0[i] = vA0[i]; nA1[i] = vA1[i]; }
    S.a_ready(cur);
    if constexpr (SP2) {
        PG8_STAGE(PG8_SB(0, 0), cB, voffB); PG8_STAGE(PG8_SB(0, 1), cB + hstep, voffB); PG8_STAGE_A(PG8_SA(0, 0), cA, 0, false); PG8_STAGE_A(PG8_SA(0, 1), cA, 1, false);
        if (wr == 1) PG8_BAR;
        PG8_WAIT_V(2); PG8_BAR;
        PG8_STAGE(PG8_SB(1, 0), cB + kstep, voffB); PG8_STAGE_A(PG8_SA(1, 0), cA + kstepA, 0, false); PG8_STAGE(PG8_SB(1, 1), cB + hstep + kstep, voffB);
        PG8_WAIT_V(6); PG8_BAR;
    } else {
        PG8_STAGE(PG8_SB(0, 0), cB, voffB); PG8_STAGE_A(PG8_SA(0, 0), cA, 0, false); PG8_STAGE(PG8_SB(0, 1), cB + hstep, voffB); PG8_STAGE_A(PG8_SA(0, 1), cA, 1, false);
        if (wr == 1) PG8_BAR;
        PG8_WAIT_V(4); PG8_BAR;
        PG8_STAGE(PG8_SB(1, 0), cB + kstep, voffB); PG8_STAGE_A(PG8_SA(1, 0), cA + kstepA, 0, false); PG8_STAGE(PG8_SB(1, 1), cB + hstep + kstep, voffB);
        PG8_WAIT_V(6); PG8_BAR;
    }
    for (;;) {
        const bool has_next = S.next(ui + 1, nxt);
        if constexpr (Sched::GATHER_ROWS) { if (has_next) PG8_ROWOFFS(nxt, nA0, nA1); }
        const char* nA = has_next ? nxt.A : cA; const char* nB = has_next ? nxt.B : cB;
        for (int t = 0; t < nt; t += 2) {
            const bool last = (t == nt - 2);
            const char* a1 = cA + (size_t)(t + 1) * kstepA;
            const char* a2 = last ? nA : cA + (size_t)(t + 2) * kstepA; const char* b2 = last ? nB : cB + (size_t)(t + 2) * kstep;
            const char* a3 = a2 + kstepA; const char* b3 = b2 + kstep;
            if (last && has_next) S.a_ready(nxt);
            if constexpr (SP2) {
            PG8_LDB(B0, 0, 0); PG8_LDB(B1, 0, 1); PG8_SCHED; PG8_LDA(At, 0, 0); PG8_STAGE_A(PG8_SA(1, 1), a1, 1, false);
            PG8_WAIT_V(8); PG8_WAIT_L(0); PG8_BAR; PG8_MMA(0, 0, At, B0); PG8_MMA(0, 1, At, B1); PG8_BAR; PG8_SCHED;
            PG8_LDA(At, 0, 1); PG8_STAGE(PG8_SB(0, 0), b2, voffB); PG8_STAGE(PG8_SB(0, 1), b2 + hstep, voffB); PG8_STAGE_A(PG8_SA(0, 0), a2, 0, last);
            PG8_WAIT_V(8); PG8_WAIT_L(0); PG8_BAR; PG8_MMA(1, 0, At, B0); PG8_MMA(1, 1, At, B1); PG8_BAR; PG8_SCHED;
            PG8_LDB(B0, 1, 0); PG8_LDB(B1, 1, 1); PG8_SCHED; PG8_LDA(At, 1, 0); PG8_STAGE_A(PG8_SA(0, 1), a2, 1, last);
            PG8_WAIT_V(8); PG8_WAIT_L(0); PG8_BAR; PG8_MMA(0, 0, At, B0); PG8_MMA(0, 1, At, B1); PG8_BAR; PG8_SCHED;
            PG8_LDA(At, 1, 1); PG8_STAGE(PG8_SB(1, 0), b3, voffB); PG8_STAGE(PG8_SB(1, 1), b3 + hstep, voffB); PG8_STAGE_A(PG8_SA(1, 0), a3, 0, last);
            PG8_WAIT_V(8); PG8_WAIT_L(0); PG8_BAR; PG8_MMA(1, 0, At, B0); PG8_MMA(1, 1, At, B1); PG8_BAR; PG8_SCHED;
            } else {
            PG8_LDB(B0, 0, 0); PG8_SCHED; PG8_LDA(At, 0, 0); PG8_STAGE_A(PG8_SA(1, 1), a1, 1, false);
            PG8_WAIT_L(8); PG8_BAR; PG8_WAIT_L(0); PG8_MMA(0, 0, At, B0); PG8_BAR; PG8_SCHED;
            PG8_LDB(B1, 0, 1); PG8_STAGE(PG8_SB(0, 0), b2, voffB);
            PG8_BAR; PG8_WAIT_L(0); PG8_MMA(0, 1, At, B1); PG8_BAR;
            PG8_LDA(At, 0, 1); PG8_STAGE_A(PG8_SA(0, 0), a2, 0, last);
            PG8_BAR; PG8_WAIT_L(0); PG8_MMA(1, 0, At, B0); PG8_BAR; PG8_SCHED;
            PG8_STAGE(PG8_SB(0, 1), b2 + hstep, voffB);
            PG8_WAIT_V(6); PG8_BAR; PG8_MMA(1, 1, At, B1); PG8_BAR;
            PG8_LDB(B0, 1, 0); PG8_SCHED; PG8_LDA(At, 1, 0); PG8_STAGE_A(PG8_SA(0, 1), a2, 1, last);
            PG8_WAIT_L(8); PG8_BAR; PG8_WAIT_L(0); PG8_MMA(0, 0, At, B0); PG8_BAR; PG8_SCHED;
            PG8_LDB(B1, 1, 1); PG8_STAGE(PG8_SB(1, 0), b3, voffB);
            PG8_BAR; PG8_WAIT_L(0); PG8_MMA(0, 1, At, B1); PG8_BAR;
            PG8_LDA(At, 1, 1); PG8_STAGE_A(PG8_SA(1, 0), a3, 0, last);
            PG8_BAR; PG8_WAIT_L(0); PG8_MMA(1, 0, At, B0); PG8_BAR; PG8_SCHED;
            PG8_STAGE(PG8_SB(1, 1), b3 + hstep, voffB);
            PG8_WAIT_V(6); PG8_BAR; PG8_MMA(1, 1, At, B1); PG8_BAR;
            }
        }
        if constexpr (ALIGN_EPI) { if (wr == 0) PG8_BAR; }
        if constexpr (!Epi::AFTER_DRAIN) { E(acc, cur, wr, wc, fr, fq); S.done(cur); }
        if (!has_next) break;
#pragma unroll
        for (int a = 0; a < 2; ++a)
#pragma unroll
            for (int b = 0; b < 2; ++b)
#pragma unroll
                for (int m = 0; m < 4; ++m)
#pragma unroll
                    for (int n = 0; n < 2; ++n) acc[a][b][m][n] = (f32x4){0.f, 0.f, 0.f, 0.f};
        cur = nxt; cA = nA; cB = nB; ++ui;
        if constexpr (Sched::GATHER_ROWS) {
#pragma unroll
            for (int i = 0; i < 2; ++i) { vA0[i] = nA0[i]; vA1[i] = nA1[i]; } }
        if constexpr (ALIGN_EPI) { if (wr == 1) PG8_BAR; }
    }
    PG8_WAIT_V(0);
    if constexpr (!ALIGN_EPI) { if (wr == 0) PG8_BAR; }
    PG8_BAR;
    if constexpr (Epi::AFTER_DRAIN) { E.fused(acc, cur, wr, wc, fr, fq, lds, wid, lane); S.done(cur); }
#undef PG8_SA
#undef PG8_SB
#undef PG8_STAGE
#undef PG8_STAGE_A
#undef PG8_ROWOFFS
#undef PG8_LDA
#undef PG8_LDB
#undef PG8_MMA
#undef PG8_WAIT_V
#undef PG8_WAIT_L
#undef PG8_BAR
#undef PG8_SCHED
}
}

#define PHASE_PROLOGUE \
    int tid_ = threadIdx.x; asm volatile("" : "+v"(tid_)); const int tid = tid_, lane = tid & 63, wave = tid >> 6; \
    const int G = GRID, bid = blockIdx.x; \
    const int gw = bid * 8 + wave, NGW = G * 8; \
    unsigned char* ws = P.ws; \
    bf16_t* H = (bf16_t*)(ws + WS_H); \
    bf16_t* HN = (bf16_t*)(ws + WS_HN); \
    bf16_t* A2 = (bf16_t*)(ws + WS_A2); \
    bf16_t* Qb = (bf16_t*)(ws + WS_Q); bf16_t* Kb = (bf16_t*)(ws + WS_K); bf16_t* Vb = (bf16_t*)(ws + WS_V); \
    bf16_t* REST = (bf16_t*)(ws + WS_REST); \
    bf16_t* YFB = (bf16_t*)(ws + WS_YFB); \
    bf16_t* Rr = (bf16_t*)(ws + WS_R); bf16_t* VV = (bf16_t*)(ws + WS_VV); bf16_t* KK = (bf16_t*)(ws + WS_KK); \
    bf16_t* KKA = (bf16_t*)(ws + WS_KKA); bf16_t* KD = (bf16_t*)(ws + WS_KD); \
    _Float16* LW = (_Float16*)(ws + WS_W); bf16_t* PP = (bf16_t*)(ws + WS_PP); bf16_t* QT = (bf16_t*)(ws + WS_QT); bf16_t* YT = (bf16_t*)(ws + WS_YT); bf16_t* ZT = (bf16_t*)(ws + WS_ZT); \
    bf16_t* Gg = (bf16_t*)(ws + WS_G); bf16_t* KR = (bf16_t*)(ws + WS_KR); bf16_t* LOW = (bf16_t*)(ws + WS_LOW); \
    float* BC = (float*)(ws + WS_BC); \
    bf16_t* AA = (bf16_t*)(ws + WS_AA); \
    bf16_t* HB = (bf16_t*)(ws + WS_HB); bf16_t* YB = (bf16_t*)(ws + WS_YB); \
    int* ROWTOK = (int*)(ws + WS_ROWTOK); int* EID = (int*)(ws + WS_EID); int* POS = (int*)(ws + WS_POS); int* DEST = (int*)(ws + WS_DEST); \
    float* GATE = (float*)(ws + WS_GATE); \
    bf16_t* YI = (bf16_t*)(ws + WS_YI); bf16_t* S5E = (bf16_t*)(ws + WS_E); bf16_t* CAR = (bf16_t*)(ws + WS_CAR); bf16_t* BTA = (bf16_t*)(ws + WS_BTA); bf16_t* BTC = (bf16_t*)(ws + WS_BTC); \
    unsigned* CTL = (unsigned*)(ws + WS_CTL); \
    bf16_t* WTIN = (bf16_t*)(ws + WS_WTIN); bf16_t* WTOUT = (bf16_t*)(ws + WS_WTOUT); bf16_t* WTGLU = (bf16_t*)(ws + WS_WTGLU); bf16_t* WT13 = (bf16_t*)(ws + WS_WT13); bf16_t* WT2 = (bf16_t*)(ws + WS_WT2); \
    const int vcu = (G % 8 == 0) ? (bid % 8) * (G / 8) + bid / 8 : bid; \
    const float* x = P.in[0]; const float* meta = P.in[1]; const float* norm_mix = P.in[2]; const float* norm_ffn = P.in[3]; const float* norm_final = P.in[4]; \
    const float* w_in = P.in[5]; const float* w_out = P.in[6]; const float* rpb = P.in[7]; const float* mu = P.in[8]; \
    const float* w0 = P.in[9]; const float* w_up = P.in[10]; const float* a0 = P.in[11]; const float* a_up = P.in[12]; const float* g_up = P.in[13]; \
    const float* k_k = P.in[14]; const float* k_a = P.in[15]; const float* r_k = P.in[16]; const float* lnx_g = P.in[17]; const float* lnx_b = P.in[18]; \
    const float* s5_b_re = P.in[19]; const float* s5_b_im = P.in[20]; const float* s5_lre = P.in[21]; const float* s5_lim = P.in[22]; const float* s5_ls = P.in[23]; \
    const float* s5_c_re = P.in[24]; const float* s5_c_im = P.in[25]; const float* s5_d = P.in[26]; const float* w_glu = P.in[27]; \
    const float* moe_wg = P.in[28]; const float* moe_bg = P.in[29]; const float* moe_we = P.in[30]; const float* moe_be = P.in[31]; \
    const float* moe_w1 = P.in[32]; const float* moe_w3 = P.in[33]; const float* moe_w2 = P.in[34];


__device__ __forceinline__ void transpose_half(const float* W, int N, int K, int k0, int n0, bf16_t* dstrow0, int lane) {
    const int kb = lane & 7, nq = lane >> 3;
    const float* src = W + (size_t)(k0 + 8 * kb) * N + n0 + 4 * nq;
    f32x4 v[8];
#pragma unroll
    for (int kk = 0; kk < 8; ++kk) v[kk] = *(const f32x4*)(src + (size_t)kk * N);
#pragma unroll
    for (int i = 0; i < 4; ++i) {
        u32x4 o; o.x = pk2(v[0][i], v[1][i]); o.y = pk2(v[2][i], v[3][i]); o.z = pk2(v[4][i], v[5][i]); o.w = pk2(v[6][i], v[7][i]);
        *(u32x4*)(dstrow0 + (size_t)(4 * nq + i) * K + k0 + 8 * kb) = o;
    }
}
__device__ __forceinline__ void transpose_item(const float* W, int N, int K, int k0, int n0, bf16_t* dstrow0, int lane) {
    transpose_half(W, N, K, k0, n0, dstrow0, lane);
    transpose_half(W, N, K, k0, n0 + 32, dstrow0 + (size_t)32 * K, lane);
}
#define CONV_DENSE_ITEMS (832 + 256 + 512 + 48)
__device__ __forceinline__ void conv_dense_item(CParams& P, int it, int lane) {
    unsigned char* ws = P.ws;
    if (it < 832) { const int kb = it / 52, nb = it % 52; transpose_item(P.in[5], INCOLS, DM, kb * 64, nb * 64, (bf16_t*)(ws + WS_WTIN) + (size_t)nb * 64 * DM, lane); return; }
    it -= 832;
    if (it < 256) { const int kb = it / 16, nb = it % 16; transpose_item(P.in[6], DM, DM, kb * 64, nb * 64, (bf16_t*)(ws + WS_WTOUT) + (size_t)nb * 64 * DM, lane); return; }
    it -= 256;
    if (it < 512) { const int kb = it / 32, nb = it % 32, n = nb * 64, half = n >> 10, c = n & 1023, row = (c >> 7) * 256 + half * 128 + (c & 127);
      transpose_item(P.in[27], 2 * DM, DM, kb * 64, n, (bf16_t*)(ws + WS_WTGLU) + (size_t)row * DM, lane); return; }
    it -= 512;
    bf16_t* lrt = (bf16_t*)(ws + WS_LRT);
    if (it < 16) { const int d = it >> 3, nb = it & 7; transpose_item(P.in[10] + (size_t)d * 64 * 512, 512, 64, 0, nb * 64, lrt + ((size_t)d * 512 + nb * 64) * 64, lane); return; }
    it -= 16;
    if (it < 16) { const int d = it >> 3, nb = it & 7; transpose_item(P.in[12] + (size_t)d * 64 * 512, 512, 64, 0, nb * 64, lrt + (size_t)2 * 512 * 64 + ((size_t)d * 512 + nb * 64) * 64, lane); return; }
    it -= 16;
    { const int kb = it >> 3, nb = it & 7; transpose_item(P.in[13], 512, 128, kb * 64, nb * 64, lrt + (size_t)4 * 512 * 64 + (size_t)nb * 64 * 128, lane); }
}
#define CONV_MOE_ITEMS (NEXP * 384)
__device__ __forceinline__ void conv_moe_item(CParams& P, int l, int it, int lane) {
    unsigned char* ws = P.ws;
    const int e = it / 384; int r = it % 384;
    if (r < 256) { const int which = r >> 7; r &= 127; const int kb = r >> 3, nb = r & 7, n = nb * 64, row = (n >> 7) * 256 + which * 128 + (n & 127);
        const float* W = (which ? P.in[33] : P.in[32]) + ((size_t)(l * NEXP + e) * DM) * DFF;
        transpose_item(W, DFF, DM, kb * 64, n, (bf16_t*)(ws + WS_WT13) + ((size_t)e * DM + row) * DM, lane); return; }
    r -= 256;
    { const int kb = r >> 4, nb = r & 15; const float* W = P.in[34] + ((size_t)(l * NEXP + e) * DFF) * DM;
      transpose_item(W, DM, DFF, kb * 64, nb * 64, (bf16_t*)(ws + WS_WT2) + ((size_t)e * DM + nb * 64) * DFF, lane); }
}

template <int MODE>
__device__ __forceinline__ void meta_gemm(const bf16_t* A, const bf16_t* Bt, bf16_t* Hrows, int task, int lane) {
    const int fr = lane & 15, fq = lane >> 4, c = task * 16 + fr;
    const bf16_t* b0 = MODE == 0 ? Bt + (size_t)c * DM : Bt + (size_t)((c >> 7) * 256 + (c & 127)) * DM;
    const bf16_t* b1 = b0 + (size_t)128 * DM;
    f32x4 acc0[2], acc1[2];
    acc0[0] = acc0[1] = acc1[0] = acc1[1] = (f32x4){0.f, 0.f, 0.f, 0.f};
#pragma unroll 4
    for (int kt = 0; kt < 32; ++kt) {
        const int ko = kt * 32 + fq * 8;
        const bf16x8 a0 = *(const bf16x8*)(A + (size_t)fr * DM + ko), a1 = *(const bf16x8*)(A + (size_t)(16 + fr) * DM + ko);
        const bf16x8 bv = *(const bf16x8*)(b0 + ko);
        acc0[0] = __builtin_amdgcn_mfma_f32_16x16x32_bf16(a0, bv, acc0[0], 0, 0, 0);
        acc0[1] = __builtin_amdgcn_mfma_f32_16x16x32_bf16(a1, bv, acc0[1], 0, 0, 0);
        if (MODE == 1) { const bf16x8 bg = *(const bf16x8*)(b1 + ko);
            acc1[0] = __builtin_amdgcn_mfma_f32_16x16x32_bf16(a0, bg, acc1[0], 0, 0, 0);
            acc1[1] = __builtin_amdgcn_mfma_f32_16x16x32_bf16(a1, bg, acc1[1], 0, 0, 0); }
    }
#pragma unroll
    for (int mi = 0; mi < 2; ++mi)
#pragma unroll
        for (int j = 0; j < 4; ++j) { bf16_t* p = Hrows + (size_t)(mi * 16 + fq * 4 + j) * DM + c;
            const float add = MODE == 0 ? acc0[mi][j] : acc0[mi][j] * __builtin_amdgcn_rcpf(1.f + __expf(-acc1[mi][j]));
            *p = (bf16_t)f2bf(bf2f(*p) + add); }
}
__device__ __forceinline__ void phase_0(CParams& P, unsigned char* lds, const int ph) {
    PHASE_PROLOGUE
            for (int row = gw; row < NT; row += NGW) {
                const float* src = row < NMAIN ? x + (size_t)row * DM : meta + (size_t)((row - NMAIN) & 15) * DM;
                f32x4 v[4];
#pragma unroll
                for (int j = 0; j < 4; ++j) { v[j] = ((const f32x4*)src)[lane + 64 * j]; strow_bf16(H + (size_t)row * DM, lane, j, v[j]); }
                store_norm_bf16(v, norm_mix, HN + (size_t)row * DM, lane);
            }
    for (int it = gw; it < CONV_DENSE_ITEMS; it += NGW) conv_dense_item(P, it, lane);
}

__device__ __forceinline__ void phase_1(CParams& P, unsigned char* lds, const int ph) {
    PHASE_PROLOGUE
    pg8::ProjOrder S; S.init(HN, WTIN, bid);
    pg8::EpiProj E{Qb, Kb, Vb, REST};
    pg8::gemm_phase<pg8::EpiProj, pg8::ProjOrder, true, true>((PG8_LAS unsigned char*)lds, DM, S, E);
}

__device__ __forceinline__ void na_units(CParams& P, unsigned char* lds, const int first, const int stride) {
    PHASE_PROLOGUE
    float* sb = (float*)lds;
    for (int i = tid; i < 8 * 465; i += 512) sb[i] = rpb[i];
    __syncthreads();
    const bf16_t* VT = Vb;
    const int fr = lane & 15, fq = lane >> 4;
    for (int u = first; u < 8192 + 16; u += stride) {
        const bool metaq = u >= 8192;
        int b, h, r = 0, qb = 0;
        if (!metaq) { qb = u & 3; r = (u >> 2) & 127; h = (u >> 9) & 7; b = u >> 12; } else { const int m = u - 8192; b = m >> 3; h = m & 7; }
        const int c = qb * 16 + fr;
        const int qrow = metaq ? NMAIN + b * NMETA + fr : b * SEQ + r * 64 + c;
        const int R0 = min(max(r - 4, 0), 120), cs = qb == 0 ? 0 : (qb == 1 ? 8 : (qb == 2 ? 24 : 32));
        const int C0 = min(max(c - 8, 0), 48);
        bf16x8 qf0 = *(const bf16x8*)(Qb + (size_t)qrow * 512 + h * 64 + fq * 8), qf1 = *(const bf16x8*)(Qb + (size_t)qrow * 512 + h * 64 + 32 + fq * 8);
        f32x4 sacc[17];
        const f32x4 zero4 = (f32x4){0.f, 0.f, 0.f, 0.f};
        if (!metaq) {
#pragma unroll
            for (int kt = 0; kt < 16; ++kt) {
                const int krow0 = b * SEQ + (R0 + (kt >> 1)) * 64 + cs + 16 * (kt & 1);
                const bf16_t* kp = Kb + (size_t)(krow0 + fr) * 512 + h * 64 + fq * 8;
                const bf16x8 a0 = *(const bf16x8*)kp, a1 = *(const bf16x8*)(kp + 32);
                f32x4 acc = __builtin_amdgcn_mfma_f32_16x16x32_bf16(a0, qf0, zero4, 0, 0, 0);
                sacc[kt] = __builtin_amdgcn_mfma_f32_16x16x32_bf16(a1, qf1, acc, 0, 0, 0);
            }
        } else {
#pragma unroll
            for (int kt = 0; kt < 16; ++kt) sacc[kt] = zero4;
        }
        {
            const bf16_t* kp = Kb + (size_t)(NMAIN + b * NMETA + fr) * 512 + h * 64 + fq * 8;
            const bf16x8 a0 = *(const bf16x8*)kp, a1 = *(const bf16x8*)(kp + 32);
            f32x4 acc = __builtin_amdgcn_mfma_f32_16x16x32_bf16(a0, qf0, zero4, 0, 0, 0);
            sacc[16] = __builtin_amdgcn_mfma_f32_16x16x32_bf16(a1, qf1, acc, 0, 0, 0);
        }
        float mx = -1e30f;
#pragma unroll
        for (int kt = 0; kt < 16; ++kt) {
            const int dr = R0 + (kt >> 1) - r + 7;
#pragma unroll
            for (int j = 0; j < 4; ++j) {
                const int kc = cs + 16 * (kt & 1) + 4 * fq + j;
                const bool inb = !metaq && kc >= C0 && kc < C0 + 16;
                const int dc = min(max(kc - c + 15, 0), 30);
                const float s = inb ? sacc[kt][j] * 0.125f + sb[(h * 15 + dr) * 31 + dc] : -1e30f;
                sacc[kt][j] = s; mx = fmaxf(mx, s);
            }
        }
#pragma unroll
        for (int j = 0; j < 4; ++j) { const float s = sacc[16][j] * 0.125f; sacc[16][j] = s; mx = fmaxf(mx, s); }
        mx = fmaxf(mx, __shfl_xor(mx, 16)); mx = fmaxf(mx, __shfl_xor(mx, 32));
        float sum = 0.f;
#pragma unroll
        for (int kt = 0; kt < 17; ++kt)
#pragma unroll
            for (int j = 0; j < 4; ++j) { const float pv = __expf(sacc[kt][j] - mx); sacc[kt][j] = pv; sum += pv; }
        sum += __shfl_xor(sum, 16); sum += __shfl_xor(sum, 32);
        f32x4 o[4] = {zero4, zero4, zero4, zero4};
        if (!metaq) {
#pragma unroll
            for (int kr = 0; kr < 8; ++kr) {
                union { bf16x8 v; unsigned u[4]; } bf;
                bf.u[0] = pk2(sacc[2 * kr][0], sacc[2 * kr][1]); bf.u[1] = pk2(sacc[2 * kr][2], sacc[2 * kr][3]);
                bf.u[2] = pk2(sacc[2 * kr + 1][0], sacc[2 * kr + 1][1]); bf.u[3] = pk2(sacc[2 * kr + 1][2], sacc[2 * kr + 1][3]);
                const size_t tok0 = (size_t)b * SEQ + (R0 + kr) * 64 + cs + 4 * fq;
#pragma unroll
                for (int dt = 0; dt < 4; ++dt) {
                    const bf16_t* vp = VT + (size_t)(h * 64 + dt * 16 + fr) * NTP + tok0;
                    union { bf16x8 v; u32x2 h2[2]; } af;
                    af.h2[0] = *(const u32x2*)vp; af.h2[1] = *(const u32x2*)(vp + 16);
                    o[dt] = __builtin_amdgcn_mfma_f32_16x16x32_bf16(af.v, bf.v, o[dt], 0, 0, 0);
                }
            }
        }
        {
            union { bf16x8 v; unsigned u[4]; } bf;
            bf.u[0] = pk2(sacc[16][0], sacc[16][1]); bf.u[1] = pk2(sacc[16][2], sacc[16][3]); bf.u[2] = 0u; bf.u[3] = 0u;
            const size_t tokm = (size_t)NMAIN + b * NMETA + 4 * fq;
#pragma unroll
            for (int dt = 0; dt < 4; ++dt) {
                const bf16_t* vp = VT + (size_t)(h * 64 + dt * 16 + fr) * NTP + tokm;
                union { bf16x8 v; u32x2 h2[2]; } af;
                af.h2[0] = *(const u32x2*)vp; af.h2[1] = (u32x2){0u, 0u};
                o[dt] = __builtin_amdgcn_mfma_f32_16x16x32_bf16(af.v, bf.v, o[dt], 0, 0, 0);
            }
        }
        const float inv = 1.f / sum;
#pragma unroll
        for (int dt = 0; dt < 4; ++dt) {
            u32x2 ov; ov.x = pk2(o[dt][0] * inv, o[dt][1] * inv); ov.y = pk2(o[dt][2] * inv, o[dt][3] * inv);
            *(u32x2*)(A2 + (size_t)qrow * DM + h * 64 + dt * 16 + 4 * fq) = ov;
        }
    }
    __syncthreads();
}

__device__ __forceinline__ void phase_3(CParams& P, unsigned char* lds, const int ph) {
    PHASE_PROLOGUE
    constexpr int TR = 66, NTILE = (NT + TR - 1) / TR, AST = 264, SST = 136;
    bf16_t* As = (bf16_t*)lds;
    unsigned short* stg = (unsigned short*)(lds + 80 * AST * 2);
    const bf16_t* lrt = (const bf16_t*)(ws + WS_LRT);
    const int fr = lane & 15, fq = lane >> 4;
    for (int u = bid; u < NTILE; u += G) {
        const int r0 = u * TR, nrows = min(TR, NT - r0);
        for (int rl = wave; rl < nrows; rl += 8) {
            const int row = r0 + rl;
            int b, pp_;
            if (row < NMAIN) { b = row >> 13; pp_ = (row & (SEQ - 1)) + NMETA; } else { b = (row - NMAIN) >> 4; pp_ = (row - NMAIN) & 15; }
            const bool hp = pp_ > 0, hn = pp_ + 1 < LSEQ;
            const int rowp = hp ? rowof(b, pp_ - 1) : row, rown = hn ? rowof(b, pp_ + 1) : row;
#pragma unroll
            for (int j = 0; j < 7; ++j) {
                const int c = 4 * lane + 256 * j;
                const u32x2 vc = *(const u32x2*)(REST + (size_t)row * RESTC + c);
                u32x2 vp = *(const u32x2*)(REST + (size_t)rowp * RESTC + c);
                u32x2 vn = *(const u32x2*)(REST + (size_t)rown * RESTC + c);
                if (!hp) { vp.x = 0; vp.y = 0; }
                if (!hn) { vn.x = 0; vn.y = 0; }
                const f32x4 m4 = *(const f32x4*)(mu + c);
                float pc[4] = {bflo(vc.x), bfhi(vc.x), bflo(vc.y), bfhi(vc.y)};
                float pq[4] = {bflo(vp.x), bfhi(vp.x), bflo(vp.y), bfhi(vp.y)};
                float pn[4] = {bflo(vn.x), bfhi(vn.x), bflo(vn.y), bfhi(vn.y)};
                float o[4];
#pragma unroll
                for (int i = 0; i < 4; ++i) o[i] = pc[i] + m4[i] * (0.5f * (pq[i] + pn[i]) - pc[i]);
                if (j == 6) {
                    if (lane < 16) { for (int i = 0; i < 4; ++i) o[i] = tanhf(o[i]); }
                    else if (lane >= 32) { for (int i = 0; i < 4; ++i) o[i] = sigmoidf_(o[i]); }
                }
                u32x2 ov; ov.x = pk2(o[0], o[1]); ov.y = pk2(o[2], o[3]);
                if (j < 6) { bf16_t* dst = j < 2 ? Rr + (size_t)row * 512 + c : (j < 4 ? KR + (size_t)row * 512 + (c - 512) : VV + (size_t)row * 512 + (c - 1024)); *(u32x2*)dst = ov; }
                else *(u32x2*)(As + rl * AST + (c - 1536)) = ov;
            }
        }
        __syncthreads();
#define P4_LOADB(t_, bv_, bias_) do { const int wh_ = (t_) >> 2, ct_ = (t_) & 3, Kw_ = wh_ < 4 ? 64 : 128, col_ = ct_ * 128 + 16 * wave + fr; \
            const bf16_t* Wt_ = lrt + (wh_ < 4 ? (size_t)wh_ * 512 * 64 : (size_t)4 * 512 * 64) + (size_t)col_ * Kw_ + 8 * fq; \
            bv_[0] = *(const bf16x8*)Wt_; bv_[1] = *(const bf16x8*)(Wt_ + 32); if (wh_ == 4) { bv_[2] = *(const bf16x8*)(Wt_ + 64); bv_[3] = *(const bf16x8*)(Wt_ + 96); } \
            bias_ = wh_ < 2 ? w0[wh_ * 512 + col_] : (wh_ < 4 ? a0[(wh_ - 2) * 512 + col_] : 0.f); } while (0)
        bf16x8 bnx[4]; float biasn;
        P4_LOADB(0, bnx, biasn);
#pragma unroll 1
        for (int t = 0; t < 20; ++t) {
            const int which = t >> 2, ct = t & 3;
            const int koff = which < 2 ? 0 : (which < 4 ? 64 : 128);
            bf16x8 bcur[4]; bcur[0] = bnx[0]; bcur[1] = bnx[1]; bcur[2] = bnx[2]; bcur[3] = bnx[3];
            const float bias = biasn;
            if (t + 1 < 20) P4_LOADB(t + 1, bnx, biasn);
            const f32x4 zero4 = (f32x4){0.f, 0.f, 0.f, 0.f};
            f32x4 acc[5] = {zero4, zero4, zero4, zero4, zero4};
#pragma unroll
            for (int ks = 0; ks < 4; ++ks) {
                if (ks < 2 || which == 4) {
#pragma unroll
                    for (int rt = 0; rt < 5; ++rt) acc[rt] = __builtin_amdgcn_mfma_f32_16x16x32_bf16(*(const bf16x8*)(As + (16 * rt + fr) * AST + koff + 32 * ks + 8 * fq), bcur[ks], acc[rt], 0, 0, 0);
                }
            }
            unsigned short* sg = stg + (t & 1) * 80 * SST + 16 * wave + fr;
#pragma unroll
            for (int rt = 0; rt < 5; ++rt)
#pragma unroll
                for (int j = 0; j < 4; ++j) { const float val = acc[rt][j] + bias; unsigned short o;
                    if (which < 2) { const _Float16 hv = (_Float16)(-0.6065306597f * sigmoidf_(val)); o = __builtin_bit_cast(unsigned short, hv); }
                    else if (which < 4) o = (unsigned short)f2bf(sigmoidf_(val));
                    else o = (unsigned short)f2bf(val);
                    sg[(16 * rt + 4 * fq + j) * SST] = o; }
            __syncthreads();
            {
                unsigned short* dst = which < 2 ? (unsigned short*)LW + (size_t)which * NT * 512 : (which < 4 ? (unsigned short*)AA + (size_t)(which - 2) * NT * 512 : (unsigned short*)Gg);
                for (int i = tid; i < nrows * 8; i += 512) { const int r = i >> 3, pc = (i & 7) * 16; const unsigned short* sp = stg + (t & 1) * 80 * SST + r * SST + pc;
                    unsigned short* gp = dst + (size_t)(r0 + r) * 512 + ct * 128 + pc; *(u32x4*)gp = *(const u32x4*)sp; *(u32x4*)(gp + 8) = *(const u32x4*)(sp + 8); }
            }
        }
#undef P4_LOADB
        __syncthreads();
        for (int rl = wave; rl < nrows; rl += 8) {
            const int row = r0 + rl;

                const int c0 = lane * 8;
                const u32x4 krv = *(const u32x4*)(KR + (size_t)row * 512 + c0);
                const u32x4 rv = *(const u32x4*)(Rr + (size_t)row * 512 + c0);
                float kr[8], rr[8], kkv[8];
#pragma unroll
                for (int i = 0; i < 4; ++i) { kr[2 * i] = bflo(krv[i]); kr[2 * i + 1] = bfhi(krv[i]); rr[2 * i] = bflo(rv[i]); rr[2 * i + 1] = bfhi(rv[i]); }
                float ss = 0.f;
#pragma unroll
                for (int i = 0; i < 8; ++i) { kkv[i] = kr[i] * k_k[c0 + i]; ss += kkv[i] * kkv[i]; }
                ss += __shfl_xor(ss, 1); ss += __shfl_xor(ss, 2); ss += __shfl_xor(ss, 4);
                const float inv = 1.f / fmaxf(sqrtf(ss), 1e-12f);
#pragma unroll
                for (int i = 0; i < 8; ++i) kkv[i] *= inv;
                u32x4 o; o.x = pk2(kkv[0], kkv[1]); o.y = pk2(kkv[2], kkv[3]); o.z = pk2(kkv[4], kkv[5]); o.w = pk2(kkv[6], kkv[7]);
                *(u32x4*)(KK + (size_t)row * 512 + c0) = o;
                float bsum = 0.f;
#pragma unroll
                for (int d = 0; d < 2; ++d) {
                    const u32x4 av = *(const u32x4*)(AA + ((size_t)d * NT + row) * 512 + c0);
                    float a[8], kka[8], kd[8];
#pragma unroll
                    for (int i = 0; i < 4; ++i) { a[2 * i] = bflo(av[i]); a[2 * i + 1] = bfhi(av[i]); }
#pragma unroll
                    for (int i = 0; i < 8; ++i) { kka[i] = kkv[i] * a[i]; kd[i] = kr[i] * (1.f + (a[i] - 1.f) * k_a[c0 + i]); bsum += rr[i] * kd[i] * r_k[c0 + i]; }
                    u32x4 o1; o1.x = pk2(kka[0], kka[1]); o1.y = pk2(kka[2], kka[3]); o1.z = pk2(kka[4], kka[5]); o1.w = pk2(kka[6], kka[7]);
                    *(u32x4*)(KKA + ((size_t)d * NT + row) * 512 + c0) = o1;
                    u32x4 o2; o2.x = pk2(kd[0], kd[1]); o2.y = pk2(kd[2], kd[3]); o2.z = pk2(kd[4], kd[5]); o2.w = pk2(kd[6], kd[7]);
                    *(u32x4*)(KD + ((size_t)d * NT + row) * 512 + c0) = o2;
                }
                bsum += __shfl_xor(bsum, 1); bsum += __shfl_xor(bsum, 2); bsum += __shfl_xor(bsum, 4);
                if ((lane & 7) == 0) BC[(size_t)row * 8 + (lane >> 3)] = bsum;
                    }
        __syncthreads();
    }
}

#define RWS 72
__device__ __forceinline__ bf16x8 rw_frag(const bf16_t* M, int row, int kofs) { return *(const bf16x8*)(M + row * RWS + kofs); }
__device__ __forceinline__ f32x4 rw_tile(const bf16_t* Am, int ra, const bf16_t* Bm, int rb, int fr, int fq) {
    f32x4 acc = (f32x4){0.f, 0.f, 0.f, 0.f};
    acc = __builtin_amdgcn_mfma_f32_16x16x32_bf16(rw_frag(Am, ra + fr, 8 * fq), rw_frag(Bm, rb + fr, 8 * fq), acc, 0, 0, 0);
    acc = __builtin_amdgcn_mfma_f32_16x16x32_bf16(rw_frag(Am, ra + fr, 32 + 8 * fq), rw_frag(Bm, rb + fr, 32 + 8 * fq), acc, 0, 0, 0);
    return acc;
}
__device__ __forceinline__ void phase_6(CParams& P, unsigned char* lds, const int ph) {
    PHASE_PROLOGUE
    constexpr int GST = 68, RST = 132;
    float* Gs = (float*)lds;
    bf16_t* A_rm = (bf16_t*)(lds + 64 * GST * 4); bf16_t* R_rm = A_rm + 64 * RWS; bf16_t* B_rm = R_rm + 64 * RWS; bf16_t* K_rm = B_rm + 64 * RWS;
    bf16_t* B_tr = K_rm + 64 * RWS; bf16_t* K_tr = B_tr + 64 * RWS; bf16_t* V_tr = K_tr + 64 * RWS;
    bf16_t* MAK = V_tr + 64 * RWS; bf16_t* MRB = MAK + 64 * RWS; bf16_t* MRK = MRB + 64 * RWS;
    bf16_t* MABr = MRK + 64 * RWS;
    float* RHS = (float*)(MABr + 64 * RWS);
    float* BT = RHS + 64 * RST; float* OFF = BT + 512; float* GC = OFF + 512;
    bf16_t* X1_tr = A_rm; bf16_t* X2_tr = K_rm;
    for (int i = tid; i < 4 * 64 * RWS / 2; i += 512) ((unsigned*)MAK)[i] = 0u;
    __syncthreads();
    const int fr = lane & 15, fq = lane >> 4;
#define RW1_BAR() do { asm volatile("s_waitcnt lgkmcnt(0)" ::: "memory"); __builtin_amdgcn_s_barrier(); asm volatile("" ::: "memory"); } while (0)
    const int t0 = tid & 63, kp = (tid >> 6) * 8;
    u32x4 nlw, nkk, nka, nkd, nrv, nvv;
#define RW1_LOAD(u_) do { const int ch_ = (u_) / RW_NCH, c_ = (u_) - ch_ * RW_NCH, d_ = ch_ >> 4, b_ = (ch_ >> 3) & 1, h_ = ch_ & 7, s_ = c_ * 64 + t0; \
        const int p_ = d_ ? LSEQ - 1 - s_ : s_; const size_t o_ = (size_t)rowof(b_, s_ < LSEQ ? p_ : 0) * 512 + h_ * 64 + kp; \
        nlw = *(const u32x4*)(LW + (size_t)d_ * NT * 512 + o_); nkk = *(const u32x4*)(KK + o_); nka = *(const u32x4*)(KKA + (size_t)d_ * NT * 512 + o_); \
        nkd = *(const u32x4*)(KD + (size_t)d_ * NT * 512 + o_); nrv = *(const u32x4*)(Rr + o_); nvv = *(const u32x4*)(VV + o_); } while (0)
    if (bid < RW_UNITS) RW1_LOAD(bid);
    for (int u = bid; u < RW_UNITS; u += G) {
        const int chain = u / RW_NCH, c = u - chain * RW_NCH;
        float lw[8], kk[8], ka[8], kd[8], rr[8]; u32x4 vv;
        {
            const bool valid = c * 64 + t0 < LSEQ;
            vv = nvv;
#pragma unroll
            for (int i = 0; i < 4; ++i) {
                union { unsigned u; _Float16 hh[2]; } cv; cv.u = nlw[i];
                lw[2 * i] = valid ? (float)cv.hh[0] : 0.f; lw[2 * i + 1] = valid ? (float)cv.hh[1] : 0.f;
                kk[2 * i] = valid ? bflo(nkk[i]) : 0.f; kk[2 * i + 1] = valid ? bfhi(nkk[i]) : 0.f;
                ka[2 * i] = valid ? bflo(nka[i]) : 0.f; ka[2 * i + 1] = valid ? bfhi(nka[i]) : 0.f;
                kd[2 * i] = valid ? bflo(nkd[i]) : 0.f; kd[2 * i + 1] = valid ? bfhi(nkd[i]) : 0.f;
                rr[2 * i] = valid ? bflo(nrv[i]) : 0.f; rr[2 * i + 1] = valid ? bfhi(nrv[i]) : 0.f;
                if (!valid) vv[i] = 0u;
            }
        }
        if (u + G < RW_UNITS) RW1_LOAD(u + G);
        *(f32x4*)(Gs + t0 * GST + kp) = (f32x4){lw[0], lw[1], lw[2], lw[3]}; *(f32x4*)(Gs + t0 * GST + kp + 4) = (f32x4){lw[4], lw[5], lw[6], lw[7]};
        RW1_BAR();
        { const int k = tid & 63, w = tid >> 6; float acc = 0.f;
#pragma unroll
          for (int i = 0; i < 8; ++i) { acc += Gs[(8 * w + i) * GST + k]; Gs[(8 * w + i) * GST + k] = acc; }
          BT[w * 64 + k] = acc; }
        RW1_BAR();
        { const int k = tid & 63, w = tid >> 6; float off = 0.f; for (int w2 = 0; w2 < w; ++w2) off += BT[w2 * 64 + k]; OFF[w * 64 + k] = off; }
        RW1_BAR();
#ifndef RW1_REP0
#define RW1_REP0 1
#endif
        for (int rep0_ = 0; rep0_ < RW1_REP0; ++rep0_) {
        {
            float va[8], vr[8], vb[8], vk[8];
            const f32x4 g0_ = *(const f32x4*)(Gs + t0 * GST + kp), g1_ = *(const f32x4*)(Gs + t0 * GST + kp + 4), o0_ = *(const f32x4*)(OFF + (t0 >> 3) * 64 + kp), o1_ = *(const f32x4*)(OFF + (t0 >> 3) * 64 + kp + 4);
            const float gg_[8] = {g0_[0] + o0_[0], g0_[1] + o0_[1], g0_[2] + o0_[2], g0_[3] + o0_[3], g1_[0] + o1_[0], g1_[1] + o1_[1], g1_[2] + o1_[2], g1_[3] + o1_[3]};
#pragma unroll
            for (int i = 0; i < 8; ++i) {
                const float g = gg_[i];
                const float eg = __expf(g), egm1 = __expf(g - lw[i]), einv = __expf(-g);
                va[i] = kk[i] * egm1; vr[i] = rr[i] * eg; vb[i] = ka[i] * einv; vk[i] = kd[i] * einv;
                if (t0 == 63) GC[kp + i] = eg;
            }
            *(f32x4*)(RHS + t0 * RST + kp) = (f32x4){va[0], va[1], va[2], va[3]}; *(f32x4*)(RHS + t0 * RST + kp + 4) = (f32x4){va[4], va[5], va[6], va[7]};
            u32x4 w4;
            w4.x = pk2(va[0], va[1]); w4.y = pk2(va[2], va[3]); w4.z = pk2(va[4], va[5]); w4.w = pk2(va[6], va[7]); *(u32x4*)(A_rm + t0 * RWS + kp) = w4;
            w4.x = pk2(vr[0], vr[1]); w4.y = pk2(vr[2], vr[3]); w4.z = pk2(vr[4], vr[5]); w4.w = pk2(vr[6], vr[7]); *(u32x4*)(R_rm + t0 * RWS + kp) = w4;
            w4.x = pk2(vb[0], vb[1]); w4.y = pk2(vb[2], vb[3]); w4.z = pk2(vb[4], vb[5]); w4.w = pk2(vb[6], vb[7]); *(u32x4*)(B_rm + t0 * RWS + kp) = w4;
            w4.x = pk2(vk[0], vk[1]); w4.y = pk2(vk[2], vk[3]); w4.z = pk2(vk[4], vk[5]); w4.w = pk2(vk[6], vk[7]); *(u32x4*)(K_rm + t0 * RWS + kp) = w4;
#pragma unroll
            for (int i = 0; i < 8; ++i) { B_tr[(kp + i) * RWS + t0] = (bf16_t)f2bf(vb[i]); K_tr[(kp + i) * RWS + t0] = (bf16_t)f2bf(vk[i]);
                V_tr[(kp + i) * RWS + t0] = (bf16_t)((i & 1) ? (vv[i >> 1] >> 16) : (vv[i >> 1] & 0xffffu)); }
        }
        RW1_BAR();
        }
        float* DQ = Gs; bf16_t* TB = (bf16_t*)BT;
#ifndef RW1_REP1
#define RW1_REP1 1
#endif
        for (int rep_ = 0; rep_ < RW1_REP1; ++rep_)
        for (int q = wave; q < 40; q += 8) {
            const int m = q / 10, e = q - m * 10, ti = e >= 6 ? 3 : (e >= 3 ? 2 : (e >= 1 ? 1 : 0)), tj = e - (ti * (ti + 1)) / 2;
            const f32x4 acc = rw_tile(m < 2 ? A_rm : R_rm, 16 * ti, (m & 1) ? K_rm : B_rm, 16 * tj, fr, fq);
            bf16_t* Mm = m == 1 ? MAK : (m == 2 ? MRB : MRK);
#pragma unroll
            for (int j = 0; j < 4; ++j) { const int t = 16 * ti + 4 * fq + j, i = 16 * tj + fr; const bool keep = m < 2 ? (i < t) : (i <= t); const float val = keep ? acc[j] : 0.f;
                if (m == 0) { MABr[t * RWS + i] = (bf16_t)f2bf(val); if (ti == tj) DQ[((ti * 16 + (t & 15)) * 4 + (fr & 3)) * 4 + (fr >> 2)] = val; }
                else Mm[t * RWS + i] = (bf16_t)f2bf(val); }
        }
        RW1_BAR();
#ifndef RW1_REP23
#define RW1_REP23 1
#endif
        for (int rep23_ = 0; rep23_ < RW1_REP23; ++rep23_) {
        if (wave >= 4) {
            for (int q = wave - 4; q < 16; q += 4) { const int ti = q >> 2, tv = q & 3; const f32x4 acc = rw_tile(MAK, 16 * ti, V_tr, 16 * tv, fr, fq);
#pragma unroll
                for (int j = 0; j < 4; ++j) RHS[(16 * ti + 4 * fq + j) * RST + 64 + 16 * tv + fr] = acc[j]; }
        } else {
            const int bb = wave, cc = lane >> 2, q = lane & 3;
            float xs[4] = {0.f, 0.f, 0.f, 0.f};
#pragma unroll
            for (int tl = 0; tl < 16; ++tl) {
                const f32x4 mv = *(const f32x4*)(DQ + ((bb * 16 + tl) * 4 + q) * 4);
                float part = mv[0] * xs[0] + mv[1] * xs[1] + mv[2] * xs[2] + mv[3] * xs[3];
                part += dppf<0xB1>(part); part += dppf<0x4E>(part);
                const float xt = (tl == cc ? 1.f : 0.f) - part;
                xs[tl >> 2] = (tl & 3) == q ? xt : xs[tl >> 2];
            }
#pragma unroll
            for (int m = 0; m < 4; ++m) TB[(bb * 16 + 4 * m + q) * 16 + cc] = (bf16_t)f2bf(xs[m]);
        }
        RW1_BAR();
        {
            const int c0 = 16 * wave;
            f32x4 X[4];
            const f32x4 zero4 = (f32x4){0.f, 0.f, 0.f, 0.f};
#define RW1_PACK(lo_, hi_, v_) do { union { bf16x8 v; unsigned u[4]; } t_; t_.u[0] = pk2(lo_[0], lo_[1]); t_.u[1] = pk2(lo_[2], lo_[3]); t_.u[2] = pk2(hi_[0], hi_[1]); t_.u[3] = pk2(hi_[2], hi_[3]); v_ = t_.v; } while (0)
#define RW1_LDA(base_, row0_, ca_, cb_, useb_, v_) do { union { bf16x8 v; u32x2 h2[2]; } t_; t_.h2[0] = *(const u32x2*)((base_) + ((row0_) + fr) * RWS + (ca_) + 4 * fq); \
            t_.h2[1] = (useb_) ? *(const u32x2*)((base_) + ((row0_) + fr) * RWS + (cb_) + 4 * fq) : (u32x2){0u, 0u}; v_ = t_.v; } while (0)
#pragma unroll
            for (int bq = 0; bq < 4; ++bq) {
                f32x4 acc;
#pragma unroll
                for (int j = 0; j < 4; ++j) acc[j] = -RHS[(16 * bq + 4 * fq + j) * RST + c0 + fr];
                bf16x8 af, bfv;
                if (bq >= 1) { RW1_LDA(MABr, 16 * bq, 0, 16, bq >= 2, af); if (bq >= 2) RW1_PACK(X[0], X[1], bfv); else RW1_PACK(X[0], zero4, bfv);
                    acc = __builtin_amdgcn_mfma_f32_16x16x32_bf16(af, bfv, acc, 0, 0, 0); }
                if (bq == 3) { RW1_LDA(MABr, 48, 32, 0, false, af); RW1_PACK(X[2], zero4, bfv); acc = __builtin_amdgcn_mfma_f32_16x16x32_bf16(af, bfv, acc, 0, 0, 0); }
                const f32x4 wv = (f32x4){-acc[0], -acc[1], -acc[2], -acc[3]};
                { union { bf16x8 v; u32x2 h2[2]; } t_; t_.h2[0] = *(const u32x2*)(TB + (bq * 16 + fr) * 16 + 4 * fq); t_.h2[1] = (u32x2){0u, 0u}; af = t_.v; }
                RW1_PACK(wv, zero4, bfv);
                X[bq] = __builtin_amdgcn_mfma_f32_16x16x32_bf16(af, bfv, zero4, 0, 0, 0);
                bf16_t* Xm = (wave < 4 ? X1_tr : X2_tr) + ((c0 & 63) + fr) * RWS + 16 * bq + 4 * fq;
                u32x2 o; o.x = pk2(X[bq][0], X[bq][1]); o.y = pk2(X[bq][2], X[bq][3]);
                *(u32x2*)Xm = o;
            }
#undef RW1_PACK
#undef RW1_LDA
        }
        RW1_BAR();
        }
#ifndef RW1_REP5
#define RW1_REP5 1
#endif
        for (int rep_ = 0; rep_ < RW1_REP5; ++rep_)
        for (int q = wave; q < 64; q += 8) {
            const int kind = q >> 4, ta = (q >> 2) & 3, tb = q & 3;
            u32x2 o;
            if (kind == 0) {
                const f32x4 acc = rw_tile(X1_tr, 16 * ta, B_tr, 16 * tb, fr, fq);
                const int k = 16 * tb + fr, kq = 16 * ta + 4 * fq; const float gc = GC[k];
                float v[4];
#pragma unroll
                for (int j = 0; j < 4; ++j) v[j] = gc * ((kq + j == k ? 1.f : 0.f) - acc[j]);
                o.x = pk2(v[0], v[1]); o.y = pk2(v[2], v[3]);
                *(u32x2*)(PP + (size_t)u * 4096 + k * 64 + 32 * (ta >> 1) + 8 * fq + 4 * (ta & 1)) = o;
            } else if (kind == 1) {
                const f32x4 acc = rw_tile(X1_tr, 16 * ta, MRB, 16 * tb, fr, fq);
                const int t = 16 * tb + fr, k0 = 16 * ta + 4 * fq;
                const u32x2 rv = *(const u32x2*)(R_rm + t * RWS + k0);
                o.x = pk2(bflo(rv.x) - acc[0], bfhi(rv.x) - acc[1]); o.y = pk2(bflo(rv.y) - acc[2], bfhi(rv.y) - acc[3]);
                *(u32x2*)(YT + (size_t)u * 4096 + t * 64 + 32 * (ta >> 1) + 8 * fq + 4 * (ta & 1)) = o;
            } else if (kind == 2) {
                const f32x4 a1 = rw_tile(K_tr, 16 * ta, V_tr, 16 * tb, fr, fq), a2 = rw_tile(B_tr, 16 * ta, X2_tr, 16 * tb, fr, fq);
                const int v_ = 16 * tb + fr, k0 = 16 * ta + 4 * fq;
                const f32x4 gc = *(const f32x4*)(GC + k0);
                o.x = pk2(gc[0] * (a1[0] - a2[0]), gc[1] * (a1[1] - a2[1])); o.y = pk2(gc[2] * (a1[2] - a2[2]), gc[3] * (a1[3] - a2[3]));
                *(u32x2*)(QT + (size_t)u * 4096 + v_ * 64 + k0) = o;
            } else {
                const f32x4 a1 = rw_tile(MRK, 16 * ta, V_tr, 16 * tb, fr, fq), a2 = rw_tile(MRB, 16 * ta, X2_tr, 16 * tb, fr, fq);
                const int v_ = 16 * tb + fr, t0_ = 16 * ta + 4 * fq;
                o.x = pk2(a1[0] - a2[0], a1[1] - a2[1]); o.y = pk2(a1[2] - a2[2], a1[3] - a2[3]);
                *(u32x2*)(ZT + (size_t)u * 4096 + v_ * 64 + t0_) = o;
            }
        }
        RW1_BAR();
    }
#undef RW1_LOAD
#undef RW1_BAR
}

__device__ __forceinline__ void phase_60(CParams& P, unsigned char* lds, const int ph) {
    PHASE_PROLOGUE
    if (bid < 32) {
        const int chain = bid, d = chain >> 4, b = (chain >> 3) & 1, h = chain & 7;
        const int fr = lane & 15, fq = lane >> 4;
        constexpr int MATB = 64 * RWS * 2, SLOT = 4 * MATB;
        bf16_t* ybuf = (bf16_t*)(lds + 3 * SLOT);
        const bool comp = wave < 4; const int vb = wave & 3, lm = wave & 3;
        const unsigned char* src = (const unsigned char*)(lm == 0 ? PP : (lm == 1 ? YT : (lm == 2 ? QT : ZT))) + (size_t)chain * RW_NCH * 8192 + lane * 16;
        u32x4 R0[8], R1[8], R2[8];
#define RW2_LD(Rx, c_) do { _Pragma("unroll") for (int i_ = 0; i_ < 8; ++i_) Rx[i_] = *(const u32x4*)(src + (size_t)(c_) * 8192 + i_ * 1024); } while (0)
#define RW2_ST(Rx, c_) do { unsigned char* dst_ = lds + ((c_) % 3) * SLOT + lm * MATB; _Pragma("unroll") for (int i_ = 0; i_ < 8; ++i_) { const int p_ = lane + 64 * i_; *(u32x4*)(dst_ + (p_ >> 3) * (RWS * 2) + (p_ & 7) * 16) = Rx[i_]; } } while (0)
#define RW2_FLUSH(c_) do { const int tl_ = 16 * lm + (lane >> 2), s_ = (c_) * 64 + tl_; const bf16_t* yb_ = ybuf + ((c_) & 1) * 64 * RWS + tl_ * RWS + 16 * (lane & 3); \
            const u32x4 y0_ = *(const u32x4*)yb_, y1_ = *(const u32x4*)(yb_ + 8); \
            if (s_ < LSEQ) { const int p_ = d ? LSEQ - 1 - s_ : s_; bf16_t* g_ = YFB + ((size_t)d * NT + rowof(b, p_)) * 512 + h * 64 + 16 * (lane & 3); *(u32x4*)g_ = y0_; *(u32x4*)(g_ + 8) = y1_; } } while (0)
        const f32x4 zero4 = (f32x4){0.f, 0.f, 0.f, 0.f};
        f32x4 S[4] = {zero4, zero4, zero4, zero4};
#define RW2_COMPUTE(c_) do { const bf16_t* sl_ = (const bf16_t*)(lds + ((c_) % 3) * SLOT); const bf16_t* sP = sl_; const bf16_t* sY = sl_ + 64 * RWS; const bf16_t* sQ = sl_ + 2 * 64 * RWS; const bf16_t* sZ = sl_ + 3 * 64 * RWS; \
            bf16_t* yo_ = ybuf + ((c_) & 1) * 64 * RWS + 16 * vb + fr; \
            union { bf16x8 v; unsigned u[4]; } bs[2]; \
            _Pragma("unroll") for (int ks = 0; ks < 2; ++ks) { bs[ks].u[0] = pk2(S[2 * ks][0], S[2 * ks][1]); bs[ks].u[1] = pk2(S[2 * ks][2], S[2 * ks][3]); \
                bs[ks].u[2] = pk2(S[2 * ks + 1][0], S[2 * ks + 1][1]); bs[ks].u[3] = pk2(S[2 * ks + 1][2], S[2 * ks + 1][3]); } \
            _Pragma("unroll") for (int tt = 0; tt < 4; ++tt) { \
                const u32x2 z2 = *(const u32x2*)(sZ + (16 * vb + fr) * RWS + 16 * tt + 4 * fq); \
                f32x4 acc = (f32x4){bflo(z2.x), bfhi(z2.x), bflo(z2.y), bfhi(z2.y)}; \
                acc = __builtin_amdgcn_mfma_f32_16x16x32_bf16(*(const bf16x8*)(sY + (16 * tt + fr) * RWS + 8 * fq), bs[0].v, acc, 0, 0, 0); \
                acc = __builtin_amdgcn_mfma_f32_16x16x32_bf16(*(const bf16x8*)(sY + (16 * tt + fr) * RWS + 32 + 8 * fq), bs[1].v, acc, 0, 0, 0); \
                _Pragma("unroll") for (int j = 0; j < 4; ++j) yo_[(16 * tt + 4 * fq + j) * RWS] = (bf16_t)f2bf(acc[j]); } \
            f32x4 Sn[4]; \
            _Pragma("unroll") for (int kt = 0; kt < 4; ++kt) { \
                const u32x2 q2 = *(const u32x2*)(sQ + (16 * vb + fr) * RWS + 16 * kt + 4 * fq); \
                f32x4 acc = (f32x4){bflo(q2.x), bfhi(q2.x), bflo(q2.y), bfhi(q2.y)}; \
                acc = __builtin_amdgcn_mfma_f32_16x16x32_bf16(*(const bf16x8*)(sP + (16 * kt + fr) * RWS + 8 * fq), bs[0].v, acc, 0, 0, 0); \
                acc = __builtin_amdgcn_mfma_f32_16x16x32_bf16(*(const bf16x8*)(sP + (16 * kt + fr) * RWS + 32 + 8 * fq), bs[1].v, acc, 0, 0, 0); \
                Sn[kt] = acc; } \
            _Pragma("unroll") for (int kt = 0; kt < 4; ++kt) S[kt] = Sn[kt]; } while (0)
#define RW2_BAR() do { asm volatile("s_waitcnt lgkmcnt(0)" ::: "memory"); __builtin_amdgcn_s_barrier(); asm volatile("" ::: "memory"); } while (0)
        if (!comp) { RW2_LD(R0, 0); RW2_ST(R0, 0); RW2_LD(R0, 1); RW2_LD(R1, 2); RW2_LD(R2, 3); }
        __syncthreads();
        for (int c = 0; c < RW_NCH; c += 3) {
            if (!comp) { if (c + 1 < RW_NCH) RW2_ST(R0, c + 1); if (c + 4 < RW_NCH) RW2_LD(R0, c + 4); if (c > 0) RW2_FLUSH(c - 1); } else RW2_COMPUTE(c);
            RW2_BAR();
            if (!comp) { if (c + 2 < RW_NCH) RW2_ST(R1, c + 2); if (c + 5 < RW_NCH) RW2_LD(R1, c + 5); RW2_FLUSH(c); } else RW2_COMPUTE(c + 1);
            RW2_BAR();
            if (!comp) { if (c + 3 < RW_NCH) RW2_ST(R2, c + 3); if (c + 6 < RW_NCH) RW2_LD(R2, c + 6); RW2_FLUSH(c + 1); } else RW2_COMPUTE(c + 2);
            RW2_BAR();
        }
        if (!comp) RW2_FLUSH(RW_NCH - 1);
#undef RW2_LD
#undef RW2_ST
#undef RW2_FLUSH
#undef RW2_COMPUTE
#undef RW2_BAR
    } else {
        na_units(P, lds, (bid - 32) * 8 + (threadIdx.x >> 6), (G - 32) * 8);
    }
}

__device__ __forceinline__ void phase_7(CParams& P, unsigned char* lds, const int ph) {
    PHASE_PROLOGUE
            for (int row = gw; row < NT; row += NGW) {
                const int c0 = lane * 8;
                const u32x4 yf = *(const u32x4*)(YFB + (size_t)row * 512 + c0);
                const u32x4 yb = *(const u32x4*)(YFB + ((size_t)NT + row) * 512 + c0);
                const u32x4 vv = *(const u32x4*)(VV + (size_t)row * 512 + c0);
                const u32x4 gg = *(const u32x4*)(Gg + (size_t)row * 512 + c0);
                float y[8], v[8], g[8];
#pragma unroll
                for (int i = 0; i < 4; ++i) { y[2 * i] = bflo(yf[i]) + bflo(yb[i]); y[2 * i + 1] = bfhi(yf[i]) + bfhi(yb[i]); v[2 * i] = bflo(vv[i]); v[2 * i + 1] = bfhi(vv[i]); g[2 * i] = bflo(gg[i]); g[2 * i + 1] = bfhi(gg[i]); }
                float sm = 0.f;
#pragma unroll
                for (int i = 0; i < 8; ++i) sm += y[i];
                sm += __shfl_xor(sm, 1); sm += __shfl_xor(sm, 2); sm += __shfl_xor(sm, 4);
                const float mean = sm * (1.f / 64.f);
                float vr = 0.f;
#pragma unroll
                for (int i = 0; i < 8; ++i) { const float dlt = y[i] - mean; vr += dlt * dlt; }
                vr += __shfl_xor(vr, 1); vr += __shfl_xor(vr, 2); vr += __shfl_xor(vr, 4);
                const float rstd = rsqrtf(vr * (1.f / 64.f) + 64e-5f);
                const float bc = BC[(size_t)row * 8 + (lane >> 3)];
                float o[8];
#pragma unroll
                for (int i = 0; i < 8; ++i) o[i] = ((y[i] - mean) * rstd * lnx_g[c0 + i] + lnx_b[c0 + i] + bc * v[i]) * g[i];
                u32x4 ov; ov.x = pk2(o[0], o[1]); ov.y = pk2(o[2], o[3]); ov.z = pk2(o[4], o[5]); ov.w = pk2(o[6], o[7]);
                *(u32x4*)(A2 + (size_t)row * DM + 512 + c0) = ov;
            }
}


__device__ __forceinline__ void phase_8(CParams& P, unsigned char* lds, const int ph) {
    PHASE_PROLOGUE
    if (gw < 64) meta_gemm<0>(A2 + (size_t)NMAIN * DM, WTOUT, H + (size_t)NMAIN * DM, gw, lane);
    pg8::DenseOrder S; S.init(A2, WTOUT, NMAIN, DM, DM, G, bid);
    pg8::EpiResidual E{H};
    pg8::gemm_phase<pg8::EpiResidual, pg8::DenseOrder, true, true>((PG8_LAS unsigned char*)lds, DM, S, E);
}

__device__ __forceinline__ void phase_9(CParams& P, unsigned char* lds, const int ph) {
    PHASE_PROLOGUE
            const int l = ph == 9 ? 0 : 1;
                    for (int i = bid * 512 + tid; i < MOE_MAXROWS; i += G * 512) ROWTOK[i] = 0;
    unsigned* cnt = CTL + CW_CNT(l);
            const float* wg = moe_wg + (size_t)l * DM * 4; const float* bg = moe_bg + l * 4;
            for (int row = gw; row < NT; row += NGW) {
                f32x4 v[4]; float ss = 0.f;
#pragma unroll
                for (int j = 0; j < 4; ++j) { v[j] = ldrow_bf16(H + (size_t)row * DM, lane, j); ss += v[j][0] * v[j][0] + v[j][1] * v[j][1] + v[j][2] * v[j][2] + v[j][3] * v[j][3]; }
                ss = wave_sum(ss);
                const float rstd = rsqrtf(ss * (1.f / DM) + 1e-6f);
                float lg[4] = {0.f, 0.f, 0.f, 0.f};
#pragma unroll
                for (int j = 0; j < 4; ++j) {
                    const f32x4 g = ((const f32x4*)(norm_ffn + l * DM))[lane + 64 * j];
#pragma unroll
                    for (int i = 0; i < 4; ++i) v[j][i] = v[j][i] * rstd * g[i];
                    u32x2 o; o.x = pk2(v[j][0], v[j][1]); o.y = pk2(v[j][2], v[j][3]);
                    ((u32x2*)(HN + (size_t)row * DM))[lane + 64 * j] = o;
#pragma unroll
                    for (int i = 0; i < 4; ++i) { const f32x4 w = *(const f32x4*)(wg + (size_t)(4 * (lane + 64 * j) + i) * 4);
                        lg[0] += v[j][i] * w[0]; lg[1] += v[j][i] * w[1]; lg[2] += v[j][i] * w[2]; lg[3] += v[j][i] * w[3]; }
                }
#pragma unroll
                for (int q = 0; q < 4; ++q) lg[q] = wave_sum(lg[q]) + bg[q];
                int grp = 0; float mx = lg[0];
#pragma unroll
                for (int q = 1; q < 4; ++q) if (lg[q] > mx) { mx = lg[q]; grp = q; }
                float den = 0.f;
#pragma unroll
                for (int q = 0; q < 4; ++q) den += __expf(lg[q] - mx);
                const float pgrp = 1.f / den;
                const float* we = moe_we + ((size_t)(l * 4 + grp) * DM) * 8;
                float le[8] = {0.f, 0.f, 0.f, 0.f, 0.f, 0.f, 0.f, 0.f};
#pragma unroll
                for (int j = 0; j < 4; ++j)
#pragma unroll
                    for (int i = 0; i < 4; ++i) { const float* wr_ = we + (size_t)(4 * (lane + 64 * j) + i) * 8; const f32x4 wa = *(const f32x4*)wr_, wb = *(const f32x4*)(wr_ + 4);
                        le[0] += v[j][i] * wa[0]; le[1] += v[j][i] * wa[1]; le[2] += v[j][i] * wa[2]; le[3] += v[j][i] * wa[3];
                        le[4] += v[j][i] * wb[0]; le[5] += v[j][i] * wb[1]; le[6] += v[j][i] * wb[2]; le[7] += v[j][i] * wb[3]; }
#pragma unroll
                for (int q = 0; q < 8; ++q) le[q] = wave_sum(le[q]) + moe_be[(l * 4 + grp) * 8 + q];
                int i1 = 0; float m1 = le[0];
#pragma unroll
                for (int q = 1; q < 8; ++q) if (le[q] > m1) { m1 = le[q]; i1 = q; }
                int i2 = (i1 + 1) & 7; float m2 = -3.0e38f;
#pragma unroll
                for (int q = 0; q < 8; ++q) if (q != i1 && le[q] > m2) { m2 = le[q]; i2 = q; }
                const float e2 = __expf(m2 - m1);
                const float g1 = pgrp / (1.f + e2), g2 = pgrp * e2 / (1.f + e2);
                if (lane == 0) {
                    const int ea = grp * 8 + i1, eb = grp * 8 + i2;
                    const unsigned pa = atomicAdd(cnt + ea, 1u), pb = atomicAdd(cnt + eb, 1u);
                    EID[row * 2] = ea; EID[row * 2 + 1] = eb; POS[row * 2] = (int)pa; POS[row * 2 + 1] = (int)pb;
                    GATE[row * 2] = g1; GATE[row * 2 + 1] = g2;
                }
            }
    for (int it = gw; it < CONV_MOE_ITEMS; it += NGW) conv_moe_item(P, l, it, lane);
}


__device__ __forceinline__ void phase_10(CParams& P, unsigned char* lds, const int ph) {
    PHASE_PROLOGUE
    const int l = ph == 10 ? 0 : 1;
    int* ps = (int*)(lds + LDS_TAB);
    if (tid == 0) { int acc_ = 0; for (int e = 0; e < NEXP; ++e) { ps[e] = acc_; const int c = (int)CTL[CW_CNT(l) + e]; acc_ += (c + MOE_RT - 1) / MOE_RT * MOE_RT; } ps[NEXP] = acc_; }
    __syncthreads();
    for (int i = bid * 512 + tid; i < NT * 2; i += G * 512) { const int dest = ps[EID[i]] + POS[i]; DEST[i] = dest; ROWTOK[dest] = i >> 1; }
    __syncthreads();
}

__device__ __forceinline__ void phase_11(CParams& P, unsigned char* lds, const int ph) {
    PHASE_PROLOGUE
    const int l = ph == 11 ? 0 : 1;
    int* et = (int*)(lds + LDS_TAB);
    if (tid == 0) { int acc_ = 0; for (int e = 0; e < NEXP; ++e) { const int c = (int)CTL[CW_CNT(l) + e], n = (c + MOE_RT - 1) / MOE_RT; for (int q = 0; q < n; ++q) et[1 + acc_ + q] = e; acc_ += n; } et[0] = acc_; }
    __syncthreads();
    pg8::MoeOrder<true> S{et + 1, et[0], vcu, (const char*)HN, (const char*)WT13, 256u * DM * 2u, 256u * DM * 2u, (unsigned)DM * DM * 2u, ROWTOK};
    pg8::EpiSwiglu E{HB};
    pg8::gemm_phase<pg8::EpiSwiglu, pg8::MoeOrder<true>, true, true>((PG8_LAS unsigned char*)lds, DM, S, E);
    __syncthreads();
}

__device__ __forceinline__ void phase_12(CParams& P, unsigned char* lds, const int ph) {
    PHASE_PROLOGUE
    const int l = ph == 12 ? 0 : 1;
    int* et = (int*)(lds + LDS_TAB);
    if (tid == 0) { int acc_ = 0; for (int e = 0; e < NEXP; ++e) { const int c = (int)CTL[CW_CNT(l) + e], n = (c + MOE_RT - 1) / MOE_RT; for (int q = 0; q < n; ++q) et[1 + acc_ + q] = e; acc_ += n; } et[0] = acc_; }
    __syncthreads();
    pg8::MoeOrder<false> S{et + 1, et[0], vcu, (const char*)HB, (const char*)WT2, 256u * DFF * 2u, 256u * DFF * 2u, (unsigned)DM * DFF * 2u, nullptr};
    pg8::EpiBf16Plain E{YB, DM};
    pg8::gemm_phase<pg8::EpiBf16Plain, pg8::MoeOrder<false>, true, true>((PG8_LAS unsigned char*)lds, DFF, S, E);
    __syncthreads();
}

__device__ __forceinline__ void phase_13(CParams& P, unsigned char* lds, const int ph) {
    PHASE_PROLOGUE
            const bool fin = ph == 21;
            for (int row = gw; row < NT; row += NGW) {
                const int d0 = DEST[row * 2], d1 = DEST[row * 2 + 1];
                const float g0 = GATE[row * 2], g1 = GATE[row * 2 + 1];
                f32x4 v[4];
#pragma unroll
                for (int j = 0; j < 4; ++j) {
                    v[j] = ldrow_bf16(H + (size_t)row * DM, lane, j);
                    const u32x2 ya = ((const u32x2*)(YB + (size_t)d0 * DM))[lane + 64 * j];
                    const u32x2 yb = ((const u32x2*)(YB + (size_t)d1 * DM))[lane + 64 * j];
                    v[j][0] += g0 * bflo(ya.x) + g1 * bflo(yb.x); v[j][1] += g0 * bfhi(ya.x) + g1 * bfhi(yb.x);
                    v[j][2] += g0 * bflo(ya.y) + g1 * bflo(yb.y); v[j][3] += g0 * bfhi(ya.y) + g1 * bfhi(yb.y);
                }
                if (!fin) {
#pragma unroll
                    for (int j = 0; j < 4; ++j) strow_bf16(H + (size_t)row * DM, lane, j, v[j]);
                    store_norm_bf16(v, norm_mix + DM, HN + (size_t)row * DM, lane);
                } else if (row < NMAIN) {
                    float ss = 0.f;
#pragma unroll
                    for (int j = 0; j < 4; ++j) ss += v[j][0] * v[j][0] + v[j][1] * v[j][1] + v[j][2] * v[j][2] + v[j][3] * v[j][3];
                    ss = wave_sum(ss);
                    const float rstd = rsqrtf(ss * (1.f / DM) + 1e-6f);
#pragma unroll
                    for (int j = 0; j < 4; ++j) { const f32x4 g = ((const f32x4*)norm_final)[lane + 64 * j]; f32x4 o;
                        o[0] = v[j][0] * rstd * g[0]; o[1] = v[j][1] * rstd * g[1]; o[2] = v[j][2] * rstd * g[2]; o[3] = v[j][3] * rstd * g[3];
                        ((f32x4*)(P.out + (size_t)row * DM))[lane + 64 * j] = o; }
                }
            }
}

__device__ __forceinline__ void phase_14(CParams& P, unsigned char* lds, const int ph) {
    PHASE_PROLOGUE
    float* pwr = (float*)lds; float* pwi = pwr + 2176; float* bbr = pwi + 2176; float* bbi = bbr + 2048; float* ccr = bbi + 2048; float* cci = ccr + 2048; float* kf = cci + 2048; float* kb = kf + 4096;
    for (int gu = bid; gu < 256; gu += G) {
        const int g = gu >> 2, part = gu & 3;
        if (tid < 128) {
            const int d = tid >> 6, p = tid & 63;
            const float step = __expf(s5_ls[d * 64 + g]);
            const float lr = s5_lre[(d * 64 + g) * 64 + p], li = s5_lim[(d * 64 + g) * 64 + p];
            const float mag = expf(lr * step);
            const float abr = mag * cosf(li * step), abi = mag * sinf(li * step);
            const float den = lr * lr + li * li;
            const float zr = ((abr - 1.f) * lr + abi * li) / den, zi = (abi * lr - (abr - 1.f) * li) / den;
            float pr = 1.f, pi = 0.f;
            for (int t = 0; t < 17; ++t) { pwr[(d * 64 + p) * 17 + t] = pr; pwi[(d * 64 + p) * 17 + t] = pi; const float nr = pr * abr - pi * abi; pi = pr * abi + pi * abr; pr = nr; }
            for (int i = 0; i < 16; ++i) { const float br = s5_b_re[((size_t)(g * 64 + p)) * 16 + i], bi = s5_b_im[((size_t)(g * 64 + p)) * 16 + i];
                bbr[(d * 64 + p) * 16 + i] = zr * br - zi * bi; bbi[(d * 64 + p) * 16 + i] = zr * bi + zi * br; }
        }
        for (int idx = tid; idx < 2048; idx += 512) { const int d = idx >> 10, i = (idx >> 6) & 15, p = idx & 63;
            ccr[(d * 64 + p) * 16 + i] = s5_c_re[((size_t)(d * 64 + g) * 16 + i) * 64 + p]; cci[(d * 64 + p) * 16 + i] = s5_c_im[((size_t)(d * 64 + g) * 16 + i) * 64 + p]; }
        __syncthreads();
        {
            const int d = tid >> 8, tau = (tid >> 4) & 15, i = tid & 15;
            float acc[16];
#pragma unroll
            for (int q = 0; q < 16; ++q) acc[q] = 0.f;
            for (int p = 0; p < 64; ++p) {
                const float cr = ccr[(d * 64 + p) * 16 + i], ci = cci[(d * 64 + p) * 16 + i], pr = pwr[(d * 64 + p) * 17 + tau], pi = pwi[(d * 64 + p) * 17 + tau];
                const float xr = cr * pr - ci * pi, xi = cr * pi + ci * pr;
#pragma unroll
                for (int q = 0; q < 16; ++q) acc[q] += xr * bbr[(d * 64 + p) * 16 + q] - xi * bbi[(d * 64 + p) * 16 + q];
            }
            float* kt = (d ? kb : kf) + (tau * 16 + i) * 16;
#pragma unroll
            for (int q = 0; q < 16; ++q) kt[q] = acc[q];
        }
        __syncthreads();
        unsigned* bta = (unsigned*)(BTA + (size_t)g * 512 * 256);
        for (int idx = part * 128 * 128 + tid; idx < (part + 1) * 128 * 128; idx += 512) {
            const int row = idx >> 7, col = (idx & 127) * 2;
            float v[2];
#pragma unroll
            for (int e = 0; e < 2; ++e) {
                const int cc_ = col + e, j = cc_ >> 4, ip = cc_ & 15;
                if (row < 256) { const int t = row >> 4, i = row & 15;
                    v[e] = j < t ? kf[((t - j) * 16 + i) * 16 + ip] : (j > t ? kb[((j - t) * 16 + i) * 16 + ip] : kf[i * 16 + ip] + kb[i * 16 + ip]); }
                else { const int kp = row - 256, d = kp >> 7, part = (kp >> 6) & 1, p = kp & 63, tau = d == 0 ? 15 - j : j;
                    const float pr = pwr[(d * 64 + p) * 17 + tau], pi = pwi[(d * 64 + p) * 17 + tau], br = bbr[(d * 64 + p) * 16 + ip], bi = bbi[(d * 64 + p) * 16 + ip];
                    v[e] = part ? pr * bi + pi * br : pr * br - pi * bi; }
            }
            bta[idx] = pk2(v[0], v[1]);
        }
        unsigned* btc = (unsigned*)(BTC + (size_t)g * 256 * 256);
        for (int idx = part * 64 * 128 + tid; idx < (part + 1) * 64 * 128; idx += 512) {
            const int row = idx >> 7, col = (idx & 127) * 2, t = row >> 4, i = row & 15;
            float v[2];
#pragma unroll
            for (int e = 0; e < 2; ++e) {
                const int k = col + e, d = k >> 7, part = (k >> 6) & 1, p = k & 63, tau = d == 0 ? t + 1 : 16 - t;
                const float cr = ccr[(d * 64 + p) * 16 + i], ci = cci[(d * 64 + p) * 16 + i], pr = pwr[(d * 64 + p) * 17 + tau], pi = pwi[(d * 64 + p) * 17 + tau];
                v[e] = part ? -(cr * pi + ci * pr) : cr * pr - ci * pi;
            }
            btc[idx] = pk2(v[0], v[1]);
        }
        __syncthreads();
    }
}

__device__ __forceinline__ void phase_15(CParams& P, unsigned char* lds, const int ph) {
    PHASE_PROLOGUE
    pg8::S5OrderA S{vcu, (const char*)HN, (const char*)BTA};
    pg8::EpiS5A E{YI, S5E};
    int Kr = 256; asm volatile("" : "+s"(Kr));
    pg8::gemm_phase<pg8::EpiS5A, pg8::S5OrderA, true, true>((PG8_LAS unsigned char*)lds, Kr, S, E);
}

__device__ __forceinline__ void phase_16(CParams& P, unsigned char* lds, const int ph) {
    PHASE_PROLOGUE
    float* Ls = (float*)lds;
    for (int wg = bid; wg < NB * 64 * 2; wg += G) {
        const int d = wg & 1, g = (wg >> 1) & 63, b = wg >> 7, p = lane;
        const float step = __expf(s5_ls[d * 64 + g]);
        const float lr = s5_lre[(d * 64 + g) * 64 + p], li = s5_lim[(d * 64 + g) * 64 + p];
        const float mag = expf(lr * step);
        const float abr = mag * cosf(li * step), abi = mag * sinf(li * step);
        float ar = 1.f, ai = 0.f;
        for (int t = 0; t < 16; ++t) { const float nr = ar * abr - ai * abi; ai = ar * abi + ai * abr; ar = nr; }
        float Ar = 1.f, Ai = 0.f;
        for (int t = 0; t < 64; ++t) { const float nr = Ar * ar - Ai * ai; Ai = Ar * ai + Ai * ar; Ar = nr; }
        const bf16_t* Ep = S5E + (size_t)g * 256 + d * 128 + p;
        bf16_t* Cp = CAR + (size_t)g * 1280 * 256 + d * 128 + p;
        const int q0 = 64 * wave;
#define S5_N(q_) ({ const int c_ = d ? 512 - (q_) : (q_); c_ == 0 ? 1024 + b : b * 512 + c_ - 1; })
        float sr = 0.f, si = 0.f;
#pragma unroll 1
        for (int hb = 0; hb < 2; ++hb) {
            float er[32], ei[32];
#pragma unroll
            for (int k = 0; k < 32; ++k) { const int n = S5_N(q0 + 32 * hb + k); er[k] = bf2f(Ep[(size_t)n * 64 * 256]); ei[k] = bf2f(Ep[(size_t)n * 64 * 256 + 64]); }
#pragma unroll
            for (int k = 0; k < 32; ++k) { const float nr = ar * sr - ai * si + er[k]; si = ar * si + ai * sr + ei[k]; sr = nr; }
        }
        Ls[(wave * 64 + p) * 2] = sr; Ls[(wave * 64 + p) * 2 + 1] = si;
        __syncthreads();
        sr = 0.f; si = 0.f;
        for (int w2 = 0; w2 < wave; ++w2) { const float l0 = Ls[(w2 * 64 + p) * 2], l1 = Ls[(w2 * 64 + p) * 2 + 1]; const float nr = Ar * sr - Ai * si + l0; si = Ar * si + Ai * sr + l1; sr = nr; }
#pragma unroll 1
        for (int hb = 0; hb < 2; ++hb) {
            float er[32], ei[32]; int nn[32];
#pragma unroll
            for (int k = 0; k < 32; ++k) { nn[k] = S5_N(q0 + 32 * hb + k); er[k] = bf2f(Ep[(size_t)nn[k] * 64 * 256]); ei[k] = bf2f(Ep[(size_t)nn[k] * 64 * 256 + 64]); }
#pragma unroll
            for (int k = 0; k < 32; ++k) { Cp[(size_t)nn[k] * 256] = (bf16_t)f2bf(sr); Cp[(size_t)nn[k] * 256 + 64] = (bf16_t)f2bf(si);
                const float nr = ar * sr - ai * si + er[k]; si = ar * si + ai * sr + ei[k]; sr = nr; }
        }
        if (wave == 7) { const int n = S5_N(512); Cp[(size_t)n * 256] = (bf16_t)f2bf(sr); Cp[(size_t)n * 256 + 64] = (bf16_t)f2bf(si); }
#undef S5_N
        __syncthreads();
    }
}

__device__ __forceinline__ void phase_22(CParams& P, unsigned char* lds, const int ph) {
    PHASE_PROLOGUE
    pg8::S5OrderC S{vcu, (const char*)CAR, (const char*)BTC};
    pg8::EpiS5C E{YI, HN, s5_d, A2};
    int Kr = 256; asm volatile("" : "+s"(Kr));
    pg8::gemm_phase<pg8::EpiS5C, pg8::S5OrderC, true, true>((PG8_LAS unsigned char*)lds, Kr, S, E);
}

__device__ __forceinline__ void phase_23(CParams& P, unsigned char* lds, const int ph) {
    PHASE_PROLOGUE
    if (gw < 64) meta_gemm<1>(A2 + (size_t)NMAIN * DM, WTGLU, H + (size_t)NMAIN * DM, gw, lane);
    pg8::DenseOrder S; S.init(A2, WTGLU, NMAIN, 2 * DM, DM, G, bid);
    pg8::EpiGlu E{H};
    pg8::gemm_phase<pg8::EpiGlu, pg8::DenseOrder, true, true>((PG8_LAS unsigned char*)lds, DM, S, E);
}
#define LAS __attribute__((address_space(3)))
#define CW_BAR 4096
#define XB_TMO      128
#define XB_XCNT(j)  (256  + 64 * (j))
#define XB_XSUB(j)  (1280 + 64 * (j))
#define XB_XGEN(j)  (2304 + 64 * (j))
#define XB_TOP      3328
#define XB_TOPGEN   3392
#define XCD_BAR_WORDS 3456
#define XB_SPIN_CAP (1u << 22)
__device__ __forceinline__ unsigned xb_ld(unsigned* p)              { return __hip_atomic_load(p, __ATOMIC_RELAXED, __HIP_MEMORY_SCOPE_AGENT); }
__device__ __forceinline__ unsigned xb_add(unsigned* p, unsigned v) { return __hip_atomic_fetch_add(p, v, __ATOMIC_RELAXED, __HIP_MEMORY_SCOPE_AGENT); }
__device__ __forceinline__ unsigned xb_xcc_id() { return (unsigned)__builtin_amdgcn_s_getreg((3 << 11) | 20) & 0xFu; }
#define XB_SPIN(cond, bar) do { unsigned _sp = 0; while (cond) { __builtin_amdgcn_s_sleep(1); \
    if ((++_sp & 255u) == 0u) { if (xb_ld(&(bar)[XB_TMO])) break; if (_sp > XB_SPIN_CAP) { atomicAdd(&(bar)[XB_TMO], 1u); break; } } } } while (0)
struct XcdBarrier { unsigned* bar; unsigned x; volatile LAS unsigned* st; };
__device__ __forceinline__ XcdBarrier xcd_barrier_post(unsigned* bar, volatile LAS unsigned* st) {
    XcdBarrier b; b.bar = bar; b.x = xb_xcc_id(); b.st = st;
    if (threadIdx.x == 0) (void)xb_add(&bar[XB_XCNT(b.x)], 1u);
    return b;
}
__device__ __forceinline__ void xcd_barrier_complete(unsigned* bar, unsigned x, unsigned& nloc, unsigned& nx) {
    const unsigned G = GRID;
    unsigned sum, cnt, mine, sp = 0u;
    for (;;) {
        sum = 0u; cnt = 0u; mine = 0u;
#pragma unroll
        for (unsigned j = 0; j < 16; ++j) { const unsigned c = xb_ld(&bar[XB_XCNT(j)]); sum += c; cnt += (c > 0u) ? 1u : 0u; mine = (j == x) ? c : mine; }
        if (sum == G) break;
        __builtin_amdgcn_s_sleep(1);
        if ((++sp & 255u) == 0u) { if (xb_ld(&bar[XB_TMO])) break; if (sp > XB_SPIN_CAP) { atomicAdd(&bar[XB_TMO], 1u); break; } }
    }
    nloc = mine > 0u ? mine : 1u; nx = cnt > 0u ? cnt : 1u;
}
__device__ __forceinline__ void xcd_barrier(const XcdBarrier& b) {
    asm volatile("s_waitcnt vmcnt(0)" ::: "memory");
    __syncthreads();
    if (threadIdx.x == 0) {
        unsigned* bar = b.bar;
        __builtin_amdgcn_s_waitcnt(0);
        unsigned nloc = b.st[0], nx = b.st[1];
        if (nloc == 0u) { xcd_barrier_complete(bar, b.x, nloc, nx); b.st[0] = nloc; b.st[1] = nx; }
        const unsigned old = xb_add(&bar[XB_XSUB(b.x)], 1u);
        const unsigned gen = old / nloc;
        if (old + 1u == (gen + 1u) * nloc) {
            __builtin_amdgcn_fence(__ATOMIC_RELEASE, "agent");
            asm volatile("s_waitcnt vmcnt(0)" ::: "memory");
            const unsigned og = xb_add(&bar[XB_TOP], 1u);
            const unsigned tg = og / nx;
            if (og + 1u == (tg + 1u) * nx) xb_add(&bar[XB_TOPGEN], 1u);
            else XB_SPIN(xb_ld(&bar[XB_TOPGEN]) == tg, bar);
            __builtin_amdgcn_fence(__ATOMIC_ACQUIRE, "agent");
            xb_add(&bar[XB_XGEN(b.x)], 1u);
            asm volatile("s_waitcnt vmcnt(0)" ::: "memory");
        } else {
            XB_SPIN(xb_ld(&bar[XB_XGEN(b.x)]) == gen, bar);
            __builtin_amdgcn_fence(__ATOMIC_ACQUIRE, "agent");
            asm volatile("s_waitcnt vmcnt(0)" ::: "memory");
        }
    }
    __syncthreads();
}


__global__ void __launch_bounds__(512, 2) mega(Params P_) {
    extern __shared__ __attribute__((aligned(16))) unsigned char lds[];
    volatile LAS unsigned* st = (volatile LAS unsigned*)(LAS unsigned char*)(lds + LDS_BARST);
    if (threadIdx.x < 16) st[threadIdx.x] = 0u;
    __syncthreads();
    CParams* pp = (CParams*)__builtin_amdgcn_kernarg_segment_ptr();
    (void)xcd_barrier_post((unsigned*)(pp->ws + WS_CTL) + CW_BAR, st);
#define GB do { XcdBarrier bar_; bar_.bar = (unsigned*)(pp->ws + WS_CTL) + CW_BAR; bar_.x = xb_xcc_id(); bar_.st = (volatile LAS unsigned*)(LAS unsigned char*)(lds + LDS_BARST); xcd_barrier(bar_); asm volatile("" : "+s"(pp)); } while (0)
#define P (*pp)
    asm volatile("" : "+s"(pp));
    phase_0(P, lds, 0); GB;
#if defined(PROBE_PH) && PROBE_PH == 0
    { int nrep = PROBE_N; asm volatile("" : "+s"(nrep)); for (int rep = 0; rep < nrep; ++rep) { GB; phase_0(P, lds, 0); GB; } }
#endif
    phase_1(P, lds, 1); GB;
#if defined(PROBE_PH) && PROBE_PH == 1
    { int nrep = PROBE_N; asm volatile("" : "+s"(nrep)); for (int rep = 0; rep < nrep; ++rep) { GB; phase_1(P, lds, 1); GB; } }
#endif
    phase_3(P, lds, 3); GB;
#if defined(PROBE_PH) && PROBE_PH == 3
    { int nrep = PROBE_N; asm volatile("" : "+s"(nrep)); for (int rep = 0; rep < nrep; ++rep) { GB; phase_3(P, lds, 3); GB; } }
#endif
    phase_6(P, lds, 6); GB;
    phase_60(P, lds, 60); GB;
#if defined(PROBE_PH) && PROBE_PH == 60
    { int nrep = PROBE_N; asm volatile("" : "+s"(nrep)); for (int rep = 0; rep < nrep; ++rep) { GB; phase_60(P, lds, 60); GB; } }
#endif
#if defined(PROBE_PH) && PROBE_PH == 6
    { int nrep = PROBE_N; asm volatile("" : "+s"(nrep)); for (int rep = 0; rep < nrep; ++rep) { GB; phase_6(P, lds, 6); GB; } }
#endif
    phase_7(P, lds, 7); GB;
#if defined(PROBE_PH) && PROBE_PH == 7
    { int nrep = PROBE_N; asm volatile("" : "+s"(nrep)); for (int rep = 0; rep < nrep; ++rep) { GB; phase_7(P, lds, 7); GB; } }
#endif
    phase_8(P, lds, 8); GB;
#if defined(PROBE_PH) && PROBE_PH == 8
    { int nrep = PROBE_N; asm volatile("" : "+s"(nrep)); for (int rep = 0; rep < nrep; ++rep) { GB; phase_8(P, lds, 8); GB; } }
#endif
    phase_9(P, lds, 9); GB;
#if defined(PROBE_PH) && PROBE_PH == 9
    { int nrep = PROBE_N; asm volatile("" : "+s"(nrep)); for (int rep = 0; rep < nrep; ++rep) { GB; phase_9(P, lds, 9); GB; } }
#endif
    phase_10(P, lds, 10); GB;
#if defined(PROBE_PH) && PROBE_PH == 10
    { int nrep = PROBE_N; asm volatile("" : "+s"(nrep)); for (int rep = 0; rep < nrep; ++rep) { GB; phase_10(P, lds, 10); GB; } }
#endif
    phase_11(P, lds, 11); GB;
#if defined(PROBE_PH) && PROBE_PH == 11
    { int nrep = PROBE_N; asm volatile("" : "+s"(nrep)); for (int rep = 0; rep < nrep; ++rep) { GB; phase_11(P, lds, 11); GB; } }
#endif
    phase_12(P, lds, 12); GB;
#if defined(PROBE_PH) && PROBE_PH == 12
    { int nrep = PROBE_N; asm volatile("" : "+s"(nrep)); for (int rep = 0; rep < nrep; ++rep) { GB; phase_12(P, lds, 12); GB; } }
#endif
    phase_13(P, lds, 13); GB;
#if defined(PROBE_PH) && PROBE_PH == 13
    { int nrep = PROBE_N; asm volatile("" : "+s"(nrep)); for (int rep = 0; rep < nrep; ++rep) { GB; phase_13(P, lds, 13); GB; } }
#endif
    phase_14(P, lds, 14); GB;
#if defined(PROBE_PH) && PROBE_PH == 14
    { int nrep = PROBE_N; asm volatile("" : "+s"(nrep)); for (int rep = 0; rep < nrep; ++rep) { GB; phase_14(P, lds, 14); GB; } }
#endif
    phase_15(P, lds, 15); GB;
#if defined(PROBE_PH) && PROBE_PH == 15
    { int nrep = PROBE_N; asm volatile("" : "+s"(nrep)); for (int rep = 0; rep < nrep; ++rep) { GB; phase_15(P, lds, 15); GB; } }
#endif
    phase_16(P, lds, 16); GB;
#if defined(PROBE_PH) && PROBE_PH == 16
    { int nrep = PROBE_N; asm volatile("" : "+s"(nrep)); for (int rep = 0; rep < nrep; ++rep) { GB; phase_16(P, lds, 16); GB; } }
#endif
    phase_22(P, lds, 22); GB;
#if defined(PROBE_PH) && PROBE_PH == 22
    { int nrep = PROBE_N; asm volatile("" : "+s"(nrep)); for (int rep = 0; rep < nrep; ++rep) { GB; phase_22(P, lds, 22); GB; } }
#endif
    phase_23(P, lds, 23); GB;
#if defined(PROBE_PH) && PROBE_PH == 23
    { int nrep = PROBE_N; asm volatile("" : "+s"(nrep)); for (int rep = 0; rep < nrep; ++rep) { GB; phase_23(P, lds, 23); GB; } }
#endif
    phase_9(P, lds, 17); GB;
#if defined(PROBE_PH) && PROBE_PH == 17
    { int nrep = PROBE_N; asm volatile("" : "+s"(nrep)); for (int rep = 0; rep < nrep; ++rep) { GB; phase_9(P, lds, 17); GB; } }
#endif
    phase_10(P, lds, 18); GB;
#if defined(PROBE_PH) && PROBE_PH == 18
    { int nrep = PROBE_N; asm volatile("" : "+s"(nrep)); for (int rep = 0; rep < nrep; ++rep) { GB; phase_10(P, lds, 18); GB; } }
#endif
    phase_11(P, lds, 19); GB;
#if defined(PROBE_PH) && PROBE_PH == 19
    { int nrep = PROBE_N; asm volatile("" : "+s"(nrep)); for (int rep = 0; rep < nrep; ++rep) { GB; phase_11(P, lds, 19); GB; } }
#endif
    phase_12(P, lds, 20); GB;
#if defined(PROBE_PH) && PROBE_PH == 20
    { int nrep = PROBE_N; asm volatile("" : "+s"(nrep)); for (int rep = 0; rep < nrep; ++rep) { GB; phase_12(P, lds, 20); GB; } }
#endif
    phase_13(P, lds, 21);
#if defined(PROBE_PH) && PROBE_PH == 21
    { int nrep = PROBE_N; asm volatile("" : "+s"(nrep)); for (int rep = 0; rep < nrep; ++rep) { GB; phase_13(P, lds, 21); GB; } }
#endif
#undef P
#undef GB
}

extern "C" void kernel_launch(void* const* d_in, const int* in_sizes, int n_in, void* d_out, int out_size, void* d_ws, size_t ws_size, hipStream_t stream) {
    static int ready = 0;
    if (!ready) {
        if (n_in != 35 || ws_size < WS_TOTAL) { fprintf(stderr, "kernel_launch: unexpected n_in %d or ws_size %zu (need %zu)\n", n_in, ws_size, (size_t)WS_TOTAL); ready = -1; return; }
        if (hipFuncSetAttribute((const void*)mega, hipFuncAttributeMaxDynamicSharedMemorySize, LDS_BYTES) != hipSuccess) { fprintf(stderr, "kernel_launch: hipFuncSetAttribute failed\n"); ready = -1; return; }
        ready = 1;
    }
    if (ready < 0) return;
    (void)hipMemsetAsync((char*)d_ws + WS_CTL, 0, 1 * MiB, stream);
    Params P{};
    for (int i = 0; i < 35; ++i) P.in[i] = (const float*)d_in[i];
    P.out = (float*)d_out; P.ws = (unsigned char*)d_ws; P.ph_lo = 0; P.ph_hi = 0;
    hipLaunchKernelGGL(mega, dim3(GRID), dim3(512), LDS_BYTES, stream, P);
}
```

```cpp
#include <hip/hip_runtime.h>
#include <stdint.h>
#include <stdio.h>

#define DM 1024
#define NB 2
#define SEQ 8192
#define NMETA 16
#define LSEQ (SEQ + NMETA)
#define NMAIN (NB * SEQ)
#define NT (NB * LSEQ)
#define NTP 16640
#define INCOLS 3328
#define RESTC 1792
#define NEXP 32
#define DFF 512
#define S5TC 48
#define S5NC 171
#define MOE_RT 256
#define MOE_MAXROWS 41216

typedef unsigned short bf16_t;
typedef short bf16x8 __attribute__((ext_vector_type(8)));
typedef float f32x4 __attribute__((ext_vector_type(4)));
typedef unsigned u32x4 __attribute__((ext_vector_type(4)));
typedef unsigned u32x2 __attribute__((ext_vector_type(2)));

constexpr size_t MiB = 1u << 20;
constexpr size_t cmax2(size_t a, size_t b) { return a > b ? a : b; }
constexpr size_t al64k(size_t x) { return (x + 65535) & ~(size_t)65535; }
constexpr size_t WS_CTL = 0;
constexpr size_t WS_H = 1 * MiB;
constexpr size_t WS_HN = WS_H + al64k((size_t)NT * DM * 2);
constexpr size_t WS_A2 = WS_HN + al64k((size_t)NTP * DM * 2);
constexpr size_t WS_WTIN = WS_A2 + al64k((size_t)NTP * DM * 2);
constexpr size_t WS_WTOUT = WS_WTIN + al64k((size_t)INCOLS * DM * 2);
constexpr size_t WS_WTGLU = WS_WTOUT + al64k((size_t)DM * DM * 2);
constexpr size_t WS_LRT = WS_WTGLU + al64k((size_t)2 * DM * DM * 2);
constexpr size_t WS_BIG = WS_LRT + al64k((size_t)(2 * 512 * 64 * 2 + 512 * 128) * 2);
constexpr size_t SZ_T512 = al64k((size_t)NT * 512 * 2);
constexpr size_t SZ_P512 = al64k((size_t)NTP * 512 * 2);
constexpr int RW_NCH = 129, RW_UNITS = 32 * RW_NCH;
constexpr size_t SZ_RWOP = al64k((size_t)RW_UNITS * 4096 * 2);
constexpr size_t WS_Q = WS_BIG;
constexpr size_t WS_K = WS_Q + SZ_P512;
constexpr size_t WS_V = WS_K + SZ_P512;
constexpr size_t WS_REST = WS_V + SZ_P512;
constexpr size_t WS_KR = WS_REST + al64k((size_t)NTP * RESTC * 2);
constexpr size_t WS_LOW = WS_KR + SZ_T512;
constexpr size_t WS_AA = WS_LOW + al64k((size_t)NT * 256 * 2);
constexpr size_t WS_XEARLY = WS_AA + 2 * SZ_T512;
constexpr size_t WS_PP = WS_REST;
constexpr size_t WS_QT = WS_PP + SZ_RWOP;
constexpr size_t WS_YT = WS_QT + SZ_RWOP;
constexpr size_t WS_ZT = WS_YT + SZ_RWOP;
constexpr size_t WS_XEND = cmax2(WS_XEARLY, WS_ZT + SZ_RWOP);
constexpr size_t WS_R = WS_XEND;
constexpr size_t WS_VV = WS_R + SZ_T512;
constexpr size_t WS_G = WS_VV + SZ_T512;
constexpr size_t WS_KK = WS_G + SZ_T512;
constexpr size_t WS_KKA = WS_KK + SZ_T512;
constexpr size_t WS_KD = WS_KKA + 2 * SZ_T512;
constexpr size_t WS_W = WS_KD + 2 * SZ_T512;
constexpr size_t WS_BC = WS_W + 2 * SZ_T512;
constexpr size_t WS_MIXEND = WS_BC + al64k((size_t)NT * 8 * 4);
constexpr size_t WS_YFB = WS_KK;
constexpr size_t WS_ROWTOK = WS_BIG;
constexpr size_t WS_HB = WS_ROWTOK + al64k((size_t)MOE_MAXROWS * 4);
constexpr size_t WS_YB = WS_HB + al64k((size_t)MOE_MAXROWS * DFF * 2);
constexpr size_t WS_WT13 = WS_YB + al64k((size_t)MOE_MAXROWS * DM * 2);
constexpr size_t WS_WT2 = WS_WT13 + al64k((size_t)NEXP * DM * DM * 2);
constexpr size_t WS_EID = WS_WT2 + al64k((size_t)NEXP * DM * DFF * 2);
constexpr size_t WS_POS = WS_EID + al64k((size_t)NT * 8);
constexpr size_t WS_DEST = WS_POS + al64k((size_t)NT * 8);
constexpr size_t WS_GATE = WS_DEST + al64k((size_t)NT * 8);
constexpr size_t WS_MOEEND = WS_GATE + al64k((size_t)NT * 8);
constexpr size_t WS_YI = WS_BIG;
constexpr size_t WS_E = WS_YI + al64k((size_t)NTP * DM * 2);
constexpr size_t WS_CAR = WS_E + al64k((size_t)1040 * 64 * 256 * 2);
constexpr size_t WS_BTA = WS_CAR + al64k((size_t)64 * 1280 * 256 * 2);
constexpr size_t WS_BTC = WS_BTA + al64k((size_t)64 * 512 * 256 * 2);
constexpr size_t WS_S5END = WS_BTC + al64k((size_t)64 * 256 * 256 * 2);
constexpr size_t cmax(size_t a, size_t b) { return a > b ? a : b; }
constexpr size_t WS_TOTAL = cmax(WS_MIXEND, cmax(WS_MOEEND, WS_S5END));
static_assert(WS_TOTAL <= 512 * MiB, "workspace map exceeds 512 MiB");

#define CW_CNT(l) (1024 + 64 * (l))

#define LDS_BYTES 163840
#define LDS_BARST (LDS_BYTES - 1024)
#define LDS_TAB (LDS_BYTES - 768)
#define LDS_RING (LDS_BYTES - 1024)
#define GRID 256

struct Params {
    const float* in[35];
    float* out;
    unsigned char* ws;
    int ph_lo, ph_hi;
};
typedef const __attribute__((address_space(4))) Params CParams;

__device__ __forceinline__ float bf2f(bf16_t v) { return __uint_as_float(((unsigned)v) << 16); }
typedef float f32x2c_ __attribute__((ext_vector_type(2)));
typedef __bf16 bf16x2c_ __attribute__((ext_vector_type(2)));
__device__ __forceinline__ unsigned pk2(float lo, float hi) { const f32x2c_ f = {lo, hi}; const bf16x2c_ b = __builtin_convertvector(f, bf16x2c_); return __builtin_bit_cast(unsigned, b); }
__device__ __forceinline__ unsigned f2bf(float f) { return (unsigned)__builtin_bit_cast(unsigned short, (__bf16)f); }
__device__ __forceinline__ float bflo(unsigned u) { return __uint_as_float(u << 16); }
__device__ __forceinline__ float bfhi(unsigned u) { return __uint_as_float(u & 0xffff0000u); }
__device__ __forceinline__ float wave_sum(float v) {
#pragma unroll
    for (int o = 1; o < 64; o <<= 1) v += __shfl_xor(v, o);
    return v;
}
__device__ __forceinline__ float wave_max(float v) {
#pragma unroll
    for (int o = 1; o < 64; o <<= 1) v = fmaxf(v, __shfl_xor(v, o));
    return v;
}
template <int CTRL> __device__ __forceinline__ float dppf(float v) { return __int_as_float(__builtin_amdgcn_update_dpp(0, __float_as_int(v), CTRL, 0xF, 0xF, true)); }
__device__ __forceinline__ float row16_sum(float v) { v += dppf<0xB1>(v); v += dppf<0x4E>(v); v += dppf<0x141>(v); v += dppf<0x140>(v); return v; }
__device__ __forceinline__ float sigmoidf_(float x) { return __builtin_amdgcn_rcpf(1.f + __expf(-x)); }
__device__ __forceinline__ int rowof(int b, int p) { return p < NMETA ? NMAIN + b * NMETA + p : b * SEQ + (p - NMETA); }

#define SA_STRIDE 40
template <class AF, class BF>
__device__ __forceinline__ void gemm_tile(unsigned char* lds, int K, int ldb, const AF& arow, const BF& bcol, f32x4 (&acc)[4][2]) {
    bf16_t* sA = (bf16_t*)lds;
    bf16_t* sB = (bf16_t*)(lds + 128 * SA_STRIDE * 2);
    const int tid = threadIdx.x, lane = tid & 63, wave = tid >> 6, wr = wave >> 2, wc = wave & 3, fr = lane & 15, fq = lane >> 4;
#pragma unroll
    for (int mi = 0; mi < 4; ++mi)
#pragma unroll
        for (int ni = 0; ni < 2; ++ni) acc[mi][ni] = (f32x4){0.f, 0.f, 0.f, 0.f};
    const int ar = tid >> 2, akc = (tid & 3) * 8;
    const bf16_t* ap = arow(ar) + akc;
    const int bnq = (tid & 31) * 4, bkp = (tid >> 5) * 2;
    const float* bp = bcol(bnq) + (size_t)bkp * ldb;
    const int nk = K / 32;
    u32x4 ra = *(const u32x4*)ap;
    f32x4 rb0 = *(const f32x4*)bp, rb1 = *(const f32x4*)(bp + ldb);
    for (int kt = 0; kt < nk; ++kt) {
        __syncthreads();
        *(u32x4*)(sA + ar * SA_STRIDE + akc) = ra;
        {
            unsigned* d = (unsigned*)(sB + bnq * SA_STRIDE + bkp);
            d[0 * (SA_STRIDE / 2)] = pk2(rb0[0], rb1[0]);
            d[1 * (SA_STRIDE / 2)] = pk2(rb0[1], rb1[1]);
            d[2 * (SA_STRIDE / 2)] = pk2(rb0[2], rb1[2]);
            d[3 * (SA_STRIDE / 2)] = pk2(rb0[3], rb1[3]);
        }
        __syncthreads();
        if (kt + 1 < nk) {
            ra = *(const u32x4*)(ap + (kt + 1) * 32);
            const float* q = bp + (size_t)(kt + 1) * 32 * ldb;
            rb0 = *(const f32x4*)q; rb1 = *(const f32x4*)(q + ldb);
        }
        bf16x8 a[4], b[2];
#pragma unroll
        for (int mi = 0; mi < 4; ++mi) a[mi] = *(const bf16x8*)(sA + (wr * 64 + mi * 16 + fr) * SA_STRIDE + fq * 8);
#pragma unroll
        for (int ni = 0; ni < 2; ++ni) b[ni] = *(const bf16x8*)(sB + (wc * 32 + ni * 16 + fr) * SA_STRIDE + fq * 8);
#pragma unroll
        for (int mi = 0; mi < 4; ++mi)
#pragma unroll
            for (int ni = 0; ni < 2; ++ni) acc[mi][ni] = __builtin_amdgcn_mfma_f32_16x16x32_bf16(a[mi], b[ni], acc[mi][ni], 0, 0, 0);
    }
    __syncthreads();
}
#define ACC_FOREACH(acc, ...) do { const int _l = threadIdx.x & 63, _w = threadIdx.x >> 6, _wr = _w >> 2, _wc = _w & 3, _fr = _l & 15, _fq = _l >> 4; \
    _Pragma("unroll") for (int _mi = 0; _mi < 4; ++_mi) _Pragma("unroll") for (int _ni = 0; _ni < 2; ++_ni) _Pragma("unroll") for (int _j = 0; _j < 4; ++_j) { \
        const int rl = _wr * 64 + _mi * 16 + _fq * 4 + _j, cl = _wc * 32 + _ni * 16 + _fr; const float val = acc[_mi][_ni][_j]; __VA_ARGS__ } } while (0)
#define ACC_FOREACH_PAIR(acc, ...) do { const int _l = threadIdx.x & 63, _w = threadIdx.x >> 6, _wr = _w >> 2, _wc = _w & 3, _fr = _l & 15, _fq = _l >> 4; \
    _Pragma("unroll") for (int _mi = 0; _mi < 4; ++_mi) _Pragma("unroll") for (int _j = 0; _j < 4; ++_j) { \
        const int rl = _wr * 64 + _mi * 16 + _fq * 4 + _j, co = _wc * 16 + _fr; const float va = acc[_mi][0][_j], vg = acc[_mi][1][_j]; __VA_ARGS__ } } while (0)

__device__ __forceinline__ void store_norm_bf16(const f32x4 (&v)[4], const float* gain, bf16_t* dst, int lane) {
    float ss = 0.f;
#pragma unroll
    for (int j = 0; j < 4; ++j) ss += v[j][0] * v[j][0] + v[j][1] * v[j][1] + v[j][2] * v[j][2] + v[j][3] * v[j][3];
    ss = wave_sum(ss);
    const float rstd = rsqrtf(ss * (1.f / DM) + 1e-6f);
#pragma unroll
    for (int j = 0; j < 4; ++j) {
        const f32x4 g = ((const f32x4*)gain)[lane + 64 * j];
        u32x2 o; o.x = pk2(v[j][0] * rstd * g[0], v[j][1] * rstd * g[1]); o.y = pk2(v[j][2] * rstd * g[2], v[j][3] * rstd * g[3]);
        ((u32x2*)dst)[lane + 64 * j] = o;
    }
}


__device__ __forceinline__ f32x4 ldrow_bf16(const bf16_t* row, int lane, int j) { const u32x2 u = ((const u32x2*)row)[lane + 64 * j]; return (f32x4){bflo(u.x), bfhi(u.x), bflo(u.y), bfhi(u.y)}; }
__device__ __forceinline__ void strow_bf16(bf16_t* row, int lane, int j, const f32x4 v) { u32x2 o; o.x = pk2(v[0], v[1]); o.y = pk2(v[2], v[3]); ((u32x2*)row)[lane + 64 * j] = o; }
namespace pg8 {
#define PG8_LAS __attribute__((address_space(3)))
constexpr int BM = 256, BK = 64, HALF = 128, HTB = HALF * BK * 2  , STAGE_BYTES = 8 * HTB, NXCD = 8, WGM = 8;
__host__ __device__ __forceinline__ int lds_byte(int r, int c) { const int st = (r >> 4) * 2 + (c >> 5), rr = r & 15, cc = c & 31, ob = rr * 64 + cc * 2; return st * 1024 + (ob ^ (((ob >> 9) & 1) << 5)); }
__host__ __device__ __forceinline__ void stage_rc(int b, int& R, int& C) { const int st = b / 1024, sb = b % 1024, swz = sb ^ (((sb >> 9) & 1) << 5); R = (st >> 1) * 16 + swz / 64; C = (st & 1) * 32 + (swz % 64) / 2; }
__host__ __device__ __forceinline__ int perm32(int rho) { const int n = rho >> 4, i = rho & 15; return 8 * (i >> 2) + 4 * n + (i & 3); }

struct Unit { int pm, pn; const char* A; const char* B; };

struct DenseOrder {
    static constexpr bool GATHER_ROWS = false;
    static constexpr bool GATHER_A = false;
    int nM, nN, nwg, G, c; const char* A; const char* Bt; size_t tstep;
    __device__ void init(const bf16_t* A_, const bf16_t* Bt_, int M, int N, int K, int G_, int c_) { nM = M / BM; nN = N / BM; nwg = nM * nN; G = G_; c = c_; A = (const char*)A_; Bt = (const char*)Bt_; tstep = (size_t)BM * K * 2; }
    __device__ bool next(int i, Unit& u) const {
        const long L = (long)i * G + c; if (L >= nwg) return false;
        int wgid = (int)L; { const int q = nwg / NXCD, r = nwg % NXCD, xcd = wgid % NXCD, off = wgid / NXCD; wgid = (xcd < r ? xcd * (q + 1) : r * (q + 1) + (xcd - r) * q) + off; }
        const int nig = WGM * nN, gid = wgid / nig, fm = gid * WGM, gsz = (nM - fm) < WGM ? (nM - fm) : WGM;
        u.pm = fm + ((wgid % nig) % gsz); u.pn = (wgid % nig) / gsz; u.A = A + (size_t)u.pm * tstep; u.B = Bt + (size_t)u.pn * tstep; return true;
    }
    __device__ __forceinline__ void a_ready(const Unit&) const {}
    __device__ __forceinline__ void done(const Unit&) const {}
};
struct ProjOrder {
    static constexpr bool GATHER_ROWS = false;
    static constexpr bool GATHER_A = false;
    DenseOrder D; const char* HNp; const char* WT;
    __device__ void init(const bf16_t* HN_, const bf16_t* WT_, int c_) { D.init(HN_, WT_, NTP, 13 * BM, DM, GRID, c_); HNp = (const char*)HN_; WT = (const char*)WT_; }
    __device__ bool next(int i, Unit& u) const {
        if (!D.next(i, u)) return false;
        const size_t ts = (size_t)BM * DM * 2;
        if (u.pn < 11) { const int wrow = u.pn < 4 ? u.pn : u.pn + 2; u.A = HNp + (size_t)u.pm * ts; u.B = WT + (size_t)wrow * ts; }
        else { u.A = WT + (size_t)(4 + (u.pn - 11)) * ts; u.B = HNp + (size_t)u.pm * ts; }
        return true;
    }
    __device__ __forceinline__ void a_ready(const Unit&) const {}
    __device__ __forceinline__ void done(const Unit&) const {}
};
template <bool GATHER> struct MoeOrder {
    static constexpr bool GATHER_ROWS = GATHER;
    static constexpr bool GATHER_A = false;
    const int* et; int TT, vcu; const char* A; const char* Bt; unsigned tstepA, tstepB, estep; const int* rowidx;
    __device__ __forceinline__ bool next(int i, Unit& u) const {
        const int L = i * GRID + vcu; if (L >= TT * 4) return false;
        const int rt = L >> 2, ct = L & 3, e = et[rt];
        u.pm = rt; u.pn = ct; u.A = GATHER ? A : A + (size_t)rt * tstepA; u.B = Bt + (size_t)e * estep + (size_t)ct * tstepB; return true;
    }
    __device__ __forceinline__ void a_ready(const Unit&) const {}
    __device__ __forceinline__ void done(const Unit&) const {}
};

struct S5OrderA {
    static constexpr bool GATHER_ROWS = false;
    static constexpr bool GATHER_A = true;
    int vcu; const char* U; const char* BTA;
    __device__ __forceinline__ bool next(int i, Unit& u) const {
        const int L = i * GRID + vcu; if (L >= 640) return false;
        const int g = L / 10, rem = L - g * 10, mt = rem >> 1, nt = rem & 1;
        u.pm = mt; u.pn = g * 2 + nt; u.A = U + ((size_t)mt * 256 * 16 * 1024 + g * 16) * 2; u.B = BTA + ((size_t)(g * 512 + nt * 256) * 256) * 2; return true;
    }
    __device__ __forceinline__ void a_ready(const Unit&) const {}
    __device__ __forceinline__ void done(const Unit&) const {}
};
struct S5OrderC {
    static constexpr bool GATHER_ROWS = false;
    static constexpr bool GATHER_A = false;
    int vcu; const char* CAR; const char* BTC;
    __device__ __forceinline__ bool next(int i, Unit& u) const {
        const int L = i * GRID + vcu; if (L >= 320) return false;
        const int g = L / 5, mt = L - g * 5;
        u.pm = mt; u.pn = g; u.A = CAR + ((size_t)(g * 1280 + mt * 256) * 256) * 2; u.B = BTC + ((size_t)g * 256 * 256) * 2; return true;
    }
    __device__ __forceinline__ void a_ready(const Unit&) const {}
    __device__ __forceinline__ void done(const Unit&) const {}
};
__device__ __forceinline__ unsigned cvt_pk_bf16(float lo, float hi) { return pk2(lo, hi); }

struct EpiProj {
    static constexpr bool PERM = true, AFTER_DRAIN = false;
    bf16_t *Q, *Kk, *VT, *REST;
    __device__ __forceinline__ void operator()(const f32x4 (&acc)[2][2][4][2], const Unit& u, int wr, int wc, int fr, int fq) const {
        bf16_t* base; int ldc; int row0, col0;
        if (u.pn < 11) { row0 = u.pm * BM + wr * 64 + fr; int colt;
            if (u.pn < 2) { base = Q; colt = u.pn * BM; ldc = 512; } else if (u.pn < 4) { base = Kk; colt = (u.pn - 2) * BM; ldc = 512; } else { base = REST; colt = (u.pn - 4) * BM; ldc = RESTC; }
            col0 = colt + wc * 32 + 8 * fq; }
        else { base = VT; ldc = NTP; row0 = (u.pn - 11) * BM + wr * 64 + fr; col0 = u.pm * BM + wc * 32 + 8 * fq; }
#pragma unroll
        for (int ai = 0; ai < 2; ++ai)
#pragma unroll
            for (int m = 0; m < 4; ++m) { bf16_t* rowp = base + (size_t)(row0 + ai * HALF + m * 16) * ldc + col0;
#pragma unroll
                for (int bj = 0; bj < 2; ++bj) { const f32x4 v0 = acc[ai][bj][m][0], v1 = acc[ai][bj][m][1];
                    u32x4 w; w.x = cvt_pk_bf16(v0[0], v0[1]); w.y = cvt_pk_bf16(v0[2], v0[3]); w.z = cvt_pk_bf16(v1[0], v1[1]); w.w = cvt_pk_bf16(v1[2], v1[3]);
                    *(u32x4*)(rowp + bj * HALF) = w; } }
    }
};
struct EpiBf16Plain {
    static constexpr bool PERM = true, AFTER_DRAIN = false;
    bf16_t* O; int ldc;
    __device__ __forceinline__ void operator()(const f32x4 (&acc)[2][2][4][2], const Unit& u, int wr, int wc, int fr, int fq) const {
        const int row0 = u.pm * BM + wr * 64 + fr; const int col0 = u.pn * BM + wc * 32 + 8 * fq;
#pragma unroll
        for (int ai = 0; ai < 2; ++ai)
#pragma unroll
            for (int m = 0; m < 4; ++m) { bf16_t* rowp = O + (size_t)(row0 + ai * HALF + m * 16) * ldc + col0;
#pragma unroll
                for (int bj = 0; bj < 2; ++bj) { const f32x4 v0 = acc[ai][bj][m][0], v1 = acc[ai][bj][m][1];
                    u32x4 w; w.x = cvt_pk_bf16(v0[0], v0[1]); w.y = cvt_pk_bf16(v0[2], v0[3]); w.z = cvt_pk_bf16(v1[0], v1[1]); w.w = cvt_pk_bf16(v1[2], v1[3]);
                    *(u32x4*)(rowp + bj * HALF) = w; } }
    }
};
struct EpiSwiglu {
    static constexpr bool PERM = true, AFTER_DRAIN = false;
    bf16_t* O;
    __device__ __forceinline__ void operator()(const f32x4 (&acc)[2][2][4][2], const Unit& u, int wr, int wc, int fr, int fq) const {
        const int row0 = u.pm * BM + wr * 64 + fr; const int col0 = u.pn * HALF + wc * 32 + 8 * fq;
#pragma unroll
        for (int ai = 0; ai < 2; ++ai)
#pragma unroll
            for (int m = 0; m < 4; ++m) {
                float o[8];
#pragma unroll
                for (int n = 0; n < 2; ++n)
#pragma unroll
                    for (int i = 0; i < 4; ++i) { const float va = acc[ai][0][m][n][i], vg = acc[ai][1][m][n][i]; o[4 * n + i] = va * __builtin_amdgcn_rcpf(1.f + __expf(-va)) * vg; }
                u32x4 w; w.x = cvt_pk_bf16(o[0], o[1]); w.y = cvt_pk_bf16(o[2], o[3]); w.z = cvt_pk_bf16(o[4], o[5]); w.w = cvt_pk_bf16(o[6], o[7]);
                *(u32x4*)(O + (size_t)(row0 + ai * HALF + m * 16) * DFF + col0) = w; }
    }
};
struct EpiResidual {
    static constexpr bool PERM = true, AFTER_DRAIN = false;
    bf16_t* Hh;
    __device__ __forceinline__ void operator()(const f32x4 (&acc)[2][2][4][2], const Unit& u, int wr, int wc, int fr, int fq) const {
        const int row0 = u.pm * BM + wr * 64 + fr; const int col0 = u.pn * BM + wc * 32 + 8 * fq;
#pragma unroll
        for (int ai = 0; ai < 2; ++ai)
#pragma unroll
            for (int m = 0; m < 4; ++m) { bf16_t* rowp = Hh + (size_t)(row0 + ai * HALF + m * 16) * DM + col0;
#pragma unroll
                for (int bj = 0; bj < 2; ++bj) { u32x4* p = (u32x4*)(rowp + bj * HALF); const u32x4 hv = *p; const f32x4 v0 = acc[ai][bj][m][0], v1 = acc[ai][bj][m][1];
                    u32x4 w; w.x = cvt_pk_bf16(__uint_as_float(hv.x << 16) + v0[0], __uint_as_float(hv.x & 0xffff0000u) + v0[1]); w.y = cvt_pk_bf16(__uint_as_float(hv.y << 16) + v0[2], __uint_as_float(hv.y & 0xffff0000u) + v0[3]);
                    w.z = cvt_pk_bf16(__uint_as_float(hv.z << 16) + v1[0], __uint_as_float(hv.z & 0xffff0000u) + v1[1]); w.w = cvt_pk_bf16(__uint_as_float(hv.w << 16) + v1[2], __uint_as_float(hv.w & 0xffff0000u) + v1[3]);
                    *p = w; } }
    }
};
struct EpiGlu {
    static constexpr bool PERM = true, AFTER_DRAIN = false;
    bf16_t* Hh;
    __device__ __forceinline__ void operator()(const f32x4 (&acc)[2][2][4][2], const Unit& u, int wr, int wc, int fr, int fq) const {
        const int row0 = u.pm * BM + wr * 64 + fr; const int col0 = u.pn * HALF + wc * 32 + 8 * fq;
#pragma unroll
        for (int ai = 0; ai < 2; ++ai)
#pragma unroll
            for (int m = 0; m < 4; ++m) { u32x4* p = (u32x4*)(Hh + (size_t)(row0 + ai * HALF + m * 16) * DM + col0); const u32x4 hv = *p;
                float o[8];
#pragma unroll
                for (int n = 0; n < 2; ++n)
#pragma unroll
                    for (int i = 0; i < 4; ++i) { const unsigned hw = hv[2 * n + (i >> 1)]; const float hcur = (i & 1) ? __uint_as_float(hw & 0xffff0000u) : __uint_as_float(hw << 16);
                        o[4 * n + i] = hcur + acc[ai][0][m][n][i] * __builtin_amdgcn_rcpf(1.f + __expf(-acc[ai][1][m][n][i])); }
                u32x4 w; w.x = cvt_pk_bf16(o[0], o[1]); w.y = cvt_pk_bf16(o[2], o[3]); w.z = cvt_pk_bf16(o[4], o[5]); w.w = cvt_pk_bf16(o[6], o[7]);
                *p = w; }
    }
};
struct EpiS5A {
    static constexpr bool PERM = true, AFTER_DRAIN = false;
    bf16_t* YI; bf16_t* E;
    __device__ __forceinline__ void operator()(const f32x4 (&acc)[2][2][4][2], const Unit& u, int wr, int wc, int fr, int fq) const {
        const int g = u.pn >> 1, nt = u.pn & 1;
        const int cl0 = wc * 32 + 8 * fq;
        bf16_t* base = nt == 0 ? YI + (size_t)(cl0 >> 4) * DM + g * 16 + (cl0 & 15) : E + (size_t)g * 256 + cl0;
        const size_t nstride = 16 * DM;
        const size_t bjstep = nt == 0 ? (size_t)8 * DM : (size_t)HALF;
#pragma unroll
        for (int ai = 0; ai < 2; ++ai)
#pragma unroll
            for (int m = 0; m < 4; ++m) { int n = u.pm * BM + ai * HALF + wr * 64 + m * 16 + fr; n = n < 1039 ? n : 1039;
                bf16_t* p = base + (size_t)n * nstride;
#pragma unroll
                for (int bj = 0; bj < 2; ++bj) { const f32x4 v0 = acc[ai][bj][m][0], v1 = acc[ai][bj][m][1];
                    u32x4 w; w.x = cvt_pk_bf16(v0[0], v0[1]); w.y = cvt_pk_bf16(v0[2], v0[3]); w.z = cvt_pk_bf16(v1[0], v1[1]); w.w = cvt_pk_bf16(v1[2], v1[3]);
                    *(u32x4*)(p + bj * bjstep) = w; } }
    }
};
struct EpiS5C {
    static constexpr bool PERM = true, AFTER_DRAIN = false;
    const bf16_t* YI; const bf16_t* Uu; const float* dvec; bf16_t* O;
    __device__ __forceinline__ void operator()(const f32x4 (&acc)[2][2][4][2], const Unit& u, int wr, int wc, int fr, int fq) const {
        const int g = u.pn;
        const int cl0 = wc * 32 + 8 * fq, ch = g * 16 + (cl0 & 15);
        const size_t off0 = (size_t)(cl0 >> 4) * DM + ch;
        const f32x4 d0 = *(const f32x4*)(dvec + ch), d1 = *(const f32x4*)(dvec + ch + 4);
#pragma unroll
        for (int ai = 0; ai < 2; ++ai)
#pragma unroll
            for (int m = 0; m < 4; ++m) { int n = u.pm * BM + ai * HALF + wr * 64 + m * 16 + fr; n = n < 1039 ? n : 1039;
#pragma unroll
                for (int bj = 0; bj < 2; ++bj) {
                    const size_t off = off0 + (size_t)n * (16 * DM) + (size_t)bj * (8 * DM);
                    const u32x4 yv = *(const u32x4*)(YI + off);
                    const f32x4 y0 = (f32x4){__uint_as_float(yv[0] << 16), __uint_as_float(yv[0] & 0xffff0000u), __uint_as_float(yv[1] << 16), __uint_as_float(yv[1] & 0xffff0000u)},
                                y1 = (f32x4){__uint_as_float(yv[2] << 16), __uint_as_float(yv[2] & 0xffff0000u), __uint_as_float(yv[3] << 16), __uint_as_float(yv[3] & 0xffff0000u)};
                    const u32x4 uv = *(const u32x4*)(Uu + off);
                    float y[8];
#pragma unroll
                    for (int q = 0; q < 4; ++q) { y[q] = acc[ai][bj][m][0][q] + y0[q] + d0[q] * (q & 1 ? __uint_as_float(uv[q >> 1] & 0xffff0000u) : __uint_as_float(uv[q >> 1] << 16));
                        y[4 + q] = acc[ai][bj][m][1][q] + y1[q] + d1[q] * (q & 1 ? __uint_as_float(uv[2 + (q >> 1)] & 0xffff0000u) : __uint_as_float(uv[2 + (q >> 1)] << 16)); }
#pragma unroll
                    for (int q = 0; q < 8; ++q) { const float z = 1.5957691216f * (y[q] + 0.044715f * y[q] * y[q] * y[q]); y[q] = y[q] * __builtin_amdgcn_rcpf(1.f + __expf(-z)); }
                    u32x4 w; w.x = cvt_pk_bf16(y[0], y[1]); w.y = cvt_pk_bf16(y[2], y[3]); w.z = cvt_pk_bf16(y[4], y[5]); w.w = cvt_pk_bf16(y[6], y[7]);
                    *(u32x4*)(O + off) = w; }
                asm volatile("" ::: "memory"); }
    }
};

template <class Epi, class Sched, bool ALIGN_EPI = false, bool SP2 = false>
__device__ __forceinline__ void gemm_phase(PG8_LAS unsigned char* lds, const int K, const Sched& S, const Epi& E) {
    int tid_ = threadIdx.x; asm volatile("" : "+v"(tid_));
    const int tid = tid_, wid = __builtin_amdgcn_readfirstlane(tid >> 6), lane = tid & 63, wr = wid >> 2, wc = wid & 3, fr = lane & 15, fq = lane >> 4;
    const int nt = K / BK;
    unsigned vA0[2], vA1[2], nA0[2], nA1[2], voffB[2];
#pragma unroll
    for (int i = 0; i < 2; ++i) { int R, C; stage_rc(tid * 16 + i * 8192, R, C); const int Rb = Epi::PERM ? ((R & ~31) + perm32(R & 31)) : R;
        vA0[i] = Sched::GATHER_A ? (unsigned)(((16 * R + (C >> 4)) * 1024 + (C & 15)) * 2) : (unsigned)(R * K + C) * 2u; voffB[i] = (unsigned)(Rb * K + C) * 2u; }
    const size_t kstep = (size_t)(BK * 2);
    const size_t hstep = (size_t)HALF * K * 2;
    const size_t kstepA = Sched::GATHER_A ? (size_t)(4 * 1024 * 2) : kstep, hstepA = Sched::GATHER_A ? (size_t)HALF * 16 * 1024 * 2 : hstep;
#define PG8_ROWOFFS(u_, d0_, d1_) do { _Pragma("unroll") for (int i_ = 0; i_ < 2; ++i_) { int R_, C_; stage_rc(tid * 16 + i_ * 8192, R_, C_); \
        d0_[i_] = (unsigned)(S.rowidx[(u_).pm * BM + R_] * K + C_) * 2u; d1_[i_] = (unsigned)(S.rowidx[(u_).pm * BM + HALF + R_] * K + C_) * 2u; } } while (0)
#define PG8_STAGE_A(bufoff, gbase, h_, nx_) do { _Pragma("unroll") for (int _i = 0; _i < 2; ++_i) { const unsigned vo_ = (nx_) ? ((h_) ? nA1[_i] : nA0[_i]) : ((h_) ? vA1[_i] : vA0[_i]); \
        __builtin_amdgcn_global_load_lds((const unsigned*)((const char*)(gbase) + vo_), (PG8_LAS unsigned*)(lds + (bufoff) + ldsw + _i * 8192), 16, 0, 0); } } while (0)
    const unsigned ldsw = (unsigned)wid * 1024u;
    const int aoff = lds_byte(wr * 64 + fr, fq * 8), boff = lds_byte(wc * 32 + fr, fq * 8);
#define PG8_SA(b, h) (((b) * 2 + (h)) * HTB)
#define PG8_SB(b, h) ((4 + (b) * 2 + (h)) * HTB)
#define PG8_STAGE(bufoff, gbase, voff) do { _Pragma("unroll") for (int _i = 0; _i < 2; ++_i) \
        __builtin_amdgcn_global_load_lds((const unsigned*)((const char*)(gbase) + (voff)[_i]), (PG8_LAS unsigned*)(lds + (bufoff) + ldsw + _i * 8192), 16, 0, 0); } while (0)
#define PG8_LDA(dst, b, h) do { _Pragma("unroll") for (int m = 0; m < 4; ++m) _Pragma("unroll") for (int k = 0; k < 2; ++k) dst[m][k] = *(const PG8_LAS bf16x8*)(lds + PG8_SA(b, h) + aoff + m * 2048 + k * 1024); } while (0)
#define PG8_LDB(dst, b, h) do { _Pragma("unroll") for (int n = 0; n < 2; ++n) _Pragma("unroll") for (int k = 0; k < 2; ++k) dst[n][k] = *(const PG8_LAS bf16x8*)(lds + PG8_SB(b, h) + boff + n * 2048 + k * 1024); } while (0)
#define PG8_MMA(ai, bj, At, Bt) do { __builtin_amdgcn_s_setprio(1); _Pragma("unroll") for (int m = 0; m < 4; ++m) _Pragma("unroll") for (int n = 0; n < 2; ++n) _Pragma("unroll") for (int k = 0; k < 2; ++k) \
        acc[ai][bj][m][n] = __builtin_amdgcn_mfma_f32_16x16x32_bf16(Bt[n][k], At[m][k], acc[ai][bj][m][n], 0, 0, 0); __builtin_amdgcn_s_setprio(0); } while (0)
#define PG8_WAIT_V(n) asm volatile("s_waitcnt vmcnt(" #n ")" ::: "memory")
#define PG8_WAIT_L(n) asm volatile("s_waitcnt lgkmcnt(" #n ")" ::: "memory")
#define PG8_BAR __builtin_amdgcn_s_barrier()
#define PG8_SCHED __builtin_amdgcn_sched_barrier(0)
    Unit cur, nxt; int ui = 0;
    if (!S.next(0, cur)) return;
    f32x4 acc[2][2][4][2];
#pragma unroll
    for (int a = 0; a < 2; ++a)
#pragma unroll
        for (int b = 0; b < 2; ++b)
#pragma unroll
            for (int m = 0; m < 4; ++m)
#pragma unroll
                for (int n = 0; n < 2; ++n) acc[a][b][m][n] = (f32x4){0.f, 0.f, 0.f, 0.f};
    bf16x8 At[4][2], B0[2][2], B1[2][2];
    const char* cA = cur.A; const char* cB = cur.B;
    if constexpr (Sched::GATHER_ROWS) { PG8_ROWOFFS(cur, vA0, vA1); }
    else {
#pragma unroll
        for (int i = 0; i < 2; ++i) vA1[i] = vA0[i] + (unsigned)hstepA;
    }
#pragma unroll
    for (int i = 0; i < 2; ++i) { nA0[i] = vA0[i]; nA1[i] = vA1[i]; }
    S.a_ready(cur);
    if constexpr (SP2) {
        PG8_STAGE(PG8_SB(0, 0), cB, voffB); PG8_STAGE(PG8_SB(0, 1), cB + hstep, voffB); PG8_STAGE_A(PG8_SA(0, 0), cA, 0, false); PG8_STAGE_A(PG8_SA(0, 1), cA, 1, false);
        if (wr == 1) PG8_BAR;
        PG8_WAIT_V(2); PG8_BAR;
        PG8_STAGE(PG8_SB(1, 0), cB + kstep, voffB); PG8_STAGE_A(PG8_SA(1, 0), cA + kstepA, 0, false); PG8_STAGE(PG8_SB(1, 1), cB + hstep + kstep, voffB);
        PG8_WAIT_V(6); PG8_BAR;
    } else {
        PG8_STAGE(PG8_SB(0, 0), cB, voffB); PG8_STAGE_A(PG8_SA(0, 0), cA, 0, false); PG8_STAGE(PG8_SB(0, 1), cB + hstep, voffB); PG8_STAGE_A(PG8_SA(0, 1), cA, 1, false);
        if (wr == 1) PG8_BAR;
        PG8_WAIT_V(4); PG8_BAR;
        PG8_STAGE(PG8_SB(1, 0), cB + kstep, voffB); PG8_STAGE_A(PG8_SA(1, 0), cA + kstepA, 0, false); PG8_STAGE(PG8_SB(1, 1), cB + hstep + kstep, voffB);
        PG8_WAIT_V(6); PG8_BAR;
    }
    for (;;) {
        const bool has_next = S.next(ui + 1, nxt);
        if constexpr (Sched::GATHER_ROWS) { if (has_next) PG8_ROWOFFS(nxt, nA0, nA1); }
        const char* nA = has_next ? nxt.A : cA; const char* nB = has_next ? nxt.B : cB;
        for (int t = 0; t < nt; t += 2) {
            const bool last = (t == nt - 2);
            const char* a1 = cA + (size_t)(t + 1) * kstepA;
            const char* a2 = last ? nA : cA + (size_t)(t + 2) * kstepA; const char* b2 = last ? nB : cB + (size_t)(t + 2) * kstep;
            const char* a3 = a2 + kstepA; const char* b3 = b2 + kstep;
            if (last && has_next) S.a_ready(nxt);
            if constexpr (SP2) {
            PG8_LDB(B0, 0, 0); PG8_LDB(B1, 0, 1); PG8_SCHED; PG8_LDA(At, 0, 0); PG8_STAGE_A(PG8_SA(1, 1), a1, 1, false);
            PG8_WAIT_V(8); PG8_WAIT_L(0); PG8_BAR; PG8_MMA(0, 0, At, B0); PG8_MMA(0, 1, At, B1); PG8_BAR; PG8_SCHED;
            PG8_LDA(At, 0, 1); PG8_STAGE(PG8_SB(0, 0), b2, voffB); PG8_STAGE(PG8_SB(0, 1), b2 + hstep, voffB); PG8_STAGE_A(PG8_SA(0, 0), a2, 0, last);
            PG8_WAIT_V(8); PG8_WAIT_L(0); PG8_BAR; PG8_MMA(1, 0, At, B0); PG8_MMA(1, 1, At, B1); PG8_BAR; PG8_SCHED;
            PG8_LDB(B0, 1, 0); PG8_LDB(B1, 1, 1); PG8_SCHED; PG8_LDA(At, 1, 0); PG8_STAGE_A(PG8_SA(0, 1), a2, 1, last);
            PG8_WAIT_V(8); PG8_WAIT_L(0); PG8_BAR; PG8_MMA(0, 0, At, B0); PG8_MMA(0, 1, At, B1); PG8_BAR; PG8_SCHED;
            PG8_LDA(At, 1, 1); PG8_STAGE(PG8_SB(1, 0), b3, voffB); PG8_STAGE(PG8_SB(1, 1), b3 + hstep, voffB); PG8_STAGE_A(PG8_SA(1, 0), a3, 0, last);
            PG8_WAIT_V(8); PG8_WAIT_L(0); PG8_BAR; PG8_MMA(1, 0, At, B0); PG8_MMA(1, 1, At, B1); PG8_BAR; PG8_SCHED;
            } else {
            PG8_LDB(B0, 0, 0); PG8_SCHED; PG8_LDA(At, 0, 0); PG8_STAGE_A(PG8_SA(1, 1), a1, 1, false);
            PG8_WAIT_L(8); PG8_BAR; PG8_WAIT_L(0); PG8_MMA(0, 0, At, B0); PG8_BAR; PG8_SCHED;
            PG8_LDB(B1, 0, 1); PG8_STAGE(PG8_SB(0, 0), b2, voffB);
            PG8_BAR; PG8_WAIT_L(0); PG8_MMA(0, 1, At, B1); PG8_BAR;
            PG8_LDA(At, 0, 1); PG8_STAGE_A(PG8_SA(0, 0), a2, 0, last);
            PG8_BAR; PG8_WAIT_L(0); PG8_MMA(1, 0, At, B0); PG8_BAR; PG8_SCHED;
            PG8_STAGE(PG8_SB(0, 1), b2 + hstep, voffB);
            PG8_WAIT_V(6); PG8_BAR; PG8_MMA(1, 1, At, B1); PG8_BAR;
            PG8_LDB(B0, 1, 0); PG8_SCHED; PG8_LDA(At, 1, 0); PG8_STAGE_A(PG8_SA(0, 1), a2, 1, last);
            PG8_WAIT_L(8); PG8_BAR; PG8_WAIT_L(0); PG8_MMA(0, 0, At, B0); PG8_BAR; PG8_SCHED;
            PG8_LDB(B1, 1, 1); PG8_STAGE(PG8_SB(1, 0), b3, voffB);
            PG8_BAR; PG8_WAIT_L(0); PG8_MMA(0, 1, At, B1); PG8_BAR;
            PG8_LDA(At, 1, 1); PG8_STAGE_A(PG8_SA(1, 0), a3, 0, last);
            PG8_BAR; PG8_WAIT_L(0); PG8_MMA(1, 0, At, B0); PG8_BAR; PG8_SCHED;
            PG8_STAGE(PG8_SB(1, 1), b3 + hstep, voffB);
            PG8_WAIT_V(6); PG8_BAR; PG8_MMA(1, 1, At, B1); PG8_BAR;
            }
        }
        if constexpr (ALIGN_EPI) { if (wr == 0) PG8_BAR; }
        if constexpr (!Epi::AFTER_DRAIN) { E(acc, cur, wr, wc, fr, fq); S.done(cur); }
        if (!has_next) break;
#pragma unroll
        for (int a = 0; a < 2; ++a)
#pragma unroll
            for (int b = 0; b < 2; ++b)
#pragma unroll
                for (int m = 0; m < 4; ++m)
#pragma unroll
                    for (int n = 0; n < 2; ++n) acc[a][b][m][n] = (f32x4){0.f, 0.f, 0.f, 0.f};
        cur = nxt; cA = nA; cB = nB; ++ui;
        if constexpr (Sched::GATHER_ROWS) {
#pragma unroll
            for (int i = 0; i < 2; ++i) { vA0[i] = nA0[i]; vA1[i] = nA1[i]; } }
        if constexpr (ALIGN_EPI) { if (wr == 1) PG8_BAR; }
    }
    PG8_WAIT_V(0);
    if constexpr (!ALIGN_EPI) { if (wr == 0) PG8_BAR; }
    PG8_BAR;
    if constexpr (Epi::AFTER_DRAIN) { E.fused(acc, cur, wr, wc, fr, fq, lds, wid, lane); S.done(cur); }
#undef PG8_SA
#undef PG8_SB
#undef PG8_STAGE
#undef PG8_STAGE_A
#undef PG8_ROWOFFS
#undef PG8_LDA
#undef PG8_LDB
#undef PG8_MMA
#undef PG8_WAIT_V
#undef PG8_WAIT_L
#undef PG8_BAR
#undef PG8_SCHED
}
}

#define PHASE_PROLOGUE \
    int tid_ = threadIdx.x; asm volatile("" : "+v"(tid_)); const int tid = tid_, lane = tid & 63, wave = tid >> 6; \
    const int G = GRID, bid = blockIdx.x; \
    const int gw = bid * 8 + wave, NGW = G * 8; \
    unsigned char* ws = P.ws; \
    bf16_t* H = (bf16_t*)(ws + WS_H); \
    bf16_t* HN = (bf16_t*)(ws + WS_HN); \
    bf16_t* A2 = (bf16_t*)(ws + WS_A2); \
    bf16_t* Qb = (bf16_t*)(ws + WS_Q); bf16_t* Kb = (bf16_t*)(ws + WS_K); bf16_t* Vb = (bf16_t*)(ws + WS_V); \
    bf16_t* REST = (bf16_t*)(ws + WS_REST); \
    bf16_t* YFB = (bf16_t*)(ws + WS_YFB); \
    bf16_t* Rr = (bf16_t*)(ws + WS_R); bf16_t* VV = (bf16_t*)(ws + WS_VV); bf16_t* KK = (bf16_t*)(ws + WS_KK); \
    bf16_t* KKA = (bf16_t*)(ws + WS_KKA); bf16_t* KD = (bf16_t*)(ws + WS_KD); \
    _Float16* LW = (_Float16*)(ws + WS_W); bf16_t* PP = (bf16_t*)(ws + WS_PP); bf16_t* QT = (bf16_t*)(ws + WS_QT); bf16_t* YT = (bf16_t*)(ws + WS_YT); bf16_t* ZT = (bf16_t*)(ws + WS_ZT); \
    bf16_t* Gg = (bf16_t*)(ws + WS_G); bf16_t* KR = (bf16_t*)(ws + WS_KR); bf16_t* LOW = (bf16_t*)(ws + WS_LOW); \
    float* BC = (float*)(ws + WS_BC); \
    bf16_t* AA = (bf16_t*)(ws + WS_AA); \
    bf16_t* HB = (bf16_t*)(ws + WS_HB); bf16_t* YB = (bf16_t*)(ws + WS_YB); \
    int* ROWTOK = (int*)(ws + WS_ROWTOK); int* EID = (int*)(ws + WS_EID); int* POS = (int*)(ws + WS_POS); int* DEST = (int*)(ws + WS_DEST); \
    float* GATE = (float*)(ws + WS_GATE); \
    bf16_t* YI = (bf16_t*)(ws + WS_YI); bf16_t* S5E = (bf16_t*)(ws + WS_E); bf16_t* CAR = (bf16_t*)(ws + WS_CAR); bf16_t* BTA = (bf16_t*)(ws + WS_BTA); bf16_t* BTC = (bf16_t*)(ws + WS_BTC); \
    unsigned* CTL = (unsigned*)(ws + WS_CTL); \
    bf16_t* WTIN = (bf16_t*)(ws + WS_WTIN); bf16_t* WTOUT = (bf16_t*)(ws + WS_WTOUT); bf16_t* WTGLU = (bf16_t*)(ws + WS_WTGLU); bf16_t* WT13 = (bf16_t*)(ws + WS_WT13); bf16_t* WT2 = (bf16_t*)(ws + WS_WT2); \
    const int vcu = (G % 8 == 0) ? (bid % 8) * (G / 8) + bid / 8 : bid; \
    const float* x = P.in[0]; const float* meta = P.in[1]; const float* norm_mix = P.in[2]; const float* norm_ffn = P.in[3]; const float* norm_final = P.in[4]; \
    const float* w_in = P.in[5]; const float* w_out = P.in[6]; const float* rpb = P.in[7]; const float* mu = P.in[8]; \
    const float* w0 = P.in[9]; const float* w_up = P.in[10]; const float* a0 = P.in[11]; const float* a_up = P.in[12]; const float* g_up = P.in[13]; \
    const float* k_k = P.in[14]; const float* k_a = P.in[15]; const float* r_k = P.in[16]; const float* lnx_g = P.in[17]; const float* lnx_b = P.in[18]; \
    const float* s5_b_re = P.in[19]; const float* s5_b_im = P.in[20]; const float* s5_lre = P.in[21]; const float* s5_lim = P.in[22]; const float* s5_ls = P.in[23]; \
    const float* s5_c_re = P.in[24]; const float* s5_c_im = P.in[25]; const float* s5_d = P.in[26]; const float* w_glu = P.in[27]; \
    const float* moe_wg = P.in[28]; const float* moe_bg = P.in[29]; const float* moe_we = P.in[30]; const float* moe_be = P.in[31]; \
    const float* moe_w1 = P.in[32]; const float* moe_w3 = P.in[33]; const float* moe_w2 = P.in[34];


__device__ __forceinline__ void transpose_half(const float* W, int N, int K, int k0, int n0, bf16_t* dstrow0, int lane) {
    const int kb = lane & 7, nq = lane >> 3;
    const float* src = W + (size_t)(k0 + 8 * kb) * N + n0 + 4 * nq;
    f32x4 v[8];
#pragma unroll
    for (int kk = 0; kk < 8; ++kk) v[kk] = *(const f32x4*)(src + (size_t)kk * N);
#pragma unroll
    for (int i = 0; i < 4; ++i) {
        u32x4 o; o.x = pk2(v[0][i], v[1][i]); o.y = pk2(v[2][i], v[3][i]); o.z = pk2(v[4][i], v[5][i]); o.w = pk2(v[6][i], v[7][i]);
        *(u32x4*)(dstrow0 + (size_t)(4 * nq + i) * K + k0 + 8 * kb) = o;
    }
}
__device__ __forceinline__ void transpose_item(const float* W, int N, int K, int k0, int n0, bf16_t* dstrow0, int lane) {
    transpose_half(W, N, K, k0, n0, dstrow0, lane);
    transpose_half(W, N, K, k0, n0 + 32, dstrow0 + (size_t)32 * K, lane);
}
#define CONV_DENSE_ITEMS (832 + 256 + 512 + 48)
__device__ __forceinline__ void conv_dense_item(CParams& P, int it, int lane) {
    unsigned char* ws = P.ws;
    if (it < 832) { const int kb = it / 52, nb = it % 52; transpose_item(P.in[5], INCOLS, DM, kb * 64, nb * 64, (bf16_t*)(ws + WS_WTIN) + (size_t)nb * 64 * DM, lane); return; }
    it -= 832;
    if (it < 256) { const int kb = it / 16, nb = it % 16; transpose_item(P.in[6], DM, DM, kb * 64, nb * 64, (bf16_t*)(ws + WS_WTOUT) + (size_t)nb * 64 * DM, lane); return; }
    it -= 256;
    if (it < 512) { const int kb = it / 32, nb = it % 32, n = nb * 64, half = n >> 10, c = n & 1023, row = (c >> 7) * 256 + half * 128 + (c & 127);
      transpose_item(P.in[27], 2 * DM, DM, kb * 64, n, (bf16_t*)(ws + WS_WTGLU) + (size_t)row * DM, lane); return; }
    it -= 512;
    bf16_t* lrt = (bf16_t*)(ws + WS_LRT);
    if (it < 16) { const int d = it >> 3, nb = it & 7; transpose_item(P.in[10] + (size_t)d * 64 * 512, 512, 64, 0, nb * 64, lrt + ((size_t)d * 512 + nb * 64) * 64, lane); return; }
    it -= 16;
    if (it < 16) { const int d = it >> 3, nb = it & 7; transpose_item(P.in[12] + (size_t)d * 64 * 512, 512, 64, 0, nb * 64, lrt + (size_t)2 * 512 * 64 + ((size_t)d * 512 + nb * 64) * 64, lane); return; }
    it -= 16;
    { const int kb = it >> 3, nb = it & 7; transpose_item(P.in[13], 512, 128, kb * 64, nb * 64, lrt + (size_t)4 * 512 * 64 + (size_t)nb * 64 * 128, lane); }
}
#define CONV_MOE_ITEMS (NEXP * 384)
__device__ __forceinline__ void conv_moe_item(CParams& P, int l, int it, int lane) {
    unsigned char* ws = P.ws;
    const int e = it / 384; int r = it % 384;
    if (r < 256) { const int which = r >> 7; r &= 127; const int kb = r >> 3, nb = r & 7, n = nb * 64, row = (n >> 7) * 256 + which * 128 + (n & 127);
        const float* W = (which ? P.in[33] : P.in[32]) + ((size_t)(l * NEXP + e) * DM) * DFF;
        transpose_item(W, DFF, DM, kb * 64, n, (bf16_t*)(ws + WS_WT13) + ((size_t)e * DM + row) * DM, lane); return; }
    r -= 256;
    { const int kb = r >> 4, nb = r & 15; const float* W = P.in[34] + ((size_t)(l * NEXP + e) * DFF) * DM;
      transpose_item(W, DM, DFF, kb * 64, nb * 64, (bf16_t*)(ws + WS_WT2) + ((size_t)e * DM + nb * 64) * DFF, lane); }
}

template <int MODE>
__device__ __forceinline__ void meta_gemm(const bf16_t* A, const bf16_t* Bt, bf16_t* Hrows, int task, int lane) {
    const int fr = lane & 15, fq = lane >> 4, c = task * 16 + fr;
    const bf16_t* b0 = MODE == 0 ? Bt + (size_t)c * DM : Bt + (size_t)((c >> 7) * 256 + (c & 127)) * DM;
    const bf16_t* b1 = b0 + (size_t)128 * DM;
    f32x4 acc0[2], acc1[2];
    acc0[0] = acc0[1] = acc1[0] = acc1[1] = (f32x4){0.f, 0.f, 0.f, 0.f};
#pragma unroll 4
    for (int kt = 0; kt < 32; ++kt) {
        const int ko = kt * 32 + fq * 8;
        const bf16x8 a0 = *(const bf16x8*)(A + (size_t)fr * DM + ko), a1 = *(const bf16x8*)(A + (size_t)(16 + fr) * DM + ko);
        const bf16x8 bv = *(const bf16x8*)(b0 + ko);
        acc0[0] = __builtin_amdgcn_mfma_f32_16x16x32_bf16(a0, bv, acc0[0], 0, 0, 0);
        acc0[1] = __builtin_amdgcn_mfma_f32_16x16x32_bf16(a1, bv, acc0[1], 0, 0, 0);
        if (MODE == 1) { const bf16x8 bg = *(const bf16x8*)(b1 + ko);
            acc1[0] = __builtin_amdgcn_mfma_f32_16x16x32_bf16(a0, bg, acc1[0], 0, 0, 0);
            acc1[1] = __builtin_amdgcn_mfma_f32_16x16x32_bf16(a1, bg, acc1[1], 0, 0, 0); }
    }
#pragma unroll
    for (int mi = 0; mi < 2; ++mi)
#pragma unroll
        for (int j = 0; j < 4; ++j) { bf16_t* p = Hrows + (size_t)(mi * 16 + fq * 4 + j) * DM + c;
            const float add = MODE == 0 ? acc0[mi][j] : acc0[mi][j] * __builtin_amdgcn_rcpf(1.f + __expf(-acc1[mi][j]));
            *p = (bf16_t)f2bf(bf2f(*p) + add); }
}
__device__ __forceinline__ void phase_0(CParams& P, unsigned char* lds, const int ph) {
    PHASE_PROLOGUE
            for (int row = gw; row < NT; row += NGW) {
                const float* src = row < NMAIN ? x + (size_t)row * DM : meta + (size_t)((row - NMAIN) & 15) * DM;
                f32x4 v[4];
#pragma unroll
                for (int j = 0; j < 4; ++j) { v[j] = ((const f32x4*)src)[lane + 64 * j]; strow_bf16(H + (size_t)row * DM, lane, j, v[j]); }
                store_norm_bf16(v, norm_mix, HN + (size_t)row * DM, lane);
            }
    for (int it = gw; it < CONV_DENSE_ITEMS; it += NGW) conv_dense_item(P, it, lane);
}

__device__ __forceinline__ void phase_1(CParams& P, unsigned char* lds, const int ph) {
    PHASE_PROLOGUE
    pg8::ProjOrder S; S.init(HN, WTIN, bid);
    pg8::EpiProj E{Qb, Kb, Vb, REST};
    pg8::gemm_phase<pg8::EpiProj, pg8::ProjOrder, true, true>((PG8_LAS unsigned char*)lds, DM, S, E);
}

__device__ __forceinline__ void na_units(CParams& P, unsigned char* lds, const int first, const int stride) {
    PHASE_PROLOGUE
    float* sb = (float*)lds;
    for (int i = tid; i < 8 * 465; i += 512) sb[i] = rpb[i];
    __syncthreads();
    const bf16_t* VT = Vb;
    const int fr = lane & 15, fq = lane >> 4;
    for (int u = first; u < 8192 + 16; u += stride) {
        const bool metaq = u >= 8192;
        int b, h, r = 0, qb = 0;
        if (!metaq) { qb = u & 3; r = (u >> 2) & 127; h = (u >> 9) & 7; b = u >> 12; } else { const int m = u - 8192; b = m >> 3; h = m & 7; }
        const int c = qb * 16 + fr;
        const int qrow = metaq ? NMAIN + b * NMETA + fr : b * SEQ + r * 64 + c;
        const int R0 = min(max(r - 4, 0), 120), cs = qb == 0 ? 0 : (qb == 1 ? 8 : (qb == 2 ? 24 : 32));
        const int C0 = min(max(c - 8, 0), 48);
        bf16x8 qf0 = *(const bf16x8*)(Qb + (size_t)qrow * 512 + h * 64 + fq * 8), qf1 = *(const bf16x8*)(Qb + (size_t)qrow * 512 + h * 64 + 32 + fq * 8);
        f32x4 sacc[17];
        const f32x4 zero4 = (f32x4){0.f, 0.f, 0.f, 0.f};
        if (!metaq) {
#pragma unroll
            for (int kt = 0; kt < 16; ++kt) {
                const int krow0 = b * SEQ + (R0 + (kt >> 1)) * 64 + cs + 16 * (kt & 1);
                const bf16_t* kp = Kb + (size_t)(krow0 + fr) * 512 + h * 64 + fq * 8;
                const bf16x8 a0 = *(const bf16x8*)kp, a1 = *(const bf16x8*)(kp + 32);
                f32x4 acc = __builtin_amdgcn_mfma_f32_16x16x32_bf16(a0, qf0, zero4, 0, 0, 0);
                sacc[kt] = __builtin_amdgcn_mfma_f32_16x16x32_bf16(a1, qf1, acc, 0, 0, 0);
            }
        } else {
#pragma unroll
            for (int kt = 0; kt < 16; ++kt) sacc[kt] = zero4;
        }
        {
            const bf16_t* kp = Kb + (size_t)(NMAIN + b * NMETA + fr) * 512 + h * 64 + fq * 8;
            const bf16x8 a0 = *(const bf16x8*)kp, a1 = *(const bf16x8*)(kp + 32);
            f32x4 acc = __builtin_amdgcn_mfma_f32_16x16x32_bf16(a0, qf0, zero4, 0, 0, 0);
            sacc[16] = __builtin_amdgcn_mfma_f32_16x16x32_bf16(a1, qf1, acc, 0, 0, 0);
        }
        float mx = -1e30f;
#pragma unroll
        for (int kt = 0; kt < 16; ++kt) {
            const int dr = R0 + (kt >> 1) - r + 7;
#pragma unroll
            for (int j = 0; j < 4; ++j) {
                const int kc = cs + 16 * (kt & 1) + 4 * fq + j;
                const bool inb = !metaq && kc >= C0 && kc < C0 + 16;
                const int dc = min(max(kc - c + 15, 0), 30);
                const float s = inb ? sacc[kt][j] * 0.125f + sb[(h * 15 + dr) * 31 + dc] : -1e30f;
                sacc[kt][j] = s; mx = fmaxf(mx, s);
            }
        }
#pragma unroll
        for (int j = 0; j < 4; ++j) { const float s = sacc[16][j] * 0.125f; sacc[16][j] = s; mx = fmaxf(mx, s); }
        mx = fmaxf(mx, __shfl_xor(mx, 16)); mx = fmaxf(mx, __shfl_xor(mx, 32));
        float sum = 0.f;
#pragma unroll
        for (int kt = 0; kt < 17; ++kt)
#pragma unroll
            for (int j = 0; j < 4; ++j) { const float pv = __expf(sacc[kt][j] - mx); sacc[kt][j] = pv; sum += pv; }
        sum += __shfl_xor(sum, 16); sum += __shfl_xor(sum, 32);
        f32x4 o[4] = {zero4, zero4, zero4, zero4};
        if (!metaq) {
#pragma unroll
            for (int kr = 0; kr < 8; ++kr) {
                union { bf16x8 v; unsigned u[4]; } bf;
                bf.u[0] = pk2(sacc[2 * kr][0], sacc[2 * kr][1]); bf.u[1] = pk2(sacc[2 * kr][2], sacc[2 * kr][3]);
                bf.u[2] = pk2(sacc[2 * kr + 1][0], sacc[2 * kr + 1][1]); bf.u[3] = pk2(sacc[2 * kr + 1][2], sacc[2 * kr + 1][3]);
                const size_t tok0 = (size_t)b * SEQ + (R0 + kr) * 64 + cs + 4 * fq;
#pragma unroll
                for (int dt = 0; dt < 4; ++dt) {
                    const bf16_t* vp = VT + (size_t)(h * 64 + dt * 16 + fr) * NTP + tok0;
                    union { bf16x8 v; u32x2 h2[2]; } af;
                    af.h2[0] = *(const u32x2*)vp; af.h2[1] = *(const u32x2*)(vp + 16);
                    o[dt] = __builtin_amdgcn_mfma_f32_16x16x32_bf16(af.v, bf.v, o[dt], 0, 0, 0);
                }
            }
        }
        {
            union { bf16x8 v; unsigned u[4]; } bf;
            bf.u[0] = pk2(sacc[16][0], sacc[16][1]); bf.u[1] = pk2(sacc[16][2], sacc[16][3]); bf.u[2] = 0u; bf.u[3] = 0u;
            const size_t tokm = (size_t)NMAIN + b * NMETA + 4 * fq;
#pragma unroll
            for (int dt = 0; dt < 4; ++dt) {
                const bf16_t* vp = VT + (size_t)(h * 64 + dt * 16 + fr) * NTP + tokm;
                union { bf16x8 v; u32x2 h2[2]; } af;
                af.h2[0] = *(const u32x2*)vp; af.h2[1] = (u32x2){0u, 0u};
                o[dt] = __builtin_amdgcn_mfma_f32_16x16x32_bf16(af.v, bf.v, o[dt], 0, 0, 0);
            }
        }
        const float inv = 1.f / sum;
#pragma unroll
        for (int dt = 0; dt < 4; ++dt) {
            u32x2 ov; ov.x = pk2(o[dt][0] * inv, o[dt][1] * inv); ov.y = pk2(o[dt][2] * inv, o[dt][3] * inv);
            *(u32x2*)(A2 + (size_t)qrow * DM + h * 64 + dt * 16 + 4 * fq) = ov;
        }
    }
    __syncthreads();
}

__device__ __forceinline__ void phase_3(CParams& P, unsigned char* lds, const int ph) {
    PHASE_PROLOGUE
    constexpr int TR = 66, NTILE = (NT + TR - 1) / TR, AST = 264, SST = 136;
    bf16_t* As = (bf16_t*)lds;
    unsigned short* stg = (unsigned short*)(lds + 80 * AST * 2);
    const bf16_t* lrt = (const bf16_t*)(ws + WS_LRT);
    const int fr = lane & 15, fq = lane >> 4;
    for (int u = bid; u < NTILE; u += G) {
        const int r0 = u * TR, nrows = min(TR, NT - r0);
        for (int rl = wave; rl < nrows; rl += 8) {
            const int row = r0 + rl;
            int b, pp_;
            if (row < NMAIN) { b = row >> 13; pp_ = (row & (SEQ - 1)) + NMETA; } else { b = (row - NMAIN) >> 4; pp_ = (row - NMAIN) & 15; }
            const bool hp = pp_ > 0, hn = pp_ + 1 < LSEQ;
            const int rowp = hp ? rowof(b, pp_ - 1) : row, rown = hn ? rowof(b, pp_ + 1) : row;
#pragma unroll
            for (int j = 0; j < 7; ++j) {
                const int c = 4 * lane + 256 * j;
                const u32x2 vc = *(const u32x2*)(REST + (size_t)row * RESTC + c);
                u32x2 vp = *(const u32x2*)(REST + (size_t)rowp * RESTC + c);
                u32x2 vn = *(const u32x2*)(REST + (size_t)rown * RESTC + c);
                if (!hp) { vp.x = 0; vp.y = 0; }
                if (!hn) { vn.x = 0; vn.y = 0; }
                const f32x4 m4 = *(const f32x4*)(mu + c);
                float pc[4] = {bflo(vc.x), bfhi(vc.x), bflo(vc.y), bfhi(vc.y)};
                float pq[4] = {bflo(vp.x), bfhi(vp.x), bflo(vp.y), bfhi(vp.y)};
                float pn[4] = {bflo(vn.x), bfhi(vn.x), bflo(vn.y), bfhi(vn.y)};
                float o[4];
#pragma unroll
                for (int i = 0; i < 4; ++i) o[i] = pc[i] + m4[i] * (0.5f * (pq[i] + pn[i]) - pc[i]);
                if (j == 6) {
                    if (lane < 16) { for (int i = 0; i < 4; ++i) o[i] = tanhf(o[i]); }
                    else if (lane >= 32) { for (int i = 0; i < 4; ++i) o[i] = sigmoidf_(o[i]); }
                }
                u32x2 ov; ov.x = pk2(o[0], o[1]); ov.y = pk2(o[2], o[3]);
                if (j < 6) { bf16_t* dst = j < 2 ? Rr + (size_t)row * 512 + c : (j < 4 ? KR + (size_t)row * 512 + (c - 512) : VV + (size_t)row * 512 + (c - 1024)); *(u32x2*)dst = ov; }
                else *(u32x2*)(As + rl * AST + (c - 1536)) = ov;
            }
        }
        __syncthreads();
#define P4_LOADB(t_, bv_, bias_) do { const int wh_ = (t_) >> 2, ct_ = (t_) & 3, Kw_ = wh_ < 4 ? 64 : 128, col_ = ct_ * 128 + 16 * wave + fr; \
            const bf16_t* Wt_ = lrt + (wh_ < 4 ? (size_t)wh_ * 512 * 64 : (size_t)4 * 512 * 64) + (size_t)col_ * Kw_ + 8 * fq; \
            bv_[0] = *(const bf16x8*)Wt_; bv_[1] = *(const bf16x8*)(Wt_ + 32); if (wh_ == 4) { bv_[2] = *(const bf16x8*)(Wt_ + 64); bv_[3] = *(const bf16x8*)(Wt_ + 96); } \
            bias_ = wh_ < 2 ? w0[wh_ * 512 + col_] : (wh_ < 4 ? a0[(wh_ - 2) * 512 + col_] : 0.f); } while (0)
        bf16x8 bnx[4]; float biasn;
        P4_LOADB(0, bnx, biasn);
#pragma unroll 1
        for (int t = 0; t < 20; ++t) {
            const int which = t >> 2, ct = t & 3;
            const int koff = which < 2 ? 0 : (which < 4 ? 64 : 128);
            bf16x8 bcur[4]; bcur[0] = bnx[0]; bcur[1] = bnx[1]; bcur[2] = bnx[2]; bcur[3] = bnx[3];
            const float bias = biasn;
            if (t + 1 < 20) P4_LOADB(t + 1, bnx, biasn);
            const f32x4 zero4 = (f32x4){0.f, 0.f, 0.f, 0.f};
            f32x4 acc[5] = {zero4, zero4, zero4, zero4, zero4};
#pragma unroll
            for (int ks = 0; ks < 4; ++ks) {
                if (ks < 2 || which == 4) {
#pragma unroll
                    for (int rt = 0; rt < 5; ++rt) acc[rt] = __builtin_amdgcn_mfma_f32_16x16x32_bf16(*(const bf16x8*)(As + (16 * rt + fr) * AST + koff + 32 * ks + 8 * fq), bcur[ks], acc[rt], 0, 0, 0);
                }
            }
            unsigned short* sg = stg + (t & 1) * 80 * SST + 16 * wave + fr;
#pragma unroll
            for (int rt = 0; rt < 5; ++rt)
#pragma unroll
                for (int j = 0; j < 4; ++j) { const float val = acc[rt][j] + bias; unsigned short o;
                    if (which < 2) { const _Float16 hv = (_Float16)(-0.6065306597f * sigmoidf_(val)); o = __builtin_bit_cast(unsigned short, hv); }
                    else if (which < 4) o = (unsigned short)f2bf(sigmoidf_(val));
                    else o = (unsigned short)f2bf(val);
                    sg[(16 * rt + 4 * fq + j) * SST] = o; }
            __syncthreads();
            {
                unsigned short* dst = which < 2 ? (unsigned short*)LW + (size_t)which * NT * 512 : (which < 4 ? (unsigned short*)AA + (size_t)(which - 2) * NT * 512 : (unsigned short*)Gg);
                for (int i = tid; i < nrows * 8; i += 512) { const int r = i >> 3, pc = (i & 7) * 16; const unsigned short* sp = stg + (t & 1) * 80 * SST + r * SST + pc;
                    unsigned short* gp = dst + (size_t)(r0 + r) * 512 + ct * 128 + pc; *(u32x4*)gp = *(const u32x4*)sp; *(u32x4*)(gp + 8) = *(const u32x4*)(sp + 8); }
            }
        }
#undef P4_LOADB
        __syncthreads();
        for (int rl = wave; rl < nrows; rl += 8) {
            const int row = r0 + rl;

                const int c0 = lane * 8;
                const u32x4 krv = *(const u32x4*)(KR + (size_t)row * 512 + c0);
                const u32x4 rv = *(const u32x4*)(Rr + (size_t)row * 512 + c0);
                float kr[8], rr[8], kkv[8];
#pragma unroll
                for (int i = 0; i < 4; ++i) { kr[2 * i] = bflo(krv[i]); kr[2 * i + 1] = bfhi(krv[i]); rr[2 * i] = bflo(rv[i]); rr[2 * i + 1] = bfhi(rv[i]); }
                float ss = 0.f;
#pragma unroll
                for (int i = 0; i < 8; ++i) { kkv[i] = kr[i] * k_k[c0 + i]; ss += kkv[i] * kkv[i]; }
                ss += __shfl_xor(ss, 1); ss += __shfl_xor(ss, 2); ss += __shfl_xor(ss, 4);
                const float inv = 1.f / fmaxf(sqrtf(ss), 1e-12f);
#pragma unroll
                for (int i = 0; i < 8; ++i) kkv[i] *= inv;
                u32x4 o; o.x = pk2(kkv[0], kkv[1]); o.y = pk2(kkv[2], kkv[3]); o.z = pk2(kkv[4], kkv[5]); o.w = pk2(kkv[6], kkv[7]);
                *(u32x4*)(KK + (size_t)row * 512 + c0) = o;
                float bsum = 0.f;
#pragma unroll
                for (int d = 0; d < 2; ++d) {
                    const u32x4 av = *(const u32x4*)(AA + ((size_t)d * NT + row) * 512 + c0);
                    float a[8], kka[8], kd[8];
#pragma unroll
                    for (int i = 0; i < 4; ++i) { a[2 * i] = bflo(av[i]); a[2 * i + 1] = bfhi(av[i]); }
#pragma unroll
                    for (int i = 0; i < 8; ++i) { kka[i] = kkv[i] * a[i]; kd[i] = kr[i] * (1.f + (a[i] - 1.f) * k_a[c0 + i]); bsum += rr[i] * kd[i] * r_k[c0 + i]; }
                    u32x4 o1; o1.x = pk2(kka[0], kka[1]); o1.y = pk2(kka[2], kka[3]); o1.z = pk2(kka[4], kka[5]); o1.w = pk2(kka[6], kka[7]);
                    *(u32x4*)(KKA + ((size_t)d * NT + row) * 512 + c0) = o1;
                    u32x4 o2; o2.x = pk2(kd[0], kd[1]); o2.y = pk2(kd[2], kd[3]); o2.z = pk2(kd[4], kd[5]); o2.w = pk2(kd[6], kd[7]);
                    *(u32x4*)(KD + ((size_t)d * NT + row) * 512 + c0) = o2;
                }
                bsum += __shfl_xor(bsum, 1); bsum += __shfl_xor(bsum, 2); bsum += __shfl_xor(bsum, 4);
                if ((lane & 7) == 0) BC[(size_t)row * 8 + (lane >> 3)] = bsum;
                    }
        __syncthreads();
    }
}

#define RWS 72
__device__ __forceinline__ bf16x8 rw_frag(const bf16_t* M, int row, int kofs) { return *(const bf16x8*)(M + row * RWS + kofs); }
__device__ __forceinline__ f32x4 rw_tile(const bf16_t* Am, int ra, const bf16_t* Bm, int rb, int fr, int fq) {
    f32x4 acc = (f32x4){0.f, 0.f, 0.f, 0.f};
    acc = __builtin_amdgcn_mfma_f32_16x16x32_bf16(rw_frag(Am, ra + fr, 8 * fq), rw_frag(Bm, rb + fr, 8 * fq), acc, 0, 0, 0);
    acc = __builtin_amdgcn_mfma_f32_16x16x32_bf16(rw_frag(Am, ra + fr, 32 + 8 * fq), rw_frag(Bm, rb + fr, 32 + 8 * fq), acc, 0, 0, 0);
    return acc;
}
__device__ __forceinline__ void phase_6(CParams& P, unsigned char* lds, const int ph) {
    PHASE_PROLOGUE
    constexpr int GST = 68, RST = 132;
    float* Gs = (float*)lds;
    bf16_t* A_rm = (bf16_t*)(lds + 64 * GST * 4); bf16_t* R_rm = A_rm + 64 * RWS; bf16_t* B_rm = R_rm + 64 * RWS; bf16_t* K_rm = B_rm + 64 * RWS;
    bf16_t* B_tr = K_rm + 64 * RWS; bf16_t* K_tr = B_tr + 64 * RWS; bf16_t* V_tr = K_tr + 64 * RWS;
    bf16_t* MAK = V_tr + 64 * RWS; bf16_t* MRB = MAK + 64 * RWS; bf16_t* MRK = MRB + 64 * RWS;
    bf16_t* MABr = MRK + 64 * RWS;
    float* RHS = (float*)(MABr + 64 * RWS);
    float* BT = RHS + 64 * RST; float* OFF = BT + 512; float* GC = OFF + 512;
    bf16_t* X1_tr = A_rm; bf16_t* X2_tr = K_rm;
    for (int i = tid; i < 4 * 64 * RWS / 2; i += 512) ((unsigned*)MAK)[i] = 0u;
    __syncthreads();
    const int fr = lane & 15, fq = lane >> 4;
#define RW1_BAR() do { asm volatile("s_waitcnt lgkmcnt(0)" ::: "memory"); __builtin_amdgcn_s_barrier(); asm volatile("" ::: "memory"); } while (0)
    const int t0 = tid & 63, kp = (tid >> 6) * 8;
    u32x4 nlw, nkk, nka, nkd, nrv, nvv;
#define RW1_LOAD(u_) do { const int ch_ = (u_) / RW_NCH, c_ = (u_) - ch_ * RW_NCH, d_ = ch_ >> 4, b_ = (ch_ >> 3) & 1, h_ = ch_ & 7, s_ = c_ * 64 + t0; \
        const int p_ = d_ ? LSEQ - 1 - s_ : s_; const size_t o_ = (size_t)rowof(b_, s_ < LSEQ ? p_ : 0) * 512 + h_ * 64 + kp; \
        nlw = *(const u32x4*)(LW + (size_t)d_ * NT * 512 + o_); nkk = *(const u32x4*)(KK + o_); nka = *(const u32x4*)(KKA + (size_t)d_ * NT * 512 + o_); \
        nkd = *(const u32x4*)(KD + (size_t)d_ * NT * 512 + o_); nrv = *(const u32x4*)(Rr + o_); nvv = *(const u32x4*)(VV + o_); } while (0)
    if (bid < RW_UNITS) RW1_LOAD(bid);
    for (int u = bid; u < RW_UNITS; u += G) {
        const int chain = u / RW_NCH, c = u - chain * RW_NCH;
        float lw[8], kk[8], ka[8], kd[8], rr[8]; u32x4 vv;
        {
            const bool valid = c * 64 + t0 < LSEQ;
            vv = nvv;
#pragma unroll
            for (int i = 0; i < 4; ++i) {
                union { unsigned u; _Float16 hh[2]; } cv; cv.u = nlw[i];
                lw[2 * i] = valid ? (float)cv.hh[0] : 0.f; lw[2 * i + 1] = valid ? (float)cv.hh[1] : 0.f;
                kk[2 * i] = valid ? bflo(nkk[i]) : 0.f; kk[2 * i + 1] = valid ? bfhi(nkk[i]) : 0.f;
                ka[2 * i] = valid ? bflo(nka[i]) : 0.f; ka[2 * i + 1] = valid ? bfhi(nka[i]) : 0.f;
                kd[2 * i] = valid ? bflo(nkd[i]) : 0.f; kd[2 * i + 1] = valid ? bfhi(nkd[i]) : 0.f;
                rr[2 * i] = valid ? bflo(nrv[i]) : 0.f; rr[2 * i + 1] = valid ? bfhi(nrv[i]) : 0.f;
                if (!valid) vv[i] = 0u;
            }
        }
        if (u + G < RW_UNITS) RW1_LOAD(u + G);
        *(f32x4*)(Gs + t0 * GST + kp) = (f32x4){lw[0], lw[1], lw[2], lw[3]}; *(f32x4*)(Gs + t0 * GST + kp + 4) = (f32x4){lw[4], lw[5], lw[6], lw[7]};
        RW1_BAR();
        { const int k = tid & 63, w = tid >> 6; float acc = 0.f;
#pragma unroll
          for (int i = 0; i < 8; ++i) { acc += Gs[(8 * w + i) * GST + k]; Gs[(8 * w + i) * GST + k] = acc; }
          BT[w * 64 + k] = acc; }
        RW1_BAR();
        { const int k = tid & 63, w = tid >> 6; float off = 0.f; for (int w2 = 0; w2 < w; ++w2) off += BT[w2 * 64 + k]; OFF[w * 64 + k] = off; }
        RW1_BAR();
#ifndef RW1_REP0
#define RW1_REP0 1
#endif
        for (int rep0_ = 0; rep0_ < RW1_REP0; ++rep0_) {
        {
            float va[8], vr[8], vb[8], vk[8];
            const f32x4 g0_ = *(const f32x4*)(Gs + t0 * GST + kp), g1_ = *(const f32x4*)(Gs + t0 * GST + kp + 4), o0_ = *(const f32x4*)(OFF + (t0 >> 3) * 64 + kp), o1_ = *(const f32x4*)(OFF + (t0 >> 3) * 64 + kp + 4);
            const float gg_[8] = {g0_[0] + o0_[0], g0_[1] + o0_[1], g0_[2] + o0_[2], g0_[3] + o0_[3], g1_[0] + o1_[0], g1_[1] + o1_[1], g1_[2] + o1_[2], g1_[3] + o1_[3]};
#pragma unroll
            for (int i = 0; i < 8; ++i) {
                const float g = gg_[i];
                const float eg = __expf(g), egm1 = __expf(g - lw[i]), einv = __expf(-g);
                va[i] = kk[i] * egm1; vr[i] = rr[i] * eg; vb[i] = ka[i] * einv; vk[i] = kd[i] * einv;
                if (t0 == 63) GC[kp + i] = eg;
            }
            *(f32x4*)(RHS + t0 * RST + kp) = (f32x4){va[0], va[1], va[2], va[3]}; *(f32x4*)(RHS + t0 * RST + kp + 4) = (f32x4){va[4], va[5], va[6], va[7]};
            u32x4 w4;
            w4.x = pk2(va[0], va[1]); w4.y = pk2(va[2], va[3]); w4.z = pk2(va[4], va[5]); w4.w = pk2(va[6], va[7]); *(u32x4*)(A_rm + t0 * RWS + kp) = w4;
            w4.x = pk2(vr[0], vr[1]); w4.y = pk2(vr[2], vr[3]); w4.z = pk2(vr[4], vr[5]); w4.w = pk2(vr[6], vr[7]); *(u32x4*)(R_rm + t0 * RWS + kp) = w4;
            w4.x = pk2(vb[0], vb[1]); w4.y = pk2(vb[2], vb[3]); w4.z = pk2(vb[4], vb[5]); w4.w = pk2(vb[6], vb[7]); *(u32x4*)(B_rm + t0 * RWS + kp) = w4;
            w4.x = pk2(vk[0], vk[1]); w4.y = pk2(vk[2], vk[3]); w4.z = pk2(vk[4], vk[5]); w4.w = pk2(vk[6], vk[7]); *(u32x4*)(K_rm + t0 * RWS + kp) = w4;
#pragma unroll
            for (int i = 0; i < 8; ++i) { B_tr[(kp + i) * RWS + t0] = (bf16_t)f2bf(vb[i]); K_tr[(kp + i) * RWS + t0] = (bf16_t)f2bf(vk[i]);
                V_tr[(kp + i) * RWS + t0] = (bf16_t)((i & 1) ? (vv[i >> 1] >> 16) : (vv[i >> 1] & 0xffffu)); }
        }
        RW1_BAR();
        }
        float* DQ = Gs; bf16_t* TB = (bf16_t*)BT;
#ifndef RW1_REP1
#define RW1_REP1 1
#endif
#pragma unroll
        for (int s1 = 0; s1 < 5; ++s1) { const int q = wave + 8 * s1;
            const int m = q / 10, e = q - m * 10, ti = e >= 6 ? 3 : (e >= 3 ? 2 : (e >= 1 ? 1 : 0)), tj = e - (ti * (ti + 1)) / 2;
            const f32x4 acc = rw_tile(m < 2 ? A_rm : R_rm, 16 * ti, (m & 1) ? K_rm : B_rm, 16 * tj, fr, fq);
            bf16_t* Mm = m == 1 ? MAK : (m == 2 ? MRB : MRK);
#pragma unroll
            for (int j = 0; j < 4; ++j) { const int t = 16 * ti + 4 * fq + j, i = 16 * tj + fr; const bool keep = m < 2 ? (i < t) : (i <= t); const float val = keep ? acc[j] : 0.f;
                if (m == 0) { MABr[t * RWS + i] = (bf16_t)f2bf(val); if (ti == tj) DQ[((ti * 16 + (t & 15)) * 4 + (fr & 3)) * 4 + (fr >> 2)] = val; }
                else Mm[t * RWS + i] = (bf16_t)f2bf(val); }
        }
        RW1_BAR();
#ifndef RW1_REP23
#define RW1_REP23 1
#endif
        for (int rep23_ = 0; rep23_ < RW1_REP23; ++rep23_) {
        if (wave >= 4) {
            for (int q = wave - 4; q < 16; q += 4) { const int ti = q >> 2, tv = q & 3; const f32x4 acc = rw_tile(MAK, 16 * ti, V_tr, 16 * tv, fr, fq);
#pragma unroll
                for (int j = 0; j < 4; ++j) RHS[(16 * ti + 4 * fq + j) * RST + 64 + 16 * tv + fr] = acc[j]; }
        } else {
            const int bb = wave, cc = lane >> 2, q = lane & 3;
            float xs[4] = {0.f, 0.f, 0.f, 0.f};
#pragma unroll
            for (int tl = 0; tl < 16; ++tl) {
                const f32x4 mv = *(const f32x4*)(DQ + ((bb * 16 + tl) * 4 + q) * 4);
                float part = mv[0] * xs[0] + mv[1] * xs[1] + mv[2] * xs[2] + mv[3] * xs[3];
                part += dppf<0xB1>(part); part += dppf<0x4E>(part);
                const float xt = (tl == cc ? 1.f : 0.f) - part;
                xs[tl >> 2] = (tl & 3) == q ? xt : xs[tl >> 2];
            }
#pragma unroll
            for (int m = 0; m < 4; ++m) TB[(bb * 16 + 4 * m + q) * 16 + cc] = (bf16_t)f2bf(xs[m]);
        }
        RW1_BAR();
        {
            const int c0 = 16 * wave;
            f32x4 X[4];
            const f32x4 zero4 = (f32x4){0.f, 0.f, 0.f, 0.f};
#define RW1_PACK(lo_, hi_, v_) do { union { bf16x8 v; unsigned u[4]; } t_; t_.u[0] = pk2(lo_[0], lo_[1]); t_.u[1] = pk2(lo_[2], lo_[3]); t_.u[2] = pk2(hi_[0], hi_[1]); t_.u[3] = pk2(hi_[2], hi_[3]); v_ = t_.v; } while (0)
#define RW1_LDA(base_, row0_, ca_, cb_, useb_, v_) do { union { bf16x8 v; u32x2 h2[2]; } t_; t_.h2[0] = *(const u32x2*)((base_) + ((row0_) + fr) * RWS + (ca_) + 4 * fq); \
            t_.h2[1] = (useb_) ? *(const u32x2*)((base_) + ((row0_) + fr) * RWS + (cb_) + 4 * fq) : (u32x2){0u, 0u}; v_ = t_.v; } while (0)
#pragma unroll
            for (int bq = 0; bq < 4; ++bq) {
                f32x4 acc;
#pragma unroll
                for (int j = 0; j < 4; ++j) acc[j] = -RHS[(16 * bq + 4 * fq + j) * RST + c0 + fr];
                bf16x8 af, bfv;
                if (bq >= 1) { RW1_LDA(MABr, 16 * bq, 0, 16, bq >= 2, af); if (bq >= 2) RW1_PACK(X[0], X[1], bfv); else RW1_PACK(X[0], zero4, bfv);
                    acc = __builtin_amdgcn_mfma_f32_16x16x32_bf16(af, bfv, acc, 0, 0, 0); }
                if (bq == 3) { RW1_LDA(MABr, 48, 32, 0, false, af); RW1_PACK(X[2], zero4, bfv); acc = __builtin_amdgcn_mfma_f32_16x16x32_bf16(af, bfv, acc, 0, 0, 0); }
                const f32x4 wv = (f32x4){-acc[0], -acc[1], -acc[2], -acc[3]};
                { union { bf16x8 v; u32x2 h2[2]; } t_; t_.h2[0] = *(const u32x2*)(TB + (bq * 16 + fr) * 16 + 4 * fq); t_.h2[1] = (u32x2){0u, 0u}; af = t_.v; }
                RW1_PACK(wv, zero4, bfv);
                X[bq] = __builtin_amdgcn_mfma_f32_16x16x32_bf16(af, bfv, zero4, 0, 0, 0);
                bf16_t* Xm = (wave < 4 ? X1_tr : X2_tr) + ((c0 & 63) + fr) * RWS + 16 * bq + 4 * fq;
                u32x2 o; o.x = pk2(X[bq][0], X[bq][1]); o.y = pk2(X[bq][2], X[bq][3]);
                *(u32x2*)Xm = o;
            }
#undef RW1_PACK
#undef RW1_LDA
        }
        RW1_BAR();
        }
#pragma unroll
        for (int s5 = 0; s5 < 2; ++s5) {
            const int tile = wave * 2 + s5, ta = tile >> 2, tb = tile & 3;
            u32x2 o;
            {
                const f32x4 acc = rw_tile(X1_tr, 16 * ta, B_tr, 16 * tb, fr, fq);
                const int k = 16 * tb + fr, kq = 16 * ta + 4 * fq; const float gc = GC[k];
                float v[4];
#pragma unroll
                for (int j = 0; j < 4; ++j) v[j] = gc * ((kq + j == k ? 1.f : 0.f) - acc[j]);
                o.x = pk2(v[0], v[1]); o.y = pk2(v[2], v[3]);
                *(u32x2*)(PP + (size_t)u * 4096 + k * 64 + 32 * (ta >> 1) + 8 * fq + 4 * (ta & 1)) = o;
            }
            {
                const f32x4 acc = rw_tile(X1_tr, 16 * ta, MRB, 16 * tb, fr, fq);
                const int t = 16 * tb + fr, k0 = 16 * ta + 4 * fq;
                const u32x2 rv = *(const u32x2*)(R_rm + t * RWS + k0);
                o.x = pk2(bflo(rv.x) - acc[0], bfhi(rv.x) - acc[1]); o.y = pk2(bflo(rv.y) - acc[2], bfhi(rv.y) - acc[3]);
                *(u32x2*)(YT + (size_t)u * 4096 + t * 64 + 32 * (ta >> 1) + 8 * fq + 4 * (ta & 1)) = o;
            }
            {
                const f32x4 a1 = rw_tile(K_tr, 16 * ta, V_tr, 16 * tb, fr, fq), a2 = rw_tile(B_tr, 16 * ta, X2_tr, 16 * tb, fr, fq);
                const int v_ = 16 * tb + fr, k0 = 16 * ta + 4 * fq;
                const f32x4 gc = *(const f32x4*)(GC + k0);
                o.x = pk2(gc[0] * (a1[0] - a2[0]), gc[1] * (a1[1] - a2[1])); o.y = pk2(gc[2] * (a1[2] - a2[2]), gc[3] * (a1[3] - a2[3]));
                *(u32x2*)(QT + (size_t)u * 4096 + v_ * 64 + k0) = o;
            }
            {
                const f32x4 a1 = rw_tile(MRK, 16 * ta, V_tr, 16 * tb, fr, fq), a2 = rw_tile(MRB, 16 * ta, X2_tr, 16 * tb, fr, fq);
                const int v_ = 16 * tb + fr, t0_ = 16 * ta + 4 * fq;
                o.x = pk2(a1[0] - a2[0], a1[1] - a2[1]); o.y = pk2(a1[2] - a2[2], a1[3] - a2[3]);
                *(u32x2*)(ZT + (size_t)u * 4096 + v_ * 64 + t0_) = o;
            }
        }
        RW1_BAR();
    }
#undef RW1_LOAD
#undef RW1_BAR
}

__device__ __forceinline__ void phase_60(CParams& P, unsigned char* lds, const int ph) {
    PHASE_PROLOGUE
    if (bid < 32) {
        const int chain = bid, d = chain >> 4, b = (chain >> 3) & 1, h = chain & 7;
        const int fr = lane & 15, fq = lane >> 4;
        constexpr int MATB = 64 * RWS * 2, SLOT = 4 * MATB;
        bf16_t* ybuf = (bf16_t*)(lds + 3 * SLOT);
        const bool comp = wave < 4; const int vb = wave & 3, lm = wave & 3;
        const unsigned char* src = (const unsigned char*)(lm == 0 ? PP : (lm == 1 ? YT : (lm == 2 ? QT : ZT))) + (size_t)chain * RW_NCH * 8192 + lane * 16;
        u32x4 R0[8], R1[8], R2[8];
#define RW2_LD(Rx, c_) do { _Pragma("unroll") for (int i_ = 0; i_ < 8; ++i_) Rx[i_] = *(const u32x4*)(src + (size_t)(c_) * 8192 + i_ * 1024); } while (0)
#define RW2_ST(Rx, c_) do { unsigned char* dst_ = lds + ((c_) % 3) * SLOT + lm * MATB; _Pragma("unroll") for (int i_ = 0; i_ < 8; ++i_) { const int p_ = lane + 64 * i_; *(u32x4*)(dst_ + (p_ >> 3) * (RWS * 2) + (p_ & 7) * 16) = Rx[i_]; } } while (0)
#define RW2_FLUSH(c_) do { const int tl_ = 16 * lm + (lane >> 2), s_ = (c_) * 64 + tl_; const bf16_t* yb_ = ybuf + ((c_) & 1) * 64 * RWS + tl_ * RWS + 16 * (lane & 3); \
            const u32x4 y0_ = *(const u32x4*)yb_, y1_ = *(const u32x4*)(yb_ + 8); \
            if (s_ < LSEQ) { const int p_ = d ? LSEQ - 1 - s_ : s_; bf16_t* g_ = YFB + ((size_t)d * NT + rowof(b, p_)) * 512 + h * 64 + 16 * (lane & 3); *(u32x4*)g_ = y0_; *(u32x4*)(g_ + 8) = y1_; } } while (0)
        const f32x4 zero4 = (f32x4){0.f, 0.f, 0.f, 0.f};
        f32x4 S[4] = {zero4, zero4, zero4, zero4};
#define RW2_COMPUTE(c_) do { const bf16_t* sl_ = (const bf16_t*)(lds + ((c_) % 3) * SLOT); const bf16_t* sP = sl_; const bf16_t* sY = sl_ + 64 * RWS; const bf16_t* sQ = sl_ + 2 * 64 * RWS; const bf16_t* sZ = sl_ + 3 * 64 * RWS; \
            bf16_t* yo_ = ybuf + ((c_) & 1) * 64 * RWS + 16 * vb + fr; \
            union { bf16x8 v; unsigned u[4]; } bs[2]; \
            _Pragma("unroll") for (int ks = 0; ks < 2; ++ks) { bs[ks].u[0] = pk2(S[2 * ks][0], S[2 * ks][1]); bs[ks].u[1] = pk2(S[2 * ks][2], S[2 * ks][3]); \
                bs[ks].u[2] = pk2(S[2 * ks + 1][0], S[2 * ks + 1][1]); bs[ks].u[3] = pk2(S[2 * ks + 1][2], S[2 * ks + 1][3]); } \
            _Pragma("unroll") for (int tt = 0; tt < 4; ++tt) { \
                const u32x2 z2 = *(const u32x2*)(sZ + (16 * vb + fr) * RWS + 16 * tt + 4 * fq); \
                f32x4 acc = (f32x4){bflo(z2.x), bfhi(z2.x), bflo(z2.y), bfhi(z2.y)}; \
                acc = __builtin_amdgcn_mfma_f32_16x16x32_bf16(*(const bf16x8*)(sY + (16 * tt + fr) * RWS + 8 * fq), bs[0].v, acc, 0, 0, 0); \
                acc = __builtin_amdgcn_mfma_f32_16x16x32_bf16(*(const bf16x8*)(sY + (16 * tt + fr) * RWS + 32 + 8 * fq), bs[1].v, acc, 0, 0, 0); \
                _Pragma("unroll") for (int j = 0; j < 4; ++j) yo_[(16 * tt + 4 * fq + j) * RWS] = (bf16_t)f2bf(acc[j]); } \
            f32x4 Sn[4]; \
            _Pragma("unroll") for (int kt = 0; kt < 4; ++kt) { \
                const u32x2 q2 = *(const u32x2*)(sQ + (16 * vb + fr) * RWS + 16 * kt + 4 * fq); \
                f32x4 acc = (f32x4){bflo(q2.x), bfhi(q2.x), bflo(q2.y), bfhi(q2.y)}; \
                acc = __builtin_amdgcn_mfma_f32_16x16x32_bf16(*(const bf16x8*)(sP + (16 * kt + fr) * RWS + 8 * fq), bs[0].v, acc, 0, 0, 0); \
                acc = __builtin_amdgcn_mfma_f32_16x16x32_bf16(*(const bf16x8*)(sP + (16 * kt + fr) * RWS + 32 + 8 * fq), bs[1].v, acc, 0, 0, 0); \
                Sn[kt] = acc; } \
            _Pragma("unroll") for (int kt = 0; kt < 4; ++kt) S[kt] = Sn[kt]; } while (0)
#define RW2_BAR() do { asm volatile("s_waitcnt lgkmcnt(0)" ::: "memory"); __builtin_amdgcn_s_barrier(); asm volatile("" ::: "memory"); } while (0)
        if (!comp) { RW2_LD(R0, 0); RW2_ST(R0, 0); RW2_LD(R0, 1); RW2_LD(R1, 2); RW2_LD(R2, 3); }
        __syncthreads();
        for (int c = 0; c < RW_NCH; c += 3) {
            if (!comp) { if (c + 1 < RW_NCH) RW2_ST(R0, c + 1); if (c + 4 < RW_NCH) RW2_LD(R0, c + 4); if (c > 0) RW2_FLUSH(c - 1); } else RW2_COMPUTE(c);
            RW2_BAR();
            if (!comp) { if (c + 2 < RW_NCH) RW2_ST(R1, c + 2); if (c + 5 < RW_NCH) RW2_LD(R1, c + 5); RW2_FLUSH(c); } else RW2_COMPUTE(c + 1);
            RW2_BAR();
            if (!comp) { if (c + 3 < RW_NCH) RW2_ST(R2, c + 3); if (c + 6 < RW_NCH) RW2_LD(R2, c + 6); RW2_FLUSH(c + 1); } else RW2_COMPUTE(c + 2);
            RW2_BAR();
        }
        if (!comp) RW2_FLUSH(RW_NCH - 1);
#undef RW2_LD
#undef RW2_ST
#undef RW2_FLUSH
#undef RW2_COMPUTE
#undef RW2_BAR
    } else {
        na_units(P, lds, (bid - 32) * 8 + (threadIdx.x >> 6), (G - 32) * 8);
    }
}

__device__ __forceinline__ void phase_7(CParams& P, unsigned char* lds, const int ph) {
    PHASE_PROLOGUE
            for (int row = gw; row < NT; row += NGW) {
                const int c0 = lane * 8;
                const u32x4 yf = *(const u32x4*)(YFB + (size_t)row * 512 + c0);
                const u32x4 yb = *(const u32x4*)(YFB + ((size_t)NT + row) * 512 + c0);
                const u32x4 vv = *(const u32x4*)(VV + (size_t)row * 512 + c0);
                const u32x4 gg = *(const u32x4*)(Gg + (size_t)row * 512 + c0);
                float y[8], v[8], g[8];
#pragma unroll
                for (int i = 0; i < 4; ++i) { y[2 * i] = bflo(yf[i]) + bflo(yb[i]); y[2 * i + 1] = bfhi(yf[i]) + bfhi(yb[i]); v[2 * i] = bflo(vv[i]); v[2 * i + 1] = bfhi(vv[i]); g[2 * i] = bflo(gg[i]); g[2 * i + 1] = bfhi(gg[i]); }
                float sm = 0.f;
#pragma unroll
                for (int i = 0; i < 8; ++i) sm += y[i];
                sm += __shfl_xor(sm, 1); sm += __shfl_xor(sm, 2); sm += __shfl_xor(sm, 4);
                const float mean = sm * (1.f / 64.f);
                float vr = 0.f;
#pragma unroll
                for (int i = 0; i < 8; ++i) { const float dlt = y[i] - mean; vr += dlt * dlt; }
                vr += __shfl_xor(vr, 1); vr += __shfl_xor(vr, 2); vr += __shfl_xor(vr, 4);
                const float rstd = rsqrtf(vr * (1.f / 64.f) + 64e-5f);
                const float bc = BC[(size_t)row * 8 + (lane >> 3)];
                float o[8];
#pragma unroll
                for (int i = 0; i < 8; ++i) o[i] = ((y[i] - mean) * rstd * lnx_g[c0 + i] + lnx_b[c0 + i] + bc * v[i]) * g[i];
                u32x4 ov; ov.x = pk2(o[0], o[1]); ov.y = pk2(o[2], o[3]); ov.z = pk2(o[4], o[5]); ov.w = pk2(o[6], o[7]);
                *(u32x4*)(A2 + (size_t)row * DM + 512 + c0) = ov;
            }
}


__device__ __forceinline__ void phase_8(CParams& P, unsigned char* lds, const int ph) {
    PHASE_PROLOGUE
    if (gw < 64) meta_gemm<0>(A2 + (size_t)NMAIN * DM, WTOUT, H + (size_t)NMAIN * DM, gw, lane);
    pg8::DenseOrder S; S.init(A2, WTOUT, NMAIN, DM, DM, G, bid);
    pg8::EpiResidual E{H};
    pg8::gemm_phase<pg8::EpiResidual, pg8::DenseOrder, true, true>((PG8_LAS unsigned char*)lds, DM, S, E);
}

__device__ __forceinline__ void phase_9(CParams& P, unsigned char* lds, const int ph) {
    PHASE_PROLOGUE
            const int l = ph == 9 ? 0 : 1;
                    for (int i = bid * 512 + tid; i < MOE_MAXROWS; i += G * 512) ROWTOK[i] = 0;
    unsigned* cnt = CTL + CW_CNT(l);
            const float* wg = moe_wg + (size_t)l * DM * 4; const float* bg = moe_bg + l * 4;
            for (int row = gw; row < NT; row += NGW) {
                f32x4 v[4]; float ss = 0.f;
#pragma unroll
                for (int j = 0; j < 4; ++j) { v[j] = ldrow_bf16(H + (size_t)row * DM, lane, j); ss += v[j][0] * v[j][0] + v[j][1] * v[j][1] + v[j][2] * v[j][2] + v[j][3] * v[j][3]; }
                ss = wave_sum(ss);
                const float rstd = rsqrtf(ss * (1.f / DM) + 1e-6f);
                float lg[4] = {0.f, 0.f, 0.f, 0.f};
#pragma unroll
                for (int j = 0; j < 4; ++j) {
                    const f32x4 g = ((const f32x4*)(norm_ffn + l * DM))[lane + 64 * j];
#pragma unroll
                    for (int i = 0; i < 4; ++i) v[j][i] = v[j][i] * rstd * g[i];
                    u32x2 o; o.x = pk2(v[j][0], v[j][1]); o.y = pk2(v[j][2], v[j][3]);
                    ((u32x2*)(HN + (size_t)row * DM))[lane + 64 * j] = o;
#pragma unroll
                    for (int i = 0; i < 4; ++i) { const f32x4 w = *(const f32x4*)(wg + (size_t)(4 * (lane + 64 * j) + i) * 4);
                        lg[0] += v[j][i] * w[0]; lg[1] += v[j][i] * w[1]; lg[2] += v[j][i] * w[2]; lg[3] += v[j][i] * w[3]; }
                }
#pragma unroll
                for (int q = 0; q < 4; ++q) lg[q] = wave_sum(lg[q]) + bg[q];
                int grp = 0; float mx = lg[0];
#pragma unroll
                for (int q = 1; q < 4; ++q) if (lg[q] > mx) { mx = lg[q]; grp = q; }
                float den = 0.f;
#pragma unroll
                for (int q = 0; q < 4; ++q) den += __expf(lg[q] - mx);
                const float pgrp = 1.f / den;
                const float* we = moe_we + ((size_t)(l * 4 + grp) * DM) * 8;
                float le[8] = {0.f, 0.f, 0.f, 0.f, 0.f, 0.f, 0.f, 0.f};
#pragma unroll
                for (int j = 0; j < 4; ++j)
#pragma unroll
                    for (int i = 0; i < 4; ++i) { const float* wr_ = we + (size_t)(4 * (lane + 64 * j) + i) * 8; const f32x4 wa = *(const f32x4*)wr_, wb = *(const f32x4*)(wr_ + 4);
                        le[0] += v[j][i] * wa[0]; le[1] += v[j][i] * wa[1]; le[2] += v[j][i] * wa[2]; le[3] += v[j][i] * wa[3];
                        le[4] += v[j][i] * wb[0]; le[5] += v[j][i] * wb[1]; le[6] += v[j][i] * wb[2]; le[7] += v[j][i] * wb[3]; }
#pragma unroll
                for (int q = 0; q < 8; ++q) le[q] = wave_sum(le[q]) + moe_be[(l * 4 + grp) * 8 + q];
                int i1 = 0; float m1 = le[0];
#pragma unroll
                for (int q = 1; q < 8; ++q) if (le[q] > m1) { m1 = le[q]; i1 = q; }
                int i2 = (i1 + 1) & 7; float m2 = -3.0e38f;
#pragma unroll
                for (int q = 0; q < 8; ++q) if (q != i1 && le[q] > m2) { m2 = le[q]; i2 = q; }
                const float e2 = __expf(m2 - m1);
                const float g1 = pgrp / (1.f + e2), g2 = pgrp * e2 / (1.f + e2);
                if (lane == 0) {
                    const int ea = grp * 8 + i1, eb = grp * 8 + i2;
                    const unsigned pa = atomicAdd(cnt + ea, 1u), pb = atomicAdd(cnt + eb, 1u);
                    EID[row * 2] = ea; EID[row * 2 + 1] = eb; POS[row * 2] = (int)pa; POS[row * 2 + 1] = (int)pb;
                    GATE[row * 2] = g1; GATE[row * 2 + 1] = g2;
                }
            }
    for (int it = gw; it < CONV_MOE_ITEMS; it += NGW) conv_moe_item(P, l, it, lane);
}


__device__ __forceinline__ void phase_10(CParams& P, unsigned char* lds, const int ph) {
    PHASE_PROLOGUE
    const int l = ph == 10 ? 0 : 1;
    int* ps = (int*)(lds + LDS_TAB);
    if (tid == 0) { int acc_ = 0; for (int e = 0; e < NEXP; ++e) { ps[e] = acc_; const int c = (int)CTL[CW_CNT(l) + e]; acc_ += (c + MOE_RT - 1) / MOE_RT * MOE_RT; } ps[NEXP] = acc_; }
    __syncthreads();
    for (int i = bid * 512 + tid; i < NT * 2; i += G * 512) { const int dest = ps[EID[i]] + POS[i]; DEST[i] = dest; ROWTOK[dest] = i >> 1; }
    __syncthreads();
}

__device__ __forceinline__ void phase_11(CParams& P, unsigned char* lds, const int ph) {
    PHASE_PROLOGUE
    const int l = ph == 11 ? 0 : 1;
    int* et = (int*)(lds + LDS_TAB);
    if (tid == 0) { int acc_ = 0; for (int e = 0; e < NEXP; ++e) { const int c = (int)CTL[CW_CNT(l) + e], n = (c + MOE_RT - 1) / MOE_RT; for (int q = 0; q < n; ++q) et[1 + acc_ + q] = e; acc_ += n; } et[0] = acc_; }
    __syncthreads();
    pg8::MoeOrder<true> S{et + 1, et[0], vcu, (const char*)HN, (const char*)WT13, 256u * DM * 2u, 256u * DM * 2u, (unsigned)DM * DM * 2u, ROWTOK};
    pg8::EpiSwiglu E{HB};
    pg8::gemm_phase<pg8::EpiSwiglu, pg8::MoeOrder<true>, true, true>((PG8_LAS unsigned char*)lds, DM, S, E);
    __syncthreads();
}

__device__ __forceinline__ void phase_12(CParams& P, unsigned char* lds, const int ph) {
    PHASE_PROLOGUE
    const int l = ph == 12 ? 0 : 1;
    int* et = (int*)(lds + LDS_TAB);
    if (tid == 0) { int acc_ = 0; for (int e = 0; e < NEXP; ++e) { const int c = (int)CTL[CW_CNT(l) + e], n = (c + MOE_RT - 1) / MOE_RT; for (int q = 0; q < n; ++q) et[1 + acc_ + q] = e; acc_ += n; } et[0] = acc_; }
    __syncthreads();
    pg8::MoeOrder<false> S{et + 1, et[0], vcu, (const char*)HB, (const char*)WT2, 256u * DFF * 2u, 256u * DFF * 2u, (unsigned)DM * DFF * 2u, nullptr};
    pg8::EpiBf16Plain E{YB, DM};
    pg8::gemm_phase<pg8::EpiBf16Plain, pg8::MoeOrder<false>, true, true>((PG8_LAS unsigned char*)lds, DFF, S, E);
    __syncthreads();
}

__device__ __forceinline__ void phase_13(CParams& P, unsigned char* lds, const int ph) {
    PHASE_PROLOGUE
            const bool fin = ph == 21;
            for (int row = gw; row < NT; row += NGW) {
                const int d0 = DEST[row * 2], d1 = DEST[row * 2 + 1];
                const float g0 = GATE[row * 2], g1 = GATE[row * 2 + 1];
                f32x4 v[4];
#pragma unroll
                for (int j = 0; j < 4; ++j) {
                    v[j] = ldrow_bf16(H + (size_t)row * DM, lane, j);
                    const u32x2 ya = ((const u32x2*)(YB + (size_t)d0 * DM))[lane + 64 * j];
                    const u32x2 yb = ((const u32x2*)(YB + (size_t)d1 * DM))[lane + 64 * j];
                    v[j][0] += g0 * bflo(ya.x) + g1 * bflo(yb.x); v[j][1] += g0 * bfhi(ya.x) + g1 * bfhi(yb.x);
                    v[j][2] += g0 * bflo(ya.y) + g1 * bflo(yb.y); v[j][3] += g0 * bfhi(ya.y) + g1 * bfhi(yb.y);
                }
                if (!fin) {
#pragma unroll
                    for (int j = 0; j < 4; ++j) strow_bf16(H + (size_t)row * DM, lane, j, v[j]);
                    store_norm_bf16(v, norm_mix + DM, HN + (size_t)row * DM, lane);
                } else if (row < NMAIN) {
                    float ss = 0.f;
#pragma unroll
                    for (int j = 0; j < 4; ++j) ss += v[j][0] * v[j][0] + v[j][1] * v[j][1] + v[j][2] * v[j][2] + v[j][3] * v[j][3];
                    ss = wave_sum(ss);
                    const float rstd = rsqrtf(ss * (1.f / DM) + 1e-6f);
#pragma unroll
                    for (int j = 0; j < 4; ++j) { const f32x4 g = ((const f32x4*)norm_final)[lane + 64 * j]; f32x4 o;
                        o[0] = v[j][0] * rstd * g[0]; o[1] = v[j][1] * rstd * g[1]; o[2] = v[j][2] * rstd * g[2]; o[3] = v[j][3] * rstd * g[3];
                        ((f32x4*)(P.out + (size_t)row * DM))[lane + 64 * j] = o; }
                }
            }
}

__device__ __forceinline__ void phase_14(CParams& P, unsigned char* lds, const int ph) {
    PHASE_PROLOGUE
    float* pwr = (float*)lds; float* pwi = pwr + 2176; float* bbr = pwi + 2176; float* bbi = bbr + 2048; float* ccr = bbi + 2048; float* cci = ccr + 2048; float* kf = cci + 2048; float* kb = kf + 4096;
    for (int gu = bid; gu < 256; gu += G) {
        const int g = gu >> 2, part = gu & 3;
        if (tid < 128) {
            const int d = tid >> 6, p = tid & 63;
            const float step = __expf(s5_ls[d * 64 + g]);
            const float lr = s5_lre[(d * 64 + g) * 64 + p], li = s5_lim[(d * 64 + g) * 64 + p];
            const float mag = expf(lr * step);
            const float abr = mag * cosf(li * step), abi = mag * sinf(li * step);
            const float den = lr * lr + li * li;
            const float zr = ((abr - 1.f) * lr + abi * li) / den, zi = (abi * lr - (abr - 1.f) * li) / den;
            float pr = 1.f, pi = 0.f;
            for (int t = 0; t < 17; ++t) { pwr[(d * 64 + p) * 17 + t] = pr; pwi[(d * 64 + p) * 17 + t] = pi; const float nr = pr * abr - pi * abi; pi = pr * abi + pi * abr; pr = nr; }
            for (int i = 0; i < 16; ++i) { const float br = s5_b_re[((size_t)(g * 64 + p)) * 16 + i], bi = s5_b_im[((size_t)(g * 64 + p)) * 16 + i];
                bbr[(d * 64 + p) * 16 + i] = zr * br - zi * bi; bbi[(d * 64 + p) * 16 + i] = zr * bi + zi * br; }
        }
        for (int idx = tid; idx < 2048; idx += 512) { const int d = idx >> 10, i = (idx >> 6) & 15, p = idx & 63;
            ccr[(d * 64 + p) * 16 + i] = s5_c_re[((size_t)(d * 64 + g) * 16 + i) * 64 + p]; cci[(d * 64 + p) * 16 + i] = s5_c_im[((size_t)(d * 64 + g) * 16 + i) * 64 + p]; }
        __syncthreads();
        {
            const int d = tid >> 8, tau = (tid >> 4) & 15, i = tid & 15;
            float acc[16];
#pragma unroll
            for (int q = 0; q < 16; ++q) acc[q] = 0.f;
            for (int p = 0; p < 64; ++p) {
                const float cr = ccr[(d * 64 + p) * 16 + i], ci = cci[(d * 64 + p) * 16 + i], pr = pwr[(d * 64 + p) * 17 + tau], pi = pwi[(d * 64 + p) * 17 + tau];
                const float xr = cr * pr - ci * pi, xi = cr * pi + ci * pr;
#pragma unroll
                for (int q = 0; q < 16; ++q) acc[q] += xr * bbr[(d * 64 + p) * 16 + q] - xi * bbi[(d * 64 + p) * 16 + q];
            }
            float* kt = (d ? kb : kf) + (tau * 16 + i) * 16;
#pragma unroll
            for (int q = 0; q < 16; ++q) kt[q] = acc[q];
        }
        __syncthreads();
        unsigned* bta = (unsigned*)(BTA + (size_t)g * 512 * 256);
        for (int idx = part * 128 * 128 + tid; idx < (part + 1) * 128 * 128; idx += 512) {
            const int row = idx >> 7, col = (idx & 127) * 2;
            float v[2];
#pragma unroll
            for (int e = 0; e < 2; ++e) {
                const int cc_ = col + e, j = cc_ >> 4, ip = cc_ & 15;
                if (row < 256) { const int t = row >> 4, i = row & 15;
                    v[e] = j < t ? kf[((t - j) * 16 + i) * 16 + ip] : (j > t ? kb[((j - t) * 16 + i) * 16 + ip] : kf[i * 16 + ip] + kb[i * 16 + ip]); }
                else { const int kp = row - 256, d = kp >> 7, part = (kp >> 6) & 1, p = kp & 63, tau = d == 0 ? 15 - j : j;
                    const float pr = pwr[(d * 64 + p) * 17 + tau], pi = pwi[(d * 64 + p) * 17 + tau], br = bbr[(d * 64 + p) * 16 + ip], bi = bbi[(d * 64 + p) * 16 + ip];
                    v[e] = part ? pr * bi + pi * br : pr * br - pi * bi; }
            }
            bta[idx] = pk2(v[0], v[1]);
        }
        unsigned* btc = (unsigned*)(BTC + (size_t)g * 256 * 256);
        for (int idx = part * 64 * 128 + tid; idx < (part + 1) * 64 * 128; idx += 512) {
            const int row = idx >> 7, col = (idx & 127) * 2, t = row >> 4, i = row & 15;
            float v[2];
#pragma unroll
            for (int e = 0; e < 2; ++e) {
                const int k = col + e, d = k >> 7, part = (k >> 6) & 1, p = k & 63, tau = d == 0 ? t + 1 : 16 - t;
                const float cr = ccr[(d * 64 + p) * 16 + i], ci = cci[(d * 64 + p) * 16 + i], pr = pwr[(d * 64 + p) * 17 + tau], pi = pwi[(d * 64 + p) * 17 + tau];
                v[e] = part ? -(cr * pi + ci * pr) : cr * pr - ci * pi;
            }
            btc[idx] = pk2(v[0], v[1]);
        }
        __syncthreads();
    }
}

__device__ __forceinline__ void phase_15(CParams& P, unsigned char* lds, const int ph) {
    PHASE_PROLOGUE
    pg8::S5OrderA S{vcu, (const char*)HN, (const char*)BTA};
    pg8::EpiS5A E{YI, S5E};
    int Kr = 256; asm volatile("" : "+s"(Kr));
    pg8::gemm_phase<pg8::EpiS5A, pg8::S5OrderA, true, true>((PG8_LAS unsigned char*)lds, Kr, S, E);
}

__device__ __forceinline__ void phase_16(CParams& P, unsigned char* lds, const int ph) {
    PHASE_PROLOGUE
    float* Ls = (float*)lds;
    for (int wg = bid; wg < NB * 64 * 2; wg += G) {
        const int d = wg & 1, g = (wg >> 1) & 63, b = wg >> 7, p = lane;
        const float step = __expf(s5_ls[d * 64 + g]);
        const float lr = s5_lre[(d * 64 + g) * 64 + p], li = s5_lim[(d * 64 + g) * 64 + p];
        const float mag = expf(lr * step);
        const float abr = mag * cosf(li * step), abi = mag * sinf(li * step);
        float ar = 1.f, ai = 0.f;
        for (int t = 0; t < 16; ++t) { const float nr = ar * abr - ai * abi; ai = ar * abi + ai * abr; ar = nr; }
        float Ar = 1.f, Ai = 0.f;
        for (int t = 0; t < 64; ++t) { const float nr = Ar * ar - Ai * ai; Ai = Ar * ai + Ai * ar; Ar = nr; }
        const bf16_t* Ep = S5E + (size_t)g * 256 + d * 128 + p;
        bf16_t* Cp = CAR + (size_t)g * 1280 * 256 + d * 128 + p;
        const int q0 = 64 * wave;
#define S5_N(q_) ({ const int c_ = d ? 512 - (q_) : (q_); c_ == 0 ? 1024 + b : b * 512 + c_ - 1; })
        float sr = 0.f, si = 0.f;
#pragma unroll 1
        for (int hb = 0; hb < 2; ++hb) {
            float er[32], ei[32];
#pragma unroll
            for (int k = 0; k < 32; ++k) { const int n = S5_N(q0 + 32 * hb + k); er[k] = bf2f(Ep[(size_t)n * 64 * 256]); ei[k] = bf2f(Ep[(size_t)n * 64 * 256 + 64]); }
#pragma unroll
            for (int k = 0; k < 32; ++k) { const float nr = ar * sr - ai * si + er[k]; si = ar * si + ai * sr + ei[k]; sr = nr; }
        }
        Ls[(wave * 64 + p) * 2] = sr; Ls[(wave * 64 + p) * 2 + 1] = si;
        __syncthreads();
        sr = 0.f; si = 0.f;
        for (int w2 = 0; w2 < wave; ++w2) { const float l0 = Ls[(w2 * 64 + p) * 2], l1 = Ls[(w2 * 64 + p) * 2 + 1]; const float nr = Ar * sr - Ai * si + l0; si = Ar * si + Ai * sr + l1; sr = nr; }
#pragma unroll 1
        for (int hb = 0; hb < 2; ++hb) {
            float er[32], ei[32]; int nn[32];
#pragma unroll
            for (int k = 0; k < 32; ++k) { nn[k] = S5_N(q0 + 32 * hb + k); er[k] = bf2f(Ep[(size_t)nn[k] * 64 * 256]); ei[k] = bf2f(Ep[(size_t)nn[k] * 64 * 256 + 64]); }
#pragma unroll
            for (int k = 0; k < 32; ++k) { Cp[(size_t)nn[k] * 256] = (bf16_t)f2bf(sr); Cp[(size_t)nn[k] * 256 + 64] = (bf16_t)f2bf(si);
                const float nr = ar * sr - ai * si + er[k]; si = ar * si + ai * sr + ei[k]; sr = nr; }
        }
        if (wave == 7) { const int n = S5_N(512); Cp[(size_t)n * 256] = (bf16_t)f2bf(sr); Cp[(size_t)n * 256 + 64] = (bf16_t)f2bf(si); }
#undef S5_N
        __syncthreads();
    }
}

__device__ __forceinline__ void phase_22(CParams& P, unsigned char* lds, const int ph) {
    PHASE_PROLOGUE
    pg8::S5OrderC S{vcu, (const char*)CAR, (const char*)BTC};
    pg8::EpiS5C E{YI, HN, s5_d, A2};
    int Kr = 256; asm volatile("" : "+s"(Kr));
    pg8::gemm_phase<pg8::EpiS5C, pg8::S5OrderC, true, true>((PG8_LAS unsigned char*)lds, Kr, S, E);
}

__device__ __forceinline__ void phase_23(CParams& P, unsigned char* lds, const int ph) {
    PHASE_PROLOGUE
    if (gw < 64) meta_gemm<1>(A2 + (size_t)NMAIN * DM, WTGLU, H + (size_t)NMAIN * DM, gw, lane);
    pg8::DenseOrder S; S.init(A2, WTGLU, NMAIN, 2 * DM, DM, G, bid);
    pg8::EpiGlu E{H};
    pg8::gemm_phase<pg8::EpiGlu, pg8::DenseOrder, true, true>((PG8_LAS unsigned char*)lds, DM, S, E);
}
#define LAS __attribute__((address_space(3)))
#define CW_BAR 4096
#define XB_TMO      128
#define XB_XCNT(j)  (256  + 64 * (j))
#define XB_XSUB(j)  (1280 + 64 * (j))
#define XB_XGEN(j)  (2304 + 64 * (j))
#define XB_TOP      3328
#define XB_TOPGEN   3392
#define XCD_BAR_WORDS 3456
#define XB_SPIN_CAP (1u << 22)
__device__ __forceinline__ unsigned xb_ld(unsigned* p)              { return __hip_atomic_load(p, __ATOMIC_RELAXED, __HIP_MEMORY_SCOPE_AGENT); }
__device__ __forceinline__ unsigned xb_add(unsigned* p, unsigned v) { return __hip_atomic_fetch_add(p, v, __ATOMIC_RELAXED, __HIP_MEMORY_SCOPE_AGENT); }
__device__ __forceinline__ unsigned xb_xcc_id() { return (unsigned)__builtin_amdgcn_s_getreg((3 << 11) | 20) & 0xFu; }
#define XB_SPIN(cond, bar) do { unsigned _sp = 0; while (cond) { __builtin_amdgcn_s_sleep(1); \
    if ((++_sp & 255u) == 0u) { if (xb_ld(&(bar)[XB_TMO])) break; if (_sp > XB_SPIN_CAP) { atomicAdd(&(bar)[XB_TMO], 1u); break; } } } } while (0)
struct XcdBarrier { unsigned* bar; unsigned x; volatile LAS unsigned* st; };
__device__ __forceinline__ XcdBarrier xcd_barrier_post(unsigned* bar, volatile LAS unsigned* st) {
    XcdBarrier b; b.bar = bar; b.x = xb_xcc_id(); b.st = st;
    if (threadIdx.x == 0) (void)xb_add(&bar[XB_XCNT(b.x)], 1u);
    return b;
}
__device__ __forceinline__ void xcd_barrier_complete(unsigned* bar, unsigned x, unsigned& nloc, unsigned& nx) {
    const unsigned G = GRID;
    unsigned sum, cnt, mine, sp = 0u;
    for (;;) {
        sum = 0u; cnt = 0u; mine = 0u;
#pragma unroll
        for (unsigned j = 0; j < 16; ++j) { const unsigned c = xb_ld(&bar[XB_XCNT(j)]); sum += c; cnt += (c > 0u) ? 1u : 0u; mine = (j == x) ? c : mine; }
        if (sum == G) break;
        __builtin_amdgcn_s_sleep(1);
        if ((++sp & 255u) == 0u) { if (xb_ld(&bar[XB_TMO])) break; if (sp > XB_SPIN_CAP) { atomicAdd(&bar[XB_TMO], 1u); break; } }
    }
    nloc = mine > 0u ? mine : 1u; nx = cnt > 0u ? cnt : 1u;
}
__device__ __forceinline__ void xcd_barrier(const XcdBarrier& b) {
    asm volatile("s_waitcnt vmcnt(0)" ::: "memory");
    __syncthreads();
    if (threadIdx.x == 0) {
        unsigned* bar = b.bar;
        __builtin_amdgcn_s_waitcnt(0);
        unsigned nloc = b.st[0], nx = b.st[1];
        if (nloc == 0u) { xcd_barrier_complete(bar, b.x, nloc, nx); b.st[0] = nloc; b.st[1] = nx; }
        const unsigned old = xb_add(&bar[XB_XSUB(b.x)], 1u);
        const unsigned gen = old / nloc;
        if (old + 1u == (gen + 1u) * nloc) {
            __builtin_amdgcn_fence(__ATOMIC_RELEASE, "agent");
            asm volatile("s_waitcnt vmcnt(0)" ::: "memory");
            const unsigned og = xb_add(&bar[XB_TOP], 1u);
            const unsigned tg = og / nx;
            if (og + 1u == (tg + 1u) * nx) xb_add(&bar[XB_TOPGEN], 1u);
            else XB_SPIN(xb_ld(&bar[XB_TOPGEN]) == tg, bar);
            __builtin_amdgcn_fence(__ATOMIC_ACQUIRE, "agent");
            xb_add(&bar[XB_XGEN(b.x)], 1u);
            asm volatile("s_waitcnt vmcnt(0)" ::: "memory");
        } else {
            XB_SPIN(xb_ld(&bar[XB_XGEN(b.x)]) == gen, bar);
            __builtin_amdgcn_fence(__ATOMIC_ACQUIRE, "agent");
            asm volatile("s_waitcnt vmcnt(0)" ::: "memory");
        }
    }
    __syncthreads();
}


__global__ void __launch_bounds__(512, 2) mega(Params P_) {
    extern __shared__ __attribute__((aligned(16))) unsigned char lds[];
    volatile LAS unsigned* st = (volatile LAS unsigned*)(LAS unsigned char*)(lds + LDS_BARST);
    if (threadIdx.x < 16) st[threadIdx.x] = 0u;
    __syncthreads();
    CParams* pp = (CParams*)__builtin_amdgcn_kernarg_segment_ptr();
    (void)xcd_barrier_post((unsigned*)(pp->ws + WS_CTL) + CW_BAR, st);
#define GB do { XcdBarrier bar_; bar_.bar = (unsigned*)(pp->ws + WS_CTL) + CW_BAR; bar_.x = xb_xcc_id(); bar_.st = (volatile LAS unsigned*)(LAS unsigned char*)(lds + LDS_BARST); xcd_barrier(bar_); asm volatile("" : "+s"(pp)); } while (0)
#define P (*pp)
    asm volatile("" : "+s"(pp));
    phase_0(P, lds, 0); GB;
#if defined(PROBE_PH) && PROBE_PH == 0
    { int nrep = PROBE_N; asm volatile("" : "+s"(nrep)); for (int rep = 0; rep < nrep; ++rep) { GB; phase_0(P, lds, 0); GB; } }
#endif
    phase_1(P, lds, 1); GB;
#if defined(PROBE_PH) && PROBE_PH == 1
    { int nrep = PROBE_N; asm volatile("" : "+s"(nrep)); for (int rep = 0; rep < nrep; ++rep) { GB; phase_1(P, lds, 1); GB; } }
#endif
    phase_3(P, lds, 3); GB;
#if defined(PROBE_PH) && PROBE_PH == 3
    { int nrep = PROBE_N; asm volatile("" : "+s"(nrep)); for (int rep = 0; rep < nrep; ++rep) { GB; phase_3(P, lds, 3); GB; } }
#endif
    phase_6(P, lds, 6); GB;
    phase_60(P, lds, 60); GB;
#if defined(PROBE_PH) && PROBE_PH == 60
    { int nrep = PROBE_N; asm volatile("" : "+s"(nrep)); for (int rep = 0; rep < nrep; ++rep) { GB; phase_60(P, lds, 60); GB; } }
#endif
#if defined(PROBE_PH) && PROBE_PH == 6
    { int nrep = PROBE_N; asm volatile("" : "+s"(nrep)); for (int rep = 0; rep < nrep; ++rep) { GB; phase_6(P, lds, 6); GB; } }
#endif
    phase_7(P, lds, 7); GB;
#if defined(PROBE_PH) && PROBE_PH == 7
    { int nrep = PROBE_N; asm volatile("" : "+s"(nrep)); for (int rep = 0; rep < nrep; ++rep) { GB; phase_7(P, lds, 7); GB; } }
#endif
    phase_8(P, lds, 8); GB;
#if defined(PROBE_PH) && PROBE_PH == 8
    { int nrep = PROBE_N; asm volatile("" : "+s"(nrep)); for (int rep = 0; rep < nrep; ++rep) { GB; phase_8(P, lds, 8); GB; } }
#endif
    phase_9(P, lds, 9); GB;
#if defined(PROBE_PH) && PROBE_PH == 9
    { int nrep = PROBE_N; asm volatile("" : "+s"(nrep)); for (int rep = 0; rep < nrep; ++rep) { GB; phase_9(P, lds, 9); GB; } }
#endif
    phase_10(P, lds, 10); GB;
#if defined(PROBE_PH) && PROBE_PH == 10
    { int nrep = PROBE_N; asm volatile("" : "+s"(nrep)); for (int rep = 0; rep < nrep; ++rep) { GB; phase_10(P, lds, 10); GB; } }
#endif
    phase_11(P, lds, 11); GB;
#if defined(PROBE_PH) && PROBE_PH == 11
    { int nrep = PROBE_N; asm volatile("" : "+s"(nrep)); for (int rep = 0; rep < nrep; ++rep) { GB; phase_11(P, lds, 11); GB; } }
#endif
    phase_12(P, lds, 12); GB;
#if defined(PROBE_PH) && PROBE_PH == 12
    { int nrep = PROBE_N; asm volatile("" : "+s"(nrep)); for (int rep = 0; rep < nrep; ++rep) { GB; phase_12(P, lds, 12); GB; } }
#endif
    phase_13(P, lds, 13); GB;
#if defined(PROBE_PH) && PROBE_PH == 13
    { int nrep = PROBE_N; asm volatile("" : "+s"(nrep)); for (int rep = 0; rep < nrep; ++rep) { GB; phase_13(P, lds, 13); GB; } }
#endif
    phase_14(P, lds, 14); GB;
#if defined(PROBE_PH) && PROBE_PH == 14
    { int nrep = PROBE_N; asm volatile("" : "+s"(nrep)); for (int rep = 0; rep < nrep; ++rep) { GB; phase_14(P, lds, 14); GB; } }
#endif
    phase_15(P, lds, 15); GB;
#if defined(PROBE_PH) && PROBE_PH == 15
    { int nrep = PROBE_N; asm volatile("" : "+s"(nrep)); for (int rep = 0; rep < nrep; ++rep) { GB; phase_15(P, lds, 15); GB; } }
#endif
    phase_16(P, lds, 16); GB;
#if defined(PROBE_PH) && PROBE_PH == 16
    { int nrep = PROBE_N; asm volatile("" : "+s"(nrep)); for (int rep = 0; rep < nrep; ++rep) { GB; phase_16(P, lds, 16); GB; } }
#endif
    phase_22(P, lds, 22); GB;
#if defined(PROBE_PH) && PROBE_PH == 22
    { int nrep = PROBE_N; asm volatile("" : "+s"(nrep)); for (int rep = 0; rep < nrep; ++rep) { GB; phase_22(P, lds, 22); GB; } }
#endif
    phase_23(P, lds, 23); GB;
#if defined(PROBE_PH) && PROBE_PH == 23
    { int nrep = PROBE_N; asm volatile("" : "+s"(nrep)); for (int rep = 0; rep < nrep; ++rep) { GB; phase_23(P, lds, 23); GB; } }
#endif
    phase_9(P, lds, 17); GB;
#if defined(PROBE_PH) && PROBE_PH == 17
    { int nrep = PROBE_N; asm volatile("" : "+s"(nrep)); for (int rep = 0; rep < nrep; ++rep) { GB; phase_9(P, lds, 17); GB; } }
#endif
    phase_10(P, lds, 18); GB;
#if defined(PROBE_PH) && PROBE_PH == 18
    { int nrep = PROBE_N; asm volatile("" : "+s"(nrep)); for (int rep = 0; rep < nrep; ++rep) { GB; phase_10(P, lds, 18); GB; } }
#endif
    phase_11(P, lds, 19); GB;
#if defined(PROBE_PH) && PROBE_PH == 19
    { int nrep = PROBE_N; asm volatile("" : "+s"(nrep)); for (int rep = 0; rep < nrep; ++rep) { GB; phase_11(P, lds, 19); GB; } }
#endif
    phase_12(P, lds, 20); GB;
#if defined(PROBE_PH) && PROBE_PH == 20
    { int nrep = PROBE_N; asm volatile("" : "+s"(nrep)); for (int rep = 0; rep < nrep; ++rep) { GB; phase_12(P, lds, 20); GB; } }
#endif
    phase_13(P, lds, 21);
#if defined(PROBE_PH) && PROBE_PH == 21
    { int nrep = PROBE_N; asm volatile("" : "+s"(nrep)); for (int rep = 0; rep < nrep; ++rep) { GB; phase_13(P, lds, 21); GB; } }
#endif
#undef P
#undef GB
}

extern "C" void kernel_launch(void* const* d_in, const int* in_sizes, int n_in, void* d_out, int out_size, void* d_ws, size_t ws_size, hipStream_t stream) {
    static int ready = 0;
    if (!ready) {
        if (n_in != 35 || ws_size < WS_TOTAL) { fprintf(stderr, "kernel_launch: unexpected n_in %d or ws_size %zu (need %zu)\n", n_in, ws_size, (size_t)WS_TOTAL); ready = -1; return; }
        if (hipFuncSetAttribute((const void*)mega, hipFuncAttributeMaxDynamicSharedMemorySize, LDS_BYTES) != hipSuccess) { fprintf(stderr, "kernel_launch: hipFuncSetAttribute failed\n"); ready = -1; return; }
        ready = 1;
    }
    if (ready < 0) return;
    (void)hipMemsetAsync((char*)d_ws + WS_CTL, 0, 1 * MiB, stream);
    Params P{};
    for (int i = 0; i < 35; ++i) P.in[i] = (const float*)d_in[i];
    P.out = (float*)d_out; P.ws = (unsigned char*)d_ws; P.ph_lo = 0; P.ph_hi = 0;
    hipLaunchKernelGGL(mega, dim3(GRID), dim3(512), LDS_BYTES, stream, P);
}
```

```cpp
#include <hip/hip_runtime.h>
#include <stdint.h>
#include <stdio.h>

#define DM 1024
#define NB 2
#define SEQ 8192
#define NMETA 16
#define LSEQ (SEQ + NMETA)
#define NMAIN (NB * SEQ)
#define NT (NB * LSEQ)
#define NTP 16640
#define INCOLS 3328
#define RESTC 1792
#define NEXP 32
#define DFF 512
#define S5TC 48
#define S5NC 171
#define MOE_RT 256
#define MOE_MAXROWS 41216

typedef unsigned short bf16_t;
typedef short bf16x8 __attribute__((ext_vector_type(8)));
typedef float f32x4 __attribute__((ext_vector_type(4)));
typedef unsigned u32x4 __attribute__((ext_vector_type(4)));
typedef unsigned u32x2 __attribute__((ext_vector_type(2)));

constexpr size_t MiB = 1u << 20;
constexpr size_t cmax2(size_t a, size_t b) { return a > b ? a : b; }
constexpr size_t al64k(size_t x) { return (x + 65535) & ~(size_t)65535; }
constexpr size_t WS_CTL = 0;
constexpr size_t WS_H = 1 * MiB;
constexpr size_t WS_HN = WS_H + al64k((size_t)NT * DM * 2);
constexpr size_t WS_A2 = WS_HN + al64k((size_t)NTP * DM * 2);
constexpr size_t WS_WTIN = WS_A2 + al64k((size_t)NTP * DM * 2);
constexpr size_t WS_WTOUT = WS_WTIN + al64k((size_t)INCOLS * DM * 2);
constexpr size_t WS_WTGLU = WS_WTOUT + al64k((size_t)DM * DM * 2);
constexpr size_t WS_LRT = WS_WTGLU + al64k((size_t)2 * DM * DM * 2);
constexpr size_t WS_BIG = WS_LRT + al64k((size_t)(2 * 512 * 64 * 2 + 512 * 128) * 2);
constexpr size_t SZ_T512 = al64k((size_t)NT * 512 * 2);
constexpr size_t SZ_P512 = al64k((size_t)NTP * 512 * 2);
constexpr int RW_NCH = 129, RW_UNITS = 32 * RW_NCH;
constexpr size_t SZ_RWOP = al64k((size_t)RW_UNITS * 4096 * 2);
constexpr size_t WS_Q = WS_BIG;
constexpr size_t WS_K = WS_Q + SZ_P512;
constexpr size_t WS_V = WS_K + SZ_P512;
constexpr size_t WS_REST = WS_V + SZ_P512;
constexpr size_t WS_KR = WS_REST + al64k((size_t)NTP * RESTC * 2);
constexpr size_t WS_LOW = WS_KR + SZ_T512;
constexpr size_t WS_AA = WS_LOW + al64k((size_t)NT * 256 * 2);
constexpr size_t WS_XEARLY = WS_AA + 2 * SZ_T512;
constexpr size_t WS_PP = WS_REST;
constexpr size_t WS_QT = WS_PP + SZ_RWOP;
constexpr size_t WS_YT = WS_QT + SZ_RWOP;
constexpr size_t WS_ZT = WS_YT + SZ_RWOP;
constexpr size_t WS_XEND = cmax2(WS_XEARLY, WS_ZT + SZ_RWOP);
constexpr size_t WS_R = WS_XEND;
constexpr size_t WS_VV = WS_R + SZ_T512;
constexpr size_t WS_G = WS_VV + SZ_T512;
constexpr size_t WS_KK = WS_G + SZ_T512;
constexpr size_t WS_KKA = WS_KK + SZ_T512;
constexpr size_t WS_KD = WS_KKA + 2 * SZ_T512;
constexpr size_t WS_W = WS_KD + 2 * SZ_T512;
constexpr size_t WS_BC = WS_W + 2 * SZ_T512;
constexpr size_t WS_MIXEND = WS_BC + al64k((size_t)NT * 8 * 4);
constexpr size_t WS_YFB = WS_KK;
constexpr size_t WS_ROWTOK = WS_BIG;
constexpr size_t WS_HB = WS_ROWTOK + al64k((size_t)MOE_MAXROWS * 4);
constexpr size_t WS_YB = WS_HB + al64k((size_t)MOE_MAXROWS * DFF * 2);
constexpr size_t WS_WT13 = WS_YB + al64k((size_t)MOE_MAXROWS * DM * 2);
constexpr size_t WS_WT2 = WS_WT13 + al64k((size_t)NEXP * DM * DM * 2);
constexpr size_t WS_EID = WS_WT2 + al64k((size_t)NEXP * DM * DFF * 2);
constexpr size_t WS_POS = WS_EID + al64k((size_t)NT * 8);
constexpr size_t WS_DEST = WS_POS + al64k((size_t)NT * 8);
constexpr size_t WS_GATE = WS_DEST + al64k((size_t)NT * 8);
constexpr size_t WS_MOEEND = WS_GATE + al64k((size_t)NT * 8);
constexpr size_t WS_YI = WS_BIG;
constexpr size_t WS_E = WS_YI + al64k((size_t)NTP * DM * 2);
constexpr size_t WS_CAR = WS_E + al64k((size_t)1040 * 64 * 256 * 2);
constexpr size_t WS_BTA = WS_CAR + al64k((size_t)64 * 1280 * 256 * 2);
constexpr size_t WS_BTC = WS_BTA + al64k((size_t)64 * 512 * 256 * 2);
constexpr size_t WS_S5END = WS_BTC + al64k((size_t)64 * 256 * 256 * 2);
constexpr size_t cmax(size_t a, size_t b) { return a > b ? a : b; }
constexpr size_t WS_TOTAL = cmax(WS_MIXEND, cmax(WS_MOEEND, WS_S5END));
static_assert(WS_TOTAL <= 512 * MiB, "workspace map exceeds 512 MiB");

#define CW_CNT(l) (1024 + 64 * (l))

#define LDS_BYTES 163840
#define LDS_BARST (LDS_BYTES - 1024)
#define LDS_TAB (LDS_BYTES - 768)
#define LDS_RING (LDS_BYTES - 1024)
#define GRID 256

struct Params {
    const float* in[35];
    float* out;
    unsigned char* ws;
    int ph_lo, ph_hi;
};
typedef const __attribute__((address_space(4))) Params CParams;

__device__ __forceinline__ float bf2f(bf16_t v) { return __uint_as_float(((unsigned)v) << 16); }
typedef float f32x2c_ __attribute__((ext_vector_type(2)));
typedef __bf16 bf16x2c_ __attribute__((ext_vector_type(2)));
__device__ __forceinline__ unsigned pk2(float lo, float hi) { const f32x2c_ f = {lo, hi}; const bf16x2c_ b = __builtin_convertvector(f, bf16x2c_); return __builtin_bit_cast(unsigned, b); }
__device__ __forceinline__ unsigned f2bf(float f) { return (unsigned)__builtin_bit_cast(unsigned short, (__bf16)f); }
__device__ __forceinline__ float bflo(unsigned u) { return __uint_as_float(u << 16); }
__device__ __forceinline__ float bfhi(unsigned u) { return __uint_as_float(u & 0xffff0000u); }
template <int CTRL> __device__ __forceinline__ float dppf(float v) { return __int_as_float(__builtin_amdgcn_update_dpp(0, __float_as_int(v), CTRL, 0xF, 0xF, true)); }
__device__ __forceinline__ float row16_sum(float v) { v += dppf<0xB1>(v); v += dppf<0x4E>(v); v += dppf<0x141>(v); v += dppf<0x140>(v); return v; }
__device__ __forceinline__ float wave_sum(float v) {
    v = row16_sum(v);
    { const unsigned xu = __float_as_uint(v); const auto sw = __builtin_amdgcn_permlane16_swap(xu, xu, false, false); v = __uint_as_float(sw[0]) + __uint_as_float(sw[1]); }
    { const unsigned xu = __float_as_uint(v); const auto sw = __builtin_amdgcn_permlane32_swap(xu, xu, false, false); v = __uint_as_float(sw[0]) + __uint_as_float(sw[1]); }
    return v;
}
__device__ __forceinline__ float wave_max(float v) {
    v = fmaxf(v, dppf<0xB1>(v)); v = fmaxf(v, dppf<0x4E>(v)); v = fmaxf(v, dppf<0x141>(v)); v = fmaxf(v, dppf<0x140>(v));
    { const unsigned xu = __float_as_uint(v); const auto sw = __builtin_amdgcn_permlane16_swap(xu, xu, false, false); v = fmaxf(__uint_as_float(sw[0]), __uint_as_float(sw[1])); }
    { const unsigned xu = __float_as_uint(v); const auto sw = __builtin_amdgcn_permlane32_swap(xu, xu, false, false); v = fmaxf(__uint_as_float(sw[0]), __uint_as_float(sw[1])); }
    return v;
}
__device__ __forceinline__ float sigmoidf_(float x) { return __builtin_amdgcn_rcpf(1.f + __expf(-x)); }
__device__ __forceinline__ int rowof(int b, int p) { return p < NMETA ? NMAIN + b * NMETA + p : b * SEQ + (p - NMETA); }

#define SA_STRIDE 40
template <class AF, class BF>
__device__ __forceinline__ void gemm_tile(unsigned char* lds, int K, int ldb, const AF& arow, const BF& bcol, f32x4 (&acc)[4][2]) {
    bf16_t* sA = (bf16_t*)lds;
    bf16_t* sB = (bf16_t*)(lds + 128 * SA_STRIDE * 2);
    const int tid = threadIdx.x, lane = tid & 63, wave = tid >> 6, wr = wave >> 2, wc = wave & 3, fr = lane & 15, fq = lane >> 4;
#pragma unroll
    for (int mi = 0; mi < 4; ++mi)
#pragma unroll
        for (int ni = 0; ni < 2; ++ni) acc[mi][ni] = (f32x4){0.f, 0.f, 0.f, 0.f};
    const int ar = tid >> 2, akc = (tid & 3) * 8;
    const bf16_t* ap = arow(ar) + akc;
    const int bnq = (tid & 31) * 4, bkp = (tid >> 5) * 2;
    const float* bp = bcol(bnq) + (size_t)bkp * ldb;
    const int nk = K / 32;
    u32x4 ra = *(const u32x4*)ap;
    f32x4 rb0 = *(const f32x4*)bp, rb1 = *(const f32x4*)(bp + ldb);
    for (int kt = 0; kt < nk; ++kt) {
        __syncthreads();
        *(u32x4*)(sA + ar * SA_STRIDE + akc) = ra;
        {
            unsigned* d = (unsigned*)(sB + bnq * SA_STRIDE + bkp);
            d[0 * (SA_STRIDE / 2)] = pk2(rb0[0], rb1[0]);
            d[1 * (SA_STRIDE / 2)] = pk2(rb0[1], rb1[1]);
            d[2 * (SA_STRIDE / 2)] = pk2(rb0[2], rb1[2]);
            d[3 * (SA_STRIDE / 2)] = pk2(rb0[3], rb1[3]);
        }
        __syncthreads();
        if (kt + 1 < nk) {
            ra = *(const u32x4*)(ap + (kt + 1) * 32);
            const float* q = bp + (size_t)(kt + 1) * 32 * ldb;
            rb0 = *(const f32x4*)q; rb1 = *(const f32x4*)(q + ldb);
        }
        bf16x8 a[4], b[2];
#pragma unroll
        for (int mi = 0; mi < 4; ++mi) a[mi] = *(const bf16x8*)(sA + (wr * 64 + mi * 16 + fr) * SA_STRIDE + fq * 8);
#pragma unroll
        for (int ni = 0; ni < 2; ++ni) b[ni] = *(const bf16x8*)(sB + (wc * 32 + ni * 16 + fr) * SA_STRIDE + fq * 8);
#pragma unroll
        for (int mi = 0; mi < 4; ++mi)
#pragma unroll
            for (int ni = 0; ni < 2; ++ni) acc[mi][ni] = __builtin_amdgcn_mfma_f32_16x16x32_bf16(a[mi], b[ni], acc[mi][ni], 0, 0, 0);
    }
    __syncthreads();
}
#define ACC_FOREACH(acc, ...) do { const int _l = threadIdx.x & 63, _w = threadIdx.x >> 6, _wr = _w >> 2, _wc = _w & 3, _fr = _l & 15, _fq = _l >> 4; \
    _Pragma("unroll") for (int _mi = 0; _mi < 4; ++_mi) _Pragma("unroll") for (int _ni = 0; _ni < 2; ++_ni) _Pragma("unroll") for (int _j = 0; _j < 4; ++_j) { \
        const int rl = _wr * 64 + _mi * 16 + _fq * 4 + _j, cl = _wc * 32 + _ni * 16 + _fr; const float val = acc[_mi][_ni][_j]; __VA_ARGS__ } } while (0)
#define ACC_FOREACH_PAIR(acc, ...) do { const int _l = threadIdx.x & 63, _w = threadIdx.x >> 6, _wr = _w >> 2, _wc = _w & 3, _fr = _l & 15, _fq = _l >> 4; \
    _Pragma("unroll") for (int _mi = 0; _mi < 4; ++_mi) _Pragma("unroll") for (int _j = 0; _j < 4; ++_j) { \
        const int rl = _wr * 64 + _mi * 16 + _fq * 4 + _j, co = _wc * 16 + _fr; const float va = acc[_mi][0][_j], vg = acc[_mi][1][_j]; __VA_ARGS__ } } while (0)

__device__ __forceinline__ void store_norm_bf16(const f32x4 (&v)[4], const float* gain, bf16_t* dst, int lane) {
    float ss = 0.f;
#pragma unroll
    for (int j = 0; j < 4; ++j) ss += v[j][0] * v[j][0] + v[j][1] * v[j][1] + v[j][2] * v[j][2] + v[j][3] * v[j][3];
    ss = wave_sum(ss);
    const float rstd = rsqrtf(ss * (1.f / DM) + 1e-6f);
#pragma unroll
    for (int j = 0; j < 4; ++j) {
        const f32x4 g = ((const f32x4*)gain)[lane + 64 * j];
        u32x2 o; o.x = pk2(v[j][0] * rstd * g[0], v[j][1] * rstd * g[1]); o.y = pk2(v[j][2] * rstd * g[2], v[j][3] * rstd * g[3]);
        ((u32x2*)dst)[lane + 64 * j] = o;
    }
}


__device__ __forceinline__ f32x4 ldrow_bf16(const bf16_t* row, int lane, int j) { const u32x2 u = ((const u32x2*)row)[lane + 64 * j]; return (f32x4){bflo(u.x), bfhi(u.x), bflo(u.y), bfhi(u.y)}; }
__device__ __forceinline__ void strow_bf16(bf16_t* row, int lane, int j, const f32x4 v) { u32x2 o; o.x = pk2(v[0], v[1]); o.y = pk2(v[2], v[3]); ((u32x2*)row)[lane + 64 * j] = o; }
namespace pg8 {
#define PG8_LAS __attribute__((address_space(3)))
constexpr int BM = 256, BK = 64, HALF = 128, HTB = HALF * BK * 2  , STAGE_BYTES = 8 * HTB, NXCD = 8, WGM = 8;
__host__ __device__ __forceinline__ int lds_byte(int r, int c) { const int st = (r >> 4) * 2 + (c >> 5), rr = r & 15, cc = c & 31, ob = rr * 64 + cc * 2; return st * 1024 + (ob ^ (((ob >> 9) & 1) << 5)); }
__host__ __device__ __forceinline__ void stage_rc(int b, int& R, int& C) { const int st = b / 1024, sb = b % 1024, swz = sb ^ (((sb >> 9) & 1) << 5); R = (st >> 1) * 16 + swz / 64; C = (st & 1) * 32 + (swz % 64) / 2; }
__host__ __device__ __forceinline__ int perm32(int rho) { const int n = rho >> 4, i = rho & 15; return 8 * (i >> 2) + 4 * n + (i & 3); }

struct Unit { int pm, pn; const char* A; const char* B; };

struct DenseOrder {
    static constexpr bool GATHER_ROWS = false;
    static constexpr bool GATHER_A = false;
    int nM, nN, nwg, G, c; const char* A; const char* Bt; size_t tstep;
    __device__ void init(const bf16_t* A_, const bf16_t* Bt_, int M, int N, int K, int G_, int c_) { nM = M / BM; nN = N / BM; nwg = nM * nN; G = G_; c = c_; A = (const char*)A_; Bt = (const char*)Bt_; tstep = (size_t)BM * K * 2; }
    __device__ bool next(int i, Unit& u) const {
        const long L = (long)i * G + c; if (L >= nwg) return false;
        int wgid = (int)L; { const int q = nwg / NXCD, r = nwg % NXCD, xcd = wgid % NXCD, off = wgid / NXCD; wgid = (xcd < r ? xcd * (q + 1) : r * (q + 1) + (xcd - r) * q) + off; }
        const int nig = WGM * nN, gid = wgid / nig, fm = gid * WGM, gsz = (nM - fm) < WGM ? (nM - fm) : WGM;
        u.pm = fm + ((wgid % nig) % gsz); u.pn = (wgid % nig) / gsz; u.A = A + (size_t)u.pm * tstep; u.B = Bt + (size_t)u.pn * tstep; return true;
    }
    __device__ __forceinline__ void a_ready(const Unit&) const {}
    __device__ __forceinline__ void done(const Unit&) const {}
};
struct ProjOrder {
    static constexpr bool GATHER_ROWS = false;
    static constexpr bool GATHER_A = false;
    DenseOrder D; const char* HNp; const char* WT;
    __device__ void init(const bf16_t* HN_, const bf16_t* WT_, int c_) { D.init(HN_, WT_, NTP, 13 * BM, DM, GRID, c_); HNp = (const char*)HN_; WT = (const char*)WT_; }
    __device__ bool next(int i, Unit& u) const {
        if (!D.next(i, u)) return false;
        const size_t ts = (size_t)BM * DM * 2;
        if (u.pn < 11) { const int wrow = u.pn < 4 ? u.pn : u.pn + 2; u.A = HNp + (size_t)u.pm * ts; u.B = WT + (size_t)wrow * ts; }
        else { u.A = WT + (size_t)(4 + (u.pn - 11)) * ts; u.B = HNp + (size_t)u.pm * ts; }
        return true;
    }
    __device__ __forceinline__ void a_ready(const Unit&) const {}
    __device__ __forceinline__ void done(const Unit&) const {}
};
template <bool GATHER> struct MoeOrder {
    static constexpr bool GATHER_ROWS = GATHER;
    static constexpr bool GATHER_A = false;
    const int* et; int TT, vcu; const char* A; const char* Bt; unsigned tstepA, tstepB, estep; const int* rowidx;
    __device__ __forceinline__ bool next(int i, Unit& u) const {
        const int L = i * GRID + vcu; if (L >= TT * 4) return false;
        const int rt = L >> 2, ct = L & 3, e = et[rt];
        u.pm = rt; u.pn = ct; u.A = GATHER ? A : A + (size_t)rt * tstepA; u.B = Bt + (size_t)e * estep + (size_t)ct * tstepB; return true;
    }
    __device__ __forceinline__ void a_ready(const Unit&) const {}
    __device__ __forceinline__ void done(const Unit&) const {}
};

struct S5OrderA {
    static constexpr bool GATHER_ROWS = false;
    static constexpr bool GATHER_A = true;
    int vcu; const char* U; const char* BTA;
    __device__ __forceinline__ bool next(int i, Unit& u) const {
        const int L = i * GRID + vcu; if (L >= 640) return false;
        const int g = L / 10, rem = L - g * 10, mt = rem >> 1, nt = rem & 1;
        u.pm = mt; u.pn = g * 2 + nt; u.A = U + ((size_t)mt * 256 * 16 * 1024 + g * 16) * 2; u.B = BTA + ((size_t)(g * 512 + nt * 256) * 256) * 2; return true;
    }
    __device__ __forceinline__ void a_ready(const Unit&) const {}
    __device__ __forceinline__ void done(const Unit&) const {}
};
struct S5OrderC {
    static constexpr bool GATHER_ROWS = false;
    static constexpr bool GATHER_A = false;
    int vcu; const char* CAR; const char* BTC;
    __device__ __forceinline__ bool next(int i, Unit& u) const {
        const int L = i * GRID + vcu; if (L >= 320) return false;
        const int g = L / 5, mt = L - g * 5;
        u.pm = mt; u.pn = g; u.A = CAR + ((size_t)(g * 1280 + mt * 256) * 256) * 2; u.B = BTC + ((size_t)g * 256 * 256) * 2; return true;
    }
    __device__ __forceinline__ void a_ready(const Unit&) const {}
    __device__ __forceinline__ void done(const Unit&) const {}
};
__device__ __forceinline__ unsigned cvt_pk_bf16(float lo, float hi) { return pk2(lo, hi); }

struct EpiProj {
    static constexpr bool PERM = true, AFTER_DRAIN = false;
    bf16_t *Q, *Kk, *VT, *REST;
    __device__ __forceinline__ void operator()(const f32x4 (&acc)[2][2][4][2], const Unit& u, int wr, int wc, int fr, int fq) const {
        bf16_t* base; int ldc; int row0, col0;
        if (u.pn < 11) { row0 = u.pm * BM + wr * 64 + fr; int colt;
            if (u.pn < 2) { base = Q; colt = u.pn * BM; ldc = 512; } else if (u.pn < 4) { base = Kk; colt = (u.pn - 2) * BM; ldc = 512; } else { base = REST; colt = (u.pn - 4) * BM; ldc = RESTC; }
            col0 = colt + wc * 32 + 8 * fq; }
        else { base = VT; ldc = NTP; row0 = (u.pn - 11) * BM + wr * 64 + fr; col0 = u.pm * BM + wc * 32 + 8 * fq; }
#pragma unroll
        for (int ai = 0; ai < 2; ++ai)
#pragma unroll
            for (int m = 0; m < 4; ++m) { bf16_t* rowp = base + (size_t)(row0 + ai * HALF + m * 16) * ldc + col0;
#pragma unroll
                for (int bj = 0; bj < 2; ++bj) { const f32x4 v0 = acc[ai][bj][m][0], v1 = acc[ai][bj][m][1];
                    u32x4 w; w.x = cvt_pk_bf16(v0[0], v0[1]); w.y = cvt_pk_bf16(v0[2], v0[3]); w.z = cvt_pk_bf16(v1[0], v1[1]); w.w = cvt_pk_bf16(v1[2], v1[3]);
                    *(u32x4*)(rowp + bj * HALF) = w; } }
    }
};
struct EpiBf16Plain {
    static constexpr bool PERM = true, AFTER_DRAIN = false;
    bf16_t* O; int ldc;
    __device__ __forceinline__ void operator()(const f32x4 (&acc)[2][2][4][2], const Unit& u, int wr, int wc, int fr, int fq) const {
        const int row0 = u.pm * BM + wr * 64 + fr; const int col0 = u.pn * BM + wc * 32 + 8 * fq;
#pragma unroll
        for (int ai = 0; ai < 2; ++ai)
#pragma unroll
            for (int m = 0; m < 4; ++m) { bf16_t* rowp = O + (size_t)(row0 + ai * HALF + m * 16) * ldc + col0;
#pragma unroll
                for (int bj = 0; bj < 2; ++bj) { const f32x4 v0 = acc[ai][bj][m][0], v1 = acc[ai][bj][m][1];
                    u32x4 w; w.x = cvt_pk_bf16(v0[0], v0[1]); w.y = cvt_pk_bf16(v0[2], v0[3]); w.z = cvt_pk_bf16(v1[0], v1[1]); w.w = cvt_pk_bf16(v1[2], v1[3]);
                    *(u32x4*)(rowp + bj * HALF) = w; } }
    }
};
struct EpiSwiglu {
    static constexpr bool PERM = true, AFTER_DRAIN = false;
    bf16_t* O;
    __device__ __forceinline__ void operator()(const f32x4 (&acc)[2][2][4][2], const Unit& u, int wr, int wc, int fr, int fq) const {
        const int row0 = u.pm * BM + wr * 64 + fr; const int col0 = u.pn * HALF + wc * 32 + 8 * fq;
#pragma unroll
        for (int ai = 0; ai < 2; ++ai)
#pragma unroll
            for (int m = 0; m < 4; ++m) {
                float o[8];
#pragma unroll
                for (int n = 0; n < 2; ++n)
#pragma unroll
                    for (int i = 0; i < 4; ++i) { const float va = acc[ai][0][m][n][i], vg = acc[ai][1][m][n][i]; o[4 * n + i] = va * __builtin_amdgcn_rcpf(1.f + __expf(-va)) * vg; }
                u32x4 w; w.x = cvt_pk_bf16(o[0], o[1]); w.y = cvt_pk_bf16(o[2], o[3]); w.z = cvt_pk_bf16(o[4], o[5]); w.w = cvt_pk_bf16(o[6], o[7]);
                *(u32x4*)(O + (size_t)(row0 + ai * HALF + m * 16) * DFF + col0) = w; }
    }
};
struct EpiResidual {
    static constexpr bool PERM = true, AFTER_DRAIN = false;
    bf16_t* Hh;
    __device__ __forceinline__ void operator()(const f32x4 (&acc)[2][2][4][2], const Unit& u, int wr, int wc, int fr, int fq) const {
        const int row0 = u.pm * BM + wr * 64 + fr; const int col0 = u.pn * BM + wc * 32 + 8 * fq;
#pragma unroll
        for (int ai = 0; ai < 2; ++ai)
#pragma unroll
            for (int m = 0; m < 4; ++m) { bf16_t* rowp = Hh + (size_t)(row0 + ai * HALF + m * 16) * DM + col0;
#pragma unroll
                for (int bj = 0; bj < 2; ++bj) { u32x4* p = (u32x4*)(rowp + bj * HALF); const u32x4 hv = *p; const f32x4 v0 = acc[ai][bj][m][0], v1 = acc[ai][bj][m][1];
                    u32x4 w; w.x = cvt_pk_bf16(__uint_as_float(hv.x << 16) + v0[0], __uint_as_float(hv.x & 0xffff0000u) + v0[1]); w.y = cvt_pk_bf16(__uint_as_float(hv.y << 16) + v0[2], __uint_as_float(hv.y & 0xffff0000u) + v0[3]);
                    w.z = cvt_pk_bf16(__uint_as_float(hv.z << 16) + v1[0], __uint_as_float(hv.z & 0xffff0000u) + v1[1]); w.w = cvt_pk_bf16(__uint_as_float(hv.w << 16) + v1[2], __uint_as_float(hv.w & 0xffff0000u) + v1[3]);
                    *p = w; } }
    }
};
struct EpiGlu {
    static constexpr bool PERM = true, AFTER_DRAIN = false;
    bf16_t* Hh;
    __device__ __forceinline__ void operator()(const f32x4 (&acc)[2][2][4][2], const Unit& u, int wr, int wc, int fr, int fq) const {
        const int row0 = u.pm * BM + wr * 64 + fr; const int col0 = u.pn * HALF + wc * 32 + 8 * fq;
#pragma unroll
        for (int ai = 0; ai < 2; ++ai)
#pragma unroll
            for (int m = 0; m < 4; ++m) { u32x4* p = (u32x4*)(Hh + (size_t)(row0 + ai * HALF + m * 16) * DM + col0); const u32x4 hv = *p;
                float o[8];
#pragma unroll
                for (int n = 0; n < 2; ++n)
#pragma unroll
                    for (int i = 0; i < 4; ++i) { const unsigned hw = hv[2 * n + (i >> 1)]; const float hcur = (i & 1) ? __uint_as_float(hw & 0xffff0000u) : __uint_as_float(hw << 16);
                        o[4 * n + i] = hcur + acc[ai][0][m][n][i] * __builtin_amdgcn_rcpf(1.f + __expf(-acc[ai][1][m][n][i])); }
                u32x4 w; w.x = cvt_pk_bf16(o[0], o[1]); w.y = cvt_pk_bf16(o[2], o[3]); w.z = cvt_pk_bf16(o[4], o[5]); w.w = cvt_pk_bf16(o[6], o[7]);
                *p = w; }
    }
};
struct EpiS5A {
    static constexpr bool PERM = true, AFTER_DRAIN = false;
    bf16_t* YI; bf16_t* E;
    __device__ __forceinline__ void operator()(const f32x4 (&acc)[2][2][4][2], const Unit& u, int wr, int wc, int fr, int fq) const {
        const int g = u.pn >> 1, nt = u.pn & 1;
        const int cl0 = wc * 32 + 8 * fq;
        bf16_t* base = nt == 0 ? YI + (size_t)(cl0 >> 4) * DM + g * 16 + (cl0 & 15) : E + (size_t)g * 256 + cl0;
        const size_t nstride = 16 * DM;
        const size_t bjstep = nt == 0 ? (size_t)8 * DM : (size_t)HALF;
#pragma unroll
        for (int ai = 0; ai < 2; ++ai)
#pragma unroll
            for (int m = 0; m < 4; ++m) { int n = u.pm * BM + ai * HALF + wr * 64 + m * 16 + fr; n = n < 1039 ? n : 1039;
                bf16_t* p = base + (size_t)n * nstride;
#pragma unroll
                for (int bj = 0; bj < 2; ++bj) { const f32x4 v0 = acc[ai][bj][m][0], v1 = acc[ai][bj][m][1];
                    u32x4 w; w.x = cvt_pk_bf16(v0[0], v0[1]); w.y = cvt_pk_bf16(v0[2], v0[3]); w.z = cvt_pk_bf16(v1[0], v1[1]); w.w = cvt_pk_bf16(v1[2], v1[3]);
                    *(u32x4*)(p + bj * bjstep) = w; } }
    }
};
struct EpiS5C {
    static constexpr bool PERM = true, AFTER_DRAIN = false;
    const bf16_t* YI; const bf16_t* Uu; const float* dvec; bf16_t* O;
    __device__ __forceinline__ void operator()(const f32x4 (&acc)[2][2][4][2], const Unit& u, int wr, int wc, int fr, int fq) const {
        const int g = u.pn;
        const int cl0 = wc * 32 + 8 * fq, ch = g * 16 + (cl0 & 15);
        const size_t off0 = (size_t)(cl0 >> 4) * DM + ch;
        const f32x4 d0 = *(const f32x4*)(dvec + ch), d1 = *(const f32x4*)(dvec + ch + 4);
#pragma unroll
        for (int ai = 0; ai < 2; ++ai)
#pragma unroll
            for (int m = 0; m < 4; ++m) { int n = u.pm * BM + ai * HALF + wr * 64 + m * 16 + fr; n = n < 1039 ? n : 1039;
#pragma unroll
                for (int bj = 0; bj < 2; ++bj) {
                    const size_t off = off0 + (size_t)n * (16 * DM) + (size_t)bj * (8 * DM);
                    const u32x4 yv = *(const u32x4*)(YI + off);
                    const f32x4 y0 = (f32x4){__uint_as_float(yv[0] << 16), __uint_as_float(yv[0] & 0xffff0000u), __uint_as_float(yv[1] << 16), __uint_as_float(yv[1] & 0xffff0000u)},
                                y1 = (f32x4){__uint_as_float(yv[2] << 16), __uint_as_float(yv[2] & 0xffff0000u), __uint_as_float(yv[3] << 16), __uint_as_float(yv[3] & 0xffff0000u)};
                    const u32x4 uv = *(const u32x4*)(Uu + off);
                    float y[8];
#pragma unroll
                    for (int q = 0; q < 4; ++q) { y[q] = acc[ai][bj][m][0][q] + y0[q] + d0[q] * (q & 1 ? __uint_as_float(uv[q >> 1] & 0xffff0000u) : __uint_as_float(uv[q >> 1] << 16));
                        y[4 + q] = acc[ai][bj][m][1][q] + y1[q] + d1[q] * (q & 1 ? __uint_as_float(uv[2 + (q >> 1)] & 0xffff0000u) : __uint_as_float(uv[2 + (q >> 1)] << 16)); }
#pragma unroll
                    for (int q = 0; q < 8; ++q) { const float z = 1.5957691216f * (y[q] + 0.044715f * y[q] * y[q] * y[q]); y[q] = y[q] * __builtin_amdgcn_rcpf(1.f + __expf(-z)); }
                    u32x4 w; w.x = cvt_pk_bf16(y[0], y[1]); w.y = cvt_pk_bf16(y[2], y[3]); w.z = cvt_pk_bf16(y[4], y[5]); w.w = cvt_pk_bf16(y[6], y[7]);
                    *(u32x4*)(O + off) = w; }
                asm volatile("" ::: "memory"); }
    }
};

template <class Epi, class Sched, bool ALIGN_EPI = false, bool SP2 = false>
__device__ __forceinline__ void gemm_phase(PG8_LAS unsigned char* lds, const int K, const Sched& S, const Epi& E) {
    int tid_ = threadIdx.x; asm volatile("" : "+v"(tid_));
    const int tid = tid_, wid = __builtin_amdgcn_readfirstlane(tid >> 6), lane = tid & 63, wr = wid >> 2, wc = wid & 3, fr = lane & 15, fq = lane >> 4;
    const int nt = K / BK;
    unsigned vA0[2], vA1[2], nA0[2], nA1[2], voffB[2];
#pragma unroll
    for (int i = 0; i < 2; ++i) { int R, C; stage_rc(tid * 16 + i * 8192, R, C); const int Rb = Epi::PERM ? ((R & ~31) + perm32(R & 31)) : R;
        vA0[i] = Sched::GATHER_A ? (unsigned)(((16 * R + (C >> 4)) * 1024 + (C & 15)) * 2) : (unsigned)(R * K + C) * 2u; voffB[i] = (unsigned)(Rb * K + C) * 2u; }
    const size_t kstep = (size_t)(BK * 2);
    const size_t hstep = (size_t)HALF * K * 2;
    const size_t kstepA = Sched::GATHER_A ? (size_t)(4 * 1024 * 2) : kstep, hstepA = Sched::GATHER_A ? (size_t)HALF * 16 * 1024 * 2 : hstep;
#define PG8_ROWOFFS(u_, d0_, d1_) do { _Pragma("unroll") for (int i_ = 0; i_ < 2; ++i_) { int R_, C_; stage_rc(tid * 16 + i_ * 8192, R_, C_); \
        d0_[i_] = (unsigned)(S.rowidx[(u_).pm * BM + R_] * K + C_) * 2u; d1_[i_] = (unsigned)(S.rowidx[(u_).pm * BM + HALF + R_] * K + C_) * 2u; } } while (0)
#define PG8_STAGE_A(bufoff, gbase, h_, nx_) do { _Pragma("unroll") for (int _i = 0; _i < 2; ++_i) { const unsigned vo_ = (nx_) ? ((h_) ? nA1[_i] : nA0[_i]) : ((h_) ? vA1[_i] : vA0[_i]); \
        __builtin_amdgcn_global_load_lds((const unsigned*)((const char*)(gbase) + vo_), (PG8_LAS unsigned*)(lds + (bufoff) + ldsw + _i * 8192), 16, 0, 0); } } while (0)
    const unsigned ldsw = (unsigned)wid * 1024u;
    const int aoff = lds_byte(wr * 64 + fr, fq * 8), boff = lds_byte(wc * 32 + fr, fq * 8);
#define PG8_SA(b, h) (((b) * 2 + (h)) * HTB)
#define PG8_SB(b, h) ((4 + (b) * 2 + (h)) * HTB)
#define PG8_STAGE(bufoff, gbase, voff) do { _Pragma("unroll") for (int _i = 0; _i < 2; ++_i) \
        __builtin_amdgcn_global_load_lds((const unsigned*)((const char*)(gbase) + (voff)[_i]), (PG8_LAS unsigned*)(lds + (bufoff) + ldsw + _i * 8192), 16, 0, 0); } while (0)
#define PG8_LDA(dst, b, h) do { _Pragma("unroll") for (int m = 0; m < 4; ++m) _Pragma("unroll") for (int k = 0; k < 2; ++k) dst[m][k] = *(const PG8_LAS bf16x8*)(lds + PG8_SA(b, h) + aoff + m * 2048 + k * 1024); } while (0)
#define PG8_LDB(dst, b, h) do { _Pragma("unroll") for (int n = 0; n < 2; ++n) _Pragma("unroll") for (int k = 0; k < 2; ++k) dst[n][k] = *(const PG8_LAS bf16x8*)(lds + PG8_SB(b, h) + boff + n * 2048 + k * 1024); } while (0)
#define PG8_MMA(ai, bj, At, Bt) do { __builtin_amdgcn_s_setprio(1); _Pragma("unroll") for (int m = 0; m < 4; ++m) _Pragma("unroll") for (int n = 0; n < 2; ++n) _Pragma("unroll") for (int k = 0; k < 2; ++k) \
        acc[ai][bj][m][n] = __builtin_amdgcn_mfma_f32_16x16x32_bf16(Bt[n][k], At[m][k], acc[ai][bj][m][n], 0, 0, 0); __builtin_amdgcn_s_setprio(0); } while (0)
#define PG8_WAIT_V(n) asm volatile("s_waitcnt vmcnt(" #n ")" ::: "memory")
#define PG8_WAIT_L(n) asm volatile("s_waitcnt lgkmcnt(" #n ")" ::: "memory")
#define PG8_BAR __builtin_amdgcn_s_barrier()
#define PG8_SCHED __builtin_amdgcn_sched_barrier(0)
    Unit cur, nxt; int ui = 0;
    if (!S.next(0, cur)) return;
    f32x4 acc[2][2][4][2];
#pragma unroll
    for (int a = 0; a < 2; ++a)
#pragma unroll
        for (int b = 0; b < 2; ++b)
#pragma unroll
            for (int m = 0; m < 4; ++m)
#pragma unroll
                for (int n = 0; n < 2; ++n) acc[a][b][m][n] = (f32x4){0.f, 0.f, 0.f, 0.f};
    bf16x8 At[4][2], B0[2][2], B1[2][2];
    const char* cA = cur.A; const char* cB = cur.B;
    if constexpr (Sched::GATHER_ROWS) { PG8_ROWOFFS(cur, vA0, vA1); }
    else {
#pragma unroll
        for (int i = 0; i < 2; ++i) vA1[i] = vA0[i] + (unsigned)hstepA;
    }
#pragma unroll
    for (int i = 0; i < 2; ++i) { nA0[i] = vA0[i]; nA1[i] = vA1[i]; }
    S.a_ready(cur);
    if constexpr (SP2) {
        PG8_STAGE(PG8_SB(0, 0), cB, voffB); PG8_STAGE(PG8_SB(0, 1), cB + hstep, voffB); PG8_STAGE_A(PG8_SA(0, 0), cA, 0, false); PG8_STAGE_A(PG8_SA(0, 1), cA, 1, false);
        if (wr == 1) PG8_BAR;
        PG8_WAIT_V(2); PG8_BAR;
        PG8_STAGE(PG8_SB(1, 0), cB + kstep, voffB); PG8_STAGE_A(PG8_SA(1, 0), cA + kstepA, 0, false); PG8_STAGE(PG8_SB(1, 1), cB + hstep + kstep, voffB);
        PG8_WAIT_V(6); PG8_BAR;
    } else {
        PG8_STAGE(PG8_SB(0, 0), cB, voffB); PG8_STAGE_A(PG8_SA(0, 0), cA, 0, false); PG8_STAGE(PG8_SB(0, 1), cB + hstep, voffB); PG8_STAGE_A(PG8_SA(0, 1), cA, 1, false);
        if (wr == 1) PG8_BAR;
        PG8_WAIT_V(4); PG8_BAR;
        PG8_STAGE(PG8_SB(1, 0), cB + kstep, voffB); PG8_STAGE_A(PG8_SA(1, 0), cA + kstepA, 0, false); PG8_STAGE(PG8_SB(1, 1), cB + hstep + kstep, voffB);
        PG8_WAIT_V(6); PG8_BAR;
    }
    for (;;) {
        const bool has_next = S.next(ui + 1, nxt);
        if constexpr (Sched::GATHER_ROWS) { if (has_next) PG8_ROWOFFS(nxt, nA0, nA1); }
        const char* nA = has_next ? nxt.A : cA; const char* nB = has_next ? nxt.B : cB;
        for (int t = 0; t < nt; t += 2) {
            const bool last = (t == nt - 2);
            const char* a1 = cA + (size_t)(t + 1) * kstepA;
            const char* a2 = last ? nA : cA + (size_t)(t + 2) * kstepA; const char* b2 = last ? nB : cB + (size_t)(t + 2) * kstep;
            const char* a3 = a2 + kstepA; const char* b3 = b2 + kstep;
            if (last && has_next) S.a_ready(nxt);
            if constexpr (SP2) {
            PG8_LDB(B0, 0, 0); PG8_LDB(B1, 0, 1); PG8_SCHED; PG8_LDA(At, 0, 0); PG8_STAGE_A(PG8_SA(1, 1), a1, 1, false);
            PG8_WAIT_V(8); PG8_WAIT_L(0); PG8_BAR; PG8_MMA(0, 0, At, B0); PG8_MMA(0, 1, At, B1); PG8_BAR; PG8_SCHED;
            PG8_LDA(At, 0, 1); PG8_STAGE(PG8_SB(0, 0), b2, voffB); PG8_STAGE(PG8_SB(0, 1), b2 + hstep, voffB); PG8_STAGE_A(PG8_SA(0, 0), a2, 0, last);
            PG8_WAIT_V(8); PG8_WAIT_L(0); PG8_BAR; PG8_MMA(1, 0, At, B0); PG8_MMA(1, 1, At, B1); PG8_BAR; PG8_SCHED;
            PG8_LDB(B0, 1, 0); PG8_LDB(B1, 1, 1); PG8_SCHED; PG8_LDA(At, 1, 0); PG8_STAGE_A(PG8_SA(0, 1), a2, 1, last);
            PG8_WAIT_V(8); PG8_WAIT_L(0); PG8_BAR; PG8_MMA(0, 0, At, B0); PG8_MMA(0, 1, At, B1); PG8_BAR; PG8_SCHED;
            PG8_LDA(At, 1, 1); PG8_STAGE(PG8_SB(1, 0), b3, voffB); PG8_STAGE(PG8_SB(1, 1), b3 + hstep, voffB); PG8_STAGE_A(PG8_SA(1, 0), a3, 0, last);
            PG8_WAIT_V(8); PG8_WAIT_L(0); PG8_BAR; PG8_MMA(1, 0, At, B0); PG8_MMA(1, 1, At, B1); PG8_BAR; PG8_SCHED;
            } else {
            PG8_LDB(B0, 0, 0); PG8_SCHED; PG8_LDA(At, 0, 0); PG8_STAGE_A(PG8_SA(1, 1), a1, 1, false);
            PG8_WAIT_L(8); PG8_BAR; PG8_WAIT_L(0); PG8_MMA(0, 0, At, B0); PG8_BAR; PG8_SCHED;
            PG8_LDB(B1, 0, 1); PG8_STAGE(PG8_SB(0, 0), b2, voffB);
            PG8_BAR; PG8_WAIT_L(0); PG8_MMA(0, 1, At, B1); PG8_BAR;
            PG8_LDA(At, 0, 1); PG8_STAGE_A(PG8_SA(0, 0), a2, 0, last);
            PG8_BAR; PG8_WAIT_L(0); PG8_MMA(1, 0, At, B0); PG8_BAR; PG8_SCHED;
            PG8_STAGE(PG8_SB(0, 1), b2 + hstep, voffB);
            PG8_WAIT_V(6); PG8_BAR; PG8_MMA(1, 1, At, B1); PG8_BAR;
            PG8_LDB(B0, 1, 0); PG8_SCHED; PG8_LDA(At, 1, 0); PG8_STAGE_A(PG8_SA(0, 1), a2, 1, last);
            PG8_WAIT_L(8); PG8_BAR; PG8_WAIT_L(0); PG8_MMA(0, 0, At, B0); PG8_BAR; PG8_SCHED;
            PG8_LDB(B1, 1, 1); PG8_STAGE(PG8_SB(1, 0), b3, voffB);
            PG8_BAR; PG8_WAIT_L(0); PG8_MMA(0, 1, At, B1); PG8_BAR;
            PG8_LDA(At, 1, 1); PG8_STAGE_A(PG8_SA(1, 0), a3, 0, last);
            PG8_BAR; PG8_WAIT_L(0); PG8_MMA(1, 0, At, B0); PG8_BAR; PG8_SCHED;
            PG8_STAGE(PG8_SB(1, 1), b3 + hstep, voffB);
            PG8_WAIT_V(6); PG8_BAR; PG8_MMA(1, 1, At, B1); PG8_BAR;
            }
        }
        if constexpr (ALIGN_EPI) { if (wr == 0) PG8_BAR; }
        if constexpr (!Epi::AFTER_DRAIN) { E(acc, cur, wr, wc, fr, fq); S.done(cur); }
        if (!has_next) break;
#pragma unroll
        for (int a = 0; a < 2; ++a)
#pragma unroll
            for (int b = 0; b < 2; ++b)
#pragma unroll
                for (int m = 0; m < 4; ++m)
#pragma unroll
                    for (int n = 0; n < 2; ++n) acc[a][b][m][n] = (f32x4){0.f, 0.f, 0.f, 0.f};
        cur = nxt; cA = nA; cB = nB; ++ui;
        if constexpr (Sched::GATHER_ROWS) {
#pragma unroll
            for (int i = 0; i < 2; ++i) { vA0[i] = nA0[i]; vA1[i] = nA1[i]; } }
        if constexpr (ALIGN_EPI) { if (wr == 1) PG8_BAR; }
    }
    PG8_WAIT_V(0);
    if constexpr (!ALIGN_EPI) { if (wr == 0) PG8_BAR; }
    PG8_BAR;
    if constexpr (Epi::AFTER_DRAIN) { E.fused(acc, cur, wr, wc, fr, fq, lds, wid, lane); S.done(cur); }
#undef PG8_SA
#undef PG8_SB
#undef PG8_STAGE
#undef PG8_STAGE_A
#undef PG8_ROWOFFS
#undef PG8_LDA
#undef PG8_LDB
#undef PG8_MMA
#undef PG8_WAIT_V
#undef PG8_WAIT_L
#undef PG8_BAR
#undef PG8_SCHED
}
}

#define PHASE_PROLOGUE \
    int tid_ = threadIdx.x; asm volatile("" : "+v"(tid_)); const int tid = tid_, lane = tid & 63, wave = tid >> 6; \
    const int G = GRID, bid = blockIdx.x; \
    const int gw = bid * 8 + wave, NGW = G * 8; \
    unsigned char* ws = P.ws; \
    bf16_t* H = (bf16_t*)(ws + WS_H); \
    bf16_t* HN = (bf16_t*)(ws + WS_HN); \
    bf16_t* A2 = (bf16_t*)(ws + WS_A2); \
    bf16_t* Qb = (bf16_t*)(ws + WS_Q); bf16_t* Kb = (bf16_t*)(ws + WS_K); bf16_t* Vb = (bf16_t*)(ws + WS_V); \
    bf16_t* REST = (bf16_t*)(ws + WS_REST); \
    bf16_t* YFB = (bf16_t*)(ws + WS_YFB); \
    bf16_t* Rr = (bf16_t*)(ws + WS_R); bf16_t* VV = (bf16_t*)(ws + WS_VV); bf16_t* KK = (bf16_t*)(ws + WS_KK); \
    bf16_t* KKA = (bf16_t*)(ws + WS_KKA); bf16_t* KD = (bf16_t*)(ws + WS_KD); \
    _Float16* LW = (_Float16*)(ws + WS_W); bf16_t* PP = (bf16_t*)(ws + WS_PP); bf16_t* QT = (bf16_t*)(ws + WS_QT); bf16_t* YT = (bf16_t*)(ws + WS_YT); bf16_t* ZT = (bf16_t*)(ws + WS_ZT); \
    bf16_t* Gg = (bf16_t*)(ws + WS_G); bf16_t* KR = (bf16_t*)(ws + WS_KR); bf16_t* LOW = (bf16_t*)(ws + WS_LOW); \
    float* BC = (float*)(ws + WS_BC); \
    bf16_t* AA = (bf16_t*)(ws + WS_AA); \
    bf16_t* HB = (bf16_t*)(ws + WS_HB); bf16_t* YB = (bf16_t*)(ws + WS_YB); \
    int* ROWTOK = (int*)(ws + WS_ROWTOK); int* EID = (int*)(ws + WS_EID); int* POS = (int*)(ws + WS_POS); int* DEST = (int*)(ws + WS_DEST); \
    float* GATE = (float*)(ws + WS_GATE); \
    bf16_t* YI = (bf16_t*)(ws + WS_YI); bf16_t* S5E = (bf16_t*)(ws + WS_E); bf16_t* CAR = (bf16_t*)(ws + WS_CAR); bf16_t* BTA = (bf16_t*)(ws + WS_BTA); bf16_t* BTC = (bf16_t*)(ws + WS_BTC); \
    unsigned* CTL = (unsigned*)(ws + WS_CTL); \
    bf16_t* WTIN = (bf16_t*)(ws + WS_WTIN); bf16_t* WTOUT = (bf16_t*)(ws + WS_WTOUT); bf16_t* WTGLU = (bf16_t*)(ws + WS_WTGLU); bf16_t* WT13 = (bf16_t*)(ws + WS_WT13); bf16_t* WT2 = (bf16_t*)(ws + WS_WT2); \
    const int vcu = (G % 8 == 0) ? (bid % 8) * (G / 8) + bid / 8 : bid; \
    const float* x = P.in[0]; const float* meta = P.in[1]; const float* norm_mix = P.in[2]; const float* norm_ffn = P.in[3]; const float* norm_final = P.in[4]; \
    const float* w_in = P.in[5]; const float* w_out = P.in[6]; const float* rpb = P.in[7]; const float* mu = P.in[8]; \
    const float* w0 = P.in[9]; const float* w_up = P.in[10]; const float* a0 = P.in[11]; const float* a_up = P.in[12]; const float* g_up = P.in[13]; \
    const float* k_k = P.in[14]; const float* k_a = P.in[15]; const float* r_k = P.in[16]; const float* lnx_g = P.in[17]; const float* lnx_b = P.in[18]; \
    const float* s5_b_re = P.in[19]; const float* s5_b_im = P.in[20]; const float* s5_lre = P.in[21]; const float* s5_lim = P.in[22]; const float* s5_ls = P.in[23]; \
    const float* s5_c_re = P.in[24]; const float* s5_c_im = P.in[25]; const float* s5_d = P.in[26]; const float* w_glu = P.in[27]; \
    const float* moe_wg = P.in[28]; const float* moe_bg = P.in[29]; const float* moe_we = P.in[30]; const float* moe_be = P.in[31]; \
    const float* moe_w1 = P.in[32]; const float* moe_w3 = P.in[33]; const float* moe_w2 = P.in[34];


__device__ __forceinline__ void transpose_half(const float* W, int N, int K, int k0, int n0, bf16_t* dstrow0, int lane) {
    const int kb = lane & 7, nq = lane >> 3;
    const float* src = W + (size_t)(k0 + 8 * kb) * N + n0 + 4 * nq;
    f32x4 v[8];
#pragma unroll
    for (int kk = 0; kk < 8; ++kk) v[kk] = *(const f32x4*)(src + (size_t)kk * N);
#pragma unroll
    for (int i = 0; i < 4; ++i) {
        u32x4 o; o.x = pk2(v[0][i], v[1][i]); o.y = pk2(v[2][i], v[3][i]); o.z = pk2(v[4][i], v[5][i]); o.w = pk2(v[6][i], v[7][i]);
        *(u32x4*)(dstrow0 + (size_t)(4 * nq + i) * K + k0 + 8 * kb) = o;
    }
}
__device__ __forceinline__ void transpose_item(const float* W, int N, int K, int k0, int n0, bf16_t* dstrow0, int lane) {
    transpose_half(W, N, K, k0, n0, dstrow0, lane);
    transpose_half(W, N, K, k0, n0 + 32, dstrow0 + (size_t)32 * K, lane);
}
#define CONV_DENSE_ITEMS (832 + 256 + 512 + 48)
__device__ __forceinline__ void conv_dense_item(CParams& P, int it, int lane) {
    unsigned char* ws = P.ws;
    if (it < 832) { const int kb = it / 52, nb = it % 52; transpose_item(P.in[5], INCOLS, DM, kb * 64, nb * 64, (bf16_t*)(ws + WS_WTIN) + (size_t)nb * 64 * DM, lane); return; }
    it -= 832;
    if (it < 256) { const int kb = it / 16, nb = it % 16; transpose_item(P.in[6], DM, DM, kb * 64, nb * 64, (bf16_t*)(ws + WS_WTOUT) + (size_t)nb * 64 * DM, lane); return; }
    it -= 256;
    if (it < 512) { const int kb = it / 32, nb = it % 32, n = nb * 64, half = n >> 10, c = n & 1023, row = (c >> 7) * 256 + half * 128 + (c & 127);
      transpose_item(P.in[27], 2 * DM, DM, kb * 64, n, (bf16_t*)(ws + WS_WTGLU) + (size_t)row * DM, lane); return; }
    it -= 512;
    bf16_t* lrt = (bf16_t*)(ws + WS_LRT);
    if (it < 16) { const int d = it >> 3, nb = it & 7; transpose_item(P.in[10] + (size_t)d * 64 * 512, 512, 64, 0, nb * 64, lrt + ((size_t)d * 512 + nb * 64) * 64, lane); return; }
    it -= 16;
    if (it < 16) { const int d = it >> 3, nb = it & 7; transpose_item(P.in[12] + (size_t)d * 64 * 512, 512, 64, 0, nb * 64, lrt + (size_t)2 * 512 * 64 + ((size_t)d * 512 + nb * 64) * 64, lane); return; }
    it -= 16;
    { const int kb = it >> 3, nb = it & 7; transpose_item(P.in[13], 512, 128, kb * 64, nb * 64, lrt + (size_t)4 * 512 * 64 + (size_t)nb * 64 * 128, lane); }
}
#define CONV_MOE_ITEMS (NEXP * 384)
__device__ __forceinline__ void conv_moe_item(CParams& P, int l, int it, int lane) {
    unsigned char* ws = P.ws;
    const int e = it / 384; int r = it % 384;
    if (r < 256) { const int which = r >> 7; r &= 127; const int kb = r >> 3, nb = r & 7, n = nb * 64, row = (n >> 7) * 256 + which * 128 + (n & 127);
        const float* W = (which ? P.in[33] : P.in[32]) + ((size_t)(l * NEXP + e) * DM) * DFF;
        transpose_item(W, DFF, DM, kb * 64, n, (bf16_t*)(ws + WS_WT13) + ((size_t)e * DM + row) * DM, lane); return; }
    r -= 256;
    { const int kb = r >> 4, nb = r & 15; const float* W = P.in[34] + ((size_t)(l * NEXP + e) * DFF) * DM;
      transpose_item(W, DM, DFF, kb * 64, nb * 64, (bf16_t*)(ws + WS_WT2) + ((size_t)e * DM + nb * 64) * DFF, lane); }
}

template <int MODE>
__device__ __forceinline__ void meta_gemm(const bf16_t* A, const bf16_t* Bt, bf16_t* Hrows, int task, int lane) {
    const int fr = lane & 15, fq = lane >> 4, c = task * 16 + fr;
    const bf16_t* b0 = MODE == 0 ? Bt + (size_t)c * DM : Bt + (size_t)((c >> 7) * 256 + (c & 127)) * DM;
    const bf16_t* b1 = b0 + (size_t)128 * DM;
    f32x4 acc0[2], acc1[2];
    acc0[0] = acc0[1] = acc1[0] = acc1[1] = (f32x4){0.f, 0.f, 0.f, 0.f};
#pragma unroll 4
    for (int kt = 0; kt < 32; ++kt) {
        const int ko = kt * 32 + fq * 8;
        const bf16x8 a0 = *(const bf16x8*)(A + (size_t)fr * DM + ko), a1 = *(const bf16x8*)(A + (size_t)(16 + fr) * DM + ko);
        const bf16x8 bv = *(const bf16x8*)(b0 + ko);
        acc0[0] = __builtin_amdgcn_mfma_f32_16x16x32_bf16(a0, bv, acc0[0], 0, 0, 0);
        acc0[1] = __builtin_amdgcn_mfma_f32_16x16x32_bf16(a1, bv, acc0[1], 0, 0, 0);
        if (MODE == 1) { const bf16x8 bg = *(const bf16x8*)(b1 + ko);
            acc1[0] = __builtin_amdgcn_mfma_f32_16x16x32_bf16(a0, bg, acc1[0], 0, 0, 0);
            acc1[1] = __builtin_amdgcn_mfma_f32_16x16x32_bf16(a1, bg, acc1[1], 0, 0, 0); }
    }
#pragma unroll
    for (int mi = 0; mi < 2; ++mi)
#pragma unroll
        for (int j = 0; j < 4; ++j) { bf16_t* p = Hrows + (size_t)(mi * 16 + fq * 4 + j) * DM + c;
            const float add = MODE == 0 ? acc0[mi][j] : acc0[mi][j] * __builtin_amdgcn_rcpf(1.f + __expf(-acc1[mi][j]));
            *p = (bf16_t)f2bf(bf2f(*p) + add); }
}
__device__ __forceinline__ void phase_0(CParams& P, unsigned char* lds, const int ph) {
    PHASE_PROLOGUE
            for (int row = gw; row < NT; row += NGW) {
                const float* src = row < NMAIN ? x + (size_t)row * DM : meta + (size_t)((row - NMAIN) & 15) * DM;
                f32x4 v[4];
#pragma unroll
                for (int j = 0; j < 4; ++j) { v[j] = ((const f32x4*)src)[lane + 64 * j]; strow_bf16(H + (size_t)row * DM, lane, j, v[j]); }
                store_norm_bf16(v, norm_mix, HN + (size_t)row * DM, lane);
            }
    for (int it = gw; it < CONV_DENSE_ITEMS; it += NGW) conv_dense_item(P, it, lane);
}

__device__ __forceinline__ void phase_1(CParams& P, unsigned char* lds, const int ph) {
    PHASE_PROLOGUE
    pg8::ProjOrder S; S.init(HN, WTIN, bid);
    pg8::EpiProj E{Qb, Kb, Vb, REST};
    pg8::gemm_phase<pg8::EpiProj, pg8::ProjOrder, true, true>((PG8_LAS unsigned char*)lds, DM, S, E);
}

__device__ __forceinline__ void na_units(CParams& P, unsigned char* lds, const int first, const int stride) {
    PHASE_PROLOGUE
    constexpr int KST = 68, VST = 596, NKEY = 592;
    bf16_t* Ks = (bf16_t*)lds;
    bf16_t* VTs = Ks + NKEY * KST;
    float* sb = (float*)(VTs + 64 * VST);
    const bf16_t* VT = Vb;
    const int fr = lane & 15, fq = lane >> 4;
    const f32x4 zero4 = (f32x4){0.f, 0.f, 0.f, 0.f};
    u32x4 kreg[9], vreg[9];
#define NA_BAR() do { asm volatile("s_waitcnt lgkmcnt(0)" ::: "memory"); __builtin_amdgcn_s_barrier(); asm volatile("" ::: "memory"); } while (0)
#define NA_LOAD(u_) do { if ((u_) < 1024) { const int r2_ = ((u_) & 63) * 2, h_ = ((u_) >> 6) & 7, b_ = (u_) >> 9, Rb_ = min(max(r2_ - 4, 0), 120); \
        _Pragma("unroll") for (int q = 0; q < 9; ++q) { const int i = tid + 512 * q, key = i >> 3, pc = (i & 7) * 8; const int kr = min(Rb_ + (key >> 6), 127); \
            kreg[q] = *(const u32x4*)(Kb + ((size_t)b_ * SEQ + kr * 64 + (key & 63)) * 512 + h_ * 64 + pc); } \
        _Pragma("unroll") for (int q = 0; q < 9; ++q) { const int i = tid + 512 * q, dd = i / 72, rem = i - dd * 72, kr9 = rem >> 3, pc = (rem & 7) * 8; const int kr = min(Rb_ + kr9, 127); \
            vreg[q] = *(const u32x4*)(VT + (size_t)(h_ * 64 + dd) * NTP + (size_t)b_ * SEQ + kr * 64 + pc); } } } while (0)
    if (first < 1024 + 16) NA_LOAD(first);
    for (int u = first; u < 1024 + 16; u += stride) {
        const bool metau = u >= 1024;
        int b, h, r2 = 0;
        if (!metau) { r2 = (u & 63) * 2; h = (u >> 6) & 7; b = u >> 9; } else { const int m = u - 1024; b = m >> 3; h = m & 7; }
        const int Rb = min(max(r2 - 4, 0), 120);
        if (!metau) {
            if (tid < 465) sb[tid] = rpb[h * 465 + tid];
#pragma unroll
            for (int q = 0; q < 9; ++q) { const int i = tid + 512 * q, key = i >> 3, pc = (i & 7) * 8; *(u32x4*)(Ks + key * KST + pc) = kreg[q]; }
#pragma unroll
            for (int q = 0; q < 9; ++q) { const int i = tid + 512 * q, dd = i / 72, rem = i - dd * 72, kr9 = rem >> 3, pc = (rem & 7) * 8; *(u32x4*)(VTs + dd * VST + kr9 * 64 + pc) = vreg[q]; }
        }
        for (int i = tid; i < 16 * 8; i += 512) { const int key = i >> 3, pc = (i & 7) * 8;
            *(u32x4*)(Ks + (576 + key) * KST + pc) = *(const u32x4*)(Kb + ((size_t)NMAIN + b * NMETA + key) * 512 + h * 64 + pc); }
        for (int i = tid; i < 64 * 2; i += 512) { const int dd = i >> 1, pc = (i & 1) * 8;
            *(u32x4*)(VTs + dd * VST + 576 + pc) = *(const u32x4*)(VT + (size_t)(h * 64 + dd) * NTP + NMAIN + b * NMETA + pc); }
        if (u + stride < 1024 + 16) NA_LOAD(u + stride);
        NA_BAR();
        if (!metau || wave == 0) {
            const int rr = wave >> 2, qb = wave & 3, r = r2 + rr;
            const int c = qb * 16 + fr;
            const int qrow = metau ? NMAIN + b * NMETA + fr : b * SEQ + r * 64 + c;
            const int R0 = min(max(r - 4, 0), 120), cs = qb == 0 ? 0 : (qb == 1 ? 8 : (qb == 2 ? 24 : 32));
            const int C0 = min(max(c - 8, 0), 48);
            const int ro = R0 - Rb;
            const bf16x8 qf0 = *(const bf16x8*)(Qb + (size_t)qrow * 512 + h * 64 + fq * 8), qf1 = *(const bf16x8*)(Qb + (size_t)qrow * 512 + h * 64 + 32 + fq * 8);
            f32x4 sacc[17];
            if (!metau) {
#pragma unroll
                for (int kt = 0; kt < 16; ++kt) {
                    const bf16_t* kp = Ks + ((ro + (kt >> 1)) * 64 + cs + 16 * (kt & 1) + fr) * KST + fq * 8;
                    f32x4 acc = __builtin_amdgcn_mfma_f32_16x16x32_bf16(*(const bf16x8*)kp, qf0, zero4, 0, 0, 0);
                    sacc[kt] = __builtin_amdgcn_mfma_f32_16x16x32_bf16(*(const bf16x8*)(kp + 32), qf1, acc, 0, 0, 0);
                }
            } else {
#pragma unroll
                for (int kt = 0; kt < 16; ++kt) sacc[kt] = zero4;
            }
            {
                const bf16_t* kp = Ks + (576 + fr) * KST + fq * 8;
                f32x4 acc = __builtin_amdgcn_mfma_f32_16x16x32_bf16(*(const bf16x8*)kp, qf0, zero4, 0, 0, 0);
                sacc[16] = __builtin_amdgcn_mfma_f32_16x16x32_bf16(*(const bf16x8*)(kp + 32), qf1, acc, 0, 0, 0);
            }
            float mx = -1e30f;
#pragma unroll
            for (int kt = 0; kt < 16; ++kt) {
                const int dr = R0 + (kt >> 1) - r + 7;
#pragma unroll
                for (int j = 0; j < 4; ++j) {
                    const int kc = cs + 16 * (kt & 1) + 4 * fq + j;
                    const bool inb = !metau && kc >= C0 && kc < C0 + 16;
                    const int dc = min(max(kc - c + 15, 0), 30);
                    const float bias = sb[dr * 31 + dc];
                    const float sv = sacc[kt][j] * 0.125f + bias;
                    const float s = inb ? sv : -1e30f;
                    sacc[kt][j] = s; mx = fmaxf(mx, s);
                }
            }
#pragma unroll
            for (int j = 0; j < 4; ++j) { const float s = sacc[16][j] * 0.125f; sacc[16][j] = s; mx = fmaxf(mx, s); }
            mx = fmaxf(mx, __shfl_xor(mx, 16)); mx = fmaxf(mx, __shfl_xor(mx, 32));
            float sum = 0.f;
#pragma unroll
            for (int kt = 0; kt < 17; ++kt)
#pragma unroll
                for (int j = 0; j < 4; ++j) { const float pv = __expf(sacc[kt][j] - mx); sacc[kt][j] = pv; sum += pv; }
            sum += __shfl_xor(sum, 16); sum += __shfl_xor(sum, 32);
            f32x4 o[4] = {zero4, zero4, zero4, zero4};
            if (!metau) {
#pragma unroll
                for (int kr = 0; kr < 8; ++kr) {
                    union { bf16x8 v; unsigned u[4]; } bf;
                    bf.u[0] = pk2(sacc[2 * kr][0], sacc[2 * kr][1]); bf.u[1] = pk2(sacc[2 * kr][2], sacc[2 * kr][3]);
                    bf.u[2] = pk2(sacc[2 * kr + 1][0], sacc[2 * kr + 1][1]); bf.u[3] = pk2(sacc[2 * kr + 1][2], sacc[2 * kr + 1][3]);
                    const int tok0 = (ro + kr) * 64 + cs + 4 * fq;
#pragma unroll
                    for (int dt = 0; dt < 4; ++dt) {
                        const bf16_t* vp = VTs + (dt * 16 + fr) * VST + tok0;
                        union { bf16x8 v; u32x2 h2[2]; } af;
                        af.h2[0] = *(const u32x2*)vp; af.h2[1] = *(const u32x2*)(vp + 16);
                        o[dt] = __builtin_amdgcn_mfma_f32_16x16x32_bf16(af.v, bf.v, o[dt], 0, 0, 0);
                    }
                }
            }
            {
                union { bf16x8 v; unsigned u[4]; } bf;
                bf.u[0] = pk2(sacc[16][0], sacc[16][1]); bf.u[1] = pk2(sacc[16][2], sacc[16][3]); bf.u[2] = 0u; bf.u[3] = 0u;
#pragma unroll
                for (int dt = 0; dt < 4; ++dt) {
                    const bf16_t* vp = VTs + (dt * 16 + fr) * VST + 576 + 4 * fq;
                    union { bf16x8 v; u32x2 h2[2]; } af;
                    af.h2[0] = *(const u32x2*)vp; af.h2[1] = (u32x2){0u, 0u};
                    o[dt] = __builtin_amdgcn_mfma_f32_16x16x32_bf16(af.v, bf.v, o[dt], 0, 0, 0);
                }
            }
            const float inv = 1.f / sum;
#pragma unroll
            for (int dt = 0; dt < 4; ++dt) {
                u32x2 ov; ov.x = pk2(o[dt][0] * inv, o[dt][1] * inv); ov.y = pk2(o[dt][2] * inv, o[dt][3] * inv);
                *(u32x2*)(A2 + (size_t)qrow * DM + h * 64 + dt * 16 + 4 * fq) = ov;
            }
        }
        NA_BAR();
    }
#undef NA_LOAD
#undef NA_BAR
}

__device__ __forceinline__ void phase_3(CParams& P, unsigned char* lds, const int ph) {
    PHASE_PROLOGUE
    constexpr int TR = 66, NTILE = (NT + TR - 1) / TR, AST = 264, SST = 136;
    bf16_t* As = (bf16_t*)lds;
    unsigned short* stg = (unsigned short*)(lds + 80 * AST * 2);
    const bf16_t* lrt = (const bf16_t*)(ws + WS_LRT);
    const int fr = lane & 15, fq = lane >> 4;
    for (int u = bid; u < NTILE; u += G) {
        const int r0 = u * TR, nrows = min(TR, NT - r0);
        for (int rl0 = wave; rl0 < nrows; rl0 += 24) {
            u32x2 vc[3][7], vp[3][7], vn[3][7]; bool okr[3], hp[3], hn[3]; int rows[3];
#pragma unroll
            for (int q = 0; q < 3; ++q) {
                const int rl = rl0 + 8 * q; okr[q] = rl < nrows;
                const int row = okr[q] ? r0 + rl : r0; rows[q] = row;
                int b, pp_;
                if (row < NMAIN) { b = row >> 13; pp_ = (row & (SEQ - 1)) + NMETA; } else { b = (row - NMAIN) >> 4; pp_ = (row - NMAIN) & 15; }
                hp[q] = pp_ > 0; hn[q] = pp_ + 1 < LSEQ;
                const int rowp = hp[q] ? rowof(b, pp_ - 1) : row, rown = hn[q] ? rowof(b, pp_ + 1) : row;
#pragma unroll
                for (int j = 0; j < 7; ++j) { const int c = 4 * lane + 256 * j;
                    vc[q][j] = *(const u32x2*)(REST + (size_t)row * RESTC + c); vp[q][j] = *(const u32x2*)(REST + (size_t)rowp * RESTC + c); vn[q][j] = *(const u32x2*)(REST + (size_t)rown * RESTC + c); }
            }
#pragma unroll
            for (int q = 0; q < 3; ++q) {
                if (okr[q]) {
                    const int row = rows[q], rl = rl0 + 8 * q;
#pragma unroll
                    for (int j = 0; j < 7; ++j) {
                        const int c = 4 * lane + 256 * j;
                        u32x2 a = vp[q][j], bq = vn[q][j]; const u32x2 cc = vc[q][j];
                        if (!hp[q]) { a.x = 0; a.y = 0; }
                        if (!hn[q]) { bq.x = 0; bq.y = 0; }
                        const f32x4 m4 = *(const f32x4*)(mu + c);
                        const float pc[4] = {bflo(cc.x), bfhi(cc.x), bflo(cc.y), bfhi(cc.y)};
                        const float pq[4] = {bflo(a.x), bfhi(a.x), bflo(a.y), bfhi(a.y)};
                        const float pn[4] = {bflo(bq.x), bfhi(bq.x), bflo(bq.y), bfhi(bq.y)};
                        float o[4];
#pragma unroll
                        for (int i = 0; i < 4; ++i) o[i] = pc[i] + m4[i] * (0.5f * (pq[i] + pn[i]) - pc[i]);
                        if (j == 6) {
                            if (lane < 16) { for (int i = 0; i < 4; ++i) o[i] = tanhf(o[i]); }
                            else if (lane >= 32) { for (int i = 0; i < 4; ++i) o[i] = sigmoidf_(o[i]); }
                        }
                        u32x2 ov; ov.x = pk2(o[0], o[1]); ov.y = pk2(o[2], o[3]);
                        if (j < 6) { bf16_t* dst = j < 2 ? Rr + (size_t)row * 512 + c : (j < 4 ? KR + (size_t)row * 512 + (c - 512) : VV + (size_t)row * 512 + (c - 1024)); *(u32x2*)dst = ov; }
                        else *(u32x2*)(As + rl * AST + (c - 1536)) = ov;
                    }
                }
            }
        }
        __syncthreads();
#define P4_LOADB(t_, bv_, bias_) do { const int wh_ = (t_) >> 2, ct_ = (t_) & 3, Kw_ = wh_ < 4 ? 64 : 128, col_ = ct_ * 128 + 16 * wave + fr; \
            const bf16_t* Wt_ = lrt + (wh_ < 4 ? (size_t)wh_ * 512 * 64 : (size_t)4 * 512 * 64) + (size_t)col_ * Kw_ + 8 * fq; \
            bv_[0] = *(const bf16x8*)Wt_; bv_[1] = *(const bf16x8*)(Wt_ + 32); if (wh_ == 4) { bv_[2] = *(const bf16x8*)(Wt_ + 64); bv_[3] = *(const bf16x8*)(Wt_ + 96); } \
            bias_ = wh_ < 2 ? w0[wh_ * 512 + col_] : (wh_ < 4 ? a0[(wh_ - 2) * 512 + col_] : 0.f); } while (0)
        bf16x8 bnx[4]; float biasn;
        P4_LOADB(0, bnx, biasn);
#ifndef PREP_REP2
#define PREP_REP2 1
#endif
#pragma unroll 1
        for (int t_ = 0; t_ < 20 * PREP_REP2; ++t_) { const int t = t_ % 20;
            const int which = t >> 2, ct = t & 3;
            const int koff = which < 2 ? 0 : (which < 4 ? 64 : 128);
            bf16x8 bcur[4]; bcur[0] = bnx[0]; bcur[1] = bnx[1]; bcur[2] = bnx[2]; bcur[3] = bnx[3];
            const float bias = biasn;
            if (t_ + 1 < 20 * PREP_REP2) P4_LOADB((t + 1) % 20, bnx, biasn);
            const f32x4 zero4 = (f32x4){0.f, 0.f, 0.f, 0.f};
            f32x4 acc[5] = {zero4, zero4, zero4, zero4, zero4};
#pragma unroll
            for (int ks = 0; ks < 4; ++ks) {
                if (ks < 2 || which == 4) {
#pragma unroll
                    for (int rt = 0; rt < 5; ++rt) acc[rt] = __builtin_amdgcn_mfma_f32_16x16x32_bf16(*(const bf16x8*)(As + (16 * rt + fr) * AST + koff + 32 * ks + 8 * fq), bcur[ks], acc[rt], 0, 0, 0);
                }
            }
            unsigned short* sg = stg + (t & 1) * 80 * SST + 16 * wave + fr;
#pragma unroll
            for (int rt = 0; rt < 5; ++rt)
#pragma unroll
                for (int j = 0; j < 4; ++j) { const float val = acc[rt][j] + bias; unsigned short o;
                    if (which < 2) { const _Float16 hv = (_Float16)(-0.6065306597f * sigmoidf_(val)); o = __builtin_bit_cast(unsigned short, hv); }
                    else if (which < 4) o = (unsigned short)f2bf(sigmoidf_(val));
                    else o = (unsigned short)f2bf(val);
                    sg[(16 * rt + 4 * fq + j) * SST] = o; }
            asm volatile("s_waitcnt lgkmcnt(0)" ::: "memory"); __builtin_amdgcn_s_barrier(); asm volatile("" ::: "memory");
            {
                unsigned short* dst = which < 2 ? (unsigned short*)LW + (size_t)which * NT * 512 : (which < 4 ? (unsigned short*)AA + (size_t)(which - 2) * NT * 512 : (unsigned short*)Gg);
                for (int i = tid; i < nrows * 8; i += 512) { const int r = i >> 3, pc = (i & 7) * 16; const unsigned short* sp = stg + (t & 1) * 80 * SST + r * SST + pc;
                    unsigned short* gp = dst + (size_t)(r0 + r) * 512 + ct * 128 + pc; *(u32x4*)gp = *(const u32x4*)sp; *(u32x4*)(gp + 8) = *(const u32x4*)(sp + 8); }
            }
        }
#undef P4_LOADB
        __syncthreads();
        for (int rl = wave; rl < nrows; rl += 8) {
            const int row = r0 + rl;

                const int c0 = lane * 8;
                const u32x4 krv = *(const u32x4*)(KR + (size_t)row * 512 + c0);
                const u32x4 rv = *(const u32x4*)(Rr + (size_t)row * 512 + c0);
                float kr[8], rr[8], kkv[8];
#pragma unroll
                for (int i = 0; i < 4; ++i) { kr[2 * i] = bflo(krv[i]); kr[2 * i + 1] = bfhi(krv[i]); rr[2 * i] = bflo(rv[i]); rr[2 * i + 1] = bfhi(rv[i]); }
                float ss = 0.f;
#pragma unroll
                for (int i = 0; i < 8; ++i) { kkv[i] = kr[i] * k_k[c0 + i]; ss += kkv[i] * kkv[i]; }
                ss += __shfl_xor(ss, 1); ss += __shfl_xor(ss, 2); ss += __shfl_xor(ss, 4);
                const float inv = 1.f / fmaxf(sqrtf(ss), 1e-12f);
#pragma unroll
                for (int i = 0; i < 8; ++i) kkv[i] *= inv;
                u32x4 o; o.x = pk2(kkv[0], kkv[1]); o.y = pk2(kkv[2], kkv[3]); o.z = pk2(kkv[4], kkv[5]); o.w = pk2(kkv[6], kkv[7]);
                *(u32x4*)(KK + (size_t)row * 512 + c0) = o;
                float bsum = 0.f;
#pragma unroll
                for (int d = 0; d < 2; ++d) {
                    const u32x4 av = *(const u32x4*)(AA + ((size_t)d * NT + row) * 512 + c0);
                    float a[8], kka[8], kd[8];
#pragma unroll
                    for (int i = 0; i < 4; ++i) { a[2 * i] = bflo(av[i]); a[2 * i + 1] = bfhi(av[i]); }
#pragma unroll
                    for (int i = 0; i < 8; ++i) { kka[i] = kkv[i] * a[i]; kd[i] = kr[i] * (1.f + (a[i] - 1.f) * k_a[c0 + i]); bsum += rr[i] * kd[i] * r_k[c0 + i]; }
                    u32x4 o1; o1.x = pk2(kka[0], kka[1]); o1.y = pk2(kka[2], kka[3]); o1.z = pk2(kka[4], kka[5]); o1.w = pk2(kka[6], kka[7]);
                    *(u32x4*)(KKA + ((size_t)d * NT + row) * 512 + c0) = o1;
                    u32x4 o2; o2.x = pk2(kd[0], kd[1]); o2.y = pk2(kd[2], kd[3]); o2.z = pk2(kd[4], kd[5]); o2.w = pk2(kd[6], kd[7]);
                    *(u32x4*)(KD + ((size_t)d * NT + row) * 512 + c0) = o2;
                }
                bsum += __shfl_xor(bsum, 1); bsum += __shfl_xor(bsum, 2); bsum += __shfl_xor(bsum, 4);
                if ((lane & 7) == 0) BC[(size_t)row * 8 + (lane >> 3)] = bsum;
                    }
        __syncthreads();
    }
}

#define RWS 72
__device__ __forceinline__ bf16x8 rw_frag(const bf16_t* M, int row, int kofs) { return *(const bf16x8*)(M + row * RWS + kofs); }
__device__ __forceinline__ f32x4 rw_tile(const bf16_t* Am, int ra, const bf16_t* Bm, int rb, int fr, int fq) {
    f32x4 acc = (f32x4){0.f, 0.f, 0.f, 0.f};
    acc = __builtin_amdgcn_mfma_f32_16x16x32_bf16(rw_frag(Am, ra + fr, 8 * fq), rw_frag(Bm, rb + fr, 8 * fq), acc, 0, 0, 0);
    acc = __builtin_amdgcn_mfma_f32_16x16x32_bf16(rw_frag(Am, ra + fr, 32 + 8 * fq), rw_frag(Bm, rb + fr, 32 + 8 * fq), acc, 0, 0, 0);
    return acc;
}
__device__ __forceinline__ void phase_6(CParams& P, unsigned char* lds, const int ph) {
    PHASE_PROLOGUE
    constexpr int GST = 68, RST = 132;
    float* Gs = (float*)lds;
    bf16_t* A_rm = (bf16_t*)(lds + 64 * GST * 4); bf16_t* R_rm = A_rm + 64 * RWS; bf16_t* B_rm = R_rm + 64 * RWS; bf16_t* K_rm = B_rm + 64 * RWS;
    bf16_t* B_tr = K_rm + 64 * RWS; bf16_t* K_tr = B_tr + 64 * RWS; bf16_t* V_tr = K_tr + 64 * RWS;
    bf16_t* MAK = V_tr + 64 * RWS; bf16_t* MRB = MAK + 64 * RWS; bf16_t* MRK = MRB + 64 * RWS;
    bf16_t* MABr = MRK + 64 * RWS;
    float* RHS = (float*)(MABr + 64 * RWS);
    float* BT = RHS + 64 * RST; float* OFF = BT + 512; float* GC = OFF + 512;
    bf16_t* X1_tr = A_rm; bf16_t* X2_tr = K_rm;
    for (int i = tid; i < 4 * 64 * RWS / 2; i += 512) ((unsigned*)MAK)[i] = 0u;
    __syncthreads();
    const int fr = lane & 15, fq = lane >> 4;
#define RW1_BAR() do { asm volatile("s_waitcnt lgkmcnt(0)" ::: "memory"); __builtin_amdgcn_s_barrier(); asm volatile("" ::: "memory"); } while (0)
    const int t0 = tid & 63, kp = (tid >> 6) * 8;
    u32x4 nlw, nkk, nka, nkd, nrv, nvv;
#define RW1_LOAD(u_) do { const int ch_ = (u_) / RW_NCH, c_ = (u_) - ch_ * RW_NCH, d_ = ch_ >> 4, b_ = (ch_ >> 3) & 1, h_ = ch_ & 7, s_ = c_ * 64 + t0; \
        const int p_ = d_ ? LSEQ - 1 - s_ : s_; const size_t o_ = (size_t)rowof(b_, s_ < LSEQ ? p_ : 0) * 512 + h_ * 64 + kp; \
        nlw = *(const u32x4*)(LW + (size_t)d_ * NT * 512 + o_); nkk = *(const u32x4*)(KK + o_); nka = *(const u32x4*)(KKA + (size_t)d_ * NT * 512 + o_); \
        nkd = *(const u32x4*)(KD + (size_t)d_ * NT * 512 + o_); nrv = *(const u32x4*)(Rr + o_); nvv = *(const u32x4*)(VV + o_); } while (0)
    if (bid < RW_UNITS) RW1_LOAD(bid);
    for (int u = bid; u < RW_UNITS; u += G) {
        const int chain = u / RW_NCH, c = u - chain * RW_NCH;
        float lw[8], kk[8], ka[8], kd[8], rr[8]; u32x4 vv;
        {
            const bool valid = c * 64 + t0 < LSEQ;
            vv = nvv;
#pragma unroll
            for (int i = 0; i < 4; ++i) {
                union { unsigned u; _Float16 hh[2]; } cv; cv.u = nlw[i];
                lw[2 * i] = valid ? (float)cv.hh[0] : 0.f; lw[2 * i + 1] = valid ? (float)cv.hh[1] : 0.f;
                kk[2 * i] = valid ? bflo(nkk[i]) : 0.f; kk[2 * i + 1] = valid ? bfhi(nkk[i]) : 0.f;
                ka[2 * i] = valid ? bflo(nka[i]) : 0.f; ka[2 * i + 1] = valid ? bfhi(nka[i]) : 0.f;
                kd[2 * i] = valid ? bflo(nkd[i]) : 0.f; kd[2 * i + 1] = valid ? bfhi(nkd[i]) : 0.f;
                rr[2 * i] = valid ? bflo(nrv[i]) : 0.f; rr[2 * i + 1] = valid ? bfhi(nrv[i]) : 0.f;
                if (!valid) vv[i] = 0u;
            }
        }
        if (u + G < RW_UNITS) RW1_LOAD(u + G);
        *(f32x4*)(Gs + t0 * GST + kp) = (f32x4){lw[0], lw[1], lw[2], lw[3]}; *(f32x4*)(Gs + t0 * GST + kp + 4) = (f32x4){lw[4], lw[5], lw[6], lw[7]};
        RW1_BAR();
        { const int k = tid & 63, w = tid >> 6; float acc = 0.f;
#pragma unroll
          for (int i = 0; i < 8; ++i) { acc += Gs[(8 * w + i) * GST + k]; Gs[(8 * w + i) * GST + k] = acc; }
          BT[w * 64 + k] = acc; }
        RW1_BAR();
        { const int k = tid & 63, w = tid >> 6; float off = 0.f; for (int w2 = 0; w2 < w; ++w2) off += BT[w2 * 64 + k]; OFF[w * 64 + k] = off; }
        RW1_BAR();
#ifndef RW1_REP0
#define RW1_REP0 1
#endif
        for (int rep0_ = 0; rep0_ < RW1_REP0; ++rep0_) {
        {
            float va[8], vr[8], vb[8], vk[8];
            const f32x4 g0_ = *(const f32x4*)(Gs + t0 * GST + kp), g1_ = *(const f32x4*)(Gs + t0 * GST + kp + 4), o0_ = *(const f32x4*)(OFF + (t0 >> 3) * 64 + kp), o1_ = *(const f32x4*)(OFF + (t0 >> 3) * 64 + kp + 4);
            const float gg_[8] = {g0_[0] + o0_[0], g0_[1] + o0_[1], g0_[2] + o0_[2], g0_[3] + o0_[3], g1_[0] + o1_[0], g1_[1] + o1_[1], g1_[2] + o1_[2], g1_[3] + o1_[3]};
#pragma unroll
            for (int i = 0; i < 8; ++i) {
                const float g = gg_[i];
                const float eg = __expf(g), egm1 = __expf(g - lw[i]), einv = __expf(-g);
                va[i] = kk[i] * egm1; vr[i] = rr[i] * eg; vb[i] = ka[i] * einv; vk[i] = kd[i] * einv;
                if (t0 == 63) GC[kp + i] = eg;
            }
            *(f32x4*)(RHS + t0 * RST + kp) = (f32x4){va[0], va[1], va[2], va[3]}; *(f32x4*)(RHS + t0 * RST + kp + 4) = (f32x4){va[4], va[5], va[6], va[7]};
            u32x4 w4;
            w4.x = pk2(va[0], va[1]); w4.y = pk2(va[2], va[3]); w4.z = pk2(va[4], va[5]); w4.w = pk2(va[6], va[7]); *(u32x4*)(A_rm + t0 * RWS + kp) = w4;
            w4.x = pk2(vr[0], vr[1]); w4.y = pk2(vr[2], vr[3]); w4.z = pk2(vr[4], vr[5]); w4.w = pk2(vr[6], vr[7]); *(u32x4*)(R_rm + t0 * RWS + kp) = w4;
            w4.x = pk2(vb[0], vb[1]); w4.y = pk2(vb[2], vb[3]); w4.z = pk2(vb[4], vb[5]); w4.w = pk2(vb[6], vb[7]); *(u32x4*)(B_rm + t0 * RWS + kp) = w4;
            w4.x = pk2(vk[0], vk[1]); w4.y = pk2(vk[2], vk[3]); w4.z = pk2(vk[4], vk[5]); w4.w = pk2(vk[6], vk[7]); *(u32x4*)(K_rm + t0 * RWS + kp) = w4;
#pragma unroll
            for (int i = 0; i < 8; ++i) { B_tr[(kp + i) * RWS + t0] = (bf16_t)f2bf(vb[i]); K_tr[(kp + i) * RWS + t0] = (bf16_t)f2bf(vk[i]);
                V_tr[(kp + i) * RWS + t0] = (bf16_t)((i & 1) ? (vv[i >> 1] >> 16) : (vv[i >> 1] & 0xffffu)); }
        }
        RW1_BAR();
        }
        float* DQ = Gs; bf16_t* TB = (bf16_t*)BT;
#ifndef RW1_REP1
#define RW1_REP1 1
#endif
#pragma unroll
        for (int s1 = 0; s1 < 5; ++s1) { const int q = wave + 8 * s1;
            const int m = q / 10, e = q - m * 10, ti = e >= 6 ? 3 : (e >= 3 ? 2 : (e >= 1 ? 1 : 0)), tj = e - (ti * (ti + 1)) / 2;
            const f32x4 acc = rw_tile(m < 2 ? A_rm : R_rm, 16 * ti, (m & 1) ? K_rm : B_rm, 16 * tj, fr, fq);
            bf16_t* Mm = m == 1 ? MAK : (m == 2 ? MRB : MRK);
#pragma unroll
            for (int j = 0; j < 4; ++j) { const int t = 16 * ti + 4 * fq + j, i = 16 * tj + fr; const bool keep = m < 2 ? (i < t) : (i <= t); const float val = keep ? acc[j] : 0.f;
                if (m == 0) { MABr[t * RWS + i] = (bf16_t)f2bf(val); if (ti == tj) DQ[((ti * 16 + (t & 15)) * 4 + (fr & 3)) * 4 + (fr >> 2)] = val; }
                else Mm[t * RWS + i] = (bf16_t)f2bf(val); }
        }
        RW1_BAR();
#ifndef RW1_REP23
#define RW1_REP23 1
#endif
        for (int rep23_ = 0; rep23_ < RW1_REP23; ++rep23_) {
        if (wave >= 4) {
            for (int q = wave - 4; q < 16; q += 4) { const int ti = q >> 2, tv = q & 3; const f32x4 acc = rw_tile(MAK, 16 * ti, V_tr, 16 * tv, fr, fq);
#pragma unroll
                for (int j = 0; j < 4; ++j) RHS[(16 * ti + 4 * fq + j) * RST + 64 + 16 * tv + fr] = acc[j]; }
        } else {
            const int bb = wave, cc = lane >> 2, q = lane & 3;
            float xs[4] = {0.f, 0.f, 0.f, 0.f};
#pragma unroll
            for (int tl = 0; tl < 16; ++tl) {
                const f32x4 mv = *(const f32x4*)(DQ + ((bb * 16 + tl) * 4 + q) * 4);
                float part = mv[0] * xs[0] + mv[1] * xs[1] + mv[2] * xs[2] + mv[3] * xs[3];
                part += dppf<0xB1>(part); part += dppf<0x4E>(part);
                const float xt = (tl == cc ? 1.f : 0.f) - part;
                xs[tl >> 2] = (tl & 3) == q ? xt : xs[tl >> 2];
            }
#pragma unroll
            for (int m = 0; m < 4; ++m) TB[(bb * 16 + 4 * m + q) * 16 + cc] = (bf16_t)f2bf(xs[m]);
        }
        RW1_BAR();
        {
            const int c0 = 16 * wave;
            f32x4 X[4];
            const f32x4 zero4 = (f32x4){0.f, 0.f, 0.f, 0.f};
#define RW1_PACK(lo_, hi_, v_) do { union { bf16x8 v; unsigned u[4]; } t_; t_.u[0] = pk2(lo_[0], lo_[1]); t_.u[1] = pk2(lo_[2], lo_[3]); t_.u[2] = pk2(hi_[0], hi_[1]); t_.u[3] = pk2(hi_[2], hi_[3]); v_ = t_.v; } while (0)
#define RW1_LDA(base_, row0_, ca_, cb_, useb_, v_) do { union { bf16x8 v; u32x2 h2[2]; } t_; t_.h2[0] = *(const u32x2*)((base_) + ((row0_) + fr) * RWS + (ca_) + 4 * fq); \
            t_.h2[1] = (useb_) ? *(const u32x2*)((base_) + ((row0_) + fr) * RWS + (cb_) + 4 * fq) : (u32x2){0u, 0u}; v_ = t_.v; } while (0)
#pragma unroll
            for (int bq = 0; bq < 4; ++bq) {
                f32x4 acc;
#pragma unroll
                for (int j = 0; j < 4; ++j) acc[j] = -RHS[(16 * bq + 4 * fq + j) * RST + c0 + fr];
                bf16x8 af, bfv;
                if (bq >= 1) { RW1_LDA(MABr, 16 * bq, 0, 16, bq >= 2, af); if (bq >= 2) RW1_PACK(X[0], X[1], bfv); else RW1_PACK(X[0], zero4, bfv);
                    acc = __builtin_amdgcn_mfma_f32_16x16x32_bf16(af, bfv, acc, 0, 0, 0); }
                if (bq == 3) { RW1_LDA(MABr, 48, 32, 0, false, af); RW1_PACK(X[2], zero4, bfv); acc = __builtin_amdgcn_mfma_f32_16x16x32_bf16(af, bfv, acc, 0, 0, 0); }
                const f32x4 wv = (f32x4){-acc[0], -acc[1], -acc[2], -acc[3]};
                { union { bf16x8 v; u32x2 h2[2]; } t_; t_.h2[0] = *(const u32x2*)(TB + (bq * 16 + fr) * 16 + 4 * fq); t_.h2[1] = (u32x2){0u, 0u}; af = t_.v; }
                RW1_PACK(wv, zero4, bfv);
                X[bq] = __builtin_amdgcn_mfma_f32_16x16x32_bf16(af, bfv, zero4, 0, 0, 0);
                bf16_t* Xm = (wave < 4 ? X1_tr : X2_tr) + ((c0 & 63) + fr) * RWS + 16 * bq + 4 * fq;
                u32x2 o; o.x = pk2(X[bq][0], X[bq][1]); o.y = pk2(X[bq][2], X[bq][3]);
                *(u32x2*)Xm = o;
            }
#undef RW1_PACK
#undef RW1_LDA
        }
        RW1_BAR();
        }
#pragma unroll
        for (int s5 = 0; s5 < 2; ++s5) {
            const int tile = wave * 2 + s5, ta = tile >> 2, tb = tile & 3;
            u32x2 o;
            {
                const f32x4 acc = rw_tile(X1_tr, 16 * ta, B_tr, 16 * tb, fr, fq);
                const int k = 16 * tb + fr, kq = 16 * ta + 4 * fq; const float gc = GC[k];
                float v[4];
#pragma unroll
                for (int j = 0; j < 4; ++j) v[j] = gc * ((kq + j == k ? 1.f : 0.f) - acc[j]);
                o.x = pk2(v[0], v[1]); o.y = pk2(v[2], v[3]);
                *(u32x2*)(PP + (size_t)u * 4096 + k * 64 + 32 * (ta >> 1) + 8 * fq + 4 * (ta & 1)) = o;
            }
            {
                const f32x4 acc = rw_tile(X1_tr, 16 * ta, MRB, 16 * tb, fr, fq);
                const int t = 16 * tb + fr, k0 = 16 * ta + 4 * fq;
                const u32x2 rv = *(const u32x2*)(R_rm + t * RWS + k0);
                o.x = pk2(bflo(rv.x) - acc[0], bfhi(rv.x) - acc[1]); o.y = pk2(bflo(rv.y) - acc[2], bfhi(rv.y) - acc[3]);
                *(u32x2*)(YT + (size_t)u * 4096 + t * 64 + 32 * (ta >> 1) + 8 * fq + 4 * (ta & 1)) = o;
            }
            {
                const f32x4 a1 = rw_tile(K_tr, 16 * ta, V_tr, 16 * tb, fr, fq), a2 = rw_tile(B_tr, 16 * ta, X2_tr, 16 * tb, fr, fq);
                const int v_ = 16 * tb + fr, k0 = 16 * ta + 4 * fq;
                const f32x4 gc = *(const f32x4*)(GC + k0);
                o.x = pk2(gc[0] * (a1[0] - a2[0]), gc[1] * (a1[1] - a2[1])); o.y = pk2(gc[2] * (a1[2] - a2[2]), gc[3] * (a1[3] - a2[3]));
                *(u32x2*)(QT + (size_t)u * 4096 + v_ * 64 + k0) = o;
            }
            {
                const f32x4 a1 = rw_tile(MRK, 16 * ta, V_tr, 16 * tb, fr, fq), a2 = rw_tile(MRB, 16 * ta, X2_tr, 16 * tb, fr, fq);
                const int v_ = 16 * tb + fr, t0_ = 16 * ta + 4 * fq;
                o.x = pk2(a1[0] - a2[0], a1[1] - a2[1]); o.y = pk2(a1[2] - a2[2], a1[3] - a2[3]);
                *(u32x2*)(ZT + (size_t)u * 4096 + v_ * 64 + t0_) = o;
            }
        }
        RW1_BAR();
    }
#undef RW1_LOAD
#undef RW1_BAR
}

__device__ __forceinline__ void phase_60(CParams& P, unsigned char* lds, const int ph) {
    PHASE_PROLOGUE
    if (bid < 32) {
        const int chain = bid, d = chain >> 4, b = (chain >> 3) & 1, h = chain & 7;
        const int fr = lane & 15, fq = lane >> 4;
        constexpr int MATB = 64 * RWS * 2, SLOT = 4 * MATB;
        bf16_t* ybuf = (bf16_t*)(lds + 3 * SLOT);
        const bool comp = wave < 4; const int vb = wave & 3, lm = wave & 3;
        const unsigned char* src = (const unsigned char*)(lm == 0 ? PP : (lm == 1 ? YT : (lm == 2 ? QT : ZT))) + (size_t)chain * RW_NCH * 8192 + lane * 16;
        u32x4 R0[8], R1[8], R2[8];
#define RW2_LD(Rx, c_) do { _Pragma("unroll") for (int i_ = 0; i_ < 8; ++i_) Rx[i_] = *(const u32x4*)(src + (size_t)(c_) * 8192 + i_ * 1024); } while (0)
#define RW2_ST(Rx, c_) do { unsigned char* dst_ = lds + ((c_) % 3) * SLOT + lm * MATB; _Pragma("unroll") for (int i_ = 0; i_ < 8; ++i_) { const int p_ = lane + 64 * i_; *(u32x4*)(dst_ + (p_ >> 3) * (RWS * 2) + (p_ & 7) * 16) = Rx[i_]; } } while (0)
#define RW2_FLUSH(c_) do { const int tl_ = 16 * lm + (lane >> 2), s_ = (c_) * 64 + tl_; const bf16_t* yb_ = ybuf + ((c_) & 1) * 64 * RWS + tl_ * RWS + 16 * (lane & 3); \
            const u32x4 y0_ = *(const u32x4*)yb_, y1_ = *(const u32x4*)(yb_ + 8); \
            if (s_ < LSEQ) { const int p_ = d ? LSEQ - 1 - s_ : s_; bf16_t* g_ = YFB + ((size_t)d * NT + rowof(b, p_)) * 512 + h * 64 + 16 * (lane & 3); *(u32x4*)g_ = y0_; *(u32x4*)(g_ + 8) = y1_; } } while (0)
        const f32x4 zero4 = (f32x4){0.f, 0.f, 0.f, 0.f};
        f32x4 S[4] = {zero4, zero4, zero4, zero4};
#define RW2_COMPUTE(c_) do { const bf16_t* sl_ = (const bf16_t*)(lds + ((c_) % 3) * SLOT); const bf16_t* sP = sl_; const bf16_t* sY = sl_ + 64 * RWS; const bf16_t* sQ = sl_ + 2 * 64 * RWS; const bf16_t* sZ = sl_ + 3 * 64 * RWS; \
            bf16_t* yo_ = ybuf + ((c_) & 1) * 64 * RWS + 16 * vb + fr; \
            union { bf16x8 v; unsigned u[4]; } bs[2]; \
            _Pragma("unroll") for (int ks = 0; ks < 2; ++ks) { bs[ks].u[0] = pk2(S[2 * ks][0], S[2 * ks][1]); bs[ks].u[1] = pk2(S[2 * ks][2], S[2 * ks][3]); \
                bs[ks].u[2] = pk2(S[2 * ks + 1][0], S[2 * ks + 1][1]); bs[ks].u[3] = pk2(S[2 * ks + 1][2], S[2 * ks + 1][3]); } \
            _Pragma("unroll") for (int tt = 0; tt < 4; ++tt) { \
                const u32x2 z2 = *(const u32x2*)(sZ + (16 * vb + fr) * RWS + 16 * tt + 4 * fq); \
                f32x4 acc = (f32x4){bflo(z2.x), bfhi(z2.x), bflo(z2.y), bfhi(z2.y)}; \
                acc = __builtin_amdgcn_mfma_f32_16x16x32_bf16(*(const bf16x8*)(sY + (16 * tt + fr) * RWS + 8 * fq), bs[0].v, acc, 0, 0, 0); \
                acc = __builtin_amdgcn_mfma_f32_16x16x32_bf16(*(const bf16x8*)(sY + (16 * tt + fr) * RWS + 32 + 8 * fq), bs[1].v, acc, 0, 0, 0); \
                _Pragma("unroll") for (int j = 0; j < 4; ++j) yo_[(16 * tt + 4 * fq + j) * RWS] = (bf16_t)f2bf(acc[j]); } \
            f32x4 Sn[4]; \
            _Pragma("unroll") for (int kt = 0; kt < 4; ++kt) { \
                const u32x2 q2 = *(const u32x2*)(sQ + (16 * vb + fr) * RWS + 16 * kt + 4 * fq); \
                f32x4 acc = (f32x4){bflo(q2.x), bfhi(q2.x), bflo(q2.y), bfhi(q2.y)}; \
                acc = __builtin_amdgcn_mfma_f32_16x16x32_bf16(*(const bf16x8*)(sP + (16 * kt + fr) * RWS + 8 * fq), bs[0].v, acc, 0, 0, 0); \
                acc = __builtin_amdgcn_mfma_f32_16x16x32_bf16(*(const bf16x8*)(sP + (16 * kt + fr) * RWS + 32 + 8 * fq), bs[1].v, acc, 0, 0, 0); \
                Sn[kt] = acc; } \
            _Pragma("unroll") for (int kt = 0; kt < 4; ++kt) S[kt] = Sn[kt]; } while (0)
#define RW2_BAR() do { asm volatile("s_waitcnt lgkmcnt(0)" ::: "memory"); __builtin_amdgcn_s_barrier(); asm volatile("" ::: "memory"); } while (0)
        if (!comp) { RW2_LD(R0, 0); RW2_ST(R0, 0); RW2_LD(R0, 1); RW2_LD(R1, 2); RW2_LD(R2, 3); }
        __syncthreads();
        for (int c = 0; c < RW_NCH; c += 3) {
            if (!comp) { if (c + 1 < RW_NCH) RW2_ST(R0, c + 1); if (c + 4 < RW_NCH) RW2_LD(R0, c + 4); if (c > 0) RW2_FLUSH(c - 1); } else RW2_COMPUTE(c);
            RW2_BAR();
            if (!comp) { if (c + 2 < RW_NCH) RW2_ST(R1, c + 2); if (c + 5 < RW_NCH) RW2_LD(R1, c + 5); RW2_FLUSH(c); } else RW2_COMPUTE(c + 1);
            RW2_BAR();
            if (!comp) { if (c + 3 < RW_NCH) RW2_ST(R2, c + 3); if (c + 6 < RW_NCH) RW2_LD(R2, c + 6); RW2_FLUSH(c + 1); } else RW2_COMPUTE(c + 2);
            RW2_BAR();
        }
        if (!comp) RW2_FLUSH(RW_NCH - 1);
#undef RW2_LD
#undef RW2_ST
#undef RW2_FLUSH
#undef RW2_COMPUTE
#undef RW2_BAR
    } else {
        na_units(P, lds, bid - 32, G - 32);
    }
}

__device__ __forceinline__ void phase_7(CParams& P, unsigned char* lds, const int ph) {
    PHASE_PROLOGUE
            for (int row = gw; row < NT; row += NGW) {
                const int c0 = lane * 8;
                const u32x4 yf = *(const u32x4*)(YFB + (size_t)row * 512 + c0);
                const u32x4 yb = *(const u32x4*)(YFB + ((size_t)NT + row) * 512 + c0);
                const u32x4 vv = *(const u32x4*)(VV + (size_t)row * 512 + c0);
                const u32x4 gg = *(const u32x4*)(Gg + (size_t)row * 512 + c0);
                float y[8], v[8], g[8];
#pragma unroll
                for (int i = 0; i < 4; ++i) { y[2 * i] = bflo(yf[i]) + bflo(yb[i]); y[2 * i + 1] = bfhi(yf[i]) + bfhi(yb[i]); v[2 * i] = bflo(vv[i]); v[2 * i + 1] = bfhi(vv[i]); g[2 * i] = bflo(gg[i]); g[2 * i + 1] = bfhi(gg[i]); }
                float sm = 0.f;
#pragma unroll
                for (int i = 0; i < 8; ++i) sm += y[i];
                sm += __shfl_xor(sm, 1); sm += __shfl_xor(sm, 2); sm += __shfl_xor(sm, 4);
                const float mean = sm * (1.f / 64.f);
                float vr = 0.f;
#pragma unroll
                for (int i = 0; i < 8; ++i) { const float dlt = y[i] - mean; vr += dlt * dlt; }
                vr += __shfl_xor(vr, 1); vr += __shfl_xor(vr, 2); vr += __shfl_xor(vr, 4);
                const float rstd = rsqrtf(vr * (1.f / 64.f) + 64e-5f);
                const float bc = BC[(size_t)row * 8 + (lane >> 3)];
                float o[8];
#pragma unroll
                for (int i = 0; i < 8; ++i) o[i] = ((y[i] - mean) * rstd * lnx_g[c0 + i] + lnx_b[c0 + i] + bc * v[i]) * g[i];
                u32x4 ov; ov.x = pk2(o[0], o[1]); ov.y = pk2(o[2], o[3]); ov.z = pk2(o[4], o[5]); ov.w = pk2(o[6], o[7]);
                *(u32x4*)(A2 + (size_t)row * DM + 512 + c0) = ov;
            }
}


__device__ __forceinline__ void phase_8(CParams& P, unsigned char* lds, const int ph) {
    PHASE_PROLOGUE
    if (gw < 64) meta_gemm<0>(A2 + (size_t)NMAIN * DM, WTOUT, H + (size_t)NMAIN * DM, gw, lane);
    pg8::DenseOrder S; S.init(A2, WTOUT, NMAIN, DM, DM, G, bid);
    pg8::EpiResidual E{H};
    pg8::gemm_phase<pg8::EpiResidual, pg8::DenseOrder, true, true>((PG8_LAS unsigned char*)lds, DM, S, E);
}

__device__ __forceinline__ void phase_9(CParams& P, unsigned char* lds, const int ph) {
    PHASE_PROLOGUE
            const int l = ph == 9 ? 0 : 1;
                    for (int i = bid * 512 + tid; i < MOE_MAXROWS; i += G * 512) ROWTOK[i] = 0;
    unsigned* cnt = CTL + CW_CNT(l);
            const float* wg = moe_wg + (size_t)l * DM * 4; const float* bg = moe_bg + l * 4;
            for (int row = gw; row < NT; row += NGW) {
                f32x4 v[4]; float ss = 0.f;
#pragma unroll
                for (int j = 0; j < 4; ++j) { v[j] = ldrow_bf16(H + (size_t)row * DM, lane, j); ss += v[j][0] * v[j][0] + v[j][1] * v[j][1] + v[j][2] * v[j][2] + v[j][3] * v[j][3]; }
                ss = wave_sum(ss);
                const float rstd = rsqrtf(ss * (1.f / DM) + 1e-6f);
                float lg[4] = {0.f, 0.f, 0.f, 0.f};
#pragma unroll
                for (int j = 0; j < 4; ++j) {
                    const f32x4 g = ((const f32x4*)(norm_ffn + l * DM))[lane + 64 * j];
#pragma unroll
                    for (int i = 0; i < 4; ++i) v[j][i] = v[j][i] * rstd * g[i];
                    u32x2 o; o.x = pk2(v[j][0], v[j][1]); o.y = pk2(v[j][2], v[j][3]);
                    ((u32x2*)(HN + (size_t)row * DM))[lane + 64 * j] = o;
#pragma unroll
                    for (int i = 0; i < 4; ++i) { const f32x4 w = *(const f32x4*)(wg + (size_t)(4 * (lane + 64 * j) + i) * 4);
                        lg[0] += v[j][i] * w[0]; lg[1] += v[j][i] * w[1]; lg[2] += v[j][i] * w[2]; lg[3] += v[j][i] * w[3]; }
                }
#pragma unroll
                for (int q = 0; q < 4; ++q) lg[q] = wave_sum(lg[q]) + bg[q];
                int grp = 0; float mx = lg[0];
#pragma unroll
                for (int q = 1; q < 4; ++q) if (lg[q] > mx) { mx = lg[q]; grp = q; }
                float den = 0.f;
#pragma unroll
                for (int q = 0; q < 4; ++q) den += __expf(lg[q] - mx);
                const float pgrp = 1.f / den;
                const float* we = moe_we + ((size_t)(l * 4 + grp) * DM) * 8;
                float le[8] = {0.f, 0.f, 0.f, 0.f, 0.f, 0.f, 0.f, 0.f};
#pragma unroll
                for (int j = 0; j < 4; ++j)
#pragma unroll
                    for (int i = 0; i < 4; ++i) { const float* wr_ = we + (size_t)(4 * (lane + 64 * j) + i) * 8; const f32x4 wa = *(const f32x4*)wr_, wb = *(const f32x4*)(wr_ + 4);
                        le[0] += v[j][i] * wa[0]; le[1] += v[j][i] * wa[1]; le[2] += v[j][i] * wa[2]; le[3] += v[j][i] * wa[3];
                        le[4] += v[j][i] * wb[0]; le[5] += v[j][i] * wb[1]; le[6] += v[j][i] * wb[2]; le[7] += v[j][i] * wb[3]; }
#pragma unroll
                for (int q = 0; q < 8; ++q) le[q] = wave_sum(le[q]) + moe_be[(l * 4 + grp) * 8 + q];
                int i1 = 0; float m1 = le[0];
#pragma unroll
                for (int q = 1; q < 8; ++q) if (le[q] > m1) { m1 = le[q]; i1 = q; }
                int i2 = (i1 + 1) & 7; float m2 = -3.0e38f;
#pragma unroll
                for (int q = 0; q < 8; ++q) if (q != i1 && le[q] > m2) { m2 = le[q]; i2 = q; }
                const float e2 = __expf(m2 - m1);
                const float g1 = pgrp / (1.f + e2), g2 = pgrp * e2 / (1.f + e2);
                if (lane == 0) {
                    const int ea = grp * 8 + i1, eb = grp * 8 + i2;
                    const unsigned pa = atomicAdd(cnt + ea, 1u), pb = atomicAdd(cnt + eb, 1u);
                    EID[row * 2] = ea; EID[row * 2 + 1] = eb; POS[row * 2] = (int)pa; POS[row * 2 + 1] = (int)pb;
                    GATE[row * 2] = g1; GATE[row * 2 + 1] = g2;
                }
            }
    for (int it = gw; it < CONV_MOE_ITEMS; it += NGW) conv_moe_item(P, l, it, lane);
}


__device__ __forceinline__ void phase_10(CParams& P, unsigned char* lds, const int ph) {
    PHASE_PROLOGUE
    const int l = ph == 10 ? 0 : 1;
    int* ps = (int*)(lds + LDS_TAB);
    if (tid == 0) { int acc_ = 0; for (int e = 0; e < NEXP; ++e) { ps[e] = acc_; const int c = (int)CTL[CW_CNT(l) + e]; acc_ += (c + MOE_RT - 1) / MOE_RT * MOE_RT; } ps[NEXP] = acc_; }
    __syncthreads();
    for (int i = bid * 512 + tid; i < NT * 2; i += G * 512) { const int dest = ps[EID[i]] + POS[i]; DEST[i] = dest; ROWTOK[dest] = i >> 1; }
    __syncthreads();
}

__device__ __forceinline__ void phase_11(CParams& P, unsigned char* lds, const int ph) {
    PHASE_PROLOGUE
    const int l = ph == 11 ? 0 : 1;
    int* et = (int*)(lds + LDS_TAB);
    if (tid == 0) { int acc_ = 0; for (int e = 0; e < NEXP; ++e) { const int c = (int)CTL[CW_CNT(l) + e], n = (c + MOE_RT - 1) / MOE_RT; for (int q = 0; q < n; ++q) et[1 + acc_ + q] = e; acc_ += n; } et[0] = acc_; }
    __syncthreads();
    pg8::MoeOrder<true> S{et + 1, et[0], vcu, (const char*)HN, (const char*)WT13, 256u * DM * 2u, 256u * DM * 2u, (unsigned)DM * DM * 2u, ROWTOK};
    pg8::EpiSwiglu E{HB};
    pg8::gemm_phase<pg8::EpiSwiglu, pg8::MoeOrder<true>, true, true>((PG8_LAS unsigned char*)lds, DM, S, E);
    __syncthreads();
}

__device__ __forceinline__ void phase_12(CParams& P, unsigned char* lds, const int ph) {
    PHASE_PROLOGUE
    const int l = ph == 12 ? 0 : 1;
    int* et = (int*)(lds + LDS_TAB);
    if (tid == 0) { int acc_ = 0; for (int e = 0; e < NEXP; ++e) { const int c = (int)CTL[CW_CNT(l) + e], n = (c + MOE_RT - 1) / MOE_RT; for (int q = 0; q < n; ++q) et[1 + acc_ + q] = e; acc_ += n; } et[0] = acc_; }
    __syncthreads();
    pg8::MoeOrder<false> S{et + 1, et[0], vcu, (const char*)HB, (const char*)WT2, 256u * DFF * 2u, 256u * DFF * 2u, (unsigned)DM * DFF * 2u, nullptr};
    pg8::EpiBf16Plain E{YB, DM};
    pg8::gemm_phase<pg8::EpiBf16Plain, pg8::MoeOrder<false>, true, true>((PG8_LAS unsigned char*)lds, DFF, S, E);
    __syncthreads();
}

__device__ __forceinline__ void phase_13(CParams& P, unsigned char* lds, const int ph) {
    PHASE_PROLOGUE
            const bool fin = ph == 21;
            for (int row = gw; row < NT; row += NGW) {
                const int d0 = DEST[row * 2], d1 = DEST[row * 2 + 1];
                const float g0 = GATE[row * 2], g1 = GATE[row * 2 + 1];
                f32x4 v[4];
#pragma unroll
                for (int j = 0; j < 4; ++j) {
                    v[j] = ldrow_bf16(H + (size_t)row * DM, lane, j);
                    const u32x2 ya = ((const u32x2*)(YB + (size_t)d0 * DM))[lane + 64 * j];
                    const u32x2 yb = ((const u32x2*)(YB + (size_t)d1 * DM))[lane + 64 * j];
                    v[j][0] += g0 * bflo(ya.x) + g1 * bflo(yb.x); v[j][1] += g0 * bfhi(ya.x) + g1 * bfhi(yb.x);
                    v[j][2] += g0 * bflo(ya.y) + g1 * bflo(yb.y); v[j][3] += g0 * bfhi(ya.y) + g1 * bfhi(yb.y);
                }
                if (!fin) {
#pragma unroll
                    for (int j = 0; j < 4; ++j) strow_bf16(H + (size_t)row * DM, lane, j, v[j]);
                    store_norm_bf16(v, norm_mix + DM, HN + (size_t)row * DM, lane);
                } else if (row < NMAIN) {
                    float ss = 0.f;
#pragma unroll
                    for (int j = 0; j < 4; ++j) ss += v[j][0] * v[j][0] + v[j][1] * v[j][1] + v[j][2] * v[j][2] + v[j][3] * v[j][3];
                    ss = wave_sum(ss);
                    const float rstd = rsqrtf(ss * (1.f / DM) + 1e-6f);
#pragma unroll
                    for (int j = 0; j < 4; ++j) { const f32x4 g = ((const f32x4*)norm_final)[lane + 64 * j]; f32x4 o;
                        o[0] = v[j][0] * rstd * g[0]; o[1] = v[j][1] * rstd * g[1]; o[2] = v[j][2] * rstd * g[2]; o[3] = v[j][3] * rstd * g[3];
                        ((f32x4*)(P.out + (size_t)row * DM))[lane + 64 * j] = o; }
                }
            }
}

__device__ __forceinline__ void phase_14(CParams& P, unsigned char* lds, const int ph) {
    PHASE_PROLOGUE
    float* pwr = (float*)lds; float* pwi = pwr + 2176; float* bbr = pwi + 2176; float* bbi = bbr + 2048; float* ccr = bbi + 2048; float* cci = ccr + 2048; float* kf = cci + 2048; float* kb = kf + 4096;
    for (int gu = bid; gu < 256; gu += G) {
        const int g = gu >> 2, part = gu & 3;
        if (tid < 128) {
            const int d = tid >> 6, p = tid & 63;
            const float step = __expf(s5_ls[d * 64 + g]);
            const float lr = s5_lre[(d * 64 + g) * 64 + p], li = s5_lim[(d * 64 + g) * 64 + p];
            const float mag = expf(lr * step);
            const float abr = mag * cosf(li * step), abi = mag * sinf(li * step);
            const float den = lr * lr + li * li;
            const float zr = ((abr - 1.f) * lr + abi * li) / den, zi = (abi * lr - (abr - 1.f) * li) / den;
            float pr = 1.f, pi = 0.f;
            for (int t = 0; t < 17; ++t) { pwr[(d * 64 + p) * 17 + t] = pr; pwi[(d * 64 + p) * 17 + t] = pi; const float nr = pr * abr - pi * abi; pi = pr * abi + pi * abr; pr = nr; }
            for (int i = 0; i < 16; ++i) { const float br = s5_b_re[((size_t)(g * 64 + p)) * 16 + i], bi = s5_b_im[((size_t)(g * 64 + p)) * 16 + i];
                bbr[(d * 64 + p) * 16 + i] = zr * br - zi * bi; bbi[(d * 64 + p) * 16 + i] = zr * bi + zi * br; }
        }
        for (int idx = tid; idx < 2048; idx += 512) { const int d = idx >> 10, i = (idx >> 6) & 15, p = idx & 63;
            ccr[(d * 64 + p) * 16 + i] = s5_c_re[((size_t)(d * 64 + g) * 16 + i) * 64 + p]; cci[(d * 64 + p) * 16 + i] = s5_c_im[((size_t)(d * 64 + g) * 16 + i) * 64 + p]; }
        __syncthreads();
        {
            const int d = tid >> 8, tau = (tid >> 4) & 15, i = tid & 15;
            float acc[16];
#pragma unroll
            for (int q = 0; q < 16; ++q) acc[q] = 0.f;
            for (int p = 0; p < 64; ++p) {
                const float cr = ccr[(d * 64 + p) * 16 + i], ci = cci[(d * 64 + p) * 16 + i], pr = pwr[(d * 64 + p) * 17 + tau], pi = pwi[(d * 64 + p) * 17 + tau];
                const float xr = cr * pr - ci * pi, xi = cr * pi + ci * pr;
#pragma unroll
                for (int q = 0; q < 16; ++q) acc[q] += xr * bbr[(d * 64 + p) * 16 + q] - xi * bbi[(d * 64 + p) * 16 + q];
            }
            float* kt = (d ? kb : kf) + (tau * 16 + i) * 16;
#pragma unroll
            for (int q = 0; q < 16; ++q) kt[q] = acc[q];
        }
        __syncthreads();
        unsigned* bta = (unsigned*)(BTA + (size_t)g * 512 * 256);
        for (int idx = part * 128 * 128 + tid; idx < (part + 1) * 128 * 128; idx += 512) {
            const int row = idx >> 7, col = (idx & 127) * 2;
            float v[2];
#pragma unroll
            for (int e = 0; e < 2; ++e) {
                const int cc_ = col + e, j = cc_ >> 4, ip = cc_ & 15;
                if (row < 256) { const int t = row >> 4, i = row & 15;
                    v[e] = j < t ? kf[((t - j) * 16 + i) * 16 + ip] : (j > t ? kb[((j - t) * 16 + i) * 16 + ip] : kf[i * 16 + ip] + kb[i * 16 + ip]); }
                else { const int kp = row - 256, d = kp >> 7, part = (kp >> 6) & 1, p = kp & 63, tau = d == 0 ? 15 - j : j;
                    const float pr = pwr[(d * 64 + p) * 17 + tau], pi = pwi[(d * 64 + p) * 17 + tau], br = bbr[(d * 64 + p) * 16 + ip], bi = bbi[(d * 64 + p) * 16 + ip];
                    v[e] = part ? pr * bi + pi * br : pr * br - pi * bi; }
            }
            bta[idx] = pk2(v[0], v[1]);
        }
        unsigned* btc = (unsigned*)(BTC + (size_t)g * 256 * 256);
        for (int idx = part * 64 * 128 + tid; idx < (part + 1) * 64 * 128; idx += 512) {
            const int row = idx >> 7, col = (idx & 127) * 2, t = row >> 4, i = row & 15;
            float v[2];
#pragma unroll
            for (int e = 0; e < 2; ++e) {
                const int k = col + e, d = k >> 7, part = (k >> 6) & 1, p = k & 63, tau = d == 0 ? t + 1 : 16 - t;
                const float cr = ccr[(d * 64 + p) * 16 + i], ci = cci[(d * 64 + p) * 16 + i], pr = pwr[(d * 64 + p) * 17 + tau], pi = pwi[(d * 64 + p) * 17 + tau];
                v[e] = part ? -(cr * pi + ci * pr) : cr * pr - ci * pi;
            }
            btc[idx] = pk2(v[0], v[1]);
        }
        __syncthreads();
    }
}

__device__ __forceinline__ void phase_15(CParams& P, unsigned char* lds, const int ph) {
    PHASE_PROLOGUE
    pg8::S5OrderA S{vcu, (const char*)HN, (const char*)BTA};
    pg8::EpiS5A E{YI, S5E};
    int Kr = 256; asm volatile("" : "+s"(Kr));
    pg8::gemm_phase<pg8::EpiS5A, pg8::S5OrderA, true, true>((PG8_LAS unsigned char*)lds, Kr, S, E);
}

__device__ __forceinline__ void phase_16(CParams& P, unsigned char* lds, const int ph) {
    PHASE_PROLOGUE
    float* Ls = (float*)lds;
    for (int wg = bid; wg < NB * 64 * 2; wg += G) {
        const int d = wg & 1, g = (wg >> 1) & 63, b = wg >> 7, p = lane;
        const float step = __expf(s5_ls[d * 64 + g]);
        const float lr = s5_lre[(d * 64 + g) * 64 + p], li = s5_lim[(d * 64 + g) * 64 + p];
        const float mag = expf(lr * step);
        const float abr = mag * cosf(li * step), abi = mag * sinf(li * step);
        float ar = 1.f, ai = 0.f;
        for (int t = 0; t < 16; ++t) { const float nr = ar * abr - ai * abi; ai = ar * abi + ai * abr; ar = nr; }
        float Ar = 1.f, Ai = 0.f;
        for (int t = 0; t < 64; ++t) { const float nr = Ar * ar - Ai * ai; Ai = Ar * ai + Ai * ar; Ar = nr; }
        const bf16_t* Ep = S5E + (size_t)g * 256 + d * 128 + p;
        bf16_t* Cp = CAR + (size_t)g * 1280 * 256 + d * 128 + p;
        const int q0 = 64 * wave;
#define S5_N(q_) ({ const int c_ = d ? 512 - (q_) : (q_); c_ == 0 ? 1024 + b : b * 512 + c_ - 1; })
        float sr = 0.f, si = 0.f;
#pragma unroll 1
        for (int hb = 0; hb < 2; ++hb) {
            float er[32], ei[32];
#pragma unroll
            for (int k = 0; k < 32; ++k) { const int n = S5_N(q0 + 32 * hb + k); er[k] = bf2f(Ep[(size_t)n * 64 * 256]); ei[k] = bf2f(Ep[(size_t)n * 64 * 256 + 64]); }
#pragma unroll
            for (int k = 0; k < 32; ++k) { const float nr = ar * sr - ai * si + er[k]; si = ar * si + ai * sr + ei[k]; sr = nr; }
        }
        Ls[(wave * 64 + p) * 2] = sr; Ls[(wave * 64 + p) * 2 + 1] = si;
        __syncthreads();
        sr = 0.f; si = 0.f;
        for (int w2 = 0; w2 < wave; ++w2) { const float l0 = Ls[(w2 * 64 + p) * 2], l1 = Ls[(w2 * 64 + p) * 2 + 1]; const float nr = Ar * sr - Ai * si + l0; si = Ar * si + Ai * sr + l1; sr = nr; }
#pragma unroll 1
        for (int hb = 0; hb < 2; ++hb) {
            float er[32], ei[32]; int nn[32];
#pragma unroll
            for (int k = 0; k < 32; ++k) { nn[k] = S5_N(q0 + 32 * hb + k); er[k] = bf2f(Ep[(size_t)nn[k] * 64 * 256]); ei[k] = bf2f(Ep[(size_t)nn[k] * 64 * 256 + 64]); }
#pragma unroll
            for (int k = 0; k < 32; ++k) { Cp[(size_t)nn[k] * 256] = (bf16_t)f2bf(sr); Cp[(size_t)nn[k] * 256 + 64] = (bf16_t)f2bf(si);
                const float nr = ar * sr - ai * si + er[k]; si = ar * si + ai * sr + ei[k]; sr = nr; }
        }
        if (wave == 7) { const int n = S5_N(512); Cp[(size_t)n * 256] = (bf16_t)f2bf(sr); Cp[(size_t)n * 256 + 64] = (bf16_t)f2bf(si); }
#undef S5_N
        __syncthreads();
    }
}

__device__ __forceinline__ void phase_22(CParams& P, unsigned char* lds, const int ph) {
    PHASE_PROLOGUE
    pg8::S5OrderC S{vcu, (const char*)CAR, (const char*)BTC};
    pg8::EpiS5C E{YI, HN, s5_d, A2};
    int Kr = 256; asm volatile("" : "+s"(Kr));
    pg8::gemm_phase<pg8::EpiS5C, pg8::S5OrderC, true, true>((PG8_LAS unsigned char*)lds, Kr, S, E);
}

__device__ __forceinline__ void phase_23(CParams& P, unsigned char* lds, const int ph) {
    PHASE_PROLOGUE
    if (gw < 64) meta_gemm<1>(A2 + (size_t)NMAIN * DM, WTGLU, H + (size_t)NMAIN * DM, gw, lane);
    pg8::DenseOrder S; S.init(A2, WTGLU, NMAIN, 2 * DM, DM, G, bid);
    pg8::EpiGlu E{H};
    pg8::gemm_phase<pg8::EpiGlu, pg8::DenseOrder, true, true>((PG8_LAS unsigned char*)lds, DM, S, E);
}
#define LAS __attribute__((address_space(3)))
#define CW_BAR 4096
#define XB_TMO      128
#define XB_XCNT(j)  (256  + 64 * (j))
#define XB_XSUB(j)  (1280 + 64 * (j))
#define XB_XGEN(j)  (2304 + 64 * (j))
#define XB_TOP      3328
#define XB_TOPGEN   3392
#define XCD_BAR_WORDS 3456
#define XB_SPIN_CAP (1u << 22)
__device__ __forceinline__ unsigned xb_ld(unsigned* p)              { return __hip_atomic_load(p, __ATOMIC_RELAXED, __HIP_MEMORY_SCOPE_AGENT); }
__device__ __forceinline__ unsigned xb_add(unsigned* p, unsigned v) { return __hip_atomic_fetch_add(p, v, __ATOMIC_RELAXED, __HIP_MEMORY_SCOPE_AGENT); }
__device__ __forceinline__ unsigned xb_xcc_id() { return (unsigned)__builtin_amdgcn_s_getreg((3 << 11) | 20) & 0xFu; }
#define XB_SPIN(cond, bar) do { unsigned _sp = 0; while (cond) { __builtin_amdgcn_s_sleep(1); \
    if ((++_sp & 255u) == 0u) { if (xb_ld(&(bar)[XB_TMO])) break; if (_sp > XB_SPIN_CAP) { atomicAdd(&(bar)[XB_TMO], 1u); break; } } } } while (0)
struct XcdBarrier { unsigned* bar; unsigned x; volatile LAS unsigned* st; };
__device__ __forceinline__ XcdBarrier xcd_barrier_post(unsigned* bar, volatile LAS unsigned* st) {
    XcdBarrier b; b.bar = bar; b.x = xb_xcc_id(); b.st = st;
    if (threadIdx.x == 0) (void)xb_add(&bar[XB_XCNT(b.x)], 1u);
    return b;
}
__device__ __forceinline__ void xcd_barrier_complete(unsigned* bar, unsigned x, unsigned& nloc, unsigned& nx) {
    const unsigned G = GRID;
    unsigned sum, cnt, mine, sp = 0u;
    for (;;) {
        sum = 0u; cnt = 0u; mine = 0u;
#pragma unroll
        for (unsigned j = 0; j < 16; ++j) { const unsigned c = xb_ld(&bar[XB_XCNT(j)]); sum += c; cnt += (c > 0u) ? 1u : 0u; mine = (j == x) ? c : mine; }
        if (sum == G) break;
        __builtin_amdgcn_s_sleep(1);
        if ((++sp & 255u) == 0u) { if (xb_ld(&bar[XB_TMO])) break; if (sp > XB_SPIN_CAP) { atomicAdd(&bar[XB_TMO], 1u); break; } }
    }
    nloc = mine > 0u ? mine : 1u; nx = cnt > 0u ? cnt : 1u;
}
__device__ __forceinline__ void xcd_barrier(const XcdBarrier& b) {
    asm volatile("s_waitcnt vmcnt(0)" ::: "memory");
    __syncthreads();
    if (threadIdx.x == 0) {
        unsigned* bar = b.bar;
        __builtin_amdgcn_s_waitcnt(0);
        unsigned nloc = b.st[0], nx = b.st[1];
        if (nloc == 0u) { xcd_barrier_complete(bar, b.x, nloc, nx); b.st[0] = nloc; b.st[1] = nx; }
        const unsigned old = xb_add(&bar[XB_XSUB(b.x)], 1u);
        const unsigned gen = old / nloc;
        if (old + 1u == (gen + 1u) * nloc) {
            __builtin_amdgcn_fence(__ATOMIC_RELEASE, "agent");
            asm volatile("s_waitcnt vmcnt(0)" ::: "memory");
            const unsigned og = xb_add(&bar[XB_TOP], 1u);
            const unsigned tg = og / nx;
            if (og + 1u == (tg + 1u) * nx) xb_add(&bar[XB_TOPGEN], 1u);
            else XB_SPIN(xb_ld(&bar[XB_TOPGEN]) == tg, bar);
            __builtin_amdgcn_fence(__ATOMIC_ACQUIRE, "agent");
            xb_add(&bar[XB_XGEN(b.x)], 1u);
            asm volatile("s_waitcnt vmcnt(0)" ::: "memory");
        } else {
            XB_SPIN(xb_ld(&bar[XB_XGEN(b.x)]) == gen, bar);
            __builtin_amdgcn_fence(__ATOMIC_ACQUIRE, "agent");
            asm volatile("s_waitcnt vmcnt(0)" ::: "memory");
        }
    }
    __syncthreads();
}


__global__ void __launch_bounds__(512, 2) mega(Params P_) {
    extern __shared__ __attribute__((aligned(16))) unsigned char lds[];
    volatile LAS unsigned* st = (volatile LAS unsigned*)(LAS unsigned char*)(lds + LDS_BARST);
    if (threadIdx.x < 16) st[threadIdx.x] = 0u;
    __syncthreads();
    CParams* pp = (CParams*)__builtin_amdgcn_kernarg_segment_ptr();
    (void)xcd_barrier_post((unsigned*)(pp->ws + WS_CTL) + CW_BAR, st);
#define GB do { XcdBarrier bar_; bar_.bar = (unsigned*)(pp->ws + WS_CTL) + CW_BAR; bar_.x = xb_xcc_id(); bar_.st = (volatile LAS unsigned*)(LAS unsigned char*)(lds + LDS_BARST); xcd_barrier(bar_); asm volatile("" : "+s"(pp)); } while (0)
#define P (*pp)
    asm volatile("" : "+s"(pp));
    phase_0(P, lds, 0); GB;
#if defined(PROBE_PH) && PROBE_PH == 0
    { int nrep = PROBE_N; asm volatile("" : "+s"(nrep)); for (int rep = 0; rep < nrep; ++rep) { GB; phase_0(P, lds, 0); GB; } }
#endif
    phase_1(P, lds, 1); GB;
#if defined(PROBE_PH) && PROBE_PH == 1
    { int nrep = PROBE_N; asm volatile("" : "+s"(nrep)); for (int rep = 0; rep < nrep; ++rep) { GB; phase_1(P, lds, 1); GB; } }
#endif
    phase_3(P, lds, 3); GB;
#if defined(PROBE_PH) && PROBE_PH == 3
    { int nrep = PROBE_N; asm volatile("" : "+s"(nrep)); for (int rep = 0; rep < nrep; ++rep) { GB; phase_3(P, lds, 3); GB; } }
#endif
    phase_6(P, lds, 6); GB;
    phase_60(P, lds, 60); GB;
#if defined(PROBE_PH) && PROBE_PH == 60
    { int nrep = PROBE_N; asm volatile("" : "+s"(nrep)); for (int rep = 0; rep < nrep; ++rep) { GB; phase_60(P, lds, 60); GB; } }
#endif
#if defined(PROBE_PH) && PROBE_PH == 6
    { int nrep = PROBE_N; asm volatile("" : "+s"(nrep)); for (int rep = 0; rep < nrep; ++rep) { GB; phase_6(P, lds, 6); GB; } }
#endif
    phase_7(P, lds, 7); GB;
#if defined(PROBE_PH) && PROBE_PH == 7
    { int nrep = PROBE_N; asm volatile("" : "+s"(nrep)); for (int rep = 0; rep < nrep; ++rep) { GB; phase_7(P, lds, 7); GB; } }
#endif
    phase_8(P, lds, 8); GB;
#if defined(PROBE_PH) && PROBE_PH == 8
    { int nrep = PROBE_N; asm volatile("" : "+s"(nrep)); for (int rep = 0; rep < nrep; ++rep) { GB; phase_8(P, lds, 8); GB; } }
#endif
    phase_9(P, lds, 9); GB;
#if defined(PROBE_PH) && PROBE_PH == 9
    { int nrep = PROBE_N; asm volatile("" : "+s"(nrep)); for (int rep = 0; rep < nrep; ++rep) { GB; phase_9(P, lds, 9); GB; } }
#endif
    phase_10(P, lds, 10); GB;
#if defined(PROBE_PH) && PROBE_PH == 10
    { int nrep = PROBE_N; asm volatile("" : "+s"(nrep)); for (int rep = 0; rep < nrep; ++rep) { GB; phase_10(P, lds, 10); GB; } }
#endif
    phase_11(P, lds, 11); GB;
#if defined(PROBE_PH) && PROBE_PH == 11
    { int nrep = PROBE_N; asm volatile("" : "+s"(nrep)); for (int rep = 0; rep < nrep; ++rep) { GB; phase_11(P, lds, 11); GB; } }
#endif
    phase_12(P, lds, 12); GB;
#if defined(PROBE_PH) && PROBE_PH == 12
    { int nrep = PROBE_N; asm volatile("" : "+s"(nrep)); for (int rep = 0; rep < nrep; ++rep) { GB; phase_12(P, lds, 12); GB; } }
#endif
    phase_13(P, lds, 13); GB;
#if defined(PROBE_PH) && PROBE_PH == 13
    { int nrep = PROBE_N; asm volatile("" : "+s"(nrep)); for (int rep = 0; rep < nrep; ++rep) { GB; phase_13(P, lds, 13); GB; } }
#endif
    phase_14(P, lds, 14); GB;
#if defined(PROBE_PH) && PROBE_PH == 14
    { int nrep = PROBE_N; asm volatile("" : "+s"(nrep)); for (int rep = 0; rep < nrep; ++rep) { GB; phase_14(P, lds, 14); GB; } }
#endif
    phase_15(P, lds, 15); GB;
#if defined(PROBE_PH) && PROBE_PH == 15
    { int nrep = PROBE_N; asm volatile("" : "+s"(nrep)); for (int rep = 0; rep < nrep; ++rep) { GB; phase_15(P, lds, 15); GB; } }
#endif
    phase_16(P, lds, 16); GB;
#if defined(PROBE_PH) && PROBE_PH == 16
    { int nrep = PROBE_N; asm volatile("" : "+s"(nrep)); for (int rep = 0; rep < nrep; ++rep) { GB; phase_16(P, lds, 16); GB; } }
#endif
    phase_22(P, lds, 22); GB;
#if defined(PROBE_PH) && PROBE_PH == 22
    { int nrep = PROBE_N; asm volatile("" : "+s"(nrep)); for (int rep = 0; rep < nrep; ++rep) { GB; phase_22(P, lds, 22); GB; } }
#endif
    phase_23(P, lds, 23); GB;
#if defined(PROBE_PH) && PROBE_PH == 23
    { int nrep = PROBE_N; asm volatile("" : "+s"(nrep)); for (int rep = 0; rep < nrep; ++rep) { GB; phase_23(P, lds, 23); GB; } }
#endif
    phase_9(P, lds, 17); GB;
#if defined(PROBE_PH) && PROBE_PH == 17
    { int nrep = PROBE_N; asm volatile("" : "+s"(nrep)); for (int rep = 0; rep < nrep; ++rep) { GB; phase_9(P, lds, 17); GB; } }
#endif
    phase_10(P, lds, 18); GB;
#if defined(PROBE_PH) && PROBE_PH == 18
    { int nrep = PROBE_N; asm volatile("" : "+s"(nrep)); for (int rep = 0; rep < nrep; ++rep) { GB; phase_10(P, lds, 18); GB; } }
#endif
    phase_11(P, lds, 19); GB;
#if defined(PROBE_PH) && PROBE_PH == 19
    { int nrep = PROBE_N; asm volatile("" : "+s"(nrep)); for (int rep = 0; rep < nrep; ++rep) { GB; phase_11(P, lds, 19); GB; } }
#endif
    phase_12(P, lds, 20); GB;
#if defined(PROBE_PH) && PROBE_PH == 20
    { int nrep = PROBE_N; asm volatile("" : "+s"(nrep)); for (int rep = 0; rep < nrep; ++rep) { GB; phase_12(P, lds, 20); GB; } }
#endif
    phase_13(P, lds, 21);
#if defined(PROBE_PH) && PROBE_PH == 21
    { int nrep = PROBE_N; asm volatile("" : "+s"(nrep)); for (int rep = 0; rep < nrep; ++rep) { GB; phase_13(P, lds, 21); GB; } }
#endif
#undef P
#undef GB
}

extern "C" void kernel_launch(void* const* d_in, const int* in_sizes, int n_in, void* d_out, int out_size, void* d_ws, size_t ws_size, hipStream_t stream) {
    static int ready = 0;
    if (!ready) {
        if (n_in != 35 || ws_size < WS_TOTAL) { fprintf(stderr, "kernel_launch: unexpected n_in %d or ws_size %zu (need %zu)\n", n_in, ws_size, (size_t)WS_TOTAL); ready = -1; return; }
        if (hipFuncSetAttribute((const void*)mega, hipFuncAttributeMaxDynamicSharedMemorySize, LDS_BYTES) != hipSuccess) { fprintf(stderr, "kernel_launch: hipFuncSetAttribute failed\n"); ready = -1; return; }
        ready = 1;
    }
    if (ready < 0) return;
    (void)hipMemsetAsync((char*)d_ws + WS_CTL, 0, 1 * MiB, stream);
    Params P{};
    for (int i = 0; i < 35; ++i) P.in[i] = (const float*)d_in[i];
    P.out = (float*)d_out; P.ws = (unsigned char*)d_ws; P.ph_lo = 0; P.ph_hi = 0;
    hipLaunchKernelGGL(mega, dim3(GRID), dim3(512), LDS_BYTES, stream, P);
}
```

```cpp
#include <hip/hip_runtime.h>
#include <stdint.h>
#include <stdio.h>

#define DM 1024
#define NB 2
#define SEQ 8192
#define NMETA 16
#define LSEQ (SEQ + NMETA)
#define NMAIN (NB * SEQ)
#define NT (NB * LSEQ)
#define NTP 16640
#define INCOLS 3328
#define RESTC 1792
#define NEXP 32
#define DFF 512
#define S5TC 48
#define S5NC 171
#define MOE_RT 256
#define MOE_MAXROWS 41216

typedef unsigned short bf16_t;
typedef short bf16x8 __attribute__((ext_vector_type(8)));
typedef float f32x4 __attribute__((ext_vector_type(4)));
typedef unsigned u32x4 __attribute__((ext_vector_type(4)));
typedef unsigned u32x2 __attribute__((ext_vector_type(2)));

constexpr size_t MiB = 1u << 20;
constexpr size_t cmax2(size_t a, size_t b) { return a > b ? a : b; }
constexpr size_t al64k(size_t x) { return (x + 65535) & ~(size_t)65535; }
constexpr size_t WS_CTL = 0;
constexpr size_t WS_H = 1 * MiB;
constexpr size_t WS_HN = WS_H + al64k((size_t)NT * DM * 2);
constexpr size_t WS_A2 = WS_HN + al64k((size_t)NTP * DM * 2);
constexpr size_t WS_WTIN = WS_A2 + al64k((size_t)NTP * DM * 2);
constexpr size_t WS_WTOUT = WS_WTIN + al64k((size_t)INCOLS * DM * 2);
constexpr size_t WS_WTGLU = WS_WTOUT + al64k((size_t)DM * DM * 2);
constexpr size_t WS_LRT = WS_WTGLU + al64k((size_t)2 * DM * DM * 2);
constexpr size_t WS_BIG = WS_LRT + al64k((size_t)(2 * 512 * 64 * 2 + 512 * 128) * 2);
constexpr size_t SZ_T512 = al64k((size_t)NT * 512 * 2);
constexpr size_t SZ_P512 = al64k((size_t)NTP * 512 * 2);
constexpr int RW_NCH = 129, RW_UNITS = 32 * RW_NCH;
constexpr size_t SZ_RWOP = al64k((size_t)RW_UNITS * 4096 * 2);
constexpr size_t WS_Q = WS_BIG;
constexpr size_t WS_K = WS_Q + SZ_P512;
constexpr size_t WS_V = WS_K + SZ_P512;
constexpr size_t WS_REST = WS_V + SZ_P512;
constexpr size_t WS_KR = WS_REST + al64k((size_t)NTP * RESTC * 2);
constexpr size_t WS_LOW = WS_KR + SZ_T512;
constexpr size_t WS_AA = WS_LOW + al64k((size_t)NT * 256 * 2);
constexpr size_t WS_XEARLY = WS_AA + 2 * SZ_T512;
constexpr size_t WS_PP = WS_REST;
constexpr size_t WS_QT = WS_PP + SZ_RWOP;
constexpr size_t WS_YT = WS_QT + SZ_RWOP;
constexpr size_t WS_ZT = WS_YT + SZ_RWOP;
constexpr size_t WS_XEND = cmax2(WS_XEARLY, WS_ZT + SZ_RWOP);
constexpr size_t WS_R = WS_XEND;
constexpr size_t WS_VV = WS_R + SZ_T512;
constexpr size_t WS_G = WS_VV + SZ_T512;
constexpr size_t WS_KK = WS_G + SZ_T512;
constexpr size_t WS_KKA = WS_KK + SZ_T512;
constexpr size_t WS_KD = WS_KKA + 2 * SZ_T512;
constexpr size_t WS_W = WS_KD + 2 * SZ_T512;
constexpr size_t WS_BC = WS_W + 2 * SZ_T512;
constexpr size_t WS_MIXEND = WS_BC + al64k((size_t)NT * 8 * 4);
constexpr size_t WS_YFB = WS_KK;
constexpr size_t WS_ROWTOK = WS_BIG;
constexpr size_t WS_HB = WS_ROWTOK + al64k((size_t)MOE_MAXROWS * 4);
constexpr size_t WS_YB = WS_HB + al64k((size_t)MOE_MAXROWS * DFF * 2);
constexpr size_t WS_WT13 = WS_YB + al64k((size_t)MOE_MAXROWS * DM * 2);
constexpr size_t WS_WT2 = WS_WT13 + al64k((size_t)NEXP * DM * DM * 2);
constexpr size_t WS_EID = WS_WT2 + al64k((size_t)NEXP * DM * DFF * 2);
constexpr size_t WS_POS = WS_EID + al64k((size_t)NT * 8);
constexpr size_t WS_DEST = WS_POS + al64k((size_t)NT * 8);
constexpr size_t WS_GATE = WS_DEST + al64k((size_t)NT * 8);
constexpr size_t WS_MOEEND = WS_GATE + al64k((size_t)NT * 8);
constexpr size_t WS_YI = WS_BIG;
constexpr size_t WS_E = WS_YI + al64k((size_t)NTP * DM * 2);
constexpr size_t WS_CAR = WS_E + al64k((size_t)1040 * 64 * 256 * 2);
constexpr size_t WS_S5END = WS_CAR + al64k((size_t)64 * 1280 * 256 * 2);
constexpr size_t WS_BTA = cmax2(WS_MIXEND, cmax2(WS_MOEEND, WS_S5END));
constexpr size_t WS_BTC = WS_BTA + al64k((size_t)64 * 512 * 256 * 2);
constexpr size_t WS_BTEND = WS_BTC + al64k((size_t)64 * 256 * 256 * 2);
constexpr size_t cmax(size_t a, size_t b) { return a > b ? a : b; }
constexpr size_t WS_TOTAL = WS_BTEND;
static_assert(WS_TOTAL <= 512 * MiB, "workspace map exceeds 512 MiB");

#define CW_CNT(l) (1024 + 64 * (l))

#define LDS_BYTES 163840
#define LDS_BARST (LDS_BYTES - 1024)
#define LDS_TAB (LDS_BYTES - 768)
#define LDS_RING (LDS_BYTES - 1024)
#define GRID 256

struct Params {
    const float* in[35];
    float* out;
    unsigned char* ws;
    int ph_lo, ph_hi;
};
typedef const __attribute__((address_space(4))) Params CParams;

__device__ __forceinline__ float bf2f(bf16_t v) { return __uint_as_float(((unsigned)v) << 16); }
typedef float f32x2c_ __attribute__((ext_vector_type(2)));
typedef __bf16 bf16x2c_ __attribute__((ext_vector_type(2)));
__device__ __forceinline__ unsigned pk2(float lo, float hi) { const f32x2c_ f = {lo, hi}; const bf16x2c_ b = __builtin_convertvector(f, bf16x2c_); return __builtin_bit_cast(unsigned, b); }
__device__ __forceinline__ unsigned f2bf(float f) { return (unsigned)__builtin_bit_cast(unsigned short, (__bf16)f); }
__device__ __forceinline__ float bflo(unsigned u) { return __uint_as_float(u << 16); }
__device__ __forceinline__ float bfhi(unsigned u) { return __uint_as_float(u & 0xffff0000u); }
template <int CTRL> __device__ __forceinline__ float dppf(float v) { return __int_as_float(__builtin_amdgcn_update_dpp(0, __float_as_int(v), CTRL, 0xF, 0xF, true)); }
__device__ __forceinline__ float row16_sum(float v) { v += dppf<0xB1>(v); v += dppf<0x4E>(v); v += dppf<0x141>(v); v += dppf<0x140>(v); return v; }
__device__ __forceinline__ float wave_sum(float v) {
    v = row16_sum(v);
    { const unsigned xu = __float_as_uint(v); const auto sw = __builtin_amdgcn_permlane16_swap(xu, xu, false, false); v = __uint_as_float(sw[0]) + __uint_as_float(sw[1]); }
    { const unsigned xu = __float_as_uint(v); const auto sw = __builtin_amdgcn_permlane32_swap(xu, xu, false, false); v = __uint_as_float(sw[0]) + __uint_as_float(sw[1]); }
    return v;
}
__device__ __forceinline__ float wave_max(float v) {
    v = fmaxf(v, dppf<0xB1>(v)); v = fmaxf(v, dppf<0x4E>(v)); v = fmaxf(v, dppf<0x141>(v)); v = fmaxf(v, dppf<0x140>(v));
    { const unsigned xu = __float_as_uint(v); const auto sw = __builtin_amdgcn_permlane16_swap(xu, xu, false, false); v = fmaxf(__uint_as_float(sw[0]), __uint_as_float(sw[1])); }
    { const unsigned xu = __float_as_uint(v); const auto sw = __builtin_amdgcn_permlane32_swap(xu, xu, false, false); v = fmaxf(__uint_as_float(sw[0]), __uint_as_float(sw[1])); }
    return v;
}
__device__ __forceinline__ float sigmoidf_(float x) { return __builtin_amdgcn_rcpf(1.f + __expf(-x)); }
__device__ __forceinline__ int rowof(int b, int p) { return p < NMETA ? NMAIN + b * NMETA + p : b * SEQ + (p - NMETA); }

#define SA_STRIDE 40
template <class AF, class BF>
__device__ __forceinline__ void gemm_tile(unsigned char* lds, int K, int ldb, const AF& arow, const BF& bcol, f32x4 (&acc)[4][2]) {
    bf16_t* sA = (bf16_t*)lds;
    bf16_t* sB = (bf16_t*)(lds + 128 * SA_STRIDE * 2);
    const int tid = threadIdx.x, lane = tid & 63, wave = tid >> 6, wr = wave >> 2, wc = wave & 3, fr = lane & 15, fq = lane >> 4;
#pragma unroll
    for (int mi = 0; mi < 4; ++mi)
#pragma unroll
        for (int ni = 0; ni < 2; ++ni) acc[mi][ni] = (f32x4){0.f, 0.f, 0.f, 0.f};
    const int ar = tid >> 2, akc = (tid & 3) * 8;
    const bf16_t* ap = arow(ar) + akc;
    const int bnq = (tid & 31) * 4, bkp = (tid >> 5) * 2;
    const float* bp = bcol(bnq) + (size_t)bkp * ldb;
    const int nk = K / 32;
    u32x4 ra = *(const u32x4*)ap;
    f32x4 rb0 = *(const f32x4*)bp, rb1 = *(const f32x4*)(bp + ldb);
    for (int kt = 0; kt < nk; ++kt) {
        __syncthreads();
        *(u32x4*)(sA + ar * SA_STRIDE + akc) = ra;
        {
            unsigned* d = (unsigned*)(sB + bnq * SA_STRIDE + bkp);
            d[0 * (SA_STRIDE / 2)] = pk2(rb0[0], rb1[0]);
            d[1 * (SA_STRIDE / 2)] = pk2(rb0[1], rb1[1]);
            d[2 * (SA_STRIDE / 2)] = pk2(rb0[2], rb1[2]);
            d[3 * (SA_STRIDE / 2)] = pk2(rb0[3], rb1[3]);
        }
        __syncthreads();
        if (kt + 1 < nk) {
            ra = *(const u32x4*)(ap + (kt + 1) * 32);
            const float* q = bp + (size_t)(kt + 1) * 32 * ldb;
            rb0 = *(const f32x4*)q; rb1 = *(const f32x4*)(q + ldb);
        }
        bf16x8 a[4], b[2];
#pragma unroll
        for (int mi = 0; mi < 4; ++mi) a[mi] = *(const bf16x8*)(sA + (wr * 64 + mi * 16 + fr) * SA_STRIDE + fq * 8);
#pragma unroll
        for (int ni = 0; ni < 2; ++ni) b[ni] = *(const bf16x8*)(sB + (wc * 32 + ni * 16 + fr) * SA_STRIDE + fq * 8);
#pragma unroll
        for (int mi = 0; mi < 4; ++mi)
#pragma unroll
            for (int ni = 0; ni < 2; ++ni) acc[mi][ni] = __builtin_amdgcn_mfma_f32_16x16x32_bf16(a[mi], b[ni], acc[mi][ni], 0, 0, 0);
    }
    __syncthreads();
}
#define ACC_FOREACH(acc, ...) do { const int _l = threadIdx.x & 63, _w = threadIdx.x >> 6, _wr = _w >> 2, _wc = _w & 3, _fr = _l & 15, _fq = _l >> 4; \
    _Pragma("unroll") for (int _mi = 0; _mi < 4; ++_mi) _Pragma("unroll") for (int _ni = 0; _ni < 2; ++_ni) _Pragma("unroll") for (int _j = 0; _j < 4; ++_j) { \
        const int rl = _wr * 64 + _mi * 16 + _fq * 4 + _j, cl = _wc * 32 + _ni * 16 + _fr; const float val = acc[_mi][_ni][_j]; __VA_ARGS__ } } while (0)
#define ACC_FOREACH_PAIR(acc, ...) do { const int _l = threadIdx.x & 63, _w = threadIdx.x >> 6, _wr = _w >> 2, _wc = _w & 3, _fr = _l & 15, _fq = _l >> 4; \
    _Pragma("unroll") for (int _mi = 0; _mi < 4; ++_mi) _Pragma("unroll") for (int _j = 0; _j < 4; ++_j) { \
        const int rl = _wr * 64 + _mi * 16 + _fq * 4 + _j, co = _wc * 16 + _fr; const float va = acc[_mi][0][_j], vg = acc[_mi][1][_j]; __VA_ARGS__ } } while (0)

__device__ __forceinline__ void store_norm_bf16(const f32x4 (&v)[4], const float* gain, bf16_t* dst, int lane) {
    float ss = 0.f;
#pragma unroll
    for (int j = 0; j < 4; ++j) ss += v[j][0] * v[j][0] + v[j][1] * v[j][1] + v[j][2] * v[j][2] + v[j][3] * v[j][3];
    ss = wave_sum(ss);
    const float rstd = rsqrtf(ss * (1.f / DM) + 1e-6f);
#pragma unroll
    for (int j = 0; j < 4; ++j) {
        const f32x4 g = ((const f32x4*)gain)[lane + 64 * j];
        u32x2 o; o.x = pk2(v[j][0] * rstd * g[0], v[j][1] * rstd * g[1]); o.y = pk2(v[j][2] * rstd * g[2], v[j][3] * rstd * g[3]);
        ((u32x2*)dst)[lane + 64 * j] = o;
    }
}


__device__ __forceinline__ f32x4 ldrow_bf16(const bf16_t* row, int lane, int j) { const u32x2 u = ((const u32x2*)row)[lane + 64 * j]; return (f32x4){bflo(u.x), bfhi(u.x), bflo(u.y), bfhi(u.y)}; }
__device__ __forceinline__ void strow_bf16(bf16_t* row, int lane, int j, const f32x4 v) { u32x2 o; o.x = pk2(v[0], v[1]); o.y = pk2(v[2], v[3]); ((u32x2*)row)[lane + 64 * j] = o; }
namespace pg8 {
#define PG8_LAS __attribute__((address_space(3)))
constexpr int BM = 256, BK = 64, HALF = 128, HTB = HALF * BK * 2  , STAGE_BYTES = 8 * HTB, NXCD = 8, WGM = 8;
__host__ __device__ __forceinline__ int lds_byte(int r, int c) { const int st = (r >> 4) * 2 + (c >> 5), rr = r & 15, cc = c & 31, ob = rr * 64 + cc * 2; return st * 1024 + (ob ^ (((ob >> 9) & 1) << 5)); }
__host__ __device__ __forceinline__ void stage_rc(int b, int& R, int& C) { const int st = b / 1024, sb = b % 1024, swz = sb ^ (((sb >> 9) & 1) << 5); R = (st >> 1) * 16 + swz / 64; C = (st & 1) * 32 + (swz % 64) / 2; }
__host__ __device__ __forceinline__ int perm32(int rho) { const int n = rho >> 4, i = rho & 15; return 8 * (i >> 2) + 4 * n + (i & 3); }

struct Unit { int pm, pn; const char* A; const char* B; };

struct DenseOrder {
    static constexpr bool GATHER_ROWS = false;
    static constexpr bool GATHER_A = false;
    int nM, nN, nwg, G, c; const char* A; const char* Bt; size_t tstep;
    __device__ void init(const bf16_t* A_, const bf16_t* Bt_, int M, int N, int K, int G_, int c_) { nM = M / BM; nN = N / BM; nwg = nM * nN; G = G_; c = c_; A = (const char*)A_; Bt = (const char*)Bt_; tstep = (size_t)BM * K * 2; }
    __device__ bool next(int i, Unit& u) const {
        const long L = (long)i * G + c; if (L >= nwg) return false;
        int wgid = (int)L; { const int q = nwg / NXCD, r = nwg % NXCD, xcd = wgid % NXCD, off = wgid / NXCD; wgid = (xcd < r ? xcd * (q + 1) : r * (q + 1) + (xcd - r) * q) + off; }
        const int nig = WGM * nN, gid = wgid / nig, fm = gid * WGM, gsz = (nM - fm) < WGM ? (nM - fm) : WGM;
        u.pm = fm + ((wgid % nig) % gsz); u.pn = (wgid % nig) / gsz; u.A = A + (size_t)u.pm * tstep; u.B = Bt + (size_t)u.pn * tstep; return true;
    }
    __device__ __forceinline__ void a_ready(const Unit&) const {}
    __device__ __forceinline__ void done(const Unit&) const {}
};
struct ProjOrder {
    static constexpr bool GATHER_ROWS = false;
    static constexpr bool GATHER_A = false;
    DenseOrder D; const char* HNp; const char* WT;
    __device__ void init(const bf16_t* HN_, const bf16_t* WT_, int c_) { D.init(HN_, WT_, NTP, 13 * BM, DM, GRID, c_); HNp = (const char*)HN_; WT = (const char*)WT_; }
    __device__ bool next(int i, Unit& u) const {
        if (!D.next(i, u)) return false;
        const size_t ts = (size_t)BM * DM * 2;
        if (u.pn < 11) { const int wrow = u.pn < 4 ? u.pn : u.pn + 2; u.A = HNp + (size_t)u.pm * ts; u.B = WT + (size_t)wrow * ts; }
        else { u.A = WT + (size_t)(4 + (u.pn - 11)) * ts; u.B = HNp + (size_t)u.pm * ts; }
        return true;
    }
    __device__ __forceinline__ void a_ready(const Unit&) const {}
    __device__ __forceinline__ void done(const Unit&) const {}
};
template <bool GATHER> struct MoeOrder {
    static constexpr bool GATHER_ROWS = GATHER;
    static constexpr bool GATHER_A = false;
    const int* et; int TT, vcu; const char* A; const char* Bt; unsigned tstepA, tstepB, estep; const int* rowidx;
    __device__ __forceinline__ bool next(int i, Unit& u) const {
        const int L = i * GRID + vcu; if (L >= TT * 4) return false;
        const int rt = L >> 2, ct = L & 3, e = et[rt];
        u.pm = rt; u.pn = ct; u.A = GATHER ? A : A + (size_t)rt * tstepA; u.B = Bt + (size_t)e * estep + (size_t)ct * tstepB; return true;
    }
    __device__ __forceinline__ void a_ready(const Unit&) const {}
    __device__ __forceinline__ void done(const Unit&) const {}
};

struct S5OrderA {
    static constexpr bool GATHER_ROWS = false;
    static constexpr bool GATHER_A = true;
    int vcu; const char* U; const char* BTA;
    __device__ __forceinline__ bool next(int i, Unit& u) const {
        const int L = i * GRID + vcu; if (L >= 640) return false;
        const int g = L / 10, rem = L - g * 10, mt = rem >> 1, nt = rem & 1;
        u.pm = mt; u.pn = g * 2 + nt; u.A = U + ((size_t)mt * 256 * 16 * 1024 + g * 16) * 2; u.B = BTA + ((size_t)(g * 512 + nt * 256) * 256) * 2; return true;
    }
    __device__ __forceinline__ void a_ready(const Unit&) const {}
    __device__ __forceinline__ void done(const Unit&) const {}
};
struct S5OrderC {
    static constexpr bool GATHER_ROWS = false;
    static constexpr bool GATHER_A = false;
    int vcu; const char* CAR; const char* BTC;
    __device__ __forceinline__ bool next(int i, Unit& u) const {
        const int L = i * GRID + vcu; if (L >= 320) return false;
        const int g = L / 5, mt = L - g * 5;
        u.pm = mt; u.pn = g; u.A = CAR + ((size_t)(g * 1280 + mt * 256) * 256) * 2; u.B = BTC + ((size_t)g * 256 * 256) * 2; return true;
    }
    __device__ __forceinline__ void a_ready(const Unit&) const {}
    __device__ __forceinline__ void done(const Unit&) const {}
};
__device__ __forceinline__ unsigned cvt_pk_bf16(float lo, float hi) { return pk2(lo, hi); }

struct EpiProj {
    static constexpr bool PERM = true, AFTER_DRAIN = false;
    bf16_t *Q, *Kk, *VT, *REST;
    __device__ __forceinline__ void operator()(const f32x4 (&acc)[2][2][4][2], const Unit& u, int wr, int wc, int fr, int fq) const {
        bf16_t* base; int ldc; int row0, col0;
        if (u.pn < 11) { row0 = u.pm * BM + wr * 64 + fr; int colt;
            if (u.pn < 2) { base = Q; colt = u.pn * BM; ldc = 512; } else if (u.pn < 4) { base = Kk; colt = (u.pn - 2) * BM; ldc = 512; } else { base = REST; colt = (u.pn - 4) * BM; ldc = RESTC; }
            col0 = colt + wc * 32 + 8 * fq; }
        else { base = VT; ldc = NTP; row0 = (u.pn - 11) * BM + wr * 64 + fr; col0 = u.pm * BM + wc * 32 + 8 * fq; }
#pragma unroll
        for (int ai = 0; ai < 2; ++ai)
#pragma unroll
            for (int m = 0; m < 4; ++m) { bf16_t* rowp = base + (size_t)(row0 + ai * HALF + m * 16) * ldc + col0;
#pragma unroll
                for (int bj = 0; bj < 2; ++bj) { const f32x4 v0 = acc[ai][bj][m][0], v1 = acc[ai][bj][m][1];
                    u32x4 w; w.x = cvt_pk_bf16(v0[0], v0[1]); w.y = cvt_pk_bf16(v0[2], v0[3]); w.z = cvt_pk_bf16(v1[0], v1[1]); w.w = cvt_pk_bf16(v1[2], v1[3]);
                    *(u32x4*)(rowp + bj * HALF) = w; } }
    }
};
struct EpiBf16Plain {
    static constexpr bool PERM = true, AFTER_DRAIN = false;
    bf16_t* O; int ldc;
    __device__ __forceinline__ void operator()(const f32x4 (&acc)[2][2][4][2], const Unit& u, int wr, int wc, int fr, int fq) const {
        const int row0 = u.pm * BM + wr * 64 + fr; const int col0 = u.pn * BM + wc * 32 + 8 * fq;
#pragma unroll
        for (int ai = 0; ai < 2; ++ai)
#pragma unroll
            for (int m = 0; m < 4; ++m) { bf16_t* rowp = O + (size_t)(row0 + ai * HALF + m * 16) * ldc + col0;
#pragma unroll
                for (int bj = 0; bj < 2; ++bj) { const f32x4 v0 = acc[ai][bj][m][0], v1 = acc[ai][bj][m][1];
                    u32x4 w; w.x = cvt_pk_bf16(v0[0], v0[1]); w.y = cvt_pk_bf16(v0[2], v0[3]); w.z = cvt_pk_bf16(v1[0], v1[1]); w.w = cvt_pk_bf16(v1[2], v1[3]);
                    *(u32x4*)(rowp + bj * HALF) = w; } }
    }
};
struct EpiSwiglu {
    static constexpr bool PERM = true, AFTER_DRAIN = false;
    bf16_t* O;
    __device__ __forceinline__ void operator()(const f32x4 (&acc)[2][2][4][2], const Unit& u, int wr, int wc, int fr, int fq) const {
        const int row0 = u.pm * BM + wr * 64 + fr; const int col0 = u.pn * HALF + wc * 32 + 8 * fq;
#pragma unroll
        for (int ai = 0; ai < 2; ++ai)
#pragma unroll
            for (int m = 0; m < 4; ++m) {
                float o[8];
#pragma unroll
                for (int n = 0; n < 2; ++n)
#pragma unroll
                    for (int i = 0; i < 4; ++i) { const float va = acc[ai][0][m][n][i], vg = acc[ai][1][m][n][i]; o[4 * n + i] = va * __builtin_amdgcn_rcpf(1.f + __expf(-va)) * vg; }
                u32x4 w; w.x = cvt_pk_bf16(o[0], o[1]); w.y = cvt_pk_bf16(o[2], o[3]); w.z = cvt_pk_bf16(o[4], o[5]); w.w = cvt_pk_bf16(o[6], o[7]);
                *(u32x4*)(O + (size_t)(row0 + ai * HALF + m * 16) * DFF + col0) = w; }
    }
};
struct EpiResidual {
    static constexpr bool PERM = true, AFTER_DRAIN = false;
    bf16_t* Hh;
    __device__ __forceinline__ void operator()(const f32x4 (&acc)[2][2][4][2], const Unit& u, int wr, int wc, int fr, int fq) const {
        const int row0 = u.pm * BM + wr * 64 + fr; const int col0 = u.pn * BM + wc * 32 + 8 * fq;
#pragma unroll
        for (int ai = 0; ai < 2; ++ai)
#pragma unroll
            for (int m = 0; m < 4; ++m) { bf16_t* rowp = Hh + (size_t)(row0 + ai * HALF + m * 16) * DM + col0;
#pragma unroll
                for (int bj = 0; bj < 2; ++bj) { u32x4* p = (u32x4*)(rowp + bj * HALF); const u32x4 hv = *p; const f32x4 v0 = acc[ai][bj][m][0], v1 = acc[ai][bj][m][1];
                    u32x4 w; w.x = cvt_pk_bf16(__uint_as_float(hv.x << 16) + v0[0], __uint_as_float(hv.x & 0xffff0000u) + v0[1]); w.y = cvt_pk_bf16(__uint_as_float(hv.y << 16) + v0[2], __uint_as_float(hv.y & 0xffff0000u) + v0[3]);
                    w.z = cvt_pk_bf16(__uint_as_float(hv.z << 16) + v1[0], __uint_as_float(hv.z & 0xffff0000u) + v1[1]); w.w = cvt_pk_bf16(__uint_as_float(hv.w << 16) + v1[2], __uint_as_float(hv.w & 0xffff0000u) + v1[3]);
                    *p = w; } }
    }
};
struct EpiGlu {
    static constexpr bool PERM = true, AFTER_DRAIN = false;
    bf16_t* Hh;
    __device__ __forceinline__ void operator()(const f32x4 (&acc)[2][2][4][2], const Unit& u, int wr, int wc, int fr, int fq) const {
        const int row0 = u.pm * BM + wr * 64 + fr; const int col0 = u.pn * HALF + wc * 32 + 8 * fq;
#pragma unroll
        for (int ai = 0; ai < 2; ++ai)
#pragma unroll
            for (int m = 0; m < 4; ++m) { u32x4* p = (u32x4*)(Hh + (size_t)(row0 + ai * HALF + m * 16) * DM + col0); const u32x4 hv = *p;
                float o[8];
#pragma unroll
                for (int n = 0; n < 2; ++n)
#pragma unroll
                    for (int i = 0; i < 4; ++i) { const unsigned hw = hv[2 * n + (i >> 1)]; const float hcur = (i & 1) ? __uint_as_float(hw & 0xffff0000u) : __uint_as_float(hw << 16);
                        o[4 * n + i] = hcur + acc[ai][0][m][n][i] * __builtin_amdgcn_rcpf(1.f + __expf(-acc[ai][1][m][n][i])); }
                u32x4 w; w.x = cvt_pk_bf16(o[0], o[1]); w.y = cvt_pk_bf16(o[2], o[3]); w.z = cvt_pk_bf16(o[4], o[5]); w.w = cvt_pk_bf16(o[6], o[7]);
                *p = w; }
    }
};
struct EpiS5A {
    static constexpr bool PERM = true, AFTER_DRAIN = false;
    bf16_t* YI; bf16_t* E;
    __device__ __forceinline__ void operator()(const f32x4 (&acc)[2][2][4][2], const Unit& u, int wr, int wc, int fr, int fq) const {
        const int g = u.pn >> 1, nt = u.pn & 1;
        const int cl0 = wc * 32 + 8 * fq;
        bf16_t* base = nt == 0 ? YI + (size_t)(cl0 >> 4) * DM + g * 16 + (cl0 & 15) : E + (size_t)g * 256 + cl0;
        const size_t nstride = 16 * DM;
        const size_t bjstep = nt == 0 ? (size_t)8 * DM : (size_t)HALF;
#pragma unroll
        for (int ai = 0; ai < 2; ++ai)
#pragma unroll
            for (int m = 0; m < 4; ++m) { int n = u.pm * BM + ai * HALF + wr * 64 + m * 16 + fr; n = n < 1039 ? n : 1039;
                bf16_t* p = base + (size_t)n * nstride;
#pragma unroll
                for (int bj = 0; bj < 2; ++bj) { const f32x4 v0 = acc[ai][bj][m][0], v1 = acc[ai][bj][m][1];
                    u32x4 w; w.x = cvt_pk_bf16(v0[0], v0[1]); w.y = cvt_pk_bf16(v0[2], v0[3]); w.z = cvt_pk_bf16(v1[0], v1[1]); w.w = cvt_pk_bf16(v1[2], v1[3]);
                    *(u32x4*)(p + bj * bjstep) = w; } }
    }
};
struct EpiS5C {
    static constexpr bool PERM = true, AFTER_DRAIN = false;
    const bf16_t* YI; const bf16_t* Uu; const float* dvec; bf16_t* O;
    __device__ __forceinline__ void operator()(const f32x4 (&acc)[2][2][4][2], const Unit& u, int wr, int wc, int fr, int fq) const {
        const int g = u.pn;
        const int cl0 = wc * 32 + 8 * fq, ch = g * 16 + (cl0 & 15);
        const size_t off0 = (size_t)(cl0 >> 4) * DM + ch;
        const f32x4 d0 = *(const f32x4*)(dvec + ch), d1 = *(const f32x4*)(dvec + ch + 4);
#pragma unroll
        for (int ai = 0; ai < 2; ++ai)
#pragma unroll
            for (int m = 0; m < 4; ++m) { int n = u.pm * BM + ai * HALF + wr * 64 + m * 16 + fr; n = n < 1039 ? n : 1039;
#pragma unroll
                for (int bj = 0; bj < 2; ++bj) {
                    const size_t off = off0 + (size_t)n * (16 * DM) + (size_t)bj * (8 * DM);
                    const u32x4 yv = *(const u32x4*)(YI + off);
                    const f32x4 y0 = (f32x4){__uint_as_float(yv[0] << 16), __uint_as_float(yv[0] & 0xffff0000u), __uint_as_float(yv[1] << 16), __uint_as_float(yv[1] & 0xffff0000u)},
                                y1 = (f32x4){__uint_as_float(yv[2] << 16), __uint_as_float(yv[2] & 0xffff0000u), __uint_as_float(yv[3] << 16), __uint_as_float(yv[3] & 0xffff0000u)};
                    const u32x4 uv = *(const u32x4*)(Uu + off);
                    float y[8];
#pragma unroll
                    for (int q = 0; q < 4; ++q) { y[q] = acc[ai][bj][m][0][q] + y0[q] + d0[q] * (q & 1 ? __uint_as_float(uv[q >> 1] & 0xffff0000u) : __uint_as_float(uv[q >> 1] << 16));
                        y[4 + q] = acc[ai][bj][m][1][q] + y1[q] + d1[q] * (q & 1 ? __uint_as_float(uv[2 + (q >> 1)] & 0xffff0000u) : __uint_as_float(uv[2 + (q >> 1)] << 16)); }
#pragma unroll
                    for (int q = 0; q < 8; ++q) { const float z = 1.5957691216f * (y[q] + 0.044715f * y[q] * y[q] * y[q]); y[q] = y[q] * __builtin_amdgcn_rcpf(1.f + __expf(-z)); }
                    u32x4 w; w.x = cvt_pk_bf16(y[0], y[1]); w.y = cvt_pk_bf16(y[2], y[3]); w.z = cvt_pk_bf16(y[4], y[5]); w.w = cvt_pk_bf16(y[6], y[7]);
                    *(u32x4*)(O + off) = w; }
                asm volatile("" ::: "memory"); }
    }
};

template <class Epi, class Sched, bool ALIGN_EPI = false, bool SP2 = false>
__device__ __forceinline__ void gemm_phase(PG8_LAS unsigned char* lds, const int K, const Sched& S, const Epi& E) {
    int tid_ = threadIdx.x; asm volatile("" : "+v"(tid_));
    const int tid = tid_, wid = __builtin_amdgcn_readfirstlane(tid >> 6), lane = tid & 63, wr = wid >> 2, wc = wid & 3, fr = lane & 15, fq = lane >> 4;
    const int nt = K / BK;
    unsigned vA0[2], vA1[2], nA0[2], nA1[2], voffB[2];
#pragma unroll
    for (int i = 0; i < 2; ++i) { int R, C; stage_rc(tid * 16 + i * 8192, R, C); const int Rb = Epi::PERM ? ((R & ~31) + perm32(R & 31)) : R;
        vA0[i] = Sched::GATHER_A ? (unsigned)(((16 * R + (C >> 4)) * 1024 + (C & 15)) * 2) : (unsigned)(R * K + C) * 2u; voffB[i] = (unsigned)(Rb * K + C) * 2u; }
    const size_t kstep = (size_t)(BK * 2);
    const size_t hstep = (size_t)HALF * K * 2;
    const size_t kstepA = Sched::GATHER_A ? (size_t)(4 * 1024 * 2) : kstep, hstepA = Sched::GATHER_A ? (size_t)HALF * 16 * 1024 * 2 : hstep;
#define PG8_ROWOFFS(u_, d0_, d1_) do { _Pragma("unroll") for (int i_ = 0; i_ < 2; ++i_) { int R_, C_; stage_rc(tid * 16 + i_ * 8192, R_, C_); \
        d0_[i_] = (unsigned)(S.rowidx[(u_).pm * BM + R_] * K + C_) * 2u; d1_[i_] = (unsigned)(S.rowidx[(u_).pm * BM + HALF + R_] * K + C_) * 2u; } } while (0)
#define PG8_STAGE_A(bufoff, gbase, h_, nx_) do { _Pragma("unroll") for (int _i = 0; _i < 2; ++_i) { const unsigned vo_ = (nx_) ? ((h_) ? nA1[_i] : nA0[_i]) : ((h_) ? vA1[_i] : vA0[_i]); \
        __builtin_amdgcn_global_load_lds((const unsigned*)((const char*)(gbase) + vo_), (PG8_LAS unsigned*)(lds + (bufoff) + ldsw + _i * 8192), 16, 0, 0); } } while (0)
    const unsigned ldsw = (unsigned)wid * 1024u;
    const int aoff = lds_byte(wr * 64 + fr, fq * 8), boff = lds_byte(wc * 32 + fr, fq * 8);
#define PG8_SA(b, h) (((b) * 2 + (h)) * HTB)
#define PG8_SB(b, h) ((4 + (b) * 2 + (h)) * HTB)
#define PG8_STAGE(bufoff, gbase, voff) do { _Pragma("unroll") for (int _i = 0; _i < 2; ++_i) \
        __builtin_amdgcn_global_load_lds((const unsigned*)((const char*)(gbase) + (voff)[_i]), (PG8_LAS unsigned*)(lds + (bufoff) + ldsw + _i * 8192), 16, 0, 0); } while (0)
#define PG8_LDA(dst, b, h) do { _Pragma("unroll") for (int m = 0; m < 4; ++m) _Pragma("unroll") for (int k = 0; k < 2; ++k) dst[m][k] = *(const PG8_LAS bf16x8*)(lds + PG8_SA(b, h) + aoff + m * 2048 + k * 1024); } while (0)
#define PG8_LDB(dst, b, h) do { _Pragma("unroll") for (int n = 0; n < 2; ++n) _Pragma("unroll") for (int k = 0; k < 2; ++k) dst[n][k] = *(const PG8_LAS bf16x8*)(lds + PG8_SB(b, h) + boff + n * 2048 + k * 1024); } while (0)
#define PG8_MMA(ai, bj, At, Bt) do { __builtin_amdgcn_s_setprio(1); _Pragma("unroll") for (int m = 0; m < 4; ++m) _Pragma("unroll") for (int n = 0; n < 2; ++n) _Pragma("unroll") for (int k = 0; k < 2; ++k) \
        acc[ai][bj][m][n] = __builtin_amdgcn_mfma_f32_16x16x32_bf16(Bt[n][k], At[m][k], acc[ai][bj][m][n], 0, 0, 0); __builtin_amdgcn_s_setprio(0); } while (0)
#define PG8_WAIT_V(n) asm volatile("s_waitcnt vmcnt(" #n ")" ::: "memory")
#define PG8_WAIT_L(n) asm volatile("s_waitcnt lgkmcnt(" #n ")" ::: "memory")
#define PG8_BAR __builtin_amdgcn_s_barrier()
#define PG8_SCHED __builtin_amdgcn_sched_barrier(0)
    Unit cur, nxt; int ui = 0;
    if (!S.next(0, cur)) return;
    f32x4 acc[2][2][4][2];
#pragma unroll
    for (int a = 0; a < 2; ++a)
#pragma unroll
        for (int b = 0; b < 2; ++b)
#pragma unroll
            for (int m = 0; m < 4; ++m)
#pragma unroll
                for (int n = 0; n < 2; ++n) acc[a][b][m][n] = (f32x4){0.f, 0.f, 0.f, 0.f};
    bf16x8 At[4][2], B0[2][2], B1[2][2];
    const char* cA = cur.A; const char* cB = cur.B;
    if constexpr (Sched::GATHER_ROWS) { PG8_ROWOFFS(cur, vA0, vA1); }
    else {
#pragma unroll
        for (int i = 0; i < 2; ++i) vA1[i] = vA0[i] + (unsigned)hstepA;
    }
#pragma unroll
    for (int i = 0; i < 2; ++i) { nA0[i] = vA0[i]; nA1[i] = vA1[i]; }
    S.a_ready(cur);
    if constexpr (SP2) {
        PG8_STAGE(PG8_SB(0, 0), cB, voffB); PG8_STAGE(PG8_SB(0, 1), cB + hstep, voffB); PG8_STAGE_A(PG8_SA(0, 0), cA, 0, false); PG8_STAGE_A(PG8_SA(0, 1), cA, 1, false);
        if (wr == 1) PG8_BAR;
        PG8_WAIT_V(2); PG8_BAR;
        PG8_STAGE(PG8_SB(1, 0), cB + kstep, voffB); PG8_STAGE_A(PG8_SA(1, 0), cA + kstepA, 0, false); PG8_STAGE(PG8_SB(1, 1), cB + hstep + kstep, voffB);
        PG8_WAIT_V(6); PG8_BAR;
    } else {
        PG8_STAGE(PG8_SB(0, 0), cB, voffB); PG8_STAGE_A(PG8_SA(0, 0), cA, 0, false); PG8_STAGE(PG8_SB(0, 1), cB + hstep, voffB); PG8_STAGE_A(PG8_SA(0, 1), cA, 1, false);
        if (wr == 1) PG8_BAR;
        PG8_WAIT_V(4); PG8_BAR;
        PG8_STAGE(PG8_SB(1, 0), cB + kstep, voffB); PG8_STAGE_A(PG8_SA(1, 0), cA + kstepA, 0, false); PG8_STAGE(PG8_SB(1, 1), cB + hstep + kstep, voffB);
        PG8_WAIT_V(6); PG8_BAR;
    }
    for (;;) {
        const bool has_next = S.next(ui + 1, nxt);
        if constexpr (Sched::GATHER_ROWS) { if (has_next) PG8_ROWOFFS(nxt, nA0, nA1); }
        const char* nA = has_next ? nxt.A : cA; const char* nB = has_next ? nxt.B : cB;
        for (int t = 0; t < nt; t += 2) {
            const bool last = (t == nt - 2);
            const char* a1 = cA + (size_t)(t + 1) * kstepA;
            const char* a2 = last ? nA : cA + (size_t)(t + 2) * kstepA; const char* b2 = last ? nB : cB + (size_t)(t + 2) * kstep;
            const char* a3 = a2 + kstepA; const char* b3 = b2 + kstep;
            if (last && has_next) S.a_ready(nxt);
            if constexpr (SP2) {
            PG8_LDB(B0, 0, 0); PG8_LDB(B1, 0, 1); PG8_SCHED; PG8_LDA(At, 0, 0); PG8_STAGE_A(PG8_SA(1, 1), a1, 1, false);
            PG8_WAIT_V(8); PG8_WAIT_L(0); PG8_BAR; PG8_MMA(0, 0, At, B0); PG8_MMA(0, 1, At, B1); PG8_BAR; PG8_SCHED;
            PG8_LDA(At, 0, 1); PG8_STAGE(PG8_SB(0, 0), b2, voffB); PG8_STAGE(PG8_SB(0, 1), b2 + hstep, voffB); PG8_STAGE_A(PG8_SA(0, 0), a2, 0, last);
            PG8_WAIT_V(8); PG8_WAIT_L(0); PG8_BAR; PG8_MMA(1, 0, At, B0); PG8_MMA(1, 1, At, B1); PG8_BAR; PG8_SCHED;
            PG8_LDB(B0, 1, 0); PG8_LDB(B1, 1, 1); PG8_SCHED; PG8_LDA(At, 1, 0); PG8_STAGE_A(PG8_SA(0, 1), a2, 1, last);
            PG8_WAIT_V(8); PG8_WAIT_L(0); PG8_BAR; PG8_MMA(0, 0, At, B0); PG8_MMA(0, 1, At, B1); PG8_BAR; PG8_SCHED;
            PG8_LDA(At, 1, 1); PG8_STAGE(PG8_SB(1, 0), b3, voffB); PG8_STAGE(PG8_SB(1, 1), b3 + hstep, voffB); PG8_STAGE_A(PG8_SA(1, 0), a3, 0, last);
            PG8_WAIT_V(8); PG8_WAIT_L(0); PG8_BAR; PG8_MMA(1, 0, At, B0); PG8_MMA(1, 1, At, B1); PG8_BAR; PG8_SCHED;
            } else {
            PG8_LDB(B0, 0, 0); PG8_SCHED; PG8_LDA(At, 0, 0); PG8_STAGE_A(PG8_SA(1, 1), a1, 1, false);
            PG8_WAIT_L(8); PG8_BAR; PG8_WAIT_L(0); PG8_MMA(0, 0, At, B0); PG8_BAR; PG8_SCHED;
            PG8_LDB(B1, 0, 1); PG8_STAGE(PG8_SB(0, 0), b2, voffB);
            PG8_BAR; PG8_WAIT_L(0); PG8_MMA(0, 1, At, B1); PG8_BAR;
            PG8_LDA(At, 0, 1); PG8_STAGE_A(PG8_SA(0, 0), a2, 0, last);
            PG8_BAR; PG8_WAIT_L(0); PG8_MMA(1, 0, At, B0); PG8_BAR; PG8_SCHED;
            PG8_STAGE(PG8_SB(0, 1), b2 + hstep, voffB);
            PG8_WAIT_V(6); PG8_BAR; PG8_MMA(1, 1, At, B1); PG8_BAR;
            PG8_LDB(B0, 1, 0); PG8_SCHED; PG8_LDA(At, 1, 0); PG8_STAGE_A(PG8_SA(0, 1), a2, 1, last);
            PG8_WAIT_L(8); PG8_BAR; PG8_WAIT_L(0); PG8_MMA(0, 0, At, B0); PG8_BAR; PG8_SCHED;
            PG8_LDB(B1, 1, 1); PG8_STAGE(PG8_SB(1, 0), b3, voffB);
            PG8_BAR; PG8_WAIT_L(0); PG8_MMA(0, 1, At, B1); PG8_BAR;
            PG8_LDA(At, 1, 1); PG8_STAGE_A(PG8_SA(1, 0), a3, 0, last);
            PG8_BAR; PG8_WAIT_L(0); PG8_MMA(1, 0, At, B0); PG8_BAR; PG8_SCHED;
            PG8_STAGE(PG8_SB(1, 1), b3 + hstep, voffB);
            PG8_WAIT_V(6); PG8_BAR; PG8_MMA(1, 1, At, B1); PG8_BAR;
            }
        }
        if constexpr (ALIGN_EPI) { if (wr == 0) PG8_BAR; }
        if constexpr (!Epi::AFTER_DRAIN) { E(acc, cur, wr, wc, fr, fq); S.done(cur); }
        if (!has_next) break;
#pragma unroll
        for (int a = 0; a < 2; ++a)
#pragma unroll
            for (int b = 0; b < 2; ++b)
#pragma unroll
                for (int m = 0; m < 4; ++m)
#pragma unroll
                    for (int n = 0; n < 2; ++n) acc[a][b][m][n] = (f32x4){0.f, 0.f, 0.f, 0.f};
        cur = nxt; cA = nA; cB = nB; ++ui;
        if constexpr (Sched::GATHER_ROWS) {
#pragma unroll
            for (int i = 0; i < 2; ++i) { vA0[i] = nA0[i]; vA1[i] = nA1[i]; } }
        if constexpr (ALIGN_EPI) { if (wr == 1) PG8_BAR; }
    }
    PG8_WAIT_V(0);
    if constexpr (!ALIGN_EPI) { if (wr == 0) PG8_BAR; }
    PG8_BAR;
    if constexpr (Epi::AFTER_DRAIN) { E.fused(acc, cur, wr, wc, fr, fq, lds, wid, lane); S.done(cur); }
#undef PG8_SA
#undef PG8_SB
#undef PG8_STAGE
#undef PG8_STAGE_A
#undef PG8_ROWOFFS
#undef PG8_LDA
#undef PG8_LDB
#undef PG8_MMA
#undef PG8_WAIT_V
#undef PG8_WAIT_L
#undef PG8_BAR
#undef PG8_SCHED
}
}

#define PHASE_PROLOGUE \
    int tid_ = threadIdx.x; asm volatile("" : "+v"(tid_)); const int tid = tid_, lane = tid & 63, wave = tid >> 6; \
    const int G = GRID, bid = blockIdx.x; \
    const int gw = bid * 8 + wave, NGW = G * 8; \
    unsigned char* ws = P.ws; \
    bf16_t* H = (bf16_t*)(ws + WS_H); \
    bf16_t* HN = (bf16_t*)(ws + WS_HN); \
    bf16_t* A2 = (bf16_t*)(ws + WS_A2); \
    bf16_t* Qb = (bf16_t*)(ws + WS_Q); bf16_t* Kb = (bf16_t*)(ws + WS_K); bf16_t* Vb = (bf16_t*)(ws + WS_V); \
    bf16_t* REST = (bf16_t*)(ws + WS_REST); \
    bf16_t* YFB = (bf16_t*)(ws + WS_YFB); \
    bf16_t* Rr = (bf16_t*)(ws + WS_R); bf16_t* VV = (bf16_t*)(ws + WS_VV); bf16_t* KK = (bf16_t*)(ws + WS_KK); \
    bf16_t* KKA = (bf16_t*)(ws + WS_KKA); bf16_t* KD = (bf16_t*)(ws + WS_KD); \
    _Float16* LW = (_Float16*)(ws + WS_W); bf16_t* PP = (bf16_t*)(ws + WS_PP); bf16_t* QT = (bf16_t*)(ws + WS_QT); bf16_t* YT = (bf16_t*)(ws + WS_YT); bf16_t* ZT = (bf16_t*)(ws + WS_ZT); \
    bf16_t* Gg = (bf16_t*)(ws + WS_G); bf16_t* KR = (bf16_t*)(ws + WS_KR); bf16_t* LOW = (bf16_t*)(ws + WS_LOW); \
    float* BC = (float*)(ws + WS_BC); \
    bf16_t* AA = (bf16_t*)(ws + WS_AA); \
    bf16_t* HB = (bf16_t*)(ws + WS_HB); bf16_t* YB = (bf16_t*)(ws + WS_YB); \
    int* ROWTOK = (int*)(ws + WS_ROWTOK); int* EID = (int*)(ws + WS_EID); int* POS = (int*)(ws + WS_POS); int* DEST = (int*)(ws + WS_DEST); \
    float* GATE = (float*)(ws + WS_GATE); \
    bf16_t* YI = (bf16_t*)(ws + WS_YI); bf16_t* S5E = (bf16_t*)(ws + WS_E); bf16_t* CAR = (bf16_t*)(ws + WS_CAR); bf16_t* BTA = (bf16_t*)(ws + WS_BTA); bf16_t* BTC = (bf16_t*)(ws + WS_BTC); \
    unsigned* CTL = (unsigned*)(ws + WS_CTL); \
    bf16_t* WTIN = (bf16_t*)(ws + WS_WTIN); bf16_t* WTOUT = (bf16_t*)(ws + WS_WTOUT); bf16_t* WTGLU = (bf16_t*)(ws + WS_WTGLU); bf16_t* WT13 = (bf16_t*)(ws + WS_WT13); bf16_t* WT2 = (bf16_t*)(ws + WS_WT2); \
    const int vcu = (G % 8 == 0) ? (bid % 8) * (G / 8) + bid / 8 : bid; \
    const float* x = P.in[0]; const float* meta = P.in[1]; const float* norm_mix = P.in[2]; const float* norm_ffn = P.in[3]; const float* norm_final = P.in[4]; \
    const float* w_in = P.in[5]; const float* w_out = P.in[6]; const float* rpb = P.in[7]; const float* mu = P.in[8]; \
    const float* w0 = P.in[9]; const float* w_up = P.in[10]; const float* a0 = P.in[11]; const float* a_up = P.in[12]; const float* g_up = P.in[13]; \
    const float* k_k = P.in[14]; const float* k_a = P.in[15]; const float* r_k = P.in[16]; const float* lnx_g = P.in[17]; const float* lnx_b = P.in[18]; \
    const float* s5_b_re = P.in[19]; const float* s5_b_im = P.in[20]; const float* s5_lre = P.in[21]; const float* s5_lim = P.in[22]; const float* s5_ls = P.in[23]; \
    const float* s5_c_re = P.in[24]; const float* s5_c_im = P.in[25]; const float* s5_d = P.in[26]; const float* w_glu = P.in[27]; \
    const float* moe_wg = P.in[28]; const float* moe_bg = P.in[29]; const float* moe_we = P.in[30]; const float* moe_be = P.in[31]; \
    const float* moe_w1 = P.in[32]; const float* moe_w3 = P.in[33]; const float* moe_w2 = P.in[34];


__device__ __forceinline__ void transpose_half(const float* W, int N, int K, int k0, int n0, bf16_t* dstrow0, int lane) {
    const int kb = lane & 7, nq = lane >> 3;
    const float* src = W + (size_t)(k0 + 8 * kb) * N + n0 + 4 * nq;
    f32x4 v[8];
#pragma unroll
    for (int kk = 0; kk < 8; ++kk) v[kk] = *(const f32x4*)(src + (size_t)kk * N);
#pragma unroll
    for (int i = 0; i < 4; ++i) {
        u32x4 o; o.x = pk2(v[0][i], v[1][i]); o.y = pk2(v[2][i], v[3][i]); o.z = pk2(v[4][i], v[5][i]); o.w = pk2(v[6][i], v[7][i]);
        *(u32x4*)(dstrow0 + (size_t)(4 * nq + i) * K + k0 + 8 * kb) = o;
    }
}
__device__ __forceinline__ void transpose_item(const float* W, int N, int K, int k0, int n0, bf16_t* dstrow0, int lane) {
    transpose_half(W, N, K, k0, n0, dstrow0, lane);
    transpose_half(W, N, K, k0, n0 + 32, dstrow0 + (size_t)32 * K, lane);
}
#define CONV_DENSE_ITEMS (832 + 256 + 512 + 48)
__device__ __forceinline__ void conv_dense_item(CParams& P, int it, int lane) {
    unsigned char* ws = P.ws;
    if (it < 832) { const int kb = it / 52, nb = it % 52; transpose_item(P.in[5], INCOLS, DM, kb * 64, nb * 64, (bf16_t*)(ws + WS_WTIN) + (size_t)nb * 64 * DM, lane); return; }
    it -= 832;
    if (it < 256) { const int kb = it / 16, nb = it % 16; transpose_item(P.in[6], DM, DM, kb * 64, nb * 64, (bf16_t*)(ws + WS_WTOUT) + (size_t)nb * 64 * DM, lane); return; }
    it -= 256;
    if (it < 512) { const int kb = it / 32, nb = it % 32, n = nb * 64, half = n >> 10, c = n & 1023, row = (c >> 7) * 256 + half * 128 + (c & 127);
      transpose_item(P.in[27], 2 * DM, DM, kb * 64, n, (bf16_t*)(ws + WS_WTGLU) + (size_t)row * DM, lane); return; }
    it -= 512;
    bf16_t* lrt = (bf16_t*)(ws + WS_LRT);
    if (it < 16) { const int d = it >> 3, nb = it & 7; transpose_item(P.in[10] + (size_t)d * 64 * 512, 512, 64, 0, nb * 64, lrt + ((size_t)d * 512 + nb * 64) * 64, lane); return; }
    it -= 16;
    if (it < 16) { const int d = it >> 3, nb = it & 7; transpose_item(P.in[12] + (size_t)d * 64 * 512, 512, 64, 0, nb * 64, lrt + (size_t)2 * 512 * 64 + ((size_t)d * 512 + nb * 64) * 64, lane); return; }
    it -= 16;
    { const int kb = it >> 3, nb = it & 7; transpose_item(P.in[13], 512, 128, kb * 64, nb * 64, lrt + (size_t)4 * 512 * 64 + (size_t)nb * 64 * 128, lane); }
}
#define CONV_MOE_ITEMS (NEXP * 384)
__device__ __forceinline__ void conv_moe_item(CParams& P, int l, int it, int lane) {
    unsigned char* ws = P.ws;
    const int e = it / 384; int r = it % 384;
    if (r < 256) { const int which = r >> 7; r &= 127; const int kb = r >> 3, nb = r & 7, n = nb * 64, row = (n >> 7) * 256 + which * 128 + (n & 127);
        const float* W = (which ? P.in[33] : P.in[32]) + ((size_t)(l * NEXP + e) * DM) * DFF;
        transpose_item(W, DFF, DM, kb * 64, n, (bf16_t*)(ws + WS_WT13) + ((size_t)e * DM + row) * DM, lane); return; }
    r -= 256;
    { const int kb = r >> 4, nb = r & 15; const float* W = P.in[34] + ((size_t)(l * NEXP + e) * DFF) * DM;
      transpose_item(W, DM, DFF, kb * 64, nb * 64, (bf16_t*)(ws + WS_WT2) + ((size_t)e * DM + nb * 64) * DFF, lane); }
}

template <int MODE>
__device__ __forceinline__ void meta_gemm(const bf16_t* A, const bf16_t* Bt, bf16_t* Hrows, int task, int lane) {
    const int fr = lane & 15, fq = lane >> 4, c = task * 16 + fr;
    const bf16_t* b0 = MODE == 0 ? Bt + (size_t)c * DM : Bt + (size_t)((c >> 7) * 256 + (c & 127)) * DM;
    const bf16_t* b1 = b0 + (size_t)128 * DM;
    f32x4 acc0[2], acc1[2];
    acc0[0] = acc0[1] = acc1[0] = acc1[1] = (f32x4){0.f, 0.f, 0.f, 0.f};
#pragma unroll 4
    for (int kt = 0; kt < 32; ++kt) {
        const int ko = kt * 32 + fq * 8;
        const bf16x8 a0 = *(const bf16x8*)(A + (size_t)fr * DM + ko), a1 = *(const bf16x8*)(A + (size_t)(16 + fr) * DM + ko);
        const bf16x8 bv = *(const bf16x8*)(b0 + ko);
        acc0[0] = __builtin_amdgcn_mfma_f32_16x16x32_bf16(a0, bv, acc0[0], 0, 0, 0);
        acc0[1] = __builtin_amdgcn_mfma_f32_16x16x32_bf16(a1, bv, acc0[1], 0, 0, 0);
        if (MODE == 1) { const bf16x8 bg = *(const bf16x8*)(b1 + ko);
            acc1[0] = __builtin_amdgcn_mfma_f32_16x16x32_bf16(a0, bg, acc1[0], 0, 0, 0);
            acc1[1] = __builtin_amdgcn_mfma_f32_16x16x32_bf16(a1, bg, acc1[1], 0, 0, 0); }
    }
#pragma unroll
    for (int mi = 0; mi < 2; ++mi)
#pragma unroll
        for (int j = 0; j < 4; ++j) { bf16_t* p = Hrows + (size_t)(mi * 16 + fq * 4 + j) * DM + c;
            const float add = MODE == 0 ? acc0[mi][j] : acc0[mi][j] * __builtin_amdgcn_rcpf(1.f + __expf(-acc1[mi][j]));
            *p = (bf16_t)f2bf(bf2f(*p) + add); }
}
__device__ __forceinline__ void phase_0(CParams& P, unsigned char* lds, const int ph) {
    PHASE_PROLOGUE
            for (int row = gw; row < NT; row += NGW) {
                const float* src = row < NMAIN ? x + (size_t)row * DM : meta + (size_t)((row - NMAIN) & 15) * DM;
                f32x4 v[4];
#pragma unroll
                for (int j = 0; j < 4; ++j) { v[j] = ((const f32x4*)src)[lane + 64 * j]; strow_bf16(H + (size_t)row * DM, lane, j, v[j]); }
                store_norm_bf16(v, norm_mix, HN + (size_t)row * DM, lane);
            }
    for (int it = gw; it < CONV_DENSE_ITEMS; it += NGW) conv_dense_item(P, it, lane);
}

__device__ __forceinline__ void phase_1(CParams& P, unsigned char* lds, const int ph) {
    PHASE_PROLOGUE
    pg8::ProjOrder S; S.init(HN, WTIN, bid);
    pg8::EpiProj E{Qb, Kb, Vb, REST};
    pg8::gemm_phase<pg8::EpiProj, pg8::ProjOrder, true, true>((PG8_LAS unsigned char*)lds, DM, S, E);
}

__device__ __forceinline__ void na_units(CParams& P, unsigned char* lds, const int first, const int stride) {
    PHASE_PROLOGUE
    constexpr int KST = 68, VST = 596, NKEY = 592;
    bf16_t* Ks = (bf16_t*)lds;
    bf16_t* VTs = Ks + NKEY * KST;
    float* sb = (float*)(VTs + 64 * VST);
    const bf16_t* VT = Vb;
    const int fr = lane & 15, fq = lane >> 4;
    const f32x4 zero4 = (f32x4){0.f, 0.f, 0.f, 0.f};
    u32x4 kreg[9], vreg[9];
#define NA_BAR() do { asm volatile("s_waitcnt lgkmcnt(0)" ::: "memory"); __builtin_amdgcn_s_barrier(); asm volatile("" ::: "memory"); } while (0)
#define NA_LOAD(u_) do { if ((u_) < 1024) { const int r2_ = ((u_) & 63) * 2, h_ = ((u_) >> 6) & 7, b_ = (u_) >> 9, Rb_ = min(max(r2_ - 4, 0), 120); \
        _Pragma("unroll") for (int q = 0; q < 9; ++q) { const int i = tid + 512 * q, key = i >> 3, pc = (i & 7) * 8; const int kr = min(Rb_ + (key >> 6), 127); \
            kreg[q] = *(const u32x4*)(Kb + ((size_t)b_ * SEQ + kr * 64 + (key & 63)) * 512 + h_ * 64 + pc); } \
        _Pragma("unroll") for (int q = 0; q < 9; ++q) { const int i = tid + 512 * q, dd = i / 72, rem = i - dd * 72, kr9 = rem >> 3, pc = (rem & 7) * 8; const int kr = min(Rb_ + kr9, 127); \
            vreg[q] = *(const u32x4*)(VT + (size_t)(h_ * 64 + dd) * NTP + (size_t)b_ * SEQ + kr * 64 + pc); } } } while (0)
    if (first < 1024 + 16) NA_LOAD(first);
    for (int u = first; u < 1024 + 16; u += stride) {
        const bool metau = u >= 1024;
        int b, h, r2 = 0;
        if (!metau) { r2 = (u & 63) * 2; h = (u >> 6) & 7; b = u >> 9; } else { const int m = u - 1024; b = m >> 3; h = m & 7; }
        const int Rb = min(max(r2 - 4, 0), 120);
        if (!metau) {
            if (tid < 465) sb[tid] = rpb[h * 465 + tid];
#pragma unroll
            for (int q = 0; q < 9; ++q) { const int i = tid + 512 * q, key = i >> 3, pc = (i & 7) * 8; *(u32x4*)(Ks + key * KST + pc) = kreg[q]; }
#pragma unroll
            for (int q = 0; q < 9; ++q) { const int i = tid + 512 * q, dd = i / 72, rem = i - dd * 72, kr9 = rem >> 3, pc = (rem & 7) * 8; *(u32x4*)(VTs + dd * VST + kr9 * 64 + pc) = vreg[q]; }
        }
        for (int i = tid; i < 16 * 8; i += 512) { const int key = i >> 3, pc = (i & 7) * 8;
            *(u32x4*)(Ks + (576 + key) * KST + pc) = *(const u32x4*)(Kb + ((size_t)NMAIN + b * NMETA + key) * 512 + h * 64 + pc); }
        for (int i = tid; i < 64 * 2; i += 512) { const int dd = i >> 1, pc = (i & 1) * 8;
            *(u32x4*)(VTs + dd * VST + 576 + pc) = *(const u32x4*)(VT + (size_t)(h * 64 + dd) * NTP + NMAIN + b * NMETA + pc); }
        if (u + stride < 1024 + 16) NA_LOAD(u + stride);
        NA_BAR();
        if (!metau || wave == 0) {
            const int rr = wave >> 2, qb = wave & 3, r = r2 + rr;
            const int c = qb * 16 + fr;
            const int qrow = metau ? NMAIN + b * NMETA + fr : b * SEQ + r * 64 + c;
            const int R0 = min(max(r - 4, 0), 120), cs = qb == 0 ? 0 : (qb == 1 ? 8 : (qb == 2 ? 24 : 32));
            const int C0 = min(max(c - 8, 0), 48);
            const int ro = R0 - Rb;
            const bf16x8 qf0 = *(const bf16x8*)(Qb + (size_t)qrow * 512 + h * 64 + fq * 8), qf1 = *(const bf16x8*)(Qb + (size_t)qrow * 512 + h * 64 + 32 + fq * 8);
            f32x4 sacc[17];
            if (!metau) {
#pragma unroll
                for (int kt = 0; kt < 16; ++kt) {
                    const bf16_t* kp = Ks + ((ro + (kt >> 1)) * 64 + cs + 16 * (kt & 1) + fr) * KST + fq * 8;
                    f32x4 acc = __builtin_amdgcn_mfma_f32_16x16x32_bf16(*(const bf16x8*)kp, qf0, zero4, 0, 0, 0);
                    sacc[kt] = __builtin_amdgcn_mfma_f32_16x16x32_bf16(*(const bf16x8*)(kp + 32), qf1, acc, 0, 0, 0);
                }
            } else {
#pragma unroll
                for (int kt = 0; kt < 16; ++kt) sacc[kt] = zero4;
            }
            {
                const bf16_t* kp = Ks + (576 + fr) * KST + fq * 8;
                f32x4 acc = __builtin_amdgcn_mfma_f32_16x16x32_bf16(*(const bf16x8*)kp, qf0, zero4, 0, 0, 0);
                sacc[16] = __builtin_amdgcn_mfma_f32_16x16x32_bf16(*(const bf16x8*)(kp + 32), qf1, acc, 0, 0, 0);
            }
            float mx = -1e30f;
#pragma unroll
            for (int kt = 0; kt < 16; ++kt) {
                const int dr = R0 + (kt >> 1) - r + 7;
#pragma unroll
                for (int j = 0; j < 4; ++j) {
                    const int kc = cs + 16 * (kt & 1) + 4 * fq + j;
                    const bool inb = !metau && kc >= C0 && kc < C0 + 16;
                    const int dc = min(max(kc - c + 15, 0), 30);
                    const float bias = sb[dr * 31 + dc];
                    const float sv = sacc[kt][j] * 0.125f + bias;
                    const float s = inb ? sv : -1e30f;
                    sacc[kt][j] = s; mx = fmaxf(mx, s);
                }
            }
#pragma unroll
            for (int j = 0; j < 4; ++j) { const float s = sacc[16][j] * 0.125f; sacc[16][j] = s; mx = fmaxf(mx, s); }
            mx = fmaxf(mx, __shfl_xor(mx, 16)); mx = fmaxf(mx, __shfl_xor(mx, 32));
            float sum = 0.f;
#pragma unroll
            for (int kt = 0; kt < 17; ++kt)
#pragma unroll
                for (int j = 0; j < 4; ++j) { const float pv = __expf(sacc[kt][j] - mx); sacc[kt][j] = pv; sum += pv; }
            sum += __shfl_xor(sum, 16); sum += __shfl_xor(sum, 32);
            f32x4 o[4] = {zero4, zero4, zero4, zero4};
            if (!metau) {
#pragma unroll
                for (int kr = 0; kr < 8; ++kr) {
                    union { bf16x8 v; unsigned u[4]; } bf;
                    bf.u[0] = pk2(sacc[2 * kr][0], sacc[2 * kr][1]); bf.u[1] = pk2(sacc[2 * kr][2], sacc[2 * kr][3]);
                    bf.u[2] = pk2(sacc[2 * kr + 1][0], sacc[2 * kr + 1][1]); bf.u[3] = pk2(sacc[2 * kr + 1][2], sacc[2 * kr + 1][3]);
                    const int tok0 = (ro + kr) * 64 + cs + 4 * fq;
#pragma unroll
                    for (int dt = 0; dt < 4; ++dt) {
                        const bf16_t* vp = VTs + (dt * 16 + fr) * VST + tok0;
                        union { bf16x8 v; u32x2 h2[2]; } af;
                        af.h2[0] = *(const u32x2*)vp; af.h2[1] = *(const u32x2*)(vp + 16);
                        o[dt] = __builtin_amdgcn_mfma_f32_16x16x32_bf16(af.v, bf.v, o[dt], 0, 0, 0);
                    }
                }
            }
            {
                union { bf16x8 v; unsigned u[4]; } bf;
                bf.u[0] = pk2(sacc[16][0], sacc[16][1]); bf.u[1] = pk2(sacc[16][2], sacc[16][3]); bf.u[2] = 0u; bf.u[3] = 0u;
#pragma unroll
                for (int dt = 0; dt < 4; ++dt) {
                    const bf16_t* vp = VTs + (dt * 16 + fr) * VST + 576 + 4 * fq;
                    union { bf16x8 v; u32x2 h2[2]; } af;
                    af.h2[0] = *(const u32x2*)vp; af.h2[1] = (u32x2){0u, 0u};
                    o[dt] = __builtin_amdgcn_mfma_f32_16x16x32_bf16(af.v, bf.v, o[dt], 0, 0, 0);
                }
            }
            const float inv = 1.f / sum;
#pragma unroll
            for (int dt = 0; dt < 4; ++dt) {
                u32x2 ov; ov.x = pk2(o[dt][0] * inv, o[dt][1] * inv); ov.y = pk2(o[dt][2] * inv, o[dt][3] * inv);
                *(u32x2*)(A2 + (size_t)qrow * DM + h * 64 + dt * 16 + 4 * fq) = ov;
            }
        }
        NA_BAR();
    }
#undef NA_LOAD
#undef NA_BAR
}

__device__ __forceinline__ void phase_3(CParams& P, unsigned char* lds, const int ph) {
    PHASE_PROLOGUE
    constexpr int TR = 66, NTILE = (NT + TR - 1) / TR, AST = 264, SST = 136;
    bf16_t* As = (bf16_t*)lds;
    unsigned short* stg = (unsigned short*)(lds + 80 * AST * 2);
    const bf16_t* lrt = (const bf16_t*)(ws + WS_LRT);
    const int fr = lane & 15, fq = lane >> 4;
    for (int u = bid; u < NTILE; u += G) {
        const int r0 = u * TR, nrows = min(TR, NT - r0);
        for (int rl0 = wave; rl0 < nrows; rl0 += 24) {
            u32x2 vc[3][7], vp[3][7], vn[3][7]; bool okr[3], hp[3], hn[3]; int rows[3];
#pragma unroll
            for (int q = 0; q < 3; ++q) {
                const int rl = rl0 + 8 * q; okr[q] = rl < nrows;
                const int row = okr[q] ? r0 + rl : r0; rows[q] = row;
                int b, pp_;
                if (row < NMAIN) { b = row >> 13; pp_ = (row & (SEQ - 1)) + NMETA; } else { b = (row - NMAIN) >> 4; pp_ = (row - NMAIN) & 15; }
                hp[q] = pp_ > 0; hn[q] = pp_ + 1 < LSEQ;
                const int rowp = hp[q] ? rowof(b, pp_ - 1) : row, rown = hn[q] ? rowof(b, pp_ + 1) : row;
#pragma unroll
                for (int j = 0; j < 7; ++j) { const int c = 4 * lane + 256 * j;
                    vc[q][j] = *(const u32x2*)(REST + (size_t)row * RESTC + c); vp[q][j] = *(const u32x2*)(REST + (size_t)rowp * RESTC + c); vn[q][j] = *(const u32x2*)(REST + (size_t)rown * RESTC + c); }
            }
#pragma unroll
            for (int q = 0; q < 3; ++q) {
                if (okr[q]) {
                    const int row = rows[q], rl = rl0 + 8 * q;
#pragma unroll
                    for (int j = 0; j < 7; ++j) {
                        const int c = 4 * lane + 256 * j;
                        u32x2 a = vp[q][j], bq = vn[q][j]; const u32x2 cc = vc[q][j];
                        if (!hp[q]) { a.x = 0; a.y = 0; }
                        if (!hn[q]) { bq.x = 0; bq.y = 0; }
                        const f32x4 m4 = *(const f32x4*)(mu + c);
                        const float pc[4] = {bflo(cc.x), bfhi(cc.x), bflo(cc.y), bfhi(cc.y)};
                        const float pq[4] = {bflo(a.x), bfhi(a.x), bflo(a.y), bfhi(a.y)};
                        const float pn[4] = {bflo(bq.x), bfhi(bq.x), bflo(bq.y), bfhi(bq.y)};
                        float o[4];
#pragma unroll
                        for (int i = 0; i < 4; ++i) o[i] = pc[i] + m4[i] * (0.5f * (pq[i] + pn[i]) - pc[i]);
                        if (j == 6) {
                            if (lane < 16) { for (int i = 0; i < 4; ++i) o[i] = tanhf(o[i]); }
                            else if (lane >= 32) { for (int i = 0; i < 4; ++i) o[i] = sigmoidf_(o[i]); }
                        }
                        u32x2 ov; ov.x = pk2(o[0], o[1]); ov.y = pk2(o[2], o[3]);
                        if (j < 6) { bf16_t* dst = j < 2 ? Rr + (size_t)row * 512 + c : (j < 4 ? KR + (size_t)row * 512 + (c - 512) : VV + (size_t)row * 512 + (c - 1024)); *(u32x2*)dst = ov; }
                        else *(u32x2*)(As + rl * AST + (c - 1536)) = ov;
                    }
                }
            }
        }
        __syncthreads();
#define P4_LOADB(t_, bv_, bias_) do { const int wh_ = (t_) >> 2, ct_ = (t_) & 3, Kw_ = wh_ < 4 ? 64 : 128, col_ = ct_ * 128 + 16 * wave + fr; \
            const bf16_t* Wt_ = lrt + (wh_ < 4 ? (size_t)wh_ * 512 * 64 : (size_t)4 * 512 * 64) + (size_t)col_ * Kw_ + 8 * fq; \
            bv_[0] = *(const bf16x8*)Wt_; bv_[1] = *(const bf16x8*)(Wt_ + 32); if (wh_ == 4) { bv_[2] = *(const bf16x8*)(Wt_ + 64); bv_[3] = *(const bf16x8*)(Wt_ + 96); } \
            bias_ = wh_ < 2 ? w0[wh_ * 512 + col_] : (wh_ < 4 ? a0[(wh_ - 2) * 512 + col_] : 0.f); } while (0)
        bf16x8 bnx[4]; float biasn;
        P4_LOADB(0, bnx, biasn);
#ifndef PREP_REP2
#define PREP_REP2 1
#endif
#pragma unroll 1
        for (int t_ = 0; t_ < 20 * PREP_REP2; ++t_) { const int t = t_ % 20;
            const int which = t >> 2, ct = t & 3;
            const int koff = which < 2 ? 0 : (which < 4 ? 64 : 128);
            bf16x8 bcur[4]; bcur[0] = bnx[0]; bcur[1] = bnx[1]; bcur[2] = bnx[2]; bcur[3] = bnx[3];
            const float bias = biasn;
            if (t_ + 1 < 20 * PREP_REP2) P4_LOADB((t + 1) % 20, bnx, biasn);
            const f32x4 zero4 = (f32x4){0.f, 0.f, 0.f, 0.f};
            f32x4 acc[5] = {zero4, zero4, zero4, zero4, zero4};
#pragma unroll
            for (int ks = 0; ks < 4; ++ks) {
                if (ks < 2 || which == 4) {
#pragma unroll
                    for (int rt = 0; rt < 5; ++rt) acc[rt] = __builtin_amdgcn_mfma_f32_16x16x32_bf16(*(const bf16x8*)(As + (16 * rt + fr) * AST + koff + 32 * ks + 8 * fq), bcur[ks], acc[rt], 0, 0, 0);
                }
            }
            unsigned short* sg = stg + (t & 1) * 80 * SST + 16 * wave + fr;
#pragma unroll
            for (int rt = 0; rt < 5; ++rt)
#pragma unroll
                for (int j = 0; j < 4; ++j) { const float val = acc[rt][j] + bias; unsigned short o;
                    if (which < 2) { const _Float16 hv = (_Float16)(-0.6065306597f * sigmoidf_(val)); o = __builtin_bit_cast(unsigned short, hv); }
                    else if (which < 4) o = (unsigned short)f2bf(sigmoidf_(val));
                    else o = (unsigned short)f2bf(val);
                    sg[(16 * rt + 4 * fq + j) * SST] = o; }
            asm volatile("s_waitcnt lgkmcnt(0)" ::: "memory"); __builtin_amdgcn_s_barrier(); asm volatile("" ::: "memory");
            {
                unsigned short* dst = which < 2 ? (unsigned short*)LW + (size_t)which * NT * 512 : (which < 4 ? (unsigned short*)AA + (size_t)(which - 2) * NT * 512 : (unsigned short*)Gg);
                for (int i = tid; i < nrows * 8; i += 512) { const int r = i >> 3, pc = (i & 7) * 16; const unsigned short* sp = stg + (t & 1) * 80 * SST + r * SST + pc;
                    unsigned short* gp = dst + (size_t)(r0 + r) * 512 + ct * 128 + pc; *(u32x4*)gp = *(const u32x4*)sp; *(u32x4*)(gp + 8) = *(const u32x4*)(sp + 8); }
            }
        }
#undef P4_LOADB
        __syncthreads();
        for (int rl = wave; rl < nrows; rl += 8) {
            const int row = r0 + rl;

                const int c0 = lane * 8;
                const u32x4 krv = *(const u32x4*)(KR + (size_t)row * 512 + c0);
                const u32x4 rv = *(const u32x4*)(Rr + (size_t)row * 512 + c0);
                float kr[8], rr[8], kkv[8];
#pragma unroll
                for (int i = 0; i < 4; ++i) { kr[2 * i] = bflo(krv[i]); kr[2 * i + 1] = bfhi(krv[i]); rr[2 * i] = bflo(rv[i]); rr[2 * i + 1] = bfhi(rv[i]); }
                float ss = 0.f;
#pragma unroll
                for (int i = 0; i < 8; ++i) { kkv[i] = kr[i] * k_k[c0 + i]; ss += kkv[i] * kkv[i]; }
                ss += __shfl_xor(ss, 1); ss += __shfl_xor(ss, 2); ss += __shfl_xor(ss, 4);
                const float inv = 1.f / fmaxf(sqrtf(ss), 1e-12f);
#pragma unroll
                for (int i = 0; i < 8; ++i) kkv[i] *= inv;
                u32x4 o; o.x = pk2(kkv[0], kkv[1]); o.y = pk2(kkv[2], kkv[3]); o.z = pk2(kkv[4], kkv[5]); o.w = pk2(kkv[6], kkv[7]);
                *(u32x4*)(KK + (size_t)row * 512 + c0) = o;
                float bsum = 0.f;
#pragma unroll
                for (int d = 0; d < 2; ++d) {
                    const u32x4 av = *(const u32x4*)(AA + ((size_t)d * NT + row) * 512 + c0);
                    float a[8], kka[8], kd[8];
#pragma unroll
                    for (int i = 0; i < 4; ++i) { a[2 * i] = bflo(av[i]); a[2 * i + 1] = bfhi(av[i]); }
#pragma unroll
                    for (int i = 0; i < 8; ++i) { kka[i] = kkv[i] * a[i]; kd[i] = kr[i] * (1.f + (a[i] - 1.f) * k_a[c0 + i]); bsum += rr[i] * kd[i] * r_k[c0 + i]; }
                    u32x4 o1; o1.x = pk2(kka[0], kka[1]); o1.y = pk2(kka[2], kka[3]); o1.z = pk2(kka[4], kka[5]); o1.w = pk2(kka[6], kka[7]);
                    *(u32x4*)(KKA + ((size_t)d * NT + row) * 512 + c0) = o1;
                    u32x4 o2; o2.x = pk2(kd[0], kd[1]); o2.y = pk2(kd[2], kd[3]); o2.z = pk2(kd[4], kd[5]); o2.w = pk2(kd[6], kd[7]);
                    *(u32x4*)(KD + ((size_t)d * NT + row) * 512 + c0) = o2;
                }
                bsum += __shfl_xor(bsum, 1); bsum += __shfl_xor(bsum, 2); bsum += __shfl_xor(bsum, 4);
                if ((lane & 7) == 0) BC[(size_t)row * 8 + (lane >> 3)] = bsum;
                    }
        __syncthreads();
    }
}

#define RWS 72
__device__ __forceinline__ bf16x8 rw_frag(const bf16_t* M, int row, int kofs) { return *(const bf16x8*)(M + row * RWS + kofs); }
__device__ __forceinline__ f32x4 rw_tile(const bf16_t* Am, int ra, const bf16_t* Bm, int rb, int fr, int fq) {
    f32x4 acc = (f32x4){0.f, 0.f, 0.f, 0.f};
    acc = __builtin_amdgcn_mfma_f32_16x16x32_bf16(rw_frag(Am, ra + fr, 8 * fq), rw_frag(Bm, rb + fr, 8 * fq), acc, 0, 0, 0);
    acc = __builtin_amdgcn_mfma_f32_16x16x32_bf16(rw_frag(Am, ra + fr, 32 + 8 * fq), rw_frag(Bm, rb + fr, 32 + 8 * fq), acc, 0, 0, 0);
    return acc;
}
__device__ __forceinline__ void phase_6(CParams& P, unsigned char* lds, const int ph) {
    PHASE_PROLOGUE
    constexpr int GST = 68, RST = 132;
    float* Gs = (float*)lds;
    bf16_t* A_rm = (bf16_t*)(lds + 64 * GST * 4); bf16_t* R_rm = A_rm + 64 * RWS; bf16_t* B_rm = R_rm + 64 * RWS; bf16_t* K_rm = B_rm + 64 * RWS;
    bf16_t* B_tr = K_rm + 64 * RWS; bf16_t* K_tr = B_tr + 64 * RWS; bf16_t* V_tr = K_tr + 64 * RWS;
    bf16_t* MAK = V_tr + 64 * RWS; bf16_t* MRB = MAK + 64 * RWS; bf16_t* MRK = MRB + 64 * RWS;
    bf16_t* MABr = MRK + 64 * RWS;
    float* RHS = (float*)(MABr + 64 * RWS);
    float* BT = RHS + 64 * RST; float* OFF = BT + 512; float* GC = OFF + 512;
    bf16_t* X1_tr = A_rm; bf16_t* X2_tr = K_rm;
    for (int i = tid; i < 4 * 64 * RWS / 2; i += 512) ((unsigned*)MAK)[i] = 0u;
    __syncthreads();
    const int fr = lane & 15, fq = lane >> 4;
#define RW1_BAR() do { asm volatile("s_waitcnt lgkmcnt(0)" ::: "memory"); __builtin_amdgcn_s_barrier(); asm volatile("" ::: "memory"); } while (0)
    const int t0 = tid & 63, kp = (tid >> 6) * 8;
    u32x4 nlw, nkk, nka, nkd, nrv, nvv;
#define RW1_LOAD(u_) do { const int ch_ = (u_) / RW_NCH, c_ = (u_) - ch_ * RW_NCH, d_ = ch_ >> 4, b_ = (ch_ >> 3) & 1, h_ = ch_ & 7, s_ = c_ * 64 + t0; \
        const int p_ = d_ ? LSEQ - 1 - s_ : s_; const size_t o_ = (size_t)rowof(b_, s_ < LSEQ ? p_ : 0) * 512 + h_ * 64 + kp; \
        nlw = *(const u32x4*)(LW + (size_t)d_ * NT * 512 + o_); nkk = *(const u32x4*)(KK + o_); nka = *(const u32x4*)(KKA + (size_t)d_ * NT * 512 + o_); \
        nkd = *(const u32x4*)(KD + (size_t)d_ * NT * 512 + o_); nrv = *(const u32x4*)(Rr + o_); nvv = *(const u32x4*)(VV + o_); } while (0)
    if (bid < RW_UNITS) RW1_LOAD(bid);
    for (int u = bid; u < RW_UNITS; u += G) {
        const int chain = u / RW_NCH, c = u - chain * RW_NCH;
        float lw[8], kk[8], ka[8], kd[8], rr[8]; u32x4 vv;
        {
            const bool valid = c * 64 + t0 < LSEQ;
            vv = nvv;
#pragma unroll
            for (int i = 0; i < 4; ++i) {
                union { unsigned u; _Float16 hh[2]; } cv; cv.u = nlw[i];
                lw[2 * i] = valid ? (float)cv.hh[0] : 0.f; lw[2 * i + 1] = valid ? (float)cv.hh[1] : 0.f;
                kk[2 * i] = valid ? bflo(nkk[i]) : 0.f; kk[2 * i + 1] = valid ? bfhi(nkk[i]) : 0.f;
                ka[2 * i] = valid ? bflo(nka[i]) : 0.f; ka[2 * i + 1] = valid ? bfhi(nka[i]) : 0.f;
                kd[2 * i] = valid ? bflo(nkd[i]) : 0.f; kd[2 * i + 1] = valid ? bfhi(nkd[i]) : 0.f;
                rr[2 * i] = valid ? bflo(nrv[i]) : 0.f; rr[2 * i + 1] = valid ? bfhi(nrv[i]) : 0.f;
                if (!valid) vv[i] = 0u;
            }
        }
        if (u + G < RW_UNITS) RW1_LOAD(u + G);
        float gg_[8];
#pragma unroll
        for (int i = 0; i < 8; ++i) {
            float v = lw[i];
            v += __int_as_float(__builtin_amdgcn_update_dpp(0, __float_as_int(v), 0x111, 0xF, 0xF, false));
            v += __int_as_float(__builtin_amdgcn_update_dpp(0, __float_as_int(v), 0x112, 0xF, 0xF, false));
            v += __int_as_float(__builtin_amdgcn_update_dpp(0, __float_as_int(v), 0x114, 0xF, 0xF, false));
            v += __int_as_float(__builtin_amdgcn_update_dpp(0, __float_as_int(v), 0x118, 0xF, 0xF, false));
            v += __int_as_float(__builtin_amdgcn_update_dpp(0, __float_as_int(v), 0x142, 0xA, 0xF, false));
            v += __int_as_float(__builtin_amdgcn_update_dpp(0, __float_as_int(v), 0x143, 0xC, 0xF, false));
            gg_[i] = v;
        }
#ifndef RW1_REP0
#define RW1_REP0 1
#endif
        for (int rep0_ = 0; rep0_ < RW1_REP0; ++rep0_) {
        {
            float va[8], vr[8], vb[8], vk[8];
#pragma unroll
            for (int i = 0; i < 8; ++i) {
                const float g = gg_[i];
                const float eg = __expf(g), egm1 = __expf(g - lw[i]), einv = __expf(-g);
                va[i] = kk[i] * egm1; vr[i] = rr[i] * eg; vb[i] = ka[i] * einv; vk[i] = kd[i] * einv;
                if (t0 == 63) GC[kp + i] = eg;
            }
            *(f32x4*)(RHS + t0 * RST + kp) = (f32x4){va[0], va[1], va[2], va[3]}; *(f32x4*)(RHS + t0 * RST + kp + 4) = (f32x4){va[4], va[5], va[6], va[7]};
            u32x4 w4;
            w4.x = pk2(va[0], va[1]); w4.y = pk2(va[2], va[3]); w4.z = pk2(va[4], va[5]); w4.w = pk2(va[6], va[7]); *(u32x4*)(A_rm + t0 * RWS + kp) = w4;
            w4.x = pk2(vr[0], vr[1]); w4.y = pk2(vr[2], vr[3]); w4.z = pk2(vr[4], vr[5]); w4.w = pk2(vr[6], vr[7]); *(u32x4*)(R_rm + t0 * RWS + kp) = w4;
            w4.x = pk2(vb[0], vb[1]); w4.y = pk2(vb[2], vb[3]); w4.z = pk2(vb[4], vb[5]); w4.w = pk2(vb[6], vb[7]); *(u32x4*)(B_rm + t0 * RWS + kp) = w4;
            w4.x = pk2(vk[0], vk[1]); w4.y = pk2(vk[2], vk[3]); w4.z = pk2(vk[4], vk[5]); w4.w = pk2(vk[6], vk[7]); *(u32x4*)(K_rm + t0 * RWS + kp) = w4;
#pragma unroll
            for (int i = 0; i < 8; ++i) { B_tr[(kp + i) * RWS + t0] = (bf16_t)f2bf(vb[i]); K_tr[(kp + i) * RWS + t0] = (bf16_t)f2bf(vk[i]);
                V_tr[(kp + i) * RWS + t0] = (bf16_t)((i & 1) ? (vv[i >> 1] >> 16) : (vv[i >> 1] & 0xffffu)); }
        }
        RW1_BAR();
        }
        float* DQ = Gs; bf16_t* TB = (bf16_t*)BT;
#ifndef RW1_REP1
#define RW1_REP1 1
#endif
#pragma unroll
        for (int s1 = 0; s1 < 5; ++s1) { const int q = wave + 8 * s1;
            const int m = q / 10, e = q - m * 10, ti = e >= 6 ? 3 : (e >= 3 ? 2 : (e >= 1 ? 1 : 0)), tj = e - (ti * (ti + 1)) / 2;
            const f32x4 acc = rw_tile(m < 2 ? A_rm : R_rm, 16 * ti, (m & 1) ? K_rm : B_rm, 16 * tj, fr, fq);
            bf16_t* Mm = m == 1 ? MAK : (m == 2 ? MRB : MRK);
#pragma unroll
            for (int j = 0; j < 4; ++j) { const int t = 16 * ti + 4 * fq + j, i = 16 * tj + fr; const bool keep = m < 2 ? (i < t) : (i <= t); const float val = keep ? acc[j] : 0.f;
                if (m == 0) { MABr[t * RWS + i] = (bf16_t)f2bf(val); if (ti == tj) DQ[((ti * 16 + (t & 15)) * 4 + (fr & 3)) * 4 + (fr >> 2)] = val; }
                else Mm[t * RWS + i] = (bf16_t)f2bf(val); }
        }
        RW1_BAR();
#ifndef RW1_REP23
#define RW1_REP23 1
#endif
        for (int rep23_ = 0; rep23_ < RW1_REP23; ++rep23_) {
        if (wave >= 4) {
            for (int q = wave - 4; q < 16; q += 4) { const int ti = q >> 2, tv = q & 3; const f32x4 acc = rw_tile(MAK, 16 * ti, V_tr, 16 * tv, fr, fq);
#pragma unroll
                for (int j = 0; j < 4; ++j) RHS[(16 * ti + 4 * fq + j) * RST + 64 + 16 * tv + fr] = acc[j]; }
        } else {
            const int bb = wave, cc = lane >> 2, q = lane & 3;
            float xs[4] = {0.f, 0.f, 0.f, 0.f};
#pragma unroll
            for (int tl = 0; tl < 16; ++tl) {
                const f32x4 mv = *(const f32x4*)(DQ + ((bb * 16 + tl) * 4 + q) * 4);
                float part = mv[0] * xs[0] + mv[1] * xs[1] + mv[2] * xs[2] + mv[3] * xs[3];
                part += dppf<0xB1>(part); part += dppf<0x4E>(part);
                const float xt = (tl == cc ? 1.f : 0.f) - part;
                xs[tl >> 2] = (tl & 3) == q ? xt : xs[tl >> 2];
            }
#pragma unroll
            for (int m = 0; m < 4; ++m) TB[(bb * 16 + 4 * m + q) * 16 + cc] = (bf16_t)f2bf(xs[m]);
        }
        RW1_BAR();
        {
            const int c0 = 16 * wave;
            f32x4 X[4];
            const f32x4 zero4 = (f32x4){0.f, 0.f, 0.f, 0.f};
#define RW1_PACK(lo_, hi_, v_) do { union { bf16x8 v; unsigned u[4]; } t_; t_.u[0] = pk2(lo_[0], lo_[1]); t_.u[1] = pk2(lo_[2], lo_[3]); t_.u[2] = pk2(hi_[0], hi_[1]); t_.u[3] = pk2(hi_[2], hi_[3]); v_ = t_.v; } while (0)
#define RW1_LDA(base_, row0_, ca_, cb_, useb_, v_) do { union { bf16x8 v; u32x2 h2[2]; } t_; t_.h2[0] = *(const u32x2*)((base_) + ((row0_) + fr) * RWS + (ca_) + 4 * fq); \
            t_.h2[1] = (useb_) ? *(const u32x2*)((base_) + ((row0_) + fr) * RWS + (cb_) + 4 * fq) : (u32x2){0u, 0u}; v_ = t_.v; } while (0)
#pragma unroll
            for (int bq = 0; bq < 4; ++bq) {
                f32x4 acc;
#pragma unroll
                for (int j = 0; j < 4; ++j) acc[j] = -RHS[(16 * bq + 4 * fq + j) * RST + c0 + fr];
                bf16x8 af, bfv;
                if (bq >= 1) { RW1_LDA(MABr, 16 * bq, 0, 16, bq >= 2, af); if (bq >= 2) RW1_PACK(X[0], X[1], bfv); else RW1_PACK(X[0], zero4, bfv);
                    acc = __builtin_amdgcn_mfma_f32_16x16x32_bf16(af, bfv, acc, 0, 0, 0); }
                if (bq == 3) { RW1_LDA(MABr, 48, 32, 0, false, af); RW1_PACK(X[2], zero4, bfv); acc = __builtin_amdgcn_mfma_f32_16x16x32_bf16(af, bfv, acc, 0, 0, 0); }
                const f32x4 wv = (f32x4){-acc[0], -acc[1], -acc[2], -acc[3]};
                { union { bf16x8 v; u32x2 h2[2]; } t_; t_.h2[0] = *(const u32x2*)(TB + (bq * 16 + fr) * 16 + 4 * fq); t_.h2[1] = (u32x2){0u, 0u}; af = t_.v; }
                RW1_PACK(wv, zero4, bfv);
                X[bq] = __builtin_amdgcn_mfma_f32_16x16x32_bf16(af, bfv, zero4, 0, 0, 0);
                bf16_t* Xm = (wave < 4 ? X1_tr : X2_tr) + ((c0 & 63) + fr) * RWS + 16 * bq + 4 * fq;
                u32x2 o; o.x = pk2(X[bq][0], X[bq][1]); o.y = pk2(X[bq][2], X[bq][3]);
                *(u32x2*)Xm = o;
            }
#undef RW1_PACK
#undef RW1_LDA
        }
        RW1_BAR();
        }
#pragma unroll
        for (int s5 = 0; s5 < 2; ++s5) {
            const int tile = wave * 2 + s5, ta = tile >> 2, tb = tile & 3;
            u32x2 o;
            {
                const f32x4 acc = rw_tile(X1_tr, 16 * ta, B_tr, 16 * tb, fr, fq);
                const int k = 16 * tb + fr, kq = 16 * ta + 4 * fq; const float gc = GC[k];
                float v[4];
#pragma unroll
                for (int j = 0; j < 4; ++j) v[j] = gc * ((kq + j == k ? 1.f : 0.f) - acc[j]);
                o.x = pk2(v[0], v[1]); o.y = pk2(v[2], v[3]);
                *(u32x2*)(PP + (size_t)u * 4096 + k * 64 + 32 * (ta >> 1) + 8 * fq + 4 * (ta & 1)) = o;
            }
            {
                const f32x4 acc = rw_tile(X1_tr, 16 * ta, MRB, 16 * tb, fr, fq);
                const int t = 16 * tb + fr, k0 = 16 * ta + 4 * fq;
                const u32x2 rv = *(const u32x2*)(R_rm + t * RWS + k0);
                o.x = pk2(bflo(rv.x) - acc[0], bfhi(rv.x) - acc[1]); o.y = pk2(bflo(rv.y) - acc[2], bfhi(rv.y) - acc[3]);
                *(u32x2*)(YT + (size_t)u * 4096 + t * 64 + 32 * (ta >> 1) + 8 * fq + 4 * (ta & 1)) = o;
            }
            {
                const f32x4 a1 = rw_tile(K_tr, 16 * ta, V_tr, 16 * tb, fr, fq), a2 = rw_tile(B_tr, 16 * ta, X2_tr, 16 * tb, fr, fq);
                const int v_ = 16 * tb + fr, k0 = 16 * ta + 4 * fq;
                const f32x4 gc = *(const f32x4*)(GC + k0);
                o.x = pk2(gc[0] * (a1[0] - a2[0]), gc[1] * (a1[1] - a2[1])); o.y = pk2(gc[2] * (a1[2] - a2[2]), gc[3] * (a1[3] - a2[3]));
                *(u32x2*)(QT + (size_t)u * 4096 + v_ * 64 + k0) = o;
            }
            {
                const f32x4 a1 = rw_tile(MRK, 16 * ta, V_tr, 16 * tb, fr, fq), a2 = rw_tile(MRB, 16 * ta, X2_tr, 16 * tb, fr, fq);
                const int v_ = 16 * tb + fr, t0_ = 16 * ta + 4 * fq;
                o.x = pk2(a1[0] - a2[0], a1[1] - a2[1]); o.y = pk2(a1[2] - a2[2], a1[3] - a2[3]);
                *(u32x2*)(ZT + (size_t)u * 4096 + v_ * 64 + t0_) = o;
            }
        }
        RW1_BAR();
    }
#undef RW1_LOAD
#undef RW1_BAR
}

__device__ __forceinline__ void s5_setup_units(CParams& P, unsigned char* lds, const int first, const int stride) {
    PHASE_PROLOGUE
    float* pwr = (float*)lds; float* pwi = pwr + 2176; float* bbr = pwi + 2176; float* bbi = bbr + 2048; float* ccr = bbi + 2048; float* cci = ccr + 2048; float* kf = cci + 2048; float* kb = kf + 4096;
    for (int gu = first; gu < 256; gu += stride) {
        const int g = gu >> 2, part = gu & 3;
        if (tid < 128) {
            const int d = tid >> 6, p = tid & 63;
            const float step = __expf(s5_ls[d * 64 + g]);
            const float lr = s5_lre[(d * 64 + g) * 64 + p], li = s5_lim[(d * 64 + g) * 64 + p];
            const float mag = expf(lr * step);
            const float abr = mag * cosf(li * step), abi = mag * sinf(li * step);
            const float den = lr * lr + li * li;
            const float zr = ((abr - 1.f) * lr + abi * li) / den, zi = (abi * lr - (abr - 1.f) * li) / den;
            float pr = 1.f, pi = 0.f;
            for (int t = 0; t < 17; ++t) { pwr[(d * 64 + p) * 17 + t] = pr; pwi[(d * 64 + p) * 17 + t] = pi; const float nr = pr * abr - pi * abi; pi = pr * abi + pi * abr; pr = nr; }
            for (int i = 0; i < 16; ++i) { const float br = s5_b_re[((size_t)(g * 64 + p)) * 16 + i], bi = s5_b_im[((size_t)(g * 64 + p)) * 16 + i];
                bbr[(d * 64 + p) * 16 + i] = zr * br - zi * bi; bbi[(d * 64 + p) * 16 + i] = zr * bi + zi * br; }
        }
        for (int idx = tid; idx < 2048; idx += 512) { const int d = idx >> 10, i = (idx >> 6) & 15, p = idx & 63;
            ccr[(d * 64 + p) * 16 + i] = s5_c_re[((size_t)(d * 64 + g) * 16 + i) * 64 + p]; cci[(d * 64 + p) * 16 + i] = s5_c_im[((size_t)(d * 64 + g) * 16 + i) * 64 + p]; }
        __syncthreads();
        {
            const int d = tid >> 8, tau = (tid >> 4) & 15, i = tid & 15;
            float acc[16];
#pragma unroll
            for (int q = 0; q < 16; ++q) acc[q] = 0.f;
            for (int p = 0; p < 64; ++p) {
                const float cr = ccr[(d * 64 + p) * 16 + i], ci = cci[(d * 64 + p) * 16 + i], pr = pwr[(d * 64 + p) * 17 + tau], pi = pwi[(d * 64 + p) * 17 + tau];
                const float xr = cr * pr - ci * pi, xi = cr * pi + ci * pr;
#pragma unroll
                for (int q = 0; q < 16; ++q) acc[q] += xr * bbr[(d * 64 + p) * 16 + q] - xi * bbi[(d * 64 + p) * 16 + q];
            }
            float* kt = (d ? kb : kf) + (tau * 16 + i) * 16;
#pragma unroll
            for (int q = 0; q < 16; ++q) kt[q] = acc[q];
        }
        __syncthreads();
        unsigned* bta = (unsigned*)(BTA + (size_t)g * 512 * 256);
        for (int idx = part * 128 * 128 + tid; idx < (part + 1) * 128 * 128; idx += 512) {
            const int row = idx >> 7, col = (idx & 127) * 2;
            float v[2];
#pragma unroll
            for (int e = 0; e < 2; ++e) {
                const int cc_ = col + e, j = cc_ >> 4, ip = cc_ & 15;
                if (row < 256) { const int t = row >> 4, i = row & 15;
                    v[e] = j < t ? kf[((t - j) * 16 + i) * 16 + ip] : (j > t ? kb[((j - t) * 16 + i) * 16 + ip] : kf[i * 16 + ip] + kb[i * 16 + ip]); }
                else { const int kp = row - 256, d = kp >> 7, part = (kp >> 6) & 1, p = kp & 63, tau = d == 0 ? 15 - j : j;
                    const float pr = pwr[(d * 64 + p) * 17 + tau], pi = pwi[(d * 64 + p) * 17 + tau], br = bbr[(d * 64 + p) * 16 + ip], bi = bbi[(d * 64 + p) * 16 + ip];
                    v[e] = part ? pr * bi + pi * br : pr * br - pi * bi; }
            }
            bta[idx] = pk2(v[0], v[1]);
        }
        unsigned* btc = (unsigned*)(BTC + (size_t)g * 256 * 256);
        for (int idx = part * 64 * 128 + tid; idx < (part + 1) * 64 * 128; idx += 512) {
            const int row = idx >> 7, col = (idx & 127) * 2, t = row >> 4, i = row & 15;
            float v[2];
#pragma unroll
            for (int e = 0; e < 2; ++e) {
                const int k = col + e, d = k >> 7, part = (k >> 6) & 1, p = k & 63, tau = d == 0 ? t + 1 : 16 - t;
                const float cr = ccr[(d * 64 + p) * 16 + i], ci = cci[(d * 64 + p) * 16 + i], pr = pwr[(d * 64 + p) * 17 + tau], pi = pwi[(d * 64 + p) * 17 + tau];
                v[e] = part ? -(cr * pi + ci * pr) : cr * pr - ci * pi;
            }
            btc[idx] = pk2(v[0], v[1]);
        }
        __syncthreads();
    }
}

__device__ __forceinline__ void phase_60(CParams& P, unsigned char* lds, const int ph) {
    PHASE_PROLOGUE
    if (bid < 32) {
        const int chain = bid, d = chain >> 4, b = (chain >> 3) & 1, h = chain & 7;
        const int fr = lane & 15, fq = lane >> 4;
        constexpr int MATB = 64 * RWS * 2, SLOT = 4 * MATB;
        bf16_t* ybuf = (bf16_t*)(lds + 3 * SLOT);
        const bool comp = wave < 4; const int vb = wave & 3, lm = wave & 3;
        const unsigned char* src = (const unsigned char*)(lm == 0 ? PP : (lm == 1 ? YT : (lm == 2 ? QT : ZT))) + (size_t)chain * RW_NCH * 8192 + lane * 16;
        u32x4 R0[8], R1[8], R2[8];
#define RW2_LD(Rx, c_) do { _Pragma("unroll") for (int i_ = 0; i_ < 8; ++i_) Rx[i_] = *(const u32x4*)(src + (size_t)(c_) * 8192 + i_ * 1024); } while (0)
#define RW2_ST(Rx, c_) do { unsigned char* dst_ = lds + ((c_) % 3) * SLOT + lm * MATB; _Pragma("unroll") for (int i_ = 0; i_ < 8; ++i_) { const int p_ = lane + 64 * i_; *(u32x4*)(dst_ + (p_ >> 3) * (RWS * 2) + (p_ & 7) * 16) = Rx[i_]; } } while (0)
#define RW2_FLUSH(c_) do { const int tl_ = 16 * lm + (lane >> 2), s_ = (c_) * 64 + tl_; const bf16_t* yb_ = ybuf + ((c_) & 1) * 64 * RWS + tl_ * RWS + 16 * (lane & 3); \
            const u32x4 y0_ = *(const u32x4*)yb_, y1_ = *(const u32x4*)(yb_ + 8); \
            if (s_ < LSEQ) { const int p_ = d ? LSEQ - 1 - s_ : s_; bf16_t* g_ = YFB + ((size_t)d * NT + rowof(b, p_)) * 512 + h * 64 + 16 * (lane & 3); *(u32x4*)g_ = y0_; *(u32x4*)(g_ + 8) = y1_; } } while (0)
        const f32x4 zero4 = (f32x4){0.f, 0.f, 0.f, 0.f};
        f32x4 S[4] = {zero4, zero4, zero4, zero4};
#define RW2_COMPUTE(c_) do { const bf16_t* sl_ = (const bf16_t*)(lds + ((c_) % 3) * SLOT); const bf16_t* sP = sl_; const bf16_t* sY = sl_ + 64 * RWS; const bf16_t* sQ = sl_ + 2 * 64 * RWS; const bf16_t* sZ = sl_ + 3 * 64 * RWS; \
            bf16_t* yo_ = ybuf + ((c_) & 1) * 64 * RWS + 16 * vb + fr; \
            union { bf16x8 v; unsigned u[4]; } bs[2]; \
            _Pragma("unroll") for (int ks = 0; ks < 2; ++ks) { bs[ks].u[0] = pk2(S[2 * ks][0], S[2 * ks][1]); bs[ks].u[1] = pk2(S[2 * ks][2], S[2 * ks][3]); \
                bs[ks].u[2] = pk2(S[2 * ks + 1][0], S[2 * ks + 1][1]); bs[ks].u[3] = pk2(S[2 * ks + 1][2], S[2 * ks + 1][3]); } \
            _Pragma("unroll") for (int tt = 0; tt < 4; ++tt) { \
                const u32x2 z2 = *(const u32x2*)(sZ + (16 * vb + fr) * RWS + 16 * tt + 4 * fq); \
                f32x4 acc = (f32x4){bflo(z2.x), bfhi(z2.x), bflo(z2.y), bfhi(z2.y)}; \
                acc = __builtin_amdgcn_mfma_f32_16x16x32_bf16(*(const bf16x8*)(sY + (16 * tt + fr) * RWS + 8 * fq), bs[0].v, acc, 0, 0, 0); \
                acc = __builtin_amdgcn_mfma_f32_16x16x32_bf16(*(const bf16x8*)(sY + (16 * tt + fr) * RWS + 32 + 8 * fq), bs[1].v, acc, 0, 0, 0); \
                _Pragma("unroll") for (int j = 0; j < 4; ++j) yo_[(16 * tt + 4 * fq + j) * RWS] = (bf16_t)f2bf(acc[j]); } \
            f32x4 Sn[4]; \
            _Pragma("unroll") for (int kt = 0; kt < 4; ++kt) { \
                const u32x2 q2 = *(const u32x2*)(sQ + (16 * vb + fr) * RWS + 16 * kt + 4 * fq); \
                f32x4 acc = (f32x4){bflo(q2.x), bfhi(q2.x), bflo(q2.y), bfhi(q2.y)}; \
                acc = __builtin_amdgcn_mfma_f32_16x16x32_bf16(*(const bf16x8*)(sP + (16 * kt + fr) * RWS + 8 * fq), bs[0].v, acc, 0, 0, 0); \
                acc = __builtin_amdgcn_mfma_f32_16x16x32_bf16(*(const bf16x8*)(sP + (16 * kt + fr) * RWS + 32 + 8 * fq), bs[1].v, acc, 0, 0, 0); \
                Sn[kt] = acc; } \
            _Pragma("unroll") for (int kt = 0; kt < 4; ++kt) S[kt] = Sn[kt]; } while (0)
#define RW2_BAR() do { asm volatile("s_waitcnt lgkmcnt(0)" ::: "memory"); __builtin_amdgcn_s_barrier(); asm volatile("" ::: "memory"); } while (0)
        if (!comp) { RW2_LD(R0, 0); RW2_ST(R0, 0); RW2_LD(R0, 1); RW2_LD(R1, 2); RW2_LD(R2, 3); }
        __syncthreads();
        for (int c = 0; c < RW_NCH; c += 3) {
            if (!comp) { if (c + 1 < RW_NCH) RW2_ST(R0, c + 1); if (c + 4 < RW_NCH) RW2_LD(R0, c + 4); if (c > 0) RW2_FLUSH(c - 1); } else RW2_COMPUTE(c);
            RW2_BAR();
            if (!comp) { if (c + 2 < RW_NCH) RW2_ST(R1, c + 2); if (c + 5 < RW_NCH) RW2_LD(R1, c + 5); RW2_FLUSH(c); } else RW2_COMPUTE(c + 1);
            RW2_BAR();
            if (!comp) { if (c + 3 < RW_NCH) RW2_ST(R2, c + 3); if (c + 6 < RW_NCH) RW2_LD(R2, c + 6); RW2_FLUSH(c + 1); } else RW2_COMPUTE(c + 2);
            RW2_BAR();
        }
        if (!comp) RW2_FLUSH(RW_NCH - 1);
#undef RW2_LD
#undef RW2_ST
#undef RW2_FLUSH
#undef RW2_COMPUTE
#undef RW2_BAR
    } else {
        na_units(P, lds, bid - 32, G - 32);
        s5_setup_units(P, lds, bid - 32, G - 32);
    }
}

__device__ __forceinline__ void phase_7(CParams& P, unsigned char* lds, const int ph) {
    PHASE_PROLOGUE
            for (int row = gw; row < NT; row += NGW) {
                const int c0 = lane * 8;
                const u32x4 yf = *(const u32x4*)(YFB + (size_t)row * 512 + c0);
                const u32x4 yb = *(const u32x4*)(YFB + ((size_t)NT + row) * 512 + c0);
                const u32x4 vv = *(const u32x4*)(VV + (size_t)row * 512 + c0);
                const u32x4 gg = *(const u32x4*)(Gg + (size_t)row * 512 + c0);
                float y[8], v[8], g[8];
#pragma unroll
                for (int i = 0; i < 4; ++i) { y[2 * i] = bflo(yf[i]) + bflo(yb[i]); y[2 * i + 1] = bfhi(yf[i]) + bfhi(yb[i]); v[2 * i] = bflo(vv[i]); v[2 * i + 1] = bfhi(vv[i]); g[2 * i] = bflo(gg[i]); g[2 * i + 1] = bfhi(gg[i]); }
                float sm = 0.f;
#pragma unroll
                for (int i = 0; i < 8; ++i) sm += y[i];
                sm += __shfl_xor(sm, 1); sm += __shfl_xor(sm, 2); sm += __shfl_xor(sm, 4);
                const float mean = sm * (1.f / 64.f);
                float vr = 0.f;
#pragma unroll
                for (int i = 0; i < 8; ++i) { const float dlt = y[i] - mean; vr += dlt * dlt; }
                vr += __shfl_xor(vr, 1); vr += __shfl_xor(vr, 2); vr += __shfl_xor(vr, 4);
                const float rstd = rsqrtf(vr * (1.f / 64.f) + 64e-5f);
                const float bc = BC[(size_t)row * 8 + (lane >> 3)];
                float o[8];
#pragma unroll
                for (int i = 0; i < 8; ++i) o[i] = ((y[i] - mean) * rstd * lnx_g[c0 + i] + lnx_b[c0 + i] + bc * v[i]) * g[i];
                u32x4 ov; ov.x = pk2(o[0], o[1]); ov.y = pk2(o[2], o[3]); ov.z = pk2(o[4], o[5]); ov.w = pk2(o[6], o[7]);
                *(u32x4*)(A2 + (size_t)row * DM + 512 + c0) = ov;
            }
}


__device__ __forceinline__ void phase_8(CParams& P, unsigned char* lds, const int ph) {
    PHASE_PROLOGUE
    if (gw < 64) meta_gemm<0>(A2 + (size_t)NMAIN * DM, WTOUT, H + (size_t)NMAIN * DM, gw, lane);
    pg8::DenseOrder S; S.init(A2, WTOUT, NMAIN, DM, DM, G, bid);
    pg8::EpiResidual E{H};
    pg8::gemm_phase<pg8::EpiResidual, pg8::DenseOrder, true, true>((PG8_LAS unsigned char*)lds, DM, S, E);
}

__device__ __forceinline__ void phase_9(CParams& P, unsigned char* lds, const int ph) {
    PHASE_PROLOGUE
            const int l = ph == 9 ? 0 : 1;
                    for (int i = bid * 512 + tid; i < MOE_MAXROWS; i += G * 512) ROWTOK[i] = 0;
    unsigned* cnt = CTL + CW_CNT(l);
            const float* wg = moe_wg + (size_t)l * DM * 4; const float* bg = moe_bg + l * 4;
            for (int row = gw; row < NT; row += NGW) {
                f32x4 v[4]; float ss = 0.f;
#pragma unroll
                for (int j = 0; j < 4; ++j) { v[j] = ldrow_bf16(H + (size_t)row * DM, lane, j); ss += v[j][0] * v[j][0] + v[j][1] * v[j][1] + v[j][2] * v[j][2] + v[j][3] * v[j][3]; }
                ss = wave_sum(ss);
                const float rstd = rsqrtf(ss * (1.f / DM) + 1e-6f);
                float lg[4] = {0.f, 0.f, 0.f, 0.f};
#pragma unroll
                for (int j = 0; j < 4; ++j) {
                    const f32x4 g = ((const f32x4*)(norm_ffn + l * DM))[lane + 64 * j];
#pragma unroll
                    for (int i = 0; i < 4; ++i) v[j][i] = v[j][i] * rstd * g[i];
                    u32x2 o; o.x = pk2(v[j][0], v[j][1]); o.y = pk2(v[j][2], v[j][3]);
                    ((u32x2*)(HN + (size_t)row * DM))[lane + 64 * j] = o;
#pragma unroll
                    for (int i = 0; i < 4; ++i) { const f32x4 w = *(const f32x4*)(wg + (size_t)(4 * (lane + 64 * j) + i) * 4);
                        lg[0] += v[j][i] * w[0]; lg[1] += v[j][i] * w[1]; lg[2] += v[j][i] * w[2]; lg[3] += v[j][i] * w[3]; }
                }
#pragma unroll
                for (int q = 0; q < 4; ++q) lg[q] = wave_sum(lg[q]) + bg[q];
                int grp = 0; float mx = lg[0];
#pragma unroll
                for (int q = 1; q < 4; ++q) if (lg[q] > mx) { mx = lg[q]; grp = q; }
                float den = 0.f;
#pragma unroll
                for (int q = 0; q < 4; ++q) den += __expf(lg[q] - mx);
                const float pgrp = 1.f / den;
                const float* we = moe_we + ((size_t)(l * 4 + grp) * DM) * 8;
                float le[8] = {0.f, 0.f, 0.f, 0.f, 0.f, 0.f, 0.f, 0.f};
#pragma unroll
                for (int j = 0; j < 4; ++j)
#pragma unroll
                    for (int i = 0; i < 4; ++i) { const float* wr_ = we + (size_t)(4 * (lane + 64 * j) + i) * 8; const f32x4 wa = *(const f32x4*)wr_, wb = *(const f32x4*)(wr_ + 4);
                        le[0] += v[j][i] * wa[0]; le[1] += v[j][i] * wa[1]; le[2] += v[j][i] * wa[2]; le[3] += v[j][i] * wa[3];
                        le[4] += v[j][i] * wb[0]; le[5] += v[j][i] * wb[1]; le[6] += v[j][i] * wb[2]; le[7] += v[j][i] * wb[3]; }
#pragma unroll
                for (int q = 0; q < 8; ++q) le[q] = wave_sum(le[q]) + moe_be[(l * 4 + grp) * 8 + q];
                int i1 = 0; float m1 = le[0];
#pragma unroll
                for (int q = 1; q < 8; ++q) if (le[q] > m1) { m1 = le[q]; i1 = q; }
                int i2 = (i1 + 1) & 7; float m2 = -3.0e38f;
#pragma unroll
                for (int q = 0; q < 8; ++q) if (q != i1 && le[q] > m2) { m2 = le[q]; i2 = q; }
                const float e2 = __expf(m2 - m1);
                const float g1 = pgrp / (1.f + e2), g2 = pgrp * e2 / (1.f + e2);
                if (lane == 0) {
                    const int ea = grp * 8 + i1, eb = grp * 8 + i2;
                    const unsigned pa = atomicAdd(cnt + ea, 1u), pb = atomicAdd(cnt + eb, 1u);
                    EID[row * 2] = ea; EID[row * 2 + 1] = eb; POS[row * 2] = (int)pa; POS[row * 2 + 1] = (int)pb;
                    GATE[row * 2] = g1; GATE[row * 2 + 1] = g2;
                }
            }
    for (int it = gw; it < CONV_MOE_ITEMS; it += NGW) conv_moe_item(P, l, it, lane);
}


__device__ __forceinline__ void phase_10(CParams& P, unsigned char* lds, const int ph) {
    PHASE_PROLOGUE
    const int l = ph == 10 ? 0 : 1;
    int* ps = (int*)(lds + LDS_TAB);
    if (tid == 0) { int acc_ = 0; for (int e = 0; e < NEXP; ++e) { ps[e] = acc_; const int c = (int)CTL[CW_CNT(l) + e]; acc_ += (c + MOE_RT - 1) / MOE_RT * MOE_RT; } ps[NEXP] = acc_; }
    __syncthreads();
    for (int i = bid * 512 + tid; i < NT * 2; i += G * 512) { const int dest = ps[EID[i]] + POS[i]; DEST[i] = dest; ROWTOK[dest] = i >> 1; }
    __syncthreads();
}

__device__ __forceinline__ void phase_11(CParams& P, unsigned char* lds, const int ph) {
    PHASE_PROLOGUE
    const int l = ph == 11 ? 0 : 1;
    int* et = (int*)(lds + LDS_TAB);
    if (tid == 0) { int acc_ = 0; for (int e = 0; e < NEXP; ++e) { const int c = (int)CTL[CW_CNT(l) + e], n = (c + MOE_RT - 1) / MOE_RT; for (int q = 0; q < n; ++q) et[1 + acc_ + q] = e; acc_ += n; } et[0] = acc_; }
    __syncthreads();
    pg8::MoeOrder<true> S{et + 1, et[0], vcu, (const char*)HN, (const char*)WT13, 256u * DM * 2u, 256u * DM * 2u, (unsigned)DM * DM * 2u, ROWTOK};
    pg8::EpiSwiglu E{HB};
    pg8::gemm_phase<pg8::EpiSwiglu, pg8::MoeOrder<true>, true, true>((PG8_LAS unsigned char*)lds, DM, S, E);
    __syncthreads();
}

__device__ __forceinline__ void phase_12(CParams& P, unsigned char* lds, const int ph) {
    PHASE_PROLOGUE
    const int l = ph == 12 ? 0 : 1;
    int* et = (int*)(lds + LDS_TAB);
    if (tid == 0) { int acc_ = 0; for (int e = 0; e < NEXP; ++e) { const int c = (int)CTL[CW_CNT(l) + e], n = (c + MOE_RT - 1) / MOE_RT; for (int q = 0; q < n; ++q) et[1 + acc_ + q] = e; acc_ += n; } et[0] = acc_; }
    __syncthreads();
    pg8::MoeOrder<false> S{et + 1, et[0], vcu, (const char*)HB, (const char*)WT2, 256u * DFF * 2u, 256u * DFF * 2u, (unsigned)DM * DFF * 2u, nullptr};
    pg8::EpiBf16Plain E{YB, DM};
    pg8::gemm_phase<pg8::EpiBf16Plain, pg8::MoeOrder<false>, true, true>((PG8_LAS unsigned char*)lds, DFF, S, E);
    __syncthreads();
}

__device__ __forceinline__ void phase_13(CParams& P, unsigned char* lds, const int ph) {
    PHASE_PROLOGUE
            const bool fin = ph == 21;
            for (int row = gw; row < NT; row += NGW) {
                const int d0 = DEST[row * 2], d1 = DEST[row * 2 + 1];
                const float g0 = GATE[row * 2], g1 = GATE[row * 2 + 1];
                f32x4 v[4];
#pragma unroll
                for (int j = 0; j < 4; ++j) {
                    v[j] = ldrow_bf16(H + (size_t)row * DM, lane, j);
                    const u32x2 ya = ((const u32x2*)(YB + (size_t)d0 * DM))[lane + 64 * j];
                    const u32x2 yb = ((const u32x2*)(YB + (size_t)d1 * DM))[lane + 64 * j];
                    v[j][0] += g0 * bflo(ya.x) + g1 * bflo(yb.x); v[j][1] += g0 * bfhi(ya.x) + g1 * bfhi(yb.x);
                    v[j][2] += g0 * bflo(ya.y) + g1 * bflo(yb.y); v[j][3] += g0 * bfhi(ya.y) + g1 * bfhi(yb.y);
                }
                if (!fin) {
#pragma unroll
                    for (int j = 0; j < 4; ++j) strow_bf16(H + (size_t)row * DM, lane, j, v[j]);
                    store_norm_bf16(v, norm_mix + DM, HN + (size_t)row * DM, lane);
                } else if (row < NMAIN) {
                    float ss = 0.f;
#pragma unroll
                    for (int j = 0; j < 4; ++j) ss += v[j][0] * v[j][0] + v[j][1] * v[j][1] + v[j][2] * v[j][2] + v[j][3] * v[j][3];
                    ss = wave_sum(ss);
                    const float rstd = rsqrtf(ss * (1.f / DM) + 1e-6f);
#pragma unroll
                    for (int j = 0; j < 4; ++j) { const f32x4 g = ((const f32x4*)norm_final)[lane + 64 * j]; f32x4 o;
                        o[0] = v[j][0] * rstd * g[0]; o[1] = v[j][1] * rstd * g[1]; o[2] = v[j][2] * rstd * g[2]; o[3] = v[j][3] * rstd * g[3];
                        ((f32x4*)(P.out + (size_t)row * DM))[lane + 64 * j] = o; }
                }
            }
}

__device__ __forceinline__ void phase_15(CParams& P, unsigned char* lds, const int ph) {
    PHASE_PROLOGUE
    pg8::S5OrderA S{vcu, (const char*)HN, (const char*)BTA};
    pg8::EpiS5A E{YI, S5E};
    int Kr = 256; asm volatile("" : "+s"(Kr));
    pg8::gemm_phase<pg8::EpiS5A, pg8::S5OrderA, true, true>((PG8_LAS unsigned char*)lds, Kr, S, E);
}

__device__ __forceinline__ void phase_16(CParams& P, unsigned char* lds, const int ph) {
    PHASE_PROLOGUE
    float* Ls = (float*)lds;
    for (int wg = bid; wg < NB * 64 * 2; wg += G) {
        const int d = wg & 1, g = (wg >> 1) & 63, b = wg >> 7, p = lane;
        const float step = __expf(s5_ls[d * 64 + g]);
        const float lr = s5_lre[(d * 64 + g) * 64 + p], li = s5_lim[(d * 64 + g) * 64 + p];
        const float mag = expf(lr * step);
        const float abr = mag * cosf(li * step), abi = mag * sinf(li * step);
        float ar = 1.f, ai = 0.f;
        for (int t = 0; t < 16; ++t) { const float nr = ar * abr - ai * abi; ai = ar * abi + ai * abr; ar = nr; }
        float Ar = 1.f, Ai = 0.f;
        for (int t = 0; t < 64; ++t) { const float nr = Ar * ar - Ai * ai; Ai = Ar * ai + Ai * ar; Ar = nr; }
        const bf16_t* Ep = S5E + (size_t)g * 256 + d * 128 + p;
        bf16_t* Cp = CAR + (size_t)g * 1280 * 256 + d * 128 + p;
        const int q0 = 64 * wave;
#define S5_N(q_) ({ const int c_ = d ? 512 - (q_) : (q_); c_ == 0 ? 1024 + b : b * 512 + c_ - 1; })
        float sr = 0.f, si = 0.f;
#pragma unroll 1
        for (int hb = 0; hb < 2; ++hb) {
            float er[32], ei[32];
#pragma unroll
            for (int k = 0; k < 32; ++k) { const int n = S5_N(q0 + 32 * hb + k); er[k] = bf2f(Ep[(size_t)n * 64 * 256]); ei[k] = bf2f(Ep[(size_t)n * 64 * 256 + 64]); }
#pragma unroll
            for (int k = 0; k < 32; ++k) { const float nr = ar * sr - ai * si + er[k]; si = ar * si + ai * sr + ei[k]; sr = nr; }
        }
        Ls[(wave * 64 + p) * 2] = sr; Ls[(wave * 64 + p) * 2 + 1] = si;
        __syncthreads();
        sr = 0.f; si = 0.f;
        for (int w2 = 0; w2 < wave; ++w2) { const float l0 = Ls[(w2 * 64 + p) * 2], l1 = Ls[(w2 * 64 + p) * 2 + 1]; const float nr = Ar * sr - Ai * si + l0; si = Ar * si + Ai * sr + l1; sr = nr; }
#pragma unroll 1
        for (int hb = 0; hb < 2; ++hb) {
            float er[32], ei[32]; int nn[32];
#pragma unroll
            for (int k = 0; k < 32; ++k) { nn[k] = S5_N(q0 + 32 * hb + k); er[k] = bf2f(Ep[(size_t)nn[k] * 64 * 256]); ei[k] = bf2f(Ep[(size_t)nn[k] * 64 * 256 + 64]); }
#pragma unroll
            for (int k = 0; k < 32; ++k) { Cp[(size_t)nn[k] * 256] = (bf16_t)f2bf(sr); Cp[(size_t)nn[k] * 256 + 64] = (bf16_t)f2bf(si);
                const float nr = ar * sr - ai * si + er[k]; si = ar * si + ai * sr + ei[k]; sr = nr; }
        }
        if (wave == 7) { const int n = S5_N(512); Cp[(size_t)n * 256] = (bf16_t)f2bf(sr); Cp[(size_t)n * 256 + 64] = (bf16_t)f2bf(si); }
#undef S5_N
        __syncthreads();
    }
}

__device__ __forceinline__ void phase_22(CParams& P, unsigned char* lds, const int ph) {
    PHASE_PROLOGUE
    pg8::S5OrderC S{vcu, (const char*)CAR, (const char*)BTC};
    pg8::EpiS5C E{YI, HN, s5_d, A2};
    int Kr = 256; asm volatile("" : "+s"(Kr));
    pg8::gemm_phase<pg8::EpiS5C, pg8::S5OrderC, true, true>((PG8_LAS unsigned char*)lds, Kr, S, E);
}

__device__ __forceinline__ void phase_23(CParams& P, unsigned char* lds, const int ph) {
    PHASE_PROLOGUE
    if (gw < 64) meta_gemm<1>(A2 + (size_t)NMAIN * DM, WTGLU, H + (size_t)NMAIN * DM, gw, lane);
    pg8::DenseOrder S; S.init(A2, WTGLU, NMAIN, 2 * DM, DM, G, bid);
    pg8::EpiGlu E{H};
    pg8::gemm_phase<pg8::EpiGlu, pg8::DenseOrder, true, true>((PG8_LAS unsigned char*)lds, DM, S, E);
}
#define LAS __attribute__((address_space(3)))
#define CW_BAR 4096
#define XB_TMO      128
#define XB_XCNT(j)  (256  + 64 * (j))
#define XB_XSUB(j)  (1280 + 64 * (j))
#define XB_XGEN(j)  (2304 + 64 * (j))
#define XB_TOP      3328
#define XB_TOPGEN   3392
#define XCD_BAR_WORDS 3456
#define XB_SPIN_CAP (1u << 22)
__device__ __forceinline__ unsigned xb_ld(unsigned* p)              { return __hip_atomic_load(p, __ATOMIC_RELAXED, __HIP_MEMORY_SCOPE_AGENT); }
__device__ __forceinline__ unsigned xb_add(unsigned* p, unsigned v) { return __hip_atomic_fetch_add(p, v, __ATOMIC_RELAXED, __HIP_MEMORY_SCOPE_AGENT); }
__device__ __forceinline__ unsigned xb_xcc_id() { return (unsigned)__builtin_amdgcn_s_getreg((3 << 11) | 20) & 0xFu; }
#define XB_SPIN(cond, bar) do { unsigned _sp = 0; while (cond) { __builtin_amdgcn_s_sleep(1); \
    if ((++_sp & 255u) == 0u) { if (xb_ld(&(bar)[XB_TMO])) break; if (_sp > XB_SPIN_CAP) { atomicAdd(&(bar)[XB_TMO], 1u); break; } } } } while (0)
struct XcdBarrier { unsigned* bar; unsigned x; volatile LAS unsigned* st; };
__device__ __forceinline__ XcdBarrier xcd_barrier_post(unsigned* bar, volatile LAS unsigned* st) {
    XcdBarrier b; b.bar = bar; b.x = xb_xcc_id(); b.st = st;
    if (threadIdx.x == 0) (void)xb_add(&bar[XB_XCNT(b.x)], 1u);
    return b;
}
__device__ __forceinline__ void xcd_barrier_complete(unsigned* bar, unsigned x, unsigned& nloc, unsigned& nx) {
    const unsigned G = GRID;
    unsigned sum, cnt, mine, sp = 0u;
    for (;;) {
        sum = 0u; cnt = 0u; mine = 0u;
#pragma unroll
        for (unsigned j = 0; j < 16; ++j) { const unsigned c = xb_ld(&bar[XB_XCNT(j)]); sum += c; cnt += (c > 0u) ? 1u : 0u; mine = (j == x) ? c : mine; }
        if (sum == G) break;
        __builtin_amdgcn_s_sleep(1);
        if ((++sp & 255u) == 0u) { if (xb_ld(&bar[XB_TMO])) break; if (sp > XB_SPIN_CAP) { atomicAdd(&bar[XB_TMO], 1u); break; } }
    }
    nloc = mine > 0u ? mine : 1u; nx = cnt > 0u ? cnt : 1u;
}
__device__ __forceinline__ void xcd_barrier(const XcdBarrier& b) {
    asm volatile("s_waitcnt vmcnt(0)" ::: "memory");
    __syncthreads();
    if (threadIdx.x == 0) {
        unsigned* bar = b.bar;
        __builtin_amdgcn_s_waitcnt(0);
        unsigned nloc = b.st[0], nx = b.st[1];
        if (nloc == 0u) { xcd_barrier_complete(bar, b.x, nloc, nx); b.st[0] = nloc; b.st[1] = nx; }
        const unsigned old = xb_add(&bar[XB_XSUB(b.x)], 1u);
        const unsigned gen = old / nloc;
        if (old + 1u == (gen + 1u) * nloc) {
            __builtin_amdgcn_fence(__ATOMIC_RELEASE, "agent");
            asm volatile("s_waitcnt vmcnt(0)" ::: "memory");
            const unsigned og = xb_add(&bar[XB_TOP], 1u);
            const unsigned tg = og / nx;
            if (og + 1u == (tg + 1u) * nx) xb_add(&bar[XB_TOPGEN], 1u);
            else XB_SPIN(xb_ld(&bar[XB_TOPGEN]) == tg, bar);
            __builtin_amdgcn_fence(__ATOMIC_ACQUIRE, "agent");
            xb_add(&bar[XB_XGEN(b.x)], 1u);
            asm volatile("s_waitcnt vmcnt(0)" ::: "memory");
        } else {
            XB_SPIN(xb_ld(&bar[XB_XGEN(b.x)]) == gen, bar);
            __builtin_amdgcn_fence(__ATOMIC_ACQUIRE, "agent");
            asm volatile("s_waitcnt vmcnt(0)" ::: "memory");
        }
    }
    __syncthreads();
}


__global__ void __launch_bounds__(512, 2) mega(Params P_) {
    extern __shared__ __attribute__((aligned(16))) unsigned char lds[];
    volatile LAS unsigned* st = (volatile LAS unsigned*)(LAS unsigned char*)(lds + LDS_BARST);
    if (threadIdx.x < 16) st[threadIdx.x] = 0u;
    __syncthreads();
    CParams* pp = (CParams*)__builtin_amdgcn_kernarg_segment_ptr();
    (void)xcd_barrier_post((unsigned*)(pp->ws + WS_CTL) + CW_BAR, st);
#define GB do { XcdBarrier bar_; bar_.bar = (unsigned*)(pp->ws + WS_CTL) + CW_BAR; bar_.x = xb_xcc_id(); bar_.st = (volatile LAS unsigned*)(LAS unsigned char*)(lds + LDS_BARST); xcd_barrier(bar_); asm volatile("" : "+s"(pp)); } while (0)
#define P (*pp)
    asm volatile("" : "+s"(pp));
    phase_0(P, lds, 0); GB;
#if defined(PROBE_PH) && PROBE_PH == 0
    { int nrep = PROBE_N; asm volatile("" : "+s"(nrep)); for (int rep = 0; rep < nrep; ++rep) { GB; phase_0(P, lds, 0); GB; } }
#endif
    phase_1(P, lds, 1); GB;
#if defined(PROBE_PH) && PROBE_PH == 1
    { int nrep = PROBE_N; asm volatile("" : "+s"(nrep)); for (int rep = 0; rep < nrep; ++rep) { GB; phase_1(P, lds, 1); GB; } }
#endif
    phase_3(P, lds, 3); GB;
#if defined(PROBE_PH) && PROBE_PH == 3
    { int nrep = PROBE_N; asm volatile("" : "+s"(nrep)); for (int rep = 0; rep < nrep; ++rep) { GB; phase_3(P, lds, 3); GB; } }
#endif
    phase_6(P, lds, 6); GB;
    phase_60(P, lds, 60); GB;
#if defined(PROBE_PH) && PROBE_PH == 60
    { int nrep = PROBE_N; asm volatile("" : "+s"(nrep)); for (int rep = 0; rep < nrep; ++rep) { GB; phase_60(P, lds, 60); GB; } }
#endif
#if defined(PROBE_PH) && PROBE_PH == 6
    { int nrep = PROBE_N; asm volatile("" : "+s"(nrep)); for (int rep = 0; rep < nrep; ++rep) { GB; phase_6(P, lds, 6); GB; } }
#endif
    phase_7(P, lds, 7); GB;
#if defined(PROBE_PH) && PROBE_PH == 7
    { int nrep = PROBE_N; asm volatile("" : "+s"(nrep)); for (int rep = 0; rep < nrep; ++rep) { GB; phase_7(P, lds, 7); GB; } }
#endif
    phase_8(P, lds, 8); GB;
#if defined(PROBE_PH) && PROBE_PH == 8
    { int nrep = PROBE_N; asm volatile("" : "+s"(nrep)); for (int rep = 0; rep < nrep; ++rep) { GB; phase_8(P, lds, 8); GB; } }
#endif
    phase_9(P, lds, 9); GB;
#if defined(PROBE_PH) && PROBE_PH == 9
    { int nrep = PROBE_N; asm volatile("" : "+s"(nrep)); for (int rep = 0; rep < nrep; ++rep) { GB; phase_9(P, lds, 9); GB; } }
#endif
    phase_10(P, lds, 10); GB;
#if defined(PROBE_PH) && PROBE_PH == 10
    { int nrep = PROBE_N; asm volatile("" : "+s"(nrep)); for (int rep = 0; rep < nrep; ++rep) { GB; phase_10(P, lds, 10); GB; } }
#endif
    phase_11(P, lds, 11); GB;
#if defined(PROBE_PH) && PROBE_PH == 11
    { int nrep = PROBE_N; asm volatile("" : "+s"(nrep)); for (int rep = 0; rep < nrep; ++rep) { GB; phase_11(P, lds, 11); GB; } }
#endif
    phase_12(P, lds, 12); GB;
#if defined(PROBE_PH) && PROBE_PH == 12
    { int nrep = PROBE_N; asm volatile("" : "+s"(nrep)); for (int rep = 0; rep < nrep; ++rep) { GB; phase_12(P, lds, 12); GB; } }
#endif
    phase_13(P, lds, 13); GB;
#if defined(PROBE_PH) && PROBE_PH == 13
    { int nrep = PROBE_N; asm volatile("" : "+s"(nrep)); for (int rep = 0; rep < nrep; ++rep) { GB; phase_13(P, lds, 13); GB; } }
#endif
    phase_15(P, lds, 15); GB;
#if defined(PROBE_PH) && PROBE_PH == 15
    { int nrep = PROBE_N; asm volatile("" : "+s"(nrep)); for (int rep = 0; rep < nrep; ++rep) { GB; phase_15(P, lds, 15); GB; } }
#endif
    phase_16(P, lds, 16); GB;
#if defined(PROBE_PH) && PROBE_PH == 16
    { int nrep = PROBE_N; asm volatile("" : "+s"(nrep)); for (int rep = 0; rep < nrep; ++rep) { GB; phase_16(P, lds, 16); GB; } }
#endif
    phase_22(P, lds, 22); GB;
#if defined(PROBE_PH) && PROBE_PH == 22
    { int nrep = PROBE_N; asm volatile("" : "+s"(nrep)); for (int rep = 0; rep < nrep; ++rep) { GB; phase_22(P, lds, 22); GB; } }
#endif
    phase_23(P, lds, 23); GB;
#if defined(PROBE_PH) && PROBE_PH == 23
    { int nrep = PROBE_N; asm volatile("" : "+s"(nrep)); for (int rep = 0; rep < nrep; ++rep) { GB; phase_23(P, lds, 23); GB; } }
#endif
    phase_9(P, lds, 17); GB;
#if defined(PROBE_PH) && PROBE_PH == 17
    { int nrep = PROBE_N; asm volatile("" : "+s"(nrep)); for (int rep = 0; rep < nrep; ++rep) { GB; phase_9(P, lds, 17); GB; } }
#endif
    phase_10(P, lds, 18); GB;
#if defined(PROBE_PH) && PROBE_PH == 18
    { int nrep = PROBE_N; asm volatile("" : "+s"(nrep)); for (int rep = 0; rep < nrep; ++rep) { GB; phase_10(P, lds, 18); GB; } }
#endif
    phase_11(P, lds, 19); GB;
#if defined(PROBE_PH) && PROBE_PH == 19
    { int nrep = PROBE_N; asm volatile("" : "+s"(nrep)); for (int rep = 0; rep < nrep; ++rep) { GB; phase_11(P, lds, 19); GB; } }
#endif
    phase_12(P, lds, 20); GB;
#if defined(PROBE_PH) && PROBE_PH == 20
    { int nrep = PROBE_N; asm volatile("" : "+s"(nrep)); for (int rep = 0; rep < nrep; ++rep) { GB; phase_12(P, lds, 20); GB; } }
#endif
    phase_13(P, lds, 21);
#if defined(PROBE_PH) && PROBE_PH == 21
    { int nrep = PROBE_N; asm volatile("" : "+s"(nrep)); for (int rep = 0; rep < nrep; ++rep) { GB; phase_13(P, lds, 21); GB; } }
#endif
#undef P
#undef GB
}

extern "C" void kernel_launch(void* const* d_in, const int* in_sizes, int n_in, void* d_out, int out_size, void* d_ws, size_t ws_size, hipStream_t stream) {
    static int ready = 0;
    if (!ready) {
        if (n_in != 35 || ws_size < WS_TOTAL) { fprintf(stderr, "kernel_launch: unexpected n_in %d or ws_size %zu (need %zu)\n", n_in, ws_size, (size_t)WS_TOTAL); ready = -1; return; }
        if (hipFuncSetAttribute((const void*)mega, hipFuncAttributeMaxDynamicSharedMemorySize, LDS_BYTES) != hipSuccess) { fprintf(stderr, "kernel_launch: hipFuncSetAttribute failed\n"); ready = -1; return; }
        ready = 1;
    }
    if (ready < 0) return;
    (void)hipMemsetAsync((char*)d_ws + WS_CTL, 0, 1 * MiB, stream);
    Params P{};
    for (int i = 0; i < 35; ++i) P.in[i] = (const float*)d_in[i];
    P.out = (float*)d_out; P.ws = (unsigned char*)d_ws; P.ph_lo = 0; P.ph_hi = 0;
    hipLaunchKernelGGL(mega, dim3(GRID), dim3(512), LDS_BYTES, stream, P);
}
```

```cpp
#include <hip/hip_runtime.h>
#include <stdint.h>
#include <stdio.h>

#define DM 1024
#define NB 2
#define SEQ 8192
#define NMETA 16
#define LSEQ (SEQ + NMETA)
#define NMAIN (NB * SEQ)
#define NT (NB * LSEQ)
#define NTP 16640
#define INCOLS 3328
#define RESTC 1792
#define NEXP 32
#define DFF 512
#define S5TC 48
#define S5NC 171
#define MOE_RT 256
#define MOE_MAXROWS 41216

typedef unsigned short bf16_t;
typedef short bf16x8 __attribute__((ext_vector_type(8)));
typedef float f32x4 __attribute__((ext_vector_type(4)));
typedef unsigned u32x4 __attribute__((ext_vector_type(4)));
typedef unsigned u32x2 __attribute__((ext_vector_type(2)));

constexpr size_t MiB = 1u << 20;
constexpr size_t cmax2(size_t a, size_t b) { return a > b ? a : b; }
constexpr size_t al64k(size_t x) { return (x + 65535) & ~(size_t)65535; }
constexpr size_t WS_CTL = 0;
constexpr size_t WS_H = 1 * MiB;
constexpr size_t WS_HN = WS_H + al64k((size_t)NT * DM * 2);
constexpr size_t WS_A2 = WS_HN + al64k((size_t)NTP * DM * 2);
constexpr size_t WS_WTIN = WS_A2 + al64k((size_t)NTP * DM * 2);
constexpr size_t WS_WTOUT = WS_WTIN + al64k((size_t)INCOLS * DM * 2);
constexpr size_t WS_WTGLU = WS_WTOUT + al64k((size_t)DM * DM * 2);
constexpr size_t WS_LRT = WS_WTGLU + al64k((size_t)2 * DM * DM * 2);
constexpr size_t WS_BIG = WS_LRT + al64k((size_t)(2 * 512 * 64 * 2 + 512 * 128) * 2);
constexpr size_t SZ_T512 = al64k((size_t)NT * 512 * 2);
constexpr size_t SZ_P512 = al64k((size_t)NTP * 512 * 2);
constexpr int RW_NCH = 129, RW_UNITS = 32 * RW_NCH;
constexpr size_t SZ_RWOP = al64k((size_t)RW_UNITS * 4096 * 2);
constexpr size_t WS_Q = WS_BIG;
constexpr size_t WS_K = WS_Q + SZ_P512;
constexpr size_t WS_V = WS_K + SZ_P512;
constexpr size_t WS_REST = WS_V + SZ_P512;
constexpr size_t WS_KR = WS_REST + al64k((size_t)NTP * RESTC * 2);
constexpr size_t WS_LOW = WS_KR + SZ_T512;
constexpr size_t WS_AA = WS_LOW + al64k((size_t)NT * 256 * 2);
constexpr size_t WS_XEARLY = WS_AA + 2 * SZ_T512;
constexpr size_t WS_PP = WS_REST;
constexpr size_t WS_QT = WS_PP + SZ_RWOP;
constexpr size_t WS_YT = WS_QT + SZ_RWOP;
constexpr size_t WS_ZT = WS_YT + SZ_RWOP;
constexpr size_t WS_XEND = cmax2(WS_XEARLY, WS_ZT + SZ_RWOP);
constexpr size_t WS_R = WS_XEND;
constexpr size_t WS_VV = WS_R + SZ_T512;
constexpr size_t WS_G = WS_VV + SZ_T512;
constexpr size_t WS_KK = WS_G + SZ_T512;
constexpr size_t WS_KKA = WS_KK + SZ_T512;
constexpr size_t WS_KD = WS_KKA + 2 * SZ_T512;
constexpr size_t WS_W = WS_KD + 2 * SZ_T512;
constexpr size_t WS_BC = WS_W + 2 * SZ_T512;
constexpr size_t WS_MIXEND = WS_BC + al64k((size_t)NT * 8 * 4);
constexpr size_t WS_YFB = WS_KK;
constexpr size_t WS_ROWTOK = WS_BIG;
constexpr size_t WS_HB = WS_ROWTOK + al64k((size_t)MOE_MAXROWS * 4);
constexpr size_t WS_YB = WS_HB + al64k((size_t)MOE_MAXROWS * DFF * 2);
constexpr size_t WS_WT13 = WS_YB + al64k((size_t)MOE_MAXROWS * DM * 2);
constexpr size_t WS_WT2 = WS_WT13 + al64k((size_t)NEXP * DM * DM * 2);
constexpr size_t WS_EID = WS_WT2 + al64k((size_t)NEXP * DM * DFF * 2);
constexpr size_t WS_POS = WS_EID + al64k((size_t)NT * 8);
constexpr size_t WS_DEST = WS_POS + al64k((size_t)NT * 8);
constexpr size_t WS_GATE = WS_DEST + al64k((size_t)NT * 8);
constexpr size_t WS_MOEEND = WS_GATE + al64k((size_t)NT * 8);
constexpr size_t WS_YI = WS_BIG;
constexpr size_t WS_E = WS_YI + al64k((size_t)NTP * DM * 2);
constexpr size_t WS_CAR = WS_E + al64k((size_t)1040 * 64 * 256 * 2);
constexpr size_t WS_S5END = WS_CAR + al64k((size_t)64 * 1280 * 256 * 2);
constexpr size_t WS_BTA = cmax2(WS_MIXEND, cmax2(WS_MOEEND, WS_S5END));
constexpr size_t WS_BTC = WS_BTA + al64k((size_t)64 * 512 * 256 * 2);
constexpr size_t WS_BTEND = WS_BTC + al64k((size_t)64 * 256 * 256 * 2);
constexpr size_t cmax(size_t a, size_t b) { return a > b ? a : b; }
constexpr size_t WS_TOTAL = WS_BTEND;
static_assert(WS_TOTAL <= 512 * MiB, "workspace map exceeds 512 MiB");

#define CW_CNT(l) (1024 + 64 * (l))

#define LDS_BYTES 163840
#define LDS_BARST (LDS_BYTES - 1024)
#define LDS_TAB (LDS_BYTES - 768)
#define LDS_RING (LDS_BYTES - 1024)
#define GRID 256

struct Params {
    const float* in[35];
    float* out;
    unsigned char* ws;
    int ph_lo, ph_hi;
};
typedef const __attribute__((address_space(4))) Params CParams;

__device__ __forceinline__ float bf2f(bf16_t v) { return __uint_as_float(((unsigned)v) << 16); }
typedef float f32x2c_ __attribute__((ext_vector_type(2)));
typedef __bf16 bf16x2c_ __attribute__((ext_vector_type(2)));
__device__ __forceinline__ unsigned pk2(float lo, float hi) { const f32x2c_ f = {lo, hi}; const bf16x2c_ b = __builtin_convertvector(f, bf16x2c_); return __builtin_bit_cast(unsigned, b); }
__device__ __forceinline__ unsigned f2bf(float f) { return (unsigned)__builtin_bit_cast(unsigned short, (__bf16)f); }
__device__ __forceinline__ float bflo(unsigned u) { return __uint_as_float(u << 16); }
__device__ __forceinline__ float bfhi(unsigned u) { return __uint_as_float(u & 0xffff0000u); }
template <int CTRL> __device__ __forceinline__ float dppf(float v) { return __int_as_float(__builtin_amdgcn_update_dpp(0, __float_as_int(v), CTRL, 0xF, 0xF, true)); }
__device__ __forceinline__ float row16_sum(float v) { v += dppf<0xB1>(v); v += dppf<0x4E>(v); v += dppf<0x141>(v); v += dppf<0x140>(v); return v; }
__device__ __forceinline__ float wave_sum(float v) {
    v = row16_sum(v);
    { const unsigned xu = __float_as_uint(v); const auto sw = __builtin_amdgcn_permlane16_swap(xu, xu, false, false); v = __uint_as_float(sw[0]) + __uint_as_float(sw[1]); }
    { const unsigned xu = __float_as_uint(v); const auto sw = __builtin_amdgcn_permlane32_swap(xu, xu, false, false); v = __uint_as_float(sw[0]) + __uint_as_float(sw[1]); }
    return v;
}
__device__ __forceinline__ float wave_max(float v) {
    v = fmaxf(v, dppf<0xB1>(v)); v = fmaxf(v, dppf<0x4E>(v)); v = fmaxf(v, dppf<0x141>(v)); v = fmaxf(v, dppf<0x140>(v));
    { const unsigned xu = __float_as_uint(v); const auto sw = __builtin_amdgcn_permlane16_swap(xu, xu, false, false); v = fmaxf(__uint_as_float(sw[0]), __uint_as_float(sw[1])); }
    { const unsigned xu = __float_as_uint(v); const auto sw = __builtin_amdgcn_permlane32_swap(xu, xu, false, false); v = fmaxf(__uint_as_float(sw[0]), __uint_as_float(sw[1])); }
    return v;
}
__device__ __forceinline__ float sigmoidf_(float x) { return __builtin_amdgcn_rcpf(1.f + __expf(-x)); }
__device__ __forceinline__ int rowof(int b, int p) { return p < NMETA ? NMAIN + b * NMETA + p : b * SEQ + (p - NMETA); }

#define SA_STRIDE 40
template <class AF, class BF>
__device__ __forceinline__ void gemm_tile(unsigned char* lds, int K, int ldb, const AF& arow, const BF& bcol, f32x4 (&acc)[4][2]) {
    bf16_t* sA = (bf16_t*)lds;
    bf16_t* sB = (bf16_t*)(lds + 128 * SA_STRIDE * 2);
    const int tid = threadIdx.x, lane = tid & 63, wave = tid >> 6, wr = wave >> 2, wc = wave & 3, fr = lane & 15, fq = lane >> 4;
#pragma unroll
    for (int mi = 0; mi < 4; ++mi)
#pragma unroll
        for (int ni = 0; ni < 2; ++ni) acc[mi][ni] = (f32x4){0.f, 0.f, 0.f, 0.f};
    const int ar = tid >> 2, akc = (tid & 3) * 8;
    const bf16_t* ap = arow(ar) + akc;
    const int bnq = (tid & 31) * 4, bkp = (tid >> 5) * 2;
    const float* bp = bcol(bnq) + (size_t)bkp * ldb;
    const int nk = K / 32;
    u32x4 ra = *(const u32x4*)ap;
    f32x4 rb0 = *(const f32x4*)bp, rb1 = *(const f32x4*)(bp + ldb);
    for (int kt = 0; kt < nk; ++kt) {
        __syncthreads();
        *(u32x4*)(sA + ar * SA_STRIDE + akc) = ra;
        {
            unsigned* d = (unsigned*)(sB + bnq * SA_STRIDE + bkp);
            d[0 * (SA_STRIDE / 2)] = pk2(rb0[0], rb1[0]);
            d[1 * (SA_STRIDE / 2)] = pk2(rb0[1], rb1[1]);
            d[2 * (SA_STRIDE / 2)] = pk2(rb0[2], rb1[2]);
            d[3 * (SA_STRIDE / 2)] = pk2(rb0[3], rb1[3]);
        }
        __syncthreads();
        if (kt + 1 < nk) {
            ra = *(const u32x4*)(ap + (kt + 1) * 32);
            const float* q = bp + (size_t)(kt + 1) * 32 * ldb;
            rb0 = *(const f32x4*)q; rb1 = *(const f32x4*)(q + ldb);
        }
        bf16x8 a[4], b[2];
#pragma unroll
        for (int mi = 0; mi < 4; ++mi) a[mi] = *(const bf16x8*)(sA + (wr * 64 + mi * 16 + fr) * SA_STRIDE + fq * 8);
#pragma unroll
        for (int ni = 0; ni < 2; ++ni) b[ni] = *(const bf16x8*)(sB + (wc * 32 + ni * 16 + fr) * SA_STRIDE + fq * 8);
#pragma unroll
        for (int mi = 0; mi < 4; ++mi)
#pragma unroll
            for (int ni = 0; ni < 2; ++ni) acc[mi][ni] = __builtin_amdgcn_mfma_f32_16x16x32_bf16(a[mi], b[ni], acc[mi][ni], 0, 0, 0);
    }
    __syncthreads();
}
#define ACC_FOREACH(acc, ...) do { const int _l = threadIdx.x & 63, _w = threadIdx.x >> 6, _wr = _w >> 2, _wc = _w & 3, _fr = _l & 15, _fq = _l >> 4; \
    _Pragma("unroll") for (int _mi = 0; _mi < 4; ++_mi) _Pragma("unroll") for (int _ni = 0; _ni < 2; ++_ni) _Pragma("unroll") for (int _j = 0; _j < 4; ++_j) { \
        const int rl = _wr * 64 + _mi * 16 + _fq * 4 + _j, cl = _wc * 32 + _ni * 16 + _fr; const float val = acc[_mi][_ni][_j]; __VA_ARGS__ } } while (0)
#define ACC_FOREACH_PAIR(acc, ...) do { const int _l = threadIdx.x & 63, _w = threadIdx.x >> 6, _wr = _w >> 2, _wc = _w & 3, _fr = _l & 15, _fq = _l >> 4; \
    _Pragma("unroll") for (int _mi = 0; _mi < 4; ++_mi) _Pragma("unroll") for (int _j = 0; _j < 4; ++_j) { \
        const int rl = _wr * 64 + _mi * 16 + _fq * 4 + _j, co = _wc * 16 + _fr; const float va = acc[_mi][0][_j], vg = acc[_mi][1][_j]; __VA_ARGS__ } } while (0)

__device__ __forceinline__ void store_norm_bf16(const f32x4 (&v)[4], const float* gain, bf16_t* dst, int lane) {
    float ss = 0.f;
#pragma unroll
    for (int j = 0; j < 4; ++j) ss += v[j][0] * v[j][0] + v[j][1] * v[j][1] + v[j][2] * v[j][2] + v[j][3] * v[j][3];
    ss = wave_sum(ss);
    const float rstd = rsqrtf(ss * (1.f / DM) + 1e-6f);
#pragma unroll
    for (int j = 0; j < 4; ++j) {
        const f32x4 g = ((const f32x4*)gain)[lane + 64 * j];
        u32x2 o; o.x = pk2(v[j][0] * rstd * g[0], v[j][1] * rstd * g[1]); o.y = pk2(v[j][2] * rstd * g[2], v[j][3] * rstd * g[3]);
        ((u32x2*)dst)[lane + 64 * j] = o;
    }
}


__device__ __forceinline__ f32x4 ldrow_bf16(const bf16_t* row, int lane, int j) { const u32x2 u = ((const u32x2*)row)[lane + 64 * j]; return (f32x4){bflo(u.x), bfhi(u.x), bflo(u.y), bfhi(u.y)}; }
__device__ __forceinline__ void strow_bf16(bf16_t* row, int lane, int j, const f32x4 v) { u32x2 o; o.x = pk2(v[0], v[1]); o.y = pk2(v[2], v[3]); ((u32x2*)row)[lane + 64 * j] = o; }
namespace pg8 {
#define PG8_LAS __attribute__((address_space(3)))
constexpr int BM = 256, BK = 64, HALF = 128, HTB = HALF * BK * 2  , STAGE_BYTES = 8 * HTB, NXCD = 8, WGM = 8;
__host__ __device__ __forceinline__ int lds_byte(int r, int c) { const int st = (r >> 4) * 2 + (c >> 5), rr = r & 15, cc = c & 31, ob = rr * 64 + cc * 2; return st * 1024 + (ob ^ (((ob >> 9) & 1) << 5)); }
__host__ __device__ __forceinline__ void stage_rc(int b, int& R, int& C) { const int st = b / 1024, sb = b % 1024, swz = sb ^ (((sb >> 9) & 1) << 5); R = (st >> 1) * 16 + swz / 64; C = (st & 1) * 32 + (swz % 64) / 2; }
__host__ __device__ __forceinline__ int perm32(int rho) { const int n = rho >> 4, i = rho & 15; return 8 * (i >> 2) + 4 * n + (i & 3); }

struct Unit { int pm, pn; const char* A; const char* B; };

struct DenseOrder {
    static constexpr bool GATHER_ROWS = false;
    static constexpr bool GATHER_A = false;
    int nM, nN, nwg, G, c; const char* A; const char* Bt; size_t tstep;
    __device__ void init(const bf16_t* A_, const bf16_t* Bt_, int M, int N, int K, int G_, int c_) { nM = M / BM; nN = N / BM; nwg = nM * nN; G = G_; c = c_; A = (const char*)A_; Bt = (const char*)Bt_; tstep = (size_t)BM * K * 2; }
    __device__ bool next(int i, Unit& u) const {
        const long L = (long)i * G + c; if (L >= nwg) return false;
        int wgid = (int)L; { const int q = nwg / NXCD, r = nwg % NXCD, xcd = wgid % NXCD, off = wgid / NXCD; wgid = (xcd < r ? xcd * (q + 1) : r * (q + 1) + (xcd - r) * q) + off; }
        const int nig = WGM * nN, gid = wgid / nig, fm = gid * WGM, gsz = (nM - fm) < WGM ? (nM - fm) : WGM;
        u.pm = fm + ((wgid % nig) % gsz); u.pn = (wgid % nig) / gsz; u.A = A + (size_t)u.pm * tstep; u.B = Bt + (size_t)u.pn * tstep; return true;
    }
    __device__ __forceinline__ void a_ready(const Unit&) const {}
    __device__ __forceinline__ void done(const Unit&) const {}
};
struct ProjOrder {
    static constexpr bool GATHER_ROWS = false;
    static constexpr bool GATHER_A = false;
    DenseOrder D; const char* HNp; const char* WT;
    __device__ void init(const bf16_t* HN_, const bf16_t* WT_, int c_) { D.init(HN_, WT_, NTP, 13 * BM, DM, GRID, c_); HNp = (const char*)HN_; WT = (const char*)WT_; }
    __device__ bool next(int i, Unit& u) const {
        if (!D.next(i, u)) return false;
        const size_t ts = (size_t)BM * DM * 2;
        if (u.pn < 11) { const int wrow = u.pn < 4 ? u.pn : u.pn + 2; u.A = HNp + (size_t)u.pm * ts; u.B = WT + (size_t)wrow * ts; }
        else { u.A = WT + (size_t)(4 + (u.pn - 11)) * ts; u.B = HNp + (size_t)u.pm * ts; }
        return true;
    }
    __device__ __forceinline__ void a_ready(const Unit&) const {}
    __device__ __forceinline__ void done(const Unit&) const {}
};
template <bool GATHER> struct MoeOrder {
    static constexpr bool GATHER_ROWS = GATHER;
    static constexpr bool GATHER_A = false;
    const int* et; int TT, vcu; const char* A; const char* Bt; unsigned tstepA, tstepB, estep; const int* rowidx;
    __device__ __forceinline__ bool next(int i, Unit& u) const {
        const int L = i * GRID + vcu; if (L >= TT * 4) return false;
        const int rt = L >> 2, ct = L & 3, e = et[rt];
        u.pm = rt; u.pn = ct; u.A = GATHER ? A : A + (size_t)rt * tstepA; u.B = Bt + (size_t)e * estep + (size_t)ct * tstepB; return true;
    }
    __device__ __forceinline__ void a_ready(const Unit&) const {}
    __device__ __forceinline__ void done(const Unit&) const {}
};

struct S5OrderA {
    static constexpr bool GATHER_ROWS = false;
    static constexpr bool GATHER_A = true;
    int vcu; const char* U; const char* BTA;
    __device__ __forceinline__ bool next(int i, Unit& u) const {
        const int L = i * GRID + vcu; if (L >= 640) return false;
        const int g = L / 10, rem = L - g * 10, mt = rem >> 1, nt = rem & 1;
        u.pm = mt; u.pn = g * 2 + nt; u.A = U + ((size_t)mt * 256 * 16 * 1024 + g * 16) * 2; u.B = BTA + ((size_t)(g * 512 + nt * 256) * 256) * 2; return true;
    }
    __device__ __forceinline__ void a_ready(const Unit&) const {}
    __device__ __forceinline__ void done(const Unit&) const {}
};
struct S5OrderC {
    static constexpr bool GATHER_ROWS = false;
    static constexpr bool GATHER_A = false;
    int vcu; const char* CAR; const char* BTC;
    __device__ __forceinline__ bool next(int i, Unit& u) const {
        const int L = i * GRID + vcu; if (L >= 320) return false;
        const int g = L / 5, mt = L - g * 5;
        u.pm = mt; u.pn = g; u.A = CAR + ((size_t)(g * 1280 + mt * 256) * 256) * 2; u.B = BTC + ((size_t)g * 256 * 256) * 2; return true;
    }
    __device__ __forceinline__ void a_ready(const Unit&) const {}
    __device__ __forceinline__ void done(const Unit&) const {}
};
__device__ __forceinline__ unsigned cvt_pk_bf16(float lo, float hi) { return pk2(lo, hi); }

struct EpiProj {
    static constexpr bool PERM = true, AFTER_DRAIN = false;
    bf16_t *Q, *Kk, *VT, *REST;
    __device__ __forceinline__ void operator()(const f32x4 (&acc)[2][2][4][2], const Unit& u, int wr, int wc, int fr, int fq) const {
        bf16_t* base; int ldc; int row0, col0;
        if (u.pn < 11) { row0 = u.pm * BM + wr * 64 + fr; int colt;
            if (u.pn < 2) { base = Q; colt = u.pn * BM; ldc = 512; } else if (u.pn < 4) { base = Kk; colt = (u.pn - 2) * BM; ldc = 512; } else { base = REST; colt = (u.pn - 4) * BM; ldc = RESTC; }
            col0 = colt + wc * 32 + 8 * fq; }
        else { base = VT; ldc = NTP; row0 = (u.pn - 11) * BM + wr * 64 + fr; col0 = u.pm * BM + wc * 32 + 8 * fq; }
#pragma unroll
        for (int ai = 0; ai < 2; ++ai)
#pragma unroll
            for (int m = 0; m < 4; ++m) { bf16_t* rowp = base + (size_t)(row0 + ai * HALF + m * 16) * ldc + col0;
#pragma unroll
                for (int bj = 0; bj < 2; ++bj) { const f32x4 v0 = acc[ai][bj][m][0], v1 = acc[ai][bj][m][1];
                    u32x4 w; w.x = cvt_pk_bf16(v0[0], v0[1]); w.y = cvt_pk_bf16(v0[2], v0[3]); w.z = cvt_pk_bf16(v1[0], v1[1]); w.w = cvt_pk_bf16(v1[2], v1[3]);
                    *(u32x4*)(rowp + bj * HALF) = w; } }
    }
};
struct EpiBf16Plain {
    static constexpr bool PERM = true, AFTER_DRAIN = false;
    bf16_t* O; int ldc;
    __device__ __forceinline__ void operator()(const f32x4 (&acc)[2][2][4][2], const Unit& u, int wr, int wc, int fr, int fq) const {
        const int row0 = u.pm * BM + wr * 64 + fr; const int col0 = u.pn * BM + wc * 32 + 8 * fq;
#pragma unroll
        for (int ai = 0; ai < 2; ++ai)
#pragma unroll
            for (int m = 0; m < 4; ++m) { bf16_t* rowp = O + (size_t)(row0 + ai * HALF + m * 16) * ldc + col0;
#pragma unroll
                for (int bj = 0; bj < 2; ++bj) { const f32x4 v0 = acc[ai][bj][m][0], v1 = acc[ai][bj][m][1];
                    u32x4 w; w.x = cvt_pk_bf16(v0[0], v0[1]); w.y = cvt_pk_bf16(v0[2], v0[3]); w.z = cvt_pk_bf16(v1[0], v1[1]); w.w = cvt_pk_bf16(v1[2], v1[3]);
                    *(u32x4*)(rowp + bj * HALF) = w; } }
    }
};
struct EpiSwiglu {
    static constexpr bool PERM = true, AFTER_DRAIN = false;
    bf16_t* O;
    __device__ __forceinline__ void operator()(const f32x4 (&acc)[2][2][4][2], const Unit& u, int wr, int wc, int fr, int fq) const {
        const int row0 = u.pm * BM + wr * 64 + fr; const int col0 = u.pn * HALF + wc * 32 + 8 * fq;
#pragma unroll
        for (int ai = 0; ai < 2; ++ai)
#pragma unroll
            for (int m = 0; m < 4; ++m) {
                float o[8];
#pragma unroll
                for (int n = 0; n < 2; ++n)
#pragma unroll
                    for (int i = 0; i < 4; ++i) { const float va = acc[ai][0][m][n][i], vg = acc[ai][1][m][n][i]; o[4 * n + i] = va * __builtin_amdgcn_rcpf(1.f + __expf(-va)) * vg; }
                u32x4 w; w.x = cvt_pk_bf16(o[0], o[1]); w.y = cvt_pk_bf16(o[2], o[3]); w.z = cvt_pk_bf16(o[4], o[5]); w.w = cvt_pk_bf16(o[6], o[7]);
                *(u32x4*)(O + (size_t)(row0 + ai * HALF + m * 16) * DFF + col0) = w; }
    }
};
struct EpiResidual {
    static constexpr bool PERM = true, AFTER_DRAIN = false;
    bf16_t* Hh;
    __device__ __forceinline__ void operator()(const f32x4 (&acc)[2][2][4][2], const Unit& u, int wr, int wc, int fr, int fq) const {
        const int row0 = u.pm * BM + wr * 64 + fr; const int col0 = u.pn * BM + wc * 32 + 8 * fq;
#pragma unroll
        for (int ai = 0; ai < 2; ++ai)
#pragma unroll
            for (int m = 0; m < 4; ++m) { bf16_t* rowp = Hh + (size_t)(row0 + ai * HALF + m * 16) * DM + col0;
#pragma unroll
                for (int bj = 0; bj < 2; ++bj) { u32x4* p = (u32x4*)(rowp + bj * HALF); const u32x4 hv = *p; const f32x4 v0 = acc[ai][bj][m][0], v1 = acc[ai][bj][m][1];
                    u32x4 w; w.x = cvt_pk_bf16(__uint_as_float(hv.x << 16) + v0[0], __uint_as_float(hv.x & 0xffff0000u) + v0[1]); w.y = cvt_pk_bf16(__uint_as_float(hv.y << 16) + v0[2], __uint_as_float(hv.y & 0xffff0000u) + v0[3]);
                    w.z = cvt_pk_bf16(__uint_as_float(hv.z << 16) + v1[0], __uint_as_float(hv.z & 0xffff0000u) + v1[1]); w.w = cvt_pk_bf16(__uint_as_float(hv.w << 16) + v1[2], __uint_as_float(hv.w & 0xffff0000u) + v1[3]);
                    *p = w; } }
    }
};
struct EpiGlu {
    static constexpr bool PERM = true, AFTER_DRAIN = false;
    bf16_t* Hh;
    __device__ __forceinline__ void operator()(const f32x4 (&acc)[2][2][4][2], const Unit& u, int wr, int wc, int fr, int fq) const {
        const int row0 = u.pm * BM + wr * 64 + fr; const int col0 = u.pn * HALF + wc * 32 + 8 * fq;
#pragma unroll
        for (int ai = 0; ai < 2; ++ai)
#pragma unroll
            for (int m = 0; m < 4; ++m) { u32x4* p = (u32x4*)(Hh + (size_t)(row0 + ai * HALF + m * 16) * DM + col0); const u32x4 hv = *p;
                float o[8];
#pragma unroll
                for (int n = 0; n < 2; ++n)
#pragma unroll
                    for (int i = 0; i < 4; ++i) { const unsigned hw = hv[2 * n + (i >> 1)]; const float hcur = (i & 1) ? __uint_as_float(hw & 0xffff0000u) : __uint_as_float(hw << 16);
                        o[4 * n + i] = hcur + acc[ai][0][m][n][i] * __builtin_amdgcn_rcpf(1.f + __expf(-acc[ai][1][m][n][i])); }
                u32x4 w; w.x = cvt_pk_bf16(o[0], o[1]); w.y = cvt_pk_bf16(o[2], o[3]); w.z = cvt_pk_bf16(o[4], o[5]); w.w = cvt_pk_bf16(o[6], o[7]);
                *p = w; }
    }
};
struct EpiS5A {
    static constexpr bool PERM = true, AFTER_DRAIN = false;
    bf16_t* YI; bf16_t* E;
    __device__ __forceinline__ void operator()(const f32x4 (&acc)[2][2][4][2], const Unit& u, int wr, int wc, int fr, int fq) const {
        const int g = u.pn >> 1, nt = u.pn & 1;
        const int cl0 = wc * 32 + 8 * fq;
        bf16_t* base = nt == 0 ? YI + (size_t)(cl0 >> 4) * DM + g * 16 + (cl0 & 15) : E + (size_t)g * 256 + cl0;
        const size_t nstride = 16 * DM;
        const size_t bjstep = nt == 0 ? (size_t)8 * DM : (size_t)HALF;
#pragma unroll
        for (int ai = 0; ai < 2; ++ai)
#pragma unroll
            for (int m = 0; m < 4; ++m) { int n = u.pm * BM + ai * HALF + wr * 64 + m * 16 + fr; n = n < 1039 ? n : 1039;
                bf16_t* p = base + (size_t)n * nstride;
#pragma unroll
                for (int bj = 0; bj < 2; ++bj) { const f32x4 v0 = acc[ai][bj][m][0], v1 = acc[ai][bj][m][1];
                    u32x4 w; w.x = cvt_pk_bf16(v0[0], v0[1]); w.y = cvt_pk_bf16(v0[2], v0[3]); w.z = cvt_pk_bf16(v1[0], v1[1]); w.w = cvt_pk_bf16(v1[2], v1[3]);
                    *(u32x4*)(p + bj * bjstep) = w; } }
    }
};
struct EpiS5C {
    static constexpr bool PERM = true, AFTER_DRAIN = false;
    const bf16_t* YI; const bf16_t* Uu; const float* dvec; bf16_t* O;
    __device__ __forceinline__ void operator()(const f32x4 (&acc)[2][2][4][2], const Unit& u, int wr, int wc, int fr, int fq) const {
        const int g = u.pn;
        const int cl0 = wc * 32 + 8 * fq, ch = g * 16 + (cl0 & 15);
        const size_t off0 = (size_t)(cl0 >> 4) * DM + ch;
        const f32x4 d0 = *(const f32x4*)(dvec + ch), d1 = *(const f32x4*)(dvec + ch + 4);
#pragma unroll
        for (int ai = 0; ai < 2; ++ai)
#pragma unroll
            for (int m = 0; m < 4; ++m) { int n = u.pm * BM + ai * HALF + wr * 64 + m * 16 + fr; n = n < 1039 ? n : 1039;
#pragma unroll
                for (int bj = 0; bj < 2; ++bj) {
                    const size_t off = off0 + (size_t)n * (16 * DM) + (size_t)bj * (8 * DM);
                    const u32x4 yv = *(const u32x4*)(YI + off);
                    const f32x4 y0 = (f32x4){__uint_as_float(yv[0] << 16), __uint_as_float(yv[0] & 0xffff0000u), __uint_as_float(yv[1] << 16), __uint_as_float(yv[1] & 0xffff0000u)},
                                y1 = (f32x4){__uint_as_float(yv[2] << 16), __uint_as_float(yv[2] & 0xffff0000u), __uint_as_float(yv[3] << 16), __uint_as_float(yv[3] & 0xffff0000u)};
                    const u32x4 uv = *(const u32x4*)(Uu + off);
                    float y[8];
#pragma unroll
                    for (int q = 0; q < 4; ++q) { y[q] = acc[ai][bj][m][0][q] + y0[q] + d0[q] * (q & 1 ? __uint_as_float(uv[q >> 1] & 0xffff0000u) : __uint_as_float(uv[q >> 1] << 16));
                        y[4 + q] = acc[ai][bj][m][1][q] + y1[q] + d1[q] * (q & 1 ? __uint_as_float(uv[2 + (q >> 1)] & 0xffff0000u) : __uint_as_float(uv[2 + (q >> 1)] << 16)); }
#pragma unroll
                    for (int q = 0; q < 8; ++q) { const float z = 1.5957691216f * (y[q] + 0.044715f * y[q] * y[q] * y[q]); y[q] = y[q] * __builtin_amdgcn_rcpf(1.f + __expf(-z)); }
                    u32x4 w; w.x = cvt_pk_bf16(y[0], y[1]); w.y = cvt_pk_bf16(y[2], y[3]); w.z = cvt_pk_bf16(y[4], y[5]); w.w = cvt_pk_bf16(y[6], y[7]);
                    *(u32x4*)(O + off) = w; }
                asm volatile("" ::: "memory"); }
    }
};

template <class Epi, class Sched, bool ALIGN_EPI = false, bool SP2 = false>
__device__ __forceinline__ void gemm_phase(PG8_LAS unsigned char* lds, const int K, const Sched& S, const Epi& E) {
    int tid_ = threadIdx.x; asm volatile("" : "+v"(tid_));
    const int tid = tid_, wid = __builtin_amdgcn_readfirstlane(tid >> 6), lane = tid & 63, wr = wid >> 2, wc = wid & 3, fr = lane & 15, fq = lane >> 4;
    const int nt = K / BK;
    unsigned vA0[2], vA1[2], nA0[2], nA1[2], voffB[2];
#pragma unroll
    for (int i = 0; i < 2; ++i) { int R, C; stage_rc(tid * 16 + i * 8192, R, C); const int Rb = Epi::PERM ? ((R & ~31) + perm32(R & 31)) : R;
        vA0[i] = Sched::GATHER_A ? (unsigned)(((16 * R + (C >> 4)) * 1024 + (C & 15)) * 2) : (unsigned)(R * K + C) * 2u; voffB[i] = (unsigned)(Rb * K + C) * 2u; }
    const size_t kstep = (size_t)(BK * 2);
    const size_t hstep = (size_t)HALF * K * 2;
    const size_t kstepA = Sched::GATHER_A ? (size_t)(4 * 1024 * 2) : kstep, hstepA = Sched::GATHER_A ? (size_t)HALF * 16 * 1024 * 2 : hstep;
#define PG8_ROWOFFS(u_, d0_, d1_) do { _Pragma("unroll") for (int i_ = 0; i_ < 2; ++i_) { int R_, C_; stage_rc(tid * 16 + i_ * 8192, R_, C_); \
        d0_[i_] = (unsigned)(S.rowidx[(u_).pm * BM + R_] * K + C_) * 2u; d1_[i_] = (unsigned)(S.rowidx[(u_).pm * BM + HALF + R_] * K + C_) * 2u; } } while (0)
#define PG8_STAGE_A(bufoff, gbase, h_, nx_) do { _Pragma("unroll") for (int _i = 0; _i < 2; ++_i) { const unsigned vo_ = (nx_) ? ((h_) ? nA1[_i] : nA0[_i]) : ((h_) ? vA1[_i] : vA0[_i]); \
        __builtin_amdgcn_global_load_lds((const unsigned*)((const char*)(gbase) + vo_), (PG8_LAS unsigned*)(lds + (bufoff) + ldsw + _i * 8192), 16, 0, 0); } } while (0)
    const unsigned ldsw = (unsigned)wid * 1024u;
    const int aoff = lds_byte(wr * 64 + fr, fq * 8), boff = lds_byte(wc * 32 + fr, fq * 8);
#define PG8_SA(b, h) (((b) * 2 + (h)) * HTB)
#define PG8_SB(b, h) ((4 + (b) * 2 + (h)) * HTB)
#define PG8_STAGE(bufoff, gbase, voff) do { _Pragma("unroll") for (int _i = 0; _i < 2; ++_i) \
        __builtin_amdgcn_global_load_lds((const unsigned*)((const char*)(gbase) + (voff)[_i]), (PG8_LAS unsigned*)(lds + (bufoff) + ldsw + _i * 8192), 16, 0, 0); } while (0)
#define PG8_LDA(dst, b, h) do { _Pragma("unroll") for (int m = 0; m < 4; ++m) _Pragma("unroll") for (int k = 0; k < 2; ++k) dst[m][k] = *(const PG8_LAS bf16x8*)(lds + PG8_SA(b, h) + aoff + m * 2048 + k * 1024); } while (0)
#define PG8_LDB(dst, b, h) do { _Pragma("unroll") for (int n = 0; n < 2; ++n) _Pragma("unroll") for (int k = 0; k < 2; ++k) dst[n][k] = *(const PG8_LAS bf16x8*)(lds + PG8_SB(b, h) + boff + n * 2048 + k * 1024); } while (0)
#define PG8_MMA(ai, bj, At, Bt) do { __builtin_amdgcn_s_setprio(1); _Pragma("unroll") for (int m = 0; m < 4; ++m) _Pragma("unroll") for (int n = 0; n < 2; ++n) _Pragma("unroll") for (int k = 0; k < 2; ++k) \
        acc[ai][bj][m][n] = __builtin_amdgcn_mfma_f32_16x16x32_bf16(Bt[n][k], At[m][k], acc[ai][bj][m][n], 0, 0, 0); __builtin_amdgcn_s_setprio(0); } while (0)
#define PG8_WAIT_V(n) asm volatile("s_waitcnt vmcnt(" #n ")" ::: "memory")
#define PG8_WAIT_L(n) asm volatile("s_waitcnt lgkmcnt(" #n ")" ::: "memory")
#define PG8_BAR __builtin_amdgcn_s_barrier()
#define PG8_SCHED __builtin_amdgcn_sched_barrier(0)
    Unit cur, nxt; int ui = 0;
    if (!S.next(0, cur)) return;
    f32x4 acc[2][2][4][2];
#pragma unroll
    for (int a = 0; a < 2; ++a)
#pragma unroll
        for (int b = 0; b < 2; ++b)
#pragma unroll
            for (int m = 0; m < 4; ++m)
#pragma unroll
                for (int n = 0; n < 2; ++n) acc[a][b][m][n] = (f32x4){0.f, 0.f, 0.f, 0.f};
    bf16x8 At[4][2], B0[2][2], B1[2][2];
    const char* cA = cur.A; const char* cB = cur.B;
    if constexpr (Sched::GATHER_ROWS) { PG8_ROWOFFS(cur, vA0, vA1); }
    else {
#pragma unroll
        for (int i = 0; i < 2; ++i) vA1[i] = vA0[i] + (unsigned)hstepA;
    }
#pragma unroll
    for (int i = 0; i < 2; ++i) { nA0[i] = vA0[i]; nA1[i] = vA1[i]; }
    S.a_ready(cur);
    if constexpr (SP2) {
        PG8_STAGE(PG8_SB(0, 0), cB, voffB); PG8_STAGE(PG8_SB(0, 1), cB + hstep, voffB); PG8_STAGE_A(PG8_SA(0, 0), cA, 0, false); PG8_STAGE_A(PG8_SA(0, 1), cA, 1, false);
        if (wr == 1) PG8_BAR;
        PG8_WAIT_V(2); PG8_BAR;
        PG8_STAGE(PG8_SB(1, 0), cB + kstep, voffB); PG8_STAGE_A(PG8_SA(1, 0), cA + kstepA, 0, false); PG8_STAGE(PG8_SB(1, 1), cB + hstep + kstep, voffB);
        PG8_WAIT_V(6); PG8_BAR;
    } else {
        PG8_STAGE(PG8_SB(0, 0), cB, voffB); PG8_STAGE_A(PG8_SA(0, 0), cA, 0, false); PG8_STAGE(PG8_SB(0, 1), cB + hstep, voffB); PG8_STAGE_A(PG8_SA(0, 1), cA, 1, false);
        if (wr == 1) PG8_BAR;
        PG8_WAIT_V(4); PG8_BAR;
        PG8_STAGE(PG8_SB(1, 0), cB + kstep, voffB); PG8_STAGE_A(PG8_SA(1, 0), cA + kstepA, 0, false); PG8_STAGE(PG8_SB(1, 1), cB + hstep + kstep, voffB);
        PG8_WAIT_V(6); PG8_BAR;
    }
    for (;;) {
        const bool has_next = S.next(ui + 1, nxt);
        if constexpr (Sched::GATHER_ROWS) { if (has_next) PG8_ROWOFFS(nxt, nA0, nA1); }
        const char* nA = has_next ? nxt.A : cA; const char* nB = has_next ? nxt.B : cB;
        for (int t = 0; t < nt; t += 2) {
            const bool last = (t == nt - 2);
            const char* a1 = cA + (size_t)(t + 1) * kstepA;
            const char* a2 = last ? nA : cA + (size_t)(t + 2) * kstepA; const char* b2 = last ? nB : cB + (size_t)(t + 2) * kstep;
            const char* a3 = a2 + kstepA; const char* b3 = b2 + kstep;
            if (last && has_next) S.a_ready(nxt);
            if constexpr (SP2) {
            PG8_LDB(B0, 0, 0); PG8_LDB(B1, 0, 1); PG8_SCHED; PG8_LDA(At, 0, 0); PG8_STAGE_A(PG8_SA(1, 1), a1, 1, false);
            PG8_WAIT_V(8); PG8_WAIT_L(0); PG8_BAR; PG8_MMA(0, 0, At, B0); PG8_MMA(0, 1, At, B1); PG8_BAR; PG8_SCHED;
            PG8_LDA(At, 0, 1); PG8_STAGE(PG8_SB(0, 0), b2, voffB); PG8_STAGE(PG8_SB(0, 1), b2 + hstep, voffB); PG8_STAGE_A(PG8_SA(0, 0), a2, 0, last);
            PG8_WAIT_V(8); PG8_WAIT_L(0); PG8_BAR; PG8_MMA(1, 0, At, B0); PG8_MMA(1, 1, At, B1); PG8_BAR; PG8_SCHED;
            PG8_LDB(B0, 1, 0); PG8_LDB(B1, 1, 1); PG8_SCHED; PG8_LDA(At, 1, 0); PG8_STAGE_A(PG8_SA(0, 1), a2, 1, last);
            PG8_WAIT_V(8); PG8_WAIT_L(0); PG8_BAR; PG8_MMA(0, 0, At, B0); PG8_MMA(0, 1, At, B1); PG8_BAR; PG8_SCHED;
            PG8_LDA(At, 1, 1); PG8_STAGE(PG8_SB(1, 0), b3, voffB); PG8_STAGE(PG8_SB(1, 1), b3 + hstep, voffB); PG8_STAGE_A(PG8_SA(1, 0), a3, 0, last);
            PG8_WAIT_V(8); PG8_WAIT_L(0); PG8_BAR; PG8_MMA(1, 0, At, B0); PG8_MMA(1, 1, At, B1); PG8_BAR; PG8_SCHED;
            } else {
            PG8_LDB(B0, 0, 0); PG8_SCHED; PG8_LDA(At, 0, 0); PG8_STAGE_A(PG8_SA(1, 1), a1, 1, false);
            PG8_WAIT_L(8); PG8_BAR; PG8_WAIT_L(0); PG8_MMA(0, 0, At, B0); PG8_BAR; PG8_SCHED;
            PG8_LDB(B1, 0, 1); PG8_STAGE(PG8_SB(0, 0), b2, voffB);
            PG8_BAR; PG8_WAIT_L(0); PG8_MMA(0, 1, At, B1); PG8_BAR;
            PG8_LDA(At, 0, 1); PG8_STAGE_A(PG8_SA(0, 0), a2, 0, last);
            PG8_BAR; PG8_WAIT_L(0); PG8_MMA(1, 0, At, B0); PG8_BAR; PG8_SCHED;
            PG8_STAGE(PG8_SB(0, 1), b2 + hstep, voffB);
            PG8_WAIT_V(6); PG8_BAR; PG8_MMA(1, 1, At, B1); PG8_BAR;
            PG8_LDB(B0, 1, 0); PG8_SCHED; PG8_LDA(At, 1, 0); PG8_STAGE_A(PG8_SA(0, 1), a2, 1, last);
            PG8_WAIT_L(8); PG8_BAR; PG8_WAIT_L(0); PG8_MMA(0, 0, At, B0); PG8_BAR; PG8_SCHED;
            PG8_LDB(B1, 1, 1); PG8_STAGE(PG8_SB(1, 0), b3, voffB);
            PG8_BAR; PG8_WAIT_L(0); PG8_MMA(0, 1, At, B1); PG8_BAR;
            PG8_LDA(At, 1, 1); PG8_STAGE_A(PG8_SA(1, 0), a3, 0, last);
            PG8_BAR; PG8_WAIT_L(0); PG8_MMA(1, 0, At, B0); PG8_BAR; PG8_SCHED;
            PG8_STAGE(PG8_SB(1, 1), b3 + hstep, voffB);
            PG8_WAIT_V(6); PG8_BAR; PG8_MMA(1, 1, At, B1); PG8_BAR;
            }
        }
        if constexpr (ALIGN_EPI) { if (wr == 0) PG8_BAR; }
        if constexpr (!Epi::AFTER_DRAIN) { E(acc, cur, wr, wc, fr, fq); S.done(cur); }
        if (!has_next) break;
#pragma unroll
        for (int a = 0; a < 2; ++a)
#pragma unroll
            for (int b = 0; b < 2; ++b)
#pragma unroll
                for (int m = 0; m < 4; ++m)
#pragma unroll
                    for (int n = 0; n < 2; ++n) acc[a][b][m][n] = (f32x4){0.f, 0.f, 0.f, 0.f};
        cur = nxt; cA = nA; cB = nB; ++ui;
        if constexpr (Sched::GATHER_ROWS) {
#pragma unroll
            for (int i = 0; i < 2; ++i) { vA0[i] = nA0[i]; vA1[i] = nA1[i]; } }
        if constexpr (ALIGN_EPI) { if (wr == 1) PG8_BAR; }
    }
    PG8_WAIT_V(0);
    if constexpr (!ALIGN_EPI) { if (wr == 0) PG8_BAR; }
    PG8_BAR;
    if constexpr (Epi::AFTER_DRAIN) { E.fused(acc, cur, wr, wc, fr, fq, lds, wid, lane); S.done(cur); }
#undef PG8_SA
#undef PG8_SB
#undef PG8_STAGE
#undef PG8_STAGE_A
#undef PG8_ROWOFFS
#undef PG8_LDA
#undef PG8_LDB
#undef PG8_MMA
#undef PG8_WAIT_V
#undef PG8_WAIT_L
#undef PG8_BAR
#undef PG8_SCHED
}
}

#define PHASE_PROLOGUE \
    int tid_ = threadIdx.x; asm volatile("" : "+v"(tid_)); const int tid = tid_, lane = tid & 63, wave = tid >> 6; \
    const int G = GRID, bid = blockIdx.x; \
    const int gw = bid * 8 + wave, NGW = G * 8; \
    unsigned char* ws = P.ws; \
    bf16_t* H = (bf16_t*)(ws + WS_H); \
    bf16_t* HN = (bf16_t*)(ws + WS_HN); \
    bf16_t* A2 = (bf16_t*)(ws + WS_A2); \
    bf16_t* Qb = (bf16_t*)(ws + WS_Q); bf16_t* Kb = (bf16_t*)(ws + WS_K); bf16_t* Vb = (bf16_t*)(ws + WS_V); \
    bf16_t* REST = (bf16_t*)(ws + WS_REST); \
    bf16_t* YFB = (bf16_t*)(ws + WS_YFB); \
    bf16_t* Rr = (bf16_t*)(ws + WS_R); bf16_t* VV = (bf16_t*)(ws + WS_VV); bf16_t* KK = (bf16_t*)(ws + WS_KK); \
    bf16_t* KKA = (bf16_t*)(ws + WS_KKA); bf16_t* KD = (bf16_t*)(ws + WS_KD); \
    _Float16* LW = (_Float16*)(ws + WS_W); bf16_t* PP = (bf16_t*)(ws + WS_PP); bf16_t* QT = (bf16_t*)(ws + WS_QT); bf16_t* YT = (bf16_t*)(ws + WS_YT); bf16_t* ZT = (bf16_t*)(ws + WS_ZT); \
    bf16_t* Gg = (bf16_t*)(ws + WS_G); bf16_t* KR = (bf16_t*)(ws + WS_KR); bf16_t* LOW = (bf16_t*)(ws + WS_LOW); \
    float* BC = (float*)(ws + WS_BC); \
    bf16_t* AA = (bf16_t*)(ws + WS_AA); \
    bf16_t* HB = (bf16_t*)(ws + WS_HB); bf16_t* YB = (bf16_t*)(ws + WS_YB); \
    int* ROWTOK = (int*)(ws + WS_ROWTOK); int* EID = (int*)(ws + WS_EID); int* POS = (int*)(ws + WS_POS); int* DEST = (int*)(ws + WS_DEST); \
    float* GATE = (float*)(ws + WS_GATE); \
    bf16_t* YI = (bf16_t*)(ws + WS_YI); bf16_t* S5E = (bf16_t*)(ws + WS_E); bf16_t* CAR = (bf16_t*)(ws + WS_CAR); bf16_t* BTA = (bf16_t*)(ws + WS_BTA); bf16_t* BTC = (bf16_t*)(ws + WS_BTC); \
    unsigned* CTL = (unsigned*)(ws + WS_CTL); \
    bf16_t* WTIN = (bf16_t*)(ws + WS_WTIN); bf16_t* WTOUT = (bf16_t*)(ws + WS_WTOUT); bf16_t* WTGLU = (bf16_t*)(ws + WS_WTGLU); bf16_t* WT13 = (bf16_t*)(ws + WS_WT13); bf16_t* WT2 = (bf16_t*)(ws + WS_WT2); \
    const int vcu = (G % 8 == 0) ? (bid % 8) * (G / 8) + bid / 8 : bid; \
    const float* x = P.in[0]; const float* meta = P.in[1]; const float* norm_mix = P.in[2]; const float* norm_ffn = P.in[3]; const float* norm_final = P.in[4]; \
    const float* w_in = P.in[5]; const float* w_out = P.in[6]; const float* rpb = P.in[7]; const float* mu = P.in[8]; \
    const float* w0 = P.in[9]; const float* w_up = P.in[10]; const float* a0 = P.in[11]; const float* a_up = P.in[12]; const float* g_up = P.in[13]; \
    const float* k_k = P.in[14]; const float* k_a = P.in[15]; const float* r_k = P.in[16]; const float* lnx_g = P.in[17]; const float* lnx_b = P.in[18]; \
    const float* s5_b_re = P.in[19]; const float* s5_b_im = P.in[20]; const float* s5_lre = P.in[21]; const float* s5_lim = P.in[22]; const float* s5_ls = P.in[23]; \
    const float* s5_c_re = P.in[24]; const float* s5_c_im = P.in[25]; const float* s5_d = P.in[26]; const float* w_glu = P.in[27]; \
    const float* moe_wg = P.in[28]; const float* moe_bg = P.in[29]; const float* moe_we = P.in[30]; const float* moe_be = P.in[31]; \
    const float* moe_w1 = P.in[32]; const float* moe_w3 = P.in[33]; const float* moe_w2 = P.in[34];


__device__ __forceinline__ void transpose_half(const float* W, int N, int K, int k0, int n0, bf16_t* dstrow0, int lane) {
    const int kb = lane & 7, nq = lane >> 3;
    const float* src = W + (size_t)(k0 + 8 * kb) * N + n0 + 4 * nq;
    f32x4 v[8];
#pragma unroll
    for (int kk = 0; kk < 8; ++kk) v[kk] = *(const f32x4*)(src + (size_t)kk * N);
#pragma unroll
    for (int i = 0; i < 4; ++i) {
        u32x4 o; o.x = pk2(v[0][i], v[1][i]); o.y = pk2(v[2][i], v[3][i]); o.z = pk2(v[4][i], v[5][i]); o.w = pk2(v[6][i], v[7][i]);
        *(u32x4*)(dstrow0 + (size_t)(4 * nq + i) * K + k0 + 8 * kb) = o;
    }
}
__device__ __forceinline__ void transpose_item(const float* W, int N, int K, int k0, int n0, bf16_t* dstrow0, int lane) {
    transpose_half(W, N, K, k0, n0, dstrow0, lane);
    transpose_half(W, N, K, k0, n0 + 32, dstrow0 + (size_t)32 * K, lane);
}
#define CONV_DENSE_ITEMS (832 + 256 + 512 + 48)
__device__ __forceinline__ void conv_dense_item(CParams& P, int it, int lane) {
    unsigned char* ws = P.ws;
    if (it < 832) { const int kb = it / 52, nb = it % 52; transpose_item(P.in[5], INCOLS, DM, kb * 64, nb * 64, (bf16_t*)(ws + WS_WTIN) + (size_t)nb * 64 * DM, lane); return; }
    it -= 832;
    if (it < 256) { const int kb = it / 16, nb = it % 16; transpose_item(P.in[6], DM, DM, kb * 64, nb * 64, (bf16_t*)(ws + WS_WTOUT) + (size_t)nb * 64 * DM, lane); return; }
    it -= 256;
    if (it < 512) { const int kb = it / 32, nb = it % 32, n = nb * 64, half = n >> 10, c = n & 1023, row = (c >> 7) * 256 + half * 128 + (c & 127);
      transpose_item(P.in[27], 2 * DM, DM, kb * 64, n, (bf16_t*)(ws + WS_WTGLU) + (size_t)row * DM, lane); return; }
    it -= 512;
    bf16_t* lrt = (bf16_t*)(ws + WS_LRT);
    if (it < 16) { const int d = it >> 3, nb = it & 7; transpose_item(P.in[10] + (size_t)d * 64 * 512, 512, 64, 0, nb * 64, lrt + ((size_t)d * 512 + nb * 64) * 64, lane); return; }
    it -= 16;
    if (it < 16) { const int d = it >> 3, nb = it & 7; transpose_item(P.in[12] + (size_t)d * 64 * 512, 512, 64, 0, nb * 64, lrt + (size_t)2 * 512 * 64 + ((size_t)d * 512 + nb * 64) * 64, lane); return; }
    it -= 16;
    { const int kb = it >> 3, nb = it & 7; transpose_item(P.in[13], 512, 128, kb * 64, nb * 64, lrt + (size_t)4 * 512 * 64 + (size_t)nb * 64 * 128, lane); }
}
#define CONV_MOE_ITEMS (NEXP * 384)
__device__ __forceinline__ void conv_moe_item(CParams& P, int l, int it, int lane) {
    unsigned char* ws = P.ws;
    const int e = it / 384; int r = it % 384;
    if (r < 256) { const int which = r >> 7; r &= 127; const int kb = r >> 3, nb = r & 7, n = nb * 64, row = (n >> 7) * 256 + which * 128 + (n & 127);
        const float* W = (which ? P.in[33] : P.in[32]) + ((size_t)(l * NEXP + e) * DM) * DFF;
        transpose_item(W, DFF, DM, kb * 64, n, (bf16_t*)(ws + WS_WT13) + ((size_t)e * DM + row) * DM, lane); return; }
    r -= 256;
    { const int kb = r >> 4, nb = r & 15; const float* W = P.in[34] + ((size_t)(l * NEXP + e) * DFF) * DM;
      transpose_item(W, DM, DFF, kb * 64, nb * 64, (bf16_t*)(ws + WS_WT2) + ((size_t)e * DM + nb * 64) * DFF, lane); }
}

template <int MODE>
__device__ __forceinline__ void meta_gemm(const bf16_t* A, const bf16_t* Bt, bf16_t* Hrows, int task, int lane) {
    const int fr = lane & 15, fq = lane >> 4, c = task * 16 + fr;
    const bf16_t* b0 = MODE == 0 ? Bt + (size_t)c * DM : Bt + (size_t)((c >> 7) * 256 + (c & 127)) * DM;
    const bf16_t* b1 = b0 + (size_t)128 * DM;
    f32x4 acc0[2], acc1[2];
    acc0[0] = acc0[1] = acc1[0] = acc1[1] = (f32x4){0.f, 0.f, 0.f, 0.f};
#pragma unroll 4
    for (int kt = 0; kt < 32; ++kt) {
        const int ko = kt * 32 + fq * 8;
        const bf16x8 a0 = *(const bf16x8*)(A + (size_t)fr * DM + ko), a1 = *(const bf16x8*)(A + (size_t)(16 + fr) * DM + ko);
        const bf16x8 bv = *(const bf16x8*)(b0 + ko);
        acc0[0] = __builtin_amdgcn_mfma_f32_16x16x32_bf16(a0, bv, acc0[0], 0, 0, 0);
        acc0[1] = __builtin_amdgcn_mfma_f32_16x16x32_bf16(a1, bv, acc0[1], 0, 0, 0);
        if (MODE == 1) { const bf16x8 bg = *(const bf16x8*)(b1 + ko);
            acc1[0] = __builtin_amdgcn_mfma_f32_16x16x32_bf16(a0, bg, acc1[0], 0, 0, 0);
            acc1[1] = __builtin_amdgcn_mfma_f32_16x16x32_bf16(a1, bg, acc1[1], 0, 0, 0); }
    }
#pragma unroll
    for (int mi = 0; mi < 2; ++mi)
#pragma unroll
        for (int j = 0; j < 4; ++j) { bf16_t* p = Hrows + (size_t)(mi * 16 + fq * 4 + j) * DM + c;
            const float add = MODE == 0 ? acc0[mi][j] : acc0[mi][j] * __builtin_amdgcn_rcpf(1.f + __expf(-acc1[mi][j]));
            *p = (bf16_t)f2bf(bf2f(*p) + add); }
}
__device__ __forceinline__ void phase_0(CParams& P, unsigned char* lds, const int ph) {
    PHASE_PROLOGUE
            for (int row = gw; row < NT; row += NGW) {
                const float* src = row < NMAIN ? x + (size_t)row * DM : meta + (size_t)((row - NMAIN) & 15) * DM;
                f32x4 v[4];
#pragma unroll
                for (int j = 0; j < 4; ++j) { v[j] = ((const f32x4*)src)[lane + 64 * j]; strow_bf16(H + (size_t)row * DM, lane, j, v[j]); }
                store_norm_bf16(v, norm_mix, HN + (size_t)row * DM, lane);
            }
    for (int it = gw; it < CONV_DENSE_ITEMS; it += NGW) conv_dense_item(P, it, lane);
}

__device__ __forceinline__ void phase_1(CParams& P, unsigned char* lds, const int ph) {
    PHASE_PROLOGUE
    pg8::ProjOrder S; S.init(HN, WTIN, bid);
    pg8::EpiProj E{Qb, Kb, Vb, REST};
    pg8::gemm_phase<pg8::EpiProj, pg8::ProjOrder, true, true>((PG8_LAS unsigned char*)lds, DM, S, E);
}

__device__ __forceinline__ void na_units(CParams& P, unsigned char* lds, const int first, const int stride) {
    PHASE_PROLOGUE
    constexpr int KST = 68, VST = 596, NKEY = 592;
    bf16_t* Ks = (bf16_t*)lds;
    bf16_t* VTs = Ks + NKEY * KST;
    float* sb = (float*)(VTs + 64 * VST);
    const bf16_t* VT = Vb;
    const int fr = lane & 15, fq = lane >> 4;
    const f32x4 zero4 = (f32x4){0.f, 0.f, 0.f, 0.f};
    u32x4 kreg[9], vreg[9];
#define NA_BAR() do { asm volatile("s_waitcnt lgkmcnt(0)" ::: "memory"); __builtin_amdgcn_s_barrier(); asm volatile("" ::: "memory"); } while (0)
#define NA_LOAD(u_) do { if ((u_) < 1024) { const int r2_ = ((u_) & 63) * 2, h_ = ((u_) >> 6) & 7, b_ = (u_) >> 9, Rb_ = min(max(r2_ - 4, 0), 120); \
        _Pragma("unroll") for (int q = 0; q < 9; ++q) { const int i = tid + 512 * q, key = i >> 3, pc = (i & 7) * 8; const int kr = min(Rb_ + (key >> 6), 127); \
            kreg[q] = *(const u32x4*)(Kb + ((size_t)b_ * SEQ + kr * 64 + (key & 63)) * 512 + h_ * 64 + pc); } \
        _Pragma("unroll") for (int q = 0; q < 9; ++q) { const int i = tid + 512 * q, dd = i / 72, rem = i - dd * 72, kr9 = rem >> 3, pc = (rem & 7) * 8; const int kr = min(Rb_ + kr9, 127); \
            vreg[q] = *(const u32x4*)(VT + (size_t)(h_ * 64 + dd) * NTP + (size_t)b_ * SEQ + kr * 64 + pc); } } } while (0)
    if (first < 1024 + 16) NA_LOAD(first);
    for (int u = first; u < 1024 + 16; u += stride) {
        const bool metau = u >= 1024;
        int b, h, r2 = 0;
        if (!metau) { r2 = (u & 63) * 2; h = (u >> 6) & 7; b = u >> 9; } else { const int m = u - 1024; b = m >> 3; h = m & 7; }
        const int Rb = min(max(r2 - 4, 0), 120);
        if (!metau) {
            if (tid < 465) sb[tid] = rpb[h * 465 + tid];
#pragma unroll
            for (int q = 0; q < 9; ++q) { const int i = tid + 512 * q, key = i >> 3, pc = (i & 7) * 8; *(u32x4*)(Ks + key * KST + pc) = kreg[q]; }
#pragma unroll
            for (int q = 0; q < 9; ++q) { const int i = tid + 512 * q, dd = i / 72, rem = i - dd * 72, kr9 = rem >> 3, pc = (rem & 7) * 8; *(u32x4*)(VTs + dd * VST + kr9 * 64 + pc) = vreg[q]; }
        }
        for (int i = tid; i < 16 * 8; i += 512) { const int key = i >> 3, pc = (i & 7) * 8;
            *(u32x4*)(Ks + (576 + key) * KST + pc) = *(const u32x4*)(Kb + ((size_t)NMAIN + b * NMETA + key) * 512 + h * 64 + pc); }
        for (int i = tid; i < 64 * 2; i += 512) { const int dd = i >> 1, pc = (i & 1) * 8;
            *(u32x4*)(VTs + dd * VST + 576 + pc) = *(const u32x4*)(VT + (size_t)(h * 64 + dd) * NTP + NMAIN + b * NMETA + pc); }
        if (u + stride < 1024 + 16) NA_LOAD(u + stride);
        NA_BAR();
        if (!metau || wave == 0) {
            const int rr = wave >> 2, qb = wave & 3, r = r2 + rr;
            const int c = qb * 16 + fr;
            const int qrow = metau ? NMAIN + b * NMETA + fr : b * SEQ + r * 64 + c;
            const int R0 = min(max(r - 4, 0), 120), cs = qb == 0 ? 0 : (qb == 1 ? 8 : (qb == 2 ? 24 : 32));
            const int C0 = min(max(c - 8, 0), 48);
            const int ro = R0 - Rb;
            const bf16x8 qf0 = *(const bf16x8*)(Qb + (size_t)qrow * 512 + h * 64 + fq * 8), qf1 = *(const bf16x8*)(Qb + (size_t)qrow * 512 + h * 64 + 32 + fq * 8);
            f32x4 sacc[17];
            if (!metau) {
#pragma unroll
                for (int kt = 0; kt < 16; ++kt) {
                    const bf16_t* kp = Ks + ((ro + (kt >> 1)) * 64 + cs + 16 * (kt & 1) + fr) * KST + fq * 8;
                    f32x4 acc = __builtin_amdgcn_mfma_f32_16x16x32_bf16(*(const bf16x8*)kp, qf0, zero4, 0, 0, 0);
                    sacc[kt] = __builtin_amdgcn_mfma_f32_16x16x32_bf16(*(const bf16x8*)(kp + 32), qf1, acc, 0, 0, 0);
                }
            } else {
#pragma unroll
                for (int kt = 0; kt < 16; ++kt) sacc[kt] = zero4;
            }
            {
                const bf16_t* kp = Ks + (576 + fr) * KST + fq * 8;
                f32x4 acc = __builtin_amdgcn_mfma_f32_16x16x32_bf16(*(const bf16x8*)kp, qf0, zero4, 0, 0, 0);
                sacc[16] = __builtin_amdgcn_mfma_f32_16x16x32_bf16(*(const bf16x8*)(kp + 32), qf1, acc, 0, 0, 0);
            }
            float mx = -1e30f;
#pragma unroll
            for (int kt = 0; kt < 16; ++kt) {
                const int dr = R0 + (kt >> 1) - r + 7;
#pragma unroll
                for (int j = 0; j < 4; ++j) {
                    const int kc = cs + 16 * (kt & 1) + 4 * fq + j;
                    const bool inb = !metau && kc >= C0 && kc < C0 + 16;
                    const int dc = min(max(kc - c + 15, 0), 30);
                    const float bias = sb[dr * 31 + dc];
                    const float sv = sacc[kt][j] * 0.125f + bias;
                    const float s = inb ? sv : -1e30f;
                    sacc[kt][j] = s; mx = fmaxf(mx, s);
                }
            }
#pragma unroll
            for (int j = 0; j < 4; ++j) { const float s = sacc[16][j] * 0.125f; sacc[16][j] = s; mx = fmaxf(mx, s); }
            mx = fmaxf(mx, __shfl_xor(mx, 16)); mx = fmaxf(mx, __shfl_xor(mx, 32));
            float sum = 0.f;
#pragma unroll
            for (int kt = 0; kt < 17; ++kt)
#pragma unroll
                for (int j = 0; j < 4; ++j) { const float pv = __expf(sacc[kt][j] - mx); sacc[kt][j] = pv; sum += pv; }
            sum += __shfl_xor(sum, 16); sum += __shfl_xor(sum, 32);
            f32x4 o[4] = {zero4, zero4, zero4, zero4};
            if (!metau) {
#pragma unroll
                for (int kr = 0; kr < 8; ++kr) {
                    union { bf16x8 v; unsigned u[4]; } bf;
                    bf.u[0] = pk2(sacc[2 * kr][0], sacc[2 * kr][1]); bf.u[1] = pk2(sacc[2 * kr][2], sacc[2 * kr][3]);
                    bf.u[2] = pk2(sacc[2 * kr + 1][0], sacc[2 * kr + 1][1]); bf.u[3] = pk2(sacc[2 * kr + 1][2], sacc[2 * kr + 1][3]);
                    const int tok0 = (ro + kr) * 64 + cs + 4 * fq;
#pragma unroll
                    for (int dt = 0; dt < 4; ++dt) {
                        const bf16_t* vp = VTs + (dt * 16 + fr) * VST + tok0;
                        union { bf16x8 v; u32x2 h2[2]; } af;
                        af.h2[0] = *(const u32x2*)vp; af.h2[1] = *(const u32x2*)(vp + 16);
                        o[dt] = __builtin_amdgcn_mfma_f32_16x16x32_bf16(af.v, bf.v, o[dt], 0, 0, 0);
                    }
                }
            }
            {
                union { bf16x8 v; unsigned u[4]; } bf;
                bf.u[0] = pk2(sacc[16][0], sacc[16][1]); bf.u[1] = pk2(sacc[16][2], sacc[16][3]); bf.u[2] = 0u; bf.u[3] = 0u;
#pragma unroll
                for (int dt = 0; dt < 4; ++dt) {
                    const bf16_t* vp = VTs + (dt * 16 + fr) * VST + 576 + 4 * fq;
                    union { bf16x8 v; u32x2 h2[2]; } af;
                    af.h2[0] = *(const u32x2*)vp; af.h2[1] = (u32x2){0u, 0u};
                    o[dt] = __builtin_amdgcn_mfma_f32_16x16x32_bf16(af.v, bf.v, o[dt], 0, 0, 0);
                }
            }
            const float inv = 1.f / sum;
#pragma unroll
            for (int dt = 0; dt < 4; ++dt) {
                u32x2 ov; ov.x = pk2(o[dt][0] * inv, o[dt][1] * inv); ov.y = pk2(o[dt][2] * inv, o[dt][3] * inv);
                *(u32x2*)(A2 + (size_t)qrow * DM + h * 64 + dt * 16 + 4 * fq) = ov;
            }
        }
        NA_BAR();
    }
#undef NA_LOAD
#undef NA_BAR
}

__device__ __forceinline__ void phase_3(CParams& P, unsigned char* lds, const int ph) {
    PHASE_PROLOGUE
    constexpr int TR = 66, NTILE = (NT + TR - 1) / TR, AST = 264, SST = 136;
    bf16_t* As = (bf16_t*)lds;
    unsigned short* stg = (unsigned short*)(lds + 80 * AST * 2);
    const bf16_t* lrt = (const bf16_t*)(ws + WS_LRT);
    const int fr = lane & 15, fq = lane >> 4;
    for (int u = bid; u < NTILE; u += G) {
        const int r0 = u * TR, nrows = min(TR, NT - r0);
#ifndef PREP_REP1
#define PREP_REP1 1
#endif
        for (int rep1_ = 0; rep1_ < PREP_REP1; ++rep1_)
        for (int rl0 = wave; rl0 < nrows; rl0 += 24) {
            u32x2 vc[3][7], vp[3][7], vn[3][7]; bool okr[3], hp[3], hn[3]; int rows[3];
#pragma unroll
            for (int q = 0; q < 3; ++q) {
                const int rl = rl0 + 8 * q; okr[q] = rl < nrows;
                const int row = okr[q] ? r0 + rl : r0; rows[q] = row;
                int b, pp_;
                if (row < NMAIN) { b = row >> 13; pp_ = (row & (SEQ - 1)) + NMETA; } else { b = (row - NMAIN) >> 4; pp_ = (row - NMAIN) & 15; }
                hp[q] = pp_ > 0; hn[q] = pp_ + 1 < LSEQ;
                const int rowp = hp[q] ? rowof(b, pp_ - 1) : row, rown = hn[q] ? rowof(b, pp_ + 1) : row;
#pragma unroll
                for (int j = 0; j < 7; ++j) { const int c = 4 * lane + 256 * j;
                    vc[q][j] = *(const u32x2*)(REST + (size_t)row * RESTC + c); vp[q][j] = *(const u32x2*)(REST + (size_t)rowp * RESTC + c); vn[q][j] = *(const u32x2*)(REST + (size_t)rown * RESTC + c); }
            }
#pragma unroll
            for (int q = 0; q < 3; ++q) {
                if (okr[q]) {
                    const int row = rows[q], rl = rl0 + 8 * q;
#pragma unroll
                    for (int j = 0; j < 7; ++j) {
                        const int c = 4 * lane + 256 * j;
                        u32x2 a = vp[q][j], bq = vn[q][j]; const u32x2 cc = vc[q][j];
                        if (!hp[q]) { a.x = 0; a.y = 0; }
                        if (!hn[q]) { bq.x = 0; bq.y = 0; }
                        const f32x4 m4 = *(const f32x4*)(mu + c);
                        const float pc[4] = {bflo(cc.x), bfhi(cc.x), bflo(cc.y), bfhi(cc.y)};
                        const float pq[4] = {bflo(a.x), bfhi(a.x), bflo(a.y), bfhi(a.y)};
                        const float pn[4] = {bflo(bq.x), bfhi(bq.x), bflo(bq.y), bfhi(bq.y)};
                        float o[4];
#pragma unroll
                        for (int i = 0; i < 4; ++i) o[i] = pc[i] + m4[i] * (0.5f * (pq[i] + pn[i]) - pc[i]);
                        if (j == 6) {
                            if (lane < 16) { for (int i = 0; i < 4; ++i) o[i] = tanhf(o[i]); }
                            else if (lane >= 32) { for (int i = 0; i < 4; ++i) o[i] = sigmoidf_(o[i]); }
                        }
                        u32x2 ov; ov.x = pk2(o[0], o[1]); ov.y = pk2(o[2], o[3]);
                        if (j < 6) { bf16_t* dst = j < 2 ? Rr + (size_t)row * 512 + c : (j < 4 ? KR + (size_t)row * 512 + (c - 512) : VV + (size_t)row * 512 + (c - 1024)); *(u32x2*)dst = ov; }
                        else *(u32x2*)(As + rl * AST + (c - 1536)) = ov;
                    }
                }
            }
        }
        __syncthreads();
#define P4_LOADB(t_, bv_, bias_) do { const int wh_ = (t_) >> 2, ct_ = (t_) & 3, Kw_ = wh_ < 4 ? 64 : 128, col_ = ct_ * 128 + 16 * wave + fr; \
            const bf16_t* Wt_ = lrt + (wh_ < 4 ? (size_t)wh_ * 512 * 64 : (size_t)4 * 512 * 64) + (size_t)col_ * Kw_ + 8 * fq; \
            bv_[0] = *(const bf16x8*)Wt_; bv_[1] = *(const bf16x8*)(Wt_ + 32); if (wh_ == 4) { bv_[2] = *(const bf16x8*)(Wt_ + 64); bv_[3] = *(const bf16x8*)(Wt_ + 96); } \
            bias_ = wh_ < 2 ? w0[wh_ * 512 + col_] : (wh_ < 4 ? a0[(wh_ - 2) * 512 + col_] : 0.f); } while (0)
        bf16x8 bnx[4], bn2[4]; float biasn, bias2;
        P4_LOADB(0, bnx, biasn); P4_LOADB(1, bn2, bias2);
#ifndef PREP_REP2
#define PREP_REP2 1
#endif
#pragma unroll 1
        for (int t_ = 0; t_ < 20 * PREP_REP2; ++t_) { const int t = t_ % 20;
            const int which = t >> 2, ct = t & 3;
            const int koff = which < 2 ? 0 : (which < 4 ? 64 : 128);
            bf16x8 bcur[4]; bcur[0] = bnx[0]; bcur[1] = bnx[1]; bcur[2] = bnx[2]; bcur[3] = bnx[3];
            const float bias = biasn;
            bnx[0] = bn2[0]; bnx[1] = bn2[1]; bnx[2] = bn2[2]; bnx[3] = bn2[3]; biasn = bias2;
            if (t_ + 2 < 20 * PREP_REP2) P4_LOADB((t + 2) % 20, bn2, bias2);
            const f32x4 zero4 = (f32x4){0.f, 0.f, 0.f, 0.f};
            f32x4 acc[5] = {zero4, zero4, zero4, zero4, zero4};
#pragma unroll
            for (int ks = 0; ks < 4; ++ks) {
                if (ks < 2 || which == 4) {
#pragma unroll
                    for (int rt = 0; rt < 5; ++rt) acc[rt] = __builtin_amdgcn_mfma_f32_16x16x32_bf16(*(const bf16x8*)(As + (16 * rt + fr) * AST + koff + 32 * ks + 8 * fq), bcur[ks], acc[rt], 0, 0, 0);
                }
            }
            unsigned short* sg = stg + (t & 1) * 80 * SST + 16 * wave + fr;
#pragma unroll
            for (int rt = 0; rt < 5; ++rt)
#pragma unroll
                for (int j = 0; j < 4; ++j) { const float val = acc[rt][j] + bias; unsigned short o;
                    if (which < 2) { const _Float16 hv = (_Float16)(-0.6065306597f * sigmoidf_(val)); o = __builtin_bit_cast(unsigned short, hv); }
                    else if (which < 4) o = (unsigned short)f2bf(sigmoidf_(val));
                    else o = (unsigned short)f2bf(val);
                    sg[(16 * rt + 4 * fq + j) * SST] = o; }
            asm volatile("s_waitcnt lgkmcnt(0)" ::: "memory"); __builtin_amdgcn_s_barrier(); asm volatile("" ::: "memory");
            {
                unsigned short* dst = which < 2 ? (unsigned short*)LW + (size_t)which * NT * 512 : (which < 4 ? (unsigned short*)AA + (size_t)(which - 2) * NT * 512 : (unsigned short*)Gg);
                for (int i = tid; i < nrows * 8; i += 512) { const int r = i >> 3, pc = (i & 7) * 16; const unsigned short* sp = stg + (t & 1) * 80 * SST + r * SST + pc;
                    unsigned short* gp = dst + (size_t)(r0 + r) * 512 + ct * 128 + pc; *(u32x4*)gp = *(const u32x4*)sp; *(u32x4*)(gp + 8) = *(const u32x4*)(sp + 8); }
            }
        }
#undef P4_LOADB
        __syncthreads();
#ifndef PREP_REP3
#define PREP_REP3 1
#endif
        for (int rep3_ = 0; rep3_ < PREP_REP3; ++rep3_)
        for (int rl = wave; rl < nrows; rl += 8) {
            const int row = r0 + rl;

                const int c0 = lane * 8;
                const u32x4 krv = *(const u32x4*)(KR + (size_t)row * 512 + c0);
                const u32x4 rv = *(const u32x4*)(Rr + (size_t)row * 512 + c0);
                float kr[8], rr[8], kkv[8];
#pragma unroll
                for (int i = 0; i < 4; ++i) { kr[2 * i] = bflo(krv[i]); kr[2 * i + 1] = bfhi(krv[i]); rr[2 * i] = bflo(rv[i]); rr[2 * i + 1] = bfhi(rv[i]); }
                float ss = 0.f;
#pragma unroll
                for (int i = 0; i < 8; ++i) { kkv[i] = kr[i] * k_k[c0 + i]; ss += kkv[i] * kkv[i]; }
                ss += __shfl_xor(ss, 1); ss += __shfl_xor(ss, 2); ss += __shfl_xor(ss, 4);
                const float inv = 1.f / fmaxf(sqrtf(ss), 1e-12f);
#pragma unroll
                for (int i = 0; i < 8; ++i) kkv[i] *= inv;
                u32x4 o; o.x = pk2(kkv[0], kkv[1]); o.y = pk2(kkv[2], kkv[3]); o.z = pk2(kkv[4], kkv[5]); o.w = pk2(kkv[6], kkv[7]);
                *(u32x4*)(KK + (size_t)row * 512 + c0) = o;
                float bsum = 0.f;
#pragma unroll
                for (int d = 0; d < 2; ++d) {
                    const u32x4 av = *(const u32x4*)(AA + ((size_t)d * NT + row) * 512 + c0);
                    float a[8], kka[8], kd[8];
#pragma unroll
                    for (int i = 0; i < 4; ++i) { a[2 * i] = bflo(av[i]); a[2 * i + 1] = bfhi(av[i]); }
#pragma unroll
                    for (int i = 0; i < 8; ++i) { kka[i] = kkv[i] * a[i]; kd[i] = kr[i] * (1.f + (a[i] - 1.f) * k_a[c0 + i]); bsum += rr[i] * kd[i] * r_k[c0 + i]; }
                    u32x4 o1; o1.x = pk2(kka[0], kka[1]); o1.y = pk2(kka[2], kka[3]); o1.z = pk2(kka[4], kka[5]); o1.w = pk2(kka[6], kka[7]);
                    *(u32x4*)(KKA + ((size_t)d * NT + row) * 512 + c0) = o1;
                    u32x4 o2; o2.x = pk2(kd[0], kd[1]); o2.y = pk2(kd[2], kd[3]); o2.z = pk2(kd[4], kd[5]); o2.w = pk2(kd[6], kd[7]);
                    *(u32x4*)(KD + ((size_t)d * NT + row) * 512 + c0) = o2;
                }
                bsum += __shfl_xor(bsum, 1); bsum += __shfl_xor(bsum, 2); bsum += __shfl_xor(bsum, 4);
                if ((lane & 7) == 0) BC[(size_t)row * 8 + (lane >> 3)] = bsum;
                    }
        __syncthreads();
    }
}

#define RWS 72
__device__ __forceinline__ bf16x8 rw_frag(const bf16_t* M, int row, int kofs) { return *(const bf16x8*)(M + row * RWS + kofs); }
__device__ __forceinline__ f32x4 rw_tile(const bf16_t* Am, int ra, const bf16_t* Bm, int rb, int fr, int fq) {
    f32x4 acc = (f32x4){0.f, 0.f, 0.f, 0.f};
    acc = __builtin_amdgcn_mfma_f32_16x16x32_bf16(rw_frag(Am, ra + fr, 8 * fq), rw_frag(Bm, rb + fr, 8 * fq), acc, 0, 0, 0);
    acc = __builtin_amdgcn_mfma_f32_16x16x32_bf16(rw_frag(Am, ra + fr, 32 + 8 * fq), rw_frag(Bm, rb + fr, 32 + 8 * fq), acc, 0, 0, 0);
    return acc;
}
__device__ __forceinline__ void phase_6(CParams& P, unsigned char* lds, const int ph) {
    PHASE_PROLOGUE
    constexpr int GST = 68, RST = 132;
    float* Gs = (float*)lds;
    bf16_t* A_rm = (bf16_t*)(lds + 64 * GST * 4); bf16_t* R_rm = A_rm + 64 * RWS; bf16_t* B_rm = R_rm + 64 * RWS; bf16_t* K_rm = B_rm + 64 * RWS;
    bf16_t* B_tr = K_rm + 64 * RWS; bf16_t* K_tr = B_tr + 64 * RWS; bf16_t* V_tr = K_tr + 64 * RWS;
    bf16_t* MAK = V_tr + 64 * RWS; bf16_t* MRB = MAK + 64 * RWS; bf16_t* MRK = MRB + 64 * RWS;
    bf16_t* MABr = MRK + 64 * RWS;
    float* RHS = (float*)(MABr + 64 * RWS);
    float* BT = RHS + 64 * RST; float* OFF = BT + 512; float* GC = OFF + 512;
    bf16_t* X1_tr = A_rm; bf16_t* X2_tr = K_rm;
    for (int i = tid; i < 4 * 64 * RWS / 2; i += 512) ((unsigned*)MAK)[i] = 0u;
    __syncthreads();
    const int fr = lane & 15, fq = lane >> 4;
#define RW1_BAR() do { asm volatile("s_waitcnt lgkmcnt(0)" ::: "memory"); __builtin_amdgcn_s_barrier(); asm volatile("" ::: "memory"); } while (0)
    const int t0 = tid & 63, kp = (tid >> 6) * 8;
    u32x4 nlw, nkk, nka, nkd, nrv, nvv;
#define RW1_LOAD(u_) do { const int ch_ = (u_) / RW_NCH, c_ = (u_) - ch_ * RW_NCH, d_ = ch_ >> 4, b_ = (ch_ >> 3) & 1, h_ = ch_ & 7, s_ = c_ * 64 + t0; \
        const int p_ = d_ ? LSEQ - 1 - s_ : s_; const size_t o_ = (size_t)rowof(b_, s_ < LSEQ ? p_ : 0) * 512 + h_ * 64 + kp; \
        nlw = *(const u32x4*)(LW + (size_t)d_ * NT * 512 + o_); nkk = *(const u32x4*)(KK + o_); nka = *(const u32x4*)(KKA + (size_t)d_ * NT * 512 + o_); \
        nkd = *(const u32x4*)(KD + (size_t)d_ * NT * 512 + o_); nrv = *(const u32x4*)(Rr + o_); nvv = *(const u32x4*)(VV + o_); } while (0)
    if (bid < RW_UNITS) RW1_LOAD(bid);
    for (int u = bid; u < RW_UNITS; u += G) {
        const int chain = u / RW_NCH, c = u - chain * RW_NCH;
        float lw[8], kk[8], ka[8], kd[8], rr[8]; u32x4 vv;
        {
            const bool valid = c * 64 + t0 < LSEQ;
            vv = nvv;
#pragma unroll
            for (int i = 0; i < 4; ++i) {
                union { unsigned u; _Float16 hh[2]; } cv; cv.u = nlw[i];
                lw[2 * i] = valid ? (float)cv.hh[0] : 0.f; lw[2 * i + 1] = valid ? (float)cv.hh[1] : 0.f;
                kk[2 * i] = valid ? bflo(nkk[i]) : 0.f; kk[2 * i + 1] = valid ? bfhi(nkk[i]) : 0.f;
                ka[2 * i] = valid ? bflo(nka[i]) : 0.f; ka[2 * i + 1] = valid ? bfhi(nka[i]) : 0.f;
                kd[2 * i] = valid ? bflo(nkd[i]) : 0.f; kd[2 * i + 1] = valid ? bfhi(nkd[i]) : 0.f;
                rr[2 * i] = valid ? bflo(nrv[i]) : 0.f; rr[2 * i + 1] = valid ? bfhi(nrv[i]) : 0.f;
                if (!valid) vv[i] = 0u;
            }
        }
        if (u + G < RW_UNITS) RW1_LOAD(u + G);
        float gg_[8];
#pragma unroll
        for (int i = 0; i < 8; ++i) {
            float v = lw[i];
            v += __int_as_float(__builtin_amdgcn_update_dpp(0, __float_as_int(v), 0x111, 0xF, 0xF, false));
            v += __int_as_float(__builtin_amdgcn_update_dpp(0, __float_as_int(v), 0x112, 0xF, 0xF, false));
            v += __int_as_float(__builtin_amdgcn_update_dpp(0, __float_as_int(v), 0x114, 0xF, 0xF, false));
            v += __int_as_float(__builtin_amdgcn_update_dpp(0, __float_as_int(v), 0x118, 0xF, 0xF, false));
            v += __int_as_float(__builtin_amdgcn_update_dpp(0, __float_as_int(v), 0x142, 0xA, 0xF, false));
            v += __int_as_float(__builtin_amdgcn_update_dpp(0, __float_as_int(v), 0x143, 0xC, 0xF, false));
            gg_[i] = v;
        }
#ifndef RW1_REP0
#define RW1_REP0 1
#endif
        for (int rep0_ = 0; rep0_ < RW1_REP0; ++rep0_) {
        {
            float va[8], vr[8], vb[8], vk[8];
#pragma unroll
            for (int i = 0; i < 8; ++i) {
                const float g = gg_[i];
                const float eg = __expf(g), egm1 = __expf(g - lw[i]), einv = __expf(-g);
                va[i] = kk[i] * egm1; vr[i] = rr[i] * eg; vb[i] = ka[i] * einv; vk[i] = kd[i] * einv;
                if (t0 == 63) GC[kp + i] = eg;
            }
            *(f32x4*)(RHS + t0 * RST + kp) = (f32x4){va[0], va[1], va[2], va[3]}; *(f32x4*)(RHS + t0 * RST + kp + 4) = (f32x4){va[4], va[5], va[6], va[7]};
            u32x4 w4;
            w4.x = pk2(va[0], va[1]); w4.y = pk2(va[2], va[3]); w4.z = pk2(va[4], va[5]); w4.w = pk2(va[6], va[7]); *(u32x4*)(A_rm + t0 * RWS + kp) = w4;
            w4.x = pk2(vr[0], vr[1]); w4.y = pk2(vr[2], vr[3]); w4.z = pk2(vr[4], vr[5]); w4.w = pk2(vr[6], vr[7]); *(u32x4*)(R_rm + t0 * RWS + kp) = w4;
            w4.x = pk2(vb[0], vb[1]); w4.y = pk2(vb[2], vb[3]); w4.z = pk2(vb[4], vb[5]); w4.w = pk2(vb[6], vb[7]); *(u32x4*)(B_rm + t0 * RWS + kp) = w4;
            w4.x = pk2(vk[0], vk[1]); w4.y = pk2(vk[2], vk[3]); w4.z = pk2(vk[4], vk[5]); w4.w = pk2(vk[6], vk[7]); *(u32x4*)(K_rm + t0 * RWS + kp) = w4;
#pragma unroll
            for (int i = 0; i < 8; ++i) { B_tr[(kp + i) * RWS + t0] = (bf16_t)f2bf(vb[i]); K_tr[(kp + i) * RWS + t0] = (bf16_t)f2bf(vk[i]);
                V_tr[(kp + i) * RWS + t0] = (bf16_t)((i & 1) ? (vv[i >> 1] >> 16) : (vv[i >> 1] & 0xffffu)); }
        }
        RW1_BAR();
        }
        float* DQ = Gs; bf16_t* TB = (bf16_t*)BT;
#ifndef RW1_REP1
#define RW1_REP1 1
#endif
#pragma unroll
        for (int s1 = 0; s1 < 5; ++s1) { const int q = wave + 8 * s1;
            const int m = q / 10, e = q - m * 10, ti = e >= 6 ? 3 : (e >= 3 ? 2 : (e >= 1 ? 1 : 0)), tj = e - (ti * (ti + 1)) / 2;
            const f32x4 acc = rw_tile(m < 2 ? A_rm : R_rm, 16 * ti, (m & 1) ? K_rm : B_rm, 16 * tj, fr, fq);
            bf16_t* Mm = m == 1 ? MAK : (m == 2 ? MRB : MRK);
#pragma unroll
            for (int j = 0; j < 4; ++j) { const int t = 16 * ti + 4 * fq + j, i = 16 * tj + fr; const bool keep = m < 2 ? (i < t) : (i <= t); const float val = keep ? acc[j] : 0.f;
                if (m == 0) { MABr[t * RWS + i] = (bf16_t)f2bf(val); if (ti == tj) DQ[((ti * 16 + (t & 15)) * 4 + (fr & 3)) * 4 + (fr >> 2)] = val; }
                else Mm[t * RWS + i] = (bf16_t)f2bf(val); }
        }
        RW1_BAR();
#ifndef RW1_REP23
#define RW1_REP23 1
#endif
        for (int rep23_ = 0; rep23_ < RW1_REP23; ++rep23_) {
        if (wave >= 4) {
            for (int q = wave - 4; q < 16; q += 4) { const int ti = q >> 2, tv = q & 3; const f32x4 acc = rw_tile(MAK, 16 * ti, V_tr, 16 * tv, fr, fq);
#pragma unroll
                for (int j = 0; j < 4; ++j) RHS[(16 * ti + 4 * fq + j) * RST + 64 + 16 * tv + fr] = acc[j]; }
        } else {
            const int bb = wave, cc = lane >> 2, q = lane & 3;
            float xs[4] = {0.f, 0.f, 0.f, 0.f};
#pragma unroll
            for (int tl = 0; tl < 16; ++tl) {
                const f32x4 mv = *(const f32x4*)(DQ + ((bb * 16 + tl) * 4 + q) * 4);
                float part = mv[0] * xs[0] + mv[1] * xs[1] + mv[2] * xs[2] + mv[3] * xs[3];
                part += dppf<0xB1>(part); part += dppf<0x4E>(part);
                const float xt = (tl == cc ? 1.f : 0.f) - part;
                xs[tl >> 2] = (tl & 3) == q ? xt : xs[tl >> 2];
            }
#pragma unroll
            for (int m = 0; m < 4; ++m) TB[(bb * 16 + 4 * m + q) * 16 + cc] = (bf16_t)f2bf(xs[m]);
        }
        RW1_BAR();
        {
            const int c0 = 16 * wave;
            f32x4 X[4];
            const f32x4 zero4 = (f32x4){0.f, 0.f, 0.f, 0.f};
#define RW1_PACK(lo_, hi_, v_) do { union { bf16x8 v; unsigned u[4]; } t_; t_.u[0] = pk2(lo_[0], lo_[1]); t_.u[1] = pk2(lo_[2], lo_[3]); t_.u[2] = pk2(hi_[0], hi_[1]); t_.u[3] = pk2(hi_[2], hi_[3]); v_ = t_.v; } while (0)
#define RW1_LDA(base_, row0_, ca_, cb_, useb_, v_) do { union { bf16x8 v; u32x2 h2[2]; } t_; t_.h2[0] = *(const u32x2*)((base_) + ((row0_) + fr) * RWS + (ca_) + 4 * fq); \
            t_.h2[1] = (useb_) ? *(const u32x2*)((base_) + ((row0_) + fr) * RWS + (cb_) + 4 * fq) : (u32x2){0u, 0u}; v_ = t_.v; } while (0)
#pragma unroll
            for (int bq = 0; bq < 4; ++bq) {
                f32x4 acc;
#pragma unroll
                for (int j = 0; j < 4; ++j) acc[j] = -RHS[(16 * bq + 4 * fq + j) * RST + c0 + fr];
                bf16x8 af, bfv;
                if (bq >= 1) { RW1_LDA(MABr, 16 * bq, 0, 16, bq >= 2, af); if (bq >= 2) RW1_PACK(X[0], X[1], bfv); else RW1_PACK(X[0], zero4, bfv);
                    acc = __builtin_amdgcn_mfma_f32_16x16x32_bf16(af, bfv, acc, 0, 0, 0); }
                if (bq == 3) { RW1_LDA(MABr, 48, 32, 0, false, af); RW1_PACK(X[2], zero4, bfv); acc = __builtin_amdgcn_mfma_f32_16x16x32_bf16(af, bfv, acc, 0, 0, 0); }
                const f32x4 wv = (f32x4){-acc[0], -acc[1], -acc[2], -acc[3]};
                { union { bf16x8 v; u32x2 h2[2]; } t_; t_.h2[0] = *(const u32x2*)(TB + (bq * 16 + fr) * 16 + 4 * fq); t_.h2[1] = (u32x2){0u, 0u}; af = t_.v; }
                RW1_PACK(wv, zero4, bfv);
                X[bq] = __builtin_amdgcn_mfma_f32_16x16x32_bf16(af, bfv, zero4, 0, 0, 0);
                bf16_t* Xm = (wave < 4 ? X1_tr : X2_tr) + ((c0 & 63) + fr) * RWS + 16 * bq + 4 * fq;
                u32x2 o; o.x = pk2(X[bq][0], X[bq][1]); o.y = pk2(X[bq][2], X[bq][3]);
                *(u32x2*)Xm = o;
            }
#undef RW1_PACK
#undef RW1_LDA
        }
        RW1_BAR();
        }
#pragma unroll
        for (int s5 = 0; s5 < 2; ++s5) {
            const int tile = wave * 2 + s5, ta = tile >> 2, tb = tile & 3;
            u32x2 o;
            {
                const f32x4 acc = rw_tile(X1_tr, 16 * ta, B_tr, 16 * tb, fr, fq);
                const int k = 16 * tb + fr, kq = 16 * ta + 4 * fq; const float gc = GC[k];
                float v[4];
#pragma unroll
                for (int j = 0; j < 4; ++j) v[j] = gc * ((kq + j == k ? 1.f : 0.f) - acc[j]);
                o.x = pk2(v[0], v[1]); o.y = pk2(v[2], v[3]);
                *(u32x2*)(PP + (size_t)u * 4096 + k * 64 + 32 * (ta >> 1) + 8 * fq + 4 * (ta & 1)) = o;
            }
            {
                const f32x4 acc = rw_tile(X1_tr, 16 * ta, MRB, 16 * tb, fr, fq);
                const int t = 16 * tb + fr, k0 = 16 * ta + 4 * fq;
                const u32x2 rv = *(const u32x2*)(R_rm + t * RWS + k0);
                o.x = pk2(bflo(rv.x) - acc[0], bfhi(rv.x) - acc[1]); o.y = pk2(bflo(rv.y) - acc[2], bfhi(rv.y) - acc[3]);
                *(u32x2*)(YT + (size_t)u * 4096 + t * 64 + 32 * (ta >> 1) + 8 * fq + 4 * (ta & 1)) = o;
            }
            {
                const f32x4 a1 = rw_tile(K_tr, 16 * ta, V_tr, 16 * tb, fr, fq), a2 = rw_tile(B_tr, 16 * ta, X2_tr, 16 * tb, fr, fq);
                const int v_ = 16 * tb + fr, k0 = 16 * ta + 4 * fq;
                const f32x4 gc = *(const f32x4*)(GC + k0);
                o.x = pk2(gc[0] * (a1[0] - a2[0]), gc[1] * (a1[1] - a2[1])); o.y = pk2(gc[2] * (a1[2] - a2[2]), gc[3] * (a1[3] - a2[3]));
                *(u32x2*)(QT + (size_t)u * 4096 + v_ * 64 + k0) = o;
            }
            {
                const f32x4 a1 = rw_tile(MRK, 16 * ta, V_tr, 16 * tb, fr, fq), a2 = rw_tile(MRB, 16 * ta, X2_tr, 16 * tb, fr, fq);
                const int v_ = 16 * tb + fr, t0_ = 16 * ta + 4 * fq;
                o.x = pk2(a1[0] - a2[0], a1[1] - a2[1]); o.y = pk2(a1[2] - a2[2], a1[3] - a2[3]);
                *(u32x2*)(ZT + (size_t)u * 4096 + v_ * 64 + t0_) = o;
            }
        }
        RW1_BAR();
    }
#undef RW1_LOAD
#undef RW1_BAR
}

__device__ __forceinline__ void s5_setup_units(CParams& P, unsigned char* lds, const int first, const int stride) {
    PHASE_PROLOGUE
    float* pwr = (float*)lds; float* pwi = pwr + 2176; float* bbr = pwi + 2176; float* bbi = bbr + 2048; float* ccr = bbi + 2048; float* cci = ccr + 2048; float* kf = cci + 2048; float* kb = kf + 4096;
    for (int gu = first; gu < 256; gu += stride) {
        const int g = gu >> 2, part = gu & 3;
        if (tid < 128) {
            const int d = tid >> 6, p = tid & 63;
            const float step = __expf(s5_ls[d * 64 + g]);
            const float lr = s5_lre[(d * 64 + g) * 64 + p], li = s5_lim[(d * 64 + g) * 64 + p];
            const float mag = expf(lr * step);
            const float abr = mag * cosf(li * step), abi = mag * sinf(li * step);
            const float den = lr * lr + li * li;
            const float zr = ((abr - 1.f) * lr + abi * li) / den, zi = (abi * lr - (abr - 1.f) * li) / den;
            float pr = 1.f, pi = 0.f;
            for (int t = 0; t < 17; ++t) { pwr[(d * 64 + p) * 17 + t] = pr; pwi[(d * 64 + p) * 17 + t] = pi; const float nr = pr * abr - pi * abi; pi = pr * abi + pi * abr; pr = nr; }
            for (int i = 0; i < 16; ++i) { const float br = s5_b_re[((size_t)(g * 64 + p)) * 16 + i], bi = s5_b_im[((size_t)(g * 64 + p)) * 16 + i];
                bbr[(d * 64 + p) * 16 + i] = zr * br - zi * bi; bbi[(d * 64 + p) * 16 + i] = zr * bi + zi * br; }
        }
        for (int idx = tid; idx < 2048; idx += 512) { const int d = idx >> 10, i = (idx >> 6) & 15, p = idx & 63;
            ccr[(d * 64 + p) * 16 + i] = s5_c_re[((size_t)(d * 64 + g) * 16 + i) * 64 + p]; cci[(d * 64 + p) * 16 + i] = s5_c_im[((size_t)(d * 64 + g) * 16 + i) * 64 + p]; }
        __syncthreads();
        {
            const int d = tid >> 8, tau = (tid >> 4) & 15, i = tid & 15;
            float acc[16];
#pragma unroll
            for (int q = 0; q < 16; ++q) acc[q] = 0.f;
            for (int p = 0; p < 64; ++p) {
                const float cr = ccr[(d * 64 + p) * 16 + i], ci = cci[(d * 64 + p) * 16 + i], pr = pwr[(d * 64 + p) * 17 + tau], pi = pwi[(d * 64 + p) * 17 + tau];
                const float xr = cr * pr - ci * pi, xi = cr * pi + ci * pr;
#pragma unroll
                for (int q = 0; q < 16; ++q) acc[q] += xr * bbr[(d * 64 + p) * 16 + q] - xi * bbi[(d * 64 + p) * 16 + q];
            }
            float* kt = (d ? kb : kf) + (tau * 16 + i) * 16;
#pragma unroll
            for (int q = 0; q < 16; ++q) kt[q] = acc[q];
        }
        __syncthreads();
        unsigned* bta = (unsigned*)(BTA + (size_t)g * 512 * 256);
        for (int idx = part * 128 * 128 + tid; idx < (part + 1) * 128 * 128; idx += 512) {
            const int row = idx >> 7, col = (idx & 127) * 2;
            float v[2];
#pragma unroll
            for (int e = 0; e < 2; ++e) {
                const int cc_ = col + e, j = cc_ >> 4, ip = cc_ & 15;
                if (row < 256) { const int t = row >> 4, i = row & 15;
                    v[e] = j < t ? kf[((t - j) * 16 + i) * 16 + ip] : (j > t ? kb[((j - t) * 16 + i) * 16 + ip] : kf[i * 16 + ip] + kb[i * 16 + ip]); }
                else { const int kp = row - 256, d = kp >> 7, part = (kp >> 6) & 1, p = kp & 63, tau = d == 0 ? 15 - j : j;
                    const float pr = pwr[(d * 64 + p) * 17 + tau], pi = pwi[(d * 64 + p) * 17 + tau], br = bbr[(d * 64 + p) * 16 + ip], bi = bbi[(d * 64 + p) * 16 + ip];
                    v[e] = part ? pr * bi + pi * br : pr * br - pi * bi; }
            }
            bta[idx] = pk2(v[0], v[1]);
        }
        unsigned* btc = (unsigned*)(BTC + (size_t)g * 256 * 256);
        for (int idx = part * 64 * 128 + tid; idx < (part + 1) * 64 * 128; idx += 512) {
            const int row = idx >> 7, col = (idx & 127) * 2, t = row >> 4, i = row & 15;
            float v[2];
#pragma unroll
            for (int e = 0; e < 2; ++e) {
                const int k = col + e, d = k >> 7, part = (k >> 6) & 1, p = k & 63, tau = d == 0 ? t + 1 : 16 - t;
                const float cr = ccr[(d * 64 + p) * 16 + i], ci = cci[(d * 64 + p) * 16 + i], pr = pwr[(d * 64 + p) * 17 + tau], pi = pwi[(d * 64 + p) * 17 + tau];
                v[e] = part ? -(cr * pi + ci * pr) : cr * pr - ci * pi;
            }
            btc[idx] = pk2(v[0], v[1]);
        }
        __syncthreads();
    }
}

__device__ __forceinline__ void phase_60(CParams& P, unsigned char* lds, const int ph) {
    PHASE_PROLOGUE
    if (bid < 32) {
        const int chain = bid, d = chain >> 4, b = (chain >> 3) & 1, h = chain & 7;
        const int fr = lane & 15, fq = lane >> 4;
        constexpr int MATB = 64 * RWS * 2, SLOT = 4 * MATB;
        bf16_t* ybuf = (bf16_t*)(lds + 3 * SLOT);
        const bool comp = wave < 4; const int vb = wave & 3, lm = wave & 3;
        const unsigned char* src = (const unsigned char*)(lm == 0 ? PP : (lm == 1 ? YT : (lm == 2 ? QT : ZT))) + (size_t)chain * RW_NCH * 8192 + lane * 16;
        u32x4 R0[8], R1[8], R2[8];
#define RW2_LD(Rx, c_) do { _Pragma("unroll") for (int i_ = 0; i_ < 8; ++i_) Rx[i_] = *(const u32x4*)(src + (size_t)(c_) * 8192 + i_ * 1024); } while (0)
#define RW2_ST(Rx, c_) do { unsigned char* dst_ = lds + ((c_) % 3) * SLOT + lm * MATB; _Pragma("unroll") for (int i_ = 0; i_ < 8; ++i_) { const int p_ = lane + 64 * i_; *(u32x4*)(dst_ + (p_ >> 3) * (RWS * 2) + (p_ & 7) * 16) = Rx[i_]; } } while (0)
#define RW2_FLUSH(c_) do { const int tl_ = 16 * lm + (lane >> 2), s_ = (c_) * 64 + tl_; const bf16_t* yb_ = ybuf + ((c_) & 1) * 64 * RWS + tl_ * RWS + 16 * (lane & 3); \
            const u32x4 y0_ = *(const u32x4*)yb_, y1_ = *(const u32x4*)(yb_ + 8); \
            if (s_ < LSEQ) { const int p_ = d ? LSEQ - 1 - s_ : s_; bf16_t* g_ = YFB + ((size_t)d * NT + rowof(b, p_)) * 512 + h * 64 + 16 * (lane & 3); *(u32x4*)g_ = y0_; *(u32x4*)(g_ + 8) = y1_; } } while (0)
        const f32x4 zero4 = (f32x4){0.f, 0.f, 0.f, 0.f};
        f32x4 S[4] = {zero4, zero4, zero4, zero4};
#define RW2_COMPUTE(c_) do { const bf16_t* sl_ = (const bf16_t*)(lds + ((c_) % 3) * SLOT); const bf16_t* sP = sl_; const bf16_t* sY = sl_ + 64 * RWS; const bf16_t* sQ = sl_ + 2 * 64 * RWS; const bf16_t* sZ = sl_ + 3 * 64 * RWS; \
            bf16_t* yo_ = ybuf + ((c_) & 1) * 64 * RWS + 16 * vb + fr; \
            union { bf16x8 v; unsigned u[4]; } bs[2]; \
            _Pragma("unroll") for (int ks = 0; ks < 2; ++ks) { bs[ks].u[0] = pk2(S[2 * ks][0], S[2 * ks][1]); bs[ks].u[1] = pk2(S[2 * ks][2], S[2 * ks][3]); \
                bs[ks].u[2] = pk2(S[2 * ks + 1][0], S[2 * ks + 1][1]); bs[ks].u[3] = pk2(S[2 * ks + 1][2], S[2 * ks + 1][3]); } \
            _Pragma("unroll") for (int tt = 0; tt < 4; ++tt) { \
                const u32x2 z2 = *(const u32x2*)(sZ + (16 * vb + fr) * RWS + 16 * tt + 4 * fq); \
                f32x4 acc = (f32x4){bflo(z2.x), bfhi(z2.x), bflo(z2.y), bfhi(z2.y)}; \
                acc = __builtin_amdgcn_mfma_f32_16x16x32_bf16(*(const bf16x8*)(sY + (16 * tt + fr) * RWS + 8 * fq), bs[0].v, acc, 0, 0, 0); \
                acc = __builtin_amdgcn_mfma_f32_16x16x32_bf16(*(const bf16x8*)(sY + (16 * tt + fr) * RWS + 32 + 8 * fq), bs[1].v, acc, 0, 0, 0); \
                _Pragma("unroll") for (int j = 0; j < 4; ++j) yo_[(16 * tt + 4 * fq + j) * RWS] = (bf16_t)f2bf(acc[j]); } \
            f32x4 Sn[4]; \
            _Pragma("unroll") for (int kt = 0; kt < 4; ++kt) { \
                const u32x2 q2 = *(const u32x2*)(sQ + (16 * vb + fr) * RWS + 16 * kt + 4 * fq); \
                f32x4 acc = (f32x4){bflo(q2.x), bfhi(q2.x), bflo(q2.y), bfhi(q2.y)}; \
                acc = __builtin_amdgcn_mfma_f32_16x16x32_bf16(*(const bf16x8*)(sP + (16 * kt + fr) * RWS + 8 * fq), bs[0].v, acc, 0, 0, 0); \
                acc = __builtin_amdgcn_mfma_f32_16x16x32_bf16(*(const bf16x8*)(sP + (16 * kt + fr) * RWS + 32 + 8 * fq), bs[1].v, acc, 0, 0, 0); \
                Sn[kt] = acc; } \
            _Pragma("unroll") for (int kt = 0; kt < 4; ++kt) S[kt] = Sn[kt]; } while (0)
#define RW2_BAR() do { asm volatile("s_waitcnt lgkmcnt(0)" ::: "memory"); __builtin_amdgcn_s_barrier(); asm volatile("" ::: "memory"); } while (0)
        if (!comp) { RW2_LD(R0, 0); RW2_ST(R0, 0); RW2_LD(R0, 1); RW2_LD(R1, 2); RW2_LD(R2, 3); }
        __syncthreads();
        for (int c = 0; c < RW_NCH; c += 3) {
            if (!comp) { if (c + 1 < RW_NCH) RW2_ST(R0, c + 1); if (c + 4 < RW_NCH) RW2_LD(R0, c + 4); if (c > 0) RW2_FLUSH(c - 1); } else RW2_COMPUTE(c);
            RW2_BAR();
            if (!comp) { if (c + 2 < RW_NCH) RW2_ST(R1, c + 2); if (c + 5 < RW_NCH) RW2_LD(R1, c + 5); RW2_FLUSH(c); } else RW2_COMPUTE(c + 1);
            RW2_BAR();
            if (!comp) { if (c + 3 < RW_NCH) RW2_ST(R2, c + 3); if (c + 6 < RW_NCH) RW2_LD(R2, c + 6); RW2_FLUSH(c + 1); } else RW2_COMPUTE(c + 2);
            RW2_BAR();
        }
        if (!comp) RW2_FLUSH(RW_NCH - 1);
#undef RW2_LD
#undef RW2_ST
#undef RW2_FLUSH
#undef RW2_COMPUTE
#undef RW2_BAR
    } else {
        na_units(P, lds, bid - 32, G - 32);
        s5_setup_units(P, lds, bid - 32, G - 32);
    }
}

__device__ __forceinline__ void phase_7(CParams& P, unsigned char* lds, const int ph) {
    PHASE_PROLOGUE
            for (int row = gw; row < NT; row += NGW) {
                const int c0 = lane * 8;
                const u32x4 yf = *(const u32x4*)(YFB + (size_t)row * 512 + c0);
                const u32x4 yb = *(const u32x4*)(YFB + ((size_t)NT + row) * 512 + c0);
                const u32x4 vv = *(const u32x4*)(VV + (size_t)row * 512 + c0);
                const u32x4 gg = *(const u32x4*)(Gg + (size_t)row * 512 + c0);
                float y[8], v[8], g[8];
#pragma unroll
                for (int i = 0; i < 4; ++i) { y[2 * i] = bflo(yf[i]) + bflo(yb[i]); y[2 * i + 1] = bfhi(yf[i]) + bfhi(yb[i]); v[2 * i] = bflo(vv[i]); v[2 * i + 1] = bfhi(vv[i]); g[2 * i] = bflo(gg[i]); g[2 * i + 1] = bfhi(gg[i]); }
                float sm = 0.f;
#pragma unroll
                for (int i = 0; i < 8; ++i) sm += y[i];
                sm += __shfl_xor(sm, 1); sm += __shfl_xor(sm, 2); sm += __shfl_xor(sm, 4);
                const float mean = sm * (1.f / 64.f);
                float vr = 0.f;
#pragma unroll
                for (int i = 0; i < 8; ++i) { const float dlt = y[i] - mean; vr += dlt * dlt; }
                vr += __shfl_xor(vr, 1); vr += __shfl_xor(vr, 2); vr += __shfl_xor(vr, 4);
                const float rstd = rsqrtf(vr * (1.f / 64.f) + 64e-5f);
                const float bc = BC[(size_t)row * 8 + (lane >> 3)];
                float o[8];
#pragma unroll
                for (int i = 0; i < 8; ++i) o[i] = ((y[i] - mean) * rstd * lnx_g[c0 + i] + lnx_b[c0 + i] + bc * v[i]) * g[i];
                u32x4 ov; ov.x = pk2(o[0], o[1]); ov.y = pk2(o[2], o[3]); ov.z = pk2(o[4], o[5]); ov.w = pk2(o[6], o[7]);
                *(u32x4*)(A2 + (size_t)row * DM + 512 + c0) = ov;
            }
}


__device__ __forceinline__ void phase_8(CParams& P, unsigned char* lds, const int ph) {
    PHASE_PROLOGUE
    if (gw < 64) meta_gemm<0>(A2 + (size_t)NMAIN * DM, WTOUT, H + (size_t)NMAIN * DM, gw, lane);
    pg8::DenseOrder S; S.init(A2, WTOUT, NMAIN, DM, DM, G, bid);
    pg8::EpiResidual E{H};
    pg8::gemm_phase<pg8::EpiResidual, pg8::DenseOrder, true, true>((PG8_LAS unsigned char*)lds, DM, S, E);
}

__device__ __forceinline__ void phase_9(CParams& P, unsigned char* lds, const int ph) {
    PHASE_PROLOGUE
            const int l = ph == 9 ? 0 : 1;
                    for (int i = bid * 512 + tid; i < MOE_MAXROWS; i += G * 512) ROWTOK[i] = 0;
    unsigned* cnt = CTL + CW_CNT(l);
            const float* wg = moe_wg + (size_t)l * DM * 4; const float* bg = moe_bg + l * 4;
            for (int row = bid * 3 + wave; wave < 3 && row < NT; row += G * 3) {
                f32x4 v[4]; float ss = 0.f;
#pragma unroll
                for (int j = 0; j < 4; ++j) { v[j] = ldrow_bf16(H + (size_t)row * DM, lane, j); ss += v[j][0] * v[j][0] + v[j][1] * v[j][1] + v[j][2] * v[j][2] + v[j][3] * v[j][3]; }
                ss = wave_sum(ss);
                const float rstd = rsqrtf(ss * (1.f / DM) + 1e-6f);
                float lg[4] = {0.f, 0.f, 0.f, 0.f};
#pragma unroll
                for (int j = 0; j < 4; ++j) {
                    const f32x4 g = ((const f32x4*)(norm_ffn + l * DM))[lane + 64 * j];
#pragma unroll
                    for (int i = 0; i < 4; ++i) v[j][i] = v[j][i] * rstd * g[i];
                    u32x2 o; o.x = pk2(v[j][0], v[j][1]); o.y = pk2(v[j][2], v[j][3]);
                    ((u32x2*)(HN + (size_t)row * DM))[lane + 64 * j] = o;
#pragma unroll
                    for (int i = 0; i < 4; ++i) { const f32x4 w = *(const f32x4*)(wg + (size_t)(4 * (lane + 64 * j) + i) * 4);
                        lg[0] += v[j][i] * w[0]; lg[1] += v[j][i] * w[1]; lg[2] += v[j][i] * w[2]; lg[3] += v[j][i] * w[3]; }
                }
#pragma unroll
                for (int q = 0; q < 4; ++q) lg[q] = wave_sum(lg[q]) + bg[q];
                int grp = 0; float mx = lg[0];
#pragma unroll
                for (int q = 1; q < 4; ++q) if (lg[q] > mx) { mx = lg[q]; grp = q; }
                float den = 0.f;
#pragma unroll
                for (int q = 0; q < 4; ++q) den += __expf(lg[q] - mx);
                const float pgrp = 1.f / den;
                const float* we = moe_we + ((size_t)(l * 4 + grp) * DM) * 8;
                float le[8] = {0.f, 0.f, 0.f, 0.f, 0.f, 0.f, 0.f, 0.f};
#pragma unroll
                for (int j = 0; j < 4; ++j)
#pragma unroll
                    for (int i = 0; i < 4; ++i) { const float* wr_ = we + (size_t)(4 * (lane + 64 * j) + i) * 8; const f32x4 wa = *(const f32x4*)wr_, wb = *(const f32x4*)(wr_ + 4);
                        le[0] += v[j][i] * wa[0]; le[1] += v[j][i] * wa[1]; le[2] += v[j][i] * wa[2]; le[3] += v[j][i] * wa[3];
                        le[4] += v[j][i] * wb[0]; le[5] += v[j][i] * wb[1]; le[6] += v[j][i] * wb[2]; le[7] += v[j][i] * wb[3]; }
#pragma unroll
                for (int q = 0; q < 8; ++q) le[q] = wave_sum(le[q]) + moe_be[(l * 4 + grp) * 8 + q];
                int i1 = 0; float m1 = le[0];
#pragma unroll
                for (int q = 1; q < 8; ++q) if (le[q] > m1) { m1 = le[q]; i1 = q; }
                int i2 = (i1 + 1) & 7; float m2 = -3.0e38f;
#pragma unroll
                for (int q = 0; q < 8; ++q) if (q != i1 && le[q] > m2) { m2 = le[q]; i2 = q; }
                const float e2 = __expf(m2 - m1);
                const float g1 = pgrp / (1.f + e2), g2 = pgrp * e2 / (1.f + e2);
                if (lane == 0) {
                    const int ea = grp * 8 + i1, eb = grp * 8 + i2;
                    const unsigned pa = atomicAdd(cnt + ea, 1u), pb = atomicAdd(cnt + eb, 1u);
                    EID[row * 2] = ea; EID[row * 2 + 1] = eb; POS[row * 2] = (int)pa; POS[row * 2 + 1] = (int)pb;
                    GATE[row * 2] = g1; GATE[row * 2 + 1] = g2;
                }
            }
    if (wave >= 3) { for (int it = bid * 5 + wave - 3; it < CONV_MOE_ITEMS; it += G * 5) conv_moe_item(P, l, it, lane); }
}


__device__ __forceinline__ void phase_10(CParams& P, unsigned char* lds, const int ph) {
    PHASE_PROLOGUE
    const int l = ph == 10 ? 0 : 1;
    int* ps = (int*)(lds + LDS_TAB);
    if (tid == 0) { int acc_ = 0; for (int e = 0; e < NEXP; ++e) { ps[e] = acc_; const int c = (int)CTL[CW_CNT(l) + e]; acc_ += (c + MOE_RT - 1) / MOE_RT * MOE_RT; } ps[NEXP] = acc_; }
    __syncthreads();
    for (int i = bid * 512 + tid; i < NT * 2; i += G * 512) { const int dest = ps[EID[i]] + POS[i]; DEST[i] = dest; ROWTOK[dest] = i >> 1; }
    __syncthreads();
}

__device__ __forceinline__ void phase_11(CParams& P, unsigned char* lds, const int ph) {
    PHASE_PROLOGUE
    const int l = ph == 11 ? 0 : 1;
    int* et = (int*)(lds + LDS_TAB);
    if (tid == 0) { int acc_ = 0; for (int e = 0; e < NEXP; ++e) { const int c = (int)CTL[CW_CNT(l) + e], n = (c + MOE_RT - 1) / MOE_RT; for (int q = 0; q < n; ++q) et[1 + acc_ + q] = e; acc_ += n; } et[0] = acc_; }
    __syncthreads();
    pg8::MoeOrder<true> S{et + 1, et[0], vcu, (const char*)HN, (const char*)WT13, 256u * DM * 2u, 256u * DM * 2u, (unsigned)DM * DM * 2u, ROWTOK};
    pg8::EpiSwiglu E{HB};
    pg8::gemm_phase<pg8::EpiSwiglu, pg8::MoeOrder<true>, true, true>((PG8_LAS unsigned char*)lds, DM, S, E);
    __syncthreads();
}

__device__ __forceinline__ void phase_12(CParams& P, unsigned char* lds, const int ph) {
    PHASE_PROLOGUE
    const int l = ph == 12 ? 0 : 1;
    int* et = (int*)(lds + LDS_TAB);
    if (tid == 0) { int acc_ = 0; for (int e = 0; e < NEXP; ++e) { const int c = (int)CTL[CW_CNT(l) + e], n = (c + MOE_RT - 1) / MOE_RT; for (int q = 0; q < n; ++q) et[1 + acc_ + q] = e; acc_ += n; } et[0] = acc_; }
    __syncthreads();
    pg8::MoeOrder<false> S{et + 1, et[0], vcu, (const char*)HB, (const char*)WT2, 256u * DFF * 2u, 256u * DFF * 2u, (unsigned)DM * DFF * 2u, nullptr};
    pg8::EpiBf16Plain E{YB, DM};
    pg8::gemm_phase<pg8::EpiBf16Plain, pg8::MoeOrder<false>, true, true>((PG8_LAS unsigned char*)lds, DFF, S, E);
    __syncthreads();
}

__device__ __forceinline__ void phase_13(CParams& P, unsigned char* lds, const int ph) {
    PHASE_PROLOGUE
            const bool fin = ph == 21;
            for (int row = gw; row < NT; row += NGW) {
                const int d0 = DEST[row * 2], d1 = DEST[row * 2 + 1];
                const float g0 = GATE[row * 2], g1 = GATE[row * 2 + 1];
                f32x4 v[4];
#pragma unroll
                for (int j = 0; j < 4; ++j) {
                    v[j] = ldrow_bf16(H + (size_t)row * DM, lane, j);
                    const u32x2 ya = ((const u32x2*)(YB + (size_t)d0 * DM))[lane + 64 * j];
                    const u32x2 yb = ((const u32x2*)(YB + (size_t)d1 * DM))[lane + 64 * j];
                    v[j][0] += g0 * bflo(ya.x) + g1 * bflo(yb.x); v[j][1] += g0 * bfhi(ya.x) + g1 * bfhi(yb.x);
                    v[j][2] += g0 * bflo(ya.y) + g1 * bflo(yb.y); v[j][3] += g0 * bfhi(ya.y) + g1 * bfhi(yb.y);
                }
                if (!fin) {
#pragma unroll
                    for (int j = 0; j < 4; ++j) strow_bf16(H + (size_t)row * DM, lane, j, v[j]);
                    store_norm_bf16(v, norm_mix + DM, HN + (size_t)row * DM, lane);
                } else if (row < NMAIN) {
                    float ss = 0.f;
#pragma unroll
                    for (int j = 0; j < 4; ++j) ss += v[j][0] * v[j][0] + v[j][1] * v[j][1] + v[j][2] * v[j][2] + v[j][3] * v[j][3];
                    ss = wave_sum(ss);
                    const float rstd = rsqrtf(ss * (1.f / DM) + 1e-6f);
#pragma unroll
                    for (int j = 0; j < 4; ++j) { const f32x4 g = ((const f32x4*)norm_final)[lane + 64 * j]; f32x4 o;
                        o[0] = v[j][0] * rstd * g[0]; o[1] = v[j][1] * rstd * g[1]; o[2] = v[j][2] * rstd * g[2]; o[3] = v[j][3] * rstd * g[3];
                        ((f32x4*)(P.out + (size_t)row * DM))[lane + 64 * j] = o; }
                }
            }
}

__device__ __forceinline__ void phase_15(CParams& P, unsigned char* lds, const int ph) {
    PHASE_PROLOGUE
    pg8::S5OrderA S{vcu, (const char*)HN, (const char*)BTA};
    pg8::EpiS5A E{YI, S5E};
    int Kr = 256; asm volatile("" : "+s"(Kr));
    pg8::gemm_phase<pg8::EpiS5A, pg8::S5OrderA, true, true>((PG8_LAS unsigned char*)lds, Kr, S, E);
}

__device__ __forceinline__ void phase_16(CParams& P, unsigned char* lds, const int ph) {
    PHASE_PROLOGUE
    float* Ls = (float*)lds;
    for (int wg = bid; wg < NB * 64 * 2; wg += G) {
        const int d = wg & 1, g = (wg >> 1) & 63, b = wg >> 7, p = lane;
        const float step = __expf(s5_ls[d * 64 + g]);
        const float lr = s5_lre[(d * 64 + g) * 64 + p], li = s5_lim[(d * 64 + g) * 64 + p];
        const float mag = expf(lr * step);
        const float abr = mag * cosf(li * step), abi = mag * sinf(li * step);
        float ar = 1.f, ai = 0.f;
        for (int t = 0; t < 16; ++t) { const float nr = ar * abr - ai * abi; ai = ar * abi + ai * abr; ar = nr; }
        float Ar = 1.f, Ai = 0.f;
        for (int t = 0; t < 64; ++t) { const float nr = Ar * ar - Ai * ai; Ai = Ar * ai + Ai * ar; Ar = nr; }
        const bf16_t* Ep = S5E + (size_t)g * 256 + d * 128 + p;
        bf16_t* Cp = CAR + (size_t)g * 1280 * 256 + d * 128 + p;
        const int q0 = 64 * wave;
#define S5_N(q_) ({ const int c_ = d ? 512 - (q_) : (q_); c_ == 0 ? 1024 + b : b * 512 + c_ - 1; })
        float sr = 0.f, si = 0.f;
#pragma unroll 1
        for (int hb = 0; hb < 2; ++hb) {
            float er[32], ei[32];
#pragma unroll
            for (int k = 0; k < 32; ++k) { const int n = S5_N(q0 + 32 * hb + k); er[k] = bf2f(Ep[(size_t)n * 64 * 256]); ei[k] = bf2f(Ep[(size_t)n * 64 * 256 + 64]); }
#pragma unroll
            for (int k = 0; k < 32; ++k) { const float nr = ar * sr - ai * si + er[k]; si = ar * si + ai * sr + ei[k]; sr = nr; }
        }
        Ls[(wave * 64 + p) * 2] = sr; Ls[(wave * 64 + p) * 2 + 1] = si;
        __syncthreads();
        sr = 0.f; si = 0.f;
        for (int w2 = 0; w2 < wave; ++w2) { const float l0 = Ls[(w2 * 64 + p) * 2], l1 = Ls[(w2 * 64 + p) * 2 + 1]; const float nr = Ar * sr - Ai * si + l0; si = Ar * si + Ai * sr + l1; sr = nr; }
#pragma unroll 1
        for (int hb = 0; hb < 2; ++hb) {
            float er[32], ei[32]; int nn[32];
#pragma unroll
            for (int k = 0; k < 32; ++k) { nn[k] = S5_N(q0 + 32 * hb + k); er[k] = bf2f(Ep[(size_t)nn[k] * 64 * 256]); ei[k] = bf2f(Ep[(size_t)nn[k] * 64 * 256 + 64]); }
#pragma unroll
            for (int k = 0; k < 32; ++k) { Cp[(size_t)nn[k] * 256] = (bf16_t)f2bf(sr); Cp[(size_t)nn[k] * 256 + 64] = (bf16_t)f2bf(si);
                const float nr = ar * sr - ai * si + er[k]; si = ar * si + ai * sr + ei[k]; sr = nr; }
        }
        if (wave == 7) { const int n = S5_N(512); Cp[(size_t)n * 256] = (bf16_t)f2bf(sr); Cp[(size_t)n * 256 + 64] = (bf16_t)f2bf(si); }
#undef S5_N
        __syncthreads();
    }
}

__device__ __forceinline__ void phase_22(CParams& P, unsigned char* lds, const int ph) {
    PHASE_PROLOGUE
    pg8::S5OrderC S{vcu, (const char*)CAR, (const char*)BTC};
    pg8::EpiS5C E{YI, HN, s5_d, A2};
    int Kr = 256; asm volatile("" : "+s"(Kr));
    pg8::gemm_phase<pg8::EpiS5C, pg8::S5OrderC, true, true>((PG8_LAS unsigned char*)lds, Kr, S, E);
}

__device__ __forceinline__ void phase_23(CParams& P, unsigned char* lds, const int ph) {
    PHASE_PROLOGUE
    if (gw < 64) meta_gemm<1>(A2 + (size_t)NMAIN * DM, WTGLU, H + (size_t)NMAIN * DM, gw, lane);
    pg8::DenseOrder S; S.init(A2, WTGLU, NMAIN, 2 * DM, DM, G, bid);
    pg8::EpiGlu E{H};
    pg8::gemm_phase<pg8::EpiGlu, pg8::DenseOrder, true, true>((PG8_LAS unsigned char*)lds, DM, S, E);
}
#define LAS __attribute__((address_space(3)))
#define CW_BAR 4096
#define XB_TMO      128
#define XB_XCNT(j)  (256  + 64 * (j))
#define XB_XSUB(j)  (1280 + 64 * (j))
#define XB_XGEN(j)  (2304 + 64 * (j))
#define XB_TOP      3328
#define XB_TOPGEN   3392
#define XCD_BAR_WORDS 3456
#define XB_SPIN_CAP (1u << 22)
__device__ __forceinline__ unsigned xb_ld(unsigned* p)              { return __hip_atomic_load(p, __ATOMIC_RELAXED, __HIP_MEMORY_SCOPE_AGENT); }
__device__ __forceinline__ unsigned xb_add(unsigned* p, unsigned v) { return __hip_atomic_fetch_add(p, v, __ATOMIC_RELAXED, __HIP_MEMORY_SCOPE_AGENT); }
__device__ __forceinline__ unsigned xb_xcc_id() { return (unsigned)__builtin_amdgcn_s_getreg((3 << 11) | 20) & 0xFu; }
#define XB_SPIN(cond, bar) do { unsigned _sp = 0; while (cond) { __builtin_amdgcn_s_sleep(1); \
    if ((++_sp & 255u) == 0u) { if (xb_ld(&(bar)[XB_TMO])) break; if (_sp > XB_SPIN_CAP) { atomicAdd(&(bar)[XB_TMO], 1u); break; } } } } while (0)
struct XcdBarrier { unsigned* bar; unsigned x; volatile LAS unsigned* st; };
__device__ __forceinline__ XcdBarrier xcd_barrier_post(unsigned* bar, volatile LAS unsigned* st) {
    XcdBarrier b; b.bar = bar; b.x = xb_xcc_id(); b.st = st;
    if (threadIdx.x == 0) (void)xb_add(&bar[XB_XCNT(b.x)], 1u);
    return b;
}
__device__ __forceinline__ void xcd_barrier_complete(unsigned* bar, unsigned x, unsigned& nloc, unsigned& nx) {
    const unsigned G = GRID;
    unsigned sum, cnt, mine, sp = 0u;
    for (;;) {
        sum = 0u; cnt = 0u; mine = 0u;
#pragma unroll
        for (unsigned j = 0; j < 16; ++j) { const unsigned c = xb_ld(&bar[XB_XCNT(j)]); sum += c; cnt += (c > 0u) ? 1u : 0u; mine = (j == x) ? c : mine; }
        if (sum == G) break;
        __builtin_amdgcn_s_sleep(1);
        if ((++sp & 255u) == 0u) { if (xb_ld(&bar[XB_TMO])) break; if (sp > XB_SPIN_CAP) { atomicAdd(&bar[XB_TMO], 1u); break; } }
    }
    nloc = mine > 0u ? mine : 1u; nx = cnt > 0u ? cnt : 1u;
}
__device__ __forceinline__ void xcd_barrier(const XcdBarrier& b) {
    asm volatile("s_waitcnt vmcnt(0)" ::: "memory");
    __syncthreads();
    if (threadIdx.x == 0) {
        unsigned* bar = b.bar;
        __builtin_amdgcn_s_waitcnt(0);
        unsigned nloc = b.st[0], nx = b.st[1];
        if (nloc == 0u) { xcd_barrier_complete(bar, b.x, nloc, nx); b.st[0] = nloc; b.st[1] = nx; }
        const unsigned old = xb_add(&bar[XB_XSUB(b.x)], 1u);
        const unsigned gen = old / nloc;
        if (old + 1u == (gen + 1u) * nloc) {
            __builtin_amdgcn_fence(__ATOMIC_RELEASE, "agent");
            asm volatile("s_waitcnt vmcnt(0)" ::: "memory");
            const unsigned og = xb_add(&bar[XB_TOP], 1u);
            const unsigned tg = og / nx;
            if (og + 1u == (tg + 1u) * nx) xb_add(&bar[XB_TOPGEN], 1u);
            else XB_SPIN(xb_ld(&bar[XB_TOPGEN]) == tg, bar);
            __builtin_amdgcn_fence(__ATOMIC_ACQUIRE, "agent");
            xb_add(&bar[XB_XGEN(b.x)], 1u);
            asm volatile("s_waitcnt vmcnt(0)" ::: "memory");
        } else {
            XB_SPIN(xb_ld(&bar[XB_XGEN(b.x)]) == gen, bar);
            __builtin_amdgcn_fence(__ATOMIC_ACQUIRE, "agent");
            asm volatile("s_waitcnt vmcnt(0)" ::: "memory");
        }
    }
    __syncthreads();
}


__global__ void __launch_bounds__(512, 2) mega(Params P_) {
    extern __shared__ __attribute__((aligned(16))) unsigned char lds[];
    volatile LAS unsigned* st = (volatile LAS unsigned*)(LAS unsigned char*)(lds + LDS_BARST);
    if (threadIdx.x < 16) st[threadIdx.x] = 0u;
    __syncthreads();
    CParams* pp = (CParams*)__builtin_amdgcn_kernarg_segment_ptr();
    (void)xcd_barrier_post((unsigned*)(pp->ws + WS_CTL) + CW_BAR, st);
#define GB do { XcdBarrier bar_; bar_.bar = (unsigned*)(pp->ws + WS_CTL) + CW_BAR; bar_.x = xb_xcc_id(); bar_.st = (volatile LAS unsigned*)(LAS unsigned char*)(lds + LDS_BARST); xcd_barrier(bar_); asm volatile("" : "+s"(pp)); } while (0)
#define P (*pp)
    asm volatile("" : "+s"(pp));
    phase_0(P, lds, 0); GB;
#if defined(PROBE_PH) && PROBE_PH == 0
    { int nrep = PROBE_N; asm volatile("" : "+s"(nrep)); for (int rep = 0; rep < nrep; ++rep) { GB; phase_0(P, lds, 0); GB; } }
#endif
    phase_1(P, lds, 1); GB;
#if defined(PROBE_PH) && PROBE_PH == 1
    { int nrep = PROBE_N; asm volatile("" : "+s"(nrep)); for (int rep = 0; rep < nrep; ++rep) { GB; phase_1(P, lds, 1); GB; } }
#endif
    phase_3(P, lds, 3); GB;
#if defined(PROBE_PH) && PROBE_PH == 3
    { int nrep = PROBE_N; asm volatile("" : "+s"(nrep)); for (int rep = 0; rep < nrep; ++rep) { GB; phase_3(P, lds, 3); GB; } }
#endif
    phase_6(P, lds, 6); GB;
    phase_60(P, lds, 60); GB;
#if defined(PROBE_PH) && PROBE_PH == 60
    { int nrep = PROBE_N; asm volatile("" : "+s"(nrep)); for (int rep = 0; rep < nrep; ++rep) { GB; phase_60(P, lds, 60); GB; } }
#endif
#if defined(PROBE_PH) && PROBE_PH == 6
    { int nrep = PROBE_N; asm volatile("" : "+s"(nrep)); for (int rep = 0; rep < nrep; ++rep) { GB; phase_6(P, lds, 6); GB; } }
#endif
    phase_7(P, lds, 7); GB;
#if defined(PROBE_PH) && PROBE_PH == 7
    { int nrep = PROBE_N; asm volatile("" : "+s"(nrep)); for (int rep = 0; rep < nrep; ++rep) { GB; phase_7(P, lds, 7); GB; } }
#endif
    phase_8(P, lds, 8); GB;
#if defined(PROBE_PH) && PROBE_PH == 8
    { int nrep = PROBE_N; asm volatile("" : "+s"(nrep)); for (int rep = 0; rep < nrep; ++rep) { GB; phase_8(P, lds, 8); GB; } }
#endif
    phase_9(P, lds, 9); GB;
#if defined(PROBE_PH) && PROBE_PH == 9
    { int nrep = PROBE_N; asm volatile("" : "+s"(nrep)); for (int rep = 0; rep < nrep; ++rep) { GB; phase_9(P, lds, 9); GB; } }
#endif
    phase_10(P, lds, 10); GB;
#if defined(PROBE_PH) && PROBE_PH == 10
    { int nrep = PROBE_N; asm volatile("" : "+s"(nrep)); for (int rep = 0; rep < nrep; ++rep) { GB; phase_10(P, lds, 10); GB; } }
#endif
    phase_11(P, lds, 11); GB;
#if defined(PROBE_PH) && PROBE_PH == 11
    { int nrep = PROBE_N; asm volatile("" : "+s"(nrep)); for (int rep = 0; rep < nrep; ++rep) { GB; phase_11(P, lds, 11); GB; } }
#endif
    phase_12(P, lds, 12); GB;
#if defined(PROBE_PH) && PROBE_PH == 12
    { int nrep = PROBE_N; asm volatile("" : "+s"(nrep)); for (int rep = 0; rep < nrep; ++rep) { GB; phase_12(P, lds, 12); GB; } }
#endif
    phase_13(P, lds, 13); GB;
#if defined(PROBE_PH) && PROBE_PH == 13
    { int nrep = PROBE_N; asm volatile("" : "+s"(nrep)); for (int rep = 0; rep < nrep; ++rep) { GB; phase_13(P, lds, 13); GB; } }
#endif
    phase_15(P, lds, 15); GB;
#if defined(PROBE_PH) && PROBE_PH == 15
    { int nrep = PROBE_N; asm volatile("" : "+s"(nrep)); for (int rep = 0; rep < nrep; ++rep) { GB; phase_15(P, lds, 15); GB; } }
#endif
    phase_16(P, lds, 16); GB;
#if defined(PROBE_PH) && PROBE_PH == 16
    { int nrep = PROBE_N; asm volatile("" : "+s"(nrep)); for (int rep = 0; rep < nrep; ++rep) { GB; phase_16(P, lds, 16); GB; } }
#endif
    phase_22(P, lds, 22); GB;
#if defined(PROBE_PH) && PROBE_PH == 22
    { int nrep = PROBE_N; asm volatile("" : "+s"(nrep)); for (int rep = 0; rep < nrep; ++rep) { GB; phase_22(P, lds, 22); GB; } }
#endif
    phase_23(P, lds, 23); GB;
#if defined(PROBE_PH) && PROBE_PH == 23
    { int nrep = PROBE_N; asm volatile("" : "+s"(nrep)); for (int rep = 0; rep < nrep; ++rep) { GB; phase_23(P, lds, 23); GB; } }
#endif
    phase_9(P, lds, 17); GB;
#if defined(PROBE_PH) && PROBE_PH == 17
    { int nrep = PROBE_N; asm volatile("" : "+s"(nrep)); for (int rep = 0; rep < nrep; ++rep) { GB; phase_9(P, lds, 17); GB; } }
#endif
    phase_10(P, lds, 18); GB;
#if defined(PROBE_PH) && PROBE_PH == 18
    { int nrep = PROBE_N; asm volatile("" : "+s"(nrep)); for (int rep = 0; rep < nrep; ++rep) { GB; phase_10(P, lds, 18); GB; } }
#endif
    phase_11(P, lds, 19); GB;
#if defined(PROBE_PH) && PROBE_PH == 19
    { int nrep = PROBE_N; asm volatile("" : "+s"(nrep)); for (int rep = 0; rep < nrep; ++rep) { GB; phase_11(P, lds, 19); GB; } }
#endif
    phase_12(P, lds, 20); GB;
#if defined(PROBE_PH) && PROBE_PH == 20
    { int nrep = PROBE_N; asm volatile("" : "+s"(nrep)); for (int rep = 0; rep < nrep; ++rep) { GB; phase_12(P, lds, 20); GB; } }
#endif
    phase_13(P, lds, 21);
#if defined(PROBE_PH) && PROBE_PH == 21
    { int nrep = PROBE_N; asm volatile("" : "+s"(nrep)); for (int rep = 0; rep < nrep; ++rep) { GB; phase_13(P, lds, 21); GB; } }
#endif
#undef P
#undef GB
}

extern "C" void kernel_launch(void* const* d_in, const int* in_sizes, int n_in, void* d_out, int out_size, void* d_ws, size_t ws_size, hipStream_t stream) {
    static int ready = 0;
    if (!ready) {
        if (n_in != 35 || ws_size < WS_TOTAL) { fprintf(stderr, "kernel_launch: unexpected n_in %d or ws_size %zu (need %zu)\n", n_in, ws_size, (size_t)WS_TOTAL); ready = -1; return; }
        if (hipFuncSetAttribute((const void*)mega, hipFuncAttributeMaxDynamicSharedMemorySize, LDS_BYTES) != hipSuccess) { fprintf(stderr, "kernel_launch: hipFuncSetAttribute failed\n"); ready = -1; return; }
        ready = 1;
    }
    if (ready < 0) return;
    (void)hipMemsetAsync((char*)d_ws + WS_CTL, 0, 1 * MiB, stream);
    Params P{};
    for (int i = 0; i < 35; ++i) P.in[i] = (const float*)d_in[i];
    P.out = (float*)d_out; P.ws = (unsigned char*)d_ws; P.ph_lo = 0; P.ph_hi = 0;
    hipLaunchKernelGGL(mega, dim3(GRID), dim3(512), LDS_BYTES, stream, P);
}
```

```cpp
#include <hip/hip_runtime.h>
#include <stdint.h>
#include <stdio.h>

#define DM 1024
#define NB 2
#define SEQ 8192
#define NMETA 16
#define LSEQ (SEQ + NMETA)
#define NMAIN (NB * SEQ)
#define NT (NB * LSEQ)
#define NTP 16640
#define INCOLS 3328
#define RESTC 1792
#define NEXP 32
#define DFF 512
#define S5TC 48
#define S5NC 171
#define MOE_RT 256
#define MOE_MAXROWS 41216

typedef unsigned short bf16_t;
typedef short bf16x8 __attribute__((ext_vector_type(8)));
typedef float f32x4 __attribute__((ext_vector_type(4)));
typedef unsigned u32x4 __attribute__((ext_vector_type(4)));
typedef unsigned u32x2 __attribute__((ext_vector_type(2)));

constexpr size_t MiB = 1u << 20;
constexpr size_t cmax2(size_t a, size_t b) { return a > b ? a : b; }
constexpr size_t al64k(size_t x) { return (x + 65535) & ~(size_t)65535; }
constexpr size_t WS_CTL = 0;
constexpr size_t WS_H = 1 * MiB;
constexpr size_t WS_HN = WS_H + al64k((size_t)NT * DM * 2);
constexpr size_t WS_A2 = WS_HN + al64k((size_t)NTP * DM * 2);
constexpr size_t WS_WTIN = WS_A2 + al64k((size_t)NTP * DM * 2);
constexpr size_t WS_WTOUT = WS_WTIN + al64k((size_t)INCOLS * DM * 2);
constexpr size_t WS_WTGLU = WS_WTOUT + al64k((size_t)DM * DM * 2);
constexpr size_t WS_LRT = WS_WTGLU + al64k((size_t)2 * DM * DM * 2);
constexpr size_t WS_BIG = WS_LRT + al64k((size_t)(2 * 512 * 64 * 2 + 512 * 128) * 2);
constexpr size_t SZ_T512 = al64k((size_t)NT * 512 * 2);
constexpr size_t SZ_P512 = al64k((size_t)NTP * 512 * 2);
constexpr int RW_NCH = 129, RW_UNITS = 32 * RW_NCH;
constexpr size_t SZ_RWOP = al64k((size_t)RW_UNITS * 4096 * 2);
constexpr size_t WS_Q = WS_BIG;
constexpr size_t WS_K = WS_Q + SZ_P512;
constexpr size_t WS_V = WS_K + SZ_P512;
constexpr size_t WS_REST = WS_V + SZ_P512;
constexpr size_t WS_KR = WS_REST + al64k((size_t)NTP * RESTC * 2);
constexpr size_t WS_LOW = WS_KR + SZ_T512;
constexpr size_t WS_AA = WS_LOW + al64k((size_t)NT * 256 * 2);
constexpr size_t WS_XEARLY = WS_AA + 2 * SZ_T512;
constexpr size_t WS_PP = WS_REST;
constexpr size_t WS_QT = WS_PP + SZ_RWOP;
constexpr size_t WS_YT = WS_QT + SZ_RWOP;
constexpr size_t WS_ZT = WS_YT + SZ_RWOP;
constexpr size_t WS_XEND = cmax2(WS_XEARLY, WS_ZT + SZ_RWOP);
constexpr size_t WS_R = WS_XEND;
constexpr size_t WS_VV = WS_R + SZ_T512;
constexpr size_t WS_G = WS_VV + SZ_T512;
constexpr size_t WS_KK = WS_G + SZ_T512;
constexpr size_t WS_KKA = WS_KK + SZ_T512;
constexpr size_t WS_KD = WS_KKA + 2 * SZ_T512;
constexpr size_t WS_W = WS_KD + 2 * SZ_T512;
constexpr size_t WS_BC = WS_W + 2 * SZ_T512;
constexpr size_t WS_MIXEND = WS_BC + al64k((size_t)NT * 8 * 4);
constexpr size_t WS_YFB = WS_KK;
constexpr size_t WS_ROWTOK = WS_BIG;
constexpr size_t WS_HB = WS_ROWTOK + al64k((size_t)MOE_MAXROWS * 4);
constexpr size_t WS_YB = WS_HB + al64k((size_t)MOE_MAXROWS * DFF * 2);
constexpr size_t WS_WT13 = WS_YB + al64k((size_t)MOE_MAXROWS * DM * 2);
constexpr size_t WS_WT2 = WS_WT13 + al64k((size_t)NEXP * DM * DM * 2);
constexpr size_t WS_EID = WS_WT2 + al64k((size_t)NEXP * DM * DFF * 2);
constexpr size_t WS_POS = WS_EID + al64k((size_t)NT * 8);
constexpr size_t WS_DEST = WS_POS + al64k((size_t)NT * 8);
constexpr size_t WS_GATE = WS_DEST + al64k((size_t)NT * 8);
constexpr size_t WS_WT13B = WS_GATE + al64k((size_t)NT * 8);
constexpr size_t WS_WT2B = WS_WT13B + al64k((size_t)NEXP * DM * DM * 2);
constexpr size_t WS_MOEEND = WS_WT2B + al64k((size_t)NEXP * DM * DFF * 2);
constexpr size_t WS_YI = WS_BIG;
constexpr size_t WS_E = WS_YI + al64k((size_t)NTP * DM * 2);
constexpr size_t WS_CAR = WS_E + al64k((size_t)1040 * 64 * 256 * 2);
constexpr size_t WS_S5END = WS_CAR + al64k((size_t)64 * 1280 * 256 * 2);
constexpr size_t WS_BTA = cmax2(WS_MIXEND, cmax2(WS_MOEEND, WS_S5END));
constexpr size_t WS_BTC = WS_BTA + al64k((size_t)64 * 512 * 256 * 2);
constexpr size_t WS_BTEND = WS_BTC + al64k((size_t)64 * 256 * 256 * 2);
constexpr size_t cmax(size_t a, size_t b) { return a > b ? a : b; }
constexpr size_t WS_TOTAL = WS_BTEND;
static_assert(WS_TOTAL <= 512 * MiB, "workspace map exceeds 512 MiB");

#define CW_CNT(l) (1024 + 64 * (l))
#define CW_WGC 16384

#define LDS_BYTES 163840
#define LDS_BARST (LDS_BYTES - 1024)
#define LDS_TAB (LDS_BYTES - 768)
#define LDS_RING (LDS_BYTES - 1024)
#define GRID 256

struct Params {
    const float* in[35];
    float* out;
    unsigned char* ws;
    int ph_lo, ph_hi;
};
typedef const __attribute__((address_space(4))) Params CParams;

__device__ __forceinline__ float bf2f(bf16_t v) { return __uint_as_float(((unsigned)v) << 16); }
typedef float f32x2c_ __attribute__((ext_vector_type(2)));
typedef __bf16 bf16x2c_ __attribute__((ext_vector_type(2)));
__device__ __forceinline__ unsigned pk2(float lo, float hi) { const f32x2c_ f = {lo, hi}; const bf16x2c_ b = __builtin_convertvector(f, bf16x2c_); return __builtin_bit_cast(unsigned, b); }
__device__ __forceinline__ unsigned f2bf(float f) { return (unsigned)__builtin_bit_cast(unsigned short, (__bf16)f); }
__device__ __forceinline__ float bflo(unsigned u) { return __uint_as_float(u << 16); }
__device__ __forceinline__ float bfhi(unsigned u) { return __uint_as_float(u & 0xffff0000u); }
template <int CTRL> __device__ __forceinline__ float dppf(float v) { return __int_as_float(__builtin_amdgcn_update_dpp(0, __float_as_int(v), CTRL, 0xF, 0xF, true)); }
__device__ __forceinline__ float row16_sum(float v) { v += dppf<0xB1>(v); v += dppf<0x4E>(v); v += dppf<0x141>(v); v += dppf<0x140>(v); return v; }
__device__ __forceinline__ float wave_sum(float v) {
    v = row16_sum(v);
    { const unsigned xu = __float_as_uint(v); const auto sw = __builtin_amdgcn_permlane16_swap(xu, xu, false, false); v = __uint_as_float(sw[0]) + __uint_as_float(sw[1]); }
    { const unsigned xu = __float_as_uint(v); const auto sw = __builtin_amdgcn_permlane32_swap(xu, xu, false, false); v = __uint_as_float(sw[0]) + __uint_as_float(sw[1]); }
    return v;
}
__device__ __forceinline__ float wave_max(float v) {
    v = fmaxf(v, dppf<0xB1>(v)); v = fmaxf(v, dppf<0x4E>(v)); v = fmaxf(v, dppf<0x141>(v)); v = fmaxf(v, dppf<0x140>(v));
    { const unsigned xu = __float_as_uint(v); const auto sw = __builtin_amdgcn_permlane16_swap(xu, xu, false, false); v = fmaxf(__uint_as_float(sw[0]), __uint_as_float(sw[1])); }
    { const unsigned xu = __float_as_uint(v); const auto sw = __builtin_amdgcn_permlane32_swap(xu, xu, false, false); v = fmaxf(__uint_as_float(sw[0]), __uint_as_float(sw[1])); }
    return v;
}
__device__ __forceinline__ float sigmoidf_(float x) { return __builtin_amdgcn_rcpf(1.f + __expf(-x)); }
__device__ __forceinline__ int rowof(int b, int p) { return p < NMETA ? NMAIN + b * NMETA + p : b * SEQ + (p - NMETA); }

#define SA_STRIDE 40
template <class AF, class BF>
__device__ __forceinline__ void gemm_tile(unsigned char* lds, int K, int ldb, const AF& arow, const BF& bcol, f32x4 (&acc)[4][2]) {
    bf16_t* sA = (bf16_t*)lds;
    bf16_t* sB = (bf16_t*)(lds + 128 * SA_STRIDE * 2);
    const int tid = threadIdx.x, lane = tid & 63, wave = tid >> 6, wr = wave >> 2, wc = wave & 3, fr = lane & 15, fq = lane >> 4;
#pragma unroll
    for (int mi = 0; mi < 4; ++mi)
#pragma unroll
        for (int ni = 0; ni < 2; ++ni) acc[mi][ni] = (f32x4){0.f, 0.f, 0.f, 0.f};
    const int ar = tid >> 2, akc = (tid & 3) * 8;
    const bf16_t* ap = arow(ar) + akc;
    const int bnq = (tid & 31) * 4, bkp = (tid >> 5) * 2;
    const float* bp = bcol(bnq) + (size_t)bkp * ldb;
    const int nk = K / 32;
    u32x4 ra = *(const u32x4*)ap;
    f32x4 rb0 = *(const f32x4*)bp, rb1 = *(const f32x4*)(bp + ldb);
    for (int kt = 0; kt < nk; ++kt) {
        __syncthreads();
        *(u32x4*)(sA + ar * SA_STRIDE + akc) = ra;
        {
            unsigned* d = (unsigned*)(sB + bnq * SA_STRIDE + bkp);
            d[0 * (SA_STRIDE / 2)] = pk2(rb0[0], rb1[0]);
            d[1 * (SA_STRIDE / 2)] = pk2(rb0[1], rb1[1]);
            d[2 * (SA_STRIDE / 2)] = pk2(rb0[2], rb1[2]);
            d[3 * (SA_STRIDE / 2)] = pk2(rb0[3], rb1[3]);
        }
        __syncthreads();
        if (kt + 1 < nk) {
            ra = *(const u32x4*)(ap + (kt + 1) * 32);
            const float* q = bp + (size_t)(kt + 1) * 32 * ldb;
            rb0 = *(const f32x4*)q; rb1 = *(const f32x4*)(q + ldb);
        }
        bf16x8 a[4], b[2];
#pragma unroll
        for (int mi = 0; mi < 4; ++mi) a[mi] = *(const bf16x8*)(sA + (wr * 64 + mi * 16 + fr) * SA_STRIDE + fq * 8);
#pragma unroll
        for (int ni = 0; ni < 2; ++ni) b[ni] = *(const bf16x8*)(sB + (wc * 32 + ni * 16 + fr) * SA_STRIDE + fq * 8);
#pragma unroll
        for (int mi = 0; mi < 4; ++mi)
#pragma unroll
            for (int ni = 0; ni < 2; ++ni) acc[mi][ni] = __builtin_amdgcn_mfma_f32_16x16x32_bf16(a[mi], b[ni], acc[mi][ni], 0, 0, 0);
    }
    __syncthreads();
}
#define ACC_FOREACH(acc, ...) do { const int _l = threadIdx.x & 63, _w = threadIdx.x >> 6, _wr = _w >> 2, _wc = _w & 3, _fr = _l & 15, _fq = _l >> 4; \
    _Pragma("unroll") for (int _mi = 0; _mi < 4; ++_mi) _Pragma("unroll") for (int _ni = 0; _ni < 2; ++_ni) _Pragma("unroll") for (int _j = 0; _j < 4; ++_j) { \
        const int rl = _wr * 64 + _mi * 16 + _fq * 4 + _j, cl = _wc * 32 + _ni * 16 + _fr; const float val = acc[_mi][_ni][_j]; __VA_ARGS__ } } while (0)
#define ACC_FOREACH_PAIR(acc, ...) do { const int _l = threadIdx.x & 63, _w = threadIdx.x >> 6, _wr = _w >> 2, _wc = _w & 3, _fr = _l & 15, _fq = _l >> 4; \
    _Pragma("unroll") for (int _mi = 0; _mi < 4; ++_mi) _Pragma("unroll") for (int _j = 0; _j < 4; ++_j) { \
        const int rl = _wr * 64 + _mi * 16 + _fq * 4 + _j, co = _wc * 16 + _fr; const float va = acc[_mi][0][_j], vg = acc[_mi][1][_j]; __VA_ARGS__ } } while (0)

__device__ __forceinline__ void store_norm_bf16(const f32x4 (&v)[4], const float* gain, bf16_t* dst, int lane) {
    float ss = 0.f;
#pragma unroll
    for (int j = 0; j < 4; ++j) ss += v[j][0] * v[j][0] + v[j][1] * v[j][1] + v[j][2] * v[j][2] + v[j][3] * v[j][3];
    ss = wave_sum(ss);
    const float rstd = rsqrtf(ss * (1.f / DM) + 1e-6f);
#pragma unroll
    for (int j = 0; j < 4; ++j) {
        const f32x4 g = ((const f32x4*)gain)[lane + 64 * j];
        u32x2 o; o.x = pk2(v[j][0] * rstd * g[0], v[j][1] * rstd * g[1]); o.y = pk2(v[j][2] * rstd * g[2], v[j][3] * rstd * g[3]);
        ((u32x2*)dst)[lane + 64 * j] = o;
    }
}


__device__ __forceinline__ f32x4 ldrow_bf16(const bf16_t* row, int lane, int j) { const u32x2 u = ((const u32x2*)row)[lane + 64 * j]; return (f32x4){bflo(u.x), bfhi(u.x), bflo(u.y), bfhi(u.y)}; }
__device__ __forceinline__ void strow_bf16(bf16_t* row, int lane, int j, const f32x4 v) { u32x2 o; o.x = pk2(v[0], v[1]); o.y = pk2(v[2], v[3]); ((u32x2*)row)[lane + 64 * j] = o; }
namespace pg8 {
#define PG8_LAS __attribute__((address_space(3)))
constexpr int BM = 256, BK = 64, HALF = 128, HTB = HALF * BK * 2  , STAGE_BYTES = 8 * HTB, NXCD = 8, WGM = 8;
__host__ __device__ __forceinline__ int lds_byte(int r, int c) { const int st = (r >> 4) * 2 + (c >> 5), rr = r & 15, cc = c & 31, ob = rr * 64 + cc * 2; return st * 1024 + (ob ^ (((ob >> 9) & 1) << 5)); }
__host__ __device__ __forceinline__ void stage_rc(int b, int& R, int& C) { const int st = b / 1024, sb = b % 1024, swz = sb ^ (((sb >> 9) & 1) << 5); R = (st >> 1) * 16 + swz / 64; C = (st & 1) * 32 + (swz % 64) / 2; }
__host__ __device__ __forceinline__ int perm32(int rho) { const int n = rho >> 4, i = rho & 15; return 8 * (i >> 2) + 4 * n + (i & 3); }

struct Unit { int pm, pn; const char* A; const char* B; };

struct DenseOrder {
    static constexpr bool GATHER_ROWS = false;
    static constexpr bool GATHER_A = false;
    int nM, nN, nwg, G, c; const char* A; const char* Bt; size_t tstep;
    __device__ void init(const bf16_t* A_, const bf16_t* Bt_, int M, int N, int K, int G_, int c_) { nM = M / BM; nN = N / BM; nwg = nM * nN; G = G_; c = c_; A = (const char*)A_; Bt = (const char*)Bt_; tstep = (size_t)BM * K * 2; }
    __device__ bool next(int i, Unit& u) const {
        const long L = (long)i * G + c; if (L >= nwg) return false;
        int wgid = (int)L; { const int q = nwg / NXCD, r = nwg % NXCD, xcd = wgid % NXCD, off = wgid / NXCD; wgid = (xcd < r ? xcd * (q + 1) : r * (q + 1) + (xcd - r) * q) + off; }
        const int nig = WGM * nN, gid = wgid / nig, fm = gid * WGM, gsz = (nM - fm) < WGM ? (nM - fm) : WGM;
        u.pm = fm + ((wgid % nig) % gsz); u.pn = (wgid % nig) / gsz; u.A = A + (size_t)u.pm * tstep; u.B = Bt + (size_t)u.pn * tstep; return true;
    }
    __device__ __forceinline__ void a_ready(const Unit&) const {}
    __device__ __forceinline__ void done(const Unit&) const {}
};
struct ProjOrder {
    static constexpr bool GATHER_ROWS = false;
    static constexpr bool GATHER_A = false;
    DenseOrder D; const char* HNp; const char* WT;
    __device__ void init(const bf16_t* HN_, const bf16_t* WT_, int c_) { D.init(HN_, WT_, NTP, 13 * BM, DM, GRID, c_); HNp = (const char*)HN_; WT = (const char*)WT_; }
    __device__ bool next(int i, Unit& u) const {
        if (!D.next(i, u)) return false;
        const size_t ts = (size_t)BM * DM * 2;
        if (u.pn < 11) { const int wrow = u.pn < 4 ? u.pn : u.pn + 2; u.A = HNp + (size_t)u.pm * ts; u.B = WT + (size_t)wrow * ts; }
        else { u.A = WT + (size_t)(4 + (u.pn - 11)) * ts; u.B = HNp + (size_t)u.pm * ts; }
        return true;
    }
    __device__ __forceinline__ void a_ready(const Unit&) const {}
    __device__ __forceinline__ void done(const Unit&) const {}
};
template <bool GATHER> struct MoeOrder {
    static constexpr bool GATHER_ROWS = GATHER;
    static constexpr bool GATHER_A = false;
    const int* et; int TT, vcu; const char* A; const char* Bt; unsigned tstepA, tstepB, estep; const int* rowidx;
    __device__ __forceinline__ bool next(int i, Unit& u) const {
        const int L = i * GRID + vcu; if (L >= TT * 4) return false;
        const int rt = L >> 2, ct = L & 3, e = et[rt];
        u.pm = rt; u.pn = ct; u.A = GATHER ? A : A + (size_t)rt * tstepA; u.B = Bt + (size_t)e * estep + (size_t)ct * tstepB; return true;
    }
    __device__ __forceinline__ void a_ready(const Unit&) const {}
    __device__ __forceinline__ void done(const Unit&) const {}
};

struct S5OrderA {
    static constexpr bool GATHER_ROWS = false;
    static constexpr bool GATHER_A = true;
    int vcu; const char* U; const char* BTA;
    __device__ __forceinline__ bool next(int i, Unit& u) const {
        const int L = i * GRID + vcu; if (L >= 640) return false;
        const int g = L / 10, rem = L - g * 10, mt = rem >> 1, nt = rem & 1;
        u.pm = mt; u.pn = g * 2 + nt; u.A = U + ((size_t)mt * 256 * 16 * 1024 + g * 16) * 2; u.B = BTA + ((size_t)(g * 512 + nt * 256) * 256) * 2; return true;
    }
    __device__ __forceinline__ void a_ready(const Unit&) const {}
    __device__ __forceinline__ void done(const Unit&) const {}
};
struct S5OrderC {
    static constexpr bool GATHER_ROWS = false;
    static constexpr bool GATHER_A = false;
    int vcu; const char* CAR; const char* BTC;
    __device__ __forceinline__ bool next(int i, Unit& u) const {
        const int L = i * GRID + vcu; if (L >= 320) return false;
        const int g = L / 5, mt = L - g * 5;
        u.pm = mt; u.pn = g; u.A = CAR + ((size_t)(g * 1280 + mt * 256) * 256) * 2; u.B = BTC + ((size_t)g * 256 * 256) * 2; return true;
    }
    __device__ __forceinline__ void a_ready(const Unit&) const {}
    __device__ __forceinline__ void done(const Unit&) const {}
};
__device__ __forceinline__ unsigned cvt_pk_bf16(float lo, float hi) { return pk2(lo, hi); }

struct EpiProj {
    static constexpr bool PERM = true, AFTER_DRAIN = false;
    bf16_t *Q, *Kk, *VT, *REST;
    __device__ __forceinline__ void operator()(const f32x4 (&acc)[2][2][4][2], const Unit& u, int wr, int wc, int fr, int fq) const {
        bf16_t* base; int ldc; int row0, col0;
        if (u.pn < 11) { row0 = u.pm * BM + wr * 64 + fr; int colt;
            if (u.pn < 2) { base = Q; colt = u.pn * BM; ldc = 512; } else if (u.pn < 4) { base = Kk; colt = (u.pn - 2) * BM; ldc = 512; } else { base = REST; colt = (u.pn - 4) * BM; ldc = RESTC; }
            col0 = colt + wc * 32 + 8 * fq; }
        else { base = VT; ldc = NTP; row0 = (u.pn - 11) * BM + wr * 64 + fr; col0 = u.pm * BM + wc * 32 + 8 * fq; }
#pragma unroll
        for (int ai = 0; ai < 2; ++ai)
#pragma unroll
            for (int m = 0; m < 4; ++m) { bf16_t* rowp = base + (size_t)(row0 + ai * HALF + m * 16) * ldc + col0;
#pragma unroll
                for (int bj = 0; bj < 2; ++bj) { const f32x4 v0 = acc[ai][bj][m][0], v1 = acc[ai][bj][m][1];
                    u32x4 w; w.x = cvt_pk_bf16(v0[0], v0[1]); w.y = cvt_pk_bf16(v0[2], v0[3]); w.z = cvt_pk_bf16(v1[0], v1[1]); w.w = cvt_pk_bf16(v1[2], v1[3]);
                    *(u32x4*)(rowp + bj * HALF) = w; } }
    }
};
struct EpiBf16Plain {
    static constexpr bool PERM = true, AFTER_DRAIN = false;
    bf16_t* O; int ldc;
    __device__ __forceinline__ void operator()(const f32x4 (&acc)[2][2][4][2], const Unit& u, int wr, int wc, int fr, int fq) const {
        const int row0 = u.pm * BM + wr * 64 + fr; const int col0 = u.pn * BM + wc * 32 + 8 * fq;
#pragma unroll
        for (int ai = 0; ai < 2; ++ai)
#pragma unroll
            for (int m = 0; m < 4; ++m) { bf16_t* rowp = O + (size_t)(row0 + ai * HALF + m * 16) * ldc + col0;
#pragma unroll
                for (int bj = 0; bj < 2; ++bj) { const f32x4 v0 = acc[ai][bj][m][0], v1 = acc[ai][bj][m][1];
                    u32x4 w; w.x = cvt_pk_bf16(v0[0], v0[1]); w.y = cvt_pk_bf16(v0[2], v0[3]); w.z = cvt_pk_bf16(v1[0], v1[1]); w.w = cvt_pk_bf16(v1[2], v1[3]);
                    *(u32x4*)(rowp + bj * HALF) = w; } }
    }
};
struct EpiSwiglu {
    static constexpr bool PERM = true, AFTER_DRAIN = false;
    bf16_t* O;
    __device__ __forceinline__ void operator()(const f32x4 (&acc)[2][2][4][2], const Unit& u, int wr, int wc, int fr, int fq) const {
        const int row0 = u.pm * BM + wr * 64 + fr; const int col0 = u.pn * HALF + wc * 32 + 8 * fq;
#pragma unroll
        for (int ai = 0; ai < 2; ++ai)
#pragma unroll
            for (int m = 0; m < 4; ++m) {
                float o[8];
#pragma unroll
                for (int n = 0; n < 2; ++n)
#pragma unroll
                    for (int i = 0; i < 4; ++i) { const float va = acc[ai][0][m][n][i], vg = acc[ai][1][m][n][i]; o[4 * n + i] = va * __builtin_amdgcn_rcpf(1.f + __expf(-va)) * vg; }
                u32x4 w; w.x = cvt_pk_bf16(o[0], o[1]); w.y = cvt_pk_bf16(o[2], o[3]); w.z = cvt_pk_bf16(o[4], o[5]); w.w = cvt_pk_bf16(o[6], o[7]);
                *(u32x4*)(O + (size_t)(row0 + ai * HALF + m * 16) * DFF + col0) = w; }
    }
};
struct EpiResidual {
    static constexpr bool PERM = true, AFTER_DRAIN = false;
    bf16_t* Hh;
    __device__ __forceinline__ void operator()(const f32x4 (&acc)[2][2][4][2], const Unit& u, int wr, int wc, int fr, int fq) const {
        const int row0 = u.pm * BM + wr * 64 + fr; const int col0 = u.pn * BM + wc * 32 + 8 * fq;
#pragma unroll
        for (int ai = 0; ai < 2; ++ai)
#pragma unroll
            for (int m = 0; m < 4; ++m) { bf16_t* rowp = Hh + (size_t)(row0 + ai * HALF + m * 16) * DM + col0;
#pragma unroll
                for (int bj = 0; bj < 2; ++bj) { u32x4* p = (u32x4*)(rowp + bj * HALF); const u32x4 hv = *p; const f32x4 v0 = acc[ai][bj][m][0], v1 = acc[ai][bj][m][1];
                    u32x4 w; w.x = cvt_pk_bf16(__uint_as_float(hv.x << 16) + v0[0], __uint_as_float(hv.x & 0xffff0000u) + v0[1]); w.y = cvt_pk_bf16(__uint_as_float(hv.y << 16) + v0[2], __uint_as_float(hv.y & 0xffff0000u) + v0[3]);
                    w.z = cvt_pk_bf16(__uint_as_float(hv.z << 16) + v1[0], __uint_as_float(hv.z & 0xffff0000u) + v1[1]); w.w = cvt_pk_bf16(__uint_as_float(hv.w << 16) + v1[2], __uint_as_float(hv.w & 0xffff0000u) + v1[3]);
                    *p = w; } }
    }
};
struct EpiGlu {
    static constexpr bool PERM = true, AFTER_DRAIN = false;
    bf16_t* Hh;
    __device__ __forceinline__ void operator()(const f32x4 (&acc)[2][2][4][2], const Unit& u, int wr, int wc, int fr, int fq) const {
        const int row0 = u.pm * BM + wr * 64 + fr; const int col0 = u.pn * HALF + wc * 32 + 8 * fq;
#pragma unroll
        for (int ai = 0; ai < 2; ++ai)
#pragma unroll
            for (int m = 0; m < 4; ++m) { u32x4* p = (u32x4*)(Hh + (size_t)(row0 + ai * HALF + m * 16) * DM + col0); const u32x4 hv = *p;
                float o[8];
#pragma unroll
                for (int n = 0; n < 2; ++n)
#pragma unroll
                    for (int i = 0; i < 4; ++i) { const unsigned hw = hv[2 * n + (i >> 1)]; const float hcur = (i & 1) ? __uint_as_float(hw & 0xffff0000u) : __uint_as_float(hw << 16);
                        o[4 * n + i] = hcur + acc[ai][0][m][n][i] * __builtin_amdgcn_rcpf(1.f + __expf(-acc[ai][1][m][n][i])); }
                u32x4 w; w.x = cvt_pk_bf16(o[0], o[1]); w.y = cvt_pk_bf16(o[2], o[3]); w.z = cvt_pk_bf16(o[4], o[5]); w.w = cvt_pk_bf16(o[6], o[7]);
                *p = w; }
    }
};
struct EpiS5A {
    static constexpr bool PERM = true, AFTER_DRAIN = false;
    bf16_t* YI; bf16_t* E;
    __device__ __forceinline__ void operator()(const f32x4 (&acc)[2][2][4][2], const Unit& u, int wr, int wc, int fr, int fq) const {
        const int g = u.pn >> 1, nt = u.pn & 1;
        const int cl0 = wc * 32 + 8 * fq;
        bf16_t* base = nt == 0 ? YI + (size_t)(cl0 >> 4) * DM + g * 16 + (cl0 & 15) : E + (size_t)g * 256 + cl0;
        const size_t nstride = 16 * DM;
        const size_t bjstep = nt == 0 ? (size_t)8 * DM : (size_t)HALF;
#pragma unroll
        for (int ai = 0; ai < 2; ++ai)
#pragma unroll
            for (int m = 0; m < 4; ++m) { int n = u.pm * BM + ai * HALF + wr * 64 + m * 16 + fr; n = n < 1039 ? n : 1039;
                bf16_t* p = base + (size_t)n * nstride;
#pragma unroll
                for (int bj = 0; bj < 2; ++bj) { const f32x4 v0 = acc[ai][bj][m][0], v1 = acc[ai][bj][m][1];
                    u32x4 w; w.x = cvt_pk_bf16(v0[0], v0[1]); w.y = cvt_pk_bf16(v0[2], v0[3]); w.z = cvt_pk_bf16(v1[0], v1[1]); w.w = cvt_pk_bf16(v1[2], v1[3]);
                    *(u32x4*)(p + bj * bjstep) = w; } }
    }
};
struct EpiS5C {
    static constexpr bool PERM = true, AFTER_DRAIN = false;
    const bf16_t* YI; const bf16_t* Uu; const float* dvec; bf16_t* O;
    __device__ __forceinline__ void operator()(const f32x4 (&acc)[2][2][4][2], const Unit& u, int wr, int wc, int fr, int fq) const {
        const int g = u.pn;
        const int cl0 = wc * 32 + 8 * fq, ch = g * 16 + (cl0 & 15);
        const size_t off0 = (size_t)(cl0 >> 4) * DM + ch;
        const f32x4 d0 = *(const f32x4*)(dvec + ch), d1 = *(const f32x4*)(dvec + ch + 4);
        u32x4 yq[8][2], uq[8][2];
#define S5C_OFF(rg_, bj_) ({ int n_ = u.pm * BM + ((rg_) >> 2) * HALF + wr * 64 + ((rg_) & 3) * 16 + fr; n_ = n_ < 1039 ? n_ : 1039; off0 + (size_t)n_ * (16 * DM) + (size_t)(bj_) * (8 * DM); })
#define S5C_LOAD(rg_) do { _Pragma("unroll") for (int bj_ = 0; bj_ < 2; ++bj_) { const size_t o_ = S5C_OFF(rg_, bj_); yq[rg_][bj_] = *(const u32x4*)(YI + o_); uq[rg_][bj_] = *(const u32x4*)(Uu + o_); } } while (0)
        S5C_LOAD(0); S5C_LOAD(1); S5C_LOAD(2);
#pragma unroll
        for (int rg = 0; rg < 8; ++rg) {
            if (rg + 3 < 8) S5C_LOAD(rg + 3);
            const int ai = rg >> 2, m = rg & 3;
#pragma unroll
            for (int bj = 0; bj < 2; ++bj) {
                const u32x4 yv = yq[rg][bj], uv = uq[rg][bj];
                const f32x4 y0 = (f32x4){__uint_as_float(yv[0] << 16), __uint_as_float(yv[0] & 0xffff0000u), __uint_as_float(yv[1] << 16), __uint_as_float(yv[1] & 0xffff0000u)},
                            y1 = (f32x4){__uint_as_float(yv[2] << 16), __uint_as_float(yv[2] & 0xffff0000u), __uint_as_float(yv[3] << 16), __uint_as_float(yv[3] & 0xffff0000u)};
                float y[8];
#pragma unroll
                for (int q = 0; q < 4; ++q) { y[q] = acc[ai][bj][m][0][q] + y0[q] + d0[q] * (q & 1 ? __uint_as_float(uv[q >> 1] & 0xffff0000u) : __uint_as_float(uv[q >> 1] << 16));
                    y[4 + q] = acc[ai][bj][m][1][q] + y1[q] + d1[q] * (q & 1 ? __uint_as_float(uv[2 + (q >> 1)] & 0xffff0000u) : __uint_as_float(uv[2 + (q >> 1)] << 16)); }
#pragma unroll
                for (int q = 0; q < 8; ++q) { const float z = 1.5957691216f * (y[q] + 0.044715f * y[q] * y[q] * y[q]); y[q] = y[q] * __builtin_amdgcn_rcpf(1.f + __expf(-z)); }
                u32x4 w; w.x = cvt_pk_bf16(y[0], y[1]); w.y = cvt_pk_bf16(y[2], y[3]); w.z = cvt_pk_bf16(y[4], y[5]); w.w = cvt_pk_bf16(y[6], y[7]);
                *(u32x4*)(O + S5C_OFF(rg, bj)) = w; }
            asm volatile("" ::: "memory"); }
#undef S5C_LOAD
#undef S5C_OFF
    }
};

template <class Epi, class Sched, bool ALIGN_EPI = false, bool SP2 = false>
__device__ __forceinline__ void gemm_phase(PG8_LAS unsigned char* lds, const int K, const Sched& S, const Epi& E) {
    int tid_ = threadIdx.x; asm volatile("" : "+v"(tid_));
    const int tid = tid_, wid = __builtin_amdgcn_readfirstlane(tid >> 6), lane = tid & 63, wr = wid >> 2, wc = wid & 3, fr = lane & 15, fq = lane >> 4;
    const int nt = K / BK;
    unsigned vA0[2], vA1[2], nA0[2], nA1[2], voffB[2];
#pragma unroll
    for (int i = 0; i < 2; ++i) { int R, C; stage_rc(tid * 16 + i * 8192, R, C); const int Rb = Epi::PERM ? ((R & ~31) + perm32(R & 31)) : R;
        vA0[i] = Sched::GATHER_A ? (unsigned)(((16 * R + (C >> 4)) * 1024 + (C & 15)) * 2) : (unsigned)(R * K + C) * 2u; voffB[i] = (unsigned)(Rb * K + C) * 2u; }
    const size_t kstep = (size_t)(BK * 2);
    const size_t hstep = (size_t)HALF * K * 2;
    const size_t kstepA = Sched::GATHER_A ? (size_t)(4 * 1024 * 2) : kstep, hstepA = Sched::GATHER_A ? (size_t)HALF * 16 * 1024 * 2 : hstep;
#define PG8_ROWOFFS(u_, d0_, d1_) do { _Pragma("unroll") for (int i_ = 0; i_ < 2; ++i_) { int R_, C_; stage_rc(tid * 16 + i_ * 8192, R_, C_); \
        d0_[i_] = (unsigned)(S.rowidx[(u_).pm * BM + R_] * K + C_) * 2u; d1_[i_] = (unsigned)(S.rowidx[(u_).pm * BM + HALF + R_] * K + C_) * 2u; } } while (0)
#define PG8_STAGE_A(bufoff, gbase, h_, nx_) do { _Pragma("unroll") for (int _i = 0; _i < 2; ++_i) { const unsigned vo_ = (nx_) ? ((h_) ? nA1[_i] : nA0[_i]) : ((h_) ? vA1[_i] : vA0[_i]); \
        __builtin_amdgcn_global_load_lds((const unsigned*)((const char*)(gbase) + vo_), (PG8_LAS unsigned*)(lds + (bufoff) + ldsw + _i * 8192), 16, 0, 0); } } while (0)
    const unsigned ldsw = (unsigned)wid * 1024u;
    const int aoff = lds_byte(wr * 64 + fr, fq * 8), boff = lds_byte(wc * 32 + fr, fq * 8);
#define PG8_SA(b, h) (((b) * 2 + (h)) * HTB)
#define PG8_SB(b, h) ((4 + (b) * 2 + (h)) * HTB)
#define PG8_STAGE(bufoff, gbase, voff) do { _Pragma("unroll") for (int _i = 0; _i < 2; ++_i) \
        __builtin_amdgcn_global_load_lds((const unsigned*)((const char*)(gbase) + (voff)[_i]), (PG8_LAS unsigned*)(lds + (bufoff) + ldsw + _i * 8192), 16, 0, 0); } while (0)
#define PG8_LDA(dst, b, h) do { _Pragma("unroll") for (int m = 0; m < 4; ++m) _Pragma("unroll") for (int k = 0; k < 2; ++k) dst[m][k] = *(const PG8_LAS bf16x8*)(lds + PG8_SA(b, h) + aoff + m * 2048 + k * 1024); } while (0)
#define PG8_LDB(dst, b, h) do { _Pragma("unroll") for (int n = 0; n < 2; ++n) _Pragma("unroll") for (int k = 0; k < 2; ++k) dst[n][k] = *(const PG8_LAS bf16x8*)(lds + PG8_SB(b, h) + boff + n * 2048 + k * 1024); } while (0)
#define PG8_MMA(ai, bj, At, Bt) do { __builtin_amdgcn_s_setprio(1); _Pragma("unroll") for (int m = 0; m < 4; ++m) _Pragma("unroll") for (int n = 0; n < 2; ++n) _Pragma("unroll") for (int k = 0; k < 2; ++k) \
        acc[ai][bj][m][n] = __builtin_amdgcn_mfma_f32_16x16x32_bf16(Bt[n][k], At[m][k], acc[ai][bj][m][n], 0, 0, 0); __builtin_amdgcn_s_setprio(0); } while (0)
#define PG8_WAIT_V(n) asm volatile("s_waitcnt vmcnt(" #n ")" ::: "memory")
#define PG8_WAIT_L(n) asm volatile("s_waitcnt lgkmcnt(" #n ")" ::: "memory")
#define PG8_BAR __builtin_amdgcn_s_barrier()
#define PG8_SCHED __builtin_amdgcn_sched_barrier(0)
    Unit cur, nxt; int ui = 0;
    if (!S.next(0, cur)) return;
    f32x4 acc[2][2][4][2];
#pragma unroll
    for (int a = 0; a < 2; ++a)
#pragma unroll
        for (int b = 0; b < 2; ++b)
#pragma unroll
            for (int m = 0; m < 4; ++m)
#pragma unroll
                for (int n = 0; n < 2; ++n) acc[a][b][m][n] = (f32x4){0.f, 0.f, 0.f, 0.f};
    bf16x8 At[4][2], B0[2][2], B1[2][2];
    const char* cA = cur.A; const char* cB = cur.B;
    if constexpr (Sched::GATHER_ROWS) { PG8_ROWOFFS(cur, vA0, vA1); }
    else {
#pragma unroll
        for (int i = 0; i < 2; ++i) vA1[i] = vA0[i] + (unsigned)hstepA;
    }
#pragma unroll
    for (int i = 0; i < 2; ++i) { nA0[i] = vA0[i]; nA1[i] = vA1[i]; }
    S.a_ready(cur);
    if constexpr (SP2) {
        PG8_STAGE(PG8_SB(0, 0), cB, voffB); PG8_STAGE(PG8_SB(0, 1), cB + hstep, voffB); PG8_STAGE_A(PG8_SA(0, 0), cA, 0, false); PG8_STAGE_A(PG8_SA(0, 1), cA, 1, false);
        if (wr == 1) PG8_BAR;
        PG8_WAIT_V(2); PG8_BAR;
        PG8_STAGE(PG8_SB(1, 0), cB + kstep, voffB); PG8_STAGE_A(PG8_SA(1, 0), cA + kstepA, 0, false); PG8_STAGE(PG8_SB(1, 1), cB + hstep + kstep, voffB);
        PG8_WAIT_V(6); PG8_BAR;
    } else {
        PG8_STAGE(PG8_SB(0, 0), cB, voffB); PG8_STAGE_A(PG8_SA(0, 0), cA, 0, false); PG8_STAGE(PG8_SB(0, 1), cB + hstep, voffB); PG8_STAGE_A(PG8_SA(0, 1), cA, 1, false);
        if (wr == 1) PG8_BAR;
        PG8_WAIT_V(4); PG8_BAR;
        PG8_STAGE(PG8_SB(1, 0), cB + kstep, voffB); PG8_STAGE_A(PG8_SA(1, 0), cA + kstepA, 0, false); PG8_STAGE(PG8_SB(1, 1), cB + hstep + kstep, voffB);
        PG8_WAIT_V(6); PG8_BAR;
    }
    for (;;) {
        const bool has_next = S.next(ui + 1, nxt);
        if constexpr (Sched::GATHER_ROWS) { if (has_next) PG8_ROWOFFS(nxt, nA0, nA1); }
        const char* nA = has_next ? nxt.A : cA; const char* nB = has_next ? nxt.B : cB;
        for (int t = 0; t < nt; t += 2) {
            const bool last = (t == nt - 2);
            const char* a1 = cA + (size_t)(t + 1) * kstepA;
            const char* a2 = last ? nA : cA + (size_t)(t + 2) * kstepA; const char* b2 = last ? nB : cB + (size_t)(t + 2) * kstep;
            const char* a3 = a2 + kstepA; const char* b3 = b2 + kstep;
            if (last && has_next) S.a_ready(nxt);
            if constexpr (SP2) {
            PG8_LDB(B0, 0, 0); PG8_LDB(B1, 0, 1); PG8_SCHED; PG8_LDA(At, 0, 0); PG8_STAGE_A(PG8_SA(1, 1), a1, 1, false);
            PG8_WAIT_V(8); PG8_WAIT_L(0); PG8_BAR; PG8_MMA(0, 0, At, B0); PG8_MMA(0, 1, At, B1); PG8_BAR; PG8_SCHED;
            PG8_LDA(At, 0, 1); PG8_STAGE(PG8_SB(0, 0), b2, voffB); PG8_STAGE(PG8_SB(0, 1), b2 + hstep, voffB); PG8_STAGE_A(PG8_SA(0, 0), a2, 0, last);
            PG8_WAIT_V(8); PG8_WAIT_L(0); PG8_BAR; PG8_MMA(1, 0, At, B0); PG8_MMA(1, 1, At, B1); PG8_BAR; PG8_SCHED;
            PG8_LDB(B0, 1, 0); PG8_LDB(B1, 1, 1); PG8_SCHED; PG8_LDA(At, 1, 0); PG8_STAGE_A(PG8_SA(0, 1), a2, 1, last);
            PG8_WAIT_V(8); PG8_WAIT_L(0); PG8_BAR; PG8_MMA(0, 0, At, B0); PG8_MMA(0, 1, At, B1); PG8_BAR; PG8_SCHED;
            PG8_LDA(At, 1, 1); PG8_STAGE(PG8_SB(1, 0), b3, voffB); PG8_STAGE(PG8_SB(1, 1), b3 + hstep, voffB); PG8_STAGE_A(PG8_SA(1, 0), a3, 0, last);
            PG8_WAIT_V(8); PG8_WAIT_L(0); PG8_BAR; PG8_MMA(1, 0, At, B0); PG8_MMA(1, 1, At, B1); PG8_BAR; PG8_SCHED;
            } else {
            PG8_LDB(B0, 0, 0); PG8_SCHED; PG8_LDA(At, 0, 0); PG8_STAGE_A(PG8_SA(1, 1), a1, 1, false);
            PG8_WAIT_L(8); PG8_BAR; PG8_WAIT_L(0); PG8_MMA(0, 0, At, B0); PG8_BAR; PG8_SCHED;
            PG8_LDB(B1, 0, 1); PG8_STAGE(PG8_SB(0, 0), b2, voffB);
            PG8_BAR; PG8_WAIT_L(0); PG8_MMA(0, 1, At, B1); PG8_BAR;
            PG8_LDA(At, 0, 1); PG8_STAGE_A(PG8_SA(0, 0), a2, 0, last);
            PG8_BAR; PG8_WAIT_L(0); PG8_MMA(1, 0, At, B0); PG8_BAR; PG8_SCHED;
            PG8_STAGE(PG8_SB(0, 1), b2 + hstep, voffB);
            PG8_WAIT_V(6); PG8_BAR; PG8_MMA(1, 1, At, B1); PG8_BAR;
            PG8_LDB(B0, 1, 0); PG8_SCHED; PG8_LDA(At, 1, 0); PG8_STAGE_A(PG8_SA(0, 1), a2, 1, last);
            PG8_WAIT_L(8); PG8_BAR; PG8_WAIT_L(0); PG8_MMA(0, 0, At, B0); PG8_BAR; PG8_SCHED;
            PG8_LDB(B1, 1, 1); PG8_STAGE(PG8_SB(1, 0), b3, voffB);
            PG8_BAR; PG8_WAIT_L(0); PG8_MMA(0, 1, At, B1); PG8_BAR;
            PG8_LDA(At, 1, 1); PG8_STAGE_A(PG8_SA(1, 0), a3, 0, last);
            PG8_BAR; PG8_WAIT_L(0); PG8_MMA(1, 0, At, B0); PG8_BAR; PG8_SCHED;
            PG8_STAGE(PG8_SB(1, 1), b3 + hstep, voffB);
            PG8_WAIT_V(6); PG8_BAR; PG8_MMA(1, 1, At, B1); PG8_BAR;
            }
        }
        if constexpr (ALIGN_EPI) { if (wr == 0) PG8_BAR; }
        if constexpr (!Epi::AFTER_DRAIN) { E(acc, cur, wr, wc, fr, fq); S.done(cur); }
        if (!has_next) break;
#pragma unroll
        for (int a = 0; a < 2; ++a)
#pragma unroll
            for (int b = 0; b < 2; ++b)
#pragma unroll
                for (int m = 0; m < 4; ++m)
#pragma unroll
                    for (int n = 0; n < 2; ++n) acc[a][b][m][n] = (f32x4){0.f, 0.f, 0.f, 0.f};
        cur = nxt; cA = nA; cB = nB; ++ui;
        if constexpr (Sched::GATHER_ROWS) {
#pragma unroll
            for (int i = 0; i < 2; ++i) { vA0[i] = nA0[i]; vA1[i] = nA1[i]; } }
        if constexpr (ALIGN_EPI) { if (wr == 1) PG8_BAR; }
    }
    PG8_WAIT_V(0);
    if constexpr (!ALIGN_EPI) { if (wr == 0) PG8_BAR; }
    PG8_BAR;
    if constexpr (Epi::AFTER_DRAIN) { E.fused(acc, cur, wr, wc, fr, fq, lds, wid, lane); S.done(cur); }
#undef PG8_SA
#undef PG8_SB
#undef PG8_STAGE
#undef PG8_STAGE_A
#undef PG8_ROWOFFS
#undef PG8_LDA
#undef PG8_LDB
#undef PG8_MMA
#undef PG8_WAIT_V
#undef PG8_WAIT_L
#undef PG8_BAR
#undef PG8_SCHED
}
}

#define PHASE_PROLOGUE \
    int tid_ = threadIdx.x; asm volatile("" : "+v"(tid_)); const int tid = tid_, lane = tid & 63, wave = tid >> 6; \
    const int G = GRID, bid = blockIdx.x; \
    const int gw = bid * 8 + wave, NGW = G * 8; \
    unsigned char* ws = P.ws; \
    bf16_t* H = (bf16_t*)(ws + WS_H); \
    bf16_t* HN = (bf16_t*)(ws + WS_HN); \
    bf16_t* A2 = (bf16_t*)(ws + WS_A2); \
    bf16_t* Qb = (bf16_t*)(ws + WS_Q); bf16_t* Kb = (bf16_t*)(ws + WS_K); bf16_t* Vb = (bf16_t*)(ws + WS_V); \
    bf16_t* REST = (bf16_t*)(ws + WS_REST); \
    bf16_t* YFB = (bf16_t*)(ws + WS_YFB); \
    bf16_t* Rr = (bf16_t*)(ws + WS_R); bf16_t* VV = (bf16_t*)(ws + WS_VV); bf16_t* KK = (bf16_t*)(ws + WS_KK); \
    bf16_t* KKA = (bf16_t*)(ws + WS_KKA); bf16_t* KD = (bf16_t*)(ws + WS_KD); \
    _Float16* LW = (_Float16*)(ws + WS_W); bf16_t* PP = (bf16_t*)(ws + WS_PP); bf16_t* QT = (bf16_t*)(ws + WS_QT); bf16_t* YT = (bf16_t*)(ws + WS_YT); bf16_t* ZT = (bf16_t*)(ws + WS_ZT); \
    bf16_t* Gg = (bf16_t*)(ws + WS_G); bf16_t* KR = (bf16_t*)(ws + WS_KR); bf16_t* LOW = (bf16_t*)(ws + WS_LOW); \
    float* BC = (float*)(ws + WS_BC); \
    bf16_t* AA = (bf16_t*)(ws + WS_AA); \
    bf16_t* HB = (bf16_t*)(ws + WS_HB); bf16_t* YB = (bf16_t*)(ws + WS_YB); \
    int* ROWTOK = (int*)(ws + WS_ROWTOK); int* EID = (int*)(ws + WS_EID); int* POS = (int*)(ws + WS_POS); int* DEST = (int*)(ws + WS_DEST); \
    float* GATE = (float*)(ws + WS_GATE); \
    bf16_t* YI = (bf16_t*)(ws + WS_YI); bf16_t* S5E = (bf16_t*)(ws + WS_E); bf16_t* CAR = (bf16_t*)(ws + WS_CAR); bf16_t* BTA = (bf16_t*)(ws + WS_BTA); bf16_t* BTC = (bf16_t*)(ws + WS_BTC); \
    unsigned* CTL = (unsigned*)(ws + WS_CTL); \
    bf16_t* WTIN = (bf16_t*)(ws + WS_WTIN); bf16_t* WTOUT = (bf16_t*)(ws + WS_WTOUT); bf16_t* WTGLU = (bf16_t*)(ws + WS_WTGLU); bf16_t* WT13 = (bf16_t*)(ws + WS_WT13); bf16_t* WT2 = (bf16_t*)(ws + WS_WT2); \
    const int vcu = (G % 8 == 0) ? (bid % 8) * (G / 8) + bid / 8 : bid; \
    const float* x = P.in[0]; const float* meta = P.in[1]; const float* norm_mix = P.in[2]; const float* norm_ffn = P.in[3]; const float* norm_final = P.in[4]; \
    const float* w_in = P.in[5]; const float* w_out = P.in[6]; const float* rpb = P.in[7]; const float* mu = P.in[8]; \
    const float* w0 = P.in[9]; const float* w_up = P.in[10]; const float* a0 = P.in[11]; const float* a_up = P.in[12]; const float* g_up = P.in[13]; \
    const float* k_k = P.in[14]; const float* k_a = P.in[15]; const float* r_k = P.in[16]; const float* lnx_g = P.in[17]; const float* lnx_b = P.in[18]; \
    const float* s5_b_re = P.in[19]; const float* s5_b_im = P.in[20]; const float* s5_lre = P.in[21]; const float* s5_lim = P.in[22]; const float* s5_ls = P.in[23]; \
    const float* s5_c_re = P.in[24]; const float* s5_c_im = P.in[25]; const float* s5_d = P.in[26]; const float* w_glu = P.in[27]; \
    const float* moe_wg = P.in[28]; const float* moe_bg = P.in[29]; const float* moe_we = P.in[30]; const float* moe_be = P.in[31]; \
    const float* moe_w1 = P.in[32]; const float* moe_w3 = P.in[33]; const float* moe_w2 = P.in[34];


__device__ __forceinline__ void transpose_half(const float* W, int N, int K, int k0, int n0, bf16_t* dstrow0, int lane) {
    const int kb = lane & 7, nq = lane >> 3;
    const float* src = W + (size_t)(k0 + 8 * kb) * N + n0 + 4 * nq;
    f32x4 v[8];
#pragma unroll
    for (int kk = 0; kk < 8; ++kk) v[kk] = *(const f32x4*)(src + (size_t)kk * N);
#pragma unroll
    for (int i = 0; i < 4; ++i) {
        u32x4 o; o.x = pk2(v[0][i], v[1][i]); o.y = pk2(v[2][i], v[3][i]); o.z = pk2(v[4][i], v[5][i]); o.w = pk2(v[6][i], v[7][i]);
        *(u32x4*)(dstrow0 + (size_t)(4 * nq + i) * K + k0 + 8 * kb) = o;
    }
}
__device__ __forceinline__ void transpose_item(const float* W, int N, int K, int k0, int n0, bf16_t* dstrow0, int lane) {
    const int kb = lane & 7, nq = lane >> 3;
    const float* src = W + (size_t)(k0 + 8 * kb) * N + n0 + 4 * nq;
    f32x4 v[8], w[8];
#pragma unroll
    for (int kk = 0; kk < 8; ++kk) { v[kk] = *(const f32x4*)(src + (size_t)kk * N); w[kk] = *(const f32x4*)(src + (size_t)kk * N + 32); }
    bf16_t* d = dstrow0 + (size_t)(4 * nq) * K + k0 + 8 * kb;
#pragma unroll
    for (int i = 0; i < 4; ++i) {
        u32x4 o; o.x = pk2(v[0][i], v[1][i]); o.y = pk2(v[2][i], v[3][i]); o.z = pk2(v[4][i], v[5][i]); o.w = pk2(v[6][i], v[7][i]);
        *(u32x4*)(d + (size_t)i * K) = o;
    }
#pragma unroll
    for (int i = 0; i < 4; ++i) {
        u32x4 o; o.x = pk2(w[0][i], w[1][i]); o.y = pk2(w[2][i], w[3][i]); o.z = pk2(w[4][i], w[5][i]); o.w = pk2(w[6][i], w[7][i]);
        *(u32x4*)(d + (size_t)(32 + i) * K) = o;
    }
}
#define CONV_DENSE_ITEMS (832 + 256 + 512 + 48)
__device__ __forceinline__ void conv_dense_item(CParams& P, int it, int lane) {
    unsigned char* ws = P.ws;
    if (it < 832) { const int kb = it / 52, nb = it % 52; transpose_item(P.in[5], INCOLS, DM, kb * 64, nb * 64, (bf16_t*)(ws + WS_WTIN) + (size_t)nb * 64 * DM, lane); return; }
    it -= 832;
    if (it < 256) { const int kb = it / 16, nb = it % 16; transpose_item(P.in[6], DM, DM, kb * 64, nb * 64, (bf16_t*)(ws + WS_WTOUT) + (size_t)nb * 64 * DM, lane); return; }
    it -= 256;
    if (it < 512) { const int kb = it / 32, nb = it % 32, n = nb * 64, half = n >> 10, c = n & 1023, row = (c >> 7) * 256 + half * 128 + (c & 127);
      transpose_item(P.in[27], 2 * DM, DM, kb * 64, n, (bf16_t*)(ws + WS_WTGLU) + (size_t)row * DM, lane); return; }
    it -= 512;
    bf16_t* lrt = (bf16_t*)(ws + WS_LRT);
    if (it < 16) { const int d = it >> 3, nb = it & 7; transpose_item(P.in[10] + (size_t)d * 64 * 512, 512, 64, 0, nb * 64, lrt + ((size_t)d * 512 + nb * 64) * 64, lane); return; }
    it -= 16;
    if (it < 16) { const int d = it >> 3, nb = it & 7; transpose_item(P.in[12] + (size_t)d * 64 * 512, 512, 64, 0, nb * 64, lrt + (size_t)2 * 512 * 64 + ((size_t)d * 512 + nb * 64) * 64, lane); return; }
    it -= 16;
    { const int kb = it >> 3, nb = it & 7; transpose_item(P.in[13], 512, 128, kb * 64, nb * 64, lrt + (size_t)4 * 512 * 64 + (size_t)nb * 64 * 128, lane); }
}
#define CONV_MOE_ITEMS (NEXP * 384)
__device__ __forceinline__ void conv_moe_item(CParams& P, int l, int it, int lane) {
    unsigned char* ws = P.ws;
    const int e = it / 384; int r = it % 384;
    if (r < 256) { const int which = r >> 7; r &= 127; const int kb = r >> 3, nb = r & 7, n = nb * 64, row = (n >> 7) * 256 + which * 128 + (n & 127);
        const float* W = (which ? P.in[33] : P.in[32]) + ((size_t)(l * NEXP + e) * DM) * DFF;
        transpose_item(W, DFF, DM, kb * 64, n, (bf16_t*)(ws + (l ? WS_WT13B : WS_WT13)) + ((size_t)e * DM + row) * DM, lane); return; }
    r -= 256;
    { const int kb = r >> 4, nb = r & 15; const float* W = P.in[34] + ((size_t)(l * NEXP + e) * DFF) * DM;
      transpose_item(W, DM, DFF, kb * 64, nb * 64, (bf16_t*)(ws + (l ? WS_WT2B : WS_WT2)) + ((size_t)e * DM + nb * 64) * DFF, lane); }
}
#ifndef FILL_Q11
#define FILL_Q11 1
#define FILL_Q12 1
#define FILL_Q15 1
#define FILL_Q22 1
#endif
#define FILL_N22 (192 * 8 * FILL_Q22)
#define FILL_A (FILL_N22 + 128 * 8 * FILL_Q15)
__device__ __forceinline__ void conv_range(CParams& P, int first, int n, int lane) {
    for (int q = 0; q < n; ++q) { const int it = first + q; if (it < CONV_MOE_ITEMS) conv_moe_item(P, 1, it, lane); }
}

template <int MODE>
__device__ __forceinline__ void meta_gemm(const bf16_t* A, const bf16_t* Bt, bf16_t* Hrows, int task, int lane) {
    const int fr = lane & 15, fq = lane >> 4, c = task * 16 + fr;
    const bf16_t* b0 = MODE == 0 ? Bt + (size_t)c * DM : Bt + (size_t)((c >> 7) * 256 + (c & 127)) * DM;
    const bf16_t* b1 = b0 + (size_t)128 * DM;
    f32x4 acc0[2], acc1[2];
    acc0[0] = acc0[1] = acc1[0] = acc1[1] = (f32x4){0.f, 0.f, 0.f, 0.f};
#pragma unroll 4
    for (int kt = 0; kt < 32; ++kt) {
        const int ko = kt * 32 + fq * 8;
        const bf16x8 a0 = *(const bf16x8*)(A + (size_t)fr * DM + ko), a1 = *(const bf16x8*)(A + (size_t)(16 + fr) * DM + ko);
        const bf16x8 bv = *(const bf16x8*)(b0 + ko);
        acc0[0] = __builtin_amdgcn_mfma_f32_16x16x32_bf16(a0, bv, acc0[0], 0, 0, 0);
        acc0[1] = __builtin_amdgcn_mfma_f32_16x16x32_bf16(a1, bv, acc0[1], 0, 0, 0);
        if (MODE == 1) { const bf16x8 bg = *(const bf16x8*)(b1 + ko);
            acc1[0] = __builtin_amdgcn_mfma_f32_16x16x32_bf16(a0, bg, acc1[0], 0, 0, 0);
            acc1[1] = __builtin_amdgcn_mfma_f32_16x16x32_bf16(a1, bg, acc1[1], 0, 0, 0); }
    }
#pragma unroll
    for (int mi = 0; mi < 2; ++mi)
#pragma unroll
        for (int j = 0; j < 4; ++j) { bf16_t* p = Hrows + (size_t)(mi * 16 + fq * 4 + j) * DM + c;
            const float add = MODE == 0 ? acc0[mi][j] : acc0[mi][j] * __builtin_amdgcn_rcpf(1.f + __expf(-acc1[mi][j]));
            *p = (bf16_t)f2bf(bf2f(*p) + add); }
}
__device__ __forceinline__ void phase_0(CParams& P, unsigned char* lds, const int ph) {
    PHASE_PROLOGUE
            for (int row = gw; row < NT; row += NGW) {
                const float* src = row < NMAIN ? x + (size_t)row * DM : meta + (size_t)((row - NMAIN) & 15) * DM;
                f32x4 v[4];
#pragma unroll
                for (int j = 0; j < 4; ++j) { v[j] = ((const f32x4*)src)[lane + 64 * j]; strow_bf16(H + (size_t)row * DM, lane, j, v[j]); }
                store_norm_bf16(v, norm_mix, HN + (size_t)row * DM, lane);
            }
    for (int it = gw; it < CONV_DENSE_ITEMS; it += NGW) conv_dense_item(P, it, lane);
}

__device__ __forceinline__ void phase_1(CParams& P, unsigned char* lds, const int ph) {
    PHASE_PROLOGUE
    pg8::ProjOrder S; S.init(HN, WTIN, bid);
    pg8::EpiProj E{Qb, Kb, Vb, REST};
    pg8::gemm_phase<pg8::EpiProj, pg8::ProjOrder, true, true>((PG8_LAS unsigned char*)lds, DM, S, E);
}

__device__ __forceinline__ void na_units(CParams& P, unsigned char* lds, const int first, const int stride) {
    PHASE_PROLOGUE
    constexpr int KST = 68, VST = 596, NKEY = 592;
    bf16_t* Ks = (bf16_t*)lds;
    bf16_t* VTs = Ks + NKEY * KST;
    float* sb = (float*)(VTs + 64 * VST);
    const bf16_t* VT = Vb;
    const int fr = lane & 15, fq = lane >> 4;
    const f32x4 zero4 = (f32x4){0.f, 0.f, 0.f, 0.f};
    u32x4 kreg[9], vreg[9];
#define NA_BAR() do { asm volatile("s_waitcnt lgkmcnt(0)" ::: "memory"); __builtin_amdgcn_s_barrier(); asm volatile("" ::: "memory"); } while (0)
#define NA_LOAD(u_) do { if ((u_) < 1024) { const int r2_ = ((u_) & 63) * 2, h_ = ((u_) >> 6) & 7, b_ = (u_) >> 9, Rb_ = min(max(r2_ - 4, 0), 120); \
        _Pragma("unroll") for (int q = 0; q < 9; ++q) { const int i = tid + 512 * q, key = i >> 3, pc = (i & 7) * 8; const int kr = min(Rb_ + (key >> 6), 127); \
            kreg[q] = *(const u32x4*)(Kb + ((size_t)b_ * SEQ + kr * 64 + (key & 63)) * 512 + h_ * 64 + pc); } \
        _Pragma("unroll") for (int q = 0; q < 9; ++q) { const int i = tid + 512 * q, dd = i / 72, rem = i - dd * 72, kr9 = rem >> 3, pc = (rem & 7) * 8; const int kr = min(Rb_ + kr9, 127); \
            vreg[q] = *(const u32x4*)(VT + (size_t)(h_ * 64 + dd) * NTP + (size_t)b_ * SEQ + kr * 64 + pc); } } } while (0)
    if (first < 1024 + 16) NA_LOAD(first);
    for (int u = first; u < 1024 + 16; u += stride) {
        const bool metau = u >= 1024;
        int b, h, r2 = 0;
        if (!metau) { r2 = (u & 63) * 2; h = (u >> 6) & 7; b = u >> 9; } else { const int m = u - 1024; b = m >> 3; h = m & 7; }
        const int Rb = min(max(r2 - 4, 0), 120);
        if (!metau) {
            if (tid < 465) sb[tid] = rpb[h * 465 + tid];
#pragma unroll
            for (int q = 0; q < 9; ++q) { const int i = tid + 512 * q, key = i >> 3, pc = (i & 7) * 8; *(u32x4*)(Ks + key * KST + pc) = kreg[q]; }
#pragma unroll
            for (int q = 0; q < 9; ++q) { const int i = tid + 512 * q, dd = i / 72, rem = i - dd * 72, kr9 = rem >> 3, pc = (rem & 7) * 8; *(u32x4*)(VTs + dd * VST + kr9 * 64 + pc) = vreg[q]; }
        }
        for (int i = tid; i < 16 * 8; i += 512) { const int key = i >> 3, pc = (i & 7) * 8;
            *(u32x4*)(Ks + (576 + key) * KST + pc) = *(const u32x4*)(Kb + ((size_t)NMAIN + b * NMETA + key) * 512 + h * 64 + pc); }
        for (int i = tid; i < 64 * 2; i += 512) { const int dd = i >> 1, pc = (i & 1) * 8;
            *(u32x4*)(VTs + dd * VST + 576 + pc) = *(const u32x4*)(VT + (size_t)(h * 64 + dd) * NTP + NMAIN + b * NMETA + pc); }
        if (u + stride < 1024 + 16) NA_LOAD(u + stride);
        NA_BAR();
        if (!metau || wave == 0) {
            const int rr = wave >> 2, qb = wave & 3, r = r2 + rr;
            const int c = qb * 16 + fr;
            const int qrow = metau ? NMAIN + b * NMETA + fr : b * SEQ + r * 64 + c;
            const int R0 = min(max(r - 4, 0), 120), cs = qb == 0 ? 0 : (qb == 1 ? 8 : (qb == 2 ? 24 : 32));
            const int C0 = min(max(c - 8, 0), 48);
            const int ro = R0 - Rb;
            const bf16x8 qf0 = *(const bf16x8*)(Qb + (size_t)qrow * 512 + h * 64 + fq * 8), qf1 = *(const bf16x8*)(Qb + (size_t)qrow * 512 + h * 64 + 32 + fq * 8);
            f32x4 sacc[17];
            if (!metau) {
#pragma unroll
                for (int kt = 0; kt < 16; ++kt) {
                    const bf16_t* kp = Ks + ((ro + (kt >> 1)) * 64 + cs + 16 * (kt & 1) + fr) * KST + fq * 8;
                    f32x4 acc = __builtin_amdgcn_mfma_f32_16x16x32_bf16(*(const bf16x8*)kp, qf0, zero4, 0, 0, 0);
                    sacc[kt] = __builtin_amdgcn_mfma_f32_16x16x32_bf16(*(const bf16x8*)(kp + 32), qf1, acc, 0, 0, 0);
                }
            } else {
#pragma unroll
                for (int kt = 0; kt < 16; ++kt) sacc[kt] = zero4;
            }
            {
                const bf16_t* kp = Ks + (576 + fr) * KST + fq * 8;
                f32x4 acc = __builtin_amdgcn_mfma_f32_16x16x32_bf16(*(const bf16x8*)kp, qf0, zero4, 0, 0, 0);
                sacc[16] = __builtin_amdgcn_mfma_f32_16x16x32_bf16(*(const bf16x8*)(kp + 32), qf1, acc, 0, 0, 0);
            }
            float mx = -1e30f;
#pragma unroll
            for (int kt = 0; kt < 16; ++kt) {
                const int dr = R0 + (kt >> 1) - r + 7;
#pragma unroll
                for (int j = 0; j < 4; ++j) {
                    const int kc = cs + 16 * (kt & 1) + 4 * fq + j;
                    const bool inb = !metau && kc >= C0 && kc < C0 + 16;
                    const int dc = min(max(kc - c + 15, 0), 30);
                    const float bias = sb[dr * 31 + dc];
                    const float sv = sacc[kt][j] * 0.125f + bias;
                    const float s = inb ? sv : -1e30f;
                    sacc[kt][j] = s; mx = fmaxf(mx, s);
                }
            }
#pragma unroll
            for (int j = 0; j < 4; ++j) { const float s = sacc[16][j] * 0.125f; sacc[16][j] = s; mx = fmaxf(mx, s); }
            mx = fmaxf(mx, __shfl_xor(mx, 16)); mx = fmaxf(mx, __shfl_xor(mx, 32));
            float sum = 0.f;
#pragma unroll
            for (int kt = 0; kt < 17; ++kt)
#pragma unroll
                for (int j = 0; j < 4; ++j) { const float pv = __expf(sacc[kt][j] - mx); sacc[kt][j] = pv; sum += pv; }
            sum += __shfl_xor(sum, 16); sum += __shfl_xor(sum, 32);
            f32x4 o[4] = {zero4, zero4, zero4, zero4};
            if (!metau) {
#pragma unroll
                for (int kr = 0; kr < 8; ++kr) {
                    union { bf16x8 v; unsigned u[4]; } bf;
                    bf.u[0] = pk2(sacc[2 * kr][0], sacc[2 * kr][1]); bf.u[1] = pk2(sacc[2 * kr][2], sacc[2 * kr][3]);
                    bf.u[2] = pk2(sacc[2 * kr + 1][0], sacc[2 * kr + 1][1]); bf.u[3] = pk2(sacc[2 * kr + 1][2], sacc[2 * kr + 1][3]);
                    const int tok0 = (ro + kr) * 64 + cs + 4 * fq;
#pragma unroll
                    for (int dt = 0; dt < 4; ++dt) {
                        const bf16_t* vp = VTs + (dt * 16 + fr) * VST + tok0;
                        union { bf16x8 v; u32x2 h2[2]; } af;
                        af.h2[0] = *(const u32x2*)vp; af.h2[1] = *(const u32x2*)(vp + 16);
                        o[dt] = __builtin_amdgcn_mfma_f32_16x16x32_bf16(af.v, bf.v, o[dt], 0, 0, 0);
                    }
                }
            }
            {
                union { bf16x8 v; unsigned u[4]; } bf;
                bf.u[0] = pk2(sacc[16][0], sacc[16][1]); bf.u[1] = pk2(sacc[16][2], sacc[16][3]); bf.u[2] = 0u; bf.u[3] = 0u;
#pragma unroll
                for (int dt = 0; dt < 4; ++dt) {
                    const bf16_t* vp = VTs + (dt * 16 + fr) * VST + 576 + 4 * fq;
                    union { bf16x8 v; u32x2 h2[2]; } af;
                    af.h2[0] = *(const u32x2*)vp; af.h2[1] = (u32x2){0u, 0u};
                    o[dt] = __builtin_amdgcn_mfma_f32_16x16x32_bf16(af.v, bf.v, o[dt], 0, 0, 0);
                }
            }
            const float inv = 1.f / sum;
#pragma unroll
            for (int dt = 0; dt < 4; ++dt) {
                u32x2 ov; ov.x = pk2(o[dt][0] * inv, o[dt][1] * inv); ov.y = pk2(o[dt][2] * inv, o[dt][3] * inv);
                *(u32x2*)(A2 + (size_t)qrow * DM + h * 64 + dt * 16 + 4 * fq) = ov;
            }
        }
        NA_BAR();
    }
#undef NA_LOAD
#undef NA_BAR
}

__device__ __forceinline__ void phase_3(CParams& P, unsigned char* lds, const int ph) {
    PHASE_PROLOGUE
    constexpr int TR = 66, NTILE = (NT + TR - 1) / TR, AST = 264, SST = 136;
    bf16_t* As = (bf16_t*)lds;
    unsigned short* stg = (unsigned short*)(lds + 80 * AST * 2);
    const bf16_t* lrt = (const bf16_t*)(ws + WS_LRT);
    const int fr = lane & 15, fq = lane >> 4;
    for (int u = bid; u < NTILE; u += G) {
        const int r0 = u * TR, nrows = min(TR, NT - r0);
#ifndef PREP_REP1
#define PREP_REP1 1
#endif
        for (int rep1_ = 0; rep1_ < PREP_REP1; ++rep1_)
        for (int rl0 = wave; rl0 < nrows; rl0 += 24) {
            u32x2 vc[3][7], vp[3][7], vn[3][7]; bool okr[3], hp[3], hn[3]; int rows[3];
#pragma unroll
            for (int q = 0; q < 3; ++q) {
                const int rl = rl0 + 8 * q; okr[q] = rl < nrows;
                const int row = okr[q] ? r0 + rl : r0; rows[q] = row;
                int b, pp_;
                if (row < NMAIN) { b = row >> 13; pp_ = (row & (SEQ - 1)) + NMETA; } else { b = (row - NMAIN) >> 4; pp_ = (row - NMAIN) & 15; }
                hp[q] = pp_ > 0; hn[q] = pp_ + 1 < LSEQ;
                const int rowp = hp[q] ? rowof(b, pp_ - 1) : row, rown = hn[q] ? rowof(b, pp_ + 1) : row;
#pragma unroll
                for (int j = 0; j < 7; ++j) { const int c = 4 * lane + 256 * j;
                    vc[q][j] = *(const u32x2*)(REST + (size_t)row * RESTC + c); vp[q][j] = *(const u32x2*)(REST + (size_t)rowp * RESTC + c); vn[q][j] = *(const u32x2*)(REST + (size_t)rown * RESTC + c); }
            }
#pragma unroll
            for (int q = 0; q < 3; ++q) {
                if (okr[q]) {
                    const int row = rows[q], rl = rl0 + 8 * q;
#pragma unroll
                    for (int j = 0; j < 7; ++j) {
                        const int c = 4 * lane + 256 * j;
                        u32x2 a = vp[q][j], bq = vn[q][j]; const u32x2 cc = vc[q][j];
                        if (!hp[q]) { a.x = 0; a.y = 0; }
                        if (!hn[q]) { bq.x = 0; bq.y = 0; }
                        const f32x4 m4 = *(const f32x4*)(mu + c);
                        const float pc[4] = {bflo(cc.x), bfhi(cc.x), bflo(cc.y), bfhi(cc.y)};
                        const float pq[4] = {bflo(a.x), bfhi(a.x), bflo(a.y), bfhi(a.y)};
                        const float pn[4] = {bflo(bq.x), bfhi(bq.x), bflo(bq.y), bfhi(bq.y)};
                        float o[4];
#pragma unroll
                        for (int i = 0; i < 4; ++i) o[i] = pc[i] + m4[i] * (0.5f * (pq[i] + pn[i]) - pc[i]);
                        if (j == 6) {
                            if (lane < 16) { for (int i = 0; i < 4; ++i) o[i] = tanhf(o[i]); }
                            else if (lane >= 32) { for (int i = 0; i < 4; ++i) o[i] = sigmoidf_(o[i]); }
                        }
                        u32x2 ov; ov.x = pk2(o[0], o[1]); ov.y = pk2(o[2], o[3]);
                        if (j < 6) { bf16_t* dst = j < 2 ? Rr + (size_t)row * 512 + c : (j < 4 ? KR + (size_t)row * 512 + (c - 512) : VV + (size_t)row * 512 + (c - 1024)); *(u32x2*)dst = ov; }
                        else *(u32x2*)(As + rl * AST + (c - 1536)) = ov;
                    }
                }
            }
        }
        __syncthreads();
#define P4_LOADB(t_, bv_, bias_) do { const int wh_ = (t_) >> 2, ct_ = (t_) & 3, Kw_ = wh_ < 4 ? 64 : 128, col_ = ct_ * 128 + 16 * wave + fr; \
            const bf16_t* Wt_ = lrt + (wh_ < 4 ? (size_t)wh_ * 512 * 64 : (size_t)4 * 512 * 64) + (size_t)col_ * Kw_ + 8 * fq; \
            bv_[0] = *(const bf16x8*)Wt_; bv_[1] = *(const bf16x8*)(Wt_ + 32); if (wh_ == 4) { bv_[2] = *(const bf16x8*)(Wt_ + 64); bv_[3] = *(const bf16x8*)(Wt_ + 96); } \
            bias_ = wh_ < 2 ? w0[wh_ * 512 + col_] : (wh_ < 4 ? a0[(wh_ - 2) * 512 + col_] : 0.f); } while (0)
        bf16x8 bnx[4], bn2[4]; float biasn, bias2;
        P4_LOADB(0, bnx, biasn); P4_LOADB(1, bn2, bias2);
#ifndef PREP_REP2
#define PREP_REP2 1
#endif
#pragma unroll 1
        for (int t_ = 0; t_ < 20 * PREP_REP2; ++t_) { const int t = t_ % 20;
            const int which = t >> 2, ct = t & 3;
            const int koff = which < 2 ? 0 : (which < 4 ? 64 : 128);
            bf16x8 bcur[4]; bcur[0] = bnx[0]; bcur[1] = bnx[1]; bcur[2] = bnx[2]; bcur[3] = bnx[3];
            const float bias = biasn;
            bnx[0] = bn2[0]; bnx[1] = bn2[1]; bnx[2] = bn2[2]; bnx[3] = bn2[3]; biasn = bias2;
            if (t_ + 2 < 20 * PREP_REP2) P4_LOADB((t + 2) % 20, bn2, bias2);
            const f32x4 zero4 = (f32x4){0.f, 0.f, 0.f, 0.f};
            f32x4 acc[5] = {zero4, zero4, zero4, zero4, zero4};
#pragma unroll
            for (int ks = 0; ks < 4; ++ks) {
                if (ks < 2 || which == 4) {
#pragma unroll
                    for (int rt = 0; rt < 5; ++rt) acc[rt] = __builtin_amdgcn_mfma_f32_16x16x32_bf16(*(const bf16x8*)(As + (16 * rt + fr) * AST + koff + 32 * ks + 8 * fq), bcur[ks], acc[rt], 0, 0, 0);
                }
            }
            unsigned short* sg = stg + (t & 1) * 80 * SST + 16 * wave + fr;
#pragma unroll
            for (int rt = 0; rt < 5; ++rt)
#pragma unroll
                for (int j = 0; j < 4; ++j) { const float val = acc[rt][j] + bias; unsigned short o;
                    if (which < 2) { const _Float16 hv = (_Float16)(-0.6065306597f * sigmoidf_(val)); o = __builtin_bit_cast(unsigned short, hv); }
                    else if (which < 4) o = (unsigned short)f2bf(sigmoidf_(val));
                    else o = (unsigned short)f2bf(val);
                    sg[(16 * rt + 4 * fq + j) * SST] = o; }
            asm volatile("s_waitcnt lgkmcnt(0)" ::: "memory"); __builtin_amdgcn_s_barrier(); asm volatile("" ::: "memory");
            {
                unsigned short* dst = which < 2 ? (unsigned short*)LW + (size_t)which * NT * 512 : (which < 4 ? (unsigned short*)AA + (size_t)(which - 2) * NT * 512 : (unsigned short*)Gg);
                for (int i = tid; i < nrows * 8; i += 512) { const int r = i >> 3, pc = (i & 7) * 16; const unsigned short* sp = stg + (t & 1) * 80 * SST + r * SST + pc;
                    unsigned short* gp = dst + (size_t)(r0 + r) * 512 + ct * 128 + pc; *(u32x4*)gp = *(const u32x4*)sp; *(u32x4*)(gp + 8) = *(const u32x4*)(sp + 8); }
            }
        }
#undef P4_LOADB
        __syncthreads();
#ifndef PREP_REP3
#define PREP_REP3 1
#endif
        for (int rep3_ = 0; rep3_ < PREP_REP3; ++rep3_)
        for (int rl = wave; rl < nrows; rl += 8) {
            const int row = r0 + rl;

                const int c0 = lane * 8;
                const u32x4 krv = *(const u32x4*)(KR + (size_t)row * 512 + c0);
                const u32x4 rv = *(const u32x4*)(Rr + (size_t)row * 512 + c0);
                float kr[8], rr[8], kkv[8];
#pragma unroll
                for (int i = 0; i < 4; ++i) { kr[2 * i] = bflo(krv[i]); kr[2 * i + 1] = bfhi(krv[i]); rr[2 * i] = bflo(rv[i]); rr[2 * i + 1] = bfhi(rv[i]); }
                float ss = 0.f;
#pragma unroll
                for (int i = 0; i < 8; ++i) { kkv[i] = kr[i] * k_k[c0 + i]; ss += kkv[i] * kkv[i]; }
                ss += __shfl_xor(ss, 1); ss += __shfl_xor(ss, 2); ss += __shfl_xor(ss, 4);
                const float inv = 1.f / fmaxf(sqrtf(ss), 1e-12f);
#pragma unroll
                for (int i = 0; i < 8; ++i) kkv[i] *= inv;
                u32x4 o; o.x = pk2(kkv[0], kkv[1]); o.y = pk2(kkv[2], kkv[3]); o.z = pk2(kkv[4], kkv[5]); o.w = pk2(kkv[6], kkv[7]);
                *(u32x4*)(KK + (size_t)row * 512 + c0) = o;
                float bsum = 0.f;
#pragma unroll
                for (int d = 0; d < 2; ++d) {
                    const u32x4 av = *(const u32x4*)(AA + ((size_t)d * NT + row) * 512 + c0);
                    float a[8], kka[8], kd[8];
#pragma unroll
                    for (int i = 0; i < 4; ++i) { a[2 * i] = bflo(av[i]); a[2 * i + 1] = bfhi(av[i]); }
#pragma unroll
                    for (int i = 0; i < 8; ++i) { kka[i] = kkv[i] * a[i]; kd[i] = kr[i] * (1.f + (a[i] - 1.f) * k_a[c0 + i]); bsum += rr[i] * kd[i] * r_k[c0 + i]; }
                    u32x4 o1; o1.x = pk2(kka[0], kka[1]); o1.y = pk2(kka[2], kka[3]); o1.z = pk2(kka[4], kka[5]); o1.w = pk2(kka[6], kka[7]);
                    *(u32x4*)(KKA + ((size_t)d * NT + row) * 512 + c0) = o1;
                    u32x4 o2; o2.x = pk2(kd[0], kd[1]); o2.y = pk2(kd[2], kd[3]); o2.z = pk2(kd[4], kd[5]); o2.w = pk2(kd[6], kd[7]);
                    *(u32x4*)(KD + ((size_t)d * NT + row) * 512 + c0) = o2;
                }
                bsum += __shfl_xor(bsum, 1); bsum += __shfl_xor(bsum, 2); bsum += __shfl_xor(bsum, 4);
                if ((lane & 7) == 0) BC[(size_t)row * 8 + (lane >> 3)] = bsum;
                    }
        __syncthreads();
    }
}

#define RWS 72
__device__ __forceinline__ bf16x8 rw_frag(const bf16_t* M, int row, int kofs) { return *(const bf16x8*)(M + row * RWS + kofs); }
__device__ __forceinline__ f32x4 rw_tile(const bf16_t* Am, int ra, const bf16_t* Bm, int rb, int fr, int fq) {
    f32x4 acc = (f32x4){0.f, 0.f, 0.f, 0.f};
    acc = __builtin_amdgcn_mfma_f32_16x16x32_bf16(rw_frag(Am, ra + fr, 8 * fq), rw_frag(Bm, rb + fr, 8 * fq), acc, 0, 0, 0);
    acc = __builtin_amdgcn_mfma_f32_16x16x32_bf16(rw_frag(Am, ra + fr, 32 + 8 * fq), rw_frag(Bm, rb + fr, 32 + 8 * fq), acc, 0, 0, 0);
    return acc;
}
__device__ __forceinline__ void phase_6(CParams& P, unsigned char* lds, const int ph) {
    PHASE_PROLOGUE
    constexpr int GST = 68, RST = 132;
    float* Gs = (float*)lds;
    bf16_t* A_rm = (bf16_t*)(lds + 64 * GST * 4); bf16_t* R_rm = A_rm + 64 * RWS; bf16_t* B_rm = R_rm + 64 * RWS; bf16_t* K_rm = B_rm + 64 * RWS;
    bf16_t* B_tr = K_rm + 64 * RWS; bf16_t* K_tr = B_tr + 64 * RWS; bf16_t* V_tr = K_tr + 64 * RWS;
    bf16_t* MAK = V_tr + 64 * RWS; bf16_t* MRB = MAK + 64 * RWS; bf16_t* MRK = MRB + 64 * RWS;
    bf16_t* MABr = MRK + 64 * RWS;
    float* RHS = (float*)(MABr + 64 * RWS);
    float* BT = RHS + 64 * RST; float* OFF = BT + 512; float* GC = OFF + 512;
    bf16_t* X1_tr = A_rm; bf16_t* X2_tr = K_rm;
    for (int i = tid; i < 4 * 64 * RWS / 2; i += 512) ((unsigned*)MAK)[i] = 0u;
    __syncthreads();
    const int fr = lane & 15, fq = lane >> 4;
#define RW1_BAR() do { asm volatile("s_waitcnt lgkmcnt(0)" ::: "memory"); __builtin_amdgcn_s_barrier(); asm volatile("" ::: "memory"); } while (0)
    const int t0 = tid & 63, kp = (tid >> 6) * 8;
    u32x4 nlw, nkk, nka, nkd, nrv, nvv;
#define RW1_LOAD(u_) do { const int ch_ = (u_) / RW_NCH, c_ = (u_) - ch_ * RW_NCH, d_ = ch_ >> 4, b_ = (ch_ >> 3) & 1, h_ = ch_ & 7, s_ = c_ * 64 + t0; \
        const int p_ = d_ ? LSEQ - 1 - s_ : s_; const size_t o_ = (size_t)rowof(b_, s_ < LSEQ ? p_ : 0) * 512 + h_ * 64 + kp; \
        nlw = *(const u32x4*)(LW + (size_t)d_ * NT * 512 + o_); nkk = *(const u32x4*)(KK + o_); nka = *(const u32x4*)(KKA + (size_t)d_ * NT * 512 + o_); \
        nkd = *(const u32x4*)(KD + (size_t)d_ * NT * 512 + o_); nrv = *(const u32x4*)(Rr + o_); nvv = *(const u32x4*)(VV + o_); } while (0)
    if (bid < RW_UNITS) RW1_LOAD(bid);
    for (int u = bid; u < RW_UNITS; u += G) {
        const int chain = u / RW_NCH, c = u - chain * RW_NCH;
        float lw[8], kk[8], ka[8], kd[8], rr[8]; u32x4 vv;
        {
            const bool valid = c * 64 + t0 < LSEQ;
            vv = nvv;
#pragma unroll
            for (int i = 0; i < 4; ++i) {
                union { unsigned u; _Float16 hh[2]; } cv; cv.u = nlw[i];
                lw[2 * i] = valid ? (float)cv.hh[0] : 0.f; lw[2 * i + 1] = valid ? (float)cv.hh[1] : 0.f;
                kk[2 * i] = valid ? bflo(nkk[i]) : 0.f; kk[2 * i + 1] = valid ? bfhi(nkk[i]) : 0.f;
                ka[2 * i] = valid ? bflo(nka[i]) : 0.f; ka[2 * i + 1] = valid ? bfhi(nka[i]) : 0.f;
                kd[2 * i] = valid ? bflo(nkd[i]) : 0.f; kd[2 * i + 1] = valid ? bfhi(nkd[i]) : 0.f;
                rr[2 * i] = valid ? bflo(nrv[i]) : 0.f; rr[2 * i + 1] = valid ? bfhi(nrv[i]) : 0.f;
                if (!valid) vv[i] = 0u;
            }
        }
        if (u + G < RW_UNITS) RW1_LOAD(u + G);
        float gg_[8];
#pragma unroll
        for (int i = 0; i < 8; ++i) {
            float v = lw[i];
            v += __int_as_float(__builtin_amdgcn_update_dpp(0, __float_as_int(v), 0x111, 0xF, 0xF, false));
            v += __int_as_float(__builtin_amdgcn_update_dpp(0, __float_as_int(v), 0x112, 0xF, 0xF, false));
            v += __int_as_float(__builtin_amdgcn_update_dpp(0, __float_as_int(v), 0x114, 0xF, 0xF, false));
            v += __int_as_float(__builtin_amdgcn_update_dpp(0, __float_as_int(v), 0x118, 0xF, 0xF, false));
            v += __int_as_float(__builtin_amdgcn_update_dpp(0, __float_as_int(v), 0x142, 0xA, 0xF, false));
            v += __int_as_float(__builtin_amdgcn_update_dpp(0, __float_as_int(v), 0x143, 0xC, 0xF, false));
            gg_[i] = v;
        }
#ifndef RW1_REP0
#define RW1_REP0 1
#endif
        for (int rep0_ = 0; rep0_ < RW1_REP0; ++rep0_) {
        {
            float va[8], vr[8], vb[8], vk[8];
#pragma unroll
            for (int i = 0; i < 8; ++i) {
                const float g = gg_[i];
                const float eg = __expf(g), egm1 = __expf(g - lw[i]), einv = __expf(-g);
                va[i] = kk[i] * egm1; vr[i] = rr[i] * eg; vb[i] = ka[i] * einv; vk[i] = kd[i] * einv;
                if (t0 == 63) GC[kp + i] = eg;
            }
            *(f32x4*)(RHS + t0 * RST + kp) = (f32x4){va[0], va[1], va[2], va[3]}; *(f32x4*)(RHS + t0 * RST + kp + 4) = (f32x4){va[4], va[5], va[6], va[7]};
            u32x4 w4;
            w4.x = pk2(va[0], va[1]); w4.y = pk2(va[2], va[3]); w4.z = pk2(va[4], va[5]); w4.w = pk2(va[6], va[7]); *(u32x4*)(A_rm + t0 * RWS + kp) = w4;
            w4.x = pk2(vr[0], vr[1]); w4.y = pk2(vr[2], vr[3]); w4.z = pk2(vr[4], vr[5]); w4.w = pk2(vr[6], vr[7]); *(u32x4*)(R_rm + t0 * RWS + kp) = w4;
            w4.x = pk2(vb[0], vb[1]); w4.y = pk2(vb[2], vb[3]); w4.z = pk2(vb[4], vb[5]); w4.w = pk2(vb[6], vb[7]); *(u32x4*)(B_rm + t0 * RWS + kp) = w4;
            w4.x = pk2(vk[0], vk[1]); w4.y = pk2(vk[2], vk[3]); w4.z = pk2(vk[4], vk[5]); w4.w = pk2(vk[6], vk[7]); *(u32x4*)(K_rm + t0 * RWS + kp) = w4;
#pragma unroll
            for (int i = 0; i < 8; ++i) { B_tr[(kp + i) * RWS + t0] = (bf16_t)f2bf(vb[i]); K_tr[(kp + i) * RWS + t0] = (bf16_t)f2bf(vk[i]);
                V_tr[(kp + i) * RWS + t0] = (bf16_t)((i & 1) ? (vv[i >> 1] >> 16) : (vv[i >> 1] & 0xffffu)); }
        }
        RW1_BAR();
        }
        float* DQ = Gs; bf16_t* TB = (bf16_t*)BT;
#ifndef RW1_REP1
#define RW1_REP1 1
#endif
#pragma unroll
        for (int s1 = 0; s1 < 5; ++s1) { const int q = wave + 8 * s1;
            const int m = q / 10, e = q - m * 10, ti = e >= 6 ? 3 : (e >= 3 ? 2 : (e >= 1 ? 1 : 0)), tj = e - (ti * (ti + 1)) / 2;
            const f32x4 acc = rw_tile(m < 2 ? A_rm : R_rm, 16 * ti, (m & 1) ? K_rm : B_rm, 16 * tj, fr, fq);
            bf16_t* Mm = m == 1 ? MAK : (m == 2 ? MRB : MRK);
#pragma unroll
            for (int j = 0; j < 4; ++j) { const int t = 16 * ti + 4 * fq + j, i = 16 * tj + fr; const bool keep = m < 2 ? (i < t) : (i <= t); const float val = keep ? acc[j] : 0.f;
                if (m == 0) { MABr[t * RWS + i] = (bf16_t)f2bf(val); if (ti == tj) DQ[((ti * 16 + (t & 15)) * 4 + (fr & 3)) * 4 + (fr >> 2)] = val; }
                else Mm[t * RWS + i] = (bf16_t)f2bf(val); }
        }
        RW1_BAR();
#ifndef RW1_REP23
#define RW1_REP23 1
#endif
        for (int rep23_ = 0; rep23_ < RW1_REP23; ++rep23_) {
        if (wave >= 4) {
            for (int q = wave - 4; q < 16; q += 4) { const int ti = q >> 2, tv = q & 3; const f32x4 acc = rw_tile(MAK, 16 * ti, V_tr, 16 * tv, fr, fq);
#pragma unroll
                for (int j = 0; j < 4; ++j) RHS[(16 * ti + 4 * fq + j) * RST + 64 + 16 * tv + fr] = acc[j]; }
        } else {
            const int bb = wave, cc = lane >> 2, q = lane & 3;
            float xs[4] = {0.f, 0.f, 0.f, 0.f};
#pragma unroll
            for (int tl = 0; tl < 16; ++tl) {
                const f32x4 mv = *(const f32x4*)(DQ + ((bb * 16 + tl) * 4 + q) * 4);
                float part = mv[0] * xs[0] + mv[1] * xs[1] + mv[2] * xs[2] + mv[3] * xs[3];
                part += dppf<0xB1>(part); part += dppf<0x4E>(part);
                const float xt = (tl == cc ? 1.f : 0.f) - part;
                xs[tl >> 2] = (tl & 3) == q ? xt : xs[tl >> 2];
            }
#pragma unroll
            for (int m = 0; m < 4; ++m) TB[(bb * 16 + 4 * m + q) * 16 + cc] = (bf16_t)f2bf(xs[m]);
        }
        RW1_BAR();
        {
            const int c0 = 16 * wave;
            f32x4 X[4];
            const f32x4 zero4 = (f32x4){0.f, 0.f, 0.f, 0.f};
#define RW1_PACK(lo_, hi_, v_) do { union { bf16x8 v; unsigned u[4]; } t_; t_.u[0] = pk2(lo_[0], lo_[1]); t_.u[1] = pk2(lo_[2], lo_[3]); t_.u[2] = pk2(hi_[0], hi_[1]); t_.u[3] = pk2(hi_[2], hi_[3]); v_ = t_.v; } while (0)
#define RW1_LDA(base_, row0_, ca_, cb_, useb_, v_) do { union { bf16x8 v; u32x2 h2[2]; } t_; t_.h2[0] = *(const u32x2*)((base_) + ((row0_) + fr) * RWS + (ca_) + 4 * fq); \
            t_.h2[1] = (useb_) ? *(const u32x2*)((base_) + ((row0_) + fr) * RWS + (cb_) + 4 * fq) : (u32x2){0u, 0u}; v_ = t_.v; } while (0)
#pragma unroll
            for (int bq = 0; bq < 4; ++bq) {
                f32x4 acc;
#pragma unroll
                for (int j = 0; j < 4; ++j) acc[j] = -RHS[(16 * bq + 4 * fq + j) * RST + c0 + fr];
                bf16x8 af, bfv;
                if (bq >= 1) { RW1_LDA(MABr, 16 * bq, 0, 16, bq >= 2, af); if (bq >= 2) RW1_PACK(X[0], X[1], bfv); else RW1_PACK(X[0], zero4, bfv);
                    acc = __builtin_amdgcn_mfma_f32_16x16x32_bf16(af, bfv, acc, 0, 0, 0); }
                if (bq == 3) { RW1_LDA(MABr, 48, 32, 0, false, af); RW1_PACK(X[2], zero4, bfv); acc = __builtin_amdgcn_mfma_f32_16x16x32_bf16(af, bfv, acc, 0, 0, 0); }
                const f32x4 wv = (f32x4){-acc[0], -acc[1], -acc[2], -acc[3]};
                { union { bf16x8 v; u32x2 h2[2]; } t_; t_.h2[0] = *(const u32x2*)(TB + (bq * 16 + fr) * 16 + 4 * fq); t_.h2[1] = (u32x2){0u, 0u}; af = t_.v; }
                RW1_PACK(wv, zero4, bfv);
                X[bq] = __builtin_amdgcn_mfma_f32_16x16x32_bf16(af, bfv, zero4, 0, 0, 0);
                bf16_t* Xm = (wave < 4 ? X1_tr : X2_tr) + ((c0 & 63) + fr) * RWS + 16 * bq + 4 * fq;
                u32x2 o; o.x = pk2(X[bq][0], X[bq][1]); o.y = pk2(X[bq][2], X[bq][3]);
                *(u32x2*)Xm = o;
            }
#undef RW1_PACK
#undef RW1_LDA
        }
        RW1_BAR();
        }
#pragma unroll
        for (int s5 = 0; s5 < 2; ++s5) {
            const int tile = wave * 2 + s5, ta = tile >> 2, tb = tile & 3;
            u32x2 o;
            {
                const f32x4 acc = rw_tile(X1_tr, 16 * ta, B_tr, 16 * tb, fr, fq);
                const int k = 16 * tb + fr, kq = 16 * ta + 4 * fq; const float gc = GC[k];
                float v[4];
#pragma unroll
                for (int j = 0; j < 4; ++j) v[j] = gc * ((kq + j == k ? 1.f : 0.f) - acc[j]);
                o.x = pk2(v[0], v[1]); o.y = pk2(v[2], v[3]);
                *(u32x2*)(PP + (size_t)u * 4096 + k * 64 + 32 * (ta >> 1) + 8 * fq + 4 * (ta & 1)) = o;
            }
            {
                const f32x4 acc = rw_tile(X1_tr, 16 * ta, MRB, 16 * tb, fr, fq);
                const int t = 16 * tb + fr, k0 = 16 * ta + 4 * fq;
                const u32x2 rv = *(const u32x2*)(R_rm + t * RWS + k0);
                o.x = pk2(bflo(rv.x) - acc[0], bfhi(rv.x) - acc[1]); o.y = pk2(bflo(rv.y) - acc[2], bfhi(rv.y) - acc[3]);
                *(u32x2*)(YT + (size_t)u * 4096 + t * 64 + 32 * (ta >> 1) + 8 * fq + 4 * (ta & 1)) = o;
            }
            {
                const f32x4 a1 = rw_tile(K_tr, 16 * ta, V_tr, 16 * tb, fr, fq), a2 = rw_tile(B_tr, 16 * ta, X2_tr, 16 * tb, fr, fq);
                const int v_ = 16 * tb + fr, k0 = 16 * ta + 4 * fq;
                const f32x4 gc = *(const f32x4*)(GC + k0);
                o.x = pk2(gc[0] * (a1[0] - a2[0]), gc[1] * (a1[1] - a2[1])); o.y = pk2(gc[2] * (a1[2] - a2[2]), gc[3] * (a1[3] - a2[3]));
                *(u32x2*)(QT + (size_t)u * 4096 + v_ * 64 + k0) = o;
            }
            {
                const f32x4 a1 = rw_tile(MRK, 16 * ta, V_tr, 16 * tb, fr, fq), a2 = rw_tile(MRB, 16 * ta, X2_tr, 16 * tb, fr, fq);
                const int v_ = 16 * tb + fr, t0_ = 16 * ta + 4 * fq;
                o.x = pk2(a1[0] - a2[0], a1[1] - a2[1]); o.y = pk2(a1[2] - a2[2], a1[3] - a2[3]);
                *(u32x2*)(ZT + (size_t)u * 4096 + v_ * 64 + t0_) = o;
            }
        }
        RW1_BAR();
    }
#undef RW1_LOAD
#undef RW1_BAR
}

__device__ __forceinline__ void s5_setup_units(CParams& P, unsigned char* lds, const int first, const int stride) {
    PHASE_PROLOGUE
    float* pwr = (float*)lds; float* pwi = pwr + 2176; float* bbr = pwi + 2176; float* bbi = bbr + 2048; float* ccr = bbi + 2048; float* cci = ccr + 2048; float* kf = cci + 2048; float* kb = kf + 4096;
    for (int gu = first; gu < 256; gu += stride) {
        const int g = gu >> 2, part = gu & 3;
        if (tid < 128) {
            const int d = tid >> 6, p = tid & 63;
            const float step = __expf(s5_ls[d * 64 + g]);
            const float lr = s5_lre[(d * 64 + g) * 64 + p], li = s5_lim[(d * 64 + g) * 64 + p];
            const float mag = expf(lr * step);
            const float abr = mag * cosf(li * step), abi = mag * sinf(li * step);
            const float den = lr * lr + li * li;
            const float zr = ((abr - 1.f) * lr + abi * li) / den, zi = (abi * lr - (abr - 1.f) * li) / den;
            float pr = 1.f, pi = 0.f;
            for (int t = 0; t < 17; ++t) { pwr[(d * 64 + p) * 17 + t] = pr; pwi[(d * 64 + p) * 17 + t] = pi; const float nr = pr * abr - pi * abi; pi = pr * abi + pi * abr; pr = nr; }
            for (int i = 0; i < 16; ++i) { const float br = s5_b_re[((size_t)(g * 64 + p)) * 16 + i], bi = s5_b_im[((size_t)(g * 64 + p)) * 16 + i];
                bbr[(d * 64 + p) * 16 + i] = zr * br - zi * bi; bbi[(d * 64 + p) * 16 + i] = zr * bi + zi * br; }
        }
        for (int idx = tid; idx < 2048; idx += 512) { const int d = idx >> 10, i = (idx >> 6) & 15, p = idx & 63;
            ccr[(d * 64 + p) * 16 + i] = s5_c_re[((size_t)(d * 64 + g) * 16 + i) * 64 + p]; cci[(d * 64 + p) * 16 + i] = s5_c_im[((size_t)(d * 64 + g) * 16 + i) * 64 + p]; }
        __syncthreads();
        {
            const int d = tid >> 8, tau = (tid >> 4) & 15, i = tid & 15;
            float acc[16];
#pragma unroll
            for (int q = 0; q < 16; ++q) acc[q] = 0.f;
            for (int p = 0; p < 64; ++p) {
                const float cr = ccr[(d * 64 + p) * 16 + i], ci = cci[(d * 64 + p) * 16 + i], pr = pwr[(d * 64 + p) * 17 + tau], pi = pwi[(d * 64 + p) * 17 + tau];
                const float xr = cr * pr - ci * pi, xi = cr * pi + ci * pr;
#pragma unroll
                for (int q = 0; q < 16; ++q) acc[q] += xr * bbr[(d * 64 + p) * 16 + q] - xi * bbi[(d * 64 + p) * 16 + q];
            }
            float* kt = (d ? kb : kf) + (tau * 16 + i) * 16;
#pragma unroll
            for (int q = 0; q < 16; ++q) kt[q] = acc[q];
        }
        __syncthreads();
        unsigned* bta = (unsigned*)(BTA + (size_t)g * 512 * 256);
        for (int idx = part * 128 * 128 + tid; idx < (part + 1) * 128 * 128; idx += 512) {
            const int row = idx >> 7, col = (idx & 127) * 2;
            float v[2];
#pragma unroll
            for (int e = 0; e < 2; ++e) {
                const int cc_ = col + e, j = cc_ >> 4, ip = cc_ & 15;
                if (row < 256) { const int t = row >> 4, i = row & 15;
                    v[e] = j < t ? kf[((t - j) * 16 + i) * 16 + ip] : (j > t ? kb[((j - t) * 16 + i) * 16 + ip] : kf[i * 16 + ip] + kb[i * 16 + ip]); }
                else { const int kp = row - 256, d = kp >> 7, part = (kp >> 6) & 1, p = kp & 63, tau = d == 0 ? 15 - j : j;
                    const float pr = pwr[(d * 64 + p) * 17 + tau], pi = pwi[(d * 64 + p) * 17 + tau], br = bbr[(d * 64 + p) * 16 + ip], bi = bbi[(d * 64 + p) * 16 + ip];
                    v[e] = part ? pr * bi + pi * br : pr * br - pi * bi; }
            }
            bta[idx] = pk2(v[0], v[1]);
        }
        unsigned* btc = (unsigned*)(BTC + (size_t)g * 256 * 256);
        for (int idx = part * 64 * 128 + tid; idx < (part + 1) * 64 * 128; idx += 512) {
            const int row = idx >> 7, col = (idx & 127) * 2, t = row >> 4, i = row & 15;
            float v[2];
#pragma unroll
            for (int e = 0; e < 2; ++e) {
                const int k = col + e, d = k >> 7, part = (k >> 6) & 1, p = k & 63, tau = d == 0 ? t + 1 : 16 - t;
                const float cr = ccr[(d * 64 + p) * 16 + i], ci = cci[(d * 64 + p) * 16 + i], pr = pwr[(d * 64 + p) * 17 + tau], pi = pwi[(d * 64 + p) * 17 + tau];
                v[e] = part ? -(cr * pi + ci * pr) : cr * pr - ci * pi;
            }
            btc[idx] = pk2(v[0], v[1]);
        }
        __syncthreads();
    }
}

__device__ __forceinline__ void phase_60(CParams& P, unsigned char* lds, const int ph) {
    PHASE_PROLOGUE
    if (bid < 32) {
        const int chain = bid, d = chain >> 4, b = (chain >> 3) & 1, h = chain & 7;
        const int fr = lane & 15, fq = lane >> 4;
        constexpr int MATB = 64 * RWS * 2, SLOT = 4 * MATB;
        bf16_t* ybuf = (bf16_t*)(lds + 3 * SLOT);
        const bool comp = wave < 4; const int vb = wave & 3, lm = wave & 3;
        const unsigned char* src = (const unsigned char*)(lm == 0 ? PP : (lm == 1 ? YT : (lm == 2 ? QT : ZT))) + (size_t)chain * RW_NCH * 8192 + lane * 16;
        u32x4 R0[8], R1[8], R2[8];
#define RW2_LD(Rx, c_) do { _Pragma("unroll") for (int i_ = 0; i_ < 8; ++i_) Rx[i_] = *(const u32x4*)(src + (size_t)(c_) * 8192 + i_ * 1024); } while (0)
#define RW2_ST(Rx, c_) do { unsigned char* dst_ = lds + ((c_) % 3) * SLOT + lm * MATB; _Pragma("unroll") for (int i_ = 0; i_ < 8; ++i_) { const int p_ = lane + 64 * i_; *(u32x4*)(dst_ + (p_ >> 3) * (RWS * 2) + (p_ & 7) * 16) = Rx[i_]; } } while (0)
#define RW2_FLUSH(c_) do { const int tl_ = 16 * lm + (lane >> 2), s_ = (c_) * 64 + tl_; const bf16_t* yb_ = ybuf + ((c_) & 1) * 64 * RWS + tl_ * RWS + 16 * (lane & 3); \
            const u32x4 y0_ = *(const u32x4*)yb_, y1_ = *(const u32x4*)(yb_ + 8); \
            if (s_ < LSEQ) { const int p_ = d ? LSEQ - 1 - s_ : s_; bf16_t* g_ = YFB + ((size_t)d * NT + rowof(b, p_)) * 512 + h * 64 + 16 * (lane & 3); *(u32x4*)g_ = y0_; *(u32x4*)(g_ + 8) = y1_; } } while (0)
        const f32x4 zero4 = (f32x4){0.f, 0.f, 0.f, 0.f};
        f32x4 S[4] = {zero4, zero4, zero4, zero4};
#define RW2_COMPUTE(c_) do { const bf16_t* sl_ = (const bf16_t*)(lds + ((c_) % 3) * SLOT); const bf16_t* sP = sl_; const bf16_t* sY = sl_ + 64 * RWS; const bf16_t* sQ = sl_ + 2 * 64 * RWS; const bf16_t* sZ = sl_ + 3 * 64 * RWS; \
            bf16_t* yo_ = ybuf + ((c_) & 1) * 64 * RWS + 16 * vb + fr; \
            union { bf16x8 v; unsigned u[4]; } bs[2]; \
            _Pragma("unroll") for (int ks = 0; ks < 2; ++ks) { bs[ks].u[0] = pk2(S[2 * ks][0], S[2 * ks][1]); bs[ks].u[1] = pk2(S[2 * ks][2], S[2 * ks][3]); \
                bs[ks].u[2] = pk2(S[2 * ks + 1][0], S[2 * ks + 1][1]); bs[ks].u[3] = pk2(S[2 * ks + 1][2], S[2 * ks + 1][3]); } \
            _Pragma("unroll") for (int tt = 0; tt < 4; ++tt) { \
                const u32x2 z2 = *(const u32x2*)(sZ + (16 * vb + fr) * RWS + 16 * tt + 4 * fq); \
                f32x4 acc = (f32x4){bflo(z2.x), bfhi(z2.x), bflo(z2.y), bfhi(z2.y)}; \
                acc = __builtin_amdgcn_mfma_f32_16x16x32_bf16(*(const bf16x8*)(sY + (16 * tt + fr) * RWS + 8 * fq), bs[0].v, acc, 0, 0, 0); \
                acc = __builtin_amdgcn_mfma_f32_16x16x32_bf16(*(const bf16x8*)(sY + (16 * tt + fr) * RWS + 32 + 8 * fq), bs[1].v, acc, 0, 0, 0); \
                _Pragma("unroll") for (int j = 0; j < 4; ++j) yo_[(16 * tt + 4 * fq + j) * RWS] = (bf16_t)f2bf(acc[j]); } \
            f32x4 Sn[4]; \
            _Pragma("unroll") for (int kt = 0; kt < 4; ++kt) { \
                const u32x2 q2 = *(const u32x2*)(sQ + (16 * vb + fr) * RWS + 16 * kt + 4 * fq); \
                f32x4 acc = (f32x4){bflo(q2.x), bfhi(q2.x), bflo(q2.y), bfhi(q2.y)}; \
                acc = __builtin_amdgcn_mfma_f32_16x16x32_bf16(*(const bf16x8*)(sP + (16 * kt + fr) * RWS + 8 * fq), bs[0].v, acc, 0, 0, 0); \
                acc = __builtin_amdgcn_mfma_f32_16x16x32_bf16(*(const bf16x8*)(sP + (16 * kt + fr) * RWS + 32 + 8 * fq), bs[1].v, acc, 0, 0, 0); \
                Sn[kt] = acc; } \
            _Pragma("unroll") for (int kt = 0; kt < 4; ++kt) S[kt] = Sn[kt]; } while (0)
#define RW2_BAR() do { asm volatile("s_waitcnt lgkmcnt(0)" ::: "memory"); __builtin_amdgcn_s_barrier(); asm volatile("" ::: "memory"); } while (0)
        if (!comp) { RW2_LD(R0, 0); RW2_ST(R0, 0); RW2_LD(R0, 1); RW2_LD(R1, 2); RW2_LD(R2, 3); }
        __syncthreads();
        for (int c = 0; c < RW_NCH; c += 3) {
            if (!comp) { if (c + 1 < RW_NCH) RW2_ST(R0, c + 1); if (c + 4 < RW_NCH) RW2_LD(R0, c + 4); if (c > 0) RW2_FLUSH(c - 1); } else RW2_COMPUTE(c);
            RW2_BAR();
            if (!comp) { if (c + 2 < RW_NCH) RW2_ST(R1, c + 2); if (c + 5 < RW_NCH) RW2_LD(R1, c + 5); RW2_FLUSH(c); } else RW2_COMPUTE(c + 1);
            RW2_BAR();
            if (!comp) { if (c + 3 < RW_NCH) RW2_ST(R2, c + 3); if (c + 6 < RW_NCH) RW2_LD(R2, c + 6); RW2_FLUSH(c + 1); } else RW2_COMPUTE(c + 2);
            RW2_BAR();
        }
        if (!comp) RW2_FLUSH(RW_NCH - 1);
#undef RW2_LD
#undef RW2_ST
#undef RW2_FLUSH
#undef RW2_COMPUTE
#undef RW2_BAR
    } else {
        na_units(P, lds, bid - 32, G - 32);
        s5_setup_units(P, lds, bid - 32, G - 32);
    }
}

__device__ __forceinline__ void phase_7(CParams& P, unsigned char* lds, const int ph) {
    PHASE_PROLOGUE
            for (int row = gw; row < NT; row += NGW) {
                const int c0 = lane * 8;
                const u32x4 yf = *(const u32x4*)(YFB + (size_t)row * 512 + c0);
                const u32x4 yb = *(const u32x4*)(YFB + ((size_t)NT + row) * 512 + c0);
                const u32x4 vv = *(const u32x4*)(VV + (size_t)row * 512 + c0);
                const u32x4 gg = *(const u32x4*)(Gg + (size_t)row * 512 + c0);
                float y[8], v[8], g[8];
#pragma unroll
                for (int i = 0; i < 4; ++i) { y[2 * i] = bflo(yf[i]) + bflo(yb[i]); y[2 * i + 1] = bfhi(yf[i]) + bfhi(yb[i]); v[2 * i] = bflo(vv[i]); v[2 * i + 1] = bfhi(vv[i]); g[2 * i] = bflo(gg[i]); g[2 * i + 1] = bfhi(gg[i]); }
                float sm = 0.f;
#pragma unroll
                for (int i = 0; i < 8; ++i) sm += y[i];
                sm += __shfl_xor(sm, 1); sm += __shfl_xor(sm, 2); sm += __shfl_xor(sm, 4);
                const float mean = sm * (1.f / 64.f);
                float vr = 0.f;
#pragma unroll
                for (int i = 0; i < 8; ++i) { const float dlt = y[i] - mean; vr += dlt * dlt; }
                vr += __shfl_xor(vr, 1); vr += __shfl_xor(vr, 2); vr += __shfl_xor(vr, 4);
                const float rstd = rsqrtf(vr * (1.f / 64.f) + 64e-5f);
                const float bc = BC[(size_t)row * 8 + (lane >> 3)];
                float o[8];
#pragma unroll
                for (int i = 0; i < 8; ++i) o[i] = ((y[i] - mean) * rstd * lnx_g[c0 + i] + lnx_b[c0 + i] + bc * v[i]) * g[i];
                u32x4 ov; ov.x = pk2(o[0], o[1]); ov.y = pk2(o[2], o[3]); ov.z = pk2(o[4], o[5]); ov.w = pk2(o[6], o[7]);
                *(u32x4*)(A2 + (size_t)row * DM + 512 + c0) = ov;
            }
}


__device__ __forceinline__ void phase_8(CParams& P, unsigned char* lds, const int ph) {
    PHASE_PROLOGUE
    if (gw < 64) meta_gemm<0>(A2 + (size_t)NMAIN * DM, WTOUT, H + (size_t)NMAIN * DM, gw, lane);
    pg8::DenseOrder S; S.init(A2, WTOUT, NMAIN, DM, DM, G, bid);
    pg8::EpiResidual E{H};
    pg8::gemm_phase<pg8::EpiResidual, pg8::DenseOrder, true, true>((PG8_LAS unsigned char*)lds, DM, S, E);
}

__device__ __forceinline__ void phase_9(CParams& P, unsigned char* lds, const int ph) {
    PHASE_PROLOGUE
            const int l = ph == 9 ? 0 : 1;
                    for (int i = bid * 512 + tid; i < MOE_MAXROWS; i += G * 512) ROWTOK[i] = 0;
    __attribute__((address_space(3))) int* lcnt = (__attribute__((address_space(3))) int*)lds;
    if (tid < NEXP) lcnt[tid] = 0;
    __syncthreads();
            const float* wg = moe_wg + (size_t)l * DM * 4; const float* bg = moe_bg + l * 4;
            for (int row = bid * 3 + wave; wave < 3 && row < NT; row += G * 3) {
                f32x4 v[4]; float ss = 0.f;
#pragma unroll
                for (int j = 0; j < 4; ++j) { v[j] = ldrow_bf16(H + (size_t)row * DM, lane, j); ss += v[j][0] * v[j][0] + v[j][1] * v[j][1] + v[j][2] * v[j][2] + v[j][3] * v[j][3]; }
                ss = wave_sum(ss);
                const float rstd = rsqrtf(ss * (1.f / DM) + 1e-6f);
                float lg[4] = {0.f, 0.f, 0.f, 0.f};
#pragma unroll
                for (int j = 0; j < 4; ++j) {
                    const f32x4 g = ((const f32x4*)(norm_ffn + l * DM))[lane + 64 * j];
#pragma unroll
                    for (int i = 0; i < 4; ++i) v[j][i] = v[j][i] * rstd * g[i];
                    u32x2 o; o.x = pk2(v[j][0], v[j][1]); o.y = pk2(v[j][2], v[j][3]);
                    ((u32x2*)(HN + (size_t)row * DM))[lane + 64 * j] = o;
#pragma unroll
                    for (int i = 0; i < 4; ++i) { const f32x4 w = *(const f32x4*)(wg + (size_t)(4 * (lane + 64 * j) + i) * 4);
                        lg[0] += v[j][i] * w[0]; lg[1] += v[j][i] * w[1]; lg[2] += v[j][i] * w[2]; lg[3] += v[j][i] * w[3]; }
                }
#pragma unroll
                for (int q = 0; q < 4; ++q) lg[q] = wave_sum(lg[q]) + bg[q];
                int grp = 0; float mx = lg[0];
#pragma unroll
                for (int q = 1; q < 4; ++q) if (lg[q] > mx) { mx = lg[q]; grp = q; }
                float den = 0.f;
#pragma unroll
                for (int q = 0; q < 4; ++q) den += __expf(lg[q] - mx);
                const float pgrp = 1.f / den;
                const float* we = moe_we + ((size_t)(l * 4 + grp) * DM) * 8;
                float le[8] = {0.f, 0.f, 0.f, 0.f, 0.f, 0.f, 0.f, 0.f};
#pragma unroll
                for (int j = 0; j < 4; ++j)
#pragma unroll
                    for (int i = 0; i < 4; ++i) { const float* wr_ = we + (size_t)(4 * (lane + 64 * j) + i) * 8; const f32x4 wa = *(const f32x4*)wr_, wb = *(const f32x4*)(wr_ + 4);
                        le[0] += v[j][i] * wa[0]; le[1] += v[j][i] * wa[1]; le[2] += v[j][i] * wa[2]; le[3] += v[j][i] * wa[3];
                        le[4] += v[j][i] * wb[0]; le[5] += v[j][i] * wb[1]; le[6] += v[j][i] * wb[2]; le[7] += v[j][i] * wb[3]; }
#pragma unroll
                for (int q = 0; q < 8; ++q) le[q] = wave_sum(le[q]) + moe_be[(l * 4 + grp) * 8 + q];
                int i1 = 0; float m1 = le[0];
#pragma unroll
                for (int q = 1; q < 8; ++q) if (le[q] > m1) { m1 = le[q]; i1 = q; }
                int i2 = (i1 + 1) & 7; float m2 = -3.0e38f;
#pragma unroll
                for (int q = 0; q < 8; ++q) if (q != i1 && le[q] > m2) { m2 = le[q]; i2 = q; }
                const float e2 = __expf(m2 - m1);
                const float g1 = pgrp / (1.f + e2), g2 = pgrp * e2 / (1.f + e2);
                if (lane == 0) {
                    const int ea = grp * 8 + i1, eb = grp * 8 + i2;
                    const int pa = __hip_atomic_fetch_add(lcnt + ea, 1, __ATOMIC_RELAXED, __HIP_MEMORY_SCOPE_WORKGROUP), pb = __hip_atomic_fetch_add(lcnt + eb, 1, __ATOMIC_RELAXED, __HIP_MEMORY_SCOPE_WORKGROUP);
                    EID[row * 2] = ea; EID[row * 2 + 1] = eb; POS[row * 2] = (int)pa; POS[row * 2 + 1] = (int)pb;
                    GATE[row * 2] = g1; GATE[row * 2 + 1] = g2;
                }
            }
    if (wave >= 3 && ph != 117) {
        int first = 0;
        if (l == 1) {
            const int c = lane < NEXP ? (int)CTL[CW_CNT(0) + lane] : 0; const int tt = (int)wave_sum((float)((c + MOE_RT - 1) / MOE_RT));
            const int r = (4 * tt - 1) & (GRID - 1);
            first = FILL_A + (GRID - 1 - r) * 8 * (FILL_Q11 + FILL_Q12);
        }
        for (int it = first + bid * 5 + wave - 3; it < CONV_MOE_ITEMS; it += G * 5) conv_moe_item(P, l, it, lane);
    }
    __syncthreads();
    if (tid < NEXP) CTL[CW_WGC + bid * NEXP + tid] = (unsigned)lcnt[tid];
}


__device__ __forceinline__ void phase_10(CParams& P, unsigned char* lds, const int ph) {
    PHASE_PROLOGUE
    const int l = ph == 10 ? 0 : 1;
    int* T = (int*)lds;
    int* psum = (int*)(lds + 32768);
    int* tots = (int*)(lds + 32768 + 2048);
    int* ps = (int*)(lds + LDS_TAB);
    {
        const int e = tid & 31, part = tid >> 5;
        int c[16]; int s_ = 0;
#pragma unroll
        for (int k = 0; k < 16; ++k) c[k] = (int)CTL[CW_WGC + (part * 16 + k) * NEXP + e];
#pragma unroll
        for (int k = 0; k < 16; ++k) s_ += c[k];
        psum[part * 32 + e] = s_;
        __syncthreads();
        int off = 0, tot = 0;
#pragma unroll
        for (int p_ = 0; p_ < 16; ++p_) { const int v = psum[p_ * 32 + e]; off += p_ < part ? v : 0; tot += v; }
#pragma unroll
        for (int k = 0; k < 16; ++k) { T[(part * 16 + k) * 32 + e] = off; off += c[k]; }
        if (part == 0) { tots[e] = tot; if (bid == 0) CTL[CW_CNT(l) + e] = (unsigned)tot; }
    }
    __syncthreads();
    if (tid == 0) { int acc_ = 0; for (int e = 0; e < NEXP; ++e) { ps[e] = acc_; acc_ += (tots[e] + MOE_RT - 1) / MOE_RT * MOE_RT; } ps[NEXP] = acc_; }
    __syncthreads();
    for (int i = bid * 512 + tid; i < NT * 2; i += G * 512) { const int row = i >> 1, w = (row % (GRID * 3)) / 3, e = EID[i]; const int dest = ps[e] + T[w * 32 + e] + POS[i]; DEST[i] = dest; ROWTOK[dest] = row; }
    __syncthreads();
}

__device__ __forceinline__ void phase_11(CParams& P, unsigned char* lds, const int ph) {
    PHASE_PROLOGUE
    const int l = ph == 11 ? 0 : 1;
    int* et = (int*)(lds + LDS_TAB);
    if (tid == 0) { int acc_ = 0; for (int e = 0; e < NEXP; ++e) { const int c = (int)CTL[CW_CNT(l) + e], n = (c + MOE_RT - 1) / MOE_RT; for (int q = 0; q < n; ++q) et[1 + acc_ + q] = e; acc_ += n; } et[0] = acc_; }
    __syncthreads();
    const int nun = et[0] * 4;
    pg8::MoeOrder<true> S{et + 1, et[0], vcu, (const char*)HN, (const char*)(l ? ws + WS_WT13B : ws + WS_WT13), 256u * DM * 2u, 256u * DM * 2u, (unsigned)DM * DM * 2u, ROWTOK};
    pg8::EpiSwiglu E{HB};
    pg8::gemm_phase<pg8::EpiSwiglu, pg8::MoeOrder<true>, true, true>((PG8_LAS unsigned char*)lds, DM, S, E);
    __syncthreads();
    { const int r = (nun - 1) & (GRID - 1);
      if (l == 0 && vcu > r) conv_range(P, FILL_A + ((vcu - r - 1) * 8 + wave) * FILL_Q11, FILL_Q11, lane); }
}

__device__ __forceinline__ void phase_12(CParams& P, unsigned char* lds, const int ph) {
    PHASE_PROLOGUE
    const int l = ph == 12 ? 0 : 1;
    int* et = (int*)(lds + LDS_TAB);
    if (tid == 0) { int acc_ = 0; for (int e = 0; e < NEXP; ++e) { const int c = (int)CTL[CW_CNT(l) + e], n = (c + MOE_RT - 1) / MOE_RT; for (int q = 0; q < n; ++q) et[1 + acc_ + q] = e; acc_ += n; } et[0] = acc_; }
    __syncthreads();
    const int nun = et[0] * 4;
    pg8::MoeOrder<false> S{et + 1, et[0], vcu, (const char*)HB, (const char*)(l ? ws + WS_WT2B : ws + WS_WT2), 256u * DFF * 2u, 256u * DFF * 2u, (unsigned)DM * DFF * 2u, nullptr};
    pg8::EpiBf16Plain E{YB, DM};
    pg8::gemm_phase<pg8::EpiBf16Plain, pg8::MoeOrder<false>, true, true>((PG8_LAS unsigned char*)lds, DFF, S, E);
    __syncthreads();
    { const int r = (nun - 1) & (GRID - 1);
      if (l == 0 && vcu > r) conv_range(P, FILL_A + (GRID - 1 - r) * 8 * FILL_Q11 + ((vcu - r - 1) * 8 + wave) * FILL_Q12, FILL_Q12, lane); }
}

__device__ __forceinline__ void phase_13(CParams& P, unsigned char* lds, const int ph) {
    PHASE_PROLOGUE
            const bool fin = ph == 21;
            for (int row = gw; row < NT; row += NGW) {
                const int d0 = DEST[row * 2], d1 = DEST[row * 2 + 1];
                const float g0 = GATE[row * 2], g1 = GATE[row * 2 + 1];
                f32x4 v[4];
#pragma unroll
                for (int j = 0; j < 4; ++j) {
                    v[j] = ldrow_bf16(H + (size_t)row * DM, lane, j);
                    const u32x2 ya = ((const u32x2*)(YB + (size_t)d0 * DM))[lane + 64 * j];
                    const u32x2 yb = ((const u32x2*)(YB + (size_t)d1 * DM))[lane + 64 * j];
                    v[j][0] += g0 * bflo(ya.x) + g1 * bflo(yb.x); v[j][1] += g0 * bfhi(ya.x) + g1 * bfhi(yb.x);
                    v[j][2] += g0 * bflo(ya.y) + g1 * bflo(yb.y); v[j][3] += g0 * bfhi(ya.y) + g1 * bfhi(yb.y);
                }
                if (!fin) {
#pragma unroll
                    for (int j = 0; j < 4; ++j) strow_bf16(H + (size_t)row * DM, lane, j, v[j]);
                    store_norm_bf16(v, norm_mix + DM, HN + (size_t)row * DM, lane);
                } else if (row < NMAIN) {
                    float ss = 0.f;
#pragma unroll
                    for (int j = 0; j < 4; ++j) ss += v[j][0] * v[j][0] + v[j][1] * v[j][1] + v[j][2] * v[j][2] + v[j][3] * v[j][3];
                    ss = wave_sum(ss);
                    const float rstd = rsqrtf(ss * (1.f / DM) + 1e-6f);
#pragma unroll
                    for (int j = 0; j < 4; ++j) { const f32x4 g = ((const f32x4*)norm_final)[lane + 64 * j]; f32x4 o;
                        o[0] = v[j][0] * rstd * g[0]; o[1] = v[j][1] * rstd * g[1]; o[2] = v[j][2] * rstd * g[2]; o[3] = v[j][3] * rstd * g[3];
                        ((f32x4*)(P.out + (size_t)row * DM))[lane + 64 * j] = o; }
                }
            }
}

__device__ __forceinline__ void phase_15(CParams& P, unsigned char* lds, const int ph) {
    PHASE_PROLOGUE
    pg8::S5OrderA S{vcu, (const char*)HN, (const char*)BTA};
    pg8::EpiS5A E{YI, S5E};
    int Kr = 256; asm volatile("" : "+s"(Kr));
    pg8::gemm_phase<pg8::EpiS5A, pg8::S5OrderA, true, true>((PG8_LAS unsigned char*)lds, Kr, S, E);
    if (vcu >= 128) conv_range(P, FILL_N22 + ((vcu - 128) * 8 + wave) * FILL_Q15, FILL_Q15, lane);
}

__device__ __forceinline__ void phase_16(CParams& P, unsigned char* lds, const int ph) {
    PHASE_PROLOGUE
    float* Ls = (float*)lds;
    for (int wg = bid; wg < NB * 64 * 2; wg += G) {
        const int d = wg & 1, g = (wg >> 1) & 63, b = wg >> 7, p = lane;
        const float step = __expf(s5_ls[d * 64 + g]);
        const float lr = s5_lre[(d * 64 + g) * 64 + p], li = s5_lim[(d * 64 + g) * 64 + p];
        const float mag = expf(lr * step);
        const float abr = mag * cosf(li * step), abi = mag * sinf(li * step);
        float ar = 1.f, ai = 0.f;
        for (int t = 0; t < 16; ++t) { const float nr = ar * abr - ai * abi; ai = ar * abi + ai * abr; ar = nr; }
        float Ar = 1.f, Ai = 0.f;
        for (int t = 0; t < 64; ++t) { const float nr = Ar * ar - Ai * ai; Ai = Ar * ai + Ai * ar; Ar = nr; }
        const bf16_t* Ep = S5E + (size_t)g * 256 + d * 128 + p;
        bf16_t* Cp = CAR + (size_t)g * 1280 * 256 + d * 128 + p;
        const int q0 = 64 * wave;
#define S5_N(q_) ({ const int c_ = d ? 512 - (q_) : (q_); c_ == 0 ? 1024 + b : b * 512 + c_ - 1; })
        float sr = 0.f, si = 0.f;
#pragma unroll 1
        for (int hb = 0; hb < 2; ++hb) {
            float er[32], ei[32];
#pragma unroll
            for (int k = 0; k < 32; ++k) { const int n = S5_N(q0 + 32 * hb + k); er[k] = bf2f(Ep[(size_t)n * 64 * 256]); ei[k] = bf2f(Ep[(size_t)n * 64 * 256 + 64]); }
#pragma unroll
            for (int k = 0; k < 32; ++k) { const float nr = ar * sr - ai * si + er[k]; si = ar * si + ai * sr + ei[k]; sr = nr; }
        }
        Ls[(wave * 64 + p) * 2] = sr; Ls[(wave * 64 + p) * 2 + 1] = si;
        __syncthreads();
        sr = 0.f; si = 0.f;
        for (int w2 = 0; w2 < wave; ++w2) { const float l0 = Ls[(w2 * 64 + p) * 2], l1 = Ls[(w2 * 64 + p) * 2 + 1]; const float nr = Ar * sr - Ai * si + l0; si = Ar * si + Ai * sr + l1; sr = nr; }
#pragma unroll 1
        for (int hb = 0; hb < 2; ++hb) {
            float er[32], ei[32]; int nn[32];
#pragma unroll
            for (int k = 0; k < 32; ++k) { nn[k] = S5_N(q0 + 32 * hb + k); er[k] = bf2f(Ep[(size_t)nn[k] * 64 * 256]); ei[k] = bf2f(Ep[(size_t)nn[k] * 64 * 256 + 64]); }
#pragma unroll
            for (int k = 0; k < 32; ++k) { Cp[(size_t)nn[k] * 256] = (bf16_t)f2bf(sr); Cp[(size_t)nn[k] * 256 + 64] = (bf16_t)f2bf(si);
                const float nr = ar * sr - ai * si + er[k]; si = ar * si + ai * sr + ei[k]; sr = nr; }
        }
        if (wave == 7) { const int n = S5_N(512); Cp[(size_t)n * 256] = (bf16_t)f2bf(sr); Cp[(size_t)n * 256 + 64] = (bf16_t)f2bf(si); }
#undef S5_N
        __syncthreads();
    }
}

__device__ __forceinline__ void phase_22(CParams& P, unsigned char* lds, const int ph) {
    PHASE_PROLOGUE
    pg8::S5OrderC S{vcu, (const char*)CAR, (const char*)BTC};
    pg8::EpiS5C E{YI, HN, s5_d, A2};
    int Kr = 256; asm volatile("" : "+s"(Kr));
    pg8::gemm_phase<pg8::EpiS5C, pg8::S5OrderC, true, true>((PG8_LAS unsigned char*)lds, Kr, S, E);
    if (vcu >= 64) conv_range(P, ((vcu - 64) * 8 + wave) * FILL_Q22, FILL_Q22, lane);
}

__device__ __forceinline__ void phase_23(CParams& P, unsigned char* lds, const int ph) {
    PHASE_PROLOGUE
    if (gw < 64) meta_gemm<1>(A2 + (size_t)NMAIN * DM, WTGLU, H + (size_t)NMAIN * DM, gw, lane);
    pg8::DenseOrder S; S.init(A2, WTGLU, NMAIN, 2 * DM, DM, G, bid);
    pg8::EpiGlu E{H};
    pg8::gemm_phase<pg8::EpiGlu, pg8::DenseOrder, true, true>((PG8_LAS unsigned char*)lds, DM, S, E);
}
#define LAS __attribute__((address_space(3)))
#define CW_BAR 4096
#define XB_TMO      128
#define XB_XCNT(j)  (256  + 64 * (j))
#define XB_XSUB(j)  (1280 + 64 * (j))
#define XB_XGEN(j)  (2304 + 64 * (j))
#define XB_TOP      3328
#define XB_TOPGEN   3392
#define XCD_BAR_WORDS 3456
#define XB_SPIN_CAP (1u << 22)
__device__ __forceinline__ unsigned xb_ld(unsigned* p)              { return __hip_atomic_load(p, __ATOMIC_RELAXED, __HIP_MEMORY_SCOPE_AGENT); }
__device__ __forceinline__ unsigned xb_add(unsigned* p, unsigned v) { return __hip_atomic_fetch_add(p, v, __ATOMIC_RELAXED, __HIP_MEMORY_SCOPE_AGENT); }
__device__ __forceinline__ unsigned xb_xcc_id() { return (unsigned)__builtin_amdgcn_s_getreg((3 << 11) | 20) & 0xFu; }
#define XB_SPIN(cond, bar) do { unsigned _sp = 0; while (cond) { __builtin_amdgcn_s_sleep(1); \
    if ((++_sp & 255u) == 0u) { if (xb_ld(&(bar)[XB_TMO])) break; if (_sp > XB_SPIN_CAP) { atomicAdd(&(bar)[XB_TMO], 1u); break; } } } } while (0)
struct XcdBarrier { unsigned* bar; unsigned x; volatile LAS unsigned* st; };
__device__ __forceinline__ XcdBarrier xcd_barrier_post(unsigned* bar, volatile LAS unsigned* st) {
    XcdBarrier b; b.bar = bar; b.x = xb_xcc_id(); b.st = st;
    if (threadIdx.x == 0) (void)xb_add(&bar[XB_XCNT(b.x)], 1u);
    return b;
}
__device__ __forceinline__ void xcd_barrier_complete(unsigned* bar, unsigned x, unsigned& nloc, unsigned& nx) {
    const unsigned G = GRID;
    unsigned sum, cnt, mine, sp = 0u;
    for (;;) {
        sum = 0u; cnt = 0u; mine = 0u;
#pragma unroll
        for (unsigned j = 0; j < 16; ++j) { const unsigned c = xb_ld(&bar[XB_XCNT(j)]); sum += c; cnt += (c > 0u) ? 1u : 0u; mine = (j == x) ? c : mine; }
        if (sum == G) break;
        __builtin_amdgcn_s_sleep(1);
        if ((++sp & 255u) == 0u) { if (xb_ld(&bar[XB_TMO])) break; if (sp > XB_SPIN_CAP) { atomicAdd(&bar[XB_TMO], 1u); break; } }
    }
    nloc = mine > 0u ? mine : 1u; nx = cnt > 0u ? cnt : 1u;
}
__device__ __forceinline__ void xcd_barrier(const XcdBarrier& b) {
    asm volatile("s_waitcnt vmcnt(0)" ::: "memory");
    __syncthreads();
    if (threadIdx.x == 0) {
        unsigned* bar = b.bar;
        __builtin_amdgcn_s_waitcnt(0);
        unsigned nloc = b.st[0], nx = b.st[1];
        if (nloc == 0u) { xcd_barrier_complete(bar, b.x, nloc, nx); b.st[0] = nloc; b.st[1] = nx; }
        const unsigned old = xb_add(&bar[XB_XSUB(b.x)], 1u);
        const unsigned gen = old / nloc;
        if (old + 1u == (gen + 1u) * nloc) {
            __builtin_amdgcn_fence(__ATOMIC_RELEASE, "agent");
            asm volatile("s_waitcnt vmcnt(0)" ::: "memory");
            const unsigned og = xb_add(&bar[XB_TOP], 1u);
            const unsigned tg = og / nx;
            if (og + 1u == (tg + 1u) * nx) xb_add(&bar[XB_TOPGEN], 1u);
            else XB_SPIN(xb_ld(&bar[XB_TOPGEN]) == tg, bar);
            __builtin_amdgcn_fence(__ATOMIC_ACQUIRE, "agent");
            xb_add(&bar[XB_XGEN(b.x)], 1u);
            asm volatile("s_waitcnt vmcnt(0)" ::: "memory");
        } else {
            XB_SPIN(xb_ld(&bar[XB_XGEN(b.x)]) == gen, bar);
            __builtin_amdgcn_fence(__ATOMIC_ACQUIRE, "agent");
            asm volatile("s_waitcnt vmcnt(0)" ::: "memory");
        }
    }
    __syncthreads();
}


__global__ void __launch_bounds__(512, 2) mega(Params P_) {
    extern __shared__ __attribute__((aligned(16))) unsigned char lds[];
    volatile LAS unsigned* st = (volatile LAS unsigned*)(LAS unsigned char*)(lds + LDS_BARST);
    if (threadIdx.x < 16) st[threadIdx.x] = 0u;
    __syncthreads();
    CParams* pp = (CParams*)__builtin_amdgcn_kernarg_segment_ptr();
    (void)xcd_barrier_post((unsigned*)(pp->ws + WS_CTL) + CW_BAR, st);
#define GB do { XcdBarrier bar_; bar_.bar = (unsigned*)(pp->ws + WS_CTL) + CW_BAR; bar_.x = xb_xcc_id(); bar_.st = (volatile LAS unsigned*)(LAS unsigned char*)(lds + LDS_BARST); xcd_barrier(bar_); asm volatile("" : "+s"(pp)); } while (0)
#define P (*pp)
    asm volatile("" : "+s"(pp));
    phase_0(P, lds, 0); GB;
#if defined(PROBE_PH) && PROBE_PH == 0
    { int nrep = PROBE_N; asm volatile("" : "+s"(nrep)); for (int rep = 0; rep < nrep; ++rep) { GB; phase_0(P, lds, 0); GB; } }
#endif
    phase_1(P, lds, 1); GB;
#if defined(PROBE_PH) && PROBE_PH == 1
    { int nrep = PROBE_N; asm volatile("" : "+s"(nrep)); for (int rep = 0; rep < nrep; ++rep) { GB; phase_1(P, lds, 1); GB; } }
#endif
    phase_3(P, lds, 3); GB;
#if defined(PROBE_PH) && PROBE_PH == 3
    { int nrep = PROBE_N; asm volatile("" : "+s"(nrep)); for (int rep = 0; rep < nrep; ++rep) { GB; phase_3(P, lds, 3); GB; } }
#endif
    phase_6(P, lds, 6); GB;
    phase_60(P, lds, 60); GB;
#if defined(PROBE_PH) && PROBE_PH == 60
    { int nrep = PROBE_N; asm volatile("" : "+s"(nrep)); for (int rep = 0; rep < nrep; ++rep) { GB; phase_60(P, lds, 60); GB; } }
#endif
#if defined(PROBE_PH) && PROBE_PH == 6
    { int nrep = PROBE_N; asm volatile("" : "+s"(nrep)); for (int rep = 0; rep < nrep; ++rep) { GB; phase_6(P, lds, 6); GB; } }
#endif
    phase_7(P, lds, 7); GB;
#if defined(PROBE_PH) && PROBE_PH == 7
    { int nrep = PROBE_N; asm volatile("" : "+s"(nrep)); for (int rep = 0; rep < nrep; ++rep) { GB; phase_7(P, lds, 7); GB; } }
#endif
    phase_8(P, lds, 8); GB;
#if defined(PROBE_PH) && PROBE_PH == 8
    { int nrep = PROBE_N; asm volatile("" : "+s"(nrep)); for (int rep = 0; rep < nrep; ++rep) { GB; phase_8(P, lds, 8); GB; } }
#endif
    phase_9(P, lds, 9); GB;
#if defined(PROBE_PH) && PROBE_PH == 9
    { int nrep = PROBE_N; asm volatile("" : "+s"(nrep)); for (int rep = 0; rep < nrep; ++rep) { GB; phase_9(P, lds, 9); GB; } }
#endif
    phase_10(P, lds, 10); GB;
#if defined(PROBE_PH) && PROBE_PH == 10
    { int nrep = PROBE_N; asm volatile("" : "+s"(nrep)); for (int rep = 0; rep < nrep; ++rep) { GB; phase_10(P, lds, 10); GB; } }
#endif
    phase_11(P, lds, 11); GB;
#if defined(PROBE_PH) && PROBE_PH == 11
    { int nrep = PROBE_N; asm volatile("" : "+s"(nrep)); for (int rep = 0; rep < nrep; ++rep) { GB; phase_11(P, lds, 11); GB; } }
#endif
    phase_12(P, lds, 12); GB;
#if defined(PROBE_PH) && PROBE_PH == 12
    { int nrep = PROBE_N; asm volatile("" : "+s"(nrep)); for (int rep = 0; rep < nrep; ++rep) { GB; phase_12(P, lds, 12); GB; } }
#endif
    phase_13(P, lds, 13); GB;
#if defined(PROBE_PH) && PROBE_PH == 13
    { int nrep = PROBE_N; asm volatile("" : "+s"(nrep)); for (int rep = 0; rep < nrep; ++rep) { GB; phase_13(P, lds, 13); GB; } }
#endif
    phase_15(P, lds, 15); GB;
#if defined(PROBE_PH) && PROBE_PH == 15
    { int nrep = PROBE_N; asm volatile("" : "+s"(nrep)); for (int rep = 0; rep < nrep; ++rep) { GB; phase_15(P, lds, 15); GB; } }
#endif
    phase_16(P, lds, 16); GB;
#if defined(PROBE_PH) && PROBE_PH == 16
    { int nrep = PROBE_N; asm volatile("" : "+s"(nrep)); for (int rep = 0; rep < nrep; ++rep) { GB; phase_16(P, lds, 16); GB; } }
#endif
    phase_22(P, lds, 22); GB;
#if defined(PROBE_PH) && PROBE_PH == 22
    { int nrep = PROBE_N; asm volatile("" : "+s"(nrep)); for (int rep = 0; rep < nrep; ++rep) { GB; phase_22(P, lds, 22); GB; } }
#endif
    phase_23(P, lds, 23); GB;
#if defined(PROBE_PH) && PROBE_PH == 23
    { int nrep = PROBE_N; asm volatile("" : "+s"(nrep)); for (int rep = 0; rep < nrep; ++rep) { GB; phase_23(P, lds, 23); GB; } }
#endif
    phase_9(P, lds, 17); GB;
#if defined(PROBE_PH) && (PROBE_PH == 17 || PROBE_PH == 117)
    { int nrep = PROBE_N; asm volatile("" : "+s"(nrep)); for (int rep = 0; rep < nrep; ++rep) { GB; if (blockIdx.x == 0 && threadIdx.x < 32) ((unsigned*)(pp->ws + WS_CTL))[CW_CNT(1) + threadIdx.x] = 0u; GB; phase_9(P, lds, PROBE_PH); GB; } }
#endif
    phase_10(P, lds, 18); GB;
#if defined(PROBE_PH) && PROBE_PH == 18
    { int nrep = PROBE_N; asm volatile("" : "+s"(nrep)); for (int rep = 0; rep < nrep; ++rep) { GB; phase_10(P, lds, 18); GB; } }
#endif
    phase_11(P, lds, 19); GB;
#if defined(PROBE_PH) && PROBE_PH == 19
    { int nrep = PROBE_N; asm volatile("" : "+s"(nrep)); for (int rep = 0; rep < nrep; ++rep) { GB; phase_11(P, lds, 19); GB; } }
#endif
    phase_12(P, lds, 20); GB;
#if defined(PROBE_PH) && PROBE_PH == 20
    { int nrep = PROBE_N; asm volatile("" : "+s"(nrep)); for (int rep = 0; rep < nrep; ++rep) { GB; phase_12(P, lds, 20); GB; } }
#endif
    phase_13(P, lds, 21);
#if defined(PROBE_PH) && PROBE_PH == 21
    { int nrep = PROBE_N; asm volatile("" : "+s"(nrep)); for (int rep = 0; rep < nrep; ++rep) { GB; phase_13(P, lds, 21); GB; } }
#endif
#undef P
#undef GB
}

extern "C" void kernel_launch(void* const* d_in, const int* in_sizes, int n_in, void* d_out, int out_size, void* d_ws, size_t ws_size, hipStream_t stream) {
    static int ready = 0;
    if (!ready) {
        if (n_in != 35 || ws_size < WS_TOTAL) { fprintf(stderr, "kernel_launch: unexpected n_in %d or ws_size %zu (need %zu)\n", n_in, ws_size, (size_t)WS_TOTAL); ready = -1; return; }
        if (hipFuncSetAttribute((const void*)mega, hipFuncAttributeMaxDynamicSharedMemorySize, LDS_BYTES) != hipSuccess) { fprintf(stderr, "kernel_launch: hipFuncSetAttribute failed\n"); ready = -1; return; }
        ready = 1;
    }
    if (ready < 0) return;
    (void)hipMemsetAsync((char*)d_ws + WS_CTL, 0, 1 * MiB, stream);
    Params P{};
    for (int i = 0; i < 35; ++i) P.in[i] = (const float*)d_in[i];
    P.out = (float*)d_out; P.ws = (unsigned char*)d_ws; P.ph_lo = 0; P.ph_hi = 0;
    hipLaunchKernelGGL(mega, dim3(GRID), dim3(512), LDS_BYTES, stream, P);
}
```

```cpp
#include <hip/hip_runtime.h>
#include <stdint.h>
#include <stdio.h>

#define DM 1024
#define NB 2
#define SEQ 8192
#define NMETA 16
#define LSEQ (SEQ + NMETA)
#define NMAIN (NB * SEQ)
#define NT (NB * LSEQ)
#define NTP 16640
#define INCOLS 3328
#define RESTC 1792
#define NEXP 32
#define DFF 512
#define S5TC 48
#define S5NC 171
#define MOE_RT 256
#define MOE_MAXROWS 41216

typedef unsigned short bf16_t;
typedef short bf16x8 __attribute__((ext_vector_type(8)));
typedef float f32x4 __attribute__((ext_vector_type(4)));
typedef unsigned u32x4 __attribute__((ext_vector_type(4)));
typedef unsigned u32x2 __attribute__((ext_vector_type(2)));

constexpr size_t MiB = 1u << 20;
constexpr size_t cmax2(size_t a, size_t b) { return a > b ? a : b; }
constexpr size_t al64k(size_t x) { return (x + 65535) & ~(size_t)65535; }
constexpr size_t WS_CTL = 0;
constexpr size_t WS_H = 1 * MiB;
constexpr size_t WS_HN = WS_H + al64k((size_t)NT * DM * 2);
constexpr size_t WS_A2 = WS_HN + al64k((size_t)NTP * DM * 2);
constexpr size_t WS_WTIN = WS_A2 + al64k((size_t)NTP * DM * 2);
constexpr size_t WS_WTOUT = WS_WTIN + al64k((size_t)INCOLS * DM * 2);
constexpr size_t WS_WTGLU = WS_WTOUT + al64k((size_t)DM * DM * 2);
constexpr size_t WS_LRT = WS_WTGLU + al64k((size_t)2 * DM * DM * 2);
constexpr size_t WS_BIG = WS_LRT + al64k((size_t)(2 * 512 * 64 * 2 + 512 * 128) * 2);
constexpr size_t SZ_T512 = al64k((size_t)NT * 512 * 2);
constexpr size_t SZ_P512 = al64k((size_t)NTP * 512 * 2);
constexpr int RW_NCH = 129, RW_UNITS = 32 * RW_NCH;
constexpr size_t SZ_RWOP = al64k((size_t)RW_UNITS * 4096 * 2);
constexpr size_t WS_Q = WS_BIG;
constexpr size_t WS_K = WS_Q + SZ_P512;
constexpr size_t WS_V = WS_K + SZ_P512;
constexpr size_t WS_REST = WS_V + SZ_P512;
constexpr size_t WS_KR = WS_REST + al64k((size_t)NTP * RESTC * 2);
constexpr size_t WS_LOW = WS_KR + SZ_T512;
constexpr size_t WS_AA = WS_LOW + al64k((size_t)NT * 256 * 2);
constexpr size_t WS_XEARLY = WS_AA + 2 * SZ_T512;
constexpr size_t WS_PP = WS_REST;
constexpr size_t WS_QT = WS_PP + SZ_RWOP;
constexpr size_t WS_YT = WS_QT + SZ_RWOP;
constexpr size_t WS_ZT = WS_YT + SZ_RWOP;
constexpr size_t WS_XEND = cmax2(WS_XEARLY, WS_ZT + SZ_RWOP);
constexpr size_t WS_R = WS_XEND;
constexpr size_t WS_VV = WS_R + SZ_T512;
constexpr size_t WS_G = WS_VV + SZ_T512;
constexpr size_t WS_KK = WS_G + SZ_T512;
constexpr size_t WS_KKA = WS_KK + SZ_T512;
constexpr size_t WS_KD = WS_KKA + 2 * SZ_T512;
constexpr size_t WS_W = WS_KD + 2 * SZ_T512;
constexpr size_t WS_BC = WS_W + 2 * SZ_T512;
constexpr size_t WS_MIXEND = WS_BC + al64k((size_t)NT * 8 * 4);
constexpr size_t WS_YFB = WS_KK;
constexpr size_t WS_ROWTOK = WS_BIG;
constexpr size_t WS_HB = WS_ROWTOK + al64k((size_t)MOE_MAXROWS * 4);
constexpr size_t WS_YB = WS_HB + al64k((size_t)MOE_MAXROWS * DFF * 2);
constexpr size_t WS_WT13 = WS_YB + al64k((size_t)MOE_MAXROWS * DM * 2);
constexpr size_t WS_WT2 = WS_WT13 + al64k((size_t)NEXP * DM * DM * 2);
constexpr size_t WS_EID = WS_WT2 + al64k((size_t)NEXP * DM * DFF * 2);
constexpr size_t WS_POS = WS_EID + al64k((size_t)NT * 8);
constexpr size_t WS_DEST = WS_POS + al64k((size_t)NT * 8);
constexpr size_t WS_GATE = WS_DEST + al64k((size_t)NT * 8);
constexpr size_t WS_WT13B = WS_GATE + al64k((size_t)NT * 8);
constexpr size_t WS_WT2B = WS_WT13B + al64k((size_t)NEXP * DM * DM * 2);
constexpr size_t WS_MOEEND = WS_WT2B + al64k((size_t)NEXP * DM * DFF * 2);
constexpr size_t WS_YI = WS_BIG;
constexpr size_t WS_E = WS_YI + al64k((size_t)NTP * DM * 2);
constexpr size_t WS_CAR = WS_E + al64k((size_t)1040 * 64 * 256 * 2);
constexpr size_t WS_S5END = WS_CAR + al64k((size_t)64 * 1280 * 256 * 2);
constexpr size_t WS_BTA = cmax2(WS_MIXEND, cmax2(WS_MOEEND, WS_S5END));
constexpr size_t WS_BTC = WS_BTA + al64k((size_t)64 * 512 * 256 * 2);
constexpr size_t WS_BTEND = WS_BTC + al64k((size_t)64 * 256 * 256 * 2);
constexpr size_t cmax(size_t a, size_t b) { return a > b ? a : b; }
constexpr size_t WS_TOTAL = WS_BTEND;
static_assert(WS_TOTAL <= 512 * MiB, "workspace map exceeds 512 MiB");

#define CW_CNT(l) (1024 + 64 * (l))
#define CW_WGC 16384

#define LDS_BYTES 163840
#define LDS_BARST (LDS_BYTES - 1024)
#define LDS_TAB (LDS_BYTES - 768)
#define LDS_RING (LDS_BYTES - 1024)
#define GRID 256

struct Params {
    const float* in[35];
    float* out;
    unsigned char* ws;
    int ph_lo, ph_hi;
};
typedef const __attribute__((address_space(4))) Params CParams;

__device__ __forceinline__ float bf2f(bf16_t v) { return __uint_as_float(((unsigned)v) << 16); }
typedef float f32x2c_ __attribute__((ext_vector_type(2)));
typedef __bf16 bf16x2c_ __attribute__((ext_vector_type(2)));
__device__ __forceinline__ unsigned pk2(float lo, float hi) { const f32x2c_ f = {lo, hi}; const bf16x2c_ b = __builtin_convertvector(f, bf16x2c_); return __builtin_bit_cast(unsigned, b); }
__device__ __forceinline__ unsigned f2bf(float f) { return (unsigned)__builtin_bit_cast(unsigned short, (__bf16)f); }
__device__ __forceinline__ float bflo(unsigned u) { return __uint_as_float(u << 16); }
__device__ __forceinline__ float bfhi(unsigned u) { return __uint_as_float(u & 0xffff0000u); }
template <int CTRL> __device__ __forceinline__ float dppf(float v) { return __int_as_float(__builtin_amdgcn_update_dpp(0, __float_as_int(v), CTRL, 0xF, 0xF, true)); }
__device__ __forceinline__ float row16_sum(float v) { v += dppf<0xB1>(v); v += dppf<0x4E>(v); v += dppf<0x141>(v); v += dppf<0x140>(v); return v; }
__device__ __forceinline__ float wave_sum(float v) {
    v = row16_sum(v);
    { const unsigned xu = __float_as_uint(v); const auto sw = __builtin_amdgcn_permlane16_swap(xu, xu, false, false); v = __uint_as_float(sw[0]) + __uint_as_float(sw[1]); }
    { const unsigned xu = __float_as_uint(v); const auto sw = __builtin_amdgcn_permlane32_swap(xu, xu, false, false); v = __uint_as_float(sw[0]) + __uint_as_float(sw[1]); }
    return v;
}
__device__ __forceinline__ float wave_max(float v) {
    v = fmaxf(v, dppf<0xB1>(v)); v = fmaxf(v, dppf<0x4E>(v)); v = fmaxf(v, dppf<0x141>(v)); v = fmaxf(v, dppf<0x140>(v));
    { const unsigned xu = __float_as_uint(v); const auto sw = __builtin_amdgcn_permlane16_swap(xu, xu, false, false); v = fmaxf(__uint_as_float(sw[0]), __uint_as_float(sw[1])); }
    { const unsigned xu = __float_as_uint(v); const auto sw = __builtin_amdgcn_permlane32_swap(xu, xu, false, false); v = fmaxf(__uint_as_float(sw[0]), __uint_as_float(sw[1])); }
    return v;
}
__device__ __forceinline__ float sigmoidf_(float x) { return __builtin_amdgcn_rcpf(1.f + __expf(-x)); }
__device__ __forceinline__ int rowof(int b, int p) { return p < NMETA ? NMAIN + b * NMETA + p : b * SEQ + (p - NMETA); }

#define SA_STRIDE 40
template <class AF, class BF>
__device__ __forceinline__ void gemm_tile(unsigned char* lds, int K, int ldb, const AF& arow, const BF& bcol, f32x4 (&acc)[4][2]) {
    bf16_t* sA = (bf16_t*)lds;
    bf16_t* sB = (bf16_t*)(lds + 128 * SA_STRIDE * 2);
    const int tid = threadIdx.x, lane = tid & 63, wave = tid >> 6, wr = wave >> 2, wc = wave & 3, fr = lane & 15, fq = lane >> 4;
#pragma unroll
    for (int mi = 0; mi < 4; ++mi)
#pragma unroll
        for (int ni = 0; ni < 2; ++ni) acc[mi][ni] = (f32x4){0.f, 0.f, 0.f, 0.f};
    const int ar = tid >> 2, akc = (tid & 3) * 8;
    const bf16_t* ap = arow(ar) + akc;
    const int bnq = (tid & 31) * 4, bkp = (tid >> 5) * 2;
    const float* bp = bcol(bnq) + (size_t)bkp * ldb;
    const int nk = K / 32;
    u32x4 ra = *(const u32x4*)ap;
    f32x4 rb0 = *(const f32x4*)bp, rb1 = *(const f32x4*)(bp + ldb);
    for (int kt = 0; kt < nk; ++kt) {
        __syncthreads();
        *(u32x4*)(sA + ar * SA_STRIDE + akc) = ra;
        {
            unsigned* d = (unsigned*)(sB + bnq * SA_STRIDE + bkp);
            d[0 * (SA_STRIDE / 2)] = pk2(rb0[0], rb1[0]);
            d[1 * (SA_STRIDE / 2)] = pk2(rb0[1], rb1[1]);
            d[2 * (SA_STRIDE / 2)] = pk2(rb0[2], rb1[2]);
            d[3 * (SA_STRIDE / 2)] = pk2(rb0[3], rb1[3]);
        }
        __syncthreads();
        if (kt + 1 < nk) {
            ra = *(const u32x4*)(ap + (kt + 1) * 32);
            const float* q = bp + (size_t)(kt + 1) * 32 * ldb;
            rb0 = *(const f32x4*)q; rb1 = *(const f32x4*)(q + ldb);
        }
        bf16x8 a[4], b[2];
#pragma unroll
        for (int mi = 0; mi < 4; ++mi) a[mi] = *(const bf16x8*)(sA + (wr * 64 + mi * 16 + fr) * SA_STRIDE + fq * 8);
#pragma unroll
        for (int ni = 0; ni < 2; ++ni) b[ni] = *(const bf16x8*)(sB + (wc * 32 + ni * 16 + fr) * SA_STRIDE + fq * 8);
#pragma unroll
        for (int mi = 0; mi < 4; ++mi)
#pragma unroll
            for (int ni = 0; ni < 2; ++ni) acc[mi][ni] = __builtin_amdgcn_mfma_f32_16x16x32_bf16(a[mi], b[ni], acc[mi][ni], 0, 0, 0);
    }
    __syncthreads();
}
#define ACC_FOREACH(acc, ...) do { const int _l = threadIdx.x & 63, _w = threadIdx.x >> 6, _wr = _w >> 2, _wc = _w & 3, _fr = _l & 15, _fq = _l >> 4; \
    _Pragma("unroll") for (int _mi = 0; _mi < 4; ++_mi) _Pragma("unroll") for (int _ni = 0; _ni < 2; ++_ni) _Pragma("unroll") for (int _j = 0; _j < 4; ++_j) { \
        const int rl = _wr * 64 + _mi * 16 + _fq * 4 + _j, cl = _wc * 32 + _ni * 16 + _fr; const float val = acc[_mi][_ni][_j]; __VA_ARGS__ } } while (0)
#define ACC_FOREACH_PAIR(acc, ...) do { const int _l = threadIdx.x & 63, _w = threadIdx.x >> 6, _wr = _w >> 2, _wc = _w & 3, _fr = _l & 15, _fq = _l >> 4; \
    _Pragma("unroll") for (int _mi = 0; _mi < 4; ++_mi) _Pragma("unroll") for (int _j = 0; _j < 4; ++_j) { \
        const int rl = _wr * 64 + _mi * 16 + _fq * 4 + _j, co = _wc * 16 + _fr; const float va = acc[_mi][0][_j], vg = acc[_mi][1][_j]; __VA_ARGS__ } } while (0)

__device__ __forceinline__ void store_norm_bf16(const f32x4 (&v)[4], const float* gain, bf16_t* dst, int lane) {
    float ss = 0.f;
#pragma unroll
    for (int j = 0; j < 4; ++j) ss += v[j][0] * v[j][0] + v[j][1] * v[j][1] + v[j][2] * v[j][2] + v[j][3] * v[j][3];
    ss = wave_sum(ss);
    const float rstd = rsqrtf(ss * (1.f / DM) + 1e-6f);
#pragma unroll
    for (int j = 0; j < 4; ++j) {
        const f32x4 g = ((const f32x4*)gain)[lane + 64 * j];
        u32x2 o; o.x = pk2(v[j][0] * rstd * g[0], v[j][1] * rstd * g[1]); o.y = pk2(v[j][2] * rstd * g[2], v[j][3] * rstd * g[3]);
        ((u32x2*)dst)[lane + 64 * j] = o;
    }
}


__device__ __forceinline__ f32x4 ldrow_bf16(const bf16_t* row, int lane, int j) { const u32x2 u = ((const u32x2*)row)[lane + 64 * j]; return (f32x4){bflo(u.x), bfhi(u.x), bflo(u.y), bfhi(u.y)}; }
__device__ __forceinline__ void strow_bf16(bf16_t* row, int lane, int j, const f32x4 v) { u32x2 o; o.x = pk2(v[0], v[1]); o.y = pk2(v[2], v[3]); ((u32x2*)row)[lane + 64 * j] = o; }
namespace pg8 {
#define PG8_LAS __attribute__((address_space(3)))
constexpr int BM = 256, BK = 64, HALF = 128, HTB = HALF * BK * 2  , STAGE_BYTES = 8 * HTB, NXCD = 8, WGM = 8;
__host__ __device__ __forceinline__ int lds_byte(int r, int c) { const int st = (r >> 4) * 2 + (c >> 5), rr = r & 15, cc = c & 31, ob = rr * 64 + cc * 2; return st * 1024 + (ob ^ (((ob >> 9) & 1) << 5)); }
__host__ __device__ __forceinline__ void stage_rc(int b, int& R, int& C) { const int st = b / 1024, sb = b % 1024, swz = sb ^ (((sb >> 9) & 1) << 5); R = (st >> 1) * 16 + swz / 64; C = (st & 1) * 32 + (swz % 64) / 2; }
__host__ __device__ __forceinline__ int perm32(int rho) { const int n = rho >> 4, i = rho & 15; return 8 * (i >> 2) + 4 * n + (i & 3); }

struct Unit { int pm, pn; const char* A; const char* B; };

struct DenseOrder {
    static constexpr bool GATHER_ROWS = false;
    static constexpr bool GATHER_A = false;
    int nM, nN, nwg, G, c; const char* A; const char* Bt; size_t tstep;
    __device__ void init(const bf16_t* A_, const bf16_t* Bt_, int M, int N, int K, int G_, int c_) { nM = M / BM; nN = N / BM; nwg = nM * nN; G = G_; c = c_; A = (const char*)A_; Bt = (const char*)Bt_; tstep = (size_t)BM * K * 2; }
    __device__ bool next(int i, Unit& u) const {
        const long L = (long)i * G + c; if (L >= nwg) return false;
        int wgid = (int)L; { const int q = nwg / NXCD, r = nwg % NXCD, xcd = wgid % NXCD, off = wgid / NXCD; wgid = (xcd < r ? xcd * (q + 1) : r * (q + 1) + (xcd - r) * q) + off; }
        const int nig = WGM * nN, gid = wgid / nig, fm = gid * WGM, gsz = (nM - fm) < WGM ? (nM - fm) : WGM;
        u.pm = fm + ((wgid % nig) % gsz); u.pn = (wgid % nig) / gsz; u.A = A + (size_t)u.pm * tstep; u.B = Bt + (size_t)u.pn * tstep; return true;
    }
    __device__ __forceinline__ void a_ready(const Unit&) const {}
    __device__ __forceinline__ void done(const Unit&) const {}
};
struct ProjOrder {
    static constexpr bool GATHER_ROWS = false;
    static constexpr bool GATHER_A = false;
    DenseOrder D; const char* HNp; const char* WT;
    __device__ void init(const bf16_t* HN_, const bf16_t* WT_, int c_) { D.init(HN_, WT_, NTP, 13 * BM, DM, GRID, c_); HNp = (const char*)HN_; WT = (const char*)WT_; }
    __device__ bool next(int i, Unit& u) const {
        if (!D.next(i, u)) return false;
        const size_t ts = (size_t)BM * DM * 2;
        if (u.pn < 11) { const int wrow = u.pn < 4 ? u.pn : u.pn + 2; u.A = HNp + (size_t)u.pm * ts; u.B = WT + (size_t)wrow * ts; }
        else { u.A = WT + (size_t)(4 + (u.pn - 11)) * ts; u.B = HNp + (size_t)u.pm * ts; }
        return true;
    }
    __device__ __forceinline__ void a_ready(const Unit&) const {}
    __device__ __forceinline__ void done(const Unit&) const {}
};
template <bool GATHER> struct MoeOrder {
    static constexpr bool GATHER_ROWS = GATHER;
    static constexpr bool GATHER_A = false;
    const int* et; int TT, vcu; const char* A; const char* Bt; unsigned tstepA, tstepB, estep; const int* rowidx;
    __device__ __forceinline__ bool next(int i, Unit& u) const {
        const int L = i * GRID + vcu; if (L >= TT * 4) return false;
        const int rt = L >> 2, ct = L & 3, e = et[rt];
        u.pm = rt; u.pn = ct; u.A = GATHER ? A : A + (size_t)rt * tstepA; u.B = Bt + (size_t)e * estep + (size_t)ct * tstepB; return true;
    }
    __device__ __forceinline__ void a_ready(const Unit&) const {}
    __device__ __forceinline__ void done(const Unit&) const {}
};

struct S5OrderA {
    static constexpr bool GATHER_ROWS = false;
    static constexpr bool GATHER_A = true;
    int vcu; const char* U; const char* BTA;
    __device__ __forceinline__ bool next(int i, Unit& u) const {
        const int L = i * GRID + vcu; if (L >= 640) return false;
        const int g = L / 10, rem = L - g * 10, mt = rem >> 1, nt = rem & 1;
        u.pm = mt; u.pn = g * 2 + nt; u.A = U + ((size_t)mt * 256 * 16 * 1024 + g * 16) * 2; u.B = BTA + ((size_t)(g * 512 + nt * 256) * 256) * 2; return true;
    }
    __device__ __forceinline__ void a_ready(const Unit&) const {}
    __device__ __forceinline__ void done(const Unit&) const {}
};
struct S5OrderC {
    static constexpr bool GATHER_ROWS = false;
    static constexpr bool GATHER_A = false;
    int vcu; const char* CAR; const char* BTC;
    __device__ __forceinline__ bool next(int i, Unit& u) const {
        const int L = i * GRID + vcu; if (L >= 320) return false;
        const int g = L / 5, mt = L - g * 5;
        u.pm = mt; u.pn = g; u.A = CAR + ((size_t)(g * 1280 + mt * 256) * 256) * 2; u.B = BTC + ((size_t)g * 256 * 256) * 2; return true;
    }
    __device__ __forceinline__ void a_ready(const Unit&) const {}
    __device__ __forceinline__ void done(const Unit&) const {}
};
__device__ __forceinline__ unsigned cvt_pk_bf16(float lo, float hi) { return pk2(lo, hi); }

struct EpiProj {
    static constexpr bool PERM = true, AFTER_DRAIN = false;
    bf16_t *Q, *Kk, *VT, *REST;
    __device__ __forceinline__ void operator()(const f32x4 (&acc)[2][2][4][2], const Unit& u, int wr, int wc, int fr, int fq) const {
        bf16_t* base; int ldc; int row0, col0;
        if (u.pn < 11) { row0 = u.pm * BM + wr * 64 + fr; int colt;
            if (u.pn < 2) { base = Q; colt = u.pn * BM; ldc = 512; } else if (u.pn < 4) { base = Kk; colt = (u.pn - 2) * BM; ldc = 512; } else { base = REST; colt = (u.pn - 4) * BM; ldc = RESTC; }
            col0 = colt + wc * 32 + 8 * fq; }
        else { base = VT; ldc = NTP; row0 = (u.pn - 11) * BM + wr * 64 + fr; col0 = u.pm * BM + wc * 32 + 8 * fq; }
#pragma unroll
        for (int ai = 0; ai < 2; ++ai)
#pragma unroll
            for (int m = 0; m < 4; ++m) { bf16_t* rowp = base + (size_t)(row0 + ai * HALF + m * 16) * ldc + col0;
#pragma unroll
                for (int bj = 0; bj < 2; ++bj) { const f32x4 v0 = acc[ai][bj][m][0], v1 = acc[ai][bj][m][1];
                    u32x4 w; w.x = cvt_pk_bf16(v0[0], v0[1]); w.y = cvt_pk_bf16(v0[2], v0[3]); w.z = cvt_pk_bf16(v1[0], v1[1]); w.w = cvt_pk_bf16(v1[2], v1[3]);
                    *(u32x4*)(rowp + bj * HALF) = w; } }
    }
};
struct EpiBf16Plain {
    static constexpr bool PERM = true, AFTER_DRAIN = false;
    bf16_t* O; int ldc;
    __device__ __forceinline__ void operator()(const f32x4 (&acc)[2][2][4][2], const Unit& u, int wr, int wc, int fr, int fq) const {
        const int row0 = u.pm * BM + wr * 64 + fr; const int col0 = u.pn * BM + wc * 32 + 8 * fq;
#pragma unroll
        for (int ai = 0; ai < 2; ++ai)
#pragma unroll
            for (int m = 0; m < 4; ++m) { bf16_t* rowp = O + (size_t)(row0 + ai * HALF + m * 16) * ldc + col0;
#pragma unroll
                for (int bj = 0; bj < 2; ++bj) { const f32x4 v0 = acc[ai][bj][m][0], v1 = acc[ai][bj][m][1];
                    u32x4 w; w.x = cvt_pk_bf16(v0[0], v0[1]); w.y = cvt_pk_bf16(v0[2], v0[3]); w.z = cvt_pk_bf16(v1[0], v1[1]); w.w = cvt_pk_bf16(v1[2], v1[3]);
                    *(u32x4*)(rowp + bj * HALF) = w; } }
    }
};
struct EpiSwiglu {
    static constexpr bool PERM = true, AFTER_DRAIN = false;
    bf16_t* O;
    __device__ __forceinline__ void operator()(const f32x4 (&acc)[2][2][4][2], const Unit& u, int wr, int wc, int fr, int fq) const {
        const int row0 = u.pm * BM + wr * 64 + fr; const int col0 = u.pn * HALF + wc * 32 + 8 * fq;
#pragma unroll
        for (int ai = 0; ai < 2; ++ai)
#pragma unroll
            for (int m = 0; m < 4; ++m) {
                float o[8];
#pragma unroll
                for (int n = 0; n < 2; ++n)
#pragma unroll
                    for (int i = 0; i < 4; ++i) { const float va = acc[ai][0][m][n][i], vg = acc[ai][1][m][n][i]; o[4 * n + i] = va * __builtin_amdgcn_rcpf(1.f + __expf(-va)) * vg; }
                u32x4 w; w.x = cvt_pk_bf16(o[0], o[1]); w.y = cvt_pk_bf16(o[2], o[3]); w.z = cvt_pk_bf16(o[4], o[5]); w.w = cvt_pk_bf16(o[6], o[7]);
                *(u32x4*)(O + (size_t)(row0 + ai * HALF + m * 16) * DFF + col0) = w; }
    }
};
struct EpiResidual {
    static constexpr bool PERM = true, AFTER_DRAIN = false;
    bf16_t* Hh;
    __device__ __forceinline__ void operator()(const f32x4 (&acc)[2][2][4][2], const Unit& u, int wr, int wc, int fr, int fq) const {
        const int row0 = u.pm * BM + wr * 64 + fr; const int col0 = u.pn * BM + wc * 32 + 8 * fq;
#pragma unroll
        for (int ai = 0; ai < 2; ++ai)
#pragma unroll
            for (int m = 0; m < 4; ++m) { bf16_t* rowp = Hh + (size_t)(row0 + ai * HALF + m * 16) * DM + col0;
#pragma unroll
                for (int bj = 0; bj < 2; ++bj) { u32x4* p = (u32x4*)(rowp + bj * HALF); const u32x4 hv = *p; const f32x4 v0 = acc[ai][bj][m][0], v1 = acc[ai][bj][m][1];
                    u32x4 w; w.x = cvt_pk_bf16(__uint_as_float(hv.x << 16) + v0[0], __uint_as_float(hv.x & 0xffff0000u) + v0[1]); w.y = cvt_pk_bf16(__uint_as_float(hv.y << 16) + v0[2], __uint_as_float(hv.y & 0xffff0000u) + v0[3]);
                    w.z = cvt_pk_bf16(__uint_as_float(hv.z << 16) + v1[0], __uint_as_float(hv.z & 0xffff0000u) + v1[1]); w.w = cvt_pk_bf16(__uint_as_float(hv.w << 16) + v1[2], __uint_as_float(hv.w & 0xffff0000u) + v1[3]);
                    *p = w; } }
    }
};
struct EpiGlu {
    static constexpr bool PERM = true, AFTER_DRAIN = false;
    bf16_t* Hh;
    __device__ __forceinline__ void operator()(const f32x4 (&acc)[2][2][4][2], const Unit& u, int wr, int wc, int fr, int fq) const {
        const int row0 = u.pm * BM + wr * 64 + fr; const int col0 = u.pn * HALF + wc * 32 + 8 * fq;
#pragma unroll
        for (int ai = 0; ai < 2; ++ai)
#pragma unroll
            for (int m = 0; m < 4; ++m) { u32x4* p = (u32x4*)(Hh + (size_t)(row0 + ai * HALF + m * 16) * DM + col0); const u32x4 hv = *p;
                float o[8];
#pragma unroll
                for (int n = 0; n < 2; ++n)
#pragma unroll
                    for (int i = 0; i < 4; ++i) { const unsigned hw = hv[2 * n + (i >> 1)]; const float hcur = (i & 1) ? __uint_as_float(hw & 0xffff0000u) : __uint_as_float(hw << 16);
                        o[4 * n + i] = hcur + acc[ai][0][m][n][i] * __builtin_amdgcn_rcpf(1.f + __expf(-acc[ai][1][m][n][i])); }
                u32x4 w; w.x = cvt_pk_bf16(o[0], o[1]); w.y = cvt_pk_bf16(o[2], o[3]); w.z = cvt_pk_bf16(o[4], o[5]); w.w = cvt_pk_bf16(o[6], o[7]);
                *p = w; }
    }
};
struct EpiS5A {
    static constexpr bool PERM = true, AFTER_DRAIN = false;
    bf16_t* YI; bf16_t* E;
    __device__ __forceinline__ void operator()(const f32x4 (&acc)[2][2][4][2], const Unit& u, int wr, int wc, int fr, int fq) const {
        const int g = u.pn >> 1, nt = u.pn & 1;
        const int cl0 = wc * 32 + 8 * fq;
        bf16_t* base = nt == 0 ? YI + (size_t)(cl0 >> 4) * DM + g * 16 + (cl0 & 15) : E + (size_t)g * 256 + cl0;
        const size_t nstride = 16 * DM;
        const size_t bjstep = nt == 0 ? (size_t)8 * DM : (size_t)HALF;
#pragma unroll
        for (int ai = 0; ai < 2; ++ai)
#pragma unroll
            for (int m = 0; m < 4; ++m) { int n = u.pm * BM + ai * HALF + wr * 64 + m * 16 + fr; n = n < 1039 ? n : 1039;
                bf16_t* p = base + (size_t)n * nstride;
#pragma unroll
                for (int bj = 0; bj < 2; ++bj) { const f32x4 v0 = acc[ai][bj][m][0], v1 = acc[ai][bj][m][1];
                    u32x4 w; w.x = cvt_pk_bf16(v0[0], v0[1]); w.y = cvt_pk_bf16(v0[2], v0[3]); w.z = cvt_pk_bf16(v1[0], v1[1]); w.w = cvt_pk_bf16(v1[2], v1[3]);
                    *(u32x4*)(p + bj * bjstep) = w; } }
    }
};
struct EpiS5C {
    static constexpr bool PERM = true, AFTER_DRAIN = false;
    const bf16_t* YI; const bf16_t* Uu; const float* dvec; bf16_t* O;
    __device__ __forceinline__ void operator()(const f32x4 (&acc)[2][2][4][2], const Unit& u, int wr, int wc, int fr, int fq) const {
        const int g = u.pn;
        const int cl0 = wc * 32 + 8 * fq, ch = g * 16 + (cl0 & 15);
        const size_t off0 = (size_t)(cl0 >> 4) * DM + ch;
        const f32x4 d0 = *(const f32x4*)(dvec + ch), d1 = *(const f32x4*)(dvec + ch + 4);
        u32x4 yq[8][2], uq[8][2];
#define S5C_OFF(rg_, bj_) ({ int n_ = u.pm * BM + ((rg_) >> 2) * HALF + wr * 64 + ((rg_) & 3) * 16 + fr; n_ = n_ < 1039 ? n_ : 1039; off0 + (size_t)n_ * (16 * DM) + (size_t)(bj_) * (8 * DM); })
#define S5C_LOAD(rg_) do { _Pragma("unroll") for (int bj_ = 0; bj_ < 2; ++bj_) { const size_t o_ = S5C_OFF(rg_, bj_); yq[rg_][bj_] = *(const u32x4*)(YI + o_); uq[rg_][bj_] = *(const u32x4*)(Uu + o_); } } while (0)
        S5C_LOAD(0); S5C_LOAD(1); S5C_LOAD(2);
#pragma unroll
        for (int rg = 0; rg < 8; ++rg) {
            if (rg + 3 < 8) S5C_LOAD(rg + 3);
            const int ai = rg >> 2, m = rg & 3;
#pragma unroll
            for (int bj = 0; bj < 2; ++bj) {
                const u32x4 yv = yq[rg][bj], uv = uq[rg][bj];
                const f32x4 y0 = (f32x4){__uint_as_float(yv[0] << 16), __uint_as_float(yv[0] & 0xffff0000u), __uint_as_float(yv[1] << 16), __uint_as_float(yv[1] & 0xffff0000u)},
                            y1 = (f32x4){__uint_as_float(yv[2] << 16), __uint_as_float(yv[2] & 0xffff0000u), __uint_as_float(yv[3] << 16), __uint_as_float(yv[3] & 0xffff0000u)};
                float y[8];
#pragma unroll
                for (int q = 0; q < 4; ++q) { y[q] = acc[ai][bj][m][0][q] + y0[q] + d0[q] * (q & 1 ? __uint_as_float(uv[q >> 1] & 0xffff0000u) : __uint_as_float(uv[q >> 1] << 16));
                    y[4 + q] = acc[ai][bj][m][1][q] + y1[q] + d1[q] * (q & 1 ? __uint_as_float(uv[2 + (q >> 1)] & 0xffff0000u) : __uint_as_float(uv[2 + (q >> 1)] << 16)); }
#pragma unroll
                for (int q = 0; q < 8; ++q) { const float z = 1.5957691216f * (y[q] + 0.044715f * y[q] * y[q] * y[q]); y[q] = y[q] * __builtin_amdgcn_rcpf(1.f + __expf(-z)); }
                u32x4 w; w.x = cvt_pk_bf16(y[0], y[1]); w.y = cvt_pk_bf16(y[2], y[3]); w.z = cvt_pk_bf16(y[4], y[5]); w.w = cvt_pk_bf16(y[6], y[7]);
                *(u32x4*)(O + S5C_OFF(rg, bj)) = w; }
            asm volatile("" ::: "memory"); }
#undef S5C_LOAD
#undef S5C_OFF
    }
};

template <class Epi, class Sched, bool ALIGN_EPI = false, bool SP2 = false>
__device__ __forceinline__ void gemm_phase(PG8_LAS unsigned char* lds, const int K, const Sched& S, const Epi& E) {
    int tid_ = threadIdx.x; asm volatile("" : "+v"(tid_));
    const int tid = tid_, wid = __builtin_amdgcn_readfirstlane(tid >> 6), lane = tid & 63, wr = wid >> 2, wc = wid & 3, fr = lane & 15, fq = lane >> 4;
    const int nt = K / BK;
    unsigned vA0[2], vA1[2], nA0[2], nA1[2], voffB[2];
#pragma unroll
    for (int i = 0; i < 2; ++i) { int R, C; stage_rc(tid * 16 + i * 8192, R, C); const int Rb = Epi::PERM ? ((R & ~31) + perm32(R & 31)) : R;
        vA0[i] = Sched::GATHER_A ? (unsigned)(((16 * R + (C >> 4)) * 1024 + (C & 15)) * 2) : (unsigned)(R * K + C) * 2u; voffB[i] = (unsigned)(Rb * K + C) * 2u; }
    const size_t kstep = (size_t)(BK * 2);
    const size_t hstep = (size_t)HALF * K * 2;
    const size_t kstepA = Sched::GATHER_A ? (size_t)(4 * 1024 * 2) : kstep, hstepA = Sched::GATHER_A ? (size_t)HALF * 16 * 1024 * 2 : hstep;
#define PG8_ROWOFFS(u_, d0_, d1_) do { _Pragma("unroll") for (int i_ = 0; i_ < 2; ++i_) { int R_, C_; stage_rc(tid * 16 + i_ * 8192, R_, C_); \
        d0_[i_] = (unsigned)(S.rowidx[(u_).pm * BM + R_] * K + C_) * 2u; d1_[i_] = (unsigned)(S.rowidx[(u_).pm * BM + HALF + R_] * K + C_) * 2u; } } while (0)
#define PG8_STAGE_A(bufoff, gbase, h_, nx_) do { _Pragma("unroll") for (int _i = 0; _i < 2; ++_i) { const unsigned vo_ = (nx_) ? ((h_) ? nA1[_i] : nA0[_i]) : ((h_) ? vA1[_i] : vA0[_i]); \
        __builtin_amdgcn_global_load_lds((const unsigned*)((const char*)(gbase) + vo_), (PG8_LAS unsigned*)(lds + (bufoff) + ldsw + _i * 8192), 16, 0, 0); } } while (0)
    const unsigned ldsw = (unsigned)wid * 1024u;
    const int aoff = lds_byte(wr * 64 + fr, fq * 8), boff = lds_byte(wc * 32 + fr, fq * 8);
#define PG8_SA(b, h) (((b) * 2 + (h)) * HTB)
#define PG8_SB(b, h) ((4 + (b) * 2 + (h)) * HTB)
#define PG8_STAGE(bufoff, gbase, voff) do { _Pragma("unroll") for (int _i = 0; _i < 2; ++_i) \
        __builtin_amdgcn_global_load_lds((const unsigned*)((const char*)(gbase) + (voff)[_i]), (PG8_LAS unsigned*)(lds + (bufoff) + ldsw + _i * 8192), 16, 0, 0); } while (0)
#define PG8_LDA(dst, b, h) do { _Pragma("unroll") for (int m = 0; m < 4; ++m) _Pragma("unroll") for (int k = 0; k < 2; ++k) dst[m][k] = *(const PG8_LAS bf16x8*)(lds + PG8_SA(b, h) + aoff + m * 2048 + k * 1024); } while (0)
#define PG8_LDB(dst, b, h) do { _Pragma("unroll") for (int n = 0; n < 2; ++n) _Pragma("unroll") for (int k = 0; k < 2; ++k) dst[n][k] = *(const PG8_LAS bf16x8*)(lds + PG8_SB(b, h) + boff + n * 2048 + k * 1024); } while (0)
#define PG8_MMA(ai, bj, At, Bt) do { __builtin_amdgcn_s_setprio(1); _Pragma("unroll") for (int m = 0; m < 4; ++m) _Pragma("unroll") for (int n = 0; n < 2; ++n) _Pragma("unroll") for (int k = 0; k < 2; ++k) \
        acc[ai][bj][m][n] = __builtin_amdgcn_mfma_f32_16x16x32_bf16(Bt[n][k], At[m][k], acc[ai][bj][m][n], 0, 0, 0); __builtin_amdgcn_s_setprio(0); } while (0)
#define PG8_WAIT_V(n) asm volatile("s_waitcnt vmcnt(" #n ")" ::: "memory")
#define PG8_WAIT_L(n) asm volatile("s_waitcnt lgkmcnt(" #n ")" ::: "memory")
#define PG8_BAR __builtin_amdgcn_s_barrier()
#define PG8_SCHED __builtin_amdgcn_sched_barrier(0)
    Unit cur, nxt; int ui = 0;
    if (!S.next(0, cur)) return;
    f32x4 acc[2][2][4][2];
#pragma unroll
    for (int a = 0; a < 2; ++a)
#pragma unroll
        for (int b = 0; b < 2; ++b)
#pragma unroll
            for (int m = 0; m < 4; ++m)
#pragma unroll
                for (int n = 0; n < 2; ++n) acc[a][b][m][n] = (f32x4){0.f, 0.f, 0.f, 0.f};
    bf16x8 At[4][2], B0[2][2], B1[2][2];
    const char* cA = cur.A; const char* cB = cur.B;
    if constexpr (Sched::GATHER_ROWS) { PG8_ROWOFFS(cur, vA0, vA1); }
    else {
#pragma unroll
        for (int i = 0; i < 2; ++i) vA1[i] = vA0[i] + (unsigned)hstepA;
    }
#pragma unroll
    for (int i = 0; i < 2; ++i) { nA0[i] = vA0[i]; nA1[i] = vA1[i]; }
    S.a_ready(cur);
    if constexpr (SP2) {
        PG8_STAGE(PG8_SB(0, 0), cB, voffB); PG8_STAGE(PG8_SB(0, 1), cB + hstep, voffB); PG8_STAGE_A(PG8_SA(0, 0), cA, 0, false); PG8_STAGE_A(PG8_SA(0, 1), cA, 1, false);
        if (wr == 1) PG8_BAR;
        PG8_WAIT_V(2); PG8_BAR;
        PG8_STAGE(PG8_SB(1, 0), cB + kstep, voffB); PG8_STAGE_A(PG8_SA(1, 0), cA + kstepA, 0, false); PG8_STAGE(PG8_SB(1, 1), cB + hstep + kstep, voffB);
        PG8_WAIT_V(6); PG8_BAR;
    } else {
        PG8_STAGE(PG8_SB(0, 0), cB, voffB); PG8_STAGE_A(PG8_SA(0, 0), cA, 0, false); PG8_STAGE(PG8_SB(0, 1), cB + hstep, voffB); PG8_STAGE_A(PG8_SA(0, 1), cA, 1, false);
        if (wr == 1) PG8_BAR;
        PG8_WAIT_V(4); PG8_BAR;
        PG8_STAGE(PG8_SB(1, 0), cB + kstep, voffB); PG8_STAGE_A(PG8_SA(1, 0), cA + kstepA, 0, false); PG8_STAGE(PG8_SB(1, 1), cB + hstep + kstep, voffB);
        PG8_WAIT_V(6); PG8_BAR;
    }
    for (;;) {
        const bool has_next = S.next(ui + 1, nxt);
        if constexpr (Sched::GATHER_ROWS) { if (has_next) PG8_ROWOFFS(nxt, nA0, nA1); }
        const char* nA = has_next ? nxt.A : cA; const char* nB = has_next ? nxt.B : cB;
        for (int t = 0; t < nt; t += 2) {
            const bool last = (t == nt - 2);
            const char* a1 = cA + (size_t)(t + 1) * kstepA;
            const char* a2 = last ? nA : cA + (size_t)(t + 2) * kstepA; const char* b2 = last ? nB : cB + (size_t)(t + 2) * kstep;
            const char* a3 = a2 + kstepA; const char* b3 = b2 + kstep;
            if (last && has_next) S.a_ready(nxt);
            if constexpr (SP2) {
            PG8_LDB(B0, 0, 0); PG8_LDB(B1, 0, 1); PG8_SCHED; PG8_LDA(At, 0, 0); PG8_STAGE_A(PG8_SA(1, 1), a1, 1, false);
            PG8_WAIT_V(8); PG8_WAIT_L(0); PG8_BAR; PG8_MMA(0, 0, At, B0); PG8_MMA(0, 1, At, B1); PG8_BAR; PG8_SCHED;
            PG8_LDA(At, 0, 1); PG8_STAGE(PG8_SB(0, 0), b2, voffB); PG8_STAGE(PG8_SB(0, 1), b2 + hstep, voffB); PG8_STAGE_A(PG8_SA(0, 0), a2, 0, last);
            PG8_WAIT_V(8); PG8_WAIT_L(0); PG8_BAR; PG8_MMA(1, 0, At, B0); PG8_MMA(1, 1, At, B1); PG8_BAR; PG8_SCHED;
            PG8_LDB(B0, 1, 0); PG8_LDB(B1, 1, 1); PG8_SCHED; PG8_LDA(At, 1, 0); PG8_STAGE_A(PG8_SA(0, 1), a2, 1, last);
            PG8_WAIT_V(8); PG8_WAIT_L(0); PG8_BAR; PG8_MMA(0, 0, At, B0); PG8_MMA(0, 1, At, B1); PG8_BAR; PG8_SCHED;
            PG8_LDA(At, 1, 1); PG8_STAGE(PG8_SB(1, 0), b3, voffB); PG8_STAGE(PG8_SB(1, 1), b3 + hstep, voffB); PG8_STAGE_A(PG8_SA(1, 0), a3, 0, last);
            PG8_WAIT_V(8); PG8_WAIT_L(0); PG8_BAR; PG8_MMA(1, 0, At, B0); PG8_MMA(1, 1, At, B1); PG8_BAR; PG8_SCHED;
            } else {
            PG8_LDB(B0, 0, 0); PG8_SCHED; PG8_LDA(At, 0, 0); PG8_STAGE_A(PG8_SA(1, 1), a1, 1, false);
            PG8_WAIT_L(8); PG8_BAR; PG8_WAIT_L(0); PG8_MMA(0, 0, At, B0); PG8_BAR; PG8_SCHED;
            PG8_LDB(B1, 0, 1); PG8_STAGE(PG8_SB(0, 0), b2, voffB);
            PG8_BAR; PG8_WAIT_L(0); PG8_MMA(0, 1, At, B1); PG8_BAR;
            PG8_LDA(At, 0, 1); PG8_STAGE_A(PG8_SA(0, 0), a2, 0, last);
            PG8_BAR; PG8_WAIT_L(0); PG8_MMA(1, 0, At, B0); PG8_BAR; PG8_SCHED;
            PG8_STAGE(PG8_SB(0, 1), b2 + hstep, voffB);
            PG8_WAIT_V(6); PG8_BAR; PG8_MMA(1, 1, At, B1); PG8_BAR;
            PG8_LDB(B0, 1, 0); PG8_SCHED; PG8_LDA(At, 1, 0); PG8_STAGE_A(PG8_SA(0, 1), a2, 1, last);
            PG8_WAIT_L(8); PG8_BAR; PG8_WAIT_L(0); PG8_MMA(0, 0, At, B0); PG8_BAR; PG8_SCHED;
            PG8_LDB(B1, 1, 1); PG8_STAGE(PG8_SB(1, 0), b3, voffB);
            PG8_BAR; PG8_WAIT_L(0); PG8_MMA(0, 1, At, B1); PG8_BAR;
            PG8_LDA(At, 1, 1); PG8_STAGE_A(PG8_SA(1, 0), a3, 0, last);
            PG8_BAR; PG8_WAIT_L(0); PG8_MMA(1, 0, At, B0); PG8_BAR; PG8_SCHED;
            PG8_STAGE(PG8_SB(1, 1), b3 + hstep, voffB);
            PG8_WAIT_V(6); PG8_BAR; PG8_MMA(1, 1, At, B1); PG8_BAR;
            }
        }
        if constexpr (ALIGN_EPI) { if (wr == 0) PG8_BAR; }
        if constexpr (!Epi::AFTER_DRAIN) { E(acc, cur, wr, wc, fr, fq); S.done(cur); }
        if (!has_next) break;
#pragma unroll
        for (int a = 0; a < 2; ++a)
#pragma unroll
            for (int b = 0; b < 2; ++b)
#pragma unroll
                for (int m = 0; m < 4; ++m)
#pragma unroll
                    for (int n = 0; n < 2; ++n) acc[a][b][m][n] = (f32x4){0.f, 0.f, 0.f, 0.f};
        cur = nxt; cA = nA; cB = nB; ++ui;
        if constexpr (Sched::GATHER_ROWS) {
#pragma unroll
            for (int i = 0; i < 2; ++i) { vA0[i] = nA0[i]; vA1[i] = nA1[i]; } }
        if constexpr (ALIGN_EPI) { if (wr == 1) PG8_BAR; }
    }
    PG8_WAIT_V(0);
    if constexpr (!ALIGN_EPI) { if (wr == 0) PG8_BAR; }
    PG8_BAR;
    if constexpr (Epi::AFTER_DRAIN) { E.fused(acc, cur, wr, wc, fr, fq, lds, wid, lane); S.done(cur); }
#undef PG8_SA
#undef PG8_SB
#undef PG8_STAGE
#undef PG8_STAGE_A
#undef PG8_ROWOFFS
#undef PG8_LDA
#undef PG8_LDB
#undef PG8_MMA
#undef PG8_WAIT_V
#undef PG8_WAIT_L
#undef PG8_BAR
#undef PG8_SCHED
}
}

#define PHASE_PROLOGUE \
    int tid_ = threadIdx.x; asm volatile("" : "+v"(tid_)); const int tid = tid_, lane = tid & 63, wave = tid >> 6; \
    const int G = GRID, bid = blockIdx.x; \
    const int gw = bid * 8 + wave, NGW = G * 8; \
    unsigned char* ws = P.ws; \
    bf16_t* H = (bf16_t*)(ws + WS_H); \
    bf16_t* HN = (bf16_t*)(ws + WS_HN); \
    bf16_t* A2 = (bf16_t*)(ws + WS_A2); \
    bf16_t* Qb = (bf16_t*)(ws + WS_Q); bf16_t* Kb = (bf16_t*)(ws + WS_K); bf16_t* Vb = (bf16_t*)(ws + WS_V); \
    bf16_t* REST = (bf16_t*)(ws + WS_REST); \
    bf16_t* YFB = (bf16_t*)(ws + WS_YFB); \
    bf16_t* Rr = (bf16_t*)(ws + WS_R); bf16_t* VV = (bf16_t*)(ws + WS_VV); bf16_t* KK = (bf16_t*)(ws + WS_KK); \
    bf16_t* KKA = (bf16_t*)(ws + WS_KKA); bf16_t* KD = (bf16_t*)(ws + WS_KD); \
    _Float16* LW = (_Float16*)(ws + WS_W); bf16_t* PP = (bf16_t*)(ws + WS_PP); bf16_t* QT = (bf16_t*)(ws + WS_QT); bf16_t* YT = (bf16_t*)(ws + WS_YT); bf16_t* ZT = (bf16_t*)(ws + WS_ZT); \
    bf16_t* Gg = (bf16_t*)(ws + WS_G); bf16_t* KR = (bf16_t*)(ws + WS_KR); bf16_t* LOW = (bf16_t*)(ws + WS_LOW); \
    float* BC = (float*)(ws + WS_BC); \
    bf16_t* AA = (bf16_t*)(ws + WS_AA); \
    bf16_t* HB = (bf16_t*)(ws + WS_HB); bf16_t* YB = (bf16_t*)(ws + WS_YB); \
    int* ROWTOK = (int*)(ws + WS_ROWTOK); int* EID = (int*)(ws + WS_EID); int* POS = (int*)(ws + WS_POS); int* DEST = (int*)(ws + WS_DEST); \
    float* GATE = (float*)(ws + WS_GATE); \
    bf16_t* YI = (bf16_t*)(ws + WS_YI); bf16_t* S5E = (bf16_t*)(ws + WS_E); bf16_t* CAR = (bf16_t*)(ws + WS_CAR); bf16_t* BTA = (bf16_t*)(ws + WS_BTA); bf16_t* BTC = (bf16_t*)(ws + WS_BTC); \
    unsigned* CTL = (unsigned*)(ws + WS_CTL); \
    bf16_t* WTIN = (bf16_t*)(ws + WS_WTIN); bf16_t* WTOUT = (bf16_t*)(ws + WS_WTOUT); bf16_t* WTGLU = (bf16_t*)(ws + WS_WTGLU); bf16_t* WT13 = (bf16_t*)(ws + WS_WT13); bf16_t* WT2 = (bf16_t*)(ws + WS_WT2); \
    const int vcu = (G % 8 == 0) ? (bid % 8) * (G / 8) + bid / 8 : bid; \
    const float* x = P.in[0]; const float* meta = P.in[1]; const float* norm_mix = P.in[2]; const float* norm_ffn = P.in[3]; const float* norm_final = P.in[4]; \
    const float* w_in = P.in[5]; const float* w_out = P.in[6]; const float* rpb = P.in[7]; const float* mu = P.in[8]; \
    const float* w0 = P.in[9]; const float* w_up = P.in[10]; const float* a0 = P.in[11]; const float* a_up = P.in[12]; const float* g_up = P.in[13]; \
    const float* k_k = P.in[14]; const float* k_a = P.in[15]; const float* r_k = P.in[16]; const float* lnx_g = P.in[17]; const float* lnx_b = P.in[18]; \
    const float* s5_b_re = P.in[19]; const float* s5_b_im = P.in[20]; const float* s5_lre = P.in[21]; const float* s5_lim = P.in[22]; const float* s5_ls = P.in[23]; \
    const float* s5_c_re = P.in[24]; const float* s5_c_im = P.in[25]; const float* s5_d = P.in[26]; const float* w_glu = P.in[27]; \
    const float* moe_wg = P.in[28]; const float* moe_bg = P.in[29]; const float* moe_we = P.in[30]; const float* moe_be = P.in[31]; \
    const float* moe_w1 = P.in[32]; const float* moe_w3 = P.in[33]; const float* moe_w2 = P.in[34];


__device__ __forceinline__ void transpose_half(const float* W, int N, int K, int k0, int n0, bf16_t* dstrow0, int lane) {
    const int kb = lane & 7, nq = lane >> 3;
    const float* src = W + (size_t)(k0 + 8 * kb) * N + n0 + 4 * nq;
    f32x4 v[8];
#pragma unroll
    for (int kk = 0; kk < 8; ++kk) v[kk] = *(const f32x4*)(src + (size_t)kk * N);
#pragma unroll
    for (int i = 0; i < 4; ++i) {
        u32x4 o; o.x = pk2(v[0][i], v[1][i]); o.y = pk2(v[2][i], v[3][i]); o.z = pk2(v[4][i], v[5][i]); o.w = pk2(v[6][i], v[7][i]);
        *(u32x4*)(dstrow0 + (size_t)(4 * nq + i) * K + k0 + 8 * kb) = o;
    }
}
__device__ __forceinline__ void transpose_item(const float* W, int N, int K, int k0, int n0, bf16_t* dstrow0, int lane) {
    const int kb = lane & 7, nq = lane >> 3;
    const float* src = W + (size_t)(k0 + 8 * kb) * N + n0 + 4 * nq;
    f32x4 v[8], w[8];
#pragma unroll
    for (int kk = 0; kk < 8; ++kk) { v[kk] = *(const f32x4*)(src + (size_t)kk * N); w[kk] = *(const f32x4*)(src + (size_t)kk * N + 32); }
    bf16_t* d = dstrow0 + (size_t)(4 * nq) * K + k0 + 8 * kb;
#pragma unroll
    for (int i = 0; i < 4; ++i) {
        u32x4 o; o.x = pk2(v[0][i], v[1][i]); o.y = pk2(v[2][i], v[3][i]); o.z = pk2(v[4][i], v[5][i]); o.w = pk2(v[6][i], v[7][i]);
        *(u32x4*)(d + (size_t)i * K) = o;
    }
#pragma unroll
    for (int i = 0; i < 4; ++i) {
        u32x4 o; o.x = pk2(w[0][i], w[1][i]); o.y = pk2(w[2][i], w[3][i]); o.z = pk2(w[4][i], w[5][i]); o.w = pk2(w[6][i], w[7][i]);
        *(u32x4*)(d + (size_t)(32 + i) * K) = o;
    }
}
#define CONV_DENSE_ITEMS (832 + 256 + 512 + 48)
__device__ __forceinline__ void conv_dense_item(CParams& P, int it, int lane) {
    unsigned char* ws = P.ws;
    if (it < 832) { const int kb = it / 52, nb = it % 52; transpose_item(P.in[5], INCOLS, DM, kb * 64, nb * 64, (bf16_t*)(ws + WS_WTIN) + (size_t)nb * 64 * DM, lane); return; }
    it -= 832;
    if (it < 256) { const int kb = it / 16, nb = it % 16; transpose_item(P.in[6], DM, DM, kb * 64, nb * 64, (bf16_t*)(ws + WS_WTOUT) + (size_t)nb * 64 * DM, lane); return; }
    it -= 256;
    if (it < 512) { const int kb = it / 32, nb = it % 32, n = nb * 64, half = n >> 10, c = n & 1023, row = (c >> 7) * 256 + half * 128 + (c & 127);
      transpose_item(P.in[27], 2 * DM, DM, kb * 64, n, (bf16_t*)(ws + WS_WTGLU) + (size_t)row * DM, lane); return; }
    it -= 512;
    bf16_t* lrt = (bf16_t*)(ws + WS_LRT);
    if (it < 16) { const int d = it >> 3, nb = it & 7; transpose_item(P.in[10] + (size_t)d * 64 * 512, 512, 64, 0, nb * 64, lrt + ((size_t)d * 512 + nb * 64) * 64, lane); return; }
    it -= 16;
    if (it < 16) { const int d = it >> 3, nb = it & 7; transpose_item(P.in[12] + (size_t)d * 64 * 512, 512, 64, 0, nb * 64, lrt + (size_t)2 * 512 * 64 + ((size_t)d * 512 + nb * 64) * 64, lane); return; }
    it -= 16;
    { const int kb = it >> 3, nb = it & 7; transpose_item(P.in[13], 512, 128, kb * 64, nb * 64, lrt + (size_t)4 * 512 * 64 + (size_t)nb * 64 * 128, lane); }
}
#define CONV_MOE_ITEMS (NEXP * 384)
__device__ __forceinline__ void conv_moe_item(CParams& P, int l, int it, int lane) {
    unsigned char* ws = P.ws;
    const int e = it / 384; int r = it % 384;
    if (r < 256) { const int which = r >> 7; r &= 127; const int kb = r >> 3, nb = r & 7, n = nb * 64, row = (n >> 7) * 256 + which * 128 + (n & 127);
        const float* W = (which ? P.in[33] : P.in[32]) + ((size_t)(l * NEXP + e) * DM) * DFF;
        transpose_item(W, DFF, DM, kb * 64, n, (bf16_t*)(ws + (l ? WS_WT13B : WS_WT13)) + ((size_t)e * DM + row) * DM, lane); return; }
    r -= 256;
    { const int kb = r >> 4, nb = r & 15; const float* W = P.in[34] + ((size_t)(l * NEXP + e) * DFF) * DM;
      transpose_item(W, DM, DFF, kb * 64, nb * 64, (bf16_t*)(ws + (l ? WS_WT2B : WS_WT2)) + ((size_t)e * DM + nb * 64) * DFF, lane); }
}
#ifndef FILL_Q11
#define FILL_Q11 1
#define FILL_Q12 1
#define FILL_Q15 1
#define FILL_Q22 1
#endif
#define FILL_N22 (192 * 8 * FILL_Q22)
#define FILL_A (FILL_N22 + 128 * 8 * FILL_Q15)
__device__ __forceinline__ void conv_range(CParams& P, int first, int n, int lane) {
    for (int q = 0; q < n; ++q) { const int it = first + q; if (it < CONV_MOE_ITEMS) conv_moe_item(P, 1, it, lane); }
}

template <int MODE>
__device__ __forceinline__ void meta_gemm(const bf16_t* A, const bf16_t* Bt, bf16_t* Hrows, int task, int lane) {
    const int fr = lane & 15, fq = lane >> 4, c = task * 16 + fr;
    const bf16_t* b0 = MODE == 0 ? Bt + (size_t)c * DM : Bt + (size_t)((c >> 7) * 256 + (c & 127)) * DM;
    const bf16_t* b1 = b0 + (size_t)128 * DM;
    f32x4 acc0[2], acc1[2];
    acc0[0] = acc0[1] = acc1[0] = acc1[1] = (f32x4){0.f, 0.f, 0.f, 0.f};
#pragma unroll 4
    for (int kt = 0; kt < 32; ++kt) {
        const int ko = kt * 32 + fq * 8;
        const bf16x8 a0 = *(const bf16x8*)(A + (size_t)fr * DM + ko), a1 = *(const bf16x8*)(A + (size_t)(16 + fr) * DM + ko);
        const bf16x8 bv = *(const bf16x8*)(b0 + ko);
        acc0[0] = __builtin_amdgcn_mfma_f32_16x16x32_bf16(a0, bv, acc0[0], 0, 0, 0);
        acc0[1] = __builtin_amdgcn_mfma_f32_16x16x32_bf16(a1, bv, acc0[1], 0, 0, 0);
        if (MODE == 1) { const bf16x8 bg = *(const bf16x8*)(b1 + ko);
            acc1[0] = __builtin_amdgcn_mfma_f32_16x16x32_bf16(a0, bg, acc1[0], 0, 0, 0);
            acc1[1] = __builtin_amdgcn_mfma_f32_16x16x32_bf16(a1, bg, acc1[1], 0, 0, 0); }
    }
#pragma unroll
    for (int mi = 0; mi < 2; ++mi)
#pragma unroll
        for (int j = 0; j < 4; ++j) { bf16_t* p = Hrows + (size_t)(mi * 16 + fq * 4 + j) * DM + c;
            const float add = MODE == 0 ? acc0[mi][j] : acc0[mi][j] * __builtin_amdgcn_rcpf(1.f + __expf(-acc1[mi][j]));
            *p = (bf16_t)f2bf(bf2f(*p) + add); }
}
__device__ __forceinline__ void phase_0(CParams& P, unsigned char* lds, const int ph) {
    PHASE_PROLOGUE
            for (int row = gw; row < NT; row += NGW) {
                const float* src = row < NMAIN ? x + (size_t)row * DM : meta + (size_t)((row - NMAIN) & 15) * DM;
                f32x4 v[4];
#pragma unroll
                for (int j = 0; j < 4; ++j) { v[j] = ((const f32x4*)src)[lane + 64 * j]; strow_bf16(H + (size_t)row * DM, lane, j, v[j]); }
                store_norm_bf16(v, norm_mix, HN + (size_t)row * DM, lane);
            }
    for (int it = gw; it < CONV_DENSE_ITEMS; it += NGW) conv_dense_item(P, it, lane);
}

__device__ __forceinline__ void phase_1(CParams& P, unsigned char* lds, const int ph) {
    PHASE_PROLOGUE
    pg8::ProjOrder S; S.init(HN, WTIN, bid);
    pg8::EpiProj E{Qb, Kb, Vb, REST};
    pg8::gemm_phase<pg8::EpiProj, pg8::ProjOrder, true, true>((PG8_LAS unsigned char*)lds, DM, S, E);
}

__device__ __forceinline__ void na_units(CParams& P, unsigned char* lds, const int first, const int stride) {
    PHASE_PROLOGUE
    constexpr int KST = 68, VST = 596, NKEY = 592;
    bf16_t* Ks = (bf16_t*)lds;
    bf16_t* VTs = Ks + NKEY * KST;
    float* sb = (float*)(VTs + 64 * VST);
    const bf16_t* VT = Vb;
    const int fr = lane & 15, fq = lane >> 4;
    const f32x4 zero4 = (f32x4){0.f, 0.f, 0.f, 0.f};
    u32x4 kreg[9], vreg[9];
#define NA_BAR() do { asm volatile("s_waitcnt lgkmcnt(0)" ::: "memory"); __builtin_amdgcn_s_barrier(); asm volatile("" ::: "memory"); } while (0)
#define NA_LOAD(u_) do { if ((u_) < 1024) { const int r2_ = ((u_) & 63) * 2, h_ = ((u_) >> 6) & 7, b_ = (u_) >> 9, Rb_ = min(max(r2_ - 4, 0), 120); \
        _Pragma("unroll") for (int q = 0; q < 9; ++q) { const int i = tid + 512 * q, key = i >> 3, pc = (i & 7) * 8; const int kr = min(Rb_ + (key >> 6), 127); \
            kreg[q] = *(const u32x4*)(Kb + ((size_t)b_ * SEQ + kr * 64 + (key & 63)) * 512 + h_ * 64 + pc); } \
        _Pragma("unroll") for (int q = 0; q < 9; ++q) { const int i = tid + 512 * q, dd = i / 72, rem = i - dd * 72, kr9 = rem >> 3, pc = (rem & 7) * 8; const int kr = min(Rb_ + kr9, 127); \
            vreg[q] = *(const u32x4*)(VT + (size_t)(h_ * 64 + dd) * NTP + (size_t)b_ * SEQ + kr * 64 + pc); } } } while (0)
    if (first < 1024 + 16) NA_LOAD(first);
    for (int u = first; u < 1024 + 16; u += stride) {
        const bool metau = u >= 1024;
        int b, h, r2 = 0;
        if (!metau) { r2 = (u & 63) * 2; h = (u >> 6) & 7; b = u >> 9; } else { const int m = u - 1024; b = m >> 3; h = m & 7; }
        const int Rb = min(max(r2 - 4, 0), 120);
        if (!metau) {
            if (tid < 465) sb[tid] = rpb[h * 465 + tid];
#pragma unroll
            for (int q = 0; q < 9; ++q) { const int i = tid + 512 * q, key = i >> 3, pc = (i & 7) * 8; *(u32x4*)(Ks + key * KST + pc) = kreg[q]; }
#pragma unroll
            for (int q = 0; q < 9; ++q) { const int i = tid + 512 * q, dd = i / 72, rem = i - dd * 72, kr9 = rem >> 3, pc = (rem & 7) * 8; *(u32x4*)(VTs + dd * VST + kr9 * 64 + pc) = vreg[q]; }
        }
        for (int i = tid; i < 16 * 8; i += 512) { const int key = i >> 3, pc = (i & 7) * 8;
            *(u32x4*)(Ks + (576 + key) * KST + pc) = *(const u32x4*)(Kb + ((size_t)NMAIN + b * NMETA + key) * 512 + h * 64 + pc); }
        for (int i = tid; i < 64 * 2; i += 512) { const int dd = i >> 1, pc = (i & 1) * 8;
            *(u32x4*)(VTs + dd * VST + 576 + pc) = *(const u32x4*)(VT + (size_t)(h * 64 + dd) * NTP + NMAIN + b * NMETA + pc); }
        if (u + stride < 1024 + 16) NA_LOAD(u + stride);
        NA_BAR();
        if (!metau || wave == 0) {
            const int rr = wave >> 2, qb = wave & 3, r = r2 + rr;
            const int c = qb * 16 + fr;
            const int qrow = metau ? NMAIN + b * NMETA + fr : b * SEQ + r * 64 + c;
            const int R0 = min(max(r - 4, 0), 120), cs = qb == 0 ? 0 : (qb == 1 ? 8 : (qb == 2 ? 24 : 32));
            const int C0 = min(max(c - 8, 0), 48);
            const int ro = R0 - Rb;
            const bf16x8 qf0 = *(const bf16x8*)(Qb + (size_t)qrow * 512 + h * 64 + fq * 8), qf1 = *(const bf16x8*)(Qb + (size_t)qrow * 512 + h * 64 + 32 + fq * 8);
            f32x4 sacc[17];
            if (!metau) {
#pragma unroll
                for (int kt = 0; kt < 16; ++kt) {
                    const bf16_t* kp = Ks + ((ro + (kt >> 1)) * 64 + cs + 16 * (kt & 1) + fr) * KST + fq * 8;
                    f32x4 acc = __builtin_amdgcn_mfma_f32_16x16x32_bf16(*(const bf16x8*)kp, qf0, zero4, 0, 0, 0);
                    sacc[kt] = __builtin_amdgcn_mfma_f32_16x16x32_bf16(*(const bf16x8*)(kp + 32), qf1, acc, 0, 0, 0);
                }
            } else {
#pragma unroll
                for (int kt = 0; kt < 16; ++kt) sacc[kt] = zero4;
            }
            {
                const bf16_t* kp = Ks + (576 + fr) * KST + fq * 8;
                f32x4 acc = __builtin_amdgcn_mfma_f32_16x16x32_bf16(*(const bf16x8*)kp, qf0, zero4, 0, 0, 0);
                sacc[16] = __builtin_amdgcn_mfma_f32_16x16x32_bf16(*(const bf16x8*)(kp + 32), qf1, acc, 0, 0, 0);
            }
            float mx = -1e30f;
#pragma unroll
            for (int kt = 0; kt < 16; ++kt) {
                const int dr = R0 + (kt >> 1) - r + 7;
#pragma unroll
                for (int j = 0; j < 4; ++j) {
                    const int kc = cs + 16 * (kt & 1) + 4 * fq + j;
                    const bool inb = !metau && kc >= C0 && kc < C0 + 16;
                    const int dc = min(max(kc - c + 15, 0), 30);
                    const float bias = sb[dr * 31 + dc];
                    const float sv = sacc[kt][j] * 0.125f + bias;
                    const float s = inb ? sv : -1e30f;
                    sacc[kt][j] = s; mx = fmaxf(mx, s);
                }
            }
#pragma unroll
            for (int j = 0; j < 4; ++j) { const float s = sacc[16][j] * 0.125f; sacc[16][j] = s; mx = fmaxf(mx, s); }
            mx = fmaxf(mx, __shfl_xor(mx, 16)); mx = fmaxf(mx, __shfl_xor(mx, 32));
            float sum = 0.f;
#pragma unroll
            for (int kt = 0; kt < 17; ++kt)
#pragma unroll
                for (int j = 0; j < 4; ++j) { const float pv = __expf(sacc[kt][j] - mx); sacc[kt][j] = pv; sum += pv; }
            sum += __shfl_xor(sum, 16); sum += __shfl_xor(sum, 32);
            f32x4 o[4] = {zero4, zero4, zero4, zero4};
            if (!metau) {
#pragma unroll
                for (int kr = 0; kr < 8; ++kr) {
                    union { bf16x8 v; unsigned u[4]; } bf;
                    bf.u[0] = pk2(sacc[2 * kr][0], sacc[2 * kr][1]); bf.u[1] = pk2(sacc[2 * kr][2], sacc[2 * kr][3]);
                    bf.u[2] = pk2(sacc[2 * kr + 1][0], sacc[2 * kr + 1][1]); bf.u[3] = pk2(sacc[2 * kr + 1][2], sacc[2 * kr + 1][3]);
                    const int tok0 = (ro + kr) * 64 + cs + 4 * fq;
#pragma unroll
                    for (int dt = 0; dt < 4; ++dt) {
                        const bf16_t* vp = VTs + (dt * 16 + fr) * VST + tok0;
                        union { bf16x8 v; u32x2 h2[2]; } af;
                        af.h2[0] = *(const u32x2*)vp; af.h2[1] = *(const u32x2*)(vp + 16);
                        o[dt] = __builtin_amdgcn_mfma_f32_16x16x32_bf16(af.v, bf.v, o[dt], 0, 0, 0);
                    }
                }
            }
            {
                union { bf16x8 v; unsigned u[4]; } bf;
                bf.u[0] = pk2(sacc[16][0], sacc[16][1]); bf.u[1] = pk2(sacc[16][2], sacc[16][3]); bf.u[2] = 0u; bf.u[3] = 0u;
#pragma unroll
                for (int dt = 0; dt < 4; ++dt) {
                    const bf16_t* vp = VTs + (dt * 16 + fr) * VST + 576 + 4 * fq;
                    union { bf16x8 v; u32x2 h2[2]; } af;
                    af.h2[0] = *(const u32x2*)vp; af.h2[1] = (u32x2){0u, 0u};
                    o[dt] = __builtin_amdgcn_mfma_f32_16x16x32_bf16(af.v, bf.v, o[dt], 0, 0, 0);
                }
            }
            const float inv = 1.f / sum;
#pragma unroll
            for (int dt = 0; dt < 4; ++dt) {
                u32x2 ov; ov.x = pk2(o[dt][0] * inv, o[dt][1] * inv); ov.y = pk2(o[dt][2] * inv, o[dt][3] * inv);
                *(u32x2*)(A2 + (size_t)qrow * DM + h * 64 + dt * 16 + 4 * fq) = ov;
            }
        }
        NA_BAR();
    }
#undef NA_LOAD
#undef NA_BAR
}

__device__ __forceinline__ void phase_3(CParams& P, unsigned char* lds, const int ph) {
    PHASE_PROLOGUE
    constexpr int TR = 66, NTILE = (NT + TR - 1) / TR, AST = 264, SST = 136;
    bf16_t* As = (bf16_t*)lds;
    unsigned short* stg = (unsigned short*)(lds + 80 * AST * 2);
    const bf16_t* lrt = (const bf16_t*)(ws + WS_LRT);
    const int fr = lane & 15, fq = lane >> 4;
    for (int u = bid; u < NTILE; u += G) {
        const int r0 = u * TR, nrows = min(TR, NT - r0);
#ifndef PREP_REP1
#define PREP_REP1 1
#endif
        for (int rep1_ = 0; rep1_ < PREP_REP1; ++rep1_)
        for (int rl0 = wave; rl0 < nrows; rl0 += 24) {
            u32x2 vc[3][7], vp[3][7], vn[3][7]; bool okr[3], hp[3], hn[3]; int rows[3];
#pragma unroll
            for (int q = 0; q < 3; ++q) {
                const int rl = rl0 + 8 * q; okr[q] = rl < nrows;
                const int row = okr[q] ? r0 + rl : r0; rows[q] = row;
                int b, pp_;
                if (row < NMAIN) { b = row >> 13; pp_ = (row & (SEQ - 1)) + NMETA; } else { b = (row - NMAIN) >> 4; pp_ = (row - NMAIN) & 15; }
                hp[q] = pp_ > 0; hn[q] = pp_ + 1 < LSEQ;
                const int rowp = hp[q] ? rowof(b, pp_ - 1) : row, rown = hn[q] ? rowof(b, pp_ + 1) : row;
#pragma unroll
                for (int j = 0; j < 7; ++j) { const int c = 4 * lane + 256 * j;
                    vc[q][j] = *(const u32x2*)(REST + (size_t)row * RESTC + c); vp[q][j] = *(const u32x2*)(REST + (size_t)rowp * RESTC + c); vn[q][j] = *(const u32x2*)(REST + (size_t)rown * RESTC + c); }
            }
#pragma unroll
            for (int q = 0; q < 3; ++q) {
                if (okr[q]) {
                    const int row = rows[q], rl = rl0 + 8 * q;
#pragma unroll
                    for (int j = 0; j < 7; ++j) {
                        const int c = 4 * lane + 256 * j;
                        u32x2 a = vp[q][j], bq = vn[q][j]; const u32x2 cc = vc[q][j];
                        if (!hp[q]) { a.x = 0; a.y = 0; }
                        if (!hn[q]) { bq.x = 0; bq.y = 0; }
                        const f32x4 m4 = *(const f32x4*)(mu + c);
                        const float pc[4] = {bflo(cc.x), bfhi(cc.x), bflo(cc.y), bfhi(cc.y)};
                        const float pq[4] = {bflo(a.x), bfhi(a.x), bflo(a.y), bfhi(a.y)};
                        const float pn[4] = {bflo(bq.x), bfhi(bq.x), bflo(bq.y), bfhi(bq.y)};
                        float o[4];
#pragma unroll
                        for (int i = 0; i < 4; ++i) o[i] = pc[i] + m4[i] * (0.5f * (pq[i] + pn[i]) - pc[i]);
                        if (j == 6) {
                            if (lane < 16) { for (int i = 0; i < 4; ++i) o[i] = tanhf(o[i]); }
                            else if (lane >= 32) { for (int i = 0; i < 4; ++i) o[i] = sigmoidf_(o[i]); }
                        }
                        u32x2 ov; ov.x = pk2(o[0], o[1]); ov.y = pk2(o[2], o[3]);
                        if (j < 6) { bf16_t* dst = j < 2 ? Rr + (size_t)row * 512 + c : (j < 4 ? KR + (size_t)row * 512 + (c - 512) : VV + (size_t)row * 512 + (c - 1024)); *(u32x2*)dst = ov; }
                        else *(u32x2*)(As + rl * AST + (c - 1536)) = ov;
                    }
                }
            }
        }
        __syncthreads();
#define P4_LOADB(t_, bv_, bias_) do { const int wh_ = (t_) >> 2, ct_ = (t_) & 3, Kw_ = wh_ < 4 ? 64 : 128, col_ = ct_ * 128 + 16 * wave + fr; \
            const bf16_t* Wt_ = lrt + (wh_ < 4 ? (size_t)wh_ * 512 * 64 : (size_t)4 * 512 * 64) + (size_t)col_ * Kw_ + 8 * fq; \
            bv_[0] = *(const bf16x8*)Wt_; bv_[1] = *(const bf16x8*)(Wt_ + 32); if (wh_ == 4) { bv_[2] = *(const bf16x8*)(Wt_ + 64); bv_[3] = *(const bf16x8*)(Wt_ + 96); } \
            bias_ = wh_ < 2 ? w0[wh_ * 512 + col_] : (wh_ < 4 ? a0[(wh_ - 2) * 512 + col_] : 0.f); } while (0)
        bf16x8 bnx[4], bn2[4]; float biasn, bias2;
        P4_LOADB(0, bnx, biasn); P4_LOADB(1, bn2, bias2);
#ifndef PREP_REP2
#define PREP_REP2 1
#endif
#pragma unroll 1
        for (int t_ = 0; t_ < 20 * PREP_REP2; ++t_) { const int t = t_ % 20;
            const int which = t >> 2, ct = t & 3;
            const int koff = which < 2 ? 0 : (which < 4 ? 64 : 128);
            bf16x8 bcur[4]; bcur[0] = bnx[0]; bcur[1] = bnx[1]; bcur[2] = bnx[2]; bcur[3] = bnx[3];
            const float bias = biasn;
            bnx[0] = bn2[0]; bnx[1] = bn2[1]; bnx[2] = bn2[2]; bnx[3] = bn2[3]; biasn = bias2;
            if (t_ + 2 < 20 * PREP_REP2) P4_LOADB((t + 2) % 20, bn2, bias2);
            const f32x4 zero4 = (f32x4){0.f, 0.f, 0.f, 0.f};
            f32x4 acc[5] = {zero4, zero4, zero4, zero4, zero4};
#pragma unroll
            for (int ks = 0; ks < 4; ++ks) {
                if (ks < 2 || which == 4) {
#pragma unroll
                    for (int rt = 0; rt < 5; ++rt) acc[rt] = __builtin_amdgcn_mfma_f32_16x16x32_bf16(*(const bf16x8*)(As + (16 * rt + fr) * AST + koff + 32 * ks + 8 * fq), bcur[ks], acc[rt], 0, 0, 0);
                }
            }
            unsigned short* sg = stg + (t & 1) * 80 * SST + 16 * wave + fr;
#pragma unroll
            for (int rt = 0; rt < 5; ++rt)
#pragma unroll
                for (int j = 0; j < 4; ++j) { const float val = acc[rt][j] + bias; unsigned short o;
                    if (which < 2) { const _Float16 hv = (_Float16)(-0.6065306597f * sigmoidf_(val)); o = __builtin_bit_cast(unsigned short, hv); }
                    else if (which < 4) o = (unsigned short)f2bf(sigmoidf_(val));
                    else o = (unsigned short)f2bf(val);
                    sg[(16 * rt + 4 * fq + j) * SST] = o; }
            asm volatile("s_waitcnt lgkmcnt(0)" ::: "memory"); __builtin_amdgcn_s_barrier(); asm volatile("" ::: "memory");
            {
                unsigned short* dst = which < 2 ? (unsigned short*)LW + (size_t)which * NT * 512 : (which < 4 ? (unsigned short*)AA + (size_t)(which - 2) * NT * 512 : (unsigned short*)Gg);
                for (int i = tid; i < nrows * 8; i += 512) { const int r = i >> 3, pc = (i & 7) * 16; const unsigned short* sp = stg + (t & 1) * 80 * SST + r * SST + pc;
                    unsigned short* gp = dst + (size_t)(r0 + r) * 512 + ct * 128 + pc; *(u32x4*)gp = *(const u32x4*)sp; *(u32x4*)(gp + 8) = *(const u32x4*)(sp + 8); }
            }
        }
#undef P4_LOADB
        __syncthreads();
#ifndef PREP_REP3
#define PREP_REP3 1
#endif
        for (int rep3_ = 0; rep3_ < PREP_REP3; ++rep3_)
        for (int rl = wave; rl < nrows; rl += 8) {
            const int row = r0 + rl;

                const int c0 = lane * 8;
                const u32x4 krv = *(const u32x4*)(KR + (size_t)row * 512 + c0);
                const u32x4 rv = *(const u32x4*)(Rr + (size_t)row * 512 + c0);
                float kr[8], rr[8], kkv[8];
#pragma unroll
                for (int i = 0; i < 4; ++i) { kr[2 * i] = bflo(krv[i]); kr[2 * i + 1] = bfhi(krv[i]); rr[2 * i] = bflo(rv[i]); rr[2 * i + 1] = bfhi(rv[i]); }
                float ss = 0.f;
#pragma unroll
                for (int i = 0; i < 8; ++i) { kkv[i] = kr[i] * k_k[c0 + i]; ss += kkv[i] * kkv[i]; }
                ss += __shfl_xor(ss, 1); ss += __shfl_xor(ss, 2); ss += __shfl_xor(ss, 4);
                const float inv = 1.f / fmaxf(sqrtf(ss), 1e-12f);
#pragma unroll
                for (int i = 0; i < 8; ++i) kkv[i] *= inv;
                u32x4 o; o.x = pk2(kkv[0], kkv[1]); o.y = pk2(kkv[2], kkv[3]); o.z = pk2(kkv[4], kkv[5]); o.w = pk2(kkv[6], kkv[7]);
                *(u32x4*)(KK + (size_t)row * 512 + c0) = o;
                float bsum = 0.f;
#pragma unroll
                for (int d = 0; d < 2; ++d) {
                    const u32x4 av = *(const u32x4*)(AA + ((size_t)d * NT + row) * 512 + c0);
                    float a[8], kka[8], kd[8];
#pragma unroll
                    for (int i = 0; i < 4; ++i) { a[2 * i] = bflo(av[i]); a[2 * i + 1] = bfhi(av[i]); }
#pragma unroll
                    for (int i = 0; i < 8; ++i) { kka[i] = kkv[i] * a[i]; kd[i] = kr[i] * (1.f + (a[i] - 1.f) * k_a[c0 + i]); bsum += rr[i] * kd[i] * r_k[c0 + i]; }
                    u32x4 o1; o1.x = pk2(kka[0], kka[1]); o1.y = pk2(kka[2], kka[3]); o1.z = pk2(kka[4], kka[5]); o1.w = pk2(kka[6], kka[7]);
                    *(u32x4*)(KKA + ((size_t)d * NT + row) * 512 + c0) = o1;
                    u32x4 o2; o2.x = pk2(kd[0], kd[1]); o2.y = pk2(kd[2], kd[3]); o2.z = pk2(kd[4], kd[5]); o2.w = pk2(kd[6], kd[7]);
                    *(u32x4*)(KD + ((size_t)d * NT + row) * 512 + c0) = o2;
                }
                bsum += __shfl_xor(bsum, 1); bsum += __shfl_xor(bsum, 2); bsum += __shfl_xor(bsum, 4);
                if ((lane & 7) == 0) BC[(size_t)row * 8 + (lane >> 3)] = bsum;
                    }
        __syncthreads();
    }
}

#define RWS 72
__device__ __forceinline__ bf16x8 rw_frag(const bf16_t* M, int row, int kofs) { return *(const bf16x8*)(M + row * RWS + kofs); }
__device__ __forceinline__ f32x4 rw_tile(const bf16_t* Am, int ra, const bf16_t* Bm, int rb, int fr, int fq) {
    f32x4 acc = (f32x4){0.f, 0.f, 0.f, 0.f};
    acc = __builtin_amdgcn_mfma_f32_16x16x32_bf16(rw_frag(Am, ra + fr, 8 * fq), rw_frag(Bm, rb + fr, 8 * fq), acc, 0, 0, 0);
    acc = __builtin_amdgcn_mfma_f32_16x16x32_bf16(rw_frag(Am, ra + fr, 32 + 8 * fq), rw_frag(Bm, rb + fr, 32 + 8 * fq), acc, 0, 0, 0);
    return acc;
}
__device__ __forceinline__ void phase_6(CParams& P, unsigned char* lds, const int ph) {
    PHASE_PROLOGUE
    constexpr int GST = 68, RST = 132;
    float* Gs = (float*)lds;
    bf16_t* A_rm = (bf16_t*)(lds + 64 * GST * 4); bf16_t* R_rm = A_rm + 64 * RWS; bf16_t* B_rm = R_rm + 64 * RWS; bf16_t* K_rm = B_rm + 64 * RWS;
    bf16_t* B_tr = K_rm + 64 * RWS; bf16_t* K_tr = B_tr + 64 * RWS; bf16_t* V_tr = K_tr + 64 * RWS;
    bf16_t* MAK = V_tr + 64 * RWS; bf16_t* MRB = MAK + 64 * RWS; bf16_t* MRK = MRB + 64 * RWS;
    bf16_t* MABr = MRK + 64 * RWS;
    float* RHS = (float*)(MABr + 64 * RWS);
    float* BT = RHS + 64 * RST; float* OFF = BT + 512; float* GC = OFF + 512;
    bf16_t* X1_tr = A_rm; bf16_t* X2_tr = K_rm;
    for (int i = tid; i < 4 * 64 * RWS / 2; i += 512) ((unsigned*)MAK)[i] = 0u;
    __syncthreads();
    const int fr = lane & 15, fq = lane >> 4;
#define RW1_BAR() do { asm volatile("s_waitcnt lgkmcnt(0)" ::: "memory"); __builtin_amdgcn_s_barrier(); asm volatile("" ::: "memory"); } while (0)
    const int t0 = tid & 63, kp = (tid >> 6) * 8;
    u32x4 nlw, nkk, nka, nkd, nrv, nvv;
#define RW1_LOAD(u_) do { const int ch_ = (u_) / RW_NCH, c_ = (u_) - ch_ * RW_NCH, d_ = ch_ >> 4, b_ = (ch_ >> 3) & 1, h_ = ch_ & 7, s_ = c_ * 64 + t0; \
        const int p_ = d_ ? LSEQ - 1 - s_ : s_; const size_t o_ = (size_t)rowof(b_, s_ < LSEQ ? p_ : 0) * 512 + h_ * 64 + kp; \
        nlw = *(const u32x4*)(LW + (size_t)d_ * NT * 512 + o_); nkk = *(const u32x4*)(KK + o_); nka = *(const u32x4*)(KKA + (size_t)d_ * NT * 512 + o_); \
        nkd = *(const u32x4*)(KD + (size_t)d_ * NT * 512 + o_); nrv = *(const u32x4*)(Rr + o_); nvv = *(const u32x4*)(VV + o_); } while (0)
    if (bid < RW_UNITS) RW1_LOAD(bid);
    for (int u = bid; u < RW_UNITS; u += G) {
        const int chain = u / RW_NCH, c = u - chain * RW_NCH;
        float lw[8], kk[8], ka[8], kd[8], rr[8]; u32x4 vv;
        {
            const bool valid = c * 64 + t0 < LSEQ;
            vv = nvv;
#pragma unroll
            for (int i = 0; i < 4; ++i) {
                union { unsigned u; _Float16 hh[2]; } cv; cv.u = nlw[i];
                lw[2 * i] = valid ? (float)cv.hh[0] : 0.f; lw[2 * i + 1] = valid ? (float)cv.hh[1] : 0.f;
                kk[2 * i] = valid ? bflo(nkk[i]) : 0.f; kk[2 * i + 1] = valid ? bfhi(nkk[i]) : 0.f;
                ka[2 * i] = valid ? bflo(nka[i]) : 0.f; ka[2 * i + 1] = valid ? bfhi(nka[i]) : 0.f;
                kd[2 * i] = valid ? bflo(nkd[i]) : 0.f; kd[2 * i + 1] = valid ? bfhi(nkd[i]) : 0.f;
                rr[2 * i] = valid ? bflo(nrv[i]) : 0.f; rr[2 * i + 1] = valid ? bfhi(nrv[i]) : 0.f;
                if (!valid) vv[i] = 0u;
            }
        }
        if (u + G < RW_UNITS) RW1_LOAD(u + G);
        float gg_[8];
#pragma unroll
        for (int i = 0; i < 8; ++i) {
            float v = lw[i];
            v += __int_as_float(__builtin_amdgcn_update_dpp(0, __float_as_int(v), 0x111, 0xF, 0xF, false));
            v += __int_as_float(__builtin_amdgcn_update_dpp(0, __float_as_int(v), 0x112, 0xF, 0xF, false));
            v += __int_as_float(__builtin_amdgcn_update_dpp(0, __float_as_int(v), 0x114, 0xF, 0xF, false));
            v += __int_as_float(__builtin_amdgcn_update_dpp(0, __float_as_int(v), 0x118, 0xF, 0xF, false));
            v += __int_as_float(__builtin_amdgcn_update_dpp(0, __float_as_int(v), 0x142, 0xA, 0xF, false));
            v += __int_as_float(__builtin_amdgcn_update_dpp(0, __float_as_int(v), 0x143, 0xC, 0xF, false));
            gg_[i] = v;
        }
#ifndef RW1_REP0
#define RW1_REP0 1
#endif
        for (int rep0_ = 0; rep0_ < RW1_REP0; ++rep0_) {
        {
            float va[8], vr[8], vb[8], vk[8];
#pragma unroll
            for (int i = 0; i < 8; ++i) {
                const float g = gg_[i];
                const float eg = __expf(g), egm1 = __expf(g - lw[i]), einv = __expf(-g);
                va[i] = kk[i] * egm1; vr[i] = rr[i] * eg; vb[i] = ka[i] * einv; vk[i] = kd[i] * einv;
                if (t0 == 63) GC[kp + i] = eg;
            }
            *(f32x4*)(RHS + t0 * RST + kp) = (f32x4){va[0], va[1], va[2], va[3]}; *(f32x4*)(RHS + t0 * RST + kp + 4) = (f32x4){va[4], va[5], va[6], va[7]};
            u32x4 w4;
            w4.x = pk2(va[0], va[1]); w4.y = pk2(va[2], va[3]); w4.z = pk2(va[4], va[5]); w4.w = pk2(va[6], va[7]); *(u32x4*)(A_rm + t0 * RWS + kp) = w4;
            w4.x = pk2(vr[0], vr[1]); w4.y = pk2(vr[2], vr[3]); w4.z = pk2(vr[4], vr[5]); w4.w = pk2(vr[6], vr[7]); *(u32x4*)(R_rm + t0 * RWS + kp) = w4;
            w4.x = pk2(vb[0], vb[1]); w4.y = pk2(vb[2], vb[3]); w4.z = pk2(vb[4], vb[5]); w4.w = pk2(vb[6], vb[7]); *(u32x4*)(B_rm + t0 * RWS + kp) = w4;
            w4.x = pk2(vk[0], vk[1]); w4.y = pk2(vk[2], vk[3]); w4.z = pk2(vk[4], vk[5]); w4.w = pk2(vk[6], vk[7]); *(u32x4*)(K_rm + t0 * RWS + kp) = w4;
#pragma unroll
            for (int i = 0; i < 8; ++i) { B_tr[(kp + i) * RWS + t0] = (bf16_t)f2bf(vb[i]); K_tr[(kp + i) * RWS + t0] = (bf16_t)f2bf(vk[i]);
                V_tr[(kp + i) * RWS + t0] = (bf16_t)((i & 1) ? (vv[i >> 1] >> 16) : (vv[i >> 1] & 0xffffu)); }
        }
        RW1_BAR();
        }
        float* DQ = Gs; bf16_t* TB = (bf16_t*)BT;
#ifndef RW1_REP1
#define RW1_REP1 1
#endif
#pragma unroll
        for (int s1 = 0; s1 < 5; ++s1) { const int q = wave + 8 * s1;
            const int m = q / 10, e = q - m * 10, ti = e >= 6 ? 3 : (e >= 3 ? 2 : (e >= 1 ? 1 : 0)), tj = e - (ti * (ti + 1)) / 2;
            const f32x4 acc = rw_tile(m < 2 ? A_rm : R_rm, 16 * ti, (m & 1) ? K_rm : B_rm, 16 * tj, fr, fq);
            bf16_t* Mm = m == 1 ? MAK : (m == 2 ? MRB : MRK);
#pragma unroll
            for (int j = 0; j < 4; ++j) { const int t = 16 * ti + 4 * fq + j, i = 16 * tj + fr; const bool keep = m < 2 ? (i < t) : (i <= t); const float val = keep ? acc[j] : 0.f;
                if (m == 0) { MABr[t * RWS + i] = (bf16_t)f2bf(val); if (ti == tj) DQ[((ti * 16 + (t & 15)) * 4 + (fr & 3)) * 4 + (fr >> 2)] = val; }
                else Mm[t * RWS + i] = (bf16_t)f2bf(val); }
        }
        RW1_BAR();
#ifndef RW1_REP23
#define RW1_REP23 1
#endif
        for (int rep23_ = 0; rep23_ < RW1_REP23; ++rep23_) {
        if (wave >= 4) {
            for (int q = wave - 4; q < 16; q += 4) { const int ti = q >> 2, tv = q & 3; const f32x4 acc = rw_tile(MAK, 16 * ti, V_tr, 16 * tv, fr, fq);
#pragma unroll
                for (int j = 0; j < 4; ++j) RHS[(16 * ti + 4 * fq + j) * RST + 64 + 16 * tv + fr] = acc[j]; }
        } else {
            const int bb = wave, cc = lane >> 2, q = lane & 3;
            float xs[4] = {0.f, 0.f, 0.f, 0.f};
#pragma unroll
            for (int tl = 0; tl < 16; ++tl) {
                const f32x4 mv = *(const f32x4*)(DQ + ((bb * 16 + tl) * 4 + q) * 4);
                float part = mv[0] * xs[0] + mv[1] * xs[1] + mv[2] * xs[2] + mv[3] * xs[3];
                part += dppf<0xB1>(part); part += dppf<0x4E>(part);
                const float xt = (tl == cc ? 1.f : 0.f) - part;
                xs[tl >> 2] = (tl & 3) == q ? xt : xs[tl >> 2];
            }
#pragma unroll
            for (int m = 0; m < 4; ++m) TB[(bb * 16 + 4 * m + q) * 16 + cc] = (bf16_t)f2bf(xs[m]);
        }
        RW1_BAR();
        {
            const int c0 = 16 * wave;
            f32x4 X[4];
            const f32x4 zero4 = (f32x4){0.f, 0.f, 0.f, 0.f};
#define RW1_PACK(lo_, hi_, v_) do { union { bf16x8 v; unsigned u[4]; } t_; t_.u[0] = pk2(lo_[0], lo_[1]); t_.u[1] = pk2(lo_[2], lo_[3]); t_.u[2] = pk2(hi_[0], hi_[1]); t_.u[3] = pk2(hi_[2], hi_[3]); v_ = t_.v; } while (0)
#define RW1_LDA(base_, row0_, ca_, cb_, useb_, v_) do { union { bf16x8 v; u32x2 h2[2]; } t_; t_.h2[0] = *(const u32x2*)((base_) + ((row0_) + fr) * RWS + (ca_) + 4 * fq); \
            t_.h2[1] = (useb_) ? *(const u32x2*)((base_) + ((row0_) + fr) * RWS + (cb_) + 4 * fq) : (u32x2){0u, 0u}; v_ = t_.v; } while (0)
#pragma unroll
            for (int bq = 0; bq < 4; ++bq) {
                f32x4 acc;
#pragma unroll
                for (int j = 0; j < 4; ++j) acc[j] = -RHS[(16 * bq + 4 * fq + j) * RST + c0 + fr];
                bf16x8 af, bfv;
                if (bq >= 1) { RW1_LDA(MABr, 16 * bq, 0, 16, bq >= 2, af); if (bq >= 2) RW1_PACK(X[0], X[1], bfv); else RW1_PACK(X[0], zero4, bfv);
                    acc = __builtin_amdgcn_mfma_f32_16x16x32_bf16(af, bfv, acc, 0, 0, 0); }
                if (bq == 3) { RW1_LDA(MABr, 48, 32, 0, false, af); RW1_PACK(X[2], zero4, bfv); acc = __builtin_amdgcn_mfma_f32_16x16x32_bf16(af, bfv, acc, 0, 0, 0); }
                const f32x4 wv = (f32x4){-acc[0], -acc[1], -acc[2], -acc[3]};
                { union { bf16x8 v; u32x2 h2[2]; } t_; t_.h2[0] = *(const u32x2*)(TB + (bq * 16 + fr) * 16 + 4 * fq); t_.h2[1] = (u32x2){0u, 0u}; af = t_.v; }
                RW1_PACK(wv, zero4, bfv);
                X[bq] = __builtin_amdgcn_mfma_f32_16x16x32_bf16(af, bfv, zero4, 0, 0, 0);
                bf16_t* Xm = (wave < 4 ? X1_tr : X2_tr) + ((c0 & 63) + fr) * RWS + 16 * bq + 4 * fq;
                u32x2 o; o.x = pk2(X[bq][0], X[bq][1]); o.y = pk2(X[bq][2], X[bq][3]);
                *(u32x2*)Xm = o;
            }
#undef RW1_PACK
#undef RW1_LDA
        }
        RW1_BAR();
        }
#pragma unroll
        for (int s5 = 0; s5 < 2; ++s5) {
            const int tile = wave * 2 + s5, ta = tile >> 2, tb = tile & 3;
            u32x2 o;
            {
                const f32x4 acc = rw_tile(X1_tr, 16 * ta, B_tr, 16 * tb, fr, fq);
                const int k = 16 * tb + fr, kq = 16 * ta + 4 * fq; const float gc = GC[k];
                float v[4];
#pragma unroll
                for (int j = 0; j < 4; ++j) v[j] = gc * ((kq + j == k ? 1.f : 0.f) - acc[j]);
                o.x = pk2(v[0], v[1]); o.y = pk2(v[2], v[3]);
                *(u32x2*)(PP + (size_t)u * 4096 + k * 64 + 32 * (ta >> 1) + 8 * fq + 4 * (ta & 1)) = o;
            }
            {
                const f32x4 acc = rw_tile(X1_tr, 16 * ta, MRB, 16 * tb, fr, fq);
                const int t = 16 * tb + fr, k0 = 16 * ta + 4 * fq;
                const u32x2 rv = *(const u32x2*)(R_rm + t * RWS + k0);
                o.x = pk2(bflo(rv.x) - acc[0], bfhi(rv.x) - acc[1]); o.y = pk2(bflo(rv.y) - acc[2], bfhi(rv.y) - acc[3]);
                *(u32x2*)(YT + (size_t)u * 4096 + t * 64 + 32 * (ta >> 1) + 8 * fq + 4 * (ta & 1)) = o;
            }
            {
                const f32x4 a1 = rw_tile(K_tr, 16 * ta, V_tr, 16 * tb, fr, fq), a2 = rw_tile(B_tr, 16 * ta, X2_tr, 16 * tb, fr, fq);
                const int v_ = 16 * tb + fr, k0 = 16 * ta + 4 * fq;
                const f32x4 gc = *(const f32x4*)(GC + k0);
                o.x = pk2(gc[0] * (a1[0] - a2[0]), gc[1] * (a1[1] - a2[1])); o.y = pk2(gc[2] * (a1[2] - a2[2]), gc[3] * (a1[3] - a2[3]));
                *(u32x2*)(QT + (size_t)u * 4096 + v_ * 64 + k0) = o;
            }
            {
                const f32x4 a1 = rw_tile(MRK, 16 * ta, V_tr, 16 * tb, fr, fq), a2 = rw_tile(MRB, 16 * ta, X2_tr, 16 * tb, fr, fq);
                const int v_ = 16 * tb + fr, t0_ = 16 * ta + 4 * fq;
                o.x = pk2(a1[0] - a2[0], a1[1] - a2[1]); o.y = pk2(a1[2] - a2[2], a1[3] - a2[3]);
                *(u32x2*)(ZT + (size_t)u * 4096 + v_ * 64 + t0_) = o;
            }
        }
        RW1_BAR();
    }
#undef RW1_LOAD
#undef RW1_BAR
}

__device__ __forceinline__ void s5_setup_units(CParams& P, unsigned char* lds, const int first, const int stride) {
    PHASE_PROLOGUE
    float* pwr = (float*)lds; float* pwi = pwr + 2176; float* bbr = pwi + 2176; float* bbi = bbr + 2048; float* ccr = bbi + 2048; float* cci = ccr + 2048; float* kf = cci + 2048; float* kb = kf + 4096;
    for (int gu = first; gu < 256; gu += stride) {
        const int g = gu >> 2, part = gu & 3;
        if (tid < 128) {
            const int d = tid >> 6, p = tid & 63;
            const float step = __expf(s5_ls[d * 64 + g]);
            const float lr = s5_lre[(d * 64 + g) * 64 + p], li = s5_lim[(d * 64 + g) * 64 + p];
            const float mag = expf(lr * step);
            const float abr = mag * cosf(li * step), abi = mag * sinf(li * step);
            const float den = lr * lr + li * li;
            const float zr = ((abr - 1.f) * lr + abi * li) / den, zi = (abi * lr - (abr - 1.f) * li) / den;
            float pr = 1.f, pi = 0.f;
            for (int t = 0; t < 17; ++t) { pwr[(d * 64 + p) * 17 + t] = pr; pwi[(d * 64 + p) * 17 + t] = pi; const float nr = pr * abr - pi * abi; pi = pr * abi + pi * abr; pr = nr; }
            for (int i = 0; i < 16; ++i) { const float br = s5_b_re[((size_t)(g * 64 + p)) * 16 + i], bi = s5_b_im[((size_t)(g * 64 + p)) * 16 + i];
                bbr[(d * 64 + p) * 16 + i] = zr * br - zi * bi; bbi[(d * 64 + p) * 16 + i] = zr * bi + zi * br; }
        }
        for (int idx = tid; idx < 2048; idx += 512) { const int d = idx >> 10, i = (idx >> 6) & 15, p = idx & 63;
            ccr[(d * 64 + p) * 16 + i] = s5_c_re[((size_t)(d * 64 + g) * 16 + i) * 64 + p]; cci[(d * 64 + p) * 16 + i] = s5_c_im[((size_t)(d * 64 + g) * 16 + i) * 64 + p]; }
        __syncthreads();
        {
            const int d = tid >> 8, tau = (tid >> 4) & 15, i = tid & 15;
            float acc[16];
#pragma unroll
            for (int q = 0; q < 16; ++q) acc[q] = 0.f;
            for (int p = 0; p < 64; ++p) {
                const float cr = ccr[(d * 64 + p) * 16 + i], ci = cci[(d * 64 + p) * 16 + i], pr = pwr[(d * 64 + p) * 17 + tau], pi = pwi[(d * 64 + p) * 17 + tau];
                const float xr = cr * pr - ci * pi, xi = cr * pi + ci * pr;
#pragma unroll
                for (int q = 0; q < 16; ++q) acc[q] += xr * bbr[(d * 64 + p) * 16 + q] - xi * bbi[(d * 64 + p) * 16 + q];
            }
            float* kt = (d ? kb : kf) + (tau * 16 + i) * 16;
#pragma unroll
            for (int q = 0; q < 16; ++q) kt[q] = acc[q];
        }
        __syncthreads();
        unsigned* bta = (unsigned*)(BTA + (size_t)g * 512 * 256);
        for (int idx = part * 128 * 128 + tid; idx < (part + 1) * 128 * 128; idx += 512) {
            const int row = idx >> 7, col = (idx & 127) * 2;
            float v[2];
#pragma unroll
            for (int e = 0; e < 2; ++e) {
                const int cc_ = col + e, j = cc_ >> 4, ip = cc_ & 15;
                if (row < 256) { const int t = row >> 4, i = row & 15;
                    v[e] = j < t ? kf[((t - j) * 16 + i) * 16 + ip] : (j > t ? kb[((j - t) * 16 + i) * 16 + ip] : kf[i * 16 + ip] + kb[i * 16 + ip]); }
                else { const int kp = row - 256, d = kp >> 7, part = (kp >> 6) & 1, p = kp & 63, tau = d == 0 ? 15 - j : j;
                    const float pr = pwr[(d * 64 + p) * 17 + tau], pi = pwi[(d * 64 + p) * 17 + tau], br = bbr[(d * 64 + p) * 16 + ip], bi = bbi[(d * 64 + p) * 16 + ip];
                    v[e] = part ? pr * bi + pi * br : pr * br - pi * bi; }
            }
            bta[idx] = pk2(v[0], v[1]);
        }
        unsigned* btc = (unsigned*)(BTC + (size_t)g * 256 * 256);
        for (int idx = part * 64 * 128 + tid; idx < (part + 1) * 64 * 128; idx += 512) {
            const int row = idx >> 7, col = (idx & 127) * 2, t = row >> 4, i = row & 15;
            float v[2];
#pragma unroll
            for (int e = 0; e < 2; ++e) {
                const int k = col + e, d = k >> 7, part = (k >> 6) & 1, p = k & 63, tau = d == 0 ? t + 1 : 16 - t;
                const float cr = ccr[(d * 64 + p) * 16 + i], ci = cci[(d * 64 + p) * 16 + i], pr = pwr[(d * 64 + p) * 17 + tau], pi = pwi[(d * 64 + p) * 17 + tau];
                v[e] = part ? -(cr * pi + ci * pr) : cr * pr - ci * pi;
            }
            btc[idx] = pk2(v[0], v[1]);
        }
        __syncthreads();
    }
}

__device__ __forceinline__ void phase_60(CParams& P, unsigned char* lds, const int ph) {
    PHASE_PROLOGUE
    if (bid < 32) {
        const int chain = bid, d = chain >> 4, b = (chain >> 3) & 1, h = chain & 7;
        const int fr = lane & 15, fq = lane >> 4;
        constexpr int MATB = 64 * RWS * 2, SLOT = 4 * MATB;
        bf16_t* ybuf = (bf16_t*)(lds + 3 * SLOT);
        const bool comp = wave < 4; const int vb = wave & 3, lm = wave & 3;
        const unsigned char* src = (const unsigned char*)(lm == 0 ? PP : (lm == 1 ? YT : (lm == 2 ? QT : ZT))) + (size_t)chain * RW_NCH * 8192 + lane * 16;
        u32x4 R0[8], R1[8], R2[8];
#define RW2_LD(Rx, c_) do { _Pragma("unroll") for (int i_ = 0; i_ < 8; ++i_) Rx[i_] = *(const u32x4*)(src + (size_t)(c_) * 8192 + i_ * 1024); } while (0)
#define RW2_ST(Rx, c_) do { unsigned char* dst_ = lds + ((c_) % 3) * SLOT + lm * MATB; _Pragma("unroll") for (int i_ = 0; i_ < 8; ++i_) { const int p_ = lane + 64 * i_; *(u32x4*)(dst_ + (p_ >> 3) * (RWS * 2) + (p_ & 7) * 16) = Rx[i_]; } } while (0)
#define RW2_FLUSH(c_) do { const int tl_ = 16 * lm + (lane >> 2), s_ = (c_) * 64 + tl_; const bf16_t* yb_ = ybuf + ((c_) & 1) * 64 * RWS + tl_ * RWS + 16 * (lane & 3); \
            const u32x4 y0_ = *(const u32x4*)yb_, y1_ = *(const u32x4*)(yb_ + 8); \
            if (s_ < LSEQ) { const int p_ = d ? LSEQ - 1 - s_ : s_; bf16_t* g_ = YFB + ((size_t)d * NT + rowof(b, p_)) * 512 + h * 64 + 16 * (lane & 3); *(u32x4*)g_ = y0_; *(u32x4*)(g_ + 8) = y1_; } } while (0)
        const f32x4 zero4 = (f32x4){0.f, 0.f, 0.f, 0.f};
        f32x4 S[4] = {zero4, zero4, zero4, zero4};
#define RW2_COMPUTE(c_) do { const bf16_t* sl_ = (const bf16_t*)(lds + ((c_) % 3) * SLOT); const bf16_t* sP = sl_; const bf16_t* sY = sl_ + 64 * RWS; const bf16_t* sQ = sl_ + 2 * 64 * RWS; const bf16_t* sZ = sl_ + 3 * 64 * RWS; \
            bf16_t* yo_ = ybuf + ((c_) & 1) * 64 * RWS + 16 * vb + fr; \
            union { bf16x8 v; unsigned u[4]; } bs[2]; \
            _Pragma("unroll") for (int ks = 0; ks < 2; ++ks) { bs[ks].u[0] = pk2(S[2 * ks][0], S[2 * ks][1]); bs[ks].u[1] = pk2(S[2 * ks][2], S[2 * ks][3]); \
                bs[ks].u[2] = pk2(S[2 * ks + 1][0], S[2 * ks + 1][1]); bs[ks].u[3] = pk2(S[2 * ks + 1][2], S[2 * ks + 1][3]); } \
            _Pragma("unroll") for (int tt = 0; tt < 4; ++tt) { \
                const u32x2 z2 = *(const u32x2*)(sZ + (16 * vb + fr) * RWS + 16 * tt + 4 * fq); \
                f32x4 acc = (f32x4){bflo(z2.x), bfhi(z2.x), bflo(z2.y), bfhi(z2.y)}; \
                acc = __builtin_amdgcn_mfma_f32_16x16x32_bf16(*(const bf16x8*)(sY + (16 * tt + fr) * RWS + 8 * fq), bs[0].v, acc, 0, 0, 0); \
                acc = __builtin_amdgcn_mfma_f32_16x16x32_bf16(*(const bf16x8*)(sY + (16 * tt + fr) * RWS + 32 + 8 * fq), bs[1].v, acc, 0, 0, 0); \
                _Pragma("unroll") for (int j = 0; j < 4; ++j) yo_[(16 * tt + 4 * fq + j) * RWS] = (bf16_t)f2bf(acc[j]); } \
            f32x4 Sn[4]; \
            _Pragma("unroll") for (int kt = 0; kt < 4; ++kt) { \
                const u32x2 q2 = *(const u32x2*)(sQ + (16 * vb + fr) * RWS + 16 * kt + 4 * fq); \
                f32x4 acc = (f32x4){bflo(q2.x), bfhi(q2.x), bflo(q2.y), bfhi(q2.y)}; \
                acc = __builtin_amdgcn_mfma_f32_16x16x32_bf16(*(const bf16x8*)(sP + (16 * kt + fr) * RWS + 8 * fq), bs[0].v, acc, 0, 0, 0); \
                acc = __builtin_amdgcn_mfma_f32_16x16x32_bf16(*(const bf16x8*)(sP + (16 * kt + fr) * RWS + 32 + 8 * fq), bs[1].v, acc, 0, 0, 0); \
                Sn[kt] = acc; } \
            _Pragma("unroll") for (int kt = 0; kt < 4; ++kt) S[kt] = Sn[kt]; } while (0)
#define RW2_BAR() do { asm volatile("s_waitcnt lgkmcnt(0)" ::: "memory"); __builtin_amdgcn_s_barrier(); asm volatile("" ::: "memory"); } while (0)
        if (!comp) { RW2_LD(R0, 0); RW2_ST(R0, 0); RW2_LD(R0, 1); RW2_LD(R1, 2); RW2_LD(R2, 3); }
        __syncthreads();
        for (int c = 0; c < RW_NCH; c += 3) {
            if (!comp) { if (c + 1 < RW_NCH) RW2_ST(R0, c + 1); if (c + 4 < RW_NCH) RW2_LD(R0, c + 4); if (c > 0) RW2_FLUSH(c - 1); } else RW2_COMPUTE(c);
            RW2_BAR();
            if (!comp) { if (c + 2 < RW_NCH) RW2_ST(R1, c + 2); if (c + 5 < RW_NCH) RW2_LD(R1, c + 5); RW2_FLUSH(c); } else RW2_COMPUTE(c + 1);
            RW2_BAR();
            if (!comp) { if (c + 3 < RW_NCH) RW2_ST(R2, c + 3); if (c + 6 < RW_NCH) RW2_LD(R2, c + 6); RW2_FLUSH(c + 1); } else RW2_COMPUTE(c + 2);
            RW2_BAR();
        }
        if (!comp) RW2_FLUSH(RW_NCH - 1);
#undef RW2_LD
#undef RW2_ST
#undef RW2_FLUSH
#undef RW2_COMPUTE
#undef RW2_BAR
    } else {
        na_units(P, lds, bid - 32, G - 32);
        s5_setup_units(P, lds, bid - 32, G - 32);
    }
}

__device__ __forceinline__ void phase_7(CParams& P, unsigned char* lds, const int ph) {
    PHASE_PROLOGUE
            for (int row = gw; row < NT; row += NGW) {
                const int c0 = lane * 8;
                const u32x4 yf = *(const u32x4*)(YFB + (size_t)row * 512 + c0);
                const u32x4 yb = *(const u32x4*)(YFB + ((size_t)NT + row) * 512 + c0);
                const u32x4 vv = *(const u32x4*)(VV + (size_t)row * 512 + c0);
                const u32x4 gg = *(const u32x4*)(Gg + (size_t)row * 512 + c0);
                float y[8], v[8], g[8];
#pragma unroll
                for (int i = 0; i < 4; ++i) { y[2 * i] = bflo(yf[i]) + bflo(yb[i]); y[2 * i + 1] = bfhi(yf[i]) + bfhi(yb[i]); v[2 * i] = bflo(vv[i]); v[2 * i + 1] = bfhi(vv[i]); g[2 * i] = bflo(gg[i]); g[2 * i + 1] = bfhi(gg[i]); }
                float sm = 0.f;
#pragma unroll
                for (int i = 0; i < 8; ++i) sm += y[i];
                sm += __shfl_xor(sm, 1); sm += __shfl_xor(sm, 2); sm += __shfl_xor(sm, 4);
                const float mean = sm * (1.f / 64.f);
                float vr = 0.f;
#pragma unroll
                for (int i = 0; i < 8; ++i) { const float dlt = y[i] - mean; vr += dlt * dlt; }
                vr += __shfl_xor(vr, 1); vr += __shfl_xor(vr, 2); vr += __shfl_xor(vr, 4);
                const float rstd = rsqrtf(vr * (1.f / 64.f) + 64e-5f);
                const float bc = BC[(size_t)row * 8 + (lane >> 3)];
                float o[8];
#pragma unroll
                for (int i = 0; i < 8; ++i) o[i] = ((y[i] - mean) * rstd * lnx_g[c0 + i] + lnx_b[c0 + i] + bc * v[i]) * g[i];
                u32x4 ov; ov.x = pk2(o[0], o[1]); ov.y = pk2(o[2], o[3]); ov.z = pk2(o[4], o[5]); ov.w = pk2(o[6], o[7]);
                *(u32x4*)(A2 + (size_t)row * DM + 512 + c0) = ov;
            }
}


__device__ __forceinline__ void phase_8(CParams& P, unsigned char* lds, const int ph) {
    PHASE_PROLOGUE
    if (gw < 64) meta_gemm<0>(A2 + (size_t)NMAIN * DM, WTOUT, H + (size_t)NMAIN * DM, gw, lane);
    pg8::DenseOrder S; S.init(A2, WTOUT, NMAIN, DM, DM, G, bid);
    pg8::EpiResidual E{H};
    pg8::gemm_phase<pg8::EpiResidual, pg8::DenseOrder, true, true>((PG8_LAS unsigned char*)lds, DM, S, E);
}

__device__ __forceinline__ void phase_9(CParams& P, unsigned char* lds, const int ph) {
    PHASE_PROLOGUE
            const int l = ph == 9 ? 0 : 1;
                    for (int i = bid * 512 + tid; i < MOE_MAXROWS; i += G * 512) ROWTOK[i] = 0;
    __attribute__((address_space(3))) int* lcnt = (__attribute__((address_space(3))) int*)lds;
    if (tid < NEXP + 2) lcnt[tid] = 0;
    __syncthreads();
            const float* wg = moe_wg + (size_t)l * DM * 4; const float* bg = moe_bg + l * 4;
    int first = 0;
    if (l == 1) {
        const int c = lane < NEXP ? (int)CTL[CW_CNT(0) + lane] : 0; const int tt = (int)wave_sum((float)((c + MOE_RT - 1) / MOE_RT));
        const int r = (4 * tt - 1) & (GRID - 1);
        first = FILL_A + (GRID - 1 - r) * 8 * (FILL_Q11 + FILL_Q12);
    }
    const int nrows = (NT - bid + GRID - 1) / GRID;
    const int nconv = ph == 117 ? 0 : (CONV_MOE_ITEMS - first - bid + GRID - 1) / GRID;
    int mode = __builtin_amdgcn_readfirstlane(wave) < 3 ? 0 : 1, switched = 0;
            for (;;) {
                int q_ = 0; if (lane == 0) q_ = __hip_atomic_fetch_add(lcnt + NEXP + mode, 1, __ATOMIC_RELAXED, __HIP_MEMORY_SCOPE_WORKGROUP);
                q_ = __builtin_amdgcn_readfirstlane(q_);
                if (q_ >= (mode ? nconv : nrows)) { if (switched) break; switched = 1; mode ^= 1; continue; }
                if (mode) { conv_moe_item(P, l, first + bid + GRID * q_, lane); continue; }
                const int row = bid + GRID * q_;
                f32x4 v[4]; float ss = 0.f;
#pragma unroll
                for (int j = 0; j < 4; ++j) { v[j] = ldrow_bf16(H + (size_t)row * DM, lane, j); ss += v[j][0] * v[j][0] + v[j][1] * v[j][1] + v[j][2] * v[j][2] + v[j][3] * v[j][3]; }
                ss = wave_sum(ss);
                const float rstd = rsqrtf(ss * (1.f / DM) + 1e-6f);
                float lg[4] = {0.f, 0.f, 0.f, 0.f};
#pragma unroll
                for (int j = 0; j < 4; ++j) {
                    const f32x4 g = ((const f32x4*)(norm_ffn + l * DM))[lane + 64 * j];
#pragma unroll
                    for (int i = 0; i < 4; ++i) v[j][i] = v[j][i] * rstd * g[i];
                    u32x2 o; o.x = pk2(v[j][0], v[j][1]); o.y = pk2(v[j][2], v[j][3]);
                    ((u32x2*)(HN + (size_t)row * DM))[lane + 64 * j] = o;
#pragma unroll
                    for (int i = 0; i < 4; ++i) { const f32x4 w = *(const f32x4*)(wg + (size_t)(4 * (lane + 64 * j) + i) * 4);
                        lg[0] += v[j][i] * w[0]; lg[1] += v[j][i] * w[1]; lg[2] += v[j][i] * w[2]; lg[3] += v[j][i] * w[3]; }
                }
#pragma unroll
                for (int q = 0; q < 4; ++q) lg[q] = wave_sum(lg[q]) + bg[q];
                int grp = 0; float mx = lg[0];
#pragma unroll
                for (int q = 1; q < 4; ++q) if (lg[q] > mx) { mx = lg[q]; grp = q; }
                float den = 0.f;
#pragma unroll
                for (int q = 0; q < 4; ++q) den += __expf(lg[q] - mx);
                const float pgrp = 1.f / den;
                const float* we = moe_we + ((size_t)(l * 4 + grp) * DM) * 8;
                float le[8] = {0.f, 0.f, 0.f, 0.f, 0.f, 0.f, 0.f, 0.f};
#pragma unroll
                for (int j = 0; j < 4; ++j)
#pragma unroll
                    for (int i = 0; i < 4; ++i) { const float* wr_ = we + (size_t)(4 * (lane + 64 * j) + i) * 8; const f32x4 wa = *(const f32x4*)wr_, wb = *(const f32x4*)(wr_ + 4);
                        le[0] += v[j][i] * wa[0]; le[1] += v[j][i] * wa[1]; le[2] += v[j][i] * wa[2]; le[3] += v[j][i] * wa[3];
                        le[4] += v[j][i] * wb[0]; le[5] += v[j][i] * wb[1]; le[6] += v[j][i] * wb[2]; le[7] += v[j][i] * wb[3]; }
#pragma unroll
                for (int q = 0; q < 8; ++q) le[q] = wave_sum(le[q]) + moe_be[(l * 4 + grp) * 8 + q];
                int i1 = 0; float m1 = le[0];
#pragma unroll
                for (int q = 1; q < 8; ++q) if (le[q] > m1) { m1 = le[q]; i1 = q; }
                int i2 = (i1 + 1) & 7; float m2 = -3.0e38f;
#pragma unroll
                for (int q = 0; q < 8; ++q) if (q != i1 && le[q] > m2) { m2 = le[q]; i2 = q; }
                const float e2 = __expf(m2 - m1);
                const float g1 = pgrp / (1.f + e2), g2 = pgrp * e2 / (1.f + e2);
                if (lane == 0) {
                    const int ea = grp * 8 + i1, eb = grp * 8 + i2;
                    const int pa = __hip_atomic_fetch_add(lcnt + ea, 1, __ATOMIC_RELAXED, __HIP_MEMORY_SCOPE_WORKGROUP), pb = __hip_atomic_fetch_add(lcnt + eb, 1, __ATOMIC_RELAXED, __HIP_MEMORY_SCOPE_WORKGROUP);
                    EID[row * 2] = ea; EID[row * 2 + 1] = eb; POS[row * 2] = (int)pa; POS[row * 2 + 1] = (int)pb;
                    GATE[row * 2] = g1; GATE[row * 2 + 1] = g2;
                }
            }
    __syncthreads();
    if (tid < NEXP) CTL[CW_WGC + bid * NEXP + tid] = (unsigned)lcnt[tid];
}


__device__ __forceinline__ void phase_10(CParams& P, unsigned char* lds, const int ph) {
    PHASE_PROLOGUE
    const int l = ph == 10 ? 0 : 1;
    int* T = (int*)lds;
    int* psum = (int*)(lds + 32768);
    int* tots = (int*)(lds + 32768 + 2048);
    int* ps = (int*)(lds + LDS_TAB);
    {
        const int e = tid & 31, part = tid >> 5;
        int c[16]; int s_ = 0;
#pragma unroll
        for (int k = 0; k < 16; ++k) c[k] = (int)CTL[CW_WGC + (part * 16 + k) * NEXP + e];
#pragma unroll
        for (int k = 0; k < 16; ++k) s_ += c[k];
        psum[part * 32 + e] = s_;
        __syncthreads();
        int off = 0, tot = 0;
#pragma unroll
        for (int p_ = 0; p_ < 16; ++p_) { const int v = psum[p_ * 32 + e]; off += p_ < part ? v : 0; tot += v; }
#pragma unroll
        for (int k = 0; k < 16; ++k) { T[(part * 16 + k) * 32 + e] = off; off += c[k]; }
        if (part == 0) { tots[e] = tot; if (bid == 0) CTL[CW_CNT(l) + e] = (unsigned)tot; }
    }
    __syncthreads();
    if (tid == 0) { int acc_ = 0; for (int e = 0; e < NEXP; ++e) { ps[e] = acc_; acc_ += (tots[e] + MOE_RT - 1) / MOE_RT * MOE_RT; } ps[NEXP] = acc_; }
    __syncthreads();
    for (int i = bid * 512 + tid; i < NT * 2; i += G * 512) { const int row = i >> 1, w = row & (GRID - 1), e = EID[i]; const int dest = ps[e] + T[w * 32 + e] + POS[i]; DEST[i] = dest; ROWTOK[dest] = row; }
    __syncthreads();
}

__device__ __forceinline__ void phase_11(CParams& P, unsigned char* lds, const int ph) {
    PHASE_PROLOGUE
    const int l = ph == 11 ? 0 : 1;
    int* et = (int*)(lds + LDS_TAB);
    if (tid == 0) { int acc_ = 0; for (int e = 0; e < NEXP; ++e) { const int c = (int)CTL[CW_CNT(l) + e], n = (c + MOE_RT - 1) / MOE_RT; for (int q = 0; q < n; ++q) et[1 + acc_ + q] = e; acc_ += n; } et[0] = acc_; }
    __syncthreads();
    const int nun = et[0] * 4;
    pg8::MoeOrder<true> S{et + 1, et[0], vcu, (const char*)HN, (const char*)(l ? ws + WS_WT13B : ws + WS_WT13), 256u * DM * 2u, 256u * DM * 2u, (unsigned)DM * DM * 2u, ROWTOK};
    pg8::EpiSwiglu E{HB};
    pg8::gemm_phase<pg8::EpiSwiglu, pg8::MoeOrder<true>, true, true>((PG8_LAS unsigned char*)lds, DM, S, E);
    __syncthreads();
    { const int r = (nun - 1) & (GRID - 1);
      if (l == 0 && vcu > r) conv_range(P, FILL_A + ((vcu - r - 1) * 8 + wave) * FILL_Q11, FILL_Q11, lane); }
}

__device__ __forceinline__ void phase_12(CParams& P, unsigned char* lds, const int ph) {
    PHASE_PROLOGUE
    const int l = ph == 12 ? 0 : 1;
    int* et = (int*)(lds + LDS_TAB);
    if (tid == 0) { int acc_ = 0; for (int e = 0; e < NEXP; ++e) { const int c = (int)CTL[CW_CNT(l) + e], n = (c + MOE_RT - 1) / MOE_RT; for (int q = 0; q < n; ++q) et[1 + acc_ + q] = e; acc_ += n; } et[0] = acc_; }
    __syncthreads();
    const int nun = et[0] * 4;
    pg8::MoeOrder<false> S{et + 1, et[0], vcu, (const char*)HB, (const char*)(l ? ws + WS_WT2B : ws + WS_WT2), 256u * DFF * 2u, 256u * DFF * 2u, (unsigned)DM * DFF * 2u, nullptr};
    pg8::EpiBf16Plain E{YB, DM};
    pg8::gemm_phase<pg8::EpiBf16Plain, pg8::MoeOrder<false>, true, true>((PG8_LAS unsigned char*)lds, DFF, S, E);
    __syncthreads();
    { const int r = (nun - 1) & (GRID - 1);
      if (l == 0 && vcu > r) conv_range(P, FILL_A + (GRID - 1 - r) * 8 * FILL_Q11 + ((vcu - r - 1) * 8 + wave) * FILL_Q12, FILL_Q12, lane); }
}

__device__ __forceinline__ void phase_13(CParams& P, unsigned char* lds, const int ph) {
    PHASE_PROLOGUE
            const bool fin = ph == 21;
            for (int row = gw; row < NT; row += NGW) {
                const int d0 = DEST[row * 2], d1 = DEST[row * 2 + 1];
                const float g0 = GATE[row * 2], g1 = GATE[row * 2 + 1];
                f32x4 v[4];
#pragma unroll
                for (int j = 0; j < 4; ++j) {
                    v[j] = ldrow_bf16(H + (size_t)row * DM, lane, j);
                    const u32x2 ya = ((const u32x2*)(YB + (size_t)d0 * DM))[lane + 64 * j];
                    const u32x2 yb = ((const u32x2*)(YB + (size_t)d1 * DM))[lane + 64 * j];
                    v[j][0] += g0 * bflo(ya.x) + g1 * bflo(yb.x); v[j][1] += g0 * bfhi(ya.x) + g1 * bfhi(yb.x);
                    v[j][2] += g0 * bflo(ya.y) + g1 * bflo(yb.y); v[j][3] += g0 * bfhi(ya.y) + g1 * bfhi(yb.y);
                }
                if (!fin) {
#pragma unroll
                    for (int j = 0; j < 4; ++j) strow_bf16(H + (size_t)row * DM, lane, j, v[j]);
                    store_norm_bf16(v, norm_mix + DM, HN + (size_t)row * DM, lane);
                } else if (row < NMAIN) {
                    float ss = 0.f;
#pragma unroll
                    for (int j = 0; j < 4; ++j) ss += v[j][0] * v[j][0] + v[j][1] * v[j][1] + v[j][2] * v[j][2] + v[j][3] * v[j][3];
                    ss = wave_sum(ss);
                    const float rstd = rsqrtf(ss * (1.f / DM) + 1e-6f);
#pragma unroll
                    for (int j = 0; j < 4; ++j) { const f32x4 g = ((const f32x4*)norm_final)[lane + 64 * j]; f32x4 o;
                        o[0] = v[j][0] * rstd * g[0]; o[1] = v[j][1] * rstd * g[1]; o[2] = v[j][2] * rstd * g[2]; o[3] = v[j][3] * rstd * g[3];
                        ((f32x4*)(P.out + (size_t)row * DM))[lane + 64 * j] = o; }
                }
            }
}

__device__ __forceinline__ void phase_15(CParams& P, unsigned char* lds, const int ph) {
    PHASE_PROLOGUE
    pg8::S5OrderA S{vcu, (const char*)HN, (const char*)BTA};
    pg8::EpiS5A E{YI, S5E};
    int Kr = 256; asm volatile("" : "+s"(Kr));
    pg8::gemm_phase<pg8::EpiS5A, pg8::S5OrderA, true, true>((PG8_LAS unsigned char*)lds, Kr, S, E);
    if (vcu >= 128) conv_range(P, FILL_N22 + ((vcu - 128) * 8 + wave) * FILL_Q15, FILL_Q15, lane);
}

__device__ __forceinline__ void phase_16(CParams& P, unsigned char* lds, const int ph) {
    PHASE_PROLOGUE
    float* Ls = (float*)lds;
    for (int wg = bid; wg < NB * 64 * 2; wg += G) {
        const int d = wg & 1, g = (wg >> 1) & 63, b = wg >> 7, p = lane;
        const float step = __expf(s5_ls[d * 64 + g]);
        const float lr = s5_lre[(d * 64 + g) * 64 + p], li = s5_lim[(d * 64 + g) * 64 + p];
        const float mag = expf(lr * step);
        const float abr = mag * cosf(li * step), abi = mag * sinf(li * step);
        float ar = 1.f, ai = 0.f;
        for (int t = 0; t < 16; ++t) { const float nr = ar * abr - ai * abi; ai = ar * abi + ai * abr; ar = nr; }
        float Ar = 1.f, Ai = 0.f;
        for (int t = 0; t < 64; ++t) { const float nr = Ar * ar - Ai * ai; Ai = Ar * ai + Ai * ar; Ar = nr; }
        const bf16_t* Ep = S5E + (size_t)g * 256 + d * 128 + p;
        bf16_t* Cp = CAR + (size_t)g * 1280 * 256 + d * 128 + p;
        const int q0 = 64 * wave;
#define S5_N(q_) ({ const int c_ = d ? 512 - (q_) : (q_); c_ == 0 ? 1024 + b : b * 512 + c_ - 1; })
        float sr = 0.f, si = 0.f;
#pragma unroll 1
        for (int hb = 0; hb < 2; ++hb) {
            float er[32], ei[32];
#pragma unroll
            for (int k = 0; k < 32; ++k) { const int n = S5_N(q0 + 32 * hb + k); er[k] = bf2f(Ep[(size_t)n * 64 * 256]); ei[k] = bf2f(Ep[(size_t)n * 64 * 256 + 64]); }
#pragma unroll
            for (int k = 0; k < 32; ++k) { const float nr = ar * sr - ai * si + er[k]; si = ar * si + ai * sr + ei[k]; sr = nr; }
        }
        Ls[(wave * 64 + p) * 2] = sr; Ls[(wave * 64 + p) * 2 + 1] = si;
        __syncthreads();
        sr = 0.f; si = 0.f;
        for (int w2 = 0; w2 < wave; ++w2) { const float l0 = Ls[(w2 * 64 + p) * 2], l1 = Ls[(w2 * 64 + p) * 2 + 1]; const float nr = Ar * sr - Ai * si + l0; si = Ar * si + Ai * sr + l1; sr = nr; }
#pragma unroll 1
        for (int hb = 0; hb < 2; ++hb) {
            float er[32], ei[32]; int nn[32];
#pragma unroll
            for (int k = 0; k < 32; ++k) { nn[k] = S5_N(q0 + 32 * hb + k); er[k] = bf2f(Ep[(size_t)nn[k] * 64 * 256]); ei[k] = bf2f(Ep[(size_t)nn[k] * 64 * 256 + 64]); }
#pragma unroll
            for (int k = 0; k < 32; ++k) { Cp[(size_t)nn[k] * 256] = (bf16_t)f2bf(sr); Cp[(size_t)nn[k] * 256 + 64] = (bf16_t)f2bf(si);
                const float nr = ar * sr - ai * si + er[k]; si = ar * si + ai * sr + ei[k]; sr = nr; }
        }
        if (wave == 7) { const int n = S5_N(512); Cp[(size_t)n * 256] = (bf16_t)f2bf(sr); Cp[(size_t)n * 256 + 64] = (bf16_t)f2bf(si); }
#undef S5_N
        __syncthreads();
    }
}

__device__ __forceinline__ void phase_22(CParams& P, unsigned char* lds, const int ph) {
    PHASE_PROLOGUE
    pg8::S5OrderC S{vcu, (const char*)CAR, (const char*)BTC};
    pg8::EpiS5C E{YI, HN, s5_d, A2};
    int Kr = 256; asm volatile("" : "+s"(Kr));
    pg8::gemm_phase<pg8::EpiS5C, pg8::S5OrderC, true, true>((PG8_LAS unsigned char*)lds, Kr, S, E);
    if (vcu >= 64) conv_range(P, ((vcu - 64) * 8 + wave) * FILL_Q22, FILL_Q22, lane);
}

__device__ __forceinline__ void phase_23(CParams& P, unsigned char* lds, const int ph) {
    PHASE_PROLOGUE
    if (gw < 64) meta_gemm<1>(A2 + (size_t)NMAIN * DM, WTGLU, H + (size_t)NMAIN * DM, gw, lane);
    pg8::DenseOrder S; S.init(A2, WTGLU, NMAIN, 2 * DM, DM, G, bid);
    pg8::EpiGlu E{H};
    pg8::gemm_phase<pg8::EpiGlu, pg8::DenseOrder, true, true>((PG8_LAS unsigned char*)lds, DM, S, E);
}
#define LAS __attribute__((address_space(3)))
#define CW_BAR 4096
#define XB_TMO      128
#define XB_XCNT(j)  (256  + 64 * (j))
#define XB_XSUB(j)  (1280 + 64 * (j))
#define XB_XGEN(j)  (2304 + 64 * (j))
#define XB_TOP      3328
#define XB_TOPGEN   3392
#define XCD_BAR_WORDS 3456
#define XB_SPIN_CAP (1u << 22)
__device__ __forceinline__ unsigned xb_ld(unsigned* p)              { return __hip_atomic_load(p, __ATOMIC_RELAXED, __HIP_MEMORY_SCOPE_AGENT); }
__device__ __forceinline__ unsigned xb_add(unsigned* p, unsigned v) { return __hip_atomic_fetch_add(p, v, __ATOMIC_RELAXED, __HIP_MEMORY_SCOPE_AGENT); }
__device__ __forceinline__ unsigned xb_xcc_id() { return (unsigned)__builtin_amdgcn_s_getreg((3 << 11) | 20) & 0xFu; }
#define XB_SPIN(cond, bar) do { unsigned _sp = 0; while (cond) { __builtin_amdgcn_s_sleep(1); \
    if ((++_sp & 255u) == 0u) { if (xb_ld(&(bar)[XB_TMO])) break; if (_sp > XB_SPIN_CAP) { atomicAdd(&(bar)[XB_TMO], 1u); break; } } } } while (0)
struct XcdBarrier { unsigned* bar; unsigned x; volatile LAS unsigned* st; };
__device__ __forceinline__ XcdBarrier xcd_barrier_post(unsigned* bar, volatile LAS unsigned* st) {
    XcdBarrier b; b.bar = bar; b.x = xb_xcc_id(); b.st = st;
    if (threadIdx.x == 0) (void)xb_add(&bar[XB_XCNT(b.x)], 1u);
    return b;
}
__device__ __forceinline__ void xcd_barrier_complete(unsigned* bar, unsigned x, unsigned& nloc, unsigned& nx) {
    const unsigned G = GRID;
    unsigned sum, cnt, mine, sp = 0u;
    for (;;) {
        sum = 0u; cnt = 0u; mine = 0u;
#pragma unroll
        for (unsigned j = 0; j < 16; ++j) { const unsigned c = xb_ld(&bar[XB_XCNT(j)]); sum += c; cnt += (c > 0u) ? 1u : 0u; mine = (j == x) ? c : mine; }
        if (sum == G) break;
        __builtin_amdgcn_s_sleep(1);
        if ((++sp & 255u) == 0u) { if (xb_ld(&bar[XB_TMO])) break; if (sp > XB_SPIN_CAP) { atomicAdd(&bar[XB_TMO], 1u); break; } }
    }
    nloc = mine > 0u ? mine : 1u; nx = cnt > 0u ? cnt : 1u;
}
__device__ __forceinline__ void xcd_barrier(const XcdBarrier& b) {
    asm volatile("s_waitcnt vmcnt(0)" ::: "memory");
    __syncthreads();
    if (threadIdx.x == 0) {
        unsigned* bar = b.bar;
        __builtin_amdgcn_s_waitcnt(0);
        unsigned nloc = b.st[0], nx = b.st[1];
        if (nloc == 0u) { xcd_barrier_complete(bar, b.x, nloc, nx); b.st[0] = nloc; b.st[1] = nx; }
        const unsigned old = xb_add(&bar[XB_XSUB(b.x)], 1u);
        const unsigned gen = old / nloc;
        if (old + 1u == (gen + 1u) * nloc) {
            __builtin_amdgcn_fence(__ATOMIC_RELEASE, "agent");
            asm volatile("s_waitcnt vmcnt(0)" ::: "memory");
            const unsigned og = xb_add(&bar[XB_TOP], 1u);
            const unsigned tg = og / nx;
            if (og + 1u == (tg + 1u) * nx) xb_add(&bar[XB_TOPGEN], 1u);
            else XB_SPIN(xb_ld(&bar[XB_TOPGEN]) == tg, bar);
            __builtin_amdgcn_fence(__ATOMIC_ACQUIRE, "agent");
            xb_add(&bar[XB_XGEN(b.x)], 1u);
            asm volatile("s_waitcnt vmcnt(0)" ::: "memory");
        } else {
            XB_SPIN(xb_ld(&bar[XB_XGEN(b.x)]) == gen, bar);
            __builtin_amdgcn_fence(__ATOMIC_ACQUIRE, "agent");
            asm volatile("s_waitcnt vmcnt(0)" ::: "memory");
        }
    }
    __syncthreads();
}


__global__ void __launch_bounds__(512, 2) mega(Params P_) {
    extern __shared__ __attribute__((aligned(16))) unsigned char lds[];
    volatile LAS unsigned* st = (volatile LAS unsigned*)(LAS unsigned char*)(lds + LDS_BARST);
    if (threadIdx.x < 16) st[threadIdx.x] = 0u;
    __syncthreads();
    CParams* pp = (CParams*)__builtin_amdgcn_kernarg_segment_ptr();
    (void)xcd_barrier_post((unsigned*)(pp->ws + WS_CTL) + CW_BAR, st);
#define GB do { XcdBarrier bar_; bar_.bar = (unsigned*)(pp->ws + WS_CTL) + CW_BAR; bar_.x = xb_xcc_id(); bar_.st = (volatile LAS unsigned*)(LAS unsigned char*)(lds + LDS_BARST); xcd_barrier(bar_); asm volatile("" : "+s"(pp)); } while (0)
#define P (*pp)
    asm volatile("" : "+s"(pp));
    phase_0(P, lds, 0); GB;
#if defined(PROBE_PH) && PROBE_PH == 0
    { int nrep = PROBE_N; asm volatile("" : "+s"(nrep)); for (int rep = 0; rep < nrep; ++rep) { GB; phase_0(P, lds, 0); GB; } }
#endif
    phase_1(P, lds, 1); GB;
#if defined(PROBE_PH) && PROBE_PH == 1
    { int nrep = PROBE_N; asm volatile("" : "+s"(nrep)); for (int rep = 0; rep < nrep; ++rep) { GB; phase_1(P, lds, 1); GB; } }
#endif
    phase_3(P, lds, 3); GB;
#if defined(PROBE_PH) && PROBE_PH == 3
    { int nrep = PROBE_N; asm volatile("" : "+s"(nrep)); for (int rep = 0; rep < nrep; ++rep) { GB; phase_3(P, lds, 3); GB; } }
#endif
    phase_6(P, lds, 6); GB;
    phase_60(P, lds, 60); GB;
#if defined(PROBE_PH) && PROBE_PH == 60
    { int nrep = PROBE_N; asm volatile("" : "+s"(nrep)); for (int rep = 0; rep < nrep; ++rep) { GB; phase_60(P, lds, 60); GB; } }
#endif
#if defined(PROBE_PH) && PROBE_PH == 6
    { int nrep = PROBE_N; asm volatile("" : "+s"(nrep)); for (int rep = 0; rep < nrep; ++rep) { GB; phase_6(P, lds, 6); GB; } }
#endif
    phase_7(P, lds, 7); GB;
#if defined(PROBE_PH) && PROBE_PH == 7
    { int nrep = PROBE_N; asm volatile("" : "+s"(nrep)); for (int rep = 0; rep < nrep; ++rep) { GB; phase_7(P, lds, 7); GB; } }
#endif
    phase_8(P, lds, 8); GB;
#if defined(PROBE_PH) && PROBE_PH == 8
    { int nrep = PROBE_N; asm volatile("" : "+s"(nrep)); for (int rep = 0; rep < nrep; ++rep) { GB; phase_8(P, lds, 8); GB; } }
#endif
    phase_9(P, lds, 9); GB;
#if defined(PROBE_PH) && PROBE_PH == 9
    { int nrep = PROBE_N; asm volatile("" : "+s"(nrep)); for (int rep = 0; rep < nrep; ++rep) { GB; phase_9(P, lds, 9); GB; } }
#endif
    phase_10(P, lds, 10); GB;
#if defined(PROBE_PH) && PROBE_PH == 10
    { int nrep = PROBE_N; asm volatile("" : "+s"(nrep)); for (int rep = 0; rep < nrep; ++rep) { GB; phase_10(P, lds, 10); GB; } }
#endif
    phase_11(P, lds, 11); GB;
#if defined(PROBE_PH) && PROBE_PH == 11
    { int nrep = PROBE_N; asm volatile("" : "+s"(nrep)); for (int rep = 0; rep < nrep; ++rep) { GB; phase_11(P, lds, 11); GB; } }
#endif
    phase_12(P, lds, 12); GB;
#if defined(PROBE_PH) && PROBE_PH == 12
    { int nrep = PROBE_N; asm volatile("" : "+s"(nrep)); for (int rep = 0; rep < nrep; ++rep) { GB; phase_12(P, lds, 12); GB; } }
#endif
    phase_13(P, lds, 13); GB;
#if defined(PROBE_PH) && PROBE_PH == 13
    { int nrep = PROBE_N; asm volatile("" : "+s"(nrep)); for (int rep = 0; rep < nrep; ++rep) { GB; phase_13(P, lds, 13); GB; } }
#endif
    phase_15(P, lds, 15); GB;
#if defined(PROBE_PH) && PROBE_PH == 15
    { int nrep = PROBE_N; asm volatile("" : "+s"(nrep)); for (int rep = 0; rep < nrep; ++rep) { GB; phase_15(P, lds, 15); GB; } }
#endif
    phase_16(P, lds, 16); GB;
#if defined(PROBE_PH) && PROBE_PH == 16
    { int nrep = PROBE_N; asm volatile("" : "+s"(nrep)); for (int rep = 0; rep < nrep; ++rep) { GB; phase_16(P, lds, 16); GB; } }
#endif
    phase_22(P, lds, 22); GB;
#if defined(PROBE_PH) && PROBE_PH == 22
    { int nrep = PROBE_N; asm volatile("" : "+s"(nrep)); for (int rep = 0; rep < nrep; ++rep) { GB; phase_22(P, lds, 22); GB; } }
#endif
    phase_23(P, lds, 23); GB;
#if defined(PROBE_PH) && PROBE_PH == 23
    { int nrep = PROBE_N; asm volatile("" : "+s"(nrep)); for (int rep = 0; rep < nrep; ++rep) { GB; phase_23(P, lds, 23); GB; } }
#endif
    phase_9(P, lds, 17); GB;
#if defined(PROBE_PH) && (PROBE_PH == 17 || PROBE_PH == 117)
    { int nrep = PROBE_N; asm volatile("" : "+s"(nrep)); for (int rep = 0; rep < nrep; ++rep) { GB; if (blockIdx.x == 0 && threadIdx.x < 32) ((unsigned*)(pp->ws + WS_CTL))[CW_CNT(1) + threadIdx.x] = 0u; GB; phase_9(P, lds, PROBE_PH); GB; } }
#endif
    phase_10(P, lds, 18); GB;
#if defined(PROBE_PH) && PROBE_PH == 18
    { int nrep = PROBE_N; asm volatile("" : "+s"(nrep)); for (int rep = 0; rep < nrep; ++rep) { GB; phase_10(P, lds, 18); GB; } }
#endif
    phase_11(P, lds, 19); GB;
#if defined(PROBE_PH) && PROBE_PH == 19
    { int nrep = PROBE_N; asm volatile("" : "+s"(nrep)); for (int rep = 0; rep < nrep; ++rep) { GB; phase_11(P, lds, 19); GB; } }
#endif
    phase_12(P, lds, 20); GB;
#if defined(PROBE_PH) && PROBE_PH == 20
    { int nrep = PROBE_N; asm volatile("" : "+s"(nrep)); for (int rep = 0; rep < nrep; ++rep) { GB; phase_12(P, lds, 20); GB; } }
#endif
    phase_13(P, lds, 21);
#if defined(PROBE_PH) && PROBE_PH == 21
    { int nrep = PROBE_N; asm volatile("" : "+s"(nrep)); for (int rep = 0; rep < nrep; ++rep) { GB; phase_13(P, lds, 21); GB; } }
#endif
#undef P
#undef GB
}

extern "C" void kernel_launch(void* const* d_in, const int* in_sizes, int n_in, void* d_out, int out_size, void* d_ws, size_t ws_size, hipStream_t stream) {
    static int ready = 0;
    if (!ready) {
        if (n_in != 35 || ws_size < WS_TOTAL) { fprintf(stderr, "kernel_launch: unexpected n_in %d or ws_size %zu (need %zu)\n", n_in, ws_size, (size_t)WS_TOTAL); ready = -1; return; }
        if (hipFuncSetAttribute((const void*)mega, hipFuncAttributeMaxDynamicSharedMemorySize, LDS_BYTES) != hipSuccess) { fprintf(stderr, "kernel_launch: hipFuncSetAttribute failed\n"); ready = -1; return; }
        ready = 1;
    }
    if (ready < 0) return;
    (void)hipMemsetAsync((char*)d_ws + WS_CTL, 0, 1 * MiB, stream);
    Params P{};
    for (int i = 0; i < 35; ++i) P.in[i] = (const float*)d_in[i];
    P.out = (float*)d_out; P.ws = (unsigned char*)d_ws; P.ph_lo = 0; P.ph_hi = 0;
    hipLaunchKernelGGL(mega, dim3(GRID), dim3(512), LDS_BYTES, stream, P);
}
```

```cpp
#include <hip/hip_runtime.h>
#include <stdint.h>
#include <stdio.h>

#define DM 1024
#define NB 2
#define SEQ 8192
#define NMETA 16
#define LSEQ (SEQ + NMETA)
#define NMAIN (NB * SEQ)
#define NT (NB * LSEQ)
#define NTP 16640
#define INCOLS 3328
#define RESTC 1792
#define NEXP 32
#define DFF 512
#define S5TC 48
#define S5NC 171
#define MOE_RT 256
#define MOE_MAXROWS 41216

typedef unsigned short bf16_t;
typedef short bf16x8 __attribute__((ext_vector_type(8)));
typedef float f32x4 __attribute__((ext_vector_type(4)));
typedef unsigned u32x4 __attribute__((ext_vector_type(4)));
typedef unsigned u32x2 __attribute__((ext_vector_type(2)));

constexpr size_t MiB = 1u << 20;
constexpr size_t cmax2(size_t a, size_t b) { return a > b ? a : b; }
constexpr size_t al64k(size_t x) { return (x + 65535) & ~(size_t)65535; }
constexpr size_t WS_CTL = 0;
constexpr size_t WS_H = 1 * MiB;
constexpr size_t WS_HN = WS_H + al64k((size_t)NT * DM * 2);
constexpr size_t WS_A2 = WS_HN + al64k((size_t)NTP * DM * 2);
constexpr size_t WS_WTIN = WS_A2 + al64k((size_t)NTP * DM * 2);
constexpr size_t WS_WTOUT = WS_WTIN + al64k((size_t)INCOLS * DM * 2);
constexpr size_t WS_WTGLU = WS_WTOUT + al64k((size_t)DM * DM * 2);
constexpr size_t WS_LRT = WS_WTGLU + al64k((size_t)2 * DM * DM * 2);
constexpr size_t WS_BIG = WS_LRT + al64k((size_t)(2 * 512 * 64 * 2 + 512 * 128) * 2);
constexpr size_t SZ_T512 = al64k((size_t)NT * 512 * 2);
constexpr size_t SZ_P512 = al64k((size_t)NTP * 512 * 2);
constexpr int RW_NCH = 129, RW_UNITS = 32 * RW_NCH;
constexpr size_t SZ_RWOP = al64k((size_t)RW_UNITS * 4096 * 2);
constexpr size_t WS_Q = WS_BIG;
constexpr size_t WS_K = WS_Q + SZ_P512;
constexpr size_t WS_V = WS_K + SZ_P512;
constexpr size_t WS_REST = WS_V + SZ_P512;
constexpr size_t WS_KR = WS_REST + al64k((size_t)NTP * RESTC * 2);
constexpr size_t WS_LOW = WS_KR + SZ_T512;
constexpr size_t WS_AA = WS_LOW + al64k((size_t)NT * 256 * 2);
constexpr size_t WS_XEARLY = WS_AA + 2 * SZ_T512;
constexpr size_t WS_PP = WS_REST;
constexpr size_t WS_QT = WS_PP + SZ_RWOP;
constexpr size_t WS_YT = WS_QT + SZ_RWOP;
constexpr size_t WS_ZT = WS_YT + SZ_RWOP;
constexpr size_t WS_XEND = cmax2(WS_XEARLY, WS_ZT + SZ_RWOP);
constexpr size_t WS_R = WS_XEND;
constexpr size_t WS_VV = WS_R + SZ_T512;
constexpr size_t WS_G = WS_VV + SZ_T512;
constexpr size_t WS_KK = WS_G + SZ_T512;
constexpr size_t WS_KKA = WS_KK + SZ_T512;
constexpr size_t WS_KD = WS_KKA + 2 * SZ_T512;
constexpr size_t WS_W = WS_KD + 2 * SZ_T512;
constexpr size_t WS_BC = WS_W + 2 * SZ_T512;
constexpr size_t WS_MIXEND = WS_BC + al64k((size_t)NT * 8 * 4);
constexpr size_t WS_YFB = WS_KK;
constexpr size_t WS_ROWTOK = WS_BIG;
constexpr size_t WS_HB = WS_ROWTOK + al64k((size_t)MOE_MAXROWS * 4);
constexpr size_t WS_YB = WS_HB + al64k((size_t)MOE_MAXROWS * DFF * 2);
constexpr size_t WS_WT13 = WS_YB + al64k((size_t)MOE_MAXROWS * DM * 2);
constexpr size_t WS_WT2 = WS_WT13 + al64k((size_t)NEXP * DM * DM * 2);
constexpr size_t WS_EID = WS_WT2 + al64k((size_t)NEXP * DM * DFF * 2);
constexpr size_t WS_POS = WS_EID + al64k((size_t)NT * 8);
constexpr size_t WS_DEST = WS_POS + al64k((size_t)NT * 8);
constexpr size_t WS_GATE = WS_DEST + al64k((size_t)NT * 8);
constexpr size_t WS_WT13B = WS_GATE + al64k((size_t)NT * 8);
constexpr size_t WS_WT2B = WS_WT13B + al64k((size_t)NEXP * DM * DM * 2);
constexpr size_t WS_MOEEND = WS_WT2B + al64k((size_t)NEXP * DM * DFF * 2);
constexpr size_t WS_YI = WS_BIG;
constexpr size_t WS_E = WS_YI + al64k((size_t)NTP * DM * 2);
constexpr size_t WS_CAR = WS_E + al64k((size_t)1040 * 64 * 256 * 2);
constexpr size_t WS_S5END = WS_CAR + al64k((size_t)64 * 1280 * 256 * 2);
constexpr size_t WS_BTA = cmax2(WS_MIXEND, cmax2(WS_MOEEND, WS_S5END));
constexpr size_t WS_BTC = WS_BTA + al64k((size_t)64 * 512 * 256 * 2);
constexpr size_t WS_BTEND = WS_BTC + al64k((size_t)64 * 256 * 256 * 2);
constexpr size_t cmax(size_t a, size_t b) { return a > b ? a : b; }
constexpr size_t WS_TOTAL = WS_BTEND;
static_assert(WS_TOTAL <= 512 * MiB, "workspace map exceeds 512 MiB");

#define CW_CNT(l) (1024 + 64 * (l))
#define CW_WGC 16384

#define LDS_BYTES 163840
#define LDS_BARST (LDS_BYTES - 1024)
#define LDS_TAB (LDS_BYTES - 768)
#define LDS_RING (LDS_BYTES - 1024)
#define GRID 256

struct Params {
    const float* in[35];
    float* out;
    unsigned char* ws;
    int ph_lo, ph_hi;
};
typedef const __attribute__((address_space(4))) Params CParams;

__device__ __forceinline__ float bf2f(bf16_t v) { return __uint_as_float(((unsigned)v) << 16); }
typedef float f32x2c_ __attribute__((ext_vector_type(2)));
typedef __bf16 bf16x2c_ __attribute__((ext_vector_type(2)));
__device__ __forceinline__ unsigned pk2(float lo, float hi) { const f32x2c_ f = {lo, hi}; const bf16x2c_ b = __builtin_convertvector(f, bf16x2c_); return __builtin_bit_cast(unsigned, b); }
__device__ __forceinline__ unsigned f2bf(float f) { return (unsigned)__builtin_bit_cast(unsigned short, (__bf16)f); }
__device__ __forceinline__ float bflo(unsigned u) { return __uint_as_float(u << 16); }
__device__ __forceinline__ float bfhi(unsigned u) { return __uint_as_float(u & 0xffff0000u); }
template <int CTRL> __device__ __forceinline__ float dppf(float v) { return __int_as_float(__builtin_amdgcn_update_dpp(0, __float_as_int(v), CTRL, 0xF, 0xF, true)); }
__device__ __forceinline__ float row16_sum(float v) { v += dppf<0xB1>(v); v += dppf<0x4E>(v); v += dppf<0x141>(v); v += dppf<0x140>(v); return v; }
__device__ __forceinline__ float wave_sum(float v) {
    v = row16_sum(v);
    { const unsigned xu = __float_as_uint(v); const auto sw = __builtin_amdgcn_permlane16_swap(xu, xu, false, false); v = __uint_as_float(sw[0]) + __uint_as_float(sw[1]); }
    { const unsigned xu = __float_as_uint(v); const auto sw = __builtin_amdgcn_permlane32_swap(xu, xu, false, false); v = __uint_as_float(sw[0]) + __uint_as_float(sw[1]); }
    return v;
}
__device__ __forceinline__ float wave_max(float v) {
    v = fmaxf(v, dppf<0xB1>(v)); v = fmaxf(v, dppf<0x4E>(v)); v = fmaxf(v, dppf<0x141>(v)); v = fmaxf(v, dppf<0x140>(v));
    { const unsigned xu = __float_as_uint(v); const auto sw = __builtin_amdgcn_permlane16_swap(xu, xu, false, false); v = fmaxf(__uint_as_float(sw[0]), __uint_as_float(sw[1])); }
    { const unsigned xu = __float_as_uint(v); const auto sw = __builtin_amdgcn_permlane32_swap(xu, xu, false, false); v = fmaxf(__uint_as_float(sw[0]), __uint_as_float(sw[1])); }
    return v;
}
__device__ __forceinline__ float sigmoidf_(float x) { return __builtin_amdgcn_rcpf(1.f + __expf(-x)); }
__device__ __forceinline__ int rowof(int b, int p) { return p < NMETA ? NMAIN + b * NMETA + p : b * SEQ + (p - NMETA); }

#define SA_STRIDE 40
template <class AF, class BF>
__device__ __forceinline__ void gemm_tile(unsigned char* lds, int K, int ldb, const AF& arow, const BF& bcol, f32x4 (&acc)[4][2]) {
    bf16_t* sA = (bf16_t*)lds;
    bf16_t* sB = (bf16_t*)(lds + 128 * SA_STRIDE * 2);
    const int tid = threadIdx.x, lane = tid & 63, wave = tid >> 6, wr = wave >> 2, wc = wave & 3, fr = lane & 15, fq = lane >> 4;
#pragma unroll
    for (int mi = 0; mi < 4; ++mi)
#pragma unroll
        for (int ni = 0; ni < 2; ++ni) acc[mi][ni] = (f32x4){0.f, 0.f, 0.f, 0.f};
    const int ar = tid >> 2, akc = (tid & 3) * 8;
    const bf16_t* ap = arow(ar) + akc;
    const int bnq = (tid & 31) * 4, bkp = (tid >> 5) * 2;
    const float* bp = bcol(bnq) + (size_t)bkp * ldb;
    const int nk = K / 32;
    u32x4 ra = *(const u32x4*)ap;
    f32x4 rb0 = *(const f32x4*)bp, rb1 = *(const f32x4*)(bp + ldb);
    for (int kt = 0; kt < nk; ++kt) {
        __syncthreads();
        *(u32x4*)(sA + ar * SA_STRIDE + akc) = ra;
        {
            unsigned* d = (unsigned*)(sB + bnq * SA_STRIDE + bkp);
            d[0 * (SA_STRIDE / 2)] = pk2(rb0[0], rb1[0]);
            d[1 * (SA_STRIDE / 2)] = pk2(rb0[1], rb1[1]);
            d[2 * (SA_STRIDE / 2)] = pk2(rb0[2], rb1[2]);
            d[3 * (SA_STRIDE / 2)] = pk2(rb0[3], rb1[3]);
        }
        __syncthreads();
        if (kt + 1 < nk) {
            ra = *(const u32x4*)(ap + (kt + 1) * 32);
            const float* q = bp + (size_t)(kt + 1) * 32 * ldb;
            rb0 = *(const f32x4*)q; rb1 = *(const f32x4*)(q + ldb);
        }
        bf16x8 a[4], b[2];
#pragma unroll
        for (int mi = 0; mi < 4; ++mi) a[mi] = *(const bf16x8*)(sA + (wr * 64 + mi * 16 + fr) * SA_STRIDE + fq * 8);
#pragma unroll
        for (int ni = 0; ni < 2; ++ni) b[ni] = *(const bf16x8*)(sB + (wc * 32 + ni * 16 + fr) * SA_STRIDE + fq * 8);
#pragma unroll
        for (int mi = 0; mi < 4; ++mi)
#pragma unroll
            for (int ni = 0; ni < 2; ++ni) acc[mi][ni] = __builtin_amdgcn_mfma_f32_16x16x32_bf16(a[mi], b[ni], acc[mi][ni], 0, 0, 0);
    }
    __syncthreads();
}
#define ACC_FOREACH(acc, ...) do { const int _l = threadIdx.x & 63, _w = threadIdx.x >> 6, _wr = _w >> 2, _wc = _w & 3, _fr = _l & 15, _fq = _l >> 4; \
    _Pragma("unroll") for (int _mi = 0; _mi < 4; ++_mi) _Pragma("unroll") for (int _ni = 0; _ni < 2; ++_ni) _Pragma("unroll") for (int _j = 0; _j < 4; ++_j) { \
        const int rl = _wr * 64 + _mi * 16 + _fq * 4 + _j, cl = _wc * 32 + _ni * 16 + _fr; const float val = acc[_mi][_ni][_j]; __VA_ARGS__ } } while (0)
#define ACC_FOREACH_PAIR(acc, ...) do { const int _l = threadIdx.x & 63, _w = threadIdx.x >> 6, _wr = _w >> 2, _wc = _w & 3, _fr = _l & 15, _fq = _l >> 4; \
    _Pragma("unroll") for (int _mi = 0; _mi < 4; ++_mi) _Pragma("unroll") for (int _j = 0; _j < 4; ++_j) { \
        const int rl = _wr * 64 + _mi * 16 + _fq * 4 + _j, co = _wc * 16 + _fr; const float va = acc[_mi][0][_j], vg = acc[_mi][1][_j]; __VA_ARGS__ } } while (0)

__device__ __forceinline__ void store_norm_bf16(const f32x4 (&v)[4], const float* gain, bf16_t* dst, int lane) {
    float ss = 0.f;
#pragma unroll
    for (int j = 0; j < 4; ++j) ss += v[j][0] * v[j][0] + v[j][1] * v[j][1] + v[j][2] * v[j][2] + v[j][3] * v[j][3];
    ss = wave_sum(ss);
    const float rstd = rsqrtf(ss * (1.f / DM) + 1e-6f);
#pragma unroll
    for (int j = 0; j < 4; ++j) {
        const f32x4 g = ((const f32x4*)gain)[lane + 64 * j];
        u32x2 o; o.x = pk2(v[j][0] * rstd * g[0], v[j][1] * rstd * g[1]); o.y = pk2(v[j][2] * rstd * g[2], v[j][3] * rstd * g[3]);
        ((u32x2*)dst)[lane + 64 * j] = o;
    }
}


__device__ __forceinline__ f32x4 ldrow_bf16(const bf16_t* row, int lane, int j) { const u32x2 u = ((const u32x2*)row)[lane + 64 * j]; return (f32x4){bflo(u.x), bfhi(u.x), bflo(u.y), bfhi(u.y)}; }
__device__ __forceinline__ void strow_bf16(bf16_t* row, int lane, int j, const f32x4 v) { u32x2 o; o.x = pk2(v[0], v[1]); o.y = pk2(v[2], v[3]); ((u32x2*)row)[lane + 64 * j] = o; }
namespace pg8 {
#define PG8_LAS __attribute__((address_space(3)))
constexpr int BM = 256, BK = 64, HALF = 128, HTB = HALF * BK * 2  , STAGE_BYTES = 8 * HTB, NXCD = 8, WGM = 8;
__host__ __device__ __forceinline__ int lds_byte(int r, int c) { const int st = (r >> 4) * 2 + (c >> 5), rr = r & 15, cc = c & 31, ob = rr * 64 + cc * 2; return st * 1024 + (ob ^ (((ob >> 9) & 1) << 5)); }
__host__ __device__ __forceinline__ void stage_rc(int b, int& R, int& C) { const int st = b / 1024, sb = b % 1024, swz = sb ^ (((sb >> 9) & 1) << 5); R = (st >> 1) * 16 + swz / 64; C = (st & 1) * 32 + (swz % 64) / 2; }
__host__ __device__ __forceinline__ int perm32(int rho) { const int n = rho >> 4, i = rho & 15; return 8 * (i >> 2) + 4 * n + (i & 3); }

struct Unit { int pm, pn; const char* A; const char* B; };

struct DenseOrder {
    static constexpr bool GATHER_ROWS = false;
    static constexpr bool GATHER_A = false;
    int nM, nN, nwg, G, c; const char* A; const char* Bt; size_t tstep;
    __device__ void init(const bf16_t* A_, const bf16_t* Bt_, int M, int N, int K, int G_, int c_) { nM = M / BM; nN = N / BM; nwg = nM * nN; G = G_; c = c_; A = (const char*)A_; Bt = (const char*)Bt_; tstep = (size_t)BM * K * 2; }
    __device__ bool next(int i, Unit& u) const {
        const long L = (long)i * G + c; if (L >= nwg) return false;
        int wgid = (int)L; { const int q = nwg / NXCD, r = nwg % NXCD, xcd = wgid % NXCD, off = wgid / NXCD; wgid = (xcd < r ? xcd * (q + 1) : r * (q + 1) + (xcd - r) * q) + off; }
        const int nig = WGM * nN, gid = wgid / nig, fm = gid * WGM, gsz = (nM - fm) < WGM ? (nM - fm) : WGM;
        u.pm = fm + ((wgid % nig) % gsz); u.pn = (wgid % nig) / gsz; u.A = A + (size_t)u.pm * tstep; u.B = Bt + (size_t)u.pn * tstep; return true;
    }
    __device__ __forceinline__ void a_ready(const Unit&) const {}
    __device__ __forceinline__ void done(const Unit&) const {}
};
struct ProjOrder {
    static constexpr bool GATHER_ROWS = false;
    static constexpr bool GATHER_A = false;
    DenseOrder D; const char* HNp; const char* WT;
    __device__ void init(const bf16_t* HN_, const bf16_t* WT_, int c_) { D.init(HN_, WT_, NTP, 13 * BM, DM, GRID, c_); HNp = (const char*)HN_; WT = (const char*)WT_; }
    __device__ bool next(int i, Unit& u) const {
        if (!D.next(i, u)) return false;
        const size_t ts = (size_t)BM * DM * 2;
        if (u.pn < 11) { const int wrow = u.pn < 4 ? u.pn : u.pn + 2; u.A = HNp + (size_t)u.pm * ts; u.B = WT + (size_t)wrow * ts; }
        else { u.A = WT + (size_t)(4 + (u.pn - 11)) * ts; u.B = HNp + (size_t)u.pm * ts; }
        return true;
    }
    __device__ __forceinline__ void a_ready(const Unit&) const {}
    __device__ __forceinline__ void done(const Unit&) const {}
};
template <bool GATHER> struct MoeOrder {
    static constexpr bool GATHER_ROWS = GATHER;
    static constexpr bool GATHER_A = false;
    const int* et; int TT, vcu; const char* A; const char* Bt; unsigned tstepA, tstepB, estep; const int* rowidx; int bid;
    __device__ __forceinline__ bool next(int i, Unit& u) const {
        const int nfull = (TT * 4) & ~(GRID - 1);
        const int L = i * GRID >= nfull ? nfull + bid : i * GRID + vcu; if (i * GRID > nfull || L >= TT * 4) return false;
        const int rt = L >> 2, ct = L & 3, e = et[rt];
        u.pm = rt; u.pn = ct; u.A = GATHER ? A : A + (size_t)rt * tstepA; u.B = Bt + (size_t)e * estep + (size_t)ct * tstepB; return true;
    }
    __device__ __forceinline__ void a_ready(const Unit&) const {}
    __device__ __forceinline__ void done(const Unit&) const {}
};

struct S5OrderA {
    static constexpr bool GATHER_ROWS = false;
    static constexpr bool GATHER_A = true;
    int vcu; const char* U; const char* BTA;
    __device__ __forceinline__ bool next(int i, Unit& u) const {
        const int L = i * GRID + vcu; if (L >= 512) return false;
        const int g = L >> 3, rem = L & 7, mt = rem >> 1, nt = rem & 1;
        u.pm = mt; u.pn = g * 2 + nt; u.A = U + ((size_t)mt * 256 * 16 * 1024 + g * 16) * 2; u.B = BTA + ((size_t)(g * 512 + nt * 256) * 256) * 2; return true;
    }
    __device__ __forceinline__ void a_ready(const Unit&) const {}
    __device__ __forceinline__ void done(const Unit&) const {}
};
struct S5OrderC {
    static constexpr bool GATHER_ROWS = false;
    static constexpr bool GATHER_A = false;
    int vcu; const char* CAR; const char* BTC;
    __device__ __forceinline__ bool next(int i, Unit& u) const {
        const int L = i * GRID + vcu; if (L >= 256) return false;
        const int g = L >> 2, mt = L & 3;
        u.pm = mt; u.pn = g; u.A = CAR + ((size_t)(g * 1280 + mt * 256) * 256) * 2; u.B = BTC + ((size_t)g * 256 * 256) * 2; return true;
    }
    __device__ __forceinline__ void a_ready(const Unit&) const {}
    __device__ __forceinline__ void done(const Unit&) const {}
};
__device__ __forceinline__ unsigned cvt_pk_bf16(float lo, float hi) { return pk2(lo, hi); }

struct EpiProj {
    static constexpr bool PERM = true, AFTER_DRAIN = false;
    bf16_t *Q, *Kk, *VT, *REST;
    __device__ __forceinline__ void operator()(const f32x4 (&acc)[2][2][4][2], const Unit& u, int wr, int wc, int fr, int fq) const {
        bf16_t* base; int ldc; int row0, col0;
        if (u.pn < 11) { row0 = u.pm * BM + wr * 64 + fr; int colt;
            if (u.pn < 2) { base = Q; colt = u.pn * BM; ldc = 512; } else if (u.pn < 4) { base = Kk; colt = (u.pn - 2) * BM; ldc = 512; } else { base = REST; colt = (u.pn - 4) * BM; ldc = RESTC; }
            col0 = colt + wc * 32 + 8 * fq; }
        else { base = VT; ldc = NTP; row0 = (u.pn - 11) * BM + wr * 64 + fr; col0 = u.pm * BM + wc * 32 + 8 * fq; }
#pragma unroll
        for (int ai = 0; ai < 2; ++ai)
#pragma unroll
            for (int m = 0; m < 4; ++m) { bf16_t* rowp = base + (size_t)(row0 + ai * HALF + m * 16) * ldc + col0;
#pragma unroll
                for (int bj = 0; bj < 2; ++bj) { const f32x4 v0 = acc[ai][bj][m][0], v1 = acc[ai][bj][m][1];
                    u32x4 w; w.x = cvt_pk_bf16(v0[0], v0[1]); w.y = cvt_pk_bf16(v0[2], v0[3]); w.z = cvt_pk_bf16(v1[0], v1[1]); w.w = cvt_pk_bf16(v1[2], v1[3]);
                    *(u32x4*)(rowp + bj * HALF) = w; } }
    }
};
struct EpiBf16Plain {
    static constexpr bool PERM = true, AFTER_DRAIN = false;
    bf16_t* O; int ldc;
    __device__ __forceinline__ void operator()(const f32x4 (&acc)[2][2][4][2], const Unit& u, int wr, int wc, int fr, int fq) const {
        const int row0 = u.pm * BM + wr * 64 + fr; const int col0 = u.pn * BM + wc * 32 + 8 * fq;
#pragma unroll
        for (int ai = 0; ai < 2; ++ai)
#pragma unroll
            for (int m = 0; m < 4; ++m) { bf16_t* rowp = O + (size_t)(row0 + ai * HALF + m * 16) * ldc + col0;
#pragma unroll
                for (int bj = 0; bj < 2; ++bj) { const f32x4 v0 = acc[ai][bj][m][0], v1 = acc[ai][bj][m][1];
                    u32x4 w; w.x = cvt_pk_bf16(v0[0], v0[1]); w.y = cvt_pk_bf16(v0[2], v0[3]); w.z = cvt_pk_bf16(v1[0], v1[1]); w.w = cvt_pk_bf16(v1[2], v1[3]);
                    *(u32x4*)(rowp + bj * HALF) = w; } }
    }
};
struct EpiSwiglu {
    static constexpr bool PERM = true, AFTER_DRAIN = false;
    bf16_t* O;
    __device__ __forceinline__ void operator()(const f32x4 (&acc)[2][2][4][2], const Unit& u, int wr, int wc, int fr, int fq) const {
        const int row0 = u.pm * BM + wr * 64 + fr; const int col0 = u.pn * HALF + wc * 32 + 8 * fq;
#pragma unroll
        for (int ai = 0; ai < 2; ++ai)
#pragma unroll
            for (int m = 0; m < 4; ++m) {
                float o[8];
#pragma unroll
                for (int n = 0; n < 2; ++n)
#pragma unroll
                    for (int i = 0; i < 4; ++i) { const float va = acc[ai][0][m][n][i], vg = acc[ai][1][m][n][i]; o[4 * n + i] = va * __builtin_amdgcn_rcpf(1.f + __expf(-va)) * vg; }
                u32x4 w; w.x = cvt_pk_bf16(o[0], o[1]); w.y = cvt_pk_bf16(o[2], o[3]); w.z = cvt_pk_bf16(o[4], o[5]); w.w = cvt_pk_bf16(o[6], o[7]);
                *(u32x4*)(O + (size_t)(row0 + ai * HALF + m * 16) * DFF + col0) = w; }
    }
};
struct EpiResidual {
    static constexpr bool PERM = true, AFTER_DRAIN = false;
    bf16_t* Hh;
    __device__ __forceinline__ void operator()(const f32x4 (&acc)[2][2][4][2], const Unit& u, int wr, int wc, int fr, int fq) const {
        const int row0 = u.pm * BM + wr * 64 + fr; const int col0 = u.pn * BM + wc * 32 + 8 * fq;
#pragma unroll
        for (int ai = 0; ai < 2; ++ai)
#pragma unroll
            for (int m = 0; m < 4; ++m) { bf16_t* rowp = Hh + (size_t)(row0 + ai * HALF + m * 16) * DM + col0;
#pragma unroll
                for (int bj = 0; bj < 2; ++bj) { u32x4* p = (u32x4*)(rowp + bj * HALF); const u32x4 hv = *p; const f32x4 v0 = acc[ai][bj][m][0], v1 = acc[ai][bj][m][1];
                    u32x4 w; w.x = cvt_pk_bf16(__uint_as_float(hv.x << 16) + v0[0], __uint_as_float(hv.x & 0xffff0000u) + v0[1]); w.y = cvt_pk_bf16(__uint_as_float(hv.y << 16) + v0[2], __uint_as_float(hv.y & 0xffff0000u) + v0[3]);
                    w.z = cvt_pk_bf16(__uint_as_float(hv.z << 16) + v1[0], __uint_as_float(hv.z & 0xffff0000u) + v1[1]); w.w = cvt_pk_bf16(__uint_as_float(hv.w << 16) + v1[2], __uint_as_float(hv.w & 0xffff0000u) + v1[3]);
                    *p = w; } }
    }
};
struct EpiGlu {
    static constexpr bool PERM = true, AFTER_DRAIN = false;
    bf16_t* Hh;
    __device__ __forceinline__ void operator()(const f32x4 (&acc)[2][2][4][2], const Unit& u, int wr, int wc, int fr, int fq) const {
        const int row0 = u.pm * BM + wr * 64 + fr; const int col0 = u.pn * HALF + wc * 32 + 8 * fq;
#pragma unroll
        for (int ai = 0; ai < 2; ++ai)
#pragma unroll
            for (int m = 0; m < 4; ++m) { u32x4* p = (u32x4*)(Hh + (size_t)(row0 + ai * HALF + m * 16) * DM + col0); const u32x4 hv = *p;
                float o[8];
#pragma unroll
                for (int n = 0; n < 2; ++n)
#pragma unroll
                    for (int i = 0; i < 4; ++i) { const unsigned hw = hv[2 * n + (i >> 1)]; const float hcur = (i & 1) ? __uint_as_float(hw & 0xffff0000u) : __uint_as_float(hw << 16);
                        o[4 * n + i] = hcur + acc[ai][0][m][n][i] * __builtin_amdgcn_rcpf(1.f + __expf(-acc[ai][1][m][n][i])); }
                u32x4 w; w.x = cvt_pk_bf16(o[0], o[1]); w.y = cvt_pk_bf16(o[2], o[3]); w.z = cvt_pk_bf16(o[4], o[5]); w.w = cvt_pk_bf16(o[6], o[7]);
                *p = w; }
    }
};
struct EpiS5A {
    static constexpr bool PERM = true, AFTER_DRAIN = false;
    bf16_t* YI; bf16_t* E;
    __device__ __forceinline__ void operator()(const f32x4 (&acc)[2][2][4][2], const Unit& u, int wr, int wc, int fr, int fq) const {
        const int g = u.pn >> 1, nt = u.pn & 1;
        const int cl0 = wc * 32 + 8 * fq;
        bf16_t* base = nt == 0 ? YI + (size_t)(cl0 >> 4) * DM + g * 16 + (cl0 & 15) : E + (size_t)g * 256 + cl0;
        const size_t nstride = 16 * DM;
        const size_t bjstep = nt == 0 ? (size_t)8 * DM : (size_t)HALF;
#pragma unroll
        for (int ai = 0; ai < 2; ++ai)
#pragma unroll
            for (int m = 0; m < 4; ++m) { int n = u.pm * BM + ai * HALF + wr * 64 + m * 16 + fr; n = n < 1039 ? n : 1039;
                bf16_t* p = base + (size_t)n * nstride;
#pragma unroll
                for (int bj = 0; bj < 2; ++bj) { const f32x4 v0 = acc[ai][bj][m][0], v1 = acc[ai][bj][m][1];
                    u32x4 w; w.x = cvt_pk_bf16(v0[0], v0[1]); w.y = cvt_pk_bf16(v0[2], v0[3]); w.z = cvt_pk_bf16(v1[0], v1[1]); w.w = cvt_pk_bf16(v1[2], v1[3]);
                    *(u32x4*)(p + bj * bjstep) = w; } }
    }
};
struct EpiS5C {
    static constexpr bool PERM = true, AFTER_DRAIN = false;
    const bf16_t* YI; const bf16_t* Uu; const float* dvec; bf16_t* O;
    __device__ __forceinline__ void operator()(const f32x4 (&acc)[2][2][4][2], const Unit& u, int wr, int wc, int fr, int fq) const {
        const int g = u.pn;
        const int cl0 = wc * 32 + 8 * fq, ch = g * 16 + (cl0 & 15);
        const size_t off0 = (size_t)(cl0 >> 4) * DM + ch;
        const f32x4 d0 = *(const f32x4*)(dvec + ch), d1 = *(const f32x4*)(dvec + ch + 4);
        u32x4 yq[8][2], uq[8][2];
#define S5C_OFF(rg_, bj_) ({ int n_ = u.pm * BM + ((rg_) >> 2) * HALF + wr * 64 + ((rg_) & 3) * 16 + fr; n_ = n_ < 1039 ? n_ : 1039; off0 + (size_t)n_ * (16 * DM) + (size_t)(bj_) * (8 * DM); })
#define S5C_LOAD(rg_) do { _Pragma("unroll") for (int bj_ = 0; bj_ < 2; ++bj_) { const size_t o_ = S5C_OFF(rg_, bj_); yq[rg_][bj_] = *(const u32x4*)(YI + o_); uq[rg_][bj_] = *(const u32x4*)(Uu + o_); } } while (0)
        S5C_LOAD(0); S5C_LOAD(1); S5C_LOAD(2);
#pragma unroll
        for (int rg = 0; rg < 8; ++rg) {
            if (rg + 3 < 8) S5C_LOAD(rg + 3);
            const int ai = rg >> 2, m = rg & 3;
#pragma unroll
            for (int bj = 0; bj < 2; ++bj) {
                const u32x4 yv = yq[rg][bj], uv = uq[rg][bj];
                const f32x4 y0 = (f32x4){__uint_as_float(yv[0] << 16), __uint_as_float(yv[0] & 0xffff0000u), __uint_as_float(yv[1] << 16), __uint_as_float(yv[1] & 0xffff0000u)},
                            y1 = (f32x4){__uint_as_float(yv[2] << 16), __uint_as_float(yv[2] & 0xffff0000u), __uint_as_float(yv[3] << 16), __uint_as_float(yv[3] & 0xffff0000u)};
                float y[8];
#pragma unroll
                for (int q = 0; q < 4; ++q) { y[q] = acc[ai][bj][m][0][q] + y0[q] + d0[q] * (q & 1 ? __uint_as_float(uv[q >> 1] & 0xffff0000u) : __uint_as_float(uv[q >> 1] << 16));
                    y[4 + q] = acc[ai][bj][m][1][q] + y1[q] + d1[q] * (q & 1 ? __uint_as_float(uv[2 + (q >> 1)] & 0xffff0000u) : __uint_as_float(uv[2 + (q >> 1)] << 16)); }
#pragma unroll
                for (int q = 0; q < 8; ++q) { const float z = 1.5957691216f * (y[q] + 0.044715f * y[q] * y[q] * y[q]); y[q] = y[q] * __builtin_amdgcn_rcpf(1.f + __expf(-z)); }
                u32x4 w; w.x = cvt_pk_bf16(y[0], y[1]); w.y = cvt_pk_bf16(y[2], y[3]); w.z = cvt_pk_bf16(y[4], y[5]); w.w = cvt_pk_bf16(y[6], y[7]);
                *(u32x4*)(O + S5C_OFF(rg, bj)) = w; }
            asm volatile("" ::: "memory"); }
#undef S5C_LOAD
#undef S5C_OFF
    }
};

template <class Epi, class Sched, bool ALIGN_EPI = false, bool SP2 = false>
__device__ __forceinline__ void gemm_phase(PG8_LAS unsigned char* lds, const int K, const Sched& S, const Epi& E) {
    int tid_ = threadIdx.x; asm volatile("" : "+v"(tid_));
    const int tid = tid_, wid = __builtin_amdgcn_readfirstlane(tid >> 6), lane = tid & 63, wr = wid >> 2, wc = wid & 3, fr = lane & 15, fq = lane >> 4;
    const int nt = K / BK;
    unsigned vA0[2], vA1[2], nA0[2], nA1[2], voffB[2];
#pragma unroll
    for (int i = 0; i < 2; ++i) { int R, C; stage_rc(tid * 16 + i * 8192, R, C); const int Rb = Epi::PERM ? ((R & ~31) + perm32(R & 31)) : R;
        vA0[i] = Sched::GATHER_A ? (unsigned)(((16 * R + (C >> 4)) * 1024 + (C & 15)) * 2) : (unsigned)(R * K + C) * 2u; voffB[i] = (unsigned)(Rb * K + C) * 2u; }
    const size_t kstep = (size_t)(BK * 2);
    const size_t hstep = (size_t)HALF * K * 2;
    const size_t kstepA = Sched::GATHER_A ? (size_t)(4 * 1024 * 2) : kstep, hstepA = Sched::GATHER_A ? (size_t)HALF * 16 * 1024 * 2 : hstep;
#define PG8_ROWOFFS(u_, d0_, d1_) do { _Pragma("unroll") for (int i_ = 0; i_ < 2; ++i_) { int R_, C_; stage_rc(tid * 16 + i_ * 8192, R_, C_); \
        d0_[i_] = (unsigned)(S.rowidx[(u_).pm * BM + R_] * K + C_) * 2u; d1_[i_] = (unsigned)(S.rowidx[(u_).pm * BM + HALF + R_] * K + C_) * 2u; } } while (0)
#define PG8_STAGE_A(bufoff, gbase, h_, nx_) do { _Pragma("unroll") for (int _i = 0; _i < 2; ++_i) { const unsigned vo_ = (nx_) ? ((h_) ? nA1[_i] : nA0[_i]) : ((h_) ? vA1[_i] : vA0[_i]); \
        __builtin_amdgcn_global_load_lds((const unsigned*)((const char*)(gbase) + vo_), (PG8_LAS unsigned*)(lds + (bufoff) + ldsw + _i * 8192), 16, 0, 0); } } while (0)
    const unsigned ldsw = (unsigned)wid * 1024u;
    const int aoff = lds_byte(wr * 64 + fr, fq * 8), boff = lds_byte(wc * 32 + fr, fq * 8);
#define PG8_SA(b, h) (((b) * 2 + (h)) * HTB)
#define PG8_SB(b, h) ((4 + (b) * 2 + (h)) * HTB)
#define PG8_STAGE(bufoff, gbase, voff) do { _Pragma("unroll") for (int _i = 0; _i < 2; ++_i) \
        __builtin_amdgcn_global_load_lds((const unsigned*)((const char*)(gbase) + (voff)[_i]), (PG8_LAS unsigned*)(lds + (bufoff) + ldsw + _i * 8192), 16, 0, 0); } while (0)
#define PG8_LDA(dst, b, h) do { _Pragma("unroll") for (int m = 0; m < 4; ++m) _Pragma("unroll") for (int k = 0; k < 2; ++k) dst[m][k] = *(const PG8_LAS bf16x8*)(lds + PG8_SA(b, h) + aoff + m * 2048 + k * 1024); } while (0)
#define PG8_LDB(dst, b, h) do { _Pragma("unroll") for (int n = 0; n < 2; ++n) _Pragma("unroll") for (int k = 0; k < 2; ++k) dst[n][k] = *(const PG8_LAS bf16x8*)(lds + PG8_SB(b, h) + boff + n * 2048 + k * 1024); } while (0)
#define PG8_MMA(ai, bj, At, Bt) do { __builtin_amdgcn_s_setprio(1); _Pragma("unroll") for (int m = 0; m < 4; ++m) _Pragma("unroll") for (int n = 0; n < 2; ++n) _Pragma("unroll") for (int k = 0; k < 2; ++k) \
        acc[ai][bj][m][n] = __builtin_amdgcn_mfma_f32_16x16x32_bf16(Bt[n][k], At[m][k], acc[ai][bj][m][n], 0, 0, 0); __builtin_amdgcn_s_setprio(0); } while (0)
#define PG8_WAIT_V(n) asm volatile("s_waitcnt vmcnt(" #n ")" ::: "memory")
#define PG8_WAIT_L(n) asm volatile("s_waitcnt lgkmcnt(" #n ")" ::: "memory")
#define PG8_BAR __builtin_amdgcn_s_barrier()
#define PG8_SCHED __builtin_amdgcn_sched_barrier(0)
    Unit cur, nxt; int ui = 0;
    if (!S.next(0, cur)) return;
    f32x4 acc[2][2][4][2];
#pragma unroll
    for (int a = 0; a < 2; ++a)
#pragma unroll
        for (int b = 0; b < 2; ++b)
#pragma unroll
            for (int m = 0; m < 4; ++m)
#pragma unroll
                for (int n = 0; n < 2; ++n) acc[a][b][m][n] = (f32x4){0.f, 0.f, 0.f, 0.f};
    bf16x8 At[4][2], B0[2][2], B1[2][2];
    const char* cA = cur.A; const char* cB = cur.B;
    if constexpr (Sched::GATHER_ROWS) { PG8_ROWOFFS(cur, vA0, vA1); }
    else {
#pragma unroll
        for (int i = 0; i < 2; ++i) vA1[i] = vA0[i] + (unsigned)hstepA;
    }
#pragma unroll
    for (int i = 0; i < 2; ++i) { nA0[i] = vA0[i]; nA1[i] = vA1[i]; }
    S.a_ready(cur);
    if constexpr (SP2) {
        PG8_STAGE(PG8_SB(0, 0), cB, voffB); PG8_STAGE(PG8_SB(0, 1), cB + hstep, voffB); PG8_STAGE_A(PG8_SA(0, 0), cA, 0, false); PG8_STAGE_A(PG8_SA(0, 1), cA, 1, false);
        if (wr == 1) PG8_BAR;
        PG8_WAIT_V(2); PG8_BAR;
        PG8_STAGE(PG8_SB(1, 0), cB + kstep, voffB); PG8_STAGE_A(PG8_SA(1, 0), cA + kstepA, 0, false); PG8_STAGE(PG8_SB(1, 1), cB + hstep + kstep, voffB);
        PG8_WAIT_V(6); PG8_BAR;
    } else {
        PG8_STAGE(PG8_SB(0, 0), cB, voffB); PG8_STAGE_A(PG8_SA(0, 0), cA, 0, false); PG8_STAGE(PG8_SB(0, 1), cB + hstep, voffB); PG8_STAGE_A(PG8_SA(0, 1), cA, 1, false);
        if (wr == 1) PG8_BAR;
        PG8_WAIT_V(4); PG8_BAR;
        PG8_STAGE(PG8_SB(1, 0), cB + kstep, voffB); PG8_STAGE_A(PG8_SA(1, 0), cA + kstepA, 0, false); PG8_STAGE(PG8_SB(1, 1), cB + hstep + kstep, voffB);
        PG8_WAIT_V(6); PG8_BAR;
    }
    for (;;) {
        const bool has_next = S.next(ui + 1, nxt);
        if constexpr (Sched::GATHER_ROWS) { if (has_next) PG8_ROWOFFS(nxt, nA0, nA1); }
        const char* nA = has_next ? nxt.A : cA; const char* nB = has_next ? nxt.B : cB;
        for (int t = 0; t < nt; t += 2) {
            const bool last = (t == nt - 2);
            const char* a1 = cA + (size_t)(t + 1) * kstepA;
            const char* a2 = last ? nA : cA + (size_t)(t + 2) * kstepA; const char* b2 = last ? nB : cB + (size_t)(t + 2) * kstep;
            const char* a3 = a2 + kstepA; const char* b3 = b2 + kstep;
            if (last && has_next) S.a_ready(nxt);
            if constexpr (SP2) {
            PG8_LDB(B0, 0, 0); PG8_LDB(B1, 0, 1); PG8_SCHED; PG8_LDA(At, 0, 0); PG8_STAGE_A(PG8_SA(1, 1), a1, 1, false);
            PG8_WAIT_V(8); PG8_WAIT_L(0); PG8_BAR; PG8_MMA(0, 0, At, B0); PG8_MMA(0, 1, At, B1); PG8_BAR; PG8_SCHED;
            PG8_LDA(At, 0, 1); PG8_STAGE(PG8_SB(0, 0), b2, voffB); PG8_STAGE(PG8_SB(0, 1), b2 + hstep, voffB); PG8_STAGE_A(PG8_SA(0, 0), a2, 0, last);
            PG8_WAIT_V(8); PG8_WAIT_L(0); PG8_BAR; PG8_MMA(1, 0, At, B0); PG8_MMA(1, 1, At, B1); PG8_BAR; PG8_SCHED;
            PG8_LDB(B0, 1, 0); PG8_LDB(B1, 1, 1); PG8_SCHED; PG8_LDA(At, 1, 0); PG8_STAGE_A(PG8_SA(0, 1), a2, 1, last);
            PG8_WAIT_V(8); PG8_WAIT_L(0); PG8_BAR; PG8_MMA(0, 0, At, B0); PG8_MMA(0, 1, At, B1); PG8_BAR; PG8_SCHED;
            PG8_LDA(At, 1, 1); PG8_STAGE(PG8_SB(1, 0), b3, voffB); PG8_STAGE(PG8_SB(1, 1), b3 + hstep, voffB); PG8_STAGE_A(PG8_SA(1, 0), a3, 0, last);
            PG8_WAIT_V(8); PG8_WAIT_L(0); PG8_BAR; PG8_MMA(1, 0, At, B0); PG8_MMA(1, 1, At, B1); PG8_BAR; PG8_SCHED;
            } else {
            PG8_LDB(B0, 0, 0); PG8_SCHED; PG8_LDA(At, 0, 0); PG8_STAGE_A(PG8_SA(1, 1), a1, 1, false);
            PG8_WAIT_L(8); PG8_BAR; PG8_WAIT_L(0); PG8_MMA(0, 0, At, B0); PG8_BAR; PG8_SCHED;
            PG8_LDB(B1, 0, 1); PG8_STAGE(PG8_SB(0, 0), b2, voffB);
            PG8_BAR; PG8_WAIT_L(0); PG8_MMA(0, 1, At, B1); PG8_BAR;
            PG8_LDA(At, 0, 1); PG8_STAGE_A(PG8_SA(0, 0), a2, 0, last);
            PG8_BAR; PG8_WAIT_L(0); PG8_MMA(1, 0, At, B0); PG8_BAR; PG8_SCHED;
            PG8_STAGE(PG8_SB(0, 1), b2 + hstep, voffB);
            PG8_WAIT_V(6); PG8_BAR; PG8_MMA(1, 1, At, B1); PG8_BAR;
            PG8_LDB(B0, 1, 0); PG8_SCHED; PG8_LDA(At, 1, 0); PG8_STAGE_A(PG8_SA(0, 1), a2, 1, last);
            PG8_WAIT_L(8); PG8_BAR; PG8_WAIT_L(0); PG8_MMA(0, 0, At, B0); PG8_BAR; PG8_SCHED;
            PG8_LDB(B1, 1, 1); PG8_STAGE(PG8_SB(1, 0), b3, voffB);
            PG8_BAR; PG8_WAIT_L(0); PG8_MMA(0, 1, At, B1); PG8_BAR;
            PG8_LDA(At, 1, 1); PG8_STAGE_A(PG8_SA(1, 0), a3, 0, last);
            PG8_BAR; PG8_WAIT_L(0); PG8_MMA(1, 0, At, B0); PG8_BAR; PG8_SCHED;
            PG8_STAGE(PG8_SB(1, 1), b3 + hstep, voffB);
            PG8_WAIT_V(6); PG8_BAR; PG8_MMA(1, 1, At, B1); PG8_BAR;
            }
        }
        if constexpr (ALIGN_EPI) { if (wr == 0) PG8_BAR; }
        if constexpr (!Epi::AFTER_DRAIN) { E(acc, cur, wr, wc, fr, fq); S.done(cur); }
        if (!has_next) break;
#pragma unroll
        for (int a = 0; a < 2; ++a)
#pragma unroll
            for (int b = 0; b < 2; ++b)
#pragma unroll
                for (int m = 0; m < 4; ++m)
#pragma unroll
                    for (int n = 0; n < 2; ++n) acc[a][b][m][n] = (f32x4){0.f, 0.f, 0.f, 0.f};
        cur = nxt; cA = nA; cB = nB; ++ui;
        if constexpr (Sched::GATHER_ROWS) {
#pragma unroll
            for (int i = 0; i < 2; ++i) { vA0[i] = nA0[i]; vA1[i] = nA1[i]; } }
        if constexpr (ALIGN_EPI) { if (wr == 1) PG8_BAR; }
    }
    PG8_WAIT_V(0);
    if constexpr (!ALIGN_EPI) { if (wr == 0) PG8_BAR; }
    PG8_BAR;
    if constexpr (Epi::AFTER_DRAIN) { E.fused(acc, cur, wr, wc, fr, fq, lds, wid, lane); S.done(cur); }
#undef PG8_SA
#undef PG8_SB
#undef PG8_STAGE
#undef PG8_STAGE_A
#undef PG8_ROWOFFS
#undef PG8_LDA
#undef PG8_LDB
#undef PG8_MMA
#undef PG8_WAIT_V
#undef PG8_WAIT_L
#undef PG8_BAR
#undef PG8_SCHED
}
}

#define PHASE_PROLOGUE \
    int tid_ = threadIdx.x; asm volatile("" : "+v"(tid_)); const int tid = tid_, lane = tid & 63, wave = tid >> 6; \
    const int G = GRID, bid = blockIdx.x; \
    const int gw = bid * 8 + wave, NGW = G * 8; \
    unsigned char* ws = P.ws; \
    bf16_t* H = (bf16_t*)(ws + WS_H); \
    bf16_t* HN = (bf16_t*)(ws + WS_HN); \
    bf16_t* A2 = (bf16_t*)(ws + WS_A2); \
    bf16_t* Qb = (bf16_t*)(ws + WS_Q); bf16_t* Kb = (bf16_t*)(ws + WS_K); bf16_t* Vb = (bf16_t*)(ws + WS_V); \
    bf16_t* REST = (bf16_t*)(ws + WS_REST); \
    bf16_t* YFB = (bf16_t*)(ws + WS_YFB); \
    bf16_t* Rr = (bf16_t*)(ws + WS_R); bf16_t* VV = (bf16_t*)(ws + WS_VV); bf16_t* KK = (bf16_t*)(ws + WS_KK); \
    bf16_t* KKA = (bf16_t*)(ws + WS_KKA); bf16_t* KD = (bf16_t*)(ws + WS_KD); \
    _Float16* LW = (_Float16*)(ws + WS_W); bf16_t* PP = (bf16_t*)(ws + WS_PP); bf16_t* QT = (bf16_t*)(ws + WS_QT); bf16_t* YT = (bf16_t*)(ws + WS_YT); bf16_t* ZT = (bf16_t*)(ws + WS_ZT); \
    bf16_t* Gg = (bf16_t*)(ws + WS_G); bf16_t* KR = (bf16_t*)(ws + WS_KR); bf16_t* LOW = (bf16_t*)(ws + WS_LOW); \
    float* BC = (float*)(ws + WS_BC); \
    bf16_t* AA = (bf16_t*)(ws + WS_AA); \
    bf16_t* HB = (bf16_t*)(ws + WS_HB); bf16_t* YB = (bf16_t*)(ws + WS_YB); \
    int* ROWTOK = (int*)(ws + WS_ROWTOK); int* EID = (int*)(ws + WS_EID); int* POS = (int*)(ws + WS_POS); int* DEST = (int*)(ws + WS_DEST); \
    float* GATE = (float*)(ws + WS_GATE); \
    bf16_t* YI = (bf16_t*)(ws + WS_YI); bf16_t* S5E = (bf16_t*)(ws + WS_E); bf16_t* CAR = (bf16_t*)(ws + WS_CAR); bf16_t* BTA = (bf16_t*)(ws + WS_BTA); bf16_t* BTC = (bf16_t*)(ws + WS_BTC); \
    unsigned* CTL = (unsigned*)(ws + WS_CTL); \
    bf16_t* WTIN = (bf16_t*)(ws + WS_WTIN); bf16_t* WTOUT = (bf16_t*)(ws + WS_WTOUT); bf16_t* WTGLU = (bf16_t*)(ws + WS_WTGLU); bf16_t* WT13 = (bf16_t*)(ws + WS_WT13); bf16_t* WT2 = (bf16_t*)(ws + WS_WT2); \
    const int vcu = (G % 8 == 0) ? (bid % 8) * (G / 8) + bid / 8 : bid; \
    const float* x = P.in[0]; const float* meta = P.in[1]; const float* norm_mix = P.in[2]; const float* norm_ffn = P.in[3]; const float* norm_final = P.in[4]; \
    const float* w_in = P.in[5]; const float* w_out = P.in[6]; const float* rpb = P.in[7]; const float* mu = P.in[8]; \
    const float* w0 = P.in[9]; const float* w_up = P.in[10]; const float* a0 = P.in[11]; const float* a_up = P.in[12]; const float* g_up = P.in[13]; \
    const float* k_k = P.in[14]; const float* k_a = P.in[15]; const float* r_k = P.in[16]; const float* lnx_g = P.in[17]; const float* lnx_b = P.in[18]; \
    const float* s5_b_re = P.in[19]; const float* s5_b_im = P.in[20]; const float* s5_lre = P.in[21]; const float* s5_lim = P.in[22]; const float* s5_ls = P.in[23]; \
    const float* s5_c_re = P.in[24]; const float* s5_c_im = P.in[25]; const float* s5_d = P.in[26]; const float* w_glu = P.in[27]; \
    const float* moe_wg = P.in[28]; const float* moe_bg = P.in[29]; const float* moe_we = P.in[30]; const float* moe_be = P.in[31]; \
    const float* moe_w1 = P.in[32]; const float* moe_w3 = P.in[33]; const float* moe_w2 = P.in[34];


__device__ __forceinline__ void transpose_half(const float* W, int N, int K, int k0, int n0, bf16_t* dstrow0, int lane) {
    const int kb = lane & 7, nq = lane >> 3;
    const float* src = W + (size_t)(k0 + 8 * kb) * N + n0 + 4 * nq;
    f32x4 v[8];
#pragma unroll
    for (int kk = 0; kk < 8; ++kk) v[kk] = *(const f32x4*)(src + (size_t)kk * N);
#pragma unroll
    for (int i = 0; i < 4; ++i) {
        u32x4 o; o.x = pk2(v[0][i], v[1][i]); o.y = pk2(v[2][i], v[3][i]); o.z = pk2(v[4][i], v[5][i]); o.w = pk2(v[6][i], v[7][i]);
        *(u32x4*)(dstrow0 + (size_t)(4 * nq + i) * K + k0 + 8 * kb) = o;
    }
}
template <int PM = 0>
__device__ __forceinline__ void transpose_item(const float* W, int N, int K, int k0, int n0, bf16_t* dstrow0, int lane) {
    const int kb = lane & 7, nq = lane >> 3;
    const float* src = PM == 2 ? W + (size_t)(8 * kb) * N + 4 * nq : W + (size_t)(k0 + 8 * kb) * N + n0 + 4 * nq;
    f32x4 v[8], w[8];
#pragma unroll
    for (int kk = 0; kk < 8; ++kk) { v[kk] = __builtin_nontemporal_load((const f32x4*)(src + (size_t)kk * N)); w[kk] = __builtin_nontemporal_load((const f32x4*)(src + (size_t)kk * N + 32)); }
    bf16_t* d = dstrow0 + (size_t)(4 * nq) * K + k0 + 8 * kb;
    if (PM == 1) { float t_ = 0.f;
#pragma unroll
        for (int kk = 0; kk < 8; ++kk) t_ += v[kk][0] + v[kk][3] + w[kk][1] + w[kk][2];
        if (t_ != 1.2345e-30f) return; }
#pragma unroll
    for (int i = 0; i < 4; ++i) {
        u32x4 o; o.x = pk2(v[0][i], v[1][i]); o.y = pk2(v[2][i], v[3][i]); o.z = pk2(v[4][i], v[5][i]); o.w = pk2(v[6][i], v[7][i]);
        *(u32x4*)(d + (size_t)i * K) = o;
    }
#pragma unroll
    for (int i = 0; i < 4; ++i) {
        u32x4 o; o.x = pk2(w[0][i], w[1][i]); o.y = pk2(w[2][i], w[3][i]); o.z = pk2(w[4][i], w[5][i]); o.w = pk2(w[6][i], w[7][i]);
        *(u32x4*)(d + (size_t)(32 + i) * K) = o;
    }
}
#define CONV_DENSE_ITEMS (832 + 256 + 512 + 48)
__device__ __forceinline__ void conv_dense_item(CParams& P, int it, int lane) {
    unsigned char* ws = P.ws;
    if (it < 832) { const int kb = it / 52, nb = it % 52; transpose_item(P.in[5], INCOLS, DM, kb * 64, nb * 64, (bf16_t*)(ws + WS_WTIN) + (size_t)nb * 64 * DM, lane); return; }
    it -= 832;
    if (it < 256) { const int kb = it / 16, nb = it % 16; transpose_item(P.in[6], DM, DM, kb * 64, nb * 64, (bf16_t*)(ws + WS_WTOUT) + (size_t)nb * 64 * DM, lane); return; }
    it -= 256;
    if (it < 512) { const int kb = it / 32, nb = it % 32, n = nb * 64, half = n >> 10, c = n & 1023, row = (c >> 7) * 256 + half * 128 + (c & 127);
      transpose_item(P.in[27], 2 * DM, DM, kb * 64, n, (bf16_t*)(ws + WS_WTGLU) + (size_t)row * DM, lane); return; }
    it -= 512;
    bf16_t* lrt = (bf16_t*)(ws + WS_LRT);
    if (it < 16) { const int d = it >> 3, nb = it & 7; transpose_item(P.in[10] + (size_t)d * 64 * 512, 512, 64, 0, nb * 64, lrt + ((size_t)d * 512 + nb * 64) * 64, lane); return; }
    it -= 16;
    if (it < 16) { const int d = it >> 3, nb = it & 7; transpose_item(P.in[12] + (size_t)d * 64 * 512, 512, 64, 0, nb * 64, lrt + (size_t)2 * 512 * 64 + ((size_t)d * 512 + nb * 64) * 64, lane); return; }
    it -= 16;
    { const int kb = it >> 3, nb = it & 7; transpose_item(P.in[13], 512, 128, kb * 64, nb * 64, lrt + (size_t)4 * 512 * 64 + (size_t)nb * 64 * 128, lane); }
}
#define CONV_MOE_ITEMS (NEXP * 384)
template <int PM = 0>
__device__ __forceinline__ void conv_moe_item(CParams& P, int l, int it, int lane) {
    unsigned char* ws = P.ws;
    const int e = it / 384; int r = it % 384;
    if (r < 256) { const int which = r >> 7; r &= 127; const int kb = r >> 3, nb = r & 7, n = nb * 64, row = (n >> 7) * 256 + which * 128 + (n & 127);
        const float* W = (which ? P.in[33] : P.in[32]) + ((size_t)(l * NEXP + e) * DM) * DFF;
        transpose_item<PM>(W, DFF, DM, kb * 64, n, (bf16_t*)(ws + (l ? WS_WT13B : WS_WT13)) + ((size_t)e * DM + row) * DM, lane); return; }
    r -= 256;
    { const int kb = r >> 4, nb = r & 15; const float* W = P.in[34] + ((size_t)(l * NEXP + e) * DFF) * DM;
      transpose_item<PM>(W, DM, DFF, kb * 64, nb * 64, (bf16_t*)(ws + (l ? WS_WT2B : WS_WT2)) + ((size_t)e * DM + nb * 64) * DFF, lane); }
}
#ifndef FILL_Q11
#define FILL_Q11 2
#define FILL_Q12 2
#define FILL_Q15 0
#define FILL_Q22 0
#endif
#define FILL_N22 (192 * 8 * FILL_Q22)
#define FILL_A (FILL_N22 + 128 * 8 * FILL_Q15)
__device__ __forceinline__ void conv_range(CParams& P, int first, int n, int lane) {
    for (int q = 0; q < n; ++q) { const int it = first + q; if (it < CONV_MOE_ITEMS) conv_moe_item(P, 1, it, lane); }
}

template <int MODE>
__device__ __forceinline__ void meta_gemm(const bf16_t* A, const bf16_t* Bt, bf16_t* Hrows, int task, int wave, int lane, unsigned char* lds) {
    const int fr = lane & 15, fq = lane >> 4, c = task * 16 + fr;
    const bf16_t* b0 = MODE == 0 ? Bt + (size_t)c * DM : Bt + (size_t)((c >> 7) * 256 + (c & 127)) * DM;
    const bf16_t* b1 = b0 + (size_t)128 * DM;
    f32x4 acc0[2], acc1[2];
    acc0[0] = acc0[1] = acc1[0] = acc1[1] = (f32x4){0.f, 0.f, 0.f, 0.f};
#pragma unroll
    for (int kt = 0; kt < 4; ++kt) {
        const int ko = wave * 128 + kt * 32 + fq * 8;
        const bf16x8 a0 = *(const bf16x8*)(A + (size_t)fr * DM + ko), a1 = *(const bf16x8*)(A + (size_t)(16 + fr) * DM + ko);
        const bf16x8 bv = *(const bf16x8*)(b0 + ko);
        acc0[0] = __builtin_amdgcn_mfma_f32_16x16x32_bf16(a0, bv, acc0[0], 0, 0, 0);
        acc0[1] = __builtin_amdgcn_mfma_f32_16x16x32_bf16(a1, bv, acc0[1], 0, 0, 0);
        if (MODE == 1) { const bf16x8 bg = *(const bf16x8*)(b1 + ko);
            acc1[0] = __builtin_amdgcn_mfma_f32_16x16x32_bf16(a0, bg, acc1[0], 0, 0, 0);
            acc1[1] = __builtin_amdgcn_mfma_f32_16x16x32_bf16(a1, bg, acc1[1], 0, 0, 0); }
    }
    f32x4* red = (f32x4*)lds;
    red[(wave * 4 + 0) * 64 + lane] = acc0[0]; red[(wave * 4 + 1) * 64 + lane] = acc0[1];
    if (MODE == 1) { red[(wave * 4 + 2) * 64 + lane] = acc1[0]; red[(wave * 4 + 3) * 64 + lane] = acc1[1]; }
    __syncthreads();
    if (wave == 0) {
#pragma unroll
        for (int w = 1; w < 8; ++w) { acc0[0] += red[(w * 4 + 0) * 64 + lane]; acc0[1] += red[(w * 4 + 1) * 64 + lane];
            if (MODE == 1) { acc1[0] += red[(w * 4 + 2) * 64 + lane]; acc1[1] += red[(w * 4 + 3) * 64 + lane]; } }
#pragma unroll
        for (int mi = 0; mi < 2; ++mi)
#pragma unroll
            for (int j = 0; j < 4; ++j) { bf16_t* p = Hrows + (size_t)(mi * 16 + fq * 4 + j) * DM + c;
                const float add = MODE == 0 ? acc0[mi][j] : acc0[mi][j] * __builtin_amdgcn_rcpf(1.f + __expf(-acc1[mi][j]));
                *p = (bf16_t)f2bf(bf2f(*p) + add); }
    }
    __syncthreads();
}

template <int MODE>
__device__ __forceinline__ void s5_meta_rows(const bf16_t* U, const bf16_t* CARg, const bf16_t* Bg, bf16_t* YI, bf16_t* S5E, const float* dvec, bf16_t* A2, int g, int wave, int lane) {
    const int fr = lane & 15, fq = lane >> 4;
    bf16x8 a[8];
#pragma unroll
    for (int ks = 0; ks < 8; ++ks) { const int k0 = ks * 32 + fq * 8;
        const bf16_t* ap = MODE == 0 ? U + (size_t)(NMAIN + (fr & 1) * 16 + (k0 >> 4)) * DM + g * 16 + (k0 & 15) : CARg + (size_t)(1024 + (fr & 1)) * 256 + k0;
        a[ks] = *(const bf16x8*)ap;
        if (fr >= 2) a[ks] = (bf16x8){0, 0, 0, 0, 0, 0, 0, 0}; }
    constexpr int NCB = MODE == 0 ? 4 : 2;
#pragma unroll
    for (int cbi = 0; cbi < NCB; ++cbi) {
        const int col = (wave * NCB + cbi) * 16 + fr;
        f32x4 acc = (f32x4){0.f, 0.f, 0.f, 0.f};
#pragma unroll
        for (int ks = 0; ks < 8; ++ks) acc = __builtin_amdgcn_mfma_f32_16x16x32_bf16(a[ks], *(const bf16x8*)(Bg + (size_t)col * 256 + ks * 32 + fq * 8), acc, 0, 0, 0);
        if (fq == 0) {
#pragma unroll
            for (int j = 0; j < 2; ++j) { const int n = 1024 + j;
                if (MODE == 0) {
                    if (col < 256) YI[(size_t)(16 * n + (col >> 4)) * DM + g * 16 + (col & 15)] = (bf16_t)f2bf(acc[j]);
                    else S5E[((size_t)n * 64 + g) * 256 + (col - 256)] = (bf16_t)f2bf(acc[j]);
                } else {
                    const size_t off = (size_t)(16 * n + (col >> 4)) * DM + g * 16 + (col & 15);
                    const float y = acc[j] + bf2f(YI[off]) + dvec[g * 16 + (col & 15)] * bf2f(U[off]);
                    const float z = 1.5957691216f * (y + 0.044715f * y * y * y);
                    A2[off] = (bf16_t)f2bf(y * __builtin_amdgcn_rcpf(1.f + __expf(-z)));
                }
            }
        }
    }
}
__device__ __forceinline__ void phase_0(CParams& P, unsigned char* lds, const int ph) {
    PHASE_PROLOGUE
            for (int row = gw; row < NT; row += NGW) {
                const float* src = row < NMAIN ? x + (size_t)row * DM : meta + (size_t)((row - NMAIN) & 15) * DM;
                f32x4 v[4];
#pragma unroll
                for (int j = 0; j < 4; ++j) { v[j] = __builtin_nontemporal_load((const f32x4*)src + lane + 64 * j); strow_bf16(H + (size_t)row * DM, lane, j, v[j]); }
                store_norm_bf16(v, norm_mix, HN + (size_t)row * DM, lane);
            }
    for (int it = gw; it < CONV_DENSE_ITEMS; it += NGW) conv_dense_item(P, it, lane);
}

__device__ __forceinline__ void phase_1(CParams& P, unsigned char* lds, const int ph) {
    PHASE_PROLOGUE
    pg8::ProjOrder S; S.init(HN, WTIN, bid);
    pg8::EpiProj E{Qb, Kb, Vb, REST};
    pg8::gemm_phase<pg8::EpiProj, pg8::ProjOrder, true, true>((PG8_LAS unsigned char*)lds, DM, S, E);
}

__device__ __forceinline__ void na_units(CParams& P, unsigned char* lds, const int xq, const int li) {
    PHASE_PROLOGUE
    constexpr int KST = 68, VST = 596, NKEY = 592;
    bf16_t* Ks = (bf16_t*)lds;
    bf16_t* VTs = Ks + NKEY * KST;
    float* sb = (float*)(VTs + 64 * VST);
    const bf16_t* VT = Vb;
    const int fr = lane & 15, fq = lane >> 4;
    const f32x4 zero4 = (f32x4){0.f, 0.f, 0.f, 0.f};
    u32x4 kreg[9], vreg[9];
#define NA_BAR() do { asm volatile("s_waitcnt lgkmcnt(0)" ::: "memory"); __builtin_amdgcn_s_barrier(); asm volatile("" ::: "memory"); } while (0)
#define NA_LOAD(u_) do { if ((u_) < 1024) { const int r2_ = ((u_) & 63) * 2, h_ = ((u_) >> 6) & 7, b_ = (u_) >> 9, Rb_ = min(max(r2_ - 4, 0), 120); \
        _Pragma("unroll") for (int q = 0; q < 9; ++q) { const int i = tid + 512 * q, key = i >> 3, pc = (i & 7) * 8; const int kr = min(Rb_ + (key >> 6), 127); \
            kreg[q] = *(const u32x4*)(Kb + ((size_t)b_ * SEQ + kr * 64 + (key & 63)) * 512 + h_ * 64 + pc); } \
        _Pragma("unroll") for (int q = 0; q < 9; ++q) { const int i = tid + 512 * q, dd = i / 72, rem = i - dd * 72, kr9 = rem >> 3, pc = (rem & 7) * 8; const int kr = min(Rb_ + kr9, 127); \
            vreg[q] = *(const u32x4*)(VT + (size_t)(h_ * 64 + dd) * NTP + (size_t)b_ * SEQ + kr * 64 + pc); } } } while (0)
    const int ntot = li < 8 ? 3 : (li - 8 < 6 ? 6 : 5);
#define NA_UNIT(k_) ({ const int v_ = (k_) < 3 ? 28 * (k_) + li : 84 + 20 * ((k_) - 3) + (li - 8); v_ < 128 ? 128 * xq + v_ : 1024 + 2 * xq + (v_ - 128); })
    NA_LOAD(NA_UNIT(0));
    for (int k = 0; k < ntot; ++k) { const int u = NA_UNIT(k);
        const bool metau = u >= 1024;
        int b, h, r2 = 0;
        if (!metau) { r2 = (u & 63) * 2; h = (u >> 6) & 7; b = u >> 9; } else { const int m = u - 1024; b = m >> 3; h = m & 7; }
        const int Rb = min(max(r2 - 4, 0), 120);
        if (!metau) {
            if (tid < 465) sb[tid] = rpb[h * 465 + tid];
#pragma unroll
            for (int q = 0; q < 9; ++q) { const int i = tid + 512 * q, key = i >> 3, pc = (i & 7) * 8; *(u32x4*)(Ks + key * KST + pc) = kreg[q]; }
#pragma unroll
            for (int q = 0; q < 9; ++q) { const int i = tid + 512 * q, dd = i / 72, rem = i - dd * 72, kr9 = rem >> 3, pc = (rem & 7) * 8; *(u32x4*)(VTs + dd * VST + kr9 * 64 + pc) = vreg[q]; }
        }
        for (int i = tid; i < 16 * 8; i += 512) { const int key = i >> 3, pc = (i & 7) * 8;
            *(u32x4*)(Ks + (576 + key) * KST + pc) = *(const u32x4*)(Kb + ((size_t)NMAIN + b * NMETA + key) * 512 + h * 64 + pc); }
        for (int i = tid; i < 64 * 2; i += 512) { const int dd = i >> 1, pc = (i & 1) * 8;
            *(u32x4*)(VTs + dd * VST + 576 + pc) = *(const u32x4*)(VT + (size_t)(h * 64 + dd) * NTP + NMAIN + b * NMETA + pc); }
        if (k + 1 < ntot) NA_LOAD(NA_UNIT(k + 1));
        NA_BAR();
        if (!metau || wave == 0) {
            const int rr = wave >> 2, qb = wave & 3, r = r2 + rr;
            const int c = qb * 16 + fr;
            const int qrow = metau ? NMAIN + b * NMETA + fr : b * SEQ + r * 64 + c;
            const int R0 = min(max(r - 4, 0), 120), cs = qb == 0 ? 0 : (qb == 1 ? 8 : (qb == 2 ? 24 : 32));
            const int C0 = min(max(c - 8, 0), 48);
            const int ro = R0 - Rb;
            const bf16x8 qf0 = *(const bf16x8*)(Qb + (size_t)qrow * 512 + h * 64 + fq * 8), qf1 = *(const bf16x8*)(Qb + (size_t)qrow * 512 + h * 64 + 32 + fq * 8);
            f32x4 sacc[17];
            if (!metau) {
#pragma unroll
                for (int kt = 0; kt < 16; ++kt) {
                    const bf16_t* kp = Ks + ((ro + (kt >> 1)) * 64 + cs + 16 * (kt & 1) + fr) * KST + fq * 8;
                    f32x4 acc = __builtin_amdgcn_mfma_f32_16x16x32_bf16(*(const bf16x8*)kp, qf0, zero4, 0, 0, 0);
                    sacc[kt] = __builtin_amdgcn_mfma_f32_16x16x32_bf16(*(const bf16x8*)(kp + 32), qf1, acc, 0, 0, 0);
                }
            } else {
#pragma unroll
                for (int kt = 0; kt < 16; ++kt) sacc[kt] = zero4;
            }
            {
                const bf16_t* kp = Ks + (576 + fr) * KST + fq * 8;
                f32x4 acc = __builtin_amdgcn_mfma_f32_16x16x32_bf16(*(const bf16x8*)kp, qf0, zero4, 0, 0, 0);
                sacc[16] = __builtin_amdgcn_mfma_f32_16x16x32_bf16(*(const bf16x8*)(kp + 32), qf1, acc, 0, 0, 0);
            }
            float mx = -1e30f;
#pragma unroll
            for (int kt = 0; kt < 16; ++kt) {
                const int dr = R0 + (kt >> 1) - r + 7;
#pragma unroll
                for (int j = 0; j < 4; ++j) {
                    const int kc = cs + 16 * (kt & 1) + 4 * fq + j;
                    const bool inb = !metau && kc >= C0 && kc < C0 + 16;
                    const int dc = min(max(kc - c + 15, 0), 30);
                    const float bias = sb[dr * 31 + dc];
                    const float sv = sacc[kt][j] * 0.125f + bias;
                    const float s = inb ? sv : -1e30f;
                    sacc[kt][j] = s; mx = fmaxf(mx, s);
                }
            }
#pragma unroll
            for (int j = 0; j < 4; ++j) { const float s = sacc[16][j] * 0.125f; sacc[16][j] = s; mx = fmaxf(mx, s); }
            mx = fmaxf(mx, __shfl_xor(mx, 16)); mx = fmaxf(mx, __shfl_xor(mx, 32));
            float sum = 0.f;
#pragma unroll
            for (int kt = 0; kt < 17; ++kt)
#pragma unroll
                for (int j = 0; j < 4; ++j) { const float pv = __expf(sacc[kt][j] - mx); sacc[kt][j] = pv; sum += pv; }
            sum += __shfl_xor(sum, 16); sum += __shfl_xor(sum, 32);
            f32x4 o[4] = {zero4, zero4, zero4, zero4};
            if (!metau) {
#pragma unroll
                for (int kr = 0; kr < 8; ++kr) {
                    union { bf16x8 v; unsigned u[4]; } bf;
                    bf.u[0] = pk2(sacc[2 * kr][0], sacc[2 * kr][1]); bf.u[1] = pk2(sacc[2 * kr][2], sacc[2 * kr][3]);
                    bf.u[2] = pk2(sacc[2 * kr + 1][0], sacc[2 * kr + 1][1]); bf.u[3] = pk2(sacc[2 * kr + 1][2], sacc[2 * kr + 1][3]);
                    const int tok0 = (ro + kr) * 64 + cs + 4 * fq;
#pragma unroll
                    for (int dt = 0; dt < 4; ++dt) {
                        const bf16_t* vp = VTs + (dt * 16 + fr) * VST + tok0;
                        union { bf16x8 v; u32x2 h2[2]; } af;
                        af.h2[0] = *(const u32x2*)vp; af.h2[1] = *(const u32x2*)(vp + 16);
                        o[dt] = __builtin_amdgcn_mfma_f32_16x16x32_bf16(af.v, bf.v, o[dt], 0, 0, 0);
                    }
                }
            }
            {
                union { bf16x8 v; unsigned u[4]; } bf;
                bf.u[0] = pk2(sacc[16][0], sacc[16][1]); bf.u[1] = pk2(sacc[16][2], sacc[16][3]); bf.u[2] = 0u; bf.u[3] = 0u;
#pragma unroll
                for (int dt = 0; dt < 4; ++dt) {
                    const bf16_t* vp = VTs + (dt * 16 + fr) * VST + 576 + 4 * fq;
                    union { bf16x8 v; u32x2 h2[2]; } af;
                    af.h2[0] = *(const u32x2*)vp; af.h2[1] = (u32x2){0u, 0u};
                    o[dt] = __builtin_amdgcn_mfma_f32_16x16x32_bf16(af.v, bf.v, o[dt], 0, 0, 0);
                }
            }
            const float inv = 1.f / sum;
#pragma unroll
            for (int dt = 0; dt < 4; ++dt) {
                u32x2 ov; ov.x = pk2(o[dt][0] * inv, o[dt][1] * inv); ov.y = pk2(o[dt][2] * inv, o[dt][3] * inv);
                *(u32x2*)(A2 + (size_t)qrow * DM + h * 64 + dt * 16 + 4 * fq) = ov;
            }
        }
        NA_BAR();
    }
#undef NA_LOAD
#undef NA_UNIT
#undef NA_BAR
}

__device__ __forceinline__ void phase_3(CParams& P, unsigned char* lds, const int ph) {
    PHASE_PROLOGUE
    constexpr int TR = 66, NTILE = (NT + TR - 1) / TR, AST = 264, SST = 136;
    bf16_t* As = (bf16_t*)lds;
    unsigned short* stg = (unsigned short*)(lds + 80 * AST * 2);
    const bf16_t* lrt = (const bf16_t*)(ws + WS_LRT);
    const int fr = lane & 15, fq = lane >> 4;
    for (int u = bid; u < NTILE; u += G) {
        const int r0 = u * TR, nrows = min(TR, NT - r0);
#ifndef PREP_REP1
#define PREP_REP1 1
#endif
        for (int rep1_ = 0; rep1_ < PREP_REP1; ++rep1_)
        for (int rl0 = wave; rl0 < nrows; rl0 += 24) {
            u32x2 vc[3][7], vp[3][7], vn[3][7]; bool okr[3], hp[3], hn[3]; int rows[3];
#pragma unroll
            for (int q = 0; q < 3; ++q) {
                const int rl = rl0 + 8 * q; okr[q] = rl < nrows;
                const int row = okr[q] ? r0 + rl : r0; rows[q] = row;
                int b, pp_;
                if (row < NMAIN) { b = row >> 13; pp_ = (row & (SEQ - 1)) + NMETA; } else { b = (row - NMAIN) >> 4; pp_ = (row - NMAIN) & 15; }
                hp[q] = pp_ > 0; hn[q] = pp_ + 1 < LSEQ;
                const int rowp = hp[q] ? rowof(b, pp_ - 1) : row, rown = hn[q] ? rowof(b, pp_ + 1) : row;
#pragma unroll
                for (int j = 0; j < 7; ++j) { const int c = 4 * lane + 256 * j;
                    vc[q][j] = *(const u32x2*)(REST + (size_t)row * RESTC + c); vp[q][j] = *(const u32x2*)(REST + (size_t)rowp * RESTC + c); vn[q][j] = *(const u32x2*)(REST + (size_t)rown * RESTC + c); }
            }
#pragma unroll
            for (int q = 0; q < 3; ++q) {
                if (okr[q]) {
                    const int row = rows[q], rl = rl0 + 8 * q;
#pragma unroll
                    for (int j = 0; j < 7; ++j) {
                        const int c = 4 * lane + 256 * j;
                        u32x2 a = vp[q][j], bq = vn[q][j]; const u32x2 cc = vc[q][j];
                        if (!hp[q]) { a.x = 0; a.y = 0; }
                        if (!hn[q]) { bq.x = 0; bq.y = 0; }
                        const f32x4 m4 = *(const f32x4*)(mu + c);
                        const float pc[4] = {bflo(cc.x), bfhi(cc.x), bflo(cc.y), bfhi(cc.y)};
                        const float pq[4] = {bflo(a.x), bfhi(a.x), bflo(a.y), bfhi(a.y)};
                        const float pn[4] = {bflo(bq.x), bfhi(bq.x), bflo(bq.y), bfhi(bq.y)};
                        float o[4];
#pragma unroll
                        for (int i = 0; i < 4; ++i) o[i] = pc[i] + m4[i] * (0.5f * (pq[i] + pn[i]) - pc[i]);
                        if (j == 6) {
                            if (lane < 16) { for (int i = 0; i < 4; ++i) o[i] = tanhf(o[i]); }
                            else if (lane >= 32) { for (int i = 0; i < 4; ++i) o[i] = sigmoidf_(o[i]); }
                        }
                        u32x2 ov; ov.x = pk2(o[0], o[1]); ov.y = pk2(o[2], o[3]);
                        if (j < 6) { bf16_t* dst = j < 2 ? Rr + (size_t)row * 512 + c : (j < 4 ? KR + (size_t)row * 512 + (c - 512) : VV + (size_t)row * 512 + (c - 1024)); *(u32x2*)dst = ov; }
                        else *(u32x2*)(As + rl * AST + (c - 1536)) = ov;
                    }
                }
            }
        }
        __syncthreads();
#define P4_LOADB(bk_, bv_, bias_) do { const int wh_ = (bk_) >> 5, cb_ = (bk_) & 31, Kw_ = wh_ < 4 ? 64 : 128; \
            const bf16_t* Wt_ = lrt + (wh_ < 4 ? (size_t)wh_ * 512 * 64 : (size_t)4 * 512 * 64) + (size_t)(cb_ * 16 + fr) * Kw_ + 8 * fq; \
            bv_[0] = *(const bf16x8*)Wt_; bv_[1] = *(const bf16x8*)(Wt_ + 32); if (wh_ == 4) { bv_[2] = *(const bf16x8*)(Wt_ + 64); bv_[3] = *(const bf16x8*)(Wt_ + 96); } \
            bias_ = wh_ < 2 ? *(const f32x4*)(w0 + wh_ * 512 + cb_ * 16 + 4 * fq) : (wh_ < 4 ? *(const f32x4*)(a0 + (wh_ - 2) * 512 + cb_ * 16 + 4 * fq) : (f32x4){0.f, 0.f, 0.f, 0.f}); } while (0)
        bf16x8 bnx[4], bn2[4]; f32x4 biasn, bias2;
        P4_LOADB(wave, bnx, biasn); P4_LOADB(wave + 8, bn2, bias2);
#ifndef PREP_REP2
#define PREP_REP2 1
#endif
#pragma unroll 1
        for (int t_ = 0; t_ < 20 * PREP_REP2; ++t_) { const int bk = wave + 8 * (t_ % 20);
            const int which = bk >> 5, cb = bk & 31;
            const int koff = which < 2 ? 0 : (which < 4 ? 64 : 128);
            bf16x8 bcur[4]; bcur[0] = bnx[0]; bcur[1] = bnx[1]; bcur[2] = bnx[2]; bcur[3] = bnx[3];
            const f32x4 bias = biasn;
            bnx[0] = bn2[0]; bnx[1] = bn2[1]; bnx[2] = bn2[2]; bnx[3] = bn2[3]; biasn = bias2;
            if (t_ + 2 < 20 * PREP_REP2) P4_LOADB(wave + 8 * ((t_ + 2) % 20), bn2, bias2);
            const f32x4 zero4 = (f32x4){0.f, 0.f, 0.f, 0.f};
            f32x4 acc[5] = {zero4, zero4, zero4, zero4, zero4};
#pragma unroll
            for (int ks = 0; ks < 4; ++ks) {
                if (ks < 2 || which == 4) {
#pragma unroll
                    for (int rt = 0; rt < 5; ++rt) acc[rt] = __builtin_amdgcn_mfma_f32_16x16x32_bf16(bcur[ks], *(const bf16x8*)(As + (16 * rt + fr) * AST + koff + 32 * ks + 8 * fq), acc[rt], 0, 0, 0);
                }
            }
            unsigned short* dst = (which < 2 ? (unsigned short*)LW + (size_t)which * NT * 512 : (which < 4 ? (unsigned short*)AA + (size_t)(which - 2) * NT * 512 : (unsigned short*)Gg)) + cb * 16 + 4 * fq;
#pragma unroll
            for (int rt = 0; rt < 5; ++rt) {
                unsigned short o[4];
#pragma unroll
                for (int j = 0; j < 4; ++j) { const float val = acc[rt][j] + bias[j];
                    if (which < 2) { const _Float16 hv = (_Float16)(-0.6065306597f * sigmoidf_(val)); o[j] = __builtin_bit_cast(unsigned short, hv); }
                    else if (which < 4) o[j] = (unsigned short)f2bf(sigmoidf_(val));
                    else o[j] = (unsigned short)f2bf(val); }
                const int r = 16 * rt + fr;
                if (r < nrows) { u32x2 ov; ov.x = (unsigned)o[0] | ((unsigned)o[1] << 16); ov.y = (unsigned)o[2] | ((unsigned)o[3] << 16); *(u32x2*)(dst + (size_t)(r0 + r) * 512) = ov; }
            }
        }
#undef P4_LOADB
        __syncthreads();
#ifndef PREP_REP3
#define PREP_REP3 1
#endif
        for (int rep3_ = 0; rep3_ < PREP_REP3; ++rep3_) {
        u32x4 nkr, nrv, nav0, nav1;
#define P3_LD3(rl_) do { const size_t ro_ = (size_t)(r0 + (rl_)) * 512 + lane * 8; nkr = *(const u32x4*)(KR + ro_); nrv = *(const u32x4*)(Rr + ro_); nav0 = *(const u32x4*)(AA + ro_); nav1 = *(const u32x4*)(AA + (size_t)NT * 512 + ro_); } while (0)
        if (wave < nrows) P3_LD3(wave);
        for (int rl = wave; rl < nrows; rl += 8) {
            const int row = r0 + rl;

                const int c0 = lane * 8;
                const u32x4 krv = nkr, rv = nrv; u32x4 avd[2]; avd[0] = nav0; avd[1] = nav1;
                if (rl + 8 < nrows) P3_LD3(rl + 8);
                float kr[8], rr[8], kkv[8];
#pragma unroll
                for (int i = 0; i < 4; ++i) { kr[2 * i] = bflo(krv[i]); kr[2 * i + 1] = bfhi(krv[i]); rr[2 * i] = bflo(rv[i]); rr[2 * i + 1] = bfhi(rv[i]); }
                float ss = 0.f;
#pragma unroll
                for (int i = 0; i < 8; ++i) { kkv[i] = kr[i] * k_k[c0 + i]; ss += kkv[i] * kkv[i]; }
                ss += __shfl_xor(ss, 1); ss += __shfl_xor(ss, 2); ss += __shfl_xor(ss, 4);
                const float inv = 1.f / fmaxf(sqrtf(ss), 1e-12f);
#pragma unroll
                for (int i = 0; i < 8; ++i) kkv[i] *= inv;
                u32x4 o; o.x = pk2(kkv[0], kkv[1]); o.y = pk2(kkv[2], kkv[3]); o.z = pk2(kkv[4], kkv[5]); o.w = pk2(kkv[6], kkv[7]);
                *(u32x4*)(KK + (size_t)row * 512 + c0) = o;
                float bsum = 0.f;
#pragma unroll
                for (int d = 0; d < 2; ++d) {
                    const u32x4 av = avd[d];
                    float a[8], kka[8], kd[8];
#pragma unroll
                    for (int i = 0; i < 4; ++i) { a[2 * i] = bflo(av[i]); a[2 * i + 1] = bfhi(av[i]); }
#pragma unroll
                    for (int i = 0; i < 8; ++i) { kka[i] = kkv[i] * a[i]; kd[i] = kr[i] * (1.f + (a[i] - 1.f) * k_a[c0 + i]); bsum += rr[i] * kd[i] * r_k[c0 + i]; }
                    u32x4 o1; o1.x = pk2(kka[0], kka[1]); o1.y = pk2(kka[2], kka[3]); o1.z = pk2(kka[4], kka[5]); o1.w = pk2(kka[6], kka[7]);
                    *(u32x4*)(KKA + ((size_t)d * NT + row) * 512 + c0) = o1;
                    u32x4 o2; o2.x = pk2(kd[0], kd[1]); o2.y = pk2(kd[2], kd[3]); o2.z = pk2(kd[4], kd[5]); o2.w = pk2(kd[6], kd[7]);
                    *(u32x4*)(KD + ((size_t)d * NT + row) * 512 + c0) = o2;
                }
                bsum += __shfl_xor(bsum, 1); bsum += __shfl_xor(bsum, 2); bsum += __shfl_xor(bsum, 4);
                if ((lane & 7) == 0) BC[(size_t)row * 8 + (lane >> 3)] = bsum;
                    }
#undef P3_LD3
        }
        __syncthreads();
    }
}

#define RWS 72
__device__ __forceinline__ bf16x8 rw_frag(const bf16_t* M, int row, int kofs) { return *(const bf16x8*)(M + row * RWS + kofs); }
__device__ __forceinline__ f32x4 rw_tile(const bf16_t* Am, int ra, const bf16_t* Bm, int rb, int fr, int fq) {
    f32x4 acc = (f32x4){0.f, 0.f, 0.f, 0.f};
    acc = __builtin_amdgcn_mfma_f32_16x16x32_bf16(rw_frag(Am, ra + fr, 8 * fq), rw_frag(Bm, rb + fr, 8 * fq), acc, 0, 0, 0);
    acc = __builtin_amdgcn_mfma_f32_16x16x32_bf16(rw_frag(Am, ra + fr, 32 + 8 * fq), rw_frag(Bm, rb + fr, 32 + 8 * fq), acc, 0, 0, 0);
    return acc;
}
__device__ __forceinline__ void phase_6(CParams& P, unsigned char* lds, const int ph) {
    PHASE_PROLOGUE
    constexpr int GST = 68, RST = 132;
    float* Gs = (float*)lds;
    bf16_t* A_rm = (bf16_t*)(lds + 64 * GST * 4); bf16_t* R_rm = A_rm + 64 * RWS; bf16_t* B_rm = R_rm + 64 * RWS; bf16_t* K_rm = B_rm + 64 * RWS;
    bf16_t* B_tr = K_rm + 64 * RWS; bf16_t* K_tr = B_tr + 64 * RWS; bf16_t* V_tr = K_tr + 64 * RWS;
    bf16_t* MAK = V_tr + 64 * RWS; bf16_t* MRB = MAK + 64 * RWS; bf16_t* MRK = MRB + 64 * RWS;
    bf16_t* MABr = MRK + 64 * RWS;
    float* RHS = (float*)(MABr + 64 * RWS);
    float* BT = RHS + 64 * RST; float* OFF = BT + 512; float* GC = OFF + 512;
    bf16_t* X1_tr = A_rm; bf16_t* X2_tr = K_rm;
    for (int i = tid; i < 4 * 64 * RWS / 2; i += 512) ((unsigned*)MAK)[i] = 0u;
    __syncthreads();
    const int fr = lane & 15, fq = lane >> 4;
#define RW1_BAR() do { asm volatile("s_waitcnt lgkmcnt(0)" ::: "memory"); __builtin_amdgcn_s_barrier(); asm volatile("" ::: "memory"); } while (0)
    const int t0 = tid & 63, kp = (tid >> 6) * 8;
    u32x4 nlw, nkk, nka, nkd, nrv, nvv;
#define RW1_LOAD(u_) do { const int ch_ = (u_) / RW_NCH, c_ = (u_) - ch_ * RW_NCH, d_ = ch_ >> 4, b_ = (ch_ >> 3) & 1, h_ = ch_ & 7, s_ = c_ * 64 + t0; \
        const int p_ = d_ ? LSEQ - 1 - s_ : s_; const size_t o_ = (size_t)rowof(b_, s_ < LSEQ ? p_ : 0) * 512 + h_ * 64 + kp; \
        nlw = __builtin_nontemporal_load((const u32x4*)(LW + (size_t)d_ * NT * 512 + o_)); nkk = *(const u32x4*)(KK + o_); nka = __builtin_nontemporal_load((const u32x4*)(KKA + (size_t)d_ * NT * 512 + o_)); \
        nkd = __builtin_nontemporal_load((const u32x4*)(KD + (size_t)d_ * NT * 512 + o_)); nrv = *(const u32x4*)(Rr + o_); nvv = *(const u32x4*)(VV + o_); } while (0)
    if (bid < RW_UNITS) RW1_LOAD(bid);
    for (int u = bid; u < RW_UNITS; u += G) {
        const int chain = u / RW_NCH, c = u - chain * RW_NCH;
        float lw[8], kk[8], ka[8], kd[8], rr[8]; u32x4 vv;
        {
            const bool valid = c * 64 + t0 < LSEQ;
            vv = nvv;
#pragma unroll
            for (int i = 0; i < 4; ++i) {
                union { unsigned u; _Float16 hh[2]; } cv; cv.u = nlw[i];
                lw[2 * i] = valid ? (float)cv.hh[0] : 0.f; lw[2 * i + 1] = valid ? (float)cv.hh[1] : 0.f;
                kk[2 * i] = valid ? bflo(nkk[i]) : 0.f; kk[2 * i + 1] = valid ? bfhi(nkk[i]) : 0.f;
                ka[2 * i] = valid ? bflo(nka[i]) : 0.f; ka[2 * i + 1] = valid ? bfhi(nka[i]) : 0.f;
                kd[2 * i] = valid ? bflo(nkd[i]) : 0.f; kd[2 * i + 1] = valid ? bfhi(nkd[i]) : 0.f;
                rr[2 * i] = valid ? bflo(nrv[i]) : 0.f; rr[2 * i + 1] = valid ? bfhi(nrv[i]) : 0.f;
                if (!valid) vv[i] = 0u;
            }
        }
        if (u + G < RW_UNITS) RW1_LOAD(u + G);
        float gg_[8];
#pragma unroll
        for (int i = 0; i < 8; ++i) {
            float v = lw[i];
            v += __int_as_float(__builtin_amdgcn_update_dpp(0, __float_as_int(v), 0x111, 0xF, 0xF, false));
            v += __int_as_float(__builtin_amdgcn_update_dpp(0, __float_as_int(v), 0x112, 0xF, 0xF, false));
            v += __int_as_float(__builtin_amdgcn_update_dpp(0, __float_as_int(v), 0x114, 0xF, 0xF, false));
            v += __int_as_float(__builtin_amdgcn_update_dpp(0, __float_as_int(v), 0x118, 0xF, 0xF, false));
            v += __int_as_float(__builtin_amdgcn_update_dpp(0, __float_as_int(v), 0x142, 0xA, 0xF, false));
            v += __int_as_float(__builtin_amdgcn_update_dpp(0, __float_as_int(v), 0x143, 0xC, 0xF, false));
            gg_[i] = v;
        }
#ifndef RW1_REP0
#define RW1_REP0 1
#endif
        for (int rep0_ = 0; rep0_ < RW1_REP0; ++rep0_) {
        {
            float va[8], vr[8], vb[8], vk[8];
#pragma unroll
            for (int i = 0; i < 8; ++i) {
                const float g = gg_[i];
                const float eg = __expf(g), egm1 = __expf(g - lw[i]), einv = __expf(-g);
                va[i] = kk[i] * egm1; vr[i] = rr[i] * eg; vb[i] = ka[i] * einv; vk[i] = kd[i] * einv;
                if (t0 == 63) GC[kp + i] = eg;
            }
            *(f32x4*)(RHS + t0 * RST + kp) = (f32x4){va[0], va[1], va[2], va[3]}; *(f32x4*)(RHS + t0 * RST + kp + 4) = (f32x4){va[4], va[5], va[6], va[7]};
            u32x4 w4;
            w4.x = pk2(va[0], va[1]); w4.y = pk2(va[2], va[3]); w4.z = pk2(va[4], va[5]); w4.w = pk2(va[6], va[7]); *(u32x4*)(A_rm + t0 * RWS + kp) = w4;
            w4.x = pk2(vr[0], vr[1]); w4.y = pk2(vr[2], vr[3]); w4.z = pk2(vr[4], vr[5]); w4.w = pk2(vr[6], vr[7]); *(u32x4*)(R_rm + t0 * RWS + kp) = w4;
            w4.x = pk2(vb[0], vb[1]); w4.y = pk2(vb[2], vb[3]); w4.z = pk2(vb[4], vb[5]); w4.w = pk2(vb[6], vb[7]); *(u32x4*)(B_rm + t0 * RWS + kp) = w4;
            w4.x = pk2(vk[0], vk[1]); w4.y = pk2(vk[2], vk[3]); w4.z = pk2(vk[4], vk[5]); w4.w = pk2(vk[6], vk[7]); *(u32x4*)(K_rm + t0 * RWS + kp) = w4;
#pragma unroll
            for (int i = 0; i < 8; ++i) { B_tr[(kp + i) * RWS + t0] = (bf16_t)f2bf(vb[i]); K_tr[(kp + i) * RWS + t0] = (bf16_t)f2bf(vk[i]);
                V_tr[(kp + i) * RWS + t0] = (bf16_t)((i & 1) ? (vv[i >> 1] >> 16) : (vv[i >> 1] & 0xffffu)); }
        }
        RW1_BAR();
        }
        float* DQ = Gs; bf16_t* TB = (bf16_t*)BT;
#ifndef RW1_REP1
#define RW1_REP1 1
#endif
#pragma unroll
        for (int s1 = 0; s1 < 5; ++s1) { const int q = wave + 8 * s1;
            const int m = q / 10, e = q - m * 10, ti = e >= 6 ? 3 : (e >= 3 ? 2 : (e >= 1 ? 1 : 0)), tj = e - (ti * (ti + 1)) / 2;
            const f32x4 acc = rw_tile(m < 2 ? A_rm : R_rm, 16 * ti, (m & 1) ? K_rm : B_rm, 16 * tj, fr, fq);
            bf16_t* Mm = m == 1 ? MAK : (m == 2 ? MRB : MRK);
#pragma unroll
            for (int j = 0; j < 4; ++j) { const int t = 16 * ti + 4 * fq + j, i = 16 * tj + fr; const bool keep = m < 2 ? (i < t) : (i <= t); const float val = keep ? acc[j] : 0.f;
                if (m == 0) { MABr[t * RWS + i] = (bf16_t)f2bf(val); if (ti == tj) DQ[((ti * 16 + (t & 15)) * 4 + (fr & 3)) * 4 + (fr >> 2)] = val; }
                else Mm[t * RWS + i] = (bf16_t)f2bf(val); }
        }
        RW1_BAR();
#ifndef RW1_REP23
#define RW1_REP23 1
#endif
        for (int rep23_ = 0; rep23_ < RW1_REP23; ++rep23_) {
        if (wave >= 4) {
            for (int q = wave - 4; q < 16; q += 4) { const int ti = q >> 2, tv = q & 3; const f32x4 acc = rw_tile(MAK, 16 * ti, V_tr, 16 * tv, fr, fq);
#pragma unroll
                for (int j = 0; j < 4; ++j) RHS[(16 * ti + 4 * fq + j) * RST + 64 + 16 * tv + fr] = acc[j]; }
        } else {
            const int bb = wave, cc = lane >> 2, q = lane & 3;
            float xs[4] = {0.f, 0.f, 0.f, 0.f};
#pragma unroll
            for (int tl = 0; tl < 16; ++tl) {
                const f32x4 mv = *(const f32x4*)(DQ + ((bb * 16 + tl) * 4 + q) * 4);
                float part = mv[0] * xs[0] + mv[1] * xs[1] + mv[2] * xs[2] + mv[3] * xs[3];
                part += dppf<0xB1>(part); part += dppf<0x4E>(part);
                const float xt = (tl == cc ? 1.f : 0.f) - part;
                xs[tl >> 2] = (tl & 3) == q ? xt : xs[tl >> 2];
            }
#pragma unroll
            for (int m = 0; m < 4; ++m) TB[(bb * 16 + 4 * m + q) * 16 + cc] = (bf16_t)f2bf(xs[m]);
        }
        RW1_BAR();
        {
            const int c0 = 16 * wave;
            f32x4 X[4];
            const f32x4 zero4 = (f32x4){0.f, 0.f, 0.f, 0.f};
#define RW1_PACK(lo_, hi_, v_) do { union { bf16x8 v; unsigned u[4]; } t_; t_.u[0] = pk2(lo_[0], lo_[1]); t_.u[1] = pk2(lo_[2], lo_[3]); t_.u[2] = pk2(hi_[0], hi_[1]); t_.u[3] = pk2(hi_[2], hi_[3]); v_ = t_.v; } while (0)
#define RW1_LDA(base_, row0_, ca_, cb_, useb_, v_) do { union { bf16x8 v; u32x2 h2[2]; } t_; t_.h2[0] = *(const u32x2*)((base_) + ((row0_) + fr) * RWS + (ca_) + 4 * fq); \
            t_.h2[1] = (useb_) ? *(const u32x2*)((base_) + ((row0_) + fr) * RWS + (cb_) + 4 * fq) : (u32x2){0u, 0u}; v_ = t_.v; } while (0)
#pragma unroll
            for (int bq = 0; bq < 4; ++bq) {
                f32x4 acc;
#pragma unroll
                for (int j = 0; j < 4; ++j) acc[j] = -RHS[(16 * bq + 4 * fq + j) * RST + c0 + fr];
                bf16x8 af, bfv;
                if (bq >= 1) { RW1_LDA(MABr, 16 * bq, 0, 16, bq >= 2, af); if (bq >= 2) RW1_PACK(X[0], X[1], bfv); else RW1_PACK(X[0], zero4, bfv);
                    acc = __builtin_amdgcn_mfma_f32_16x16x32_bf16(af, bfv, acc, 0, 0, 0); }
                if (bq == 3) { RW1_LDA(MABr, 48, 32, 0, false, af); RW1_PACK(X[2], zero4, bfv); acc = __builtin_amdgcn_mfma_f32_16x16x32_bf16(af, bfv, acc, 0, 0, 0); }
                const f32x4 wv = (f32x4){-acc[0], -acc[1], -acc[2], -acc[3]};
                { union { bf16x8 v; u32x2 h2[2]; } t_; t_.h2[0] = *(const u32x2*)(TB + (bq * 16 + fr) * 16 + 4 * fq); t_.h2[1] = (u32x2){0u, 0u}; af = t_.v; }
                RW1_PACK(wv, zero4, bfv);
                X[bq] = __builtin_amdgcn_mfma_f32_16x16x32_bf16(af, bfv, zero4, 0, 0, 0);
                bf16_t* Xm = (wave < 4 ? X1_tr : X2_tr) + ((c0 & 63) + fr) * RWS + 16 * bq + 4 * fq;
                u32x2 o; o.x = pk2(X[bq][0], X[bq][1]); o.y = pk2(X[bq][2], X[bq][3]);
                *(u32x2*)Xm = o;
            }
#undef RW1_PACK
#undef RW1_LDA
        }
        RW1_BAR();
        }
#pragma unroll
        for (int s5 = 0; s5 < 2; ++s5) {
            const int tile = wave * 2 + s5, ta = tile >> 2, tb = tile & 3;
            u32x2 o;
            {
                const f32x4 acc = rw_tile(X1_tr, 16 * ta, B_tr, 16 * tb, fr, fq);
                const int k = 16 * tb + fr, kq = 16 * ta + 4 * fq; const float gc = GC[k];
                float v[4];
#pragma unroll
                for (int j = 0; j < 4; ++j) v[j] = gc * ((kq + j == k ? 1.f : 0.f) - acc[j]);
                o.x = pk2(v[0], v[1]); o.y = pk2(v[2], v[3]);
                *(u32x2*)(PP + (size_t)u * 4096 + k * 64 + 32 * (ta >> 1) + 8 * fq + 4 * (ta & 1)) = o;
            }
            {
                const f32x4 acc = rw_tile(X1_tr, 16 * ta, MRB, 16 * tb, fr, fq);
                const int t = 16 * tb + fr, k0 = 16 * ta + 4 * fq;
                const u32x2 rv = *(const u32x2*)(R_rm + t * RWS + k0);
                o.x = pk2(bflo(rv.x) - acc[0], bfhi(rv.x) - acc[1]); o.y = pk2(bflo(rv.y) - acc[2], bfhi(rv.y) - acc[3]);
                *(u32x2*)(YT + (size_t)u * 4096 + t * 64 + 32 * (ta >> 1) + 8 * fq + 4 * (ta & 1)) = o;
            }
            {
                const f32x4 a1 = rw_tile(K_tr, 16 * ta, V_tr, 16 * tb, fr, fq), a2 = rw_tile(B_tr, 16 * ta, X2_tr, 16 * tb, fr, fq);
                const int v_ = 16 * tb + fr, k0 = 16 * ta + 4 * fq;
                const f32x4 gc = *(const f32x4*)(GC + k0);
                o.x = pk2(gc[0] * (a1[0] - a2[0]), gc[1] * (a1[1] - a2[1])); o.y = pk2(gc[2] * (a1[2] - a2[2]), gc[3] * (a1[3] - a2[3]));
                *(u32x2*)(QT + (size_t)u * 4096 + v_ * 64 + k0) = o;
            }
            {
                const f32x4 a1 = rw_tile(V_tr, 16 * tb, MRK, 16 * ta, fr, fq), a2 = rw_tile(X2_tr, 16 * tb, MRB, 16 * ta, fr, fq);
                const int t_ = 16 * ta + fr, v0_ = 16 * tb + 4 * fq, s_ = c * 64 + t_;
                o.x = pk2(a1[0] - a2[0], a1[1] - a2[1]); o.y = pk2(a1[2] - a2[2], a1[3] - a2[3]);
                if (s_ < LSEQ) { const int d_ = chain >> 4, b_ = (chain >> 3) & 1, h_ = chain & 7, p_ = d_ ? LSEQ - 1 - s_ : s_; *(u32x2*)(ZT + ((size_t)d_ * NT + rowof(b_, p_)) * 512 + h_ * 64 + v0_) = o; }
            }
        }
        RW1_BAR();
    }
#undef RW1_LOAD
#undef RW1_BAR
}

__device__ __forceinline__ void s5_setup_units(CParams& P, unsigned char* lds, const int first, const int stride) {
    PHASE_PROLOGUE
    float* pwr = (float*)lds; float* pwi = pwr + 2176; float* bbr = pwi + 2176; float* bbi = bbr + 2048; float* ccr = bbi + 2048; float* cci = ccr + 2048; float* kf = cci + 2048; float* kb = kf + 4096;
    for (int gu = first; gu < 64; gu += stride) {
        const int g = gu;
        if (tid < 128) {
            const int d = tid >> 6, p = tid & 63;
            const float step = __expf(s5_ls[d * 64 + g]);
            const float lr = s5_lre[(d * 64 + g) * 64 + p], li = s5_lim[(d * 64 + g) * 64 + p];
            const float mag = expf(lr * step);
            const float abr = mag * cosf(li * step), abi = mag * sinf(li * step);
            const float den = lr * lr + li * li;
            const float zr = ((abr - 1.f) * lr + abi * li) / den, zi = (abi * lr - (abr - 1.f) * li) / den;
            float pr = 1.f, pi = 0.f;
            for (int t = 0; t < 17; ++t) { pwr[(d * 64 + p) * 17 + t] = pr; pwi[(d * 64 + p) * 17 + t] = pi; const float nr = pr * abr - pi * abi; pi = pr * abi + pi * abr; pr = nr; }
            for (int i = 0; i < 16; ++i) { const float br = s5_b_re[((size_t)(g * 64 + p)) * 16 + i], bi = s5_b_im[((size_t)(g * 64 + p)) * 16 + i];
                bbr[(d * 64 + p) * 16 + i] = zr * br - zi * bi; bbi[(d * 64 + p) * 16 + i] = zr * bi + zi * br; }
        }
        for (int idx = tid; idx < 2048; idx += 512) { const int d = idx >> 10, i = (idx >> 6) & 15, p = idx & 63;
            ccr[(d * 64 + p) * 16 + i] = s5_c_re[((size_t)(d * 64 + g) * 16 + i) * 64 + p]; cci[(d * 64 + p) * 16 + i] = s5_c_im[((size_t)(d * 64 + g) * 16 + i) * 64 + p]; }
        __syncthreads();
        {
            const int d = tid >> 8, tau = (tid >> 4) & 15, i = tid & 15;
            float acc[16];
#pragma unroll
            for (int q = 0; q < 16; ++q) acc[q] = 0.f;
            for (int p = 0; p < 64; ++p) {
                const float cr = ccr[(d * 64 + p) * 16 + i], ci = cci[(d * 64 + p) * 16 + i], pr = pwr[(d * 64 + p) * 17 + tau], pi = pwi[(d * 64 + p) * 17 + tau];
                const float xr = cr * pr - ci * pi, xi = cr * pi + ci * pr;
#pragma unroll
                for (int q = 0; q < 16; ++q) acc[q] += xr * bbr[(d * 64 + p) * 16 + q] - xi * bbi[(d * 64 + p) * 16 + q];
            }
            float* kt = (d ? kb : kf) + (tau * 16 + i) * 16;
#pragma unroll
            for (int q = 0; q < 16; ++q) kt[q] = acc[q];
        }
        __syncthreads();
        {
            const int i = tid >> 5, j = (tid & 31) >> 1, ip0 = (tid & 1) * 8;
            const float* kfi = kf + i * 16 + ip0; const float* kbi = kb + i * 16 + ip0;
            bf16_t* dst = BTA + (size_t)g * 512 * 256 + (size_t)i * 256 + j * 16 + ip0;
#pragma unroll 4
            for (int t = 0; t < 16; ++t) {
                const int dl = t - j; const float* sp = dl >= 0 ? kfi + dl * 256 : kbi - dl * 256;
                f32x4 v0 = *(const f32x4*)sp, v1 = *(const f32x4*)(sp + 4);
                if (dl == 0) { const f32x4 w0_ = *(const f32x4*)kbi, w1_ = *(const f32x4*)(kbi + 4); v0 += w0_; v1 += w1_; }
                u32x4 o; o.x = pk2(v0[0], v0[1]); o.y = pk2(v0[2], v0[3]); o.z = pk2(v1[0], v1[1]); o.w = pk2(v1[2], v1[3]);
                *(u32x4*)(dst + (size_t)t * 16 * 256) = o;
            }
        }
        {
            const int j = (tid & 31) >> 1, ip0 = (tid & 1) * 8;
            bf16_t* dst = BTA + (size_t)g * 512 * 256 + (size_t)256 * 256 + j * 16 + ip0;
#pragma unroll 2
            for (int it = 0; it < 16; ++it) {
                const int kp = (tid >> 5) + 16 * it, d = kp >> 7, im = (kp >> 6) & 1, p = kp & 63, tau = d == 0 ? 15 - j : j;
                const float pr = pwr[(d * 64 + p) * 17 + tau], pi = pwi[(d * 64 + p) * 17 + tau];
                const f32x4 br0 = *(const f32x4*)(bbr + (d * 64 + p) * 16 + ip0), br1 = *(const f32x4*)(bbr + (d * 64 + p) * 16 + ip0 + 4);
                const f32x4 bi0 = *(const f32x4*)(bbi + (d * 64 + p) * 16 + ip0), bi1 = *(const f32x4*)(bbi + (d * 64 + p) * 16 + ip0 + 4);
                f32x4 v0, v1;
                if (im) { v0 = pr * bi0 + pi * br0; v1 = pr * bi1 + pi * br1; } else { v0 = pr * br0 - pi * bi0; v1 = pr * br1 - pi * bi1; }
                u32x4 o; o.x = pk2(v0[0], v0[1]); o.y = pk2(v0[2], v0[3]); o.z = pk2(v1[0], v1[1]); o.w = pk2(v1[2], v1[3]);
                *(u32x4*)(dst + (size_t)kp * 256) = o;
            }
        }
        {
            const int k0 = (tid & 127) * 2, d = k0 >> 7, im = (k0 >> 6) & 1, p0 = k0 & 63, iq = (tid >> 7) * 4;
            const f32x4 cr0 = *(const f32x4*)(ccr + (d * 64 + p0) * 16 + iq), ci0 = *(const f32x4*)(cci + (d * 64 + p0) * 16 + iq);
            const f32x4 cr1 = *(const f32x4*)(ccr + (d * 64 + p0 + 1) * 16 + iq), ci1 = *(const f32x4*)(cci + (d * 64 + p0 + 1) * 16 + iq);
            unsigned* dst = (unsigned*)(BTC + (size_t)g * 256 * 256) + (tid & 127);
#pragma unroll 2
            for (int t = 0; t < 16; ++t) {
                const int tau = d == 0 ? t + 1 : 16 - t;
                const float pr0 = pwr[(d * 64 + p0) * 17 + tau], pi0 = pwi[(d * 64 + p0) * 17 + tau], pr1 = pwr[(d * 64 + p0 + 1) * 17 + tau], pi1 = pwi[(d * 64 + p0 + 1) * 17 + tau];
#pragma unroll
                for (int ii = 0; ii < 4; ++ii) {
                    const float a_ = im ? -(cr0[ii] * pi0 + ci0[ii] * pr0) : cr0[ii] * pr0 - ci0[ii] * pi0;
                    const float b_ = im ? -(cr1[ii] * pi1 + ci1[ii] * pr1) : cr1[ii] * pr1 - ci1[ii] * pi1;
                    dst[(size_t)(t * 16 + iq + ii) * 128] = pk2(a_, b_);
                }
            }
        }
        __syncthreads();
    }
}

#ifndef RW2_SHIFT
#define RW2_SHIFT 0
#endif
#define RW2_MASK ((1 << RW2_SHIFT) - 1)
__device__ __forceinline__ void phase_60(CParams& P, unsigned char* lds, const int ph) {
    PHASE_PROLOGUE
    if ((bid & RW2_MASK) == 0 && (bid >> RW2_SHIFT) < 32) {
        if (ph == 260 || ph == 360 || ph == 460) return;
        const int chain = bid >> RW2_SHIFT, d = chain >> 4, b = (chain >> 3) & 1, h = chain & 7;
        const int fr = lane & 15, fq = lane >> 4;
        constexpr int MATB = 64 * RWS * 2, SLOT = 4 * MATB;
        bf16_t* ybuf = (bf16_t*)(lds + 3 * SLOT);
        const bool comp = wave < 4; const int vb = wave & 3, lm = wave & 3;
        const unsigned char* src = (const unsigned char*)(lm == 0 ? PP : (lm == 1 ? YT : QT)) + (size_t)chain * RW_NCH * 8192 + lane * 16;
        u32x4 R0[8], R1[8], R2[8];
#define RW2_LD(Rx, c_) do { if (lm < 3) { _Pragma("unroll") for (int i_ = 0; i_ < 8; ++i_) Rx[i_] = __builtin_nontemporal_load((const u32x4*)(src + (size_t)(c_) * 8192 + i_ * 1024)); } } while (0)
#define RW2_ST(Rx, c_) do { if (lm < 3) { unsigned char* dst_ = lds + ((c_) % 3) * SLOT + lm * MATB; _Pragma("unroll") for (int i_ = 0; i_ < 8; ++i_) { const int p_ = lane + 64 * i_; *(u32x4*)(dst_ + (p_ >> 3) * (RWS * 2) + (p_ & 7) * 16) = Rx[i_]; } } } while (0)
#define RW2_FLUSH(c_) do { const int tl_ = 16 * lm + (lane >> 2), s_ = (c_) * 64 + tl_; const bf16_t* yb_ = ybuf + ((c_) & 1) * 64 * RWS + tl_ * RWS + 16 * (lane & 3); \
            const u32x4 y0_ = *(const u32x4*)yb_, y1_ = *(const u32x4*)(yb_ + 8); \
            if (s_ < LSEQ) { const int p_ = d ? LSEQ - 1 - s_ : s_; bf16_t* g_ = YFB + ((size_t)d * NT + rowof(b, p_)) * 512 + h * 64 + 16 * (lane & 3); *(u32x4*)g_ = y0_; *(u32x4*)(g_ + 8) = y1_; } } while (0)
        const f32x4 zero4 = (f32x4){0.f, 0.f, 0.f, 0.f};
        f32x4 S[4] = {zero4, zero4, zero4, zero4};
#define RW2_COMPUTE(c_) do { const bf16_t* sl_ = (const bf16_t*)(lds + ((c_) % 3) * SLOT); const bf16_t* sP = sl_; const bf16_t* sY = sl_ + 64 * RWS; const bf16_t* sQ = sl_ + 2 * 64 * RWS; const bf16_t* sZ = sl_ + 3 * 64 * RWS; \
            bf16_t* yo_ = ybuf + ((c_) & 1) * 64 * RWS + 16 * vb + fr; \
            union { bf16x8 v; unsigned u[4]; } bs[2]; \
            _Pragma("unroll") for (int ks = 0; ks < 2; ++ks) { bs[ks].u[0] = pk2(S[2 * ks][0], S[2 * ks][1]); bs[ks].u[1] = pk2(S[2 * ks][2], S[2 * ks][3]); \
                bs[ks].u[2] = pk2(S[2 * ks + 1][0], S[2 * ks + 1][1]); bs[ks].u[3] = pk2(S[2 * ks + 1][2], S[2 * ks + 1][3]); } \
            _Pragma("unroll") for (int tt = 0; tt < 4; ++tt) { \
                f32x4 acc = zero4; \
                acc = __builtin_amdgcn_mfma_f32_16x16x32_bf16(*(const bf16x8*)(sY + (16 * tt + fr) * RWS + 8 * fq), bs[0].v, acc, 0, 0, 0); \
                acc = __builtin_amdgcn_mfma_f32_16x16x32_bf16(*(const bf16x8*)(sY + (16 * tt + fr) * RWS + 32 + 8 * fq), bs[1].v, acc, 0, 0, 0); \
                _Pragma("unroll") for (int j = 0; j < 4; ++j) yo_[(16 * tt + 4 * fq + j) * RWS] = (bf16_t)f2bf(acc[j]); } \
            f32x4 Sn[4]; \
            _Pragma("unroll") for (int kt = 0; kt < 4; ++kt) { \
                const u32x2 q2 = *(const u32x2*)(sQ + (16 * vb + fr) * RWS + 16 * kt + 4 * fq); \
                f32x4 acc = (f32x4){bflo(q2.x), bfhi(q2.x), bflo(q2.y), bfhi(q2.y)}; \
                acc = __builtin_amdgcn_mfma_f32_16x16x32_bf16(*(const bf16x8*)(sP + (16 * kt + fr) * RWS + 8 * fq), bs[0].v, acc, 0, 0, 0); \
                acc = __builtin_amdgcn_mfma_f32_16x16x32_bf16(*(const bf16x8*)(sP + (16 * kt + fr) * RWS + 32 + 8 * fq), bs[1].v, acc, 0, 0, 0); \
                Sn[kt] = acc; } \
            _Pragma("unroll") for (int kt = 0; kt < 4; ++kt) S[kt] = Sn[kt]; } while (0)
#define RW2_BAR() do { asm volatile("s_waitcnt lgkmcnt(0)" ::: "memory"); __builtin_amdgcn_s_barrier(); asm volatile("" ::: "memory"); } while (0)
        if (!comp) { RW2_LD(R0, 0); RW2_ST(R0, 0); RW2_LD(R0, 1); RW2_LD(R1, 2); RW2_LD(R2, 3); }
        __syncthreads();
        for (int c = 0; c < RW_NCH; c += 3) {
            if (!comp) { if (c + 1 < RW_NCH) RW2_ST(R0, c + 1); if (c + 4 < RW_NCH) RW2_LD(R0, c + 4); if (c > 0) RW2_FLUSH(c - 1); } else RW2_COMPUTE(c);
            RW2_BAR();
            if (!comp) { if (c + 2 < RW_NCH) RW2_ST(R1, c + 2); if (c + 5 < RW_NCH) RW2_LD(R1, c + 5); RW2_FLUSH(c); } else RW2_COMPUTE(c + 1);
            RW2_BAR();
            if (!comp) { if (c + 3 < RW_NCH) RW2_ST(R2, c + 3); if (c + 6 < RW_NCH) RW2_LD(R2, c + 6); RW2_FLUSH(c + 1); } else RW2_COMPUTE(c + 2);
            RW2_BAR();
        }
        if (!comp) RW2_FLUSH(RW_NCH - 1);
#undef RW2_LD
#undef RW2_ST
#undef RW2_FLUSH
#undef RW2_COMPUTE
#undef RW2_BAR
    } else {
        const int j_ = RW2_SHIFT ? bid - 1 - (bid >> RW2_SHIFT) : bid - 32;
        if (ph == 60 || ph == 260 || ph == 460) na_units(P, lds, j_ & 7, j_ >> 3);
        if ((ph == 60 || ph == 360 || ph == 460) && j_ < 64) s5_setup_units(P, lds, j_, 64);
    }
}

__device__ __forceinline__ void phase_7(CParams& P, unsigned char* lds, const int ph) {
    PHASE_PROLOGUE
            for (int row = gw; row < NT; row += NGW) {
                const int c0 = lane * 8;
                const u32x4 yf = *(const u32x4*)(YFB + (size_t)row * 512 + c0);
                const u32x4 yb = *(const u32x4*)(YFB + ((size_t)NT + row) * 512 + c0);
                const u32x4 zf = *(const u32x4*)(ZT + (size_t)row * 512 + c0);
                const u32x4 zb = *(const u32x4*)(ZT + ((size_t)NT + row) * 512 + c0);
                const u32x4 vv = *(const u32x4*)(VV + (size_t)row * 512 + c0);
                const u32x4 gg = *(const u32x4*)(Gg + (size_t)row * 512 + c0);
                float y[8], v[8], g[8];
#pragma unroll
                for (int i = 0; i < 4; ++i) { y[2 * i] = (bflo(yf[i]) + bflo(zf[i])) + (bflo(yb[i]) + bflo(zb[i])); y[2 * i + 1] = (bfhi(yf[i]) + bfhi(zf[i])) + (bfhi(yb[i]) + bfhi(zb[i])); v[2 * i] = bflo(vv[i]); v[2 * i + 1] = bfhi(vv[i]); g[2 * i] = bflo(gg[i]); g[2 * i + 1] = bfhi(gg[i]); }
                float sm = 0.f;
#pragma unroll
                for (int i = 0; i < 8; ++i) sm += y[i];
                sm += __shfl_xor(sm, 1); sm += __shfl_xor(sm, 2); sm += __shfl_xor(sm, 4);
                const float mean = sm * (1.f / 64.f);
                float vr = 0.f;
#pragma unroll
                for (int i = 0; i < 8; ++i) { const float dlt = y[i] - mean; vr += dlt * dlt; }
                vr += __shfl_xor(vr, 1); vr += __shfl_xor(vr, 2); vr += __shfl_xor(vr, 4);
                const float rstd = rsqrtf(vr * (1.f / 64.f) + 64e-5f);
                const float bc = BC[(size_t)row * 8 + (lane >> 3)];
                float o[8];
#pragma unroll
                for (int i = 0; i < 8; ++i) o[i] = ((y[i] - mean) * rstd * lnx_g[c0 + i] + lnx_b[c0 + i] + bc * v[i]) * g[i];
                u32x4 ov; ov.x = pk2(o[0], o[1]); ov.y = pk2(o[2], o[3]); ov.z = pk2(o[4], o[5]); ov.w = pk2(o[6], o[7]);
                *(u32x4*)(A2 + (size_t)row * DM + 512 + c0) = ov;
            }
}


__device__ __forceinline__ void phase_8(CParams& P, unsigned char* lds, const int ph) {
    PHASE_PROLOGUE
    bf16_t* Hd = ph == 108 ? (bf16_t*)(ws + WS_BIG) : H;
    if (bid < 64) meta_gemm<0>(A2 + (size_t)NMAIN * DM, WTOUT, Hd + (size_t)NMAIN * DM, bid, wave, lane, lds);
    pg8::DenseOrder S; S.init(A2, WTOUT, NMAIN, DM, DM, G, bid);
    pg8::EpiResidual E{Hd};
    pg8::gemm_phase<pg8::EpiResidual, pg8::DenseOrder, true, true>((PG8_LAS unsigned char*)lds, DM, S, E);
}

#ifndef ROUTE_WAVES
#define ROUTE_WAVES 6
#endif
__device__ __forceinline__ void phase_9(CParams& P, unsigned char* lds, const int ph) {
    PHASE_PROLOGUE
            const int l = (ph == 9 || ph == 109 || ph == 209 || ph == 309) ? 0 : 1;
                    for (int i = bid * 512 + tid; i < MOE_MAXROWS; i += G * 512) ROWTOK[i] = 0;
    __attribute__((address_space(3))) int* lcnt = (__attribute__((address_space(3))) int*)lds;
    if (tid < NEXP + 2) lcnt[tid] = 0;
            const float* wg = moe_wg + (size_t)l * DM * 4; const float* bg = moe_bg + l * 4;
    __attribute__((address_space(3))) f32x4* wgL = (__attribute__((address_space(3))) f32x4*)(lds + 1024);
    __attribute__((address_space(3))) f32x4* weL = (__attribute__((address_space(3))) f32x4*)(lds + 1024 + 16384);
    for (int k = tid; k < DM; k += 512) wgL[((k >> 8) * 4 + (k & 3)) * 64 + ((k >> 2) & 63)] = *(const f32x4*)(wg + (size_t)k * 4);
    for (int t = tid; t < 4 * DM; t += 512) { const int grp_ = t >> 10, k = t & 1023, s_ = (k >> 8) * 4 + (k & 3), ln_ = (k >> 2) & 63; const float* src_ = moe_we + ((size_t)(l * 4 + grp_) * DM + k) * 8;
        weL[((grp_ * 2 + 0) * 16 + s_) * 64 + ln_] = *(const f32x4*)src_; weL[((grp_ * 2 + 1) * 16 + s_) * 64 + ln_] = *(const f32x4*)(src_ + 4); }
    f32x4 gain[4];
#pragma unroll
    for (int j = 0; j < 4; ++j) gain[j] = ((const f32x4*)(norm_ffn + l * DM))[lane + 64 * j];
    __syncthreads();
    int first = 0;
    if (l == 1) {
        const int c = lane < NEXP ? (int)CTL[CW_CNT(0) + lane] : 0; const int tt = (int)wave_sum((float)((c + MOE_RT - 1) / MOE_RT));
        const int r = (4 * tt - 1) & (GRID - 1);
        first = FILL_A + (GRID - 1 - r) * 8 * (FILL_Q11 + FILL_Q12);
    }
    const int nrows = (ph == 109 || ph == 209 || ph == 309) ? 0 : (NT - bid + GRID - 1) / GRID;
    const int nconv = ph == 117 ? 0 : CONV_MOE_ITEMS - first;
    const int wv_ = __builtin_amdgcn_readfirstlane(wave);
#define P9_TAKE(which_) ({ int q_ = 0; if (lane == 0) q_ = __hip_atomic_fetch_add(lcnt + NEXP + (which_), 1, __ATOMIC_RELAXED, __HIP_MEMORY_SCOPE_WORKGROUP); __builtin_amdgcn_readfirstlane(q_); })
#pragma unroll 1
    for (int pass = 0; pass < 2; ++pass) {
        if ((wv_ < ROUTE_WAVES) != (pass == 0)) {
            for (;;) {
                const int q_ = P9_TAKE(1), o_ = bid * 8 + (q_ & 7) + GRID * 8 * (q_ >> 3);
                if (o_ >= nconv) break;
                if (ph == 109) conv_moe_item<1>(P, l, first + o_, lane); else if (ph == 209) conv_moe_item<2>(P, 1, first + o_, lane); else conv_moe_item(P, l, first + o_, lane);
            }
            continue;
        }
        int cur = P9_TAKE(0);
        u32x2 hv[4];
#pragma unroll
        for (int j = 0; j < 4; ++j) hv[j] = ((const u32x2*)(H + (size_t)(bid + GRID * (cur < nrows ? cur : 0)) * DM))[lane + 64 * j];
            while (cur < nrows) {
                const int row = bid + GRID * cur;
                const int nxt = P9_TAKE(0);
                u32x2 hn[4];
#pragma unroll
                for (int j = 0; j < 4; ++j) hn[j] = ((const u32x2*)(H + (size_t)(bid + GRID * (nxt < nrows ? nxt : 0)) * DM))[lane + 64 * j];
                f32x4 v[4]; float ss = 0.f;
#pragma unroll
                for (int j = 0; j < 4; ++j) { v[j] = (f32x4){bflo(hv[j].x), bfhi(hv[j].x), bflo(hv[j].y), bfhi(hv[j].y)}; ss += v[j][0] * v[j][0] + v[j][1] * v[j][1] + v[j][2] * v[j][2] + v[j][3] * v[j][3]; }
                ss = wave_sum(ss);
                const float rstd = rsqrtf(ss * (1.f / DM) + 1e-6f);
                float lg[4] = {0.f, 0.f, 0.f, 0.f};
#pragma unroll
                for (int j = 0; j < 4; ++j) {
#pragma unroll
                    for (int i = 0; i < 4; ++i) v[j][i] = v[j][i] * rstd * gain[j][i];
                    u32x2 o; o.x = pk2(v[j][0], v[j][1]); o.y = pk2(v[j][2], v[j][3]);
                    ((u32x2*)(HN + (size_t)row * DM))[lane + 64 * j] = o;
#pragma unroll
                    for (int i = 0; i < 4; ++i) { const f32x4 w = wgL[(j * 4 + i) * 64 + lane];
                        lg[0] += v[j][i] * w[0]; lg[1] += v[j][i] * w[1]; lg[2] += v[j][i] * w[2]; lg[3] += v[j][i] * w[3]; }
                }
#pragma unroll
                for (int q = 0; q < 4; ++q) lg[q] = wave_sum(lg[q]) + bg[q];
                int grp = 0; float mx = lg[0];
#pragma unroll
                for (int q = 1; q < 4; ++q) if (lg[q] > mx) { mx = lg[q]; grp = q; }
                float den = 0.f;
#pragma unroll
                for (int q = 0; q < 4; ++q) den += __expf(lg[q] - mx);
                const float pgrp = 1.f / den;
                float le[8] = {0.f, 0.f, 0.f, 0.f, 0.f, 0.f, 0.f, 0.f};
#pragma unroll
                for (int j = 0; j < 4; ++j)
#pragma unroll
                    for (int i = 0; i < 4; ++i) { const f32x4 wa = weL[((grp * 2 + 0) * 16 + j * 4 + i) * 64 + lane], wb = weL[((grp * 2 + 1) * 16 + j * 4 + i) * 64 + lane];
                        le[0] += v[j][i] * wa[0]; le[1] += v[j][i] * wa[1]; le[2] += v[j][i] * wa[2]; le[3] += v[j][i] * wa[3];
                        le[4] += v[j][i] * wb[0]; le[5] += v[j][i] * wb[1]; le[6] += v[j][i] * wb[2]; le[7] += v[j][i] * wb[3]; }
#pragma unroll
                for (int q = 0; q < 8; ++q) le[q] = wave_sum(le[q]) + moe_be[(l * 4 + grp) * 8 + q];
                int i1 = 0; float m1 = le[0];
#pragma unroll
                for (int q = 1; q < 8; ++q) if (le[q] > m1) { m1 = le[q]; i1 = q; }
                int i2 = (i1 + 1) & 7; float m2 = -3.0e38f;
#pragma unroll
                for (int q = 0; q < 8; ++q) if (q != i1 && le[q] > m2) { m2 = le[q]; i2 = q; }
                const float e2 = __expf(m2 - m1);
                const float g1 = pgrp / (1.f + e2), g2 = pgrp * e2 / (1.f + e2);
                if (lane == 0) {
                    const int ea = grp * 8 + i1, eb = grp * 8 + i2;
                    const int pa = __hip_atomic_fetch_add(lcnt + ea, 1, __ATOMIC_RELAXED, __HIP_MEMORY_SCOPE_WORKGROUP), pb = __hip_atomic_fetch_add(lcnt + eb, 1, __ATOMIC_RELAXED, __HIP_MEMORY_SCOPE_WORKGROUP);
                    EID[row * 2] = ea; EID[row * 2 + 1] = eb; POS[row * 2] = (int)pa; POS[row * 2 + 1] = (int)pb;
                    GATE[row * 2] = g1; GATE[row * 2 + 1] = g2;
                }
#pragma unroll
                for (int j = 0; j < 4; ++j) hv[j] = hn[j];
                cur = nxt;
            }
    }
#undef P9_TAKE
    __syncthreads();
    if (tid < NEXP && !(ph == 109 || ph == 209 || ph == 309)) CTL[CW_WGC + bid * NEXP + tid] = (unsigned)lcnt[tid];
}


__device__ __forceinline__ void phase_10(CParams& P, unsigned char* lds, const int ph) {
    PHASE_PROLOGUE
    const int l = ph == 10 ? 0 : 1;
    int* T = (int*)lds;
    int* psum = (int*)(lds + 32768);
    int* tots = (int*)(lds + 32768 + 2048);
    int* ps = (int*)(lds + LDS_TAB);
    {
        const int e = tid & 31, part = tid >> 5;
        int c[16]; int s_ = 0;
#pragma unroll
        for (int k = 0; k < 16; ++k) c[k] = (int)CTL[CW_WGC + (part * 16 + k) * NEXP + e];
#pragma unroll
        for (int k = 0; k < 16; ++k) s_ += c[k];
        psum[part * 32 + e] = s_;
        __syncthreads();
        int off = 0, tot = 0;
#pragma unroll
        for (int p_ = 0; p_ < 16; ++p_) { const int v = psum[p_ * 32 + e]; off += p_ < part ? v : 0; tot += v; }
#pragma unroll
        for (int k = 0; k < 16; ++k) { T[(part * 16 + k) * 32 + e] = off; off += c[k]; }
        if (part == 0) { tots[e] = tot; if (bid == 0) CTL[CW_CNT(l) + e] = (unsigned)tot; }
    }
    __syncthreads();
    if (tid == 0) { int acc_ = 0; for (int e = 0; e < NEXP; ++e) { ps[e] = acc_; acc_ += (tots[e] + MOE_RT - 1) / MOE_RT * MOE_RT; } ps[NEXP] = acc_; }
    __syncthreads();
    for (int i = bid * 512 + tid; i < NT * 2; i += G * 512) { const int row = i >> 1, w = row & (GRID - 1), e = EID[i]; const int dest = ps[e] + T[w * 32 + e] + POS[i]; DEST[i] = dest; ROWTOK[dest] = row; }
    __syncthreads();
}

__device__ __forceinline__ void phase_11(CParams& P, unsigned char* lds, const int ph) {
    PHASE_PROLOGUE
    const int l = (ph == 11 || ph == 111) ? 0 : 1;
    int* et = (int*)(lds + LDS_TAB);
    if (tid == 0) { int acc_ = 0; for (int e = 0; e < NEXP; ++e) { const int c = (int)CTL[CW_CNT(l) + e], n = (c + MOE_RT - 1) / MOE_RT; for (int q = 0; q < n; ++q) et[1 + acc_ + q] = e; acc_ += n; } et[0] = acc_; }
    __syncthreads();
    const int nun = et[0] * 4;
    pg8::MoeOrder<true> S{et + 1, et[0], vcu, (const char*)HN, (const char*)(l ? ws + WS_WT13B : ws + WS_WT13), 256u * DM * 2u, 256u * DM * 2u, (unsigned)DM * DM * 2u, ROWTOK, bid};
    pg8::EpiSwiglu E{HB};
    pg8::gemm_phase<pg8::EpiSwiglu, pg8::MoeOrder<true>, true, true>((PG8_LAS unsigned char*)lds, DM, S, E);
    __syncthreads();
    { const int r = (nun - 1) & (GRID - 1);
      if (ph == 11 && bid > r) conv_range(P, FILL_A + ((bid - r - 1) * 8 + wave) * FILL_Q11, FILL_Q11, lane); }
}

__device__ __forceinline__ void phase_12(CParams& P, unsigned char* lds, const int ph) {
    PHASE_PROLOGUE
    const int l = (ph == 12 || ph == 112) ? 0 : 1;
    int* et = (int*)(lds + LDS_TAB);
    if (tid == 0) { int acc_ = 0; for (int e = 0; e < NEXP; ++e) { const int c = (int)CTL[CW_CNT(l) + e], n = (c + MOE_RT - 1) / MOE_RT; for (int q = 0; q < n; ++q) et[1 + acc_ + q] = e; acc_ += n; } et[0] = acc_; }
    __syncthreads();
    const int nun = et[0] * 4;
    pg8::MoeOrder<false> S{et + 1, et[0], vcu, (const char*)HB, (const char*)(l ? ws + WS_WT2B : ws + WS_WT2), 256u * DFF * 2u, 256u * DFF * 2u, (unsigned)DM * DFF * 2u, nullptr, bid};
    pg8::EpiBf16Plain E{YB, DM};
    pg8::gemm_phase<pg8::EpiBf16Plain, pg8::MoeOrder<false>, true, true>((PG8_LAS unsigned char*)lds, DFF, S, E);
    __syncthreads();
    { const int r = (nun - 1) & (GRID - 1);
      if (ph == 12 && bid > r) conv_range(P, FILL_A + (GRID - 1 - r) * 8 * FILL_Q11 + ((bid - r - 1) * 8 + wave) * FILL_Q12, FILL_Q12, lane); }
}

__device__ __forceinline__ void phase_13(CParams& P, unsigned char* lds, const int ph) {
    PHASE_PROLOGUE
            const bool fin = ph == 21 || ph == 121;
            bf16_t* Hw = (ph == 113) ? (bf16_t*)(ws + WS_WT13) : H;
            for (int row = gw; row < NT; row += NGW) {
                const int d0 = DEST[row * 2], d1 = DEST[row * 2 + 1];
                const float g0 = GATE[row * 2], g1 = GATE[row * 2 + 1];
                f32x4 v[4];
#pragma unroll
                for (int j = 0; j < 4; ++j) {
                    v[j] = ldrow_bf16(H + (size_t)row * DM, lane, j);
                    const u32x2 ya = ((const u32x2*)(YB + (size_t)d0 * DM))[lane + 64 * j];
                    const u32x2 yb = ((const u32x2*)(YB + (size_t)d1 * DM))[lane + 64 * j];
                    v[j][0] += g0 * bflo(ya.x) + g1 * bflo(yb.x); v[j][1] += g0 * bfhi(ya.x) + g1 * bfhi(yb.x);
                    v[j][2] += g0 * bflo(ya.y) + g1 * bflo(yb.y); v[j][3] += g0 * bfhi(ya.y) + g1 * bfhi(yb.y);
                }
                if (!fin) {
#pragma unroll
                    for (int j = 0; j < 4; ++j) strow_bf16(Hw + (size_t)row * DM, lane, j, v[j]);
                    store_norm_bf16(v, norm_mix + DM, HN + (size_t)row * DM, lane);
                } else if (row < NMAIN) {
                    float ss = 0.f;
#pragma unroll
                    for (int j = 0; j < 4; ++j) ss += v[j][0] * v[j][0] + v[j][1] * v[j][1] + v[j][2] * v[j][2] + v[j][3] * v[j][3];
                    ss = wave_sum(ss);
                    const float rstd = rsqrtf(ss * (1.f / DM) + 1e-6f);
#pragma unroll
                    for (int j = 0; j < 4; ++j) { const f32x4 g = ((const f32x4*)norm_final)[lane + 64 * j]; f32x4 o;
                        o[0] = v[j][0] * rstd * g[0]; o[1] = v[j][1] * rstd * g[1]; o[2] = v[j][2] * rstd * g[2]; o[3] = v[j][3] * rstd * g[3];
                        __builtin_nontemporal_store(o, (f32x4*)(P.out + (size_t)row * DM) + lane + 64 * j); }
                }
            }
}

__device__ __forceinline__ void phase_15(CParams& P, unsigned char* lds, const int ph) {
    PHASE_PROLOGUE
    pg8::S5OrderA S{vcu, (const char*)HN, (const char*)BTA};
    pg8::EpiS5A E{YI, S5E};
    int Kr = 256; asm volatile("" : "+s"(Kr));
    pg8::gemm_phase<pg8::EpiS5A, pg8::S5OrderA, true, true>((PG8_LAS unsigned char*)lds, Kr, S, E);
    if (bid < 64) s5_meta_rows<0>(HN, nullptr, BTA + (size_t)bid * 512 * 256, YI, S5E, nullptr, nullptr, bid, wave, lane);
}

__device__ __forceinline__ void phase_16(CParams& P, unsigned char* lds, const int ph) {
    PHASE_PROLOGUE
    float* Ls = (float*)lds;
    for (int wg = bid; wg < NB * 64 * 2; wg += G) {
        const int d = wg & 1, g = (wg >> 1) & 63, b = wg >> 7, p = lane;
        const float step = __expf(s5_ls[d * 64 + g]);
        const float lr = s5_lre[(d * 64 + g) * 64 + p], li = s5_lim[(d * 64 + g) * 64 + p];
        const float mag = expf(lr * step);
        const float abr = mag * cosf(li * step), abi = mag * sinf(li * step);
        float ar = 1.f, ai = 0.f;
        for (int t = 0; t < 16; ++t) { const float nr = ar * abr - ai * abi; ai = ar * abi + ai * abr; ar = nr; }
        float Ar = 1.f, Ai = 0.f;
        for (int t = 0; t < 64; ++t) { const float nr = Ar * ar - Ai * ai; Ai = Ar * ai + Ai * ar; Ar = nr; }
        const bf16_t* Ep = S5E + (size_t)g * 256 + d * 128 + p;
        bf16_t* Cp = CAR + (size_t)g * 1280 * 256 + d * 128 + p;
        const int q0 = 64 * wave;
#define S5_N(q_) ({ const int c_ = d ? 512 - (q_) : (q_); c_ == 0 ? 1024 + b : b * 512 + c_ - 1; })
        float sr = 0.f, si = 0.f;
#pragma unroll 1
        for (int hb = 0; hb < 2; ++hb) {
            float er[32], ei[32];
#pragma unroll
            for (int k = 0; k < 32; ++k) { const int n = S5_N(q0 + 32 * hb + k); er[k] = bf2f(Ep[(size_t)n * 64 * 256]); ei[k] = bf2f(Ep[(size_t)n * 64 * 256 + 64]); }
#pragma unroll
            for (int k = 0; k < 32; ++k) { const float nr = ar * sr - ai * si + er[k]; si = ar * si + ai * sr + ei[k]; sr = nr; }
        }
        Ls[(wave * 64 + p) * 2] = sr; Ls[(wave * 64 + p) * 2 + 1] = si;
        __syncthreads();
        sr = 0.f; si = 0.f;
        for (int w2 = 0; w2 < wave; ++w2) { const float l0 = Ls[(w2 * 64 + p) * 2], l1 = Ls[(w2 * 64 + p) * 2 + 1]; const float nr = Ar * sr - Ai * si + l0; si = Ar * si + Ai * sr + l1; sr = nr; }
#pragma unroll 1
        for (int hb = 0; hb < 2; ++hb) {
            float er[32], ei[32]; int nn[32];
#pragma unroll
            for (int k = 0; k < 32; ++k) { nn[k] = S5_N(q0 + 32 * hb + k); er[k] = bf2f(Ep[(size_t)nn[k] * 64 * 256]); ei[k] = bf2f(Ep[(size_t)nn[k] * 64 * 256 + 64]); }
#pragma unroll
            for (int k = 0; k < 32; ++k) { Cp[(size_t)nn[k] * 256] = (bf16_t)f2bf(sr); Cp[(size_t)nn[k] * 256 + 64] = (bf16_t)f2bf(si);
                const float nr = ar * sr - ai * si + er[k]; si = ar * si + ai * sr + ei[k]; sr = nr; }
        }
        if (wave == 7) { const int n = S5_N(512); Cp[(size_t)n * 256] = (bf16_t)f2bf(sr); Cp[(size_t)n * 256 + 64] = (bf16_t)f2bf(si); }
#undef S5_N
        __syncthreads();
    }
}

__device__ __forceinline__ void phase_22(CParams& P, unsigned char* lds, const int ph) {
    PHASE_PROLOGUE
    pg8::S5OrderC S{vcu, (const char*)CAR, (const char*)BTC};
    pg8::EpiS5C E{YI, HN, s5_d, A2};
    int Kr = 256; asm volatile("" : "+s"(Kr));
    pg8::gemm_phase<pg8::EpiS5C, pg8::S5OrderC, true, true>((PG8_LAS unsigned char*)lds, Kr, S, E);
    if (bid < 64) s5_meta_rows<1>(HN, CAR + (size_t)bid * 1280 * 256, BTC + (size_t)bid * 256 * 256, YI, nullptr, s5_d, A2, bid, wave, lane);
}

__device__ __forceinline__ void phase_23(CParams& P, unsigned char* lds, const int ph) {
    PHASE_PROLOGUE
    bf16_t* Hd = ph == 123 ? (bf16_t*)(ws + WS_BIG) : H;
    if (bid < 64) meta_gemm<1>(A2 + (size_t)NMAIN * DM, WTGLU, Hd + (size_t)NMAIN * DM, bid, wave, lane, lds);
    pg8::DenseOrder S; S.init(A2, WTGLU, NMAIN, 2 * DM, DM, G, bid);
    pg8::EpiGlu E{Hd};
    pg8::gemm_phase<pg8::EpiGlu, pg8::DenseOrder, true, true>((PG8_LAS unsigned char*)lds, DM, S, E);
}
#define LAS __attribute__((address_space(3)))
#define CW_BAR 4096
#define XB_TMO      128
#define XB_XCNT(j)  (256  + 64 * (j))
#define XB_XSUB(j)  (1280 + 64 * (j))
#define XB_XGEN(j)  (2304 + 64 * (j))
#define XB_TOP      3328
#define XB_TOPGEN   3392
#define XCD_BAR_WORDS 3456
#define XB_SPIN_CAP (1u << 22)
__device__ __forceinline__ unsigned xb_ld(unsigned* p)              { return __hip_atomic_load(p, __ATOMIC_RELAXED, __HIP_MEMORY_SCOPE_AGENT); }
__device__ __forceinline__ unsigned xb_add(unsigned* p, unsigned v) { return __hip_atomic_fetch_add(p, v, __ATOMIC_RELAXED, __HIP_MEMORY_SCOPE_AGENT); }
__device__ __forceinline__ unsigned xb_xcc_id() { return (unsigned)__builtin_amdgcn_s_getreg((3 << 11) | 20) & 0xFu; }
#define XB_SPIN(cond, bar) do { unsigned _sp = 0; while (cond) { __builtin_amdgcn_s_sleep(1); \
    if ((++_sp & 255u) == 0u) { if (xb_ld(&(bar)[XB_TMO])) break; if (_sp > XB_SPIN_CAP) { atomicAdd(&(bar)[XB_TMO], 1u); break; } } } } while (0)
struct XcdBarrier { unsigned* bar; unsigned x; volatile LAS unsigned* st; };
__device__ __forceinline__ XcdBarrier xcd_barrier_post(unsigned* bar, volatile LAS unsigned* st) {
    XcdBarrier b; b.bar = bar; b.x = xb_xcc_id(); b.st = st;
    if (threadIdx.x == 0) (void)xb_add(&bar[XB_XCNT(b.x)], 1u);
    return b;
}
__device__ __forceinline__ void xcd_barrier_complete(unsigned* bar, unsigned x, unsigned& nloc, unsigned& nx) {
    const unsigned G = GRID;
    unsigned sum, cnt, mine, sp = 0u;
    for (;;) {
        sum = 0u; cnt = 0u; mine = 0u;
#pragma unroll
        for (unsigned j = 0; j < 16; ++j) { const unsigned c = xb_ld(&bar[XB_XCNT(j)]); sum += c; cnt += (c > 0u) ? 1u : 0u; mine = (j == x) ? c : mine; }
        if (sum == G) break;
        __builtin_amdgcn_s_sleep(1);
        if ((++sp & 255u) == 0u) { if (xb_ld(&bar[XB_TMO])) break; if (sp > XB_SPIN_CAP) { atomicAdd(&bar[XB_TMO], 1u); break; } }
    }
    nloc = mine > 0u ? mine : 1u; nx = cnt > 0u ? cnt : 1u;
}
__device__ __forceinline__ void xcd_barrier(const XcdBarrier& b) {
    asm volatile("s_waitcnt vmcnt(0)" ::: "memory");
    __syncthreads();
    if (threadIdx.x == 0) {
        unsigned* bar = b.bar;
        __builtin_amdgcn_s_waitcnt(0);
        unsigned nloc = b.st[0], nx = b.st[1];
        if (nloc == 0u) { xcd_barrier_complete(bar, b.x, nloc, nx); b.st[0] = nloc; b.st[1] = nx; }
        const unsigned old = xb_add(&bar[XB_XSUB(b.x)], 1u);
        const unsigned gen = old / nloc;
        if (old + 1u == (gen + 1u) * nloc) {
            __builtin_amdgcn_fence(__ATOMIC_RELEASE, "agent");
            asm volatile("s_waitcnt vmcnt(0)" ::: "memory");
            const unsigned og = xb_add(&bar[XB_TOP], 1u);
            const unsigned tg = og / nx;
            if (og + 1u == (tg + 1u) * nx) xb_add(&bar[XB_TOPGEN], 1u);
            else XB_SPIN(xb_ld(&bar[XB_TOPGEN]) == tg, bar);
            __builtin_amdgcn_fence(__ATOMIC_ACQUIRE, "agent");
            xb_add(&bar[XB_XGEN(b.x)], 1u);
            asm volatile("s_waitcnt vmcnt(0)" ::: "memory");
        } else {
            XB_SPIN(xb_ld(&bar[XB_XGEN(b.x)]) == gen, bar);
            __builtin_amdgcn_fence(__ATOMIC_ACQUIRE, "agent");
            asm volatile("s_waitcnt vmcnt(0)" ::: "memory");
        }
    }
    __syncthreads();
}


__global__ void __launch_bounds__(512, 2) mega(Params P_) {
    extern __shared__ __attribute__((aligned(16))) unsigned char lds[];
    volatile LAS unsigned* st = (volatile LAS unsigned*)(LAS unsigned char*)(lds + LDS_BARST);
    if (threadIdx.x < 16) st[threadIdx.x] = 0u;
    __syncthreads();
    CParams* pp = (CParams*)__builtin_amdgcn_kernarg_segment_ptr();
    (void)xcd_barrier_post((unsigned*)(pp->ws + WS_CTL) + CW_BAR, st);
#define GB do { XcdBarrier bar_; bar_.bar = (unsigned*)(pp->ws + WS_CTL) + CW_BAR; bar_.x = xb_xcc_id(); bar_.st = (volatile LAS unsigned*)(LAS unsigned char*)(lds + LDS_BARST); xcd_barrier(bar_); asm volatile("" : "+s"(pp)); } while (0)
#define P (*pp)
    asm volatile("" : "+s"(pp));
    phase_0(P, lds, 0); GB;
#if defined(PROBE_PH) && PROBE_PH == 0
    { int nrep = PROBE_N; asm volatile("" : "+s"(nrep)); for (int rep = 0; rep < nrep; ++rep) { GB; phase_0(P, lds, 0); GB; } }
#endif
    phase_1(P, lds, 1); GB;
#if defined(PROBE_PH) && PROBE_PH == 1
    { int nrep = PROBE_N; asm volatile("" : "+s"(nrep)); for (int rep = 0; rep < nrep; ++rep) { GB; phase_1(P, lds, 1); GB; } }
#endif
    phase_3(P, lds, 3); GB;
#if defined(PROBE_PH) && PROBE_PH == 3
    { int nrep = PROBE_N; asm volatile("" : "+s"(nrep)); for (int rep = 0; rep < nrep; ++rep) { GB; phase_3(P, lds, 3); GB; } }
#endif
    phase_6(P, lds, 6); GB;
#if defined(PROBE_PH) && (PROBE_PH == 60 || PROBE_PH == 160 || PROBE_PH == 260 || PROBE_PH == 360 || PROBE_PH == 460)
    { int nrep = PROBE_N; asm volatile("" : "+s"(nrep)); for (int rep = 0; rep <= nrep; ++rep) { int ph_ = rep ? PROBE_PH : 60; asm volatile("" : "+s"(ph_)); phase_60(P, lds, ph_); GB; GB; } }
#else
    phase_60(P, lds, 60); GB;
#endif
#if defined(PROBE_PH) && PROBE_PH == 6
    { int nrep = PROBE_N; asm volatile("" : "+s"(nrep)); for (int rep = 0; rep < nrep; ++rep) { GB; phase_6(P, lds, 6); GB; } }
#endif
    phase_7(P, lds, 7); GB;
#if defined(PROBE_PH) && PROBE_PH == 7
    { int nrep = PROBE_N; asm volatile("" : "+s"(nrep)); for (int rep = 0; rep < nrep; ++rep) { GB; phase_7(P, lds, 7); GB; } }
#endif
    phase_8(P, lds, 8); GB;
#if defined(PROBE_PH) && (PROBE_PH == 108)
    { int nrep = PROBE_N; asm volatile("" : "+s"(nrep)); for (int rep = 0; rep < nrep; ++rep) { GB; phase_8(P, lds, PROBE_PH); GB; } }
#endif
    phase_9(P, lds, 9); GB;
#if defined(PROBE_PH) && (PROBE_PH == 9 || PROBE_PH == 109 || PROBE_PH == 209 || PROBE_PH == 309)
    { int nrep = PROBE_N; asm volatile("" : "+s"(nrep)); for (int rep = 0; rep < nrep; ++rep) { GB; phase_9(P, lds, PROBE_PH); GB; } }
#endif
    phase_10(P, lds, 10); GB;
#if defined(PROBE_PH) && PROBE_PH == 10
    { int nrep = PROBE_N; asm volatile("" : "+s"(nrep)); for (int rep = 0; rep < nrep; ++rep) { GB; phase_10(P, lds, 10); GB; } }
#endif
    phase_11(P, lds, 11); GB;
#if defined(PROBE_PH) && (PROBE_PH == 111)
    { int nrep = PROBE_N; asm volatile("" : "+s"(nrep)); for (int rep = 0; rep < nrep; ++rep) { GB; phase_11(P, lds, PROBE_PH); GB; } }
#endif
    phase_12(P, lds, 12); GB;
#if defined(PROBE_PH) && (PROBE_PH == 112)
    { int nrep = PROBE_N; asm volatile("" : "+s"(nrep)); for (int rep = 0; rep < nrep; ++rep) { GB; phase_12(P, lds, PROBE_PH); GB; } }
#endif
    phase_13(P, lds, 13); GB;
#if defined(PROBE_PH) && (PROBE_PH == 113)
    { int nrep = PROBE_N; asm volatile("" : "+s"(nrep)); for (int rep = 0; rep < nrep; ++rep) { GB; phase_13(P, lds, PROBE_PH); GB; } }
#endif
    phase_15(P, lds, 15); GB;
#if defined(PROBE_PH) && PROBE_PH == 15
    { int nrep = PROBE_N; asm volatile("" : "+s"(nrep)); for (int rep = 0; rep < nrep; ++rep) { GB; phase_15(P, lds, 15); GB; } }
#endif
    phase_16(P, lds, 16); GB;
#if defined(PROBE_PH) && PROBE_PH == 16
    { int nrep = PROBE_N; asm volatile("" : "+s"(nrep)); for (int rep = 0; rep < nrep; ++rep) { GB; phase_16(P, lds, 16); GB; } }
#endif
    phase_22(P, lds, 22); GB;
#if defined(PROBE_PH) && PROBE_PH == 22
    { int nrep = PROBE_N; asm volatile("" : "+s"(nrep)); for (int rep = 0; rep < nrep; ++rep) { GB; phase_22(P, lds, 22); GB; } }
#endif
    phase_23(P, lds, 23); GB;
#if defined(PROBE_PH) && (PROBE_PH == 123)
    { int nrep = PROBE_N; asm volatile("" : "+s"(nrep)); for (int rep = 0; rep < nrep; ++rep) { GB; phase_23(P, lds, PROBE_PH); GB; } }
#endif
    phase_9(P, lds, 17); GB;
#if defined(PROBE_PH) && (PROBE_PH == 17 || PROBE_PH == 117)
    { int nrep = PROBE_N; asm volatile("" : "+s"(nrep)); for (int rep = 0; rep < nrep; ++rep) { GB; if (blockIdx.x == 0 && threadIdx.x < 32) ((unsigned*)(pp->ws + WS_CTL))[CW_CNT(1) + threadIdx.x] = 0u; GB; phase_9(P, lds, PROBE_PH); GB; } }
#endif
    phase_10(P, lds, 18); GB;
#if defined(PROBE_PH) && PROBE_PH == 18
    { int nrep = PROBE_N; asm volatile("" : "+s"(nrep)); for (int rep = 0; rep < nrep; ++rep) { GB; phase_10(P, lds, 18); GB; } }
#endif
    phase_11(P, lds, 19); GB;
#if defined(PROBE_PH) && PROBE_PH == 19
    { int nrep = PROBE_N; asm volatile("" : "+s"(nrep)); for (int rep = 0; rep < nrep; ++rep) { GB; phase_11(P, lds, 19); GB; } }
#endif
    phase_12(P, lds, 20); GB;
#if defined(PROBE_PH) && PROBE_PH == 20
    { int nrep = PROBE_N; asm volatile("" : "+s"(nrep)); for (int rep = 0; rep < nrep; ++rep) { GB; phase_12(P, lds, 20); GB; } }
#endif
    phase_13(P, lds, 21);
#if defined(PROBE_PH) && (PROBE_PH == 121)
    { int nrep = PROBE_N; asm volatile("" : "+s"(nrep)); for (int rep = 0; rep < nrep; ++rep) { GB; phase_13(P, lds, PROBE_PH); GB; } }
#endif
#undef P
#undef GB
}

extern "C" void kernel_launch(void* const* d_in, const int* in_sizes, int n_in, void* d_out, int out_size, void* d_ws, size_t ws_size, hipStream_t stream) {
    static int ready = 0;
    if (!ready) {
        if (n_in != 35 || ws_size < WS_TOTAL) { fprintf(stderr, "kernel_launch: unexpected n_in %d or ws_size %zu (need %zu)\n", n_in, ws_size, (size_t)WS_TOTAL); ready = -1; return; }
        if (hipFuncSetAttribute((const void*)mega, hipFuncAttributeMaxDynamicSharedMemorySize, LDS_BYTES) != hipSuccess) { fprintf(stderr, "kernel_launch: hipFuncSetAttribute failed\n"); ready = -1; return; }
        ready = 1;
    }
    if (ready < 0) return;
    (void)hipMemsetAsync((char*)d_ws + WS_CTL, 0, 32768, stream);
    Params P{};
    for (int i = 0; i < 35; ++i) P.in[i] = (const float*)d_in[i];
    P.out = (float*)d_out; P.ws = (unsigned char*)d_ws; P.ph_lo = 0; P.ph_hi = 0;
    hipLaunchKernelGGL(mega, dim3(GRID), dim3(512), LDS_BYTES, stream, P);
}
```
